# Optimizing an MI355X kernel written in HIP

```python
import math
import jax, jax.numpy as jnp
from jax import lax
import numpy as np

D_MODEL = 1024
BATCH = 4
SEQ = 4096
DEPTH = 2
DEC_BATCH = 128
DEC_SEQ = 4
PAST_LEN = 2048
PAGE_SIZE = 128

N_META = 16
D_FF = 4 * D_MODEL
LN_EPS = 1e-5
DEEPNORM_ALPHA = (2 * DEPTH) ** 0.25
DEEPNORM_BETA = (8 * DEPTH) ** -0.25
N_GDN_LAYERS = (DEPTH + 1) // 2
N_DSA_LAYERS = DEPTH // 2

GDN_K_HEADS = 8
GDN_V_HEADS = 16
GDN_HEAD_K = 128
GDN_HEAD_V = 128
GDN_KEY_DIM = GDN_K_HEADS * GDN_HEAD_K
GDN_VALUE_DIM = GDN_V_HEADS * GDN_HEAD_V
GDN_CONV_DIM = 2 * GDN_KEY_DIM + GDN_VALUE_DIM
GDN_CONV_WIDTH = 4
GDN_CHUNK = 64
GDN_IN_DIM = GDN_CONV_DIM + GDN_VALUE_DIM + 2 * GDN_V_HEADS
L2_EPS = 1e-6
RMS_EPS = 1e-6

ATT_HEADS = 8
ATT_KV_HEADS = 2
ATT_HEAD_DIM = 128
IDX_HEADS = 8
IDX_HEAD_DIM = 64
TOPK_MAX = 256
Q_BLOCK = 128
ROPE_THETA = 500000.0
ATT_ROT_DIM = ATT_HEAD_DIM // 4
IDX_ROT_DIM = IDX_HEAD_DIM // 4
DSA_SIZES = (ATT_HEADS * ATT_HEAD_DIM, ATT_KV_HEADS * ATT_HEAD_DIM, ATT_KV_HEADS * ATT_HEAD_DIM,
             IDX_HEADS * IDX_HEAD_DIM, IDX_HEAD_DIM, IDX_HEADS)
DSA_IN_DIM = sum(DSA_SIZES)

kernel_name = "hybrid_gdn_dsa_decoder_step"

F32 = jnp.float32


def _layernorm(x, g, b):
    xf = x.astype(F32)
    mu = jnp.mean(xf, -1, keepdims=True)
    var = jnp.mean(jnp.square(xf - mu), -1, keepdims=True)
    return ((xf - mu) * lax.rsqrt(var + LN_EPS) * g.astype(F32) + b.astype(F32)).astype(x.dtype)


def _l2norm(x):
    xf = x.astype(F32)
    return xf * lax.rsqrt(jnp.sum(xf * xf, -1, keepdims=True) + L2_EPS)


def _rope_partial(x, pos, rot_dim):
    half = rot_dim // 2
    inv_freq = ROPE_THETA ** (-jnp.arange(half, dtype=F32) * 2.0 / rot_dim)
    ang = pos.astype(F32)[:, None] * inv_freq[None, :]
    cos = jnp.cos(ang)[:, None, :]
    sin = jnp.sin(ang)[:, None, :]
    xf = x.astype(F32)
    x1 = xf[..., :half]
    x2 = xf[..., half:rot_dim]
    out = jnp.concatenate([x1 * cos - x2 * sin, x2 * cos + x1 * sin, xf[..., rot_dim:]], -1)
    return out.astype(x.dtype)


def _sqrelu_mlp(x, w1, w2):
    return jnp.square(jax.nn.relu(x @ w1)) @ w2


def _gdn_project(x, w_in):
    proj = x @ w_in
    c0 = GDN_CONV_DIM
    c1 = c0 + GDN_VALUE_DIM
    mixed = proj[..., :c0]
    z = proj[..., c0:c1]
    b = proj[..., c1:c1 + GDN_V_HEADS]
    a = proj[..., c1 + GDN_V_HEADS:]
    return mixed, z, b, a


def _causal_conv_silu(xp, conv_w, T):
    out = xp[:, 0:T] * conv_w[0]
    for j in range(1, GDN_CONV_WIDTH):
        out = out + xp[:, j:j + T] * conv_w[j]
    return jax.nn.silu(out)


def _gdn_heads(mixed_c, b, a, a_log, dt_bias):
    B, T, _ = mixed_c.shape
    rep = GDN_V_HEADS // GDN_K_HEADS
    q = mixed_c[..., :GDN_KEY_DIM].reshape(B, T, GDN_K_HEADS, GDN_HEAD_K)
    k = mixed_c[..., GDN_KEY_DIM:2 * GDN_KEY_DIM].reshape(B, T, GDN_K_HEADS, GDN_HEAD_K)
    v = mixed_c[..., 2 * GDN_KEY_DIM:].reshape(B, T, GDN_V_HEADS, GDN_HEAD_V).astype(F32)
    q = jnp.repeat(_l2norm(q), rep, axis=2) * (GDN_HEAD_K ** -0.5)
    k = jnp.repeat(_l2norm(k), rep, axis=2)
    beta = jax.nn.sigmoid(b.astype(F32))
    g = -jnp.exp(a_log.astype(F32)) * jax.nn.softplus(a.astype(F32) + dt_bias.astype(F32))
    return q, k, v, beta, g


def _gdn_chunked(q, k, v, beta, g, s0):
    B, T, H, _ = q.shape
    dv = v.shape[-1]
    C = GDN_CHUNK
    N = T // C

    def to_chunks(t):
        return jnp.moveaxis(t.reshape((B, N, C) + t.shape[2:]), 3, 1)

    qc, kc, vc, bc = to_chunks(q), to_chunks(k), to_chunks(v), to_chunks(beta)
    gc = jnp.cumsum(to_chunks(g), axis=-1)
    tril = jnp.tril(jnp.ones((C, C), bool))
    strict = jnp.tril(jnp.ones((C, C), bool), -1)
    diff = gc[..., :, None] - gc[..., None, :]
    decay = jnp.where(tril, jnp.exp(jnp.where(tril, diff, 0.0)), 0.0)
    kk = jnp.einsum('bhncd,bhnsd->bhncs', kc, kc)
    a_mat = jnp.where(strict, kk * decay * bc[..., :, None], 0.0)
    eye = jnp.eye(C, dtype=F32)
    rhs = jnp.concatenate([vc * bc[..., None], kc * (bc * jnp.exp(gc))[..., None]], -1)
    sol = lax.linalg.triangular_solve(eye + a_mat, rhs, left_side=True, lower=True,
                                      unit_diagonal=True)
    u = sol[..., :dv]
    w = sol[..., dv:]
    qk = jnp.einsum('bhncd,bhnsd->bhncs', qc, kc) * decay
    qg = qc * jnp.exp(gc)[..., None]
    glast = gc[..., -1]
    kd = kc * jnp.exp(glast[..., None] - gc)[..., None]

    def step(S, xs):
        u_i, w_i, qg_i, qk_i, kd_i, gl_i = xs
        v_new = u_i - jnp.einsum('bhck,bhkv->bhcv', w_i, S)
        o = jnp.einsum('bhck,bhkv->bhcv', qg_i, S) + jnp.einsum('bhcs,bhsv->bhcv', qk_i, v_new)
        S = S * jnp.exp(gl_i)[..., None, None] + jnp.einsum('bhck,bhcv->bhkv', kd_i, v_new)
        return S, o

    xs = tuple(jnp.moveaxis(t, 2, 0) for t in (u, w, qg, qk, kd, glast))
    s_final, o = lax.scan(step, s0, xs)
    o = jnp.moveaxis(o, 0, 2).reshape(B, H, T, dv).transpose(0, 2, 1, 3)
    return o, s_final


def _gdn_output(o, z, norm_w, w_out, dtype):
    B, T = o.shape[:2]
    on = o * lax.rsqrt(jnp.mean(o * o, -1, keepdims=True) + RMS_EPS) * norm_w.astype(F32)
    zf = z.astype(F32).reshape(B, T, GDN_V_HEADS, GDN_HEAD_V)
    out = (on * jax.nn.silu(zf)).reshape(B, T, GDN_VALUE_DIM).astype(dtype)
    return out @ w_out


def _gdn_prompt(x, w_in, conv_w, a_log, dt_bias, norm_w, w_out):
    B, L, _ = x.shape
    mixed, z, b, a = _gdn_project(x, w_in)
    xp = jnp.concatenate([jnp.zeros((B, GDN_CONV_WIDTH - 1, GDN_CONV_DIM), mixed.dtype), mixed], 1)
    conv_tail = xp[:, -(GDN_CONV_WIDTH - 1):]
    q, k, v, beta, g = _gdn_heads(_causal_conv_silu(xp, conv_w, L), b, a, a_log, dt_bias)
    n_pad = (-N_META) % GDN_CHUNK
    n_tail = (-(n_pad + L)) % GDN_CHUNK

    def padt(t):
        return jnp.pad(t, ((0, 0), (n_pad, n_tail)) + ((0, 0),) * (t.ndim - 2))

    s0 = jnp.zeros((B, GDN_V_HEADS, GDN_HEAD_K, GDN_HEAD_V), F32)
    o, s_final = _gdn_chunked(padt(q), padt(k), padt(v), padt(beta), padt(g), s0)
    o = o[:, n_pad:n_pad + L]
    return _gdn_output(o, z, norm_w, w_out, x.dtype), s_final, conv_tail


def _gdn_sample(x, state, conv_state, w_in, conv_w, a_log, dt_bias, norm_w, w_out):
    B, T, _ = x.shape
    mixed, z, b, a = _gdn_project(x, w_in)
    xp = jnp.concatenate([conv_state.astype(mixed.dtype), mixed], 1)
    conv_new = xp[:, -(GDN_CONV_WIDTH - 1):]
    q, k, v, beta, g = _gdn_heads(_causal_conv_silu(xp, conv_w, T), b, a, a_log, dt_bias)

    def step(S, xs):
        q_t, k_t, v_t, b_t, g_t = xs
        S = S * jnp.exp(g_t)[..., None, None]
        delta = (v_t - jnp.einsum('bhk,bhkv->bhv', k_t, S)) * b_t[..., None]
        S = S + jnp.einsum('bhk,bhv->bhkv', k_t, delta)
        return S, jnp.einsum('bhk,bhkv->bhv', q_t, S)

    xs = tuple(jnp.moveaxis(t, 1, 0) for t in (q, k, v, beta, g))
    s_new, o = lax.scan(step, state.astype(F32), xs)
    o = jnp.moveaxis(o, 0, 1)
    return _gdn_output(o, z, norm_w, w_out, x.dtype), s_new, conv_new


def _dsa_project(x, pos, w_in, ik_g, ik_b):
    B, T, _ = x.shape
    splits = np.cumsum(DSA_SIZES)[:-1].tolist()
    q, k, v, iq, ik, iw = jnp.split(x @ w_in, splits, axis=-1)
    q = _rope_partial(q.reshape(B, T, ATT_HEADS, ATT_HEAD_DIM), pos, ATT_ROT_DIM)
    k = _rope_partial(k.reshape(B, T, ATT_KV_HEADS, ATT_HEAD_DIM), pos, ATT_ROT_DIM)
    v = v.reshape(B, T, ATT_KV_HEADS, ATT_HEAD_DIM)
    iq = _rope_partial(iq.reshape(B, T, IDX_HEADS, IDX_HEAD_DIM), pos, IDX_ROT_DIM)
    ik = _rope_partial(_layernorm(ik, ik_g, ik_b)[:, :, None, :], pos, IDX_ROT_DIM)[:, :, 0, :]
    iw = iw * (IDX_HEADS ** -0.5)
    return q, k, v, iq, ik, iw


def _index_topk(iq, iw, qpos, ik, topk):
    dots = jnp.einsum('bthd,bsd->bths', iq.astype(F32), ik.astype(F32))
    score = jnp.einsum('bth,bths->bts', iw.astype(F32), jax.nn.relu(dots)) * (IDX_HEAD_DIM ** -0.5)
    kpos = jnp.arange(ik.shape[1], dtype=jnp.int32)
    score = jnp.where(kpos[None, None, :] < N_META, jnp.inf, score)
    score = jnp.where(kpos[None, None, :] <= qpos[None, :, None], score, -jnp.inf)
    _, sel = lax.top_k(score, topk)
    valid = sel <= qpos[None, :, None]
    return sel, valid


def _sparse_attend(q, kg, vg, valid):
    B, T, H, Dh = q.shape
    G = H // ATT_KV_HEADS
    qg = q.reshape(B, T, ATT_KV_HEADS, G, Dh).astype(F32)
    s = jnp.einsum('bthgd,btkhd->bthgk', qg, kg.astype(F32)) * (Dh ** -0.5)
    s = jnp.where(valid[:, :, None, None, :], s, -jnp.inf)
    p = jax.nn.softmax(s, axis=-1)
    o = jnp.einsum('bthgk,btkhd->bthgd', p, vg.astype(F32))
    return o.reshape(B, T, H * Dh)


def _gather_rows(rows, sel):
    return jax.vmap(lambda r, s: r[s])(rows, sel)


def _dsa_prompt(x, w_in, ik_g, ik_b, w_o):
    B, L, _ = x.shape
    pos = jnp.arange(L, dtype=jnp.int32)
    q, k, v, iq, ik, iw = _dsa_project(x, pos, w_in, ik_g, ik_b)
    topk = min(TOPK_MAX, (L - N_META) // 4)
    n_blk = -(-L // Q_BLOCK)
    pad = n_blk * Q_BLOCK - L

    def padq(t):
        return jnp.pad(t, ((0, 0), (0, pad)) + ((0, 0),) * (t.ndim - 2))

    qp, iqp, iwp = padq(q), padq(iq), padq(iw)

    def block(i):
        s0 = i * Q_BLOCK
        qb = lax.dynamic_slice_in_dim(qp, s0, Q_BLOCK, axis=1)
        iqb = lax.dynamic_slice_in_dim(iqp, s0, Q_BLOCK, axis=1)
        iwb = lax.dynamic_slice_in_dim(iwp, s0, Q_BLOCK, axis=1)
        qpos = s0 + jnp.arange(Q_BLOCK, dtype=jnp.int32)
        sel, valid = _index_topk(iqb, iwb, qpos, ik, topk)
        return _sparse_attend(qb, _gather_rows(k, sel), _gather_rows(v, sel), valid)

    o = lax.map(block, jnp.arange(n_blk, dtype=jnp.int32))
    o = jnp.moveaxis(o, 0, 1).reshape(B, n_blk * Q_BLOCK, -1)[:, :L]
    return o.astype(x.dtype) @ w_o, k, v, ik


def _dsa_sample(x, cache_k, cache_v, cache_ik, page_table, w_in, ik_g, ik_b, w_o):
    B, T, _ = x.shape
    past = page_table.shape[1] * PAGE_SIZE
    pos = past + jnp.arange(T, dtype=jnp.int32)
    q, k, v, iq, ik, iw = _dsa_project(x, pos, w_in, ik_g, ik_b)
    ik_past = cache_ik[page_table].reshape(B, past, IDX_HEAD_DIM)
    ik_all = jnp.concatenate([ik_past.astype(ik.dtype), ik], 1)
    topk = min(TOPK_MAX, (past + T) // 4)
    sel, valid = _index_topk(iq, iw, pos, ik_all, topk)
    in_past = sel < past
    sp = jnp.minimum(sel, past - 1)
    phys = jax.vmap(lambda pt, s: pt[s])(page_table, sp // PAGE_SIZE)
    off = sp % PAGE_SIZE
    sn = jnp.clip(sel - past, 0, T - 1)

    def gather(pool, new):
        rows_past = pool[phys, off]
        rows_new = _gather_rows(new, sn)
        return jnp.where(in_past[..., None, None], rows_past.astype(new.dtype), rows_new)

    o = _sparse_attend(q, gather(cache_k, k), gather(cache_v, v), valid)
    return o.astype(x.dtype) @ w_o, k, v, ik


def setup_inputs(seed: int = 0) -> dict:
    key = jax.random.key(seed)
    ks = jax.random.split(key, 26)

    def nrm(kk, shape, scale=1.0):
        return jax.random.normal(kk, shape, F32) * scale

    n_pages = PAST_LEN // PAGE_SIZE
    n_used = DEC_BATCH * n_pages
    n_pool = n_used + (n_used + 3) // 4
    page_table = jax.random.permutation(ks[0], n_pool)[:n_used].reshape(DEC_BATCH, n_pages).astype(jnp.int32)
    ng, nd = N_GDN_LAYERS, N_DSA_LAYERS
    dt = jnp.exp(jax.random.uniform(ks[1], (ng, GDN_V_HEADS), F32, math.log(1e-3), math.log(1e-1)))
    return {
        "x_prompt": nrm(ks[2], (BATCH, SEQ, D_MODEL)),
        "x_sample": nrm(ks[3], (DEC_BATCH, DEC_SEQ, D_MODEL)),
        "state_gdn": nrm(ks[4], (ng, DEC_BATCH, GDN_V_HEADS, GDN_HEAD_K, GDN_HEAD_V), 0.2),
        "state_gdn_conv": nrm(ks[5], (ng, DEC_BATCH, GDN_CONV_WIDTH - 1, GDN_CONV_DIM)),
        "cache_k": nrm(ks[6], (nd, n_pool, PAGE_SIZE, ATT_KV_HEADS, ATT_HEAD_DIM)),
        "cache_v": nrm(ks[7], (nd, n_pool, PAGE_SIZE, ATT_KV_HEADS, ATT_HEAD_DIM)),
        "cache_idx_k": nrm(ks[8], (nd, n_pool, PAGE_SIZE, IDX_HEAD_DIM)),
        "page_table": page_table,
        "meta_tokens": nrm(ks[9], (N_META, D_MODEL)),
        "ln1_g": 1.0 + nrm(ks[10], (DEPTH, D_MODEL), 0.05),
        "ln1_b": nrm(ks[11], (DEPTH, D_MODEL), 0.02),
        "ln2_g": 1.0 + nrm(ks[12], (DEPTH, D_MODEL), 0.05),
        "ln2_b": nrm(ks[13], (DEPTH, D_MODEL), 0.02),
        "mlp_w1": nrm(ks[14], (DEPTH, D_MODEL, D_FF), D_MODEL ** -0.5),
        "mlp_w2": nrm(ks[15], (DEPTH, D_FF, D_MODEL), DEEPNORM_BETA * D_FF ** -0.5),
        "gdn_w_in": nrm(ks[16], (ng, D_MODEL, GDN_IN_DIM), D_MODEL ** -0.5),
        "gdn_conv_w": nrm(ks[17], (ng, GDN_CONV_WIDTH, GDN_CONV_DIM), GDN_CONV_WIDTH ** -0.5),
        "gdn_a_log": jnp.log(jax.random.uniform(ks[18], (ng, GDN_V_HEADS), F32, 1.0, 16.0)),
        "gdn_dt_bias": dt + jnp.log(-jnp.expm1(-dt)),
        "gdn_norm_w": 1.0 + nrm(ks[19], (ng, GDN_HEAD_V), 0.05),
        "gdn_w_out": nrm(ks[20], (ng, GDN_VALUE_DIM, D_MODEL), DEEPNORM_BETA * GDN_VALUE_DIM ** -0.5),
        "dsa_w_in": nrm(ks[21], (nd, D_MODEL, DSA_IN_DIM), D_MODEL ** -0.5),
        "dsa_ik_norm_g": 1.0 + nrm(ks[22], (nd, IDX_HEAD_DIM), 0.05),
        "dsa_ik_norm_b": nrm(ks[23], (nd, IDX_HEAD_DIM), 0.02),
        "dsa_w_o": nrm(ks[24], (nd, ATT_HEADS * ATT_HEAD_DIM, D_MODEL),
                       DEEPNORM_BETA * (ATT_HEADS * ATT_HEAD_DIM) ** -0.5),
    }


def reference(x_prompt, x_sample, state_gdn, state_gdn_conv, cache_k, cache_v, cache_idx_k, page_table,
              meta_tokens, ln1_g, ln1_b, ln2_g, ln2_b, mlp_w1, mlp_w2,
              gdn_w_in, gdn_conv_w, gdn_a_log, gdn_dt_bias, gdn_norm_w, gdn_w_out,
              dsa_w_in, dsa_ik_norm_g, dsa_ik_norm_b, dsa_w_o):
    B = x_prompt.shape[0]
    meta = jnp.broadcast_to(meta_tokens[None].astype(x_prompt.dtype), (B, N_META, D_MODEL))
    hp = jnp.concatenate([meta, x_prompt], 1)
    hs = x_sample
    gsp, gcp, gss, gcs = [], [], [], []
    kp, vp, ikp, ksm, vsm, iks = [], [], [], [], [], []
    for i in range(DEPTH):
        j = i // 2
        if i % 2 == 0:
            mp, s_p, c_p = _gdn_prompt(hp, gdn_w_in[j], gdn_conv_w[j], gdn_a_log[j], gdn_dt_bias[j],
                                       gdn_norm_w[j], gdn_w_out[j])
            ms, s_s, c_s = _gdn_sample(hs, state_gdn[j], state_gdn_conv[j], gdn_w_in[j], gdn_conv_w[j],
                                       gdn_a_log[j], gdn_dt_bias[j], gdn_norm_w[j], gdn_w_out[j])
            gsp.append(s_p.astype(state_gdn.dtype))
            gcp.append(c_p.astype(state_gdn_conv.dtype))
            gss.append(s_s.astype(state_gdn.dtype))
            gcs.append(c_s.astype(state_gdn_conv.dtype))
        else:
            mp, k_p, v_p, ik_p = _dsa_prompt(hp, dsa_w_in[j], dsa_ik_norm_g[j], dsa_ik_norm_b[j], dsa_w_o[j])
            ms, k_s, v_s, ik_s = _dsa_sample(hs, cache_k[j], cache_v[j], cache_idx_k[j], page_table,
                                             dsa_w_in[j], dsa_ik_norm_g[j], dsa_ik_norm_b[j], dsa_w_o[j])
            kp.append(k_p)
            vp.append(v_p)
            ikp.append(ik_p)
            ksm.append(k_s)
            vsm.append(v_s)
            iks.append(ik_s)
        hp = _layernorm(DEEPNORM_ALPHA * hp + mp, ln1_g[i], ln1_b[i])
        hs = _layernorm(DEEPNORM_ALPHA * hs + ms, ln1_g[i], ln1_b[i])
        hp = _layernorm(DEEPNORM_ALPHA * hp + _sqrelu_mlp(hp, mlp_w1[i], mlp_w2[i]), ln2_g[i], ln2_b[i])
        hs = _layernorm(DEEPNORM_ALPHA * hs + _sqrelu_mlp(hs, mlp_w1[i], mlp_w2[i]), ln2_g[i], ln2_b[i])
    y_prompt = hp[:, N_META:]
    return (y_prompt, hs, jnp.stack(gsp), jnp.stack(gcp), jnp.stack(gss), jnp.stack(gcs),
            jnp.stack(kp), jnp.stack(vp), jnp.stack(ikp), jnp.stack(ksm), jnp.stack(vsm), jnp.stack(iks))
```

```cpp
#include <hip/hip_runtime.h>
#include <stdint.h>
#include <stdio.h>

#ifndef MEGA
#define MEGA 0
#endif

namespace {

typedef unsigned short bf16_t;
typedef short bf16x8 __attribute__((ext_vector_type(8)));
typedef float f32x4 __attribute__((ext_vector_type(4)));

constexpr int D = 1024, BATCH = 4, SEQ = 4096, NMETA = 16, LP = SEQ + NMETA;
constexpr int DB = 128, DS = 4, PAST = 2048;
constexpr int NPR = BATCH * LP;
constexpr int NSR = DB * DS;
constexpr int NT = NPR + NSR;
constexpr int MPAD = 17152;
constexpr int DFF = 4096;
constexpr int GIN = 6176, GIN_PAD = 6272;
constexpr int DIN = 2120, DIN_PAD = 2176;
constexpr int NTHR = 512;
constexpr int LDS_BYTES = 150 * 1024;
constexpr float ALPHA = 1.4142135623730951f;

struct Params {
    const float *x_prompt, *x_sample, *state_gdn, *state_conv, *cache_k, *cache_v, *cache_ik;
    const int* page_table;
    const float *meta, *ln1_g, *ln1_b, *ln2_g, *ln2_b, *mlp_w1, *mlp_w2, *gdn_w_in, *gdn_conv_w, *gdn_a_log, *gdn_dt_bias,
        *gdn_norm_w, *gdn_w_out, *dsa_w_in, *dsa_ik_g, *dsa_ik_b, *dsa_w_o;
    float *y_prompt, *y_sample, *gs_prompt, *gc_prompt, *gs_sample, *gc_sample, *k_prompt, *v_prompt, *ik_prompt, *k_sample,
        *v_sample, *ik_sample;
    unsigned* bar;
    bf16_t *wt_gin, *wt_gout, *wt_w1, *wt_w2, *wt_din, *wt_do;
    bf16_t *hA, *hB;
    float* preln;
    bf16_t *mixed, *z;
    float* ba;
    bf16_t *gated, *act;
    float *p1, *qr, *iq, *iw;
    int* sel;
};

__device__ const double kInvFreq[16] = {1.0, 0.44036660267178046, 0.19392274474868576, 0.08539710028576561,
    0.03760603093086393, 0.016560440080994446, 0.007292664737217109, 0.003211445994752591, 0.001414213562373095,
    0.000622772421914596, 0.0002742481756762073, 0.00012076973741146504, 5.318295896944988e-05, 2.341999896140934e-05,
    1.031338537721246e-05, 4.5416704806078695e-06};

__device__ __forceinline__ float bf2f(bf16_t h) { return __uint_as_float(((unsigned)h) << 16); }
__device__ __forceinline__ bf16_t f2bf(float f) {
    unsigned u = __float_as_uint(f);
    u += 0x7fffu + ((u >> 16) & 1u);
    return (bf16_t)(u >> 16);
}
__device__ __forceinline__ unsigned pk2(float lo, float hi) { return (unsigned)f2bf(lo) | ((unsigned)f2bf(hi) << 16); }
__device__ __forceinline__ void st_bf16x4(bf16_t* p, f32x4 v) {
    uint2 o; o.x = pk2(v[0], v[1]); o.y = pk2(v[2], v[3]);
    *(uint2*)p = o;
}
__device__ __forceinline__ f32x4 ld_bf16x4(const bf16_t* p) {
    uint2 o = *(const uint2*)p;
    f32x4 v; v[0] = __uint_as_float(o.x << 16); v[1] = __uint_as_float(o.x & 0xffff0000u);
    v[2] = __uint_as_float(o.y << 16); v[3] = __uint_as_float(o.y & 0xffff0000u);
    return v;
}
__device__ __forceinline__ float wave_sum(float v) {
#pragma unroll
    for (int o = 1; o < 64; o <<= 1) v += __shfl_xor(v, o);
    return v;
}
__device__ __forceinline__ float wave_max(float v) {
#pragma unroll
    for (int o = 1; o < 64; o <<= 1) v = fmaxf(v, __shfl_xor(v, o));
    return v;
}
__device__ __forceinline__ int wave_sum_i(int v) {
#pragma unroll
    for (int o = 1; o < 64; o <<= 1) v += __shfl_xor(v, o);
    return v;
}
__device__ __forceinline__ float silu(float x) { return x / (1.f + __expf(-x)); }
__device__ __forceinline__ void lds_fence() { asm volatile("s_waitcnt lgkmcnt(0)" ::: "memory"); }

__device__ __forceinline__ void transpose_convert(const float* __restrict__ W, int K, int N, int Npad, bf16_t* __restrict__ WT, float* tile,
                                  int bid, int nb) {
    const int tid = threadIdx.x;
    const int tk = K / 64, tn = Npad / 64;
    for (int it = bid; it < tk * tn; it += nb) {
        const int kb = it / tn, nbk = it % tn, k0 = kb * 64, n0 = nbk * 64;
#pragma unroll
        for (int i = 0; i < 8; ++i) {
            const int r = (tid >> 6) + 8 * i, c = tid & 63, n = n0 + c;
            tile[r * 65 + c] = (n < N) ? W[(size_t)(k0 + r) * N + n] : 0.f;
        }
        __syncthreads();
#pragma unroll
        for (int i = 0; i < 8; ++i) {
            const int rn = (tid >> 6) + 8 * i, ck = tid & 63;
            WT[(size_t)(n0 + rn) * K + k0 + ck] = f2bf(tile[ck * 65 + rn]);
        }
        __syncthreads();
    }
}

__device__ __forceinline__ void phase_prologue(const Params& p, char* smem, int bid, int nb) {
    float* tile = (float*)smem;
    transpose_convert(p.gdn_w_in, D, GIN, GIN_PAD, p.wt_gin, tile, bid, nb);
    transpose_convert(p.gdn_w_out, 2048, D, D, p.wt_gout, tile, bid, nb);
    transpose_convert(p.mlp_w1, D, DFF, DFF, p.wt_w1, tile, bid, nb);
    transpose_convert(p.mlp_w1 + (size_t)D * DFF, D, DFF, DFF, p.wt_w1 + (size_t)D * DFF, tile, bid, nb);
    transpose_convert(p.mlp_w2, DFF, D, D, p.wt_w2, tile, bid, nb);
    transpose_convert(p.mlp_w2 + (size_t)D * DFF, DFF, D, D, p.wt_w2 + (size_t)D * DFF, tile, bid, nb);
    transpose_convert(p.dsa_w_in, D, DIN, DIN_PAD, p.wt_din, tile, bid, nb);
    transpose_convert(p.dsa_w_o, D, D, D, p.wt_do, tile, bid, nb);
    for (int idx = bid * NTHR + threadIdx.x; idx < MPAD * 256; idx += nb * NTHR) {
        const int row = idx >> 8, c4 = (idx & 255) * 4;
        f32x4 v = {0.f, 0.f, 0.f, 0.f};
        if (row < NPR) {
            const int b = row / LP, t = row % LP;
            const float* src = (t < NMETA) ? (p.meta + (size_t)t * D) : (p.x_prompt + ((size_t)b * SEQ + (t - NMETA)) * D);
            v = *(const f32x4*)(src + c4);
        } else if (row < NT) {
            v = *(const f32x4*)(p.x_sample + (size_t)(row - NPR) * D + c4);
        }
        st_bf16x4(p.hA + (size_t)row * D + c4, v);
    }
}

template <class Epi>
__device__ __forceinline__ void gemm_phase(const bf16_t* __restrict__ A, int lda, const bf16_t* __restrict__ Bt, int K, int Mtiles, int Ntiles,
                           const Epi& epi, char* smem, int bid, int nb) {
    bf16_t* As = (bf16_t*)smem;
    bf16_t* Bs = As + 256 * 72;
    const int tid = threadIdx.x, lane = tid & 63, wave = tid >> 6;
    const int wm = wave >> 1, wn = wave & 1;
    const int fr = lane & 15, fq = lane >> 4;
    const int ntiles = Mtiles * Ntiles;
    const int nk = K / 64;
    for (int tile = bid; tile < ntiles; tile += nb) {
        const int tm = tile % Mtiles, tn = tile / Mtiles;
        const bf16_t* Ag = A + (size_t)tm * 256 * lda;
        const bf16_t* Bg = Bt + (size_t)tn * 128 * K;
        f32x4 acc[4][4];
#pragma unroll
        for (int i = 0; i < 4; ++i)
#pragma unroll
            for (int j = 0; j < 4; ++j) acc[i][j] = (f32x4){0.f, 0.f, 0.f, 0.f};
        const int c0 = tid, c1 = tid + 512, c2 = tid + 1024, c3 = tid + 1536;
        const bf16_t* ga0 = Ag + (size_t)(c0 >> 3) * lda + (c0 & 7) * 8;
        const bf16_t* ga1 = Ag + (size_t)(c1 >> 3) * lda + (c1 & 7) * 8;
        const bf16_t* ga2 = Ag + (size_t)(c2 >> 3) * lda + (c2 & 7) * 8;
        const bf16_t* ga3 = Ag + (size_t)(c3 >> 3) * lda + (c3 & 7) * 8;
        const bf16_t* gb0 = Bg + (size_t)(c0 >> 3) * K + (c0 & 7) * 8;
        const bf16_t* gb1 = Bg + (size_t)(c1 >> 3) * K + (c1 & 7) * 8;
        bf16_t* sa0 = As + (c0 >> 3) * 72 + (c0 & 7) * 8;
        bf16_t* sa1 = As + (c1 >> 3) * 72 + (c1 & 7) * 8;
        bf16_t* sa2 = As + (c2 >> 3) * 72 + (c2 & 7) * 8;
        bf16_t* sa3 = As + (c3 >> 3) * 72 + (c3 & 7) * 8;
        bf16_t* sb0 = Bs + (c0 >> 3) * 72 + (c0 & 7) * 8;
        bf16_t* sb1 = Bs + (c1 >> 3) * 72 + (c1 & 7) * 8;
        uint4 ra0 = *(const uint4*)ga0, ra1 = *(const uint4*)ga1, ra2 = *(const uint4*)ga2, ra3 = *(const uint4*)ga3;
        uint4 rb0 = *(const uint4*)gb0, rb1 = *(const uint4*)gb1;
        *(uint4*)sa0 = ra0; *(uint4*)sa1 = ra1; *(uint4*)sa2 = ra2; *(uint4*)sa3 = ra3; *(uint4*)sb0 = rb0; *(uint4*)sb1 = rb1;
        __syncthreads();
        for (int kt = 0; kt < nk; ++kt) {
            const bool more = (kt + 1 < nk);
            if (more) {
                const int k0 = (kt + 1) * 64;
                ra0 = *(const uint4*)(ga0 + k0); ra1 = *(const uint4*)(ga1 + k0); ra2 = *(const uint4*)(ga2 + k0); ra3 = *(const uint4*)(ga3 + k0);
                rb0 = *(const uint4*)(gb0 + k0); rb1 = *(const uint4*)(gb1 + k0);
            }
#pragma unroll
            for (int kk = 0; kk < 2; ++kk) {
                bf16x8 af[4], bfr[4];
#pragma unroll
                for (int i = 0; i < 4; ++i) af[i] = *(const bf16x8*)(As + (wm * 64 + i * 16 + fr) * 72 + kk * 32 + fq * 8);
#pragma unroll
                for (int j = 0; j < 4; ++j) bfr[j] = *(const bf16x8*)(Bs + (wn * 64 + j * 16 + fr) * 72 + kk * 32 + fq * 8);
#pragma unroll
                for (int i = 0; i < 4; ++i)
#pragma unroll
                    for (int j = 0; j < 4; ++j) acc[i][j] = __builtin_amdgcn_mfma_f32_16x16x32_bf16(bfr[j], af[i], acc[i][j], 0, 0, 0);
            }
            __syncthreads();
            if (more) {
                *(uint4*)sa0 = ra0; *(uint4*)sa1 = ra1; *(uint4*)sa2 = ra2; *(uint4*)sa3 = ra3; *(uint4*)sb0 = rb0; *(uint4*)sb1 = rb1;
                __syncthreads();
            }
        }
#pragma unroll
        for (int i = 0; i < 4; ++i)
#pragma unroll
            for (int j = 0; j < 4; ++j) {
                const int row = tm * 256 + wm * 64 + i * 16 + fr, col = tn * 128 + wn * 64 + j * 16 + fq * 4;
                epi(row, col, acc[i][j]);
            }
    }
}

struct EpiGdnIn {
    bf16_t *mixed, *z; float* ba;
    __device__ __forceinline__ void operator()(int row, int col, f32x4 v) const {
        if (col < 4096) st_bf16x4(mixed + (size_t)row * 4096 + col, v);
        else if (col < 6144) st_bf16x4(z + (size_t)row * 2048 + (col - 4096), v);
        else if (col < 6176) *(f32x4*)(ba + (size_t)row * 32 + (col - 6144)) = v;
    }
};
struct EpiResid {
    float* out; const bf16_t* h;
    __device__ __forceinline__ void operator()(int row, int col, f32x4 v) const {
        const f32x4 r = ld_bf16x4(h + (size_t)row * D + col);
        *(f32x4*)(out + (size_t)row * D + col) = v + r * ALPHA;
    }
};
struct EpiRelu2 {
    bf16_t* act;
    __device__ __forceinline__ void operator()(int row, int col, f32x4 v) const {
#pragma unroll
        for (int e = 0; e < 4; ++e) { const float r = fmaxf(v[e], 0.f); v[e] = r * r; }
        st_bf16x4(act + (size_t)row * DFF + col, v);
    }
};
struct EpiF32 {
    float* out; int ld;
    __device__ __forceinline__ void operator()(int row, int col, f32x4 v) const { *(f32x4*)(out + (size_t)row * ld + col) = v; }
};

__device__ __forceinline__ void ln_phase(const float* __restrict__ X, const float* __restrict__ g, const float* __restrict__ bta, bf16_t* Hout,
                         float* yp, float* ys, int bid, int nb) {
    const int lane = threadIdx.x & 63, wave = threadIdx.x >> 6;
    f32x4 gv[4], bv[4];
#pragma unroll
    for (int j = 0; j < 4; ++j) { gv[j] = *(const f32x4*)(g + j * 256 + lane * 4); bv[j] = *(const f32x4*)(bta + j * 256 + lane * 4); }
    for (int row = bid * 8 + wave; row < NT; row += nb * 8) {
        f32x4 v[4]; float s = 0.f;
#pragma unroll
        for (int j = 0; j < 4; ++j) { v[j] = *(const f32x4*)(X + (size_t)row * D + j * 256 + lane * 4); s += (v[j][0] + v[j][1]) + (v[j][2] + v[j][3]); }
        const float mean = wave_sum(s) * (1.f / D);
        float s2 = 0.f;
#pragma unroll
        for (int j = 0; j < 4; ++j) { v[j] = v[j] - mean; s2 += (v[j][0] * v[j][0] + v[j][1] * v[j][1]) + (v[j][2] * v[j][2] + v[j][3] * v[j][3]); }
        const float rstd = rsqrtf(wave_sum(s2) * (1.f / D) + 1e-5f);
        float* yo = nullptr;
        if (yp) {
            if (row < NPR) { const int b = row / LP, t = row % LP; if (t >= NMETA) yo = yp + ((size_t)b * SEQ + (t - NMETA)) * D; }
            else yo = ys + (size_t)(row - NPR) * D;
        }
#pragma unroll
        for (int j = 0; j < 4; ++j) {
            const f32x4 o = v[j] * rstd * gv[j] + bv[j];
            if (Hout) st_bf16x4(Hout + (size_t)row * D + j * 256 + lane * 4, o);
            if (yo) *(f32x4*)(yo + j * 256 + lane * 4) = o;
        }
    }
}

__device__ __forceinline__ void gdn_recurrent_phase(const Params& p, char* smem, int bid, int nb) {
    float* sq = (float*)smem;
    float* sk = sq + 128;
    float* sv = sk + 128;
    float* red = sv + 128;
    float* red2 = red + 512;
    float* part = red2 + 512;
    const int tid = threadIdx.x, lane = tid & 63, wave = tid >> 6;
    const int vcol = tid & 127, kq = tid >> 7;
    for (int idx = bid * NTHR + tid; idx < (BATCH + DB) * 3 * 4096; idx += nb * NTHR) {
        const int c = idx & 4095, r = (idx >> 12) % 3, b = idx / (3 * 4096);
        if (b < BATCH) p.gc_prompt[idx] = bf2f(p.mixed[((size_t)b * LP + (LP - 3) + r) * 4096 + c]);
        else { const int bs = b - BATCH; p.gc_sample[(size_t)(bs * 3 + r) * 4096 + c] = bf2f(p.mixed[((size_t)NPR + bs * 4 + 1 + r) * 4096 + c]); }
    }
    const int nunits = 64 + DB * 16;
    for (int u = bid; u < nunits; u += nb) {
        const bool is_prompt = u < 64;
        int b, h, T; size_t row0;
        if (is_prompt) { b = u >> 4; h = u & 15; T = LP; row0 = (size_t)b * LP; }
        else { const int uu = u - 64; b = uu >> 4; h = uu & 15; T = DS; row0 = (size_t)NPR + (size_t)b * DS; }
        const int kh = h >> 1;
        float S[32];
        if (is_prompt) {
#pragma unroll
            for (int i = 0; i < 32; ++i) S[i] = 0.f;
        } else {
            const float* Sp = p.state_gdn + ((size_t)(b * 16 + h) * 128) * 128;
#pragma unroll
            for (int i = 0; i < 32; ++i) S[i] = Sp[(size_t)(kq * 32 + i) * 128 + vcol];
        }
        const float Aexp = __expf(p.gdn_a_log[h]);
        const float dtb = p.gdn_dt_bias[h];
        const float nw = p.gdn_norm_w[vcol];
        const int which = tid >> 7;
        const int ch = (which == 0) ? (kh * 128 + vcol) : (which == 1) ? (1024 + kh * 128 + vcol) : (2048 + h * 128 + vcol);
        float cw[4];
#pragma unroll
        for (int j = 0; j < 4; ++j) cw[j] = p.gdn_conv_w[j * 4096 + ch];
        for (int t = 0; t < T; ++t) {
            if (tid < 384) {
                float a = 0.f;
#pragma unroll
                for (int j = 0; j < 4; ++j) {
                    const int tt = t - 3 + j;
                    float xv;
                    if (tt >= 0) xv = bf2f(p.mixed[(row0 + tt) * 4096 + ch]);
                    else xv = is_prompt ? 0.f : p.state_conv[((size_t)b * 3 + (tt + 3)) * 4096 + ch];
                    a += xv * cw[j];
                }
                const float y = silu(a);
                if (which == 0) sq[vcol] = y; else if (which == 1) sk[vcol] = y; else sv[vcol] = y;
                const float ss = wave_sum(y * y);
                if (lane == 0) part[wave] = ss;
            }
            __syncthreads();
            const float qn = rsqrtf(part[0] + part[1] + 1e-6f) * 0.08838834764831845f;
            const float kn = rsqrtf(part[2] + part[3] + 1e-6f);
            const float* bap = p.ba + (row0 + t) * 32;
            const float beta = 1.f / (1.f + __expf(-bap[h]));
            const float aa = bap[16 + h] + dtb;
            const float sp = (aa > 20.f) ? aa : log1pf(__expf(aa));
            const float dec = __expf(-Aexp * sp);
            float ks_part = 0.f;
#pragma unroll
            for (int i = 0; i < 32; ++i) { S[i] *= dec; ks_part += sk[kq * 32 + i] * S[i]; }
            red[kq * 128 + vcol] = ks_part * kn;
            __syncthreads();
            const float kS = (red[vcol] + red[128 + vcol]) + (red[256 + vcol] + red[384 + vcol]);
            const float delta = (sv[vcol] - kS) * beta * kn;
            float o_part = 0.f;
#pragma unroll
            for (int i = 0; i < 32; ++i) { S[i] += sk[kq * 32 + i] * delta; o_part += sq[kq * 32 + i] * S[i]; }
            red2[kq * 128 + vcol] = o_part * qn;
            __syncthreads();
            float o = 0.f;
            if (tid < 128) {
                o = (red2[vcol] + red2[128 + vcol]) + (red2[256 + vcol] + red2[384 + vcol]);
                const float ss = wave_sum(o * o);
                if (lane == 0) part[8 + wave] = ss;
            }
            __syncthreads();
            if (tid < 128) {
                const float rms = rsqrtf((part[8] + part[9]) * (1.f / 128.f) + 1e-6f);
                const float zz = bf2f(p.z[(row0 + t) * 2048 + h * 128 + vcol]);
                p.gated[(row0 + t) * 2048 + h * 128 + vcol] = f2bf(o * rms * nw * silu(zz));
            }
        }
        float* So = (is_prompt ? p.gs_prompt : p.gs_sample) + ((size_t)(b * 16 + h) * 128) * 128;
#pragma unroll
        for (int i = 0; i < 32; ++i) So[(size_t)(kq * 32 + i) * 128 + vcol] = S[i];
        __syncthreads();
    }
}

__device__ __forceinline__ void rope_cs(int pos, int fi, float& c, float& s) {
    const double rev = (double)pos * kInvFreq[fi] * 0.15915494309189535;
    const float r = (float)(rev - floor(rev));
    c = __builtin_amdgcn_cosf(r);
    s = __builtin_amdgcn_sinf(r);
}
__device__ __forceinline__ void dsa_post_phase(const Params& p, int bid, int nb) {
    const int lane = threadIdx.x & 63, wave = threadIdx.x >> 6;
    for (int row = bid * 8 + wave; row < NT; row += nb * 8) {
        const float* P = p.p1 + (size_t)row * DIN_PAD;
        const bool prompt = row < NPR;
        const int pos = prompt ? (row % LP) : (PAST + ((row - NPR) & 3));
        float* kout = prompt ? (p.k_prompt + (size_t)row * 256) : (p.k_sample + (size_t)(row - NPR) * 256);
        float* vout = prompt ? (p.v_prompt + (size_t)row * 256) : (p.v_sample + (size_t)(row - NPR) * 256);
        for (int e = lane; e < 1280; e += 64) {
            const int d = e & 127;
            float o = P[e];
            if (d < 32) {
                float c, s; rope_cs(pos, d & 15, c, s);
                if (d < 16) o = o * c - P[e + 16] * s; else o = o * c + P[e - 16] * s;
            }
            if (e < 1024) p.qr[(size_t)row * 1024 + e] = o; else kout[e - 1024] = o;
        }
        for (int e = lane; e < 256; e += 64) vout[e] = P[1280 + e];
        for (int e = lane; e < 512; e += 64) {
            const int d = e & 63;
            float o = P[1536 + e];
            if (d < 16) {
                float c, s; rope_cs(pos, (d & 7) * 2, c, s);
                if (d < 8) o = o * c - P[1536 + e + 8] * s; else o = o * c + P[1536 + e - 8] * s;
            }
            p.iq[(size_t)row * 512 + e] = o;
        }
        {
            const float x = P[2048 + lane];
            const float mu = wave_sum(x) * (1.f / 64.f);
            const float dv = x - mu;
            const float var = wave_sum(dv * dv) * (1.f / 64.f);
            const float xn = dv * rsqrtf(var + 1e-5f) * p.dsa_ik_g[lane] + p.dsa_ik_b[lane];
            const float other = __shfl_xor(xn, 8);
            float o = xn;
            if (lane < 16) {
                float c, s; rope_cs(pos, (lane & 7) * 2, c, s);
                if (lane < 8) o = xn * c - other * s; else o = xn * c + other * s;
            }
            float* io = prompt ? (p.ik_prompt + (size_t)row * 64) : (p.ik_sample + (size_t)(row - NPR) * 64);
            io[lane] = o;
        }
        if (lane < 8) p.iw[(size_t)row * 8 + lane] = P[2112 + lane] * 0.35355339059327373f;
    }
}

__device__ __forceinline__ const float* ik_row(const Params& p, bool prompt, int b, int s) {
    if (prompt) return p.ik_prompt + ((size_t)b * LP + s) * 64;
    if (s < PAST) { const int pg = p.page_table[b * 16 + (s >> 7)]; return p.cache_ik + ((size_t)pg * 128 + (s & 127)) * 64; }
    return p.ik_sample + ((size_t)b * DS + (s - PAST)) * 64;
}
__device__ __forceinline__ const float* kv_row(const float* own_p, const float* own_s, const float* cache, const int* page_table,
                                               bool prompt, int b, int s) {
    if (prompt) return own_p + ((size_t)b * LP + s) * 256;
    if (s < PAST) { const int pg = page_table[b * 16 + (s >> 7)]; return cache + ((size_t)pg * 128 + (s & 127)) * 256; }
    return own_s + ((size_t)b * DS + (s - PAST)) * 256;
}

__device__ __forceinline__ void indexer_phase(const Params& p, char* smem, int bid, int nb) {
    const int lane = threadIdx.x & 63, wave = threadIdx.x >> 6;
    float* sc = (float*)smem + wave * (4096 + 512);
    float* qs = sc + 4096;
    const unsigned long long ltmask = (1ull << lane) - 1ull;
    for (int row = bid * 8 + wave; row < NT; row += nb * 8) {
        const bool prompt = row < NPR;
        int b, qpos;
        if (prompt) { b = row / LP; qpos = row % LP; } else { b = (row - NPR) >> 2; qpos = PAST + ((row - NPR) & 3); }
        int* selrow = p.sel + (size_t)row * 256;
        const int n = qpos - 15;
        if (n <= 240) {
            for (int j = lane; j < 256; j += 64) selrow[j] = (j <= qpos) ? j : -1;
            continue;
        }
        for (int j = lane; j < 512; j += 64) qs[j] = p.iq[(size_t)row * 512 + j];
        float w[8];
#pragma unroll
        for (int h = 0; h < 8; ++h) w[h] = p.iw[(size_t)row * 8 + h];
        lds_fence();
        for (int j0 = 0; j0 < n; j0 += 64) {
            const int s = 16 + j0 + lane;
            const bool valid = s <= qpos;
            const float* kp = ik_row(p, prompt, b, valid ? s : qpos);
            f32x4 kv[16];
#pragma unroll
            for (int c = 0; c < 16; ++c) kv[c] = *(const f32x4*)(kp + c * 4);
            float score = 0.f;
#pragma unroll
            for (int h = 0; h < 8; ++h) {
                float d = 0.f;
#pragma unroll
                for (int c = 0; c < 16; ++c) {
                    const f32x4 q4 = *(const f32x4*)(qs + h * 64 + c * 4);
                    d += kv[c][0] * q4[0]; d += kv[c][1] * q4[1]; d += kv[c][2] * q4[2]; d += kv[c][3] * q4[3];
                }
                score += w[h] * fmaxf(d, 0.f);
            }
            sc[j0 + lane] = valid ? score : -INFINITY;
        }
        lds_fence();
        unsigned key[64];
#pragma unroll
        for (int j = 0; j < 64; ++j) {
            const int idx = j * 64 + lane;
            const float x = (idx < n) ? sc[idx] : -INFINITY;
            const unsigned u = __float_as_uint(x);
            key[j] = (u & 0x80000000u) ? ~u : (u | 0x80000000u);
        }
        lds_fence();
        unsigned T = 0u;
        for (int bit = 31; bit >= 0; --bit) {
            const unsigned cand = T | (1u << bit);
            int c = 0;
#pragma unroll
            for (int j = 0; j < 64; ++j) c += (key[j] >= cand) ? 1 : 0;
            c = wave_sum_i(c);
            if (c >= 240) T = cand;
        }
        int cgt = 0;
#pragma unroll
        for (int j = 0; j < 64; ++j) cgt += (key[j] > T) ? 1 : 0;
        cgt = wave_sum_i(cgt);
        const int need_eq = 240 - cgt;
        if (lane < 16) selrow[lane] = lane;
        int base = 16, erun = 0;
#pragma unroll
        for (int j = 0; j < 64; ++j) {
            const bool gt = key[j] > T, eq = key[j] == T;
            const unsigned long long meq = __ballot(eq);
            const int rank = erun + __popcll(meq & ltmask);
            const bool take = gt || (eq && rank < need_eq);
            const unsigned long long m = __ballot(take);
            if (take) selrow[base + __popcll(m & ltmask)] = 16 + j * 64 + lane;
            base += __popcll(m);
            erun += __popcll(meq);
        }
    }
}

__device__ __forceinline__ void attn_phase(const Params& p, char* smem, int bid, int nb) {
    float* qs = (float*)smem;
    float* ps = qs + 1024;
    int* sidx = (int*)(ps + 2048);
    const int tid = threadIdx.x, lane = tid & 63, wave = tid >> 6;
    for (int row = bid; row < NT; row += nb) {
        const bool prompt = row < NPR;
        const int b = prompt ? (row / LP) : ((row - NPR) >> 2);
        qs[tid] = p.qr[(size_t)row * 1024 + tid];
        qs[tid + 512] = p.qr[(size_t)row * 1024 + 512 + tid];
        if (tid < 256) sidx[tid] = p.sel[(size_t)row * 256 + tid];
        __syncthreads();
        {
            const int j = tid & 255, kvh = tid >> 8;
            const int s = sidx[j];
            const bool valid = s >= 0;
            const float* kp = kv_row(p.k_prompt, p.k_sample, p.cache_k, p.page_table, prompt, b, valid ? s : 0) + kvh * 128;
            float d0 = 0.f, d1 = 0.f, d2 = 0.f, d3 = 0.f;
            const float* q0 = qs + (kvh * 4) * 128;
#pragma unroll 8
            for (int c = 0; c < 32; ++c) {
                const f32x4 kv = *(const f32x4*)(kp + c * 4);
                const f32x4 a0 = *(const f32x4*)(q0 + c * 4), a1 = *(const f32x4*)(q0 + 128 + c * 4), a2 = *(const f32x4*)(q0 + 256 + c * 4),
                            a3 = *(const f32x4*)(q0 + 384 + c * 4);
                d0 += kv[0] * a0[0] + kv[1] * a0[1] + kv[2] * a0[2] + kv[3] * a0[3];
                d1 += kv[0] * a1[0] + kv[1] * a1[1] + kv[2] * a1[2] + kv[3] * a1[3];
                d2 += kv[0] * a2[0] + kv[1] * a2[1] + kv[2] * a2[2] + kv[3] * a2[3];
                d3 += kv[0] * a3[0] + kv[1] * a3[1] + kv[2] * a3[2] + kv[3] * a3[3];
            }
            const float sc = 0.08838834764831845f;
            ps[(kvh * 4 + 0) * 256 + j] = valid ? d0 * sc : -INFINITY;
            ps[(kvh * 4 + 1) * 256 + j] = valid ? d1 * sc : -INFINITY;
            ps[(kvh * 4 + 2) * 256 + j] = valid ? d2 * sc : -INFINITY;
            ps[(kvh * 4 + 3) * 256 + j] = valid ? d3 * sc : -INFINITY;
        }
        __syncthreads();
        {
            float v[4]; float m = -INFINITY;
#pragma unroll
            for (int i = 0; i < 4; ++i) { v[i] = ps[wave * 256 + lane + 64 * i]; m = fmaxf(m, v[i]); }
            m = wave_max(m);
            float sum = 0.f;
#pragma unroll
            for (int i = 0; i < 4; ++i) { v[i] = __expf(v[i] - m); sum += v[i]; }
            sum = wave_sum(sum);
            const float inv = 1.f / sum;
#pragma unroll
            for (int i = 0; i < 4; ++i) ps[wave * 256 + lane + 64 * i] = v[i] * inv;
        }
        __syncthreads();
        {
            const int h = wave, d = lane * 2, kvh = h >> 2;
            float o0 = 0.f, o1 = 0.f;
            for (int j = 0; j < 256; ++j) {
                int s = sidx[j]; if (s < 0) s = 0;
                const float* vp = kv_row(p.v_prompt, p.v_sample, p.cache_v, p.page_table, prompt, b, s) + kvh * 128 + d;
                const float pj = ps[h * 256 + j];
                const float2 vv = *(const float2*)vp;
                o0 += pj * vv.x; o1 += pj * vv.y;
            }
            *(unsigned*)(p.gated + (size_t)row * 1024 + h * 128 + d) = pk2(o0, o1);
        }
        __syncthreads();
    }
}

constexpr int NPHASE = 17;
template <int PH>
__device__ __forceinline__ void run_phase(const Params& p, char* smem, int bid, int nb) {
    constexpr int MT = MPAD / 256;
    if constexpr (PH == 0) phase_prologue(p, smem, bid, nb);
    else if constexpr (PH == 1) gemm_phase(p.hA, D, p.wt_gin, D, MT, GIN_PAD / 128, EpiGdnIn{p.mixed, p.z, p.ba}, smem, bid, nb);
    else if constexpr (PH == 2) gdn_recurrent_phase(p, smem, bid, nb);
    else if constexpr (PH == 3) gemm_phase(p.gated, 2048, p.wt_gout, 2048, MT, D / 128, EpiResid{p.preln, p.hA}, smem, bid, nb);
    else if constexpr (PH == 4) ln_phase(p.preln, p.ln1_g, p.ln1_b, p.hB, nullptr, nullptr, bid, nb);
    else if constexpr (PH == 5) gemm_phase(p.hB, D, p.wt_w1, D, MT, DFF / 128, EpiRelu2{p.act}, smem, bid, nb);
    else if constexpr (PH == 6) gemm_phase(p.act, DFF, p.wt_w2, DFF, MT, D / 128, EpiResid{p.preln, p.hB}, smem, bid, nb);
    else if constexpr (PH == 7) ln_phase(p.preln, p.ln2_g, p.ln2_b, p.hA, nullptr, nullptr, bid, nb);
    else if constexpr (PH == 8) gemm_phase(p.hA, D, p.wt_din, D, MT, DIN_PAD / 128, EpiF32{p.p1, DIN_PAD}, smem, bid, nb);
    else if constexpr (PH == 9) dsa_post_phase(p, bid, nb);
    else if constexpr (PH == 10) indexer_phase(p, smem, bid, nb);
    else if constexpr (PH == 11) attn_phase(p, smem, bid, nb);
    else if constexpr (PH == 12) gemm_phase(p.gated, D, p.wt_do, D, MT, D / 128, EpiResid{p.preln, p.hA}, smem, bid, nb);
    else if constexpr (PH == 13) ln_phase(p.preln, p.ln1_g + D, p.ln1_b + D, p.hB, nullptr, nullptr, bid, nb);
    else if constexpr (PH == 14) gemm_phase(p.hB, D, p.wt_w1 + (size_t)D * DFF, D, MT, DFF / 128, EpiRelu2{p.act}, smem, bid, nb);
    else if constexpr (PH == 15) gemm_phase(p.act, DFF, p.wt_w2 + (size_t)D * DFF, DFF, MT, D / 128, EpiResid{p.preln, p.hB}, smem, bid, nb);
    else if constexpr (PH == 16) ln_phase(p.preln, p.ln2_g + D, p.ln2_b + D, nullptr, p.y_prompt, p.y_sample, bid, nb);
}

template <int PH>
__global__ void __launch_bounds__(NTHR, 2) k_phase(Params p) {
    extern __shared__ __attribute__((aligned(16))) char smem[];
    run_phase<PH>(p, smem, blockIdx.x, gridDim.x);
}

template <int PH>
void launch_phase(const Params& p, hipStream_t stream) {
    static bool attr_done = false;
    if (!attr_done) {
        hipFuncSetAttribute((const void*)k_phase<PH>, hipFuncAttributeMaxDynamicSharedMemorySize, LDS_BYTES);
        attr_done = true;
    }
    hipLaunchKernelGGL(k_phase<PH>, dim3(256), dim3(NTHR), LDS_BYTES, stream, p);
}
template <int PH>
void launch_all(const Params& p, hipStream_t stream) {
    launch_phase<PH>(p, stream);
    if constexpr (PH + 1 < NPHASE) launch_all<PH + 1>(p, stream);
}

}

extern "C" void kernel_launch(void* const* d_in, const int* in_sizes, int n_in, void* d_out, int out_size, void* d_ws, size_t ws_size,
                              hipStream_t stream) {
    Params p{};
    p.x_prompt = (const float*)d_in[0]; p.x_sample = (const float*)d_in[1]; p.state_gdn = (const float*)d_in[2];
    p.state_conv = (const float*)d_in[3]; p.cache_k = (const float*)d_in[4]; p.cache_v = (const float*)d_in[5];
    p.cache_ik = (const float*)d_in[6]; p.page_table = (const int*)d_in[7]; p.meta = (const float*)d_in[8];
    p.ln1_g = (const float*)d_in[9]; p.ln1_b = (const float*)d_in[10]; p.ln2_g = (const float*)d_in[11]; p.ln2_b = (const float*)d_in[12];
    p.mlp_w1 = (const float*)d_in[13]; p.mlp_w2 = (const float*)d_in[14]; p.gdn_w_in = (const float*)d_in[15];
    p.gdn_conv_w = (const float*)d_in[16]; p.gdn_a_log = (const float*)d_in[17]; p.gdn_dt_bias = (const float*)d_in[18];
    p.gdn_norm_w = (const float*)d_in[19]; p.gdn_w_out = (const float*)d_in[20]; p.dsa_w_in = (const float*)d_in[21];
    p.dsa_ik_g = (const float*)d_in[22]; p.dsa_ik_b = (const float*)d_in[23]; p.dsa_w_o = (const float*)d_in[24];
    float* o = (float*)d_out;
    p.y_prompt = o; o += (size_t)BATCH * SEQ * D;
    p.y_sample = o; o += (size_t)NSR * D;
    p.gs_prompt = o; o += (size_t)BATCH * 16 * 128 * 128;
    p.gc_prompt = o; o += (size_t)BATCH * 3 * 4096;
    p.gs_sample = o; o += (size_t)DB * 16 * 128 * 128;
    p.gc_sample = o; o += (size_t)DB * 3 * 4096;
    p.k_prompt = o; o += (size_t)NPR * 256;
    p.v_prompt = o; o += (size_t)NPR * 256;
    p.ik_prompt = o; o += (size_t)NPR * 64;
    p.k_sample = o; o += (size_t)NSR * 256;
    p.v_sample = o; o += (size_t)NSR * 256;
    p.ik_sample = o; o += (size_t)NSR * 64;
    char* w = (char*)d_ws;
    auto take = [&](size_t bytes) { char* r = w; w += (bytes + 255) & ~(size_t)255; return r; };
    p.bar = (unsigned*)take(16384);
    p.wt_gin = (bf16_t*)take((size_t)GIN_PAD * D * 2);
    p.wt_gout = (bf16_t*)take((size_t)D * 2048 * 2);
    p.wt_w1 = (bf16_t*)take((size_t)2 * D * DFF * 2);
    p.wt_w2 = (bf16_t*)take((size_t)2 * D * DFF * 2);
    p.wt_din = (bf16_t*)take((size_t)DIN_PAD * D * 2);
    p.wt_do = (bf16_t*)take((size_t)D * D * 2);
    p.hA = (bf16_t*)take((size_t)MPAD * D * 2);
    p.hB = (bf16_t*)take((size_t)MPAD * D * 2);
    p.preln = (float*)take((size_t)MPAD * D * 4);
    p.mixed = (bf16_t*)take((size_t)MPAD * 4096 * 2);
    p.z = (bf16_t*)take((size_t)MPAD * 2048 * 2);
    p.ba = (float*)take((size_t)MPAD * 32 * 4);
    p.gated = (bf16_t*)take((size_t)MPAD * 2048 * 2);
    p.act = (bf16_t*)take((size_t)MPAD * DFF * 2);
    p.p1 = (float*)take((size_t)MPAD * DIN_PAD * 4);
    p.qr = (float*)take((size_t)MPAD * 1024 * 4);
    p.iq = (float*)take((size_t)MPAD * 512 * 4);
    p.iw = (float*)take((size_t)MPAD * 8 * 4);
    p.sel = (int*)take((size_t)MPAD * 256 * 4);
    if ((size_t)(w - (char*)d_ws) > ws_size) { fprintf(stderr, "kernel_launch: workspace too small (%zu needed, %zu given)\n", (size_t)(w - (char*)d_ws), ws_size); return; }
    launch_all<0>(p, stream);
}
```

```cpp
#include <hip/hip_runtime.h>
#include <stdint.h>
#include <stdio.h>

#ifndef MEGA
#define MEGA 1
#endif

namespace {

typedef unsigned short bf16_t;
typedef short bf16x8 __attribute__((ext_vector_type(8)));
typedef float f32x4 __attribute__((ext_vector_type(4)));

constexpr int D = 1024, BATCH = 4, SEQ = 4096, NMETA = 16, LP = SEQ + NMETA;
constexpr int DB = 128, DS = 4, PAST = 2048;
constexpr int NPR = BATCH * LP;
constexpr int NSR = DB * DS;
constexpr int NT = NPR + NSR;
constexpr int MPAD = 17152;
constexpr int DFF = 4096;
constexpr int GIN = 6176, GIN_PAD = 6272;
constexpr int DIN = 2120, DIN_PAD = 2176;
constexpr int NTHR = 512;
constexpr int LDS_BYTES = 150 * 1024;
constexpr float ALPHA = 1.4142135623730951f;

struct Params {
    const float *x_prompt, *x_sample, *state_gdn, *state_conv, *cache_k, *cache_v, *cache_ik;
    const int* page_table;
    const float *meta, *ln1_g, *ln1_b, *ln2_g, *ln2_b, *mlp_w1, *mlp_w2, *gdn_w_in, *gdn_conv_w, *gdn_a_log, *gdn_dt_bias,
        *gdn_norm_w, *gdn_w_out, *dsa_w_in, *dsa_ik_g, *dsa_ik_b, *dsa_w_o;
    float *y_prompt, *y_sample, *gs_prompt, *gc_prompt, *gs_sample, *gc_sample, *k_prompt, *v_prompt, *ik_prompt, *k_sample,
        *v_sample, *ik_sample;
    unsigned* bar;
    bf16_t *wt_gin, *wt_gout, *wt_w1, *wt_w2, *wt_din, *wt_do;
    bf16_t *hA, *hB;
    float* preln;
    bf16_t *mixed, *z;
    float* ba;
    bf16_t *gated, *act;
    float *p1, *qr, *iq, *iw;
    int* sel;
    bf16_t *g_negw, *g_qg, *g_kdT, *g_aqk;
    float *g_u, *g_dec, *g_o;
};

__device__ const double kInvFreq[16] = {1.0, 0.44036660267178046, 0.19392274474868576, 0.08539710028576561,
    0.03760603093086393, 0.016560440080994446, 0.007292664737217109, 0.003211445994752591, 0.001414213562373095,
    0.000622772421914596, 0.0002742481756762073, 0.00012076973741146504, 5.318295896944988e-05, 2.341999896140934e-05,
    1.031338537721246e-05, 4.5416704806078695e-06};

__device__ __forceinline__ float bf2f(bf16_t h) { return __uint_as_float(((unsigned)h) << 16); }
typedef __bf16 hwbf16x2 __attribute__((ext_vector_type(2)));
typedef float f32x2 __attribute__((ext_vector_type(2)));
typedef float f32x16 __attribute__((ext_vector_type(16)));
typedef unsigned u32x4 __attribute__((ext_vector_type(4)));
__device__ __forceinline__ unsigned pk2(float lo, float hi) {
    const f32x2 v = {lo, hi};
    return __builtin_bit_cast(unsigned, __builtin_convertvector(v, hwbf16x2));
}
__device__ __forceinline__ bf16_t f2bf(float f) { return (bf16_t)(pk2(f, 0.f) & 0xffffu); }
__device__ __forceinline__ void st_bf16x4(bf16_t* p, f32x4 v) {
    uint2 o; o.x = pk2(v[0], v[1]); o.y = pk2(v[2], v[3]);
    *(uint2*)p = o;
}
__device__ __forceinline__ f32x4 cvt_bf16x4(uint2 o) {
    f32x4 v; v[0] = __uint_as_float(o.x << 16); v[1] = __uint_as_float(o.x & 0xffff0000u);
    v[2] = __uint_as_float(o.y << 16); v[3] = __uint_as_float(o.y & 0xffff0000u);
    return v;
}
__device__ __forceinline__ f32x4 ld_bf16x4(const bf16_t* p) {
    uint2 o = *(const uint2*)p;
    f32x4 v; v[0] = __uint_as_float(o.x << 16); v[1] = __uint_as_float(o.x & 0xffff0000u);
    v[2] = __uint_as_float(o.y << 16); v[3] = __uint_as_float(o.y & 0xffff0000u);
    return v;
}
__device__ __forceinline__ float wave_sum(float v) {
#pragma unroll
    for (int o = 1; o < 64; o <<= 1) v += __shfl_xor(v, o);
    return v;
}
__device__ __forceinline__ float wave_max(float v) {
#pragma unroll
    for (int o = 1; o < 64; o <<= 1) v = fmaxf(v, __shfl_xor(v, o));
    return v;
}
__device__ __forceinline__ int wave_sum_i(int v) {
#pragma unroll
    for (int o = 1; o < 64; o <<= 1) v += __shfl_xor(v, o);
    return v;
}
__device__ __forceinline__ float silu(float x) { return x / (1.f + __expf(-x)); }
__device__ __forceinline__ void lds_fence() { asm volatile("s_waitcnt lgkmcnt(0)" ::: "memory"); }

__device__ __forceinline__ void transpose_convert(const float* __restrict__ W, int K, int N, int Npad, bf16_t* __restrict__ WT, float* tile,
                                  int bid, int nb) {
    const int tid = threadIdx.x;
    const int tk = K / 64, tn = Npad / 64;
    for (int it = bid; it < tk * tn; it += nb) {
        const int kb = it / tn, nbk = it % tn, k0 = kb * 64, n0 = nbk * 64;
#pragma unroll
        for (int i = 0; i < 8; ++i) {
            const int r = (tid >> 6) + 8 * i, c = tid & 63, n = n0 + c;
            tile[r * 65 + c] = (n < N) ? W[(size_t)(k0 + r) * N + n] : 0.f;
        }
        __syncthreads();
#pragma unroll
        for (int i = 0; i < 8; ++i) {
            const int rn = (tid >> 6) + 8 * i, ck = tid & 63;
            WT[(size_t)(n0 + rn) * K + k0 + ck] = f2bf(tile[ck * 65 + rn]);
        }
        __syncthreads();
    }
}

__device__ __forceinline__ void phase_prologue(const Params& p, char* smem, int bid, int nb) {
    float* tile = (float*)smem;
    transpose_convert(p.gdn_w_in, D, GIN, GIN_PAD, p.wt_gin, tile, bid, nb);
    transpose_convert(p.gdn_w_out, 2048, D, D, p.wt_gout, tile, bid, nb);
    transpose_convert(p.mlp_w1, D, DFF, DFF, p.wt_w1, tile, bid, nb);
    transpose_convert(p.mlp_w1 + (size_t)D * DFF, D, DFF, DFF, p.wt_w1 + (size_t)D * DFF, tile, bid, nb);
    transpose_convert(p.mlp_w2, DFF, D, D, p.wt_w2, tile, bid, nb);
    transpose_convert(p.mlp_w2 + (size_t)D * DFF, DFF, D, D, p.wt_w2 + (size_t)D * DFF, tile, bid, nb);
    transpose_convert(p.dsa_w_in, D, DIN, DIN_PAD, p.wt_din, tile, bid, nb);
    transpose_convert(p.dsa_w_o, D, D, D, p.wt_do, tile, bid, nb);
    for (int idx = bid * NTHR + threadIdx.x; idx < MPAD * 256; idx += nb * NTHR) {
        const int row = idx >> 8, c4 = (idx & 255) * 4;
        f32x4 v = {0.f, 0.f, 0.f, 0.f};
        if (row < NPR) {
            const int b = row / LP, t = row % LP;
            const float* src = (t < NMETA) ? (p.meta + (size_t)t * D) : (p.x_prompt + ((size_t)b * SEQ + (t - NMETA)) * D);
            v = *(const f32x4*)(src + c4);
        } else if (row < NT) {
            v = *(const f32x4*)(p.x_sample + (size_t)(row - NPR) * D + c4);
        }
        st_bf16x4(p.hA + (size_t)row * D + c4, v);
    }
}

template <class Epi>
__device__ __forceinline__ void gemm_phase(const bf16_t* __restrict__ A, int lda, const bf16_t* __restrict__ Bt, int K, int Mtiles, int Ntiles,
                           const Epi& epi, char* smem, int bid, int nb) {
    bf16_t* As = (bf16_t*)smem;
    bf16_t* Bs = As + 256 * 72;
    const int tid = threadIdx.x, lane = tid & 63, wave = tid >> 6;
    const int wm = wave >> 1, wn = wave & 1;
    const int fr = lane & 15, fq = lane >> 4;
    const int ntiles = Mtiles * Ntiles;
    const int nk = K / 64;
    for (int tile = bid; tile < ntiles; tile += nb) {
        const int tm = tile % Mtiles, tn = tile / Mtiles;
        const bf16_t* Ag = A + (size_t)tm * 256 * lda;
        const bf16_t* Bg = Bt + (size_t)tn * 128 * K;
        f32x4 acc[4][4];
#pragma unroll
        for (int i = 0; i < 4; ++i)
#pragma unroll
            for (int j = 0; j < 4; ++j) acc[i][j] = (f32x4){0.f, 0.f, 0.f, 0.f};
        const int c0 = tid, c1 = tid + 512, c2 = tid + 1024, c3 = tid + 1536;
        const bf16_t* ga0 = Ag + (size_t)(c0 >> 3) * lda + (c0 & 7) * 8;
        const bf16_t* ga1 = Ag + (size_t)(c1 >> 3) * lda + (c1 & 7) * 8;
        const bf16_t* ga2 = Ag + (size_t)(c2 >> 3) * lda + (c2 & 7) * 8;
        const bf16_t* ga3 = Ag + (size_t)(c3 >> 3) * lda + (c3 & 7) * 8;
        const bf16_t* gb0 = Bg + (size_t)(c0 >> 3) * K + (c0 & 7) * 8;
        const bf16_t* gb1 = Bg + (size_t)(c1 >> 3) * K + (c1 & 7) * 8;
        bf16_t* sa0 = As + (c0 >> 3) * 72 + (c0 & 7) * 8;
        bf16_t* sa1 = As + (c1 >> 3) * 72 + (c1 & 7) * 8;
        bf16_t* sa2 = As + (c2 >> 3) * 72 + (c2 & 7) * 8;
        bf16_t* sa3 = As + (c3 >> 3) * 72 + (c3 & 7) * 8;
        bf16_t* sb0 = Bs + (c0 >> 3) * 72 + (c0 & 7) * 8;
        bf16_t* sb1 = Bs + (c1 >> 3) * 72 + (c1 & 7) * 8;
        uint4 ra0 = *(const uint4*)ga0, ra1 = *(const uint4*)ga1, ra2 = *(const uint4*)ga2, ra3 = *(const uint4*)ga3;
        uint4 rb0 = *(const uint4*)gb0, rb1 = *(const uint4*)gb1;
        *(uint4*)sa0 = ra0; *(uint4*)sa1 = ra1; *(uint4*)sa2 = ra2; *(uint4*)sa3 = ra3; *(uint4*)sb0 = rb0; *(uint4*)sb1 = rb1;
        __syncthreads();
        for (int kt = 0; kt < nk; ++kt) {
            const bool more = (kt + 1 < nk);
            if (more) {
                const int k0 = (kt + 1) * 64;
                ra0 = *(const uint4*)(ga0 + k0); ra1 = *(const uint4*)(ga1 + k0); ra2 = *(const uint4*)(ga2 + k0); ra3 = *(const uint4*)(ga3 + k0);
                rb0 = *(const uint4*)(gb0 + k0); rb1 = *(const uint4*)(gb1 + k0);
            }
#pragma unroll
            for (int kk = 0; kk < 2; ++kk) {
                bf16x8 af[4], bfr[4];
#pragma unroll
                for (int i = 0; i < 4; ++i) af[i] = *(const bf16x8*)(As + (wm * 64 + i * 16 + fr) * 72 + kk * 32 + fq * 8);
#pragma unroll
                for (int j = 0; j < 4; ++j) bfr[j] = *(const bf16x8*)(Bs + (wn * 64 + j * 16 + fr) * 72 + kk * 32 + fq * 8);
#pragma unroll
                for (int i = 0; i < 4; ++i)
#pragma unroll
                    for (int j = 0; j < 4; ++j) acc[i][j] = __builtin_amdgcn_mfma_f32_16x16x32_bf16(bfr[j], af[i], acc[i][j], 0, 0, 0);
            }
            __syncthreads();
            if (more) {
                *(uint4*)sa0 = ra0; *(uint4*)sa1 = ra1; *(uint4*)sa2 = ra2; *(uint4*)sa3 = ra3; *(uint4*)sb0 = rb0; *(uint4*)sb1 = rb1;
                __syncthreads();
            }
        }
#pragma unroll
        for (int i = 0; i < 4; ++i)
#pragma unroll
            for (int j = 0; j < 4; ++j) {
                const int row = tm * 256 + wm * 64 + i * 16 + fr, col = tn * 128 + wn * 64 + j * 16 + fq * 4;
                epi(row, col, acc[i][j]);
            }
    }
}

struct EpiGdnIn {
    bf16_t *mixed, *z; float* ba;
    __device__ __forceinline__ void operator()(int row, int col, f32x4 v) const {
        if (col < 4096) st_bf16x4(mixed + (size_t)row * 4096 + col, v);
        else if (col < 6144) st_bf16x4(z + (size_t)row * 2048 + (col - 4096), v);
        else if (col < 6176) *(f32x4*)(ba + (size_t)row * 32 + (col - 6144)) = v;
    }
};
struct EpiResid {
    float* out; const bf16_t* h;
    __device__ __forceinline__ void operator()(int row, int col, f32x4 v) const {
        const f32x4 r = ld_bf16x4(h + (size_t)row * D + col);
        *(f32x4*)(out + (size_t)row * D + col) = v + r * ALPHA;
    }
};
struct EpiRelu2 {
    bf16_t* act;
    __device__ __forceinline__ void operator()(int row, int col, f32x4 v) const {
#pragma unroll
        for (int e = 0; e < 4; ++e) { const float r = fmaxf(v[e], 0.f); v[e] = r * r; }
        st_bf16x4(act + (size_t)row * DFF + col, v);
    }
};
struct EpiF32 {
    float* out; int ld;
    __device__ __forceinline__ void operator()(int row, int col, f32x4 v) const { *(f32x4*)(out + (size_t)row * ld + col) = v; }
};

__device__ __forceinline__ void ln_phase(const float* __restrict__ X, const float* __restrict__ g, const float* __restrict__ bta, bf16_t* Hout,
                         float* yp, float* ys, int bid, int nb) {
    const int lane = threadIdx.x & 63, wave = threadIdx.x >> 6;
    f32x4 gv[4], bv[4];
#pragma unroll
    for (int j = 0; j < 4; ++j) { gv[j] = *(const f32x4*)(g + j * 256 + lane * 4); bv[j] = *(const f32x4*)(bta + j * 256 + lane * 4); }
    for (int row = bid * 8 + wave; row < NT; row += nb * 8) {
        f32x4 v[4]; float s = 0.f;
#pragma unroll
        for (int j = 0; j < 4; ++j) { v[j] = *(const f32x4*)(X + (size_t)row * D + j * 256 + lane * 4); s += (v[j][0] + v[j][1]) + (v[j][2] + v[j][3]); }
        const float mean = wave_sum(s) * (1.f / D);
        float s2 = 0.f;
#pragma unroll
        for (int j = 0; j < 4; ++j) { v[j] = v[j] - mean; s2 += (v[j][0] * v[j][0] + v[j][1] * v[j][1]) + (v[j][2] * v[j][2] + v[j][3] * v[j][3]); }
        const float rstd = rsqrtf(wave_sum(s2) * (1.f / D) + 1e-5f);
        float* yo = nullptr;
        if (yp) {
            if (row < NPR) { const int b = row / LP, t = row % LP; if (t >= NMETA) yo = yp + ((size_t)b * SEQ + (t - NMETA)) * D; }
            else yo = ys + (size_t)(row - NPR) * D;
        }
#pragma unroll
        for (int j = 0; j < 4; ++j) {
            const f32x4 o = v[j] * rstd * gv[j] + bv[j];
            if (Hout) st_bf16x4(Hout + (size_t)row * D + j * 256 + lane * 4, o);
            if (yo) *(f32x4*)(yo + j * 256 + lane * 4) = o;
        }
    }
}

__device__ __forceinline__ void gdn_sample_unit(const Params& p, char* smem, int b, int h) {
    float* sq = (float*)smem;
    float* sk = sq + 128;
    float* sv = sk + 128;
    float* red = sv + 128;
    float* red2 = red + 512;
    float* part = red2 + 512;
    const int tid = threadIdx.x, lane = tid & 63, wave = tid >> 6;
    const int vcol = tid & 127, kq = tid >> 7;
    const size_t row0 = (size_t)NPR + (size_t)b * DS;
    const int kh = h >> 1;
    float S[32];
    {
        const float* Sp = p.state_gdn + ((size_t)(b * 16 + h) * 128) * 128;
#pragma unroll
        for (int i = 0; i < 32; ++i) S[i] = Sp[(size_t)(kq * 32 + i) * 128 + vcol];
    }
    const float Aexp = __expf(p.gdn_a_log[h]);
    const float dtb = p.gdn_dt_bias[h];
    const float nw = p.gdn_norm_w[vcol];
    const int which = tid >> 7;
    const int ch = (which == 0) ? (kh * 128 + vcol) : (which == 1) ? (1024 + kh * 128 + vcol) : (2048 + h * 128 + vcol);
    float cw[4];
#pragma unroll
    for (int j = 0; j < 4; ++j) cw[j] = p.gdn_conv_w[j * 4096 + ch];
    for (int t = 0; t < DS; ++t) {
        if (tid < 384) {
            float a = 0.f;
#pragma unroll
            for (int j = 0; j < 4; ++j) {
                const int tt = t - 3 + j;
                float xv;
                if (tt >= 0) xv = bf2f(p.mixed[(row0 + tt) * 4096 + ch]);
                else xv = p.state_conv[((size_t)b * 3 + (tt + 3)) * 4096 + ch];
                a += xv * cw[j];
            }
            const float y = silu(a);
            if (which == 0) sq[vcol] = y; else if (which == 1) sk[vcol] = y; else sv[vcol] = y;
            const float ss = wave_sum(y * y);
            if (lane == 0) part[wave] = ss;
        }
        __syncthreads();
        const float qn = rsqrtf(part[0] + part[1] + 1e-6f) * 0.08838834764831845f;
        const float kn = rsqrtf(part[2] + part[3] + 1e-6f);
        const float* bap = p.ba + (row0 + t) * 32;
        const float beta = 1.f / (1.f + __expf(-bap[h]));
        const float aa = bap[16 + h] + dtb;
        const float sp = (aa > 20.f) ? aa : log1pf(__expf(aa));
        const float dec = __expf(-Aexp * sp);
        float ks_part = 0.f;
#pragma unroll
        for (int i = 0; i < 32; ++i) { S[i] *= dec; ks_part += sk[kq * 32 + i] * S[i]; }
        red[kq * 128 + vcol] = ks_part * kn;
        __syncthreads();
        const float kS = (red[vcol] + red[128 + vcol]) + (red[256 + vcol] + red[384 + vcol]);
        const float delta = (sv[vcol] - kS) * beta * kn;
        float o_part = 0.f;
#pragma unroll
        for (int i = 0; i < 32; ++i) { S[i] += sk[kq * 32 + i] * delta; o_part += sq[kq * 32 + i] * S[i]; }
        red2[kq * 128 + vcol] = o_part * qn;
        __syncthreads();
        float o = 0.f;
        if (tid < 128) {
            o = (red2[vcol] + red2[128 + vcol]) + (red2[256 + vcol] + red2[384 + vcol]);
            const float ss = wave_sum(o * o);
            if (lane == 0) part[8 + wave] = ss;
        }
        __syncthreads();
        if (tid < 128) {
            const float rms = rsqrtf((part[8] + part[9]) * (1.f / 128.f) + 1e-6f);
            const float zz = bf2f(p.z[(row0 + t) * 2048 + h * 128 + vcol]);
            p.gated[(row0 + t) * 2048 + h * 128 + vcol] = f2bf(o * rms * nw * silu(zz));
        }
    }
    float* So = p.gs_sample + ((size_t)(b * 16 + h) * 128) * 128;
#pragma unroll
    for (int i = 0; i < 32; ++i) So[(size_t)(kq * 32 + i) * 128 + vcol] = S[i];
    __syncthreads();
}

#define MFMA32(a, b, c) __builtin_amdgcn_mfma_f32_32x32x16_bf16((a), (b), (c), 0, 0, 0)
constexpr int NCH = 65;
constexpr int NCU = BATCH * 16 * NCH;
__device__ __forceinline__ int crow(int reg, int hh) { return (reg & 3) + 8 * (reg >> 2) + 4 * hh; }
__device__ __forceinline__ bf16x8 pack_step(const f32x16& x, int s) {
    u32x4 q;
    q[0] = pk2(x[8 * s + 0], x[8 * s + 1]); q[1] = pk2(x[8 * s + 2], x[8 * s + 3]);
    q[2] = pk2(x[8 * s + 4], x[8 * s + 5]); q[3] = pk2(x[8 * s + 6], x[8 * s + 7]);
    return __builtin_bit_cast(bf16x8, q);
}
__device__ __forceinline__ bf16x8 frag_perm(const bf16_t* p0) {
    const uint2 lo = *(const uint2*)p0, hi = *(const uint2*)(p0 + 8);
    u32x4 q; q[0] = lo.x; q[1] = lo.y; q[2] = hi.x; q[3] = hi.y;
    return __builtin_bit_cast(bf16x8, q);
}

__device__ __forceinline__ void gdn_stageA(const Params& p, char* smem0, int bid, int nb) {
    const int tid = threadIdx.x, lane = tid & 63, wave = tid >> 6;
    for (int idx = bid * NTHR + tid; idx < (BATCH + DB) * 3 * 4096; idx += nb * NTHR) {
        const int c = idx & 4095, r = (idx >> 12) % 3, b = idx / (3 * 4096);
        if (b < BATCH) p.gc_prompt[idx] = bf2f(p.mixed[((size_t)b * LP + (LP - 3) + r) * 4096 + c]);
        else { const int bs = b - BATCH; p.gc_sample[(size_t)(bs * 3 + r) * 4096 + c] = bf2f(p.mixed[((size_t)NPR + bs * 4 + 1 + r) * 4096 + c]); }
    }
    for (int u = bid; u < NCU; u += nb) {
        unsigned zofs = 0; asm volatile("" : "+v"(zofs));
        char* smem = smem0 + zofs;
        bf16_t* Qb = (bf16_t*)smem;
        bf16_t* Kb = Qb + 64 * 136;
        float* RHS = (float*)(Kb + 64 * 136);
        float* Am = RHS + 64 * 256;
        float* sbeta = Am + 64 * 68;
        float* sgc = sbeta + 64;
        float* segc = sgc + 64;
        float* sekd = segc + 64;
        float* srk = sekd + 64;
        const int h = u & 15, n = (u >> 4) % NCH, b = u / (16 * NCH);
        const int kh = h >> 1;
        const size_t su = (size_t)((b * 16 + h) * NCH + n);
        const int t0 = n * 64;
        if (wave < 6) {
            const int part = wave >> 1, half = wave & 1;
            const int cq = lane & 31, tsub = lane >> 5;
            const int tl0 = 32 * half + 16 * tsub;
            const int chb = ((part == 0) ? (kh * 128) : (part == 1) ? (1024 + kh * 128) : (2048 + h * 128)) + cq * 4;
            f32x4 cw[4];
#pragma unroll
            for (int j = 0; j < 4; ++j) cw[j] = *(const f32x4*)(p.gdn_conv_w + j * 4096 + chb);
            uint2 xr[19];
#pragma unroll
            for (int i = 0; i < 19; ++i) {
                const int t = t0 + tl0 - 3 + i;
                if (t >= 0 && t < LP) xr[i] = *(const uint2*)(p.mixed + ((size_t)b * LP + t) * 4096 + chb);
                else xr[i] = make_uint2(0u, 0u);
            }
#pragma unroll
            for (int i = 0; i < 16; ++i) {
                const f32x4 a = cvt_bf16x4(xr[i]) * cw[0] + cvt_bf16x4(xr[i + 1]) * cw[1] + cvt_bf16x4(xr[i + 2]) * cw[2] + cvt_bf16x4(xr[i + 3]) * cw[3];
                const bool valid = (t0 + tl0 + i) < LP;
                f32x4 y;
#pragma unroll
                for (int e2 = 0; e2 < 4; ++e2) y[e2] = valid ? silu(a[e2]) : 0.f;
                const int c = tl0 + i;
                if (part < 2) {
                    float ss = (y[0] * y[0] + y[1] * y[1]) + (y[2] * y[2] + y[3] * y[3]);
#pragma unroll
                    for (int o = 1; o < 32; o <<= 1) ss += __shfl_xor(ss, o);
                    const float nrm = rsqrtf(ss + 1e-6f) * ((part == 0) ? 0.08838834764831845f : 1.f);
                    y = y * nrm;
                    if (part == 0) st_bf16x4(Qb + c * 136 + cq * 4, y);
                    else { st_bf16x4(Kb + c * 136 + cq * 4, y); *(f32x4*)(RHS + c * 256 + 128 + cq * 4) = y; }
                } else {
                    *(f32x4*)(RHS + c * 256 + cq * 4) = y;
                }
            }
        } else if (wave == 6) {
            const int c = lane, t = t0 + c;
            float beta = 0.f, g = 0.f;
            if (t < LP) {
                const float* bap = p.ba + ((size_t)b * LP + t) * 32;
                beta = 1.f / (1.f + __expf(-bap[h]));
                const float aa = bap[16 + h] + p.gdn_dt_bias[h];
                const float sp = (aa > 20.f) ? aa : log1pf(__expf(aa));
                g = -__expf(p.gdn_a_log[h]) * sp;
            }
            float gc = g;
#pragma unroll
            for (int o = 1; o < 64; o <<= 1) { const float v = __shfl_up(gc, o); if (lane >= o) gc += v; }
            const float glast = __shfl(gc, 63);
            sbeta[c] = beta; sgc[c] = gc; segc[c] = __expf(gc); sekd[c] = __expf(glast - gc); srk[c] = beta * __expf(gc);
            if (lane == 0) p.g_dec[su] = __expf(glast);
        }
        __syncthreads();
        {
            const int which = wave >> 2, ti = (wave >> 1) & 1, tj = wave & 1;
            const int r = lane & 31, hh = lane >> 5;
            f32x16 acc;
#pragma unroll
            for (int i = 0; i < 16; ++i) acc[i] = 0.f;
            const bf16_t* Ap = Kb + (32 * ti + r) * 136 + 8 * hh;
            const bf16_t* Bp = (which ? Qb : Kb) + (32 * tj + r) * 136 + 8 * hh;
#pragma unroll
            for (int ks = 0; ks < 8; ++ks) acc = MFMA32(*(const bf16x8*)(Ap + 16 * ks), *(const bf16x8*)(Bp + 16 * ks), acc);
            const int c = 32 * tj + r;
            const float gcc = sgc[c], bc = sbeta[c];
            if (which == 0) {
#pragma unroll
                for (int reg = 0; reg < 16; ++reg) {
                    const int cp = 32 * ti + crow(reg, hh);
                    const float dcy = __expf(fminf(gcc - sgc[cp], 0.f));
                    Am[c * 68 + cp] = (cp < c) ? (bc * acc[reg] * dcy) : 0.f;
                }
            } else {
                bf16_t* aq = p.g_aqk + su * 4096 + (size_t)c * 64;
#pragma unroll
                for (int g4 = 0; g4 < 4; ++g4) {
                    const int cp0 = 32 * ti + 8 * g4 + 4 * hh;
                    f32x4 v;
#pragma unroll
                    for (int e2 = 0; e2 < 4; ++e2) {
                        const int cp = cp0 + e2;
                        const float dcy = __expf(fminf(gcc - sgc[cp], 0.f));
                        v[e2] = (cp <= c) ? (acc[4 * g4 + e2] * dcy) : 0.f;
                    }
                    st_bf16x4(aq + cp0, v);
                }
            }
        }
        __syncthreads();
        if (wave < 4) {
            const int col = 64 * wave + lane;
            const float* rs = sbeta + __builtin_amdgcn_readfirstlane((wave < 2) ? 0 : 256);
            float x[64];
#pragma unroll
            for (int i = 0; i < 64; ++i) x[i] = RHS[i * 256 + col] * rs[i];
#pragma unroll
            for (int i = 1; i < 64; ++i) {
                float a0 = x[i], a1 = 0.f;
#pragma unroll
                for (int j4 = 0; j4 < i; j4 += 4) {
                    const f32x4 a = *(const f32x4*)(Am + i * 68 + j4);
                    a0 -= a[0] * x[j4]; a1 -= a[1] * x[j4 + 1]; a0 -= a[2] * x[j4 + 2]; a1 -= a[3] * x[j4 + 3];
                }
                x[i] = a0 + a1;
                asm volatile("" ::: "memory");
            }
            if (wave < 2) {
                float* up = p.g_u + su * 8192 + col;
#pragma unroll
                for (int i = 0; i < 64; ++i) up[i * 128] = x[i];
            } else {
                bf16_t* wp = p.g_negw + su * 8192 + (col - 128);
#pragma unroll
                for (int i = 0; i < 64; ++i) wp[i * 128] = f2bf(-x[i]);
            }
        } else {
            const int t2 = tid - 256;
#pragma unroll
            for (int it = 0; it < 4; ++it) {
                const int chk = t2 + 256 * it, c = chk >> 4, d0 = (chk & 15) * 8;
                const float e = segc[c];
                const uint4 raw = *(const uint4*)(Qb + c * 136 + d0);
                uint4 o;
                o.x = pk2(__uint_as_float(raw.x << 16) * e, __uint_as_float(raw.x & 0xffff0000u) * e);
                o.y = pk2(__uint_as_float(raw.y << 16) * e, __uint_as_float(raw.y & 0xffff0000u) * e);
                o.z = pk2(__uint_as_float(raw.z << 16) * e, __uint_as_float(raw.z & 0xffff0000u) * e);
                o.w = pk2(__uint_as_float(raw.w << 16) * e, __uint_as_float(raw.w & 0xffff0000u) * e);
                *(uint4*)(p.g_qg + su * 8192 + c * 128 + d0) = o;
            }
#pragma unroll
            for (int it = 0; it < 4; ++it) {
                const int item = t2 + 256 * it, d = item & 127, c0 = (item >> 7) * 8;
                float v[8];
#pragma unroll
                for (int i = 0; i < 8; ++i) v[i] = bf2f(Kb[(c0 + i) * 136 + d]) * sekd[c0 + i];
                uint4 o; o.x = pk2(v[0], v[1]); o.y = pk2(v[2], v[3]); o.z = pk2(v[4], v[5]); o.w = pk2(v[6], v[7]);
                *(uint4*)(p.g_kdT + su * 8192 + d * 64 + c0) = o;
            }
        }
        __syncthreads();
    }
}

constexpr int GB_NW = 0, GB_QG = 64 * 136, GB_KD = 2 * 64 * 136, GB_AQ = 2 * 64 * 136 + 128 * 72, GB_ELEMS = 2 * 64 * 136 + 128 * 72 + 64 * 72;
__device__ __forceinline__ void gdn_chain(const Params& p, char* smem, int b, int h) {
    bf16_t* lds = (bf16_t*)smem;
    const int tid = threadIdx.x, lane = tid & 63, wave = tid >> 6;
    const int r = lane & 31, hh = lane >> 5;
    const size_t su0 = (size_t)(b * 16 + h) * NCH;
    const bool loader = wave >= 4;
    const int t2 = tid - 256;
    uint4 st0, st1, st2, st3, st4, st5, st6, st7, st8, st9, st10, st11, st12, st13;
    f32x16 S[4], un0, un1;
#pragma unroll
    for (int i = 0; i < 4; ++i)
#pragma unroll
        for (int j = 0; j < 16; ++j) S[i][j] = 0.f;
    const int ch0 = t2, ch1 = t2 + 256, ch2 = t2 + 512, ch3 = t2 + 768;
#define GB_GLOAD(n_) do { const size_t su_ = su0 + (n_); \
        const bf16_t* a_ = p.g_negw + su_ * 8192; const bf16_t* b_ = p.g_qg + su_ * 8192; const bf16_t* c_ = p.g_kdT + su_ * 8192; const bf16_t* d_ = p.g_aqk + su_ * 4096; \
        st0 = *(const uint4*)(a_ + (size_t)ch0 * 8); st1 = *(const uint4*)(a_ + (size_t)ch1 * 8); st2 = *(const uint4*)(a_ + (size_t)ch2 * 8); st3 = *(const uint4*)(a_ + (size_t)ch3 * 8); \
        st4 = *(const uint4*)(b_ + (size_t)ch0 * 8); st5 = *(const uint4*)(b_ + (size_t)ch1 * 8); st6 = *(const uint4*)(b_ + (size_t)ch2 * 8); st7 = *(const uint4*)(b_ + (size_t)ch3 * 8); \
        st8 = *(const uint4*)(c_ + (size_t)ch0 * 8); st9 = *(const uint4*)(c_ + (size_t)ch1 * 8); st10 = *(const uint4*)(c_ + (size_t)ch2 * 8); st11 = *(const uint4*)(c_ + (size_t)ch3 * 8); \
        st12 = *(const uint4*)(d_ + (size_t)ch0 * 8); st13 = *(const uint4*)(d_ + (size_t)ch1 * 8); } while (0)
#define GB_SSTORE(buf_) do { bf16_t* q_ = (buf_); \
        *(uint4*)(q_ + GB_NW + (ch0 >> 4) * 136 + (ch0 & 15) * 8) = st0; *(uint4*)(q_ + GB_NW + (ch1 >> 4) * 136 + (ch1 & 15) * 8) = st1; \
        *(uint4*)(q_ + GB_NW + (ch2 >> 4) * 136 + (ch2 & 15) * 8) = st2; *(uint4*)(q_ + GB_NW + (ch3 >> 4) * 136 + (ch3 & 15) * 8) = st3; \
        *(uint4*)(q_ + GB_QG + (ch0 >> 4) * 136 + (ch0 & 15) * 8) = st4; *(uint4*)(q_ + GB_QG + (ch1 >> 4) * 136 + (ch1 & 15) * 8) = st5; \
        *(uint4*)(q_ + GB_QG + (ch2 >> 4) * 136 + (ch2 & 15) * 8) = st6; *(uint4*)(q_ + GB_QG + (ch3 >> 4) * 136 + (ch3 & 15) * 8) = st7; \
        *(uint4*)(q_ + GB_KD + (ch0 >> 3) * 72 + (ch0 & 7) * 8) = st8; *(uint4*)(q_ + GB_KD + (ch1 >> 3) * 72 + (ch1 & 7) * 8) = st9; \
        *(uint4*)(q_ + GB_KD + (ch2 >> 3) * 72 + (ch2 & 7) * 8) = st10; *(uint4*)(q_ + GB_KD + (ch3 >> 3) * 72 + (ch3 & 7) * 8) = st11; \
        *(uint4*)(q_ + GB_AQ + (ch0 >> 3) * 72 + (ch0 & 7) * 8) = st12; *(uint4*)(q_ + GB_AQ + (ch1 >> 3) * 72 + (ch1 & 7) * 8) = st13; } while (0)
#define GB_ULOAD(n_) do { const float* up_ = p.g_u + (su0 + (n_)) * 8192 + 32 * wave + r; \
        _Pragma("unroll") for (int reg_ = 0; reg_ < 16; ++reg_) { un0[reg_] = up_[(crow(reg_, hh)) * 128]; un1[reg_] = up_[(32 + crow(reg_, hh)) * 128]; } } while (0)
    if (loader) {
        GB_GLOAD(0); GB_SSTORE(lds);
        __syncthreads();
        for (int n = 0; n < NCH; ++n) {
            unsigned zofs = 0; asm volatile("" : "+v"(zofs));
            bf16_t* nxt = lds + ((n + 1) & 1) * GB_ELEMS + zofs;
            if (n + 1 < NCH) { GB_GLOAD(n + 1); GB_SSTORE(nxt); }
            __syncthreads();
        }
    } else {
        GB_ULOAD(0);
        __syncthreads();
        for (int n = 0; n < NCH; ++n) {
            unsigned zofs = 0; asm volatile("" : "+v"(zofs));
            bf16_t* cur = lds + (n & 1) * GB_ELEMS + zofs;
            const bool more = (n + 1 < NCH);
            const float dec = p.g_dec[su0 + n];
            f32x16 vn[2], o[2];
            vn[0] = un0; vn[1] = un1;
#pragma unroll
            for (int j = 0; j < 16; ++j) { o[0][j] = 0.f; o[1][j] = 0.f; }
            if (more) { GB_ULOAD(n + 1); }
#pragma unroll
            for (int kt = 0; kt < 4; ++kt)
#pragma unroll
                for (int s = 0; s < 2; ++s) {
                    const bf16x8 sb = pack_step(S[kt], s);
                    const int k0 = 32 * kt + 16 * s + 4 * hh;
#pragma unroll
                    for (int ct = 0; ct < 2; ++ct) {
                        vn[ct] = MFMA32(frag_perm(cur + GB_NW + (32 * ct + r) * 136 + k0), sb, vn[ct]);
                        o[ct] = MFMA32(frag_perm(cur + GB_QG + (32 * ct + r) * 136 + k0), sb, o[ct]);
                    }
                }
            bf16x8 vb[2][2];
#pragma unroll
            for (int ct = 0; ct < 2; ++ct)
#pragma unroll
                for (int s = 0; s < 2; ++s) vb[ct][s] = pack_step(vn[ct], s);
#pragma unroll
            for (int s = 0; s < 2; ++s) {
                o[0] = MFMA32(frag_perm(cur + GB_AQ + (r) * 72 + 16 * s + 4 * hh), vb[0][s], o[0]);
                o[1] = MFMA32(frag_perm(cur + GB_AQ + (32 + r) * 72 + 16 * s + 4 * hh), vb[0][s], o[1]);
                o[1] = MFMA32(frag_perm(cur + GB_AQ + (32 + r) * 72 + 32 + 16 * s + 4 * hh), vb[1][s], o[1]);
            }
#pragma unroll
            for (int dt = 0; dt < 4; ++dt) {
                S[dt] = S[dt] * dec;
#pragma unroll
                for (int ckt = 0; ckt < 2; ++ckt)
#pragma unroll
                    for (int s = 0; s < 2; ++s)
                        S[dt] = MFMA32(frag_perm(cur + GB_KD + (32 * dt + r) * 72 + 32 * ckt + 16 * s + 4 * hh), vb[ckt][s], S[dt]);
            }
#pragma unroll
            for (int ct = 0; ct < 2; ++ct)
#pragma unroll
                for (int reg = 0; reg < 16; ++reg) {
                    const int t = 64 * n + 32 * ct + crow(reg, hh);
                    if (t < LP) p.g_o[(((size_t)b * LP + t) * 16 + h) * 128 + 32 * wave + r] = o[ct][reg];
                }
            __syncthreads();
        }
    }
    if (!loader) {
#pragma unroll
        for (int dt = 0; dt < 4; ++dt)
#pragma unroll
            for (int reg = 0; reg < 16; ++reg)
                p.gs_prompt[((size_t)(b * 16 + h) * 128 + 32 * dt + crow(reg, hh)) * 128 + 32 * wave + r] = S[dt][reg];
    }
    __syncthreads();
}

__device__ __forceinline__ void gdn_seq_phase(const Params& p, char* smem, int bid, int nb) {
    if (bid < 64) gdn_chain(p, smem, bid >> 4, bid & 15);
    int* slot = (int*)(smem + LDS_BYTES - 32);
    for (;;) {
        if (threadIdx.x == 0) *slot = (int)atomicAdd(p.bar + 3520, 1u);
        __syncthreads();
        const int u = *slot;
        __syncthreads();
        if (u >= DB * 16) break;
        gdn_sample_unit(p, smem, u >> 4, u & 15);
    }
}

__device__ __forceinline__ void gdn_gate_phase(const Params& p, int bid, int nb) {
    const int lane = threadIdx.x & 63, wave = threadIdx.x >> 6;
    const f32x2 nw = *(const f32x2*)(p.gdn_norm_w + lane * 2);
    for (int it = bid * 8 + wave; it < NPR * 16; it += nb * 8) {
        const f32x2 o = *(const f32x2*)(p.g_o + (size_t)it * 128 + lane * 2);
        const float ss = wave_sum(o[0] * o[0] + o[1] * o[1]);
        const float rms = rsqrtf(ss * (1.f / 128.f) + 1e-6f);
        const unsigned zr = *(const unsigned*)(p.z + (size_t)it * 128 + lane * 2);
        const float z0 = __uint_as_float(zr << 16), z1 = __uint_as_float(zr & 0xffff0000u);
        *(unsigned*)(p.gated + (size_t)it * 128 + lane * 2) = pk2(o[0] * rms * nw[0] * silu(z0), o[1] * rms * nw[1] * silu(z1));
    }
}

__device__ __forceinline__ void rope_cs(int pos, int fi, float& c, float& s) {
    const double rev = (double)pos * kInvFreq[fi] * 0.15915494309189535;
    const float r = (float)(rev - floor(rev));
    c = __builtin_amdgcn_cosf(r);
    s = __builtin_amdgcn_sinf(r);
}
__device__ __forceinline__ void dsa_post_phase(const Params& p, int bid, int nb) {
    const int lane = threadIdx.x & 63, wave = threadIdx.x >> 6;
    for (int row = bid * 8 + wave; row < NT; row += nb * 8) {
        const float* P = p.p1 + (size_t)row * DIN_PAD;
        const bool prompt = row < NPR;
        const int pos = prompt ? (row % LP) : (PAST + ((row - NPR) & 3));
        float* kout = prompt ? (p.k_prompt + (size_t)row * 256) : (p.k_sample + (size_t)(row - NPR) * 256);
        float* vout = prompt ? (p.v_prompt + (size_t)row * 256) : (p.v_sample + (size_t)(row - NPR) * 256);
        for (int e = lane; e < 1280; e += 64) {
            const int d = e & 127;
            float o = P[e];
            if (d < 32) {
                float c, s; rope_cs(pos, d & 15, c, s);
                if (d < 16) o = o * c - P[e + 16] * s; else o = o * c + P[e - 16] * s;
            }
            if (e < 1024) p.qr[(size_t)row * 1024 + e] = o; else kout[e - 1024] = o;
        }
        for (int e = lane; e < 256; e += 64) vout[e] = P[1280 + e];
        for (int e = lane; e < 512; e += 64) {
            const int d = e & 63;
            float o = P[1536 + e];
            if (d < 16) {
                float c, s; rope_cs(pos, (d & 7) * 2, c, s);
                if (d < 8) o = o * c - P[1536 + e + 8] * s; else o = o * c + P[1536 + e - 8] * s;
            }
            p.iq[(size_t)row * 512 + e] = o;
        }
        {
            const float x = P[2048 + lane];
            const float mu = wave_sum(x) * (1.f / 64.f);
            const float dv = x - mu;
            const float var = wave_sum(dv * dv) * (1.f / 64.f);
            const float xn = dv * rsqrtf(var + 1e-5f) * p.dsa_ik_g[lane] + p.dsa_ik_b[lane];
            const float other = __shfl_xor(xn, 8);
            float o = xn;
            if (lane < 16) {
                float c, s; rope_cs(pos, (lane & 7) * 2, c, s);
                if (lane < 8) o = xn * c - other * s; else o = xn * c + other * s;
            }
            float* io = prompt ? (p.ik_prompt + (size_t)row * 64) : (p.ik_sample + (size_t)(row - NPR) * 64);
            io[lane] = o;
        }
        if (lane < 8) p.iw[(size_t)row * 8 + lane] = P[2112 + lane] * 0.35355339059327373f;
    }
}

__device__ __forceinline__ const float* ik_row(const Params& p, bool prompt, int b, int s) {
    if (prompt) return p.ik_prompt + ((size_t)b * LP + s) * 64;
    if (s < PAST) { const int pg = p.page_table[b * 16 + (s >> 7)]; return p.cache_ik + ((size_t)pg * 128 + (s & 127)) * 64; }
    return p.ik_sample + ((size_t)b * DS + (s - PAST)) * 64;
}
__device__ __forceinline__ const float* kv_row(const float* own_p, const float* own_s, const float* cache, const int* page_table,
                                               bool prompt, int b, int s) {
    if (prompt) return own_p + ((size_t)b * LP + s) * 256;
    if (s < PAST) { const int pg = page_table[b * 16 + (s >> 7)]; return cache + ((size_t)pg * 128 + (s & 127)) * 256; }
    return own_s + ((size_t)b * DS + (s - PAST)) * 256;
}

__device__ __forceinline__ void indexer_phase(const Params& p, char* smem, int bid, int nb) {
    const int lane = threadIdx.x & 63, wave = threadIdx.x >> 6;
    float* sc = (float*)smem + wave * (4096 + 512);
    float* qs = sc + 4096;
    const unsigned long long ltmask = (1ull << lane) - 1ull;
    for (int row = bid * 8 + wave; row < NT; row += nb * 8) {
        const bool prompt = row < NPR;
        int b, qpos;
        if (prompt) { b = row / LP; qpos = row % LP; } else { b = (row - NPR) >> 2; qpos = PAST + ((row - NPR) & 3); }
        int* selrow = p.sel + (size_t)row * 256;
        const int n = qpos - 15;
        if (n <= 240) {
            for (int j = lane; j < 256; j += 64) selrow[j] = (j <= qpos) ? j : -1;
            continue;
        }
        for (int j = lane; j < 512; j += 64) qs[j] = p.iq[(size_t)row * 512 + j];
        float w[8];
#pragma unroll
        for (int h = 0; h < 8; ++h) w[h] = p.iw[(size_t)row * 8 + h];
        lds_fence();
        for (int j0 = 0; j0 < n; j0 += 64) {
            const int s = 16 + j0 + lane;
            const bool valid = s <= qpos;
            const float* kp = ik_row(p, prompt, b, valid ? s : qpos);
            float dh[8];
#pragma unroll
            for (int h = 0; h < 8; ++h) dh[h] = 0.f;
#pragma unroll
            for (int half = 0; half < 2; ++half) {
                f32x4 kv[8];
#pragma unroll
                for (int c = 0; c < 8; ++c) kv[c] = *(const f32x4*)(kp + half * 32 + c * 4);
#pragma unroll
                for (int h = 0; h < 8; ++h) {
                    float d = dh[h];
#pragma unroll
                    for (int c = 0; c < 8; ++c) {
                        const f32x4 q4 = *(const f32x4*)(qs + h * 64 + half * 32 + c * 4);
                        d += kv[c][0] * q4[0]; d += kv[c][1] * q4[1]; d += kv[c][2] * q4[2]; d += kv[c][3] * q4[3];
                    }
                    dh[h] = d;
                }
            }
            float score = 0.f;
#pragma unroll
            for (int h = 0; h < 8; ++h) score += w[h] * fmaxf(dh[h], 0.f);
            sc[j0 + lane] = valid ? score : -INFINITY;
        }
        lds_fence();
        unsigned key[64];
#pragma unroll
        for (int j = 0; j < 64; ++j) {
            const int idx = j * 64 + lane;
            const float x = (idx < n) ? sc[idx] : -INFINITY;
            const unsigned u = __float_as_uint(x);
            key[j] = (u & 0x80000000u) ? ~u : (u | 0x80000000u);
        }
        lds_fence();
        unsigned T = 0u;
        for (int bit = 31; bit >= 0; --bit) {
            const unsigned cand = T | (1u << bit);
            int c = 0;
#pragma unroll
            for (int j = 0; j < 64; ++j) c += (key[j] >= cand) ? 1 : 0;
            c = wave_sum_i(c);
            if (c >= 240) T = cand;
        }
        int cgt = 0;
#pragma unroll
        for (int j = 0; j < 64; ++j) cgt += (key[j] > T) ? 1 : 0;
        cgt = wave_sum_i(cgt);
        const int need_eq = 240 - cgt;
        if (lane < 16) selrow[lane] = lane;
        int base = 16, erun = 0;
#pragma unroll
        for (int j = 0; j < 64; ++j) {
            const bool gt = key[j] > T, eq = key[j] == T;
            const unsigned long long meq = __ballot(eq);
            const int rank = erun + __popcll(meq & ltmask);
            const bool take = gt || (eq && rank < need_eq);
            const unsigned long long m = __ballot(take);
            if (take) selrow[base + __popcll(m & ltmask)] = 16 + j * 64 + lane;
            base += __popcll(m);
            erun += __popcll(meq);
        }
    }
}

__device__ __forceinline__ void attn_phase(const Params& p, char* smem, int bid, int nb) {
    float* qs = (float*)smem;
    float* ps = qs + 1024;
    int* sidx = (int*)(ps + 2048);
    const int tid = threadIdx.x, lane = tid & 63, wave = tid >> 6;
    for (int row = bid; row < NT; row += nb) {
        const bool prompt = row < NPR;
        const int b = prompt ? (row / LP) : ((row - NPR) >> 2);
        qs[tid] = p.qr[(size_t)row * 1024 + tid];
        qs[tid + 512] = p.qr[(size_t)row * 1024 + 512 + tid];
        if (tid < 256) sidx[tid] = p.sel[(size_t)row * 256 + tid];
        __syncthreads();
        {
            const int j = tid & 255, kvh = tid >> 8;
            const int s = sidx[j];
            const bool valid = s >= 0;
            const float* kp = kv_row(p.k_prompt, p.k_sample, p.cache_k, p.page_table, prompt, b, valid ? s : 0) + kvh * 128;
            float d0 = 0.f, d1 = 0.f, d2 = 0.f, d3 = 0.f;
            const float* q0 = qs + (kvh * 4) * 128;
#pragma unroll 8
            for (int c = 0; c < 32; ++c) {
                const f32x4 kv = *(const f32x4*)(kp + c * 4);
                const f32x4 a0 = *(const f32x4*)(q0 + c * 4), a1 = *(const f32x4*)(q0 + 128 + c * 4), a2 = *(const f32x4*)(q0 + 256 + c * 4),
                            a3 = *(const f32x4*)(q0 + 384 + c * 4);
                d0 += kv[0] * a0[0] + kv[1] * a0[1] + kv[2] * a0[2] + kv[3] * a0[3];
                d1 += kv[0] * a1[0] + kv[1] * a1[1] + kv[2] * a1[2] + kv[3] * a1[3];
                d2 += kv[0] * a2[0] + kv[1] * a2[1] + kv[2] * a2[2] + kv[3] * a2[3];
                d3 += kv[0] * a3[0] + kv[1] * a3[1] + kv[2] * a3[2] + kv[3] * a3[3];
            }
            const float sc = 0.08838834764831845f;
            ps[(kvh * 4 + 0) * 256 + j] = valid ? d0 * sc : -INFINITY;
            ps[(kvh * 4 + 1) * 256 + j] = valid ? d1 * sc : -INFINITY;
            ps[(kvh * 4 + 2) * 256 + j] = valid ? d2 * sc : -INFINITY;
            ps[(kvh * 4 + 3) * 256 + j] = valid ? d3 * sc : -INFINITY;
        }
        __syncthreads();
        {
            float v[4]; float m = -INFINITY;
#pragma unroll
            for (int i = 0; i < 4; ++i) { v[i] = ps[wave * 256 + lane + 64 * i]; m = fmaxf(m, v[i]); }
            m = wave_max(m);
            float sum = 0.f;
#pragma unroll
            for (int i = 0; i < 4; ++i) { v[i] = __expf(v[i] - m); sum += v[i]; }
            sum = wave_sum(sum);
            const float inv = 1.f / sum;
#pragma unroll
            for (int i = 0; i < 4; ++i) ps[wave * 256 + lane + 64 * i] = v[i] * inv;
        }
        __syncthreads();
        {
            const int h = wave, d = lane * 2, kvh = h >> 2;
            float o0 = 0.f, o1 = 0.f;
            for (int j = 0; j < 256; ++j) {
                int s = sidx[j]; if (s < 0) s = 0;
                const float* vp = kv_row(p.v_prompt, p.v_sample, p.cache_v, p.page_table, prompt, b, s) + kvh * 128 + d;
                const float pj = ps[h * 256 + j];
                const float2 vv = *(const float2*)vp;
                o0 += pj * vv.x; o1 += pj * vv.y;
            }
            *(unsigned*)(p.gated + (size_t)row * 1024 + h * 128 + d) = pk2(o0, o1);
        }
        __syncthreads();
    }
}

#define XB_TMO      128
#define XB_XCNT(j)  (256  + 64 * (j))
#define XB_XSUB(j)  (1280 + 64 * (j))
#define XB_XGEN(j)  (2304 + 64 * (j))
#define XB_TOP      3328
#define XB_TOPGEN   3392
#define XCD_BAR_WORDS 3456
#define XB_SPIN_CAP (1u << 18)
#define LAS __attribute__((address_space(3)))

__device__ __forceinline__ unsigned xb_ld(unsigned* p)              { return __hip_atomic_load(p, __ATOMIC_RELAXED, __HIP_MEMORY_SCOPE_AGENT); }
__device__ __forceinline__ unsigned xb_add(unsigned* p, unsigned v) { return __hip_atomic_fetch_add(p, v, __ATOMIC_RELAXED, __HIP_MEMORY_SCOPE_AGENT); }
__device__ __forceinline__ unsigned xb_xcc_id() { return (unsigned)__builtin_amdgcn_s_getreg((3 << 11) | 20) & 0xFu; }
#define XB_SPIN(cond, bar) do { unsigned _sp = 0; while (cond) { __builtin_amdgcn_s_sleep(1); \
    if ((++_sp & 255u) == 0u) { if (xb_ld(&(bar)[XB_TMO])) break; if (_sp > XB_SPIN_CAP) { atomicAdd(&(bar)[XB_TMO], 1u); break; } } } } while (0)

struct XcdBarrier {
    unsigned* bar; unsigned x;
    volatile LAS unsigned* st;
};

__device__ __forceinline__ XcdBarrier xcd_barrier_post(unsigned* bar, volatile LAS unsigned* st) {
    XcdBarrier b; b.bar = bar; b.x = xb_xcc_id(); b.st = st;
    if (threadIdx.x == 0) (void)xb_add(&bar[XB_XCNT(b.x)], 1u);
    return b;
}
__device__ __forceinline__ void xcd_barrier_complete(unsigned* bar, unsigned x, unsigned& nloc, unsigned& nx) {
    const unsigned G = gridDim.x * gridDim.y * gridDim.z;
    unsigned sum, cnt, mine, sp = 0u;
    for (;;) {
        sum = 0u; cnt = 0u; mine = 0u;
#pragma unroll
        for (unsigned j = 0; j < 16; ++j) { const unsigned c = xb_ld(&bar[XB_XCNT(j)]); sum += c; cnt += (c > 0u) ? 1u : 0u; mine = (j == x) ? c : mine; }
        if (sum == G) break;
        __builtin_amdgcn_s_sleep(1);
        if ((++sp & 255u) == 0u) { if (xb_ld(&bar[XB_TMO])) break; if (sp > XB_SPIN_CAP) { atomicAdd(&bar[XB_TMO], 1u); break; } }
    }
    nloc = mine > 0u ? mine : 1u; nx = cnt > 0u ? cnt : 1u;
}

__device__ __forceinline__ void xcd_barrier(const XcdBarrier& b) {
    asm volatile("s_waitcnt vmcnt(0)" ::: "memory");
    __syncthreads();
    if (threadIdx.x == 0) {
        unsigned* bar = b.bar;
        __builtin_amdgcn_s_waitcnt(0);
        unsigned nloc = b.st[0], nx = b.st[1];
        if (nloc == 0u) { xcd_barrier_complete(bar, b.x, nloc, nx); b.st[0] = nloc; b.st[1] = nx; }
        const unsigned old = xb_add(&bar[XB_XSUB(b.x)], 1u);
        const unsigned gen = old / nloc;
        if (old + 1u == (gen + 1u) * nloc) {
            __builtin_amdgcn_fence(__ATOMIC_RELEASE, "agent");
            asm volatile("s_waitcnt vmcnt(0)" ::: "memory");
            const unsigned og = xb_add(&bar[XB_TOP], 1u);
            const unsigned tg = og / nx;
            if (og + 1u == (tg + 1u) * nx) xb_add(&bar[XB_TOPGEN], 1u);
            else XB_SPIN(xb_ld(&bar[XB_TOPGEN]) == tg, bar);
            __builtin_amdgcn_fence(__ATOMIC_ACQUIRE, "agent");
            xb_add(&bar[XB_XGEN(b.x)], 1u);
            asm volatile("s_waitcnt vmcnt(0)" ::: "memory");
        } else {
            XB_SPIN(xb_ld(&bar[XB_XGEN(b.x)]) == gen, bar);
            __builtin_amdgcn_fence(__ATOMIC_ACQUIRE, "agent");
            asm volatile("s_waitcnt vmcnt(0)" ::: "memory");
        }
    }
    __syncthreads();
}


constexpr int NPHASE = 19;
template <int PH>
__device__ __forceinline__ void run_phase(const Params& p, char* smem, int bid, int nb) {
    constexpr int MT = MPAD / 256;
    if constexpr (PH == 0) phase_prologue(p, smem, bid, nb);
    else if constexpr (PH == 1) gemm_phase(p.hA, D, p.wt_gin, D, MT, GIN_PAD / 128, EpiGdnIn{p.mixed, p.z, p.ba}, smem, bid, nb);
    else if constexpr (PH == 2) gdn_stageA(p, smem, bid, nb);
    else if constexpr (PH == 3) gdn_seq_phase(p, smem, bid, nb);
    else if constexpr (PH == 4) gdn_gate_phase(p, bid, nb);
    else if constexpr (PH == 5) gemm_phase(p.gated, 2048, p.wt_gout, 2048, MT, D / 128, EpiResid{p.preln, p.hA}, smem, bid, nb);
    else if constexpr (PH == 6) ln_phase(p.preln, p.ln1_g, p.ln1_b, p.hB, nullptr, nullptr, bid, nb);
    else if constexpr (PH == 7) gemm_phase(p.hB, D, p.wt_w1, D, MT, DFF / 128, EpiRelu2{p.act}, smem, bid, nb);
    else if constexpr (PH == 8) gemm_phase(p.act, DFF, p.wt_w2, DFF, MT, D / 128, EpiResid{p.preln, p.hB}, smem, bid, nb);
    else if constexpr (PH == 9) ln_phase(p.preln, p.ln2_g, p.ln2_b, p.hA, nullptr, nullptr, bid, nb);
    else if constexpr (PH == 10) gemm_phase(p.hA, D, p.wt_din, D, MT, DIN_PAD / 128, EpiF32{p.p1, DIN_PAD}, smem, bid, nb);
    else if constexpr (PH == 11) dsa_post_phase(p, bid, nb);
    else if constexpr (PH == 12) indexer_phase(p, smem, bid, nb);
    else if constexpr (PH == 13) attn_phase(p, smem, bid, nb);
    else if constexpr (PH == 14) gemm_phase(p.gated, D, p.wt_do, D, MT, D / 128, EpiResid{p.preln, p.hA}, smem, bid, nb);
    else if constexpr (PH == 15) ln_phase(p.preln, p.ln1_g + D, p.ln1_b + D, p.hB, nullptr, nullptr, bid, nb);
    else if constexpr (PH == 16) gemm_phase(p.hB, D, p.wt_w1 + (size_t)D * DFF, D, MT, DFF / 128, EpiRelu2{p.act}, smem, bid, nb);
    else if constexpr (PH == 17) gemm_phase(p.act, DFF, p.wt_w2 + (size_t)D * DFF, DFF, MT, D / 128, EpiResid{p.preln, p.hB}, smem, bid, nb);
    else if constexpr (PH == 18) ln_phase(p.preln, p.ln2_g + D, p.ln2_b + D, nullptr, p.y_prompt, p.y_sample, bid, nb);
}

template <int PH>
__global__ void __launch_bounds__(NTHR, 2) k_phase(Params p) {
    extern __shared__ __attribute__((aligned(16))) char smem[];
    run_phase<PH>(p, smem, blockIdx.x, gridDim.x);
}

template <int PH>
__device__ __forceinline__ void mega_run(const Params& p, char* smem, const XcdBarrier& bar) {
    run_phase<PH>(p, smem, blockIdx.x, gridDim.x);
    if constexpr (PH + 1 < NPHASE) {
        xcd_barrier(bar);
        mega_run<PH + 1>(p, smem, bar);
    }
}
__global__ void __launch_bounds__(NTHR, 2) k_mega(Params p) {
    extern __shared__ __attribute__((aligned(16))) char smem[];
    volatile LAS unsigned* st = (volatile LAS unsigned*)(smem + LDS_BYTES - 16);
    if (threadIdx.x == 0) { st[0] = 0u; st[1] = 0u; st[2] = 0u; st[3] = 0u; }
    __syncthreads();
    XcdBarrier bar = xcd_barrier_post(p.bar, st);
    mega_run<0>(p, smem, bar);
}

template <int PH>
void launch_phase(const Params& p, hipStream_t stream) {
    static bool attr_done = false;
    if (!attr_done) {
        (void)hipFuncSetAttribute((const void*)k_phase<PH>, hipFuncAttributeMaxDynamicSharedMemorySize, LDS_BYTES);
        attr_done = true;
    }
    hipLaunchKernelGGL(k_phase<PH>, dim3(256), dim3(NTHR), LDS_BYTES, stream, p);
}
template <int PH>
void launch_all(const Params& p, hipStream_t stream) {
    launch_phase<PH>(p, stream);
    if constexpr (PH + 1 < NPHASE) launch_all<PH + 1>(p, stream);
}

}

extern "C" void kernel_launch(void* const* d_in, const int* in_sizes, int n_in, void* d_out, int out_size, void* d_ws, size_t ws_size,
                              hipStream_t stream) {
    Params p{};
    p.x_prompt = (const float*)d_in[0]; p.x_sample = (const float*)d_in[1]; p.state_gdn = (const float*)d_in[2];
    p.state_conv = (const float*)d_in[3]; p.cache_k = (const float*)d_in[4]; p.cache_v = (const float*)d_in[5];
    p.cache_ik = (const float*)d_in[6]; p.page_table = (const int*)d_in[7]; p.meta = (const float*)d_in[8];
    p.ln1_g = (const float*)d_in[9]; p.ln1_b = (const float*)d_in[10]; p.ln2_g = (const float*)d_in[11]; p.ln2_b = (const float*)d_in[12];
    p.mlp_w1 = (const float*)d_in[13]; p.mlp_w2 = (const float*)d_in[14]; p.gdn_w_in = (const float*)d_in[15];
    p.gdn_conv_w = (const float*)d_in[16]; p.gdn_a_log = (const float*)d_in[17]; p.gdn_dt_bias = (const float*)d_in[18];
    p.gdn_norm_w = (const float*)d_in[19]; p.gdn_w_out = (const float*)d_in[20]; p.dsa_w_in = (const float*)d_in[21];
    p.dsa_ik_g = (const float*)d_in[22]; p.dsa_ik_b = (const float*)d_in[23]; p.dsa_w_o = (const float*)d_in[24];
    float* o = (float*)d_out;
    p.y_prompt = o; o += (size_t)BATCH * SEQ * D;
    p.y_sample = o; o += (size_t)NSR * D;
    p.gs_prompt = o; o += (size_t)BATCH * 16 * 128 * 128;
    p.gc_prompt = o; o += (size_t)BATCH * 3 * 4096;
    p.gs_sample = o; o += (size_t)DB * 16 * 128 * 128;
    p.gc_sample = o; o += (size_t)DB * 3 * 4096;
    p.k_prompt = o; o += (size_t)NPR * 256;
    p.v_prompt = o; o += (size_t)NPR * 256;
    p.ik_prompt = o; o += (size_t)NPR * 64;
    p.k_sample = o; o += (size_t)NSR * 256;
    p.v_sample = o; o += (size_t)NSR * 256;
    p.ik_sample = o; o += (size_t)NSR * 64;
    char* w = (char*)d_ws;
    auto take = [&](size_t bytes) { char* r = w; w += (bytes + 255) & ~(size_t)255; return r; };
    p.bar = (unsigned*)take(16384);
    p.wt_gin = (bf16_t*)take((size_t)GIN_PAD * D * 2);
    p.wt_gout = (bf16_t*)take((size_t)D * 2048 * 2);
    p.wt_w1 = (bf16_t*)take((size_t)2 * D * DFF * 2);
    p.wt_w2 = (bf16_t*)take((size_t)2 * D * DFF * 2);
    p.wt_din = (bf16_t*)take((size_t)DIN_PAD * D * 2);
    p.wt_do = (bf16_t*)take((size_t)D * D * 2);
    p.hA = (bf16_t*)take((size_t)MPAD * D * 2);
    p.hB = (bf16_t*)take((size_t)MPAD * D * 2);
    p.preln = (float*)take((size_t)MPAD * D * 4);
    p.mixed = (bf16_t*)take((size_t)MPAD * 4096 * 2);
    p.z = (bf16_t*)take((size_t)MPAD * 2048 * 2);
    p.ba = (float*)take((size_t)MPAD * 32 * 4);
    p.gated = (bf16_t*)take((size_t)MPAD * 2048 * 2);
    p.act = (bf16_t*)take((size_t)MPAD * DFF * 2);
    p.p1 = (float*)take((size_t)MPAD * DIN_PAD * 4);
    p.qr = (float*)take((size_t)MPAD * 1024 * 4);
    p.iq = (float*)take((size_t)MPAD * 512 * 4);
    p.iw = (float*)take((size_t)MPAD * 8 * 4);
    p.sel = (int*)take((size_t)MPAD * 256 * 4);
    p.g_o = (float*)take((size_t)NPR * 2048 * 4);
    p.g_dec = (float*)take((size_t)NCU * 4);
    p.g_u = (float*)p.act;
    p.g_negw = (bf16_t*)p.p1;
    p.g_qg = p.g_negw + (size_t)NCU * 8192;
    p.g_kdT = (bf16_t*)p.qr;
    p.g_aqk = (bf16_t*)p.iq;
    if ((size_t)(w - (char*)d_ws) > ws_size) { fprintf(stderr, "kernel_launch: workspace too small (%zu needed, %zu given)\n", (size_t)(w - (char*)d_ws), ws_size); return; }
#if MEGA
    static int grid = 0;
    if (grid == 0) {
        int dev = 0, cus = 0;
        if (hipGetDevice(&dev) != hipSuccess || hipDeviceGetAttribute(&cus, hipDeviceAttributeMultiprocessorCount, dev) != hipSuccess || cus <= 0) cus = 256;
        (void)hipFuncSetAttribute((const void*)k_mega, hipFuncAttributeMaxDynamicSharedMemorySize, LDS_BYTES);
        grid = cus;
    }
    (void)hipMemsetAsync(p.bar, 0, 16384, stream);
    hipLaunchKernelGGL(k_mega, dim3(grid), dim3(NTHR), LDS_BYTES, stream, p);
#else
    launch_all<0>(p, stream);
#endif
}
```

```cpp
#include <hip/hip_runtime.h>
#include <stdint.h>
#include <stdio.h>

#ifndef MEGA
#define MEGA 1
#endif

namespace {

typedef unsigned short bf16_t;
typedef short bf16x8 __attribute__((ext_vector_type(8)));
typedef float f32x4 __attribute__((ext_vector_type(4)));

constexpr int D = 1024, BATCH = 4, SEQ = 4096, NMETA = 16, LP = SEQ + NMETA;
constexpr int DB = 128, DS = 4, PAST = 2048;
constexpr int NPR = BATCH * LP;
constexpr int NSR = DB * DS;
constexpr int NT = NPR + NSR;
constexpr int MPAD = 17152;
constexpr int DFF = 4096;
constexpr int GIN = 6176, GIN_PAD = 6272;
constexpr int DIN = 2120, DIN_PAD = 2176;
constexpr int NTHR = 512;
constexpr int LPAD = 4160;
constexpr int LDS_BYTES = 150 * 1024;
constexpr float ALPHA = 1.4142135623730951f;

struct Params {
    const float *x_prompt, *x_sample, *state_gdn, *state_conv, *cache_k, *cache_v, *cache_ik;
    const int* page_table;
    const float *meta, *ln1_g, *ln1_b, *ln2_g, *ln2_b, *mlp_w1, *mlp_w2, *gdn_w_in, *gdn_conv_w, *gdn_a_log, *gdn_dt_bias,
        *gdn_norm_w, *gdn_w_out, *dsa_w_in, *dsa_ik_g, *dsa_ik_b, *dsa_w_o;
    float *y_prompt, *y_sample, *gs_prompt, *gc_prompt, *gs_sample, *gc_sample, *k_prompt, *v_prompt, *ik_prompt, *k_sample,
        *v_sample, *ik_sample;
    unsigned* bar;
    bf16_t *wt_gin, *wt_gout, *wt_w1, *wt_w2, *wt_din, *wt_do;
    bf16_t *hA, *hB;
    float* preln;
    bf16_t *mixed, *z;
    float* ba;
    bf16_t *gated, *act;
    float *p1, *qr, *iq, *iw;
    int* sel;
    bf16_t *g_negw, *g_qg, *g_kdT, *g_aqk;
    float *g_u, *g_dec, *g_o;
    bf16_t *q_b, *k_b, *vt_b, *iq_b, *ik_b;
    unsigned long long* maskT;
};

__device__ const double kInvFreq[16] = {1.0, 0.44036660267178046, 0.19392274474868576, 0.08539710028576561,
    0.03760603093086393, 0.016560440080994446, 0.007292664737217109, 0.003211445994752591, 0.001414213562373095,
    0.000622772421914596, 0.0002742481756762073, 0.00012076973741146504, 5.318295896944988e-05, 2.341999896140934e-05,
    1.031338537721246e-05, 4.5416704806078695e-06};

__device__ __forceinline__ float bf2f(bf16_t h) { return __uint_as_float(((unsigned)h) << 16); }
typedef __bf16 hwbf16x2 __attribute__((ext_vector_type(2)));
typedef float f32x2 __attribute__((ext_vector_type(2)));
typedef float f32x16 __attribute__((ext_vector_type(16)));
typedef unsigned u32x4 __attribute__((ext_vector_type(4)));
__device__ __forceinline__ unsigned pk2(float lo, float hi) {
    const f32x2 v = {lo, hi};
    return __builtin_bit_cast(unsigned, __builtin_convertvector(v, hwbf16x2));
}
__device__ __forceinline__ bf16_t f2bf(float f) { return (bf16_t)(pk2(f, 0.f) & 0xffffu); }
__device__ __forceinline__ void st_bf16x4(bf16_t* p, f32x4 v) {
    uint2 o; o.x = pk2(v[0], v[1]); o.y = pk2(v[2], v[3]);
    *(uint2*)p = o;
}
__device__ __forceinline__ f32x4 cvt_bf16x4(uint2 o) {
    f32x4 v; v[0] = __uint_as_float(o.x << 16); v[1] = __uint_as_float(o.x & 0xffff0000u);
    v[2] = __uint_as_float(o.y << 16); v[3] = __uint_as_float(o.y & 0xffff0000u);
    return v;
}
__device__ __forceinline__ f32x4 ld_bf16x4(const bf16_t* p) {
    uint2 o = *(const uint2*)p;
    f32x4 v; v[0] = __uint_as_float(o.x << 16); v[1] = __uint_as_float(o.x & 0xffff0000u);
    v[2] = __uint_as_float(o.y << 16); v[3] = __uint_as_float(o.y & 0xffff0000u);
    return v;
}
__device__ __forceinline__ float wave_sum(float v) {
#pragma unroll
    for (int o = 1; o < 64; o <<= 1) v += __shfl_xor(v, o);
    return v;
}
__device__ __forceinline__ float wave_max(float v) {
#pragma unroll
    for (int o = 1; o < 64; o <<= 1) v = fmaxf(v, __shfl_xor(v, o));
    return v;
}
__device__ __forceinline__ int wave_sum_i(int v) {
#pragma unroll
    for (int o = 1; o < 64; o <<= 1) v += __shfl_xor(v, o);
    return v;
}
__device__ __forceinline__ float silu(float x) { return x / (1.f + __expf(-x)); }
__device__ __forceinline__ int tid_opaque() { int t = threadIdx.x; asm volatile("" : "+v"(t)); return t; }
__device__ __forceinline__ void lds_fence() { asm volatile("s_waitcnt lgkmcnt(0)" ::: "memory"); }

__device__ __forceinline__ void transpose_convert(const float* __restrict__ W, int K, int N, int Npad, bf16_t* __restrict__ WT, float* tile,
                                  int bid, int nb) {
    const int tid = tid_opaque();
    const int tk = K / 64, tn = Npad / 64;
    for (int it = bid; it < tk * tn; it += nb) {
        const int kb = it / tn, nbk = it % tn, k0 = kb * 64, n0 = nbk * 64;
#pragma unroll
        for (int i = 0; i < 8; ++i) {
            const int r = (tid >> 6) + 8 * i, c = tid & 63, n = n0 + c;
            tile[r * 65 + c] = (n < N) ? W[(size_t)(k0 + r) * N + n] : 0.f;
        }
        __syncthreads();
#pragma unroll
        for (int i = 0; i < 8; ++i) {
            const int rn = (tid >> 6) + 8 * i, ck = tid & 63;
            WT[(size_t)(n0 + rn) * K + k0 + ck] = f2bf(tile[ck * 65 + rn]);
        }
        __syncthreads();
    }
}

__device__ __forceinline__ void phase_prologue(const Params& p, char* smem, int bid, int nb) {
    float* tile = (float*)smem;
    transpose_convert(p.gdn_w_in, D, GIN, GIN_PAD, p.wt_gin, tile, bid, nb);
    transpose_convert(p.gdn_w_out, 2048, D, D, p.wt_gout, tile, bid, nb);
    transpose_convert(p.mlp_w1, D, DFF, DFF, p.wt_w1, tile, bid, nb);
    transpose_convert(p.mlp_w1 + (size_t)D * DFF, D, DFF, DFF, p.wt_w1 + (size_t)D * DFF, tile, bid, nb);
    transpose_convert(p.mlp_w2, DFF, D, D, p.wt_w2, tile, bid, nb);
    transpose_convert(p.mlp_w2 + (size_t)D * DFF, DFF, D, D, p.wt_w2 + (size_t)D * DFF, tile, bid, nb);
    transpose_convert(p.dsa_w_in, D, DIN, DIN_PAD, p.wt_din, tile, bid, nb);
    transpose_convert(p.dsa_w_o, D, D, D, p.wt_do, tile, bid, nb);
    for (int idx = bid * NTHR + tid_opaque(); idx < MPAD * 256; idx += nb * NTHR) {
        const int row = idx >> 8, c4 = (idx & 255) * 4;
        f32x4 v = {0.f, 0.f, 0.f, 0.f};
        if (row < NPR) {
            const int b = row / LP, t = row % LP;
            const float* src = (t < NMETA) ? (p.meta + (size_t)t * D) : (p.x_prompt + ((size_t)b * SEQ + (t - NMETA)) * D);
            v = *(const f32x4*)(src + c4);
        } else if (row < NT) {
            v = *(const f32x4*)(p.x_sample + (size_t)(row - NPR) * D + c4);
        }
        st_bf16x4(p.hA + (size_t)row * D + c4, v);
    }
}

template <class Epi>
__device__ __forceinline__ void gemm_phase(const bf16_t* __restrict__ A, int lda, const bf16_t* __restrict__ Bt, int K, int Mtiles, int Ntiles,
                           const Epi& epi, char* smem, int bid, int nb) {
    bf16_t* As = (bf16_t*)smem;
    bf16_t* Bs = As + 256 * 72;
    const int tid = tid_opaque(), lane = tid & 63, wave = tid >> 6;
    const int wm = wave >> 1, wn = wave & 1;
    const int fr = lane & 15, fq = lane >> 4;
    const int ntiles = Mtiles * Ntiles;
    const int nk = K / 64;
    for (int tile = bid; tile < ntiles; tile += nb) {
        const int tm = tile % Mtiles, tn = tile / Mtiles;
        const bf16_t* Ag = A + (size_t)tm * 256 * lda;
        const bf16_t* Bg = Bt + (size_t)tn * 128 * K;
        f32x4 acc[4][4];
#pragma unroll
        for (int i = 0; i < 4; ++i)
#pragma unroll
            for (int j = 0; j < 4; ++j) acc[i][j] = (f32x4){0.f, 0.f, 0.f, 0.f};
        const int c0 = tid, c1 = tid + 512, c2 = tid + 1024, c3 = tid + 1536;
        const bf16_t* ga0 = Ag + (size_t)(c0 >> 3) * lda + (c0 & 7) * 8;
        const bf16_t* ga1 = Ag + (size_t)(c1 >> 3) * lda + (c1 & 7) * 8;
        const bf16_t* ga2 = Ag + (size_t)(c2 >> 3) * lda + (c2 & 7) * 8;
        const bf16_t* ga3 = Ag + (size_t)(c3 >> 3) * lda + (c3 & 7) * 8;
        const bf16_t* gb0 = Bg + (size_t)(c0 >> 3) * K + (c0 & 7) * 8;
        const bf16_t* gb1 = Bg + (size_t)(c1 >> 3) * K + (c1 & 7) * 8;
        bf16_t* sa0 = As + (c0 >> 3) * 72 + (c0 & 7) * 8;
        bf16_t* sa1 = As + (c1 >> 3) * 72 + (c1 & 7) * 8;
        bf16_t* sa2 = As + (c2 >> 3) * 72 + (c2 & 7) * 8;
        bf16_t* sa3 = As + (c3 >> 3) * 72 + (c3 & 7) * 8;
        bf16_t* sb0 = Bs + (c0 >> 3) * 72 + (c0 & 7) * 8;
        bf16_t* sb1 = Bs + (c1 >> 3) * 72 + (c1 & 7) * 8;
        uint4 ra0 = *(const uint4*)ga0, ra1 = *(const uint4*)ga1, ra2 = *(const uint4*)ga2, ra3 = *(const uint4*)ga3;
        uint4 rb0 = *(const uint4*)gb0, rb1 = *(const uint4*)gb1;
        *(uint4*)sa0 = ra0; *(uint4*)sa1 = ra1; *(uint4*)sa2 = ra2; *(uint4*)sa3 = ra3; *(uint4*)sb0 = rb0; *(uint4*)sb1 = rb1;
        __syncthreads();
        for (int kt = 0; kt < nk; ++kt) {
            const bool more = (kt + 1 < nk);
            if (more) {
                const int k0 = (kt + 1) * 64;
                ra0 = *(const uint4*)(ga0 + k0); ra1 = *(const uint4*)(ga1 + k0); ra2 = *(const uint4*)(ga2 + k0); ra3 = *(const uint4*)(ga3 + k0);
                rb0 = *(const uint4*)(gb0 + k0); rb1 = *(const uint4*)(gb1 + k0);
            }
#pragma unroll
            for (int kk = 0; kk < 2; ++kk) {
                bf16x8 af[4], bfr[4];
#pragma unroll
                for (int i = 0; i < 4; ++i) af[i] = *(const bf16x8*)(As + (wm * 64 + i * 16 + fr) * 72 + kk * 32 + fq * 8);
#pragma unroll
                for (int j = 0; j < 4; ++j) bfr[j] = *(const bf16x8*)(Bs + (wn * 64 + j * 16 + fr) * 72 + kk * 32 + fq * 8);
#pragma unroll
                for (int i = 0; i < 4; ++i)
#pragma unroll
                    for (int j = 0; j < 4; ++j) acc[i][j] = __builtin_amdgcn_mfma_f32_16x16x32_bf16(bfr[j], af[i], acc[i][j], 0, 0, 0);
            }
            __syncthreads();
            if (more) {
                *(uint4*)sa0 = ra0; *(uint4*)sa1 = ra1; *(uint4*)sa2 = ra2; *(uint4*)sa3 = ra3; *(uint4*)sb0 = rb0; *(uint4*)sb1 = rb1;
                __syncthreads();
            }
        }
#pragma unroll
        for (int i = 0; i < 4; ++i)
#pragma unroll
            for (int j = 0; j < 4; ++j) {
                const int row = tm * 256 + wm * 64 + i * 16 + fr, col = tn * 128 + wn * 64 + j * 16 + fq * 4;
                epi(row, col, acc[i][j]);
            }
    }
}

struct EpiGdnIn {
    bf16_t *mixed, *z; float* ba;
    __device__ __forceinline__ void operator()(int row, int col, f32x4 v) const {
        if (col < 4096) st_bf16x4(mixed + (size_t)row * 4096 + col, v);
        else if (col < 6144) st_bf16x4(z + (size_t)row * 2048 + (col - 4096), v);
        else if (col < 6176) *(f32x4*)(ba + (size_t)row * 32 + (col - 6144)) = v;
    }
};
struct EpiResid {
    float* out; const bf16_t* h;
    __device__ __forceinline__ void operator()(int row, int col, f32x4 v) const {
        const f32x4 r = ld_bf16x4(h + (size_t)row * D + col);
        *(f32x4*)(out + (size_t)row * D + col) = v + r * ALPHA;
    }
};
struct EpiRelu2 {
    bf16_t* act;
    __device__ __forceinline__ void operator()(int row, int col, f32x4 v) const {
#pragma unroll
        for (int e = 0; e < 4; ++e) { const float r = fmaxf(v[e], 0.f); v[e] = r * r; }
        st_bf16x4(act + (size_t)row * DFF + col, v);
    }
};
struct EpiF32 {
    float* out; int ld;
    __device__ __forceinline__ void operator()(int row, int col, f32x4 v) const { *(f32x4*)(out + (size_t)row * ld + col) = v; }
};

__device__ __forceinline__ void ln_phase(const float* __restrict__ X, const float* __restrict__ g, const float* __restrict__ bta, bf16_t* Hout,
                         float* yp, float* ys, int bid, int nb) {
    const int tid_ = tid_opaque(); const int lane = tid_ & 63, wave = tid_ >> 6;
    f32x4 gv[4], bv[4];
#pragma unroll
    for (int j = 0; j < 4; ++j) { gv[j] = *(const f32x4*)(g + j * 256 + lane * 4); bv[j] = *(const f32x4*)(bta + j * 256 + lane * 4); }
    for (int row = bid * 8 + wave; row < NT; row += nb * 8) {
        f32x4 v[4]; float s = 0.f;
#pragma unroll
        for (int j = 0; j < 4; ++j) { v[j] = *(const f32x4*)(X + (size_t)row * D + j * 256 + lane * 4); s += (v[j][0] + v[j][1]) + (v[j][2] + v[j][3]); }
        const float mean = wave_sum(s) * (1.f / D);
        float s2 = 0.f;
#pragma unroll
        for (int j = 0; j < 4; ++j) { v[j] = v[j] - mean; s2 += (v[j][0] * v[j][0] + v[j][1] * v[j][1]) + (v[j][2] * v[j][2] + v[j][3] * v[j][3]); }
        const float rstd = rsqrtf(wave_sum(s2) * (1.f / D) + 1e-5f);
        float* yo = nullptr;
        if (yp) {
            if (row < NPR) { const int b = row / LP, t = row % LP; if (t >= NMETA) yo = yp + ((size_t)b * SEQ + (t - NMETA)) * D; }
            else yo = ys + (size_t)(row - NPR) * D;
        }
#pragma unroll
        for (int j = 0; j < 4; ++j) {
            const f32x4 o = v[j] * rstd * gv[j] + bv[j];
            if (Hout) st_bf16x4(Hout + (size_t)row * D + j * 256 + lane * 4, o);
            if (yo) *(f32x4*)(yo + j * 256 + lane * 4) = o;
        }
    }
}

__device__ __forceinline__ void gdn_sample_unit(const Params& p, char* smem, int b, int h) {
    float* sq = (float*)smem;
    float* sk = sq + 128;
    float* sv = sk + 128;
    float* red = sv + 128;
    float* red2 = red + 512;
    float* part = red2 + 512;
    const int tid = tid_opaque(), lane = tid & 63, wave = tid >> 6;
    const int vcol = tid & 127, kq = tid >> 7;
    const size_t row0 = (size_t)NPR + (size_t)b * DS;
    const int kh = h >> 1;
    float S[32];
    {
        const float* Sp = p.state_gdn + ((size_t)(b * 16 + h) * 128) * 128;
#pragma unroll
        for (int i = 0; i < 32; ++i) S[i] = Sp[(size_t)(kq * 32 + i) * 128 + vcol];
    }
    const float Aexp = __expf(p.gdn_a_log[h]);
    const float dtb = p.gdn_dt_bias[h];
    const float nw = p.gdn_norm_w[vcol];
    const int which = tid >> 7;
    const int ch = (which == 0) ? (kh * 128 + vcol) : (which == 1) ? (1024 + kh * 128 + vcol) : (2048 + h * 128 + vcol);
    float cw[4];
#pragma unroll
    for (int j = 0; j < 4; ++j) cw[j] = p.gdn_conv_w[j * 4096 + ch];
    for (int t = 0; t < DS; ++t) {
        if (tid < 384) {
            float a = 0.f;
#pragma unroll
            for (int j = 0; j < 4; ++j) {
                const int tt = t - 3 + j;
                float xv;
                if (tt >= 0) xv = bf2f(p.mixed[(row0 + tt) * 4096 + ch]);
                else xv = p.state_conv[((size_t)b * 3 + (tt + 3)) * 4096 + ch];
                a += xv * cw[j];
            }
            const float y = silu(a);
            if (which == 0) sq[vcol] = y; else if (which == 1) sk[vcol] = y; else sv[vcol] = y;
            const float ss = wave_sum(y * y);
            if (lane == 0) part[wave] = ss;
        }
        __syncthreads();
        const float qn = rsqrtf(part[0] + part[1] + 1e-6f) * 0.08838834764831845f;
        const float kn = rsqrtf(part[2] + part[3] + 1e-6f);
        const float* bap = p.ba + (row0 + t) * 32;
        const float beta = 1.f / (1.f + __expf(-bap[h]));
        const float aa = bap[16 + h] + dtb;
        const float sp = (aa > 20.f) ? aa : log1pf(__expf(aa));
        const float dec = __expf(-Aexp * sp);
        float ks_part = 0.f;
#pragma unroll
        for (int i = 0; i < 32; ++i) { S[i] *= dec; ks_part += sk[kq * 32 + i] * S[i]; }
        red[kq * 128 + vcol] = ks_part * kn;
        __syncthreads();
        const float kS = (red[vcol] + red[128 + vcol]) + (red[256 + vcol] + red[384 + vcol]);
        const float delta = (sv[vcol] - kS) * beta * kn;
        float o_part = 0.f;
#pragma unroll
        for (int i = 0; i < 32; ++i) { S[i] += sk[kq * 32 + i] * delta; o_part += sq[kq * 32 + i] * S[i]; }
        red2[kq * 128 + vcol] = o_part * qn;
        __syncthreads();
        float o = 0.f;
        if (tid < 128) {
            o = (red2[vcol] + red2[128 + vcol]) + (red2[256 + vcol] + red2[384 + vcol]);
            const float ss = wave_sum(o * o);
            if (lane == 0) part[8 + wave] = ss;
        }
        __syncthreads();
        if (tid < 128) {
            const float rms = rsqrtf((part[8] + part[9]) * (1.f / 128.f) + 1e-6f);
            const float zz = bf2f(p.z[(row0 + t) * 2048 + h * 128 + vcol]);
            p.gated[(row0 + t) * 2048 + h * 128 + vcol] = f2bf(o * rms * nw * silu(zz));
        }
    }
    float* So = p.gs_sample + ((size_t)(b * 16 + h) * 128) * 128;
#pragma unroll
    for (int i = 0; i < 32; ++i) So[(size_t)(kq * 32 + i) * 128 + vcol] = S[i];
    __syncthreads();
}

#define MFMA32(a, b, c) __builtin_amdgcn_mfma_f32_32x32x16_bf16((a), (b), (c), 0, 0, 0)
constexpr int NCH = 65;
constexpr int NCU = BATCH * 16 * NCH;
__device__ __forceinline__ int crow(int reg, int hh) { return (reg & 3) + 8 * (reg >> 2) + 4 * hh; }
__device__ __forceinline__ bf16x8 pack_step(const f32x16& x, int s) {
    u32x4 q;
    q[0] = pk2(x[8 * s + 0], x[8 * s + 1]); q[1] = pk2(x[8 * s + 2], x[8 * s + 3]);
    q[2] = pk2(x[8 * s + 4], x[8 * s + 5]); q[3] = pk2(x[8 * s + 6], x[8 * s + 7]);
    return __builtin_bit_cast(bf16x8, q);
}
__device__ __forceinline__ bf16x8 frag_perm(const bf16_t* p0) {
    const uint2 lo = *(const uint2*)p0, hi = *(const uint2*)(p0 + 8);
    u32x4 q; q[0] = lo.x; q[1] = lo.y; q[2] = hi.x; q[3] = hi.y;
    return __builtin_bit_cast(bf16x8, q);
}

__device__ __forceinline__ void gdn_stageA(const Params& p, char* smem0, int bid, int nb) {
    const int tid = tid_opaque(), lane = tid & 63, wave = tid >> 6;
    for (int idx = bid * NTHR + tid; idx < (BATCH + DB) * 3 * 4096; idx += nb * NTHR) {
        const int c = idx & 4095, r = (idx >> 12) % 3, b = idx / (3 * 4096);
        if (b < BATCH) p.gc_prompt[idx] = bf2f(p.mixed[((size_t)b * LP + (LP - 3) + r) * 4096 + c]);
        else { const int bs = b - BATCH; p.gc_sample[(size_t)(bs * 3 + r) * 4096 + c] = bf2f(p.mixed[((size_t)NPR + bs * 4 + 1 + r) * 4096 + c]); }
    }
    for (int u = bid; u < NCU; u += nb) {
        unsigned zofs = 0; asm volatile("" : "+v"(zofs));
        char* smem = smem0 + zofs;
        bf16_t* Qb = (bf16_t*)smem;
        bf16_t* Kb = Qb + 64 * 136;
        float* RHS = (float*)(Kb + 64 * 136);
        float* Am = RHS + 64 * 256;
        float* sbeta = Am + 64 * 68;
        float* sgc = sbeta + 64;
        float* segc = sgc + 64;
        float* sekd = segc + 64;
        float* srk = sekd + 64;
        const int h = u & 15, n = (u >> 4) % NCH, b = u / (16 * NCH);
        const int kh = h >> 1;
        const size_t su = (size_t)((b * 16 + h) * NCH + n);
        const int t0 = n * 64;
        if (wave < 6) {
            const int part = wave >> 1, half = wave & 1;
            const int cq = lane & 31, tsub = lane >> 5;
            const int tl0 = 32 * half + 16 * tsub;
            const int chb = ((part == 0) ? (kh * 128) : (part == 1) ? (1024 + kh * 128) : (2048 + h * 128)) + cq * 4;
            f32x4 cw[4];
#pragma unroll
            for (int j = 0; j < 4; ++j) cw[j] = *(const f32x4*)(p.gdn_conv_w + j * 4096 + chb);
            uint2 xr[19];
#pragma unroll
            for (int i = 0; i < 19; ++i) {
                const int t = t0 + tl0 - 3 + i;
                if (t >= 0 && t < LP) xr[i] = *(const uint2*)(p.mixed + ((size_t)b * LP + t) * 4096 + chb);
                else xr[i] = make_uint2(0u, 0u);
            }
#pragma unroll
            for (int i = 0; i < 16; ++i) {
                const f32x4 a = cvt_bf16x4(xr[i]) * cw[0] + cvt_bf16x4(xr[i + 1]) * cw[1] + cvt_bf16x4(xr[i + 2]) * cw[2] + cvt_bf16x4(xr[i + 3]) * cw[3];
                const bool valid = (t0 + tl0 + i) < LP;
                f32x4 y;
#pragma unroll
                for (int e2 = 0; e2 < 4; ++e2) y[e2] = valid ? silu(a[e2]) : 0.f;
                const int c = tl0 + i;
                if (part < 2) {
                    float ss = (y[0] * y[0] + y[1] * y[1]) + (y[2] * y[2] + y[3] * y[3]);
#pragma unroll
                    for (int o = 1; o < 32; o <<= 1) ss += __shfl_xor(ss, o);
                    const float nrm = rsqrtf(ss + 1e-6f) * ((part == 0) ? 0.08838834764831845f : 1.f);
                    y = y * nrm;
                    if (part == 0) st_bf16x4(Qb + c * 136 + cq * 4, y);
                    else { st_bf16x4(Kb + c * 136 + cq * 4, y); *(f32x4*)(RHS + c * 256 + 128 + cq * 4) = y; }
                } else {
                    *(f32x4*)(RHS + c * 256 + cq * 4) = y;
                }
            }
        } else if (wave == 6) {
            const int c = lane, t = t0 + c;
            float beta = 0.f, g = 0.f;
            if (t < LP) {
                const float* bap = p.ba + ((size_t)b * LP + t) * 32;
                beta = 1.f / (1.f + __expf(-bap[h]));
                const float aa = bap[16 + h] + p.gdn_dt_bias[h];
                const float sp = (aa > 20.f) ? aa : log1pf(__expf(aa));
                g = -__expf(p.gdn_a_log[h]) * sp;
            }
            float gc = g;
#pragma unroll
            for (int o = 1; o < 64; o <<= 1) { const float v = __shfl_up(gc, o); if (lane >= o) gc += v; }
            const float glast = __shfl(gc, 63);
            sbeta[c] = beta; sgc[c] = gc; segc[c] = __expf(gc); sekd[c] = __expf(glast - gc); srk[c] = beta * __expf(gc);
            if (lane == 0) p.g_dec[su] = __expf(glast);
        }
        __syncthreads();
        {
            const int which = wave >> 2, ti = (wave >> 1) & 1, tj = wave & 1;
            const int r = lane & 31, hh = lane >> 5;
            f32x16 acc;
#pragma unroll
            for (int i = 0; i < 16; ++i) acc[i] = 0.f;
            const bf16_t* Ap = Kb + (32 * ti + r) * 136 + 8 * hh;
            const bf16_t* Bp = (which ? Qb : Kb) + (32 * tj + r) * 136 + 8 * hh;
#pragma unroll
            for (int ks = 0; ks < 8; ++ks) acc = MFMA32(*(const bf16x8*)(Ap + 16 * ks), *(const bf16x8*)(Bp + 16 * ks), acc);
            const int c = 32 * tj + r;
            const float gcc = sgc[c], bc = sbeta[c];
            if (which == 0) {
#pragma unroll
                for (int reg = 0; reg < 16; ++reg) {
                    const int cp = 32 * ti + crow(reg, hh);
                    const float dcy = __expf(fminf(gcc - sgc[cp], 0.f));
                    Am[c * 68 + cp] = (cp < c) ? (bc * acc[reg] * dcy) : 0.f;
                }
            } else {
                bf16_t* aq = p.g_aqk + su * 4096 + (size_t)c * 64;
#pragma unroll
                for (int g4 = 0; g4 < 4; ++g4) {
                    const int cp0 = 32 * ti + 8 * g4 + 4 * hh;
                    f32x4 v;
#pragma unroll
                    for (int e2 = 0; e2 < 4; ++e2) {
                        const int cp = cp0 + e2;
                        const float dcy = __expf(fminf(gcc - sgc[cp], 0.f));
                        v[e2] = (cp <= c) ? (acc[4 * g4 + e2] * dcy) : 0.f;
                    }
                    st_bf16x4(aq + cp0, v);
                }
            }
        }
        __syncthreads();
        if (wave < 4) {
            const int col = 64 * wave + lane;
            const float* rs = sbeta + __builtin_amdgcn_readfirstlane((wave < 2) ? 0 : 256);
            float x[64];
#pragma unroll
            for (int i = 0; i < 64; ++i) x[i] = RHS[i * 256 + col] * rs[i];
#pragma unroll
            for (int i = 1; i < 64; ++i) {
                float a0 = x[i], a1 = 0.f;
#pragma unroll
                for (int j4 = 0; j4 < i; j4 += 4) {
                    const f32x4 a = *(const f32x4*)(Am + i * 68 + j4);
                    a0 -= a[0] * x[j4]; a1 -= a[1] * x[j4 + 1]; a0 -= a[2] * x[j4 + 2]; a1 -= a[3] * x[j4 + 3];
                }
                x[i] = a0 + a1;
                asm volatile("" ::: "memory");
            }
            if (wave < 2) {
                float* up = p.g_u + su * 8192 + col;
#pragma unroll
                for (int i = 0; i < 64; ++i) up[i * 128] = x[i];
            } else {
                bf16_t* wp = p.g_negw + su * 8192 + (col - 128);
#pragma unroll
                for (int i = 0; i < 64; ++i) wp[i * 128] = f2bf(-x[i]);
            }
        } else {
            const int t2 = tid - 256;
#pragma unroll
            for (int it = 0; it < 4; ++it) {
                const int chk = t2 + 256 * it, c = chk >> 4, d0 = (chk & 15) * 8;
                const float e = segc[c];
                const uint4 raw = *(const uint4*)(Qb + c * 136 + d0);
                uint4 o;
                o.x = pk2(__uint_as_float(raw.x << 16) * e, __uint_as_float(raw.x & 0xffff0000u) * e);
                o.y = pk2(__uint_as_float(raw.y << 16) * e, __uint_as_float(raw.y & 0xffff0000u) * e);
                o.z = pk2(__uint_as_float(raw.z << 16) * e, __uint_as_float(raw.z & 0xffff0000u) * e);
                o.w = pk2(__uint_as_float(raw.w << 16) * e, __uint_as_float(raw.w & 0xffff0000u) * e);
                *(uint4*)(p.g_qg + su * 8192 + c * 128 + d0) = o;
            }
#pragma unroll
            for (int it = 0; it < 4; ++it) {
                const int item = t2 + 256 * it, d = item & 127, c0 = (item >> 7) * 8;
                float v[8];
#pragma unroll
                for (int i = 0; i < 8; ++i) v[i] = bf2f(Kb[(c0 + i) * 136 + d]) * sekd[c0 + i];
                uint4 o; o.x = pk2(v[0], v[1]); o.y = pk2(v[2], v[3]); o.z = pk2(v[4], v[5]); o.w = pk2(v[6], v[7]);
                *(uint4*)(p.g_kdT + su * 8192 + d * 64 + c0) = o;
            }
        }
        __syncthreads();
    }
}

constexpr int GB_NW = 0, GB_QG = 64 * 136, GB_KD = 2 * 64 * 136, GB_AQ = 2 * 64 * 136 + 128 * 72, GB_ELEMS = 2 * 64 * 136 + 128 * 72 + 64 * 72;
__device__ __forceinline__ void gdn_chain(const Params& p, char* smem, int b, int h) {
    bf16_t* lds = (bf16_t*)smem;
    const int tid = tid_opaque(), lane = tid & 63, wave = tid >> 6;
    const int r = lane & 31, hh = lane >> 5;
    const size_t su0 = (size_t)(b * 16 + h) * NCH;
    const bool loader = wave >= 4;
    const int t2 = tid - 256;
    uint4 st0, st1, st2, st3, st4, st5, st6, st7, st8, st9, st10, st11, st12, st13;
    f32x16 S[4], un0, un1;
#pragma unroll
    for (int i = 0; i < 4; ++i)
#pragma unroll
        for (int j = 0; j < 16; ++j) S[i][j] = 0.f;
    const int ch0 = t2, ch1 = t2 + 256, ch2 = t2 + 512, ch3 = t2 + 768;
#define GB_GLOAD(n_) do { const size_t su_ = su0 + (n_); \
        const bf16_t* a_ = p.g_negw + su_ * 8192; const bf16_t* b_ = p.g_qg + su_ * 8192; const bf16_t* c_ = p.g_kdT + su_ * 8192; const bf16_t* d_ = p.g_aqk + su_ * 4096; \
        st0 = *(const uint4*)(a_ + (size_t)ch0 * 8); st1 = *(const uint4*)(a_ + (size_t)ch1 * 8); st2 = *(const uint4*)(a_ + (size_t)ch2 * 8); st3 = *(const uint4*)(a_ + (size_t)ch3 * 8); \
        st4 = *(const uint4*)(b_ + (size_t)ch0 * 8); st5 = *(const uint4*)(b_ + (size_t)ch1 * 8); st6 = *(const uint4*)(b_ + (size_t)ch2 * 8); st7 = *(const uint4*)(b_ + (size_t)ch3 * 8); \
        st8 = *(const uint4*)(c_ + (size_t)ch0 * 8); st9 = *(const uint4*)(c_ + (size_t)ch1 * 8); st10 = *(const uint4*)(c_ + (size_t)ch2 * 8); st11 = *(const uint4*)(c_ + (size_t)ch3 * 8); \
        st12 = *(const uint4*)(d_ + (size_t)ch0 * 8); st13 = *(const uint4*)(d_ + (size_t)ch1 * 8); } while (0)
#define GB_SSTORE(buf_) do { bf16_t* q_ = (buf_); \
        *(uint4*)(q_ + GB_NW + (ch0 >> 4) * 136 + (ch0 & 15) * 8) = st0; *(uint4*)(q_ + GB_NW + (ch1 >> 4) * 136 + (ch1 & 15) * 8) = st1; \
        *(uint4*)(q_ + GB_NW + (ch2 >> 4) * 136 + (ch2 & 15) * 8) = st2; *(uint4*)(q_ + GB_NW + (ch3 >> 4) * 136 + (ch3 & 15) * 8) = st3; \
        *(uint4*)(q_ + GB_QG + (ch0 >> 4) * 136 + (ch0 & 15) * 8) = st4; *(uint4*)(q_ + GB_QG + (ch1 >> 4) * 136 + (ch1 & 15) * 8) = st5; \
        *(uint4*)(q_ + GB_QG + (ch2 >> 4) * 136 + (ch2 & 15) * 8) = st6; *(uint4*)(q_ + GB_QG + (ch3 >> 4) * 136 + (ch3 & 15) * 8) = st7; \
        *(uint4*)(q_ + GB_KD + (ch0 >> 3) * 72 + (ch0 & 7) * 8) = st8; *(uint4*)(q_ + GB_KD + (ch1 >> 3) * 72 + (ch1 & 7) * 8) = st9; \
        *(uint4*)(q_ + GB_KD + (ch2 >> 3) * 72 + (ch2 & 7) * 8) = st10; *(uint4*)(q_ + GB_KD + (ch3 >> 3) * 72 + (ch3 & 7) * 8) = st11; \
        *(uint4*)(q_ + GB_AQ + (ch0 >> 3) * 72 + (ch0 & 7) * 8) = st12; *(uint4*)(q_ + GB_AQ + (ch1 >> 3) * 72 + (ch1 & 7) * 8) = st13; } while (0)
#define GB_ULOAD(n_) do { const float* up_ = p.g_u + (su0 + (n_)) * 8192 + 32 * wave + r; \
        _Pragma("unroll") for (int reg_ = 0; reg_ < 16; ++reg_) { un0[reg_] = up_[(crow(reg_, hh)) * 128]; un1[reg_] = up_[(32 + crow(reg_, hh)) * 128]; } } while (0)
    if (loader) {
        GB_GLOAD(0); GB_SSTORE(lds);
        __syncthreads();
        for (int n = 0; n < NCH; ++n) {
            unsigned zofs = 0; asm volatile("" : "+v"(zofs));
            bf16_t* nxt = lds + ((n + 1) & 1) * GB_ELEMS + zofs;
            if (n + 1 < NCH) { GB_GLOAD(n + 1); GB_SSTORE(nxt); }
            __syncthreads();
        }
    } else {
        GB_ULOAD(0);
        __syncthreads();
        for (int n = 0; n < NCH; ++n) {
            unsigned zofs = 0; asm volatile("" : "+v"(zofs));
            bf16_t* cur = lds + (n & 1) * GB_ELEMS + zofs;
            const bool more = (n + 1 < NCH);
            const float dec = p.g_dec[su0 + n];
            f32x16 vn[2], o[2];
            vn[0] = un0; vn[1] = un1;
#pragma unroll
            for (int j = 0; j < 16; ++j) { o[0][j] = 0.f; o[1][j] = 0.f; }
            if (more) { GB_ULOAD(n + 1); }
#pragma unroll
            for (int kt = 0; kt < 4; ++kt)
#pragma unroll
                for (int s = 0; s < 2; ++s) {
                    const bf16x8 sb = pack_step(S[kt], s);
                    const int k0 = 32 * kt + 16 * s + 4 * hh;
#pragma unroll
                    for (int ct = 0; ct < 2; ++ct) {
                        vn[ct] = MFMA32(frag_perm(cur + GB_NW + (32 * ct + r) * 136 + k0), sb, vn[ct]);
                        o[ct] = MFMA32(frag_perm(cur + GB_QG + (32 * ct + r) * 136 + k0), sb, o[ct]);
                    }
                }
            bf16x8 vb[2][2];
#pragma unroll
            for (int ct = 0; ct < 2; ++ct)
#pragma unroll
                for (int s = 0; s < 2; ++s) vb[ct][s] = pack_step(vn[ct], s);
#pragma unroll
            for (int s = 0; s < 2; ++s) {
                o[0] = MFMA32(frag_perm(cur + GB_AQ + (r) * 72 + 16 * s + 4 * hh), vb[0][s], o[0]);
                o[1] = MFMA32(frag_perm(cur + GB_AQ + (32 + r) * 72 + 16 * s + 4 * hh), vb[0][s], o[1]);
                o[1] = MFMA32(frag_perm(cur + GB_AQ + (32 + r) * 72 + 32 + 16 * s + 4 * hh), vb[1][s], o[1]);
            }
#pragma unroll
            for (int dt = 0; dt < 4; ++dt) {
                S[dt] = S[dt] * dec;
#pragma unroll
                for (int ckt = 0; ckt < 2; ++ckt)
#pragma unroll
                    for (int s = 0; s < 2; ++s)
                        S[dt] = MFMA32(frag_perm(cur + GB_KD + (32 * dt + r) * 72 + 32 * ckt + 16 * s + 4 * hh), vb[ckt][s], S[dt]);
            }
#pragma unroll
            for (int ct = 0; ct < 2; ++ct)
#pragma unroll
                for (int reg = 0; reg < 16; ++reg) {
                    const int t = 64 * n + 32 * ct + crow(reg, hh);
                    if (t < LP) p.g_o[(((size_t)b * LP + t) * 16 + h) * 128 + 32 * wave + r] = o[ct][reg];
                }
            __syncthreads();
        }
    }
    if (!loader) {
#pragma unroll
        for (int dt = 0; dt < 4; ++dt)
#pragma unroll
            for (int reg = 0; reg < 16; ++reg)
                p.gs_prompt[((size_t)(b * 16 + h) * 128 + 32 * dt + crow(reg, hh)) * 128 + 32 * wave + r] = S[dt][reg];
    }
    __syncthreads();
}

__device__ __forceinline__ void gdn_seq_phase(const Params& p, char* smem, int bid, int nb) {
    if (bid < 64) gdn_chain(p, smem, bid >> 4, bid & 15);
    int* slot = (int*)(smem + LDS_BYTES - 32);
    for (;;) {
        if (threadIdx.x == 0) *slot = (int)atomicAdd(p.bar + 3520, 1u);
        __syncthreads();
        const int u = *slot;
        __syncthreads();
        if (u >= DB * 16) break;
        gdn_sample_unit(p, smem, u >> 4, u & 15);
    }
}

__device__ __forceinline__ void gdn_gate_phase(const Params& p, int bid, int nb) {
    const int tid_ = tid_opaque(); const int lane = tid_ & 63, wave = tid_ >> 6;
    const f32x2 nw = *(const f32x2*)(p.gdn_norm_w + lane * 2);
    for (int it = bid * 8 + wave; it < NPR * 16; it += nb * 8) {
        const f32x2 o = *(const f32x2*)(p.g_o + (size_t)it * 128 + lane * 2);
        const float ss = wave_sum(o[0] * o[0] + o[1] * o[1]);
        const float rms = rsqrtf(ss * (1.f / 128.f) + 1e-6f);
        const unsigned zr = *(const unsigned*)(p.z + (size_t)it * 128 + lane * 2);
        const float z0 = __uint_as_float(zr << 16), z1 = __uint_as_float(zr & 0xffff0000u);
        *(unsigned*)(p.gated + (size_t)it * 128 + lane * 2) = pk2(o[0] * rms * nw[0] * silu(z0), o[1] * rms * nw[1] * silu(z1));
    }
}

__device__ __forceinline__ void rope_cs(int pos, int fi, float& c, float& s) {
    const double rev = (double)pos * kInvFreq[fi] * 0.15915494309189535;
    const float r = (float)(rev - floor(rev));
    c = __builtin_amdgcn_cosf(r);
    s = __builtin_amdgcn_sinf(r);
}
__device__ __forceinline__ void dsa_post_phase(const Params& p, int bid, int nb) {
    const int tid_ = tid_opaque(); const int lane = tid_ & 63, wave = tid_ >> 6;
    for (int row = bid * 8 + wave; row < NT; row += nb * 8) {
        const float* P = p.p1 + (size_t)row * DIN_PAD;
        const bool prompt = row < NPR;
        const int pos = prompt ? (row % LP) : (PAST + ((row - NPR) & 3));
        float* kout = prompt ? (p.k_prompt + (size_t)row * 256) : (p.k_sample + (size_t)(row - NPR) * 256);
        float* vout = prompt ? (p.v_prompt + (size_t)row * 256) : (p.v_sample + (size_t)(row - NPR) * 256);
        for (int e = lane; e < 1280; e += 64) {
            const int d = e & 127;
            float o = P[e];
            if (d < 32) {
                float c, s; rope_cs(pos, d & 15, c, s);
                if (d < 16) o = o * c - P[e + 16] * s; else o = o * c + P[e - 16] * s;
            }
            if (e < 1024) {
                p.qr[(size_t)row * 1024 + e] = o;
                if (prompt) p.q_b[(size_t)row * 1024 + e] = f2bf(o * 0.12751743f);
            } else {
                kout[e - 1024] = o;
                if (prompt) { const int bb = row / LP, kvh = (e - 1024) >> 7; p.k_b[((size_t)(bb * 2 + kvh) * LPAD + pos) * 128 + d] = f2bf(o); }
            }
        }
        for (int e = lane; e < 256; e += 64) {
            const float o = P[1280 + e];
            vout[e] = o;
            if (prompt) { const int bb = row / LP, kvh = e >> 7, d = e & 127; p.vt_b[((size_t)(bb * 2 + kvh) * 128 + d) * LPAD + pos] = f2bf(o); }
        }
        for (int e = lane; e < 512; e += 64) {
            const int d = e & 63;
            float o = P[1536 + e];
            if (d < 16) {
                float c, s; rope_cs(pos, (d & 7) * 2, c, s);
                if (d < 8) o = o * c - P[1536 + e + 8] * s; else o = o * c + P[1536 + e - 8] * s;
            }
            p.iq[(size_t)row * 512 + e] = o;
            if (prompt) p.iq_b[(size_t)row * 512 + e] = f2bf(o);
        }
        {
            const float x = P[2048 + lane];
            const float mu = wave_sum(x) * (1.f / 64.f);
            const float dv = x - mu;
            const float var = wave_sum(dv * dv) * (1.f / 64.f);
            const float xn = dv * rsqrtf(var + 1e-5f) * p.dsa_ik_g[lane] + p.dsa_ik_b[lane];
            const float other = __shfl_xor(xn, 8);
            float o = xn;
            if (lane < 16) {
                float c, s; rope_cs(pos, (lane & 7) * 2, c, s);
                if (lane < 8) o = xn * c - other * s; else o = xn * c + other * s;
            }
            float* io = prompt ? (p.ik_prompt + (size_t)row * 64) : (p.ik_sample + (size_t)(row - NPR) * 64);
            io[lane] = o;
            if (prompt) p.ik_b[((size_t)(row / LP) * LPAD + pos) * 64 + lane] = f2bf(o);
        }
        if (lane < 8) p.iw[(size_t)row * 8 + lane] = P[2112 + lane] * 0.35355339059327373f;
    }
    for (int idx = bid * NTHR + tid_opaque(); idx < BATCH * (LPAD - LP) * 256; idx += nb * NTHR) {
        const int c = idx & 255, tp = (idx >> 8) % (LPAD - LP), bb = idx / ((LPAD - LP) * 256);
        const int t = LP + tp, kvh = c >> 7, d = c & 127;
        p.k_b[((size_t)(bb * 2 + kvh) * LPAD + t) * 128 + d] = 0;
        p.vt_b[((size_t)(bb * 2 + kvh) * 128 + d) * LPAD + t] = 0;
        if (c < 64) p.ik_b[((size_t)bb * LPAD + t) * 64 + c] = 0;
        if (c < 65) p.maskT[((size_t)bb * 65 + c) * LPAD + t] = (c == 0) ? 1ull : 0ull;
    }
}

__device__ __forceinline__ const float* ik_row(const Params& p, bool prompt, int b, int s) {
    if (prompt) return p.ik_prompt + ((size_t)b * LP + s) * 64;
    if (s < PAST) { const int pg = p.page_table[b * 16 + (s >> 7)]; return p.cache_ik + ((size_t)pg * 128 + (s & 127)) * 64; }
    return p.ik_sample + ((size_t)b * DS + (s - PAST)) * 64;
}
__device__ __forceinline__ const float* kv_row(const float* own_p, const float* own_s, const float* cache, const int* page_table,
                                               bool prompt, int b, int s) {
    if (prompt) return own_p + ((size_t)b * LP + s) * 256;
    if (s < PAST) { const int pg = page_table[b * 16 + (s >> 7)]; return cache + ((size_t)pg * 128 + (s & 127)) * 256; }
    return own_s + ((size_t)b * DS + (s - PAST)) * 256;
}

template <bool PROMPT>
__device__ __forceinline__ void select_emit(const float* sc, int qpos, int lane, unsigned long long* maskcol, int* selrow) {
    const unsigned long long ltmask = (1ull << lane) - 1ull;
    unsigned key[65];
#pragma unroll
    for (int j = 0; j < 65; ++j) {
        const int s = j * 64 + lane;
        const float x = (s >= 16 && s <= qpos) ? sc[s] : -INFINITY;
        const unsigned u = __float_as_uint(x);
        key[j] = (u & 0x80000000u) ? ~u : (u | 0x80000000u);
    }
    unsigned T = 0u;
    for (int bit = 31; bit >= 0; --bit) {
        const unsigned cand = T | (1u << bit);
        int c = 0;
#pragma unroll
        for (int j = 0; j < 65; ++j) c += (key[j] >= cand) ? 1 : 0;
        c = wave_sum_i(c);
        if (c >= 240) T = cand;
    }
    int cgt = 0;
#pragma unroll
    for (int j = 0; j < 65; ++j) cgt += (key[j] > T) ? 1 : 0;
    cgt = wave_sum_i(cgt);
    const int need_eq = 240 - cgt;
    if (!PROMPT) { if (lane < 16) selrow[lane] = lane; }
    int base = 16, erun = 0;
    unsigned long long myword = 0ull, word64 = 0ull;
#pragma unroll
    for (int j = 0; j < 65; ++j) {
        const bool gt = key[j] > T, eq = key[j] == T;
        const unsigned long long meq = __ballot(eq);
        const int rank = erun + __popcll(meq & ltmask);
        const bool take = gt || (eq && rank < need_eq);
        unsigned long long m = __ballot(take);
        if (PROMPT) {
            if (j == 0) m |= 0xFFFFull;
            if (j < 64) { if (lane == j) myword = m; } else word64 = m;
        } else {
            if (take) selrow[base + __popcll(m & ltmask)] = j * 64 + lane;
            base += __popcll(m);
        }
        erun += __popcll(meq);
    }
    if (PROMPT) {
        maskcol[(size_t)lane * LPAD] = myword;
        if (lane == 0) maskcol[(size_t)64 * LPAD] = word64;
    }
}

__device__ __forceinline__ void indexer_phase(const Params& p, char* smem, int bid, int nb) {
    const int tid_ = tid_opaque(); const int lane = tid_ & 63, wave = tid_ >> 6;
    float* sc = (float*)smem + wave * (4160 + 512);
    float* qs = sc + 4160;
    for (int row = bid * 8 + wave; row < NT; row += nb * 8) {
        const bool prompt = row < NPR;
        int b, qpos;
        if (prompt) { b = row / LP; qpos = row % LP; } else { b = (row - NPR) >> 2; qpos = PAST + ((row - NPR) & 3); }
        int* selrow = p.sel + (size_t)row * 256;
        unsigned long long* maskcol = p.maskT + (size_t)b * 65 * LPAD + qpos;
        const int n = qpos - 15;
        if (n <= 240) {
            if (prompt) {
                for (int j = lane; j < 65; j += 64) {
                    const int lo = j * 64;
                    unsigned long long m = 0ull;
                    if (qpos >= lo + 63) m = ~0ull; else if (qpos >= lo) m = (1ull << (qpos - lo + 1)) - 1ull;
                    maskcol[(size_t)j * LPAD] = m;
                }
            } else {
                for (int j = lane; j < 256; j += 64) selrow[j] = (j <= qpos) ? j : -1;
            }
            continue;
        }
        for (int j = lane; j < 512; j += 64) qs[j] = p.iq[(size_t)row * 512 + j];
        float w[8];
#pragma unroll
        for (int h = 0; h < 8; ++h) w[h] = p.iw[(size_t)row * 8 + h];
        lds_fence();
        for (int j0 = 0; j0 < n; j0 += 64) {
            const int s = 16 + j0 + lane;
            const bool valid = s <= qpos;
            const float* kp = ik_row(p, prompt, b, valid ? s : qpos);
            float dh[8];
#pragma unroll
            for (int h = 0; h < 8; ++h) dh[h] = 0.f;
#pragma unroll
            for (int half = 0; half < 2; ++half) {
                f32x4 kv[8];
#pragma unroll
                for (int c = 0; c < 8; ++c) kv[c] = *(const f32x4*)(kp + half * 32 + c * 4);
#pragma unroll
                for (int h = 0; h < 8; ++h) {
                    float d = dh[h];
#pragma unroll
                    for (int c = 0; c < 8; ++c) {
                        const f32x4 q4 = *(const f32x4*)(qs + h * 64 + half * 32 + c * 4);
                        d += kv[c][0] * q4[0]; d += kv[c][1] * q4[1]; d += kv[c][2] * q4[2]; d += kv[c][3] * q4[3];
                    }
                    dh[h] = d;
                }
            }
            float score = 0.f;
#pragma unroll
            for (int h = 0; h < 8; ++h) score += w[h] * fmaxf(dh[h], 0.f);
            if (valid) sc[s] = score;
        }
        lds_fence();
        if (prompt) select_emit<true>(sc, qpos, lane, maskcol, selrow);
        else select_emit<false>(sc, qpos, lane, maskcol, selrow);
        lds_fence();
    }
}

__device__ __forceinline__ void attn_sample_query(const Params& p, char* smem, int row) {
    float* qs = (float*)smem;
    float* ps = qs + 1024;
    int* sidx = (int*)(ps + 2048);
    const int tid = tid_opaque(), lane = tid & 63, wave = tid >> 6;
    const bool prompt = false;
    const int b = (row - NPR) >> 2;
    qs[tid] = p.qr[(size_t)row * 1024 + tid];
    qs[tid + 512] = p.qr[(size_t)row * 1024 + 512 + tid];
    if (tid < 256) sidx[tid] = p.sel[(size_t)row * 256 + tid];
    __syncthreads();
    {
        const int j = tid & 255, kvh = tid >> 8;
        const int s = sidx[j];
        const bool valid = s >= 0;
        const float* kp = kv_row(p.k_prompt, p.k_sample, p.cache_k, p.page_table, prompt, b, valid ? s : 0) + kvh * 128;
        float d0 = 0.f, d1 = 0.f, d2 = 0.f, d3 = 0.f;
        const float* q0 = qs + (kvh * 4) * 128;
#pragma unroll 8
        for (int c = 0; c < 32; ++c) {
            const f32x4 kv = *(const f32x4*)(kp + c * 4);
            const f32x4 a0 = *(const f32x4*)(q0 + c * 4), a1 = *(const f32x4*)(q0 + 128 + c * 4), a2 = *(const f32x4*)(q0 + 256 + c * 4),
                        a3 = *(const f32x4*)(q0 + 384 + c * 4);
            d0 += kv[0] * a0[0] + kv[1] * a0[1] + kv[2] * a0[2] + kv[3] * a0[3];
            d1 += kv[0] * a1[0] + kv[1] * a1[1] + kv[2] * a1[2] + kv[3] * a1[3];
            d2 += kv[0] * a2[0] + kv[1] * a2[1] + kv[2] * a2[2] + kv[3] * a2[3];
            d3 += kv[0] * a3[0] + kv[1] * a3[1] + kv[2] * a3[2] + kv[3] * a3[3];
        }
        const float sc = 0.08838834764831845f;
        ps[(kvh * 4 + 0) * 256 + j] = valid ? d0 * sc : -INFINITY;
        ps[(kvh * 4 + 1) * 256 + j] = valid ? d1 * sc : -INFINITY;
        ps[(kvh * 4 + 2) * 256 + j] = valid ? d2 * sc : -INFINITY;
        ps[(kvh * 4 + 3) * 256 + j] = valid ? d3 * sc : -INFINITY;
    }
    __syncthreads();
    {
        float v[4]; float m = -INFINITY;
#pragma unroll
        for (int i = 0; i < 4; ++i) { v[i] = ps[wave * 256 + lane + 64 * i]; m = fmaxf(m, v[i]); }
        m = wave_max(m);
        float sum = 0.f;
#pragma unroll
        for (int i = 0; i < 4; ++i) { v[i] = __expf(v[i] - m); sum += v[i]; }
        sum = wave_sum(sum);
        const float inv = 1.f / sum;
#pragma unroll
        for (int i = 0; i < 4; ++i) ps[wave * 256 + lane + 64 * i] = v[i] * inv;
    }
    __syncthreads();
    {
        const int h = wave, d = lane * 2, kvh = h >> 2;
        float o0 = 0.f, o1 = 0.f;
#pragma unroll 16
        for (int j = 0; j < 256; ++j) {
            int s = sidx[j]; if (s < 0) s = 0;
            const float* vp = kv_row(p.v_prompt, p.v_sample, p.cache_v, p.page_table, prompt, b, s) + kvh * 128 + d;
            const float pj = ps[h * 256 + j];
            const float2 vv = *(const float2*)vp;
            o0 += pj * vv.x; o1 += pj * vv.y;
        }
        *(unsigned*)(p.gated + (size_t)row * 1024 + h * 128 + d) = pk2(o0, o1);
    }
    __syncthreads();
}

constexpr int AT_K = 0, AT_V = 64 * 136, AT_ELEMS = 64 * 136 + 128 * 72;
__device__ __forceinline__ void attn_dense_unit(const Params& p, char* smem, int b, int kvh, int qb) {
    bf16_t* lds = (bf16_t*)smem;
    const int tid = tid_opaque(), lane = tid & 63, wave = tid >> 6;
    const int r = lane & 31, hh = lane >> 5;
    const int g = wave & 3, qs = wave >> 2;
    const int head = kvh * 4 + g;
    const int tq = 64 * qb + 32 * qs + r;
    const int tqc = (tq < LP) ? tq : (LP - 1);
    bf16x8 qf[8];
    {
        const bf16_t* qp = p.q_b + ((size_t)b * LP + tqc) * 1024 + head * 128 + 8 * hh;
#pragma unroll
        for (int ks = 0; ks < 8; ++ks) qf[ks] = *(const bf16x8*)(qp + 16 * ks);
    }
    f32x16 O[4];
#pragma unroll
    for (int i = 0; i < 4; ++i)
#pragma unroll
        for (int j = 0; j < 16; ++j) O[i][j] = 0.f;
    float mrun = -3.0e38f, lrun = 0.f;
    const bf16_t* Kg = p.k_b + ((size_t)(b * 2 + kvh) * LPAD) * 128;
    const bf16_t* Vg = p.vt_b + ((size_t)(b * 2 + kvh) * 128) * LPAD;
    const unsigned long long* mcol = p.maskT + (size_t)b * 65 * LPAD + tq;
    const int kc0 = tid, kc1 = tid + 512;
    uint4 sk0, sk1, sv0, sv1;
#define AT_GLOAD(kt_) do { const bf16_t* kg_ = Kg + (size_t)(kt_) * 64 * 128; const bf16_t* vg_ = Vg + (size_t)(kt_) * 64; \
        sk0 = *(const uint4*)(kg_ + (size_t)kc0 * 8); sk1 = *(const uint4*)(kg_ + (size_t)kc1 * 8); \
        sv0 = *(const uint4*)(vg_ + (size_t)(kc0 >> 3) * LPAD + (kc0 & 7) * 8); sv1 = *(const uint4*)(vg_ + (size_t)(kc1 >> 3) * LPAD + (kc1 & 7) * 8); } while (0)
#define AT_SSTORE(buf_) do { bf16_t* q_ = (buf_); \
        *(uint4*)(q_ + AT_K + (kc0 >> 4) * 136 + (kc0 & 15) * 8) = sk0; *(uint4*)(q_ + AT_K + (kc1 >> 4) * 136 + (kc1 & 15) * 8) = sk1; \
        *(uint4*)(q_ + AT_V + (kc0 >> 3) * 72 + (kc0 & 7) * 8) = sv0; *(uint4*)(q_ + AT_V + (kc1 >> 3) * 72 + (kc1 & 7) * 8) = sv1; } while (0)
    AT_GLOAD(0); AT_SSTORE(lds);
    __syncthreads();
    for (int kt = 0; kt <= qb; ++kt) {
        unsigned zofs = 0; asm volatile("" : "+v"(zofs));
        bf16_t* cur = lds + (kt & 1) * AT_ELEMS + zofs;
        bf16_t* nxt = lds + ((kt + 1) & 1) * AT_ELEMS + zofs;
        const bool more = kt < qb;
        if (more) { AT_GLOAD(kt + 1); }
        const unsigned long long mw = mcol[(size_t)kt * LPAD];
        f32x16 st[2];
#pragma unroll
        for (int j = 0; j < 16; ++j) { st[0][j] = 0.f; st[1][j] = 0.f; }
#pragma unroll
        for (int ks = 0; ks < 8; ++ks) {
            st[0] = MFMA32(*(const bf16x8*)(cur + AT_K + (r) * 136 + 16 * ks + 8 * hh), qf[ks], st[0]);
            st[1] = MFMA32(*(const bf16x8*)(cur + AT_K + (32 + r) * 136 + 16 * ks + 8 * hh), qf[ks], st[1]);
        }
        float mx = -3.0e38f;
#pragma unroll
        for (int kk = 0; kk < 2; ++kk) {
            const unsigned w = (unsigned)(mw >> (32 * kk)) >> (4 * hh);
#pragma unroll
            for (int reg = 0; reg < 16; ++reg) {
                const int bit = (reg & 3) + 8 * (reg >> 2);
                const float v = ((w >> bit) & 1u) ? st[kk][reg] : -3.0e38f;
                st[kk][reg] = v;
                mx = fmaxf(mx, v);
            }
        }
        mx = fmaxf(mx, __shfl_xor(mx, 32));
        const float mnew = fmaxf(mrun, mx);
        const float alpha = __builtin_amdgcn_exp2f(mrun - mnew);
        mrun = mnew;
        float psum = 0.f;
#pragma unroll
        for (int kk = 0; kk < 2; ++kk)
#pragma unroll
            for (int reg = 0; reg < 16; ++reg) { const float pv = __builtin_amdgcn_exp2f(st[kk][reg] - mnew); st[kk][reg] = pv; psum += pv; }
        lrun = lrun * alpha + psum;
#pragma unroll
        for (int dt = 0; dt < 4; ++dt) O[dt] = O[dt] * alpha;
        bf16x8 pb[2][2];
#pragma unroll
        for (int kk = 0; kk < 2; ++kk)
#pragma unroll
            for (int s = 0; s < 2; ++s) pb[kk][s] = pack_step(st[kk], s);
#pragma unroll
        for (int dt = 0; dt < 4; ++dt)
#pragma unroll
            for (int kk = 0; kk < 2; ++kk)
#pragma unroll
                for (int s = 0; s < 2; ++s)
                    O[dt] = MFMA32(frag_perm(cur + AT_V + (32 * dt + r) * 72 + 32 * kk + 16 * s + 4 * hh), pb[kk][s], O[dt]);
        if (more) { AT_SSTORE(nxt); }
        __syncthreads();
    }
    const float ltot = lrun + __shfl_xor(lrun, 32);
    const float inv = 1.f / ltot;
    if (tq < LP) {
        bf16_t* op = p.gated + ((size_t)b * LP + tq) * 1024 + head * 128;
#pragma unroll
        for (int dt = 0; dt < 4; ++dt)
#pragma unroll
            for (int g4 = 0; g4 < 4; ++g4) {
                f32x4 v;
#pragma unroll
                for (int e2 = 0; e2 < 4; ++e2) v[e2] = O[dt][4 * g4 + e2] * inv;
                st_bf16x4(op + 32 * dt + 8 * g4 + 4 * hh, v);
            }
    }
    __syncthreads();
}

__device__ __forceinline__ void attn_phase(const Params& p, char* smem, int bid, int nb) {
    int* slot = (int*)(smem + LDS_BYTES - 32);
    for (;;) {
        if (threadIdx.x == 0) *slot = (int)atomicAdd(p.bar + 3584, 1u);
        __syncthreads();
        const int u = *slot;
        __syncthreads();
        if (u >= 520 + NSR) break;
        if (u < 520) attn_dense_unit(p, smem, (u & 7) >> 1, u & 1, 64 - (u >> 3));
        else attn_sample_query(p, smem, NPR + (u - 520));
    }
}

#define XB_TMO      128
#define XB_XCNT(j)  (256  + 64 * (j))
#define XB_XSUB(j)  (1280 + 64 * (j))
#define XB_XGEN(j)  (2304 + 64 * (j))
#define XB_TOP      3328
#define XB_TOPGEN   3392
#define XCD_BAR_WORDS 3456
#define XB_SPIN_CAP (1u << 18)
#define LAS __attribute__((address_space(3)))

__device__ __forceinline__ unsigned xb_ld(unsigned* p)              { return __hip_atomic_load(p, __ATOMIC_RELAXED, __HIP_MEMORY_SCOPE_AGENT); }
__device__ __forceinline__ unsigned xb_add(unsigned* p, unsigned v) { return __hip_atomic_fetch_add(p, v, __ATOMIC_RELAXED, __HIP_MEMORY_SCOPE_AGENT); }
__device__ __forceinline__ unsigned xb_xcc_id() { return (unsigned)__builtin_amdgcn_s_getreg((3 << 11) | 20) & 0xFu; }
#define XB_SPIN(cond, bar) do { unsigned _sp = 0; while (cond) { __builtin_amdgcn_s_sleep(1); \
    if ((++_sp & 255u) == 0u) { if (xb_ld(&(bar)[XB_TMO])) break; if (_sp > XB_SPIN_CAP) { atomicAdd(&(bar)[XB_TMO], 1u); break; } } } } while (0)

struct XcdBarrier {
    unsigned* bar; unsigned x;
    volatile LAS unsigned* st;
};

__device__ __forceinline__ XcdBarrier xcd_barrier_post(unsigned* bar, volatile LAS unsigned* st) {
    XcdBarrier b; b.bar = bar; b.x = xb_xcc_id(); b.st = st;
    if (threadIdx.x == 0) (void)xb_add(&bar[XB_XCNT(b.x)], 1u);
    return b;
}
__device__ __forceinline__ void xcd_barrier_complete(unsigned* bar, unsigned x, unsigned& nloc, unsigned& nx) {
    const unsigned G = gridDim.x * gridDim.y * gridDim.z;
    unsigned sum, cnt, mine, sp = 0u;
    for (;;) {
        sum = 0u; cnt = 0u; mine = 0u;
#pragma unroll
        for (unsigned j = 0; j < 16; ++j) { const unsigned c = xb_ld(&bar[XB_XCNT(j)]); sum += c; cnt += (c > 0u) ? 1u : 0u; mine = (j == x) ? c : mine; }
        if (sum == G) break;
        __builtin_amdgcn_s_sleep(1);
        if ((++sp & 255u) == 0u) { if (xb_ld(&bar[XB_TMO])) break; if (sp > XB_SPIN_CAP) { atomicAdd(&bar[XB_TMO], 1u); break; } }
    }
    nloc = mine > 0u ? mine : 1u; nx = cnt > 0u ? cnt : 1u;
}

__device__ __forceinline__ void xcd_barrier(const XcdBarrier& b) {
    asm volatile("s_waitcnt vmcnt(0)" ::: "memory");
    __syncthreads();
    if (threadIdx.x == 0) {
        unsigned* bar = b.bar;
        __builtin_amdgcn_s_waitcnt(0);
        unsigned nloc = b.st[0], nx = b.st[1];
        if (nloc == 0u) { xcd_barrier_complete(bar, b.x, nloc, nx); b.st[0] = nloc; b.st[1] = nx; }
        const unsigned old = xb_add(&bar[XB_XSUB(b.x)], 1u);
        const unsigned gen = old / nloc;
        if (old + 1u == (gen + 1u) * nloc) {
            __builtin_amdgcn_fence(__ATOMIC_RELEASE, "agent");
            asm volatile("s_waitcnt vmcnt(0)" ::: "memory");
            const unsigned og = xb_add(&bar[XB_TOP], 1u);
            const unsigned tg = og / nx;
            if (og + 1u == (tg + 1u) * nx) xb_add(&bar[XB_TOPGEN], 1u);
            else XB_SPIN(xb_ld(&bar[XB_TOPGEN]) == tg, bar);
            __builtin_amdgcn_fence(__ATOMIC_ACQUIRE, "agent");
            xb_add(&bar[XB_XGEN(b.x)], 1u);
            asm volatile("s_waitcnt vmcnt(0)" ::: "memory");
        } else {
            XB_SPIN(xb_ld(&bar[XB_XGEN(b.x)]) == gen, bar);
            __builtin_amdgcn_fence(__ATOMIC_ACQUIRE, "agent");
            asm volatile("s_waitcnt vmcnt(0)" ::: "memory");
        }
    }
    __syncthreads();
}


constexpr int NPHASE = 19;
template <int PH>
__device__ __forceinline__ void run_phase(const Params& p, char* smem, int bid, int nb) {
    constexpr int MT = MPAD / 256;
    if constexpr (PH == 0) phase_prologue(p, smem, bid, nb);
    else if constexpr (PH == 1) gemm_phase(p.hA, D, p.wt_gin, D, MT, GIN_PAD / 128, EpiGdnIn{p.mixed, p.z, p.ba}, smem, bid, nb);
    else if constexpr (PH == 2) gdn_stageA(p, smem, bid, nb);
    else if constexpr (PH == 3) gdn_seq_phase(p, smem, bid, nb);
    else if constexpr (PH == 4) gdn_gate_phase(p, bid, nb);
    else if constexpr (PH == 5) gemm_phase(p.gated, 2048, p.wt_gout, 2048, MT, D / 128, EpiResid{p.preln, p.hA}, smem, bid, nb);
    else if constexpr (PH == 6) ln_phase(p.preln, p.ln1_g, p.ln1_b, p.hB, nullptr, nullptr, bid, nb);
    else if constexpr (PH == 7) gemm_phase(p.hB, D, p.wt_w1, D, MT, DFF / 128, EpiRelu2{p.act}, smem, bid, nb);
    else if constexpr (PH == 8) gemm_phase(p.act, DFF, p.wt_w2, DFF, MT, D / 128, EpiResid{p.preln, p.hB}, smem, bid, nb);
    else if constexpr (PH == 9) ln_phase(p.preln, p.ln2_g, p.ln2_b, p.hA, nullptr, nullptr, bid, nb);
    else if constexpr (PH == 10) gemm_phase(p.hA, D, p.wt_din, D, MT, DIN_PAD / 128, EpiF32{p.p1, DIN_PAD}, smem, bid, nb);
    else if constexpr (PH == 11) dsa_post_phase(p, bid, nb);
    else if constexpr (PH == 12) indexer_phase(p, smem, bid, nb);
    else if constexpr (PH == 13) attn_phase(p, smem, bid, nb);
    else if constexpr (PH == 14) gemm_phase(p.gated, D, p.wt_do, D, MT, D / 128, EpiResid{p.preln, p.hA}, smem, bid, nb);
    else if constexpr (PH == 15) ln_phase(p.preln, p.ln1_g + D, p.ln1_b + D, p.hB, nullptr, nullptr, bid, nb);
    else if constexpr (PH == 16) gemm_phase(p.hB, D, p.wt_w1 + (size_t)D * DFF, D, MT, DFF / 128, EpiRelu2{p.act}, smem, bid, nb);
    else if constexpr (PH == 17) gemm_phase(p.act, DFF, p.wt_w2 + (size_t)D * DFF, DFF, MT, D / 128, EpiResid{p.preln, p.hB}, smem, bid, nb);
    else if constexpr (PH == 18) ln_phase(p.preln, p.ln2_g + D, p.ln2_b + D, nullptr, p.y_prompt, p.y_sample, bid, nb);
}

template <int PH>
__global__ void __launch_bounds__(NTHR, 2) k_phase(Params p) {
    extern __shared__ __attribute__((aligned(16))) char smem[];
    run_phase<PH>(p, smem, blockIdx.x, gridDim.x);
}

template <int PH>
__device__ __forceinline__ void mega_run(const Params& p, char* smem, const XcdBarrier& bar) {
    run_phase<PH>(p, smem, blockIdx.x, gridDim.x);
    if constexpr (PH + 1 < NPHASE) {
        xcd_barrier(bar);
        mega_run<PH + 1>(p, smem, bar);
    }
}
__global__ void __launch_bounds__(NTHR, 2) k_mega(Params p) {
    extern __shared__ __attribute__((aligned(16))) char smem[];
    volatile LAS unsigned* st = (volatile LAS unsigned*)(smem + LDS_BYTES - 16);
    if (threadIdx.x == 0) { st[0] = 0u; st[1] = 0u; st[2] = 0u; st[3] = 0u; }
    __syncthreads();
    XcdBarrier bar = xcd_barrier_post(p.bar, st);
    mega_run<0>(p, smem, bar);
}

template <int PH>
void launch_phase(const Params& p, hipStream_t stream) {
    static bool attr_done = false;
    if (!attr_done) {
        (void)hipFuncSetAttribute((const void*)k_phase<PH>, hipFuncAttributeMaxDynamicSharedMemorySize, LDS_BYTES);
        attr_done = true;
    }
    hipLaunchKernelGGL(k_phase<PH>, dim3(256), dim3(NTHR), LDS_BYTES, stream, p);
}
template <int PH>
void launch_all(const Params& p, hipStream_t stream) {
    launch_phase<PH>(p, stream);
    if constexpr (PH + 1 < NPHASE) launch_all<PH + 1>(p, stream);
}

}

extern "C" void kernel_launch(void* const* d_in, const int* in_sizes, int n_in, void* d_out, int out_size, void* d_ws, size_t ws_size,
                              hipStream_t stream) {
    Params p{};
    p.x_prompt = (const float*)d_in[0]; p.x_sample = (const float*)d_in[1]; p.state_gdn = (const float*)d_in[2];
    p.state_conv = (const float*)d_in[3]; p.cache_k = (const float*)d_in[4]; p.cache_v = (const float*)d_in[5];
    p.cache_ik = (const float*)d_in[6]; p.page_table = (const int*)d_in[7]; p.meta = (const float*)d_in[8];
    p.ln1_g = (const float*)d_in[9]; p.ln1_b = (const float*)d_in[10]; p.ln2_g = (const float*)d_in[11]; p.ln2_b = (const float*)d_in[12];
    p.mlp_w1 = (const float*)d_in[13]; p.mlp_w2 = (const float*)d_in[14]; p.gdn_w_in = (const float*)d_in[15];
    p.gdn_conv_w = (const float*)d_in[16]; p.gdn_a_log = (const float*)d_in[17]; p.gdn_dt_bias = (const float*)d_in[18];
    p.gdn_norm_w = (const float*)d_in[19]; p.gdn_w_out = (const float*)d_in[20]; p.dsa_w_in = (const float*)d_in[21];
    p.dsa_ik_g = (const float*)d_in[22]; p.dsa_ik_b = (const float*)d_in[23]; p.dsa_w_o = (const float*)d_in[24];
    float* o = (float*)d_out;
    p.y_prompt = o; o += (size_t)BATCH * SEQ * D;
    p.y_sample = o; o += (size_t)NSR * D;
    p.gs_prompt = o; o += (size_t)BATCH * 16 * 128 * 128;
    p.gc_prompt = o; o += (size_t)BATCH * 3 * 4096;
    p.gs_sample = o; o += (size_t)DB * 16 * 128 * 128;
    p.gc_sample = o; o += (size_t)DB * 3 * 4096;
    p.k_prompt = o; o += (size_t)NPR * 256;
    p.v_prompt = o; o += (size_t)NPR * 256;
    p.ik_prompt = o; o += (size_t)NPR * 64;
    p.k_sample = o; o += (size_t)NSR * 256;
    p.v_sample = o; o += (size_t)NSR * 256;
    p.ik_sample = o; o += (size_t)NSR * 64;
    char* w = (char*)d_ws;
    auto take = [&](size_t bytes) { char* r = w; w += (bytes + 255) & ~(size_t)255; return r; };
    p.bar = (unsigned*)take(16384);
    p.wt_gin = (bf16_t*)take((size_t)GIN_PAD * D * 2);
    p.wt_gout = (bf16_t*)take((size_t)D * 2048 * 2);
    p.wt_w1 = (bf16_t*)take((size_t)2 * D * DFF * 2);
    p.wt_w2 = (bf16_t*)take((size_t)2 * D * DFF * 2);
    p.wt_din = (bf16_t*)take((size_t)DIN_PAD * D * 2);
    p.wt_do = (bf16_t*)take((size_t)D * D * 2);
    p.hA = (bf16_t*)take((size_t)MPAD * D * 2);
    p.hB = (bf16_t*)take((size_t)MPAD * D * 2);
    p.preln = (float*)take((size_t)MPAD * D * 4);
    p.mixed = (bf16_t*)take((size_t)MPAD * 4096 * 2);
    p.z = (bf16_t*)take((size_t)MPAD * 2048 * 2);
    p.ba = (float*)take((size_t)MPAD * 32 * 4);
    p.gated = (bf16_t*)take((size_t)MPAD * 2048 * 2);
    p.act = (bf16_t*)take((size_t)MPAD * DFF * 2);
    p.p1 = (float*)take((size_t)MPAD * DIN_PAD * 4);
    p.qr = (float*)take((size_t)MPAD * 1024 * 4);
    p.iq = (float*)take((size_t)MPAD * 512 * 4);
    p.iw = (float*)take((size_t)MPAD * 8 * 4);
    p.sel = (int*)take((size_t)MPAD * 256 * 4);
    p.g_o = (float*)take((size_t)NPR * 2048 * 4);
    p.q_b = (bf16_t*)take((size_t)NPR * 1024 * 2);
    p.k_b = (bf16_t*)take((size_t)BATCH * 2 * LPAD * 128 * 2);
    p.vt_b = (bf16_t*)take((size_t)BATCH * 2 * 128 * LPAD * 2);
    p.iq_b = (bf16_t*)take((size_t)NPR * 512 * 2);
    p.ik_b = (bf16_t*)take((size_t)BATCH * LPAD * 64 * 2);
    p.maskT = (unsigned long long*)take((size_t)BATCH * 65 * LPAD * 8);
    p.g_dec = (float*)take((size_t)NCU * 4);
    p.g_u = (float*)p.act;
    p.g_negw = (bf16_t*)p.p1;
    p.g_qg = p.g_negw + (size_t)NCU * 8192;
    p.g_kdT = (bf16_t*)p.qr;
    p.g_aqk = (bf16_t*)p.iq;
    if ((size_t)(w - (char*)d_ws) > ws_size) { fprintf(stderr, "kernel_launch: workspace too small (%zu needed, %zu given)\n", (size_t)(w - (char*)d_ws), ws_size); return; }
#if MEGA
    static int grid = 0;
    if (grid == 0) {
        int dev = 0, cus = 0;
        if (hipGetDevice(&dev) != hipSuccess || hipDeviceGetAttribute(&cus, hipDeviceAttributeMultiprocessorCount, dev) != hipSuccess || cus <= 0) cus = 256;
        (void)hipFuncSetAttribute((const void*)k_mega, hipFuncAttributeMaxDynamicSharedMemorySize, LDS_BYTES);
        grid = cus;
    }
    (void)hipMemsetAsync(p.bar, 0, 16384, stream);
    hipLaunchKernelGGL(k_mega, dim3(grid), dim3(NTHR), LDS_BYTES, stream, p);
#else
    launch_all<0>(p, stream);
#endif
}
```

```cpp
#include <hip/hip_runtime.h>
#include <stdint.h>
#include <stdio.h>

#ifndef MEGA
#define MEGA 1
#endif

namespace {

typedef unsigned short bf16_t;
typedef short bf16x8 __attribute__((ext_vector_type(8)));
typedef float f32x4 __attribute__((ext_vector_type(4)));

constexpr int D = 1024, BATCH = 4, SEQ = 4096, NMETA = 16, LP = SEQ + NMETA;
constexpr int DB = 128, DS = 4, PAST = 2048;
constexpr int NPR = BATCH * LP;
constexpr int NSR = DB * DS;
constexpr int NT = NPR + NSR;
constexpr int MPAD = 17152;
constexpr int DFF = 4096;
constexpr int GIN = 6176, GIN_PAD = 6272;
constexpr int DIN = 2120, DIN_PAD = 2176;
constexpr int NTHR = 512;
constexpr int LPAD = 4160;
constexpr int LDS_BYTES = 150 * 1024;
constexpr float ALPHA = 1.4142135623730951f;

struct Params {
    const float *x_prompt, *x_sample, *state_gdn, *state_conv, *cache_k, *cache_v, *cache_ik;
    const int* page_table;
    const float *meta, *ln1_g, *ln1_b, *ln2_g, *ln2_b, *mlp_w1, *mlp_w2, *gdn_w_in, *gdn_conv_w, *gdn_a_log, *gdn_dt_bias,
        *gdn_norm_w, *gdn_w_out, *dsa_w_in, *dsa_ik_g, *dsa_ik_b, *dsa_w_o;
    float *y_prompt, *y_sample, *gs_prompt, *gc_prompt, *gs_sample, *gc_sample, *k_prompt, *v_prompt, *ik_prompt, *k_sample,
        *v_sample, *ik_sample;
    unsigned* bar;
    bf16_t *wt_gin, *wt_gout, *wt_w1, *wt_w2, *wt_din, *wt_do;
    bf16_t *hA, *hB;
    float* preln;
    bf16_t *mixed, *z;
    float* ba;
    bf16_t *gated, *act;
    float *p1, *qr, *iq, *iw;
    int* sel;
    bf16_t *g_negw, *g_qg, *g_kdT, *g_aqk;
    float *g_u, *g_dec, *g_o;
    bf16_t *q_b, *k_b, *vt_b, *iq_b, *ik_b;
    unsigned long long* maskT;
};

__device__ const double kInvFreq[16] = {1.0, 0.44036660267178046, 0.19392274474868576, 0.08539710028576561,
    0.03760603093086393, 0.016560440080994446, 0.007292664737217109, 0.003211445994752591, 0.001414213562373095,
    0.000622772421914596, 0.0002742481756762073, 0.00012076973741146504, 5.318295896944988e-05, 2.341999896140934e-05,
    1.031338537721246e-05, 4.5416704806078695e-06};

__device__ __forceinline__ float bf2f(bf16_t h) { return __uint_as_float(((unsigned)h) << 16); }
typedef __bf16 hwbf16x2 __attribute__((ext_vector_type(2)));
typedef float f32x2 __attribute__((ext_vector_type(2)));
typedef float f32x16 __attribute__((ext_vector_type(16)));
typedef unsigned u32x4 __attribute__((ext_vector_type(4)));
__device__ __forceinline__ unsigned pk2(float lo, float hi) {
    const f32x2 v = {lo, hi};
    return __builtin_bit_cast(unsigned, __builtin_convertvector(v, hwbf16x2));
}
__device__ __forceinline__ bf16_t f2bf(float f) { return (bf16_t)(pk2(f, 0.f) & 0xffffu); }
__device__ __forceinline__ void st_bf16x4(bf16_t* p, f32x4 v) {
    uint2 o; o.x = pk2(v[0], v[1]); o.y = pk2(v[2], v[3]);
    *(uint2*)p = o;
}
__device__ __forceinline__ f32x4 cvt_bf16x4(uint2 o) {
    f32x4 v; v[0] = __uint_as_float(o.x << 16); v[1] = __uint_as_float(o.x & 0xffff0000u);
    v[2] = __uint_as_float(o.y << 16); v[3] = __uint_as_float(o.y & 0xffff0000u);
    return v;
}
__device__ __forceinline__ f32x4 ld_bf16x4(const bf16_t* p) {
    uint2 o = *(const uint2*)p;
    f32x4 v; v[0] = __uint_as_float(o.x << 16); v[1] = __uint_as_float(o.x & 0xffff0000u);
    v[2] = __uint_as_float(o.y << 16); v[3] = __uint_as_float(o.y & 0xffff0000u);
    return v;
}
__device__ __forceinline__ float wave_sum(float v) {
#pragma unroll
    for (int o = 1; o < 64; o <<= 1) v += __shfl_xor(v, o);
    return v;
}
__device__ __forceinline__ float wave_max(float v) {
#pragma unroll
    for (int o = 1; o < 64; o <<= 1) v = fmaxf(v, __shfl_xor(v, o));
    return v;
}
__device__ __forceinline__ int wave_sum_i(int v) {
#pragma unroll
    for (int o = 1; o < 64; o <<= 1) v += __shfl_xor(v, o);
    return v;
}
__device__ __forceinline__ float silu(float x) { return x / (1.f + __expf(-x)); }
__device__ __forceinline__ int tid_opaque() { int t = threadIdx.x; asm volatile("" : "+v"(t)); return t; }
__device__ __forceinline__ void lds_fence() { asm volatile("s_waitcnt lgkmcnt(0)" ::: "memory"); }

__device__ __forceinline__ void transpose_convert(const float* __restrict__ W, int K, int N, int Npad, bf16_t* __restrict__ WT, float* tile,
                                  int bid, int nb) {
    const int tid = tid_opaque();
    const int tk = K / 64, tn = Npad / 64;
    for (int it = bid; it < tk * tn; it += nb) {
        const int kb = it / tn, nbk = it % tn, k0 = kb * 64, n0 = nbk * 64;
#pragma unroll
        for (int i = 0; i < 8; ++i) {
            const int r = (tid >> 6) + 8 * i, c = tid & 63, n = n0 + c;
            tile[r * 65 + c] = (n < N) ? W[(size_t)(k0 + r) * N + n] : 0.f;
        }
        __syncthreads();
#pragma unroll
        for (int i = 0; i < 8; ++i) {
            const int rn = (tid >> 6) + 8 * i, ck = tid & 63;
            WT[(size_t)(n0 + rn) * K + k0 + ck] = f2bf(tile[ck * 65 + rn]);
        }
        __syncthreads();
    }
}

__device__ __forceinline__ void phase_prologue(const Params& p, char* smem, int bid, int nb) {
    float* tile = (float*)smem;
    transpose_convert(p.gdn_w_in, D, GIN, GIN_PAD, p.wt_gin, tile, bid, nb);
    transpose_convert(p.gdn_w_out, 2048, D, D, p.wt_gout, tile, bid, nb);
    transpose_convert(p.mlp_w1, D, DFF, DFF, p.wt_w1, tile, bid, nb);
    transpose_convert(p.mlp_w1 + (size_t)D * DFF, D, DFF, DFF, p.wt_w1 + (size_t)D * DFF, tile, bid, nb);
    transpose_convert(p.mlp_w2, DFF, D, D, p.wt_w2, tile, bid, nb);
    transpose_convert(p.mlp_w2 + (size_t)D * DFF, DFF, D, D, p.wt_w2 + (size_t)D * DFF, tile, bid, nb);
    transpose_convert(p.dsa_w_in, D, DIN, DIN_PAD, p.wt_din, tile, bid, nb);
    transpose_convert(p.dsa_w_o, D, D, D, p.wt_do, tile, bid, nb);
    for (int idx = bid * NTHR + tid_opaque(); idx < MPAD * 256; idx += nb * NTHR) {
        const int row = idx >> 8, c4 = (idx & 255) * 4;
        f32x4 v = {0.f, 0.f, 0.f, 0.f};
        if (row < NPR) {
            const int b = row / LP, t = row % LP;
            const float* src = (t < NMETA) ? (p.meta + (size_t)t * D) : (p.x_prompt + ((size_t)b * SEQ + (t - NMETA)) * D);
            v = *(const f32x4*)(src + c4);
        } else if (row < NT) {
            v = *(const f32x4*)(p.x_sample + (size_t)(row - NPR) * D + c4);
        }
        st_bf16x4(p.hA + (size_t)row * D + c4, v);
    }
}

template <class Epi>
__device__ __forceinline__ void gemm_phase(const bf16_t* __restrict__ A, int lda, const bf16_t* __restrict__ Bt, int K, int Mtiles, int Ntiles,
                           const Epi& epi, char* smem, int bid, int nb) {
    bf16_t* As = (bf16_t*)smem;
    bf16_t* Bs = As + 256 * 72;
    const int tid = tid_opaque(), lane = tid & 63, wave = tid >> 6;
    const int wm = wave >> 1, wn = wave & 1;
    const int fr = lane & 15, fq = lane >> 4;
    const int ntiles = Mtiles * Ntiles;
    const int nk = K / 64;
    for (int tile = bid; tile < ntiles; tile += nb) {
        const int tm = tile % Mtiles, tn = tile / Mtiles;
        const bf16_t* Ag = A + (size_t)tm * 256 * lda;
        const bf16_t* Bg = Bt + (size_t)tn * 128 * K;
        f32x4 acc[4][4];
#pragma unroll
        for (int i = 0; i < 4; ++i)
#pragma unroll
            for (int j = 0; j < 4; ++j) acc[i][j] = (f32x4){0.f, 0.f, 0.f, 0.f};
        const int c0 = tid, c1 = tid + 512, c2 = tid + 1024, c3 = tid + 1536;
        const bf16_t* ga0 = Ag + (size_t)(c0 >> 3) * lda + (c0 & 7) * 8;
        const bf16_t* ga1 = Ag + (size_t)(c1 >> 3) * lda + (c1 & 7) * 8;
        const bf16_t* ga2 = Ag + (size_t)(c2 >> 3) * lda + (c2 & 7) * 8;
        const bf16_t* ga3 = Ag + (size_t)(c3 >> 3) * lda + (c3 & 7) * 8;
        const bf16_t* gb0 = Bg + (size_t)(c0 >> 3) * K + (c0 & 7) * 8;
        const bf16_t* gb1 = Bg + (size_t)(c1 >> 3) * K + (c1 & 7) * 8;
        bf16_t* sa0 = As + (c0 >> 3) * 72 + (c0 & 7) * 8;
        bf16_t* sa1 = As + (c1 >> 3) * 72 + (c1 & 7) * 8;
        bf16_t* sa2 = As + (c2 >> 3) * 72 + (c2 & 7) * 8;
        bf16_t* sa3 = As + (c3 >> 3) * 72 + (c3 & 7) * 8;
        bf16_t* sb0 = Bs + (c0 >> 3) * 72 + (c0 & 7) * 8;
        bf16_t* sb1 = Bs + (c1 >> 3) * 72 + (c1 & 7) * 8;
        uint4 ra0 = *(const uint4*)ga0, ra1 = *(const uint4*)ga1, ra2 = *(const uint4*)ga2, ra3 = *(const uint4*)ga3;
        uint4 rb0 = *(const uint4*)gb0, rb1 = *(const uint4*)gb1;
        *(uint4*)sa0 = ra0; *(uint4*)sa1 = ra1; *(uint4*)sa2 = ra2; *(uint4*)sa3 = ra3; *(uint4*)sb0 = rb0; *(uint4*)sb1 = rb1;
        __syncthreads();
        for (int kt = 0; kt < nk; ++kt) {
            const bool more = (kt + 1 < nk);
            if (more) {
                const int k0 = (kt + 1) * 64;
                ra0 = *(const uint4*)(ga0 + k0); ra1 = *(const uint4*)(ga1 + k0); ra2 = *(const uint4*)(ga2 + k0); ra3 = *(const uint4*)(ga3 + k0);
                rb0 = *(const uint4*)(gb0 + k0); rb1 = *(const uint4*)(gb1 + k0);
            }
#pragma unroll
            for (int kk = 0; kk < 2; ++kk) {
                bf16x8 af[4], bfr[4];
#pragma unroll
                for (int i = 0; i < 4; ++i) af[i] = *(const bf16x8*)(As + (wm * 64 + i * 16 + fr) * 72 + kk * 32 + fq * 8);
#pragma unroll
                for (int j = 0; j < 4; ++j) bfr[j] = *(const bf16x8*)(Bs + (wn * 64 + j * 16 + fr) * 72 + kk * 32 + fq * 8);
#pragma unroll
                for (int i = 0; i < 4; ++i)
#pragma unroll
                    for (int j = 0; j < 4; ++j) acc[i][j] = __builtin_amdgcn_mfma_f32_16x16x32_bf16(bfr[j], af[i], acc[i][j], 0, 0, 0);
            }
            __syncthreads();
            if (more) {
                *(uint4*)sa0 = ra0; *(uint4*)sa1 = ra1; *(uint4*)sa2 = ra2; *(uint4*)sa3 = ra3; *(uint4*)sb0 = rb0; *(uint4*)sb1 = rb1;
                __syncthreads();
            }
        }
#pragma unroll
        for (int i = 0; i < 4; ++i)
#pragma unroll
            for (int j = 0; j < 4; ++j) {
                const int row = tm * 256 + wm * 64 + i * 16 + fr, col = tn * 128 + wn * 64 + j * 16 + fq * 4;
                epi(row, col, acc[i][j]);
            }
    }
}

struct EpiGdnIn {
    bf16_t *mixed, *z; float* ba;
    __device__ __forceinline__ void operator()(int row, int col, f32x4 v) const {
        if (col < 4096) st_bf16x4(mixed + (size_t)row * 4096 + col, v);
        else if (col < 6144) st_bf16x4(z + (size_t)row * 2048 + (col - 4096), v);
        else if (col < 6176) *(f32x4*)(ba + (size_t)row * 32 + (col - 6144)) = v;
    }
};
struct EpiResid {
    float* out; const bf16_t* h;
    __device__ __forceinline__ void operator()(int row, int col, f32x4 v) const {
        const f32x4 r = ld_bf16x4(h + (size_t)row * D + col);
        *(f32x4*)(out + (size_t)row * D + col) = v + r * ALPHA;
    }
};
struct EpiRelu2 {
    bf16_t* act;
    __device__ __forceinline__ void operator()(int row, int col, f32x4 v) const {
#pragma unroll
        for (int e = 0; e < 4; ++e) { const float r = fmaxf(v[e], 0.f); v[e] = r * r; }
        st_bf16x4(act + (size_t)row * DFF + col, v);
    }
};
struct EpiF32 {
    float* out; int ld;
    __device__ __forceinline__ void operator()(int row, int col, f32x4 v) const { *(f32x4*)(out + (size_t)row * ld + col) = v; }
};

__device__ __forceinline__ void ln_phase(const float* __restrict__ X, const float* __restrict__ g, const float* __restrict__ bta, bf16_t* Hout,
                         float* yp, float* ys, int bid, int nb) {
    const int tid_ = tid_opaque(); const int lane = tid_ & 63, wave = tid_ >> 6;
    f32x4 gv[4], bv[4];
#pragma unroll
    for (int j = 0; j < 4; ++j) { gv[j] = *(const f32x4*)(g + j * 256 + lane * 4); bv[j] = *(const f32x4*)(bta + j * 256 + lane * 4); }
    for (int row = bid * 8 + wave; row < NT; row += nb * 8) {
        f32x4 v[4]; float s = 0.f;
#pragma unroll
        for (int j = 0; j < 4; ++j) { v[j] = *(const f32x4*)(X + (size_t)row * D + j * 256 + lane * 4); s += (v[j][0] + v[j][1]) + (v[j][2] + v[j][3]); }
        const float mean = wave_sum(s) * (1.f / D);
        float s2 = 0.f;
#pragma unroll
        for (int j = 0; j < 4; ++j) { v[j] = v[j] - mean; s2 += (v[j][0] * v[j][0] + v[j][1] * v[j][1]) + (v[j][2] * v[j][2] + v[j][3] * v[j][3]); }
        const float rstd = rsqrtf(wave_sum(s2) * (1.f / D) + 1e-5f);
        float* yo = nullptr;
        if (yp) {
            if (row < NPR) { const int b = row / LP, t = row % LP; if (t >= NMETA) yo = yp + ((size_t)b * SEQ + (t - NMETA)) * D; }
            else yo = ys + (size_t)(row - NPR) * D;
        }
#pragma unroll
        for (int j = 0; j < 4; ++j) {
            const f32x4 o = v[j] * rstd * gv[j] + bv[j];
            if (Hout) st_bf16x4(Hout + (size_t)row * D + j * 256 + lane * 4, o);
            if (yo) *(f32x4*)(yo + j * 256 + lane * 4) = o;
        }
    }
}

__device__ __forceinline__ void gdn_sample_unit(const Params& p, char* smem, int b, int h) {
    float* sq = (float*)smem;
    float* sk = sq + 128;
    float* sv = sk + 128;
    float* red = sv + 128;
    float* red2 = red + 512;
    float* part = red2 + 512;
    const int tid = tid_opaque(), lane = tid & 63, wave = tid >> 6;
    const int vcol = tid & 127, kq = tid >> 7;
    const size_t row0 = (size_t)NPR + (size_t)b * DS;
    const int kh = h >> 1;
    float S[32];
    {
        const float* Sp = p.state_gdn + ((size_t)(b * 16 + h) * 128) * 128;
#pragma unroll
        for (int i = 0; i < 32; ++i) S[i] = Sp[(size_t)(kq * 32 + i) * 128 + vcol];
    }
    const float Aexp = __expf(p.gdn_a_log[h]);
    const float dtb = p.gdn_dt_bias[h];
    const float nw = p.gdn_norm_w[vcol];
    const int which = tid >> 7;
    const int ch = (which == 0) ? (kh * 128 + vcol) : (which == 1) ? (1024 + kh * 128 + vcol) : (2048 + h * 128 + vcol);
    float cw[4];
#pragma unroll
    for (int j = 0; j < 4; ++j) cw[j] = p.gdn_conv_w[j * 4096 + ch];
    for (int t = 0; t < DS; ++t) {
        if (tid < 384) {
            float a = 0.f;
#pragma unroll
            for (int j = 0; j < 4; ++j) {
                const int tt = t - 3 + j;
                float xv;
                if (tt >= 0) xv = bf2f(p.mixed[(row0 + tt) * 4096 + ch]);
                else xv = p.state_conv[((size_t)b * 3 + (tt + 3)) * 4096 + ch];
                a += xv * cw[j];
            }
            const float y = silu(a);
            if (which == 0) sq[vcol] = y; else if (which == 1) sk[vcol] = y; else sv[vcol] = y;
            const float ss = wave_sum(y * y);
            if (lane == 0) part[wave] = ss;
        }
        __syncthreads();
        const float qn = rsqrtf(part[0] + part[1] + 1e-6f) * 0.08838834764831845f;
        const float kn = rsqrtf(part[2] + part[3] + 1e-6f);
        const float* bap = p.ba + (row0 + t) * 32;
        const float beta = 1.f / (1.f + __expf(-bap[h]));
        const float aa = bap[16 + h] + dtb;
        const float sp = (aa > 20.f) ? aa : log1pf(__expf(aa));
        const float dec = __expf(-Aexp * sp);
        float ks_part = 0.f;
#pragma unroll
        for (int i = 0; i < 32; ++i) { S[i] *= dec; ks_part += sk[kq * 32 + i] * S[i]; }
        red[kq * 128 + vcol] = ks_part * kn;
        __syncthreads();
        const float kS = (red[vcol] + red[128 + vcol]) + (red[256 + vcol] + red[384 + vcol]);
        const float delta = (sv[vcol] - kS) * beta * kn;
        float o_part = 0.f;
#pragma unroll
        for (int i = 0; i < 32; ++i) { S[i] += sk[kq * 32 + i] * delta; o_part += sq[kq * 32 + i] * S[i]; }
        red2[kq * 128 + vcol] = o_part * qn;
        __syncthreads();
        float o = 0.f;
        if (tid < 128) {
            o = (red2[vcol] + red2[128 + vcol]) + (red2[256 + vcol] + red2[384 + vcol]);
            const float ss = wave_sum(o * o);
            if (lane == 0) part[8 + wave] = ss;
        }
        __syncthreads();
        if (tid < 128) {
            const float rms = rsqrtf((part[8] + part[9]) * (1.f / 128.f) + 1e-6f);
            const float zz = bf2f(p.z[(row0 + t) * 2048 + h * 128 + vcol]);
            p.gated[(row0 + t) * 2048 + h * 128 + vcol] = f2bf(o * rms * nw * silu(zz));
        }
    }
    float* So = p.gs_sample + ((size_t)(b * 16 + h) * 128) * 128;
#pragma unroll
    for (int i = 0; i < 32; ++i) So[(size_t)(kq * 32 + i) * 128 + vcol] = S[i];
    __syncthreads();
}

#define MFMA32(a, b, c) __builtin_amdgcn_mfma_f32_32x32x16_bf16((a), (b), (c), 0, 0, 0)
constexpr int NCH = 65;
constexpr int NCU = BATCH * 16 * NCH;
__device__ __forceinline__ int crow(int reg, int hh) { return (reg & 3) + 8 * (reg >> 2) + 4 * hh; }
__device__ __forceinline__ bf16x8 pack_step(const f32x16& x, int s) {
    u32x4 q;
    q[0] = pk2(x[8 * s + 0], x[8 * s + 1]); q[1] = pk2(x[8 * s + 2], x[8 * s + 3]);
    q[2] = pk2(x[8 * s + 4], x[8 * s + 5]); q[3] = pk2(x[8 * s + 6], x[8 * s + 7]);
    return __builtin_bit_cast(bf16x8, q);
}
__device__ __forceinline__ bf16x8 frag_perm(const bf16_t* p0) {
    const uint2 lo = *(const uint2*)p0, hi = *(const uint2*)(p0 + 8);
    u32x4 q; q[0] = lo.x; q[1] = lo.y; q[2] = hi.x; q[3] = hi.y;
    return __builtin_bit_cast(bf16x8, q);
}

__device__ __forceinline__ void gdn_stageA(const Params& p, char* smem0, int bid, int nb) {
    const int tid = tid_opaque(), lane = tid & 63, wave = tid >> 6;
    for (int idx = bid * NTHR + tid; idx < (BATCH + DB) * 3 * 4096; idx += nb * NTHR) {
        const int c = idx & 4095, r = (idx >> 12) % 3, b = idx / (3 * 4096);
        if (b < BATCH) p.gc_prompt[idx] = bf2f(p.mixed[((size_t)b * LP + (LP - 3) + r) * 4096 + c]);
        else { const int bs = b - BATCH; p.gc_sample[(size_t)(bs * 3 + r) * 4096 + c] = bf2f(p.mixed[((size_t)NPR + bs * 4 + 1 + r) * 4096 + c]); }
    }
    for (int u = bid; u < NCU; u += nb) {
        unsigned zofs = 0; asm volatile("" : "+v"(zofs));
        char* smem = smem0 + zofs;
        bf16_t* Qb = (bf16_t*)smem;
        bf16_t* Kb = Qb + 64 * 136;
        float* RHS = (float*)(Kb + 64 * 136);
        float* Am = RHS + 64 * 256;
        float* sbeta = Am + 64 * 68;
        float* sgc = sbeta + 64;
        float* segc = sgc + 64;
        float* sekd = segc + 64;
        float* srk = sekd + 64;
        const int h = u & 15, n = (u >> 4) % NCH, b = u / (16 * NCH);
        const int kh = h >> 1;
        const size_t su = (size_t)((b * 16 + h) * NCH + n);
        const int t0 = n * 64;
        if (wave < 6) {
            const int part = wave >> 1, half = wave & 1;
            const int cq = lane & 31, tsub = lane >> 5;
            const int tl0 = 32 * half + 16 * tsub;
            const int chb = ((part == 0) ? (kh * 128) : (part == 1) ? (1024 + kh * 128) : (2048 + h * 128)) + cq * 4;
            f32x4 cw[4];
#pragma unroll
            for (int j = 0; j < 4; ++j) cw[j] = *(const f32x4*)(p.gdn_conv_w + j * 4096 + chb);
            uint2 xr[19];
#pragma unroll
            for (int i = 0; i < 19; ++i) {
                const int t = t0 + tl0 - 3 + i;
                if (t >= 0 && t < LP) xr[i] = *(const uint2*)(p.mixed + ((size_t)b * LP + t) * 4096 + chb);
                else xr[i] = make_uint2(0u, 0u);
            }
#pragma unroll
            for (int i = 0; i < 16; ++i) {
                const f32x4 a = cvt_bf16x4(xr[i]) * cw[0] + cvt_bf16x4(xr[i + 1]) * cw[1] + cvt_bf16x4(xr[i + 2]) * cw[2] + cvt_bf16x4(xr[i + 3]) * cw[3];
                const bool valid = (t0 + tl0 + i) < LP;
                f32x4 y;
#pragma unroll
                for (int e2 = 0; e2 < 4; ++e2) y[e2] = valid ? silu(a[e2]) : 0.f;
                const int c = tl0 + i;
                if (part < 2) {
                    float ss = (y[0] * y[0] + y[1] * y[1]) + (y[2] * y[2] + y[3] * y[3]);
#pragma unroll
                    for (int o = 1; o < 32; o <<= 1) ss += __shfl_xor(ss, o);
                    const float nrm = rsqrtf(ss + 1e-6f) * ((part == 0) ? 0.08838834764831845f : 1.f);
                    y = y * nrm;
                    if (part == 0) st_bf16x4(Qb + c * 136 + cq * 4, y);
                    else { st_bf16x4(Kb + c * 136 + cq * 4, y); *(f32x4*)(RHS + c * 256 + 128 + cq * 4) = y; }
                } else {
                    *(f32x4*)(RHS + c * 256 + cq * 4) = y;
                }
            }
        } else if (wave == 6) {
            const int c = lane, t = t0 + c;
            float beta = 0.f, g = 0.f;
            if (t < LP) {
                const float* bap = p.ba + ((size_t)b * LP + t) * 32;
                beta = 1.f / (1.f + __expf(-bap[h]));
                const float aa = bap[16 + h] + p.gdn_dt_bias[h];
                const float sp = (aa > 20.f) ? aa : log1pf(__expf(aa));
                g = -__expf(p.gdn_a_log[h]) * sp;
            }
            float gc = g;
#pragma unroll
            for (int o = 1; o < 64; o <<= 1) { const float v = __shfl_up(gc, o); if (lane >= o) gc += v; }
            const float glast = __shfl(gc, 63);
            sbeta[c] = beta; sgc[c] = gc; segc[c] = __expf(gc); sekd[c] = __expf(glast - gc); srk[c] = beta * __expf(gc);
            if (lane == 0) p.g_dec[su] = __expf(glast);
        }
        __syncthreads();
        {
            const int which = wave >> 2, ti = (wave >> 1) & 1, tj = wave & 1;
            const int r = lane & 31, hh = lane >> 5;
            f32x16 acc;
#pragma unroll
            for (int i = 0; i < 16; ++i) acc[i] = 0.f;
            const bf16_t* Ap = Kb + (32 * ti + r) * 136 + 8 * hh;
            const bf16_t* Bp = (which ? Qb : Kb) + (32 * tj + r) * 136 + 8 * hh;
#pragma unroll
            for (int ks = 0; ks < 8; ++ks) acc = MFMA32(*(const bf16x8*)(Ap + 16 * ks), *(const bf16x8*)(Bp + 16 * ks), acc);
            const int c = 32 * tj + r;
            const float gcc = sgc[c], bc = sbeta[c];
            if (which == 0) {
#pragma unroll
                for (int reg = 0; reg < 16; ++reg) {
                    const int cp = 32 * ti + crow(reg, hh);
                    const float dcy = __expf(fminf(gcc - sgc[cp], 0.f));
                    Am[c * 68 + cp] = (cp < c) ? (bc * acc[reg] * dcy) : 0.f;
                }
            } else {
                bf16_t* aq = p.g_aqk + su * 4096 + (size_t)c * 64;
#pragma unroll
                for (int g4 = 0; g4 < 4; ++g4) {
                    const int cp0 = 32 * ti + 8 * g4 + 4 * hh;
                    f32x4 v;
#pragma unroll
                    for (int e2 = 0; e2 < 4; ++e2) {
                        const int cp = cp0 + e2;
                        const float dcy = __expf(fminf(gcc - sgc[cp], 0.f));
                        v[e2] = (cp <= c) ? (acc[4 * g4 + e2] * dcy) : 0.f;
                    }
                    st_bf16x4(aq + cp0, v);
                }
            }
        }
        __syncthreads();
        if (wave < 4) {
            const int col = 64 * wave + lane;
            const float* rs = sbeta + __builtin_amdgcn_readfirstlane((wave < 2) ? 0 : 256);
            float x[64];
#pragma unroll
            for (int i = 0; i < 64; ++i) x[i] = RHS[i * 256 + col] * rs[i];
#pragma unroll
            for (int i = 1; i < 64; ++i) {
                float a0 = x[i], a1 = 0.f;
#pragma unroll
                for (int j4 = 0; j4 < i; j4 += 4) {
                    const f32x4 a = *(const f32x4*)(Am + i * 68 + j4);
                    a0 -= a[0] * x[j4]; a1 -= a[1] * x[j4 + 1]; a0 -= a[2] * x[j4 + 2]; a1 -= a[3] * x[j4 + 3];
                }
                x[i] = a0 + a1;
                asm volatile("" ::: "memory");
            }
            if (wave < 2) {
                float* up = p.g_u + su * 8192 + col;
#pragma unroll
                for (int i = 0; i < 64; ++i) up[i * 128] = x[i];
            } else {
                bf16_t* wp = p.g_negw + su * 8192 + (col - 128);
#pragma unroll
                for (int i = 0; i < 64; ++i) wp[i * 128] = f2bf(-x[i]);
            }
        } else {
            const int t2 = tid - 256;
#pragma unroll
            for (int it = 0; it < 4; ++it) {
                const int chk = t2 + 256 * it, c = chk >> 4, d0 = (chk & 15) * 8;
                const float e = segc[c];
                const uint4 raw = *(const uint4*)(Qb + c * 136 + d0);
                uint4 o;
                o.x = pk2(__uint_as_float(raw.x << 16) * e, __uint_as_float(raw.x & 0xffff0000u) * e);
                o.y = pk2(__uint_as_float(raw.y << 16) * e, __uint_as_float(raw.y & 0xffff0000u) * e);
                o.z = pk2(__uint_as_float(raw.z << 16) * e, __uint_as_float(raw.z & 0xffff0000u) * e);
                o.w = pk2(__uint_as_float(raw.w << 16) * e, __uint_as_float(raw.w & 0xffff0000u) * e);
                *(uint4*)(p.g_qg + su * 8192 + c * 128 + d0) = o;
            }
#pragma unroll
            for (int it = 0; it < 4; ++it) {
                const int item = t2 + 256 * it, d = item & 127, c0 = (item >> 7) * 8;
                float v[8];
#pragma unroll
                for (int i = 0; i < 8; ++i) v[i] = bf2f(Kb[(c0 + i) * 136 + d]) * sekd[c0 + i];
                uint4 o; o.x = pk2(v[0], v[1]); o.y = pk2(v[2], v[3]); o.z = pk2(v[4], v[5]); o.w = pk2(v[6], v[7]);
                *(uint4*)(p.g_kdT + su * 8192 + d * 64 + c0) = o;
            }
        }
        __syncthreads();
    }
}

constexpr int GB_NW = 0, GB_QG = 64 * 136, GB_KD = 2 * 64 * 136, GB_AQ = 2 * 64 * 136 + 128 * 72, GB_ELEMS = 2 * 64 * 136 + 128 * 72 + 64 * 72;
__device__ __forceinline__ void gdn_chain(const Params& p, char* smem, int b, int h) {
    bf16_t* lds = (bf16_t*)smem;
    const int tid = tid_opaque(), lane = tid & 63, wave = tid >> 6;
    const int r = lane & 31, hh = lane >> 5;
    const size_t su0 = (size_t)(b * 16 + h) * NCH;
    const bool loader = wave >= 4;
    const int t2 = tid - 256;
    uint4 st0, st1, st2, st3, st4, st5, st6, st7, st8, st9, st10, st11, st12, st13;
    f32x16 S[4], un0, un1;
#pragma unroll
    for (int i = 0; i < 4; ++i)
#pragma unroll
        for (int j = 0; j < 16; ++j) S[i][j] = 0.f;
    const int ch0 = t2, ch1 = t2 + 256, ch2 = t2 + 512, ch3 = t2 + 768;
#define GB_GLOAD(n_) do { const size_t su_ = su0 + (n_); \
        const bf16_t* a_ = p.g_negw + su_ * 8192; const bf16_t* b_ = p.g_qg + su_ * 8192; const bf16_t* c_ = p.g_kdT + su_ * 8192; const bf16_t* d_ = p.g_aqk + su_ * 4096; \
        st0 = *(const uint4*)(a_ + (size_t)ch0 * 8); st1 = *(const uint4*)(a_ + (size_t)ch1 * 8); st2 = *(const uint4*)(a_ + (size_t)ch2 * 8); st3 = *(const uint4*)(a_ + (size_t)ch3 * 8); \
        st4 = *(const uint4*)(b_ + (size_t)ch0 * 8); st5 = *(const uint4*)(b_ + (size_t)ch1 * 8); st6 = *(const uint4*)(b_ + (size_t)ch2 * 8); st7 = *(const uint4*)(b_ + (size_t)ch3 * 8); \
        st8 = *(const uint4*)(c_ + (size_t)ch0 * 8); st9 = *(const uint4*)(c_ + (size_t)ch1 * 8); st10 = *(const uint4*)(c_ + (size_t)ch2 * 8); st11 = *(const uint4*)(c_ + (size_t)ch3 * 8); \
        st12 = *(const uint4*)(d_ + (size_t)ch0 * 8); st13 = *(const uint4*)(d_ + (size_t)ch1 * 8); } while (0)
#define GB_SSTORE(buf_) do { bf16_t* q_ = (buf_); \
        *(uint4*)(q_ + GB_NW + (ch0 >> 4) * 136 + (ch0 & 15) * 8) = st0; *(uint4*)(q_ + GB_NW + (ch1 >> 4) * 136 + (ch1 & 15) * 8) = st1; \
        *(uint4*)(q_ + GB_NW + (ch2 >> 4) * 136 + (ch2 & 15) * 8) = st2; *(uint4*)(q_ + GB_NW + (ch3 >> 4) * 136 + (ch3 & 15) * 8) = st3; \
        *(uint4*)(q_ + GB_QG + (ch0 >> 4) * 136 + (ch0 & 15) * 8) = st4; *(uint4*)(q_ + GB_QG + (ch1 >> 4) * 136 + (ch1 & 15) * 8) = st5; \
        *(uint4*)(q_ + GB_QG + (ch2 >> 4) * 136 + (ch2 & 15) * 8) = st6; *(uint4*)(q_ + GB_QG + (ch3 >> 4) * 136 + (ch3 & 15) * 8) = st7; \
        *(uint4*)(q_ + GB_KD + (ch0 >> 3) * 72 + (ch0 & 7) * 8) = st8; *(uint4*)(q_ + GB_KD + (ch1 >> 3) * 72 + (ch1 & 7) * 8) = st9; \
        *(uint4*)(q_ + GB_KD + (ch2 >> 3) * 72 + (ch2 & 7) * 8) = st10; *(uint4*)(q_ + GB_KD + (ch3 >> 3) * 72 + (ch3 & 7) * 8) = st11; \
        *(uint4*)(q_ + GB_AQ + (ch0 >> 3) * 72 + (ch0 & 7) * 8) = st12; *(uint4*)(q_ + GB_AQ + (ch1 >> 3) * 72 + (ch1 & 7) * 8) = st13; } while (0)
#define GB_ULOAD(n_) do { const float* up_ = p.g_u + (su0 + (n_)) * 8192 + 32 * wave + r; \
        _Pragma("unroll") for (int reg_ = 0; reg_ < 16; ++reg_) { un0[reg_] = up_[(crow(reg_, hh)) * 128]; un1[reg_] = up_[(32 + crow(reg_, hh)) * 128]; } } while (0)
    if (loader) {
        GB_GLOAD(0); GB_SSTORE(lds);
        __syncthreads();
        for (int n = 0; n < NCH; ++n) {
            unsigned zofs = 0; asm volatile("" : "+v"(zofs));
            bf16_t* nxt = lds + ((n + 1) & 1) * GB_ELEMS + zofs;
            if (n + 1 < NCH) { GB_GLOAD(n + 1); GB_SSTORE(nxt); }
            __syncthreads();
        }
    } else {
        GB_ULOAD(0);
        __syncthreads();
        for (int n = 0; n < NCH; ++n) {
            unsigned zofs = 0; asm volatile("" : "+v"(zofs));
            bf16_t* cur = lds + (n & 1) * GB_ELEMS + zofs;
            const bool more = (n + 1 < NCH);
            const float dec = p.g_dec[su0 + n];
            f32x16 vn[2], o[2];
            vn[0] = un0; vn[1] = un1;
#pragma unroll
            for (int j = 0; j < 16; ++j) { o[0][j] = 0.f; o[1][j] = 0.f; }
            if (more) { GB_ULOAD(n + 1); }
#pragma unroll
            for (int kt = 0; kt < 4; ++kt)
#pragma unroll
                for (int s = 0; s < 2; ++s) {
                    const bf16x8 sb = pack_step(S[kt], s);
                    const int k0 = 32 * kt + 16 * s + 4 * hh;
#pragma unroll
                    for (int ct = 0; ct < 2; ++ct) {
                        vn[ct] = MFMA32(frag_perm(cur + GB_NW + (32 * ct + r) * 136 + k0), sb, vn[ct]);
                        o[ct] = MFMA32(frag_perm(cur + GB_QG + (32 * ct + r) * 136 + k0), sb, o[ct]);
                    }
                }
            bf16x8 vb[2][2];
#pragma unroll
            for (int ct = 0; ct < 2; ++ct)
#pragma unroll
                for (int s = 0; s < 2; ++s) vb[ct][s] = pack_step(vn[ct], s);
#pragma unroll
            for (int s = 0; s < 2; ++s) {
                o[0] = MFMA32(frag_perm(cur + GB_AQ + (r) * 72 + 16 * s + 4 * hh), vb[0][s], o[0]);
                o[1] = MFMA32(frag_perm(cur + GB_AQ + (32 + r) * 72 + 16 * s + 4 * hh), vb[0][s], o[1]);
                o[1] = MFMA32(frag_perm(cur + GB_AQ + (32 + r) * 72 + 32 + 16 * s + 4 * hh), vb[1][s], o[1]);
            }
#pragma unroll
            for (int dt = 0; dt < 4; ++dt) {
                S[dt] = S[dt] * dec;
#pragma unroll
                for (int ckt = 0; ckt < 2; ++ckt)
#pragma unroll
                    for (int s = 0; s < 2; ++s)
                        S[dt] = MFMA32(frag_perm(cur + GB_KD + (32 * dt + r) * 72 + 32 * ckt + 16 * s + 4 * hh), vb[ckt][s], S[dt]);
            }
#pragma unroll
            for (int ct = 0; ct < 2; ++ct)
#pragma unroll
                for (int reg = 0; reg < 16; ++reg) {
                    const int t = 64 * n + 32 * ct + crow(reg, hh);
                    if (t < LP) p.g_o[(((size_t)b * LP + t) * 16 + h) * 128 + 32 * wave + r] = o[ct][reg];
                }
            __syncthreads();
        }
    }
    if (!loader) {
#pragma unroll
        for (int dt = 0; dt < 4; ++dt)
#pragma unroll
            for (int reg = 0; reg < 16; ++reg)
                p.gs_prompt[((size_t)(b * 16 + h) * 128 + 32 * dt + crow(reg, hh)) * 128 + 32 * wave + r] = S[dt][reg];
    }
    __syncthreads();
}

__device__ __forceinline__ void gdn_seq_phase(const Params& p, char* smem, int bid, int nb) {
    if (bid < 64) gdn_chain(p, smem, bid >> 4, bid & 15);
    int* slot = (int*)(smem + LDS_BYTES - 32);
    for (;;) {
        if (threadIdx.x == 0) *slot = (int)atomicAdd(p.bar + 3520, 1u);
        __syncthreads();
        const int u = *slot;
        __syncthreads();
        if (u >= DB * 16) break;
        gdn_sample_unit(p, smem, u >> 4, u & 15);
    }
}

__device__ __forceinline__ void gdn_gate_phase(const Params& p, int bid, int nb) {
    const int tid_ = tid_opaque(); const int lane = tid_ & 63, wave = tid_ >> 6;
    const f32x2 nw = *(const f32x2*)(p.gdn_norm_w + lane * 2);
    for (int it = bid * 8 + wave; it < NPR * 16; it += nb * 8) {
        const f32x2 o = *(const f32x2*)(p.g_o + (size_t)it * 128 + lane * 2);
        const float ss = wave_sum(o[0] * o[0] + o[1] * o[1]);
        const float rms = rsqrtf(ss * (1.f / 128.f) + 1e-6f);
        const unsigned zr = *(const unsigned*)(p.z + (size_t)it * 128 + lane * 2);
        const float z0 = __uint_as_float(zr << 16), z1 = __uint_as_float(zr & 0xffff0000u);
        *(unsigned*)(p.gated + (size_t)it * 128 + lane * 2) = pk2(o[0] * rms * nw[0] * silu(z0), o[1] * rms * nw[1] * silu(z1));
    }
}

__device__ __forceinline__ void rope_cs(int pos, int fi, float& c, float& s) {
    const double rev = (double)pos * kInvFreq[fi] * 0.15915494309189535;
    const float r = (float)(rev - floor(rev));
    c = __builtin_amdgcn_cosf(r);
    s = __builtin_amdgcn_sinf(r);
}
__device__ __forceinline__ void dsa_post_phase(const Params& p, int bid, int nb) {
    const int tid_ = tid_opaque(); const int lane = tid_ & 63, wave = tid_ >> 6;
    for (int row = bid * 8 + wave; row < NT; row += nb * 8) {
        const float* P = p.p1 + (size_t)row * DIN_PAD;
        const bool prompt = row < NPR;
        const int pos = prompt ? (row % LP) : (PAST + ((row - NPR) & 3));
        float* kout = prompt ? (p.k_prompt + (size_t)row * 256) : (p.k_sample + (size_t)(row - NPR) * 256);
        float* vout = prompt ? (p.v_prompt + (size_t)row * 256) : (p.v_sample + (size_t)(row - NPR) * 256);
        for (int e = lane; e < 1280; e += 64) {
            const int d = e & 127;
            float o = P[e];
            if (d < 32) {
                float c, s; rope_cs(pos, d & 15, c, s);
                if (d < 16) o = o * c - P[e + 16] * s; else o = o * c + P[e - 16] * s;
            }
            if (e < 1024) {
                p.qr[(size_t)row * 1024 + e] = o;
                if (prompt) p.q_b[(size_t)row * 1024 + e] = f2bf(o * 0.12751743f);
            } else {
                kout[e - 1024] = o;
                if (prompt) { const int bb = row / LP, kvh = (e - 1024) >> 7; p.k_b[((size_t)(bb * 2 + kvh) * LPAD + pos) * 128 + d] = f2bf(o); }
            }
        }
        for (int e = lane; e < 256; e += 64) {
            const float o = P[1280 + e];
            vout[e] = o;
            if (prompt) { const int bb = row / LP, kvh = e >> 7, d = e & 127; p.vt_b[((size_t)(bb * 2 + kvh) * 128 + d) * LPAD + pos] = f2bf(o); }
        }
        for (int e = lane; e < 512; e += 64) {
            const int d = e & 63;
            float o = P[1536 + e];
            if (d < 16) {
                float c, s; rope_cs(pos, (d & 7) * 2, c, s);
                if (d < 8) o = o * c - P[1536 + e + 8] * s; else o = o * c + P[1536 + e - 8] * s;
            }
            p.iq[(size_t)row * 512 + e] = o;
            if (prompt) p.iq_b[(size_t)row * 512 + e] = f2bf(o);
        }
        {
            const float x = P[2048 + lane];
            const float mu = wave_sum(x) * (1.f / 64.f);
            const float dv = x - mu;
            const float var = wave_sum(dv * dv) * (1.f / 64.f);
            const float xn = dv * rsqrtf(var + 1e-5f) * p.dsa_ik_g[lane] + p.dsa_ik_b[lane];
            const float other = __shfl_xor(xn, 8);
            float o = xn;
            if (lane < 16) {
                float c, s; rope_cs(pos, (lane & 7) * 2, c, s);
                if (lane < 8) o = xn * c - other * s; else o = xn * c + other * s;
            }
            float* io = prompt ? (p.ik_prompt + (size_t)row * 64) : (p.ik_sample + (size_t)(row - NPR) * 64);
            io[lane] = o;
            if (prompt) p.ik_b[((size_t)(row / LP) * LPAD + pos) * 64 + lane] = f2bf(o);
        }
        if (lane < 8) p.iw[(size_t)row * 8 + lane] = P[2112 + lane] * 0.35355339059327373f;
    }
    for (int idx = bid * NTHR + tid_opaque(); idx < BATCH * (LPAD - LP) * 256; idx += nb * NTHR) {
        const int c = idx & 255, tp = (idx >> 8) % (LPAD - LP), bb = idx / ((LPAD - LP) * 256);
        const int t = LP + tp, kvh = c >> 7, d = c & 127;
        p.k_b[((size_t)(bb * 2 + kvh) * LPAD + t) * 128 + d] = 0;
        p.vt_b[((size_t)(bb * 2 + kvh) * 128 + d) * LPAD + t] = 0;
        if (c < 64) p.ik_b[((size_t)bb * LPAD + t) * 64 + c] = 0;
        if (c < 65) p.maskT[((size_t)bb * 65 + c) * LPAD + t] = (c == 0) ? 1ull : 0ull;
    }
}

__device__ __forceinline__ const float* ik_row(const Params& p, bool prompt, int b, int s) {
    if (prompt) return p.ik_prompt + ((size_t)b * LP + s) * 64;
    if (s < PAST) { const int pg = p.page_table[b * 16 + (s >> 7)]; return p.cache_ik + ((size_t)pg * 128 + (s & 127)) * 64; }
    return p.ik_sample + ((size_t)b * DS + (s - PAST)) * 64;
}
__device__ __forceinline__ const float* kv_row(const float* own_p, const float* own_s, const float* cache, const int* page_table,
                                               bool prompt, int b, int s) {
    if (prompt) return own_p + ((size_t)b * LP + s) * 256;
    if (s < PAST) { const int pg = page_table[b * 16 + (s >> 7)]; return cache + ((size_t)pg * 128 + (s & 127)) * 256; }
    return own_s + ((size_t)b * DS + (s - PAST)) * 256;
}

template <bool PROMPT>
__device__ __forceinline__ void select_emit(const float* sc, int qpos, int lane, unsigned long long* maskcol, int* selrow) {
    const unsigned long long ltmask = (1ull << lane) - 1ull;
    unsigned key[65];
#pragma unroll
    for (int j = 0; j < 65; ++j) {
        const int s = j * 64 + lane;
        const float x = (s >= 16 && s <= qpos) ? sc[s] : -INFINITY;
        const unsigned u = __float_as_uint(x);
        key[j] = (u & 0x80000000u) ? ~u : (u | 0x80000000u);
    }
    unsigned T = 0u;
    bool exact = false;
    for (int bit = 31; bit >= 0; --bit) {
        const unsigned cand = T | (1u << bit);
        int c = 0;
#pragma unroll
        for (int j = 0; j < 65; ++j) c += __popcll(__ballot(key[j] >= cand));
        if (c >= 240) { T = cand; if (c == 240) { exact = true; break; } }
    }
    int need_eq = 0;
    if (!exact) {
        int cgt = 0;
#pragma unroll
        for (int j = 0; j < 65; ++j) cgt += __popcll(__ballot(key[j] > T));
        need_eq = 240 - cgt;
    }
    if (!PROMPT) { if (lane < 16) selrow[lane] = lane; }
    int base = 16, erun = 0;
    unsigned long long myword = 0ull, word64 = 0ull;
#pragma unroll
    for (int j = 0; j < 65; ++j) {
        const bool gt = exact ? (key[j] >= T) : (key[j] > T);
        const bool eq = exact ? false : (key[j] == T);
        const unsigned long long meq = __ballot(eq);
        const int rank = erun + __popcll(meq & ltmask);
        const bool take = gt || (eq && rank < need_eq);
        unsigned long long m = __ballot(take);
        if (PROMPT) {
            if (j == 0) m |= 0xFFFFull;
            if (j < 64) { if (lane == j) myword = m; } else word64 = m;
        } else {
            if (take) selrow[base + __popcll(m & ltmask)] = j * 64 + lane;
            base += __popcll(m);
        }
        erun += __popcll(meq);
    }
    if (PROMPT) {
        maskcol[(size_t)lane * LPAD] = myword;
        if (lane == 0) maskcol[(size_t)64 * LPAD] = word64;
    }
}

__device__ __forceinline__ void indexer_sample_row(const Params& p, float* sc, float* qs, int row, int lane) {
    const int b = (row - NPR) >> 2, qpos = PAST + ((row - NPR) & 3);
    int* selrow = p.sel + (size_t)row * 256;
    const int n = qpos - 15;
    for (int j = lane; j < 512; j += 64) qs[j] = p.iq[(size_t)row * 512 + j];
    float w[8];
#pragma unroll
    for (int h = 0; h < 8; ++h) w[h] = p.iw[(size_t)row * 8 + h];
    lds_fence();
    for (int j0 = 0; j0 < n; j0 += 64) {
        const int s = 16 + j0 + lane;
        const bool valid = s <= qpos;
        const float* kp = ik_row(p, false, b, valid ? s : qpos);
        float dh[8];
#pragma unroll
        for (int h = 0; h < 8; ++h) dh[h] = 0.f;
#pragma unroll
        for (int half = 0; half < 2; ++half) {
            f32x4 kv[8];
#pragma unroll
            for (int c = 0; c < 8; ++c) kv[c] = *(const f32x4*)(kp + half * 32 + c * 4);
#pragma unroll
            for (int h = 0; h < 8; ++h) {
                float d = dh[h];
#pragma unroll
                for (int c = 0; c < 8; ++c) {
                    const f32x4 q4 = *(const f32x4*)(qs + h * 64 + half * 32 + c * 4);
                    d += kv[c][0] * q4[0]; d += kv[c][1] * q4[1]; d += kv[c][2] * q4[2]; d += kv[c][3] * q4[3];
                }
                dh[h] = d;
            }
        }
        float score = 0.f;
#pragma unroll
        for (int h = 0; h < 8; ++h) score += w[h] * fmaxf(dh[h], 0.f);
        if (valid) sc[s] = score;
    }
    lds_fence();
    select_emit<false>(sc, qpos, lane, nullptr, selrow);
    lds_fence();
}

__device__ __forceinline__ void indexer_prompt_unit(const Params& p, float* sc, int b, int g8, int tid) {
    const int lane = tid & 63, wave = tid >> 6;
    const int r = lane & 31, hh = lane >> 5;
    const int t0 = g8 * 8;
    if (t0 < 256) {
        const int qpos = t0 + wave;
        unsigned long long* maskcol = p.maskT + (size_t)b * 65 * LPAD + qpos;
        for (int j = lane; j < 65; j += 64) {
            const int lo = j * 64;
            unsigned long long m = 0ull;
            if (qpos >= lo + 63) m = ~0ull; else if (qpos >= lo) m = (1ull << (qpos - lo + 1)) - 1ull;
            maskcol[(size_t)j * LPAD] = m;
        }
        return;
    }
    bf16x8 af[2][4];
    {
        const int e2 = r & 3, hb = (r >> 2) & 1, a = r >> 3;
        const int qi = 2 * hb + (a >> 1), head = 4 * (a & 1) + e2;
#pragma unroll
        for (int rt = 0; rt < 2; ++rt) {
            const bf16_t* ap = p.iq_b + ((size_t)b * LP + t0 + 4 * rt + qi) * 512 + head * 64 + 8 * hh;
#pragma unroll
            for (int ks = 0; ks < 4; ++ks) af[rt][ks] = *(const bf16x8*)(ap + 16 * ks);
        }
    }
    float wq[2][2][8];
#pragma unroll
    for (int rt = 0; rt < 2; ++rt)
#pragma unroll
        for (int ql = 0; ql < 2; ++ql) {
            const float* wp = p.iw + ((size_t)b * LP + t0 + 4 * rt + 2 * hh + ql) * 8;
            const f32x4 w0 = *(const f32x4*)wp, w1 = *(const f32x4*)(wp + 4);
#pragma unroll
            for (int e2 = 0; e2 < 4; ++e2) { wq[rt][ql][e2] = w0[e2]; wq[rt][ql][4 + e2] = w1[e2]; }
        }
    const int nkt = (t0 + 7) / 32 + 1;
    const bf16_t* kbase = p.ik_b + ((size_t)b * LPAD + r) * 64 + 8 * hh;
    bf16x8 bq[4];
    if (wave < nkt) {
#pragma unroll
        for (int ks = 0; ks < 4; ++ks) bq[ks] = *(const bf16x8*)(kbase + (size_t)wave * 32 * 64 + 16 * ks);
    }
    for (int kt = wave; kt < nkt; kt += 8) {
        bf16x8 bn[4];
        const int ktn = (kt + 8 < nkt) ? (kt + 8) : kt;
#pragma unroll
        for (int ks = 0; ks < 4; ++ks) bn[ks] = *(const bf16x8*)(kbase + (size_t)ktn * 32 * 64 + 16 * ks);
#pragma unroll
        for (int rt = 0; rt < 2; ++rt) {
            f32x16 acc;
#pragma unroll
            for (int i = 0; i < 16; ++i) acc[i] = 0.f;
#pragma unroll
            for (int ks = 0; ks < 4; ++ks) acc = MFMA32(af[rt][ks], bq[ks], acc);
#pragma unroll
            for (int ql = 0; ql < 2; ++ql) {
                float s = 0.f;
#pragma unroll
                for (int a2 = 0; a2 < 2; ++a2)
#pragma unroll
                    for (int e2 = 0; e2 < 4; ++e2) s += wq[rt][ql][4 * a2 + e2] * fmaxf(acc[4 * (2 * ql + a2) + e2], 0.f);
                sc[(4 * rt + 2 * hh + ql) * 4160 + 32 * kt + r] = s;
            }
        }
#pragma unroll
        for (int ks = 0; ks < 4; ++ks) bq[ks] = bn[ks];
    }
    __syncthreads();
    {
        const int qpos = t0 + wave;
        select_emit<true>(sc + wave * 4160, qpos, lane, p.maskT + (size_t)b * 65 * LPAD + qpos, nullptr);
    }
    __syncthreads();
}

__device__ __forceinline__ void indexer_phase(const Params& p, char* smem, int bid, int nb) {
    const int tid = tid_opaque();
    float* sc = (float*)smem;
    int* slot = (int*)(smem + LDS_BYTES - 32);
    for (;;) {
        if (threadIdx.x == 0) *slot = (int)atomicAdd(p.bar + 3648, 1u);
        __syncthreads();
        const int u = *slot;
        __syncthreads();
        if (u >= 64 + BATCH * 514) break;
        if (u < 64) {
            const int wave = tid >> 6;
            indexer_sample_row(p, sc + wave * 4160, sc + 8 * 4160 + wave * 512, NPR + u * 8 + wave, tid & 63);
            __syncthreads();
        } else {
            const int v = u - 64;
            indexer_prompt_unit(p, sc, v & 3, 513 - (v >> 2), tid);
        }
    }
}

__device__ __forceinline__ void attn_sample_query(const Params& p, char* smem, int row) {
    float* qs = (float*)smem;
    float* ps = qs + 1024;
    int* sidx = (int*)(ps + 2048);
    const int tid = tid_opaque(), lane = tid & 63, wave = tid >> 6;
    const bool prompt = false;
    const int b = (row - NPR) >> 2;
    qs[tid] = p.qr[(size_t)row * 1024 + tid];
    qs[tid + 512] = p.qr[(size_t)row * 1024 + 512 + tid];
    if (tid < 256) sidx[tid] = p.sel[(size_t)row * 256 + tid];
    __syncthreads();
    {
        const int j = tid & 255, kvh = tid >> 8;
        const int s = sidx[j];
        const bool valid = s >= 0;
        const float* kp = kv_row(p.k_prompt, p.k_sample, p.cache_k, p.page_table, prompt, b, valid ? s : 0) + kvh * 128;
        float d0 = 0.f, d1 = 0.f, d2 = 0.f, d3 = 0.f;
        const float* q0 = qs + (kvh * 4) * 128;
#pragma unroll 8
        for (int c = 0; c < 32; ++c) {
            const f32x4 kv = *(const f32x4*)(kp + c * 4);
            const f32x4 a0 = *(const f32x4*)(q0 + c * 4), a1 = *(const f32x4*)(q0 + 128 + c * 4), a2 = *(const f32x4*)(q0 + 256 + c * 4),
                        a3 = *(const f32x4*)(q0 + 384 + c * 4);
            d0 += kv[0] * a0[0] + kv[1] * a0[1] + kv[2] * a0[2] + kv[3] * a0[3];
            d1 += kv[0] * a1[0] + kv[1] * a1[1] + kv[2] * a1[2] + kv[3] * a1[3];
            d2 += kv[0] * a2[0] + kv[1] * a2[1] + kv[2] * a2[2] + kv[3] * a2[3];
            d3 += kv[0] * a3[0] + kv[1] * a3[1] + kv[2] * a3[2] + kv[3] * a3[3];
        }
        const float sc = 0.08838834764831845f;
        ps[(kvh * 4 + 0) * 256 + j] = valid ? d0 * sc : -INFINITY;
        ps[(kvh * 4 + 1) * 256 + j] = valid ? d1 * sc : -INFINITY;
        ps[(kvh * 4 + 2) * 256 + j] = valid ? d2 * sc : -INFINITY;
        ps[(kvh * 4 + 3) * 256 + j] = valid ? d3 * sc : -INFINITY;
    }
    __syncthreads();
    {
        float v[4]; float m = -INFINITY;
#pragma unroll
        for (int i = 0; i < 4; ++i) { v[i] = ps[wave * 256 + lane + 64 * i]; m = fmaxf(m, v[i]); }
        m = wave_max(m);
        float sum = 0.f;
#pragma unroll
        for (int i = 0; i < 4; ++i) { v[i] = __expf(v[i] - m); sum += v[i]; }
        sum = wave_sum(sum);
        const float inv = 1.f / sum;
#pragma unroll
        for (int i = 0; i < 4; ++i) ps[wave * 256 + lane + 64 * i] = v[i] * inv;
    }
    __syncthreads();
    {
        const int h = wave, d = lane * 2, kvh = h >> 2;
        float o0 = 0.f, o1 = 0.f;
#pragma unroll 16
        for (int j = 0; j < 256; ++j) {
            int s = sidx[j]; if (s < 0) s = 0;
            const float* vp = kv_row(p.v_prompt, p.v_sample, p.cache_v, p.page_table, prompt, b, s) + kvh * 128 + d;
            const float pj = ps[h * 256 + j];
            const float2 vv = *(const float2*)vp;
            o0 += pj * vv.x; o1 += pj * vv.y;
        }
        *(unsigned*)(p.gated + (size_t)row * 1024 + h * 128 + d) = pk2(o0, o1);
    }
    __syncthreads();
}

constexpr int AT_K = 0, AT_V = 64 * 136, AT_ELEMS = 64 * 136 + 128 * 72;
__device__ __forceinline__ void attn_dense_unit(const Params& p, char* smem, int b, int kvh, int qb) {
    bf16_t* lds = (bf16_t*)smem;
    const int tid = tid_opaque(), lane = tid & 63, wave = tid >> 6;
    const int r = lane & 31, hh = lane >> 5;
    const int g = wave & 3, qs = wave >> 2;
    const int head = kvh * 4 + g;
    const int tq = 64 * qb + 32 * qs + r;
    const int tqc = (tq < LP) ? tq : (LP - 1);
    bf16x8 qf[8];
    {
        const bf16_t* qp = p.q_b + ((size_t)b * LP + tqc) * 1024 + head * 128 + 8 * hh;
#pragma unroll
        for (int ks = 0; ks < 8; ++ks) qf[ks] = *(const bf16x8*)(qp + 16 * ks);
    }
    f32x16 O[4];
#pragma unroll
    for (int i = 0; i < 4; ++i)
#pragma unroll
        for (int j = 0; j < 16; ++j) O[i][j] = 0.f;
    float mrun = -3.0e38f, lrun = 0.f;
    const bf16_t* Kg = p.k_b + ((size_t)(b * 2 + kvh) * LPAD) * 128;
    const bf16_t* Vg = p.vt_b + ((size_t)(b * 2 + kvh) * 128) * LPAD;
    const unsigned long long* mcol = p.maskT + (size_t)b * 65 * LPAD + tq;
    const int kc0 = tid, kc1 = tid + 512;
    uint4 sk0, sk1, sv0, sv1;
#define AT_GLOAD(kt_) do { const bf16_t* kg_ = Kg + (size_t)(kt_) * 64 * 128; const bf16_t* vg_ = Vg + (size_t)(kt_) * 64; \
        sk0 = *(const uint4*)(kg_ + (size_t)kc0 * 8); sk1 = *(const uint4*)(kg_ + (size_t)kc1 * 8); \
        sv0 = *(const uint4*)(vg_ + (size_t)(kc0 >> 3) * LPAD + (kc0 & 7) * 8); sv1 = *(const uint4*)(vg_ + (size_t)(kc1 >> 3) * LPAD + (kc1 & 7) * 8); } while (0)
#define AT_SSTORE(buf_) do { bf16_t* q_ = (buf_); \
        *(uint4*)(q_ + AT_K + (kc0 >> 4) * 136 + (kc0 & 15) * 8) = sk0; *(uint4*)(q_ + AT_K + (kc1 >> 4) * 136 + (kc1 & 15) * 8) = sk1; \
        *(uint4*)(q_ + AT_V + (kc0 >> 3) * 72 + (kc0 & 7) * 8) = sv0; *(uint4*)(q_ + AT_V + (kc1 >> 3) * 72 + (kc1 & 7) * 8) = sv1; } while (0)
    AT_GLOAD(0); AT_SSTORE(lds);
    __syncthreads();
    for (int kt = 0; kt <= qb; ++kt) {
        unsigned zofs = 0; asm volatile("" : "+v"(zofs));
        bf16_t* cur = lds + (kt & 1) * AT_ELEMS + zofs;
        bf16_t* nxt = lds + ((kt + 1) & 1) * AT_ELEMS + zofs;
        const bool more = kt < qb;
        if (more) { AT_GLOAD(kt + 1); }
        const unsigned long long mw = mcol[(size_t)kt * LPAD];
        f32x16 st[2];
#pragma unroll
        for (int j = 0; j < 16; ++j) { st[0][j] = 0.f; st[1][j] = 0.f; }
#pragma unroll
        for (int ks = 0; ks < 8; ++ks) {
            st[0] = MFMA32(*(const bf16x8*)(cur + AT_K + (r) * 136 + 16 * ks + 8 * hh), qf[ks], st[0]);
            st[1] = MFMA32(*(const bf16x8*)(cur + AT_K + (32 + r) * 136 + 16 * ks + 8 * hh), qf[ks], st[1]);
        }
        float mx = -3.0e38f;
#pragma unroll
        for (int kk = 0; kk < 2; ++kk) {
            const unsigned w = (unsigned)(mw >> (32 * kk)) >> (4 * hh);
#pragma unroll
            for (int reg = 0; reg < 16; ++reg) {
                const int bit = (reg & 3) + 8 * (reg >> 2);
                const float v = ((w >> bit) & 1u) ? st[kk][reg] : -3.0e38f;
                st[kk][reg] = v;
                mx = fmaxf(mx, v);
            }
        }
        mx = fmaxf(mx, __shfl_xor(mx, 32));
        const float mnew = fmaxf(mrun, mx);
        const float alpha = __builtin_amdgcn_exp2f(mrun - mnew);
        mrun = mnew;
        float psum = 0.f;
#pragma unroll
        for (int kk = 0; kk < 2; ++kk)
#pragma unroll
            for (int reg = 0; reg < 16; ++reg) { const float pv = __builtin_amdgcn_exp2f(st[kk][reg] - mnew); st[kk][reg] = pv; psum += pv; }
        lrun = lrun * alpha + psum;
#pragma unroll
        for (int dt = 0; dt < 4; ++dt) O[dt] = O[dt] * alpha;
        bf16x8 pb[2][2];
#pragma unroll
        for (int kk = 0; kk < 2; ++kk)
#pragma unroll
            for (int s = 0; s < 2; ++s) pb[kk][s] = pack_step(st[kk], s);
#pragma unroll
        for (int dt = 0; dt < 4; ++dt)
#pragma unroll
            for (int kk = 0; kk < 2; ++kk)
#pragma unroll
                for (int s = 0; s < 2; ++s)
                    O[dt] = MFMA32(frag_perm(cur + AT_V + (32 * dt + r) * 72 + 32 * kk + 16 * s + 4 * hh), pb[kk][s], O[dt]);
        if (more) { AT_SSTORE(nxt); }
        __syncthreads();
    }
    const float ltot = lrun + __shfl_xor(lrun, 32);
    const float inv = 1.f / ltot;
    if (tq < LP) {
        bf16_t* op = p.gated + ((size_t)b * LP + tq) * 1024 + head * 128;
#pragma unroll
        for (int dt = 0; dt < 4; ++dt)
#pragma unroll
            for (int g4 = 0; g4 < 4; ++g4) {
                f32x4 v;
#pragma unroll
                for (int e2 = 0; e2 < 4; ++e2) v[e2] = O[dt][4 * g4 + e2] * inv;
                st_bf16x4(op + 32 * dt + 8 * g4 + 4 * hh, v);
            }
    }
    __syncthreads();
}

__device__ __forceinline__ void attn_phase(const Params& p, char* smem, int bid, int nb) {
    int* slot = (int*)(smem + LDS_BYTES - 32);
    for (;;) {
        if (threadIdx.x == 0) *slot = (int)atomicAdd(p.bar + 3584, 1u);
        __syncthreads();
        const int u = *slot;
        __syncthreads();
        if (u >= 520 + NSR) break;
        if (u < 520) attn_dense_unit(p, smem, (u & 7) >> 1, u & 1, 64 - (u >> 3));
        else attn_sample_query(p, smem, NPR + (u - 520));
    }
}

#define XB_TMO      128
#define XB_XCNT(j)  (256  + 64 * (j))
#define XB_XSUB(j)  (1280 + 64 * (j))
#define XB_XGEN(j)  (2304 + 64 * (j))
#define XB_TOP      3328
#define XB_TOPGEN   3392
#define XCD_BAR_WORDS 3456
#define XB_SPIN_CAP (1u << 18)
#define LAS __attribute__((address_space(3)))

__device__ __forceinline__ unsigned xb_ld(unsigned* p)              { return __hip_atomic_load(p, __ATOMIC_RELAXED, __HIP_MEMORY_SCOPE_AGENT); }
__device__ __forceinline__ unsigned xb_add(unsigned* p, unsigned v) { return __hip_atomic_fetch_add(p, v, __ATOMIC_RELAXED, __HIP_MEMORY_SCOPE_AGENT); }
__device__ __forceinline__ unsigned xb_xcc_id() { return (unsigned)__builtin_amdgcn_s_getreg((3 << 11) | 20) & 0xFu; }
#define XB_SPIN(cond, bar) do { unsigned _sp = 0; while (cond) { __builtin_amdgcn_s_sleep(1); \
    if ((++_sp & 255u) == 0u) { if (xb_ld(&(bar)[XB_TMO])) break; if (_sp > XB_SPIN_CAP) { atomicAdd(&(bar)[XB_TMO], 1u); break; } } } } while (0)

struct XcdBarrier {
    unsigned* bar; unsigned x;
    volatile LAS unsigned* st;
};

__device__ __forceinline__ XcdBarrier xcd_barrier_post(unsigned* bar, volatile LAS unsigned* st) {
    XcdBarrier b; b.bar = bar; b.x = xb_xcc_id(); b.st = st;
    if (threadIdx.x == 0) (void)xb_add(&bar[XB_XCNT(b.x)], 1u);
    return b;
}
__device__ __forceinline__ void xcd_barrier_complete(unsigned* bar, unsigned x, unsigned& nloc, unsigned& nx) {
    const unsigned G = gridDim.x * gridDim.y * gridDim.z;
    unsigned sum, cnt, mine, sp = 0u;
    for (;;) {
        sum = 0u; cnt = 0u; mine = 0u;
#pragma unroll
        for (unsigned j = 0; j < 16; ++j) { const unsigned c = xb_ld(&bar[XB_XCNT(j)]); sum += c; cnt += (c > 0u) ? 1u : 0u; mine = (j == x) ? c : mine; }
        if (sum == G) break;
        __builtin_amdgcn_s_sleep(1);
        if ((++sp & 255u) == 0u) { if (xb_ld(&bar[XB_TMO])) break; if (sp > XB_SPIN_CAP) { atomicAdd(&bar[XB_TMO], 1u); break; } }
    }
    nloc = mine > 0u ? mine : 1u; nx = cnt > 0u ? cnt : 1u;
}

__device__ __forceinline__ void xcd_barrier(const XcdBarrier& b) {
    asm volatile("s_waitcnt vmcnt(0)" ::: "memory");
    __syncthreads();
    if (threadIdx.x == 0) {
        unsigned* bar = b.bar;
        __builtin_amdgcn_s_waitcnt(0);
        unsigned nloc = b.st[0], nx = b.st[1];
        if (nloc == 0u) { xcd_barrier_complete(bar, b.x, nloc, nx); b.st[0] = nloc; b.st[1] = nx; }
        const unsigned old = xb_add(&bar[XB_XSUB(b.x)], 1u);
        const unsigned gen = old / nloc;
        if (old + 1u == (gen + 1u) * nloc) {
            __builtin_amdgcn_fence(__ATOMIC_RELEASE, "agent");
            asm volatile("s_waitcnt vmcnt(0)" ::: "memory");
            const unsigned og = xb_add(&bar[XB_TOP], 1u);
            const unsigned tg = og / nx;
            if (og + 1u == (tg + 1u) * nx) xb_add(&bar[XB_TOPGEN], 1u);
            else XB_SPIN(xb_ld(&bar[XB_TOPGEN]) == tg, bar);
            __builtin_amdgcn_fence(__ATOMIC_ACQUIRE, "agent");
            xb_add(&bar[XB_XGEN(b.x)], 1u);
            asm volatile("s_waitcnt vmcnt(0)" ::: "memory");
        } else {
            XB_SPIN(xb_ld(&bar[XB_XGEN(b.x)]) == gen, bar);
            __builtin_amdgcn_fence(__ATOMIC_ACQUIRE, "agent");
            asm volatile("s_waitcnt vmcnt(0)" ::: "memory");
        }
    }
    __syncthreads();
}


constexpr int NPHASE = 19;
template <int PH>
__device__ __forceinline__ void run_phase(const Params& p, char* smem, int bid, int nb) {
    constexpr int MT = MPAD / 256;
    if constexpr (PH == 0) phase_prologue(p, smem, bid, nb);
    else if constexpr (PH == 1) gemm_phase(p.hA, D, p.wt_gin, D, MT, GIN_PAD / 128, EpiGdnIn{p.mixed, p.z, p.ba}, smem, bid, nb);
    else if constexpr (PH == 2) gdn_stageA(p, smem, bid, nb);
    else if constexpr (PH == 3) gdn_seq_phase(p, smem, bid, nb);
    else if constexpr (PH == 4) gdn_gate_phase(p, bid, nb);
    else if constexpr (PH == 5) gemm_phase(p.gated, 2048, p.wt_gout, 2048, MT, D / 128, EpiResid{p.preln, p.hA}, smem, bid, nb);
    else if constexpr (PH == 6) ln_phase(p.preln, p.ln1_g, p.ln1_b, p.hB, nullptr, nullptr, bid, nb);
    else if constexpr (PH == 7) gemm_phase(p.hB, D, p.wt_w1, D, MT, DFF / 128, EpiRelu2{p.act}, smem, bid, nb);
    else if constexpr (PH == 8) gemm_phase(p.act, DFF, p.wt_w2, DFF, MT, D / 128, EpiResid{p.preln, p.hB}, smem, bid, nb);
    else if constexpr (PH == 9) ln_phase(p.preln, p.ln2_g, p.ln2_b, p.hA, nullptr, nullptr, bid, nb);
    else if constexpr (PH == 10) gemm_phase(p.hA, D, p.wt_din, D, MT, DIN_PAD / 128, EpiF32{p.p1, DIN_PAD}, smem, bid, nb);
    else if constexpr (PH == 11) dsa_post_phase(p, bid, nb);
    else if constexpr (PH == 12) indexer_phase(p, smem, bid, nb);
    else if constexpr (PH == 13) attn_phase(p, smem, bid, nb);
    else if constexpr (PH == 14) gemm_phase(p.gated, D, p.wt_do, D, MT, D / 128, EpiResid{p.preln, p.hA}, smem, bid, nb);
    else if constexpr (PH == 15) ln_phase(p.preln, p.ln1_g + D, p.ln1_b + D, p.hB, nullptr, nullptr, bid, nb);
    else if constexpr (PH == 16) gemm_phase(p.hB, D, p.wt_w1 + (size_t)D * DFF, D, MT, DFF / 128, EpiRelu2{p.act}, smem, bid, nb);
    else if constexpr (PH == 17) gemm_phase(p.act, DFF, p.wt_w2 + (size_t)D * DFF, DFF, MT, D / 128, EpiResid{p.preln, p.hB}, smem, bid, nb);
    else if constexpr (PH == 18) ln_phase(p.preln, p.ln2_g + D, p.ln2_b + D, nullptr, p.y_prompt, p.y_sample, bid, nb);
}

template <int PH>
__global__ void __launch_bounds__(NTHR, 2) k_phase(Params p) {
    extern __shared__ __attribute__((aligned(16))) char smem[];
    run_phase<PH>(p, smem, blockIdx.x, gridDim.x);
}

template <int PH>
__device__ __forceinline__ void mega_run(const Params& p, char* smem, const XcdBarrier& bar) {
    run_phase<PH>(p, smem, blockIdx.x, gridDim.x);
    if constexpr (PH + 1 < NPHASE) {
        xcd_barrier(bar);
        mega_run<PH + 1>(p, smem, bar);
    }
}
__global__ void __launch_bounds__(NTHR, 2) k_mega(Params p) {
    extern __shared__ __attribute__((aligned(16))) char smem[];
    volatile LAS unsigned* st = (volatile LAS unsigned*)(smem + LDS_BYTES - 16);
    if (threadIdx.x == 0) { st[0] = 0u; st[1] = 0u; st[2] = 0u; st[3] = 0u; }
    __syncthreads();
    XcdBarrier bar = xcd_barrier_post(p.bar, st);
    mega_run<0>(p, smem, bar);
}

template <int PH>
void launch_phase(const Params& p, hipStream_t stream) {
    static bool attr_done = false;
    if (!attr_done) {
        (void)hipFuncSetAttribute((const void*)k_phase<PH>, hipFuncAttributeMaxDynamicSharedMemorySize, LDS_BYTES);
        attr_done = true;
    }
    hipLaunchKernelGGL(k_phase<PH>, dim3(256), dim3(NTHR), LDS_BYTES, stream, p);
}
template <int PH>
void launch_all(const Params& p, hipStream_t stream) {
    launch_phase<PH>(p, stream);
    if constexpr (PH + 1 < NPHASE) launch_all<PH + 1>(p, stream);
}

}

extern "C" void kernel_launch(void* const* d_in, const int* in_sizes, int n_in, void* d_out, int out_size, void* d_ws, size_t ws_size,
                              hipStream_t stream) {
    Params p{};
    p.x_prompt = (const float*)d_in[0]; p.x_sample = (const float*)d_in[1]; p.state_gdn = (const float*)d_in[2];
    p.state_conv = (const float*)d_in[3]; p.cache_k = (const float*)d_in[4]; p.cache_v = (const float*)d_in[5];
    p.cache_ik = (const float*)d_in[6]; p.page_table = (const int*)d_in[7]; p.meta = (const float*)d_in[8];
    p.ln1_g = (const float*)d_in[9]; p.ln1_b = (const float*)d_in[10]; p.ln2_g = (const float*)d_in[11]; p.ln2_b = (const float*)d_in[12];
    p.mlp_w1 = (const float*)d_in[13]; p.mlp_w2 = (const float*)d_in[14]; p.gdn_w_in = (const float*)d_in[15];
    p.gdn_conv_w = (const float*)d_in[16]; p.gdn_a_log = (const float*)d_in[17]; p.gdn_dt_bias = (const float*)d_in[18];
    p.gdn_norm_w = (const float*)d_in[19]; p.gdn_w_out = (const float*)d_in[20]; p.dsa_w_in = (const float*)d_in[21];
    p.dsa_ik_g = (const float*)d_in[22]; p.dsa_ik_b = (const float*)d_in[23]; p.dsa_w_o = (const float*)d_in[24];
    float* o = (float*)d_out;
    p.y_prompt = o; o += (size_t)BATCH * SEQ * D;
    p.y_sample = o; o += (size_t)NSR * D;
    p.gs_prompt = o; o += (size_t)BATCH * 16 * 128 * 128;
    p.gc_prompt = o; o += (size_t)BATCH * 3 * 4096;
    p.gs_sample = o; o += (size_t)DB * 16 * 128 * 128;
    p.gc_sample = o; o += (size_t)DB * 3 * 4096;
    p.k_prompt = o; o += (size_t)NPR * 256;
    p.v_prompt = o; o += (size_t)NPR * 256;
    p.ik_prompt = o; o += (size_t)NPR * 64;
    p.k_sample = o; o += (size_t)NSR * 256;
    p.v_sample = o; o += (size_t)NSR * 256;
    p.ik_sample = o; o += (size_t)NSR * 64;
    char* w = (char*)d_ws;
    auto take = [&](size_t bytes) { char* r = w; w += (bytes + 255) & ~(size_t)255; return r; };
    p.bar = (unsigned*)take(16384);
    p.wt_gin = (bf16_t*)take((size_t)GIN_PAD * D * 2);
    p.wt_gout = (bf16_t*)take((size_t)D * 2048 * 2);
    p.wt_w1 = (bf16_t*)take((size_t)2 * D * DFF * 2);
    p.wt_w2 = (bf16_t*)take((size_t)2 * D * DFF * 2);
    p.wt_din = (bf16_t*)take((size_t)DIN_PAD * D * 2);
    p.wt_do = (bf16_t*)take((size_t)D * D * 2);
    p.hA = (bf16_t*)take((size_t)MPAD * D * 2);
    p.hB = (bf16_t*)take((size_t)MPAD * D * 2);
    p.preln = (float*)take((size_t)MPAD * D * 4);
    p.mixed = (bf16_t*)take((size_t)MPAD * 4096 * 2);
    p.z = (bf16_t*)take((size_t)MPAD * 2048 * 2);
    p.ba = (float*)take((size_t)MPAD * 32 * 4);
    p.gated = (bf16_t*)take((size_t)MPAD * 2048 * 2);
    p.act = (bf16_t*)take((size_t)MPAD * DFF * 2);
    p.p1 = (float*)take((size_t)MPAD * DIN_PAD * 4);
    p.qr = (float*)take((size_t)MPAD * 1024 * 4);
    p.iq = (float*)take((size_t)MPAD * 512 * 4);
    p.iw = (float*)take((size_t)MPAD * 8 * 4);
    p.sel = (int*)take((size_t)MPAD * 256 * 4);
    p.g_o = (float*)take((size_t)NPR * 2048 * 4);
    p.q_b = (bf16_t*)take((size_t)NPR * 1024 * 2);
    p.k_b = (bf16_t*)take((size_t)BATCH * 2 * LPAD * 128 * 2);
    p.vt_b = (bf16_t*)take((size_t)BATCH * 2 * 128 * LPAD * 2);
    p.iq_b = (bf16_t*)take((size_t)NPR * 512 * 2);
    p.ik_b = (bf16_t*)take((size_t)BATCH * LPAD * 64 * 2);
    p.maskT = (unsigned long long*)take((size_t)BATCH * 65 * LPAD * 8);
    p.g_dec = (float*)take((size_t)NCU * 4);
    p.g_u = (float*)p.act;
    p.g_negw = (bf16_t*)p.p1;
    p.g_qg = p.g_negw + (size_t)NCU * 8192;
    p.g_kdT = (bf16_t*)p.qr;
    p.g_aqk = (bf16_t*)p.iq;
    if ((size_t)(w - (char*)d_ws) > ws_size) { fprintf(stderr, "kernel_launch: workspace too small (%zu needed, %zu given)\n", (size_t)(w - (char*)d_ws), ws_size); return; }
#if MEGA
    static int grid = 0;
    if (grid == 0) {
        int dev = 0, cus = 0;
        if (hipGetDevice(&dev) != hipSuccess || hipDeviceGetAttribute(&cus, hipDeviceAttributeMultiprocessorCount, dev) != hipSuccess || cus <= 0) cus = 256;
        (void)hipFuncSetAttribute((const void*)k_mega, hipFuncAttributeMaxDynamicSharedMemorySize, LDS_BYTES);
        grid = cus;
    }
    (void)hipMemsetAsync(p.bar, 0, 16384, stream);
    hipLaunchKernelGGL(k_mega, dim3(grid), dim3(NTHR), LDS_BYTES, stream, p);
#else
    launch_all<0>(p, stream);
#endif
}
```

```cpp
#include <hip/hip_runtime.h>
#include <stdint.h>
#include <stdio.h>

#ifndef MEGA
#define MEGA 1
#endif

namespace {

typedef unsigned short bf16_t;
typedef short bf16x8 __attribute__((ext_vector_type(8)));
typedef float f32x4 __attribute__((ext_vector_type(4)));

constexpr int D = 1024, BATCH = 4, SEQ = 4096, NMETA = 16, LP = SEQ + NMETA;
constexpr int DB = 128, DS = 4, PAST = 2048;
constexpr int NPR = BATCH * LP;
constexpr int NSR = DB * DS;
constexpr int NT = NPR + NSR;
constexpr int MPAD = 17152;
constexpr int DFF = 4096;
constexpr int GIN = 6176, GIN_PAD = 6400;
constexpr int DIN = 2120, DIN_PAD = 2304;
constexpr int NTHR = 512;
constexpr int LPAD = 4160;
constexpr int LDS_BYTES = 150 * 1024;
constexpr float ALPHA = 1.4142135623730951f;

struct Params {
    const float *x_prompt, *x_sample, *state_gdn, *state_conv, *cache_k, *cache_v, *cache_ik;
    const int* page_table;
    const float *meta, *ln1_g, *ln1_b, *ln2_g, *ln2_b, *mlp_w1, *mlp_w2, *gdn_w_in, *gdn_conv_w, *gdn_a_log, *gdn_dt_bias,
        *gdn_norm_w, *gdn_w_out, *dsa_w_in, *dsa_ik_g, *dsa_ik_b, *dsa_w_o;
    float *y_prompt, *y_sample, *gs_prompt, *gc_prompt, *gs_sample, *gc_sample, *k_prompt, *v_prompt, *ik_prompt, *k_sample,
        *v_sample, *ik_sample;
    unsigned* bar;
    bf16_t *wt_gin, *wt_gout, *wt_w1, *wt_w2, *wt_din, *wt_do;
    bf16_t *hA, *hB;
    float* preln;
    bf16_t *mixed, *z;
    float* ba;
    bf16_t *gated, *act;
    float *p1, *qr, *iq, *iw;
    int* sel;
    bf16_t *g_negw, *g_qg, *g_kdT, *g_aqk;
    float *g_u, *g_dec, *g_o;
    bf16_t *q_b, *k_b, *vt_b, *iq_b, *ik_b;
    unsigned long long* maskT;
};

__device__ const double kInvFreq[16] = {1.0, 0.44036660267178046, 0.19392274474868576, 0.08539710028576561,
    0.03760603093086393, 0.016560440080994446, 0.007292664737217109, 0.003211445994752591, 0.001414213562373095,
    0.000622772421914596, 0.0002742481756762073, 0.00012076973741146504, 5.318295896944988e-05, 2.341999896140934e-05,
    1.031338537721246e-05, 4.5416704806078695e-06};

__device__ __forceinline__ float bf2f(bf16_t h) { return __uint_as_float(((unsigned)h) << 16); }
typedef __bf16 hwbf16x2 __attribute__((ext_vector_type(2)));
typedef float f32x2 __attribute__((ext_vector_type(2)));
typedef float f32x16 __attribute__((ext_vector_type(16)));
typedef unsigned u32x4 __attribute__((ext_vector_type(4)));
__device__ __forceinline__ unsigned pk2(float lo, float hi) {
    const f32x2 v = {lo, hi};
    return __builtin_bit_cast(unsigned, __builtin_convertvector(v, hwbf16x2));
}
__device__ __forceinline__ bf16_t f2bf(float f) { return (bf16_t)(pk2(f, 0.f) & 0xffffu); }
__device__ __forceinline__ void st_bf16x4(bf16_t* p, f32x4 v) {
    uint2 o; o.x = pk2(v[0], v[1]); o.y = pk2(v[2], v[3]);
    *(uint2*)p = o;
}
__device__ __forceinline__ f32x4 cvt_bf16x4(uint2 o) {
    f32x4 v; v[0] = __uint_as_float(o.x << 16); v[1] = __uint_as_float(o.x & 0xffff0000u);
    v[2] = __uint_as_float(o.y << 16); v[3] = __uint_as_float(o.y & 0xffff0000u);
    return v;
}
__device__ __forceinline__ f32x4 ld_bf16x4(const bf16_t* p) {
    uint2 o = *(const uint2*)p;
    f32x4 v; v[0] = __uint_as_float(o.x << 16); v[1] = __uint_as_float(o.x & 0xffff0000u);
    v[2] = __uint_as_float(o.y << 16); v[3] = __uint_as_float(o.y & 0xffff0000u);
    return v;
}
__device__ __forceinline__ float wave_sum(float v) {
#pragma unroll
    for (int o = 1; o < 64; o <<= 1) v += __shfl_xor(v, o);
    return v;
}
__device__ __forceinline__ float wave_max(float v) {
#pragma unroll
    for (int o = 1; o < 64; o <<= 1) v = fmaxf(v, __shfl_xor(v, o));
    return v;
}
__device__ __forceinline__ int wave_sum_i(int v) {
#pragma unroll
    for (int o = 1; o < 64; o <<= 1) v += __shfl_xor(v, o);
    return v;
}
__device__ __forceinline__ float silu(float x) { return x / (1.f + __expf(-x)); }
__device__ __forceinline__ int tid_opaque() { int t = threadIdx.x; asm volatile("" : "+v"(t)); return t; }
__device__ __forceinline__ void lds_fence() { asm volatile("s_waitcnt lgkmcnt(0)" ::: "memory"); }

__device__ __forceinline__ void transpose_convert(const float* __restrict__ W, int K, int N, int Npad, bf16_t* __restrict__ WT, float* tile,
                                  int bid, int nb) {
    const int tid = tid_opaque();
    const int tk = K / 64, tn = Npad / 64;
    for (int it = bid; it < tk * tn; it += nb) {
        const int kb = it / tn, nbk = it % tn, k0 = kb * 64, n0 = nbk * 64;
#pragma unroll
        for (int i = 0; i < 8; ++i) {
            const int r = (tid >> 6) + 8 * i, c = tid & 63, n = n0 + c;
            tile[r * 65 + c] = (n < N) ? W[(size_t)(k0 + r) * N + n] : 0.f;
        }
        __syncthreads();
        {
            const int rn = tid >> 3, c8 = (tid & 7) * 8;
            const float* tp = tile + c8 * 65 + rn;
            uint4 o;
            o.x = pk2(tp[0], tp[65]); o.y = pk2(tp[2 * 65], tp[3 * 65]); o.z = pk2(tp[4 * 65], tp[5 * 65]); o.w = pk2(tp[6 * 65], tp[7 * 65]);
            *(uint4*)(WT + (size_t)(n0 + rn) * K + k0 + c8) = o;
        }
        __syncthreads();
    }
}

__device__ __forceinline__ void phase_prologue(const Params& p, char* smem, int bid, int nb) {
    float* tile = (float*)smem;
    transpose_convert(p.gdn_w_in, D, GIN, GIN_PAD, p.wt_gin, tile, bid, nb);
    transpose_convert(p.gdn_w_out, 2048, D, D, p.wt_gout, tile, bid, nb);
    transpose_convert(p.mlp_w1, D, DFF, DFF, p.wt_w1, tile, bid, nb);
    transpose_convert(p.mlp_w1 + (size_t)D * DFF, D, DFF, DFF, p.wt_w1 + (size_t)D * DFF, tile, bid, nb);
    transpose_convert(p.mlp_w2, DFF, D, D, p.wt_w2, tile, bid, nb);
    transpose_convert(p.mlp_w2 + (size_t)D * DFF, DFF, D, D, p.wt_w2 + (size_t)D * DFF, tile, bid, nb);
    transpose_convert(p.dsa_w_in, D, DIN, DIN_PAD, p.wt_din, tile, bid, nb);
    transpose_convert(p.dsa_w_o, D, D, D, p.wt_do, tile, bid, nb);
    for (int idx = bid * NTHR + tid_opaque(); idx < (MPAD - 16384) * 256; idx += nb * NTHR)
        *(f32x4*)(p.preln + (size_t)16384 * D + (size_t)idx * 4) = (f32x4){0.f, 0.f, 0.f, 0.f};
    for (int idx = bid * NTHR + tid_opaque(); idx < MPAD * 256; idx += nb * NTHR) {
        const int row = idx >> 8, c4 = (idx & 255) * 4;
        f32x4 v = {0.f, 0.f, 0.f, 0.f};
        if (row < NPR) {
            const int b = row / LP, t = row % LP;
            const float* src = (t < NMETA) ? (p.meta + (size_t)t * D) : (p.x_prompt + ((size_t)b * SEQ + (t - NMETA)) * D);
            v = *(const f32x4*)(src + c4);
        } else if (row < NT) {
            v = *(const f32x4*)(p.x_sample + (size_t)(row - NPR) * D + c4);
        }
        st_bf16x4(p.hA + (size_t)row * D + c4, v);
    }
}

template <class Epi>
__device__ __forceinline__ void gemm_phase(const bf16_t* __restrict__ A, int lda, const bf16_t* __restrict__ Bt, int K, int Mtiles, int Ntiles,
                           const Epi& epi, char* smem, int bid, int nb) {
    bf16_t* As = (bf16_t*)smem;
    bf16_t* Bs = As + 256 * 72;
    const int tid = tid_opaque(), lane = tid & 63, wave = tid >> 6;
    const int wm = wave >> 1, wn = wave & 1;
    const int fr = lane & 15, fq = lane >> 4;
    const int ntiles = Mtiles * Ntiles;
    const int nk = K / 64;
    for (int tile = bid; tile < ntiles; tile += nb) {
        const int tm = tile % Mtiles, tn = tile / Mtiles;
        const bf16_t* Ag = A + (size_t)tm * 256 * lda;
        const bf16_t* Bg = Bt + (size_t)tn * 128 * K;
        f32x4 acc[4][4];
#pragma unroll
        for (int i = 0; i < 4; ++i)
#pragma unroll
            for (int j = 0; j < 4; ++j) acc[i][j] = (f32x4){0.f, 0.f, 0.f, 0.f};
        const int c0 = tid, c1 = tid + 512, c2 = tid + 1024, c3 = tid + 1536;
        const bf16_t* ga0 = Ag + (size_t)(c0 >> 3) * lda + (c0 & 7) * 8;
        const bf16_t* ga1 = Ag + (size_t)(c1 >> 3) * lda + (c1 & 7) * 8;
        const bf16_t* ga2 = Ag + (size_t)(c2 >> 3) * lda + (c2 & 7) * 8;
        const bf16_t* ga3 = Ag + (size_t)(c3 >> 3) * lda + (c3 & 7) * 8;
        const bf16_t* gb0 = Bg + (size_t)(c0 >> 3) * K + (c0 & 7) * 8;
        const bf16_t* gb1 = Bg + (size_t)(c1 >> 3) * K + (c1 & 7) * 8;
        bf16_t* sa0 = As + (c0 >> 3) * 72 + (c0 & 7) * 8;
        bf16_t* sa1 = As + (c1 >> 3) * 72 + (c1 & 7) * 8;
        bf16_t* sa2 = As + (c2 >> 3) * 72 + (c2 & 7) * 8;
        bf16_t* sa3 = As + (c3 >> 3) * 72 + (c3 & 7) * 8;
        bf16_t* sb0 = Bs + (c0 >> 3) * 72 + (c0 & 7) * 8;
        bf16_t* sb1 = Bs + (c1 >> 3) * 72 + (c1 & 7) * 8;
        uint4 ra0 = *(const uint4*)ga0, ra1 = *(const uint4*)ga1, ra2 = *(const uint4*)ga2, ra3 = *(const uint4*)ga3;
        uint4 rb0 = *(const uint4*)gb0, rb1 = *(const uint4*)gb1;
        *(uint4*)sa0 = ra0; *(uint4*)sa1 = ra1; *(uint4*)sa2 = ra2; *(uint4*)sa3 = ra3; *(uint4*)sb0 = rb0; *(uint4*)sb1 = rb1;
        __syncthreads();
        for (int kt = 0; kt < nk; ++kt) {
            const bool more = (kt + 1 < nk);
            if (more) {
                const int k0 = (kt + 1) * 64;
                ra0 = *(const uint4*)(ga0 + k0); ra1 = *(const uint4*)(ga1 + k0); ra2 = *(const uint4*)(ga2 + k0); ra3 = *(const uint4*)(ga3 + k0);
                rb0 = *(const uint4*)(gb0 + k0); rb1 = *(const uint4*)(gb1 + k0);
            }
#pragma unroll
            for (int kk = 0; kk < 2; ++kk) {
                bf16x8 af[4], bfr[4];
#pragma unroll
                for (int i = 0; i < 4; ++i) af[i] = *(const bf16x8*)(As + (wm * 64 + i * 16 + fr) * 72 + kk * 32 + fq * 8);
#pragma unroll
                for (int j = 0; j < 4; ++j) bfr[j] = *(const bf16x8*)(Bs + (wn * 64 + j * 16 + fr) * 72 + kk * 32 + fq * 8);
#pragma unroll
                for (int i = 0; i < 4; ++i)
#pragma unroll
                    for (int j = 0; j < 4; ++j) acc[i][j] = __builtin_amdgcn_mfma_f32_16x16x32_bf16(bfr[j], af[i], acc[i][j], 0, 0, 0);
            }
            __syncthreads();
            if (more) {
                *(uint4*)sa0 = ra0; *(uint4*)sa1 = ra1; *(uint4*)sa2 = ra2; *(uint4*)sa3 = ra3; *(uint4*)sb0 = rb0; *(uint4*)sb1 = rb1;
                __syncthreads();
            }
        }
#pragma unroll
        for (int i = 0; i < 4; ++i)
#pragma unroll
            for (int j = 0; j < 4; ++j) {
                const int row = tm * 256 + wm * 64 + i * 16 + fr, col = tn * 128 + wn * 64 + j * 16 + fq * 4;
                epi(row, col, acc[i][j]);
            }
    }
}

namespace pg8 {
#define PG8_LAS __attribute__((address_space(3)))
constexpr int BM = 256, BK = 64, HALF = 128, HTB = HALF * BK * 2  , STAGE_BYTES = 8 * HTB, NXCD = 8, WGM = 8;
__device__ __forceinline__ int lds_byte(int r, int c) { const int st = (r >> 4) * 2 + (c >> 5), rr = r & 15, cc = c & 31, ob = rr * 64 + cc * 2; return st * 1024 + (ob ^ (((ob >> 9) & 1) << 5)); }
__device__ __forceinline__ void stage_rc(int b, int& R, int& C) { const int st = b / 1024, sb = b % 1024, swz = sb ^ (((sb >> 9) & 1) << 5); R = (st >> 1) * 16 + swz / 64; C = (st & 1) * 32 + (swz % 64) / 2; }
struct Unit { int pm, pn, pk; };
struct Gemm { const bf16_t* A; const bf16_t* Bt; int K; int splits; };
struct StaticOrder {
    int nM, nN, nNr, pm0, nwg, G, c;
    __device__ void init(int nM_, int nNr_, int splits, int pm0_, int G_, int c_) { nM = nM_; nNr = nNr_; nN = nNr_ * splits; pm0 = pm0_; nwg = nM * nN; G = G_; c = c_; }
    __device__ bool next(int i, Unit& u) const {
        const long L = (long)i * G + c; if (L >= nwg) return false;
        int wgid = (int)L; { const int q = nwg / NXCD, r = nwg % NXCD, xcd = wgid % NXCD, off = wgid / NXCD; wgid = (xcd < r ? xcd * (q + 1) : r * (q + 1) + (xcd - r) * q) + off; }
        const int nig = WGM * nN, gid = wgid / nig, fm = gid * WGM, gsz = (nM - fm) < WGM ? (nM - fm) : WGM;
        const int pnv = (wgid % nig) / gsz;
        u.pm = pm0 + fm + ((wgid % nig) % gsz); u.pn = pnv % nNr; u.pk = pnv / nNr; return true;
    }
};
template <class Epi>
__device__ __forceinline__ void gemm_phase(PG8_LAS unsigned char* lds, const Gemm g, const StaticOrder& S, const Epi& E) {
    const int tid = threadIdx.x, wid = __builtin_amdgcn_readfirstlane(tid >> 6), lane = tid & 63, wr = wid >> 2, wc = wid & 3, fr = lane & 15, fq = lane >> 4;
    const int K = g.K, Kp = K / g.splits, nt = Kp / BK;
    unsigned voffA[2], voffB[2];
#pragma unroll
    for (int i = 0; i < 2; ++i) { int R, C; stage_rc(tid * 16 + i * 8192, R, C); voffA[i] = (unsigned)(R * K + C) * 2u; voffB[i] = voffA[i]; }
    const size_t kstep = (size_t)(BK * 2);
    const size_t hstep = (size_t)HALF * K * 2;
    const size_t tstep = 2 * hstep;
    const size_t pstep = (size_t)Kp * 2;
    const unsigned ldsw = (unsigned)wid * 1024u;
    const int aoff = lds_byte(wr * 64 + fr, fq * 8), boff = lds_byte(wc * 32 + fr, fq * 8);
#define PG8_SA(b, h) (((b) * 2 + (h)) * HTB)
#define PG8_SB(b, h) ((4 + (b) * 2 + (h)) * HTB)
#define PG8_STAGE(bufoff, gbase, voff) do { _Pragma("unroll") for (int _i = 0; _i < 2; ++_i) \
        __builtin_amdgcn_global_load_lds((const unsigned*)((const char*)(gbase) + (voff)[_i]), (PG8_LAS unsigned*)(lds + (bufoff) + ldsw + _i * 8192), 16, 0, 0); } while (0)
#define PG8_LDA(dst, b, h) do { _Pragma("unroll") for (int m = 0; m < 4; ++m) _Pragma("unroll") for (int k = 0; k < 2; ++k) dst[m][k] = *(const PG8_LAS bf16x8*)(lds + PG8_SA(b, h) + aoff + m * 2048 + k * 1024); } while (0)
#define PG8_LDB(dst, b, h) do { _Pragma("unroll") for (int n = 0; n < 2; ++n) _Pragma("unroll") for (int k = 0; k < 2; ++k) dst[n][k] = *(const PG8_LAS bf16x8*)(lds + PG8_SB(b, h) + boff + n * 2048 + k * 1024); } while (0)
#define PG8_MMA(ai, bj, At, Bt) do { __builtin_amdgcn_s_setprio(1); _Pragma("unroll") for (int m = 0; m < 4; ++m) _Pragma("unroll") for (int n = 0; n < 2; ++n) _Pragma("unroll") for (int k = 0; k < 2; ++k) \
        acc[ai][bj][m][n] = __builtin_amdgcn_mfma_f32_16x16x32_bf16(Bt[n][k], At[m][k], acc[ai][bj][m][n], 0, 0, 0); __builtin_amdgcn_s_setprio(0); } while (0)
#define PG8_WAIT_V(n) asm volatile("s_waitcnt vmcnt(" #n ")" ::: "memory")
#define PG8_WAIT_L(n) asm volatile("s_waitcnt lgkmcnt(" #n ")" ::: "memory")
#define PG8_BAR __builtin_amdgcn_s_barrier()
#define PG8_SCHED __builtin_amdgcn_sched_barrier(0)
    Unit cur, nxt; int ui = 0;
    if (!S.next(0, cur)) return;
    f32x4 acc[2][2][4][2];
#pragma unroll
    for (int a = 0; a < 2; ++a)
#pragma unroll
        for (int b = 0; b < 2; ++b)
#pragma unroll
            for (int m = 0; m < 4; ++m)
#pragma unroll
                for (int n = 0; n < 2; ++n) acc[a][b][m][n] = (f32x4){0.f, 0.f, 0.f, 0.f};
    bf16x8 At[4][2], B0[2][2], B1[2][2];
    const char* cA = (const char*)g.A + (size_t)cur.pm * tstep + (size_t)cur.pk * pstep; const char* cB = (const char*)g.Bt + (size_t)cur.pn * tstep + (size_t)cur.pk * pstep;
    PG8_STAGE(PG8_SB(0, 0), cB, voffB); PG8_STAGE(PG8_SA(0, 0), cA, voffA); PG8_STAGE(PG8_SB(0, 1), cB + hstep, voffB); PG8_STAGE(PG8_SA(0, 1), cA + hstep, voffA);
    if (wr == 1) PG8_BAR;
    PG8_WAIT_V(4); PG8_BAR;
    PG8_STAGE(PG8_SB(1, 0), cB + kstep, voffB); PG8_STAGE(PG8_SA(1, 0), cA + kstep, voffA); PG8_STAGE(PG8_SB(1, 1), cB + hstep + kstep, voffB);
    PG8_WAIT_V(6); PG8_BAR;
    for (;;) {
        const bool has_next = S.next(ui + 1, nxt);
        const char* nA = has_next ? (const char*)g.A + (size_t)nxt.pm * tstep + (size_t)nxt.pk * pstep : cA; const char* nB = has_next ? (const char*)g.Bt + (size_t)nxt.pn * tstep + (size_t)nxt.pk * pstep : cB;
        for (int t = 0; t < nt; t += 2) {
            const bool last = (t == nt - 2);
            const char* a1 = cA + (size_t)(t + 1) * kstep;
            const char* a2 = last ? nA : cA + (size_t)(t + 2) * kstep; const char* b2 = last ? nB : cB + (size_t)(t + 2) * kstep;
            const char* a3 = a2 + kstep; const char* b3 = b2 + kstep;
            PG8_LDB(B0, 0, 0); PG8_SCHED; PG8_LDA(At, 0, 0); PG8_STAGE(PG8_SA(1, 1), a1 + hstep, voffA);
            PG8_WAIT_L(8); PG8_BAR; PG8_WAIT_L(0); PG8_MMA(0, 0, At, B0); PG8_BAR; PG8_SCHED;
            PG8_LDB(B1, 0, 1); PG8_STAGE(PG8_SB(0, 0), b2, voffB);
            PG8_BAR; PG8_WAIT_L(0); PG8_MMA(0, 1, At, B1); PG8_BAR;
            PG8_LDA(At, 0, 1); PG8_STAGE(PG8_SA(0, 0), a2, voffA);
            PG8_BAR; PG8_WAIT_L(0); PG8_MMA(1, 0, At, B0); PG8_BAR; PG8_SCHED;
            PG8_STAGE(PG8_SB(0, 1), b2 + hstep, voffB);
            PG8_WAIT_V(6); PG8_BAR; PG8_MMA(1, 1, At, B1); PG8_BAR;
            PG8_LDB(B0, 1, 0); PG8_SCHED; PG8_LDA(At, 1, 0); PG8_STAGE(PG8_SA(0, 1), a2 + hstep, voffA);
            PG8_WAIT_L(8); PG8_BAR; PG8_WAIT_L(0); PG8_MMA(0, 0, At, B0); PG8_BAR; PG8_SCHED;
            PG8_LDB(B1, 1, 1); PG8_STAGE(PG8_SB(1, 0), b3, voffB);
            PG8_BAR; PG8_WAIT_L(0); PG8_MMA(0, 1, At, B1); PG8_BAR;
            PG8_LDA(At, 1, 1); PG8_STAGE(PG8_SA(1, 0), a3, voffA);
            PG8_BAR; PG8_WAIT_L(0); PG8_MMA(1, 0, At, B0); PG8_BAR; PG8_SCHED;
            PG8_STAGE(PG8_SB(1, 1), b3 + hstep, voffB);
            PG8_WAIT_V(6); PG8_BAR; PG8_MMA(1, 1, At, B1); PG8_BAR;
        }
#pragma unroll
        for (int ai = 0; ai < 2; ++ai)
#pragma unroll
            for (int m = 0; m < 4; ++m)
#pragma unroll
                for (int bj = 0; bj < 2; ++bj)
#pragma unroll
                    for (int n = 0; n < 2; ++n)
                        E(cur.pm * BM + ai * HALF + wr * 64 + m * 16 + fr, cur.pn * BM + bj * HALF + wc * 32 + n * 16 + 4 * fq, acc[ai][bj][m][n], cur.pk);
        if (!has_next) break;
#pragma unroll
        for (int a = 0; a < 2; ++a)
#pragma unroll
            for (int b = 0; b < 2; ++b)
#pragma unroll
                for (int m = 0; m < 4; ++m)
#pragma unroll
                    for (int n = 0; n < 2; ++n) acc[a][b][m][n] = (f32x4){0.f, 0.f, 0.f, 0.f};
        cur = nxt; cA = nA; cB = nB; ++ui;
    }
    PG8_WAIT_V(0);
    if (wr == 0) PG8_BAR;
    PG8_BAR;
#undef PG8_SA
#undef PG8_SB
#undef PG8_STAGE
#undef PG8_LDA
#undef PG8_LDB
#undef PG8_MMA
#undef PG8_WAIT_V
#undef PG8_WAIT_L
#undef PG8_BAR
#undef PG8_SCHED
}
}

template <class Epi>
__device__ __forceinline__ void gemm_big(const bf16_t* A, int K, const bf16_t* Bt, int Npad, const Epi& e, char* smem, int bid, int nb) {
    pg8::StaticOrder S; S.init(MPAD / 256, Npad / 256, 1, 0, nb, bid);
    pg8::gemm_phase((PG8_LAS unsigned char*)smem, pg8::Gemm{A, Bt, K, 1}, S, e);
}
template <class Epi1, class Epi2>
__device__ __forceinline__ void gemm_n1024(const bf16_t* A, int K, const bf16_t* Bt, const Epi1& e1, const Epi2& e2, int splits, char* smem, int bid, int nb) {
    pg8::StaticOrder S; S.init(64, 4, 1, 0, nb, bid);
    pg8::gemm_phase((PG8_LAS unsigned char*)smem, pg8::Gemm{A, Bt, K, 1}, S, e1);
    pg8::StaticOrder S2; S2.init(3, 4, splits, 64, nb, bid);
    pg8::gemm_phase((PG8_LAS unsigned char*)smem, pg8::Gemm{A, Bt, K, splits}, S2, e2);
}

struct EpiGdnIn {
    bf16_t *mixed, *z; float* ba;
    __device__ __forceinline__ void operator()(int row, int col, f32x4 v, int = 0) const {
        if (col < 4096) st_bf16x4(mixed + (size_t)row * 4096 + col, v);
        else if (col < 6144) st_bf16x4(z + (size_t)row * 2048 + (col - 4096), v);
        else if (col < 6176) *(f32x4*)(ba + (size_t)row * 32 + (col - 6144)) = v;
    }
};
struct EpiResid {
    float* out; const bf16_t* h;
    __device__ __forceinline__ void operator()(int row, int col, f32x4 v, int = 0) const {
        const f32x4 r = ld_bf16x4(h + (size_t)row * D + col);
        *(f32x4*)(out + (size_t)row * D + col) = v + r * ALPHA;
    }
};
struct EpiResidAtomic {
    float* out; const bf16_t* h;
    __device__ __forceinline__ void operator()(int row, int col, f32x4 v, int pk) const {
        if (pk == 0) { const f32x4 r = ld_bf16x4(h + (size_t)row * D + col); v = v + r * ALPHA; }
        float* o = out + (size_t)row * D + col;
        unsafeAtomicAdd(o, v[0]); unsafeAtomicAdd(o + 1, v[1]); unsafeAtomicAdd(o + 2, v[2]); unsafeAtomicAdd(o + 3, v[3]);
    }
};
struct EpiRelu2 {
    bf16_t* act;
    __device__ __forceinline__ void operator()(int row, int col, f32x4 v, int = 0) const {
#pragma unroll
        for (int e = 0; e < 4; ++e) { const float r = fmaxf(v[e], 0.f); v[e] = r * r; }
        st_bf16x4(act + (size_t)row * DFF + col, v);
    }
};
struct EpiF32 {
    float* out; int ld;
    __device__ __forceinline__ void operator()(int row, int col, f32x4 v, int = 0) const { *(f32x4*)(out + (size_t)row * ld + col) = v; }
};

__device__ __forceinline__ void ln_phase(const float* X, const float* __restrict__ g, const float* __restrict__ bta, bf16_t* Hout,
                         float* yp, float* ys, int bid, int nb) {
    const int tid_ = tid_opaque(); const int lane = tid_ & 63, wave = tid_ >> 6;
    f32x4 gv[4], bv[4];
#pragma unroll
    for (int j = 0; j < 4; ++j) { gv[j] = *(const f32x4*)(g + j * 256 + lane * 4); bv[j] = *(const f32x4*)(bta + j * 256 + lane * 4); }
    for (int row = bid * 8 + wave; row < NT; row += nb * 8) {
        f32x4 v[4]; float s = 0.f;
#pragma unroll
        for (int j = 0; j < 4; ++j) { v[j] = *(const f32x4*)(X + (size_t)row * D + j * 256 + lane * 4); s += (v[j][0] + v[j][1]) + (v[j][2] + v[j][3]); }
        if (row >= 16384) {
#pragma unroll
            for (int j = 0; j < 4; ++j) *(f32x4*)(const_cast<float*>(X) + (size_t)row * D + j * 256 + lane * 4) = (f32x4){0.f, 0.f, 0.f, 0.f};
        }
        const float mean = wave_sum(s) * (1.f / D);
        float s2 = 0.f;
#pragma unroll
        for (int j = 0; j < 4; ++j) { v[j] = v[j] - mean; s2 += (v[j][0] * v[j][0] + v[j][1] * v[j][1]) + (v[j][2] * v[j][2] + v[j][3] * v[j][3]); }
        const float rstd = rsqrtf(wave_sum(s2) * (1.f / D) + 1e-5f);
        float* yo = nullptr;
        if (yp) {
            if (row < NPR) { const int b = row / LP, t = row % LP; if (t >= NMETA) yo = yp + ((size_t)b * SEQ + (t - NMETA)) * D; }
            else yo = ys + (size_t)(row - NPR) * D;
        }
#pragma unroll
        for (int j = 0; j < 4; ++j) {
            const f32x4 o = v[j] * rstd * gv[j] + bv[j];
            if (Hout) st_bf16x4(Hout + (size_t)row * D + j * 256 + lane * 4, o);
            if (yo) *(f32x4*)(yo + j * 256 + lane * 4) = o;
        }
    }
}

__device__ __forceinline__ void gdn_sample_pass(const Params& p, char* smem, int pass, int tid) {
    float* sq = (float*)smem;
    float* sk = sq + 256;
    float* part = sk + 256;
    float* part2 = part + 16;
    const int lane = tid & 63, wave = tid >> 6, ug = wave >> 2, wq = wave & 3;
    const int half = lane >> 5, v = wq * 32 + (lane & 31);
    const int u = pass * 2 + ug, b = u >> 4, h = u & 15, kh = h >> 1;
    const size_t row0 = (size_t)NPR + (size_t)b * DS;
    float S[64];
    {
        const float* Sp = p.state_gdn + ((size_t)(b * 16 + h) * 128 + half * 64) * 128 + v;
#pragma unroll
        for (int k = 0; k < 64; ++k) S[k] = Sp[(size_t)k * 128];
    }
    const float Aexp = __expf(p.gdn_a_log[h]);
    const float dtb = p.gdn_dt_bias[h];
    const float nw = p.gdn_norm_w[v];
    const int chA = (half ? 1024 : 0) + kh * 128 + v, chv = 2048 + h * 128 + v;
    float cA[4], cv[4];
#pragma unroll
    for (int j = 0; j < 4; ++j) { cA[j] = p.gdn_conv_w[j * 4096 + chA]; cv[j] = p.gdn_conv_w[j * 4096 + chv]; }
    float xA[7], xv[7];
#pragma unroll
    for (int i = 0; i < 3; ++i) {
        const float* cs = p.state_conv + ((size_t)b * 3 + i) * 4096;
        xA[i] = cs[chA]; xv[i] = cs[chv];
    }
#pragma unroll
    for (int i = 0; i < 4; ++i) {
        const bf16_t* mr = p.mixed + (row0 + i) * 4096;
        xA[3 + i] = bf2f(mr[chA]); xv[3 + i] = bf2f(mr[chv]);
    }
    float* sqg = sq + ug * 128;
    float* skg = sk + ug * 128;
    float* pg = part + ug * 8;
    float* pg2 = part2 + ug * 4;
    const float* kmine = skg + half * 64;
    const float* qmine = sqg + half * 64;
#pragma unroll
    for (int t = 0; t < DS; ++t) {
        const float yA = silu(xA[t] * cA[0] + xA[t + 1] * cA[1] + xA[t + 2] * cA[2] + xA[t + 3] * cA[3]);
        const float yv = silu(xv[t] * cv[0] + xv[t + 1] * cv[1] + xv[t + 2] * cv[2] + xv[t + 3] * cv[3]);
        (half ? skg : sqg)[v] = yA;
        float ssA = yA * yA;
#pragma unroll
        for (int o = 1; o < 32; o <<= 1) ssA += __shfl_xor(ssA, o);
        if ((lane & 31) == 0) pg[wq * 2 + half] = ssA;
        __syncthreads();
        const float qn = rsqrtf((pg[0] + pg[2]) + (pg[4] + pg[6]) + 1e-6f) * 0.08838834764831845f;
        const float kn = rsqrtf((pg[1] + pg[3]) + (pg[5] + pg[7]) + 1e-6f);
        const float* bap = p.ba + (row0 + t) * 32;
        const float beta = 1.f / (1.f + __expf(-bap[h]));
        const float aa = bap[16 + h] + dtb;
        const float sp = (aa > 20.f) ? aa : log1pf(__expf(aa));
        const float dec = __expf(-Aexp * sp);
        float kS0 = 0.f, kS1 = 0.f;
#pragma unroll
        for (int k = 0; k < 64; k += 4) {
            const f32x4 kk = *(const f32x4*)(kmine + k);
            S[k] *= dec; S[k + 1] *= dec; S[k + 2] *= dec; S[k + 3] *= dec;
            kS0 += kk[0] * S[k]; kS1 += kk[1] * S[k + 1]; kS0 += kk[2] * S[k + 2]; kS1 += kk[3] * S[k + 3];
        }
        float kS = kS0 + kS1;
        kS += __shfl_xor(kS, 32);
        const float delta = (yv - kS * kn) * beta * kn;
        float o0 = 0.f, o1 = 0.f;
#pragma unroll
        for (int k = 0; k < 64; k += 4) {
            const f32x4 kk = *(const f32x4*)(kmine + k);
            const f32x4 qq = *(const f32x4*)(qmine + k);
            S[k] += kk[0] * delta; S[k + 1] += kk[1] * delta; S[k + 2] += kk[2] * delta; S[k + 3] += kk[3] * delta;
            o0 += qq[0] * S[k]; o1 += qq[1] * S[k + 1]; o0 += qq[2] * S[k + 2]; o1 += qq[3] * S[k + 3];
        }
        float o = o0 + o1;
        o = (o + __shfl_xor(o, 32)) * qn;
        float s3 = o * o;
#pragma unroll
        for (int x = 1; x < 32; x <<= 1) s3 += __shfl_xor(s3, x);
        if (lane == 0) pg2[wq] = s3;
        __syncthreads();
        if (half == 0) {
            const float rms = rsqrtf(((pg2[0] + pg2[1]) + (pg2[2] + pg2[3])) * (1.f / 128.f) + 1e-6f);
            const float zz = bf2f(p.z[(row0 + t) * 2048 + h * 128 + v]);
            p.gated[(row0 + t) * 2048 + h * 128 + v] = f2bf(o * rms * nw * silu(zz));
        }
    }
    {
        float* So = p.gs_sample + ((size_t)(b * 16 + h) * 128 + half * 64) * 128 + v;
#pragma unroll
        for (int k = 0; k < 64; ++k) So[(size_t)k * 128] = S[k];
    }
    __syncthreads();
}

#define MFMA32(a, b, c) __builtin_amdgcn_mfma_f32_32x32x16_bf16((a), (b), (c), 0, 0, 0)
constexpr int NCH = 65;
constexpr int NCU = BATCH * 16 * NCH;
__device__ __forceinline__ int crow(int reg, int hh) { return (reg & 3) + 8 * (reg >> 2) + 4 * hh; }
__device__ __forceinline__ bf16x8 pack_step(const f32x16& x, int s) {
    u32x4 q;
    q[0] = pk2(x[8 * s + 0], x[8 * s + 1]); q[1] = pk2(x[8 * s + 2], x[8 * s + 3]);
    q[2] = pk2(x[8 * s + 4], x[8 * s + 5]); q[3] = pk2(x[8 * s + 6], x[8 * s + 7]);
    return __builtin_bit_cast(bf16x8, q);
}
__device__ __forceinline__ bf16x8 frag_perm(const bf16_t* p0) {
    const uint2 lo = *(const uint2*)p0, hi = *(const uint2*)(p0 + 8);
    u32x4 q; q[0] = lo.x; q[1] = lo.y; q[2] = hi.x; q[3] = hi.y;
    return __builtin_bit_cast(bf16x8, q);
}

__device__ __forceinline__ void gdn_stageA(const Params& p, char* smem0, int bid, int nb) {
    const int tid = tid_opaque(), lane = tid & 63, wave = tid >> 6;
    for (int idx = bid * NTHR + tid; idx < (BATCH + DB) * 3 * 4096; idx += nb * NTHR) {
        const int c = idx & 4095, r = (idx >> 12) % 3, b = idx / (3 * 4096);
        if (b < BATCH) p.gc_prompt[idx] = bf2f(p.mixed[((size_t)b * LP + (LP - 3) + r) * 4096 + c]);
        else { const int bs = b - BATCH; p.gc_sample[(size_t)(bs * 3 + r) * 4096 + c] = bf2f(p.mixed[((size_t)NPR + bs * 4 + 1 + r) * 4096 + c]); }
    }
    for (int u = bid; u < NCU; u += nb) {
        unsigned zofs = 0; asm volatile("" : "+v"(zofs));
        char* smem = smem0 + zofs;
        bf16_t* Qb = (bf16_t*)smem;
        bf16_t* Kb = Qb + 64 * 136;
        float* RHS = (float*)(Kb + 64 * 136);
        float* Am = RHS + 64 * 256;
        float* sbeta = Am + 64 * 68;
        float* sgc = sbeta + 64;
        float* segc = sgc + 64;
        float* sekd = segc + 64;
        float* srk = sekd + 64;
        const int h = u & 15, n = (u >> 4) % NCH, b = u / (16 * NCH);
        const int kh = h >> 1;
        const size_t su = (size_t)((b * 16 + h) * NCH + n);
        const int t0 = n * 64;
        if (wave < 6) {
            const int part = wave >> 1, half = wave & 1;
            const int cq = lane & 31, tsub = lane >> 5;
            const int tl0 = 32 * half + 16 * tsub;
            const int chb = ((part == 0) ? (kh * 128) : (part == 1) ? (1024 + kh * 128) : (2048 + h * 128)) + cq * 4;
            f32x4 cw[4];
#pragma unroll
            for (int j = 0; j < 4; ++j) cw[j] = *(const f32x4*)(p.gdn_conv_w + j * 4096 + chb);
            uint2 xr[19];
#pragma unroll
            for (int i = 0; i < 19; ++i) {
                const int t = t0 + tl0 - 3 + i;
                if (t >= 0 && t < LP) xr[i] = *(const uint2*)(p.mixed + ((size_t)b * LP + t) * 4096 + chb);
                else xr[i] = make_uint2(0u, 0u);
            }
#pragma unroll
            for (int i = 0; i < 16; ++i) {
                const f32x4 a = cvt_bf16x4(xr[i]) * cw[0] + cvt_bf16x4(xr[i + 1]) * cw[1] + cvt_bf16x4(xr[i + 2]) * cw[2] + cvt_bf16x4(xr[i + 3]) * cw[3];
                const bool valid = (t0 + tl0 + i) < LP;
                f32x4 y;
#pragma unroll
                for (int e2 = 0; e2 < 4; ++e2) y[e2] = valid ? silu(a[e2]) : 0.f;
                const int c = tl0 + i;
                if (part < 2) {
                    float ss = (y[0] * y[0] + y[1] * y[1]) + (y[2] * y[2] + y[3] * y[3]);
#pragma unroll
                    for (int o = 1; o < 32; o <<= 1) ss += __shfl_xor(ss, o);
                    const float nrm = rsqrtf(ss + 1e-6f) * ((part == 0) ? 0.08838834764831845f : 1.f);
                    y = y * nrm;
                    if (part == 0) st_bf16x4(Qb + c * 136 + cq * 4, y);
                    else { st_bf16x4(Kb + c * 136 + cq * 4, y); *(f32x4*)(RHS + c * 256 + 128 + cq * 4) = y; }
                } else {
                    *(f32x4*)(RHS + c * 256 + cq * 4) = y;
                }
            }
        } else if (wave == 6) {
            const int c = lane, t = t0 + c;
            float beta = 0.f, g = 0.f;
            if (t < LP) {
                const float* bap = p.ba + ((size_t)b * LP + t) * 32;
                beta = 1.f / (1.f + __expf(-bap[h]));
                const float aa = bap[16 + h] + p.gdn_dt_bias[h];
                const float sp = (aa > 20.f) ? aa : log1pf(__expf(aa));
                g = -__expf(p.gdn_a_log[h]) * sp;
            }
            float gc = g;
#pragma unroll
            for (int o = 1; o < 64; o <<= 1) { const float v = __shfl_up(gc, o); if (lane >= o) gc += v; }
            const float glast = __shfl(gc, 63);
            sbeta[c] = beta; sgc[c] = gc; segc[c] = __expf(gc); sekd[c] = __expf(glast - gc); srk[c] = beta * __expf(gc);
            if (lane == 0) p.g_dec[su] = __expf(glast);
        }
        __syncthreads();
        {
            const int which = wave >> 2, ti = (wave >> 1) & 1, tj = wave & 1;
            const int r = lane & 31, hh = lane >> 5;
            f32x16 acc;
#pragma unroll
            for (int i = 0; i < 16; ++i) acc[i] = 0.f;
            const bf16_t* Ap = Kb + (32 * ti + r) * 136 + 8 * hh;
            const bf16_t* Bp = (which ? Qb : Kb) + (32 * tj + r) * 136 + 8 * hh;
#pragma unroll
            for (int ks = 0; ks < 8; ++ks) acc = MFMA32(*(const bf16x8*)(Ap + 16 * ks), *(const bf16x8*)(Bp + 16 * ks), acc);
            const int c = 32 * tj + r;
            const float gcc = sgc[c], bc = sbeta[c];
            if (which == 0) {
#pragma unroll
                for (int reg = 0; reg < 16; ++reg) {
                    const int cp = 32 * ti + crow(reg, hh);
                    const float dcy = __expf(fminf(gcc - sgc[cp], 0.f));
                    Am[c * 68 + cp] = (cp < c) ? (bc * acc[reg] * dcy) : 0.f;
                }
            } else {
                bf16_t* aq = p.g_aqk + su * 4096 + (size_t)c * 64;
#pragma unroll
                for (int g4 = 0; g4 < 4; ++g4) {
                    const int cp0 = 32 * ti + 8 * g4 + 4 * hh;
                    f32x4 v;
#pragma unroll
                    for (int e2 = 0; e2 < 4; ++e2) {
                        const int cp = cp0 + e2;
                        const float dcy = __expf(fminf(gcc - sgc[cp], 0.f));
                        v[e2] = (cp <= c) ? (acc[4 * g4 + e2] * dcy) : 0.f;
                    }
                    st_bf16x4(aq + cp0, v);
                }
            }
        }
        __syncthreads();
        if (wave < 4) {
            const int col = 64 * wave + lane;
            const float* rs = sbeta + __builtin_amdgcn_readfirstlane((wave < 2) ? 0 : 256);
            float x[64];
#pragma unroll
            for (int i = 0; i < 64; ++i) x[i] = RHS[i * 256 + col] * rs[i];
#pragma unroll
            for (int i = 1; i < 64; ++i) {
                float a0 = x[i], a1 = 0.f;
#pragma unroll
                for (int j4 = 0; j4 < i; j4 += 4) {
                    const f32x4 a = *(const f32x4*)(Am + i * 68 + j4);
                    a0 -= a[0] * x[j4]; a1 -= a[1] * x[j4 + 1]; a0 -= a[2] * x[j4 + 2]; a1 -= a[3] * x[j4 + 3];
                }
                x[i] = a0 + a1;
                asm volatile("" ::: "memory");
            }
            if (wave < 2) {
                float* up = p.g_u + su * 8192 + col;
#pragma unroll
                for (int i = 0; i < 64; ++i) up[i * 128] = x[i];
            } else {
                bf16_t* wp = p.g_negw + su * 8192 + (col - 128);
#pragma unroll
                for (int i = 0; i < 64; ++i) wp[i * 128] = f2bf(-x[i]);
            }
        } else {
            const int t2 = tid - 256;
#pragma unroll
            for (int it = 0; it < 4; ++it) {
                const int chk = t2 + 256 * it, c = chk >> 4, d0 = (chk & 15) * 8;
                const float e = segc[c];
                const uint4 raw = *(const uint4*)(Qb + c * 136 + d0);
                uint4 o;
                o.x = pk2(__uint_as_float(raw.x << 16) * e, __uint_as_float(raw.x & 0xffff0000u) * e);
                o.y = pk2(__uint_as_float(raw.y << 16) * e, __uint_as_float(raw.y & 0xffff0000u) * e);
                o.z = pk2(__uint_as_float(raw.z << 16) * e, __uint_as_float(raw.z & 0xffff0000u) * e);
                o.w = pk2(__uint_as_float(raw.w << 16) * e, __uint_as_float(raw.w & 0xffff0000u) * e);
                *(uint4*)(p.g_qg + su * 8192 + c * 128 + d0) = o;
            }
#pragma unroll
            for (int it = 0; it < 4; ++it) {
                const int item = t2 + 256 * it, d = item & 127, c0 = (item >> 7) * 8;
                float v[8];
#pragma unroll
                for (int i = 0; i < 8; ++i) v[i] = bf2f(Kb[(c0 + i) * 136 + d]) * sekd[c0 + i];
                uint4 o; o.x = pk2(v[0], v[1]); o.y = pk2(v[2], v[3]); o.z = pk2(v[4], v[5]); o.w = pk2(v[6], v[7]);
                *(uint4*)(p.g_kdT + su * 8192 + d * 64 + c0) = o;
            }
        }
        __syncthreads();
    }
}

constexpr int GB_NW = 0, GB_QG = 64 * 136, GB_KD = 2 * 64 * 136, GB_AQ = 2 * 64 * 136 + 128 * 72, GB_ELEMS = 2 * 64 * 136 + 128 * 72 + 64 * 72;
__device__ __forceinline__ void gdn_chain(const Params& p, char* smem, int b, int h) {
    bf16_t* lds = (bf16_t*)smem;
    const int tid = tid_opaque(), lane = tid & 63, wave = tid >> 6;
    const int r = lane & 31, hh = lane >> 5;
    const size_t su0 = (size_t)(b * 16 + h) * NCH;
    const bool loader = wave >= 4;
    const int t2 = tid - 256;
    uint4 sa0, sa1, sa2, sa3, sa4, sa5, sa6, sa7, sa8, sa9, sa10, sa11, sa12, sa13;
    uint4 sb0, sb1, sb2, sb3, sb4, sb5, sb6, sb7, sb8, sb9, sb10, sb11, sb12, sb13;
    f32x16 S[4], un0, un1;
#pragma unroll
    for (int i = 0; i < 4; ++i)
#pragma unroll
        for (int j = 0; j < 16; ++j) S[i][j] = 0.f;
    const int ch0 = t2, ch1 = t2 + 256, ch2 = t2 + 512, ch3 = t2 + 768;
#define GB_GLOAD(P, n_) do { const size_t su_ = su0 + (n_); \
        const bf16_t* a_ = p.g_negw + su_ * 8192; const bf16_t* b_ = p.g_qg + su_ * 8192; const bf16_t* c_ = p.g_kdT + su_ * 8192; const bf16_t* d_ = p.g_aqk + su_ * 4096; \
        P##0 = *(const uint4*)(a_ + (size_t)ch0 * 8); P##1 = *(const uint4*)(a_ + (size_t)ch1 * 8); P##2 = *(const uint4*)(a_ + (size_t)ch2 * 8); P##3 = *(const uint4*)(a_ + (size_t)ch3 * 8); \
        P##4 = *(const uint4*)(b_ + (size_t)ch0 * 8); P##5 = *(const uint4*)(b_ + (size_t)ch1 * 8); P##6 = *(const uint4*)(b_ + (size_t)ch2 * 8); P##7 = *(const uint4*)(b_ + (size_t)ch3 * 8); \
        P##8 = *(const uint4*)(c_ + (size_t)ch0 * 8); P##9 = *(const uint4*)(c_ + (size_t)ch1 * 8); P##10 = *(const uint4*)(c_ + (size_t)ch2 * 8); P##11 = *(const uint4*)(c_ + (size_t)ch3 * 8); \
        P##12 = *(const uint4*)(d_ + (size_t)ch0 * 8); P##13 = *(const uint4*)(d_ + (size_t)ch1 * 8); } while (0)
#define GB_SSTORE(P, buf_) do { bf16_t* q_ = (buf_); \
        *(uint4*)(q_ + GB_NW + (ch0 >> 4) * 136 + (ch0 & 15) * 8) = P##0; *(uint4*)(q_ + GB_NW + (ch1 >> 4) * 136 + (ch1 & 15) * 8) = P##1; \
        *(uint4*)(q_ + GB_NW + (ch2 >> 4) * 136 + (ch2 & 15) * 8) = P##2; *(uint4*)(q_ + GB_NW + (ch3 >> 4) * 136 + (ch3 & 15) * 8) = P##3; \
        *(uint4*)(q_ + GB_QG + (ch0 >> 4) * 136 + (ch0 & 15) * 8) = P##4; *(uint4*)(q_ + GB_QG + (ch1 >> 4) * 136 + (ch1 & 15) * 8) = P##5; \
        *(uint4*)(q_ + GB_QG + (ch2 >> 4) * 136 + (ch2 & 15) * 8) = P##6; *(uint4*)(q_ + GB_QG + (ch3 >> 4) * 136 + (ch3 & 15) * 8) = P##7; \
        *(uint4*)(q_ + GB_KD + (ch0 >> 3) * 72 + (ch0 & 7) * 8) = P##8; *(uint4*)(q_ + GB_KD + (ch1 >> 3) * 72 + (ch1 & 7) * 8) = P##9; \
        *(uint4*)(q_ + GB_KD + (ch2 >> 3) * 72 + (ch2 & 7) * 8) = P##10; *(uint4*)(q_ + GB_KD + (ch3 >> 3) * 72 + (ch3 & 7) * 8) = P##11; \
        *(uint4*)(q_ + GB_AQ + (ch0 >> 3) * 72 + (ch0 & 7) * 8) = P##12; *(uint4*)(q_ + GB_AQ + (ch1 >> 3) * 72 + (ch1 & 7) * 8) = P##13; } while (0)
#define GB_ULOAD(n_) do { const float* up_ = p.g_u + (su0 + (n_)) * 8192 + 32 * wave + r; \
        _Pragma("unroll") for (int reg_ = 0; reg_ < 16; ++reg_) { un0[reg_] = up_[(crow(reg_, hh)) * 128]; un1[reg_] = up_[(32 + crow(reg_, hh)) * 128]; } } while (0)
    if (loader) {
        bf16_t* buf0 = lds;
        bf16_t* buf1 = lds + GB_ELEMS;
        GB_GLOAD(sa, 0); GB_SSTORE(sa, buf0);
        GB_GLOAD(sa, 1);
        __syncthreads();
        for (int n = 0; n < NCH; n += 2) {
            if (n + 2 < NCH) { GB_GLOAD(sb, n + 2); }
            if (n + 1 < NCH) { GB_SSTORE(sa, buf1); }
            __syncthreads();
            if (n + 1 >= NCH) break;
            if (n + 3 < NCH) { GB_GLOAD(sa, n + 3); }
            if (n + 2 < NCH) { GB_SSTORE(sb, buf0); }
            __syncthreads();
        }
    } else {
        GB_ULOAD(0);
        float dec_next = p.g_dec[su0];
        __syncthreads();
        for (int n = 0; n < NCH; ++n) {
            unsigned zofs = 0; asm volatile("" : "+v"(zofs));
            bf16_t* cur = lds + (n & 1) * GB_ELEMS + zofs;
            const bool more = (n + 1 < NCH);
            const float dec = dec_next;
            if (more) dec_next = p.g_dec[su0 + n + 1];
            f32x16 vn[2], o[2];
            vn[0] = un0; vn[1] = un1;
#pragma unroll
            for (int j = 0; j < 16; ++j) { o[0][j] = 0.f; o[1][j] = 0.f; }
            if (more) { GB_ULOAD(n + 1); }
#pragma unroll
            for (int kt = 0; kt < 4; ++kt)
#pragma unroll
                for (int s = 0; s < 2; ++s) {
                    const bf16x8 sb = pack_step(S[kt], s);
                    const int k0 = 32 * kt + 16 * s + 4 * hh;
#pragma unroll
                    for (int ct = 0; ct < 2; ++ct) {
                        vn[ct] = MFMA32(frag_perm(cur + GB_NW + (32 * ct + r) * 136 + k0), sb, vn[ct]);
                        o[ct] = MFMA32(frag_perm(cur + GB_QG + (32 * ct + r) * 136 + k0), sb, o[ct]);
                    }
                }
            bf16x8 vb[2][2];
#pragma unroll
            for (int ct = 0; ct < 2; ++ct)
#pragma unroll
                for (int s = 0; s < 2; ++s) vb[ct][s] = pack_step(vn[ct], s);
#pragma unroll
            for (int s = 0; s < 2; ++s) {
                o[0] = MFMA32(frag_perm(cur + GB_AQ + (r) * 72 + 16 * s + 4 * hh), vb[0][s], o[0]);
                o[1] = MFMA32(frag_perm(cur + GB_AQ + (32 + r) * 72 + 16 * s + 4 * hh), vb[0][s], o[1]);
                o[1] = MFMA32(frag_perm(cur + GB_AQ + (32 + r) * 72 + 32 + 16 * s + 4 * hh), vb[1][s], o[1]);
            }
#pragma unroll
            for (int dt = 0; dt < 4; ++dt) {
                S[dt] = S[dt] * dec;
#pragma unroll
                for (int ckt = 0; ckt < 2; ++ckt)
#pragma unroll
                    for (int s = 0; s < 2; ++s)
                        S[dt] = MFMA32(frag_perm(cur + GB_KD + (32 * dt + r) * 72 + 32 * ckt + 16 * s + 4 * hh), vb[ckt][s], S[dt]);
            }
#pragma unroll
            for (int ct = 0; ct < 2; ++ct)
#pragma unroll
                for (int reg = 0; reg < 16; ++reg) {
                    const int t = 64 * n + 32 * ct + crow(reg, hh);
                    if (t < LP) p.g_o[(((size_t)b * LP + t) * 16 + h) * 128 + 32 * wave + r] = o[ct][reg];
                }
            __syncthreads();
        }
    }
    if (!loader) {
#pragma unroll
        for (int dt = 0; dt < 4; ++dt)
#pragma unroll
            for (int reg = 0; reg < 16; ++reg)
                p.gs_prompt[((size_t)(b * 16 + h) * 128 + 32 * dt + crow(reg, hh)) * 128 + 32 * wave + r] = S[dt][reg];
    }
    __syncthreads();
}

__device__ __forceinline__ void gdn_seq_phase(const Params& p, char* smem, int bid, int nb, int rep = 0) {
    if (bid < 64) gdn_chain(p, smem, bid >> 4, bid & 15);
    int* slot = (int*)(smem + LDS_BYTES - 32);
    const int tid = tid_opaque();
    for (;;) {
        if (threadIdx.x == 0) *slot = (int)atomicAdd(p.bar + 3520 + 16 * rep, 1u);
        __syncthreads();
        const int u = *slot;
        __syncthreads();
        if (u >= DB * 16 / 2) break;
        gdn_sample_pass(p, smem, u, tid_opaque());
    }
}

__device__ __forceinline__ void gdn_gate_phase(const Params& p, int bid, int nb) {
    const int tid_ = tid_opaque(); const int lane = tid_ & 63, wave = tid_ >> 6;
    const f32x2 nw = *(const f32x2*)(p.gdn_norm_w + lane * 2);
    for (int it = bid * 8 + wave; it < NPR * 16; it += nb * 8) {
        const f32x2 o = *(const f32x2*)(p.g_o + (size_t)it * 128 + lane * 2);
        const float ss = wave_sum(o[0] * o[0] + o[1] * o[1]);
        const float rms = rsqrtf(ss * (1.f / 128.f) + 1e-6f);
        const unsigned zr = *(const unsigned*)(p.z + (size_t)it * 128 + lane * 2);
        const float z0 = __uint_as_float(zr << 16), z1 = __uint_as_float(zr & 0xffff0000u);
        *(unsigned*)(p.gated + (size_t)it * 128 + lane * 2) = pk2(o[0] * rms * nw[0] * silu(z0), o[1] * rms * nw[1] * silu(z1));
    }
}

__device__ __forceinline__ void rope_cs(int pos, int fi, float& c, float& s) {
    const double rev = (double)pos * kInvFreq[fi] * 0.15915494309189535;
    const float r = (float)(rev - floor(rev));
    c = __builtin_amdgcn_cosf(r);
    s = __builtin_amdgcn_sinf(r);
}
__device__ __forceinline__ void dsa_post_phase(const Params& p, int bid, int nb) {
    const int tid_ = tid_opaque(); const int lane = tid_ & 63, wave = tid_ >> 6;
    for (int row = bid * 8 + wave; row < NT; row += nb * 8) {
        const float* P = p.p1 + (size_t)row * DIN_PAD;
        const bool prompt = row < NPR;
        const int pos = prompt ? (row % LP) : (PAST + ((row - NPR) & 3));
        float* kout = prompt ? (p.k_prompt + (size_t)row * 256) : (p.k_sample + (size_t)(row - NPR) * 256);
        float* vout = prompt ? (p.v_prompt + (size_t)row * 256) : (p.v_sample + (size_t)(row - NPR) * 256);
        for (int e = lane; e < 1280; e += 64) {
            const int d = e & 127;
            float o = P[e];
            if (d < 32) {
                float c, s; rope_cs(pos, d & 15, c, s);
                if (d < 16) o = o * c - P[e + 16] * s; else o = o * c + P[e - 16] * s;
            }
            if (e < 1024) {
                p.qr[(size_t)row * 1024 + e] = o;
                if (prompt) p.q_b[(size_t)row * 1024 + e] = f2bf(o * 0.12751743f);
            } else {
                kout[e - 1024] = o;
                if (prompt) { const int bb = row / LP, kvh = (e - 1024) >> 7; p.k_b[((size_t)(bb * 2 + kvh) * LPAD + pos) * 128 + d] = f2bf(o); }
            }
        }
        for (int e = lane; e < 256; e += 64) {
            const float o = P[1280 + e];
            vout[e] = o;
            if (prompt) { const int bb = row / LP, kvh = e >> 7, d = e & 127; p.vt_b[((size_t)(bb * 2 + kvh) * 128 + d) * LPAD + pos] = f2bf(o); }
        }
        for (int e = lane; e < 512; e += 64) {
            const int d = e & 63;
            float o = P[1536 + e];
            if (d < 16) {
                float c, s; rope_cs(pos, (d & 7) * 2, c, s);
                if (d < 8) o = o * c - P[1536 + e + 8] * s; else o = o * c + P[1536 + e - 8] * s;
            }
            p.iq[(size_t)row * 512 + e] = o;
            if (prompt) p.iq_b[(size_t)row * 512 + e] = f2bf(o);
        }
        {
            const float x = P[2048 + lane];
            const float mu = wave_sum(x) * (1.f / 64.f);
            const float dv = x - mu;
            const float var = wave_sum(dv * dv) * (1.f / 64.f);
            const float xn = dv * rsqrtf(var + 1e-5f) * p.dsa_ik_g[lane] + p.dsa_ik_b[lane];
            const float other = __shfl_xor(xn, 8);
            float o = xn;
            if (lane < 16) {
                float c, s; rope_cs(pos, (lane & 7) * 2, c, s);
                if (lane < 8) o = xn * c - other * s; else o = xn * c + other * s;
            }
            float* io = prompt ? (p.ik_prompt + (size_t)row * 64) : (p.ik_sample + (size_t)(row - NPR) * 64);
            io[lane] = o;
            if (prompt) p.ik_b[((size_t)(row / LP) * LPAD + pos) * 64 + lane] = f2bf(o);
        }
        if (lane < 8) p.iw[(size_t)row * 8 + lane] = P[2112 + lane] * 0.35355339059327373f;
    }
    for (int idx = bid * NTHR + tid_opaque(); idx < BATCH * (LPAD - LP) * 256; idx += nb * NTHR) {
        const int c = idx & 255, tp = (idx >> 8) % (LPAD - LP), bb = idx / ((LPAD - LP) * 256);
        const int t = LP + tp, kvh = c >> 7, d = c & 127;
        p.k_b[((size_t)(bb * 2 + kvh) * LPAD + t) * 128 + d] = 0;
        p.vt_b[((size_t)(bb * 2 + kvh) * 128 + d) * LPAD + t] = 0;
        if (c < 64) p.ik_b[((size_t)bb * LPAD + t) * 64 + c] = 0;
        if (c < 65) p.maskT[((size_t)bb * 65 + c) * LPAD + t] = (c == 0) ? 1ull : 0ull;
    }
}

__device__ __forceinline__ const float* ik_row(const Params& p, bool prompt, int b, int s) {
    if (prompt) return p.ik_prompt + ((size_t)b * LP + s) * 64;
    if (s < PAST) { const int pg = p.page_table[b * 16 + (s >> 7)]; return p.cache_ik + ((size_t)pg * 128 + (s & 127)) * 64; }
    return p.ik_sample + ((size_t)b * DS + (s - PAST)) * 64;
}
__device__ __forceinline__ const float* kv_row(const float* own_p, const float* own_s, const float* cache, const int* page_table,
                                               bool prompt, int b, int s) {
    if (prompt) return own_p + ((size_t)b * LP + s) * 256;
    if (s < PAST) { const int pg = page_table[b * 16 + (s >> 7)]; return cache + ((size_t)pg * 128 + (s & 127)) * 256; }
    return own_s + ((size_t)b * DS + (s - PAST)) * 256;
}

template <bool PROMPT>
__device__ __forceinline__ void select_emit(const float* sc, int qpos, int lane, unsigned long long* maskcol, int* selrow) {
    const unsigned long long ltmask = (1ull << lane) - 1ull;
    unsigned key[65];
#pragma unroll
    for (int j = 0; j < 65; ++j) {
        const int s = j * 64 + lane;
        const float x = (s >= 16 && s <= qpos) ? sc[s] : -INFINITY;
        const unsigned u = __float_as_uint(x);
        key[j] = (u & 0x80000000u) ? ~u : (u | 0x80000000u);
    }
    unsigned T = 0u;
    bool exact = false;
    for (int bit = 31; bit >= 0; --bit) {
        const unsigned cand = T | (1u << bit);
        int c = 0;
#pragma unroll
        for (int j = 0; j < 65; ++j) c += __popcll(__ballot(key[j] >= cand));
        if (c >= 240) { T = cand; if (c == 240) { exact = true; break; } }
    }
    int need_eq = 0;
    if (!exact) {
        int cgt = 0;
#pragma unroll
        for (int j = 0; j < 65; ++j) cgt += __popcll(__ballot(key[j] > T));
        need_eq = 240 - cgt;
    }
    if (!PROMPT) { if (lane < 16) selrow[lane] = lane; }
    int base = 16, erun = 0;
    unsigned long long myword = 0ull, word64 = 0ull;
#pragma unroll
    for (int j = 0; j < 65; ++j) {
        const bool gt = exact ? (key[j] >= T) : (key[j] > T);
        const bool eq = exact ? false : (key[j] == T);
        const unsigned long long meq = __ballot(eq);
        const int rank = erun + __popcll(meq & ltmask);
        const bool take = gt || (eq && rank < need_eq);
        unsigned long long m = __ballot(take);
        if (PROMPT) {
            if (j == 0) m |= 0xFFFFull;
            if (j < 64) { if (lane == j) myword = m; } else word64 = m;
        } else {
            if (take) selrow[base + __popcll(m & ltmask)] = j * 64 + lane;
            base += __popcll(m);
        }
        erun += __popcll(meq);
    }
    if (PROMPT) {
        maskcol[(size_t)lane * LPAD] = myword;
        if (lane == 0) maskcol[(size_t)64 * LPAD] = word64;
    }
}

__device__ __forceinline__ void indexer_sample_row(const Params& p, float* sc, float* qs, int row, int lane) {
    const int b = (row - NPR) >> 2, qpos = PAST + ((row - NPR) & 3);
    int* selrow = p.sel + (size_t)row * 256;
    const int n = qpos - 15;
    for (int j = lane; j < 512; j += 64) qs[j] = p.iq[(size_t)row * 512 + j];
    float w[8];
#pragma unroll
    for (int h = 0; h < 8; ++h) w[h] = p.iw[(size_t)row * 8 + h];
    lds_fence();
    for (int j0 = 0; j0 < n; j0 += 64) {
        const int s = 16 + j0 + lane;
        const bool valid = s <= qpos;
        const float* kp = ik_row(p, false, b, valid ? s : qpos);
        float dh[8];
#pragma unroll
        for (int h = 0; h < 8; ++h) dh[h] = 0.f;
#pragma unroll
        for (int half = 0; half < 2; ++half) {
            f32x4 kv[8];
#pragma unroll
            for (int c = 0; c < 8; ++c) kv[c] = *(const f32x4*)(kp + half * 32 + c * 4);
#pragma unroll
            for (int h = 0; h < 8; ++h) {
                float d = dh[h];
#pragma unroll
                for (int c = 0; c < 8; ++c) {
                    const f32x4 q4 = *(const f32x4*)(qs + h * 64 + half * 32 + c * 4);
                    d += kv[c][0] * q4[0]; d += kv[c][1] * q4[1]; d += kv[c][2] * q4[2]; d += kv[c][3] * q4[3];
                }
                dh[h] = d;
            }
        }
        float score = 0.f;
#pragma unroll
        for (int h = 0; h < 8; ++h) score += w[h] * fmaxf(dh[h], 0.f);
        if (valid) sc[s] = score;
    }
    lds_fence();
    select_emit<false>(sc, qpos, lane, nullptr, selrow);
    lds_fence();
}

__device__ __forceinline__ void indexer_prompt_unit(const Params& p, float* sc, int b, int g8, int tid) {
    const int lane = tid & 63, wave = tid >> 6;
    const int r = lane & 31, hh = lane >> 5;
    const int t0 = g8 * 8;
    if (t0 < 256) {
        const int qpos = t0 + wave;
        unsigned long long* maskcol = p.maskT + (size_t)b * 65 * LPAD + qpos;
        for (int j = lane; j < 65; j += 64) {
            const int lo = j * 64;
            unsigned long long m = 0ull;
            if (qpos >= lo + 63) m = ~0ull; else if (qpos >= lo) m = (1ull << (qpos - lo + 1)) - 1ull;
            maskcol[(size_t)j * LPAD] = m;
        }
        return;
    }
    bf16x8 af[2][4];
    {
        const int e2 = r & 3, hb = (r >> 2) & 1, a = r >> 3;
        const int qi = 2 * hb + (a >> 1), head = 4 * (a & 1) + e2;
#pragma unroll
        for (int rt = 0; rt < 2; ++rt) {
            const bf16_t* ap = p.iq_b + ((size_t)b * LP + t0 + 4 * rt + qi) * 512 + head * 64 + 8 * hh;
#pragma unroll
            for (int ks = 0; ks < 4; ++ks) af[rt][ks] = *(const bf16x8*)(ap + 16 * ks);
        }
    }
    float wq[2][2][8];
#pragma unroll
    for (int rt = 0; rt < 2; ++rt)
#pragma unroll
        for (int ql = 0; ql < 2; ++ql) {
            const float* wp = p.iw + ((size_t)b * LP + t0 + 4 * rt + 2 * hh + ql) * 8;
            const f32x4 w0 = *(const f32x4*)wp, w1 = *(const f32x4*)(wp + 4);
#pragma unroll
            for (int e2 = 0; e2 < 4; ++e2) { wq[rt][ql][e2] = w0[e2]; wq[rt][ql][4 + e2] = w1[e2]; }
        }
    const int nkt = (t0 + 7) / 32 + 1;
    const bf16_t* kbase = p.ik_b + ((size_t)b * LPAD + r) * 64 + 8 * hh;
    bf16x8 bq[4];
    if (wave < nkt) {
#pragma unroll
        for (int ks = 0; ks < 4; ++ks) bq[ks] = *(const bf16x8*)(kbase + (size_t)wave * 32 * 64 + 16 * ks);
    }
    for (int kt = wave; kt < nkt; kt += 8) {
        bf16x8 bn[4];
        const int ktn = (kt + 8 < nkt) ? (kt + 8) : kt;
#pragma unroll
        for (int ks = 0; ks < 4; ++ks) bn[ks] = *(const bf16x8*)(kbase + (size_t)ktn * 32 * 64 + 16 * ks);
#pragma unroll
        for (int rt = 0; rt < 2; ++rt) {
            f32x16 acc;
#pragma unroll
            for (int i = 0; i < 16; ++i) acc[i] = 0.f;
#pragma unroll
            for (int ks = 0; ks < 4; ++ks) acc = MFMA32(af[rt][ks], bq[ks], acc);
#pragma unroll
            for (int ql = 0; ql < 2; ++ql) {
                float s = 0.f;
#pragma unroll
                for (int a2 = 0; a2 < 2; ++a2)
#pragma unroll
                    for (int e2 = 0; e2 < 4; ++e2) s += wq[rt][ql][4 * a2 + e2] * fmaxf(acc[4 * (2 * ql + a2) + e2], 0.f);
                sc[(4 * rt + 2 * hh + ql) * 4160 + 32 * kt + r] = s;
            }
        }
#pragma unroll
        for (int ks = 0; ks < 4; ++ks) bq[ks] = bn[ks];
    }
    __syncthreads();
    {
        const int qpos = t0 + wave;
        select_emit<true>(sc + wave * 4160, qpos, lane, p.maskT + (size_t)b * 65 * LPAD + qpos, nullptr);
    }
    __syncthreads();
}

__device__ __forceinline__ void indexer_phase(const Params& p, char* smem, int bid, int nb, int rep = 0) {
    int* slot = (int*)(smem + LDS_BYTES - 32);
    for (;;) {
        const int tid = tid_opaque();
        unsigned zofs = 0; asm volatile("" : "+v"(zofs));
        float* sc = (float*)(smem + zofs);
        if (threadIdx.x == 0) *slot = (int)atomicAdd(p.bar + 3648 + 16 * rep, 1u);
        __syncthreads();
        const int u = *slot;
        __syncthreads();
        if (u >= 64 + BATCH * 514) break;
        if (u < 64) {
            const int wave = tid >> 6;
            indexer_sample_row(p, sc + wave * 4160, sc + 8 * 4160 + wave * 512, NPR + u * 8 + wave, tid & 63);
            __syncthreads();
        } else {
            const int v = u - 64;
            indexer_prompt_unit(p, sc, v & 3, 513 - (v >> 2), tid);
        }
    }
}

__device__ __forceinline__ void attn_sample_query(const Params& p, char* smem, int row) {
    float* qs = (float*)smem;
    float* ps = qs + 1024;
    int* sidx = (int*)(ps + 2048);
    const int tid = tid_opaque(), lane = tid & 63, wave = tid >> 6;
    const bool prompt = false;
    const int b = (row - NPR) >> 2;
    qs[tid] = p.qr[(size_t)row * 1024 + tid];
    qs[tid + 512] = p.qr[(size_t)row * 1024 + 512 + tid];
    if (tid < 256) sidx[tid] = p.sel[(size_t)row * 256 + tid];
    __syncthreads();
    {
        const int j = tid & 255, kvh = tid >> 8;
        const int s = sidx[j];
        const bool valid = s >= 0;
        const float* kp = kv_row(p.k_prompt, p.k_sample, p.cache_k, p.page_table, prompt, b, valid ? s : 0) + kvh * 128;
        float d0 = 0.f, d1 = 0.f, d2 = 0.f, d3 = 0.f;
        const float* q0 = qs + (kvh * 4) * 128;
#pragma unroll 8
        for (int c = 0; c < 32; ++c) {
            const f32x4 kv = *(const f32x4*)(kp + c * 4);
            const f32x4 a0 = *(const f32x4*)(q0 + c * 4), a1 = *(const f32x4*)(q0 + 128 + c * 4), a2 = *(const f32x4*)(q0 + 256 + c * 4),
                        a3 = *(const f32x4*)(q0 + 384 + c * 4);
            d0 += kv[0] * a0[0] + kv[1] * a0[1] + kv[2] * a0[2] + kv[3] * a0[3];
            d1 += kv[0] * a1[0] + kv[1] * a1[1] + kv[2] * a1[2] + kv[3] * a1[3];
            d2 += kv[0] * a2[0] + kv[1] * a2[1] + kv[2] * a2[2] + kv[3] * a2[3];
            d3 += kv[0] * a3[0] + kv[1] * a3[1] + kv[2] * a3[2] + kv[3] * a3[3];
        }
        const float sc = 0.08838834764831845f;
        ps[(kvh * 4 + 0) * 256 + j] = valid ? d0 * sc : -INFINITY;
        ps[(kvh * 4 + 1) * 256 + j] = valid ? d1 * sc : -INFINITY;
        ps[(kvh * 4 + 2) * 256 + j] = valid ? d2 * sc : -INFINITY;
        ps[(kvh * 4 + 3) * 256 + j] = valid ? d3 * sc : -INFINITY;
    }
    __syncthreads();
    {
        float v[4]; float m = -INFINITY;
#pragma unroll
        for (int i = 0; i < 4; ++i) { v[i] = ps[wave * 256 + lane + 64 * i]; m = fmaxf(m, v[i]); }
        m = wave_max(m);
        float sum = 0.f;
#pragma unroll
        for (int i = 0; i < 4; ++i) { v[i] = __expf(v[i] - m); sum += v[i]; }
        sum = wave_sum(sum);
        const float inv = 1.f / sum;
#pragma unroll
        for (int i = 0; i < 4; ++i) ps[wave * 256 + lane + 64 * i] = v[i] * inv;
    }
    __syncthreads();
    {
        const int h = wave, d = lane * 2, kvh = h >> 2;
        float o0 = 0.f, o1 = 0.f;
#pragma unroll 16
        for (int j = 0; j < 256; ++j) {
            int s = sidx[j]; if (s < 0) s = 0;
            const float* vp = kv_row(p.v_prompt, p.v_sample, p.cache_v, p.page_table, prompt, b, s) + kvh * 128 + d;
            const float pj = ps[h * 256 + j];
            const float2 vv = *(const float2*)vp;
            o0 += pj * vv.x; o1 += pj * vv.y;
        }
        *(unsigned*)(p.gated + (size_t)row * 1024 + h * 128 + d) = pk2(o0, o1);
    }
    __syncthreads();
}

constexpr int AT_K = 0, AT_V = 64 * 136, AT_ELEMS = 64 * 136 + 128 * 72;
__device__ __forceinline__ void attn_dense_unit(const Params& p, char* smem, int b, int kvh, int qb) {
    bf16_t* lds = (bf16_t*)smem;
    const int tid = tid_opaque(), lane = tid & 63, wave = tid >> 6;
    const int r = lane & 31, hh = lane >> 5;
    const int g = wave & 3, qs = wave >> 2;
    const int head = kvh * 4 + g;
    const int tq = 64 * qb + 32 * qs + r;
    const int tqc = (tq < LP) ? tq : (LP - 1);
    bf16x8 qf[8];
    {
        const bf16_t* qp = p.q_b + ((size_t)b * LP + tqc) * 1024 + head * 128 + 8 * hh;
#pragma unroll
        for (int ks = 0; ks < 8; ++ks) qf[ks] = *(const bf16x8*)(qp + 16 * ks);
    }
    f32x16 O[4];
#pragma unroll
    for (int i = 0; i < 4; ++i)
#pragma unroll
        for (int j = 0; j < 16; ++j) O[i][j] = 0.f;
    float mrun = -3.0e38f, lrun = 0.f;
    const bf16_t* Kg = p.k_b + ((size_t)(b * 2 + kvh) * LPAD) * 128;
    const bf16_t* Vg = p.vt_b + ((size_t)(b * 2 + kvh) * 128) * LPAD;
    const unsigned long long* mcol = p.maskT + (size_t)b * 65 * LPAD + tq;
    const int kc0 = tid, kc1 = tid + 512;
    uint4 sk0, sk1, sv0, sv1;
#define AT_GLOAD(kt_) do { const bf16_t* kg_ = Kg + (size_t)(kt_) * 64 * 128; const bf16_t* vg_ = Vg + (size_t)(kt_) * 64; \
        sk0 = *(const uint4*)(kg_ + (size_t)kc0 * 8); sk1 = *(const uint4*)(kg_ + (size_t)kc1 * 8); \
        sv0 = *(const uint4*)(vg_ + (size_t)(kc0 >> 3) * LPAD + (kc0 & 7) * 8); sv1 = *(const uint4*)(vg_ + (size_t)(kc1 >> 3) * LPAD + (kc1 & 7) * 8); } while (0)
#define AT_SSTORE(buf_) do { bf16_t* q_ = (buf_); \
        *(uint4*)(q_ + AT_K + (kc0 >> 4) * 136 + (kc0 & 15) * 8) = sk0; *(uint4*)(q_ + AT_K + (kc1 >> 4) * 136 + (kc1 & 15) * 8) = sk1; \
        *(uint4*)(q_ + AT_V + (kc0 >> 3) * 72 + (kc0 & 7) * 8) = sv0; *(uint4*)(q_ + AT_V + (kc1 >> 3) * 72 + (kc1 & 7) * 8) = sv1; } while (0)
    AT_GLOAD(0); AT_SSTORE(lds);
    __syncthreads();
    for (int kt = 0; kt <= qb; ++kt) {
        unsigned zofs = 0; asm volatile("" : "+v"(zofs));
        bf16_t* cur = lds + (kt & 1) * AT_ELEMS + zofs;
        bf16_t* nxt = lds + ((kt + 1) & 1) * AT_ELEMS + zofs;
        const bool more = kt < qb;
        if (more) { AT_GLOAD(kt + 1); }
        const unsigned long long mw = mcol[(size_t)kt * LPAD];
        f32x16 st[2];
#pragma unroll
        for (int j = 0; j < 16; ++j) { st[0][j] = 0.f; st[1][j] = 0.f; }
#pragma unroll
        for (int ks = 0; ks < 8; ++ks) {
            st[0] = MFMA32(*(const bf16x8*)(cur + AT_K + (r) * 136 + 16 * ks + 8 * hh), qf[ks], st[0]);
            st[1] = MFMA32(*(const bf16x8*)(cur + AT_K + (32 + r) * 136 + 16 * ks + 8 * hh), qf[ks], st[1]);
        }
        float mx = -3.0e38f;
#pragma unroll
        for (int kk = 0; kk < 2; ++kk) {
            const unsigned w = (unsigned)(mw >> (32 * kk)) >> (4 * hh);
#pragma unroll
            for (int reg = 0; reg < 16; ++reg) {
                const int bit = (reg & 3) + 8 * (reg >> 2);
                const float v = ((w >> bit) & 1u) ? st[kk][reg] : -3.0e38f;
                st[kk][reg] = v;
                mx = fmaxf(mx, v);
            }
        }
        mx = fmaxf(mx, __shfl_xor(mx, 32));
        const float mnew = fmaxf(mrun, mx);
        const float alpha = __builtin_amdgcn_exp2f(mrun - mnew);
        mrun = mnew;
        float psum = 0.f;
#pragma unroll
        for (int kk = 0; kk < 2; ++kk)
#pragma unroll
            for (int reg = 0; reg < 16; ++reg) { const float pv = __builtin_amdgcn_exp2f(st[kk][reg] - mnew); st[kk][reg] = pv; psum += pv; }
        lrun = lrun * alpha + psum;
#pragma unroll
        for (int dt = 0; dt < 4; ++dt) O[dt] = O[dt] * alpha;
        bf16x8 pb[2][2];
#pragma unroll
        for (int kk = 0; kk < 2; ++kk)
#pragma unroll
            for (int s = 0; s < 2; ++s) pb[kk][s] = pack_step(st[kk], s);
#pragma unroll
        for (int dt = 0; dt < 4; ++dt)
#pragma unroll
            for (int kk = 0; kk < 2; ++kk)
#pragma unroll
                for (int s = 0; s < 2; ++s)
                    O[dt] = MFMA32(frag_perm(cur + AT_V + (32 * dt + r) * 72 + 32 * kk + 16 * s + 4 * hh), pb[kk][s], O[dt]);
        if (more) { AT_SSTORE(nxt); }
        __syncthreads();
    }
    const float ltot = lrun + __shfl_xor(lrun, 32);
    const float inv = 1.f / ltot;
    if (tq < LP) {
        bf16_t* op = p.gated + ((size_t)b * LP + tq) * 1024 + head * 128;
#pragma unroll
        for (int dt = 0; dt < 4; ++dt)
#pragma unroll
            for (int g4 = 0; g4 < 4; ++g4) {
                f32x4 v;
#pragma unroll
                for (int e2 = 0; e2 < 4; ++e2) v[e2] = O[dt][4 * g4 + e2] * inv;
                st_bf16x4(op + 32 * dt + 8 * g4 + 4 * hh, v);
            }
    }
    __syncthreads();
}

__device__ __forceinline__ void attn_phase(const Params& p, char* smem, int bid, int nb, int rep = 0) {
    int* slot = (int*)(smem + LDS_BYTES - 32);
    for (;;) {
        if (threadIdx.x == 0) *slot = (int)atomicAdd(p.bar + 3584 + 16 * rep, 1u);
        __syncthreads();
        const int u = *slot;
        __syncthreads();
        if (u >= 520 + NSR) break;
        if (u < 520) attn_dense_unit(p, smem, (u & 7) >> 1, u & 1, 64 - (u >> 3));
        else attn_sample_query(p, smem, NPR + (u - 520));
    }
}

#define XB_TMO      128
#define XB_XCNT(j)  (256  + 64 * (j))
#define XB_XSUB(j)  (1280 + 64 * (j))
#define XB_XGEN(j)  (2304 + 64 * (j))
#define XB_TOP      3328
#define XB_TOPGEN   3392
#define XCD_BAR_WORDS 3456
#define XB_SPIN_CAP (1u << 18)
#define LAS __attribute__((address_space(3)))

__device__ __forceinline__ unsigned xb_ld(unsigned* p)              { return __hip_atomic_load(p, __ATOMIC_RELAXED, __HIP_MEMORY_SCOPE_AGENT); }
__device__ __forceinline__ unsigned xb_add(unsigned* p, unsigned v) { return __hip_atomic_fetch_add(p, v, __ATOMIC_RELAXED, __HIP_MEMORY_SCOPE_AGENT); }
__device__ __forceinline__ unsigned xb_xcc_id() { return (unsigned)__builtin_amdgcn_s_getreg((3 << 11) | 20) & 0xFu; }
#define XB_SPIN(cond, bar) do { unsigned _sp = 0; while (cond) { __builtin_amdgcn_s_sleep(1); \
    if ((++_sp & 255u) == 0u) { if (xb_ld(&(bar)[XB_TMO])) break; if (_sp > XB_SPIN_CAP) { atomicAdd(&(bar)[XB_TMO], 1u); break; } } } } while (0)

struct XcdBarrier {
    unsigned* bar; unsigned x;
    volatile LAS unsigned* st;
};

__device__ __forceinline__ XcdBarrier xcd_barrier_post(unsigned* bar, volatile LAS unsigned* st) {
    XcdBarrier b; b.bar = bar; b.x = xb_xcc_id(); b.st = st;
    if (threadIdx.x == 0) (void)xb_add(&bar[XB_XCNT(b.x)], 1u);
    return b;
}
__device__ __forceinline__ void xcd_barrier_complete(unsigned* bar, unsigned x, unsigned& nloc, unsigned& nx) {
    const unsigned G = gridDim.x * gridDim.y * gridDim.z;
    unsigned sum, cnt, mine, sp = 0u;
    for (;;) {
        sum = 0u; cnt = 0u; mine = 0u;
#pragma unroll
        for (unsigned j = 0; j < 16; ++j) { const unsigned c = xb_ld(&bar[XB_XCNT(j)]); sum += c; cnt += (c > 0u) ? 1u : 0u; mine = (j == x) ? c : mine; }
        if (sum == G) break;
        __builtin_amdgcn_s_sleep(1);
        if ((++sp & 255u) == 0u) { if (xb_ld(&bar[XB_TMO])) break; if (sp > XB_SPIN_CAP) { atomicAdd(&bar[XB_TMO], 1u); break; } }
    }
    nloc = mine > 0u ? mine : 1u; nx = cnt > 0u ? cnt : 1u;
}

__device__ __forceinline__ void xcd_barrier(const XcdBarrier& b) {
    asm volatile("s_waitcnt vmcnt(0)" ::: "memory");
    __syncthreads();
    if (threadIdx.x == 0) {
        unsigned* bar = b.bar;
        __builtin_amdgcn_s_waitcnt(0);
        unsigned nloc = b.st[0], nx = b.st[1];
        if (nloc == 0u) { xcd_barrier_complete(bar, b.x, nloc, nx); b.st[0] = nloc; b.st[1] = nx; }
        const unsigned old = xb_add(&bar[XB_XSUB(b.x)], 1u);
        const unsigned gen = old / nloc;
        if (old + 1u == (gen + 1u) * nloc) {
            __builtin_amdgcn_fence(__ATOMIC_RELEASE, "agent");
            asm volatile("s_waitcnt vmcnt(0)" ::: "memory");
            const unsigned og = xb_add(&bar[XB_TOP], 1u);
            const unsigned tg = og / nx;
            if (og + 1u == (tg + 1u) * nx) xb_add(&bar[XB_TOPGEN], 1u);
            else XB_SPIN(xb_ld(&bar[XB_TOPGEN]) == tg, bar);
            __builtin_amdgcn_fence(__ATOMIC_ACQUIRE, "agent");
            xb_add(&bar[XB_XGEN(b.x)], 1u);
            asm volatile("s_waitcnt vmcnt(0)" ::: "memory");
        } else {
            XB_SPIN(xb_ld(&bar[XB_XGEN(b.x)]) == gen, bar);
            __builtin_amdgcn_fence(__ATOMIC_ACQUIRE, "agent");
            asm volatile("s_waitcnt vmcnt(0)" ::: "memory");
        }
    }
    __syncthreads();
}


constexpr int NPHASE = 19;
template <int PH>
__device__ __forceinline__ void run_phase(const Params& p, char* smem, int bid, int nb, int rep = 0) {
    constexpr int MT = MPAD / 256;
    if constexpr (PH == 0) phase_prologue(p, smem, bid, nb);
    else if constexpr (PH == 1) gemm_big(p.hA, D, p.wt_gin, GIN_PAD, EpiGdnIn{p.mixed, p.z, p.ba}, smem, bid, nb);
    else if constexpr (PH == 2) gdn_stageA(p, smem, bid, nb);
    else if constexpr (PH == 3) gdn_seq_phase(p, smem, bid, nb, rep);
    else if constexpr (PH == 4) gdn_gate_phase(p, bid, nb);
    else if constexpr (PH == 5) gemm_n1024(p.gated, 2048, p.wt_gout, EpiResid{p.preln, p.hA}, EpiResidAtomic{p.preln, p.hA}, 8, smem, bid, nb);
    else if constexpr (PH == 6) ln_phase(p.preln, p.ln1_g, p.ln1_b, p.hB, nullptr, nullptr, bid, nb);
    else if constexpr (PH == 7) gemm_big(p.hB, D, p.wt_w1, DFF, EpiRelu2{p.act}, smem, bid, nb);
    else if constexpr (PH == 8) gemm_n1024(p.act, DFF, p.wt_w2, EpiResid{p.preln, p.hB}, EpiResidAtomic{p.preln, p.hB}, 16, smem, bid, nb);
    else if constexpr (PH == 9) ln_phase(p.preln, p.ln2_g, p.ln2_b, p.hA, nullptr, nullptr, bid, nb);
    else if constexpr (PH == 10) gemm_big(p.hA, D, p.wt_din, DIN_PAD, EpiF32{p.p1, DIN_PAD}, smem, bid, nb);
    else if constexpr (PH == 11) dsa_post_phase(p, bid, nb);
    else if constexpr (PH == 12) indexer_phase(p, smem, bid, nb, rep);
    else if constexpr (PH == 13) attn_phase(p, smem, bid, nb, rep);
    else if constexpr (PH == 14) gemm_n1024(p.gated, D, p.wt_do, EpiResid{p.preln, p.hA}, EpiResidAtomic{p.preln, p.hA}, 4, smem, bid, nb);
    else if constexpr (PH == 15) ln_phase(p.preln, p.ln1_g + D, p.ln1_b + D, p.hB, nullptr, nullptr, bid, nb);
    else if constexpr (PH == 16) gemm_big(p.hB, D, p.wt_w1 + (size_t)D * DFF, DFF, EpiRelu2{p.act}, smem, bid, nb);
    else if constexpr (PH == 17) gemm_n1024(p.act, DFF, p.wt_w2 + (size_t)D * DFF, EpiResid{p.preln, p.hB}, EpiResidAtomic{p.preln, p.hB}, 16, smem, bid, nb);
    else if constexpr (PH == 18) ln_phase(p.preln, p.ln2_g + D, p.ln2_b + D, nullptr, p.y_prompt, p.y_sample, bid, nb);
}

template <int PH>
__global__ void __launch_bounds__(NTHR, 2) k_phase(Params p) {
    extern __shared__ __attribute__((aligned(16))) char smem[];
    run_phase<PH>(p, smem, blockIdx.x, gridDim.x);
}

template <int PH>
__device__ __forceinline__ void mega_run(const Params& p, char* smem, const XcdBarrier& bar) {
    run_phase<PH>(p, smem, blockIdx.x, gridDim.x);
#ifdef PROBE_MASK
    if constexpr ((PROBE_MASK >> PH) & 1) { xcd_barrier(bar); run_phase<PH>(p, smem, blockIdx.x, gridDim.x, 1); }
#endif
    if constexpr (PH + 1 < NPHASE) {
        xcd_barrier(bar);
        mega_run<PH + 1>(p, smem, bar);
    }
}
__global__ void __launch_bounds__(NTHR, 2) k_mega(Params p) {
    extern __shared__ __attribute__((aligned(16))) char smem[];
    volatile LAS unsigned* st = (volatile LAS unsigned*)(smem + LDS_BYTES - 16);
    if (threadIdx.x == 0) { st[0] = 0u; st[1] = 0u; st[2] = 0u; st[3] = 0u; }
    __syncthreads();
    XcdBarrier bar = xcd_barrier_post(p.bar, st);
    mega_run<0>(p, smem, bar);
}

template <int PH>
void launch_phase(const Params& p, hipStream_t stream) {
    static bool attr_done = false;
    if (!attr_done) {
        (void)hipFuncSetAttribute((const void*)k_phase<PH>, hipFuncAttributeMaxDynamicSharedMemorySize, LDS_BYTES);
        attr_done = true;
    }
    hipLaunchKernelGGL(k_phase<PH>, dim3(256), dim3(NTHR), LDS_BYTES, stream, p);
}
template <int PH>
void launch_all(const Params& p, hipStream_t stream) {
    launch_phase<PH>(p, stream);
    if constexpr (PH + 1 < NPHASE) launch_all<PH + 1>(p, stream);
}

}

extern "C" void kernel_launch(void* const* d_in, const int* in_sizes, int n_in, void* d_out, int out_size, void* d_ws, size_t ws_size,
                              hipStream_t stream) {
    Params p{};
    p.x_prompt = (const float*)d_in[0]; p.x_sample = (const float*)d_in[1]; p.state_gdn = (const float*)d_in[2];
    p.state_conv = (const float*)d_in[3]; p.cache_k = (const float*)d_in[4]; p.cache_v = (const float*)d_in[5];
    p.cache_ik = (const float*)d_in[6]; p.page_table = (const int*)d_in[7]; p.meta = (const float*)d_in[8];
    p.ln1_g = (const float*)d_in[9]; p.ln1_b = (const float*)d_in[10]; p.ln2_g = (const float*)d_in[11]; p.ln2_b = (const float*)d_in[12];
    p.mlp_w1 = (const float*)d_in[13]; p.mlp_w2 = (const float*)d_in[14]; p.gdn_w_in = (const float*)d_in[15];
    p.gdn_conv_w = (const float*)d_in[16]; p.gdn_a_log = (const float*)d_in[17]; p.gdn_dt_bias = (const float*)d_in[18];
    p.gdn_norm_w = (const float*)d_in[19]; p.gdn_w_out = (const float*)d_in[20]; p.dsa_w_in = (const float*)d_in[21];
    p.dsa_ik_g = (const float*)d_in[22]; p.dsa_ik_b = (const float*)d_in[23]; p.dsa_w_o = (const float*)d_in[24];
    float* o = (float*)d_out;
    p.y_prompt = o; o += (size_t)BATCH * SEQ * D;
    p.y_sample = o; o += (size_t)NSR * D;
    p.gs_prompt = o; o += (size_t)BATCH * 16 * 128 * 128;
    p.gc_prompt = o; o += (size_t)BATCH * 3 * 4096;
    p.gs_sample = o; o += (size_t)DB * 16 * 128 * 128;
    p.gc_sample = o; o += (size_t)DB * 3 * 4096;
    p.k_prompt = o; o += (size_t)NPR * 256;
    p.v_prompt = o; o += (size_t)NPR * 256;
    p.ik_prompt = o; o += (size_t)NPR * 64;
    p.k_sample = o; o += (size_t)NSR * 256;
    p.v_sample = o; o += (size_t)NSR * 256;
    p.ik_sample = o; o += (size_t)NSR * 64;
    char* w = (char*)d_ws;
    auto take = [&](size_t bytes) { char* r = w; w += (bytes + 255) & ~(size_t)255; return r; };
    p.bar = (unsigned*)take(16384);
    p.wt_gin = (bf16_t*)take((size_t)GIN_PAD * D * 2);
    p.wt_gout = (bf16_t*)take((size_t)D * 2048 * 2);
    p.wt_w1 = (bf16_t*)take((size_t)2 * D * DFF * 2);
    p.wt_w2 = (bf16_t*)take((size_t)2 * D * DFF * 2);
    p.wt_din = (bf16_t*)take((size_t)DIN_PAD * D * 2);
    p.wt_do = (bf16_t*)take((size_t)D * D * 2);
    p.hA = (bf16_t*)take((size_t)MPAD * D * 2);
    p.hB = (bf16_t*)take((size_t)MPAD * D * 2);
    p.preln = (float*)take((size_t)MPAD * D * 4);
    p.mixed = (bf16_t*)take((size_t)MPAD * 4096 * 2);
    p.z = (bf16_t*)take((size_t)MPAD * 2048 * 2);
    p.ba = (float*)take((size_t)MPAD * 32 * 4);
    p.gated = (bf16_t*)take((size_t)MPAD * 2048 * 2);
    p.act = (bf16_t*)take((size_t)MPAD * DFF * 2);
    p.p1 = (float*)take((size_t)MPAD * DIN_PAD * 4);
    p.qr = (float*)take((size_t)MPAD * 1024 * 4);
    p.iq = (float*)take((size_t)MPAD * 512 * 4);
    p.iw = (float*)take((size_t)MPAD * 8 * 4);
    p.sel = (int*)take((size_t)MPAD * 256 * 4);
    p.g_o = (float*)take((size_t)NPR * 2048 * 4);
    p.q_b = (bf16_t*)take((size_t)NPR * 1024 * 2);
    p.k_b = (bf16_t*)take((size_t)BATCH * 2 * LPAD * 128 * 2);
    p.vt_b = (bf16_t*)take((size_t)BATCH * 2 * 128 * LPAD * 2);
    p.iq_b = (bf16_t*)take((size_t)NPR * 512 * 2);
    p.ik_b = (bf16_t*)take((size_t)BATCH * LPAD * 64 * 2);
    p.maskT = (unsigned long long*)take((size_t)BATCH * 65 * LPAD * 8);
    p.g_dec = (float*)take((size_t)NCU * 4);
    p.g_u = (float*)p.act;
    p.g_negw = (bf16_t*)p.p1;
    p.g_qg = p.g_negw + (size_t)NCU * 8192;
    p.g_kdT = (bf16_t*)p.qr;
    p.g_aqk = (bf16_t*)p.iq;
    if ((size_t)(w - (char*)d_ws) > ws_size) { fprintf(stderr, "kernel_launch: workspace too small (%zu needed, %zu given)\n", (size_t)(w - (char*)d_ws), ws_size); return; }
#if MEGA
    static int grid = 0;
    if (grid == 0) {
        int dev = 0, cus = 0;
        if (hipGetDevice(&dev) != hipSuccess || hipDeviceGetAttribute(&cus, hipDeviceAttributeMultiprocessorCount, dev) != hipSuccess || cus <= 0) cus = 256;
        (void)hipFuncSetAttribute((const void*)k_mega, hipFuncAttributeMaxDynamicSharedMemorySize, LDS_BYTES);
        grid = cus;
    }
    (void)hipMemsetAsync(p.bar, 0, 16384, stream);
    hipLaunchKernelGGL(k_mega, dim3(grid), dim3(NTHR), LDS_BYTES, stream, p);
#else
    launch_all<0>(p, stream);
#endif
}
```

```cpp
#include <hip/hip_runtime.h>
#include <stdint.h>
#include <stdio.h>

#ifndef MEGA
#define MEGA 1
#endif

namespace {

typedef unsigned short bf16_t;
typedef short bf16x8 __attribute__((ext_vector_type(8)));
typedef float f32x4 __attribute__((ext_vector_type(4)));

constexpr int D = 1024, BATCH = 4, SEQ = 4096, NMETA = 16, LP = SEQ + NMETA;
constexpr int DB = 128, DS = 4, PAST = 2048;
constexpr int NPR = BATCH * LP;
constexpr int NSR = DB * DS;
constexpr int NT = NPR + NSR;
constexpr int MPAD = 17152;
constexpr int DFF = 4096;
constexpr int GIN = 6176, GIN_PAD = 6400;
constexpr int DIN = 2120, DIN_PAD = 2304;
constexpr int NTHR = 512;
constexpr int LPAD = 4160;
constexpr int LDS_BYTES = 150 * 1024;
constexpr float ALPHA = 1.4142135623730951f;

struct Params {
    const float *x_prompt, *x_sample, *state_gdn, *state_conv, *cache_k, *cache_v, *cache_ik;
    const int* page_table;
    const float *meta, *ln1_g, *ln1_b, *ln2_g, *ln2_b, *mlp_w1, *mlp_w2, *gdn_w_in, *gdn_conv_w, *gdn_a_log, *gdn_dt_bias,
        *gdn_norm_w, *gdn_w_out, *dsa_w_in, *dsa_ik_g, *dsa_ik_b, *dsa_w_o;
    float *y_prompt, *y_sample, *gs_prompt, *gc_prompt, *gs_sample, *gc_sample, *k_prompt, *v_prompt, *ik_prompt, *k_sample,
        *v_sample, *ik_sample;
    unsigned* bar;
    bf16_t *wt_gin, *wt_gout, *wt_w1, *wt_w2, *wt_din, *wt_do;
    bf16_t *hA, *hB;
    float* preln;
    bf16_t *mixed, *z;
    float* ba;
    bf16_t *gated, *act;
    float *p1, *qr, *iq, *iw;
    int* sel;
    bf16_t *g_negw, *g_qg, *g_kdT, *g_aqk;
    float *g_u, *g_dec, *g_o;
    bf16_t *q_b, *k_b, *vt_b, *iq_b, *ik_b;
    unsigned long long* maskT;
};

__device__ const double kInvFreq[16] = {1.0, 0.44036660267178046, 0.19392274474868576, 0.08539710028576561,
    0.03760603093086393, 0.016560440080994446, 0.007292664737217109, 0.003211445994752591, 0.001414213562373095,
    0.000622772421914596, 0.0002742481756762073, 0.00012076973741146504, 5.318295896944988e-05, 2.341999896140934e-05,
    1.031338537721246e-05, 4.5416704806078695e-06};

__device__ __forceinline__ float bf2f(bf16_t h) { return __uint_as_float(((unsigned)h) << 16); }
typedef __bf16 hwbf16x2 __attribute__((ext_vector_type(2)));
typedef float f32x2 __attribute__((ext_vector_type(2)));
typedef float f32x16 __attribute__((ext_vector_type(16)));
typedef unsigned u32x4 __attribute__((ext_vector_type(4)));
__device__ __forceinline__ unsigned pk2(float lo, float hi) {
    const f32x2 v = {lo, hi};
    return __builtin_bit_cast(unsigned, __builtin_convertvector(v, hwbf16x2));
}
__device__ __forceinline__ bf16_t f2bf(float f) { return (bf16_t)(pk2(f, 0.f) & 0xffffu); }
__device__ __forceinline__ void st_bf16x4(bf16_t* p, f32x4 v) {
    uint2 o; o.x = pk2(v[0], v[1]); o.y = pk2(v[2], v[3]);
    *(uint2*)p = o;
}
__device__ __forceinline__ f32x4 cvt_bf16x4(uint2 o) {
    f32x4 v; v[0] = __uint_as_float(o.x << 16); v[1] = __uint_as_float(o.x & 0xffff0000u);
    v[2] = __uint_as_float(o.y << 16); v[3] = __uint_as_float(o.y & 0xffff0000u);
    return v;
}
__device__ __forceinline__ f32x4 ld_bf16x4(const bf16_t* p) {
    uint2 o = *(const uint2*)p;
    f32x4 v; v[0] = __uint_as_float(o.x << 16); v[1] = __uint_as_float(o.x & 0xffff0000u);
    v[2] = __uint_as_float(o.y << 16); v[3] = __uint_as_float(o.y & 0xffff0000u);
    return v;
}
__device__ __forceinline__ float wave_sum(float v) {
#pragma unroll
    for (int o = 1; o < 64; o <<= 1) v += __shfl_xor(v, o);
    return v;
}
__device__ __forceinline__ float wave_max(float v) {
#pragma unroll
    for (int o = 1; o < 64; o <<= 1) v = fmaxf(v, __shfl_xor(v, o));
    return v;
}
__device__ __forceinline__ int wave_sum_i(int v) {
#pragma unroll
    for (int o = 1; o < 64; o <<= 1) v += __shfl_xor(v, o);
    return v;
}
__device__ __forceinline__ float silu(float x) { return x * __builtin_amdgcn_rcpf(1.f + __expf(-x)); }
__device__ __forceinline__ int tid_opaque() { int t = threadIdx.x; asm volatile("" : "+v"(t)); return t; }
__device__ __forceinline__ void lds_fence() { asm volatile("s_waitcnt lgkmcnt(0)" ::: "memory"); }

__device__ __forceinline__ void transpose_convert(const float* __restrict__ W, int K, int N, int Npad, bf16_t* __restrict__ WT, float* tile,
                                  int bid, int nb) {
    const int tid = tid_opaque();
    const int tk = K / 64, tn = Npad / 64;
    for (int it = bid; it < tk * tn; it += nb) {
        const int kb = it / tn, nbk = it % tn, k0 = kb * 64, n0 = nbk * 64;
#pragma unroll
        for (int i = 0; i < 8; ++i) {
            const int r = (tid >> 6) + 8 * i, c = tid & 63, n = n0 + c;
            tile[r * 65 + c] = (n < N) ? W[(size_t)(k0 + r) * N + n] : 0.f;
        }
        __syncthreads();
        {
            const int rn = tid >> 3, c8 = (tid & 7) * 8;
            const float* tp = tile + c8 * 65 + rn;
            uint4 o;
            o.x = pk2(tp[0], tp[65]); o.y = pk2(tp[2 * 65], tp[3 * 65]); o.z = pk2(tp[4 * 65], tp[5 * 65]); o.w = pk2(tp[6 * 65], tp[7 * 65]);
            *(uint4*)(WT + (size_t)(n0 + rn) * K + k0 + c8) = o;
        }
        __syncthreads();
    }
}

__device__ __forceinline__ void phase_prologue(const Params& p, char* smem, int bid, int nb) {
    float* tile = (float*)smem;
    transpose_convert(p.gdn_w_in, D, GIN, GIN_PAD, p.wt_gin, tile, bid, nb);
    transpose_convert(p.gdn_w_out, 2048, D, D, p.wt_gout, tile, bid, nb);
    transpose_convert(p.mlp_w1, D, DFF, DFF, p.wt_w1, tile, bid, nb);
    transpose_convert(p.mlp_w1 + (size_t)D * DFF, D, DFF, DFF, p.wt_w1 + (size_t)D * DFF, tile, bid, nb);
    transpose_convert(p.mlp_w2, DFF, D, D, p.wt_w2, tile, bid, nb);
    transpose_convert(p.mlp_w2 + (size_t)D * DFF, DFF, D, D, p.wt_w2 + (size_t)D * DFF, tile, bid, nb);
    transpose_convert(p.dsa_w_in, D, DIN, DIN_PAD, p.wt_din, tile, bid, nb);
    transpose_convert(p.dsa_w_o, D, D, D, p.wt_do, tile, bid, nb);
    for (int idx = bid * NTHR + tid_opaque(); idx < (MPAD - 16384) * 256; idx += nb * NTHR)
        *(f32x4*)(p.preln + (size_t)16384 * D + (size_t)idx * 4) = (f32x4){0.f, 0.f, 0.f, 0.f};
    for (int idx = bid * NTHR + tid_opaque(); idx < MPAD * 256; idx += nb * NTHR) {
        const int row = idx >> 8, c4 = (idx & 255) * 4;
        f32x4 v = {0.f, 0.f, 0.f, 0.f};
        if (row < NPR) {
            const int b = row / LP, t = row % LP;
            const float* src = (t < NMETA) ? (p.meta + (size_t)t * D) : (p.x_prompt + ((size_t)b * SEQ + (t - NMETA)) * D);
            v = *(const f32x4*)(src + c4);
        } else if (row < NT) {
            v = *(const f32x4*)(p.x_sample + (size_t)(row - NPR) * D + c4);
        }
        st_bf16x4(p.hA + (size_t)row * D + c4, v);
    }
}

template <class Epi>
__device__ __forceinline__ void gemm_phase(const bf16_t* __restrict__ A, int lda, const bf16_t* __restrict__ Bt, int K, int Mtiles, int Ntiles,
                           const Epi& epi, char* smem, int bid, int nb) {
    bf16_t* As = (bf16_t*)smem;
    bf16_t* Bs = As + 256 * 72;
    const int tid = tid_opaque(), lane = tid & 63, wave = tid >> 6;
    const int wm = wave >> 1, wn = wave & 1;
    const int fr = lane & 15, fq = lane >> 4;
    const int ntiles = Mtiles * Ntiles;
    const int nk = K / 64;
    for (int tile = bid; tile < ntiles; tile += nb) {
        const int tm = tile % Mtiles, tn = tile / Mtiles;
        const bf16_t* Ag = A + (size_t)tm * 256 * lda;
        const bf16_t* Bg = Bt + (size_t)tn * 128 * K;
        f32x4 acc[4][4];
#pragma unroll
        for (int i = 0; i < 4; ++i)
#pragma unroll
            for (int j = 0; j < 4; ++j) acc[i][j] = (f32x4){0.f, 0.f, 0.f, 0.f};
        const int c0 = tid, c1 = tid + 512, c2 = tid + 1024, c3 = tid + 1536;
        const bf16_t* ga0 = Ag + (size_t)(c0 >> 3) * lda + (c0 & 7) * 8;
        const bf16_t* ga1 = Ag + (size_t)(c1 >> 3) * lda + (c1 & 7) * 8;
        const bf16_t* ga2 = Ag + (size_t)(c2 >> 3) * lda + (c2 & 7) * 8;
        const bf16_t* ga3 = Ag + (size_t)(c3 >> 3) * lda + (c3 & 7) * 8;
        const bf16_t* gb0 = Bg + (size_t)(c0 >> 3) * K + (c0 & 7) * 8;
        const bf16_t* gb1 = Bg + (size_t)(c1 >> 3) * K + (c1 & 7) * 8;
        bf16_t* sa0 = As + (c0 >> 3) * 72 + (c0 & 7) * 8;
        bf16_t* sa1 = As + (c1 >> 3) * 72 + (c1 & 7) * 8;
        bf16_t* sa2 = As + (c2 >> 3) * 72 + (c2 & 7) * 8;
        bf16_t* sa3 = As + (c3 >> 3) * 72 + (c3 & 7) * 8;
        bf16_t* sb0 = Bs + (c0 >> 3) * 72 + (c0 & 7) * 8;
        bf16_t* sb1 = Bs + (c1 >> 3) * 72 + (c1 & 7) * 8;
        uint4 ra0 = *(const uint4*)ga0, ra1 = *(const uint4*)ga1, ra2 = *(const uint4*)ga2, ra3 = *(const uint4*)ga3;
        uint4 rb0 = *(const uint4*)gb0, rb1 = *(const uint4*)gb1;
        *(uint4*)sa0 = ra0; *(uint4*)sa1 = ra1; *(uint4*)sa2 = ra2; *(uint4*)sa3 = ra3; *(uint4*)sb0 = rb0; *(uint4*)sb1 = rb1;
        __syncthreads();
        for (int kt = 0; kt < nk; ++kt) {
            const bool more = (kt + 1 < nk);
            if (more) {
                const int k0 = (kt + 1) * 64;
                ra0 = *(const uint4*)(ga0 + k0); ra1 = *(const uint4*)(ga1 + k0); ra2 = *(const uint4*)(ga2 + k0); ra3 = *(const uint4*)(ga3 + k0);
                rb0 = *(const uint4*)(gb0 + k0); rb1 = *(const uint4*)(gb1 + k0);
            }
#pragma unroll
            for (int kk = 0; kk < 2; ++kk) {
                bf16x8 af[4], bfr[4];
#pragma unroll
                for (int i = 0; i < 4; ++i) af[i] = *(const bf16x8*)(As + (wm * 64 + i * 16 + fr) * 72 + kk * 32 + fq * 8);
#pragma unroll
                for (int j = 0; j < 4; ++j) bfr[j] = *(const bf16x8*)(Bs + (wn * 64 + j * 16 + fr) * 72 + kk * 32 + fq * 8);
#pragma unroll
                for (int i = 0; i < 4; ++i)
#pragma unroll
                    for (int j = 0; j < 4; ++j) acc[i][j] = __builtin_amdgcn_mfma_f32_16x16x32_bf16(bfr[j], af[i], acc[i][j], 0, 0, 0);
            }
            __syncthreads();
            if (more) {
                *(uint4*)sa0 = ra0; *(uint4*)sa1 = ra1; *(uint4*)sa2 = ra2; *(uint4*)sa3 = ra3; *(uint4*)sb0 = rb0; *(uint4*)sb1 = rb1;
                __syncthreads();
            }
        }
#pragma unroll
        for (int i = 0; i < 4; ++i)
#pragma unroll
            for (int j = 0; j < 4; ++j) {
                const int row = tm * 256 + wm * 64 + i * 16 + fr, col = tn * 128 + wn * 64 + j * 16 + fq * 4;
                epi(row, col, acc[i][j]);
            }
    }
}

namespace pg8 {
#define PG8_LAS __attribute__((address_space(3)))
constexpr int BM = 256, BK = 64, HALF = 128, HTB = HALF * BK * 2  , STAGE_BYTES = 8 * HTB, NXCD = 8, WGM = 8;
__device__ __forceinline__ int lds_byte(int r, int c) { const int st = (r >> 4) * 2 + (c >> 5), rr = r & 15, cc = c & 31, ob = rr * 64 + cc * 2; return st * 1024 + (ob ^ (((ob >> 9) & 1) << 5)); }
__device__ __forceinline__ void stage_rc(int b, int& R, int& C) { const int st = b / 1024, sb = b % 1024, swz = sb ^ (((sb >> 9) & 1) << 5); R = (st >> 1) * 16 + swz / 64; C = (st & 1) * 32 + (swz % 64) / 2; }
struct Unit { int pm, pn, pk; };
struct Gemm { const bf16_t* A; const bf16_t* Bt; int K; int splits; };
struct StaticOrder {
    int nM, nN, nNr, pm0, nwg, G, c;
    __device__ void init(int nM_, int nNr_, int splits, int pm0_, int G_, int c_) { nM = nM_; nNr = nNr_; nN = nNr_ * splits; pm0 = pm0_; nwg = nM * nN; G = G_; c = c_; }
    __device__ bool next(int i, Unit& u) const {
        const long L = (long)i * G + c; if (L >= nwg) return false;
        int wgid = (int)L; { const int q = nwg / NXCD, r = nwg % NXCD, xcd = wgid % NXCD, off = wgid / NXCD; wgid = (xcd < r ? xcd * (q + 1) : r * (q + 1) + (xcd - r) * q) + off; }
        const int nig = WGM * nN, gid = wgid / nig, fm = gid * WGM, gsz = (nM - fm) < WGM ? (nM - fm) : WGM;
        const int pnv = (wgid % nig) / gsz;
        u.pm = pm0 + fm + ((wgid % nig) % gsz); u.pn = pnv % nNr; u.pk = pnv / nNr; return true;
    }
};
template <class Epi>
__device__ __forceinline__ void gemm_phase(PG8_LAS unsigned char* lds, const Gemm g, const StaticOrder& S, const Epi& E) {
    const int tid = tid_opaque(), wid = __builtin_amdgcn_readfirstlane(tid >> 6), lane = tid & 63, wr = wid >> 2, wc = wid & 3, fr = lane & 15, fq = lane >> 4;
    const int K = g.K, Kp = K / g.splits, nt = Kp / BK;
    unsigned voffA[2], voffB[2];
#pragma unroll
    for (int i = 0; i < 2; ++i) { int R, C; stage_rc(tid * 16 + i * 8192, R, C); voffA[i] = (unsigned)(R * K + C) * 2u; voffB[i] = voffA[i]; }
    const size_t kstep = (size_t)(BK * 2);
    const size_t hstep = (size_t)HALF * K * 2;
    const size_t tstep = 2 * hstep;
    const size_t pstep = (size_t)Kp * 2;
    const unsigned ldsw = (unsigned)wid * 1024u;
    const int aoff = lds_byte(wr * 64 + fr, fq * 8), boff = lds_byte(wc * 32 + fr, fq * 8);
#define PG8_SA(b, h) (((b) * 2 + (h)) * HTB)
#define PG8_SB(b, h) ((4 + (b) * 2 + (h)) * HTB)
#define PG8_STAGE(bufoff, gbase, voff) do { _Pragma("unroll") for (int _i = 0; _i < 2; ++_i) \
        __builtin_amdgcn_global_load_lds((const unsigned*)((const char*)(gbase) + (voff)[_i]), (PG8_LAS unsigned*)(lds + (bufoff) + ldsw + _i * 8192), 16, 0, 0); } while (0)
#define PG8_LDA(dst, b, h) do { _Pragma("unroll") for (int m = 0; m < 4; ++m) _Pragma("unroll") for (int k = 0; k < 2; ++k) dst[m][k] = *(const PG8_LAS bf16x8*)(lds + PG8_SA(b, h) + aoff + m * 2048 + k * 1024); } while (0)
#define PG8_LDB(dst, b, h) do { _Pragma("unroll") for (int n = 0; n < 2; ++n) _Pragma("unroll") for (int k = 0; k < 2; ++k) dst[n][k] = *(const PG8_LAS bf16x8*)(lds + PG8_SB(b, h) + boff + n * 2048 + k * 1024); } while (0)
#define PG8_MMA(ai, bj, At, Bt) do { __builtin_amdgcn_s_setprio(1); _Pragma("unroll") for (int m = 0; m < 4; ++m) _Pragma("unroll") for (int n = 0; n < 2; ++n) _Pragma("unroll") for (int k = 0; k < 2; ++k) \
        acc[ai][bj][m][n] = __builtin_amdgcn_mfma_f32_16x16x32_bf16(Bt[n][k], At[m][k], acc[ai][bj][m][n], 0, 0, 0); __builtin_amdgcn_s_setprio(0); } while (0)
#define PG8_WAIT_V(n) asm volatile("s_waitcnt vmcnt(" #n ")" ::: "memory")
#define PG8_WAIT_L(n) asm volatile("s_waitcnt lgkmcnt(" #n ")" ::: "memory")
#define PG8_BAR __builtin_amdgcn_s_barrier()
#define PG8_SCHED __builtin_amdgcn_sched_barrier(0)
    Unit cur, nxt; int ui = 0;
    if (!S.next(0, cur)) return;
    f32x4 acc[2][2][4][2];
#pragma unroll
    for (int a = 0; a < 2; ++a)
#pragma unroll
        for (int b = 0; b < 2; ++b)
#pragma unroll
            for (int m = 0; m < 4; ++m)
#pragma unroll
                for (int n = 0; n < 2; ++n) acc[a][b][m][n] = (f32x4){0.f, 0.f, 0.f, 0.f};
    bf16x8 At[4][2], B0[2][2], B1[2][2];
    const char* cA = (const char*)g.A + (size_t)cur.pm * tstep + (size_t)cur.pk * pstep; const char* cB = (const char*)g.Bt + (size_t)cur.pn * tstep + (size_t)cur.pk * pstep;
    PG8_STAGE(PG8_SB(0, 0), cB, voffB); PG8_STAGE(PG8_SA(0, 0), cA, voffA); PG8_STAGE(PG8_SB(0, 1), cB + hstep, voffB); PG8_STAGE(PG8_SA(0, 1), cA + hstep, voffA);
    if (wr == 1) PG8_BAR;
    PG8_WAIT_V(4); PG8_BAR;
    PG8_STAGE(PG8_SB(1, 0), cB + kstep, voffB); PG8_STAGE(PG8_SA(1, 0), cA + kstep, voffA); PG8_STAGE(PG8_SB(1, 1), cB + hstep + kstep, voffB);
    PG8_WAIT_V(6); PG8_BAR;
    for (;;) {
        const bool has_next = S.next(ui + 1, nxt);
        const char* nA = has_next ? (const char*)g.A + (size_t)nxt.pm * tstep + (size_t)nxt.pk * pstep : cA; const char* nB = has_next ? (const char*)g.Bt + (size_t)nxt.pn * tstep + (size_t)nxt.pk * pstep : cB;
        for (int t = 0; t < nt; t += 2) {
            const bool last = (t == nt - 2);
            const char* a1 = cA + (size_t)(t + 1) * kstep;
            const char* a2 = last ? nA : cA + (size_t)(t + 2) * kstep; const char* b2 = last ? nB : cB + (size_t)(t + 2) * kstep;
            const char* a3 = a2 + kstep; const char* b3 = b2 + kstep;
            PG8_LDB(B0, 0, 0); PG8_SCHED; PG8_LDA(At, 0, 0); PG8_STAGE(PG8_SA(1, 1), a1 + hstep, voffA);
            PG8_WAIT_L(8); PG8_BAR; PG8_WAIT_L(0); PG8_MMA(0, 0, At, B0); PG8_BAR; PG8_SCHED;
            PG8_LDB(B1, 0, 1); PG8_STAGE(PG8_SB(0, 0), b2, voffB);
            PG8_BAR; PG8_WAIT_L(0); PG8_MMA(0, 1, At, B1); PG8_BAR;
            PG8_LDA(At, 0, 1); PG8_STAGE(PG8_SA(0, 0), a2, voffA);
            PG8_BAR; PG8_WAIT_L(0); PG8_MMA(1, 0, At, B0); PG8_BAR; PG8_SCHED;
            PG8_STAGE(PG8_SB(0, 1), b2 + hstep, voffB);
            PG8_WAIT_V(6); PG8_BAR; PG8_MMA(1, 1, At, B1); PG8_BAR;
            PG8_LDB(B0, 1, 0); PG8_SCHED; PG8_LDA(At, 1, 0); PG8_STAGE(PG8_SA(0, 1), a2 + hstep, voffA);
            PG8_WAIT_L(8); PG8_BAR; PG8_WAIT_L(0); PG8_MMA(0, 0, At, B0); PG8_BAR; PG8_SCHED;
            PG8_LDB(B1, 1, 1); PG8_STAGE(PG8_SB(1, 0), b3, voffB);
            PG8_BAR; PG8_WAIT_L(0); PG8_MMA(0, 1, At, B1); PG8_BAR;
            PG8_LDA(At, 1, 1); PG8_STAGE(PG8_SA(1, 0), a3, voffA);
            PG8_BAR; PG8_WAIT_L(0); PG8_MMA(1, 0, At, B0); PG8_BAR; PG8_SCHED;
            PG8_STAGE(PG8_SB(1, 1), b3 + hstep, voffB);
            PG8_WAIT_V(6); PG8_BAR; PG8_MMA(1, 1, At, B1); PG8_BAR;
        }
#pragma unroll
        for (int ai = 0; ai < 2; ++ai)
#pragma unroll
            for (int m = 0; m < 4; ++m)
#pragma unroll
                for (int bj = 0; bj < 2; ++bj)
#pragma unroll
                    for (int n = 0; n < 2; ++n)
                        E(cur.pm * BM + ai * HALF + wr * 64 + m * 16 + fr, cur.pn * BM + bj * HALF + wc * 32 + n * 16 + 4 * fq, acc[ai][bj][m][n], cur.pk);
        if (!has_next) break;
#pragma unroll
        for (int a = 0; a < 2; ++a)
#pragma unroll
            for (int b = 0; b < 2; ++b)
#pragma unroll
                for (int m = 0; m < 4; ++m)
#pragma unroll
                    for (int n = 0; n < 2; ++n) acc[a][b][m][n] = (f32x4){0.f, 0.f, 0.f, 0.f};
        cur = nxt; cA = nA; cB = nB; ++ui;
    }
    PG8_WAIT_V(0);
    if (wr == 0) PG8_BAR;
    PG8_BAR;
#undef PG8_SA
#undef PG8_SB
#undef PG8_STAGE
#undef PG8_LDA
#undef PG8_LDB
#undef PG8_MMA
#undef PG8_WAIT_V
#undef PG8_WAIT_L
#undef PG8_BAR
#undef PG8_SCHED
}
}

template <class Epi>
__device__ __forceinline__ void gemm_big(const bf16_t* A, int K, const bf16_t* Bt, int Npad, const Epi& e, char* smem, int bid, int nb) {
    pg8::StaticOrder S; S.init(MPAD / 256, Npad / 256, 1, 0, nb, bid);
    pg8::gemm_phase((PG8_LAS unsigned char*)smem, pg8::Gemm{A, Bt, K, 1}, S, e);
}
template <class Epi1, class Epi2>
__device__ __forceinline__ void gemm_n1024(const bf16_t* A, int K, const bf16_t* Bt, const Epi1& e1, const Epi2& e2, int splits, char* smem, int bid, int nb) {
    pg8::StaticOrder S; S.init(64, 4, 1, 0, nb, bid);
    pg8::gemm_phase((PG8_LAS unsigned char*)smem, pg8::Gemm{A, Bt, K, 1}, S, e1);
    pg8::StaticOrder S2; S2.init(3, 4, splits, 64, nb, bid);
    pg8::gemm_phase((PG8_LAS unsigned char*)smem, pg8::Gemm{A, Bt, K, splits}, S2, e2);
}

struct EpiGdnIn {
    bf16_t *mixed, *z; float* ba;
    __device__ __forceinline__ void operator()(int row, int col, f32x4 v, int = 0) const {
        if (col < 4096) st_bf16x4(mixed + (size_t)row * 4096 + col, v);
        else if (col < 6144) st_bf16x4(z + (size_t)row * 2048 + (col - 4096), v);
        else if (col < 6176) *(f32x4*)(ba + (size_t)row * 32 + (col - 6144)) = v;
    }
};
struct EpiResid {
    float* out; const bf16_t* h;
    __device__ __forceinline__ void operator()(int row, int col, f32x4 v, int = 0) const {
        const f32x4 r = ld_bf16x4(h + (size_t)row * D + col);
        *(f32x4*)(out + (size_t)row * D + col) = v + r * ALPHA;
    }
};
struct EpiResidAtomic {
    float* out; const bf16_t* h;
    __device__ __forceinline__ void operator()(int row, int col, f32x4 v, int pk) const {
        if (pk == 0) { const f32x4 r = ld_bf16x4(h + (size_t)row * D + col); v = v + r * ALPHA; }
        float* o = out + (size_t)row * D + col;
        unsafeAtomicAdd(o, v[0]); unsafeAtomicAdd(o + 1, v[1]); unsafeAtomicAdd(o + 2, v[2]); unsafeAtomicAdd(o + 3, v[3]);
    }
};
struct EpiRelu2 {
    bf16_t* act;
    __device__ __forceinline__ void operator()(int row, int col, f32x4 v, int = 0) const {
#pragma unroll
        for (int e = 0; e < 4; ++e) { const float r = fmaxf(v[e], 0.f); v[e] = r * r; }
        st_bf16x4(act + (size_t)row * DFF + col, v);
    }
};
struct EpiF32 {
    float* out; int ld;
    __device__ __forceinline__ void operator()(int row, int col, f32x4 v, int = 0) const { *(f32x4*)(out + (size_t)row * ld + col) = v; }
};

__device__ __forceinline__ void ln_phase(const float* X, const float* __restrict__ g, const float* __restrict__ bta, bf16_t* Hout,
                         float* yp, float* ys, int bid, int nb) {
    const int tid_ = tid_opaque(); const int lane = tid_ & 63, wave = tid_ >> 6;
    f32x4 gv[4], bv[4];
#pragma unroll
    for (int j = 0; j < 4; ++j) { gv[j] = *(const f32x4*)(g + j * 256 + lane * 4); bv[j] = *(const f32x4*)(bta + j * 256 + lane * 4); }
    for (int row = bid * 8 + wave; row < NT; row += nb * 8) {
        f32x4 v[4]; float s = 0.f;
#pragma unroll
        for (int j = 0; j < 4; ++j) { v[j] = *(const f32x4*)(X + (size_t)row * D + j * 256 + lane * 4); s += (v[j][0] + v[j][1]) + (v[j][2] + v[j][3]); }
        if (row >= 16384) {
#pragma unroll
            for (int j = 0; j < 4; ++j) *(f32x4*)(const_cast<float*>(X) + (size_t)row * D + j * 256 + lane * 4) = (f32x4){0.f, 0.f, 0.f, 0.f};
        }
        const float mean = wave_sum(s) * (1.f / D);
        float s2 = 0.f;
#pragma unroll
        for (int j = 0; j < 4; ++j) { v[j] = v[j] - mean; s2 += (v[j][0] * v[j][0] + v[j][1] * v[j][1]) + (v[j][2] * v[j][2] + v[j][3] * v[j][3]); }
        const float rstd = rsqrtf(wave_sum(s2) * (1.f / D) + 1e-5f);
        float* yo = nullptr;
        if (yp) {
            if (row < NPR) { const int b = row / LP, t = row % LP; if (t >= NMETA) yo = yp + ((size_t)b * SEQ + (t - NMETA)) * D; }
            else yo = ys + (size_t)(row - NPR) * D;
        }
#pragma unroll
        for (int j = 0; j < 4; ++j) {
            const f32x4 o = v[j] * rstd * gv[j] + bv[j];
            if (Hout) st_bf16x4(Hout + (size_t)row * D + j * 256 + lane * 4, o);
            if (yo) *(f32x4*)(yo + j * 256 + lane * 4) = o;
        }
    }
}

__device__ __forceinline__ void gdn_sample_pass(const Params& p, char* smem, int pass, int tid) {
    float* sq = (float*)smem;
    float* sk = sq + 256;
    float* part = sk + 256;
    float* part2 = part + 16;
    const int lane = tid & 63, wave = tid >> 6, ug = wave >> 2, wq = wave & 3;
    const int half = lane >> 5, v = wq * 32 + (lane & 31);
    const int u = pass * 2 + ug, b = u >> 4, h = u & 15, kh = h >> 1;
    const size_t row0 = (size_t)NPR + (size_t)b * DS;
    float S[64];
    {
        const float* Sp = p.state_gdn + ((size_t)(b * 16 + h) * 128 + half * 64) * 128 + v;
#pragma unroll
        for (int k = 0; k < 64; ++k) S[k] = Sp[(size_t)k * 128];
    }
    const float Aexp = __expf(p.gdn_a_log[h]);
    const float dtb = p.gdn_dt_bias[h];
    const float nw = p.gdn_norm_w[v];
    const int chA = (half ? 1024 : 0) + kh * 128 + v, chv = 2048 + h * 128 + v;
    float cA[4], cv[4];
#pragma unroll
    for (int j = 0; j < 4; ++j) { cA[j] = p.gdn_conv_w[j * 4096 + chA]; cv[j] = p.gdn_conv_w[j * 4096 + chv]; }
    float xA[7], xv[7];
#pragma unroll
    for (int i = 0; i < 3; ++i) {
        const float* cs = p.state_conv + ((size_t)b * 3 + i) * 4096;
        xA[i] = cs[chA]; xv[i] = cs[chv];
    }
#pragma unroll
    for (int i = 0; i < 4; ++i) {
        const bf16_t* mr = p.mixed + (row0 + i) * 4096;
        xA[3 + i] = bf2f(mr[chA]); xv[3 + i] = bf2f(mr[chv]);
    }
    float* sqg = sq + ug * 128;
    float* skg = sk + ug * 128;
    float* pg = part + ug * 8;
    float* pg2 = part2 + ug * 4;
    const float* kmine = skg + half * 64;
    const float* qmine = sqg + half * 64;
#pragma unroll
    for (int t = 0; t < DS; ++t) {
        const float yA = silu(xA[t] * cA[0] + xA[t + 1] * cA[1] + xA[t + 2] * cA[2] + xA[t + 3] * cA[3]);
        const float yv = silu(xv[t] * cv[0] + xv[t + 1] * cv[1] + xv[t + 2] * cv[2] + xv[t + 3] * cv[3]);
        (half ? skg : sqg)[v] = yA;
        float ssA = yA * yA;
#pragma unroll
        for (int o = 1; o < 32; o <<= 1) ssA += __shfl_xor(ssA, o);
        if ((lane & 31) == 0) pg[wq * 2 + half] = ssA;
        __syncthreads();
        const float qn = rsqrtf((pg[0] + pg[2]) + (pg[4] + pg[6]) + 1e-6f) * 0.08838834764831845f;
        const float kn = rsqrtf((pg[1] + pg[3]) + (pg[5] + pg[7]) + 1e-6f);
        const float* bap = p.ba + (row0 + t) * 32;
        const float beta = 1.f / (1.f + __expf(-bap[h]));
        const float aa = bap[16 + h] + dtb;
        const float sp = (aa > 20.f) ? aa : log1pf(__expf(aa));
        const float dec = __expf(-Aexp * sp);
        float kS0 = 0.f, kS1 = 0.f;
#pragma unroll
        for (int k = 0; k < 64; k += 4) {
            const f32x4 kk = *(const f32x4*)(kmine + k);
            S[k] *= dec; S[k + 1] *= dec; S[k + 2] *= dec; S[k + 3] *= dec;
            kS0 += kk[0] * S[k]; kS1 += kk[1] * S[k + 1]; kS0 += kk[2] * S[k + 2]; kS1 += kk[3] * S[k + 3];
        }
        float kS = kS0 + kS1;
        kS += __shfl_xor(kS, 32);
        const float delta = (yv - kS * kn) * beta * kn;
        float o0 = 0.f, o1 = 0.f;
#pragma unroll
        for (int k = 0; k < 64; k += 4) {
            const f32x4 kk = *(const f32x4*)(kmine + k);
            const f32x4 qq = *(const f32x4*)(qmine + k);
            S[k] += kk[0] * delta; S[k + 1] += kk[1] * delta; S[k + 2] += kk[2] * delta; S[k + 3] += kk[3] * delta;
            o0 += qq[0] * S[k]; o1 += qq[1] * S[k + 1]; o0 += qq[2] * S[k + 2]; o1 += qq[3] * S[k + 3];
        }
        float o = o0 + o1;
        o = (o + __shfl_xor(o, 32)) * qn;
        float s3 = o * o;
#pragma unroll
        for (int x = 1; x < 32; x <<= 1) s3 += __shfl_xor(s3, x);
        if (lane == 0) pg2[wq] = s3;
        __syncthreads();
        if (half == 0) {
            const float rms = rsqrtf(((pg2[0] + pg2[1]) + (pg2[2] + pg2[3])) * (1.f / 128.f) + 1e-6f);
            const float zz = bf2f(p.z[(row0 + t) * 2048 + h * 128 + v]);
            p.gated[(row0 + t) * 2048 + h * 128 + v] = f2bf(o * rms * nw * silu(zz));
        }
    }
    {
        float* So = p.gs_sample + ((size_t)(b * 16 + h) * 128 + half * 64) * 128 + v;
#pragma unroll
        for (int k = 0; k < 64; ++k) So[(size_t)k * 128] = S[k];
    }
    __syncthreads();
}

#define MFMA32(a, b, c) __builtin_amdgcn_mfma_f32_32x32x16_bf16((a), (b), (c), 0, 0, 0)
constexpr int NCH = 65;
constexpr int NCU = BATCH * 16 * NCH;
__device__ __forceinline__ int crow(int reg, int hh) { return (reg & 3) + 8 * (reg >> 2) + 4 * hh; }
__device__ __forceinline__ bf16x8 pack_step(const f32x16& x, int s) {
    u32x4 q;
    q[0] = pk2(x[8 * s + 0], x[8 * s + 1]); q[1] = pk2(x[8 * s + 2], x[8 * s + 3]);
    q[2] = pk2(x[8 * s + 4], x[8 * s + 5]); q[3] = pk2(x[8 * s + 6], x[8 * s + 7]);
    return __builtin_bit_cast(bf16x8, q);
}
__device__ __forceinline__ bf16x8 frag_perm(const bf16_t* p0) {
    const uint2 lo = *(const uint2*)p0, hi = *(const uint2*)(p0 + 8);
    u32x4 q; q[0] = lo.x; q[1] = lo.y; q[2] = hi.x; q[3] = hi.y;
    return __builtin_bit_cast(bf16x8, q);
}

__device__ __forceinline__ void gdn_stageA(const Params& p, char* smem0, int bid, int nb) {
    const int tid = tid_opaque(), lane = tid & 63, wave = tid >> 6;
    for (int idx = bid * NTHR + tid; idx < (BATCH + DB) * 3 * 4096; idx += nb * NTHR) {
        const int c = idx & 4095, r = (idx >> 12) % 3, b = idx / (3 * 4096);
        if (b < BATCH) p.gc_prompt[idx] = bf2f(p.mixed[((size_t)b * LP + (LP - 3) + r) * 4096 + c]);
        else { const int bs = b - BATCH; p.gc_sample[(size_t)(bs * 3 + r) * 4096 + c] = bf2f(p.mixed[((size_t)NPR + bs * 4 + 1 + r) * 4096 + c]); }
    }
    for (int u = bid; u < NCU; u += nb) {
        unsigned zofs = 0; asm volatile("" : "+v"(zofs));
        char* smem = smem0 + zofs;
        bf16_t* Qb = (bf16_t*)smem;
        bf16_t* Kb = Qb + 64 * 136;
        float* RHS = (float*)(Kb + 64 * 136);
        float* Am = RHS + 64 * 256;
        float* sbeta = Am + 64 * 68;
        float* sgc = sbeta + 64;
        float* segc = sgc + 64;
        float* sekd = segc + 64;
        float* srk = sekd + 64;
        const int h = u & 15, n = (u >> 4) % NCH, b = u / (16 * NCH);
        const int kh = h >> 1;
        const size_t su = (size_t)((b * 16 + h) * NCH + n);
        const int t0 = n * 64;
        if (wave < 6) {
            const int part = wave >> 1, half = wave & 1;
            const int cq = lane & 31, tsub = lane >> 5;
            const int tl0 = 32 * half + 16 * tsub;
            const int chb = ((part == 0) ? (kh * 128) : (part == 1) ? (1024 + kh * 128) : (2048 + h * 128)) + cq * 4;
            f32x4 cw[4];
#pragma unroll
            for (int j = 0; j < 4; ++j) cw[j] = *(const f32x4*)(p.gdn_conv_w + j * 4096 + chb);
            uint2 xr[19];
#pragma unroll
            for (int i = 0; i < 19; ++i) {
                const int t = t0 + tl0 - 3 + i;
                if (t >= 0 && t < LP) xr[i] = *(const uint2*)(p.mixed + ((size_t)b * LP + t) * 4096 + chb);
                else xr[i] = make_uint2(0u, 0u);
            }
#pragma unroll
            for (int hb = 0; hb < 2; ++hb) {
                f32x4 yv[8];
                float ssv[8];
#pragma unroll
                for (int i8 = 0; i8 < 8; ++i8) {
                    const int i = hb * 8 + i8;
                    const f32x4 a = cvt_bf16x4(xr[i]) * cw[0] + cvt_bf16x4(xr[i + 1]) * cw[1] + cvt_bf16x4(xr[i + 2]) * cw[2] + cvt_bf16x4(xr[i + 3]) * cw[3];
                    const bool valid = (t0 + tl0 + i) < LP;
#pragma unroll
                    for (int e2 = 0; e2 < 4; ++e2) yv[i8][e2] = valid ? silu(a[e2]) : 0.f;
                    ssv[i8] = (yv[i8][0] * yv[i8][0] + yv[i8][1] * yv[i8][1]) + (yv[i8][2] * yv[i8][2] + yv[i8][3] * yv[i8][3]);
                }
                if (part < 2) {
#pragma unroll
                    for (int o = 1; o < 32; o <<= 1)
#pragma unroll
                        for (int i8 = 0; i8 < 8; ++i8) ssv[i8] += __shfl_xor(ssv[i8], o);
                }
#pragma unroll
                for (int i8 = 0; i8 < 8; ++i8) {
                    const int c = tl0 + hb * 8 + i8;
                    f32x4 y = yv[i8];
                    if (part < 2) {
                        const float nrm = rsqrtf(ssv[i8] + 1e-6f) * ((part == 0) ? 0.08838834764831845f : 1.f);
                        y = y * nrm;
                        if (part == 0) st_bf16x4(Qb + c * 136 + cq * 4, y);
                        else { st_bf16x4(Kb + c * 136 + cq * 4, y); *(f32x4*)(RHS + c * 256 + 128 + cq * 4) = y; }
                    } else {
                        *(f32x4*)(RHS + c * 256 + cq * 4) = y;
                    }
                }
            }
        } else if (wave == 6) {
            const int c = lane, t = t0 + c;
            float beta = 0.f, g = 0.f;
            if (t < LP) {
                const float* bap = p.ba + ((size_t)b * LP + t) * 32;
                beta = 1.f / (1.f + __expf(-bap[h]));
                const float aa = bap[16 + h] + p.gdn_dt_bias[h];
                const float sp = (aa > 20.f) ? aa : log1pf(__expf(aa));
                g = -__expf(p.gdn_a_log[h]) * sp;
            }
            float gc = g;
#pragma unroll
            for (int o = 1; o < 64; o <<= 1) { const float v = __shfl_up(gc, o); if (lane >= o) gc += v; }
            const float glast = __shfl(gc, 63);
            sbeta[c] = beta; sgc[c] = gc; segc[c] = __expf(gc); sekd[c] = __expf(glast - gc); srk[c] = beta * __expf(gc);
            if (lane == 0) p.g_dec[su] = __expf(glast);
        }
        __syncthreads();
        {
            const int which = wave >> 2, ti = (wave >> 1) & 1, tj = wave & 1;
            const int r = lane & 31, hh = lane >> 5;
            f32x16 acc;
#pragma unroll
            for (int i = 0; i < 16; ++i) acc[i] = 0.f;
            const bf16_t* Ap = Kb + (32 * ti + r) * 136 + 8 * hh;
            const bf16_t* Bp = (which ? Qb : Kb) + (32 * tj + r) * 136 + 8 * hh;
#pragma unroll
            for (int ks = 0; ks < 8; ++ks) acc = MFMA32(*(const bf16x8*)(Ap + 16 * ks), *(const bf16x8*)(Bp + 16 * ks), acc);
            const int c = 32 * tj + r;
            const float gcc = sgc[c], bc = sbeta[c];
            if (which == 0) {
#pragma unroll
                for (int reg = 0; reg < 16; ++reg) {
                    const int cp = 32 * ti + crow(reg, hh);
                    const float dcy = __expf(fminf(gcc - sgc[cp], 0.f));
                    Am[c * 68 + cp] = (cp < c) ? (bc * acc[reg] * dcy) : 0.f;
                }
            } else {
                bf16_t* aq = p.g_aqk + su * 4096 + (size_t)c * 64;
#pragma unroll
                for (int g4 = 0; g4 < 4; ++g4) {
                    const int cp0 = 32 * ti + 8 * g4 + 4 * hh;
                    f32x4 v;
#pragma unroll
                    for (int e2 = 0; e2 < 4; ++e2) {
                        const int cp = cp0 + e2;
                        const float dcy = __expf(fminf(gcc - sgc[cp], 0.f));
                        v[e2] = (cp <= c) ? (acc[4 * g4 + e2] * dcy) : 0.f;
                    }
                    st_bf16x4(aq + cp0, v);
                }
            }
        }
        __syncthreads();
        if (wave < 4) {
            const int col = 64 * wave + lane;
            const float* rs = sbeta + __builtin_amdgcn_readfirstlane((wave < 2) ? 0 : 256);
            float x[64];
#pragma unroll
            for (int i = 0; i < 64; ++i) x[i] = RHS[i * 256 + col] * rs[i];
#pragma unroll
            for (int i0 = 0; i0 < 64; i0 += 4) {
                float a0 = x[i0], a1 = x[i0 + 1], a2 = x[i0 + 2], a3 = x[i0 + 3];
#pragma unroll
                for (int j4 = 0; j4 < i0; j4 += 4) {
                    const f32x4 r0 = *(const f32x4*)(Am + (i0) * 68 + j4), r1 = *(const f32x4*)(Am + (i0 + 1) * 68 + j4);
                    const f32x4 r2 = *(const f32x4*)(Am + (i0 + 2) * 68 + j4), r3 = *(const f32x4*)(Am + (i0 + 3) * 68 + j4);
                    a0 -= r0[0] * x[j4]; a1 -= r1[0] * x[j4]; a2 -= r2[0] * x[j4]; a3 -= r3[0] * x[j4];
                    a0 -= r0[1] * x[j4 + 1]; a1 -= r1[1] * x[j4 + 1]; a2 -= r2[1] * x[j4 + 1]; a3 -= r3[1] * x[j4 + 1];
                    a0 -= r0[2] * x[j4 + 2]; a1 -= r1[2] * x[j4 + 2]; a2 -= r2[2] * x[j4 + 2]; a3 -= r3[2] * x[j4 + 2];
                    a0 -= r0[3] * x[j4 + 3]; a1 -= r1[3] * x[j4 + 3]; a2 -= r2[3] * x[j4 + 3]; a3 -= r3[3] * x[j4 + 3];
                    if ((j4 & 12) == 12) asm volatile("" ::: "memory");
                }
                const f32x4 t1 = *(const f32x4*)(Am + (i0 + 1) * 68 + i0), t2 = *(const f32x4*)(Am + (i0 + 2) * 68 + i0), t3 = *(const f32x4*)(Am + (i0 + 3) * 68 + i0);
                a1 -= t1[0] * a0;
                a2 -= t2[0] * a0; a2 -= t2[1] * a1;
                a3 -= t3[0] * a0; a3 -= t3[1] * a1; a3 -= t3[2] * a2;
                x[i0] = a0; x[i0 + 1] = a1; x[i0 + 2] = a2; x[i0 + 3] = a3;
                asm volatile("" ::: "memory");
            }
            if (wave < 2) {
                float* up = p.g_u + su * 8192 + col;
#pragma unroll
                for (int i = 0; i < 64; ++i) up[i * 128] = x[i];
            } else {
                bf16_t* wp = p.g_negw + su * 8192 + (col - 128);
#pragma unroll
                for (int i = 0; i < 64; ++i) wp[i * 128] = f2bf(-x[i]);
            }
        } else {
            const int t2 = tid - 256;
#pragma unroll
            for (int it = 0; it < 4; ++it) {
                const int chk = t2 + 256 * it, c = chk >> 4, d0 = (chk & 15) * 8;
                const float e = segc[c];
                const uint4 raw = *(const uint4*)(Qb + c * 136 + d0);
                uint4 o;
                o.x = pk2(__uint_as_float(raw.x << 16) * e, __uint_as_float(raw.x & 0xffff0000u) * e);
                o.y = pk2(__uint_as_float(raw.y << 16) * e, __uint_as_float(raw.y & 0xffff0000u) * e);
                o.z = pk2(__uint_as_float(raw.z << 16) * e, __uint_as_float(raw.z & 0xffff0000u) * e);
                o.w = pk2(__uint_as_float(raw.w << 16) * e, __uint_as_float(raw.w & 0xffff0000u) * e);
                *(uint4*)(p.g_qg + su * 8192 + c * 128 + d0) = o;
            }
#pragma unroll
            for (int it = 0; it < 4; ++it) {
                const int item = t2 + 256 * it, d = item & 127, c0 = (item >> 7) * 8;
                float v[8];
#pragma unroll
                for (int i = 0; i < 8; ++i) v[i] = bf2f(Kb[(c0 + i) * 136 + d]) * sekd[c0 + i];
                uint4 o; o.x = pk2(v[0], v[1]); o.y = pk2(v[2], v[3]); o.z = pk2(v[4], v[5]); o.w = pk2(v[6], v[7]);
                *(uint4*)(p.g_kdT + su * 8192 + d * 64 + c0) = o;
            }
        }
        __syncthreads();
    }
}

constexpr int GB_NW = 0, GB_QG = 64 * 136, GB_KD = 2 * 64 * 136, GB_AQ = 2 * 64 * 136 + 128 * 72, GB_ELEMS = 2 * 64 * 136 + 128 * 72 + 64 * 72;
__device__ __forceinline__ void gdn_chain(const Params& p, char* smem, int b, int h) {
    bf16_t* lds = (bf16_t*)smem;
    const int tid = tid_opaque(), lane = tid & 63, wave = tid >> 6;
    const int r = lane & 31, hh = lane >> 5;
    const size_t su0 = (size_t)(b * 16 + h) * NCH;
    const bool loader = wave >= 4;
    const int t2 = tid - 256;
    uint4 sa0, sa1, sa2, sa3, sa4, sa5, sa6, sa7, sa8, sa9, sa10, sa11, sa12, sa13;
    uint4 sb0, sb1, sb2, sb3, sb4, sb5, sb6, sb7, sb8, sb9, sb10, sb11, sb12, sb13;
    f32x16 S[4], un0, un1;
#pragma unroll
    for (int i = 0; i < 4; ++i)
#pragma unroll
        for (int j = 0; j < 16; ++j) S[i][j] = 0.f;
    const int ch0 = t2, ch1 = t2 + 256, ch2 = t2 + 512, ch3 = t2 + 768;
#define GB_GLOAD(P, n_) do { const size_t su_ = su0 + (n_); \
        const bf16_t* a_ = p.g_negw + su_ * 8192; const bf16_t* b_ = p.g_qg + su_ * 8192; const bf16_t* c_ = p.g_kdT + su_ * 8192; const bf16_t* d_ = p.g_aqk + su_ * 4096; \
        P##0 = *(const uint4*)(a_ + (size_t)ch0 * 8); P##1 = *(const uint4*)(a_ + (size_t)ch1 * 8); P##2 = *(const uint4*)(a_ + (size_t)ch2 * 8); P##3 = *(const uint4*)(a_ + (size_t)ch3 * 8); \
        P##4 = *(const uint4*)(b_ + (size_t)ch0 * 8); P##5 = *(const uint4*)(b_ + (size_t)ch1 * 8); P##6 = *(const uint4*)(b_ + (size_t)ch2 * 8); P##7 = *(const uint4*)(b_ + (size_t)ch3 * 8); \
        P##8 = *(const uint4*)(c_ + (size_t)ch0 * 8); P##9 = *(const uint4*)(c_ + (size_t)ch1 * 8); P##10 = *(const uint4*)(c_ + (size_t)ch2 * 8); P##11 = *(const uint4*)(c_ + (size_t)ch3 * 8); \
        P##12 = *(const uint4*)(d_ + (size_t)ch0 * 8); P##13 = *(const uint4*)(d_ + (size_t)ch1 * 8); } while (0)
#define GB_SSTORE(P, buf_) do { bf16_t* q_ = (buf_); \
        *(uint4*)(q_ + GB_NW + (ch0 >> 4) * 136 + (ch0 & 15) * 8) = P##0; *(uint4*)(q_ + GB_NW + (ch1 >> 4) * 136 + (ch1 & 15) * 8) = P##1; \
        *(uint4*)(q_ + GB_NW + (ch2 >> 4) * 136 + (ch2 & 15) * 8) = P##2; *(uint4*)(q_ + GB_NW + (ch3 >> 4) * 136 + (ch3 & 15) * 8) = P##3; \
        *(uint4*)(q_ + GB_QG + (ch0 >> 4) * 136 + (ch0 & 15) * 8) = P##4; *(uint4*)(q_ + GB_QG + (ch1 >> 4) * 136 + (ch1 & 15) * 8) = P##5; \
        *(uint4*)(q_ + GB_QG + (ch2 >> 4) * 136 + (ch2 & 15) * 8) = P##6; *(uint4*)(q_ + GB_QG + (ch3 >> 4) * 136 + (ch3 & 15) * 8) = P##7; \
        *(uint4*)(q_ + GB_KD + (ch0 >> 3) * 72 + (ch0 & 7) * 8) = P##8; *(uint4*)(q_ + GB_KD + (ch1 >> 3) * 72 + (ch1 & 7) * 8) = P##9; \
        *(uint4*)(q_ + GB_KD + (ch2 >> 3) * 72 + (ch2 & 7) * 8) = P##10; *(uint4*)(q_ + GB_KD + (ch3 >> 3) * 72 + (ch3 & 7) * 8) = P##11; \
        *(uint4*)(q_ + GB_AQ + (ch0 >> 3) * 72 + (ch0 & 7) * 8) = P##12; *(uint4*)(q_ + GB_AQ + (ch1 >> 3) * 72 + (ch1 & 7) * 8) = P##13; } while (0)
#define GB_ULOAD(n_) do { const float* up_ = p.g_u + (su0 + (n_)) * 8192 + 32 * wave + r; \
        _Pragma("unroll") for (int reg_ = 0; reg_ < 16; ++reg_) { un0[reg_] = up_[(crow(reg_, hh)) * 128]; un1[reg_] = up_[(32 + crow(reg_, hh)) * 128]; } } while (0)
    if (loader) {
        bf16_t* buf0 = lds;
        bf16_t* buf1 = lds + GB_ELEMS;
        GB_GLOAD(sa, 0); GB_SSTORE(sa, buf0);
        GB_GLOAD(sa, 1);
        __syncthreads();
        for (int n = 0; n < NCH; n += 2) {
            if (n + 2 < NCH) { GB_GLOAD(sb, n + 2); }
            if (n + 1 < NCH) { GB_SSTORE(sa, buf1); }
            __syncthreads();
            if (n + 1 >= NCH) break;
            if (n + 3 < NCH) { GB_GLOAD(sa, n + 3); }
            if (n + 2 < NCH) { GB_SSTORE(sb, buf0); }
            __syncthreads();
        }
    } else {
        GB_ULOAD(0);
        float dec_next = p.g_dec[su0];
        __syncthreads();
        for (int n = 0; n < NCH; ++n) {
            unsigned zofs = 0; asm volatile("" : "+v"(zofs));
            bf16_t* cur = lds + (n & 1) * GB_ELEMS + zofs;
            const bool more = (n + 1 < NCH);
            const float dec = dec_next;
            if (more) dec_next = p.g_dec[su0 + n + 1];
            f32x16 vn[2], o[2];
            vn[0] = un0; vn[1] = un1;
#pragma unroll
            for (int j = 0; j < 16; ++j) { o[0][j] = 0.f; o[1][j] = 0.f; }
            if (more) { GB_ULOAD(n + 1); }
#pragma unroll
            for (int kt = 0; kt < 4; ++kt)
#pragma unroll
                for (int s = 0; s < 2; ++s) {
                    const bf16x8 sb = pack_step(S[kt], s);
                    const int k0 = 32 * kt + 16 * s + 4 * hh;
#pragma unroll
                    for (int ct = 0; ct < 2; ++ct) {
                        vn[ct] = MFMA32(frag_perm(cur + GB_NW + (32 * ct + r) * 136 + k0), sb, vn[ct]);
                        o[ct] = MFMA32(frag_perm(cur + GB_QG + (32 * ct + r) * 136 + k0), sb, o[ct]);
                    }
                }
            bf16x8 vb[2][2];
#pragma unroll
            for (int ct = 0; ct < 2; ++ct)
#pragma unroll
                for (int s = 0; s < 2; ++s) vb[ct][s] = pack_step(vn[ct], s);
#pragma unroll
            for (int s = 0; s < 2; ++s) {
                o[0] = MFMA32(frag_perm(cur + GB_AQ + (r) * 72 + 16 * s + 4 * hh), vb[0][s], o[0]);
                o[1] = MFMA32(frag_perm(cur + GB_AQ + (32 + r) * 72 + 16 * s + 4 * hh), vb[0][s], o[1]);
                o[1] = MFMA32(frag_perm(cur + GB_AQ + (32 + r) * 72 + 32 + 16 * s + 4 * hh), vb[1][s], o[1]);
            }
#pragma unroll
            for (int dt = 0; dt < 4; ++dt) {
                S[dt] = S[dt] * dec;
#pragma unroll
                for (int ckt = 0; ckt < 2; ++ckt)
#pragma unroll
                    for (int s = 0; s < 2; ++s)
                        S[dt] = MFMA32(frag_perm(cur + GB_KD + (32 * dt + r) * 72 + 32 * ckt + 16 * s + 4 * hh), vb[ckt][s], S[dt]);
            }
#pragma unroll
            for (int ct = 0; ct < 2; ++ct)
#pragma unroll
                for (int reg = 0; reg < 16; ++reg) {
                    const int t = 64 * n + 32 * ct + crow(reg, hh);
                    if (t < LP) p.g_o[(((size_t)b * LP + t) * 16 + h) * 128 + 32 * wave + r] = o[ct][reg];
                }
            __syncthreads();
        }
    }
    if (!loader) {
#pragma unroll
        for (int dt = 0; dt < 4; ++dt)
#pragma unroll
            for (int reg = 0; reg < 16; ++reg)
                p.gs_prompt[((size_t)(b * 16 + h) * 128 + 32 * dt + crow(reg, hh)) * 128 + 32 * wave + r] = S[dt][reg];
    }
    __syncthreads();
}

__device__ __forceinline__ void gdn_seq_phase(const Params& p, char* smem, int bid, int nb, int rep = 0) {
    if (bid < 64) gdn_chain(p, smem, bid >> 4, bid & 15);
    int* slot = (int*)(smem + LDS_BYTES - 32);
    const int tid = tid_opaque();
    for (;;) {
        if (threadIdx.x == 0) *slot = (int)atomicAdd(p.bar + 3520 + 16 * rep, 1u);
        __syncthreads();
        const int u = *slot;
        __syncthreads();
        if (u >= DB * 16 / 2) break;
        gdn_sample_pass(p, smem, u, tid_opaque());
    }
}

__device__ __forceinline__ void gdn_gate_phase(const Params& p, int bid, int nb) {
    const int tid_ = tid_opaque(); const int lane = tid_ & 63, wave = tid_ >> 6;
    const f32x2 nw = *(const f32x2*)(p.gdn_norm_w + lane * 2);
    for (int it = bid * 8 + wave; it < NPR * 16; it += nb * 8) {
        const f32x2 o = *(const f32x2*)(p.g_o + (size_t)it * 128 + lane * 2);
        const float ss = wave_sum(o[0] * o[0] + o[1] * o[1]);
        const float rms = rsqrtf(ss * (1.f / 128.f) + 1e-6f);
        const unsigned zr = *(const unsigned*)(p.z + (size_t)it * 128 + lane * 2);
        const float z0 = __uint_as_float(zr << 16), z1 = __uint_as_float(zr & 0xffff0000u);
        *(unsigned*)(p.gated + (size_t)it * 128 + lane * 2) = pk2(o[0] * rms * nw[0] * silu(z0), o[1] * rms * nw[1] * silu(z1));
    }
}

__device__ __forceinline__ void rope_cs(int pos, int fi, float& c, float& s) {
    const double rev = (double)pos * kInvFreq[fi] * 0.15915494309189535;
    const float r = (float)(rev - floor(rev));
    c = __builtin_amdgcn_cosf(r);
    s = __builtin_amdgcn_sinf(r);
}
__device__ __forceinline__ void dsa_post_phase(const Params& p, int bid, int nb) {
    const int tid_ = tid_opaque(); const int lane = tid_ & 63, wave = tid_ >> 6;
    for (int row = bid * 8 + wave; row < NT; row += nb * 8) {
        const float* P = p.p1 + (size_t)row * DIN_PAD;
        const bool prompt = row < NPR;
        const int pos = prompt ? (row % LP) : (PAST + ((row - NPR) & 3));
        float* kout = prompt ? (p.k_prompt + (size_t)row * 256) : (p.k_sample + (size_t)(row - NPR) * 256);
        float* vout = prompt ? (p.v_prompt + (size_t)row * 256) : (p.v_sample + (size_t)(row - NPR) * 256);
        for (int e = lane; e < 1280; e += 64) {
            const int d = e & 127;
            float o = P[e];
            if (d < 32) {
                float c, s; rope_cs(pos, d & 15, c, s);
                if (d < 16) o = o * c - P[e + 16] * s; else o = o * c + P[e - 16] * s;
            }
            if (e < 1024) {
                p.qr[(size_t)row * 1024 + e] = o;
                if (prompt) p.q_b[(size_t)row * 1024 + e] = f2bf(o * 0.12751743f);
            } else {
                kout[e - 1024] = o;
                if (prompt) { const int bb = row / LP, kvh = (e - 1024) >> 7; p.k_b[((size_t)(bb * 2 + kvh) * LPAD + pos) * 128 + d] = f2bf(o); }
            }
        }
        for (int e = lane; e < 256; e += 64) {
            const float o = P[1280 + e];
            vout[e] = o;
            if (prompt) { const int bb = row / LP, kvh = e >> 7, d = e & 127; p.vt_b[((size_t)(bb * 2 + kvh) * 128 + d) * LPAD + pos] = f2bf(o); }
        }
        for (int e = lane; e < 512; e += 64) {
            const int d = e & 63;
            float o = P[1536 + e];
            if (d < 16) {
                float c, s; rope_cs(pos, (d & 7) * 2, c, s);
                if (d < 8) o = o * c - P[1536 + e + 8] * s; else o = o * c + P[1536 + e - 8] * s;
            }
            p.iq[(size_t)row * 512 + e] = o;
            if (prompt) p.iq_b[(size_t)row * 512 + e] = f2bf(o);
        }
        {
            const float x = P[2048 + lane];
            const float mu = wave_sum(x) * (1.f / 64.f);
            const float dv = x - mu;
            const float var = wave_sum(dv * dv) * (1.f / 64.f);
            const float xn = dv * rsqrtf(var + 1e-5f) * p.dsa_ik_g[lane] + p.dsa_ik_b[lane];
            const float other = __shfl_xor(xn, 8);
            float o = xn;
            if (lane < 16) {
                float c, s; rope_cs(pos, (lane & 7) * 2, c, s);
                if (lane < 8) o = xn * c - other * s; else o = xn * c + other * s;
            }
            float* io = prompt ? (p.ik_prompt + (size_t)row * 64) : (p.ik_sample + (size_t)(row - NPR) * 64);
            io[lane] = o;
            if (prompt) p.ik_b[((size_t)(row / LP) * LPAD + pos) * 64 + lane] = f2bf(o);
        }
        if (lane < 8) p.iw[(size_t)row * 8 + lane] = P[2112 + lane] * 0.35355339059327373f;
    }
    for (int idx = bid * NTHR + tid_opaque(); idx < BATCH * (LPAD - LP) * 256; idx += nb * NTHR) {
        const int c = idx & 255, tp = (idx >> 8) % (LPAD - LP), bb = idx / ((LPAD - LP) * 256);
        const int t = LP + tp, kvh = c >> 7, d = c & 127;
        p.k_b[((size_t)(bb * 2 + kvh) * LPAD + t) * 128 + d] = 0;
        p.vt_b[((size_t)(bb * 2 + kvh) * 128 + d) * LPAD + t] = 0;
        if (c < 64) p.ik_b[((size_t)bb * LPAD + t) * 64 + c] = 0;
        if (c < 65) p.maskT[((size_t)bb * 65 + c) * LPAD + t] = (c == 0) ? 1ull : 0ull;
    }
}

__device__ __forceinline__ const float* ik_row(const Params& p, bool prompt, int b, int s) {
    if (prompt) return p.ik_prompt + ((size_t)b * LP + s) * 64;
    if (s < PAST) { const int pg = p.page_table[b * 16 + (s >> 7)]; return p.cache_ik + ((size_t)pg * 128 + (s & 127)) * 64; }
    return p.ik_sample + ((size_t)b * DS + (s - PAST)) * 64;
}
__device__ __forceinline__ const float* kv_row(const float* own_p, const float* own_s, const float* cache, const int* page_table,
                                               bool prompt, int b, int s) {
    if (prompt) return own_p + ((size_t)b * LP + s) * 256;
    if (s < PAST) { const int pg = page_table[b * 16 + (s >> 7)]; return cache + ((size_t)pg * 128 + (s & 127)) * 256; }
    return own_s + ((size_t)b * DS + (s - PAST)) * 256;
}

template <bool PROMPT>
__device__ __forceinline__ void select_emit(const float* sc, int qpos, int lane, unsigned long long* maskcol, int* selrow) {
    const unsigned long long ltmask = (1ull << lane) - 1ull;
    unsigned key[65];
#pragma unroll
    for (int j = 0; j < 65; ++j) {
        const int s = j * 64 + lane;
        const float x = (s >= 16 && s <= qpos) ? sc[s] : -INFINITY;
        const unsigned u = __float_as_uint(x);
        key[j] = (u & 0x80000000u) ? ~u : (u | 0x80000000u);
    }
    unsigned T = 0u;
    bool exact = false;
    for (int bit = 31; bit >= 0; --bit) {
        const unsigned cand = T | (1u << bit);
        int c = 0;
#pragma unroll
        for (int j = 0; j < 65; ++j) c += __popcll(__ballot(key[j] >= cand));
        if (c >= 240) { T = cand; if (c == 240) { exact = true; break; } }
    }
    int need_eq = 0;
    if (!exact) {
        int cgt = 0;
#pragma unroll
        for (int j = 0; j < 65; ++j) cgt += __popcll(__ballot(key[j] > T));
        need_eq = 240 - cgt;
    }
    if (!PROMPT) { if (lane < 16) selrow[lane] = lane; }
    int base = 16, erun = 0;
    unsigned long long myword = 0ull, word64 = 0ull;
#pragma unroll
    for (int j = 0; j < 65; ++j) {
        const bool gt = exact ? (key[j] >= T) : (key[j] > T);
        const bool eq = exact ? false : (key[j] == T);
        const unsigned long long meq = __ballot(eq);
        const int rank = erun + __popcll(meq & ltmask);
        const bool take = gt || (eq && rank < need_eq);
        unsigned long long m = __ballot(take);
        if (PROMPT) {
            if (j == 0) m |= 0xFFFFull;
            if (j < 64) { if (lane == j) myword = m; } else word64 = m;
        } else {
            if (take) selrow[base + __popcll(m & ltmask)] = j * 64 + lane;
            base += __popcll(m);
        }
        erun += __popcll(meq);
    }
    if (PROMPT) {
        maskcol[(size_t)lane * LPAD] = myword;
        if (lane == 0) maskcol[(size_t)64 * LPAD] = word64;
    }
}

__device__ __forceinline__ void indexer_sample_row(const Params& p, float* sc, float* qs, int row, int lane) {
    const int b = (row - NPR) >> 2, qpos = PAST + ((row - NPR) & 3);
    int* selrow = p.sel + (size_t)row * 256;
    const int n = qpos - 15;
    for (int j = lane; j < 512; j += 64) qs[j] = p.iq[(size_t)row * 512 + j];
    float w[8];
#pragma unroll
    for (int h = 0; h < 8; ++h) w[h] = p.iw[(size_t)row * 8 + h];
    lds_fence();
    for (int j0 = 0; j0 < n; j0 += 64) {
        const int s = 16 + j0 + lane;
        const bool valid = s <= qpos;
        const float* kp = ik_row(p, false, b, valid ? s : qpos);
        float dh[8];
#pragma unroll
        for (int h = 0; h < 8; ++h) dh[h] = 0.f;
#pragma unroll
        for (int half = 0; half < 2; ++half) {
            f32x4 kv[8];
#pragma unroll
            for (int c = 0; c < 8; ++c) kv[c] = *(const f32x4*)(kp + half * 32 + c * 4);
#pragma unroll
            for (int h = 0; h < 8; ++h) {
                float d = dh[h];
#pragma unroll
                for (int c = 0; c < 8; ++c) {
                    const f32x4 q4 = *(const f32x4*)(qs + h * 64 + half * 32 + c * 4);
                    d += kv[c][0] * q4[0]; d += kv[c][1] * q4[1]; d += kv[c][2] * q4[2]; d += kv[c][3] * q4[3];
                }
                dh[h] = d;
            }
        }
        float score = 0.f;
#pragma unroll
        for (int h = 0; h < 8; ++h) score += w[h] * fmaxf(dh[h], 0.f);
        if (valid) sc[s] = score;
    }
    lds_fence();
    select_emit<false>(sc, qpos, lane, nullptr, selrow);
    lds_fence();
}

__device__ __forceinline__ void indexer_prompt_unit(const Params& p, float* sc, int b, int g8, int tid) {
    const int lane = tid & 63, wave = tid >> 6;
    const int r = lane & 31, hh = lane >> 5;
    const int t0 = g8 * 8;
    if (t0 < 256) {
        const int qpos = t0 + wave;
        unsigned long long* maskcol = p.maskT + (size_t)b * 65 * LPAD + qpos;
        for (int j = lane; j < 65; j += 64) {
            const int lo = j * 64;
            unsigned long long m = 0ull;
            if (qpos >= lo + 63) m = ~0ull; else if (qpos >= lo) m = (1ull << (qpos - lo + 1)) - 1ull;
            maskcol[(size_t)j * LPAD] = m;
        }
        return;
    }
    bf16x8 af[2][4];
    {
        const int e2 = r & 3, hb = (r >> 2) & 1, a = r >> 3;
        const int qi = 2 * hb + (a >> 1), head = 4 * (a & 1) + e2;
#pragma unroll
        for (int rt = 0; rt < 2; ++rt) {
            const bf16_t* ap = p.iq_b + ((size_t)b * LP + t0 + 4 * rt + qi) * 512 + head * 64 + 8 * hh;
#pragma unroll
            for (int ks = 0; ks < 4; ++ks) af[rt][ks] = *(const bf16x8*)(ap + 16 * ks);
        }
    }
    float wq[2][2][8];
#pragma unroll
    for (int rt = 0; rt < 2; ++rt)
#pragma unroll
        for (int ql = 0; ql < 2; ++ql) {
            const float* wp = p.iw + ((size_t)b * LP + t0 + 4 * rt + 2 * hh + ql) * 8;
            const f32x4 w0 = *(const f32x4*)wp, w1 = *(const f32x4*)(wp + 4);
#pragma unroll
            for (int e2 = 0; e2 < 4; ++e2) { wq[rt][ql][e2] = w0[e2]; wq[rt][ql][4 + e2] = w1[e2]; }
        }
    const int nkt = (t0 + 7) / 32 + 1;
    const bf16_t* kbase = p.ik_b + ((size_t)b * LPAD + r) * 64 + 8 * hh;
    bf16x8 bq[4];
    if (wave < nkt) {
#pragma unroll
        for (int ks = 0; ks < 4; ++ks) bq[ks] = *(const bf16x8*)(kbase + (size_t)wave * 32 * 64 + 16 * ks);
    }
    for (int kt = wave; kt < nkt; kt += 8) {
        bf16x8 bn[4];
        const int ktn = (kt + 8 < nkt) ? (kt + 8) : kt;
#pragma unroll
        for (int ks = 0; ks < 4; ++ks) bn[ks] = *(const bf16x8*)(kbase + (size_t)ktn * 32 * 64 + 16 * ks);
#pragma unroll
        for (int rt = 0; rt < 2; ++rt) {
            f32x16 acc;
#pragma unroll
            for (int i = 0; i < 16; ++i) acc[i] = 0.f;
#pragma unroll
            for (int ks = 0; ks < 4; ++ks) acc = MFMA32(af[rt][ks], bq[ks], acc);
#pragma unroll
            for (int ql = 0; ql < 2; ++ql) {
                float s = 0.f;
#pragma unroll
                for (int a2 = 0; a2 < 2; ++a2)
#pragma unroll
                    for (int e2 = 0; e2 < 4; ++e2) s += wq[rt][ql][4 * a2 + e2] * fmaxf(acc[4 * (2 * ql + a2) + e2], 0.f);
                sc[(4 * rt + 2 * hh + ql) * 4160 + 32 * kt + r] = s;
            }
        }
#pragma unroll
        for (int ks = 0; ks < 4; ++ks) bq[ks] = bn[ks];
    }
    __syncthreads();
    {
        const int qpos = t0 + wave;
        select_emit<true>(sc + wave * 4160, qpos, lane, p.maskT + (size_t)b * 65 * LPAD + qpos, nullptr);
    }
    __syncthreads();
}

__device__ __forceinline__ void indexer_phase(const Params& p, char* smem, int bid, int nb, int rep = 0) {
    int* slot = (int*)(smem + LDS_BYTES - 32);
    for (;;) {
        const int tid = tid_opaque();
        unsigned zofs = 0; asm volatile("" : "+v"(zofs));
        float* sc = (float*)(smem + zofs);
        if (threadIdx.x == 0) *slot = (int)atomicAdd(p.bar + 3648 + 16 * rep, 1u);
        __syncthreads();
        const int u = *slot;
        __syncthreads();
        if (u >= 64 + BATCH * 514) break;
        if (u < 64) {
            const int wave = tid >> 6;
            indexer_sample_row(p, sc + wave * 4160, sc + 8 * 4160 + wave * 512, NPR + u * 8 + wave, tid & 63);
            __syncthreads();
        } else {
            const int v = u - 64;
            indexer_prompt_unit(p, sc, v & 3, 513 - (v >> 2), tid);
        }
    }
}

__device__ __forceinline__ void attn_sample_query(const Params& p, char* smem, int row) {
    float* qs = (float*)smem;
    float* ps = qs + 1024;
    int* sidx = (int*)(ps + 2048);
    const int tid = tid_opaque(), lane = tid & 63, wave = tid >> 6;
    const bool prompt = false;
    const int b = (row - NPR) >> 2;
    qs[tid] = p.qr[(size_t)row * 1024 + tid];
    qs[tid + 512] = p.qr[(size_t)row * 1024 + 512 + tid];
    if (tid < 256) sidx[tid] = p.sel[(size_t)row * 256 + tid];
    __syncthreads();
    {
        const int j = tid & 255, kvh = tid >> 8;
        const int s = sidx[j];
        const bool valid = s >= 0;
        const float* kp = kv_row(p.k_prompt, p.k_sample, p.cache_k, p.page_table, prompt, b, valid ? s : 0) + kvh * 128;
        float d0 = 0.f, d1 = 0.f, d2 = 0.f, d3 = 0.f;
        const float* q0 = qs + (kvh * 4) * 128;
#pragma unroll 8
        for (int c = 0; c < 32; ++c) {
            const f32x4 kv = *(const f32x4*)(kp + c * 4);
            const f32x4 a0 = *(const f32x4*)(q0 + c * 4), a1 = *(const f32x4*)(q0 + 128 + c * 4), a2 = *(const f32x4*)(q0 + 256 + c * 4),
                        a3 = *(const f32x4*)(q0 + 384 + c * 4);
            d0 += kv[0] * a0[0] + kv[1] * a0[1] + kv[2] * a0[2] + kv[3] * a0[3];
            d1 += kv[0] * a1[0] + kv[1] * a1[1] + kv[2] * a1[2] + kv[3] * a1[3];
            d2 += kv[0] * a2[0] + kv[1] * a2[1] + kv[2] * a2[2] + kv[3] * a2[3];
            d3 += kv[0] * a3[0] + kv[1] * a3[1] + kv[2] * a3[2] + kv[3] * a3[3];
        }
        const float sc = 0.08838834764831845f;
        ps[(kvh * 4 + 0) * 256 + j] = valid ? d0 * sc : -INFINITY;
        ps[(kvh * 4 + 1) * 256 + j] = valid ? d1 * sc : -INFINITY;
        ps[(kvh * 4 + 2) * 256 + j] = valid ? d2 * sc : -INFINITY;
        ps[(kvh * 4 + 3) * 256 + j] = valid ? d3 * sc : -INFINITY;
    }
    __syncthreads();
    {
        float v[4]; float m = -INFINITY;
#pragma unroll
        for (int i = 0; i < 4; ++i) { v[i] = ps[wave * 256 + lane + 64 * i]; m = fmaxf(m, v[i]); }
        m = wave_max(m);
        float sum = 0.f;
#pragma unroll
        for (int i = 0; i < 4; ++i) { v[i] = __expf(v[i] - m); sum += v[i]; }
        sum = wave_sum(sum);
        const float inv = 1.f / sum;
#pragma unroll
        for (int i = 0; i < 4; ++i) ps[wave * 256 + lane + 64 * i] = v[i] * inv;
    }
    __syncthreads();
    {
        const int h = wave, d = lane * 2, kvh = h >> 2;
        float o0 = 0.f, o1 = 0.f;
#pragma unroll 16
        for (int j = 0; j < 256; ++j) {
            int s = sidx[j]; if (s < 0) s = 0;
            const float* vp = kv_row(p.v_prompt, p.v_sample, p.cache_v, p.page_table, prompt, b, s) + kvh * 128 + d;
            const float pj = ps[h * 256 + j];
            const float2 vv = *(const float2*)vp;
            o0 += pj * vv.x; o1 += pj * vv.y;
        }
        *(unsigned*)(p.gated + (size_t)row * 1024 + h * 128 + d) = pk2(o0, o1);
    }
    __syncthreads();
}

constexpr int AT_K = 0, AT_V = 64 * 136, AT_ELEMS = 64 * 136 + 128 * 72;
__device__ __forceinline__ void attn_dense_unit(const Params& p, char* smem, int b, int kvh, int qb) {
    bf16_t* lds = (bf16_t*)smem;
    const int tid = tid_opaque(), lane = tid & 63, wave = tid >> 6;
    const int r = lane & 31, hh = lane >> 5;
    const int g = wave & 3, qs = wave >> 2;
    const int head = kvh * 4 + g;
    const int tq = 64 * qb + 32 * qs + r;
    const int tqc = (tq < LP) ? tq : (LP - 1);
    bf16x8 qf[8];
    {
        const bf16_t* qp = p.q_b + ((size_t)b * LP + tqc) * 1024 + head * 128 + 8 * hh;
#pragma unroll
        for (int ks = 0; ks < 8; ++ks) qf[ks] = *(const bf16x8*)(qp + 16 * ks);
    }
    f32x16 O[4];
#pragma unroll
    for (int i = 0; i < 4; ++i)
#pragma unroll
        for (int j = 0; j < 16; ++j) O[i][j] = 0.f;
    float mrun = -3.0e38f, lrun = 0.f;
    const bf16_t* Kg = p.k_b + ((size_t)(b * 2 + kvh) * LPAD) * 128;
    const bf16_t* Vg = p.vt_b + ((size_t)(b * 2 + kvh) * 128) * LPAD;
    const unsigned long long* mcol = p.maskT + (size_t)b * 65 * LPAD + tq;
    const int kc0 = tid, kc1 = tid + 512;
    uint4 sk0, sk1, sv0, sv1;
#define AT_GLOAD(kt_) do { const bf16_t* kg_ = Kg + (size_t)(kt_) * 64 * 128; const bf16_t* vg_ = Vg + (size_t)(kt_) * 64; \
        sk0 = *(const uint4*)(kg_ + (size_t)kc0 * 8); sk1 = *(const uint4*)(kg_ + (size_t)kc1 * 8); \
        sv0 = *(const uint4*)(vg_ + (size_t)(kc0 >> 3) * LPAD + (kc0 & 7) * 8); sv1 = *(const uint4*)(vg_ + (size_t)(kc1 >> 3) * LPAD + (kc1 & 7) * 8); } while (0)
#define AT_SSTORE(buf_) do { bf16_t* q_ = (buf_); \
        *(uint4*)(q_ + AT_K + (kc0 >> 4) * 136 + (kc0 & 15) * 8) = sk0; *(uint4*)(q_ + AT_K + (kc1 >> 4) * 136 + (kc1 & 15) * 8) = sk1; \
        *(uint4*)(q_ + AT_V + (kc0 >> 3) * 72 + (kc0 & 7) * 8) = sv0; *(uint4*)(q_ + AT_V + (kc1 >> 3) * 72 + (kc1 & 7) * 8) = sv1; } while (0)
    AT_GLOAD(0); AT_SSTORE(lds);
    __syncthreads();
    for (int kt = 0; kt <= qb; ++kt) {
        unsigned zofs = 0; asm volatile("" : "+v"(zofs));
        bf16_t* cur = lds + (kt & 1) * AT_ELEMS + zofs;
        bf16_t* nxt = lds + ((kt + 1) & 1) * AT_ELEMS + zofs;
        const bool more = kt < qb;
        if (more) { AT_GLOAD(kt + 1); }
        const unsigned long long mw = mcol[(size_t)kt * LPAD];
        f32x16 st[2];
#pragma unroll
        for (int j = 0; j < 16; ++j) { st[0][j] = 0.f; st[1][j] = 0.f; }
#pragma unroll
        for (int ks = 0; ks < 8; ++ks) {
            st[0] = MFMA32(*(const bf16x8*)(cur + AT_K + (r) * 136 + 16 * ks + 8 * hh), qf[ks], st[0]);
            st[1] = MFMA32(*(const bf16x8*)(cur + AT_K + (32 + r) * 136 + 16 * ks + 8 * hh), qf[ks], st[1]);
        }
        float mx = -3.0e38f;
#pragma unroll
        for (int kk = 0; kk < 2; ++kk) {
            const unsigned w = (unsigned)(mw >> (32 * kk)) >> (4 * hh);
#pragma unroll
            for (int reg = 0; reg < 16; ++reg) {
                const int bit = (reg & 3) + 8 * (reg >> 2);
                const float v = ((w >> bit) & 1u) ? st[kk][reg] : -3.0e38f;
                st[kk][reg] = v;
                mx = fmaxf(mx, v);
            }
        }
        mx = fmaxf(mx, __shfl_xor(mx, 32));
        const float mnew = fmaxf(mrun, mx);
        const float alpha = __builtin_amdgcn_exp2f(mrun - mnew);
        mrun = mnew;
        float psum = 0.f;
#pragma unroll
        for (int kk = 0; kk < 2; ++kk)
#pragma unroll
            for (int reg = 0; reg < 16; ++reg) { const float pv = __builtin_amdgcn_exp2f(st[kk][reg] - mnew); st[kk][reg] = pv; psum += pv; }
        lrun = lrun * alpha + psum;
#pragma unroll
        for (int dt = 0; dt < 4; ++dt) O[dt] = O[dt] * alpha;
        bf16x8 pb[2][2];
#pragma unroll
        for (int kk = 0; kk < 2; ++kk)
#pragma unroll
            for (int s = 0; s < 2; ++s) pb[kk][s] = pack_step(st[kk], s);
#pragma unroll
        for (int dt = 0; dt < 4; ++dt)
#pragma unroll
            for (int kk = 0; kk < 2; ++kk)
#pragma unroll
                for (int s = 0; s < 2; ++s)
                    O[dt] = MFMA32(frag_perm(cur + AT_V + (32 * dt + r) * 72 + 32 * kk + 16 * s + 4 * hh), pb[kk][s], O[dt]);
        if (more) { AT_SSTORE(nxt); }
        __syncthreads();
    }
    const float ltot = lrun + __shfl_xor(lrun, 32);
    const float inv = 1.f / ltot;
    if (tq < LP) {
        bf16_t* op = p.gated + ((size_t)b * LP + tq) * 1024 + head * 128;
#pragma unroll
        for (int dt = 0; dt < 4; ++dt)
#pragma unroll
            for (int g4 = 0; g4 < 4; ++g4) {
                f32x4 v;
#pragma unroll
                for (int e2 = 0; e2 < 4; ++e2) v[e2] = O[dt][4 * g4 + e2] * inv;
                st_bf16x4(op + 32 * dt + 8 * g4 + 4 * hh, v);
            }
    }
    __syncthreads();
}

__device__ __forceinline__ void attn_phase(const Params& p, char* smem, int bid, int nb, int rep = 0) {
    int* slot = (int*)(smem + LDS_BYTES - 32);
    for (;;) {
        if (threadIdx.x == 0) *slot = (int)atomicAdd(p.bar + 3584 + 16 * rep, 1u);
        __syncthreads();
        const int u = *slot;
        __syncthreads();
        if (u >= 520 + NSR) break;
        if (u < 520) attn_dense_unit(p, smem, (u & 7) >> 1, u & 1, 64 - (u >> 3));
        else attn_sample_query(p, smem, NPR + (u - 520));
    }
}

#define XB_TMO      128
#define XB_XCNT(j)  (256  + 64 * (j))
#define XB_XSUB(j)  (1280 + 64 * (j))
#define XB_XGEN(j)  (2304 + 64 * (j))
#define XB_TOP      3328
#define XB_TOPGEN   3392
#define XCD_BAR_WORDS 3456
#define XB_SPIN_CAP (1u << 18)
#define LAS __attribute__((address_space(3)))

__device__ __forceinline__ unsigned xb_ld(unsigned* p)              { return __hip_atomic_load(p, __ATOMIC_RELAXED, __HIP_MEMORY_SCOPE_AGENT); }
__device__ __forceinline__ unsigned xb_add(unsigned* p, unsigned v) { return __hip_atomic_fetch_add(p, v, __ATOMIC_RELAXED, __HIP_MEMORY_SCOPE_AGENT); }
__device__ __forceinline__ unsigned xb_xcc_id() { return (unsigned)__builtin_amdgcn_s_getreg((3 << 11) | 20) & 0xFu; }
#define XB_SPIN(cond, bar) do { unsigned _sp = 0; while (cond) { __builtin_amdgcn_s_sleep(1); \
    if ((++_sp & 255u) == 0u) { if (xb_ld(&(bar)[XB_TMO])) break; if (_sp > XB_SPIN_CAP) { atomicAdd(&(bar)[XB_TMO], 1u); break; } } } } while (0)

struct XcdBarrier {
    unsigned* bar; unsigned x;
    volatile LAS unsigned* st;
};

__device__ __forceinline__ XcdBarrier xcd_barrier_post(unsigned* bar, volatile LAS unsigned* st) {
    XcdBarrier b; b.bar = bar; b.x = xb_xcc_id(); b.st = st;
    if (threadIdx.x == 0) (void)xb_add(&bar[XB_XCNT(b.x)], 1u);
    return b;
}
__device__ __forceinline__ void xcd_barrier_complete(unsigned* bar, unsigned x, unsigned& nloc, unsigned& nx) {
    const unsigned G = gridDim.x * gridDim.y * gridDim.z;
    unsigned sum, cnt, mine, sp = 0u;
    for (;;) {
        sum = 0u; cnt = 0u; mine = 0u;
#pragma unroll
        for (unsigned j = 0; j < 16; ++j) { const unsigned c = xb_ld(&bar[XB_XCNT(j)]); sum += c; cnt += (c > 0u) ? 1u : 0u; mine = (j == x) ? c : mine; }
        if (sum == G) break;
        __builtin_amdgcn_s_sleep(1);
        if ((++sp & 255u) == 0u) { if (xb_ld(&bar[XB_TMO])) break; if (sp > XB_SPIN_CAP) { atomicAdd(&bar[XB_TMO], 1u); break; } }
    }
    nloc = mine > 0u ? mine : 1u; nx = cnt > 0u ? cnt : 1u;
}

__device__ __forceinline__ void xcd_barrier(const XcdBarrier& b) {
    asm volatile("s_waitcnt vmcnt(0)" ::: "memory");
    __syncthreads();
    if (threadIdx.x == 0) {
        unsigned* bar = b.bar;
        __builtin_amdgcn_s_waitcnt(0);
        unsigned nloc = b.st[0], nx = b.st[1];
        if (nloc == 0u) { xcd_barrier_complete(bar, b.x, nloc, nx); b.st[0] = nloc; b.st[1] = nx; }
        const unsigned old = xb_add(&bar[XB_XSUB(b.x)], 1u);
        const unsigned gen = old / nloc;
        if (old + 1u == (gen + 1u) * nloc) {
            __builtin_amdgcn_fence(__ATOMIC_RELEASE, "agent");
            asm volatile("s_waitcnt vmcnt(0)" ::: "memory");
            const unsigned og = xb_add(&bar[XB_TOP], 1u);
            const unsigned tg = og / nx;
            if (og + 1u == (tg + 1u) * nx) xb_add(&bar[XB_TOPGEN], 1u);
            else XB_SPIN(xb_ld(&bar[XB_TOPGEN]) == tg, bar);
            __builtin_amdgcn_fence(__ATOMIC_ACQUIRE, "agent");
            xb_add(&bar[XB_XGEN(b.x)], 1u);
            asm volatile("s_waitcnt vmcnt(0)" ::: "memory");
        } else {
            XB_SPIN(xb_ld(&bar[XB_XGEN(b.x)]) == gen, bar);
            __builtin_amdgcn_fence(__ATOMIC_ACQUIRE, "agent");
            asm volatile("s_waitcnt vmcnt(0)" ::: "memory");
        }
    }
    __syncthreads();
}


constexpr int NPHASE = 19;
template <int PH>
__device__ __forceinline__ void run_phase(const Params& p, char* smem, int bid, int nb, int rep = 0) {
    constexpr int MT = MPAD / 256;
    if constexpr (PH == 0) phase_prologue(p, smem, bid, nb);
    else if constexpr (PH == 1) gemm_big(p.hA, D, p.wt_gin, GIN_PAD, EpiGdnIn{p.mixed, p.z, p.ba}, smem, bid, nb);
    else if constexpr (PH == 2) gdn_stageA(p, smem, bid, nb);
    else if constexpr (PH == 3) gdn_seq_phase(p, smem, bid, nb, rep);
    else if constexpr (PH == 4) gdn_gate_phase(p, bid, nb);
    else if constexpr (PH == 5) gemm_n1024(p.gated, 2048, p.wt_gout, EpiResid{p.preln, p.hA}, EpiResidAtomic{p.preln, p.hA}, 8, smem, bid, nb);
    else if constexpr (PH == 6) ln_phase(p.preln, p.ln1_g, p.ln1_b, p.hB, nullptr, nullptr, bid, nb);
    else if constexpr (PH == 7) gemm_big(p.hB, D, p.wt_w1, DFF, EpiRelu2{p.act}, smem, bid, nb);
    else if constexpr (PH == 8) gemm_n1024(p.act, DFF, p.wt_w2, EpiResid{p.preln, p.hB}, EpiResidAtomic{p.preln, p.hB}, 16, smem, bid, nb);
    else if constexpr (PH == 9) ln_phase(p.preln, p.ln2_g, p.ln2_b, p.hA, nullptr, nullptr, bid, nb);
    else if constexpr (PH == 10) gemm_big(p.hA, D, p.wt_din, DIN_PAD, EpiF32{p.p1, DIN_PAD}, smem, bid, nb);
    else if constexpr (PH == 11) dsa_post_phase(p, bid, nb);
    else if constexpr (PH == 12) indexer_phase(p, smem, bid, nb, rep);
    else if constexpr (PH == 13) attn_phase(p, smem, bid, nb, rep);
    else if constexpr (PH == 14) gemm_n1024(p.gated, D, p.wt_do, EpiResid{p.preln, p.hA}, EpiResidAtomic{p.preln, p.hA}, 4, smem, bid, nb);
    else if constexpr (PH == 15) ln_phase(p.preln, p.ln1_g + D, p.ln1_b + D, p.hB, nullptr, nullptr, bid, nb);
    else if constexpr (PH == 16) gemm_big(p.hB, D, p.wt_w1 + (size_t)D * DFF, DFF, EpiRelu2{p.act}, smem, bid, nb);
    else if constexpr (PH == 17) gemm_n1024(p.act, DFF, p.wt_w2 + (size_t)D * DFF, EpiResid{p.preln, p.hB}, EpiResidAtomic{p.preln, p.hB}, 16, smem, bid, nb);
    else if constexpr (PH == 18) ln_phase(p.preln, p.ln2_g + D, p.ln2_b + D, nullptr, p.y_prompt, p.y_sample, bid, nb);
}

template <int PH>
__global__ void __launch_bounds__(NTHR, 2) k_phase(Params p) {
    extern __shared__ __attribute__((aligned(16))) char smem[];
    run_phase<PH>(p, smem, blockIdx.x, gridDim.x);
}

template <int PH>
__device__ __forceinline__ void mega_run(const Params& p, char* smem, const XcdBarrier& bar) {
    run_phase<PH>(p, smem, blockIdx.x, gridDim.x);
#ifdef PROBE_MASK
    if constexpr ((PROBE_MASK >> PH) & 1) { xcd_barrier(bar); run_phase<PH>(p, smem, blockIdx.x, gridDim.x, 1); }
#endif
    if constexpr (PH + 1 < NPHASE) {
        xcd_barrier(bar);
        mega_run<PH + 1>(p, smem, bar);
    }
}
__global__ void __launch_bounds__(NTHR, 2) k_mega(Params p) {
    extern __shared__ __attribute__((aligned(16))) char smem[];
    volatile LAS unsigned* st = (volatile LAS unsigned*)(smem + LDS_BYTES - 16);
    if (threadIdx.x == 0) { st[0] = 0u; st[1] = 0u; st[2] = 0u; st[3] = 0u; }
    __syncthreads();
    XcdBarrier bar = xcd_barrier_post(p.bar, st);
    mega_run<0>(p, smem, bar);
}

template <int PH>
void launch_phase(const Params& p, hipStream_t stream) {
    static bool attr_done = false;
    if (!attr_done) {
        (void)hipFuncSetAttribute((const void*)k_phase<PH>, hipFuncAttributeMaxDynamicSharedMemorySize, LDS_BYTES);
        attr_done = true;
    }
    hipLaunchKernelGGL(k_phase<PH>, dim3(256), dim3(NTHR), LDS_BYTES, stream, p);
}
template <int PH>
void launch_all(const Params& p, hipStream_t stream) {
    launch_phase<PH>(p, stream);
    if constexpr (PH + 1 < NPHASE) launch_all<PH + 1>(p, stream);
}

}

extern "C" void kernel_launch(void* const* d_in, const int* in_sizes, int n_in, void* d_out, int out_size, void* d_ws, size_t ws_size,
                              hipStream_t stream) {
    Params p{};
    p.x_prompt = (const float*)d_in[0]; p.x_sample = (const float*)d_in[1]; p.state_gdn = (const float*)d_in[2];
    p.state_conv = (const float*)d_in[3]; p.cache_k = (const float*)d_in[4]; p.cache_v = (const float*)d_in[5];
    p.cache_ik = (const float*)d_in[6]; p.page_table = (const int*)d_in[7]; p.meta = (const float*)d_in[8];
    p.ln1_g = (const float*)d_in[9]; p.ln1_b = (const float*)d_in[10]; p.ln2_g = (const float*)d_in[11]; p.ln2_b = (const float*)d_in[12];
    p.mlp_w1 = (const float*)d_in[13]; p.mlp_w2 = (const float*)d_in[14]; p.gdn_w_in = (const float*)d_in[15];
    p.gdn_conv_w = (const float*)d_in[16]; p.gdn_a_log = (const float*)d_in[17]; p.gdn_dt_bias = (const float*)d_in[18];
    p.gdn_norm_w = (const float*)d_in[19]; p.gdn_w_out = (const float*)d_in[20]; p.dsa_w_in = (const float*)d_in[21];
    p.dsa_ik_g = (const float*)d_in[22]; p.dsa_ik_b = (const float*)d_in[23]; p.dsa_w_o = (const float*)d_in[24];
    float* o = (float*)d_out;
    p.y_prompt = o; o += (size_t)BATCH * SEQ * D;
    p.y_sample = o; o += (size_t)NSR * D;
    p.gs_prompt = o; o += (size_t)BATCH * 16 * 128 * 128;
    p.gc_prompt = o; o += (size_t)BATCH * 3 * 4096;
    p.gs_sample = o; o += (size_t)DB * 16 * 128 * 128;
    p.gc_sample = o; o += (size_t)DB * 3 * 4096;
    p.k_prompt = o; o += (size_t)NPR * 256;
    p.v_prompt = o; o += (size_t)NPR * 256;
    p.ik_prompt = o; o += (size_t)NPR * 64;
    p.k_sample = o; o += (size_t)NSR * 256;
    p.v_sample = o; o += (size_t)NSR * 256;
    p.ik_sample = o; o += (size_t)NSR * 64;
    char* w = (char*)d_ws;
    auto take = [&](size_t bytes) { char* r = w; w += (bytes + 255) & ~(size_t)255; return r; };
    p.bar = (unsigned*)take(16384);
    p.wt_gin = (bf16_t*)take((size_t)GIN_PAD * D * 2);
    p.wt_gout = (bf16_t*)take((size_t)D * 2048 * 2);
    p.wt_w1 = (bf16_t*)take((size_t)2 * D * DFF * 2);
    p.wt_w2 = (bf16_t*)take((size_t)2 * D * DFF * 2);
    p.wt_din = (bf16_t*)take((size_t)DIN_PAD * D * 2);
    p.wt_do = (bf16_t*)take((size_t)D * D * 2);
    p.hA = (bf16_t*)take((size_t)MPAD * D * 2);
    p.hB = (bf16_t*)take((size_t)MPAD * D * 2);
    p.preln = (float*)take((size_t)MPAD * D * 4);
    p.mixed = (bf16_t*)take((size_t)MPAD * 4096 * 2);
    p.z = (bf16_t*)take((size_t)MPAD * 2048 * 2);
    p.ba = (float*)take((size_t)MPAD * 32 * 4);
    p.gated = (bf16_t*)take((size_t)MPAD * 2048 * 2);
    p.act = (bf16_t*)take((size_t)MPAD * DFF * 2);
    p.p1 = (float*)take((size_t)MPAD * DIN_PAD * 4);
    p.qr = (float*)take((size_t)MPAD * 1024 * 4);
    p.iq = (float*)take((size_t)MPAD * 512 * 4);
    p.iw = (float*)take((size_t)MPAD * 8 * 4);
    p.sel = (int*)take((size_t)MPAD * 256 * 4);
    p.g_o = (float*)take((size_t)NPR * 2048 * 4);
    p.q_b = (bf16_t*)take((size_t)NPR * 1024 * 2);
    p.k_b = (bf16_t*)take((size_t)BATCH * 2 * LPAD * 128 * 2);
    p.vt_b = (bf16_t*)take((size_t)BATCH * 2 * 128 * LPAD * 2);
    p.iq_b = (bf16_t*)take((size_t)NPR * 512 * 2);
    p.ik_b = (bf16_t*)take((size_t)BATCH * LPAD * 64 * 2);
    p.maskT = (unsigned long long*)take((size_t)BATCH * 65 * LPAD * 8);
    p.g_dec = (float*)take((size_t)NCU * 4);
    p.g_u = (float*)p.act;
    p.g_negw = (bf16_t*)p.p1;
    p.g_qg = p.g_negw + (size_t)NCU * 8192;
    p.g_kdT = (bf16_t*)p.qr;
    p.g_aqk = (bf16_t*)p.iq;
    if ((size_t)(w - (char*)d_ws) > ws_size) { fprintf(stderr, "kernel_launch: workspace too small (%zu needed, %zu given)\n", (size_t)(w - (char*)d_ws), ws_size); return; }
#if MEGA
    static int grid = 0;
    if (grid == 0) {
        int dev = 0, cus = 0;
        if (hipGetDevice(&dev) != hipSuccess || hipDeviceGetAttribute(&cus, hipDeviceAttributeMultiprocessorCount, dev) != hipSuccess || cus <= 0) cus = 256;
        (void)hipFuncSetAttribute((const void*)k_mega, hipFuncAttributeMaxDynamicSharedMemorySize, LDS_BYTES);
        grid = cus;
    }
    (void)hipMemsetAsync(p.bar, 0, 16384, stream);
    hipLaunchKernelGGL(k_mega, dim3(grid), dim3(NTHR), LDS_BYTES, stream, p);
#else
    launch_all<0>(p, stream);
#endif
}
```

```cpp
#include <hip/hip_runtime.h>
#include <stdint.h>
#include <stdio.h>

#ifndef MEGA
#define MEGA 1
#endif

namespace {

typedef unsigned short bf16_t;
typedef short bf16x8 __attribute__((ext_vector_type(8)));
typedef float f32x4 __attribute__((ext_vector_type(4)));

constexpr int D = 1024, BATCH = 4, SEQ = 4096, NMETA = 16, LP = SEQ + NMETA;
constexpr int DB = 128, DS = 4, PAST = 2048;
constexpr int NPR = BATCH * LP;
constexpr int NSR = DB * DS;
constexpr int NT = NPR + NSR;
constexpr int MPAD = 17152;
constexpr int DFF = 4096;
constexpr int GIN = 6176, GIN_PAD = 6400;
constexpr int DIN = 2120, DIN_PAD = 2304;
constexpr int NTHR = 512;
constexpr int LPAD = 4160;
constexpr int LDS_BYTES = 150 * 1024;
constexpr float ALPHA = 1.4142135623730951f;

struct Params {
    const float *x_prompt, *x_sample, *state_gdn, *state_conv, *cache_k, *cache_v, *cache_ik;
    const int* page_table;
    const float *meta, *ln1_g, *ln1_b, *ln2_g, *ln2_b, *mlp_w1, *mlp_w2, *gdn_w_in, *gdn_conv_w, *gdn_a_log, *gdn_dt_bias,
        *gdn_norm_w, *gdn_w_out, *dsa_w_in, *dsa_ik_g, *dsa_ik_b, *dsa_w_o;
    float *y_prompt, *y_sample, *gs_prompt, *gc_prompt, *gs_sample, *gc_sample, *k_prompt, *v_prompt, *ik_prompt, *k_sample,
        *v_sample, *ik_sample;
    unsigned* bar;
    bf16_t *wt_gin, *wt_gout, *wt_w1, *wt_w2, *wt_din, *wt_do;
    bf16_t *hA, *hB;
    float* preln;
    bf16_t *mixed, *z;
    float* ba;
    bf16_t *gated, *act;
    float *p1, *qr, *iq, *iw;
    int* sel;
    bf16_t *g_negw, *g_qg, *g_kdT, *g_aqk;
    float *g_u, *g_dec;
    bf16_t* g_o;
    float* rope_tab;
    bf16_t *q_b, *k_b, *vt_b, *iq_b, *ik_b;
    unsigned long long* maskT;
};

__device__ const double kInvFreq[16] = {1.0, 0.44036660267178046, 0.19392274474868576, 0.08539710028576561,
    0.03760603093086393, 0.016560440080994446, 0.007292664737217109, 0.003211445994752591, 0.001414213562373095,
    0.000622772421914596, 0.0002742481756762073, 0.00012076973741146504, 5.318295896944988e-05, 2.341999896140934e-05,
    1.031338537721246e-05, 4.5416704806078695e-06};

__device__ __forceinline__ float bf2f(bf16_t h) { return __uint_as_float(((unsigned)h) << 16); }
typedef __bf16 hwbf16x2 __attribute__((ext_vector_type(2)));
typedef float f32x2 __attribute__((ext_vector_type(2)));
typedef float f32x16 __attribute__((ext_vector_type(16)));
typedef unsigned u32x4 __attribute__((ext_vector_type(4)));
__device__ __forceinline__ unsigned pk2(float lo, float hi) {
    const f32x2 v = {lo, hi};
    return __builtin_bit_cast(unsigned, __builtin_convertvector(v, hwbf16x2));
}
__device__ __forceinline__ bf16_t f2bf(float f) { return (bf16_t)(pk2(f, 0.f) & 0xffffu); }
__device__ __forceinline__ void st_bf16x4(bf16_t* p, f32x4 v) {
    uint2 o; o.x = pk2(v[0], v[1]); o.y = pk2(v[2], v[3]);
    *(uint2*)p = o;
}
__device__ __forceinline__ f32x4 cvt_bf16x4(uint2 o) {
    f32x4 v; v[0] = __uint_as_float(o.x << 16); v[1] = __uint_as_float(o.x & 0xffff0000u);
    v[2] = __uint_as_float(o.y << 16); v[3] = __uint_as_float(o.y & 0xffff0000u);
    return v;
}
__device__ __forceinline__ f32x4 ld_bf16x4(const bf16_t* p) {
    uint2 o = *(const uint2*)p;
    f32x4 v; v[0] = __uint_as_float(o.x << 16); v[1] = __uint_as_float(o.x & 0xffff0000u);
    v[2] = __uint_as_float(o.y << 16); v[3] = __uint_as_float(o.y & 0xffff0000u);
    return v;
}
__device__ __forceinline__ float wave_sum(float v) {
#pragma unroll
    for (int o = 1; o < 64; o <<= 1) v += __shfl_xor(v, o);
    return v;
}
__device__ __forceinline__ float wave_max(float v) {
#pragma unroll
    for (int o = 1; o < 64; o <<= 1) v = fmaxf(v, __shfl_xor(v, o));
    return v;
}
__device__ __forceinline__ int wave_sum_i(int v) {
#pragma unroll
    for (int o = 1; o < 64; o <<= 1) v += __shfl_xor(v, o);
    return v;
}
__device__ __forceinline__ float silu(float x) { return x * __builtin_amdgcn_rcpf(1.f + __expf(-x)); }
__device__ __forceinline__ int tid_opaque() { int t = threadIdx.x; asm volatile("" : "+v"(t)); return t; }
__device__ __forceinline__ void lds_fence() { asm volatile("s_waitcnt lgkmcnt(0)" ::: "memory"); }

__device__ __forceinline__ void transpose_convert(const float* __restrict__ W, int K, int N, int Npad, bf16_t* __restrict__ WT, float* tile,
                                  int bid, int nb) {
    const int tid = tid_opaque();
    const int tk = K / 64, tn = Npad / 64;
    for (int it = bid; it < tk * tn; it += nb) {
        const int kb = it / tn, nbk = it % tn, k0 = kb * 64, n0 = nbk * 64;
#pragma unroll
        for (int i = 0; i < 8; ++i) {
            const int r = (tid >> 6) + 8 * i, c = tid & 63, n = n0 + c;
            tile[r * 65 + c] = (n < N) ? W[(size_t)(k0 + r) * N + n] : 0.f;
        }
        __syncthreads();
        {
            const int rn = tid >> 3, c8 = (tid & 7) * 8;
            const float* tp = tile + c8 * 65 + rn;
            uint4 o;
            o.x = pk2(tp[0], tp[65]); o.y = pk2(tp[2 * 65], tp[3 * 65]); o.z = pk2(tp[4 * 65], tp[5 * 65]); o.w = pk2(tp[6 * 65], tp[7 * 65]);
            *(uint4*)(WT + (size_t)(n0 + rn) * K + k0 + c8) = o;
        }
        __syncthreads();
    }
}

__device__ __forceinline__ void phase_prologue(const Params& p, char* smem, int bid, int nb) {
    float* tile = (float*)smem;
    transpose_convert(p.gdn_w_in, D, GIN, GIN_PAD, p.wt_gin, tile, bid, nb);
    transpose_convert(p.gdn_w_out, 2048, D, D, p.wt_gout, tile, bid, nb);
    transpose_convert(p.mlp_w1, D, DFF, DFF, p.wt_w1, tile, bid, nb);
    transpose_convert(p.mlp_w1 + (size_t)D * DFF, D, DFF, DFF, p.wt_w1 + (size_t)D * DFF, tile, bid, nb);
    transpose_convert(p.mlp_w2, DFF, D, D, p.wt_w2, tile, bid, nb);
    transpose_convert(p.mlp_w2 + (size_t)D * DFF, DFF, D, D, p.wt_w2 + (size_t)D * DFF, tile, bid, nb);
    transpose_convert(p.dsa_w_in, D, DIN, DIN_PAD, p.wt_din, tile, bid, nb);
    transpose_convert(p.dsa_w_o, D, D, D, p.wt_do, tile, bid, nb);
    for (int idx = bid * NTHR + tid_opaque(); idx < (MPAD - 16384) * 256; idx += nb * NTHR)
        *(f32x4*)(p.preln + (size_t)16384 * D + (size_t)idx * 4) = (f32x4){0.f, 0.f, 0.f, 0.f};
    for (int idx = bid * NTHR + tid_opaque(); idx < LP * 24; idx += nb * NTHR) {
        const int pos = idx / 24, f = idx % 24;
        const int fi = (f < 16) ? f : (f - 16) * 2;
        const double rev = (double)pos * kInvFreq[fi] * 0.15915494309189535;
        const float r = (float)(rev - floor(rev));
        p.rope_tab[idx * 2] = __builtin_amdgcn_cosf(r);
        p.rope_tab[idx * 2 + 1] = __builtin_amdgcn_sinf(r);
    }
    for (int idx = bid * NTHR + tid_opaque(); idx < MPAD * 256; idx += nb * NTHR) {
        const int row = idx >> 8, c4 = (idx & 255) * 4;
        f32x4 v = {0.f, 0.f, 0.f, 0.f};
        if (row < NPR) {
            const int b = row / LP, t = row % LP;
            const float* src = (t < NMETA) ? (p.meta + (size_t)t * D) : (p.x_prompt + ((size_t)b * SEQ + (t - NMETA)) * D);
            v = *(const f32x4*)(src + c4);
        } else if (row < NT) {
            v = *(const f32x4*)(p.x_sample + (size_t)(row - NPR) * D + c4);
        }
        st_bf16x4(p.hA + (size_t)row * D + c4, v);
    }
}

template <class Epi>
__device__ __forceinline__ void gemm_phase(const bf16_t* __restrict__ A, int lda, const bf16_t* __restrict__ Bt, int K, int Mtiles, int Ntiles,
                           const Epi& epi, char* smem, int bid, int nb) {
    bf16_t* As = (bf16_t*)smem;
    bf16_t* Bs = As + 256 * 72;
    const int tid = tid_opaque(), lane = tid & 63, wave = tid >> 6;
    const int wm = wave >> 1, wn = wave & 1;
    const int fr = lane & 15, fq = lane >> 4;
    const int ntiles = Mtiles * Ntiles;
    const int nk = K / 64;
    for (int tile = bid; tile < ntiles; tile += nb) {
        const int tm = tile % Mtiles, tn = tile / Mtiles;
        const bf16_t* Ag = A + (size_t)tm * 256 * lda;
        const bf16_t* Bg = Bt + (size_t)tn * 128 * K;
        f32x4 acc[4][4];
#pragma unroll
        for (int i = 0; i < 4; ++i)
#pragma unroll
            for (int j = 0; j < 4; ++j) acc[i][j] = (f32x4){0.f, 0.f, 0.f, 0.f};
        const int c0 = tid, c1 = tid + 512, c2 = tid + 1024, c3 = tid + 1536;
        const bf16_t* ga0 = Ag + (size_t)(c0 >> 3) * lda + (c0 & 7) * 8;
        const bf16_t* ga1 = Ag + (size_t)(c1 >> 3) * lda + (c1 & 7) * 8;
        const bf16_t* ga2 = Ag + (size_t)(c2 >> 3) * lda + (c2 & 7) * 8;
        const bf16_t* ga3 = Ag + (size_t)(c3 >> 3) * lda + (c3 & 7) * 8;
        const bf16_t* gb0 = Bg + (size_t)(c0 >> 3) * K + (c0 & 7) * 8;
        const bf16_t* gb1 = Bg + (size_t)(c1 >> 3) * K + (c1 & 7) * 8;
        bf16_t* sa0 = As + (c0 >> 3) * 72 + (c0 & 7) * 8;
        bf16_t* sa1 = As + (c1 >> 3) * 72 + (c1 & 7) * 8;
        bf16_t* sa2 = As + (c2 >> 3) * 72 + (c2 & 7) * 8;
        bf16_t* sa3 = As + (c3 >> 3) * 72 + (c3 & 7) * 8;
        bf16_t* sb0 = Bs + (c0 >> 3) * 72 + (c0 & 7) * 8;
        bf16_t* sb1 = Bs + (c1 >> 3) * 72 + (c1 & 7) * 8;
        uint4 ra0 = *(const uint4*)ga0, ra1 = *(const uint4*)ga1, ra2 = *(const uint4*)ga2, ra3 = *(const uint4*)ga3;
        uint4 rb0 = *(const uint4*)gb0, rb1 = *(const uint4*)gb1;
        *(uint4*)sa0 = ra0; *(uint4*)sa1 = ra1; *(uint4*)sa2 = ra2; *(uint4*)sa3 = ra3; *(uint4*)sb0 = rb0; *(uint4*)sb1 = rb1;
        __syncthreads();
        for (int kt = 0; kt < nk; ++kt) {
            const bool more = (kt + 1 < nk);
            if (more) {
                const int k0 = (kt + 1) * 64;
                ra0 = *(const uint4*)(ga0 + k0); ra1 = *(const uint4*)(ga1 + k0); ra2 = *(const uint4*)(ga2 + k0); ra3 = *(const uint4*)(ga3 + k0);
                rb0 = *(const uint4*)(gb0 + k0); rb1 = *(const uint4*)(gb1 + k0);
            }
#pragma unroll
            for (int kk = 0; kk < 2; ++kk) {
                bf16x8 af[4], bfr[4];
#pragma unroll
                for (int i = 0; i < 4; ++i) af[i] = *(const bf16x8*)(As + (wm * 64 + i * 16 + fr) * 72 + kk * 32 + fq * 8);
#pragma unroll
                for (int j = 0; j < 4; ++j) bfr[j] = *(const bf16x8*)(Bs + (wn * 64 + j * 16 + fr) * 72 + kk * 32 + fq * 8);
#pragma unroll
                for (int i = 0; i < 4; ++i)
#pragma unroll
                    for (int j = 0; j < 4; ++j) acc[i][j] = __builtin_amdgcn_mfma_f32_16x16x32_bf16(bfr[j], af[i], acc[i][j], 0, 0, 0);
            }
            __syncthreads();
            if (more) {
                *(uint4*)sa0 = ra0; *(uint4*)sa1 = ra1; *(uint4*)sa2 = ra2; *(uint4*)sa3 = ra3; *(uint4*)sb0 = rb0; *(uint4*)sb1 = rb1;
                __syncthreads();
            }
        }
#pragma unroll
        for (int i = 0; i < 4; ++i)
#pragma unroll
            for (int j = 0; j < 4; ++j) {
                const int row = tm * 256 + wm * 64 + i * 16 + fr, col = tn * 128 + wn * 64 + j * 16 + fq * 4;
                epi(row, col, acc[i][j]);
            }
    }
}

namespace pg8 {
#define PG8_LAS __attribute__((address_space(3)))
constexpr int BM = 256, BK = 64, HALF = 128, HTB = HALF * BK * 2  , STAGE_BYTES = 8 * HTB, NXCD = 8, WGM = 8;
__device__ __forceinline__ int lds_byte(int r, int c) { const int st = (r >> 4) * 2 + (c >> 5), rr = r & 15, cc = c & 31, ob = rr * 64 + cc * 2; return st * 1024 + (ob ^ (((ob >> 9) & 1) << 5)); }
__device__ __forceinline__ void stage_rc(int b, int& R, int& C) { const int st = b / 1024, sb = b % 1024, swz = sb ^ (((sb >> 9) & 1) << 5); R = (st >> 1) * 16 + swz / 64; C = (st & 1) * 32 + (swz % 64) / 2; }
struct Unit { int pm, pn, pk; };
struct Gemm { const bf16_t* A; const bf16_t* Bt; int K; int splits; };
struct StaticOrder {
    int nM, nN, nNr, pm0, nwg, G, c;
    __device__ void init(int nM_, int nNr_, int splits, int pm0_, int G_, int c_) { nM = nM_; nNr = nNr_; nN = nNr_ * splits; pm0 = pm0_; nwg = nM * nN; G = G_; c = c_; }
    __device__ bool next(int i, Unit& u) const {
        const long L = (long)i * G + c; if (L >= nwg) return false;
        int wgid = (int)L; { const int q = nwg / NXCD, r = nwg % NXCD, xcd = wgid % NXCD, off = wgid / NXCD; wgid = (xcd < r ? xcd * (q + 1) : r * (q + 1) + (xcd - r) * q) + off; }
        const int nig = WGM * nN, gid = wgid / nig, fm = gid * WGM, gsz = (nM - fm) < WGM ? (nM - fm) : WGM;
        const int pnv = (wgid % nig) / gsz;
        u.pm = pm0 + fm + ((wgid % nig) % gsz); u.pn = pnv % nNr; u.pk = pnv / nNr; return true;
    }
};
template <class Epi>
__device__ __forceinline__ void gemm_phase(PG8_LAS unsigned char* lds, const Gemm g, const StaticOrder& S, const Epi& E) {
    const int tid = tid_opaque(), wid = __builtin_amdgcn_readfirstlane(tid >> 6), lane = tid & 63, wr = wid >> 2, wc = wid & 3, fr = lane & 15, fq = lane >> 4;
    const int K = g.K, Kp = K / g.splits, nt = Kp / BK;
    unsigned voffA[2], voffB[2];
#pragma unroll
    for (int i = 0; i < 2; ++i) { int R, C; stage_rc(tid * 16 + i * 8192, R, C); voffA[i] = (unsigned)(R * K + C) * 2u; voffB[i] = voffA[i]; }
    const size_t kstep = (size_t)(BK * 2);
    const size_t hstep = (size_t)HALF * K * 2;
    const size_t tstep = 2 * hstep;
    const size_t pstep = (size_t)Kp * 2;
    const unsigned ldsw = (unsigned)wid * 1024u;
    const int aoff = lds_byte(wr * 64 + fr, fq * 8), boff = lds_byte(wc * 32 + fr, fq * 8);
#define PG8_SA(b, h) (((b) * 2 + (h)) * HTB)
#define PG8_SB(b, h) ((4 + (b) * 2 + (h)) * HTB)
#define PG8_STAGE(bufoff, gbase, voff) do { _Pragma("unroll") for (int _i = 0; _i < 2; ++_i) \
        __builtin_amdgcn_global_load_lds((const unsigned*)((const char*)(gbase) + (voff)[_i]), (PG8_LAS unsigned*)(lds + (bufoff) + ldsw + _i * 8192), 16, 0, 0); } while (0)
#define PG8_LDA(dst, b, h) do { _Pragma("unroll") for (int m = 0; m < 4; ++m) _Pragma("unroll") for (int k = 0; k < 2; ++k) dst[m][k] = *(const PG8_LAS bf16x8*)(lds + PG8_SA(b, h) + aoff + m * 2048 + k * 1024); } while (0)
#define PG8_LDB(dst, b, h) do { _Pragma("unroll") for (int n = 0; n < 2; ++n) _Pragma("unroll") for (int k = 0; k < 2; ++k) dst[n][k] = *(const PG8_LAS bf16x8*)(lds + PG8_SB(b, h) + boff + n * 2048 + k * 1024); } while (0)
#define PG8_MMA(ai, bj, At, Bt) do { __builtin_amdgcn_s_setprio(1); _Pragma("unroll") for (int m = 0; m < 4; ++m) _Pragma("unroll") for (int n = 0; n < 2; ++n) _Pragma("unroll") for (int k = 0; k < 2; ++k) \
        acc[ai][bj][m][n] = __builtin_amdgcn_mfma_f32_16x16x32_bf16(Bt[n][k], At[m][k], acc[ai][bj][m][n], 0, 0, 0); __builtin_amdgcn_s_setprio(0); } while (0)
#define PG8_WAIT_V(n) asm volatile("s_waitcnt vmcnt(" #n ")" ::: "memory")
#define PG8_WAIT_L(n) asm volatile("s_waitcnt lgkmcnt(" #n ")" ::: "memory")
#define PG8_BAR __builtin_amdgcn_s_barrier()
#define PG8_SCHED __builtin_amdgcn_sched_barrier(0)
    Unit cur, nxt; int ui = 0;
    if (!S.next(0, cur)) return;
    f32x4 acc[2][2][4][2];
#pragma unroll
    for (int a = 0; a < 2; ++a)
#pragma unroll
        for (int b = 0; b < 2; ++b)
#pragma unroll
            for (int m = 0; m < 4; ++m)
#pragma unroll
                for (int n = 0; n < 2; ++n) acc[a][b][m][n] = (f32x4){0.f, 0.f, 0.f, 0.f};
    bf16x8 At[4][2], B0[2][2], B1[2][2];
    const char* cA = (const char*)g.A + (size_t)cur.pm * tstep + (size_t)cur.pk * pstep; const char* cB = (const char*)g.Bt + (size_t)cur.pn * tstep + (size_t)cur.pk * pstep;
    PG8_STAGE(PG8_SB(0, 0), cB, voffB); PG8_STAGE(PG8_SA(0, 0), cA, voffA); PG8_STAGE(PG8_SB(0, 1), cB + hstep, voffB); PG8_STAGE(PG8_SA(0, 1), cA + hstep, voffA);
    if (wr == 1) PG8_BAR;
    PG8_WAIT_V(4); PG8_BAR;
    PG8_STAGE(PG8_SB(1, 0), cB + kstep, voffB); PG8_STAGE(PG8_SA(1, 0), cA + kstep, voffA); PG8_STAGE(PG8_SB(1, 1), cB + hstep + kstep, voffB);
    PG8_WAIT_V(6); PG8_BAR;
    for (;;) {
        const bool has_next = S.next(ui + 1, nxt);
        const char* nA = has_next ? (const char*)g.A + (size_t)nxt.pm * tstep + (size_t)nxt.pk * pstep : cA; const char* nB = has_next ? (const char*)g.Bt + (size_t)nxt.pn * tstep + (size_t)nxt.pk * pstep : cB;
        for (int t = 0; t < nt; t += 2) {
            const bool last = (t == nt - 2);
            const char* a1 = cA + (size_t)(t + 1) * kstep;
            const char* a2 = last ? nA : cA + (size_t)(t + 2) * kstep; const char* b2 = last ? nB : cB + (size_t)(t + 2) * kstep;
            const char* a3 = a2 + kstep; const char* b3 = b2 + kstep;
            PG8_LDB(B0, 0, 0); PG8_SCHED; PG8_LDA(At, 0, 0); PG8_STAGE(PG8_SA(1, 1), a1 + hstep, voffA);
            PG8_WAIT_L(8); PG8_BAR; PG8_WAIT_L(0); PG8_MMA(0, 0, At, B0); PG8_BAR; PG8_SCHED;
            PG8_LDB(B1, 0, 1); PG8_STAGE(PG8_SB(0, 0), b2, voffB);
            PG8_BAR; PG8_WAIT_L(0); PG8_MMA(0, 1, At, B1); PG8_BAR;
            PG8_LDA(At, 0, 1); PG8_STAGE(PG8_SA(0, 0), a2, voffA);
            PG8_BAR; PG8_WAIT_L(0); PG8_MMA(1, 0, At, B0); PG8_BAR; PG8_SCHED;
            PG8_STAGE(PG8_SB(0, 1), b2 + hstep, voffB);
            PG8_WAIT_V(6); PG8_BAR; PG8_MMA(1, 1, At, B1); PG8_BAR;
            PG8_LDB(B0, 1, 0); PG8_SCHED; PG8_LDA(At, 1, 0); PG8_STAGE(PG8_SA(0, 1), a2 + hstep, voffA);
            PG8_WAIT_L(8); PG8_BAR; PG8_WAIT_L(0); PG8_MMA(0, 0, At, B0); PG8_BAR; PG8_SCHED;
            PG8_LDB(B1, 1, 1); PG8_STAGE(PG8_SB(1, 0), b3, voffB);
            PG8_BAR; PG8_WAIT_L(0); PG8_MMA(0, 1, At, B1); PG8_BAR;
            PG8_LDA(At, 1, 1); PG8_STAGE(PG8_SA(1, 0), a3, voffA);
            PG8_BAR; PG8_WAIT_L(0); PG8_MMA(1, 0, At, B0); PG8_BAR; PG8_SCHED;
            PG8_STAGE(PG8_SB(1, 1), b3 + hstep, voffB);
            PG8_WAIT_V(6); PG8_BAR; PG8_MMA(1, 1, At, B1); PG8_BAR;
        }
#pragma unroll
        for (int ai = 0; ai < 2; ++ai)
#pragma unroll
            for (int m = 0; m < 4; ++m)
#pragma unroll
                for (int bj = 0; bj < 2; ++bj)
#pragma unroll
                    for (int n = 0; n < 2; ++n)
                        E(cur.pm * BM + ai * HALF + wr * 64 + m * 16 + fr, cur.pn * BM + bj * HALF + wc * 32 + n * 16 + 4 * fq, acc[ai][bj][m][n], cur.pk);
        if (!has_next) break;
#pragma unroll
        for (int a = 0; a < 2; ++a)
#pragma unroll
            for (int b = 0; b < 2; ++b)
#pragma unroll
                for (int m = 0; m < 4; ++m)
#pragma unroll
                    for (int n = 0; n < 2; ++n) acc[a][b][m][n] = (f32x4){0.f, 0.f, 0.f, 0.f};
        cur = nxt; cA = nA; cB = nB; ++ui;
    }
    PG8_WAIT_V(0);
    if (wr == 0) PG8_BAR;
    PG8_BAR;
#undef PG8_SA
#undef PG8_SB
#undef PG8_STAGE
#undef PG8_LDA
#undef PG8_LDB
#undef PG8_MMA
#undef PG8_WAIT_V
#undef PG8_WAIT_L
#undef PG8_BAR
#undef PG8_SCHED
}
}

template <class Epi>
__device__ __forceinline__ void gemm_big(const bf16_t* A, int K, const bf16_t* Bt, int Npad, const Epi& e, char* smem, int bid, int nb) {
    pg8::StaticOrder S; S.init(MPAD / 256, Npad / 256, 1, 0, nb, bid);
    pg8::gemm_phase((PG8_LAS unsigned char*)smem, pg8::Gemm{A, Bt, K, 1}, S, e);
}
template <class Epi1, class Epi2>
__device__ __forceinline__ void gemm_n1024(const bf16_t* A, int K, const bf16_t* Bt, const Epi1& e1, const Epi2& e2, int splits, char* smem, int bid, int nb) {
    pg8::StaticOrder S; S.init(64, 4, 1, 0, nb, bid);
    pg8::gemm_phase((PG8_LAS unsigned char*)smem, pg8::Gemm{A, Bt, K, 1}, S, e1);
    pg8::StaticOrder S2; S2.init(3, 4, splits, 64, nb, bid);
    pg8::gemm_phase((PG8_LAS unsigned char*)smem, pg8::Gemm{A, Bt, K, splits}, S2, e2);
}

struct EpiGdnIn {
    bf16_t *mixed, *z; float* ba;
    __device__ __forceinline__ void operator()(int row, int col, f32x4 v, int = 0) const {
        if (col < 4096) st_bf16x4(mixed + (size_t)row * 4096 + col, v);
        else if (col < 6144) st_bf16x4(z + (size_t)row * 2048 + (col - 4096), v);
        else if (col < 6176) *(f32x4*)(ba + (size_t)row * 32 + (col - 6144)) = v;
    }
};
struct EpiResid {
    float* out; const bf16_t* h;
    __device__ __forceinline__ void operator()(int row, int col, f32x4 v, int = 0) const {
        const f32x4 r = ld_bf16x4(h + (size_t)row * D + col);
        *(f32x4*)(out + (size_t)row * D + col) = v + r * ALPHA;
    }
};
struct EpiResidAtomic {
    float* out; const bf16_t* h;
    __device__ __forceinline__ void operator()(int row, int col, f32x4 v, int pk) const {
        if (pk == 0) { const f32x4 r = ld_bf16x4(h + (size_t)row * D + col); v = v + r * ALPHA; }
        float* o = out + (size_t)row * D + col;
        unsafeAtomicAdd(o, v[0]); unsafeAtomicAdd(o + 1, v[1]); unsafeAtomicAdd(o + 2, v[2]); unsafeAtomicAdd(o + 3, v[3]);
    }
};
struct EpiRelu2 {
    bf16_t* act;
    __device__ __forceinline__ void operator()(int row, int col, f32x4 v, int = 0) const {
#pragma unroll
        for (int e = 0; e < 4; ++e) { const float r = fmaxf(v[e], 0.f); v[e] = r * r; }
        st_bf16x4(act + (size_t)row * DFF + col, v);
    }
};
struct EpiF32 {
    float* out; int ld;
    __device__ __forceinline__ void operator()(int row, int col, f32x4 v, int = 0) const { *(f32x4*)(out + (size_t)row * ld + col) = v; }
};

__device__ __forceinline__ void ln_phase(const float* X, const float* __restrict__ g, const float* __restrict__ bta, bf16_t* Hout,
                         float* yp, float* ys, int bid, int nb) {
    const int tid_ = tid_opaque(); const int lane = tid_ & 63, wave = tid_ >> 6;
    f32x4 gv[4], bv[4];
#pragma unroll
    for (int j = 0; j < 4; ++j) { gv[j] = *(const f32x4*)(g + j * 256 + lane * 4); bv[j] = *(const f32x4*)(bta + j * 256 + lane * 4); }
    for (int row = bid * 8 + wave; row < NT; row += nb * 8) {
        f32x4 v[4]; float s = 0.f;
#pragma unroll
        for (int j = 0; j < 4; ++j) { v[j] = *(const f32x4*)(X + (size_t)row * D + j * 256 + lane * 4); s += (v[j][0] + v[j][1]) + (v[j][2] + v[j][3]); }
        if (row >= 16384) {
#pragma unroll
            for (int j = 0; j < 4; ++j) *(f32x4*)(const_cast<float*>(X) + (size_t)row * D + j * 256 + lane * 4) = (f32x4){0.f, 0.f, 0.f, 0.f};
        }
        const float mean = wave_sum(s) * (1.f / D);
        float s2 = 0.f;
#pragma unroll
        for (int j = 0; j < 4; ++j) { v[j] = v[j] - mean; s2 += (v[j][0] * v[j][0] + v[j][1] * v[j][1]) + (v[j][2] * v[j][2] + v[j][3] * v[j][3]); }
        const float rstd = rsqrtf(wave_sum(s2) * (1.f / D) + 1e-5f);
        float* yo = nullptr;
        if (yp) {
            if (row < NPR) { const int b = row / LP, t = row % LP; if (t >= NMETA) yo = yp + ((size_t)b * SEQ + (t - NMETA)) * D; }
            else yo = ys + (size_t)(row - NPR) * D;
        }
#pragma unroll
        for (int j = 0; j < 4; ++j) {
            const f32x4 o = v[j] * rstd * gv[j] + bv[j];
            if (Hout) st_bf16x4(Hout + (size_t)row * D + j * 256 + lane * 4, o);
            if (yo) *(f32x4*)(yo + j * 256 + lane * 4) = o;
        }
    }
}

__device__ __forceinline__ void gdn_sample_pass(const Params& p, char* smem, int pass, int tid) {
    float* sq = (float*)smem;
    float* sk = sq + 256;
    float* part = sk + 256;
    float* part2 = part + 16;
    const int lane = tid & 63, wave = tid >> 6, ug = wave >> 2, wq = wave & 3;
    const int half = lane >> 5, v = wq * 32 + (lane & 31);
    const int u = pass * 2 + ug, b = u >> 4, h = u & 15, kh = h >> 1;
    const size_t row0 = (size_t)NPR + (size_t)b * DS;
    float S[64];
    {
        const float* Sp = p.state_gdn + ((size_t)(b * 16 + h) * 128 + half * 64) * 128 + v;
#pragma unroll
        for (int k = 0; k < 64; ++k) S[k] = Sp[(size_t)k * 128];
    }
    const float Aexp = __expf(p.gdn_a_log[h]);
    const float dtb = p.gdn_dt_bias[h];
    const float nw = p.gdn_norm_w[v];
    const int chA = (half ? 1024 : 0) + kh * 128 + v, chv = 2048 + h * 128 + v;
    float cA[4], cv[4];
#pragma unroll
    for (int j = 0; j < 4; ++j) { cA[j] = p.gdn_conv_w[j * 4096 + chA]; cv[j] = p.gdn_conv_w[j * 4096 + chv]; }
    float xA[7], xv[7];
#pragma unroll
    for (int i = 0; i < 3; ++i) {
        const float* cs = p.state_conv + ((size_t)b * 3 + i) * 4096;
        xA[i] = cs[chA]; xv[i] = cs[chv];
    }
#pragma unroll
    for (int i = 0; i < 4; ++i) {
        const bf16_t* mr = p.mixed + (row0 + i) * 4096;
        xA[3 + i] = bf2f(mr[chA]); xv[3 + i] = bf2f(mr[chv]);
    }
    float* sqg = sq + ug * 128;
    float* skg = sk + ug * 128;
    float* pg = part + ug * 8;
    float* pg2 = part2 + ug * 4;
    const float* kmine = skg + half * 64;
    const float* qmine = sqg + half * 64;
#pragma unroll
    for (int t = 0; t < DS; ++t) {
        const float yA = silu(xA[t] * cA[0] + xA[t + 1] * cA[1] + xA[t + 2] * cA[2] + xA[t + 3] * cA[3]);
        const float yv = silu(xv[t] * cv[0] + xv[t + 1] * cv[1] + xv[t + 2] * cv[2] + xv[t + 3] * cv[3]);
        (half ? skg : sqg)[v] = yA;
        float ssA = yA * yA;
#pragma unroll
        for (int o = 1; o < 32; o <<= 1) ssA += __shfl_xor(ssA, o);
        if ((lane & 31) == 0) pg[wq * 2 + half] = ssA;
        __syncthreads();
        const float qn = rsqrtf((pg[0] + pg[2]) + (pg[4] + pg[6]) + 1e-6f) * 0.08838834764831845f;
        const float kn = rsqrtf((pg[1] + pg[3]) + (pg[5] + pg[7]) + 1e-6f);
        const float* bap = p.ba + (row0 + t) * 32;
        const float beta = 1.f / (1.f + __expf(-bap[h]));
        const float aa = bap[16 + h] + dtb;
        const float sp = (aa > 20.f) ? aa : log1pf(__expf(aa));
        const float dec = __expf(-Aexp * sp);
        float kS0 = 0.f, kS1 = 0.f;
#pragma unroll
        for (int k = 0; k < 64; k += 4) {
            const f32x4 kk = *(const f32x4*)(kmine + k);
            S[k] *= dec; S[k + 1] *= dec; S[k + 2] *= dec; S[k + 3] *= dec;
            kS0 += kk[0] * S[k]; kS1 += kk[1] * S[k + 1]; kS0 += kk[2] * S[k + 2]; kS1 += kk[3] * S[k + 3];
        }
        float kS = kS0 + kS1;
        kS += __shfl_xor(kS, 32);
        const float delta = (yv - kS * kn) * beta * kn;
        float o0 = 0.f, o1 = 0.f;
#pragma unroll
        for (int k = 0; k < 64; k += 4) {
            const f32x4 kk = *(const f32x4*)(kmine + k);
            const f32x4 qq = *(const f32x4*)(qmine + k);
            S[k] += kk[0] * delta; S[k + 1] += kk[1] * delta; S[k + 2] += kk[2] * delta; S[k + 3] += kk[3] * delta;
            o0 += qq[0] * S[k]; o1 += qq[1] * S[k + 1]; o0 += qq[2] * S[k + 2]; o1 += qq[3] * S[k + 3];
        }
        float o = o0 + o1;
        o = (o + __shfl_xor(o, 32)) * qn;
        float s3 = o * o;
#pragma unroll
        for (int x = 1; x < 32; x <<= 1) s3 += __shfl_xor(s3, x);
        if (lane == 0) pg2[wq] = s3;
        __syncthreads();
        if (half == 0) {
            const float rms = rsqrtf(((pg2[0] + pg2[1]) + (pg2[2] + pg2[3])) * (1.f / 128.f) + 1e-6f);
            const float zz = bf2f(p.z[(row0 + t) * 2048 + h * 128 + v]);
            p.gated[(row0 + t) * 2048 + h * 128 + v] = f2bf(o * rms * nw * silu(zz));
        }
    }
    {
        float* So = p.gs_sample + ((size_t)(b * 16 + h) * 128 + half * 64) * 128 + v;
#pragma unroll
        for (int k = 0; k < 64; ++k) So[(size_t)k * 128] = S[k];
    }
    __syncthreads();
}

#define MFMA32(a, b, c) __builtin_amdgcn_mfma_f32_32x32x16_bf16((a), (b), (c), 0, 0, 0)
constexpr int NCH = 65;
constexpr int NCU = BATCH * 16 * NCH;
__device__ __forceinline__ int crow(int reg, int hh) { return (reg & 3) + 8 * (reg >> 2) + 4 * hh; }
__device__ __forceinline__ bf16x8 pack_step(const f32x16& x, int s) {
    u32x4 q;
    q[0] = pk2(x[8 * s + 0], x[8 * s + 1]); q[1] = pk2(x[8 * s + 2], x[8 * s + 3]);
    q[2] = pk2(x[8 * s + 4], x[8 * s + 5]); q[3] = pk2(x[8 * s + 6], x[8 * s + 7]);
    return __builtin_bit_cast(bf16x8, q);
}
__device__ __forceinline__ bf16x8 frag_perm(const bf16_t* p0) {
    const uint2 lo = *(const uint2*)p0, hi = *(const uint2*)(p0 + 8);
    u32x4 q; q[0] = lo.x; q[1] = lo.y; q[2] = hi.x; q[3] = hi.y;
    return __builtin_bit_cast(bf16x8, q);
}

__device__ __forceinline__ void gdn_stageA(const Params& p, char* smem0, int bid, int nb) {
    const int tid = tid_opaque(), lane = tid & 63, wave = tid >> 6;
    for (int idx = bid * NTHR + tid; idx < (BATCH + DB) * 3 * 4096; idx += nb * NTHR) {
        const int c = idx & 4095, r = (idx >> 12) % 3, b = idx / (3 * 4096);
        if (b < BATCH) p.gc_prompt[idx] = bf2f(p.mixed[((size_t)b * LP + (LP - 3) + r) * 4096 + c]);
        else { const int bs = b - BATCH; p.gc_sample[(size_t)(bs * 3 + r) * 4096 + c] = bf2f(p.mixed[((size_t)NPR + bs * 4 + 1 + r) * 4096 + c]); }
    }
    for (int u = bid; u < NCU; u += nb) {
        unsigned zofs = 0; asm volatile("" : "+v"(zofs));
        char* smem = smem0 + zofs;
        bf16_t* Qb = (bf16_t*)smem;
        bf16_t* Kb = Qb + 64 * 136;
        float* RHS = (float*)(Kb + 64 * 136);
        float* Am = RHS + 64 * 256;
        float* sbeta = Am + 64 * 68;
        float* sgc = sbeta + 64;
        float* segc = sgc + 64;
        float* sekd = segc + 64;
        float* srk = sekd + 64;
        const int h = u & 15, n = (u >> 4) % NCH, b = u / (16 * NCH);
        const int kh = h >> 1;
        const size_t su = (size_t)((b * 16 + h) * NCH + n);
        const int t0 = n * 64;
        if (wave < 6) {
            const int part = wave >> 1, half = wave & 1;
            const int cq = lane & 31, tsub = lane >> 5;
            const int tl0 = 32 * half + 16 * tsub;
            const int chb = ((part == 0) ? (kh * 128) : (part == 1) ? (1024 + kh * 128) : (2048 + h * 128)) + cq * 4;
            f32x4 cw[4];
#pragma unroll
            for (int j = 0; j < 4; ++j) cw[j] = *(const f32x4*)(p.gdn_conv_w + j * 4096 + chb);
            uint2 xr[19];
#pragma unroll
            for (int i = 0; i < 19; ++i) {
                const int t = t0 + tl0 - 3 + i;
                if (t >= 0 && t < LP) xr[i] = *(const uint2*)(p.mixed + ((size_t)b * LP + t) * 4096 + chb);
                else xr[i] = make_uint2(0u, 0u);
            }
#pragma unroll
            for (int hb = 0; hb < 2; ++hb) {
                f32x4 yv[8];
                float ssv[8];
#pragma unroll
                for (int i8 = 0; i8 < 8; ++i8) {
                    const int i = hb * 8 + i8;
                    const f32x4 a = cvt_bf16x4(xr[i]) * cw[0] + cvt_bf16x4(xr[i + 1]) * cw[1] + cvt_bf16x4(xr[i + 2]) * cw[2] + cvt_bf16x4(xr[i + 3]) * cw[3];
                    const bool valid = (t0 + tl0 + i) < LP;
#pragma unroll
                    for (int e2 = 0; e2 < 4; ++e2) yv[i8][e2] = valid ? silu(a[e2]) : 0.f;
                    ssv[i8] = (yv[i8][0] * yv[i8][0] + yv[i8][1] * yv[i8][1]) + (yv[i8][2] * yv[i8][2] + yv[i8][3] * yv[i8][3]);
                }
                if (part < 2) {
#pragma unroll
                    for (int o = 1; o < 32; o <<= 1)
#pragma unroll
                        for (int i8 = 0; i8 < 8; ++i8) ssv[i8] += __shfl_xor(ssv[i8], o);
                }
#pragma unroll
                for (int i8 = 0; i8 < 8; ++i8) {
                    const int c = tl0 + hb * 8 + i8;
                    f32x4 y = yv[i8];
                    if (part < 2) {
                        const float nrm = rsqrtf(ssv[i8] + 1e-6f) * ((part == 0) ? 0.08838834764831845f : 1.f);
                        y = y * nrm;
                        if (part == 0) st_bf16x4(Qb + c * 136 + cq * 4, y);
                        else { st_bf16x4(Kb + c * 136 + cq * 4, y); *(f32x4*)(RHS + c * 256 + 128 + cq * 4) = y; }
                    } else {
                        *(f32x4*)(RHS + c * 256 + cq * 4) = y;
                    }
                }
            }
        } else if (wave == 6) {
            const int c = lane, t = t0 + c;
            float beta = 0.f, g = 0.f;
            if (t < LP) {
                const float* bap = p.ba + ((size_t)b * LP + t) * 32;
                beta = 1.f / (1.f + __expf(-bap[h]));
                const float aa = bap[16 + h] + p.gdn_dt_bias[h];
                const float sp = (aa > 20.f) ? aa : log1pf(__expf(aa));
                g = -__expf(p.gdn_a_log[h]) * sp;
            }
            float gc = g;
#pragma unroll
            for (int o = 1; o < 64; o <<= 1) { const float v = __shfl_up(gc, o); if (lane >= o) gc += v; }
            const float glast = __shfl(gc, 63);
            sbeta[c] = beta; sgc[c] = gc; segc[c] = __expf(gc); sekd[c] = __expf(glast - gc); srk[c] = beta * __expf(gc);
            if (lane == 0) p.g_dec[su] = __expf(glast);
        }
        __syncthreads();
        {
            const int which = wave >> 2, ti = (wave >> 1) & 1, tj = wave & 1;
            const int r = lane & 31, hh = lane >> 5;
            f32x16 acc;
#pragma unroll
            for (int i = 0; i < 16; ++i) acc[i] = 0.f;
            const bf16_t* Ap = Kb + (32 * ti + r) * 136 + 8 * hh;
            const bf16_t* Bp = (which ? Qb : Kb) + (32 * tj + r) * 136 + 8 * hh;
#pragma unroll
            for (int ks = 0; ks < 8; ++ks) acc = MFMA32(*(const bf16x8*)(Ap + 16 * ks), *(const bf16x8*)(Bp + 16 * ks), acc);
            const int c = 32 * tj + r;
            const float gcc = sgc[c], bc = sbeta[c];
            if (which == 0) {
#pragma unroll
                for (int reg = 0; reg < 16; ++reg) {
                    const int cp = 32 * ti + crow(reg, hh);
                    const float dcy = __expf(fminf(gcc - sgc[cp], 0.f));
                    Am[c * 68 + cp] = (cp < c) ? (bc * acc[reg] * dcy) : 0.f;
                }
            } else {
                bf16_t* aq = p.g_aqk + su * 4096 + (size_t)c * 64;
#pragma unroll
                for (int g4 = 0; g4 < 4; ++g4) {
                    const int cp0 = 32 * ti + 8 * g4 + 4 * hh;
                    f32x4 v;
#pragma unroll
                    for (int e2 = 0; e2 < 4; ++e2) {
                        const int cp = cp0 + e2;
                        const float dcy = __expf(fminf(gcc - sgc[cp], 0.f));
                        v[e2] = (cp <= c) ? (acc[4 * g4 + e2] * dcy) : 0.f;
                    }
                    st_bf16x4(aq + cp0, v);
                }
            }
        }
        __syncthreads();
        if (wave < 4) {
            const int col = 64 * wave + lane;
            const float* rs = sbeta + __builtin_amdgcn_readfirstlane((wave < 2) ? 0 : 256);
            float x[64];
#pragma unroll
            for (int i = 0; i < 64; ++i) x[i] = RHS[i * 256 + col] * rs[i];
#pragma unroll
            for (int i0 = 0; i0 < 64; i0 += 4) {
                float a0 = x[i0], a1 = x[i0 + 1], a2 = x[i0 + 2], a3 = x[i0 + 3];
#pragma unroll
                for (int j4 = 0; j4 < i0; j4 += 4) {
                    const f32x4 r0 = *(const f32x4*)(Am + (i0) * 68 + j4), r1 = *(const f32x4*)(Am + (i0 + 1) * 68 + j4);
                    const f32x4 r2 = *(const f32x4*)(Am + (i0 + 2) * 68 + j4), r3 = *(const f32x4*)(Am + (i0 + 3) * 68 + j4);
                    a0 -= r0[0] * x[j4]; a1 -= r1[0] * x[j4]; a2 -= r2[0] * x[j4]; a3 -= r3[0] * x[j4];
                    a0 -= r0[1] * x[j4 + 1]; a1 -= r1[1] * x[j4 + 1]; a2 -= r2[1] * x[j4 + 1]; a3 -= r3[1] * x[j4 + 1];
                    a0 -= r0[2] * x[j4 + 2]; a1 -= r1[2] * x[j4 + 2]; a2 -= r2[2] * x[j4 + 2]; a3 -= r3[2] * x[j4 + 2];
                    a0 -= r0[3] * x[j4 + 3]; a1 -= r1[3] * x[j4 + 3]; a2 -= r2[3] * x[j4 + 3]; a3 -= r3[3] * x[j4 + 3];
                    if ((j4 & 12) == 12) asm volatile("" ::: "memory");
                }
                const f32x4 t1 = *(const f32x4*)(Am + (i0 + 1) * 68 + i0), t2 = *(const f32x4*)(Am + (i0 + 2) * 68 + i0), t3 = *(const f32x4*)(Am + (i0 + 3) * 68 + i0);
                a1 -= t1[0] * a0;
                a2 -= t2[0] * a0; a2 -= t2[1] * a1;
                a3 -= t3[0] * a0; a3 -= t3[1] * a1; a3 -= t3[2] * a2;
                x[i0] = a0; x[i0 + 1] = a1; x[i0 + 2] = a2; x[i0 + 3] = a3;
                asm volatile("" ::: "memory");
            }
            if (wave < 2) {
                float* up = p.g_u + su * 8192 + col;
#pragma unroll
                for (int i = 0; i < 64; ++i) up[i * 128] = x[i];
            } else {
                bf16_t* wp = p.g_negw + su * 8192 + (col - 128);
#pragma unroll
                for (int i = 0; i < 64; ++i) wp[i * 128] = f2bf(-x[i]);
            }
        } else {
            const int t2 = tid - 256;
#pragma unroll
            for (int it = 0; it < 4; ++it) {
                const int chk = t2 + 256 * it, c = chk >> 4, d0 = (chk & 15) * 8;
                const float e = segc[c];
                const uint4 raw = *(const uint4*)(Qb + c * 136 + d0);
                uint4 o;
                o.x = pk2(__uint_as_float(raw.x << 16) * e, __uint_as_float(raw.x & 0xffff0000u) * e);
                o.y = pk2(__uint_as_float(raw.y << 16) * e, __uint_as_float(raw.y & 0xffff0000u) * e);
                o.z = pk2(__uint_as_float(raw.z << 16) * e, __uint_as_float(raw.z & 0xffff0000u) * e);
                o.w = pk2(__uint_as_float(raw.w << 16) * e, __uint_as_float(raw.w & 0xffff0000u) * e);
                *(uint4*)(p.g_qg + su * 8192 + c * 128 + d0) = o;
            }
#pragma unroll
            for (int it = 0; it < 4; ++it) {
                const int item = t2 + 256 * it, d = item & 127, c0 = (item >> 7) * 8;
                float v[8];
#pragma unroll
                for (int i = 0; i < 8; ++i) v[i] = bf2f(Kb[(c0 + i) * 136 + d]) * sekd[c0 + i];
                uint4 o; o.x = pk2(v[0], v[1]); o.y = pk2(v[2], v[3]); o.z = pk2(v[4], v[5]); o.w = pk2(v[6], v[7]);
                *(uint4*)(p.g_kdT + su * 8192 + d * 64 + c0) = o;
            }
        }
        __syncthreads();
    }
}

constexpr int GB_NW = 0, GB_QG = 64 * 136, GB_KD = 2 * 64 * 136, GB_AQ = 2 * 64 * 136 + 128 * 72, GB_ELEMS = 2 * 64 * 136 + 128 * 72 + 64 * 72;
__device__ __forceinline__ void gdn_chain(const Params& p, char* smem, int b, int h) {
    bf16_t* lds = (bf16_t*)smem;
    const int tid = tid_opaque(), lane = tid & 63, wave = tid >> 6;
    const int r = lane & 31, hh = lane >> 5;
    const size_t su0 = (size_t)(b * 16 + h) * NCH;
    const bool loader = wave >= 4;
    const int t2 = tid - 256;
    uint4 sa0, sa1, sa2, sa3, sa4, sa5, sa6, sa7, sa8, sa9, sa10, sa11, sa12, sa13;
    uint4 sb0, sb1, sb2, sb3, sb4, sb5, sb6, sb7, sb8, sb9, sb10, sb11, sb12, sb13;
    f32x16 S[4], un0, un1;
#pragma unroll
    for (int i = 0; i < 4; ++i)
#pragma unroll
        for (int j = 0; j < 16; ++j) S[i][j] = 0.f;
    const int ch0 = t2, ch1 = t2 + 256, ch2 = t2 + 512, ch3 = t2 + 768;
#define GB_GLOAD(P, n_) do { const size_t su_ = su0 + (n_); \
        const bf16_t* a_ = p.g_negw + su_ * 8192; const bf16_t* b_ = p.g_qg + su_ * 8192; const bf16_t* c_ = p.g_kdT + su_ * 8192; const bf16_t* d_ = p.g_aqk + su_ * 4096; \
        P##0 = *(const uint4*)(a_ + (size_t)ch0 * 8); P##1 = *(const uint4*)(a_ + (size_t)ch1 * 8); P##2 = *(const uint4*)(a_ + (size_t)ch2 * 8); P##3 = *(const uint4*)(a_ + (size_t)ch3 * 8); \
        P##4 = *(const uint4*)(b_ + (size_t)ch0 * 8); P##5 = *(const uint4*)(b_ + (size_t)ch1 * 8); P##6 = *(const uint4*)(b_ + (size_t)ch2 * 8); P##7 = *(const uint4*)(b_ + (size_t)ch3 * 8); \
        P##8 = *(const uint4*)(c_ + (size_t)ch0 * 8); P##9 = *(const uint4*)(c_ + (size_t)ch1 * 8); P##10 = *(const uint4*)(c_ + (size_t)ch2 * 8); P##11 = *(const uint4*)(c_ + (size_t)ch3 * 8); \
        P##12 = *(const uint4*)(d_ + (size_t)ch0 * 8); P##13 = *(const uint4*)(d_ + (size_t)ch1 * 8); } while (0)
#define GB_SSTORE(P, buf_) do { bf16_t* q_ = (buf_); \
        *(uint4*)(q_ + GB_NW + (ch0 >> 4) * 136 + (ch0 & 15) * 8) = P##0; *(uint4*)(q_ + GB_NW + (ch1 >> 4) * 136 + (ch1 & 15) * 8) = P##1; \
        *(uint4*)(q_ + GB_NW + (ch2 >> 4) * 136 + (ch2 & 15) * 8) = P##2; *(uint4*)(q_ + GB_NW + (ch3 >> 4) * 136 + (ch3 & 15) * 8) = P##3; \
        *(uint4*)(q_ + GB_QG + (ch0 >> 4) * 136 + (ch0 & 15) * 8) = P##4; *(uint4*)(q_ + GB_QG + (ch1 >> 4) * 136 + (ch1 & 15) * 8) = P##5; \
        *(uint4*)(q_ + GB_QG + (ch2 >> 4) * 136 + (ch2 & 15) * 8) = P##6; *(uint4*)(q_ + GB_QG + (ch3 >> 4) * 136 + (ch3 & 15) * 8) = P##7; \
        *(uint4*)(q_ + GB_KD + (ch0 >> 3) * 72 + (ch0 & 7) * 8) = P##8; *(uint4*)(q_ + GB_KD + (ch1 >> 3) * 72 + (ch1 & 7) * 8) = P##9; \
        *(uint4*)(q_ + GB_KD + (ch2 >> 3) * 72 + (ch2 & 7) * 8) = P##10; *(uint4*)(q_ + GB_KD + (ch3 >> 3) * 72 + (ch3 & 7) * 8) = P##11; \
        *(uint4*)(q_ + GB_AQ + (ch0 >> 3) * 72 + (ch0 & 7) * 8) = P##12; *(uint4*)(q_ + GB_AQ + (ch1 >> 3) * 72 + (ch1 & 7) * 8) = P##13; } while (0)
#define GB_ULOAD(n_) do { const float* up_ = p.g_u + (su0 + (n_)) * 8192 + 32 * wave + r; \
        _Pragma("unroll") for (int reg_ = 0; reg_ < 16; ++reg_) { un0[reg_] = up_[(crow(reg_, hh)) * 128]; un1[reg_] = up_[(32 + crow(reg_, hh)) * 128]; } } while (0)
    if (loader) {
        bf16_t* buf0 = lds;
        bf16_t* buf1 = lds + GB_ELEMS;
        GB_GLOAD(sa, 0); GB_SSTORE(sa, buf0);
        GB_GLOAD(sa, 1);
        __syncthreads();
        for (int n = 0; n < NCH; n += 2) {
            if (n + 2 < NCH) { GB_GLOAD(sb, n + 2); }
            if (n + 1 < NCH) { GB_SSTORE(sa, buf1); }
            __syncthreads();
            if (n + 1 >= NCH) break;
            if (n + 3 < NCH) { GB_GLOAD(sa, n + 3); }
            if (n + 2 < NCH) { GB_SSTORE(sb, buf0); }
            __syncthreads();
        }
    } else {
        GB_ULOAD(0);
        float dec_next = p.g_dec[su0];
        __syncthreads();
        for (int n = 0; n < NCH; ++n) {
            unsigned zofs = 0; asm volatile("" : "+v"(zofs));
            bf16_t* cur = lds + (n & 1) * GB_ELEMS + zofs;
            const bool more = (n + 1 < NCH);
            const float dec = dec_next;
            if (more) dec_next = p.g_dec[su0 + n + 1];
            f32x16 vn[2], o[2];
            vn[0] = un0; vn[1] = un1;
#pragma unroll
            for (int j = 0; j < 16; ++j) { o[0][j] = 0.f; o[1][j] = 0.f; }
            if (more) { GB_ULOAD(n + 1); }
#pragma unroll
            for (int kt = 0; kt < 4; ++kt)
#pragma unroll
                for (int s = 0; s < 2; ++s) {
                    const bf16x8 sb = pack_step(S[kt], s);
                    const int k0 = 32 * kt + 16 * s + 4 * hh;
#pragma unroll
                    for (int ct = 0; ct < 2; ++ct) {
                        vn[ct] = MFMA32(frag_perm(cur + GB_NW + (32 * ct + r) * 136 + k0), sb, vn[ct]);
                        o[ct] = MFMA32(frag_perm(cur + GB_QG + (32 * ct + r) * 136 + k0), sb, o[ct]);
                    }
                }
            bf16x8 vb[2][2];
#pragma unroll
            for (int ct = 0; ct < 2; ++ct)
#pragma unroll
                for (int s = 0; s < 2; ++s) vb[ct][s] = pack_step(vn[ct], s);
#pragma unroll
            for (int s = 0; s < 2; ++s) {
                o[0] = MFMA32(frag_perm(cur + GB_AQ + (r) * 72 + 16 * s + 4 * hh), vb[0][s], o[0]);
                o[1] = MFMA32(frag_perm(cur + GB_AQ + (32 + r) * 72 + 16 * s + 4 * hh), vb[0][s], o[1]);
                o[1] = MFMA32(frag_perm(cur + GB_AQ + (32 + r) * 72 + 32 + 16 * s + 4 * hh), vb[1][s], o[1]);
            }
#pragma unroll
            for (int dt = 0; dt < 4; ++dt) {
                S[dt] = S[dt] * dec;
#pragma unroll
                for (int ckt = 0; ckt < 2; ++ckt)
#pragma unroll
                    for (int s = 0; s < 2; ++s)
                        S[dt] = MFMA32(frag_perm(cur + GB_KD + (32 * dt + r) * 72 + 32 * ckt + 16 * s + 4 * hh), vb[ckt][s], S[dt]);
            }
#pragma unroll
            for (int ct = 0; ct < 2; ++ct)
#pragma unroll
                for (int reg = 0; reg < 16; ++reg) {
                    const int t = 64 * n + 32 * ct + crow(reg, hh);
                    if (t < LP) p.g_o[(((size_t)b * LP + t) * 16 + h) * 128 + 32 * wave + r] = f2bf(o[ct][reg]);
                }
            __syncthreads();
        }
    }
    if (!loader) {
#pragma unroll
        for (int dt = 0; dt < 4; ++dt)
#pragma unroll
            for (int reg = 0; reg < 16; ++reg)
                p.gs_prompt[((size_t)(b * 16 + h) * 128 + 32 * dt + crow(reg, hh)) * 128 + 32 * wave + r] = S[dt][reg];
    }
    __syncthreads();
}

__device__ __forceinline__ void gdn_seq_phase(const Params& p, char* smem, int bid, int nb, int rep = 0) {
    if (bid < 64) gdn_chain(p, smem, bid >> 4, bid & 15);
    int* slot = (int*)(smem + LDS_BYTES - 32);
    const int tid = tid_opaque();
    for (;;) {
        if (threadIdx.x == 0) *slot = (int)atomicAdd(p.bar + 3520 + 16 * rep, 1u);
        __syncthreads();
        const int u = *slot;
        __syncthreads();
        if (u >= DB * 16 / 2) break;
        gdn_sample_pass(p, smem, u, tid_opaque());
    }
}

__device__ __forceinline__ void gdn_gate_phase(const Params& p, int bid, int nb) {
    const int tid_ = tid_opaque(); const int lane = tid_ & 63, wave = tid_ >> 6;
    const int sub = lane >> 4, l16 = lane & 15;
    f32x4 nw0 = *(const f32x4*)(p.gdn_norm_w + l16 * 8), nw1 = *(const f32x4*)(p.gdn_norm_w + l16 * 8 + 4);
    for (int it4 = bid * 8 + wave; it4 < NPR * 4; it4 += nb * 8) {
        const size_t off = ((size_t)it4 * 4 + sub) * 128 + l16 * 8;
        const uint4 ov = *(const uint4*)(p.g_o + off);
        const uint4 zv = *(const uint4*)(p.z + off);
        const f32x4 o0 = cvt_bf16x4(make_uint2(ov.x, ov.y)), o1 = cvt_bf16x4(make_uint2(ov.z, ov.w));
        const f32x4 z0 = cvt_bf16x4(make_uint2(zv.x, zv.y)), z1 = cvt_bf16x4(make_uint2(zv.z, zv.w));
        float ss = ((o0[0] * o0[0] + o0[1] * o0[1]) + (o0[2] * o0[2] + o0[3] * o0[3])) + ((o1[0] * o1[0] + o1[1] * o1[1]) + (o1[2] * o1[2] + o1[3] * o1[3]));
#pragma unroll
        for (int x = 1; x < 16; x <<= 1) ss += __shfl_xor(ss, x);
        const float rms = rsqrtf(ss * (1.f / 128.f) + 1e-6f);
        uint4 g;
        g.x = pk2(o0[0] * rms * nw0[0] * silu(z0[0]), o0[1] * rms * nw0[1] * silu(z0[1]));
        g.y = pk2(o0[2] * rms * nw0[2] * silu(z0[2]), o0[3] * rms * nw0[3] * silu(z0[3]));
        g.z = pk2(o1[0] * rms * nw1[0] * silu(z1[0]), o1[1] * rms * nw1[1] * silu(z1[1]));
        g.w = pk2(o1[2] * rms * nw1[2] * silu(z1[2]), o1[3] * rms * nw1[3] * silu(z1[3]));
        *(uint4*)(p.gated + off) = g;
    }
}

__device__ __forceinline__ void rope4(const float* tab, int fi, f32x4 x, f32x4 partner, bool first, f32x4& o) {
    const f32x4 t0 = *(const f32x4*)(tab + fi * 2), t1 = *(const f32x4*)(tab + fi * 2 + 4);
    const float sg = first ? -1.f : 1.f;
    o[0] = x[0] * t0[0] + sg * partner[0] * t0[1];
    o[1] = x[1] * t0[2] + sg * partner[1] * t0[3];
    o[2] = x[2] * t1[0] + sg * partner[2] * t1[1];
    o[3] = x[3] * t1[2] + sg * partner[3] * t1[3];
}
__device__ __forceinline__ void dsa_post_phase(const Params& p, char* smem, int bid, int nb) {
    bf16_t* vt = (bf16_t*)smem;
    for (int u = bid; u < BATCH * 65 + 8; u += nb) {
        const int tid = tid_opaque(); const int lane = tid & 63, wave = tid >> 6;
        const bool prompt = u < BATCH * 65;
        const int b = prompt ? (u / 65) : 0, t0 = prompt ? (u % 65) * 64 : 0;
        for (int r8 = 0; r8 < 8; ++r8) {
            const int tl = wave * 8 + r8;
            const int t = t0 + tl;
            const bool rvalid = prompt ? (t < LP) : true;
            const int row = prompt ? (b * LP + t) : (NPR + (u - BATCH * 65) * 64 + tl);
            if (!rvalid) {
                for (int e = lane; e < 256; e += 64) vt[e * 72 + tl] = 0;
                continue;
            }
            const float* P = p.p1 + (size_t)row * DIN_PAD;
            const int pos = prompt ? t : (PAST + ((row - NPR) & 3));
            const float* tab = p.rope_tab + (size_t)pos * 48;
            float* kout = prompt ? (p.k_prompt + (size_t)row * 256) : (p.k_sample + (size_t)(row - NPR) * 256);
            float* vout = prompt ? (p.v_prompt + (size_t)row * 256) : (p.v_sample + (size_t)(row - NPR) * 256);
#pragma unroll
            for (int j = 0; j < 5; ++j) {
                const int e0 = (lane + 64 * j) * 4, d0 = e0 & 127;
                f32x4 x = *(const f32x4*)(P + e0);
                if (d0 < 32) {
                    const bool first = d0 < 16;
                    const f32x4 pr = *(const f32x4*)(P + (first ? e0 + 16 : e0 - 16));
                    rope4(tab, d0 & 15, x, pr, first, x);
                }
                if (j < 4) {
                    if (prompt) st_bf16x4(p.q_b + (size_t)row * 1024 + e0, x * 0.12751743f);
                    else *(f32x4*)(p.qr + (size_t)row * 1024 + e0) = x;
                } else {
                    const int ek = e0 - 1024;
                    *(f32x4*)(kout + ek) = x;
                    if (prompt) st_bf16x4(p.k_b + ((size_t)(b * 2 + (ek >> 7)) * LPAD + t) * 128 + d0, x);
                }
            }
            {
                const int e0 = lane * 4;
                const f32x4 x = *(const f32x4*)(P + 1280 + e0);
                *(f32x4*)(vout + e0) = x;
                if (prompt) {
#pragma unroll
                    for (int i = 0; i < 4; ++i) vt[(e0 + i) * 72 + tl] = f2bf(x[i]);
                }
            }
#pragma unroll
            for (int j = 0; j < 2; ++j) {
                const int e0 = (lane + 64 * j) * 4, d0 = e0 & 63;
                f32x4 x = *(const f32x4*)(P + 1536 + e0);
                if (d0 < 16) {
                    const bool first = d0 < 8;
                    const f32x4 pr = *(const f32x4*)(P + 1536 + (first ? e0 + 8 : e0 - 8));
                    rope4(tab, 16 + (d0 & 7), x, pr, first, x);
                }
                if (prompt) st_bf16x4(p.iq_b + (size_t)row * 512 + e0, x);
                else *(f32x4*)(p.iq + (size_t)row * 512 + e0) = x;
            }
            {
                const float x = P[2048 + lane];
                const float mu = wave_sum(x) * (1.f / 64.f);
                const float dv = x - mu;
                const float var = wave_sum(dv * dv) * (1.f / 64.f);
                const float xn = dv * rsqrtf(var + 1e-5f) * p.dsa_ik_g[lane] + p.dsa_ik_b[lane];
                const float other = __shfl_xor(xn, 8);
                float o = xn;
                if (lane < 16) {
                    const float c = tab[(16 + (lane & 7)) * 2], s = tab[(16 + (lane & 7)) * 2 + 1];
                    if (lane < 8) o = xn * c - other * s; else o = xn * c + other * s;
                }
                float* io = prompt ? (p.ik_prompt + (size_t)row * 64) : (p.ik_sample + (size_t)(row - NPR) * 64);
                io[lane] = o;
                if (prompt) p.ik_b[((size_t)b * LPAD + t) * 64 + lane] = f2bf(o);
            }
            if (lane < 8) p.iw[(size_t)row * 8 + lane] = P[2112 + lane] * 0.35355339059327373f;
        }
        __syncthreads();
        if (prompt) {
#pragma unroll
            for (int i = 0; i < 4; ++i) {
                const int ch = tid + 512 * i, rr = ch >> 3, c8 = (ch & 7) * 8;
                const uint4 v = *(const uint4*)(vt + rr * 72 + c8);
                *(uint4*)(p.vt_b + ((size_t)(b * 2 + (rr >> 7)) * 128 + (rr & 127)) * LPAD + t0 + c8) = v;
            }
        }
        __syncthreads();
    }
    for (int idx = bid * NTHR + tid_opaque(); idx < BATCH * (LPAD - LP) * 256; idx += nb * NTHR) {
        const int c = idx & 255, tp = (idx >> 8) % (LPAD - LP), bb = idx / ((LPAD - LP) * 256);
        const int t = LP + tp, kvh = c >> 7, d = c & 127;
        p.k_b[((size_t)(bb * 2 + kvh) * LPAD + t) * 128 + d] = 0;
        if (c < 64) p.ik_b[((size_t)bb * LPAD + t) * 64 + c] = 0;
        if (c < 65) p.maskT[((size_t)bb * 65 + c) * LPAD + t] = (c == 0) ? 1ull : 0ull;
    }
}

__device__ __forceinline__ const float* ik_row(const Params& p, bool prompt, int b, int s) {
    if (prompt) return p.ik_prompt + ((size_t)b * LP + s) * 64;
    if (s < PAST) { const int pg = p.page_table[b * 16 + (s >> 7)]; return p.cache_ik + ((size_t)pg * 128 + (s & 127)) * 64; }
    return p.ik_sample + ((size_t)b * DS + (s - PAST)) * 64;
}
__device__ __forceinline__ const float* kv_row(const float* own_p, const float* own_s, const float* cache, const int* page_table,
                                               bool prompt, int b, int s) {
    if (prompt) return own_p + ((size_t)b * LP + s) * 256;
    if (s < PAST) { const int pg = page_table[b * 16 + (s >> 7)]; return cache + ((size_t)pg * 128 + (s & 127)) * 256; }
    return own_s + ((size_t)b * DS + (s - PAST)) * 256;
}

template <bool PROMPT>
__device__ __forceinline__ void select_emit(const float* sc, int qpos, int lane, unsigned long long* maskcol, int* selrow) {
    const unsigned long long ltmask = (1ull << lane) - 1ull;
    unsigned key[65];
#pragma unroll
    for (int j = 0; j < 65; ++j) {
        const int s = j * 64 + lane;
        const float x = (s >= 16 && s <= qpos) ? sc[s] : -INFINITY;
        const unsigned u = __float_as_uint(x);
        key[j] = (u & 0x80000000u) ? ~u : (u | 0x80000000u);
    }
    unsigned T = 0u;
    bool exact = false;
    for (int bit = 31; bit >= 0; --bit) {
        const unsigned cand = T | (1u << bit);
        int c = 0;
#pragma unroll
        for (int j = 0; j < 65; ++j) c += __popcll(__ballot(key[j] >= cand));
        if (c >= 240) { T = cand; if (c == 240) { exact = true; break; } }
    }
    int need_eq = 0;
    if (!exact) {
        int cgt = 0;
#pragma unroll
        for (int j = 0; j < 65; ++j) cgt += __popcll(__ballot(key[j] > T));
        need_eq = 240 - cgt;
    }
    if (!PROMPT) { if (lane < 16) selrow[lane] = lane; }
    int base = 16, erun = 0;
    unsigned long long myword = 0ull, word64 = 0ull;
#pragma unroll
    for (int j = 0; j < 65; ++j) {
        const bool gt = exact ? (key[j] >= T) : (key[j] > T);
        const bool eq = exact ? false : (key[j] == T);
        const unsigned long long meq = __ballot(eq);
        const int rank = erun + __popcll(meq & ltmask);
        const bool take = gt || (eq && rank < need_eq);
        unsigned long long m = __ballot(take);
        if (PROMPT) {
            if (j == 0) m |= 0xFFFFull;
            if (j < 64) { if (lane == j) myword = m; } else word64 = m;
        } else {
            if (take) selrow[base + __popcll(m & ltmask)] = j * 64 + lane;
            base += __popcll(m);
        }
        erun += __popcll(meq);
    }
    if (PROMPT) {
        maskcol[(size_t)lane * LPAD] = myword;
        if (lane == 0) maskcol[(size_t)64 * LPAD] = word64;
    }
}

__device__ __forceinline__ void indexer_sample_row(const Params& p, float* sc, float* qs, int row, int lane) {
    const int b = (row - NPR) >> 2, qpos = PAST + ((row - NPR) & 3);
    int* selrow = p.sel + (size_t)row * 256;
    const int n = qpos - 15;
    for (int j = lane; j < 512; j += 64) qs[j] = p.iq[(size_t)row * 512 + j];
    float w[8];
#pragma unroll
    for (int h = 0; h < 8; ++h) w[h] = p.iw[(size_t)row * 8 + h];
    lds_fence();
    for (int j0 = 0; j0 < n; j0 += 64) {
        const int s = 16 + j0 + lane;
        const bool valid = s <= qpos;
        const float* kp = ik_row(p, false, b, valid ? s : qpos);
        float dh[8];
#pragma unroll
        for (int h = 0; h < 8; ++h) dh[h] = 0.f;
#pragma unroll
        for (int half = 0; half < 2; ++half) {
            f32x4 kv[8];
#pragma unroll
            for (int c = 0; c < 8; ++c) kv[c] = *(const f32x4*)(kp + half * 32 + c * 4);
#pragma unroll
            for (int h = 0; h < 8; ++h) {
                float d = dh[h];
#pragma unroll
                for (int c = 0; c < 8; ++c) {
                    const f32x4 q4 = *(const f32x4*)(qs + h * 64 + half * 32 + c * 4);
                    d += kv[c][0] * q4[0]; d += kv[c][1] * q4[1]; d += kv[c][2] * q4[2]; d += kv[c][3] * q4[3];
                }
                dh[h] = d;
            }
        }
        float score = 0.f;
#pragma unroll
        for (int h = 0; h < 8; ++h) score += w[h] * fmaxf(dh[h], 0.f);
        if (valid) sc[s] = score;
    }
    lds_fence();
    select_emit<false>(sc, qpos, lane, nullptr, selrow);
    lds_fence();
}

__device__ __forceinline__ void indexer_prompt_unit(const Params& p, float* sc, int b, int g8, int tid) {
    const int lane = tid & 63, wave = tid >> 6;
    const int r = lane & 31, hh = lane >> 5;
    const int t0 = g8 * 8;
    if (t0 < 256) {
        const int qpos = t0 + wave;
        unsigned long long* maskcol = p.maskT + (size_t)b * 65 * LPAD + qpos;
        for (int j = lane; j < 65; j += 64) {
            const int lo = j * 64;
            unsigned long long m = 0ull;
            if (qpos >= lo + 63) m = ~0ull; else if (qpos >= lo) m = (1ull << (qpos - lo + 1)) - 1ull;
            maskcol[(size_t)j * LPAD] = m;
        }
        return;
    }
    bf16x8 af[2][4];
    {
        const int e2 = r & 3, hb = (r >> 2) & 1, a = r >> 3;
        const int qi = 2 * hb + (a >> 1), head = 4 * (a & 1) + e2;
#pragma unroll
        for (int rt = 0; rt < 2; ++rt) {
            const bf16_t* ap = p.iq_b + ((size_t)b * LP + t0 + 4 * rt + qi) * 512 + head * 64 + 8 * hh;
#pragma unroll
            for (int ks = 0; ks < 4; ++ks) af[rt][ks] = *(const bf16x8*)(ap + 16 * ks);
        }
    }
    float wq[2][2][8];
#pragma unroll
    for (int rt = 0; rt < 2; ++rt)
#pragma unroll
        for (int ql = 0; ql < 2; ++ql) {
            const float* wp = p.iw + ((size_t)b * LP + t0 + 4 * rt + 2 * hh + ql) * 8;
            const f32x4 w0 = *(const f32x4*)wp, w1 = *(const f32x4*)(wp + 4);
#pragma unroll
            for (int e2 = 0; e2 < 4; ++e2) { wq[rt][ql][e2] = w0[e2]; wq[rt][ql][4 + e2] = w1[e2]; }
        }
    const int nkt = (t0 + 7) / 32 + 1;
    const bf16_t* kbase = p.ik_b + ((size_t)b * LPAD + r) * 64 + 8 * hh;
    bf16x8 bq[4];
    if (wave < nkt) {
#pragma unroll
        for (int ks = 0; ks < 4; ++ks) bq[ks] = *(const bf16x8*)(kbase + (size_t)wave * 32 * 64 + 16 * ks);
    }
    for (int kt = wave; kt < nkt; kt += 8) {
        bf16x8 bn[4];
        const int ktn = (kt + 8 < nkt) ? (kt + 8) : kt;
#pragma unroll
        for (int ks = 0; ks < 4; ++ks) bn[ks] = *(const bf16x8*)(kbase + (size_t)ktn * 32 * 64 + 16 * ks);
#pragma unroll
        for (int rt = 0; rt < 2; ++rt) {
            f32x16 acc;
#pragma unroll
            for (int i = 0; i < 16; ++i) acc[i] = 0.f;
#pragma unroll
            for (int ks = 0; ks < 4; ++ks) acc = MFMA32(af[rt][ks], bq[ks], acc);
#pragma unroll
            for (int ql = 0; ql < 2; ++ql) {
                float s = 0.f;
#pragma unroll
                for (int a2 = 0; a2 < 2; ++a2)
#pragma unroll
                    for (int e2 = 0; e2 < 4; ++e2) s += wq[rt][ql][4 * a2 + e2] * fmaxf(acc[4 * (2 * ql + a2) + e2], 0.f);
                sc[(4 * rt + 2 * hh + ql) * 4160 + 32 * kt + r] = s;
            }
        }
#pragma unroll
        for (int ks = 0; ks < 4; ++ks) bq[ks] = bn[ks];
    }
    __syncthreads();
    {
        const int qpos = t0 + wave;
        select_emit<true>(sc + wave * 4160, qpos, lane, p.maskT + (size_t)b * 65 * LPAD + qpos, nullptr);
    }
    __syncthreads();
}

__device__ __forceinline__ void indexer_phase(const Params& p, char* smem, int bid, int nb, int rep = 0) {
    int* slot = (int*)(smem + LDS_BYTES - 32);
    for (;;) {
        const int tid = tid_opaque();
        unsigned zofs = 0; asm volatile("" : "+v"(zofs));
        float* sc = (float*)(smem + zofs);
        if (threadIdx.x == 0) *slot = (int)atomicAdd(p.bar + 3648 + 16 * rep, 1u);
        __syncthreads();
        const int u = *slot;
        __syncthreads();
        if (u >= 64 + BATCH * 514) break;
        if (u < 64) {
            const int wave = tid >> 6;
            indexer_sample_row(p, sc + wave * 4160, sc + 8 * 4160 + wave * 512, NPR + u * 8 + wave, tid & 63);
            __syncthreads();
        } else {
            const int v = u - 64;
            indexer_prompt_unit(p, sc, v & 3, 513 - (v >> 2), tid);
        }
    }
}

__device__ __forceinline__ void attn_sample_query(const Params& p, char* smem, int row) {
    float* qs = (float*)smem;
    float* ps = qs + 1024;
    int* sidx = (int*)(ps + 2048);
    const int tid = tid_opaque(), lane = tid & 63, wave = tid >> 6;
    const bool prompt = false;
    const int b = (row - NPR) >> 2;
    qs[tid] = p.qr[(size_t)row * 1024 + tid];
    qs[tid + 512] = p.qr[(size_t)row * 1024 + 512 + tid];
    if (tid < 256) sidx[tid] = p.sel[(size_t)row * 256 + tid];
    __syncthreads();
    {
        const int j = tid & 255, kvh = tid >> 8;
        const int s = sidx[j];
        const bool valid = s >= 0;
        const float* kp = kv_row(p.k_prompt, p.k_sample, p.cache_k, p.page_table, prompt, b, valid ? s : 0) + kvh * 128;
        float d0 = 0.f, d1 = 0.f, d2 = 0.f, d3 = 0.f;
        const float* q0 = qs + (kvh * 4) * 128;
#pragma unroll 8
        for (int c = 0; c < 32; ++c) {
            const f32x4 kv = *(const f32x4*)(kp + c * 4);
            const f32x4 a0 = *(const f32x4*)(q0 + c * 4), a1 = *(const f32x4*)(q0 + 128 + c * 4), a2 = *(const f32x4*)(q0 + 256 + c * 4),
                        a3 = *(const f32x4*)(q0 + 384 + c * 4);
            d0 += kv[0] * a0[0] + kv[1] * a0[1] + kv[2] * a0[2] + kv[3] * a0[3];
            d1 += kv[0] * a1[0] + kv[1] * a1[1] + kv[2] * a1[2] + kv[3] * a1[3];
            d2 += kv[0] * a2[0] + kv[1] * a2[1] + kv[2] * a2[2] + kv[3] * a2[3];
            d3 += kv[0] * a3[0] + kv[1] * a3[1] + kv[2] * a3[2] + kv[3] * a3[3];
        }
        const float sc = 0.08838834764831845f;
        ps[(kvh * 4 + 0) * 256 + j] = valid ? d0 * sc : -INFINITY;
        ps[(kvh * 4 + 1) * 256 + j] = valid ? d1 * sc : -INFINITY;
        ps[(kvh * 4 + 2) * 256 + j] = valid ? d2 * sc : -INFINITY;
        ps[(kvh * 4 + 3) * 256 + j] = valid ? d3 * sc : -INFINITY;
    }
    __syncthreads();
    {
        float v[4]; float m = -INFINITY;
#pragma unroll
        for (int i = 0; i < 4; ++i) { v[i] = ps[wave * 256 + lane + 64 * i]; m = fmaxf(m, v[i]); }
        m = wave_max(m);
        float sum = 0.f;
#pragma unroll
        for (int i = 0; i < 4; ++i) { v[i] = __expf(v[i] - m); sum += v[i]; }
        sum = wave_sum(sum);
        const float inv = 1.f / sum;
#pragma unroll
        for (int i = 0; i < 4; ++i) ps[wave * 256 + lane + 64 * i] = v[i] * inv;
    }
    __syncthreads();
    {
        const int h = wave, d = lane * 2, kvh = h >> 2;
        float o0 = 0.f, o1 = 0.f;
#pragma unroll 16
        for (int j = 0; j < 256; ++j) {
            int s = sidx[j]; if (s < 0) s = 0;
            const float* vp = kv_row(p.v_prompt, p.v_sample, p.cache_v, p.page_table, prompt, b, s) + kvh * 128 + d;
            const float pj = ps[h * 256 + j];
            const float2 vv = *(const float2*)vp;
            o0 += pj * vv.x; o1 += pj * vv.y;
        }
        *(unsigned*)(p.gated + (size_t)row * 1024 + h * 128 + d) = pk2(o0, o1);
    }
    __syncthreads();
}

constexpr int AT_K = 0, AT_V = 64 * 136, AT_ELEMS = 64 * 136 + 128 * 72;
__device__ __forceinline__ void attn_dense_unit(const Params& p, char* smem, int b, int kvh, int qb) {
    bf16_t* lds = (bf16_t*)smem;
    const int tid = tid_opaque(), lane = tid & 63, wave = tid >> 6;
    const int r = lane & 31, hh = lane >> 5;
    const int g = wave & 3, qs = wave >> 2;
    const int head = kvh * 4 + g;
    const int tq = 64 * qb + 32 * qs + r;
    const int tqc = (tq < LP) ? tq : (LP - 1);
    bf16x8 qf[8];
    {
        const bf16_t* qp = p.q_b + ((size_t)b * LP + tqc) * 1024 + head * 128 + 8 * hh;
#pragma unroll
        for (int ks = 0; ks < 8; ++ks) qf[ks] = *(const bf16x8*)(qp + 16 * ks);
    }
    f32x16 O[4];
#pragma unroll
    for (int i = 0; i < 4; ++i)
#pragma unroll
        for (int j = 0; j < 16; ++j) O[i][j] = 0.f;
    float mrun = -3.0e38f, lrun = 0.f;
    const bf16_t* Kg = p.k_b + ((size_t)(b * 2 + kvh) * LPAD) * 128;
    const bf16_t* Vg = p.vt_b + ((size_t)(b * 2 + kvh) * 128) * LPAD;
    const unsigned long long* mcol = p.maskT + (size_t)b * 65 * LPAD + tq;
    const int kc0 = tid, kc1 = tid + 512;
    uint4 sk0, sk1, sv0, sv1;
#define AT_GLOAD(kt_) do { const bf16_t* kg_ = Kg + (size_t)(kt_) * 64 * 128; const bf16_t* vg_ = Vg + (size_t)(kt_) * 64; \
        sk0 = *(const uint4*)(kg_ + (size_t)kc0 * 8); sk1 = *(const uint4*)(kg_ + (size_t)kc1 * 8); \
        sv0 = *(const uint4*)(vg_ + (size_t)(kc0 >> 3) * LPAD + (kc0 & 7) * 8); sv1 = *(const uint4*)(vg_ + (size_t)(kc1 >> 3) * LPAD + (kc1 & 7) * 8); } while (0)
#define AT_SSTORE(buf_) do { bf16_t* q_ = (buf_); \
        *(uint4*)(q_ + AT_K + (kc0 >> 4) * 136 + (kc0 & 15) * 8) = sk0; *(uint4*)(q_ + AT_K + (kc1 >> 4) * 136 + (kc1 & 15) * 8) = sk1; \
        *(uint4*)(q_ + AT_V + (kc0 >> 3) * 72 + (kc0 & 7) * 8) = sv0; *(uint4*)(q_ + AT_V + (kc1 >> 3) * 72 + (kc1 & 7) * 8) = sv1; } while (0)
    AT_GLOAD(0); AT_SSTORE(lds);
    __syncthreads();
    for (int kt = 0; kt <= qb; ++kt) {
        unsigned zofs = 0; asm volatile("" : "+v"(zofs));
        bf16_t* cur = lds + (kt & 1) * AT_ELEMS + zofs;
        bf16_t* nxt = lds + ((kt + 1) & 1) * AT_ELEMS + zofs;
        const bool more = kt < qb;
        if (more) { AT_GLOAD(kt + 1); }
        const unsigned long long mw = mcol[(size_t)kt * LPAD];
        f32x16 st[2];
#pragma unroll
        for (int j = 0; j < 16; ++j) { st[0][j] = 0.f; st[1][j] = 0.f; }
#pragma unroll
        for (int ks = 0; ks < 8; ++ks) {
            st[0] = MFMA32(*(const bf16x8*)(cur + AT_K + (r) * 136 + 16 * ks + 8 * hh), qf[ks], st[0]);
            st[1] = MFMA32(*(const bf16x8*)(cur + AT_K + (32 + r) * 136 + 16 * ks + 8 * hh), qf[ks], st[1]);
        }
        float mx = -3.0e38f;
#pragma unroll
        for (int kk = 0; kk < 2; ++kk) {
            const unsigned w = (unsigned)(mw >> (32 * kk)) >> (4 * hh);
#pragma unroll
            for (int reg = 0; reg < 16; ++reg) {
                const int bit = (reg & 3) + 8 * (reg >> 2);
                const float v = ((w >> bit) & 1u) ? st[kk][reg] : -3.0e38f;
                st[kk][reg] = v;
                mx = fmaxf(mx, v);
            }
        }
        mx = fmaxf(mx, __shfl_xor(mx, 32));
        const float mnew = fmaxf(mrun, mx);
        const float alpha = __builtin_amdgcn_exp2f(mrun - mnew);
        mrun = mnew;
        float psum = 0.f;
#pragma unroll
        for (int kk = 0; kk < 2; ++kk)
#pragma unroll
            for (int reg = 0; reg < 16; ++reg) { const float pv = __builtin_amdgcn_exp2f(st[kk][reg] - mnew); st[kk][reg] = pv; psum += pv; }
        lrun = lrun * alpha + psum;
#pragma unroll
        for (int dt = 0; dt < 4; ++dt) O[dt] = O[dt] * alpha;
        bf16x8 pb[2][2];
#pragma unroll
        for (int kk = 0; kk < 2; ++kk)
#pragma unroll
            for (int s = 0; s < 2; ++s) pb[kk][s] = pack_step(st[kk], s);
#pragma unroll
        for (int dt = 0; dt < 4; ++dt)
#pragma unroll
            for (int kk = 0; kk < 2; ++kk)
#pragma unroll
                for (int s = 0; s < 2; ++s)
                    O[dt] = MFMA32(frag_perm(cur + AT_V + (32 * dt + r) * 72 + 32 * kk + 16 * s + 4 * hh), pb[kk][s], O[dt]);
        if (more) { AT_SSTORE(nxt); }
        __syncthreads();
    }
    const float ltot = lrun + __shfl_xor(lrun, 32);
    const float inv = 1.f / ltot;
    if (tq < LP) {
        bf16_t* op = p.gated + ((size_t)b * LP + tq) * 1024 + head * 128;
#pragma unroll
        for (int dt = 0; dt < 4; ++dt)
#pragma unroll
            for (int g4 = 0; g4 < 4; ++g4) {
                f32x4 v;
#pragma unroll
                for (int e2 = 0; e2 < 4; ++e2) v[e2] = O[dt][4 * g4 + e2] * inv;
                st_bf16x4(op + 32 * dt + 8 * g4 + 4 * hh, v);
            }
    }
    __syncthreads();
}

__device__ __forceinline__ void attn_phase(const Params& p, char* smem, int bid, int nb, int rep = 0) {
    int* slot = (int*)(smem + LDS_BYTES - 32);
    for (;;) {
        if (threadIdx.x == 0) *slot = (int)atomicAdd(p.bar + 3584 + 16 * rep, 1u);
        __syncthreads();
        const int u = *slot;
        __syncthreads();
        if (u >= 520 + NSR) break;
        if (u < 520) attn_dense_unit(p, smem, (u & 7) >> 1, u & 1, 64 - (u >> 3));
        else attn_sample_query(p, smem, NPR + (u - 520));
    }
}

#define XB_TMO      128
#define XB_XCNT(j)  (256  + 64 * (j))
#define XB_XSUB(j)  (1280 + 64 * (j))
#define XB_XGEN(j)  (2304 + 64 * (j))
#define XB_TOP      3328
#define XB_TOPGEN   3392
#define XCD_BAR_WORDS 3456
#define XB_SPIN_CAP (1u << 18)
#define LAS __attribute__((address_space(3)))

__device__ __forceinline__ unsigned xb_ld(unsigned* p)              { return __hip_atomic_load(p, __ATOMIC_RELAXED, __HIP_MEMORY_SCOPE_AGENT); }
__device__ __forceinline__ unsigned xb_add(unsigned* p, unsigned v) { return __hip_atomic_fetch_add(p, v, __ATOMIC_RELAXED, __HIP_MEMORY_SCOPE_AGENT); }
__device__ __forceinline__ unsigned xb_xcc_id() { return (unsigned)__builtin_amdgcn_s_getreg((3 << 11) | 20) & 0xFu; }
#define XB_SPIN(cond, bar) do { unsigned _sp = 0; while (cond) { __builtin_amdgcn_s_sleep(1); \
    if ((++_sp & 255u) == 0u) { if (xb_ld(&(bar)[XB_TMO])) break; if (_sp > XB_SPIN_CAP) { atomicAdd(&(bar)[XB_TMO], 1u); break; } } } } while (0)

struct XcdBarrier {
    unsigned* bar; unsigned x;
    volatile LAS unsigned* st;
};

__device__ __forceinline__ XcdBarrier xcd_barrier_post(unsigned* bar, volatile LAS unsigned* st) {
    XcdBarrier b; b.bar = bar; b.x = xb_xcc_id(); b.st = st;
    if (threadIdx.x == 0) (void)xb_add(&bar[XB_XCNT(b.x)], 1u);
    return b;
}
__device__ __forceinline__ void xcd_barrier_complete(unsigned* bar, unsigned x, unsigned& nloc, unsigned& nx) {
    const unsigned G = gridDim.x * gridDim.y * gridDim.z;
    unsigned sum, cnt, mine, sp = 0u;
    for (;;) {
        sum = 0u; cnt = 0u; mine = 0u;
#pragma unroll
        for (unsigned j = 0; j < 16; ++j) { const unsigned c = xb_ld(&bar[XB_XCNT(j)]); sum += c; cnt += (c > 0u) ? 1u : 0u; mine = (j == x) ? c : mine; }
        if (sum == G) break;
        __builtin_amdgcn_s_sleep(1);
        if ((++sp & 255u) == 0u) { if (xb_ld(&bar[XB_TMO])) break; if (sp > XB_SPIN_CAP) { atomicAdd(&bar[XB_TMO], 1u); break; } }
    }
    nloc = mine > 0u ? mine : 1u; nx = cnt > 0u ? cnt : 1u;
}

__device__ __forceinline__ void xcd_barrier(const XcdBarrier& b) {
    asm volatile("s_waitcnt vmcnt(0)" ::: "memory");
    __syncthreads();
    if (threadIdx.x == 0) {
        unsigned* bar = b.bar;
        __builtin_amdgcn_s_waitcnt(0);
        unsigned nloc = b.st[0], nx = b.st[1];
        if (nloc == 0u) { xcd_barrier_complete(bar, b.x, nloc, nx); b.st[0] = nloc; b.st[1] = nx; }
        const unsigned old = xb_add(&bar[XB_XSUB(b.x)], 1u);
        const unsigned gen = old / nloc;
        if (old + 1u == (gen + 1u) * nloc) {
            __builtin_amdgcn_fence(__ATOMIC_RELEASE, "agent");
            asm volatile("s_waitcnt vmcnt(0)" ::: "memory");
            const unsigned og = xb_add(&bar[XB_TOP], 1u);
            const unsigned tg = og / nx;
            if (og + 1u == (tg + 1u) * nx) xb_add(&bar[XB_TOPGEN], 1u);
            else XB_SPIN(xb_ld(&bar[XB_TOPGEN]) == tg, bar);
            __builtin_amdgcn_fence(__ATOMIC_ACQUIRE, "agent");
            xb_add(&bar[XB_XGEN(b.x)], 1u);
            asm volatile("s_waitcnt vmcnt(0)" ::: "memory");
        } else {
            XB_SPIN(xb_ld(&bar[XB_XGEN(b.x)]) == gen, bar);
            __builtin_amdgcn_fence(__ATOMIC_ACQUIRE, "agent");
            asm volatile("s_waitcnt vmcnt(0)" ::: "memory");
        }
    }
    __syncthreads();
}


constexpr int NPHASE = 19;
template <int PH>
__device__ __forceinline__ void run_phase(const Params& p, char* smem, int bid, int nb, int rep = 0) {
    constexpr int MT = MPAD / 256;
    if constexpr (PH == 0) phase_prologue(p, smem, bid, nb);
    else if constexpr (PH == 1) gemm_big(p.hA, D, p.wt_gin, GIN_PAD, EpiGdnIn{p.mixed, p.z, p.ba}, smem, bid, nb);
    else if constexpr (PH == 2) gdn_stageA(p, smem, bid, nb);
    else if constexpr (PH == 3) gdn_seq_phase(p, smem, bid, nb, rep);
    else if constexpr (PH == 4) gdn_gate_phase(p, bid, nb);
    else if constexpr (PH == 5) gemm_n1024(p.gated, 2048, p.wt_gout, EpiResid{p.preln, p.hA}, EpiResidAtomic{p.preln, p.hA}, 8, smem, bid, nb);
    else if constexpr (PH == 6) ln_phase(p.preln, p.ln1_g, p.ln1_b, p.hB, nullptr, nullptr, bid, nb);
    else if constexpr (PH == 7) gemm_big(p.hB, D, p.wt_w1, DFF, EpiRelu2{p.act}, smem, bid, nb);
    else if constexpr (PH == 8) gemm_n1024(p.act, DFF, p.wt_w2, EpiResid{p.preln, p.hB}, EpiResidAtomic{p.preln, p.hB}, 16, smem, bid, nb);
    else if constexpr (PH == 9) ln_phase(p.preln, p.ln2_g, p.ln2_b, p.hA, nullptr, nullptr, bid, nb);
    else if constexpr (PH == 10) gemm_big(p.hA, D, p.wt_din, DIN_PAD, EpiF32{p.p1, DIN_PAD}, smem, bid, nb);
    else if constexpr (PH == 11) dsa_post_phase(p, smem, bid, nb);
    else if constexpr (PH == 12) indexer_phase(p, smem, bid, nb, rep);
    else if constexpr (PH == 13) attn_phase(p, smem, bid, nb, rep);
    else if constexpr (PH == 14) gemm_n1024(p.gated, D, p.wt_do, EpiResid{p.preln, p.hA}, EpiResidAtomic{p.preln, p.hA}, 4, smem, bid, nb);
    else if constexpr (PH == 15) ln_phase(p.preln, p.ln1_g + D, p.ln1_b + D, p.hB, nullptr, nullptr, bid, nb);
    else if constexpr (PH == 16) gemm_big(p.hB, D, p.wt_w1 + (size_t)D * DFF, DFF, EpiRelu2{p.act}, smem, bid, nb);
    else if constexpr (PH == 17) gemm_n1024(p.act, DFF, p.wt_w2 + (size_t)D * DFF, EpiResid{p.preln, p.hB}, EpiResidAtomic{p.preln, p.hB}, 16, smem, bid, nb);
    else if constexpr (PH == 18) ln_phase(p.preln, p.ln2_g + D, p.ln2_b + D, nullptr, p.y_prompt, p.y_sample, bid, nb);
}

template <int PH>
__global__ void __launch_bounds__(NTHR, 2) k_phase(Params p) {
    extern __shared__ __attribute__((aligned(16))) char smem[];
    run_phase<PH>(p, smem, blockIdx.x, gridDim.x);
}

template <int PH>
__device__ __forceinline__ void mega_run(const Params& p, char* smem, const XcdBarrier& bar) {
    run_phase<PH>(p, smem, blockIdx.x, gridDim.x);
#ifdef PROBE_MASK
    if constexpr ((PROBE_MASK >> PH) & 1) { xcd_barrier(bar); run_phase<PH>(p, smem, blockIdx.x, gridDim.x, 1); }
#endif
    if constexpr (PH + 1 < NPHASE) {
        xcd_barrier(bar);
        mega_run<PH + 1>(p, smem, bar);
    }
}
__global__ void __launch_bounds__(NTHR, 2) k_mega(Params p) {
    extern __shared__ __attribute__((aligned(16))) char smem[];
    volatile LAS unsigned* st = (volatile LAS unsigned*)(smem + LDS_BYTES - 16);
    if (threadIdx.x == 0) { st[0] = 0u; st[1] = 0u; st[2] = 0u; st[3] = 0u; }
    __syncthreads();
    XcdBarrier bar = xcd_barrier_post(p.bar, st);
    mega_run<0>(p, smem, bar);
}

template <int PH>
void launch_phase(const Params& p, hipStream_t stream) {
    static bool attr_done = false;
    if (!attr_done) {
        (void)hipFuncSetAttribute((const void*)k_phase<PH>, hipFuncAttributeMaxDynamicSharedMemorySize, LDS_BYTES);
        attr_done = true;
    }
    hipLaunchKernelGGL(k_phase<PH>, dim3(256), dim3(NTHR), LDS_BYTES, stream, p);
}
template <int PH>
void launch_all(const Params& p, hipStream_t stream) {
    launch_phase<PH>(p, stream);
    if constexpr (PH + 1 < NPHASE) launch_all<PH + 1>(p, stream);
}

}

extern "C" void kernel_launch(void* const* d_in, const int* in_sizes, int n_in, void* d_out, int out_size, void* d_ws, size_t ws_size,
                              hipStream_t stream) {
    Params p{};
    p.x_prompt = (const float*)d_in[0]; p.x_sample = (const float*)d_in[1]; p.state_gdn = (const float*)d_in[2];
    p.state_conv = (const float*)d_in[3]; p.cache_k = (const float*)d_in[4]; p.cache_v = (const float*)d_in[5];
    p.cache_ik = (const float*)d_in[6]; p.page_table = (const int*)d_in[7]; p.meta = (const float*)d_in[8];
    p.ln1_g = (const float*)d_in[9]; p.ln1_b = (const float*)d_in[10]; p.ln2_g = (const float*)d_in[11]; p.ln2_b = (const float*)d_in[12];
    p.mlp_w1 = (const float*)d_in[13]; p.mlp_w2 = (const float*)d_in[14]; p.gdn_w_in = (const float*)d_in[15];
    p.gdn_conv_w = (const float*)d_in[16]; p.gdn_a_log = (const float*)d_in[17]; p.gdn_dt_bias = (const float*)d_in[18];
    p.gdn_norm_w = (const float*)d_in[19]; p.gdn_w_out = (const float*)d_in[20]; p.dsa_w_in = (const float*)d_in[21];
    p.dsa_ik_g = (const float*)d_in[22]; p.dsa_ik_b = (const float*)d_in[23]; p.dsa_w_o = (const float*)d_in[24];
    float* o = (float*)d_out;
    p.y_prompt = o; o += (size_t)BATCH * SEQ * D;
    p.y_sample = o; o += (size_t)NSR * D;
    p.gs_prompt = o; o += (size_t)BATCH * 16 * 128 * 128;
    p.gc_prompt = o; o += (size_t)BATCH * 3 * 4096;
    p.gs_sample = o; o += (size_t)DB * 16 * 128 * 128;
    p.gc_sample = o; o += (size_t)DB * 3 * 4096;
    p.k_prompt = o; o += (size_t)NPR * 256;
    p.v_prompt = o; o += (size_t)NPR * 256;
    p.ik_prompt = o; o += (size_t)NPR * 64;
    p.k_sample = o; o += (size_t)NSR * 256;
    p.v_sample = o; o += (size_t)NSR * 256;
    p.ik_sample = o; o += (size_t)NSR * 64;
    char* w = (char*)d_ws;
    auto take = [&](size_t bytes) { char* r = w; w += (bytes + 255) & ~(size_t)255; return r; };
    p.bar = (unsigned*)take(16384);
    p.wt_gin = (bf16_t*)take((size_t)GIN_PAD * D * 2);
    p.wt_gout = (bf16_t*)take((size_t)D * 2048 * 2);
    p.wt_w1 = (bf16_t*)take((size_t)2 * D * DFF * 2);
    p.wt_w2 = (bf16_t*)take((size_t)2 * D * DFF * 2);
    p.wt_din = (bf16_t*)take((size_t)DIN_PAD * D * 2);
    p.wt_do = (bf16_t*)take((size_t)D * D * 2);
    p.hA = (bf16_t*)take((size_t)MPAD * D * 2);
    p.hB = (bf16_t*)take((size_t)MPAD * D * 2);
    p.preln = (float*)take((size_t)MPAD * D * 4);
    p.mixed = (bf16_t*)take((size_t)MPAD * 4096 * 2);
    p.z = (bf16_t*)take((size_t)MPAD * 2048 * 2);
    p.ba = (float*)take((size_t)MPAD * 32 * 4);
    p.gated = (bf16_t*)take((size_t)MPAD * 2048 * 2);
    p.act = (bf16_t*)take((size_t)MPAD * DFF * 2);
    p.p1 = (float*)take((size_t)MPAD * DIN_PAD * 4);
    p.qr = (float*)take((size_t)MPAD * 1024 * 4);
    p.iq = (float*)take((size_t)MPAD * 512 * 4);
    p.iw = (float*)take((size_t)MPAD * 8 * 4);
    p.sel = (int*)take((size_t)MPAD * 256 * 4);
    p.g_o = (bf16_t*)take((size_t)NPR * 2048 * 2);
    p.rope_tab = (float*)take((size_t)LP * 24 * 2 * 4);
    p.q_b = (bf16_t*)take((size_t)NPR * 1024 * 2);
    p.k_b = (bf16_t*)take((size_t)BATCH * 2 * LPAD * 128 * 2);
    p.vt_b = (bf16_t*)take((size_t)BATCH * 2 * 128 * LPAD * 2);
    p.iq_b = (bf16_t*)take((size_t)NPR * 512 * 2);
    p.ik_b = (bf16_t*)take((size_t)BATCH * LPAD * 64 * 2);
    p.maskT = (unsigned long long*)take((size_t)BATCH * 65 * LPAD * 8);
    p.g_dec = (float*)take((size_t)NCU * 4);
    p.g_u = (float*)p.act;
    p.g_negw = (bf16_t*)p.p1;
    p.g_qg = p.g_negw + (size_t)NCU * 8192;
    p.g_kdT = (bf16_t*)p.qr;
    p.g_aqk = (bf16_t*)p.iq;
    if ((size_t)(w - (char*)d_ws) > ws_size) { fprintf(stderr, "kernel_launch: workspace too small (%zu needed, %zu given)\n", (size_t)(w - (char*)d_ws), ws_size); return; }
#if MEGA
    static int grid = 0;
    if (grid == 0) {
        int dev = 0, cus = 0;
        if (hipGetDevice(&dev) != hipSuccess || hipDeviceGetAttribute(&cus, hipDeviceAttributeMultiprocessorCount, dev) != hipSuccess || cus <= 0) cus = 256;
        (void)hipFuncSetAttribute((const void*)k_mega, hipFuncAttributeMaxDynamicSharedMemorySize, LDS_BYTES);
        grid = cus;
    }
    (void)hipMemsetAsync(p.bar, 0, 16384, stream);
    hipLaunchKernelGGL(k_mega, dim3(grid), dim3(NTHR), LDS_BYTES, stream, p);
#else
    launch_all<0>(p, stream);
#endif
}
```

```cpp
#include <hip/hip_runtime.h>
#include <stdint.h>
#include <stdio.h>

#ifndef MEGA
#define MEGA 1
#endif

namespace {

typedef unsigned short bf16_t;
typedef short bf16x8 __attribute__((ext_vector_type(8)));
typedef float f32x4 __attribute__((ext_vector_type(4)));

constexpr int D = 1024, BATCH = 4, SEQ = 4096, NMETA = 16, LP = SEQ + NMETA;
constexpr int DB = 128, DS = 4, PAST = 2048;
constexpr int NPR = BATCH * LP;
constexpr int NSR = DB * DS;
constexpr int NT = NPR + NSR;
constexpr int MPAD = 17152;
constexpr int DFF = 4096;
constexpr int GIN = 6176, GIN_PAD = 6400;
constexpr int DIN = 2120, DIN_PAD = 2304;
constexpr int NTHR = 512;
constexpr int LPAD = 4160;
constexpr int LDS_BYTES = 150 * 1024;
constexpr float ALPHA = 1.4142135623730951f;

struct Params {
    const float *x_prompt, *x_sample, *state_gdn, *state_conv, *cache_k, *cache_v, *cache_ik;
    const int* page_table;
    const float *meta, *ln1_g, *ln1_b, *ln2_g, *ln2_b, *mlp_w1, *mlp_w2, *gdn_w_in, *gdn_conv_w, *gdn_a_log, *gdn_dt_bias,
        *gdn_norm_w, *gdn_w_out, *dsa_w_in, *dsa_ik_g, *dsa_ik_b, *dsa_w_o;
    float *y_prompt, *y_sample, *gs_prompt, *gc_prompt, *gs_sample, *gc_sample, *k_prompt, *v_prompt, *ik_prompt, *k_sample,
        *v_sample, *ik_sample;
    unsigned* bar;
    bf16_t *wt_gin, *wt_gout, *wt_w1, *wt_w2, *wt_din, *wt_do;
    bf16_t *hA, *hB;
    float* preln;
    bf16_t *mixed, *z;
    float* ba;
    bf16_t *gated, *act;
    float *p1, *qr, *iq, *iw;
    int* sel;
    bf16_t *g_negw, *g_qg, *g_kdT, *g_aqk;
    float *g_u, *g_dec;
    bf16_t* g_o;
    float* rope_tab;
    bf16_t *q_b, *k_b, *vt_b, *iq_b, *ik_b;
    unsigned long long* maskT;
};

__device__ const double kInvFreq[16] = {1.0, 0.44036660267178046, 0.19392274474868576, 0.08539710028576561,
    0.03760603093086393, 0.016560440080994446, 0.007292664737217109, 0.003211445994752591, 0.001414213562373095,
    0.000622772421914596, 0.0002742481756762073, 0.00012076973741146504, 5.318295896944988e-05, 2.341999896140934e-05,
    1.031338537721246e-05, 4.5416704806078695e-06};

__device__ __forceinline__ float bf2f(bf16_t h) { return __uint_as_float(((unsigned)h) << 16); }
typedef __bf16 hwbf16x2 __attribute__((ext_vector_type(2)));
typedef float f32x2 __attribute__((ext_vector_type(2)));
typedef float f32x16 __attribute__((ext_vector_type(16)));
typedef unsigned u32x4 __attribute__((ext_vector_type(4)));
__device__ __forceinline__ unsigned pk2(float lo, float hi) {
    const f32x2 v = {lo, hi};
    return __builtin_bit_cast(unsigned, __builtin_convertvector(v, hwbf16x2));
}
__device__ __forceinline__ bf16_t f2bf(float f) { return (bf16_t)(pk2(f, 0.f) & 0xffffu); }
__device__ __forceinline__ void st_bf16x4(bf16_t* p, f32x4 v) {
    uint2 o; o.x = pk2(v[0], v[1]); o.y = pk2(v[2], v[3]);
    *(uint2*)p = o;
}
__device__ __forceinline__ f32x4 cvt_bf16x4(uint2 o) {
    f32x4 v; v[0] = __uint_as_float(o.x << 16); v[1] = __uint_as_float(o.x & 0xffff0000u);
    v[2] = __uint_as_float(o.y << 16); v[3] = __uint_as_float(o.y & 0xffff0000u);
    return v;
}
__device__ __forceinline__ f32x4 ld_bf16x4(const bf16_t* p) {
    uint2 o = *(const uint2*)p;
    f32x4 v; v[0] = __uint_as_float(o.x << 16); v[1] = __uint_as_float(o.x & 0xffff0000u);
    v[2] = __uint_as_float(o.y << 16); v[3] = __uint_as_float(o.y & 0xffff0000u);
    return v;
}
__device__ __forceinline__ float wave_sum(float v) {
#pragma unroll
    for (int o = 1; o < 64; o <<= 1) v += __shfl_xor(v, o);
    return v;
}
__device__ __forceinline__ float wave_max(float v) {
#pragma unroll
    for (int o = 1; o < 64; o <<= 1) v = fmaxf(v, __shfl_xor(v, o));
    return v;
}
__device__ __forceinline__ int wave_sum_i(int v) {
#pragma unroll
    for (int o = 1; o < 64; o <<= 1) v += __shfl_xor(v, o);
    return v;
}
__device__ __forceinline__ float silu(float x) { return x * __builtin_amdgcn_rcpf(1.f + __expf(-x)); }
__device__ __forceinline__ int tid_opaque() { int t = threadIdx.x; asm volatile("" : "+v"(t)); return t; }
__device__ __forceinline__ void lds_fence() { asm volatile("s_waitcnt lgkmcnt(0)" ::: "memory"); }

__device__ __forceinline__ void transpose_convert(const float* __restrict__ W, int K, int N, int Npad, bf16_t* __restrict__ WT, float* tile,
                                  int bid, int nb) {
    const int tid = tid_opaque();
    const int tk = K / 64, tn = Npad / 64;
    for (int it = bid; it < tk * tn; it += nb) {
        const int kb = it / tn, nbk = it % tn, k0 = kb * 64, n0 = nbk * 64;
#pragma unroll
        for (int i = 0; i < 8; ++i) {
            const int r = (tid >> 6) + 8 * i, c = tid & 63, n = n0 + c;
            tile[r * 65 + c] = (n < N) ? W[(size_t)(k0 + r) * N + n] : 0.f;
        }
        __syncthreads();
        {
            const int rn = tid >> 3, c8 = (tid & 7) * 8;
            const float* tp = tile + c8 * 65 + rn;
            uint4 o;
            o.x = pk2(tp[0], tp[65]); o.y = pk2(tp[2 * 65], tp[3 * 65]); o.z = pk2(tp[4 * 65], tp[5 * 65]); o.w = pk2(tp[6 * 65], tp[7 * 65]);
            *(uint4*)(WT + (size_t)(n0 + rn) * K + k0 + c8) = o;
        }
        __syncthreads();
    }
}

__device__ __forceinline__ void phase_prologue(const Params& p, char* smem, int bid, int nb) {
    float* tile = (float*)smem;
    transpose_convert(p.gdn_w_in, D, GIN, GIN_PAD, p.wt_gin, tile, bid, nb);
    transpose_convert(p.gdn_w_out, 2048, D, D, p.wt_gout, tile, bid, nb);
    transpose_convert(p.mlp_w1, D, DFF, DFF, p.wt_w1, tile, bid, nb);
    transpose_convert(p.mlp_w1 + (size_t)D * DFF, D, DFF, DFF, p.wt_w1 + (size_t)D * DFF, tile, bid, nb);
    transpose_convert(p.mlp_w2, DFF, D, D, p.wt_w2, tile, bid, nb);
    transpose_convert(p.mlp_w2 + (size_t)D * DFF, DFF, D, D, p.wt_w2 + (size_t)D * DFF, tile, bid, nb);
    transpose_convert(p.dsa_w_in, D, DIN, DIN_PAD, p.wt_din, tile, bid, nb);
    transpose_convert(p.dsa_w_o, D, D, D, p.wt_do, tile, bid, nb);
    for (int idx = bid * NTHR + tid_opaque(); idx < (MPAD - 16384) * 256; idx += nb * NTHR)
        *(f32x4*)(p.preln + (size_t)16384 * D + (size_t)idx * 4) = (f32x4){0.f, 0.f, 0.f, 0.f};
    for (int idx = bid * NTHR + tid_opaque(); idx < LP * 24; idx += nb * NTHR) {
        const int pos = idx / 24, f = idx % 24;
        const int fi = (f < 16) ? f : (f - 16) * 2;
        const double rev = (double)pos * kInvFreq[fi] * 0.15915494309189535;
        const float r = (float)(rev - floor(rev));
        p.rope_tab[idx * 2] = __builtin_amdgcn_cosf(r);
        p.rope_tab[idx * 2 + 1] = __builtin_amdgcn_sinf(r);
    }
    for (int idx = bid * NTHR + tid_opaque(); idx < MPAD * 256; idx += nb * NTHR) {
        const int row = idx >> 8, c4 = (idx & 255) * 4;
        f32x4 v = {0.f, 0.f, 0.f, 0.f};
        if (row < NPR) {
            const int b = row / LP, t = row % LP;
            const float* src = (t < NMETA) ? (p.meta + (size_t)t * D) : (p.x_prompt + ((size_t)b * SEQ + (t - NMETA)) * D);
            v = *(const f32x4*)(src + c4);
        } else if (row < NT) {
            v = *(const f32x4*)(p.x_sample + (size_t)(row - NPR) * D + c4);
        }
        st_bf16x4(p.hA + (size_t)row * D + c4, v);
    }
}

template <class Epi>
__device__ __forceinline__ void gemm_phase(const bf16_t* __restrict__ A, int lda, const bf16_t* __restrict__ Bt, int K, int Mtiles, int Ntiles,
                           const Epi& epi, char* smem, int bid, int nb) {
    bf16_t* As = (bf16_t*)smem;
    bf16_t* Bs = As + 256 * 72;
    const int tid = tid_opaque(), lane = tid & 63, wave = tid >> 6;
    const int wm = wave >> 1, wn = wave & 1;
    const int fr = lane & 15, fq = lane >> 4;
    const int ntiles = Mtiles * Ntiles;
    const int nk = K / 64;
    for (int tile = bid; tile < ntiles; tile += nb) {
        const int tm = tile % Mtiles, tn = tile / Mtiles;
        const bf16_t* Ag = A + (size_t)tm * 256 * lda;
        const bf16_t* Bg = Bt + (size_t)tn * 128 * K;
        f32x4 acc[4][4];
#pragma unroll
        for (int i = 0; i < 4; ++i)
#pragma unroll
            for (int j = 0; j < 4; ++j) acc[i][j] = (f32x4){0.f, 0.f, 0.f, 0.f};
        const int c0 = tid, c1 = tid + 512, c2 = tid + 1024, c3 = tid + 1536;
        const bf16_t* ga0 = Ag + (size_t)(c0 >> 3) * lda + (c0 & 7) * 8;
        const bf16_t* ga1 = Ag + (size_t)(c1 >> 3) * lda + (c1 & 7) * 8;
        const bf16_t* ga2 = Ag + (size_t)(c2 >> 3) * lda + (c2 & 7) * 8;
        const bf16_t* ga3 = Ag + (size_t)(c3 >> 3) * lda + (c3 & 7) * 8;
        const bf16_t* gb0 = Bg + (size_t)(c0 >> 3) * K + (c0 & 7) * 8;
        const bf16_t* gb1 = Bg + (size_t)(c1 >> 3) * K + (c1 & 7) * 8;
        bf16_t* sa0 = As + (c0 >> 3) * 72 + (c0 & 7) * 8;
        bf16_t* sa1 = As + (c1 >> 3) * 72 + (c1 & 7) * 8;
        bf16_t* sa2 = As + (c2 >> 3) * 72 + (c2 & 7) * 8;
        bf16_t* sa3 = As + (c3 >> 3) * 72 + (c3 & 7) * 8;
        bf16_t* sb0 = Bs + (c0 >> 3) * 72 + (c0 & 7) * 8;
        bf16_t* sb1 = Bs + (c1 >> 3) * 72 + (c1 & 7) * 8;
        uint4 ra0 = *(const uint4*)ga0, ra1 = *(const uint4*)ga1, ra2 = *(const uint4*)ga2, ra3 = *(const uint4*)ga3;
        uint4 rb0 = *(const uint4*)gb0, rb1 = *(const uint4*)gb1;
        *(uint4*)sa0 = ra0; *(uint4*)sa1 = ra1; *(uint4*)sa2 = ra2; *(uint4*)sa3 = ra3; *(uint4*)sb0 = rb0; *(uint4*)sb1 = rb1;
        __syncthreads();
        for (int kt = 0; kt < nk; ++kt) {
            const bool more = (kt + 1 < nk);
            if (more) {
                const int k0 = (kt + 1) * 64;
                ra0 = *(const uint4*)(ga0 + k0); ra1 = *(const uint4*)(ga1 + k0); ra2 = *(const uint4*)(ga2 + k0); ra3 = *(const uint4*)(ga3 + k0);
                rb0 = *(const uint4*)(gb0 + k0); rb1 = *(const uint4*)(gb1 + k0);
            }
#pragma unroll
            for (int kk = 0; kk < 2; ++kk) {
                bf16x8 af[4], bfr[4];
#pragma unroll
                for (int i = 0; i < 4; ++i) af[i] = *(const bf16x8*)(As + (wm * 64 + i * 16 + fr) * 72 + kk * 32 + fq * 8);
#pragma unroll
                for (int j = 0; j < 4; ++j) bfr[j] = *(const bf16x8*)(Bs + (wn * 64 + j * 16 + fr) * 72 + kk * 32 + fq * 8);
#pragma unroll
                for (int i = 0; i < 4; ++i)
#pragma unroll
                    for (int j = 0; j < 4; ++j) acc[i][j] = __builtin_amdgcn_mfma_f32_16x16x32_bf16(bfr[j], af[i], acc[i][j], 0, 0, 0);
            }
            __syncthreads();
            if (more) {
                *(uint4*)sa0 = ra0; *(uint4*)sa1 = ra1; *(uint4*)sa2 = ra2; *(uint4*)sa3 = ra3; *(uint4*)sb0 = rb0; *(uint4*)sb1 = rb1;
                __syncthreads();
            }
        }
#pragma unroll
        for (int i = 0; i < 4; ++i)
#pragma unroll
            for (int j = 0; j < 4; ++j) {
                const int row = tm * 256 + wm * 64 + i * 16 + fr, col = tn * 128 + wn * 64 + j * 16 + fq * 4;
                epi(row, col, acc[i][j]);
            }
    }
}

namespace pg8 {
#define PG8_LAS __attribute__((address_space(3)))
constexpr int BM = 256, BK = 64, HALF = 128, HTB = HALF * BK * 2  , STAGE_BYTES = 8 * HTB, NXCD = 8, WGM = 8;
__device__ __forceinline__ int lds_byte(int r, int c) { const int st = (r >> 4) * 2 + (c >> 5), rr = r & 15, cc = c & 31, ob = rr * 64 + cc * 2; return st * 1024 + (ob ^ (((ob >> 9) & 1) << 5)); }
__device__ __forceinline__ void stage_rc(int b, int& R, int& C) { const int st = b / 1024, sb = b % 1024, swz = sb ^ (((sb >> 9) & 1) << 5); R = (st >> 1) * 16 + swz / 64; C = (st & 1) * 32 + (swz % 64) / 2; }
struct Unit { int pm, pn, pk; };
struct Gemm { const bf16_t* A; const bf16_t* Bt; int K; int splits; };
struct StaticOrder {
    int nM, nN, nNr, pm0, nwg, G, c;
    __device__ void init(int nM_, int nNr_, int splits, int pm0_, int G_, int c_) { nM = nM_; nNr = nNr_; nN = nNr_ * splits; pm0 = pm0_; nwg = nM * nN; G = G_; c = c_; }
    __device__ bool next(int i, Unit& u) const {
        const long L = (long)i * G + c; if (L >= nwg) return false;
        int wgid = (int)L; { const int q = nwg / NXCD, r = nwg % NXCD, xcd = wgid % NXCD, off = wgid / NXCD; wgid = (xcd < r ? xcd * (q + 1) : r * (q + 1) + (xcd - r) * q) + off; }
        const int nig = WGM * nN, gid = wgid / nig, fm = gid * WGM, gsz = (nM - fm) < WGM ? (nM - fm) : WGM;
        const int pnv = (wgid % nig) / gsz;
        u.pm = pm0 + fm + ((wgid % nig) % gsz); u.pn = pnv % nNr; u.pk = pnv / nNr; return true;
    }
};
template <class Epi>
__device__ __forceinline__ void gemm_phase(PG8_LAS unsigned char* lds, const Gemm g, const StaticOrder& S, const Epi& E) {
    const int tid = tid_opaque(), wid = __builtin_amdgcn_readfirstlane(tid >> 6), lane = tid & 63, wr = wid >> 2, wc = wid & 3, fr = lane & 15, fq = lane >> 4;
    const int K = g.K, Kp = K / g.splits, nt = Kp / BK;
    unsigned voffA[2], voffB[2];
#pragma unroll
    for (int i = 0; i < 2; ++i) { int R, C; stage_rc(tid * 16 + i * 8192, R, C); voffA[i] = (unsigned)(R * K + C) * 2u; voffB[i] = voffA[i]; }
    const size_t kstep = (size_t)(BK * 2);
    const size_t hstep = (size_t)HALF * K * 2;
    const size_t tstep = 2 * hstep;
    const size_t pstep = (size_t)Kp * 2;
    const unsigned ldsw = (unsigned)wid * 1024u;
    const int aoff = lds_byte(wr * 64 + fr, fq * 8), boff = lds_byte(wc * 32 + fr, fq * 8);
#define PG8_SA(b, h) (((b) * 2 + (h)) * HTB)
#define PG8_SB(b, h) ((4 + (b) * 2 + (h)) * HTB)
#define PG8_STAGE(bufoff, gbase, voff) do { _Pragma("unroll") for (int _i = 0; _i < 2; ++_i) \
        __builtin_amdgcn_global_load_lds((const unsigned*)((const char*)(gbase) + (voff)[_i]), (PG8_LAS unsigned*)(lds + (bufoff) + ldsw + _i * 8192), 16, 0, 0); } while (0)
#define PG8_LDA(dst, b, h) do { _Pragma("unroll") for (int m = 0; m < 4; ++m) _Pragma("unroll") for (int k = 0; k < 2; ++k) dst[m][k] = *(const PG8_LAS bf16x8*)(lds + PG8_SA(b, h) + aoff + m * 2048 + k * 1024); } while (0)
#define PG8_LDB(dst, b, h) do { _Pragma("unroll") for (int n = 0; n < 2; ++n) _Pragma("unroll") for (int k = 0; k < 2; ++k) dst[n][k] = *(const PG8_LAS bf16x8*)(lds + PG8_SB(b, h) + boff + n * 2048 + k * 1024); } while (0)
#define PG8_MMA(ai, bj, At, Bt) do { __builtin_amdgcn_s_setprio(1); _Pragma("unroll") for (int m = 0; m < 4; ++m) _Pragma("unroll") for (int n = 0; n < 2; ++n) _Pragma("unroll") for (int k = 0; k < 2; ++k) \
        acc[ai][bj][m][n] = __builtin_amdgcn_mfma_f32_16x16x32_bf16(Bt[n][k], At[m][k], acc[ai][bj][m][n], 0, 0, 0); __builtin_amdgcn_s_setprio(0); } while (0)
#define PG8_WAIT_V(n) asm volatile("s_waitcnt vmcnt(" #n ")" ::: "memory")
#define PG8_WAIT_L(n) asm volatile("s_waitcnt lgkmcnt(" #n ")" ::: "memory")
#define PG8_BAR __builtin_amdgcn_s_barrier()
#define PG8_SCHED __builtin_amdgcn_sched_barrier(0)
    Unit cur, nxt; int ui = 0;
    if (!S.next(0, cur)) return;
    f32x4 acc[2][2][4][2];
#pragma unroll
    for (int a = 0; a < 2; ++a)
#pragma unroll
        for (int b = 0; b < 2; ++b)
#pragma unroll
            for (int m = 0; m < 4; ++m)
#pragma unroll
                for (int n = 0; n < 2; ++n) acc[a][b][m][n] = (f32x4){0.f, 0.f, 0.f, 0.f};
    bf16x8 At[4][2], B0[2][2], B1[2][2];
    const char* cA = (const char*)g.A + (size_t)cur.pm * tstep + (size_t)cur.pk * pstep; const char* cB = (const char*)g.Bt + (size_t)cur.pn * tstep + (size_t)cur.pk * pstep;
    PG8_STAGE(PG8_SB(0, 0), cB, voffB); PG8_STAGE(PG8_SA(0, 0), cA, voffA); PG8_STAGE(PG8_SB(0, 1), cB + hstep, voffB); PG8_STAGE(PG8_SA(0, 1), cA + hstep, voffA);
    if (wr == 1) PG8_BAR;
    PG8_WAIT_V(4); PG8_BAR;
    PG8_STAGE(PG8_SB(1, 0), cB + kstep, voffB); PG8_STAGE(PG8_SA(1, 0), cA + kstep, voffA); PG8_STAGE(PG8_SB(1, 1), cB + hstep + kstep, voffB);
    PG8_WAIT_V(6); PG8_BAR;
    for (;;) {
        const bool has_next = S.next(ui + 1, nxt);
        const char* nA = has_next ? (const char*)g.A + (size_t)nxt.pm * tstep + (size_t)nxt.pk * pstep : cA; const char* nB = has_next ? (const char*)g.Bt + (size_t)nxt.pn * tstep + (size_t)nxt.pk * pstep : cB;
        for (int t = 0; t < nt; t += 2) {
            const bool last = (t == nt - 2);
            const char* a1 = cA + (size_t)(t + 1) * kstep;
            const char* a2 = last ? nA : cA + (size_t)(t + 2) * kstep; const char* b2 = last ? nB : cB + (size_t)(t + 2) * kstep;
            const char* a3 = a2 + kstep; const char* b3 = b2 + kstep;
            PG8_LDB(B0, 0, 0); PG8_SCHED; PG8_LDA(At, 0, 0); PG8_STAGE(PG8_SA(1, 1), a1 + hstep, voffA);
            PG8_WAIT_L(8); PG8_BAR; PG8_WAIT_L(0); PG8_MMA(0, 0, At, B0); PG8_BAR; PG8_SCHED;
            PG8_LDB(B1, 0, 1); PG8_STAGE(PG8_SB(0, 0), b2, voffB);
            PG8_BAR; PG8_WAIT_L(0); PG8_MMA(0, 1, At, B1); PG8_BAR;
            PG8_LDA(At, 0, 1); PG8_STAGE(PG8_SA(0, 0), a2, voffA);
            PG8_BAR; PG8_WAIT_L(0); PG8_MMA(1, 0, At, B0); PG8_BAR; PG8_SCHED;
            PG8_STAGE(PG8_SB(0, 1), b2 + hstep, voffB);
            PG8_WAIT_V(6); PG8_BAR; PG8_MMA(1, 1, At, B1); PG8_BAR;
            PG8_LDB(B0, 1, 0); PG8_SCHED; PG8_LDA(At, 1, 0); PG8_STAGE(PG8_SA(0, 1), a2 + hstep, voffA);
            PG8_WAIT_L(8); PG8_BAR; PG8_WAIT_L(0); PG8_MMA(0, 0, At, B0); PG8_BAR; PG8_SCHED;
            PG8_LDB(B1, 1, 1); PG8_STAGE(PG8_SB(1, 0), b3, voffB);
            PG8_BAR; PG8_WAIT_L(0); PG8_MMA(0, 1, At, B1); PG8_BAR;
            PG8_LDA(At, 1, 1); PG8_STAGE(PG8_SA(1, 0), a3, voffA);
            PG8_BAR; PG8_WAIT_L(0); PG8_MMA(1, 0, At, B0); PG8_BAR; PG8_SCHED;
            PG8_STAGE(PG8_SB(1, 1), b3 + hstep, voffB);
            PG8_WAIT_V(6); PG8_BAR; PG8_MMA(1, 1, At, B1); PG8_BAR;
        }
#pragma unroll
        for (int ai = 0; ai < 2; ++ai)
#pragma unroll
            for (int m = 0; m < 4; ++m)
#pragma unroll
                for (int bj = 0; bj < 2; ++bj)
#pragma unroll
                    for (int n = 0; n < 2; ++n)
                        E(cur.pm * BM + ai * HALF + wr * 64 + m * 16 + fr, cur.pn * BM + bj * HALF + wc * 32 + n * 16 + 4 * fq, acc[ai][bj][m][n], cur.pk);
        if (!has_next) break;
#pragma unroll
        for (int a = 0; a < 2; ++a)
#pragma unroll
            for (int b = 0; b < 2; ++b)
#pragma unroll
                for (int m = 0; m < 4; ++m)
#pragma unroll
                    for (int n = 0; n < 2; ++n) acc[a][b][m][n] = (f32x4){0.f, 0.f, 0.f, 0.f};
        cur = nxt; cA = nA; cB = nB; ++ui;
    }
    PG8_WAIT_V(0);
    if (wr == 0) PG8_BAR;
    PG8_BAR;
#undef PG8_SA
#undef PG8_SB
#undef PG8_STAGE
#undef PG8_LDA
#undef PG8_LDB
#undef PG8_MMA
#undef PG8_WAIT_V
#undef PG8_WAIT_L
#undef PG8_BAR
#undef PG8_SCHED
}
}

template <class Epi>
__device__ __forceinline__ void gemm_big(const bf16_t* A, int K, const bf16_t* Bt, int Npad, const Epi& e, char* smem, int bid, int nb) {
    pg8::StaticOrder S; S.init(MPAD / 256, Npad / 256, 1, 0, nb, bid);
    pg8::gemm_phase((PG8_LAS unsigned char*)smem, pg8::Gemm{A, Bt, K, 1}, S, e);
}
template <class Epi1, class Epi2>
__device__ __forceinline__ void gemm_n1024(const bf16_t* A, int K, const bf16_t* Bt, const Epi1& e1, const Epi2& e2, int splits, char* smem, int bid, int nb) {
    pg8::StaticOrder S; S.init(64, 4, 1, 0, nb, bid);
    pg8::gemm_phase((PG8_LAS unsigned char*)smem, pg8::Gemm{A, Bt, K, 1}, S, e1);
    pg8::StaticOrder S2; S2.init(3, 4, splits, 64, nb, bid);
    pg8::gemm_phase((PG8_LAS unsigned char*)smem, pg8::Gemm{A, Bt, K, splits}, S2, e2);
}

struct EpiGdnIn {
    bf16_t *mixed, *z; float* ba;
    __device__ __forceinline__ void operator()(int row, int col, f32x4 v, int = 0) const {
        if (col < 4096) st_bf16x4(mixed + (size_t)row * 4096 + col, v);
        else if (col < 6144) st_bf16x4(z + (size_t)row * 2048 + (col - 4096), v);
        else if (col < 6176) *(f32x4*)(ba + (size_t)row * 32 + (col - 6144)) = v;
    }
};
struct EpiResid {
    float* out; const bf16_t* h;
    __device__ __forceinline__ void operator()(int row, int col, f32x4 v, int = 0) const {
        const f32x4 r = ld_bf16x4(h + (size_t)row * D + col);
        *(f32x4*)(out + (size_t)row * D + col) = v + r * ALPHA;
    }
};
struct EpiResidAtomic {
    float* out; const bf16_t* h;
    __device__ __forceinline__ void operator()(int row, int col, f32x4 v, int pk) const {
        if (pk == 0) { const f32x4 r = ld_bf16x4(h + (size_t)row * D + col); v = v + r * ALPHA; }
        float* o = out + (size_t)row * D + col;
        unsafeAtomicAdd(o, v[0]); unsafeAtomicAdd(o + 1, v[1]); unsafeAtomicAdd(o + 2, v[2]); unsafeAtomicAdd(o + 3, v[3]);
    }
};
struct EpiRelu2 {
    bf16_t* act;
    __device__ __forceinline__ void operator()(int row, int col, f32x4 v, int = 0) const {
#pragma unroll
        for (int e = 0; e < 4; ++e) { const float r = fmaxf(v[e], 0.f); v[e] = r * r; }
        st_bf16x4(act + (size_t)row * DFF + col, v);
    }
};
struct EpiF32 {
    float* out; int ld;
    __device__ __forceinline__ void operator()(int row, int col, f32x4 v, int = 0) const { *(f32x4*)(out + (size_t)row * ld + col) = v; }
};

__device__ __forceinline__ void ln_phase(const float* X, const float* __restrict__ g, const float* __restrict__ bta, bf16_t* Hout,
                         float* yp, float* ys, int bid, int nb) {
    const int tid_ = tid_opaque(); const int lane = tid_ & 63, wave = tid_ >> 6;
    f32x4 gv[4], bv[4];
#pragma unroll
    for (int j = 0; j < 4; ++j) { gv[j] = *(const f32x4*)(g + j * 256 + lane * 4); bv[j] = *(const f32x4*)(bta + j * 256 + lane * 4); }
    for (int row = bid * 8 + wave; row < NT; row += nb * 8) {
        f32x4 v[4]; float s = 0.f;
#pragma unroll
        for (int j = 0; j < 4; ++j) { v[j] = *(const f32x4*)(X + (size_t)row * D + j * 256 + lane * 4); s += (v[j][0] + v[j][1]) + (v[j][2] + v[j][3]); }
        if (row >= 16384) {
#pragma unroll
            for (int j = 0; j < 4; ++j) *(f32x4*)(const_cast<float*>(X) + (size_t)row * D + j * 256 + lane * 4) = (f32x4){0.f, 0.f, 0.f, 0.f};
        }
        const float mean = wave_sum(s) * (1.f / D);
        float s2 = 0.f;
#pragma unroll
        for (int j = 0; j < 4; ++j) { v[j] = v[j] - mean; s2 += (v[j][0] * v[j][0] + v[j][1] * v[j][1]) + (v[j][2] * v[j][2] + v[j][3] * v[j][3]); }
        const float rstd = rsqrtf(wave_sum(s2) * (1.f / D) + 1e-5f);
        float* yo = nullptr;
        if (yp) {
            if (row < NPR) { const int b = row / LP, t = row % LP; if (t >= NMETA) yo = yp + ((size_t)b * SEQ + (t - NMETA)) * D; }
            else yo = ys + (size_t)(row - NPR) * D;
        }
#pragma unroll
        for (int j = 0; j < 4; ++j) {
            const f32x4 o = v[j] * rstd * gv[j] + bv[j];
            if (Hout) st_bf16x4(Hout + (size_t)row * D + j * 256 + lane * 4, o);
            if (yo) *(f32x4*)(yo + j * 256 + lane * 4) = o;
        }
    }
}

__device__ __forceinline__ void gdn_sample_pass(const Params& p, char* smem, int pass, int tid) {
    float* sq = (float*)smem;
    float* sk = sq + 256;
    float* part = sk + 256;
    float* part2 = part + 16;
    const int lane = tid & 63, wave = tid >> 6, ug = wave >> 2, wq = wave & 3;
    const int half = lane >> 5, v = wq * 32 + (lane & 31);
    const int u = pass * 2 + ug, b = u >> 4, h = u & 15, kh = h >> 1;
    const size_t row0 = (size_t)NPR + (size_t)b * DS;
    float S[64];
    {
        const float* Sp = p.state_gdn + ((size_t)(b * 16 + h) * 128 + half * 64) * 128 + v;
#pragma unroll
        for (int k = 0; k < 64; ++k) S[k] = Sp[(size_t)k * 128];
    }
    const float Aexp = __expf(p.gdn_a_log[h]);
    const float dtb = p.gdn_dt_bias[h];
    const float nw = p.gdn_norm_w[v];
    const int chA = (half ? 1024 : 0) + kh * 128 + v, chv = 2048 + h * 128 + v;
    float cA[4], cv[4];
#pragma unroll
    for (int j = 0; j < 4; ++j) { cA[j] = p.gdn_conv_w[j * 4096 + chA]; cv[j] = p.gdn_conv_w[j * 4096 + chv]; }
    float xA[7], xv[7];
#pragma unroll
    for (int i = 0; i < 3; ++i) {
        const float* cs = p.state_conv + ((size_t)b * 3 + i) * 4096;
        xA[i] = cs[chA]; xv[i] = cs[chv];
    }
#pragma unroll
    for (int i = 0; i < 4; ++i) {
        const bf16_t* mr = p.mixed + (row0 + i) * 4096;
        xA[3 + i] = bf2f(mr[chA]); xv[3 + i] = bf2f(mr[chv]);
    }
    float* sqg = sq + ug * 128;
    float* skg = sk + ug * 128;
    float* pg = part + ug * 8;
    float* pg2 = part2 + ug * 4;
    const float* kmine = skg + half * 64;
    const float* qmine = sqg + half * 64;
#pragma unroll
    for (int t = 0; t < DS; ++t) {
        const float yA = silu(xA[t] * cA[0] + xA[t + 1] * cA[1] + xA[t + 2] * cA[2] + xA[t + 3] * cA[3]);
        const float yv = silu(xv[t] * cv[0] + xv[t + 1] * cv[1] + xv[t + 2] * cv[2] + xv[t + 3] * cv[3]);
        (half ? skg : sqg)[v] = yA;
        float ssA = yA * yA;
#pragma unroll
        for (int o = 1; o < 32; o <<= 1) ssA += __shfl_xor(ssA, o);
        if ((lane & 31) == 0) pg[wq * 2 + half] = ssA;
        __syncthreads();
        const float qn = rsqrtf((pg[0] + pg[2]) + (pg[4] + pg[6]) + 1e-6f) * 0.08838834764831845f;
        const float kn = rsqrtf((pg[1] + pg[3]) + (pg[5] + pg[7]) + 1e-6f);
        const float* bap = p.ba + (row0 + t) * 32;
        const float beta = 1.f / (1.f + __expf(-bap[h]));
        const float aa = bap[16 + h] + dtb;
        const float sp = (aa > 20.f) ? aa : log1pf(__expf(aa));
        const float dec = __expf(-Aexp * sp);
        float kS0 = 0.f, kS1 = 0.f;
#pragma unroll
        for (int k = 0; k < 64; k += 4) {
            const f32x4 kk = *(const f32x4*)(kmine + k);
            S[k] *= dec; S[k + 1] *= dec; S[k + 2] *= dec; S[k + 3] *= dec;
            kS0 += kk[0] * S[k]; kS1 += kk[1] * S[k + 1]; kS0 += kk[2] * S[k + 2]; kS1 += kk[3] * S[k + 3];
        }
        float kS = kS0 + kS1;
        kS += __shfl_xor(kS, 32);
        const float delta = (yv - kS * kn) * beta * kn;
        float o0 = 0.f, o1 = 0.f;
#pragma unroll
        for (int k = 0; k < 64; k += 4) {
            const f32x4 kk = *(const f32x4*)(kmine + k);
            const f32x4 qq = *(const f32x4*)(qmine + k);
            S[k] += kk[0] * delta; S[k + 1] += kk[1] * delta; S[k + 2] += kk[2] * delta; S[k + 3] += kk[3] * delta;
            o0 += qq[0] * S[k]; o1 += qq[1] * S[k + 1]; o0 += qq[2] * S[k + 2]; o1 += qq[3] * S[k + 3];
        }
        float o = o0 + o1;
        o = (o + __shfl_xor(o, 32)) * qn;
        float s3 = o * o;
#pragma unroll
        for (int x = 1; x < 32; x <<= 1) s3 += __shfl_xor(s3, x);
        if (lane == 0) pg2[wq] = s3;
        __syncthreads();
        if (half == 0) {
            const float rms = rsqrtf(((pg2[0] + pg2[1]) + (pg2[2] + pg2[3])) * (1.f / 128.f) + 1e-6f);
            const float zz = bf2f(p.z[(row0 + t) * 2048 + h * 128 + v]);
            p.gated[(row0 + t) * 2048 + h * 128 + v] = f2bf(o * rms * nw * silu(zz));
        }
    }
    {
        float* So = p.gs_sample + ((size_t)(b * 16 + h) * 128 + half * 64) * 128 + v;
#pragma unroll
        for (int k = 0; k < 64; ++k) So[(size_t)k * 128] = S[k];
    }
    __syncthreads();
}

#define MFMA32(a, b, c) __builtin_amdgcn_mfma_f32_32x32x16_bf16((a), (b), (c), 0, 0, 0)
constexpr int NCH = 65;
constexpr int NCU = BATCH * 16 * NCH;
__device__ __forceinline__ int crow(int reg, int hh) { return (reg & 3) + 8 * (reg >> 2) + 4 * hh; }
__device__ __forceinline__ bf16x8 pack_step(const f32x16& x, int s) {
    u32x4 q;
    q[0] = pk2(x[8 * s + 0], x[8 * s + 1]); q[1] = pk2(x[8 * s + 2], x[8 * s + 3]);
    q[2] = pk2(x[8 * s + 4], x[8 * s + 5]); q[3] = pk2(x[8 * s + 6], x[8 * s + 7]);
    return __builtin_bit_cast(bf16x8, q);
}
__device__ __forceinline__ bf16x8 frag_perm(const bf16_t* p0) {
    const uint2 lo = *(const uint2*)p0, hi = *(const uint2*)(p0 + 8);
    u32x4 q; q[0] = lo.x; q[1] = lo.y; q[2] = hi.x; q[3] = hi.y;
    return __builtin_bit_cast(bf16x8, q);
}

__device__ __forceinline__ void gdn_stageA(const Params& p, char* smem0, int bid, int nb) {
    const int tid = tid_opaque(), lane = tid & 63, wave = tid >> 6;
    for (int idx = bid * NTHR + tid; idx < (BATCH + DB) * 3 * 4096; idx += nb * NTHR) {
        const int c = idx & 4095, r = (idx >> 12) % 3, b = idx / (3 * 4096);
        if (b < BATCH) p.gc_prompt[idx] = bf2f(p.mixed[((size_t)b * LP + (LP - 3) + r) * 4096 + c]);
        else { const int bs = b - BATCH; p.gc_sample[(size_t)(bs * 3 + r) * 4096 + c] = bf2f(p.mixed[((size_t)NPR + bs * 4 + 1 + r) * 4096 + c]); }
    }
    for (int u = bid; u < NCU; u += nb) {
        unsigned zofs = 0; asm volatile("" : "+v"(zofs));
        char* smem = smem0 + zofs;
        bf16_t* Qb = (bf16_t*)smem;
        bf16_t* Kb = Qb + 64 * 136;
        float* RHS = (float*)(Kb + 64 * 136);
        float* Am = RHS + 64 * 256;
        float* sbeta = Am + 64 * 68;
        float* sgc = sbeta + 64;
        float* segc = sgc + 64;
        float* sekd = segc + 64;
        float* srk = sekd + 64;
        const int h = u & 15, n = (u >> 4) % NCH, b = u / (16 * NCH);
        const int kh = h >> 1;
        const size_t su = (size_t)((b * 16 + h) * NCH + n);
        const int t0 = n * 64;
        if (wave < 6) {
            const int part = wave >> 1, half = wave & 1;
            const int cq = lane & 31, tsub = lane >> 5;
            const int tl0 = 32 * half + 16 * tsub;
            const int chb = ((part == 0) ? (kh * 128) : (part == 1) ? (1024 + kh * 128) : (2048 + h * 128)) + cq * 4;
            f32x4 cw[4];
#pragma unroll
            for (int j = 0; j < 4; ++j) cw[j] = *(const f32x4*)(p.gdn_conv_w + j * 4096 + chb);
            uint2 xr[19];
#pragma unroll
            for (int i = 0; i < 19; ++i) {
                const int t = t0 + tl0 - 3 + i;
                if (t >= 0 && t < LP) xr[i] = *(const uint2*)(p.mixed + ((size_t)b * LP + t) * 4096 + chb);
                else xr[i] = make_uint2(0u, 0u);
            }
#pragma unroll
            for (int hb = 0; hb < 2; ++hb) {
                f32x4 yv[8];
                float ssv[8];
#pragma unroll
                for (int i8 = 0; i8 < 8; ++i8) {
                    const int i = hb * 8 + i8;
                    const f32x4 a = cvt_bf16x4(xr[i]) * cw[0] + cvt_bf16x4(xr[i + 1]) * cw[1] + cvt_bf16x4(xr[i + 2]) * cw[2] + cvt_bf16x4(xr[i + 3]) * cw[3];
                    const bool valid = (t0 + tl0 + i) < LP;
#pragma unroll
                    for (int e2 = 0; e2 < 4; ++e2) yv[i8][e2] = valid ? silu(a[e2]) : 0.f;
                    ssv[i8] = (yv[i8][0] * yv[i8][0] + yv[i8][1] * yv[i8][1]) + (yv[i8][2] * yv[i8][2] + yv[i8][3] * yv[i8][3]);
                }
                if (part < 2) {
#pragma unroll
                    for (int o = 1; o < 32; o <<= 1)
#pragma unroll
                        for (int i8 = 0; i8 < 8; ++i8) ssv[i8] += __shfl_xor(ssv[i8], o);
                }
#pragma unroll
                for (int i8 = 0; i8 < 8; ++i8) {
                    const int c = tl0 + hb * 8 + i8;
                    f32x4 y = yv[i8];
                    if (part < 2) {
                        const float nrm = rsqrtf(ssv[i8] + 1e-6f) * ((part == 0) ? 0.08838834764831845f : 1.f);
                        y = y * nrm;
                        if (part == 0) st_bf16x4(Qb + c * 136 + cq * 4, y);
                        else { st_bf16x4(Kb + c * 136 + cq * 4, y); *(f32x4*)(RHS + c * 256 + 128 + cq * 4) = y; }
                    } else {
                        *(f32x4*)(RHS + c * 256 + cq * 4) = y;
                    }
                }
            }
        } else if (wave == 6) {
            const int c = lane, t = t0 + c;
            float beta = 0.f, g = 0.f;
            if (t < LP) {
                const float* bap = p.ba + ((size_t)b * LP + t) * 32;
                beta = 1.f / (1.f + __expf(-bap[h]));
                const float aa = bap[16 + h] + p.gdn_dt_bias[h];
                const float sp = (aa > 20.f) ? aa : log1pf(__expf(aa));
                g = -__expf(p.gdn_a_log[h]) * sp;
            }
            float gc = g;
#pragma unroll
            for (int o = 1; o < 64; o <<= 1) { const float v = __shfl_up(gc, o); if (lane >= o) gc += v; }
            const float glast = __shfl(gc, 63);
            sbeta[c] = beta; sgc[c] = gc; segc[c] = __expf(gc); sekd[c] = __expf(glast - gc); srk[c] = beta * __expf(gc);
            if (lane == 0) p.g_dec[su] = __expf(glast);
        }
        __syncthreads();
        {
            const int which = wave >> 2, ti = (wave >> 1) & 1, tj = wave & 1;
            const int r = lane & 31, hh = lane >> 5;
            f32x16 acc;
#pragma unroll
            for (int i = 0; i < 16; ++i) acc[i] = 0.f;
            const bf16_t* Ap = Kb + (32 * ti + r) * 136 + 8 * hh;
            const bf16_t* Bp = (which ? Qb : Kb) + (32 * tj + r) * 136 + 8 * hh;
#pragma unroll
            for (int ks = 0; ks < 8; ++ks) acc = MFMA32(*(const bf16x8*)(Ap + 16 * ks), *(const bf16x8*)(Bp + 16 * ks), acc);
            const int c = 32 * tj + r;
            const float gcc = sgc[c], bc = sbeta[c];
            if (which == 0) {
#pragma unroll
                for (int reg = 0; reg < 16; ++reg) {
                    const int cp = 32 * ti + crow(reg, hh);
                    const float dcy = __expf(fminf(gcc - sgc[cp], 0.f));
                    Am[c * 68 + cp] = (cp < c) ? (bc * acc[reg] * dcy) : 0.f;
                }
            } else {
                bf16_t* aq = p.g_aqk + su * 4096 + (size_t)c * 64;
#pragma unroll
                for (int g4 = 0; g4 < 4; ++g4) {
                    const int cp0 = 32 * ti + 8 * g4 + 4 * hh;
                    f32x4 v;
#pragma unroll
                    for (int e2 = 0; e2 < 4; ++e2) {
                        const int cp = cp0 + e2;
                        const float dcy = __expf(fminf(gcc - sgc[cp], 0.f));
                        v[e2] = (cp <= c) ? (acc[4 * g4 + e2] * dcy) : 0.f;
                    }
                    st_bf16x4(aq + cp0, v);
                }
            }
        }
        __syncthreads();
        if (wave < 4) {
            const int col = 64 * wave + lane;
            const float* rs = sbeta + __builtin_amdgcn_readfirstlane((wave < 2) ? 0 : 256);
            float x[64];
#pragma unroll
            for (int i = 0; i < 64; ++i) x[i] = RHS[i * 256 + col] * rs[i];
#pragma unroll
            for (int i0 = 0; i0 < 64; i0 += 4) {
                float a0 = x[i0], a1 = x[i0 + 1], a2 = x[i0 + 2], a3 = x[i0 + 3];
#pragma unroll
                for (int j4 = 0; j4 < i0; j4 += 4) {
                    const f32x4 r0 = *(const f32x4*)(Am + (i0) * 68 + j4), r1 = *(const f32x4*)(Am + (i0 + 1) * 68 + j4);
                    const f32x4 r2 = *(const f32x4*)(Am + (i0 + 2) * 68 + j4), r3 = *(const f32x4*)(Am + (i0 + 3) * 68 + j4);
                    a0 -= r0[0] * x[j4]; a1 -= r1[0] * x[j4]; a2 -= r2[0] * x[j4]; a3 -= r3[0] * x[j4];
                    a0 -= r0[1] * x[j4 + 1]; a1 -= r1[1] * x[j4 + 1]; a2 -= r2[1] * x[j4 + 1]; a3 -= r3[1] * x[j4 + 1];
                    a0 -= r0[2] * x[j4 + 2]; a1 -= r1[2] * x[j4 + 2]; a2 -= r2[2] * x[j4 + 2]; a3 -= r3[2] * x[j4 + 2];
                    a0 -= r0[3] * x[j4 + 3]; a1 -= r1[3] * x[j4 + 3]; a2 -= r2[3] * x[j4 + 3]; a3 -= r3[3] * x[j4 + 3];
                    if ((j4 & 12) == 12) asm volatile("" ::: "memory");
                }
                const f32x4 t1 = *(const f32x4*)(Am + (i0 + 1) * 68 + i0), t2 = *(const f32x4*)(Am + (i0 + 2) * 68 + i0), t3 = *(const f32x4*)(Am + (i0 + 3) * 68 + i0);
                a1 -= t1[0] * a0;
                a2 -= t2[0] * a0; a2 -= t2[1] * a1;
                a3 -= t3[0] * a0; a3 -= t3[1] * a1; a3 -= t3[2] * a2;
                x[i0] = a0; x[i0 + 1] = a1; x[i0 + 2] = a2; x[i0 + 3] = a3;
                asm volatile("" ::: "memory");
            }
            if (wave < 2) {
                float* up = p.g_u + su * 8192 + col;
#pragma unroll
                for (int i = 0; i < 64; ++i) up[i * 128] = x[i];
            } else {
                bf16_t* wp = p.g_negw + su * 8192 + (col - 128);
#pragma unroll
                for (int i = 0; i < 64; ++i) wp[i * 128] = f2bf(-x[i]);
            }
        } else {
            const int t2 = tid - 256;
#pragma unroll
            for (int it = 0; it < 4; ++it) {
                const int chk = t2 + 256 * it, c = chk >> 4, d0 = (chk & 15) * 8;
                const float e = segc[c];
                const uint4 raw = *(const uint4*)(Qb + c * 136 + d0);
                uint4 o;
                o.x = pk2(__uint_as_float(raw.x << 16) * e, __uint_as_float(raw.x & 0xffff0000u) * e);
                o.y = pk2(__uint_as_float(raw.y << 16) * e, __uint_as_float(raw.y & 0xffff0000u) * e);
                o.z = pk2(__uint_as_float(raw.z << 16) * e, __uint_as_float(raw.z & 0xffff0000u) * e);
                o.w = pk2(__uint_as_float(raw.w << 16) * e, __uint_as_float(raw.w & 0xffff0000u) * e);
                *(uint4*)(p.g_qg + su * 8192 + c * 128 + d0) = o;
            }
#pragma unroll
            for (int it = 0; it < 4; ++it) {
                const int item = t2 + 256 * it, d = item & 127, c0 = (item >> 7) * 8;
                float v[8];
#pragma unroll
                for (int i = 0; i < 8; ++i) v[i] = bf2f(Kb[(c0 + i) * 136 + d]) * sekd[c0 + i];
                uint4 o; o.x = pk2(v[0], v[1]); o.y = pk2(v[2], v[3]); o.z = pk2(v[4], v[5]); o.w = pk2(v[6], v[7]);
                *(uint4*)(p.g_kdT + su * 8192 + d * 64 + c0) = o;
            }
        }
        __syncthreads();
    }
}

constexpr int GB_NW = 0, GB_QG = 64 * 136, GB_KD = 2 * 64 * 136, GB_AQ = 2 * 64 * 136 + 128 * 72, GB_ELEMS = 2 * 64 * 136 + 128 * 72 + 64 * 72;
__device__ __forceinline__ void gdn_chain(const Params& p, char* smem, int b, int h) {
    bf16_t* lds = (bf16_t*)smem;
    const int tid = tid_opaque(), lane = tid & 63, wave = tid >> 6;
    const int r = lane & 31, hh = lane >> 5;
    const size_t su0 = (size_t)(b * 16 + h) * NCH;
    const bool loader = wave >= 4;
    const int t2 = tid - 256;
    uint4 sa0, sa1, sa2, sa3, sa4, sa5, sa6, sa7, sa8, sa9, sa10, sa11, sa12, sa13;
    uint4 sb0, sb1, sb2, sb3, sb4, sb5, sb6, sb7, sb8, sb9, sb10, sb11, sb12, sb13;
    f32x16 S[4], un0, un1;
#pragma unroll
    for (int i = 0; i < 4; ++i)
#pragma unroll
        for (int j = 0; j < 16; ++j) S[i][j] = 0.f;
    const int ch0 = t2, ch1 = t2 + 256, ch2 = t2 + 512, ch3 = t2 + 768;
#define GB_GLOAD(P, n_) do { const size_t su_ = su0 + (n_); \
        const bf16_t* a_ = p.g_negw + su_ * 8192; const bf16_t* b_ = p.g_qg + su_ * 8192; const bf16_t* c_ = p.g_kdT + su_ * 8192; const bf16_t* d_ = p.g_aqk + su_ * 4096; \
        P##0 = *(const uint4*)(a_ + (size_t)ch0 * 8); P##1 = *(const uint4*)(a_ + (size_t)ch1 * 8); P##2 = *(const uint4*)(a_ + (size_t)ch2 * 8); P##3 = *(const uint4*)(a_ + (size_t)ch3 * 8); \
        P##4 = *(const uint4*)(b_ + (size_t)ch0 * 8); P##5 = *(const uint4*)(b_ + (size_t)ch1 * 8); P##6 = *(const uint4*)(b_ + (size_t)ch2 * 8); P##7 = *(const uint4*)(b_ + (size_t)ch3 * 8); \
        P##8 = *(const uint4*)(c_ + (size_t)ch0 * 8); P##9 = *(const uint4*)(c_ + (size_t)ch1 * 8); P##10 = *(const uint4*)(c_ + (size_t)ch2 * 8); P##11 = *(const uint4*)(c_ + (size_t)ch3 * 8); \
        P##12 = *(const uint4*)(d_ + (size_t)ch0 * 8); P##13 = *(const uint4*)(d_ + (size_t)ch1 * 8); } while (0)
#define GB_SSTORE(P, buf_) do { bf16_t* q_ = (buf_); \
        *(uint4*)(q_ + GB_NW + (ch0 >> 4) * 136 + (ch0 & 15) * 8) = P##0; *(uint4*)(q_ + GB_NW + (ch1 >> 4) * 136 + (ch1 & 15) * 8) = P##1; \
        *(uint4*)(q_ + GB_NW + (ch2 >> 4) * 136 + (ch2 & 15) * 8) = P##2; *(uint4*)(q_ + GB_NW + (ch3 >> 4) * 136 + (ch3 & 15) * 8) = P##3; \
        *(uint4*)(q_ + GB_QG + (ch0 >> 4) * 136 + (ch0 & 15) * 8) = P##4; *(uint4*)(q_ + GB_QG + (ch1 >> 4) * 136 + (ch1 & 15) * 8) = P##5; \
        *(uint4*)(q_ + GB_QG + (ch2 >> 4) * 136 + (ch2 & 15) * 8) = P##6; *(uint4*)(q_ + GB_QG + (ch3 >> 4) * 136 + (ch3 & 15) * 8) = P##7; \
        *(uint4*)(q_ + GB_KD + (ch0 >> 3) * 72 + (ch0 & 7) * 8) = P##8; *(uint4*)(q_ + GB_KD + (ch1 >> 3) * 72 + (ch1 & 7) * 8) = P##9; \
        *(uint4*)(q_ + GB_KD + (ch2 >> 3) * 72 + (ch2 & 7) * 8) = P##10; *(uint4*)(q_ + GB_KD + (ch3 >> 3) * 72 + (ch3 & 7) * 8) = P##11; \
        *(uint4*)(q_ + GB_AQ + (ch0 >> 3) * 72 + (ch0 & 7) * 8) = P##12; *(uint4*)(q_ + GB_AQ + (ch1 >> 3) * 72 + (ch1 & 7) * 8) = P##13; } while (0)
#define GB_ULOAD(n_) do { const float* up_ = p.g_u + (su0 + (n_)) * 8192 + 32 * wave + r; \
        _Pragma("unroll") for (int reg_ = 0; reg_ < 16; ++reg_) { un0[reg_] = up_[(crow(reg_, hh)) * 128]; un1[reg_] = up_[(32 + crow(reg_, hh)) * 128]; } } while (0)
    if (loader) {
        bf16_t* buf0 = lds;
        bf16_t* buf1 = lds + GB_ELEMS;
        GB_GLOAD(sa, 0); GB_SSTORE(sa, buf0);
        GB_GLOAD(sa, 1);
        __syncthreads();
        for (int n = 0; n < NCH; n += 2) {
            if (n + 2 < NCH) { GB_GLOAD(sb, n + 2); }
            if (n + 1 < NCH) { GB_SSTORE(sa, buf1); }
            __syncthreads();
            if (n + 1 >= NCH) break;
            if (n + 3 < NCH) { GB_GLOAD(sa, n + 3); }
            if (n + 2 < NCH) { GB_SSTORE(sb, buf0); }
            __syncthreads();
        }
    } else {
        GB_ULOAD(0);
        float dec_next = p.g_dec[su0];
        __syncthreads();
        for (int n = 0; n < NCH; ++n) {
            unsigned zofs = 0; asm volatile("" : "+v"(zofs));
            bf16_t* cur = lds + (n & 1) * GB_ELEMS + zofs;
            const bool more = (n + 1 < NCH);
            const float dec = dec_next;
            if (more) dec_next = p.g_dec[su0 + n + 1];
            f32x16 vn[2], o[2];
            vn[0] = un0; vn[1] = un1;
#pragma unroll
            for (int j = 0; j < 16; ++j) { o[0][j] = 0.f; o[1][j] = 0.f; }
            if (more) { GB_ULOAD(n + 1); }
#pragma unroll
            for (int kt = 0; kt < 4; ++kt)
#pragma unroll
                for (int s = 0; s < 2; ++s) {
                    const bf16x8 sb = pack_step(S[kt], s);
                    const int k0 = 32 * kt + 16 * s + 4 * hh;
#pragma unroll
                    for (int ct = 0; ct < 2; ++ct) {
                        vn[ct] = MFMA32(frag_perm(cur + GB_NW + (32 * ct + r) * 136 + k0), sb, vn[ct]);
                        o[ct] = MFMA32(frag_perm(cur + GB_QG + (32 * ct + r) * 136 + k0), sb, o[ct]);
                    }
                }
            bf16x8 vb[2][2];
#pragma unroll
            for (int ct = 0; ct < 2; ++ct)
#pragma unroll
                for (int s = 0; s < 2; ++s) vb[ct][s] = pack_step(vn[ct], s);
#pragma unroll
            for (int s = 0; s < 2; ++s) {
                o[0] = MFMA32(frag_perm(cur + GB_AQ + (r) * 72 + 16 * s + 4 * hh), vb[0][s], o[0]);
                o[1] = MFMA32(frag_perm(cur + GB_AQ + (32 + r) * 72 + 16 * s + 4 * hh), vb[0][s], o[1]);
                o[1] = MFMA32(frag_perm(cur + GB_AQ + (32 + r) * 72 + 32 + 16 * s + 4 * hh), vb[1][s], o[1]);
            }
#pragma unroll
            for (int dt = 0; dt < 4; ++dt) {
                S[dt] = S[dt] * dec;
#pragma unroll
                for (int ckt = 0; ckt < 2; ++ckt)
#pragma unroll
                    for (int s = 0; s < 2; ++s)
                        S[dt] = MFMA32(frag_perm(cur + GB_KD + (32 * dt + r) * 72 + 32 * ckt + 16 * s + 4 * hh), vb[ckt][s], S[dt]);
            }
#pragma unroll
            for (int ct = 0; ct < 2; ++ct)
#pragma unroll
                for (int reg = 0; reg < 16; ++reg) {
                    const int t = 64 * n + 32 * ct + crow(reg, hh);
                    if (t < LP) p.g_o[(((size_t)b * LP + t) * 16 + h) * 128 + 32 * wave + r] = f2bf(o[ct][reg]);
                }
            __syncthreads();
        }
    }
    if (!loader) {
#pragma unroll
        for (int dt = 0; dt < 4; ++dt)
#pragma unroll
            for (int reg = 0; reg < 16; ++reg)
                p.gs_prompt[((size_t)(b * 16 + h) * 128 + 32 * dt + crow(reg, hh)) * 128 + 32 * wave + r] = S[dt][reg];
    }
    __syncthreads();
}

__device__ __forceinline__ void gdn_seq_phase(const Params& p, char* smem, int bid, int nb, int rep = 0) {
    if (bid < 64) gdn_chain(p, smem, bid >> 4, bid & 15);
    int* slot = (int*)(smem + LDS_BYTES - 32);
    const int tid = tid_opaque();
    for (;;) {
        if (threadIdx.x == 0) *slot = (int)atomicAdd(p.bar + 3520 + 16 * rep, 1u);
        __syncthreads();
        const int u = *slot;
        __syncthreads();
        if (u >= DB * 16 / 2) break;
        gdn_sample_pass(p, smem, u, tid_opaque());
    }
}

__device__ __forceinline__ void gdn_gate_phase(const Params& p, int bid, int nb) {
    const int tid_ = tid_opaque(); const int lane = tid_ & 63, wave = tid_ >> 6;
    const int sub = lane >> 4, l16 = lane & 15;
    f32x4 nw0 = *(const f32x4*)(p.gdn_norm_w + l16 * 8), nw1 = *(const f32x4*)(p.gdn_norm_w + l16 * 8 + 4);
    for (int it4 = bid * 8 + wave; it4 < NPR * 4; it4 += nb * 8) {
        const size_t off = ((size_t)it4 * 4 + sub) * 128 + l16 * 8;
        const uint4 ov = *(const uint4*)(p.g_o + off);
        const uint4 zv = *(const uint4*)(p.z + off);
        const f32x4 o0 = cvt_bf16x4(make_uint2(ov.x, ov.y)), o1 = cvt_bf16x4(make_uint2(ov.z, ov.w));
        const f32x4 z0 = cvt_bf16x4(make_uint2(zv.x, zv.y)), z1 = cvt_bf16x4(make_uint2(zv.z, zv.w));
        float ss = ((o0[0] * o0[0] + o0[1] * o0[1]) + (o0[2] * o0[2] + o0[3] * o0[3])) + ((o1[0] * o1[0] + o1[1] * o1[1]) + (o1[2] * o1[2] + o1[3] * o1[3]));
#pragma unroll
        for (int x = 1; x < 16; x <<= 1) ss += __shfl_xor(ss, x);
        const float rms = rsqrtf(ss * (1.f / 128.f) + 1e-6f);
        uint4 g;
        g.x = pk2(o0[0] * rms * nw0[0] * silu(z0[0]), o0[1] * rms * nw0[1] * silu(z0[1]));
        g.y = pk2(o0[2] * rms * nw0[2] * silu(z0[2]), o0[3] * rms * nw0[3] * silu(z0[3]));
        g.z = pk2(o1[0] * rms * nw1[0] * silu(z1[0]), o1[1] * rms * nw1[1] * silu(z1[1]));
        g.w = pk2(o1[2] * rms * nw1[2] * silu(z1[2]), o1[3] * rms * nw1[3] * silu(z1[3]));
        *(uint4*)(p.gated + off) = g;
    }
}

__device__ __forceinline__ void rope4(const float* tab, int fi, f32x4 x, f32x4 partner, bool first, f32x4& o) {
    const f32x4 t0 = *(const f32x4*)(tab + fi * 2), t1 = *(const f32x4*)(tab + fi * 2 + 4);
    const float sg = first ? -1.f : 1.f;
    o[0] = x[0] * t0[0] + sg * partner[0] * t0[1];
    o[1] = x[1] * t0[2] + sg * partner[1] * t0[3];
    o[2] = x[2] * t1[0] + sg * partner[2] * t1[1];
    o[3] = x[3] * t1[2] + sg * partner[3] * t1[3];
}
__device__ __forceinline__ void dsa_post_phase(const Params& p, char* smem, int bid, int nb) {
    bf16_t* vt = (bf16_t*)smem;
    for (int u = bid; u < BATCH * 65 + 8; u += nb) {
        const int tid = tid_opaque(); const int lane = tid & 63, wave = tid >> 6;
        const bool prompt = u < BATCH * 65;
        const int b = prompt ? (u / 65) : 0, t0 = prompt ? (u % 65) * 64 : 0;
        for (int r8 = 0; r8 < 8; ++r8) {
            const int tl = wave * 8 + r8;
            const int t = t0 + tl;
            const bool rvalid = prompt ? (t < LP) : true;
            const int row = prompt ? (b * LP + t) : (NPR + (u - BATCH * 65) * 64 + tl);
            if (!rvalid) {
                for (int e = lane; e < 256; e += 64) vt[e * 72 + tl] = 0;
                continue;
            }
            const float* P = p.p1 + (size_t)row * DIN_PAD;
            const int pos = prompt ? t : (PAST + ((row - NPR) & 3));
            const float* tab = p.rope_tab + (size_t)pos * 48;
            float* kout = prompt ? (p.k_prompt + (size_t)row * 256) : (p.k_sample + (size_t)(row - NPR) * 256);
            float* vout = prompt ? (p.v_prompt + (size_t)row * 256) : (p.v_sample + (size_t)(row - NPR) * 256);
#pragma unroll
            for (int j = 0; j < 5; ++j) {
                const int e0 = (lane + 64 * j) * 4, d0 = e0 & 127;
                f32x4 x = *(const f32x4*)(P + e0);
                if (d0 < 32) {
                    const bool first = d0 < 16;
                    const f32x4 pr = *(const f32x4*)(P + (first ? e0 + 16 : e0 - 16));
                    rope4(tab, d0 & 15, x, pr, first, x);
                }
                if (j < 4) {
                    if (prompt) st_bf16x4(p.q_b + (size_t)row * 1024 + e0, x * 0.12751743f);
                    else *(f32x4*)(p.qr + (size_t)row * 1024 + e0) = x;
                } else {
                    const int ek = e0 - 1024;
                    *(f32x4*)(kout + ek) = x;
                    if (prompt) st_bf16x4(p.k_b + ((size_t)(b * 2 + (ek >> 7)) * LPAD + t) * 128 + d0, x);
                }
            }
            {
                const int e0 = lane * 4;
                const f32x4 x = *(const f32x4*)(P + 1280 + e0);
                *(f32x4*)(vout + e0) = x;
                if (prompt) {
#pragma unroll
                    for (int i = 0; i < 4; ++i) vt[(e0 + i) * 72 + tl] = f2bf(x[i]);
                }
            }
#pragma unroll
            for (int j = 0; j < 2; ++j) {
                const int e0 = (lane + 64 * j) * 4, d0 = e0 & 63;
                f32x4 x = *(const f32x4*)(P + 1536 + e0);
                if (d0 < 16) {
                    const bool first = d0 < 8;
                    const f32x4 pr = *(const f32x4*)(P + 1536 + (first ? e0 + 8 : e0 - 8));
                    rope4(tab, 16 + (d0 & 7), x, pr, first, x);
                }
                if (prompt) st_bf16x4(p.iq_b + (size_t)row * 512 + e0, x);
                else *(f32x4*)(p.iq + (size_t)row * 512 + e0) = x;
            }
            {
                const float x = P[2048 + lane];
                const float mu = wave_sum(x) * (1.f / 64.f);
                const float dv = x - mu;
                const float var = wave_sum(dv * dv) * (1.f / 64.f);
                const float xn = dv * rsqrtf(var + 1e-5f) * p.dsa_ik_g[lane] + p.dsa_ik_b[lane];
                const float other = __shfl_xor(xn, 8);
                float o = xn;
                if (lane < 16) {
                    const float c = tab[(16 + (lane & 7)) * 2], s = tab[(16 + (lane & 7)) * 2 + 1];
                    if (lane < 8) o = xn * c - other * s; else o = xn * c + other * s;
                }
                float* io = prompt ? (p.ik_prompt + (size_t)row * 64) : (p.ik_sample + (size_t)(row - NPR) * 64);
                io[lane] = o;
                if (prompt) p.ik_b[((size_t)b * LPAD + t) * 64 + lane] = f2bf(o);
            }
            if (lane < 8) p.iw[(size_t)row * 8 + lane] = P[2112 + lane] * 0.35355339059327373f;
        }
        __syncthreads();
        if (prompt) {
#pragma unroll
            for (int i = 0; i < 4; ++i) {
                const int ch = tid + 512 * i, rr = ch >> 3, c8 = (ch & 7) * 8;
                const uint4 v = *(const uint4*)(vt + rr * 72 + c8);
                *(uint4*)(p.vt_b + ((size_t)(b * 2 + (rr >> 7)) * 128 + (rr & 127)) * LPAD + t0 + c8) = v;
            }
        }
        __syncthreads();
    }
    for (int idx = bid * NTHR + tid_opaque(); idx < BATCH * (LPAD - LP) * 256; idx += nb * NTHR) {
        const int c = idx & 255, tp = (idx >> 8) % (LPAD - LP), bb = idx / ((LPAD - LP) * 256);
        const int t = LP + tp, kvh = c >> 7, d = c & 127;
        p.k_b[((size_t)(bb * 2 + kvh) * LPAD + t) * 128 + d] = 0;
        if (c < 64) p.ik_b[((size_t)bb * LPAD + t) * 64 + c] = 0;
        if (c < 65) p.maskT[((size_t)bb * 65 + c) * LPAD + t] = (c == 0) ? 1ull : 0ull;
    }
}

__device__ __forceinline__ const float* ik_row(const Params& p, bool prompt, int b, int s) {
    if (prompt) return p.ik_prompt + ((size_t)b * LP + s) * 64;
    if (s < PAST) { const int pg = p.page_table[b * 16 + (s >> 7)]; return p.cache_ik + ((size_t)pg * 128 + (s & 127)) * 64; }
    return p.ik_sample + ((size_t)b * DS + (s - PAST)) * 64;
}
__device__ __forceinline__ const float* kv_row(const float* own_p, const float* own_s, const float* cache, const int* page_table,
                                               bool prompt, int b, int s) {
    if (prompt) return own_p + ((size_t)b * LP + s) * 256;
    if (s < PAST) { const int pg = page_table[b * 16 + (s >> 7)]; return cache + ((size_t)pg * 128 + (s & 127)) * 256; }
    return own_s + ((size_t)b * DS + (s - PAST)) * 256;
}

template <bool PROMPT, int NREG>
__device__ __forceinline__ void select_emit(const float* sc, int qpos, int lane, unsigned long long* maskcol, int* selrow) {
    const unsigned long long ltmask = (1ull << lane) - 1ull;
    unsigned key[NREG];
    unsigned kmax = 0u, kmin = 0xffffffffu;
#pragma unroll
    for (int j = 0; j < NREG; ++j) {
        const int s = j * 64 + lane;
        const bool cand = (s >= 16 && s <= qpos);
        const float x = cand ? sc[s] : -INFINITY;
        const unsigned u = __float_as_uint(x);
        key[j] = (u & 0x80000000u) ? ~u : (u | 0x80000000u);
        kmax = max(kmax, key[j]);
        kmin = min(kmin, cand ? key[j] : 0xffffffffu);
    }
#pragma unroll
    for (int o = 1; o < 64; o <<= 1) { kmax = max(kmax, (unsigned)__shfl_xor((int)kmax, o)); kmin = min(kmin, (unsigned)__shfl_xor((int)kmin, o)); }
    unsigned lo = kmin, hi = kmax;
    bool exact = false;
    while (lo < hi) {
        const unsigned mid = lo + ((hi - lo) >> 1) + ((hi - lo) & 1u);
        int c = 0;
#pragma unroll
        for (int j = 0; j < NREG; ++j) c += __popcll(__ballot(key[j] >= mid));
        if (c >= 240) { lo = mid; if (c == 240) { exact = true; break; } } else hi = mid - 1u;
    }
    const unsigned T = lo;
    if (!PROMPT) { if (lane < 16) selrow[lane] = lane; }
    int base = 16;
    unsigned long long myword = 0ull, word64 = 0ull;
    if (exact) {
#pragma unroll
        for (int j = 0; j < NREG; ++j) {
            const bool take = key[j] >= T;
            unsigned long long m = __ballot(take);
            if (PROMPT) {
                if (j == 0) m |= 0xFFFFull;
                if (j < 64) { if (lane == j) myword = m; } else word64 = m;
            } else {
                if (take) selrow[base + __popcll(m & ltmask)] = j * 64 + lane;
                base += __popcll(m);
            }
        }
    } else {
        int cgt = 0;
#pragma unroll
        for (int j = 0; j < NREG; ++j) cgt += __popcll(__ballot(key[j] > T));
        const int need_eq = 240 - cgt;
        int erun = 0;
#pragma unroll
        for (int j = 0; j < NREG; ++j) {
            const bool gt = key[j] > T, eq = key[j] == T;
            const unsigned long long meq = __ballot(eq);
            const int rank = erun + __popcll(meq & ltmask);
            const bool take = gt || (eq && rank < need_eq);
            unsigned long long m = __ballot(take);
            if (PROMPT) {
                if (j == 0) m |= 0xFFFFull;
                if (j < 64) { if (lane == j) myword = m; } else word64 = m;
            } else {
                if (take) selrow[base + __popcll(m & ltmask)] = j * 64 + lane;
                base += __popcll(m);
            }
            erun += __popcll(meq);
        }
    }
    if (PROMPT) {
        if (NREG == 65) { maskcol[(size_t)lane * LPAD] = myword; if (lane == 0) maskcol[(size_t)64 * LPAD] = word64; }
        else { if (lane < NREG) maskcol[(size_t)lane * LPAD] = myword; else if (lane < 64) maskcol[(size_t)lane * LPAD] = 0ull; if (lane == 0) maskcol[(size_t)64 * LPAD] = 0ull; }
    }
}

__device__ __forceinline__ bf16x8 ld_f32x8_bf16(const float* p) {
    const f32x4 a = *(const f32x4*)p, b = *(const f32x4*)(p + 4);
    u32x4 q; q[0] = pk2(a[0], a[1]); q[1] = pk2(a[2], a[3]); q[2] = pk2(b[0], b[1]); q[3] = pk2(b[2], b[3]);
    return __builtin_bit_cast(bf16x8, q);
}
__device__ __forceinline__ void indexer_sample_unit(const Params& p, float* sc, int b, int tid) {
    const int lane = tid & 63, wave = tid >> 6;
    const int r = lane & 31, hh = lane >> 5;
    bf16x8 af[4];
    {
        const int e2 = r & 3, hb = (r >> 2) & 1, a = r >> 3;
        const int qi = 2 * hb + (a >> 1), head = 4 * (a & 1) + e2;
        const float* ap = p.iq + ((size_t)NPR + b * 4 + qi) * 512 + head * 64 + 8 * hh;
#pragma unroll
        for (int ks = 0; ks < 4; ++ks) af[ks] = ld_f32x8_bf16(ap + 16 * ks);
    }
    float wq[2][8];
#pragma unroll
    for (int ql = 0; ql < 2; ++ql) {
        const float* wp = p.iw + ((size_t)NPR + b * 4 + 2 * hh + ql) * 8;
        const f32x4 w0 = *(const f32x4*)wp, w1 = *(const f32x4*)(wp + 4);
#pragma unroll
        for (int e2 = 0; e2 < 4; ++e2) { wq[ql][e2] = w0[e2]; wq[ql][4 + e2] = w1[e2]; }
    }
    for (int kt = wave; kt < 65; kt += 8) {
        const int s = 32 * kt + r;
        const float* kp;
        if (s < PAST) { const int pg = p.page_table[b * 16 + (s >> 7)]; kp = p.cache_ik + ((size_t)pg * 128 + (s & 127)) * 64; }
        else kp = p.ik_sample + ((size_t)b * DS + ((s - PAST) & 3)) * 64;
        kp += 8 * hh;
        f32x16 acc;
#pragma unroll
        for (int i = 0; i < 16; ++i) acc[i] = 0.f;
        bf16x8 bq[4];
#pragma unroll
        for (int ks = 0; ks < 4; ++ks) bq[ks] = ld_f32x8_bf16(kp + 16 * ks);
#pragma unroll
        for (int ks = 0; ks < 4; ++ks) acc = MFMA32(af[ks], bq[ks], acc);
#pragma unroll
        for (int ql = 0; ql < 2; ++ql) {
            float v = 0.f;
#pragma unroll
            for (int a2 = 0; a2 < 2; ++a2)
#pragma unroll
                for (int e2 = 0; e2 < 4; ++e2) v += wq[ql][4 * a2 + e2] * fmaxf(acc[4 * (2 * ql + a2) + e2], 0.f);
            sc[(2 * hh + ql) * 2112 + s] = v;
        }
    }
    __syncthreads();
    if (wave < 4) select_emit<false, 33>(sc + wave * 2112, PAST + wave, lane, nullptr, p.sel + ((size_t)NPR + b * 4 + wave) * 256);
    __syncthreads();
}

__device__ __forceinline__ void indexer_prompt_unit(const Params& p, float* sc, int b, int g8, int tid) {
    const int lane = tid & 63, wave = tid >> 6;
    const int r = lane & 31, hh = lane >> 5;
    const int t0 = g8 * 8;
    if (t0 < 256) {
        const int qpos = t0 + wave;
        unsigned long long* maskcol = p.maskT + (size_t)b * 65 * LPAD + qpos;
        for (int j = lane; j < 65; j += 64) {
            const int lo = j * 64;
            unsigned long long m = 0ull;
            if (qpos >= lo + 63) m = ~0ull; else if (qpos >= lo) m = (1ull << (qpos - lo + 1)) - 1ull;
            maskcol[(size_t)j * LPAD] = m;
        }
        return;
    }
    bf16x8 af[2][4];
    {
        const int e2 = r & 3, hb = (r >> 2) & 1, a = r >> 3;
        const int qi = 2 * hb + (a >> 1), head = 4 * (a & 1) + e2;
#pragma unroll
        for (int rt = 0; rt < 2; ++rt) {
            const bf16_t* ap = p.iq_b + ((size_t)b * LP + t0 + 4 * rt + qi) * 512 + head * 64 + 8 * hh;
#pragma unroll
            for (int ks = 0; ks < 4; ++ks) af[rt][ks] = *(const bf16x8*)(ap + 16 * ks);
        }
    }
    float wq[2][2][8];
#pragma unroll
    for (int rt = 0; rt < 2; ++rt)
#pragma unroll
        for (int ql = 0; ql < 2; ++ql) {
            const float* wp = p.iw + ((size_t)b * LP + t0 + 4 * rt + 2 * hh + ql) * 8;
            const f32x4 w0 = *(const f32x4*)wp, w1 = *(const f32x4*)(wp + 4);
#pragma unroll
            for (int e2 = 0; e2 < 4; ++e2) { wq[rt][ql][e2] = w0[e2]; wq[rt][ql][4 + e2] = w1[e2]; }
        }
    const int nkt = (t0 + 7) / 32 + 1;
    const bf16_t* kbase = p.ik_b + ((size_t)b * LPAD + r) * 64 + 8 * hh;
    bf16x8 bq[4];
    if (wave < nkt) {
#pragma unroll
        for (int ks = 0; ks < 4; ++ks) bq[ks] = *(const bf16x8*)(kbase + (size_t)wave * 32 * 64 + 16 * ks);
    }
    for (int kt = wave; kt < nkt; kt += 8) {
        bf16x8 bn[4];
        const int ktn = (kt + 8 < nkt) ? (kt + 8) : kt;
#pragma unroll
        for (int ks = 0; ks < 4; ++ks) bn[ks] = *(const bf16x8*)(kbase + (size_t)ktn * 32 * 64 + 16 * ks);
#pragma unroll
        for (int rt = 0; rt < 2; ++rt) {
            f32x16 acc;
#pragma unroll
            for (int i = 0; i < 16; ++i) acc[i] = 0.f;
#pragma unroll
            for (int ks = 0; ks < 4; ++ks) acc = MFMA32(af[rt][ks], bq[ks], acc);
#pragma unroll
            for (int ql = 0; ql < 2; ++ql) {
                float s = 0.f;
#pragma unroll
                for (int a2 = 0; a2 < 2; ++a2)
#pragma unroll
                    for (int e2 = 0; e2 < 4; ++e2) s += wq[rt][ql][4 * a2 + e2] * fmaxf(acc[4 * (2 * ql + a2) + e2], 0.f);
                sc[(4 * rt + 2 * hh + ql) * 4160 + 32 * kt + r] = s;
            }
        }
#pragma unroll
        for (int ks = 0; ks < 4; ++ks) bq[ks] = bn[ks];
    }
    __syncthreads();
    {
        const int qpos = t0 + wave;
        if (t0 + 7 < 33 * 64) select_emit<true, 33>(sc + wave * 4160, qpos, lane, p.maskT + (size_t)b * 65 * LPAD + qpos, nullptr);
        else select_emit<true, 65>(sc + wave * 4160, qpos, lane, p.maskT + (size_t)b * 65 * LPAD + qpos, nullptr);
    }
    __syncthreads();
}

__device__ __forceinline__ void indexer_phase(const Params& p, char* smem, int bid, int nb, int rep = 0) {
    int* slot = (int*)(smem + LDS_BYTES - 32);
    for (;;) {
        const int tid = tid_opaque();
        unsigned zofs = 0; asm volatile("" : "+v"(zofs));
        float* sc = (float*)(smem + zofs);
        if (threadIdx.x == 0) *slot = (int)atomicAdd(p.bar + 3648 + 16 * rep, 1u);
        __syncthreads();
        const int u = *slot;
        __syncthreads();
        if (u >= DB + BATCH * 514) break;
        if (u < DB) {
            indexer_sample_unit(p, sc, u, tid);
        } else {
            const int v = u - DB;
            indexer_prompt_unit(p, sc, v & 3, 513 - (v >> 2), tid);
        }
    }
}

__device__ __forceinline__ void attn_sample_query(const Params& p, char* smem, int row) {
    float* qs = (float*)smem;
    float* ps = qs + 1024;
    const float** kptr = (const float**)(ps + 2048);
    const float** vptr = kptr + 256;
    float* red = (float*)(vptr + 256);
    const int tid = tid_opaque(), lane = tid & 63, wave = tid >> 6;
    const int b = (row - NPR) >> 2;
    qs[tid] = p.qr[(size_t)row * 1024 + tid];
    qs[tid + 512] = p.qr[(size_t)row * 1024 + 512 + tid];
    if (tid < 256) {
        const int s = p.sel[(size_t)row * 256 + tid];
        const float *kp, *vp;
        if (s < PAST) { const int pg = p.page_table[b * 16 + ((s < 0 ? 0 : s) >> 7)]; const size_t ro = ((size_t)pg * 128 + ((s < 0 ? 0 : s) & 127)) * 256; kp = p.cache_k + ro; vp = p.cache_v + ro; }
        else { const size_t ro = ((size_t)b * DS + (s - PAST)) * 256; kp = p.k_sample + ro; vp = p.v_sample + ro; }
        kptr[tid] = (s < 0) ? nullptr : kp;
        vptr[tid] = vp;
    }
    __syncthreads();
    {
        const int j = tid & 255, kvh = tid >> 8;
        const float* kp0 = kptr[j];
        const bool valid = kp0 != nullptr;
        const float* kp = (valid ? kp0 : vptr[j]) + kvh * 128;
        float d0 = 0.f, d1 = 0.f, d2 = 0.f, d3 = 0.f;
        const float* q0 = qs + (kvh * 4) * 128;
#pragma unroll 16
        for (int c = 0; c < 32; ++c) {
            const f32x4 kv = *(const f32x4*)(kp + c * 4);
            const f32x4 a0 = *(const f32x4*)(q0 + c * 4), a1 = *(const f32x4*)(q0 + 128 + c * 4), a2 = *(const f32x4*)(q0 + 256 + c * 4),
                        a3 = *(const f32x4*)(q0 + 384 + c * 4);
            d0 += kv[0] * a0[0] + kv[1] * a0[1] + kv[2] * a0[2] + kv[3] * a0[3];
            d1 += kv[0] * a1[0] + kv[1] * a1[1] + kv[2] * a1[2] + kv[3] * a1[3];
            d2 += kv[0] * a2[0] + kv[1] * a2[1] + kv[2] * a2[2] + kv[3] * a2[3];
            d3 += kv[0] * a3[0] + kv[1] * a3[1] + kv[2] * a3[2] + kv[3] * a3[3];
        }
        const float scl = 0.08838834764831845f;
        ps[(kvh * 4 + 0) * 256 + j] = valid ? d0 * scl : -INFINITY;
        ps[(kvh * 4 + 1) * 256 + j] = valid ? d1 * scl : -INFINITY;
        ps[(kvh * 4 + 2) * 256 + j] = valid ? d2 * scl : -INFINITY;
        ps[(kvh * 4 + 3) * 256 + j] = valid ? d3 * scl : -INFINITY;
    }
    __syncthreads();
    {
        float v[4]; float m = -INFINITY;
#pragma unroll
        for (int i = 0; i < 4; ++i) { v[i] = ps[wave * 256 + lane + 64 * i]; m = fmaxf(m, v[i]); }
        m = wave_max(m);
        float sum = 0.f;
#pragma unroll
        for (int i = 0; i < 4; ++i) { v[i] = __expf(v[i] - m); sum += v[i]; }
        sum = wave_sum(sum);
        const float inv = 1.f / sum;
#pragma unroll
        for (int i = 0; i < 4; ++i) ps[wave * 256 + lane + 64 * i] = v[i] * inv;
    }
    __syncthreads();
    {
        const int kvh = tid >> 8, kg = (tid >> 5) & 7, d4 = tid & 31;
        f32x4 acc[4];
#pragma unroll
        for (int g = 0; g < 4; ++g) acc[g] = (f32x4){0.f, 0.f, 0.f, 0.f};
#pragma unroll 16
        for (int i = 0; i < 32; ++i) {
            const int j = kg * 32 + i;
            const f32x4 vv = *(const f32x4*)(vptr[j] + kvh * 128 + d4 * 4);
#pragma unroll
            for (int g = 0; g < 4; ++g) acc[g] += vv * ps[(kvh * 4 + g) * 256 + j];
        }
#pragma unroll
        for (int g = 0; g < 4; ++g) *(f32x4*)(red + ((kg * 2 + kvh) * 4 + g) * 128 + d4 * 4) = acc[g];
    }
    __syncthreads();
    {
        const int h = wave, d = lane * 2;
        float o0 = 0.f, o1 = 0.f;
#pragma unroll
        for (int kg = 0; kg < 8; ++kg) { const f32x2 t = *(const f32x2*)(red + ((kg * 2 + (h >> 2)) * 4 + (h & 3)) * 128 + d); o0 += t[0]; o1 += t[1]; }
        *(unsigned*)(p.gated + (size_t)row * 1024 + h * 128 + d) = pk2(o0, o1);
    }
    __syncthreads();
}

constexpr int AT_K = 0, AT_V = 64 * 136, AT_ELEMS = 64 * 136 + 128 * 72;
__device__ __forceinline__ void attn_dense_unit(const Params& p, char* smem, int b, int kvh, int qb) {
    bf16_t* lds = (bf16_t*)smem;
    const int tid = tid_opaque(), lane = tid & 63, wave = tid >> 6;
    const int r = lane & 31, hh = lane >> 5;
    const int g = wave & 3, qs = wave >> 2;
    const int head = kvh * 4 + g;
    const int tq = 64 * qb + 32 * qs + r;
    const int tqc = (tq < LP) ? tq : (LP - 1);
    bf16x8 qf[8];
    {
        const bf16_t* qp = p.q_b + ((size_t)b * LP + tqc) * 1024 + head * 128 + 8 * hh;
#pragma unroll
        for (int ks = 0; ks < 8; ++ks) qf[ks] = *(const bf16x8*)(qp + 16 * ks);
    }
    f32x16 O[4];
#pragma unroll
    for (int i = 0; i < 4; ++i)
#pragma unroll
        for (int j = 0; j < 16; ++j) O[i][j] = 0.f;
    float mrun = -3.0e38f, lrun = 0.f;
    const bf16_t* Kg = p.k_b + ((size_t)(b * 2 + kvh) * LPAD) * 128;
    const bf16_t* Vg = p.vt_b + ((size_t)(b * 2 + kvh) * 128) * LPAD;
    const unsigned long long* mcol = p.maskT + (size_t)b * 65 * LPAD + tq;
    const int kc0 = tid, kc1 = tid + 512;
    uint4 sk0, sk1, sv0, sv1;
#define AT_GLOAD(kt_) do { const bf16_t* kg_ = Kg + (size_t)(kt_) * 64 * 128; const bf16_t* vg_ = Vg + (size_t)(kt_) * 64; \
        sk0 = *(const uint4*)(kg_ + (size_t)kc0 * 8); sk1 = *(const uint4*)(kg_ + (size_t)kc1 * 8); \
        sv0 = *(const uint4*)(vg_ + (size_t)(kc0 >> 3) * LPAD + (kc0 & 7) * 8); sv1 = *(const uint4*)(vg_ + (size_t)(kc1 >> 3) * LPAD + (kc1 & 7) * 8); } while (0)
#define AT_SSTORE(buf_) do { bf16_t* q_ = (buf_); \
        *(uint4*)(q_ + AT_K + (kc0 >> 4) * 136 + (kc0 & 15) * 8) = sk0; *(uint4*)(q_ + AT_K + (kc1 >> 4) * 136 + (kc1 & 15) * 8) = sk1; \
        *(uint4*)(q_ + AT_V + (kc0 >> 3) * 72 + (kc0 & 7) * 8) = sv0; *(uint4*)(q_ + AT_V + (kc1 >> 3) * 72 + (kc1 & 7) * 8) = sv1; } while (0)
    AT_GLOAD(0); AT_SSTORE(lds);
    __syncthreads();
    for (int kt = 0; kt <= qb; ++kt) {
        unsigned zofs = 0; asm volatile("" : "+v"(zofs));
        bf16_t* cur = lds + (kt & 1) * AT_ELEMS + zofs;
        bf16_t* nxt = lds + ((kt + 1) & 1) * AT_ELEMS + zofs;
        const bool more = kt < qb;
        if (more) { AT_GLOAD(kt + 1); }
        const unsigned long long mw = mcol[(size_t)kt * LPAD];
        f32x16 st[2];
#pragma unroll
        for (int j = 0; j < 16; ++j) { st[0][j] = 0.f; st[1][j] = 0.f; }
#pragma unroll
        for (int ks = 0; ks < 8; ++ks) {
            st[0] = MFMA32(*(const bf16x8*)(cur + AT_K + (r) * 136 + 16 * ks + 8 * hh), qf[ks], st[0]);
            st[1] = MFMA32(*(const bf16x8*)(cur + AT_K + (32 + r) * 136 + 16 * ks + 8 * hh), qf[ks], st[1]);
        }
        float mx = -3.0e38f;
#pragma unroll
        for (int kk = 0; kk < 2; ++kk) {
            const unsigned w = (unsigned)(mw >> (32 * kk)) >> (4 * hh);
#pragma unroll
            for (int reg = 0; reg < 16; ++reg) {
                const int bit = (reg & 3) + 8 * (reg >> 2);
                const float v = ((w >> bit) & 1u) ? st[kk][reg] : -3.0e38f;
                st[kk][reg] = v;
                mx = fmaxf(mx, v);
            }
        }
        mx = fmaxf(mx, __shfl_xor(mx, 32));
        const float mnew = fmaxf(mrun, mx);
        const float alpha = __builtin_amdgcn_exp2f(mrun - mnew);
        mrun = mnew;
        float psum = 0.f;
#pragma unroll
        for (int kk = 0; kk < 2; ++kk)
#pragma unroll
            for (int reg = 0; reg < 16; ++reg) { const float pv = __builtin_amdgcn_exp2f(st[kk][reg] - mnew); st[kk][reg] = pv; psum += pv; }
        lrun = lrun * alpha + psum;
#pragma unroll
        for (int dt = 0; dt < 4; ++dt) O[dt] = O[dt] * alpha;
        bf16x8 pb[2][2];
#pragma unroll
        for (int kk = 0; kk < 2; ++kk)
#pragma unroll
            for (int s = 0; s < 2; ++s) pb[kk][s] = pack_step(st[kk], s);
#pragma unroll
        for (int dt = 0; dt < 4; ++dt)
#pragma unroll
            for (int kk = 0; kk < 2; ++kk)
#pragma unroll
                for (int s = 0; s < 2; ++s)
                    O[dt] = MFMA32(frag_perm(cur + AT_V + (32 * dt + r) * 72 + 32 * kk + 16 * s + 4 * hh), pb[kk][s], O[dt]);
        if (more) { AT_SSTORE(nxt); }
        __syncthreads();
    }
    const float ltot = lrun + __shfl_xor(lrun, 32);
    const float inv = 1.f / ltot;
    if (tq < LP) {
        bf16_t* op = p.gated + ((size_t)b * LP + tq) * 1024 + head * 128;
#pragma unroll
        for (int dt = 0; dt < 4; ++dt)
#pragma unroll
            for (int g4 = 0; g4 < 4; ++g4) {
                f32x4 v;
#pragma unroll
                for (int e2 = 0; e2 < 4; ++e2) v[e2] = O[dt][4 * g4 + e2] * inv;
                st_bf16x4(op + 32 * dt + 8 * g4 + 4 * hh, v);
            }
    }
    __syncthreads();
}

__device__ __forceinline__ void attn_phase(const Params& p, char* smem, int bid, int nb, int rep = 0) {
    int* slot = (int*)(smem + LDS_BYTES - 32);
    for (;;) {
        if (threadIdx.x == 0) *slot = (int)atomicAdd(p.bar + 3584 + 16 * rep, 1u);
        __syncthreads();
        const int u = *slot;
        __syncthreads();
        if (u >= 520 + NSR) break;
        if (u < 520) attn_dense_unit(p, smem, (u & 7) >> 1, u & 1, 64 - (u >> 3));
        else attn_sample_query(p, smem, NPR + (u - 520));
    }
}

#define XB_TMO      128
#define XB_XCNT(j)  (256  + 64 * (j))
#define XB_XSUB(j)  (1280 + 64 * (j))
#define XB_XGEN(j)  (2304 + 64 * (j))
#define XB_TOP      3328
#define XB_TOPGEN   3392
#define XCD_BAR_WORDS 3456
#define XB_SPIN_CAP (1u << 18)
#define LAS __attribute__((address_space(3)))

__device__ __forceinline__ unsigned xb_ld(unsigned* p)              { return __hip_atomic_load(p, __ATOMIC_RELAXED, __HIP_MEMORY_SCOPE_AGENT); }
__device__ __forceinline__ unsigned xb_add(unsigned* p, unsigned v) { return __hip_atomic_fetch_add(p, v, __ATOMIC_RELAXED, __HIP_MEMORY_SCOPE_AGENT); }
__device__ __forceinline__ unsigned xb_xcc_id() { return (unsigned)__builtin_amdgcn_s_getreg((3 << 11) | 20) & 0xFu; }
#define XB_SPIN(cond, bar) do { unsigned _sp = 0; while (cond) { __builtin_amdgcn_s_sleep(1); \
    if ((++_sp & 255u) == 0u) { if (xb_ld(&(bar)[XB_TMO])) break; if (_sp > XB_SPIN_CAP) { atomicAdd(&(bar)[XB_TMO], 1u); break; } } } } while (0)

struct XcdBarrier {
    unsigned* bar; unsigned x;
    volatile LAS unsigned* st;
};

__device__ __forceinline__ XcdBarrier xcd_barrier_post(unsigned* bar, volatile LAS unsigned* st) {
    XcdBarrier b; b.bar = bar; b.x = xb_xcc_id(); b.st = st;
    if (threadIdx.x == 0) (void)xb_add(&bar[XB_XCNT(b.x)], 1u);
    return b;
}
__device__ __forceinline__ void xcd_barrier_complete(unsigned* bar, unsigned x, unsigned& nloc, unsigned& nx) {
    const unsigned G = gridDim.x * gridDim.y * gridDim.z;
    unsigned sum, cnt, mine, sp = 0u;
    for (;;) {
        sum = 0u; cnt = 0u; mine = 0u;
#pragma unroll
        for (unsigned j = 0; j < 16; ++j) { const unsigned c = xb_ld(&bar[XB_XCNT(j)]); sum += c; cnt += (c > 0u) ? 1u : 0u; mine = (j == x) ? c : mine; }
        if (sum == G) break;
        __builtin_amdgcn_s_sleep(1);
        if ((++sp & 255u) == 0u) { if (xb_ld(&bar[XB_TMO])) break; if (sp > XB_SPIN_CAP) { atomicAdd(&bar[XB_TMO], 1u); break; } }
    }
    nloc = mine > 0u ? mine : 1u; nx = cnt > 0u ? cnt : 1u;
}

__device__ __forceinline__ void xcd_barrier(const XcdBarrier& b) {
    asm volatile("s_waitcnt vmcnt(0)" ::: "memory");
    __syncthreads();
    if (threadIdx.x == 0) {
        unsigned* bar = b.bar;
        __builtin_amdgcn_s_waitcnt(0);
        unsigned nloc = b.st[0], nx = b.st[1];
        if (nloc == 0u) { xcd_barrier_complete(bar, b.x, nloc, nx); b.st[0] = nloc; b.st[1] = nx; }
        const unsigned old = xb_add(&bar[XB_XSUB(b.x)], 1u);
        const unsigned gen = old / nloc;
        if (old + 1u == (gen + 1u) * nloc) {
            __builtin_amdgcn_fence(__ATOMIC_RELEASE, "agent");
            asm volatile("s_waitcnt vmcnt(0)" ::: "memory");
            const unsigned og = xb_add(&bar[XB_TOP], 1u);
            const unsigned tg = og / nx;
            if (og + 1u == (tg + 1u) * nx) xb_add(&bar[XB_TOPGEN], 1u);
            else XB_SPIN(xb_ld(&bar[XB_TOPGEN]) == tg, bar);
            __builtin_amdgcn_fence(__ATOMIC_ACQUIRE, "agent");
            xb_add(&bar[XB_XGEN(b.x)], 1u);
            asm volatile("s_waitcnt vmcnt(0)" ::: "memory");
        } else {
            XB_SPIN(xb_ld(&bar[XB_XGEN(b.x)]) == gen, bar);
            __builtin_amdgcn_fence(__ATOMIC_ACQUIRE, "agent");
            asm volatile("s_waitcnt vmcnt(0)" ::: "memory");
        }
    }
    __syncthreads();
}


constexpr int NPHASE = 19;
template <int PH>
__device__ __forceinline__ void run_phase(const Params& p, char* smem, int bid, int nb, int rep = 0) {
    constexpr int MT = MPAD / 256;
    if constexpr (PH == 0) phase_prologue(p, smem, bid, nb);
    else if constexpr (PH == 1) gemm_big(p.hA, D, p.wt_gin, GIN_PAD, EpiGdnIn{p.mixed, p.z, p.ba}, smem, bid, nb);
    else if constexpr (PH == 2) gdn_stageA(p, smem, bid, nb);
    else if constexpr (PH == 3) gdn_seq_phase(p, smem, bid, nb, rep);
    else if constexpr (PH == 4) gdn_gate_phase(p, bid, nb);
    else if constexpr (PH == 5) gemm_n1024(p.gated, 2048, p.wt_gout, EpiResid{p.preln, p.hA}, EpiResidAtomic{p.preln, p.hA}, 8, smem, bid, nb);
    else if constexpr (PH == 6) ln_phase(p.preln, p.ln1_g, p.ln1_b, p.hB, nullptr, nullptr, bid, nb);
    else if constexpr (PH == 7) gemm_big(p.hB, D, p.wt_w1, DFF, EpiRelu2{p.act}, smem, bid, nb);
    else if constexpr (PH == 8) gemm_n1024(p.act, DFF, p.wt_w2, EpiResid{p.preln, p.hB}, EpiResidAtomic{p.preln, p.hB}, 16, smem, bid, nb);
    else if constexpr (PH == 9) ln_phase(p.preln, p.ln2_g, p.ln2_b, p.hA, nullptr, nullptr, bid, nb);
    else if constexpr (PH == 10) gemm_big(p.hA, D, p.wt_din, DIN_PAD, EpiF32{p.p1, DIN_PAD}, smem, bid, nb);
    else if constexpr (PH == 11) dsa_post_phase(p, smem, bid, nb);
    else if constexpr (PH == 12) indexer_phase(p, smem, bid, nb, rep);
    else if constexpr (PH == 13) attn_phase(p, smem, bid, nb, rep);
    else if constexpr (PH == 14) gemm_n1024(p.gated, D, p.wt_do, EpiResid{p.preln, p.hA}, EpiResidAtomic{p.preln, p.hA}, 4, smem, bid, nb);
    else if constexpr (PH == 15) ln_phase(p.preln, p.ln1_g + D, p.ln1_b + D, p.hB, nullptr, nullptr, bid, nb);
    else if constexpr (PH == 16) gemm_big(p.hB, D, p.wt_w1 + (size_t)D * DFF, DFF, EpiRelu2{p.act}, smem, bid, nb);
    else if constexpr (PH == 17) gemm_n1024(p.act, DFF, p.wt_w2 + (size_t)D * DFF, EpiResid{p.preln, p.hB}, EpiResidAtomic{p.preln, p.hB}, 16, smem, bid, nb);
    else if constexpr (PH == 18) ln_phase(p.preln, p.ln2_g + D, p.ln2_b + D, nullptr, p.y_prompt, p.y_sample, bid, nb);
}

template <int PH>
__global__ void __launch_bounds__(NTHR, 2) k_phase(Params p) {
    extern __shared__ __attribute__((aligned(16))) char smem[];
    run_phase<PH>(p, smem, blockIdx.x, gridDim.x);
}

template <int PH>
__device__ __forceinline__ void mega_run(const Params& p, char* smem, const XcdBarrier& bar) {
    run_phase<PH>(p, smem, blockIdx.x, gridDim.x);
#ifdef PROBE_MASK
    if constexpr ((PROBE_MASK >> PH) & 1) { xcd_barrier(bar); run_phase<PH>(p, smem, blockIdx.x, gridDim.x, 1); }
#endif
    if constexpr (PH + 1 < NPHASE) {
        xcd_barrier(bar);
        mega_run<PH + 1>(p, smem, bar);
    }
}
__global__ void __launch_bounds__(NTHR, 2) k_mega(Params p) {
    extern __shared__ __attribute__((aligned(16))) char smem[];
    volatile LAS unsigned* st = (volatile LAS unsigned*)(smem + LDS_BYTES - 16);
    if (threadIdx.x == 0) { st[0] = 0u; st[1] = 0u; st[2] = 0u; st[3] = 0u; }
    __syncthreads();
    XcdBarrier bar = xcd_barrier_post(p.bar, st);
    mega_run<0>(p, smem, bar);
}

template <int PH>
void launch_phase(const Params& p, hipStream_t stream) {
    static bool attr_done = false;
    if (!attr_done) {
        (void)hipFuncSetAttribute((const void*)k_phase<PH>, hipFuncAttributeMaxDynamicSharedMemorySize, LDS_BYTES);
        attr_done = true;
    }
    hipLaunchKernelGGL(k_phase<PH>, dim3(256), dim3(NTHR), LDS_BYTES, stream, p);
}
template <int PH>
void launch_all(const Params& p, hipStream_t stream) {
    launch_phase<PH>(p, stream);
    if constexpr (PH + 1 < NPHASE) launch_all<PH + 1>(p, stream);
}

}

extern "C" void kernel_launch(void* const* d_in, const int* in_sizes, int n_in, void* d_out, int out_size, void* d_ws, size_t ws_size,
                              hipStream_t stream) {
    Params p{};
    p.x_prompt = (const float*)d_in[0]; p.x_sample = (const float*)d_in[1]; p.state_gdn = (const float*)d_in[2];
    p.state_conv = (const float*)d_in[3]; p.cache_k = (const float*)d_in[4]; p.cache_v = (const float*)d_in[5];
    p.cache_ik = (const float*)d_in[6]; p.page_table = (const int*)d_in[7]; p.meta = (const float*)d_in[8];
    p.ln1_g = (const float*)d_in[9]; p.ln1_b = (const float*)d_in[10]; p.ln2_g = (const float*)d_in[11]; p.ln2_b = (const float*)d_in[12];
    p.mlp_w1 = (const float*)d_in[13]; p.mlp_w2 = (const float*)d_in[14]; p.gdn_w_in = (const float*)d_in[15];
    p.gdn_conv_w = (const float*)d_in[16]; p.gdn_a_log = (const float*)d_in[17]; p.gdn_dt_bias = (const float*)d_in[18];
    p.gdn_norm_w = (const float*)d_in[19]; p.gdn_w_out = (const float*)d_in[20]; p.dsa_w_in = (const float*)d_in[21];
    p.dsa_ik_g = (const float*)d_in[22]; p.dsa_ik_b = (const float*)d_in[23]; p.dsa_w_o = (const float*)d_in[24];
    float* o = (float*)d_out;
    p.y_prompt = o; o += (size_t)BATCH * SEQ * D;
    p.y_sample = o; o += (size_t)NSR * D;
    p.gs_prompt = o; o += (size_t)BATCH * 16 * 128 * 128;
    p.gc_prompt = o; o += (size_t)BATCH * 3 * 4096;
    p.gs_sample = o; o += (size_t)DB * 16 * 128 * 128;
    p.gc_sample = o; o += (size_t)DB * 3 * 4096;
    p.k_prompt = o; o += (size_t)NPR * 256;
    p.v_prompt = o; o += (size_t)NPR * 256;
    p.ik_prompt = o; o += (size_t)NPR * 64;
    p.k_sample = o; o += (size_t)NSR * 256;
    p.v_sample = o; o += (size_t)NSR * 256;
    p.ik_sample = o; o += (size_t)NSR * 64;
    char* w = (char*)d_ws;
    auto take = [&](size_t bytes) { char* r = w; w += (bytes + 255) & ~(size_t)255; return r; };
    p.bar = (unsigned*)take(16384);
    p.wt_gin = (bf16_t*)take((size_t)GIN_PAD * D * 2);
    p.wt_gout = (bf16_t*)take((size_t)D * 2048 * 2);
    p.wt_w1 = (bf16_t*)take((size_t)2 * D * DFF * 2);
    p.wt_w2 = (bf16_t*)take((size_t)2 * D * DFF * 2);
    p.wt_din = (bf16_t*)take((size_t)DIN_PAD * D * 2);
    p.wt_do = (bf16_t*)take((size_t)D * D * 2);
    p.hA = (bf16_t*)take((size_t)MPAD * D * 2);
    p.hB = (bf16_t*)take((size_t)MPAD * D * 2);
    p.preln = (float*)take((size_t)MPAD * D * 4);
    p.mixed = (bf16_t*)take((size_t)MPAD * 4096 * 2);
    p.z = (bf16_t*)take((size_t)MPAD * 2048 * 2);
    p.ba = (float*)take((size_t)MPAD * 32 * 4);
    p.gated = (bf16_t*)take((size_t)MPAD * 2048 * 2);
    p.act = (bf16_t*)take((size_t)MPAD * DFF * 2);
    p.p1 = (float*)take((size_t)MPAD * DIN_PAD * 4);
    p.qr = (float*)take((size_t)MPAD * 1024 * 4);
    p.iq = (float*)take((size_t)MPAD * 512 * 4);
    p.iw = (float*)take((size_t)MPAD * 8 * 4);
    p.sel = (int*)take((size_t)MPAD * 256 * 4);
    p.g_o = (bf16_t*)take((size_t)NPR * 2048 * 2);
    p.rope_tab = (float*)take((size_t)LP * 24 * 2 * 4);
    p.q_b = (bf16_t*)take((size_t)NPR * 1024 * 2);
    p.k_b = (bf16_t*)take((size_t)BATCH * 2 * LPAD * 128 * 2);
    p.vt_b = (bf16_t*)take((size_t)BATCH * 2 * 128 * LPAD * 2);
    p.iq_b = (bf16_t*)take((size_t)NPR * 512 * 2);
    p.ik_b = (bf16_t*)take((size_t)BATCH * LPAD * 64 * 2);
    p.maskT = (unsigned long long*)take((size_t)BATCH * 65 * LPAD * 8);
    p.g_dec = (float*)take((size_t)NCU * 4);
    p.g_u = (float*)p.act;
    p.g_negw = (bf16_t*)p.p1;
    p.g_qg = p.g_negw + (size_t)NCU * 8192;
    p.g_kdT = (bf16_t*)p.qr;
    p.g_aqk = (bf16_t*)p.iq;
    if ((size_t)(w - (char*)d_ws) > ws_size) { fprintf(stderr, "kernel_launch: workspace too small (%zu needed, %zu given)\n", (size_t)(w - (char*)d_ws), ws_size); return; }
#if MEGA
    static int grid = 0;
    if (grid == 0) {
        int dev = 0, cus = 0;
        if (hipGetDevice(&dev) != hipSuccess || hipDeviceGetAttribute(&cus, hipDeviceAttributeMultiprocessorCount, dev) != hipSuccess || cus <= 0) cus = 256;
        (void)hipFuncSetAttribute((const void*)k_mega, hipFuncAttributeMaxDynamicSharedMemorySize, LDS_BYTES);
        grid = cus;
    }
    (void)hipMemsetAsync(p.bar, 0, 16384, stream);
    hipLaunchKernelGGL(k_mega, dim3(grid), dim3(NTHR), LDS_BYTES, stream, p);
#else
    launch_all<0>(p, stream);
#endif
}
```

```cpp
#include <hip/hip_runtime.h>
#include <stdint.h>
#include <stdio.h>

#ifndef MEGA
#define MEGA 1
#endif

namespace {

typedef unsigned short bf16_t;
typedef short bf16x8 __attribute__((ext_vector_type(8)));
typedef float f32x4 __attribute__((ext_vector_type(4)));

constexpr int D = 1024, BATCH = 4, SEQ = 4096, NMETA = 16, LP = SEQ + NMETA;
constexpr int DB = 128, DS = 4, PAST = 2048;
constexpr int NPR = BATCH * LP;
constexpr int NSR = DB * DS;
constexpr int NT = NPR + NSR;
constexpr int MPAD = 17152;
constexpr int DFF = 4096;
constexpr int GIN = 6176, GIN_PAD = 6400;
constexpr int DIN = 2120, DIN_PAD = 2304;
constexpr int NTHR = 512;
constexpr int LPAD = 4160;
constexpr int LDS_BYTES = 150 * 1024;
constexpr float ALPHA = 1.4142135623730951f;

struct Params {
    const float *x_prompt, *x_sample, *state_gdn, *state_conv, *cache_k, *cache_v, *cache_ik;
    const int* page_table;
    const float *meta, *ln1_g, *ln1_b, *ln2_g, *ln2_b, *mlp_w1, *mlp_w2, *gdn_w_in, *gdn_conv_w, *gdn_a_log, *gdn_dt_bias,
        *gdn_norm_w, *gdn_w_out, *dsa_w_in, *dsa_ik_g, *dsa_ik_b, *dsa_w_o;
    float *y_prompt, *y_sample, *gs_prompt, *gc_prompt, *gs_sample, *gc_sample, *k_prompt, *v_prompt, *ik_prompt, *k_sample,
        *v_sample, *ik_sample;
    unsigned* bar;
    bf16_t *wt_gin, *wt_gout, *wt_w1, *wt_w2, *wt_din, *wt_do;
    bf16_t *hA, *hB;
    float* preln;
    bf16_t *mixed, *z;
    float* ba;
    bf16_t *gated, *act;
    float *p1, *qr, *iq, *iw;
    int* sel;
    bf16_t *g_negw, *g_qg, *g_kdT, *g_aqk;
    float *g_u, *g_dec;
    bf16_t* g_o;
    float* rope_tab;
    float* slab;
    bf16_t *q_b, *k_b, *vt_b, *iq_b, *ik_b;
    unsigned long long* maskT;
};

__device__ const double kInvFreq[16] = {1.0, 0.44036660267178046, 0.19392274474868576, 0.08539710028576561,
    0.03760603093086393, 0.016560440080994446, 0.007292664737217109, 0.003211445994752591, 0.001414213562373095,
    0.000622772421914596, 0.0002742481756762073, 0.00012076973741146504, 5.318295896944988e-05, 2.341999896140934e-05,
    1.031338537721246e-05, 4.5416704806078695e-06};

__device__ __forceinline__ float bf2f(bf16_t h) { return __uint_as_float(((unsigned)h) << 16); }
typedef __bf16 hwbf16x2 __attribute__((ext_vector_type(2)));
typedef float f32x2 __attribute__((ext_vector_type(2)));
typedef float f32x16 __attribute__((ext_vector_type(16)));
typedef unsigned u32x4 __attribute__((ext_vector_type(4)));
__device__ __forceinline__ unsigned pk2(float lo, float hi) {
    const f32x2 v = {lo, hi};
    return __builtin_bit_cast(unsigned, __builtin_convertvector(v, hwbf16x2));
}
__device__ __forceinline__ bf16_t f2bf(float f) { return (bf16_t)(pk2(f, 0.f) & 0xffffu); }
__device__ __forceinline__ void st_bf16x4(bf16_t* p, f32x4 v) {
    uint2 o; o.x = pk2(v[0], v[1]); o.y = pk2(v[2], v[3]);
    *(uint2*)p = o;
}
__device__ __forceinline__ f32x4 cvt_bf16x4(uint2 o) {
    f32x4 v; v[0] = __uint_as_float(o.x << 16); v[1] = __uint_as_float(o.x & 0xffff0000u);
    v[2] = __uint_as_float(o.y << 16); v[3] = __uint_as_float(o.y & 0xffff0000u);
    return v;
}
__device__ __forceinline__ f32x4 ld_bf16x4(const bf16_t* p) {
    uint2 o = *(const uint2*)p;
    f32x4 v; v[0] = __uint_as_float(o.x << 16); v[1] = __uint_as_float(o.x & 0xffff0000u);
    v[2] = __uint_as_float(o.y << 16); v[3] = __uint_as_float(o.y & 0xffff0000u);
    return v;
}
__device__ __forceinline__ float wave_sum(float v) {
#pragma unroll
    for (int o = 1; o < 64; o <<= 1) v += __shfl_xor(v, o);
    return v;
}
__device__ __forceinline__ float wave_max(float v) {
#pragma unroll
    for (int o = 1; o < 64; o <<= 1) v = fmaxf(v, __shfl_xor(v, o));
    return v;
}
__device__ __forceinline__ int wave_sum_i(int v) {
#pragma unroll
    for (int o = 1; o < 64; o <<= 1) v += __shfl_xor(v, o);
    return v;
}
__device__ __forceinline__ float silu(float x) { return x * __builtin_amdgcn_rcpf(1.f + __expf(-x)); }
__device__ __forceinline__ int tid_opaque() { int t = threadIdx.x; asm volatile("" : "+v"(t)); return t; }
__device__ __forceinline__ void lds_fence() { asm volatile("s_waitcnt lgkmcnt(0)" ::: "memory"); }

__device__ __forceinline__ void transpose_convert(const float* __restrict__ W, int K, int N, int Npad, bf16_t* __restrict__ WT, float* tile,
                                  int bid, int nb) {
    const int tid = tid_opaque();
    const int tk = K / 64, tn = Npad / 64;
    for (int it = bid; it < tk * tn; it += nb) {
        const int kb = it / tn, nbk = it % tn, k0 = kb * 64, n0 = nbk * 64;
#pragma unroll
        for (int i = 0; i < 8; ++i) {
            const int r = (tid >> 6) + 8 * i, c = tid & 63, n = n0 + c;
            tile[r * 65 + c] = (n < N) ? W[(size_t)(k0 + r) * N + n] : 0.f;
        }
        __syncthreads();
        {
            const int rn = tid >> 3, c8 = (tid & 7) * 8;
            const float* tp = tile + c8 * 65 + rn;
            uint4 o;
            o.x = pk2(tp[0], tp[65]); o.y = pk2(tp[2 * 65], tp[3 * 65]); o.z = pk2(tp[4 * 65], tp[5 * 65]); o.w = pk2(tp[6 * 65], tp[7 * 65]);
            *(uint4*)(WT + (size_t)(n0 + rn) * K + k0 + c8) = o;
        }
        __syncthreads();
    }
}

__device__ __forceinline__ void phase_prologue(const Params& p, char* smem, int bid, int nb) {
    float* tile = (float*)smem;
    transpose_convert(p.gdn_w_in, D, GIN, GIN_PAD, p.wt_gin, tile, bid, nb);
    transpose_convert(p.gdn_w_out, 2048, D, D, p.wt_gout, tile, bid, nb);
    transpose_convert(p.mlp_w1, D, DFF, DFF, p.wt_w1, tile, bid, nb);
    transpose_convert(p.mlp_w1 + (size_t)D * DFF, D, DFF, DFF, p.wt_w1 + (size_t)D * DFF, tile, bid, nb);
    transpose_convert(p.mlp_w2, DFF, D, D, p.wt_w2, tile, bid, nb);
    transpose_convert(p.mlp_w2 + (size_t)D * DFF, DFF, D, D, p.wt_w2 + (size_t)D * DFF, tile, bid, nb);
    transpose_convert(p.dsa_w_in, D, DIN, DIN_PAD, p.wt_din, tile, bid, nb);
    transpose_convert(p.dsa_w_o, D, D, D, p.wt_do, tile, bid, nb);
    for (int idx = bid * NTHR + tid_opaque(); idx < LP * 24; idx += nb * NTHR) {
        const int pos = idx / 24, f = idx % 24;
        const int fi = (f < 16) ? f : (f - 16) * 2;
        const double rev = (double)pos * kInvFreq[fi] * 0.15915494309189535;
        const float r = (float)(rev - floor(rev));
        p.rope_tab[idx * 2] = __builtin_amdgcn_cosf(r);
        p.rope_tab[idx * 2 + 1] = __builtin_amdgcn_sinf(r);
    }
    for (int idx = bid * NTHR + tid_opaque(); idx < MPAD * 256; idx += nb * NTHR) {
        const int row = idx >> 8, c4 = (idx & 255) * 4;
        f32x4 v = {0.f, 0.f, 0.f, 0.f};
        if (row < NPR) {
            const int b = row / LP, t = row % LP;
            const float* src = (t < NMETA) ? (p.meta + (size_t)t * D) : (p.x_prompt + ((size_t)b * SEQ + (t - NMETA)) * D);
            v = *(const f32x4*)(src + c4);
        } else if (row < NT) {
            v = *(const f32x4*)(p.x_sample + (size_t)(row - NPR) * D + c4);
        }
        st_bf16x4(p.hA + (size_t)row * D + c4, v);
    }
}

template <class Epi>
__device__ __forceinline__ void gemm_phase(const bf16_t* __restrict__ A, int lda, const bf16_t* __restrict__ Bt, int K, int Mtiles, int Ntiles,
                           const Epi& epi, char* smem, int bid, int nb) {
    bf16_t* As = (bf16_t*)smem;
    bf16_t* Bs = As + 256 * 72;
    const int tid = tid_opaque(), lane = tid & 63, wave = tid >> 6;
    const int wm = wave >> 1, wn = wave & 1;
    const int fr = lane & 15, fq = lane >> 4;
    const int ntiles = Mtiles * Ntiles;
    const int nk = K / 64;
    for (int tile = bid; tile < ntiles; tile += nb) {
        const int tm = tile % Mtiles, tn = tile / Mtiles;
        const bf16_t* Ag = A + (size_t)tm * 256 * lda;
        const bf16_t* Bg = Bt + (size_t)tn * 128 * K;
        f32x4 acc[4][4];
#pragma unroll
        for (int i = 0; i < 4; ++i)
#pragma unroll
            for (int j = 0; j < 4; ++j) acc[i][j] = (f32x4){0.f, 0.f, 0.f, 0.f};
        const int c0 = tid, c1 = tid + 512, c2 = tid + 1024, c3 = tid + 1536;
        const bf16_t* ga0 = Ag + (size_t)(c0 >> 3) * lda + (c0 & 7) * 8;
        const bf16_t* ga1 = Ag + (size_t)(c1 >> 3) * lda + (c1 & 7) * 8;
        const bf16_t* ga2 = Ag + (size_t)(c2 >> 3) * lda + (c2 & 7) * 8;
        const bf16_t* ga3 = Ag + (size_t)(c3 >> 3) * lda + (c3 & 7) * 8;
        const bf16_t* gb0 = Bg + (size_t)(c0 >> 3) * K + (c0 & 7) * 8;
        const bf16_t* gb1 = Bg + (size_t)(c1 >> 3) * K + (c1 & 7) * 8;
        bf16_t* sa0 = As + (c0 >> 3) * 72 + (c0 & 7) * 8;
        bf16_t* sa1 = As + (c1 >> 3) * 72 + (c1 & 7) * 8;
        bf16_t* sa2 = As + (c2 >> 3) * 72 + (c2 & 7) * 8;
        bf16_t* sa3 = As + (c3 >> 3) * 72 + (c3 & 7) * 8;
        bf16_t* sb0 = Bs + (c0 >> 3) * 72 + (c0 & 7) * 8;
        bf16_t* sb1 = Bs + (c1 >> 3) * 72 + (c1 & 7) * 8;
        uint4 ra0 = *(const uint4*)ga0, ra1 = *(const uint4*)ga1, ra2 = *(const uint4*)ga2, ra3 = *(const uint4*)ga3;
        uint4 rb0 = *(const uint4*)gb0, rb1 = *(const uint4*)gb1;
        *(uint4*)sa0 = ra0; *(uint4*)sa1 = ra1; *(uint4*)sa2 = ra2; *(uint4*)sa3 = ra3; *(uint4*)sb0 = rb0; *(uint4*)sb1 = rb1;
        __syncthreads();
        for (int kt = 0; kt < nk; ++kt) {
            const bool more = (kt + 1 < nk);
            if (more) {
                const int k0 = (kt + 1) * 64;
                ra0 = *(const uint4*)(ga0 + k0); ra1 = *(const uint4*)(ga1 + k0); ra2 = *(const uint4*)(ga2 + k0); ra3 = *(const uint4*)(ga3 + k0);
                rb0 = *(const uint4*)(gb0 + k0); rb1 = *(const uint4*)(gb1 + k0);
            }
#pragma unroll
            for (int kk = 0; kk < 2; ++kk) {
                bf16x8 af[4], bfr[4];
#pragma unroll
                for (int i = 0; i < 4; ++i) af[i] = *(const bf16x8*)(As + (wm * 64 + i * 16 + fr) * 72 + kk * 32 + fq * 8);
#pragma unroll
                for (int j = 0; j < 4; ++j) bfr[j] = *(const bf16x8*)(Bs + (wn * 64 + j * 16 + fr) * 72 + kk * 32 + fq * 8);
#pragma unroll
                for (int i = 0; i < 4; ++i)
#pragma unroll
                    for (int j = 0; j < 4; ++j) acc[i][j] = __builtin_amdgcn_mfma_f32_16x16x32_bf16(bfr[j], af[i], acc[i][j], 0, 0, 0);
            }
            __syncthreads();
            if (more) {
                *(uint4*)sa0 = ra0; *(uint4*)sa1 = ra1; *(uint4*)sa2 = ra2; *(uint4*)sa3 = ra3; *(uint4*)sb0 = rb0; *(uint4*)sb1 = rb1;
                __syncthreads();
            }
        }
#pragma unroll
        for (int i = 0; i < 4; ++i)
#pragma unroll
            for (int j = 0; j < 4; ++j) {
                const int row = tm * 256 + wm * 64 + i * 16 + fr, col = tn * 128 + wn * 64 + j * 16 + fq * 4;
                epi(row, col, acc[i][j]);
            }
    }
}

namespace pg8 {
#define PG8_LAS __attribute__((address_space(3)))
constexpr int BM = 256, BK = 64, HALF = 128, HTB = HALF * BK * 2  , STAGE_BYTES = 8 * HTB, NXCD = 8, WGM = 8;
__device__ __forceinline__ int lds_byte(int r, int c) { const int st = (r >> 4) * 2 + (c >> 5), rr = r & 15, cc = c & 31, ob = rr * 64 + cc * 2; return st * 1024 + (ob ^ (((ob >> 9) & 1) << 5)); }
__device__ __forceinline__ void stage_rc(int b, int& R, int& C) { const int st = b / 1024, sb = b % 1024, swz = sb ^ (((sb >> 9) & 1) << 5); R = (st >> 1) * 16 + swz / 64; C = (st & 1) * 32 + (swz % 64) / 2; }
struct Unit { int pm, pn, pk; };
struct Gemm { const bf16_t* A; const bf16_t* Bt; int K; int splits; };
struct StaticOrder {
    int nM, nN, nNr, pm0, nwg, G, c;
    __device__ void init(int nM_, int nNr_, int splits, int pm0_, int G_, int c_) { nM = nM_; nNr = nNr_; nN = nNr_ * splits; pm0 = pm0_; nwg = nM * nN; G = G_; c = c_; }
    __device__ bool next(int i, Unit& u) const {
        const long L = (long)i * G + c; if (L >= nwg) return false;
        int wgid = (int)L; { const int q = nwg / NXCD, r = nwg % NXCD, xcd = wgid % NXCD, off = wgid / NXCD; wgid = (xcd < r ? xcd * (q + 1) : r * (q + 1) + (xcd - r) * q) + off; }
        const int nig = WGM * nN, gid = wgid / nig, fm = gid * WGM, gsz = (nM - fm) < WGM ? (nM - fm) : WGM;
        const int pnv = (wgid % nig) / gsz;
        u.pm = pm0 + fm + ((wgid % nig) % gsz); u.pn = pnv % nNr; u.pk = pnv / nNr; return true;
    }
};
template <class Epi>
__device__ __forceinline__ void gemm_phase(PG8_LAS unsigned char* lds, const Gemm g, const StaticOrder& S, const Epi& E) {
    const int tid = tid_opaque(), wid = __builtin_amdgcn_readfirstlane(tid >> 6), lane = tid & 63, wr = wid >> 2, wc = wid & 3, fr = lane & 15, fq = lane >> 4;
    const int K = g.K, Kp = K / g.splits, nt = Kp / BK;
    unsigned voffA[2], voffB[2];
#pragma unroll
    for (int i = 0; i < 2; ++i) { int R, C; stage_rc(tid * 16 + i * 8192, R, C); voffA[i] = (unsigned)(R * K + C) * 2u; voffB[i] = voffA[i]; }
    const size_t kstep = (size_t)(BK * 2);
    const size_t hstep = (size_t)HALF * K * 2;
    const size_t tstep = 2 * hstep;
    const size_t pstep = (size_t)Kp * 2;
    const unsigned ldsw = (unsigned)wid * 1024u;
    const int aoff = lds_byte(wr * 64 + fr, fq * 8), boff = lds_byte(wc * 32 + fr, fq * 8);
#define PG8_SA(b, h) (((b) * 2 + (h)) * HTB)
#define PG8_SB(b, h) ((4 + (b) * 2 + (h)) * HTB)
#define PG8_STAGE(bufoff, gbase, voff) do { _Pragma("unroll") for (int _i = 0; _i < 2; ++_i) \
        __builtin_amdgcn_global_load_lds((const unsigned*)((const char*)(gbase) + (voff)[_i]), (PG8_LAS unsigned*)(lds + (bufoff) + ldsw + _i * 8192), 16, 0, 0); } while (0)
#define PG8_LDA(dst, b, h) do { _Pragma("unroll") for (int m = 0; m < 4; ++m) _Pragma("unroll") for (int k = 0; k < 2; ++k) dst[m][k] = *(const PG8_LAS bf16x8*)(lds + PG8_SA(b, h) + aoff + m * 2048 + k * 1024); } while (0)
#define PG8_LDB(dst, b, h) do { _Pragma("unroll") for (int n = 0; n < 2; ++n) _Pragma("unroll") for (int k = 0; k < 2; ++k) dst[n][k] = *(const PG8_LAS bf16x8*)(lds + PG8_SB(b, h) + boff + n * 2048 + k * 1024); } while (0)
#define PG8_MMA(ai, bj, At, Bt) do { __builtin_amdgcn_s_setprio(1); _Pragma("unroll") for (int m = 0; m < 4; ++m) _Pragma("unroll") for (int n = 0; n < 2; ++n) _Pragma("unroll") for (int k = 0; k < 2; ++k) \
        acc[ai][bj][m][n] = __builtin_amdgcn_mfma_f32_16x16x32_bf16(Bt[n][k], At[m][k], acc[ai][bj][m][n], 0, 0, 0); __builtin_amdgcn_s_setprio(0); } while (0)
#define PG8_WAIT_V(n) asm volatile("s_waitcnt vmcnt(" #n ")" ::: "memory")
#define PG8_WAIT_L(n) asm volatile("s_waitcnt lgkmcnt(" #n ")" ::: "memory")
#define PG8_BAR __builtin_amdgcn_s_barrier()
#define PG8_SCHED __builtin_amdgcn_sched_barrier(0)
    Unit cur, nxt; int ui = 0;
    if (!S.next(0, cur)) return;
    f32x4 acc[2][2][4][2];
#pragma unroll
    for (int a = 0; a < 2; ++a)
#pragma unroll
        for (int b = 0; b < 2; ++b)
#pragma unroll
            for (int m = 0; m < 4; ++m)
#pragma unroll
                for (int n = 0; n < 2; ++n) acc[a][b][m][n] = (f32x4){0.f, 0.f, 0.f, 0.f};
    bf16x8 At[4][2], B0[2][2], B1[2][2];
    const char* cA = (const char*)g.A + (size_t)cur.pm * tstep + (size_t)cur.pk * pstep; const char* cB = (const char*)g.Bt + (size_t)cur.pn * tstep + (size_t)cur.pk * pstep;
    PG8_STAGE(PG8_SB(0, 0), cB, voffB); PG8_STAGE(PG8_SA(0, 0), cA, voffA); PG8_STAGE(PG8_SB(0, 1), cB + hstep, voffB); PG8_STAGE(PG8_SA(0, 1), cA + hstep, voffA);
    if (wr == 1) PG8_BAR;
    PG8_WAIT_V(4); PG8_BAR;
    PG8_STAGE(PG8_SB(1, 0), cB + kstep, voffB); PG8_STAGE(PG8_SA(1, 0), cA + kstep, voffA); PG8_STAGE(PG8_SB(1, 1), cB + hstep + kstep, voffB);
    PG8_WAIT_V(6); PG8_BAR;
    for (;;) {
        const bool has_next = S.next(ui + 1, nxt);
        const char* nA = has_next ? (const char*)g.A + (size_t)nxt.pm * tstep + (size_t)nxt.pk * pstep : cA; const char* nB = has_next ? (const char*)g.Bt + (size_t)nxt.pn * tstep + (size_t)nxt.pk * pstep : cB;
        for (int t = 0; t < nt; t += 2) {
            const bool last = (t == nt - 2);
            const char* a1 = cA + (size_t)(t + 1) * kstep;
            const char* a2 = last ? nA : cA + (size_t)(t + 2) * kstep; const char* b2 = last ? nB : cB + (size_t)(t + 2) * kstep;
            const char* a3 = a2 + kstep; const char* b3 = b2 + kstep;
            PG8_LDB(B0, 0, 0); PG8_SCHED; PG8_LDA(At, 0, 0); PG8_STAGE(PG8_SA(1, 1), a1 + hstep, voffA);
            PG8_WAIT_L(8); PG8_BAR; PG8_WAIT_L(0); PG8_MMA(0, 0, At, B0); PG8_BAR; PG8_SCHED;
            PG8_LDB(B1, 0, 1); PG8_STAGE(PG8_SB(0, 0), b2, voffB);
            PG8_BAR; PG8_WAIT_L(0); PG8_MMA(0, 1, At, B1); PG8_BAR;
            PG8_LDA(At, 0, 1); PG8_STAGE(PG8_SA(0, 0), a2, voffA);
            PG8_BAR; PG8_WAIT_L(0); PG8_MMA(1, 0, At, B0); PG8_BAR; PG8_SCHED;
            PG8_STAGE(PG8_SB(0, 1), b2 + hstep, voffB);
            PG8_WAIT_V(6); PG8_BAR; PG8_MMA(1, 1, At, B1); PG8_BAR;
            PG8_LDB(B0, 1, 0); PG8_SCHED; PG8_LDA(At, 1, 0); PG8_STAGE(PG8_SA(0, 1), a2 + hstep, voffA);
            PG8_WAIT_L(8); PG8_BAR; PG8_WAIT_L(0); PG8_MMA(0, 0, At, B0); PG8_BAR; PG8_SCHED;
            PG8_LDB(B1, 1, 1); PG8_STAGE(PG8_SB(1, 0), b3, voffB);
            PG8_BAR; PG8_WAIT_L(0); PG8_MMA(0, 1, At, B1); PG8_BAR;
            PG8_LDA(At, 1, 1); PG8_STAGE(PG8_SA(1, 0), a3, voffA);
            PG8_BAR; PG8_WAIT_L(0); PG8_MMA(1, 0, At, B0); PG8_BAR; PG8_SCHED;
            PG8_STAGE(PG8_SB(1, 1), b3 + hstep, voffB);
            PG8_WAIT_V(6); PG8_BAR; PG8_MMA(1, 1, At, B1); PG8_BAR;
        }
#pragma unroll
        for (int ai = 0; ai < 2; ++ai)
#pragma unroll
            for (int m = 0; m < 4; ++m)
#pragma unroll
                for (int bj = 0; bj < 2; ++bj)
#pragma unroll
                    for (int n = 0; n < 2; ++n)
                        E(cur.pm * BM + ai * HALF + wr * 64 + m * 16 + fr, cur.pn * BM + bj * HALF + wc * 32 + n * 16 + 4 * fq, acc[ai][bj][m][n], cur.pk);
        if (!has_next) break;
#pragma unroll
        for (int a = 0; a < 2; ++a)
#pragma unroll
            for (int b = 0; b < 2; ++b)
#pragma unroll
                for (int m = 0; m < 4; ++m)
#pragma unroll
                    for (int n = 0; n < 2; ++n) acc[a][b][m][n] = (f32x4){0.f, 0.f, 0.f, 0.f};
        cur = nxt; cA = nA; cB = nB; ++ui;
    }
    PG8_WAIT_V(0);
    if (wr == 0) PG8_BAR;
    PG8_BAR;
#undef PG8_SA
#undef PG8_SB
#undef PG8_STAGE
#undef PG8_LDA
#undef PG8_LDB
#undef PG8_MMA
#undef PG8_WAIT_V
#undef PG8_WAIT_L
#undef PG8_BAR
#undef PG8_SCHED
}
}

template <class Epi>
__device__ __forceinline__ void gemm_big(const bf16_t* A, int K, const bf16_t* Bt, int Npad, const Epi& e, char* smem, int bid, int nb) {
    pg8::StaticOrder S; S.init(MPAD / 256, Npad / 256, 1, 0, nb, bid);
    pg8::gemm_phase((PG8_LAS unsigned char*)smem, pg8::Gemm{A, Bt, K, 1}, S, e);
}
template <class Epi1, class Epi2>
__device__ __forceinline__ void gemm_n1024(const bf16_t* A, int K, const bf16_t* Bt, const Epi1& e1, const Epi2& e2, int splits, char* smem, int bid, int nb) {
    pg8::StaticOrder S; S.init(64, 4, 1, 0, nb, bid);
    pg8::gemm_phase((PG8_LAS unsigned char*)smem, pg8::Gemm{A, Bt, K, 1}, S, e1);
    pg8::StaticOrder S2; S2.init(3, 4, splits, 64, nb, bid);
    pg8::gemm_phase((PG8_LAS unsigned char*)smem, pg8::Gemm{A, Bt, K, splits}, S2, e2);
}

struct EpiGdnIn {
    bf16_t *mixed, *z; float* ba;
    __device__ __forceinline__ void operator()(int row, int col, f32x4 v, int = 0) const {
        if (col < 4096) st_bf16x4(mixed + (size_t)row * 4096 + col, v);
        else if (col < 6144) st_bf16x4(z + (size_t)row * 2048 + (col - 4096), v);
        else if (col < 6176) *(f32x4*)(ba + (size_t)row * 32 + (col - 6144)) = v;
    }
};
struct EpiResid {
    float* out; const bf16_t* h;
    __device__ __forceinline__ void operator()(int row, int col, f32x4 v, int = 0) const {
        const f32x4 r = ld_bf16x4(h + (size_t)row * D + col);
        *(f32x4*)(out + (size_t)row * D + col) = v + r * ALPHA;
    }
};
struct EpiSlab {
    float* slab;
    __device__ __forceinline__ void operator()(int row, int col, f32x4 v, int pk) const {
        *(f32x4*)(slab + ((size_t)pk * 768 + (row - 16384)) * D + col) = v;
    }
};
struct EpiRelu2 {
    bf16_t* act;
    __device__ __forceinline__ void operator()(int row, int col, f32x4 v, int = 0) const {
#pragma unroll
        for (int e = 0; e < 4; ++e) { const float r = fmaxf(v[e], 0.f); v[e] = r * r; }
        st_bf16x4(act + (size_t)row * DFF + col, v);
    }
};
struct EpiF32 {
    float* out; int ld;
    __device__ __forceinline__ void operator()(int row, int col, f32x4 v, int = 0) const { *(f32x4*)(out + (size_t)row * ld + col) = v; }
};

__device__ __forceinline__ void ln_phase(const float* X, const float* __restrict__ g, const float* __restrict__ bta, bf16_t* Hout,
                         float* yp, float* ys, const float* slab, int splits, const bf16_t* hres, int bid, int nb) {
    const int tid_ = tid_opaque(); const int lane = tid_ & 63, wave = tid_ >> 6;
    f32x4 gv[4], bv[4];
#pragma unroll
    for (int j = 0; j < 4; ++j) { gv[j] = *(const f32x4*)(g + j * 256 + lane * 4); bv[j] = *(const f32x4*)(bta + j * 256 + lane * 4); }
    for (int row = bid * 8 + wave; row < NT; row += nb * 8) {
        f32x4 v[4]; float s = 0.f;
        if (row < 16384) {
#pragma unroll
            for (int j = 0; j < 4; ++j) v[j] = *(const f32x4*)(X + (size_t)row * D + j * 256 + lane * 4);
        } else {
#pragma unroll
            for (int j = 0; j < 4; ++j) v[j] = ld_bf16x4(hres + (size_t)row * D + j * 256 + lane * 4) * ALPHA;
            for (int pk = 0; pk < splits; ++pk) {
                const float* sp = slab + ((size_t)pk * 768 + (row - 16384)) * D + lane * 4;
#pragma unroll
                for (int j = 0; j < 4; ++j) v[j] += *(const f32x4*)(sp + j * 256);
            }
        }
#pragma unroll
        for (int j = 0; j < 4; ++j) s += (v[j][0] + v[j][1]) + (v[j][2] + v[j][3]);
        const float mean = wave_sum(s) * (1.f / D);
        float s2 = 0.f;
#pragma unroll
        for (int j = 0; j < 4; ++j) { v[j] = v[j] - mean; s2 += (v[j][0] * v[j][0] + v[j][1] * v[j][1]) + (v[j][2] * v[j][2] + v[j][3] * v[j][3]); }
        const float rstd = rsqrtf(wave_sum(s2) * (1.f / D) + 1e-5f);
        float* yo = nullptr;
        if (yp) {
            if (row < NPR) { const int b = row / LP, t = row % LP; if (t >= NMETA) yo = yp + ((size_t)b * SEQ + (t - NMETA)) * D; }
            else yo = ys + (size_t)(row - NPR) * D;
        }
#pragma unroll
        for (int j = 0; j < 4; ++j) {
            const f32x4 o = v[j] * rstd * gv[j] + bv[j];
            if (Hout) st_bf16x4(Hout + (size_t)row * D + j * 256 + lane * 4, o);
            if (yo) *(f32x4*)(yo + j * 256 + lane * 4) = o;
        }
    }
}

__device__ __forceinline__ void gdn_sample_pass(const Params& p, char* smem, int pass, int tid) {
    float* sq = (float*)smem;
    float* sk = sq + 256;
    float* part = sk + 256;
    float* part2 = part + 16;
    const int lane = tid & 63, wave = tid >> 6, ug = wave >> 2, wq = wave & 3;
    const int half = lane >> 5, v = wq * 32 + (lane & 31);
    const int u = pass * 2 + ug, b = u >> 4, h = u & 15, kh = h >> 1;
    const size_t row0 = (size_t)NPR + (size_t)b * DS;
    float S[64];
    {
        const float* Sp = p.state_gdn + ((size_t)(b * 16 + h) * 128 + half * 64) * 128 + v;
#pragma unroll
        for (int k = 0; k < 64; ++k) S[k] = Sp[(size_t)k * 128];
    }
    const float Aexp = __expf(p.gdn_a_log[h]);
    const float dtb = p.gdn_dt_bias[h];
    const float nw = p.gdn_norm_w[v];
    const int chA = (half ? 1024 : 0) + kh * 128 + v, chv = 2048 + h * 128 + v;
    float cA[4], cv[4];
#pragma unroll
    for (int j = 0; j < 4; ++j) { cA[j] = p.gdn_conv_w[j * 4096 + chA]; cv[j] = p.gdn_conv_w[j * 4096 + chv]; }
    float xA[7], xv[7];
#pragma unroll
    for (int i = 0; i < 3; ++i) {
        const float* cs = p.state_conv + ((size_t)b * 3 + i) * 4096;
        xA[i] = cs[chA]; xv[i] = cs[chv];
    }
#pragma unroll
    for (int i = 0; i < 4; ++i) {
        const bf16_t* mr = p.mixed + (row0 + i) * 4096;
        xA[3 + i] = bf2f(mr[chA]); xv[3 + i] = bf2f(mr[chv]);
    }
    float* sqg = sq + ug * 128;
    float* skg = sk + ug * 128;
    float* pg = part + ug * 8;
    float* pg2 = part2 + ug * 4;
    const float* kmine = skg + half * 64;
    const float* qmine = sqg + half * 64;
#pragma unroll
    for (int t = 0; t < DS; ++t) {
        const float yA = silu(xA[t] * cA[0] + xA[t + 1] * cA[1] + xA[t + 2] * cA[2] + xA[t + 3] * cA[3]);
        const float yv = silu(xv[t] * cv[0] + xv[t + 1] * cv[1] + xv[t + 2] * cv[2] + xv[t + 3] * cv[3]);
        (half ? skg : sqg)[v] = yA;
        float ssA = yA * yA;
#pragma unroll
        for (int o = 1; o < 32; o <<= 1) ssA += __shfl_xor(ssA, o);
        if ((lane & 31) == 0) pg[wq * 2 + half] = ssA;
        __syncthreads();
        const float qn = rsqrtf((pg[0] + pg[2]) + (pg[4] + pg[6]) + 1e-6f) * 0.08838834764831845f;
        const float kn = rsqrtf((pg[1] + pg[3]) + (pg[5] + pg[7]) + 1e-6f);
        const float* bap = p.ba + (row0 + t) * 32;
        const float beta = 1.f / (1.f + __expf(-bap[h]));
        const float aa = bap[16 + h] + dtb;
        const float sp = (aa > 20.f) ? aa : log1pf(__expf(aa));
        const float dec = __expf(-Aexp * sp);
        float kS0 = 0.f, kS1 = 0.f;
#pragma unroll
        for (int k = 0; k < 64; k += 4) {
            const f32x4 kk = *(const f32x4*)(kmine + k);
            S[k] *= dec; S[k + 1] *= dec; S[k + 2] *= dec; S[k + 3] *= dec;
            kS0 += kk[0] * S[k]; kS1 += kk[1] * S[k + 1]; kS0 += kk[2] * S[k + 2]; kS1 += kk[3] * S[k + 3];
        }
        float kS = kS0 + kS1;
        kS += __shfl_xor(kS, 32);
        const float delta = (yv - kS * kn) * beta * kn;
        float o0 = 0.f, o1 = 0.f;
#pragma unroll
        for (int k = 0; k < 64; k += 4) {
            const f32x4 kk = *(const f32x4*)(kmine + k);
            const f32x4 qq = *(const f32x4*)(qmine + k);
            S[k] += kk[0] * delta; S[k + 1] += kk[1] * delta; S[k + 2] += kk[2] * delta; S[k + 3] += kk[3] * delta;
            o0 += qq[0] * S[k]; o1 += qq[1] * S[k + 1]; o0 += qq[2] * S[k + 2]; o1 += qq[3] * S[k + 3];
        }
        float o = o0 + o1;
        o = (o + __shfl_xor(o, 32)) * qn;
        float s3 = o * o;
#pragma unroll
        for (int x = 1; x < 32; x <<= 1) s3 += __shfl_xor(s3, x);
        if (lane == 0) pg2[wq] = s3;
        __syncthreads();
        if (half == 0) {
            const float rms = rsqrtf(((pg2[0] + pg2[1]) + (pg2[2] + pg2[3])) * (1.f / 128.f) + 1e-6f);
            const float zz = bf2f(p.z[(row0 + t) * 2048 + h * 128 + v]);
            p.gated[(row0 + t) * 2048 + h * 128 + v] = f2bf(o * rms * nw * silu(zz));
        }
    }
    {
        float* So = p.gs_sample + ((size_t)(b * 16 + h) * 128 + half * 64) * 128 + v;
#pragma unroll
        for (int k = 0; k < 64; ++k) So[(size_t)k * 128] = S[k];
    }
    __syncthreads();
}

#define MFMA32(a, b, c) __builtin_amdgcn_mfma_f32_32x32x16_bf16((a), (b), (c), 0, 0, 0)
constexpr int NCH = 65;
constexpr int NCU = BATCH * 16 * NCH;
__device__ __forceinline__ int crow(int reg, int hh) { return (reg & 3) + 8 * (reg >> 2) + 4 * hh; }
__device__ __forceinline__ bf16x8 pack_step(const f32x16& x, int s) {
    u32x4 q;
    q[0] = pk2(x[8 * s + 0], x[8 * s + 1]); q[1] = pk2(x[8 * s + 2], x[8 * s + 3]);
    q[2] = pk2(x[8 * s + 4], x[8 * s + 5]); q[3] = pk2(x[8 * s + 6], x[8 * s + 7]);
    return __builtin_bit_cast(bf16x8, q);
}
__device__ __forceinline__ bf16x8 frag_perm(const bf16_t* p0) {
    const uint2 lo = *(const uint2*)p0, hi = *(const uint2*)(p0 + 8);
    u32x4 q; q[0] = lo.x; q[1] = lo.y; q[2] = hi.x; q[3] = hi.y;
    return __builtin_bit_cast(bf16x8, q);
}

__device__ __forceinline__ void gdn_stageA(const Params& p, char* smem0, int bid, int nb) {
    const int tid = tid_opaque(), lane = tid & 63, wave = tid >> 6;
    for (int idx = bid * NTHR + tid; idx < (BATCH + DB) * 3 * 4096; idx += nb * NTHR) {
        const int c = idx & 4095, r = (idx >> 12) % 3, b = idx / (3 * 4096);
        if (b < BATCH) p.gc_prompt[idx] = bf2f(p.mixed[((size_t)b * LP + (LP - 3) + r) * 4096 + c]);
        else { const int bs = b - BATCH; p.gc_sample[(size_t)(bs * 3 + r) * 4096 + c] = bf2f(p.mixed[((size_t)NPR + bs * 4 + 1 + r) * 4096 + c]); }
    }
    for (int u = bid; u < NCU; u += nb) {
        unsigned zofs = 0; asm volatile("" : "+v"(zofs));
        char* smem = smem0 + zofs;
        bf16_t* Qb = (bf16_t*)smem;
        bf16_t* Kb = Qb + 64 * 136;
        float* RHS = (float*)(Kb + 64 * 136);
        float* Am = RHS + 64 * 256;
        float* sbeta = Am + 64 * 68;
        float* sgc = sbeta + 64;
        float* segc = sgc + 64;
        float* sekd = segc + 64;
        float* srk = sekd + 64;
        const int h = u & 15, n = (u >> 4) % NCH, b = u / (16 * NCH);
        const int kh = h >> 1;
        const size_t su = (size_t)((b * 16 + h) * NCH + n);
        const int t0 = n * 64;
        if (wave < 6) {
            const int part = wave >> 1, half = wave & 1;
            const int cq = lane & 31, tsub = lane >> 5;
            const int tl0 = 32 * half + 16 * tsub;
            const int chb = ((part == 0) ? (kh * 128) : (part == 1) ? (1024 + kh * 128) : (2048 + h * 128)) + cq * 4;
            f32x4 cw[4];
#pragma unroll
            for (int j = 0; j < 4; ++j) cw[j] = *(const f32x4*)(p.gdn_conv_w + j * 4096 + chb);
            uint2 xr[19];
#pragma unroll
            for (int i = 0; i < 19; ++i) {
                const int t = t0 + tl0 - 3 + i;
                if (t >= 0 && t < LP) xr[i] = *(const uint2*)(p.mixed + ((size_t)b * LP + t) * 4096 + chb);
                else xr[i] = make_uint2(0u, 0u);
            }
#pragma unroll
            for (int hb = 0; hb < 2; ++hb) {
                f32x4 yv[8];
                float ssv[8];
#pragma unroll
                for (int i8 = 0; i8 < 8; ++i8) {
                    const int i = hb * 8 + i8;
                    const f32x4 a = cvt_bf16x4(xr[i]) * cw[0] + cvt_bf16x4(xr[i + 1]) * cw[1] + cvt_bf16x4(xr[i + 2]) * cw[2] + cvt_bf16x4(xr[i + 3]) * cw[3];
                    const bool valid = (t0 + tl0 + i) < LP;
#pragma unroll
                    for (int e2 = 0; e2 < 4; ++e2) yv[i8][e2] = valid ? silu(a[e2]) : 0.f;
                    ssv[i8] = (yv[i8][0] * yv[i8][0] + yv[i8][1] * yv[i8][1]) + (yv[i8][2] * yv[i8][2] + yv[i8][3] * yv[i8][3]);
                }
                if (part < 2) {
#pragma unroll
                    for (int o = 1; o < 32; o <<= 1)
#pragma unroll
                        for (int i8 = 0; i8 < 8; ++i8) ssv[i8] += __shfl_xor(ssv[i8], o);
                }
#pragma unroll
                for (int i8 = 0; i8 < 8; ++i8) {
                    const int c = tl0 + hb * 8 + i8;
                    f32x4 y = yv[i8];
                    if (part < 2) {
                        const float nrm = rsqrtf(ssv[i8] + 1e-6f) * ((part == 0) ? 0.08838834764831845f : 1.f);
                        y = y * nrm;
                        if (part == 0) st_bf16x4(Qb + c * 136 + cq * 4, y);
                        else { st_bf16x4(Kb + c * 136 + cq * 4, y); *(f32x4*)(RHS + c * 256 + 128 + cq * 4) = y; }
                    } else {
                        *(f32x4*)(RHS + c * 256 + cq * 4) = y;
                    }
                }
            }
        } else if (wave == 6) {
            const int c = lane, t = t0 + c;
            float beta = 0.f, g = 0.f;
            if (t < LP) {
                const float* bap = p.ba + ((size_t)b * LP + t) * 32;
                beta = 1.f / (1.f + __expf(-bap[h]));
                const float aa = bap[16 + h] + p.gdn_dt_bias[h];
                const float sp = (aa > 20.f) ? aa : log1pf(__expf(aa));
                g = -__expf(p.gdn_a_log[h]) * sp;
            }
            float gc = g;
#pragma unroll
            for (int o = 1; o < 64; o <<= 1) { const float v = __shfl_up(gc, o); if (lane >= o) gc += v; }
            const float glast = __shfl(gc, 63);
            sbeta[c] = beta; sgc[c] = gc; segc[c] = __expf(gc); sekd[c] = __expf(glast - gc); srk[c] = beta * __expf(gc);
            if (lane == 0) p.g_dec[su] = __expf(glast);
        }
        __syncthreads();
        {
            const int which = wave >> 2, ti = (wave >> 1) & 1, tj = wave & 1;
            const int r = lane & 31, hh = lane >> 5;
            f32x16 acc;
#pragma unroll
            for (int i = 0; i < 16; ++i) acc[i] = 0.f;
            const bf16_t* Ap = Kb + (32 * ti + r) * 136 + 8 * hh;
            const bf16_t* Bp = (which ? Qb : Kb) + (32 * tj + r) * 136 + 8 * hh;
#pragma unroll
            for (int ks = 0; ks < 8; ++ks) acc = MFMA32(*(const bf16x8*)(Ap + 16 * ks), *(const bf16x8*)(Bp + 16 * ks), acc);
            const int c = 32 * tj + r;
            const float gcc = sgc[c], bc = sbeta[c];
            if (which == 0) {
#pragma unroll
                for (int reg = 0; reg < 16; ++reg) {
                    const int cp = 32 * ti + crow(reg, hh);
                    const float dcy = __expf(fminf(gcc - sgc[cp], 0.f));
                    Am[c * 68 + cp] = (cp < c) ? (bc * acc[reg] * dcy) : 0.f;
                }
            } else {
                bf16_t* aq = p.g_aqk + su * 4096 + (size_t)c * 64;
#pragma unroll
                for (int g4 = 0; g4 < 4; ++g4) {
                    const int cp0 = 32 * ti + 8 * g4 + 4 * hh;
                    f32x4 v;
#pragma unroll
                    for (int e2 = 0; e2 < 4; ++e2) {
                        const int cp = cp0 + e2;
                        const float dcy = __expf(fminf(gcc - sgc[cp], 0.f));
                        v[e2] = (cp <= c) ? (acc[4 * g4 + e2] * dcy) : 0.f;
                    }
                    st_bf16x4(aq + cp0, v);
                }
            }
        }
        __syncthreads();
        if (wave < 4) {
            const int col = 64 * wave + lane;
            const float* rs = sbeta + __builtin_amdgcn_readfirstlane((wave < 2) ? 0 : 256);
            float x[64];
#pragma unroll
            for (int i = 0; i < 64; ++i) x[i] = RHS[i * 256 + col] * rs[i];
#pragma unroll
            for (int i0 = 0; i0 < 64; i0 += 4) {
                float a0 = x[i0], a1 = x[i0 + 1], a2 = x[i0 + 2], a3 = x[i0 + 3];
#pragma unroll
                for (int j4 = 0; j4 < i0; j4 += 4) {
                    const f32x4 r0 = *(const f32x4*)(Am + (i0) * 68 + j4), r1 = *(const f32x4*)(Am + (i0 + 1) * 68 + j4);
                    const f32x4 r2 = *(const f32x4*)(Am + (i0 + 2) * 68 + j4), r3 = *(const f32x4*)(Am + (i0 + 3) * 68 + j4);
                    a0 -= r0[0] * x[j4]; a1 -= r1[0] * x[j4]; a2 -= r2[0] * x[j4]; a3 -= r3[0] * x[j4];
                    a0 -= r0[1] * x[j4 + 1]; a1 -= r1[1] * x[j4 + 1]; a2 -= r2[1] * x[j4 + 1]; a3 -= r3[1] * x[j4 + 1];
                    a0 -= r0[2] * x[j4 + 2]; a1 -= r1[2] * x[j4 + 2]; a2 -= r2[2] * x[j4 + 2]; a3 -= r3[2] * x[j4 + 2];
                    a0 -= r0[3] * x[j4 + 3]; a1 -= r1[3] * x[j4 + 3]; a2 -= r2[3] * x[j4 + 3]; a3 -= r3[3] * x[j4 + 3];
                    if ((j4 & 12) == 12) asm volatile("" ::: "memory");
                }
                const f32x4 t1 = *(const f32x4*)(Am + (i0 + 1) * 68 + i0), t2 = *(const f32x4*)(Am + (i0 + 2) * 68 + i0), t3 = *(const f32x4*)(Am + (i0 + 3) * 68 + i0);
                a1 -= t1[0] * a0;
                a2 -= t2[0] * a0; a2 -= t2[1] * a1;
                a3 -= t3[0] * a0; a3 -= t3[1] * a1; a3 -= t3[2] * a2;
                x[i0] = a0; x[i0 + 1] = a1; x[i0 + 2] = a2; x[i0 + 3] = a3;
                asm volatile("" ::: "memory");
            }
            if (wave < 2) {
                float* up = p.g_u + su * 8192 + col;
#pragma unroll
                for (int i = 0; i < 64; ++i) up[i * 128] = x[i];
            } else {
                bf16_t* wp = p.g_negw + su * 8192 + (col - 128);
#pragma unroll
                for (int i = 0; i < 64; ++i) wp[i * 128] = f2bf(-x[i]);
            }
        } else {
            const int t2 = tid - 256;
#pragma unroll
            for (int it = 0; it < 4; ++it) {
                const int chk = t2 + 256 * it, c = chk >> 4, d0 = (chk & 15) * 8;
                const float e = segc[c];
                const uint4 raw = *(const uint4*)(Qb + c * 136 + d0);
                uint4 o;
                o.x = pk2(__uint_as_float(raw.x << 16) * e, __uint_as_float(raw.x & 0xffff0000u) * e);
                o.y = pk2(__uint_as_float(raw.y << 16) * e, __uint_as_float(raw.y & 0xffff0000u) * e);
                o.z = pk2(__uint_as_float(raw.z << 16) * e, __uint_as_float(raw.z & 0xffff0000u) * e);
                o.w = pk2(__uint_as_float(raw.w << 16) * e, __uint_as_float(raw.w & 0xffff0000u) * e);
                *(uint4*)(p.g_qg + su * 8192 + c * 128 + d0) = o;
            }
#pragma unroll
            for (int it = 0; it < 4; ++it) {
                const int item = t2 + 256 * it, d = item & 127, c0 = (item >> 7) * 8;
                float v[8];
#pragma unroll
                for (int i = 0; i < 8; ++i) v[i] = bf2f(Kb[(c0 + i) * 136 + d]) * sekd[c0 + i];
                uint4 o; o.x = pk2(v[0], v[1]); o.y = pk2(v[2], v[3]); o.z = pk2(v[4], v[5]); o.w = pk2(v[6], v[7]);
                *(uint4*)(p.g_kdT + su * 8192 + d * 64 + c0) = o;
            }
        }
        __syncthreads();
    }
}

constexpr int GB_NW = 0, GB_QG = 64 * 136, GB_KD = 2 * 64 * 136, GB_AQ = 2 * 64 * 136 + 128 * 72, GB_ELEMS = 2 * 64 * 136 + 128 * 72 + 64 * 72;
__device__ __forceinline__ void gdn_chain(const Params& p, char* smem, int b, int h) {
    bf16_t* lds = (bf16_t*)smem;
    const int tid = tid_opaque(), lane = tid & 63, wave = tid >> 6;
    const int r = lane & 31, hh = lane >> 5;
    const size_t su0 = (size_t)(b * 16 + h) * NCH;
    const bool loader = wave >= 4;
    const int t2 = tid - 256;
    uint4 sa0, sa1, sa2, sa3, sa4, sa5, sa6, sa7, sa8, sa9, sa10, sa11, sa12, sa13;
    uint4 sb0, sb1, sb2, sb3, sb4, sb5, sb6, sb7, sb8, sb9, sb10, sb11, sb12, sb13;
    f32x16 S[4], un0, un1;
#pragma unroll
    for (int i = 0; i < 4; ++i)
#pragma unroll
        for (int j = 0; j < 16; ++j) S[i][j] = 0.f;
    const int ch0 = t2, ch1 = t2 + 256, ch2 = t2 + 512, ch3 = t2 + 768;
#define GB_GLOAD(P, n_) do { const size_t su_ = su0 + (n_); \
        const bf16_t* a_ = p.g_negw + su_ * 8192; const bf16_t* b_ = p.g_qg + su_ * 8192; const bf16_t* c_ = p.g_kdT + su_ * 8192; const bf16_t* d_ = p.g_aqk + su_ * 4096; \
        P##0 = *(const uint4*)(a_ + (size_t)ch0 * 8); P##1 = *(const uint4*)(a_ + (size_t)ch1 * 8); P##2 = *(const uint4*)(a_ + (size_t)ch2 * 8); P##3 = *(const uint4*)(a_ + (size_t)ch3 * 8); \
        P##4 = *(const uint4*)(b_ + (size_t)ch0 * 8); P##5 = *(const uint4*)(b_ + (size_t)ch1 * 8); P##6 = *(const uint4*)(b_ + (size_t)ch2 * 8); P##7 = *(const uint4*)(b_ + (size_t)ch3 * 8); \
        P##8 = *(const uint4*)(c_ + (size_t)ch0 * 8); P##9 = *(const uint4*)(c_ + (size_t)ch1 * 8); P##10 = *(const uint4*)(c_ + (size_t)ch2 * 8); P##11 = *(const uint4*)(c_ + (size_t)ch3 * 8); \
        P##12 = *(const uint4*)(d_ + (size_t)ch0 * 8); P##13 = *(const uint4*)(d_ + (size_t)ch1 * 8); } while (0)
#define GB_SSTORE(P, buf_) do { bf16_t* q_ = (buf_); \
        *(uint4*)(q_ + GB_NW + (ch0 >> 4) * 136 + (ch0 & 15) * 8) = P##0; *(uint4*)(q_ + GB_NW + (ch1 >> 4) * 136 + (ch1 & 15) * 8) = P##1; \
        *(uint4*)(q_ + GB_NW + (ch2 >> 4) * 136 + (ch2 & 15) * 8) = P##2; *(uint4*)(q_ + GB_NW + (ch3 >> 4) * 136 + (ch3 & 15) * 8) = P##3; \
        *(uint4*)(q_ + GB_QG + (ch0 >> 4) * 136 + (ch0 & 15) * 8) = P##4; *(uint4*)(q_ + GB_QG + (ch1 >> 4) * 136 + (ch1 & 15) * 8) = P##5; \
        *(uint4*)(q_ + GB_QG + (ch2 >> 4) * 136 + (ch2 & 15) * 8) = P##6; *(uint4*)(q_ + GB_QG + (ch3 >> 4) * 136 + (ch3 & 15) * 8) = P##7; \
        *(uint4*)(q_ + GB_KD + (ch0 >> 3) * 72 + (ch0 & 7) * 8) = P##8; *(uint4*)(q_ + GB_KD + (ch1 >> 3) * 72 + (ch1 & 7) * 8) = P##9; \
        *(uint4*)(q_ + GB_KD + (ch2 >> 3) * 72 + (ch2 & 7) * 8) = P##10; *(uint4*)(q_ + GB_KD + (ch3 >> 3) * 72 + (ch3 & 7) * 8) = P##11; \
        *(uint4*)(q_ + GB_AQ + (ch0 >> 3) * 72 + (ch0 & 7) * 8) = P##12; *(uint4*)(q_ + GB_AQ + (ch1 >> 3) * 72 + (ch1 & 7) * 8) = P##13; } while (0)
#define GB_ULOAD(n_) do { const float* up_ = p.g_u + (su0 + (n_)) * 8192 + 32 * wave + r; \
        _Pragma("unroll") for (int reg_ = 0; reg_ < 16; ++reg_) { un0[reg_] = up_[(crow(reg_, hh)) * 128]; un1[reg_] = up_[(32 + crow(reg_, hh)) * 128]; } } while (0)
    if (loader) {
        bf16_t* buf0 = lds;
        bf16_t* buf1 = lds + GB_ELEMS;
        GB_GLOAD(sa, 0); GB_SSTORE(sa, buf0);
        GB_GLOAD(sa, 1);
        __syncthreads();
        for (int n = 0; n < NCH; n += 2) {
            if (n + 2 < NCH) { GB_GLOAD(sb, n + 2); }
            if (n + 1 < NCH) { GB_SSTORE(sa, buf1); }
            __syncthreads();
            if (n + 1 >= NCH) break;
            if (n + 3 < NCH) { GB_GLOAD(sa, n + 3); }
            if (n + 2 < NCH) { GB_SSTORE(sb, buf0); }
            __syncthreads();
        }
    } else {
        GB_ULOAD(0);
        float dec_next = p.g_dec[su0];
        __syncthreads();
        for (int n = 0; n < NCH; ++n) {
            unsigned zofs = 0; asm volatile("" : "+v"(zofs));
            bf16_t* cur = lds + (n & 1) * GB_ELEMS + zofs;
            const bool more = (n + 1 < NCH);
            const float dec = dec_next;
            if (more) dec_next = p.g_dec[su0 + n + 1];
            f32x16 vn[2], o[2];
            vn[0] = un0; vn[1] = un1;
#pragma unroll
            for (int j = 0; j < 16; ++j) { o[0][j] = 0.f; o[1][j] = 0.f; }
            if (more) { GB_ULOAD(n + 1); }
#pragma unroll
            for (int kt = 0; kt < 4; ++kt)
#pragma unroll
                for (int s = 0; s < 2; ++s) {
                    const bf16x8 sb = pack_step(S[kt], s);
                    const int k0 = 32 * kt + 16 * s + 4 * hh;
#pragma unroll
                    for (int ct = 0; ct < 2; ++ct) {
                        vn[ct] = MFMA32(frag_perm(cur + GB_NW + (32 * ct + r) * 136 + k0), sb, vn[ct]);
                        o[ct] = MFMA32(frag_perm(cur + GB_QG + (32 * ct + r) * 136 + k0), sb, o[ct]);
                    }
                }
            bf16x8 vb[2][2];
#pragma unroll
            for (int ct = 0; ct < 2; ++ct)
#pragma unroll
                for (int s = 0; s < 2; ++s) vb[ct][s] = pack_step(vn[ct], s);
#pragma unroll
            for (int s = 0; s < 2; ++s) {
                o[0] = MFMA32(frag_perm(cur + GB_AQ + (r) * 72 + 16 * s + 4 * hh), vb[0][s], o[0]);
                o[1] = MFMA32(frag_perm(cur + GB_AQ + (32 + r) * 72 + 16 * s + 4 * hh), vb[0][s], o[1]);
                o[1] = MFMA32(frag_perm(cur + GB_AQ + (32 + r) * 72 + 32 + 16 * s + 4 * hh), vb[1][s], o[1]);
            }
#pragma unroll
            for (int dt = 0; dt < 4; ++dt) {
                S[dt] = S[dt] * dec;
#pragma unroll
                for (int ckt = 0; ckt < 2; ++ckt)
#pragma unroll
                    for (int s = 0; s < 2; ++s)
                        S[dt] = MFMA32(frag_perm(cur + GB_KD + (32 * dt + r) * 72 + 32 * ckt + 16 * s + 4 * hh), vb[ckt][s], S[dt]);
            }
#pragma unroll
            for (int ct = 0; ct < 2; ++ct)
#pragma unroll
                for (int reg = 0; reg < 16; ++reg) {
                    const int t = 64 * n + 32 * ct + crow(reg, hh);
                    if (t < LP) p.g_o[(((size_t)b * LP + t) * 16 + h) * 128 + 32 * wave + r] = f2bf(o[ct][reg]);
                }
            __syncthreads();
        }
    }
    if (!loader) {
#pragma unroll
        for (int dt = 0; dt < 4; ++dt)
#pragma unroll
            for (int reg = 0; reg < 16; ++reg)
                p.gs_prompt[((size_t)(b * 16 + h) * 128 + 32 * dt + crow(reg, hh)) * 128 + 32 * wave + r] = S[dt][reg];
    }
    __syncthreads();
}

__device__ __forceinline__ void gdn_seq_phase(const Params& p, char* smem, int bid, int nb, int rep = 0) {
    if (bid < 64) gdn_chain(p, smem, bid >> 4, bid & 15);
    int* slot = (int*)(smem + LDS_BYTES - 32);
    const int tid = tid_opaque();
    for (;;) {
        if (threadIdx.x == 0) *slot = (int)atomicAdd(p.bar + 3520 + 16 * rep, 1u);
        __syncthreads();
        const int u = *slot;
        __syncthreads();
        if (u >= DB * 16 / 2) break;
        gdn_sample_pass(p, smem, u, tid_opaque());
    }
}

__device__ __forceinline__ void gdn_gate_phase(const Params& p, int bid, int nb) {
    const int tid_ = tid_opaque(); const int lane = tid_ & 63, wave = tid_ >> 6;
    const int sub = lane >> 4, l16 = lane & 15;
    f32x4 nw0 = *(const f32x4*)(p.gdn_norm_w + l16 * 8), nw1 = *(const f32x4*)(p.gdn_norm_w + l16 * 8 + 4);
    for (int it4 = bid * 8 + wave; it4 < NPR * 4; it4 += nb * 8) {
        const size_t off = ((size_t)it4 * 4 + sub) * 128 + l16 * 8;
        const uint4 ov = *(const uint4*)(p.g_o + off);
        const uint4 zv = *(const uint4*)(p.z + off);
        const f32x4 o0 = cvt_bf16x4(make_uint2(ov.x, ov.y)), o1 = cvt_bf16x4(make_uint2(ov.z, ov.w));
        const f32x4 z0 = cvt_bf16x4(make_uint2(zv.x, zv.y)), z1 = cvt_bf16x4(make_uint2(zv.z, zv.w));
        float ss = ((o0[0] * o0[0] + o0[1] * o0[1]) + (o0[2] * o0[2] + o0[3] * o0[3])) + ((o1[0] * o1[0] + o1[1] * o1[1]) + (o1[2] * o1[2] + o1[3] * o1[3]));
#pragma unroll
        for (int x = 1; x < 16; x <<= 1) ss += __shfl_xor(ss, x);
        const float rms = rsqrtf(ss * (1.f / 128.f) + 1e-6f);
        uint4 g;
        g.x = pk2(o0[0] * rms * nw0[0] * silu(z0[0]), o0[1] * rms * nw0[1] * silu(z0[1]));
        g.y = pk2(o0[2] * rms * nw0[2] * silu(z0[2]), o0[3] * rms * nw0[3] * silu(z0[3]));
        g.z = pk2(o1[0] * rms * nw1[0] * silu(z1[0]), o1[1] * rms * nw1[1] * silu(z1[1]));
        g.w = pk2(o1[2] * rms * nw1[2] * silu(z1[2]), o1[3] * rms * nw1[3] * silu(z1[3]));
        *(uint4*)(p.gated + off) = g;
    }
}

__device__ __forceinline__ void rope4(const float* tab, int fi, f32x4 x, f32x4 partner, bool first, f32x4& o) {
    const f32x4 t0 = *(const f32x4*)(tab + fi * 2), t1 = *(const f32x4*)(tab + fi * 2 + 4);
    const float sg = first ? -1.f : 1.f;
    o[0] = x[0] * t0[0] + sg * partner[0] * t0[1];
    o[1] = x[1] * t0[2] + sg * partner[1] * t0[3];
    o[2] = x[2] * t1[0] + sg * partner[2] * t1[1];
    o[3] = x[3] * t1[2] + sg * partner[3] * t1[3];
}
__device__ __forceinline__ void dsa_post_phase(const Params& p, char* smem, int bid, int nb) {
    bf16_t* vt = (bf16_t*)smem;
    for (int u = bid; u < BATCH * 65 + 8; u += nb) {
        const int tid = tid_opaque(); const int lane = tid & 63, wave = tid >> 6;
        const bool prompt = u < BATCH * 65;
        const int b = prompt ? (u / 65) : 0, t0 = prompt ? (u % 65) * 64 : 0;
        for (int r8 = 0; r8 < 8; ++r8) {
            const int tl = wave * 8 + r8;
            const int t = t0 + tl;
            const bool rvalid = prompt ? (t < LP) : true;
            const int row = prompt ? (b * LP + t) : (NPR + (u - BATCH * 65) * 64 + tl);
            if (!rvalid) {
                for (int e = lane; e < 256; e += 64) vt[e * 72 + tl] = 0;
                continue;
            }
            const float* P = p.p1 + (size_t)row * DIN_PAD;
            const int pos = prompt ? t : (PAST + ((row - NPR) & 3));
            const float* tab = p.rope_tab + (size_t)pos * 48;
            float* kout = prompt ? (p.k_prompt + (size_t)row * 256) : (p.k_sample + (size_t)(row - NPR) * 256);
            float* vout = prompt ? (p.v_prompt + (size_t)row * 256) : (p.v_sample + (size_t)(row - NPR) * 256);
#pragma unroll
            for (int j = 0; j < 5; ++j) {
                const int e0 = (lane + 64 * j) * 4, d0 = e0 & 127;
                f32x4 x = *(const f32x4*)(P + e0);
                if (d0 < 32) {
                    const bool first = d0 < 16;
                    const f32x4 pr = *(const f32x4*)(P + (first ? e0 + 16 : e0 - 16));
                    rope4(tab, d0 & 15, x, pr, first, x);
                }
                if (j < 4) {
                    if (prompt) st_bf16x4(p.q_b + (size_t)row * 1024 + e0, x * 0.12751743f);
                    else *(f32x4*)(p.qr + (size_t)row * 1024 + e0) = x;
                } else {
                    const int ek = e0 - 1024;
                    *(f32x4*)(kout + ek) = x;
                    if (prompt) st_bf16x4(p.k_b + ((size_t)(b * 2 + (ek >> 7)) * LPAD + t) * 128 + d0, x);
                }
            }
            {
                const int e0 = lane * 4;
                const f32x4 x = *(const f32x4*)(P + 1280 + e0);
                *(f32x4*)(vout + e0) = x;
                if (prompt) {
#pragma unroll
                    for (int i = 0; i < 4; ++i) vt[(e0 + i) * 72 + tl] = f2bf(x[i]);
                }
            }
#pragma unroll
            for (int j = 0; j < 2; ++j) {
                const int e0 = (lane + 64 * j) * 4, d0 = e0 & 63;
                f32x4 x = *(const f32x4*)(P + 1536 + e0);
                if (d0 < 16) {
                    const bool first = d0 < 8;
                    const f32x4 pr = *(const f32x4*)(P + 1536 + (first ? e0 + 8 : e0 - 8));
                    rope4(tab, 16 + (d0 & 7), x, pr, first, x);
                }
                if (prompt) st_bf16x4(p.iq_b + (size_t)row * 512 + e0, x);
                else *(f32x4*)(p.iq + (size_t)row * 512 + e0) = x;
            }
            {
                const float x = P[2048 + lane];
                const float mu = wave_sum(x) * (1.f / 64.f);
                const float dv = x - mu;
                const float var = wave_sum(dv * dv) * (1.f / 64.f);
                const float xn = dv * rsqrtf(var + 1e-5f) * p.dsa_ik_g[lane] + p.dsa_ik_b[lane];
                const float other = __shfl_xor(xn, 8);
                float o = xn;
                if (lane < 16) {
                    const float c = tab[(16 + (lane & 7)) * 2], s = tab[(16 + (lane & 7)) * 2 + 1];
                    if (lane < 8) o = xn * c - other * s; else o = xn * c + other * s;
                }
                float* io = prompt ? (p.ik_prompt + (size_t)row * 64) : (p.ik_sample + (size_t)(row - NPR) * 64);
                io[lane] = o;
                if (prompt) p.ik_b[((size_t)b * LPAD + t) * 64 + lane] = f2bf(o);
            }
            if (lane < 8) p.iw[(size_t)row * 8 + lane] = P[2112 + lane] * 0.35355339059327373f;
        }
        __syncthreads();
        if (prompt) {
#pragma unroll
            for (int i = 0; i < 4; ++i) {
                const int ch = tid + 512 * i, rr = ch >> 3, c8 = (ch & 7) * 8;
                const uint4 v = *(const uint4*)(vt + rr * 72 + c8);
                *(uint4*)(p.vt_b + ((size_t)(b * 2 + (rr >> 7)) * 128 + (rr & 127)) * LPAD + t0 + c8) = v;
            }
        }
        __syncthreads();
    }
    for (int idx = bid * NTHR + tid_opaque(); idx < BATCH * (LPAD - LP) * 256; idx += nb * NTHR) {
        const int c = idx & 255, tp = (idx >> 8) % (LPAD - LP), bb = idx / ((LPAD - LP) * 256);
        const int t = LP + tp, kvh = c >> 7, d = c & 127;
        p.k_b[((size_t)(bb * 2 + kvh) * LPAD + t) * 128 + d] = 0;
        if (c < 64) p.ik_b[((size_t)bb * LPAD + t) * 64 + c] = 0;
        if (c < 65) p.maskT[((size_t)bb * 65 + c) * LPAD + t] = (c == 0) ? 1ull : 0ull;
    }
}

__device__ __forceinline__ const float* ik_row(const Params& p, bool prompt, int b, int s) {
    if (prompt) return p.ik_prompt + ((size_t)b * LP + s) * 64;
    if (s < PAST) { const int pg = p.page_table[b * 16 + (s >> 7)]; return p.cache_ik + ((size_t)pg * 128 + (s & 127)) * 64; }
    return p.ik_sample + ((size_t)b * DS + (s - PAST)) * 64;
}
__device__ __forceinline__ const float* kv_row(const float* own_p, const float* own_s, const float* cache, const int* page_table,
                                               bool prompt, int b, int s) {
    if (prompt) return own_p + ((size_t)b * LP + s) * 256;
    if (s < PAST) { const int pg = page_table[b * 16 + (s >> 7)]; return cache + ((size_t)pg * 128 + (s & 127)) * 256; }
    return own_s + ((size_t)b * DS + (s - PAST)) * 256;
}

template <bool PROMPT, int NREG>
__device__ __forceinline__ void select_emit(const float* sc, int qpos, int lane, unsigned long long* maskcol, int* selrow) {
    const unsigned long long ltmask = (1ull << lane) - 1ull;
    unsigned key[NREG];
    unsigned kmax = 0u, kmin = 0xffffffffu;
#pragma unroll
    for (int j = 0; j < NREG; ++j) {
        const int s = j * 64 + lane;
        const bool cand = (s >= 16 && s <= qpos);
        const float x = cand ? sc[s] : -INFINITY;
        const unsigned u = __float_as_uint(x);
        key[j] = (u & 0x80000000u) ? ~u : (u | 0x80000000u);
        kmax = max(kmax, key[j]);
        kmin = min(kmin, cand ? key[j] : 0xffffffffu);
    }
#pragma unroll
    for (int o = 1; o < 64; o <<= 1) { kmax = max(kmax, (unsigned)__shfl_xor((int)kmax, o)); kmin = min(kmin, (unsigned)__shfl_xor((int)kmin, o)); }
    unsigned lo = kmin, hi = kmax;
    bool exact = false;
    while (lo < hi) {
        const unsigned mid = lo + ((hi - lo) >> 1) + ((hi - lo) & 1u);
        int c = 0;
#pragma unroll
        for (int j = 0; j < NREG; ++j) c += __popcll(__ballot(key[j] >= mid));
        if (c >= 240) { lo = mid; if (c == 240) { exact = true; break; } } else hi = mid - 1u;
    }
    const unsigned T = lo;
    if (!PROMPT) { if (lane < 16) selrow[lane] = lane; }
    int base = 16;
    unsigned long long myword = 0ull, word64 = 0ull;
    if (exact) {
#pragma unroll
        for (int j = 0; j < NREG; ++j) {
            const bool take = key[j] >= T;
            unsigned long long m = __ballot(take);
            if (PROMPT) {
                if (j == 0) m |= 0xFFFFull;
                if (j < 64) { if (lane == j) myword = m; } else word64 = m;
            } else {
                if (take) selrow[base + __popcll(m & ltmask)] = j * 64 + lane;
                base += __popcll(m);
            }
        }
    } else {
        int cgt = 0;
#pragma unroll
        for (int j = 0; j < NREG; ++j) cgt += __popcll(__ballot(key[j] > T));
        const int need_eq = 240 - cgt;
        int erun = 0;
#pragma unroll
        for (int j = 0; j < NREG; ++j) {
            const bool gt = key[j] > T, eq = key[j] == T;
            const unsigned long long meq = __ballot(eq);
            const int rank = erun + __popcll(meq & ltmask);
            const bool take = gt || (eq && rank < need_eq);
            unsigned long long m = __ballot(take);
            if (PROMPT) {
                if (j == 0) m |= 0xFFFFull;
                if (j < 64) { if (lane == j) myword = m; } else word64 = m;
            } else {
                if (take) selrow[base + __popcll(m & ltmask)] = j * 64 + lane;
                base += __popcll(m);
            }
            erun += __popcll(meq);
        }
    }
    if (PROMPT) {
        if (NREG == 65) { maskcol[(size_t)lane * LPAD] = myword; if (lane == 0) maskcol[(size_t)64 * LPAD] = word64; }
        else { if (lane < NREG) maskcol[(size_t)lane * LPAD] = myword; else if (lane < 64) maskcol[(size_t)lane * LPAD] = 0ull; if (lane == 0) maskcol[(size_t)64 * LPAD] = 0ull; }
    }
}

__device__ __forceinline__ bf16x8 ld_f32x8_bf16(const float* p) {
    const f32x4 a = *(const f32x4*)p, b = *(const f32x4*)(p + 4);
    u32x4 q; q[0] = pk2(a[0], a[1]); q[1] = pk2(a[2], a[3]); q[2] = pk2(b[0], b[1]); q[3] = pk2(b[2], b[3]);
    return __builtin_bit_cast(bf16x8, q);
}
__device__ __forceinline__ void indexer_sample_unit(const Params& p, float* sc, int b, int tid) {
    const int lane = tid & 63, wave = tid >> 6;
    const int r = lane & 31, hh = lane >> 5;
    bf16x8 af[4];
    {
        const int e2 = r & 3, hb = (r >> 2) & 1, a = r >> 3;
        const int qi = 2 * hb + (a >> 1), head = 4 * (a & 1) + e2;
        const float* ap = p.iq + ((size_t)NPR + b * 4 + qi) * 512 + head * 64 + 8 * hh;
#pragma unroll
        for (int ks = 0; ks < 4; ++ks) af[ks] = ld_f32x8_bf16(ap + 16 * ks);
    }
    float wq[2][8];
#pragma unroll
    for (int ql = 0; ql < 2; ++ql) {
        const float* wp = p.iw + ((size_t)NPR + b * 4 + 2 * hh + ql) * 8;
        const f32x4 w0 = *(const f32x4*)wp, w1 = *(const f32x4*)(wp + 4);
#pragma unroll
        for (int e2 = 0; e2 < 4; ++e2) { wq[ql][e2] = w0[e2]; wq[ql][4 + e2] = w1[e2]; }
    }
    for (int kt = wave; kt < 65; kt += 8) {
        const int s = 32 * kt + r;
        const float* kp;
        if (s < PAST) { const int pg = p.page_table[b * 16 + (s >> 7)]; kp = p.cache_ik + ((size_t)pg * 128 + (s & 127)) * 64; }
        else kp = p.ik_sample + ((size_t)b * DS + ((s - PAST) & 3)) * 64;
        kp += 8 * hh;
        f32x16 acc;
#pragma unroll
        for (int i = 0; i < 16; ++i) acc[i] = 0.f;
        bf16x8 bq[4];
#pragma unroll
        for (int ks = 0; ks < 4; ++ks) bq[ks] = ld_f32x8_bf16(kp + 16 * ks);
#pragma unroll
        for (int ks = 0; ks < 4; ++ks) acc = MFMA32(af[ks], bq[ks], acc);
#pragma unroll
        for (int ql = 0; ql < 2; ++ql) {
            float v = 0.f;
#pragma unroll
            for (int a2 = 0; a2 < 2; ++a2)
#pragma unroll
                for (int e2 = 0; e2 < 4; ++e2) v += wq[ql][4 * a2 + e2] * fmaxf(acc[4 * (2 * ql + a2) + e2], 0.f);
            sc[(2 * hh + ql) * 2112 + s] = v;
        }
    }
    __syncthreads();
    if (wave < 4) select_emit<false, 33>(sc + wave * 2112, PAST + wave, lane, nullptr, p.sel + ((size_t)NPR + b * 4 + wave) * 256);
    __syncthreads();
}

__device__ __forceinline__ void indexer_prompt_unit(const Params& p, float* sc, int b, int g8, int tid) {
    const int lane = tid & 63, wave = tid >> 6;
    const int r = lane & 31, hh = lane >> 5;
    const int t0 = g8 * 8;
    if (t0 < 256) {
        const int qpos = t0 + wave;
        unsigned long long* maskcol = p.maskT + (size_t)b * 65 * LPAD + qpos;
        for (int j = lane; j < 65; j += 64) {
            const int lo = j * 64;
            unsigned long long m = 0ull;
            if (qpos >= lo + 63) m = ~0ull; else if (qpos >= lo) m = (1ull << (qpos - lo + 1)) - 1ull;
            maskcol[(size_t)j * LPAD] = m;
        }
        return;
    }
    bf16x8 af[2][4];
    {
        const int e2 = r & 3, hb = (r >> 2) & 1, a = r >> 3;
        const int qi = 2 * hb + (a >> 1), head = 4 * (a & 1) + e2;
#pragma unroll
        for (int rt = 0; rt < 2; ++rt) {
            const bf16_t* ap = p.iq_b + ((size_t)b * LP + t0 + 4 * rt + qi) * 512 + head * 64 + 8 * hh;
#pragma unroll
            for (int ks = 0; ks < 4; ++ks) af[rt][ks] = *(const bf16x8*)(ap + 16 * ks);
        }
    }
    float wq[2][2][8];
#pragma unroll
    for (int rt = 0; rt < 2; ++rt)
#pragma unroll
        for (int ql = 0; ql < 2; ++ql) {
            const float* wp = p.iw + ((size_t)b * LP + t0 + 4 * rt + 2 * hh + ql) * 8;
            const f32x4 w0 = *(const f32x4*)wp, w1 = *(const f32x4*)(wp + 4);
#pragma unroll
            for (int e2 = 0; e2 < 4; ++e2) { wq[rt][ql][e2] = w0[e2]; wq[rt][ql][4 + e2] = w1[e2]; }
        }
    const int nkt = (t0 + 7) / 32 + 1;
    const bf16_t* kbase = p.ik_b + ((size_t)b * LPAD + r) * 64 + 8 * hh;
    bf16x8 bq[4];
    if (wave < nkt) {
#pragma unroll
        for (int ks = 0; ks < 4; ++ks) bq[ks] = *(const bf16x8*)(kbase + (size_t)wave * 32 * 64 + 16 * ks);
    }
    for (int kt = wave; kt < nkt; kt += 8) {
        bf16x8 bn[4];
        const int ktn = (kt + 8 < nkt) ? (kt + 8) : kt;
#pragma unroll
        for (int ks = 0; ks < 4; ++ks) bn[ks] = *(const bf16x8*)(kbase + (size_t)ktn * 32 * 64 + 16 * ks);
#pragma unroll
        for (int rt = 0; rt < 2; ++rt) {
            f32x16 acc;
#pragma unroll
            for (int i = 0; i < 16; ++i) acc[i] = 0.f;
#pragma unroll
            for (int ks = 0; ks < 4; ++ks) acc = MFMA32(af[rt][ks], bq[ks], acc);
#pragma unroll
            for (int ql = 0; ql < 2; ++ql) {
                float s = 0.f;
#pragma unroll
                for (int a2 = 0; a2 < 2; ++a2)
#pragma unroll
                    for (int e2 = 0; e2 < 4; ++e2) s += wq[rt][ql][4 * a2 + e2] * fmaxf(acc[4 * (2 * ql + a2) + e2], 0.f);
                sc[(4 * rt + 2 * hh + ql) * 4160 + 32 * kt + r] = s;
            }
        }
#pragma unroll
        for (int ks = 0; ks < 4; ++ks) bq[ks] = bn[ks];
    }
    __syncthreads();
    {
        const int qpos = t0 + wave;
        if (t0 + 7 < 33 * 64) select_emit<true, 33>(sc + wave * 4160, qpos, lane, p.maskT + (size_t)b * 65 * LPAD + qpos, nullptr);
        else select_emit<true, 65>(sc + wave * 4160, qpos, lane, p.maskT + (size_t)b * 65 * LPAD + qpos, nullptr);
    }
    __syncthreads();
}

__device__ __forceinline__ void indexer_phase(const Params& p, char* smem, int bid, int nb, int rep = 0) {
    int* slot = (int*)(smem + LDS_BYTES - 32);
    for (;;) {
        const int tid = tid_opaque();
        unsigned zofs = 0; asm volatile("" : "+v"(zofs));
        float* sc = (float*)(smem + zofs);
        if (threadIdx.x == 0) *slot = (int)atomicAdd(p.bar + 3648 + 16 * rep, 1u);
        __syncthreads();
        const int u = *slot;
        __syncthreads();
        if (u >= DB + BATCH * 514) break;
        if (u < DB) {
            indexer_sample_unit(p, sc, u, tid);
        } else {
            const int v = u - DB;
            indexer_prompt_unit(p, sc, v & 3, 513 - (v >> 2), tid);
        }
    }
}

__device__ __forceinline__ void attn_sample_query(const Params& p, char* smem, int row) {
    float* qs = (float*)smem;
    float* ps = qs + 1024;
    const float** kptr = (const float**)(ps + 2048);
    const float** vptr = kptr + 256;
    float* red = (float*)(vptr + 256);
    const int tid = tid_opaque(), lane = tid & 63, wave = tid >> 6;
    const int b = (row - NPR) >> 2;
    qs[tid] = p.qr[(size_t)row * 1024 + tid];
    qs[tid + 512] = p.qr[(size_t)row * 1024 + 512 + tid];
    if (tid < 256) {
        const int s = p.sel[(size_t)row * 256 + tid];
        const float *kp, *vp;
        if (s < PAST) { const int pg = p.page_table[b * 16 + ((s < 0 ? 0 : s) >> 7)]; const size_t ro = ((size_t)pg * 128 + ((s < 0 ? 0 : s) & 127)) * 256; kp = p.cache_k + ro; vp = p.cache_v + ro; }
        else { const size_t ro = ((size_t)b * DS + (s - PAST)) * 256; kp = p.k_sample + ro; vp = p.v_sample + ro; }
        kptr[tid] = (s < 0) ? nullptr : kp;
        vptr[tid] = vp;
    }
    __syncthreads();
    {
        const int j = tid & 255, kvh = tid >> 8;
        const float* kp0 = kptr[j];
        const bool valid = kp0 != nullptr;
        const float* kp = (valid ? kp0 : vptr[j]) + kvh * 128;
        float d0 = 0.f, d1 = 0.f, d2 = 0.f, d3 = 0.f;
        const float* q0 = qs + (kvh * 4) * 128;
#pragma unroll 16
        for (int c = 0; c < 32; ++c) {
            const f32x4 kv = *(const f32x4*)(kp + c * 4);
            const f32x4 a0 = *(const f32x4*)(q0 + c * 4), a1 = *(const f32x4*)(q0 + 128 + c * 4), a2 = *(const f32x4*)(q0 + 256 + c * 4),
                        a3 = *(const f32x4*)(q0 + 384 + c * 4);
            d0 += kv[0] * a0[0] + kv[1] * a0[1] + kv[2] * a0[2] + kv[3] * a0[3];
            d1 += kv[0] * a1[0] + kv[1] * a1[1] + kv[2] * a1[2] + kv[3] * a1[3];
            d2 += kv[0] * a2[0] + kv[1] * a2[1] + kv[2] * a2[2] + kv[3] * a2[3];
            d3 += kv[0] * a3[0] + kv[1] * a3[1] + kv[2] * a3[2] + kv[3] * a3[3];
        }
        const float scl = 0.08838834764831845f;
        ps[(kvh * 4 + 0) * 256 + j] = valid ? d0 * scl : -INFINITY;
        ps[(kvh * 4 + 1) * 256 + j] = valid ? d1 * scl : -INFINITY;
        ps[(kvh * 4 + 2) * 256 + j] = valid ? d2 * scl : -INFINITY;
        ps[(kvh * 4 + 3) * 256 + j] = valid ? d3 * scl : -INFINITY;
    }
    __syncthreads();
    {
        float v[4]; float m = -INFINITY;
#pragma unroll
        for (int i = 0; i < 4; ++i) { v[i] = ps[wave * 256 + lane + 64 * i]; m = fmaxf(m, v[i]); }
        m = wave_max(m);
        float sum = 0.f;
#pragma unroll
        for (int i = 0; i < 4; ++i) { v[i] = __expf(v[i] - m); sum += v[i]; }
        sum = wave_sum(sum);
        const float inv = 1.f / sum;
#pragma unroll
        for (int i = 0; i < 4; ++i) ps[wave * 256 + lane + 64 * i] = v[i] * inv;
    }
    __syncthreads();
    {
        const int kvh = tid >> 8, kg = (tid >> 5) & 7, d4 = tid & 31;
        f32x4 acc[4];
#pragma unroll
        for (int g = 0; g < 4; ++g) acc[g] = (f32x4){0.f, 0.f, 0.f, 0.f};
#pragma unroll 16
        for (int i = 0; i < 32; ++i) {
            const int j = kg * 32 + i;
            const f32x4 vv = *(const f32x4*)(vptr[j] + kvh * 128 + d4 * 4);
#pragma unroll
            for (int g = 0; g < 4; ++g) acc[g] += vv * ps[(kvh * 4 + g) * 256 + j];
        }
#pragma unroll
        for (int g = 0; g < 4; ++g) *(f32x4*)(red + ((kg * 2 + kvh) * 4 + g) * 128 + d4 * 4) = acc[g];
    }
    __syncthreads();
    {
        const int h = wave, d = lane * 2;
        float o0 = 0.f, o1 = 0.f;
#pragma unroll
        for (int kg = 0; kg < 8; ++kg) { const f32x2 t = *(const f32x2*)(red + ((kg * 2 + (h >> 2)) * 4 + (h & 3)) * 128 + d); o0 += t[0]; o1 += t[1]; }
        *(unsigned*)(p.gated + (size_t)row * 1024 + h * 128 + d) = pk2(o0, o1);
    }
    __syncthreads();
}

constexpr int AT_K = 0, AT_V = 64 * 136, AT_ELEMS = 64 * 136 + 128 * 72;
__device__ __forceinline__ void attn_dense_unit(const Params& p, char* smem, int b, int kvh, int qb) {
    bf16_t* lds = (bf16_t*)smem;
    const int tid = tid_opaque(), lane = tid & 63, wave = tid >> 6;
    const int r = lane & 31, hh = lane >> 5;
    const int g = wave & 3, qs = wave >> 2;
    const int head = kvh * 4 + g;
    const int tq = 64 * qb + 32 * qs + r;
    const int tqc = (tq < LP) ? tq : (LP - 1);
    bf16x8 qf[8];
    {
        const bf16_t* qp = p.q_b + ((size_t)b * LP + tqc) * 1024 + head * 128 + 8 * hh;
#pragma unroll
        for (int ks = 0; ks < 8; ++ks) qf[ks] = *(const bf16x8*)(qp + 16 * ks);
    }
    f32x16 O[4];
#pragma unroll
    for (int i = 0; i < 4; ++i)
#pragma unroll
        for (int j = 0; j < 16; ++j) O[i][j] = 0.f;
    float mrun = -3.0e38f, lrun = 0.f;
    const bf16_t* Kg = p.k_b + ((size_t)(b * 2 + kvh) * LPAD) * 128;
    const bf16_t* Vg = p.vt_b + ((size_t)(b * 2 + kvh) * 128) * LPAD;
    const unsigned long long* mcol = p.maskT + (size_t)b * 65 * LPAD + tq;
    const int kc0 = tid, kc1 = tid + 512;
    uint4 sk0, sk1, sv0, sv1;
#define AT_GLOAD(kt_) do { const bf16_t* kg_ = Kg + (size_t)(kt_) * 64 * 128; const bf16_t* vg_ = Vg + (size_t)(kt_) * 64; \
        sk0 = *(const uint4*)(kg_ + (size_t)kc0 * 8); sk1 = *(const uint4*)(kg_ + (size_t)kc1 * 8); \
        sv0 = *(const uint4*)(vg_ + (size_t)(kc0 >> 3) * LPAD + (kc0 & 7) * 8); sv1 = *(const uint4*)(vg_ + (size_t)(kc1 >> 3) * LPAD + (kc1 & 7) * 8); } while (0)
#define AT_SSTORE(buf_) do { bf16_t* q_ = (buf_); \
        *(uint4*)(q_ + AT_K + (kc0 >> 4) * 136 + (kc0 & 15) * 8) = sk0; *(uint4*)(q_ + AT_K + (kc1 >> 4) * 136 + (kc1 & 15) * 8) = sk1; \
        *(uint4*)(q_ + AT_V + (kc0 >> 3) * 72 + (kc0 & 7) * 8) = sv0; *(uint4*)(q_ + AT_V + (kc1 >> 3) * 72 + (kc1 & 7) * 8) = sv1; } while (0)
    AT_GLOAD(0); AT_SSTORE(lds);
    __syncthreads();
    for (int kt = 0; kt <= qb; ++kt) {
        unsigned zofs = 0; asm volatile("" : "+v"(zofs));
        bf16_t* cur = lds + (kt & 1) * AT_ELEMS + zofs;
        bf16_t* nxt = lds + ((kt + 1) & 1) * AT_ELEMS + zofs;
        const bool more = kt < qb;
        if (more) { AT_GLOAD(kt + 1); }
        const unsigned long long mw = mcol[(size_t)kt * LPAD];
        f32x16 st[2];
#pragma unroll
        for (int j = 0; j < 16; ++j) { st[0][j] = 0.f; st[1][j] = 0.f; }
#pragma unroll
        for (int ks = 0; ks < 8; ++ks) {
            st[0] = MFMA32(*(const bf16x8*)(cur + AT_K + (r) * 136 + 16 * ks + 8 * hh), qf[ks], st[0]);
            st[1] = MFMA32(*(const bf16x8*)(cur + AT_K + (32 + r) * 136 + 16 * ks + 8 * hh), qf[ks], st[1]);
        }
        float mx = -3.0e38f;
#pragma unroll
        for (int kk = 0; kk < 2; ++kk) {
            const unsigned w = (unsigned)(mw >> (32 * kk)) >> (4 * hh);
#pragma unroll
            for (int reg = 0; reg < 16; ++reg) {
                const int bit = (reg & 3) + 8 * (reg >> 2);
                const float v = ((w >> bit) & 1u) ? st[kk][reg] : -3.0e38f;
                st[kk][reg] = v;
                mx = fmaxf(mx, v);
            }
        }
        mx = fmaxf(mx, __shfl_xor(mx, 32));
        const float mnew = fmaxf(mrun, mx);
        const float alpha = __builtin_amdgcn_exp2f(mrun - mnew);
        mrun = mnew;
        float psum = 0.f;
#pragma unroll
        for (int kk = 0; kk < 2; ++kk)
#pragma unroll
            for (int reg = 0; reg < 16; ++reg) { const float pv = __builtin_amdgcn_exp2f(st[kk][reg] - mnew); st[kk][reg] = pv; psum += pv; }
        lrun = lrun * alpha + psum;
#pragma unroll
        for (int dt = 0; dt < 4; ++dt) O[dt] = O[dt] * alpha;
        bf16x8 pb[2][2];
#pragma unroll
        for (int kk = 0; kk < 2; ++kk)
#pragma unroll
            for (int s = 0; s < 2; ++s) pb[kk][s] = pack_step(st[kk], s);
#pragma unroll
        for (int dt = 0; dt < 4; ++dt)
#pragma unroll
            for (int kk = 0; kk < 2; ++kk)
#pragma unroll
                for (int s = 0; s < 2; ++s)
                    O[dt] = MFMA32(frag_perm(cur + AT_V + (32 * dt + r) * 72 + 32 * kk + 16 * s + 4 * hh), pb[kk][s], O[dt]);
        if (more) { AT_SSTORE(nxt); }
        __syncthreads();
    }
    const float ltot = lrun + __shfl_xor(lrun, 32);
    const float inv = 1.f / ltot;
    if (tq < LP) {
        bf16_t* op = p.gated + ((size_t)b * LP + tq) * 1024 + head * 128;
#pragma unroll
        for (int dt = 0; dt < 4; ++dt)
#pragma unroll
            for (int g4 = 0; g4 < 4; ++g4) {
                f32x4 v;
#pragma unroll
                for (int e2 = 0; e2 < 4; ++e2) v[e2] = O[dt][4 * g4 + e2] * inv;
                st_bf16x4(op + 32 * dt + 8 * g4 + 4 * hh, v);
            }
    }
    __syncthreads();
}

__device__ __forceinline__ void attn_phase(const Params& p, char* smem, int bid, int nb, int rep = 0) {
    int* slot = (int*)(smem + LDS_BYTES - 32);
    for (;;) {
        if (threadIdx.x == 0) *slot = (int)atomicAdd(p.bar + 3584 + 16 * rep, 1u);
        __syncthreads();
        const int u = *slot;
        __syncthreads();
        if (u >= 520 + NSR) break;
        if (u < 520) attn_dense_unit(p, smem, (u & 7) >> 1, u & 1, 64 - (u >> 3));
        else attn_sample_query(p, smem, NPR + (u - 520));
    }
}

#define XB_TMO      128
#define XB_XCNT(j)  (256  + 64 * (j))
#define XB_XSUB(j)  (1280 + 64 * (j))
#define XB_XGEN(j)  (2304 + 64 * (j))
#define XB_TOP      3328
#define XB_TOPGEN   3392
#define XCD_BAR_WORDS 3456
#define XB_SPIN_CAP (1u << 18)
#define LAS __attribute__((address_space(3)))

__device__ __forceinline__ unsigned xb_ld(unsigned* p)              { return __hip_atomic_load(p, __ATOMIC_RELAXED, __HIP_MEMORY_SCOPE_AGENT); }
__device__ __forceinline__ unsigned xb_add(unsigned* p, unsigned v) { return __hip_atomic_fetch_add(p, v, __ATOMIC_RELAXED, __HIP_MEMORY_SCOPE_AGENT); }
__device__ __forceinline__ unsigned xb_xcc_id() { return (unsigned)__builtin_amdgcn_s_getreg((3 << 11) | 20) & 0xFu; }
#define XB_SPIN(cond, bar) do { unsigned _sp = 0; while (cond) { __builtin_amdgcn_s_sleep(1); \
    if ((++_sp & 255u) == 0u) { if (xb_ld(&(bar)[XB_TMO])) break; if (_sp > XB_SPIN_CAP) { atomicAdd(&(bar)[XB_TMO], 1u); break; } } } } while (0)

struct XcdBarrier {
    unsigned* bar; unsigned x;
    volatile LAS unsigned* st;
};

__device__ __forceinline__ XcdBarrier xcd_barrier_post(unsigned* bar, volatile LAS unsigned* st) {
    XcdBarrier b; b.bar = bar; b.x = xb_xcc_id(); b.st = st;
    if (threadIdx.x == 0) (void)xb_add(&bar[XB_XCNT(b.x)], 1u);
    return b;
}
__device__ __forceinline__ void xcd_barrier_complete(unsigned* bar, unsigned x, unsigned& nloc, unsigned& nx) {
    const unsigned G = gridDim.x * gridDim.y * gridDim.z;
    unsigned sum, cnt, mine, sp = 0u;
    for (;;) {
        sum = 0u; cnt = 0u; mine = 0u;
#pragma unroll
        for (unsigned j = 0; j < 16; ++j) { const unsigned c = xb_ld(&bar[XB_XCNT(j)]); sum += c; cnt += (c > 0u) ? 1u : 0u; mine = (j == x) ? c : mine; }
        if (sum == G) break;
        __builtin_amdgcn_s_sleep(1);
        if ((++sp & 255u) == 0u) { if (xb_ld(&bar[XB_TMO])) break; if (sp > XB_SPIN_CAP) { atomicAdd(&bar[XB_TMO], 1u); break; } }
    }
    nloc = mine > 0u ? mine : 1u; nx = cnt > 0u ? cnt : 1u;
}

__device__ __forceinline__ void xcd_barrier(const XcdBarrier& b) {
    asm volatile("s_waitcnt vmcnt(0)" ::: "memory");
    __syncthreads();
    if (threadIdx.x == 0) {
        unsigned* bar = b.bar;
        __builtin_amdgcn_s_waitcnt(0);
        unsigned nloc = b.st[0], nx = b.st[1];
        if (nloc == 0u) { xcd_barrier_complete(bar, b.x, nloc, nx); b.st[0] = nloc; b.st[1] = nx; }
        const unsigned old = xb_add(&bar[XB_XSUB(b.x)], 1u);
        const unsigned gen = old / nloc;
        if (old + 1u == (gen + 1u) * nloc) {
            __builtin_amdgcn_fence(__ATOMIC_RELEASE, "agent");
            asm volatile("s_waitcnt vmcnt(0)" ::: "memory");
            const unsigned og = xb_add(&bar[XB_TOP], 1u);
            const unsigned tg = og / nx;
            if (og + 1u == (tg + 1u) * nx) xb_add(&bar[XB_TOPGEN], 1u);
            else XB_SPIN(xb_ld(&bar[XB_TOPGEN]) == tg, bar);
            __builtin_amdgcn_fence(__ATOMIC_ACQUIRE, "agent");
            xb_add(&bar[XB_XGEN(b.x)], 1u);
            asm volatile("s_waitcnt vmcnt(0)" ::: "memory");
        } else {
            XB_SPIN(xb_ld(&bar[XB_XGEN(b.x)]) == gen, bar);
            __builtin_amdgcn_fence(__ATOMIC_ACQUIRE, "agent");
            asm volatile("s_waitcnt vmcnt(0)" ::: "memory");
        }
    }
    __syncthreads();
}


constexpr int NPHASE = 19;
template <int PH>
__device__ __forceinline__ void run_phase(const Params& p, char* smem, int bid, int nb, int rep = 0) {
    constexpr int MT = MPAD / 256;
    if constexpr (PH == 0) phase_prologue(p, smem, bid, nb);
    else if constexpr (PH == 1) gemm_big(p.hA, D, p.wt_gin, GIN_PAD, EpiGdnIn{p.mixed, p.z, p.ba}, smem, bid, nb);
    else if constexpr (PH == 2) gdn_stageA(p, smem, bid, nb);
    else if constexpr (PH == 3) gdn_seq_phase(p, smem, bid, nb, rep);
    else if constexpr (PH == 4) gdn_gate_phase(p, bid, nb);
    else if constexpr (PH == 5) gemm_n1024(p.gated, 2048, p.wt_gout, EpiResid{p.preln, p.hA}, EpiSlab{p.slab}, 8, smem, bid, nb);
    else if constexpr (PH == 6) ln_phase(p.preln, p.ln1_g, p.ln1_b, p.hB, nullptr, nullptr, p.slab, 8, p.hA, bid, nb);
    else if constexpr (PH == 7) gemm_big(p.hB, D, p.wt_w1, DFF, EpiRelu2{p.act}, smem, bid, nb);
    else if constexpr (PH == 8) gemm_n1024(p.act, DFF, p.wt_w2, EpiResid{p.preln, p.hB}, EpiSlab{p.slab}, 16, smem, bid, nb);
    else if constexpr (PH == 9) ln_phase(p.preln, p.ln2_g, p.ln2_b, p.hA, nullptr, nullptr, p.slab, 16, p.hB, bid, nb);
    else if constexpr (PH == 10) gemm_big(p.hA, D, p.wt_din, DIN_PAD, EpiF32{p.p1, DIN_PAD}, smem, bid, nb);
    else if constexpr (PH == 11) dsa_post_phase(p, smem, bid, nb);
    else if constexpr (PH == 12) indexer_phase(p, smem, bid, nb, rep);
    else if constexpr (PH == 13) attn_phase(p, smem, bid, nb, rep);
    else if constexpr (PH == 14) gemm_n1024(p.gated, D, p.wt_do, EpiResid{p.preln, p.hA}, EpiSlab{p.slab}, 4, smem, bid, nb);
    else if constexpr (PH == 15) ln_phase(p.preln, p.ln1_g + D, p.ln1_b + D, p.hB, nullptr, nullptr, p.slab, 4, p.hA, bid, nb);
    else if constexpr (PH == 16) gemm_big(p.hB, D, p.wt_w1 + (size_t)D * DFF, DFF, EpiRelu2{p.act}, smem, bid, nb);
    else if constexpr (PH == 17) gemm_n1024(p.act, DFF, p.wt_w2 + (size_t)D * DFF, EpiResid{p.preln, p.hB}, EpiSlab{p.slab}, 16, smem, bid, nb);
    else if constexpr (PH == 18) ln_phase(p.preln, p.ln2_g + D, p.ln2_b + D, nullptr, p.y_prompt, p.y_sample, p.slab, 16, p.hB, bid, nb);
}

template <int PH>
__global__ void __launch_bounds__(NTHR, 2) k_phase(Params p) {
    extern __shared__ __attribute__((aligned(16))) char smem[];
    run_phase<PH>(p, smem, blockIdx.x, gridDim.x);
}

template <int PH>
__device__ __forceinline__ void mega_run(const Params& p, char* smem, const XcdBarrier& bar) {
    run_phase<PH>(p, smem, blockIdx.x, gridDim.x);
#ifdef PROBE_MASK
    if constexpr ((PROBE_MASK >> PH) & 1) { xcd_barrier(bar); run_phase<PH>(p, smem, blockIdx.x, gridDim.x, 1); }
#endif
    if constexpr (PH + 1 < NPHASE) {
        xcd_barrier(bar);
        mega_run<PH + 1>(p, smem, bar);
    }
}
__global__ void __launch_bounds__(NTHR, 2) k_mega(Params p) {
    extern __shared__ __attribute__((aligned(16))) char smem[];
    volatile LAS unsigned* st = (volatile LAS unsigned*)(smem + LDS_BYTES - 16);
    if (threadIdx.x == 0) { st[0] = 0u; st[1] = 0u; st[2] = 0u; st[3] = 0u; }
    __syncthreads();
    XcdBarrier bar = xcd_barrier_post(p.bar, st);
    mega_run<0>(p, smem, bar);
}

template <int PH>
void launch_phase(const Params& p, hipStream_t stream) {
    static bool attr_done = false;
    if (!attr_done) {
        (void)hipFuncSetAttribute((const void*)k_phase<PH>, hipFuncAttributeMaxDynamicSharedMemorySize, LDS_BYTES);
        attr_done = true;
    }
    hipLaunchKernelGGL(k_phase<PH>, dim3(256), dim3(NTHR), LDS_BYTES, stream, p);
}
template <int PH>
void launch_all(const Params& p, hipStream_t stream) {
    launch_phase<PH>(p, stream);
    if constexpr (PH + 1 < NPHASE) launch_all<PH + 1>(p, stream);
}

}

extern "C" void kernel_launch(void* const* d_in, const int* in_sizes, int n_in, void* d_out, int out_size, void* d_ws, size_t ws_size,
                              hipStream_t stream) {
    Params p{};
    p.x_prompt = (const float*)d_in[0]; p.x_sample = (const float*)d_in[1]; p.state_gdn = (const float*)d_in[2];
    p.state_conv = (const float*)d_in[3]; p.cache_k = (const float*)d_in[4]; p.cache_v = (const float*)d_in[5];
    p.cache_ik = (const float*)d_in[6]; p.page_table = (const int*)d_in[7]; p.meta = (const float*)d_in[8];
    p.ln1_g = (const float*)d_in[9]; p.ln1_b = (const float*)d_in[10]; p.ln2_g = (const float*)d_in[11]; p.ln2_b = (const float*)d_in[12];
    p.mlp_w1 = (const float*)d_in[13]; p.mlp_w2 = (const float*)d_in[14]; p.gdn_w_in = (const float*)d_in[15];
    p.gdn_conv_w = (const float*)d_in[16]; p.gdn_a_log = (const float*)d_in[17]; p.gdn_dt_bias = (const float*)d_in[18];
    p.gdn_norm_w = (const float*)d_in[19]; p.gdn_w_out = (const float*)d_in[20]; p.dsa_w_in = (const float*)d_in[21];
    p.dsa_ik_g = (const float*)d_in[22]; p.dsa_ik_b = (const float*)d_in[23]; p.dsa_w_o = (const float*)d_in[24];
    float* o = (float*)d_out;
    p.y_prompt = o; o += (size_t)BATCH * SEQ * D;
    p.y_sample = o; o += (size_t)NSR * D;
    p.gs_prompt = o; o += (size_t)BATCH * 16 * 128 * 128;
    p.gc_prompt = o; o += (size_t)BATCH * 3 * 4096;
    p.gs_sample = o; o += (size_t)DB * 16 * 128 * 128;
    p.gc_sample = o; o += (size_t)DB * 3 * 4096;
    p.k_prompt = o; o += (size_t)NPR * 256;
    p.v_prompt = o; o += (size_t)NPR * 256;
    p.ik_prompt = o; o += (size_t)NPR * 64;
    p.k_sample = o; o += (size_t)NSR * 256;
    p.v_sample = o; o += (size_t)NSR * 256;
    p.ik_sample = o; o += (size_t)NSR * 64;
    char* w = (char*)d_ws;
    auto take = [&](size_t bytes) { char* r = w; w += (bytes + 255) & ~(size_t)255; return r; };
    p.bar = (unsigned*)take(16384);
    p.wt_gin = (bf16_t*)take((size_t)GIN_PAD * D * 2);
    p.wt_gout = (bf16_t*)take((size_t)D * 2048 * 2);
    p.wt_w1 = (bf16_t*)take((size_t)2 * D * DFF * 2);
    p.wt_w2 = (bf16_t*)take((size_t)2 * D * DFF * 2);
    p.wt_din = (bf16_t*)take((size_t)DIN_PAD * D * 2);
    p.wt_do = (bf16_t*)take((size_t)D * D * 2);
    p.hA = (bf16_t*)take((size_t)MPAD * D * 2);
    p.hB = (bf16_t*)take((size_t)MPAD * D * 2);
    p.preln = (float*)take((size_t)MPAD * D * 4);
    p.mixed = (bf16_t*)take((size_t)MPAD * 4096 * 2);
    p.z = (bf16_t*)take((size_t)MPAD * 2048 * 2);
    p.ba = (float*)take((size_t)MPAD * 32 * 4);
    p.gated = (bf16_t*)take((size_t)MPAD * 2048 * 2);
    p.act = (bf16_t*)take((size_t)MPAD * DFF * 2);
    p.p1 = (float*)take((size_t)MPAD * DIN_PAD * 4);
    p.qr = (float*)take((size_t)MPAD * 1024 * 4);
    p.iq = (float*)take((size_t)MPAD * 512 * 4);
    p.iw = (float*)take((size_t)MPAD * 8 * 4);
    p.sel = (int*)take((size_t)MPAD * 256 * 4);
    p.g_o = (bf16_t*)take((size_t)NPR * 2048 * 2);
    p.rope_tab = (float*)take((size_t)LP * 24 * 2 * 4);
    p.slab = (float*)take((size_t)16 * 768 * 1024 * 4);
    p.q_b = (bf16_t*)take((size_t)NPR * 1024 * 2);
    p.k_b = (bf16_t*)take((size_t)BATCH * 2 * LPAD * 128 * 2);
    p.vt_b = (bf16_t*)take((size_t)BATCH * 2 * 128 * LPAD * 2);
    p.iq_b = (bf16_t*)take((size_t)NPR * 512 * 2);
    p.ik_b = (bf16_t*)take((size_t)BATCH * LPAD * 64 * 2);
    p.maskT = (unsigned long long*)take((size_t)BATCH * 65 * LPAD * 8);
    p.g_dec = (float*)take((size_t)NCU * 4);
    p.g_u = (float*)p.act;
    p.g_negw = (bf16_t*)p.p1;
    p.g_qg = p.g_negw + (size_t)NCU * 8192;
    p.g_kdT = (bf16_t*)p.qr;
    p.g_aqk = (bf16_t*)p.iq;
    if ((size_t)(w - (char*)d_ws) > ws_size) { fprintf(stderr, "kernel_launch: workspace too small (%zu needed, %zu given)\n", (size_t)(w - (char*)d_ws), ws_size); return; }
#if MEGA
    static int grid = 0;
    if (grid == 0) {
        int dev = 0, cus = 0;
        if (hipGetDevice(&dev) != hipSuccess || hipDeviceGetAttribute(&cus, hipDeviceAttributeMultiprocessorCount, dev) != hipSuccess || cus <= 0) cus = 256;
        (void)hipFuncSetAttribute((const void*)k_mega, hipFuncAttributeMaxDynamicSharedMemorySize, LDS_BYTES);
        grid = cus;
    }
    (void)hipMemsetAsync(p.bar, 0, 16384, stream);
    hipLaunchKernelGGL(k_mega, dim3(grid), dim3(NTHR), LDS_BYTES, stream, p);
#else
    launch_all<0>(p, stream);
#endif
}
```

```cpp
#include <hip/hip_runtime.h>
#include <stdint.h>
#include <stdio.h>

#ifndef MEGA
#define MEGA 1
#endif

namespace {

typedef unsigned short bf16_t;
typedef short bf16x8 __attribute__((ext_vector_type(8)));
typedef float f32x4 __attribute__((ext_vector_type(4)));

constexpr int D = 1024, BATCH = 4, SEQ = 4096, NMETA = 16, LP = SEQ + NMETA;
constexpr int DB = 128, DS = 4, PAST = 2048;
constexpr int NPR = BATCH * LP;
constexpr int NSR = DB * DS;
constexpr int NT = NPR + NSR;
constexpr int MPAD = 17152;
constexpr int DFF = 4096;
constexpr int GIN = 6176, GIN_PAD = 6400;
constexpr int DIN = 2120, DIN_PAD = 2304;
constexpr int NTHR = 512;
constexpr int LPAD = 4160;
constexpr int LDS_BYTES = 150 * 1024;
constexpr float ALPHA = 1.4142135623730951f;

struct Params {
    const float *x_prompt, *x_sample, *state_gdn, *state_conv, *cache_k, *cache_v, *cache_ik;
    const int* page_table;
    const float *meta, *ln1_g, *ln1_b, *ln2_g, *ln2_b, *mlp_w1, *mlp_w2, *gdn_w_in, *gdn_conv_w, *gdn_a_log, *gdn_dt_bias,
        *gdn_norm_w, *gdn_w_out, *dsa_w_in, *dsa_ik_g, *dsa_ik_b, *dsa_w_o;
    float *y_prompt, *y_sample, *gs_prompt, *gc_prompt, *gs_sample, *gc_sample, *k_prompt, *v_prompt, *ik_prompt, *k_sample,
        *v_sample, *ik_sample;
    unsigned* bar;
    bf16_t *wt_gin, *wt_gout, *wt_w1, *wt_w2, *wt_din, *wt_do;
    bf16_t *hA, *hB;
    float* preln;
    bf16_t *mixed, *z;
    float* ba;
    bf16_t *gated, *act;
    float *p1, *qr, *iq, *iw;
    int* sel;
    bf16_t *g_negw, *g_qg, *g_kdT, *g_aqk;
    float *g_u, *g_dec;
    bf16_t* g_o;
    float* rope_tab;
    float* slab;
    bf16_t *q_b, *k_b, *vt_b, *iq_b, *ik_b;
    unsigned long long* maskT;
};

__device__ const double kInvFreq[16] = {1.0, 0.44036660267178046, 0.19392274474868576, 0.08539710028576561,
    0.03760603093086393, 0.016560440080994446, 0.007292664737217109, 0.003211445994752591, 0.001414213562373095,
    0.000622772421914596, 0.0002742481756762073, 0.00012076973741146504, 5.318295896944988e-05, 2.341999896140934e-05,
    1.031338537721246e-05, 4.5416704806078695e-06};

__device__ __forceinline__ float bf2f(bf16_t h) { return __uint_as_float(((unsigned)h) << 16); }
typedef __bf16 hwbf16x2 __attribute__((ext_vector_type(2)));
typedef float f32x2 __attribute__((ext_vector_type(2)));
typedef float f32x16 __attribute__((ext_vector_type(16)));
typedef unsigned u32x4 __attribute__((ext_vector_type(4)));
__device__ __forceinline__ unsigned pk2(float lo, float hi) {
    const f32x2 v = {lo, hi};
    return __builtin_bit_cast(unsigned, __builtin_convertvector(v, hwbf16x2));
}
__device__ __forceinline__ bf16_t f2bf(float f) { return (bf16_t)(pk2(f, 0.f) & 0xffffu); }
__device__ __forceinline__ void st_bf16x4(bf16_t* p, f32x4 v) {
    uint2 o; o.x = pk2(v[0], v[1]); o.y = pk2(v[2], v[3]);
    *(uint2*)p = o;
}
__device__ __forceinline__ f32x4 cvt_bf16x4(uint2 o) {
    f32x4 v; v[0] = __uint_as_float(o.x << 16); v[1] = __uint_as_float(o.x & 0xffff0000u);
    v[2] = __uint_as_float(o.y << 16); v[3] = __uint_as_float(o.y & 0xffff0000u);
    return v;
}
__device__ __forceinline__ f32x4 ld_bf16x4(const bf16_t* p) {
    uint2 o = *(const uint2*)p;
    f32x4 v; v[0] = __uint_as_float(o.x << 16); v[1] = __uint_as_float(o.x & 0xffff0000u);
    v[2] = __uint_as_float(o.y << 16); v[3] = __uint_as_float(o.y & 0xffff0000u);
    return v;
}
__device__ __forceinline__ float wave_sum(float v) {
#pragma unroll
    for (int o = 1; o < 64; o <<= 1) v += __shfl_xor(v, o);
    return v;
}
__device__ __forceinline__ float wave_max(float v) {
#pragma unroll
    for (int o = 1; o < 64; o <<= 1) v = fmaxf(v, __shfl_xor(v, o));
    return v;
}
__device__ __forceinline__ int wave_sum_i(int v) {
#pragma unroll
    for (int o = 1; o < 64; o <<= 1) v += __shfl_xor(v, o);
    return v;
}
__device__ __forceinline__ float silu(float x) { return x * __builtin_amdgcn_rcpf(1.f + __expf(-x)); }
__device__ __forceinline__ int tid_opaque() { int t = threadIdx.x; asm volatile("" : "+v"(t)); return t; }
__device__ __forceinline__ void lds_barrier() { asm volatile("s_waitcnt lgkmcnt(0)\n\ts_barrier" ::: "memory"); }
__device__ __forceinline__ void lds_fence() { asm volatile("s_waitcnt lgkmcnt(0)" ::: "memory"); }

__device__ __forceinline__ void transpose_convert(const float* __restrict__ W, int K, int N, int Npad, bf16_t* __restrict__ WT, float* tile,
                                  int bid, int nb) {
    const int tid = tid_opaque();
    const int tk = K / 64, tn = Npad / 64;
    for (int it = bid; it < tk * tn; it += nb) {
        const int kb = it / tn, nbk = it % tn, k0 = kb * 64, n0 = nbk * 64;
#pragma unroll
        for (int i = 0; i < 8; ++i) {
            const int r = (tid >> 6) + 8 * i, c = tid & 63, n = n0 + c;
            tile[r * 65 + c] = (n < N) ? W[(size_t)(k0 + r) * N + n] : 0.f;
        }
        __syncthreads();
        {
            const int rn = tid >> 3, c8 = (tid & 7) * 8;
            const float* tp = tile + c8 * 65 + rn;
            uint4 o;
            o.x = pk2(tp[0], tp[65]); o.y = pk2(tp[2 * 65], tp[3 * 65]); o.z = pk2(tp[4 * 65], tp[5 * 65]); o.w = pk2(tp[6 * 65], tp[7 * 65]);
            *(uint4*)(WT + (size_t)(n0 + rn) * K + k0 + c8) = o;
        }
        __syncthreads();
    }
}

__device__ __forceinline__ void phase_prologue(const Params& p, char* smem, int bid, int nb) {
    float* tile = (float*)smem;
    transpose_convert(p.gdn_w_in, D, GIN, GIN_PAD, p.wt_gin, tile, bid, nb);
    transpose_convert(p.gdn_w_out, 2048, D, D, p.wt_gout, tile, bid, nb);
    transpose_convert(p.mlp_w1, D, DFF, DFF, p.wt_w1, tile, bid, nb);
    transpose_convert(p.mlp_w1 + (size_t)D * DFF, D, DFF, DFF, p.wt_w1 + (size_t)D * DFF, tile, bid, nb);
    transpose_convert(p.mlp_w2, DFF, D, D, p.wt_w2, tile, bid, nb);
    transpose_convert(p.mlp_w2 + (size_t)D * DFF, DFF, D, D, p.wt_w2 + (size_t)D * DFF, tile, bid, nb);
    transpose_convert(p.dsa_w_in, D, DIN, DIN_PAD, p.wt_din, tile, bid, nb);
    transpose_convert(p.dsa_w_o, D, D, D, p.wt_do, tile, bid, nb);
    for (int idx = bid * NTHR + tid_opaque(); idx < LP * 24; idx += nb * NTHR) {
        const int pos = idx / 24, f = idx % 24;
        const int fi = (f < 16) ? f : (f - 16) * 2;
        const double rev = (double)pos * kInvFreq[fi] * 0.15915494309189535;
        const float r = (float)(rev - floor(rev));
        p.rope_tab[idx * 2] = __builtin_amdgcn_cosf(r);
        p.rope_tab[idx * 2 + 1] = __builtin_amdgcn_sinf(r);
    }
    for (int idx = bid * NTHR + tid_opaque(); idx < MPAD * 256; idx += nb * NTHR) {
        const int row = idx >> 8, c4 = (idx & 255) * 4;
        f32x4 v = {0.f, 0.f, 0.f, 0.f};
        if (row < NPR) {
            const int b = row / LP, t = row % LP;
            const float* src = (t < NMETA) ? (p.meta + (size_t)t * D) : (p.x_prompt + ((size_t)b * SEQ + (t - NMETA)) * D);
            v = *(const f32x4*)(src + c4);
        } else if (row < NT) {
            v = *(const f32x4*)(p.x_sample + (size_t)(row - NPR) * D + c4);
        }
        st_bf16x4(p.hA + (size_t)row * D + c4, v);
    }
}

template <class Epi>
__device__ __forceinline__ void gemm_phase(const bf16_t* __restrict__ A, int lda, const bf16_t* __restrict__ Bt, int K, int Mtiles, int Ntiles,
                           const Epi& epi, char* smem, int bid, int nb) {
    bf16_t* As = (bf16_t*)smem;
    bf16_t* Bs = As + 256 * 72;
    const int tid = tid_opaque(), lane = tid & 63, wave = tid >> 6;
    const int wm = wave >> 1, wn = wave & 1;
    const int fr = lane & 15, fq = lane >> 4;
    const int ntiles = Mtiles * Ntiles;
    const int nk = K / 64;
    for (int tile = bid; tile < ntiles; tile += nb) {
        const int tm = tile % Mtiles, tn = tile / Mtiles;
        const bf16_t* Ag = A + (size_t)tm * 256 * lda;
        const bf16_t* Bg = Bt + (size_t)tn * 128 * K;
        f32x4 acc[4][4];
#pragma unroll
        for (int i = 0; i < 4; ++i)
#pragma unroll
            for (int j = 0; j < 4; ++j) acc[i][j] = (f32x4){0.f, 0.f, 0.f, 0.f};
        const int c0 = tid, c1 = tid + 512, c2 = tid + 1024, c3 = tid + 1536;
        const bf16_t* ga0 = Ag + (size_t)(c0 >> 3) * lda + (c0 & 7) * 8;
        const bf16_t* ga1 = Ag + (size_t)(c1 >> 3) * lda + (c1 & 7) * 8;
        const bf16_t* ga2 = Ag + (size_t)(c2 >> 3) * lda + (c2 & 7) * 8;
        const bf16_t* ga3 = Ag + (size_t)(c3 >> 3) * lda + (c3 & 7) * 8;
        const bf16_t* gb0 = Bg + (size_t)(c0 >> 3) * K + (c0 & 7) * 8;
        const bf16_t* gb1 = Bg + (size_t)(c1 >> 3) * K + (c1 & 7) * 8;
        bf16_t* sa0 = As + (c0 >> 3) * 72 + (c0 & 7) * 8;
        bf16_t* sa1 = As + (c1 >> 3) * 72 + (c1 & 7) * 8;
        bf16_t* sa2 = As + (c2 >> 3) * 72 + (c2 & 7) * 8;
        bf16_t* sa3 = As + (c3 >> 3) * 72 + (c3 & 7) * 8;
        bf16_t* sb0 = Bs + (c0 >> 3) * 72 + (c0 & 7) * 8;
        bf16_t* sb1 = Bs + (c1 >> 3) * 72 + (c1 & 7) * 8;
        uint4 ra0 = *(const uint4*)ga0, ra1 = *(const uint4*)ga1, ra2 = *(const uint4*)ga2, ra3 = *(const uint4*)ga3;
        uint4 rb0 = *(const uint4*)gb0, rb1 = *(const uint4*)gb1;
        *(uint4*)sa0 = ra0; *(uint4*)sa1 = ra1; *(uint4*)sa2 = ra2; *(uint4*)sa3 = ra3; *(uint4*)sb0 = rb0; *(uint4*)sb1 = rb1;
        __syncthreads();
        for (int kt = 0; kt < nk; ++kt) {
            const bool more = (kt + 1 < nk);
            if (more) {
                const int k0 = (kt + 1) * 64;
                ra0 = *(const uint4*)(ga0 + k0); ra1 = *(const uint4*)(ga1 + k0); ra2 = *(const uint4*)(ga2 + k0); ra3 = *(const uint4*)(ga3 + k0);
                rb0 = *(const uint4*)(gb0 + k0); rb1 = *(const uint4*)(gb1 + k0);
            }
#pragma unroll
            for (int kk = 0; kk < 2; ++kk) {
                bf16x8 af[4], bfr[4];
#pragma unroll
                for (int i = 0; i < 4; ++i) af[i] = *(const bf16x8*)(As + (wm * 64 + i * 16 + fr) * 72 + kk * 32 + fq * 8);
#pragma unroll
                for (int j = 0; j < 4; ++j) bfr[j] = *(const bf16x8*)(Bs + (wn * 64 + j * 16 + fr) * 72 + kk * 32 + fq * 8);
#pragma unroll
                for (int i = 0; i < 4; ++i)
#pragma unroll
                    for (int j = 0; j < 4; ++j) acc[i][j] = __builtin_amdgcn_mfma_f32_16x16x32_bf16(bfr[j], af[i], acc[i][j], 0, 0, 0);
            }
            __syncthreads();
            if (more) {
                *(uint4*)sa0 = ra0; *(uint4*)sa1 = ra1; *(uint4*)sa2 = ra2; *(uint4*)sa3 = ra3; *(uint4*)sb0 = rb0; *(uint4*)sb1 = rb1;
                __syncthreads();
            }
        }
#pragma unroll
        for (int i = 0; i < 4; ++i)
#pragma unroll
            for (int j = 0; j < 4; ++j) {
                const int row = tm * 256 + wm * 64 + i * 16 + fr, col = tn * 128 + wn * 64 + j * 16 + fq * 4;
                epi(row, col, acc[i][j]);
            }
    }
}

namespace pg8 {
#define PG8_LAS __attribute__((address_space(3)))
constexpr int BM = 256, BK = 64, HALF = 128, HTB = HALF * BK * 2  , STAGE_BYTES = 8 * HTB, NXCD = 8, WGM = 8;
__device__ __forceinline__ int lds_byte(int r, int c) { const int st = (r >> 4) * 2 + (c >> 5), rr = r & 15, cc = c & 31, ob = rr * 64 + cc * 2; return st * 1024 + (ob ^ (((ob >> 9) & 1) << 5)); }
__device__ __forceinline__ void stage_rc(int b, int& R, int& C) { const int st = b / 1024, sb = b % 1024, swz = sb ^ (((sb >> 9) & 1) << 5); R = (st >> 1) * 16 + swz / 64; C = (st & 1) * 32 + (swz % 64) / 2; }
struct Unit { int pm, pn, pk; };
struct Gemm { const bf16_t* A; const bf16_t* Bt; int K; int splits; };
struct StaticOrder {
    int nM, nN, nNr, pm0, nwg, G, c;
    __device__ void init(int nM_, int nNr_, int splits, int pm0_, int G_, int c_) { nM = nM_; nNr = nNr_; nN = nNr_ * splits; pm0 = pm0_; nwg = nM * nN; G = G_; c = c_; }
    __device__ bool next(int i, Unit& u) const {
        const long L = (long)i * G + c; if (L >= nwg) return false;
        int wgid = (int)L; { const int q = nwg / NXCD, r = nwg % NXCD, xcd = wgid % NXCD, off = wgid / NXCD; wgid = (xcd < r ? xcd * (q + 1) : r * (q + 1) + (xcd - r) * q) + off; }
        const int nig = WGM * nN, gid = wgid / nig, fm = gid * WGM, gsz = (nM - fm) < WGM ? (nM - fm) : WGM;
        const int pnv = (wgid % nig) / gsz;
        u.pm = pm0 + fm + ((wgid % nig) % gsz); u.pn = pnv % nNr; u.pk = pnv / nNr; return true;
    }
};
template <class Epi>
__device__ __forceinline__ void gemm_phase(PG8_LAS unsigned char* lds, const Gemm g, const StaticOrder& S, const Epi& E) {
    const int tid = tid_opaque(), wid = __builtin_amdgcn_readfirstlane(tid >> 6), lane = tid & 63, wr = wid >> 2, wc = wid & 3, fr = lane & 15, fq = lane >> 4;
    const int K = g.K, Kp = K / g.splits, nt = Kp / BK;
    unsigned voffA[2], voffB[2];
#pragma unroll
    for (int i = 0; i < 2; ++i) { int R, C; stage_rc(tid * 16 + i * 8192, R, C); voffA[i] = (unsigned)(R * K + C) * 2u; voffB[i] = voffA[i]; }
    const size_t kstep = (size_t)(BK * 2);
    const size_t hstep = (size_t)HALF * K * 2;
    const size_t tstep = 2 * hstep;
    const size_t pstep = (size_t)Kp * 2;
    const unsigned ldsw = (unsigned)wid * 1024u;
    const int aoff = lds_byte(wr * 64 + fr, fq * 8), boff = lds_byte(wc * 32 + fr, fq * 8);
#define PG8_SA(b, h) (((b) * 2 + (h)) * HTB)
#define PG8_SB(b, h) ((4 + (b) * 2 + (h)) * HTB)
#define PG8_STAGE(bufoff, gbase, voff) do { _Pragma("unroll") for (int _i = 0; _i < 2; ++_i) \
        __builtin_amdgcn_global_load_lds((const unsigned*)((const char*)(gbase) + (voff)[_i]), (PG8_LAS unsigned*)(lds + (bufoff) + ldsw + _i * 8192), 16, 0, 0); } while (0)
#define PG8_LDA(dst, b, h) do { _Pragma("unroll") for (int m = 0; m < 4; ++m) _Pragma("unroll") for (int k = 0; k < 2; ++k) dst[m][k] = *(const PG8_LAS bf16x8*)(lds + PG8_SA(b, h) + aoff + m * 2048 + k * 1024); } while (0)
#define PG8_LDB(dst, b, h) do { _Pragma("unroll") for (int n = 0; n < 2; ++n) _Pragma("unroll") for (int k = 0; k < 2; ++k) dst[n][k] = *(const PG8_LAS bf16x8*)(lds + PG8_SB(b, h) + boff + n * 2048 + k * 1024); } while (0)
#define PG8_MMA(ai, bj, At, Bt) do { __builtin_amdgcn_s_setprio(1); _Pragma("unroll") for (int m = 0; m < 4; ++m) _Pragma("unroll") for (int n = 0; n < 2; ++n) _Pragma("unroll") for (int k = 0; k < 2; ++k) \
        acc[ai][bj][m][n] = __builtin_amdgcn_mfma_f32_16x16x32_bf16(Bt[n][k], At[m][k], acc[ai][bj][m][n], 0, 0, 0); __builtin_amdgcn_s_setprio(0); } while (0)
#define PG8_WAIT_V(n) asm volatile("s_waitcnt vmcnt(" #n ")" ::: "memory")
#define PG8_WAIT_L(n) asm volatile("s_waitcnt lgkmcnt(" #n ")" ::: "memory")
#define PG8_BAR __builtin_amdgcn_s_barrier()
#define PG8_SCHED __builtin_amdgcn_sched_barrier(0)
    Unit cur, nxt; int ui = 0;
    if (!S.next(0, cur)) return;
    f32x4 acc[2][2][4][2];
#pragma unroll
    for (int a = 0; a < 2; ++a)
#pragma unroll
        for (int b = 0; b < 2; ++b)
#pragma unroll
            for (int m = 0; m < 4; ++m)
#pragma unroll
                for (int n = 0; n < 2; ++n) acc[a][b][m][n] = (f32x4){0.f, 0.f, 0.f, 0.f};
    bf16x8 At[4][2], B0[2][2], B1[2][2];
    const char* cA = (const char*)g.A + (size_t)cur.pm * tstep + (size_t)cur.pk * pstep; const char* cB = (const char*)g.Bt + (size_t)cur.pn * tstep + (size_t)cur.pk * pstep;
    PG8_STAGE(PG8_SB(0, 0), cB, voffB); PG8_STAGE(PG8_SA(0, 0), cA, voffA); PG8_STAGE(PG8_SB(0, 1), cB + hstep, voffB); PG8_STAGE(PG8_SA(0, 1), cA + hstep, voffA);
    if (wr == 1) PG8_BAR;
    PG8_WAIT_V(4); PG8_BAR;
    PG8_STAGE(PG8_SB(1, 0), cB + kstep, voffB); PG8_STAGE(PG8_SA(1, 0), cA + kstep, voffA); PG8_STAGE(PG8_SB(1, 1), cB + hstep + kstep, voffB);
    PG8_WAIT_V(6); PG8_BAR;
    for (;;) {
        const bool has_next = S.next(ui + 1, nxt);
        const char* nA = has_next ? (const char*)g.A + (size_t)nxt.pm * tstep + (size_t)nxt.pk * pstep : cA; const char* nB = has_next ? (const char*)g.Bt + (size_t)nxt.pn * tstep + (size_t)nxt.pk * pstep : cB;
        for (int t = 0; t < nt; t += 2) {
            const bool last = (t == nt - 2);
            const char* a1 = cA + (size_t)(t + 1) * kstep;
            const char* a2 = last ? nA : cA + (size_t)(t + 2) * kstep; const char* b2 = last ? nB : cB + (size_t)(t + 2) * kstep;
            const char* a3 = a2 + kstep; const char* b3 = b2 + kstep;
            PG8_LDB(B0, 0, 0); PG8_SCHED; PG8_LDA(At, 0, 0); PG8_STAGE(PG8_SA(1, 1), a1 + hstep, voffA);
            PG8_WAIT_L(8); PG8_BAR; PG8_WAIT_L(0); PG8_MMA(0, 0, At, B0); PG8_BAR; PG8_SCHED;
            PG8_LDB(B1, 0, 1); PG8_STAGE(PG8_SB(0, 0), b2, voffB);
            PG8_BAR; PG8_WAIT_L(0); PG8_MMA(0, 1, At, B1); PG8_BAR;
            PG8_LDA(At, 0, 1); PG8_STAGE(PG8_SA(0, 0), a2, voffA);
            PG8_BAR; PG8_WAIT_L(0); PG8_MMA(1, 0, At, B0); PG8_BAR; PG8_SCHED;
            PG8_STAGE(PG8_SB(0, 1), b2 + hstep, voffB);
            PG8_WAIT_V(6); PG8_BAR; PG8_MMA(1, 1, At, B1); PG8_BAR;
            PG8_LDB(B0, 1, 0); PG8_SCHED; PG8_LDA(At, 1, 0); PG8_STAGE(PG8_SA(0, 1), a2 + hstep, voffA);
            PG8_WAIT_L(8); PG8_BAR; PG8_WAIT_L(0); PG8_MMA(0, 0, At, B0); PG8_BAR; PG8_SCHED;
            PG8_LDB(B1, 1, 1); PG8_STAGE(PG8_SB(1, 0), b3, voffB);
            PG8_BAR; PG8_WAIT_L(0); PG8_MMA(0, 1, At, B1); PG8_BAR;
            PG8_LDA(At, 1, 1); PG8_STAGE(PG8_SA(1, 0), a3, voffA);
            PG8_BAR; PG8_WAIT_L(0); PG8_MMA(1, 0, At, B0); PG8_BAR; PG8_SCHED;
            PG8_STAGE(PG8_SB(1, 1), b3 + hstep, voffB);
            PG8_WAIT_V(6); PG8_BAR; PG8_MMA(1, 1, At, B1); PG8_BAR;
        }
#pragma unroll
        for (int ai = 0; ai < 2; ++ai)
#pragma unroll
            for (int m = 0; m < 4; ++m)
#pragma unroll
                for (int bj = 0; bj < 2; ++bj)
#pragma unroll
                    for (int n = 0; n < 2; ++n)
                        E(cur.pm * BM + ai * HALF + wr * 64 + m * 16 + fr, cur.pn * BM + bj * HALF + wc * 32 + n * 16 + 4 * fq, acc[ai][bj][m][n], cur.pk);
        if (!has_next) break;
#pragma unroll
        for (int a = 0; a < 2; ++a)
#pragma unroll
            for (int b = 0; b < 2; ++b)
#pragma unroll
                for (int m = 0; m < 4; ++m)
#pragma unroll
                    for (int n = 0; n < 2; ++n) acc[a][b][m][n] = (f32x4){0.f, 0.f, 0.f, 0.f};
        cur = nxt; cA = nA; cB = nB; ++ui;
    }
    PG8_WAIT_V(0);
    if (wr == 0) PG8_BAR;
    PG8_BAR;
#undef PG8_SA
#undef PG8_SB
#undef PG8_STAGE
#undef PG8_LDA
#undef PG8_LDB
#undef PG8_MMA
#undef PG8_WAIT_V
#undef PG8_WAIT_L
#undef PG8_BAR
#undef PG8_SCHED
}
}

template <class Epi>
__device__ __forceinline__ void gemm_big(const bf16_t* A, int K, const bf16_t* Bt, int Npad, const Epi& e, char* smem, int bid, int nb) {
    pg8::StaticOrder S; S.init(MPAD / 256, Npad / 256, 1, 0, nb, bid);
    pg8::gemm_phase((PG8_LAS unsigned char*)smem, pg8::Gemm{A, Bt, K, 1}, S, e);
}
template <class Epi1, class Epi2>
__device__ __forceinline__ void gemm_n1024(const bf16_t* A, int K, const bf16_t* Bt, const Epi1& e1, const Epi2& e2, int splits, char* smem, int bid, int nb) {
    pg8::StaticOrder S; S.init(64, 4, 1, 0, nb, bid);
    pg8::gemm_phase((PG8_LAS unsigned char*)smem, pg8::Gemm{A, Bt, K, 1}, S, e1);
    pg8::StaticOrder S2; S2.init(3, 4, splits, 64, nb, bid);
    pg8::gemm_phase((PG8_LAS unsigned char*)smem, pg8::Gemm{A, Bt, K, splits}, S2, e2);
}

struct EpiGdnIn {
    bf16_t *mixed, *z; float* ba;
    __device__ __forceinline__ void operator()(int row, int col, f32x4 v, int = 0) const {
        if (col < 4096) st_bf16x4(mixed + (size_t)row * 4096 + col, v);
        else if (col < 6144) st_bf16x4(z + (size_t)row * 2048 + (col - 4096), v);
        else if (col < 6176) *(f32x4*)(ba + (size_t)row * 32 + (col - 6144)) = v;
    }
};
struct EpiResid {
    float* out; const bf16_t* h;
    __device__ __forceinline__ void operator()(int row, int col, f32x4 v, int = 0) const {
        const f32x4 r = ld_bf16x4(h + (size_t)row * D + col);
        *(f32x4*)(out + (size_t)row * D + col) = v + r * ALPHA;
    }
};
struct EpiSlab {
    float* slab;
    __device__ __forceinline__ void operator()(int row, int col, f32x4 v, int pk) const {
        *(f32x4*)(slab + ((size_t)pk * 768 + (row - 16384)) * D + col) = v;
    }
};
struct EpiRelu2 {
    bf16_t* act;
    __device__ __forceinline__ void operator()(int row, int col, f32x4 v, int = 0) const {
#pragma unroll
        for (int e = 0; e < 4; ++e) { const float r = fmaxf(v[e], 0.f); v[e] = r * r; }
        st_bf16x4(act + (size_t)row * DFF + col, v);
    }
};
struct EpiF32 {
    float* out; int ld;
    __device__ __forceinline__ void operator()(int row, int col, f32x4 v, int = 0) const { *(f32x4*)(out + (size_t)row * ld + col) = v; }
};

__device__ __forceinline__ void ln_phase(const float* X, const float* __restrict__ g, const float* __restrict__ bta, bf16_t* Hout,
                         float* yp, float* ys, const float* slab, int splits, const bf16_t* hres, int bid, int nb) {
    const int tid_ = tid_opaque(); const int lane = tid_ & 63, wave = tid_ >> 6;
    f32x4 gv[4], bv[4];
#pragma unroll
    for (int j = 0; j < 4; ++j) { gv[j] = *(const f32x4*)(g + j * 256 + lane * 4); bv[j] = *(const f32x4*)(bta + j * 256 + lane * 4); }
    for (int row = bid * 8 + wave; row < NT; row += nb * 8) {
        f32x4 v[4]; float s = 0.f;
        if (row < 16384) {
#pragma unroll
            for (int j = 0; j < 4; ++j) v[j] = *(const f32x4*)(X + (size_t)row * D + j * 256 + lane * 4);
        } else {
#pragma unroll
            for (int j = 0; j < 4; ++j) v[j] = ld_bf16x4(hres + (size_t)row * D + j * 256 + lane * 4) * ALPHA;
            for (int pk = 0; pk < splits; ++pk) {
                const float* sp = slab + ((size_t)pk * 768 + (row - 16384)) * D + lane * 4;
#pragma unroll
                for (int j = 0; j < 4; ++j) v[j] += *(const f32x4*)(sp + j * 256);
            }
        }
#pragma unroll
        for (int j = 0; j < 4; ++j) s += (v[j][0] + v[j][1]) + (v[j][2] + v[j][3]);
        const float mean = wave_sum(s) * (1.f / D);
        float s2 = 0.f;
#pragma unroll
        for (int j = 0; j < 4; ++j) { v[j] = v[j] - mean; s2 += (v[j][0] * v[j][0] + v[j][1] * v[j][1]) + (v[j][2] * v[j][2] + v[j][3] * v[j][3]); }
        const float rstd = rsqrtf(wave_sum(s2) * (1.f / D) + 1e-5f);
        float* yo = nullptr;
        if (yp) {
            if (row < NPR) { const int b = row / LP, t = row % LP; if (t >= NMETA) yo = yp + ((size_t)b * SEQ + (t - NMETA)) * D; }
            else yo = ys + (size_t)(row - NPR) * D;
        }
#pragma unroll
        for (int j = 0; j < 4; ++j) {
            const f32x4 o = v[j] * rstd * gv[j] + bv[j];
            if (Hout) st_bf16x4(Hout + (size_t)row * D + j * 256 + lane * 4, o);
            if (yo) *(f32x4*)(yo + j * 256 + lane * 4) = o;
        }
    }
}

__device__ __forceinline__ void gdn_sample_pass(const Params& p, char* smem, int pass, int tid) {
    float* sq = (float*)smem;
    float* sk = sq + 256;
    float* part = sk + 256;
    float* part2 = part + 16;
    const int lane = tid & 63, wave = tid >> 6, ug = wave >> 2, wq = wave & 3;
    const int half = lane >> 5, v = wq * 32 + (lane & 31);
    const int u = pass * 2 + ug, b = u >> 4, h = u & 15, kh = h >> 1;
    const size_t row0 = (size_t)NPR + (size_t)b * DS;
    float S[64];
    {
        const float* Sp = p.state_gdn + ((size_t)(b * 16 + h) * 128 + half * 64) * 128 + v;
#pragma unroll
        for (int k = 0; k < 64; ++k) S[k] = Sp[(size_t)k * 128];
    }
    const float Aexp = __expf(p.gdn_a_log[h]);
    const float dtb = p.gdn_dt_bias[h];
    const float nw = p.gdn_norm_w[v];
    const int chA = (half ? 1024 : 0) + kh * 128 + v, chv = 2048 + h * 128 + v;
    float cA[4], cv[4];
#pragma unroll
    for (int j = 0; j < 4; ++j) { cA[j] = p.gdn_conv_w[j * 4096 + chA]; cv[j] = p.gdn_conv_w[j * 4096 + chv]; }
    float xA[7], xv[7];
#pragma unroll
    for (int i = 0; i < 3; ++i) {
        const float* cs = p.state_conv + ((size_t)b * 3 + i) * 4096;
        xA[i] = cs[chA]; xv[i] = cs[chv];
    }
#pragma unroll
    for (int i = 0; i < 4; ++i) {
        const bf16_t* mr = p.mixed + (row0 + i) * 4096;
        xA[3 + i] = bf2f(mr[chA]); xv[3 + i] = bf2f(mr[chv]);
    }
    float* sqg = sq + ug * 128;
    float* skg = sk + ug * 128;
    float* pg = part + ug * 8;
    float* pg2 = part2 + ug * 4;
    const float* kmine = skg + half * 64;
    const float* qmine = sqg + half * 64;
#pragma unroll
    for (int t = 0; t < DS; ++t) {
        const float yA = silu(xA[t] * cA[0] + xA[t + 1] * cA[1] + xA[t + 2] * cA[2] + xA[t + 3] * cA[3]);
        const float yv = silu(xv[t] * cv[0] + xv[t + 1] * cv[1] + xv[t + 2] * cv[2] + xv[t + 3] * cv[3]);
        (half ? skg : sqg)[v] = yA;
        float ssA = yA * yA;
#pragma unroll
        for (int o = 1; o < 32; o <<= 1) ssA += __shfl_xor(ssA, o);
        if ((lane & 31) == 0) pg[wq * 2 + half] = ssA;
        lds_barrier();
        const float qn = rsqrtf((pg[0] + pg[2]) + (pg[4] + pg[6]) + 1e-6f) * 0.08838834764831845f;
        const float kn = rsqrtf((pg[1] + pg[3]) + (pg[5] + pg[7]) + 1e-6f);
        const float* bap = p.ba + (row0 + t) * 32;
        const float beta = 1.f / (1.f + __expf(-bap[h]));
        const float aa = bap[16 + h] + dtb;
        const float sp = (aa > 20.f) ? aa : log1pf(__expf(aa));
        const float dec = __expf(-Aexp * sp);
        float kS0 = 0.f, kS1 = 0.f;
#pragma unroll
        for (int k = 0; k < 64; k += 4) {
            const f32x4 kk = *(const f32x4*)(kmine + k);
            S[k] *= dec; S[k + 1] *= dec; S[k + 2] *= dec; S[k + 3] *= dec;
            kS0 += kk[0] * S[k]; kS1 += kk[1] * S[k + 1]; kS0 += kk[2] * S[k + 2]; kS1 += kk[3] * S[k + 3];
        }
        float kS = kS0 + kS1;
        kS += __shfl_xor(kS, 32);
        const float delta = (yv - kS * kn) * beta * kn;
        float o0 = 0.f, o1 = 0.f;
#pragma unroll
        for (int k = 0; k < 64; k += 4) {
            const f32x4 kk = *(const f32x4*)(kmine + k);
            const f32x4 qq = *(const f32x4*)(qmine + k);
            S[k] += kk[0] * delta; S[k + 1] += kk[1] * delta; S[k + 2] += kk[2] * delta; S[k + 3] += kk[3] * delta;
            o0 += qq[0] * S[k]; o1 += qq[1] * S[k + 1]; o0 += qq[2] * S[k + 2]; o1 += qq[3] * S[k + 3];
        }
        float o = o0 + o1;
        o = (o + __shfl_xor(o, 32)) * qn;
        float s3 = o * o;
#pragma unroll
        for (int x = 1; x < 32; x <<= 1) s3 += __shfl_xor(s3, x);
        if (lane == 0) pg2[wq] = s3;
        lds_barrier();
        if (half == 0) {
            const float rms = rsqrtf(((pg2[0] + pg2[1]) + (pg2[2] + pg2[3])) * (1.f / 128.f) + 1e-6f);
            const float zz = bf2f(p.z[(row0 + t) * 2048 + h * 128 + v]);
            p.gated[(row0 + t) * 2048 + h * 128 + v] = f2bf(o * rms * nw * silu(zz));
        }
    }
    {
        float* So = p.gs_sample + ((size_t)(b * 16 + h) * 128 + half * 64) * 128 + v;
#pragma unroll
        for (int k = 0; k < 64; ++k) So[(size_t)k * 128] = S[k];
    }
    lds_barrier();
}

#define MFMA32(a, b, c) __builtin_amdgcn_mfma_f32_32x32x16_bf16((a), (b), (c), 0, 0, 0)
constexpr int NCH = 65;
constexpr int NCU = BATCH * 16 * NCH;
__device__ __forceinline__ int crow(int reg, int hh) { return (reg & 3) + 8 * (reg >> 2) + 4 * hh; }
__device__ __forceinline__ bf16x8 pack_step(const f32x16& x, int s) {
    u32x4 q;
    q[0] = pk2(x[8 * s + 0], x[8 * s + 1]); q[1] = pk2(x[8 * s + 2], x[8 * s + 3]);
    q[2] = pk2(x[8 * s + 4], x[8 * s + 5]); q[3] = pk2(x[8 * s + 6], x[8 * s + 7]);
    return __builtin_bit_cast(bf16x8, q);
}
__device__ __forceinline__ bf16x8 frag_perm(const bf16_t* p0) {
    const uint2 lo = *(const uint2*)p0, hi = *(const uint2*)(p0 + 8);
    u32x4 q; q[0] = lo.x; q[1] = lo.y; q[2] = hi.x; q[3] = hi.y;
    return __builtin_bit_cast(bf16x8, q);
}

constexpr int SA_KB = 64 * 136 * 2, SA_VB = 2 * SA_KB, SA_AM = 3 * SA_KB, SA_SM = SA_AM + 64 * 68 * 4, SA_GROUP_BYTES = SA_SM + 5 * 64 * 4;
__device__ __forceinline__ void gdn_stageA(const Params& p, char* smem0, int bid, int nb) {
    {
        const int tid = tid_opaque();
        for (int idx = bid * NTHR + tid; idx < (BATCH + DB) * 3 * 4096; idx += nb * NTHR) {
            const int c = idx & 4095, r = (idx >> 12) % 3, b = idx / (3 * 4096);
            if (b < BATCH) p.gc_prompt[idx] = bf2f(p.mixed[((size_t)b * LP + (LP - 3) + r) * 4096 + c]);
            else { const int bs = b - BATCH; p.gc_sample[(size_t)(bs * 3 + r) * 4096 + c] = bf2f(p.mixed[((size_t)NPR + bs * 4 + 1 + r) * 4096 + c]); }
        }
    }
    for (int base = bid * 2; base < NCU; base += nb * 2) {
        const int tid = tid_opaque(), lane = tid & 63, grp = tid >> 8, wg = (tid >> 6) & 3, t2 = tid & 255;
        unsigned zofs = 0; asm volatile("" : "+v"(zofs));
        char* smem = smem0 + zofs + grp * SA_GROUP_BYTES;
        bf16_t* Qb = (bf16_t*)smem;
        bf16_t* Kb = (bf16_t*)(smem + SA_KB);
        bf16_t* Vb = (bf16_t*)(smem + SA_VB);
        float* Am = (float*)(smem + SA_AM);
        float* sbeta = (float*)(smem + SA_SM);
        float* sgc = sbeta + 64;
        float* segc = sgc + 64;
        float* sekd = segc + 64;
        float* srk = sekd + 64;
        const int u = base + grp;
        const int h = u & 15, n = (u >> 4) % NCH, b = u / (16 * NCH);
        const int kh = h >> 1;
        const size_t su = (size_t)((b * 16 + h) * NCH + n);
        const int t0 = n * 64;
        {
            const int cq = lane & 31, tsel = lane >> 5;
            const int tl0 = 16 * wg + 8 * tsel;
#pragma unroll
            for (int part = 0; part < 3; ++part) {
                const int chb = ((part == 0) ? (kh * 128) : (part == 1) ? (1024 + kh * 128) : (2048 + h * 128)) + cq * 4;
                f32x4 cw[4];
#pragma unroll
                for (int j = 0; j < 4; ++j) cw[j] = *(const f32x4*)(p.gdn_conv_w + j * 4096 + chb);
                uint2 xr[11];
#pragma unroll
                for (int i = 0; i < 11; ++i) {
                    const int t = t0 + tl0 - 3 + i;
                    if (t >= 0 && t < LP) xr[i] = *(const uint2*)(p.mixed + ((size_t)b * LP + t) * 4096 + chb);
                    else xr[i] = make_uint2(0u, 0u);
                }
                f32x4 yv[8];
                float ssv[8];
#pragma unroll
                for (int i = 0; i < 8; ++i) {
                    const f32x4 a = cvt_bf16x4(xr[i]) * cw[0] + cvt_bf16x4(xr[i + 1]) * cw[1] + cvt_bf16x4(xr[i + 2]) * cw[2] + cvt_bf16x4(xr[i + 3]) * cw[3];
                    const bool valid = (t0 + tl0 + i) < LP;
#pragma unroll
                    for (int e2 = 0; e2 < 4; ++e2) yv[i][e2] = valid ? silu(a[e2]) : 0.f;
                    ssv[i] = (yv[i][0] * yv[i][0] + yv[i][1] * yv[i][1]) + (yv[i][2] * yv[i][2] + yv[i][3] * yv[i][3]);
                }
                if (part < 2) {
#pragma unroll
                    for (int o = 1; o < 32; o <<= 1)
#pragma unroll
                        for (int i = 0; i < 8; ++i) ssv[i] += __shfl_xor(ssv[i], o);
                }
                bf16_t* dst = (part == 0) ? Qb : (part == 1) ? Kb : Vb;
#pragma unroll
                for (int i = 0; i < 8; ++i) {
                    f32x4 y = yv[i];
                    if (part < 2) y = y * (rsqrtf(ssv[i] + 1e-6f) * ((part == 0) ? 0.08838834764831845f : 1.f));
                    st_bf16x4(dst + (tl0 + i) * 136 + cq * 4, y);
                }
            }
        }
        if (wg == 0) {
            const int c = lane, t = t0 + c;
            float beta = 0.f, g = 0.f;
            if (t < LP) {
                const float* bap = p.ba + ((size_t)b * LP + t) * 32;
                beta = 1.f / (1.f + __expf(-bap[h]));
                const float aa = bap[16 + h] + p.gdn_dt_bias[h];
                const float sp = (aa > 20.f) ? aa : log1pf(__expf(aa));
                g = -__expf(p.gdn_a_log[h]) * sp;
            }
            float gc = g;
#pragma unroll
            for (int o = 1; o < 64; o <<= 1) { const float v = __shfl_up(gc, o); if (lane >= o) gc += v; }
            const float glast = __shfl(gc, 63);
            sbeta[c] = beta; sgc[c] = gc; segc[c] = __expf(gc); sekd[c] = __expf(glast - gc); srk[c] = beta * __expf(gc);
            if (lane == 0) p.g_dec[su] = __expf(glast);
        }
        lds_barrier();
        {
            const int ti = wg >> 1, tj = wg & 1;
            const int r = lane & 31, hh = lane >> 5;
            const int c = 32 * tj + r;
            const float gcc = sgc[c], bc = sbeta[c];
#pragma unroll
            for (int which = 0; which < 2; ++which) {
                f32x16 acc;
#pragma unroll
                for (int i = 0; i < 16; ++i) acc[i] = 0.f;
                const bf16_t* Ap = Kb + (32 * ti + r) * 136 + 8 * hh;
                const bf16_t* Bp = (which ? Qb : Kb) + (32 * tj + r) * 136 + 8 * hh;
#pragma unroll
                for (int ks = 0; ks < 8; ++ks) acc = MFMA32(*(const bf16x8*)(Ap + 16 * ks), *(const bf16x8*)(Bp + 16 * ks), acc);
                if (which == 0) {
#pragma unroll
                    for (int reg = 0; reg < 16; ++reg) {
                        const int cp = 32 * ti + crow(reg, hh);
                        const float dcy = __expf(fminf(gcc - sgc[cp], 0.f));
                        Am[c * 68 + cp] = (cp < c) ? (bc * acc[reg] * dcy) : 0.f;
                    }
                } else {
                    bf16_t* aq = p.g_aqk + su * 4096 + (size_t)c * 64;
#pragma unroll
                    for (int g4 = 0; g4 < 4; ++g4) {
                        const int cp0 = 32 * ti + 8 * g4 + 4 * hh;
                        f32x4 v;
#pragma unroll
                        for (int e2 = 0; e2 < 4; ++e2) {
                            const int cp = cp0 + e2;
                            const float dcy = __expf(fminf(gcc - sgc[cp], 0.f));
                            v[e2] = (cp <= c) ? (acc[4 * g4 + e2] * dcy) : 0.f;
                        }
                        st_bf16x4(aq + cp0, v);
                    }
                }
            }
        }
        {
#pragma unroll
            for (int it = 0; it < 4; ++it) {
                const int chk = t2 + 256 * it, c = chk >> 4, d0 = (chk & 15) * 8;
                const float ee = segc[c];
                const uint4 raw = *(const uint4*)(Qb + c * 136 + d0);
                uint4 o;
                o.x = pk2(__uint_as_float(raw.x << 16) * ee, __uint_as_float(raw.x & 0xffff0000u) * ee);
                o.y = pk2(__uint_as_float(raw.y << 16) * ee, __uint_as_float(raw.y & 0xffff0000u) * ee);
                o.z = pk2(__uint_as_float(raw.z << 16) * ee, __uint_as_float(raw.z & 0xffff0000u) * ee);
                o.w = pk2(__uint_as_float(raw.w << 16) * ee, __uint_as_float(raw.w & 0xffff0000u) * ee);
                *(uint4*)(p.g_qg + su * 8192 + c * 128 + d0) = o;
            }
#pragma unroll
            for (int it = 0; it < 4; ++it) {
                const int item = t2 + 256 * it, d = item & 127, c0 = (item >> 7) * 8;
                float v[8];
#pragma unroll
                for (int i = 0; i < 8; ++i) v[i] = bf2f(Kb[(c0 + i) * 136 + d]) * sekd[c0 + i];
                uint4 o; o.x = pk2(v[0], v[1]); o.y = pk2(v[2], v[3]); o.z = pk2(v[4], v[5]); o.w = pk2(v[6], v[7]);
                *(uint4*)(p.g_kdT + su * 8192 + d * 64 + c0) = o;
            }
        }
        lds_barrier();
        {
            const int col = 64 * wg + lane;
            const float* rs = sbeta + __builtin_amdgcn_readfirstlane((wg < 2) ? 0 : 256);
            const bf16_t* src = ((wg < 2) ? Vb : Kb) + (col & 127);
            float x[64];
#pragma unroll
            for (int i = 0; i < 64; ++i) x[i] = bf2f(src[i * 136]) * rs[i];
#pragma unroll
            for (int i0 = 0; i0 < 64; i0 += 4) {
                float a0 = x[i0], a1 = x[i0 + 1], a2 = x[i0 + 2], a3 = x[i0 + 3];
#pragma unroll
                for (int j4 = 0; j4 < i0; j4 += 4) {
                    const f32x4 r0 = *(const f32x4*)(Am + (i0) * 68 + j4), r1 = *(const f32x4*)(Am + (i0 + 1) * 68 + j4);
                    const f32x4 r2 = *(const f32x4*)(Am + (i0 + 2) * 68 + j4), r3 = *(const f32x4*)(Am + (i0 + 3) * 68 + j4);
                    a0 -= r0[0] * x[j4]; a1 -= r1[0] * x[j4]; a2 -= r2[0] * x[j4]; a3 -= r3[0] * x[j4];
                    a0 -= r0[1] * x[j4 + 1]; a1 -= r1[1] * x[j4 + 1]; a2 -= r2[1] * x[j4 + 1]; a3 -= r3[1] * x[j4 + 1];
                    a0 -= r0[2] * x[j4 + 2]; a1 -= r1[2] * x[j4 + 2]; a2 -= r2[2] * x[j4 + 2]; a3 -= r3[2] * x[j4 + 2];
                    a0 -= r0[3] * x[j4 + 3]; a1 -= r1[3] * x[j4 + 3]; a2 -= r2[3] * x[j4 + 3]; a3 -= r3[3] * x[j4 + 3];
                    if ((j4 & 12) == 12) asm volatile("" ::: "memory");
                }
                const f32x4 t1 = *(const f32x4*)(Am + (i0 + 1) * 68 + i0), t2v = *(const f32x4*)(Am + (i0 + 2) * 68 + i0), t3 = *(const f32x4*)(Am + (i0 + 3) * 68 + i0);
                a1 -= t1[0] * a0;
                a2 -= t2v[0] * a0; a2 -= t2v[1] * a1;
                a3 -= t3[0] * a0; a3 -= t3[1] * a1; a3 -= t3[2] * a2;
                x[i0] = a0; x[i0 + 1] = a1; x[i0 + 2] = a2; x[i0 + 3] = a3;
                asm volatile("" ::: "memory");
            }
            if (wg < 2) {
                float* up = p.g_u + su * 8192 + col;
#pragma unroll
                for (int i = 0; i < 64; ++i) up[i * 128] = x[i];
            } else {
                bf16_t* wp = p.g_negw + su * 8192 + (col - 128);
#pragma unroll
                for (int i = 0; i < 64; ++i) wp[i * 128] = f2bf(-x[i]);
            }
        }
        lds_barrier();
    }
}

constexpr int GB_NW = 0, GB_QG = 64 * 136, GB_KD = 2 * 64 * 136, GB_AQ = 2 * 64 * 136 + 128 * 72, GB_ELEMS = 2 * 64 * 136 + 128 * 72 + 64 * 72;
__device__ __forceinline__ void gdn_chain(const Params& p, char* smem, int b, int h) {
    bf16_t* lds = (bf16_t*)smem;
    const int tid = tid_opaque(), lane = tid & 63, wave = tid >> 6;
    const int r = lane & 31, hh = lane >> 5;
    const size_t su0 = (size_t)(b * 16 + h) * NCH;
    const bool loader = wave >= 4;
    const int t2 = tid - 256;
    uint4 sa0, sa1, sa2, sa3, sa4, sa5, sa6, sa7, sa8, sa9, sa10, sa11, sa12, sa13;
    uint4 sb0, sb1, sb2, sb3, sb4, sb5, sb6, sb7, sb8, sb9, sb10, sb11, sb12, sb13;
    f32x16 S[4], un0, un1;
#pragma unroll
    for (int i = 0; i < 4; ++i)
#pragma unroll
        for (int j = 0; j < 16; ++j) S[i][j] = 0.f;
    const int ch0 = t2, ch1 = t2 + 256, ch2 = t2 + 512, ch3 = t2 + 768;
#define GB_GLOAD(P, n_) do { const size_t su_ = su0 + (n_); \
        const bf16_t* a_ = p.g_negw + su_ * 8192; const bf16_t* b_ = p.g_qg + su_ * 8192; const bf16_t* c_ = p.g_kdT + su_ * 8192; const bf16_t* d_ = p.g_aqk + su_ * 4096; \
        P##0 = *(const uint4*)(a_ + (size_t)ch0 * 8); P##1 = *(const uint4*)(a_ + (size_t)ch1 * 8); P##2 = *(const uint4*)(a_ + (size_t)ch2 * 8); P##3 = *(const uint4*)(a_ + (size_t)ch3 * 8); \
        P##4 = *(const uint4*)(b_ + (size_t)ch0 * 8); P##5 = *(const uint4*)(b_ + (size_t)ch1 * 8); P##6 = *(const uint4*)(b_ + (size_t)ch2 * 8); P##7 = *(const uint4*)(b_ + (size_t)ch3 * 8); \
        P##8 = *(const uint4*)(c_ + (size_t)ch0 * 8); P##9 = *(const uint4*)(c_ + (size_t)ch1 * 8); P##10 = *(const uint4*)(c_ + (size_t)ch2 * 8); P##11 = *(const uint4*)(c_ + (size_t)ch3 * 8); \
        P##12 = *(const uint4*)(d_ + (size_t)ch0 * 8); P##13 = *(const uint4*)(d_ + (size_t)ch1 * 8); } while (0)
#define GB_SSTORE(P, buf_) do { bf16_t* q_ = (buf_); \
        *(uint4*)(q_ + GB_NW + (ch0 >> 4) * 136 + (ch0 & 15) * 8) = P##0; *(uint4*)(q_ + GB_NW + (ch1 >> 4) * 136 + (ch1 & 15) * 8) = P##1; \
        *(uint4*)(q_ + GB_NW + (ch2 >> 4) * 136 + (ch2 & 15) * 8) = P##2; *(uint4*)(q_ + GB_NW + (ch3 >> 4) * 136 + (ch3 & 15) * 8) = P##3; \
        *(uint4*)(q_ + GB_QG + (ch0 >> 4) * 136 + (ch0 & 15) * 8) = P##4; *(uint4*)(q_ + GB_QG + (ch1 >> 4) * 136 + (ch1 & 15) * 8) = P##5; \
        *(uint4*)(q_ + GB_QG + (ch2 >> 4) * 136 + (ch2 & 15) * 8) = P##6; *(uint4*)(q_ + GB_QG + (ch3 >> 4) * 136 + (ch3 & 15) * 8) = P##7; \
        *(uint4*)(q_ + GB_KD + (ch0 >> 3) * 72 + (ch0 & 7) * 8) = P##8; *(uint4*)(q_ + GB_KD + (ch1 >> 3) * 72 + (ch1 & 7) * 8) = P##9; \
        *(uint4*)(q_ + GB_KD + (ch2 >> 3) * 72 + (ch2 & 7) * 8) = P##10; *(uint4*)(q_ + GB_KD + (ch3 >> 3) * 72 + (ch3 & 7) * 8) = P##11; \
        *(uint4*)(q_ + GB_AQ + (ch0 >> 3) * 72 + (ch0 & 7) * 8) = P##12; *(uint4*)(q_ + GB_AQ + (ch1 >> 3) * 72 + (ch1 & 7) * 8) = P##13; } while (0)
#define GB_ULOAD(n_) do { const float* up_ = p.g_u + (su0 + (n_)) * 8192 + 32 * wave + r; \
        _Pragma("unroll") for (int reg_ = 0; reg_ < 16; ++reg_) { un0[reg_] = up_[(crow(reg_, hh)) * 128]; un1[reg_] = up_[(32 + crow(reg_, hh)) * 128]; } } while (0)
    if (loader) {
        bf16_t* buf0 = lds;
        bf16_t* buf1 = lds + GB_ELEMS;
        GB_GLOAD(sa, 0); GB_SSTORE(sa, buf0);
        GB_GLOAD(sa, 1);
        lds_barrier();
        for (int n = 0; n < NCH; n += 2) {
            if (n + 2 < NCH) { GB_GLOAD(sb, n + 2); }
            if (n + 1 < NCH) { GB_SSTORE(sa, buf1); }
            lds_barrier();
            if (n + 1 >= NCH) break;
            if (n + 3 < NCH) { GB_GLOAD(sa, n + 3); }
            if (n + 2 < NCH) { GB_SSTORE(sb, buf0); }
            lds_barrier();
        }
    } else {
        GB_ULOAD(0);
        float dec_next = p.g_dec[su0];
        lds_barrier();
        for (int n = 0; n < NCH; ++n) {
            unsigned zofs = 0; asm volatile("" : "+v"(zofs));
            bf16_t* cur = lds + (n & 1) * GB_ELEMS + zofs;
            const bool more = (n + 1 < NCH);
            const float dec = dec_next;
            if (more) dec_next = p.g_dec[su0 + n + 1];
            f32x16 vn[2], o[2];
            vn[0] = un0; vn[1] = un1;
#pragma unroll
            for (int j = 0; j < 16; ++j) { o[0][j] = 0.f; o[1][j] = 0.f; }
            if (more) { GB_ULOAD(n + 1); }
#pragma unroll
            for (int kt = 0; kt < 4; ++kt)
#pragma unroll
                for (int s = 0; s < 2; ++s) {
                    const bf16x8 sb = pack_step(S[kt], s);
                    const int k0 = 32 * kt + 16 * s + 4 * hh;
#pragma unroll
                    for (int ct = 0; ct < 2; ++ct) {
                        vn[ct] = MFMA32(frag_perm(cur + GB_NW + (32 * ct + r) * 136 + k0), sb, vn[ct]);
                        o[ct] = MFMA32(frag_perm(cur + GB_QG + (32 * ct + r) * 136 + k0), sb, o[ct]);
                    }
                }
            bf16x8 vb[2][2];
#pragma unroll
            for (int ct = 0; ct < 2; ++ct)
#pragma unroll
                for (int s = 0; s < 2; ++s) vb[ct][s] = pack_step(vn[ct], s);
#pragma unroll
            for (int s = 0; s < 2; ++s) {
                o[0] = MFMA32(frag_perm(cur + GB_AQ + (r) * 72 + 16 * s + 4 * hh), vb[0][s], o[0]);
                o[1] = MFMA32(frag_perm(cur + GB_AQ + (32 + r) * 72 + 16 * s + 4 * hh), vb[0][s], o[1]);
                o[1] = MFMA32(frag_perm(cur + GB_AQ + (32 + r) * 72 + 32 + 16 * s + 4 * hh), vb[1][s], o[1]);
            }
#pragma unroll
            for (int dt = 0; dt < 4; ++dt) {
                S[dt] = S[dt] * dec;
#pragma unroll
                for (int ckt = 0; ckt < 2; ++ckt)
#pragma unroll
                    for (int s = 0; s < 2; ++s)
                        S[dt] = MFMA32(frag_perm(cur + GB_KD + (32 * dt + r) * 72 + 32 * ckt + 16 * s + 4 * hh), vb[ckt][s], S[dt]);
            }
            asm volatile("" :: "v"(un0), "v"(un1), "v"(dec_next));
#pragma unroll
            for (int ct = 0; ct < 2; ++ct)
#pragma unroll
                for (int reg = 0; reg < 16; ++reg) {
                    const int t = 64 * n + 32 * ct + crow(reg, hh);
                    if (t < LP) p.g_o[(((size_t)b * LP + t) * 16 + h) * 128 + 32 * wave + r] = f2bf(o[ct][reg]);
                }
            lds_barrier();
        }
    }
    if (!loader) {
#pragma unroll
        for (int dt = 0; dt < 4; ++dt)
#pragma unroll
            for (int reg = 0; reg < 16; ++reg)
                p.gs_prompt[((size_t)(b * 16 + h) * 128 + 32 * dt + crow(reg, hh)) * 128 + 32 * wave + r] = S[dt][reg];
    }
    lds_barrier();
}

__device__ __forceinline__ void gdn_seq_phase(const Params& p, char* smem, int bid, int nb, int rep = 0) {
    if (bid < 64) gdn_chain(p, smem, bid >> 4, bid & 15);
    int* slot = (int*)(smem + LDS_BYTES - 32);
    const int tid = tid_opaque();
    for (;;) {
        if (threadIdx.x == 0) *slot = (int)atomicAdd(p.bar + 3520 + 16 * rep, 1u);
        lds_barrier();
        const int u = *slot;
        lds_barrier();
        if (u >= DB * 16 / 2) break;
        gdn_sample_pass(p, smem, u, tid_opaque());
    }
}

__device__ __forceinline__ void gdn_gate_phase(const Params& p, int bid, int nb) {
    const int tid_ = tid_opaque(); const int lane = tid_ & 63, wave = tid_ >> 6;
    const int sub = lane >> 4, l16 = lane & 15;
    f32x4 nw0 = *(const f32x4*)(p.gdn_norm_w + l16 * 8), nw1 = *(const f32x4*)(p.gdn_norm_w + l16 * 8 + 4);
    for (int it4 = bid * 8 + wave; it4 < NPR * 4; it4 += nb * 8) {
        const size_t off = ((size_t)it4 * 4 + sub) * 128 + l16 * 8;
        const uint4 ov = *(const uint4*)(p.g_o + off);
        const uint4 zv = *(const uint4*)(p.z + off);
        const f32x4 o0 = cvt_bf16x4(make_uint2(ov.x, ov.y)), o1 = cvt_bf16x4(make_uint2(ov.z, ov.w));
        const f32x4 z0 = cvt_bf16x4(make_uint2(zv.x, zv.y)), z1 = cvt_bf16x4(make_uint2(zv.z, zv.w));
        float ss = ((o0[0] * o0[0] + o0[1] * o0[1]) + (o0[2] * o0[2] + o0[3] * o0[3])) + ((o1[0] * o1[0] + o1[1] * o1[1]) + (o1[2] * o1[2] + o1[3] * o1[3]));
#pragma unroll
        for (int x = 1; x < 16; x <<= 1) ss += __shfl_xor(ss, x);
        const float rms = rsqrtf(ss * (1.f / 128.f) + 1e-6f);
        uint4 g;
        g.x = pk2(o0[0] * rms * nw0[0] * silu(z0[0]), o0[1] * rms * nw0[1] * silu(z0[1]));
        g.y = pk2(o0[2] * rms * nw0[2] * silu(z0[2]), o0[3] * rms * nw0[3] * silu(z0[3]));
        g.z = pk2(o1[0] * rms * nw1[0] * silu(z1[0]), o1[1] * rms * nw1[1] * silu(z1[1]));
        g.w = pk2(o1[2] * rms * nw1[2] * silu(z1[2]), o1[3] * rms * nw1[3] * silu(z1[3]));
        *(uint4*)(p.gated + off) = g;
    }
}

__device__ __forceinline__ void rope4(const float* tab, int fi, f32x4 x, f32x4 partner, bool first, f32x4& o) {
    const f32x4 t0 = *(const f32x4*)(tab + fi * 2), t1 = *(const f32x4*)(tab + fi * 2 + 4);
    const float sg = first ? -1.f : 1.f;
    o[0] = x[0] * t0[0] + sg * partner[0] * t0[1];
    o[1] = x[1] * t0[2] + sg * partner[1] * t0[3];
    o[2] = x[2] * t1[0] + sg * partner[2] * t1[1];
    o[3] = x[3] * t1[2] + sg * partner[3] * t1[3];
}
__device__ __forceinline__ void dsa_post_phase(const Params& p, char* smem, int bid, int nb) {
    bf16_t* vt = (bf16_t*)smem;
    for (int u = bid; u < BATCH * 65 + 8; u += nb) {
        const int tid = tid_opaque(); const int lane = tid & 63, wave = tid >> 6;
        const bool prompt = u < BATCH * 65;
        const int b = prompt ? (u / 65) : 0, t0 = prompt ? (u % 65) * 64 : 0;
        for (int r8 = 0; r8 < 8; ++r8) {
            const int tl = wave * 8 + r8;
            const int t = t0 + tl;
            const bool rvalid = prompt ? (t < LP) : true;
            const int row = prompt ? (b * LP + t) : (NPR + (u - BATCH * 65) * 64 + tl);
            if (!rvalid) {
                for (int e = lane; e < 256; e += 64) vt[e * 72 + tl] = 0;
                continue;
            }
            const float* P = p.p1 + (size_t)row * DIN_PAD;
            const int pos = prompt ? t : (PAST + ((row - NPR) & 3));
            const float* tab = p.rope_tab + (size_t)pos * 48;
            float* kout = prompt ? (p.k_prompt + (size_t)row * 256) : (p.k_sample + (size_t)(row - NPR) * 256);
            float* vout = prompt ? (p.v_prompt + (size_t)row * 256) : (p.v_sample + (size_t)(row - NPR) * 256);
#pragma unroll
            for (int j = 0; j < 5; ++j) {
                const int e0 = (lane + 64 * j) * 4, d0 = e0 & 127;
                f32x4 x = *(const f32x4*)(P + e0);
                if (d0 < 32) {
                    const bool first = d0 < 16;
                    const f32x4 pr = *(const f32x4*)(P + (first ? e0 + 16 : e0 - 16));
                    rope4(tab, d0 & 15, x, pr, first, x);
                }
                if (j < 4) {
                    if (prompt) st_bf16x4(p.q_b + (size_t)row * 1024 + e0, x * 0.12751743f);
                    else *(f32x4*)(p.qr + (size_t)row * 1024 + e0) = x;
                } else {
                    const int ek = e0 - 1024;
                    *(f32x4*)(kout + ek) = x;
                    if (prompt) st_bf16x4(p.k_b + ((size_t)(b * 2 + (ek >> 7)) * LPAD + t) * 128 + d0, x);
                }
            }
            {
                const int e0 = lane * 4;
                const f32x4 x = *(const f32x4*)(P + 1280 + e0);
                *(f32x4*)(vout + e0) = x;
                if (prompt) {
#pragma unroll
                    for (int i = 0; i < 4; ++i) vt[(e0 + i) * 72 + tl] = f2bf(x[i]);
                }
            }
#pragma unroll
            for (int j = 0; j < 2; ++j) {
                const int e0 = (lane + 64 * j) * 4, d0 = e0 & 63;
                f32x4 x = *(const f32x4*)(P + 1536 + e0);
                if (d0 < 16) {
                    const bool first = d0 < 8;
                    const f32x4 pr = *(const f32x4*)(P + 1536 + (first ? e0 + 8 : e0 - 8));
                    rope4(tab, 16 + (d0 & 7), x, pr, first, x);
                }
                if (prompt) st_bf16x4(p.iq_b + (size_t)row * 512 + e0, x);
                else *(f32x4*)(p.iq + (size_t)row * 512 + e0) = x;
            }
            {
                const float x = P[2048 + lane];
                const float mu = wave_sum(x) * (1.f / 64.f);
                const float dv = x - mu;
                const float var = wave_sum(dv * dv) * (1.f / 64.f);
                const float xn = dv * rsqrtf(var + 1e-5f) * p.dsa_ik_g[lane] + p.dsa_ik_b[lane];
                const float other = __shfl_xor(xn, 8);
                float o = xn;
                if (lane < 16) {
                    const float c = tab[(16 + (lane & 7)) * 2], s = tab[(16 + (lane & 7)) * 2 + 1];
                    if (lane < 8) o = xn * c - other * s; else o = xn * c + other * s;
                }
                float* io = prompt ? (p.ik_prompt + (size_t)row * 64) : (p.ik_sample + (size_t)(row - NPR) * 64);
                io[lane] = o;
                if (prompt) p.ik_b[((size_t)b * LPAD + t) * 64 + lane] = f2bf(o);
            }
            if (lane < 8) p.iw[(size_t)row * 8 + lane] = P[2112 + lane] * 0.35355339059327373f;
        }
        lds_barrier();
        if (prompt) {
#pragma unroll
            for (int i = 0; i < 4; ++i) {
                const int ch = tid + 512 * i, rr = ch >> 3, c8 = (ch & 7) * 8;
                const uint4 v = *(const uint4*)(vt + rr * 72 + c8);
                *(uint4*)(p.vt_b + ((size_t)(b * 2 + (rr >> 7)) * 128 + (rr & 127)) * LPAD + t0 + c8) = v;
            }
        }
        lds_barrier();
    }
    for (int idx = bid * NTHR + tid_opaque(); idx < BATCH * (LPAD - LP) * 256; idx += nb * NTHR) {
        const int c = idx & 255, tp = (idx >> 8) % (LPAD - LP), bb = idx / ((LPAD - LP) * 256);
        const int t = LP + tp, kvh = c >> 7, d = c & 127;
        p.k_b[((size_t)(bb * 2 + kvh) * LPAD + t) * 128 + d] = 0;
        if (c < 64) p.ik_b[((size_t)bb * LPAD + t) * 64 + c] = 0;
        if (c < 65) p.maskT[((size_t)bb * 65 + c) * LPAD + t] = (c == 0) ? 1ull : 0ull;
    }
}

__device__ __forceinline__ const float* ik_row(const Params& p, bool prompt, int b, int s) {
    if (prompt) return p.ik_prompt + ((size_t)b * LP + s) * 64;
    if (s < PAST) { const int pg = p.page_table[b * 16 + (s >> 7)]; return p.cache_ik + ((size_t)pg * 128 + (s & 127)) * 64; }
    return p.ik_sample + ((size_t)b * DS + (s - PAST)) * 64;
}
__device__ __forceinline__ const float* kv_row(const float* own_p, const float* own_s, const float* cache, const int* page_table,
                                               bool prompt, int b, int s) {
    if (prompt) return own_p + ((size_t)b * LP + s) * 256;
    if (s < PAST) { const int pg = page_table[b * 16 + (s >> 7)]; return cache + ((size_t)pg * 128 + (s & 127)) * 256; }
    return own_s + ((size_t)b * DS + (s - PAST)) * 256;
}

template <bool PROMPT, int NREG>
__device__ __forceinline__ void select_emit(const float* sc, int qpos, int lane, unsigned long long* maskcol, int* selrow) {
    const unsigned long long ltmask = (1ull << lane) - 1ull;
    unsigned key[NREG];
    unsigned kmax = 0u, kmin = 0xffffffffu;
#pragma unroll
    for (int j = 0; j < NREG; ++j) {
        const int s = j * 64 + lane;
        const bool cand = (s >= 16 && s <= qpos);
        const float x = cand ? sc[s] : -INFINITY;
        const unsigned u = __float_as_uint(x);
        key[j] = (u & 0x80000000u) ? ~u : (u | 0x80000000u);
        kmax = max(kmax, key[j]);
        kmin = min(kmin, cand ? key[j] : 0xffffffffu);
    }
#pragma unroll
    for (int o = 1; o < 64; o <<= 1) { kmax = max(kmax, (unsigned)__shfl_xor((int)kmax, o)); kmin = min(kmin, (unsigned)__shfl_xor((int)kmin, o)); }
    unsigned lo = kmin, hi = kmax;
    bool exact = false;
    while (lo < hi) {
        const unsigned mid = lo + ((hi - lo) >> 1) + ((hi - lo) & 1u);
        int c = 0;
#pragma unroll
        for (int j = 0; j < NREG; ++j) c += __popcll(__ballot(key[j] >= mid));
        if (c >= 240) { lo = mid; if (c == 240) { exact = true; break; } } else hi = mid - 1u;
    }
    const unsigned T = lo;
    if (!PROMPT) { if (lane < 16) selrow[lane] = lane; }
    int base = 16;
    unsigned long long myword = 0ull, word64 = 0ull;
    if (exact) {
#pragma unroll
        for (int j = 0; j < NREG; ++j) {
            const bool take = key[j] >= T;
            unsigned long long m = __ballot(take);
            if (PROMPT) {
                if (j == 0) m |= 0xFFFFull;
                if (j < 64) { if (lane == j) myword = m; } else word64 = m;
            } else {
                if (take) selrow[base + __popcll(m & ltmask)] = j * 64 + lane;
                base += __popcll(m);
            }
        }
    } else {
        int cgt = 0;
#pragma unroll
        for (int j = 0; j < NREG; ++j) cgt += __popcll(__ballot(key[j] > T));
        const int need_eq = 240 - cgt;
        int erun = 0;
#pragma unroll
        for (int j = 0; j < NREG; ++j) {
            const bool gt = key[j] > T, eq = key[j] == T;
            const unsigned long long meq = __ballot(eq);
            const int rank = erun + __popcll(meq & ltmask);
            const bool take = gt || (eq && rank < need_eq);
            unsigned long long m = __ballot(take);
            if (PROMPT) {
                if (j == 0) m |= 0xFFFFull;
                if (j < 64) { if (lane == j) myword = m; } else word64 = m;
            } else {
                if (take) selrow[base + __popcll(m & ltmask)] = j * 64 + lane;
                base += __popcll(m);
            }
            erun += __popcll(meq);
        }
    }
    if (PROMPT) {
        if (NREG == 65) { maskcol[(size_t)lane * LPAD] = myword; if (lane == 0) maskcol[(size_t)64 * LPAD] = word64; }
        else { if (lane < NREG) maskcol[(size_t)lane * LPAD] = myword; else if (lane < 64) maskcol[(size_t)lane * LPAD] = 0ull; if (lane == 0) maskcol[(size_t)64 * LPAD] = 0ull; }
    }
}

__device__ __forceinline__ bf16x8 ld_f32x8_bf16(const float* p) {
    const f32x4 a = *(const f32x4*)p, b = *(const f32x4*)(p + 4);
    u32x4 q; q[0] = pk2(a[0], a[1]); q[1] = pk2(a[2], a[3]); q[2] = pk2(b[0], b[1]); q[3] = pk2(b[2], b[3]);
    return __builtin_bit_cast(bf16x8, q);
}
__device__ __forceinline__ void indexer_sample_unit(const Params& p, float* sc, int b, int tid) {
    const int lane = tid & 63, wave = tid >> 6;
    const int r = lane & 31, hh = lane >> 5;
    bf16x8 af[4];
    {
        const int e2 = r & 3, hb = (r >> 2) & 1, a = r >> 3;
        const int qi = 2 * hb + (a >> 1), head = 4 * (a & 1) + e2;
        const float* ap = p.iq + ((size_t)NPR + b * 4 + qi) * 512 + head * 64 + 8 * hh;
#pragma unroll
        for (int ks = 0; ks < 4; ++ks) af[ks] = ld_f32x8_bf16(ap + 16 * ks);
    }
    float wq[2][8];
#pragma unroll
    for (int ql = 0; ql < 2; ++ql) {
        const float* wp = p.iw + ((size_t)NPR + b * 4 + 2 * hh + ql) * 8;
        const f32x4 w0 = *(const f32x4*)wp, w1 = *(const f32x4*)(wp + 4);
#pragma unroll
        for (int e2 = 0; e2 < 4; ++e2) { wq[ql][e2] = w0[e2]; wq[ql][4 + e2] = w1[e2]; }
    }
    asm volatile("" :: "v"(af[0]), "v"(af[1]), "v"(af[2]), "v"(af[3]));
#pragma unroll
    for (int ql = 0; ql < 2; ++ql) asm volatile("" :: "v"(wq[ql][0]), "v"(wq[ql][1]), "v"(wq[ql][2]), "v"(wq[ql][3]), "v"(wq[ql][4]), "v"(wq[ql][5]), "v"(wq[ql][6]), "v"(wq[ql][7]));
    const float* kps[9];
#pragma unroll
    for (int i = 0; i < 9; ++i) {
        const int kt = wave + 8 * i;
        const int s = 32 * (kt < 65 ? kt : 64) + r;
        const float* kp;
        if (s < PAST) { const int pg = p.page_table[b * 16 + (s >> 7)]; kp = p.cache_ik + ((size_t)pg * 128 + (s & 127)) * 64; }
        else kp = p.ik_sample + ((size_t)b * DS + ((s - PAST) & 3)) * 64;
        kps[i] = kp + 8 * hh;
    }
    f32x4 nx[8];
#pragma unroll
    for (int ks = 0; ks < 4; ++ks) { nx[2 * ks] = *(const f32x4*)(kps[0] + 16 * ks); nx[2 * ks + 1] = *(const f32x4*)(kps[0] + 16 * ks + 4); }
#pragma unroll
    for (int i = 0; i < 9; ++i) {
        const int kt = wave + 8 * i;
        if (kt < 65) {
            const int s = 32 * kt + r;
            bf16x8 bq[4];
#pragma unroll
            for (int ks = 0; ks < 4; ++ks) {
                u32x4 q; q[0] = pk2(nx[2 * ks][0], nx[2 * ks][1]); q[1] = pk2(nx[2 * ks][2], nx[2 * ks][3]);
                q[2] = pk2(nx[2 * ks + 1][0], nx[2 * ks + 1][1]); q[3] = pk2(nx[2 * ks + 1][2], nx[2 * ks + 1][3]);
                bq[ks] = __builtin_bit_cast(bf16x8, q);
            }
            if (i + 1 < 9) {
#pragma unroll
                for (int ks = 0; ks < 4; ++ks) { nx[2 * ks] = *(const f32x4*)(kps[i + 1] + 16 * ks); nx[2 * ks + 1] = *(const f32x4*)(kps[i + 1] + 16 * ks + 4); }
            }
            f32x16 acc;
#pragma unroll
            for (int j = 0; j < 16; ++j) acc[j] = 0.f;
#pragma unroll
            for (int ks = 0; ks < 4; ++ks) acc = MFMA32(af[ks], bq[ks], acc);
#pragma unroll
            for (int ql = 0; ql < 2; ++ql) {
                float v = 0.f;
#pragma unroll
                for (int a2 = 0; a2 < 2; ++a2)
#pragma unroll
                    for (int e2 = 0; e2 < 4; ++e2) v += wq[ql][4 * a2 + e2] * fmaxf(acc[4 * (2 * ql + a2) + e2], 0.f);
                sc[(2 * hh + ql) * 2112 + s] = v;
            }
        }
    }
    lds_barrier();
    if (wave < 4) select_emit<false, 33>(sc + wave * 2112, PAST + wave, lane, nullptr, p.sel + ((size_t)NPR + b * 4 + wave) * 256);
    lds_barrier();
}

__device__ __forceinline__ void indexer_prompt_unit(const Params& p, float* sc, int b, int g8, int tid) {
    const int lane = tid & 63, wave = tid >> 6;
    const int r = lane & 31, hh = lane >> 5;
    const int t0 = g8 * 8;
    if (t0 < 256) {
        const int qpos = t0 + wave;
        unsigned long long* maskcol = p.maskT + (size_t)b * 65 * LPAD + qpos;
        for (int j = lane; j < 65; j += 64) {
            const int lo = j * 64;
            unsigned long long m = 0ull;
            if (qpos >= lo + 63) m = ~0ull; else if (qpos >= lo) m = (1ull << (qpos - lo + 1)) - 1ull;
            maskcol[(size_t)j * LPAD] = m;
        }
        return;
    }
    bf16x8 af[2][4];
    {
        const int e2 = r & 3, hb = (r >> 2) & 1, a = r >> 3;
        const int qi = 2 * hb + (a >> 1), head = 4 * (a & 1) + e2;
#pragma unroll
        for (int rt = 0; rt < 2; ++rt) {
            const bf16_t* ap = p.iq_b + ((size_t)b * LP + t0 + 4 * rt + qi) * 512 + head * 64 + 8 * hh;
#pragma unroll
            for (int ks = 0; ks < 4; ++ks) af[rt][ks] = *(const bf16x8*)(ap + 16 * ks);
        }
    }
    float wq[2][2][8];
#pragma unroll
    for (int rt = 0; rt < 2; ++rt)
#pragma unroll
        for (int ql = 0; ql < 2; ++ql) {
            const float* wp = p.iw + ((size_t)b * LP + t0 + 4 * rt + 2 * hh + ql) * 8;
            const f32x4 w0 = *(const f32x4*)wp, w1 = *(const f32x4*)(wp + 4);
#pragma unroll
            for (int e2 = 0; e2 < 4; ++e2) { wq[rt][ql][e2] = w0[e2]; wq[rt][ql][4 + e2] = w1[e2]; }
        }
    const int nkt = (t0 + 7) / 32 + 1;
    const bf16_t* kbase = p.ik_b + ((size_t)b * LPAD + r) * 64 + 8 * hh;
    bf16x8 bq[4], bn[4];
    {
        const int k1 = (wave + 8 < nkt) ? (wave + 8) : wave;
#pragma unroll
        for (int ks = 0; ks < 4; ++ks) { bq[ks] = *(const bf16x8*)(kbase + (size_t)wave * 32 * 64 + 16 * ks); bn[ks] = *(const bf16x8*)(kbase + (size_t)k1 * 32 * 64 + 16 * ks); }
    }
    asm volatile("" :: "v"(af[0][0]), "v"(af[0][1]), "v"(af[0][2]), "v"(af[0][3]), "v"(af[1][0]), "v"(af[1][1]), "v"(af[1][2]), "v"(af[1][3]));
#pragma unroll
    for (int rt = 0; rt < 2; ++rt)
#pragma unroll
        for (int ql = 0; ql < 2; ++ql) asm volatile("" :: "v"(wq[rt][ql][0]), "v"(wq[rt][ql][1]), "v"(wq[rt][ql][2]), "v"(wq[rt][ql][3]), "v"(wq[rt][ql][4]), "v"(wq[rt][ql][5]), "v"(wq[rt][ql][6]), "v"(wq[rt][ql][7]));
    for (int kt = wave; kt < nkt; kt += 8) {
        bf16x8 bn2[4];
        const int ktn = (kt + 16 < nkt) ? (kt + 16) : kt;
#pragma unroll
        for (int ks = 0; ks < 4; ++ks) bn2[ks] = *(const bf16x8*)(kbase + (size_t)ktn * 32 * 64 + 16 * ks);
#pragma unroll
        for (int rt = 0; rt < 2; ++rt) {
            f32x16 acc;
#pragma unroll
            for (int i = 0; i < 16; ++i) acc[i] = 0.f;
#pragma unroll
            for (int ks = 0; ks < 4; ++ks) acc = MFMA32(af[rt][ks], bq[ks], acc);
#pragma unroll
            for (int ql = 0; ql < 2; ++ql) {
                float s = 0.f;
#pragma unroll
                for (int a2 = 0; a2 < 2; ++a2)
#pragma unroll
                    for (int e2 = 0; e2 < 4; ++e2) s += wq[rt][ql][4 * a2 + e2] * fmaxf(acc[4 * (2 * ql + a2) + e2], 0.f);
                sc[(4 * rt + 2 * hh + ql) * 4160 + 32 * kt + r] = s;
            }
        }
#pragma unroll
        for (int ks = 0; ks < 4; ++ks) { bq[ks] = bn[ks]; bn[ks] = bn2[ks]; }
    }
    lds_barrier();
    {
        const int qpos = t0 + wave;
        if (t0 + 7 < 33 * 64) select_emit<true, 33>(sc + wave * 4160, qpos, lane, p.maskT + (size_t)b * 65 * LPAD + qpos, nullptr);
        else select_emit<true, 65>(sc + wave * 4160, qpos, lane, p.maskT + (size_t)b * 65 * LPAD + qpos, nullptr);
    }
    lds_barrier();
}

__device__ __forceinline__ void indexer_phase(const Params& p, char* smem, int bid, int nb, int rep = 0) {
    int* slot = (int*)(smem + LDS_BYTES - 32);
    for (;;) {
        const int tid = tid_opaque();
        unsigned zofs = 0; asm volatile("" : "+v"(zofs));
        float* sc = (float*)(smem + zofs);
        if (threadIdx.x == 0) *slot = (int)atomicAdd(p.bar + 3648 + 16 * rep, 1u);
        lds_barrier();
        const int u = *slot;
        lds_barrier();
        if (u >= DB + BATCH * 514) break;
        if (u < DB) {
            indexer_sample_unit(p, sc, u, tid);
        } else {
            const int v = u - DB;
            indexer_prompt_unit(p, sc, v & 3, 513 - (v >> 2), tid);
        }
    }
}

__device__ __forceinline__ void attn_sample_query(const Params& p, char* smem, int row) {
    float* qs = (float*)smem;
    float* ps = qs + 1024;
    const float** kptr = (const float**)(ps + 2048);
    const float** vptr = kptr + 256;
    float* red = (float*)(vptr + 256);
    const int tid = tid_opaque(), lane = tid & 63, wave = tid >> 6;
    const int b = (row - NPR) >> 2;
    qs[tid] = p.qr[(size_t)row * 1024 + tid];
    qs[tid + 512] = p.qr[(size_t)row * 1024 + 512 + tid];
    if (tid < 256) {
        const int s = p.sel[(size_t)row * 256 + tid];
        const float *kp, *vp;
        if (s < PAST) { const int pg = p.page_table[b * 16 + ((s < 0 ? 0 : s) >> 7)]; const size_t ro = ((size_t)pg * 128 + ((s < 0 ? 0 : s) & 127)) * 256; kp = p.cache_k + ro; vp = p.cache_v + ro; }
        else { const size_t ro = ((size_t)b * DS + (s - PAST)) * 256; kp = p.k_sample + ro; vp = p.v_sample + ro; }
        kptr[tid] = (s < 0) ? nullptr : kp;
        vptr[tid] = vp;
    }
    lds_barrier();
    {
        const int j = tid & 255, kvh = tid >> 8;
        const float* kp0 = kptr[j];
        const bool valid = kp0 != nullptr;
        const float* kp = (valid ? kp0 : vptr[j]) + kvh * 128;
        float d0 = 0.f, d1 = 0.f, d2 = 0.f, d3 = 0.f;
        const float* q0 = qs + (kvh * 4) * 128;
#pragma unroll 16
        for (int c = 0; c < 32; ++c) {
            const f32x4 kv = *(const f32x4*)(kp + c * 4);
            const f32x4 a0 = *(const f32x4*)(q0 + c * 4), a1 = *(const f32x4*)(q0 + 128 + c * 4), a2 = *(const f32x4*)(q0 + 256 + c * 4),
                        a3 = *(const f32x4*)(q0 + 384 + c * 4);
            d0 += kv[0] * a0[0] + kv[1] * a0[1] + kv[2] * a0[2] + kv[3] * a0[3];
            d1 += kv[0] * a1[0] + kv[1] * a1[1] + kv[2] * a1[2] + kv[3] * a1[3];
            d2 += kv[0] * a2[0] + kv[1] * a2[1] + kv[2] * a2[2] + kv[3] * a2[3];
            d3 += kv[0] * a3[0] + kv[1] * a3[1] + kv[2] * a3[2] + kv[3] * a3[3];
        }
        const float scl = 0.08838834764831845f;
        ps[(kvh * 4 + 0) * 256 + j] = valid ? d0 * scl : -INFINITY;
        ps[(kvh * 4 + 1) * 256 + j] = valid ? d1 * scl : -INFINITY;
        ps[(kvh * 4 + 2) * 256 + j] = valid ? d2 * scl : -INFINITY;
        ps[(kvh * 4 + 3) * 256 + j] = valid ? d3 * scl : -INFINITY;
    }
    lds_barrier();
    {
        float v[4]; float m = -INFINITY;
#pragma unroll
        for (int i = 0; i < 4; ++i) { v[i] = ps[wave * 256 + lane + 64 * i]; m = fmaxf(m, v[i]); }
        m = wave_max(m);
        float sum = 0.f;
#pragma unroll
        for (int i = 0; i < 4; ++i) { v[i] = __expf(v[i] - m); sum += v[i]; }
        sum = wave_sum(sum);
        const float inv = 1.f / sum;
#pragma unroll
        for (int i = 0; i < 4; ++i) ps[wave * 256 + lane + 64 * i] = v[i] * inv;
    }
    lds_barrier();
    {
        const int kvh = tid >> 8, kg = (tid >> 5) & 7, d4 = tid & 31;
        f32x4 acc[4];
#pragma unroll
        for (int g = 0; g < 4; ++g) acc[g] = (f32x4){0.f, 0.f, 0.f, 0.f};
#pragma unroll 16
        for (int i = 0; i < 32; ++i) {
            const int j = kg * 32 + i;
            const f32x4 vv = *(const f32x4*)(vptr[j] + kvh * 128 + d4 * 4);
#pragma unroll
            for (int g = 0; g < 4; ++g) acc[g] += vv * ps[(kvh * 4 + g) * 256 + j];
        }
#pragma unroll
        for (int g = 0; g < 4; ++g) *(f32x4*)(red + ((kg * 2 + kvh) * 4 + g) * 128 + d4 * 4) = acc[g];
    }
    lds_barrier();
    {
        const int h = wave, d = lane * 2;
        float o0 = 0.f, o1 = 0.f;
#pragma unroll
        for (int kg = 0; kg < 8; ++kg) { const f32x2 t = *(const f32x2*)(red + ((kg * 2 + (h >> 2)) * 4 + (h & 3)) * 128 + d); o0 += t[0]; o1 += t[1]; }
        *(unsigned*)(p.gated + (size_t)row * 1024 + h * 128 + d) = pk2(o0, o1);
    }
    lds_barrier();
}

constexpr int AT_K = 0, AT_V = 64 * 136, AT_ELEMS = 64 * 136 + 128 * 72;
__device__ __forceinline__ void attn_dense_unit(const Params& p, char* smem, int b, int kvh, int qb) {
    bf16_t* lds = (bf16_t*)smem;
    const int tid = tid_opaque(), lane = tid & 63, wave = tid >> 6;
    const int r = lane & 31, hh = lane >> 5;
    const int g = wave & 3, qs = wave >> 2;
    const int head = kvh * 4 + g;
    const int tq = 64 * qb + 32 * qs + r;
    const int tqc = (tq < LP) ? tq : (LP - 1);
    bf16x8 qf[8];
    {
        const bf16_t* qp = p.q_b + ((size_t)b * LP + tqc) * 1024 + head * 128 + 8 * hh;
#pragma unroll
        for (int ks = 0; ks < 8; ++ks) qf[ks] = *(const bf16x8*)(qp + 16 * ks);
    }
    f32x16 O[4];
#pragma unroll
    for (int i = 0; i < 4; ++i)
#pragma unroll
        for (int j = 0; j < 16; ++j) O[i][j] = 0.f;
    float mrun = -3.0e38f, lrun = 0.f;
    const bf16_t* Kg = p.k_b + ((size_t)(b * 2 + kvh) * LPAD) * 128;
    const bf16_t* Vg = p.vt_b + ((size_t)(b * 2 + kvh) * 128) * LPAD;
    const unsigned long long* mcol = p.maskT + (size_t)b * 65 * LPAD + tq;
    const int kc0 = tid, kc1 = tid + 512;
    uint4 sk0, sk1, sv0, sv1;
#define AT_GLOAD(kt_) do { const bf16_t* kg_ = Kg + (size_t)(kt_) * 64 * 128; const bf16_t* vg_ = Vg + (size_t)(kt_) * 64; \
        sk0 = *(const uint4*)(kg_ + (size_t)kc0 * 8); sk1 = *(const uint4*)(kg_ + (size_t)kc1 * 8); \
        sv0 = *(const uint4*)(vg_ + (size_t)(kc0 >> 3) * LPAD + (kc0 & 7) * 8); sv1 = *(const uint4*)(vg_ + (size_t)(kc1 >> 3) * LPAD + (kc1 & 7) * 8); } while (0)
#define AT_SSTORE(buf_) do { bf16_t* q_ = (buf_); \
        *(uint4*)(q_ + AT_K + (kc0 >> 4) * 136 + (kc0 & 15) * 8) = sk0; *(uint4*)(q_ + AT_K + (kc1 >> 4) * 136 + (kc1 & 15) * 8) = sk1; \
        *(uint4*)(q_ + AT_V + (kc0 >> 3) * 72 + (kc0 & 7) * 8) = sv0; *(uint4*)(q_ + AT_V + (kc1 >> 3) * 72 + (kc1 & 7) * 8) = sv1; } while (0)
    AT_GLOAD(0); AT_SSTORE(lds);
    unsigned long long mw_next = mcol[0];
    asm volatile("" :: "v"(qf[0]), "v"(qf[1]), "v"(qf[2]), "v"(qf[3]), "v"(qf[4]), "v"(qf[5]), "v"(qf[6]), "v"(qf[7]), "v"(mw_next));
    lds_barrier();
    for (int kt = 0; kt <= qb; ++kt) {
        unsigned zofs = 0; asm volatile("" : "+v"(zofs));
        bf16_t* cur = lds + (kt & 1) * AT_ELEMS + zofs;
        bf16_t* nxt = lds + ((kt + 1) & 1) * AT_ELEMS + zofs;
        const bool more = kt < qb;
        if (more) { AT_GLOAD(kt + 1); }
        const unsigned long long mw = mw_next;
        if (more) mw_next = mcol[(size_t)(kt + 1) * LPAD];
        f32x16 st[2];
#pragma unroll
        for (int j = 0; j < 16; ++j) { st[0][j] = 0.f; st[1][j] = 0.f; }
#pragma unroll
        for (int ks = 0; ks < 8; ++ks) {
            st[0] = MFMA32(*(const bf16x8*)(cur + AT_K + (r) * 136 + 16 * ks + 8 * hh), qf[ks], st[0]);
            st[1] = MFMA32(*(const bf16x8*)(cur + AT_K + (32 + r) * 136 + 16 * ks + 8 * hh), qf[ks], st[1]);
        }
        float mx = fmaxf(st[0][0], st[1][0]);
#pragma unroll
        for (int reg = 1; reg < 16; reg += 1) mx = fmaxf(mx, fmaxf(st[0][reg], st[1][reg]));
        mx = fmaxf(mx, __shfl_xor(mx, 32));
        const float mnew = (mx > mrun + 8.f) ? mx : mrun;
        if (__any(mnew != mrun)) {
            const float alpha = __builtin_amdgcn_exp2f(mrun - mnew);
            lrun *= alpha;
#pragma unroll
            for (int dt = 0; dt < 4; ++dt) O[dt] = O[dt] * alpha;
            mrun = mnew;
        }
        float psum = 0.f;
#pragma unroll
        for (int kk = 0; kk < 2; ++kk) {
            const int w = (int)((unsigned)(mw >> (32 * kk)) >> (4 * hh));
#pragma unroll
            for (int reg = 0; reg < 16; ++reg) {
                const int bit = (reg & 3) + 8 * (reg >> 2);
                const int keep = __builtin_amdgcn_sbfe(w, bit, 1);
                const float pv = __uint_as_float(__float_as_uint(__builtin_amdgcn_exp2f(st[kk][reg] - mrun)) & (unsigned)keep);
                st[kk][reg] = pv; psum += pv;
            }
        }
        lrun += psum;
        bf16x8 pb[2][2];
#pragma unroll
        for (int kk = 0; kk < 2; ++kk)
#pragma unroll
            for (int s = 0; s < 2; ++s) pb[kk][s] = pack_step(st[kk], s);
#pragma unroll
        for (int dt = 0; dt < 4; ++dt)
#pragma unroll
            for (int kk = 0; kk < 2; ++kk)
#pragma unroll
                for (int s = 0; s < 2; ++s)
                    O[dt] = MFMA32(frag_perm(cur + AT_V + (32 * dt + r) * 72 + 32 * kk + 16 * s + 4 * hh), pb[kk][s], O[dt]);
        if (more) { AT_SSTORE(nxt); }
        lds_barrier();
    }
    const float ltot = lrun + __shfl_xor(lrun, 32);
    const float inv = 1.f / ltot;
    if (tq < LP) {
        bf16_t* op = p.gated + ((size_t)b * LP + tq) * 1024 + head * 128;
#pragma unroll
        for (int dt = 0; dt < 4; ++dt)
#pragma unroll
            for (int g4 = 0; g4 < 4; ++g4) {
                f32x4 v;
#pragma unroll
                for (int e2 = 0; e2 < 4; ++e2) v[e2] = O[dt][4 * g4 + e2] * inv;
                st_bf16x4(op + 32 * dt + 8 * g4 + 4 * hh, v);
            }
    }
    lds_barrier();
}

__device__ __forceinline__ void attn_phase(const Params& p, char* smem, int bid, int nb, int rep = 0) {
    int* slot = (int*)(smem + LDS_BYTES - 32);
    for (;;) {
        if (threadIdx.x == 0) *slot = (int)atomicAdd(p.bar + 3584 + 16 * rep, 1u);
        lds_barrier();
        const int u = *slot;
        lds_barrier();
        if (u >= 520 + NSR) break;
        if (u < 520) attn_dense_unit(p, smem, (u & 7) >> 1, u & 1, 64 - (u >> 3));
        else attn_sample_query(p, smem, NPR + (u - 520));
    }
}

#define XB_TMO      128
#define XB_XCNT(j)  (256  + 64 * (j))
#define XB_XSUB(j)  (1280 + 64 * (j))
#define XB_XGEN(j)  (2304 + 64 * (j))
#define XB_TOP      3328
#define XB_TOPGEN   3392
#define XCD_BAR_WORDS 3456
#define XB_SPIN_CAP (1u << 18)
#define LAS __attribute__((address_space(3)))

__device__ __forceinline__ unsigned xb_ld(unsigned* p)              { return __hip_atomic_load(p, __ATOMIC_RELAXED, __HIP_MEMORY_SCOPE_AGENT); }
__device__ __forceinline__ unsigned xb_add(unsigned* p, unsigned v) { return __hip_atomic_fetch_add(p, v, __ATOMIC_RELAXED, __HIP_MEMORY_SCOPE_AGENT); }
__device__ __forceinline__ unsigned xb_xcc_id() { return (unsigned)__builtin_amdgcn_s_getreg((3 << 11) | 20) & 0xFu; }
#define XB_SPIN(cond, bar) do { unsigned _sp = 0; while (cond) { __builtin_amdgcn_s_sleep(1); \
    if ((++_sp & 255u) == 0u) { if (xb_ld(&(bar)[XB_TMO])) break; if (_sp > XB_SPIN_CAP) { atomicAdd(&(bar)[XB_TMO], 1u); break; } } } } while (0)

struct XcdBarrier {
    unsigned* bar; unsigned x;
    volatile LAS unsigned* st;
};

__device__ __forceinline__ XcdBarrier xcd_barrier_post(unsigned* bar, volatile LAS unsigned* st) {
    XcdBarrier b; b.bar = bar; b.x = xb_xcc_id(); b.st = st;
    if (threadIdx.x == 0) (void)xb_add(&bar[XB_XCNT(b.x)], 1u);
    return b;
}
__device__ __forceinline__ void xcd_barrier_complete(unsigned* bar, unsigned x, unsigned& nloc, unsigned& nx) {
    const unsigned G = gridDim.x * gridDim.y * gridDim.z;
    unsigned sum, cnt, mine, sp = 0u;
    for (;;) {
        sum = 0u; cnt = 0u; mine = 0u;
#pragma unroll
        for (unsigned j = 0; j < 16; ++j) { const unsigned c = xb_ld(&bar[XB_XCNT(j)]); sum += c; cnt += (c > 0u) ? 1u : 0u; mine = (j == x) ? c : mine; }
        if (sum == G) break;
        __builtin_amdgcn_s_sleep(1);
        if ((++sp & 255u) == 0u) { if (xb_ld(&bar[XB_TMO])) break; if (sp > XB_SPIN_CAP) { atomicAdd(&bar[XB_TMO], 1u); break; } }
    }
    nloc = mine > 0u ? mine : 1u; nx = cnt > 0u ? cnt : 1u;
}

__device__ __forceinline__ void xcd_barrier(const XcdBarrier& b) {
    asm volatile("s_waitcnt vmcnt(0)" ::: "memory");
    __syncthreads();
    if (threadIdx.x == 0) {
        unsigned* bar = b.bar;
        __builtin_amdgcn_s_waitcnt(0);
        unsigned nloc = b.st[0], nx = b.st[1];
        if (nloc == 0u) { xcd_barrier_complete(bar, b.x, nloc, nx); b.st[0] = nloc; b.st[1] = nx; }
        const unsigned old = xb_add(&bar[XB_XSUB(b.x)], 1u);
        const unsigned gen = old / nloc;
        if (old + 1u == (gen + 1u) * nloc) {
            __builtin_amdgcn_fence(__ATOMIC_RELEASE, "agent");
            asm volatile("s_waitcnt vmcnt(0)" ::: "memory");
            const unsigned og = xb_add(&bar[XB_TOP], 1u);
            const unsigned tg = og / nx;
            if (og + 1u == (tg + 1u) * nx) xb_add(&bar[XB_TOPGEN], 1u);
            else XB_SPIN(xb_ld(&bar[XB_TOPGEN]) == tg, bar);
            __builtin_amdgcn_fence(__ATOMIC_ACQUIRE, "agent");
            xb_add(&bar[XB_XGEN(b.x)], 1u);
            asm volatile("s_waitcnt vmcnt(0)" ::: "memory");
        } else {
            XB_SPIN(xb_ld(&bar[XB_XGEN(b.x)]) == gen, bar);
            __builtin_amdgcn_fence(__ATOMIC_ACQUIRE, "agent");
            asm volatile("s_waitcnt vmcnt(0)" ::: "memory");
        }
    }
    __syncthreads();
}


constexpr int NPHASE = 19;
template <int PH>
__device__ __forceinline__ void run_phase(const Params& p, char* smem, int bid, int nb, int rep = 0) {
    constexpr int MT = MPAD / 256;
    if constexpr (PH == 0) phase_prologue(p, smem, bid, nb);
    else if constexpr (PH == 1) gemm_big(p.hA, D, p.wt_gin, GIN_PAD, EpiGdnIn{p.mixed, p.z, p.ba}, smem, bid, nb);
    else if constexpr (PH == 2) gdn_stageA(p, smem, bid, nb);
    else if constexpr (PH == 3) gdn_seq_phase(p, smem, bid, nb, rep);
    else if constexpr (PH == 4) gdn_gate_phase(p, bid, nb);
    else if constexpr (PH == 5) gemm_n1024(p.gated, 2048, p.wt_gout, EpiResid{p.preln, p.hA}, EpiSlab{p.slab}, 8, smem, bid, nb);
    else if constexpr (PH == 6) ln_phase(p.preln, p.ln1_g, p.ln1_b, p.hB, nullptr, nullptr, p.slab, 8, p.hA, bid, nb);
    else if constexpr (PH == 7) gemm_big(p.hB, D, p.wt_w1, DFF, EpiRelu2{p.act}, smem, bid, nb);
    else if constexpr (PH == 8) gemm_n1024(p.act, DFF, p.wt_w2, EpiResid{p.preln, p.hB}, EpiSlab{p.slab}, 16, smem, bid, nb);
    else if constexpr (PH == 9) ln_phase(p.preln, p.ln2_g, p.ln2_b, p.hA, nullptr, nullptr, p.slab, 16, p.hB, bid, nb);
    else if constexpr (PH == 10) gemm_big(p.hA, D, p.wt_din, DIN_PAD, EpiF32{p.p1, DIN_PAD}, smem, bid, nb);
    else if constexpr (PH == 11) dsa_post_phase(p, smem, bid, nb);
    else if constexpr (PH == 12) indexer_phase(p, smem, bid, nb, rep);
    else if constexpr (PH == 13) attn_phase(p, smem, bid, nb, rep);
    else if constexpr (PH == 14) gemm_n1024(p.gated, D, p.wt_do, EpiResid{p.preln, p.hA}, EpiSlab{p.slab}, 4, smem, bid, nb);
    else if constexpr (PH == 15) ln_phase(p.preln, p.ln1_g + D, p.ln1_b + D, p.hB, nullptr, nullptr, p.slab, 4, p.hA, bid, nb);
    else if constexpr (PH == 16) gemm_big(p.hB, D, p.wt_w1 + (size_t)D * DFF, DFF, EpiRelu2{p.act}, smem, bid, nb);
    else if constexpr (PH == 17) gemm_n1024(p.act, DFF, p.wt_w2 + (size_t)D * DFF, EpiResid{p.preln, p.hB}, EpiSlab{p.slab}, 16, smem, bid, nb);
    else if constexpr (PH == 18) ln_phase(p.preln, p.ln2_g + D, p.ln2_b + D, nullptr, p.y_prompt, p.y_sample, p.slab, 16, p.hB, bid, nb);
}

template <int PH>
__global__ void __launch_bounds__(NTHR, 2) k_phase(Params p) {
    extern __shared__ __attribute__((aligned(16))) char smem[];
    run_phase<PH>(p, smem, blockIdx.x, gridDim.x);
}

template <int PH>
__device__ __forceinline__ void mega_run(const Params& p, char* smem, const XcdBarrier& bar) {
    run_phase<PH>(p, smem, blockIdx.x, gridDim.x);
#ifdef PROBE_MASK
    if constexpr ((PROBE_MASK >> PH) & 1) { xcd_barrier(bar); run_phase<PH>(p, smem, blockIdx.x, gridDim.x, 1); }
#endif
    if constexpr (PH + 1 < NPHASE) {
        xcd_barrier(bar);
        mega_run<PH + 1>(p, smem, bar);
    }
}
__global__ void __launch_bounds__(NTHR, 2) k_mega(Params p) {
    extern __shared__ __attribute__((aligned(16))) char smem[];
    volatile LAS unsigned* st = (volatile LAS unsigned*)(smem + LDS_BYTES - 16);
    if (threadIdx.x == 0) { st[0] = 0u; st[1] = 0u; st[2] = 0u; st[3] = 0u; }
    __syncthreads();
    XcdBarrier bar = xcd_barrier_post(p.bar, st);
    mega_run<0>(p, smem, bar);
}

template <int PH>
void launch_phase(const Params& p, hipStream_t stream) {
    static bool attr_done = false;
    if (!attr_done) {
        (void)hipFuncSetAttribute((const void*)k_phase<PH>, hipFuncAttributeMaxDynamicSharedMemorySize, LDS_BYTES);
        attr_done = true;
    }
    hipLaunchKernelGGL(k_phase<PH>, dim3(256), dim3(NTHR), LDS_BYTES, stream, p);
}
template <int PH>
void launch_all(const Params& p, hipStream_t stream) {
    launch_phase<PH>(p, stream);
    if constexpr (PH + 1 < NPHASE) launch_all<PH + 1>(p, stream);
}

}

extern "C" void kernel_launch(void* const* d_in, const int* in_sizes, int n_in, void* d_out, int out_size, void* d_ws, size_t ws_size,
                              hipStream_t stream) {
    Params p{};
    p.x_prompt = (const float*)d_in[0]; p.x_sample = (const float*)d_in[1]; p.state_gdn = (const float*)d_in[2];
    p.state_conv = (const float*)d_in[3]; p.cache_k = (const float*)d_in[4]; p.cache_v = (const float*)d_in[5];
    p.cache_ik = (const float*)d_in[6]; p.page_table = (const int*)d_in[7]; p.meta = (const float*)d_in[8];
    p.ln1_g = (const float*)d_in[9]; p.ln1_b = (const float*)d_in[10]; p.ln2_g = (const float*)d_in[11]; p.ln2_b = (const float*)d_in[12];
    p.mlp_w1 = (const float*)d_in[13]; p.mlp_w2 = (const float*)d_in[14]; p.gdn_w_in = (const float*)d_in[15];
    p.gdn_conv_w = (const float*)d_in[16]; p.gdn_a_log = (const float*)d_in[17]; p.gdn_dt_bias = (const float*)d_in[18];
    p.gdn_norm_w = (const float*)d_in[19]; p.gdn_w_out = (const float*)d_in[20]; p.dsa_w_in = (const float*)d_in[21];
    p.dsa_ik_g = (const float*)d_in[22]; p.dsa_ik_b = (const float*)d_in[23]; p.dsa_w_o = (const float*)d_in[24];
    float* o = (float*)d_out;
    p.y_prompt = o; o += (size_t)BATCH * SEQ * D;
    p.y_sample = o; o += (size_t)NSR * D;
    p.gs_prompt = o; o += (size_t)BATCH * 16 * 128 * 128;
    p.gc_prompt = o; o += (size_t)BATCH * 3 * 4096;
    p.gs_sample = o; o += (size_t)DB * 16 * 128 * 128;
    p.gc_sample = o; o += (size_t)DB * 3 * 4096;
    p.k_prompt = o; o += (size_t)NPR * 256;
    p.v_prompt = o; o += (size_t)NPR * 256;
    p.ik_prompt = o; o += (size_t)NPR * 64;
    p.k_sample = o; o += (size_t)NSR * 256;
    p.v_sample = o; o += (size_t)NSR * 256;
    p.ik_sample = o; o += (size_t)NSR * 64;
    char* w = (char*)d_ws;
    auto take = [&](size_t bytes) { char* r = w; w += (bytes + 255) & ~(size_t)255; return r; };
    p.bar = (unsigned*)take(16384);
    p.wt_gin = (bf16_t*)take((size_t)GIN_PAD * D * 2);
    p.wt_gout = (bf16_t*)take((size_t)D * 2048 * 2);
    p.wt_w1 = (bf16_t*)take((size_t)2 * D * DFF * 2);
    p.wt_w2 = (bf16_t*)take((size_t)2 * D * DFF * 2);
    p.wt_din = (bf16_t*)take((size_t)DIN_PAD * D * 2);
    p.wt_do = (bf16_t*)take((size_t)D * D * 2);
    p.hA = (bf16_t*)take((size_t)MPAD * D * 2);
    p.hB = (bf16_t*)take((size_t)MPAD * D * 2);
    p.preln = (float*)take((size_t)MPAD * D * 4);
    p.mixed = (bf16_t*)take((size_t)MPAD * 4096 * 2);
    p.z = (bf16_t*)take((size_t)MPAD * 2048 * 2);
    p.ba = (float*)take((size_t)MPAD * 32 * 4);
    p.gated = (bf16_t*)take((size_t)MPAD * 2048 * 2);
    p.act = (bf16_t*)take((size_t)MPAD * DFF * 2);
    p.p1 = (float*)take((size_t)MPAD * DIN_PAD * 4);
    p.qr = (float*)take((size_t)MPAD * 1024 * 4);
    p.iq = (float*)take((size_t)MPAD * 512 * 4);
    p.iw = (float*)take((size_t)MPAD * 8 * 4);
    p.sel = (int*)take((size_t)MPAD * 256 * 4);
    p.g_o = (bf16_t*)take((size_t)NPR * 2048 * 2);
    p.rope_tab = (float*)take((size_t)LP * 24 * 2 * 4);
    p.slab = (float*)take((size_t)16 * 768 * 1024 * 4);
    p.q_b = (bf16_t*)take((size_t)NPR * 1024 * 2);
    p.k_b = (bf16_t*)take((size_t)BATCH * 2 * LPAD * 128 * 2);
    p.vt_b = (bf16_t*)take((size_t)BATCH * 2 * 128 * LPAD * 2);
    p.iq_b = (bf16_t*)take((size_t)NPR * 512 * 2);
    p.ik_b = (bf16_t*)take((size_t)BATCH * LPAD * 64 * 2);
    p.maskT = (unsigned long long*)take((size_t)BATCH * 65 * LPAD * 8);
    p.g_dec = (float*)take((size_t)NCU * 4);
    p.g_u = (float*)p.act;
    p.g_negw = (bf16_t*)p.p1;
    p.g_qg = p.g_negw + (size_t)NCU * 8192;
    p.g_kdT = (bf16_t*)p.qr;
    p.g_aqk = (bf16_t*)p.iq;
    if ((size_t)(w - (char*)d_ws) > ws_size) { fprintf(stderr, "kernel_launch: workspace too small (%zu needed, %zu given)\n", (size_t)(w - (char*)d_ws), ws_size); return; }
#if MEGA
    static int grid = 0;
    if (grid == 0) {
        int dev = 0, cus = 0;
        if (hipGetDevice(&dev) != hipSuccess || hipDeviceGetAttribute(&cus, hipDeviceAttributeMultiprocessorCount, dev) != hipSuccess || cus <= 0) cus = 256;
        (void)hipFuncSetAttribute((const void*)k_mega, hipFuncAttributeMaxDynamicSharedMemorySize, LDS_BYTES);
        grid = cus;
    }
    (void)hipMemsetAsync(p.bar, 0, 16384, stream);
    hipLaunchKernelGGL(k_mega, dim3(grid), dim3(NTHR), LDS_BYTES, stream, p);
#else
    launch_all<0>(p, stream);
#endif
}
```

```cpp
#include <hip/hip_runtime.h>
#include <stdint.h>
#include <stdio.h>

#ifndef MEGA
#define MEGA 1
#endif

namespace {

typedef unsigned short bf16_t;
typedef short bf16x8 __attribute__((ext_vector_type(8)));
typedef float f32x4 __attribute__((ext_vector_type(4)));

constexpr int D = 1024, BATCH = 4, SEQ = 4096, NMETA = 16, LP = SEQ + NMETA;
constexpr int DB = 128, DS = 4, PAST = 2048;
constexpr int NPR = BATCH * LP;
constexpr int NSR = DB * DS;
constexpr int NT = NPR + NSR;
constexpr int MPAD = 17152;
constexpr int DFF = 4096;
constexpr int GIN = 6176, GIN_PAD = 6400;
constexpr int DIN = 2120, DIN_PAD = 2304;
constexpr int NTHR = 512;
constexpr int LPAD = 4160;
constexpr int LDS_BYTES = 150 * 1024;
constexpr float ALPHA = 1.4142135623730951f;

struct Params {
    const float *x_prompt, *x_sample, *state_gdn, *state_conv, *cache_k, *cache_v, *cache_ik;
    const int* page_table;
    const float *meta, *ln1_g, *ln1_b, *ln2_g, *ln2_b, *mlp_w1, *mlp_w2, *gdn_w_in, *gdn_conv_w, *gdn_a_log, *gdn_dt_bias,
        *gdn_norm_w, *gdn_w_out, *dsa_w_in, *dsa_ik_g, *dsa_ik_b, *dsa_w_o;
    float *y_prompt, *y_sample, *gs_prompt, *gc_prompt, *gs_sample, *gc_sample, *k_prompt, *v_prompt, *ik_prompt, *k_sample,
        *v_sample, *ik_sample;
    unsigned* bar;
    bf16_t *wt_gin, *wt_gout, *wt_w1, *wt_w2, *wt_din, *wt_do;
    bf16_t *hA, *hB;
    float* preln;
    bf16_t *mixed, *z;
    float* ba;
    bf16_t *gated, *act;
    float *p1, *qr, *iq, *iw;
    int* sel;
    bf16_t *g_negw, *g_qg, *g_kdT, *g_aqk;
    float *g_u, *g_dec;
    bf16_t* g_o;
    float* rope_tab;
    float* slab;
    bf16_t *q_b, *k_b, *vt_b, *iq_b, *ik_b;
    unsigned long long* maskT;
};

__device__ const double kInvFreq[16] = {1.0, 0.44036660267178046, 0.19392274474868576, 0.08539710028576561,
    0.03760603093086393, 0.016560440080994446, 0.007292664737217109, 0.003211445994752591, 0.001414213562373095,
    0.000622772421914596, 0.0002742481756762073, 0.00012076973741146504, 5.318295896944988e-05, 2.341999896140934e-05,
    1.031338537721246e-05, 4.5416704806078695e-06};

__device__ __forceinline__ float bf2f(bf16_t h) { return __uint_as_float(((unsigned)h) << 16); }
typedef __bf16 hwbf16x2 __attribute__((ext_vector_type(2)));
typedef float f32x2 __attribute__((ext_vector_type(2)));
typedef float f32x16 __attribute__((ext_vector_type(16)));
typedef unsigned u32x4 __attribute__((ext_vector_type(4)));
__device__ __forceinline__ unsigned pk2(float lo, float hi) {
    const f32x2 v = {lo, hi};
    return __builtin_bit_cast(unsigned, __builtin_convertvector(v, hwbf16x2));
}
__device__ __forceinline__ bf16_t f2bf(float f) { return (bf16_t)(pk2(f, 0.f) & 0xffffu); }
__device__ __forceinline__ void st_bf16x4(bf16_t* p, f32x4 v) {
    uint2 o; o.x = pk2(v[0], v[1]); o.y = pk2(v[2], v[3]);
    *(uint2*)p = o;
}
__device__ __forceinline__ f32x4 cvt_bf16x4(uint2 o) {
    f32x4 v; v[0] = __uint_as_float(o.x << 16); v[1] = __uint_as_float(o.x & 0xffff0000u);
    v[2] = __uint_as_float(o.y << 16); v[3] = __uint_as_float(o.y & 0xffff0000u);
    return v;
}
__device__ __forceinline__ f32x4 ld_bf16x4(const bf16_t* p) {
    uint2 o = *(const uint2*)p;
    f32x4 v; v[0] = __uint_as_float(o.x << 16); v[1] = __uint_as_float(o.x & 0xffff0000u);
    v[2] = __uint_as_float(o.y << 16); v[3] = __uint_as_float(o.y & 0xffff0000u);
    return v;
}
__device__ __forceinline__ float wave_sum(float v) {
#pragma unroll
    for (int o = 1; o < 64; o <<= 1) v += __shfl_xor(v, o);
    return v;
}
__device__ __forceinline__ float wave_max(float v) {
#pragma unroll
    for (int o = 1; o < 64; o <<= 1) v = fmaxf(v, __shfl_xor(v, o));
    return v;
}
__device__ __forceinline__ int wave_sum_i(int v) {
#pragma unroll
    for (int o = 1; o < 64; o <<= 1) v += __shfl_xor(v, o);
    return v;
}
__device__ __forceinline__ float silu(float x) { return x * __builtin_amdgcn_rcpf(1.f + __expf(-x)); }
__device__ __forceinline__ int tid_opaque() { int t = threadIdx.x; asm volatile("" : "+v"(t)); return t; }
__device__ __forceinline__ void lds_barrier() { asm volatile("s_waitcnt lgkmcnt(0)\n\ts_barrier" ::: "memory"); }
__device__ __forceinline__ void lds_fence() { asm volatile("s_waitcnt lgkmcnt(0)" ::: "memory"); }

__device__ __forceinline__ void transpose_convert(const float* __restrict__ W, int K, int N, int Npad, bf16_t* __restrict__ WT, float* tile,
                                  int bid, int nb) {
    const int tid = tid_opaque();
    const int tk = K / 64, tn = Npad / 64;
    for (int it = bid; it < tk * tn; it += nb) {
        const int kb = it / tn, nbk = it % tn, k0 = kb * 64, n0 = nbk * 64;
#pragma unroll
        for (int i = 0; i < 8; ++i) {
            const int r = (tid >> 6) + 8 * i, c = tid & 63, n = n0 + c;
            tile[r * 65 + c] = (n < N) ? W[(size_t)(k0 + r) * N + n] : 0.f;
        }
        __syncthreads();
        {
            const int rn = tid >> 3, c8 = (tid & 7) * 8;
            const float* tp = tile + c8 * 65 + rn;
            uint4 o;
            o.x = pk2(tp[0], tp[65]); o.y = pk2(tp[2 * 65], tp[3 * 65]); o.z = pk2(tp[4 * 65], tp[5 * 65]); o.w = pk2(tp[6 * 65], tp[7 * 65]);
            *(uint4*)(WT + (size_t)(n0 + rn) * K + k0 + c8) = o;
        }
        __syncthreads();
    }
}

__device__ __forceinline__ void phase_prologue(const Params& p, char* smem, int bid, int nb) {
    float* tile = (float*)smem;
    transpose_convert(p.gdn_w_in, D, GIN, GIN_PAD, p.wt_gin, tile, bid, nb);
    for (int idx = bid * NTHR + tid_opaque(); idx < LP * 24; idx += nb * NTHR) {
        const int pos = idx / 24, f = idx % 24;
        const int fi = (f < 16) ? f : (f - 16) * 2;
        const double rev = (double)pos * kInvFreq[fi] * 0.15915494309189535;
        const float r = (float)(rev - floor(rev));
        p.rope_tab[idx * 2] = __builtin_amdgcn_cosf(r);
        p.rope_tab[idx * 2 + 1] = __builtin_amdgcn_sinf(r);
    }
    for (int idx = bid * NTHR + tid_opaque(); idx < MPAD * 256; idx += nb * NTHR) {
        const int row = idx >> 8, c4 = (idx & 255) * 4;
        f32x4 v = {0.f, 0.f, 0.f, 0.f};
        if (row < NPR) {
            const int b = row / LP, t = row % LP;
            const float* src = (t < NMETA) ? (p.meta + (size_t)t * D) : (p.x_prompt + ((size_t)b * SEQ + (t - NMETA)) * D);
            v = *(const f32x4*)(src + c4);
        } else if (row < NT) {
            v = *(const f32x4*)(p.x_sample + (size_t)(row - NPR) * D + c4);
        }
        st_bf16x4(p.hA + (size_t)row * D + c4, v);
    }
}

template <class Epi>
__device__ __forceinline__ void gemm_phase(const bf16_t* __restrict__ A, int lda, const bf16_t* __restrict__ Bt, int K, int Mtiles, int Ntiles,
                           const Epi& epi, char* smem, int bid, int nb) {
    bf16_t* As = (bf16_t*)smem;
    bf16_t* Bs = As + 256 * 72;
    const int tid = tid_opaque(), lane = tid & 63, wave = tid >> 6;
    const int wm = wave >> 1, wn = wave & 1;
    const int fr = lane & 15, fq = lane >> 4;
    const int ntiles = Mtiles * Ntiles;
    const int nk = K / 64;
    for (int tile = bid; tile < ntiles; tile += nb) {
        const int tm = tile % Mtiles, tn = tile / Mtiles;
        const bf16_t* Ag = A + (size_t)tm * 256 * lda;
        const bf16_t* Bg = Bt + (size_t)tn * 128 * K;
        f32x4 acc[4][4];
#pragma unroll
        for (int i = 0; i < 4; ++i)
#pragma unroll
            for (int j = 0; j < 4; ++j) acc[i][j] = (f32x4){0.f, 0.f, 0.f, 0.f};
        const int c0 = tid, c1 = tid + 512, c2 = tid + 1024, c3 = tid + 1536;
        const bf16_t* ga0 = Ag + (size_t)(c0 >> 3) * lda + (c0 & 7) * 8;
        const bf16_t* ga1 = Ag + (size_t)(c1 >> 3) * lda + (c1 & 7) * 8;
        const bf16_t* ga2 = Ag + (size_t)(c2 >> 3) * lda + (c2 & 7) * 8;
        const bf16_t* ga3 = Ag + (size_t)(c3 >> 3) * lda + (c3 & 7) * 8;
        const bf16_t* gb0 = Bg + (size_t)(c0 >> 3) * K + (c0 & 7) * 8;
        const bf16_t* gb1 = Bg + (size_t)(c1 >> 3) * K + (c1 & 7) * 8;
        bf16_t* sa0 = As + (c0 >> 3) * 72 + (c0 & 7) * 8;
        bf16_t* sa1 = As + (c1 >> 3) * 72 + (c1 & 7) * 8;
        bf16_t* sa2 = As + (c2 >> 3) * 72 + (c2 & 7) * 8;
        bf16_t* sa3 = As + (c3 >> 3) * 72 + (c3 & 7) * 8;
        bf16_t* sb0 = Bs + (c0 >> 3) * 72 + (c0 & 7) * 8;
        bf16_t* sb1 = Bs + (c1 >> 3) * 72 + (c1 & 7) * 8;
        uint4 ra0 = *(const uint4*)ga0, ra1 = *(const uint4*)ga1, ra2 = *(const uint4*)ga2, ra3 = *(const uint4*)ga3;
        uint4 rb0 = *(const uint4*)gb0, rb1 = *(const uint4*)gb1;
        *(uint4*)sa0 = ra0; *(uint4*)sa1 = ra1; *(uint4*)sa2 = ra2; *(uint4*)sa3 = ra3; *(uint4*)sb0 = rb0; *(uint4*)sb1 = rb1;
        __syncthreads();
        for (int kt = 0; kt < nk; ++kt) {
            const bool more = (kt + 1 < nk);
            if (more) {
                const int k0 = (kt + 1) * 64;
                ra0 = *(const uint4*)(ga0 + k0); ra1 = *(const uint4*)(ga1 + k0); ra2 = *(const uint4*)(ga2 + k0); ra3 = *(const uint4*)(ga3 + k0);
                rb0 = *(const uint4*)(gb0 + k0); rb1 = *(const uint4*)(gb1 + k0);
            }
#pragma unroll
            for (int kk = 0; kk < 2; ++kk) {
                bf16x8 af[4], bfr[4];
#pragma unroll
                for (int i = 0; i < 4; ++i) af[i] = *(const bf16x8*)(As + (wm * 64 + i * 16 + fr) * 72 + kk * 32 + fq * 8);
#pragma unroll
                for (int j = 0; j < 4; ++j) bfr[j] = *(const bf16x8*)(Bs + (wn * 64 + j * 16 + fr) * 72 + kk * 32 + fq * 8);
#pragma unroll
                for (int i = 0; i < 4; ++i)
#pragma unroll
                    for (int j = 0; j < 4; ++j) acc[i][j] = __builtin_amdgcn_mfma_f32_16x16x32_bf16(bfr[j], af[i], acc[i][j], 0, 0, 0);
            }
            __syncthreads();
            if (more) {
                *(uint4*)sa0 = ra0; *(uint4*)sa1 = ra1; *(uint4*)sa2 = ra2; *(uint4*)sa3 = ra3; *(uint4*)sb0 = rb0; *(uint4*)sb1 = rb1;
                __syncthreads();
            }
        }
#pragma unroll
        for (int i = 0; i < 4; ++i)
#pragma unroll
            for (int j = 0; j < 4; ++j) {
                const int row = tm * 256 + wm * 64 + i * 16 + fr, col = tn * 128 + wn * 64 + j * 16 + fq * 4;
                epi(row, col, acc[i][j]);
            }
    }
}

namespace pg8 {
#define PG8_LAS __attribute__((address_space(3)))
constexpr int BM = 256, BK = 64, HALF = 128, HTB = HALF * BK * 2  , STAGE_BYTES = 8 * HTB, NXCD = 8, WGM = 8;
__device__ __forceinline__ int lds_byte(int r, int c) { const int st = (r >> 4) * 2 + (c >> 5), rr = r & 15, cc = c & 31, ob = rr * 64 + cc * 2; return st * 1024 + (ob ^ (((ob >> 9) & 1) << 5)); }
__device__ __forceinline__ void stage_rc(int b, int& R, int& C) { const int st = b / 1024, sb = b % 1024, swz = sb ^ (((sb >> 9) & 1) << 5); R = (st >> 1) * 16 + swz / 64; C = (st & 1) * 32 + (swz % 64) / 2; }
struct Unit { int pm, pn, pk; };
struct Gemm { const bf16_t* A; const bf16_t* Bt; int K; int splits; };
struct StaticOrder {
    int nM, nN, nNr, pm0, nwg, G, c;
    __device__ void init(int nM_, int nNr_, int splits, int pm0_, int G_, int c_) { nM = nM_; nNr = nNr_; nN = nNr_ * splits; pm0 = pm0_; nwg = nM * nN; G = G_; c = c_; }
    __device__ bool next(int i, Unit& u) const {
        const long L = (long)i * G + c; if (L >= nwg) return false;
        int wgid = (int)L; { const int q = nwg / NXCD, r = nwg % NXCD, xcd = wgid % NXCD, off = wgid / NXCD; wgid = (xcd < r ? xcd * (q + 1) : r * (q + 1) + (xcd - r) * q) + off; }
        const int nig = WGM * nN, gid = wgid / nig, fm = gid * WGM, gsz = (nM - fm) < WGM ? (nM - fm) : WGM;
        const int pnv = (wgid % nig) / gsz;
        u.pm = pm0 + fm + ((wgid % nig) % gsz); u.pn = pnv % nNr; u.pk = pnv / nNr; return true;
    }
};
template <class Epi>
__device__ __forceinline__ void gemm_phase(PG8_LAS unsigned char* lds, const Gemm g, const StaticOrder& S, const Epi& E) {
    const int tid = tid_opaque(), wid = __builtin_amdgcn_readfirstlane(tid >> 6), lane = tid & 63, wr = wid >> 2, wc = wid & 3, fr = lane & 15, fq = lane >> 4;
    const int K = g.K, Kp = K / g.splits, nt = Kp / BK;
    unsigned voffA[2], voffB[2];
#pragma unroll
    for (int i = 0; i < 2; ++i) { int R, C; stage_rc(tid * 16 + i * 8192, R, C); voffA[i] = (unsigned)(R * K + C) * 2u; voffB[i] = voffA[i]; }
    const size_t kstep = (size_t)(BK * 2);
    const size_t hstep = (size_t)HALF * K * 2;
    const size_t tstep = 2 * hstep;
    const size_t pstep = (size_t)Kp * 2;
    const unsigned ldsw = (unsigned)wid * 1024u;
    const int aoff = lds_byte(wr * 64 + fr, fq * 8), boff = lds_byte(wc * 32 + fr, fq * 8);
#define PG8_SA(b, h) (((b) * 2 + (h)) * HTB)
#define PG8_SB(b, h) ((4 + (b) * 2 + (h)) * HTB)
#define PG8_STAGE(bufoff, gbase, voff) do { _Pragma("unroll") for (int _i = 0; _i < 2; ++_i) \
        __builtin_amdgcn_global_load_lds((const unsigned*)((const char*)(gbase) + (voff)[_i]), (PG8_LAS unsigned*)(lds + (bufoff) + ldsw + _i * 8192), 16, 0, 0); } while (0)
#define PG8_LDA(dst, b, h) do { _Pragma("unroll") for (int m = 0; m < 4; ++m) _Pragma("unroll") for (int k = 0; k < 2; ++k) dst[m][k] = *(const PG8_LAS bf16x8*)(lds + PG8_SA(b, h) + aoff + m * 2048 + k * 1024); } while (0)
#define PG8_LDB(dst, b, h) do { _Pragma("unroll") for (int n = 0; n < 2; ++n) _Pragma("unroll") for (int k = 0; k < 2; ++k) dst[n][k] = *(const PG8_LAS bf16x8*)(lds + PG8_SB(b, h) + boff + n * 2048 + k * 1024); } while (0)
#define PG8_MMA(ai, bj, At, Bt) do { __builtin_amdgcn_s_setprio(1); _Pragma("unroll") for (int m = 0; m < 4; ++m) _Pragma("unroll") for (int n = 0; n < 2; ++n) _Pragma("unroll") for (int k = 0; k < 2; ++k) \
        acc[ai][bj][m][n] = __builtin_amdgcn_mfma_f32_16x16x32_bf16(Bt[n][k], At[m][k], acc[ai][bj][m][n], 0, 0, 0); __builtin_amdgcn_s_setprio(0); } while (0)
#define PG8_WAIT_V(n) asm volatile("s_waitcnt vmcnt(" #n ")" ::: "memory")
#define PG8_WAIT_L(n) asm volatile("s_waitcnt lgkmcnt(" #n ")" ::: "memory")
#define PG8_BAR __builtin_amdgcn_s_barrier()
#define PG8_SCHED __builtin_amdgcn_sched_barrier(0)
    Unit cur, nxt; int ui = 0;
    if (!S.next(0, cur)) return;
    f32x4 acc[2][2][4][2];
#pragma unroll
    for (int a = 0; a < 2; ++a)
#pragma unroll
        for (int b = 0; b < 2; ++b)
#pragma unroll
            for (int m = 0; m < 4; ++m)
#pragma unroll
                for (int n = 0; n < 2; ++n) acc[a][b][m][n] = (f32x4){0.f, 0.f, 0.f, 0.f};
    bf16x8 At[4][2], B0[2][2], B1[2][2];
    const char* cA = (const char*)g.A + (size_t)cur.pm * tstep + (size_t)cur.pk * pstep; const char* cB = (const char*)g.Bt + (size_t)cur.pn * tstep + (size_t)cur.pk * pstep;
    PG8_STAGE(PG8_SB(0, 0), cB, voffB); PG8_STAGE(PG8_SA(0, 0), cA, voffA); PG8_STAGE(PG8_SB(0, 1), cB + hstep, voffB); PG8_STAGE(PG8_SA(0, 1), cA + hstep, voffA);
    if (wr == 1) PG8_BAR;
    PG8_WAIT_V(4); PG8_BAR;
    PG8_STAGE(PG8_SB(1, 0), cB + kstep, voffB); PG8_STAGE(PG8_SA(1, 0), cA + kstep, voffA); PG8_STAGE(PG8_SB(1, 1), cB + hstep + kstep, voffB);
    PG8_WAIT_V(6); PG8_BAR;
    for (;;) {
        const bool has_next = S.next(ui + 1, nxt);
        const char* nA = has_next ? (const char*)g.A + (size_t)nxt.pm * tstep + (size_t)nxt.pk * pstep : cA; const char* nB = has_next ? (const char*)g.Bt + (size_t)nxt.pn * tstep + (size_t)nxt.pk * pstep : cB;
        for (int t = 0; t < nt; t += 2) {
            const bool last = (t == nt - 2);
            const char* a1 = cA + (size_t)(t + 1) * kstep;
            const char* a2 = last ? nA : cA + (size_t)(t + 2) * kstep; const char* b2 = last ? nB : cB + (size_t)(t + 2) * kstep;
            const char* a3 = a2 + kstep; const char* b3 = b2 + kstep;
            PG8_LDB(B0, 0, 0); PG8_SCHED; PG8_LDA(At, 0, 0); PG8_STAGE(PG8_SA(1, 1), a1 + hstep, voffA);
            PG8_WAIT_L(8); PG8_BAR; PG8_WAIT_L(0); PG8_MMA(0, 0, At, B0); PG8_BAR; PG8_SCHED;
            PG8_LDB(B1, 0, 1); PG8_STAGE(PG8_SB(0, 0), b2, voffB);
            PG8_BAR; PG8_WAIT_L(0); PG8_MMA(0, 1, At, B1); PG8_BAR;
            PG8_LDA(At, 0, 1); PG8_STAGE(PG8_SA(0, 0), a2, voffA);
            PG8_BAR; PG8_WAIT_L(0); PG8_MMA(1, 0, At, B0); PG8_BAR; PG8_SCHED;
            PG8_STAGE(PG8_SB(0, 1), b2 + hstep, voffB);
            PG8_WAIT_V(6); PG8_BAR; PG8_MMA(1, 1, At, B1); PG8_BAR;
            PG8_LDB(B0, 1, 0); PG8_SCHED; PG8_LDA(At, 1, 0); PG8_STAGE(PG8_SA(0, 1), a2 + hstep, voffA);
            PG8_WAIT_L(8); PG8_BAR; PG8_WAIT_L(0); PG8_MMA(0, 0, At, B0); PG8_BAR; PG8_SCHED;
            PG8_LDB(B1, 1, 1); PG8_STAGE(PG8_SB(1, 0), b3, voffB);
            PG8_BAR; PG8_WAIT_L(0); PG8_MMA(0, 1, At, B1); PG8_BAR;
            PG8_LDA(At, 1, 1); PG8_STAGE(PG8_SA(1, 0), a3, voffA);
            PG8_BAR; PG8_WAIT_L(0); PG8_MMA(1, 0, At, B0); PG8_BAR; PG8_SCHED;
            PG8_STAGE(PG8_SB(1, 1), b3 + hstep, voffB);
            PG8_WAIT_V(6); PG8_BAR; PG8_MMA(1, 1, At, B1); PG8_BAR;
        }
#pragma unroll
        for (int ai = 0; ai < 2; ++ai)
#pragma unroll
            for (int m = 0; m < 4; ++m)
#pragma unroll
                for (int bj = 0; bj < 2; ++bj)
#pragma unroll
                    for (int n = 0; n < 2; ++n)
                        E(cur.pm * BM + ai * HALF + wr * 64 + m * 16 + fr, cur.pn * BM + bj * HALF + wc * 32 + n * 16 + 4 * fq, acc[ai][bj][m][n], cur.pk);
        if (!has_next) break;
#pragma unroll
        for (int a = 0; a < 2; ++a)
#pragma unroll
            for (int b = 0; b < 2; ++b)
#pragma unroll
                for (int m = 0; m < 4; ++m)
#pragma unroll
                    for (int n = 0; n < 2; ++n) acc[a][b][m][n] = (f32x4){0.f, 0.f, 0.f, 0.f};
        cur = nxt; cA = nA; cB = nB; ++ui;
    }
    PG8_WAIT_V(0);
    if (wr == 0) PG8_BAR;
    PG8_BAR;
#undef PG8_SA
#undef PG8_SB
#undef PG8_STAGE
#undef PG8_LDA
#undef PG8_LDB
#undef PG8_MMA
#undef PG8_WAIT_V
#undef PG8_WAIT_L
#undef PG8_BAR
#undef PG8_SCHED
}
}

template <class Epi>
__device__ __forceinline__ void gemm_big(const bf16_t* A, int K, const bf16_t* Bt, int Npad, const Epi& e, char* smem, int bid, int nb) {
    pg8::StaticOrder S; S.init(MPAD / 256, Npad / 256, 1, 0, nb, bid);
    pg8::gemm_phase((PG8_LAS unsigned char*)smem, pg8::Gemm{A, Bt, K, 1}, S, e);
}
template <class Epi1, class Epi2>
__device__ __forceinline__ void gemm_n1024(const bf16_t* A, int K, const bf16_t* Bt, const Epi1& e1, const Epi2& e2, int splits, char* smem, int bid, int nb) {
    pg8::StaticOrder S; S.init(64, 4, 1, 0, nb, bid);
    pg8::gemm_phase((PG8_LAS unsigned char*)smem, pg8::Gemm{A, Bt, K, 1}, S, e1);
    pg8::StaticOrder S2; S2.init(3, 4, splits, 64, nb, bid);
    pg8::gemm_phase((PG8_LAS unsigned char*)smem, pg8::Gemm{A, Bt, K, splits}, S2, e2);
}

struct EpiGdnIn {
    bf16_t *mixed, *z; float* ba;
    __device__ __forceinline__ void operator()(int row, int col, f32x4 v, int = 0) const {
        if (col < 4096) st_bf16x4(mixed + (size_t)row * 4096 + col, v);
        else if (col < 6144) st_bf16x4(z + (size_t)row * 2048 + (col - 4096), v);
        else if (col < 6176) *(f32x4*)(ba + (size_t)row * 32 + (col - 6144)) = v;
    }
};
struct EpiResid {
    float* out; const bf16_t* h;
    __device__ __forceinline__ void operator()(int row, int col, f32x4 v, int = 0) const {
        const f32x4 r = ld_bf16x4(h + (size_t)row * D + col);
        *(f32x4*)(out + (size_t)row * D + col) = v + r * ALPHA;
    }
};
struct EpiSlab {
    float* slab;
    __device__ __forceinline__ void operator()(int row, int col, f32x4 v, int pk) const {
        *(f32x4*)(slab + ((size_t)pk * 768 + (row - 16384)) * D + col) = v;
    }
};
struct EpiRelu2 {
    bf16_t* act;
    __device__ __forceinline__ void operator()(int row, int col, f32x4 v, int = 0) const {
#pragma unroll
        for (int e = 0; e < 4; ++e) { const float r = fmaxf(v[e], 0.f); v[e] = r * r; }
        st_bf16x4(act + (size_t)row * DFF + col, v);
    }
};
struct EpiF32 {
    float* out; int ld;
    __device__ __forceinline__ void operator()(int row, int col, f32x4 v, int = 0) const { *(f32x4*)(out + (size_t)row * ld + col) = v; }
};

__device__ __forceinline__ void ln_phase(const float* X, const float* __restrict__ g, const float* __restrict__ bta, bf16_t* Hout,
                         float* yp, float* ys, const float* slab, int splits, const bf16_t* hres, int bid, int nb) {
    const int tid_ = tid_opaque(); const int lane = tid_ & 63, wave = tid_ >> 6;
    f32x4 gv[4], bv[4];
#pragma unroll
    for (int j = 0; j < 4; ++j) { gv[j] = *(const f32x4*)(g + j * 256 + lane * 4); bv[j] = *(const f32x4*)(bta + j * 256 + lane * 4); }
    for (int row = bid * 8 + wave; row < NT; row += nb * 8) {
        f32x4 v[4]; float s = 0.f;
        if (row < 16384) {
#pragma unroll
            for (int j = 0; j < 4; ++j) v[j] = *(const f32x4*)(X + (size_t)row * D + j * 256 + lane * 4);
        } else {
#pragma unroll
            for (int j = 0; j < 4; ++j) v[j] = ld_bf16x4(hres + (size_t)row * D + j * 256 + lane * 4) * ALPHA;
            for (int pk = 0; pk < splits; ++pk) {
                const float* sp = slab + ((size_t)pk * 768 + (row - 16384)) * D + lane * 4;
#pragma unroll
                for (int j = 0; j < 4; ++j) v[j] += *(const f32x4*)(sp + j * 256);
            }
        }
#pragma unroll
        for (int j = 0; j < 4; ++j) s += (v[j][0] + v[j][1]) + (v[j][2] + v[j][3]);
        const float mean = wave_sum(s) * (1.f / D);
        float s2 = 0.f;
#pragma unroll
        for (int j = 0; j < 4; ++j) { v[j] = v[j] - mean; s2 += (v[j][0] * v[j][0] + v[j][1] * v[j][1]) + (v[j][2] * v[j][2] + v[j][3] * v[j][3]); }
        const float rstd = rsqrtf(wave_sum(s2) * (1.f / D) + 1e-5f);
        float* yo = nullptr;
        if (yp) {
            if (row < NPR) { const int b = row / LP, t = row % LP; if (t >= NMETA) yo = yp + ((size_t)b * SEQ + (t - NMETA)) * D; }
            else yo = ys + (size_t)(row - NPR) * D;
        }
#pragma unroll
        for (int j = 0; j < 4; ++j) {
            const f32x4 o = v[j] * rstd * gv[j] + bv[j];
            if (Hout) st_bf16x4(Hout + (size_t)row * D + j * 256 + lane * 4, o);
            if (yo) *(f32x4*)(yo + j * 256 + lane * 4) = o;
        }
    }
}

__device__ __forceinline__ void gdn_sample_pass(const Params& p, char* smem, int pass, int tid) {
    float* sq = (float*)smem;
    float* sk = sq + 256;
    float* part = sk + 256;
    float* part2 = part + 16;
    const int lane = tid & 63, wave = tid >> 6, ug = wave >> 2, wq = wave & 3;
    const int half = lane >> 5, v = wq * 32 + (lane & 31);
    const int u = pass * 2 + ug, b = u >> 4, h = u & 15, kh = h >> 1;
    const size_t row0 = (size_t)NPR + (size_t)b * DS;
    float S[64];
    {
        const float* Sp = p.state_gdn + ((size_t)(b * 16 + h) * 128 + half * 64) * 128 + v;
#pragma unroll
        for (int k = 0; k < 64; ++k) S[k] = Sp[(size_t)k * 128];
    }
    const float Aexp = __expf(p.gdn_a_log[h]);
    const float dtb = p.gdn_dt_bias[h];
    const float nw = p.gdn_norm_w[v];
    const int chA = (half ? 1024 : 0) + kh * 128 + v, chv = 2048 + h * 128 + v;
    float cA[4], cv[4];
#pragma unroll
    for (int j = 0; j < 4; ++j) { cA[j] = p.gdn_conv_w[j * 4096 + chA]; cv[j] = p.gdn_conv_w[j * 4096 + chv]; }
    float xA[7], xv[7];
#pragma unroll
    for (int i = 0; i < 3; ++i) {
        const float* cs = p.state_conv + ((size_t)b * 3 + i) * 4096;
        xA[i] = cs[chA]; xv[i] = cs[chv];
    }
#pragma unroll
    for (int i = 0; i < 4; ++i) {
        const bf16_t* mr = p.mixed + (row0 + i) * 4096;
        xA[3 + i] = bf2f(mr[chA]); xv[3 + i] = bf2f(mr[chv]);
    }
    float* sqg = sq + ug * 128;
    float* skg = sk + ug * 128;
    float* pg = part + ug * 8;
    float* pg2 = part2 + ug * 4;
    const float* kmine = skg + half * 64;
    const float* qmine = sqg + half * 64;
#pragma unroll
    for (int t = 0; t < DS; ++t) {
        const float yA = silu(xA[t] * cA[0] + xA[t + 1] * cA[1] + xA[t + 2] * cA[2] + xA[t + 3] * cA[3]);
        const float yv = silu(xv[t] * cv[0] + xv[t + 1] * cv[1] + xv[t + 2] * cv[2] + xv[t + 3] * cv[3]);
        (half ? skg : sqg)[v] = yA;
        float ssA = yA * yA;
#pragma unroll
        for (int o = 1; o < 32; o <<= 1) ssA += __shfl_xor(ssA, o);
        if ((lane & 31) == 0) pg[wq * 2 + half] = ssA;
        lds_barrier();
        const float qn = rsqrtf((pg[0] + pg[2]) + (pg[4] + pg[6]) + 1e-6f) * 0.08838834764831845f;
        const float kn = rsqrtf((pg[1] + pg[3]) + (pg[5] + pg[7]) + 1e-6f);
        const float* bap = p.ba + (row0 + t) * 32;
        const float beta = 1.f / (1.f + __expf(-bap[h]));
        const float aa = bap[16 + h] + dtb;
        const float sp = (aa > 20.f) ? aa : log1pf(__expf(aa));
        const float dec = __expf(-Aexp * sp);
        float kS0 = 0.f, kS1 = 0.f;
#pragma unroll
        for (int k = 0; k < 64; k += 4) {
            const f32x4 kk = *(const f32x4*)(kmine + k);
            S[k] *= dec; S[k + 1] *= dec; S[k + 2] *= dec; S[k + 3] *= dec;
            kS0 += kk[0] * S[k]; kS1 += kk[1] * S[k + 1]; kS0 += kk[2] * S[k + 2]; kS1 += kk[3] * S[k + 3];
        }
        float kS = kS0 + kS1;
        kS += __shfl_xor(kS, 32);
        const float delta = (yv - kS * kn) * beta * kn;
        float o0 = 0.f, o1 = 0.f;
#pragma unroll
        for (int k = 0; k < 64; k += 4) {
            const f32x4 kk = *(const f32x4*)(kmine + k);
            const f32x4 qq = *(const f32x4*)(qmine + k);
            S[k] += kk[0] * delta; S[k + 1] += kk[1] * delta; S[k + 2] += kk[2] * delta; S[k + 3] += kk[3] * delta;
            o0 += qq[0] * S[k]; o1 += qq[1] * S[k + 1]; o0 += qq[2] * S[k + 2]; o1 += qq[3] * S[k + 3];
        }
        float o = o0 + o1;
        o = (o + __shfl_xor(o, 32)) * qn;
        float s3 = o * o;
#pragma unroll
        for (int x = 1; x < 32; x <<= 1) s3 += __shfl_xor(s3, x);
        if (lane == 0) pg2[wq] = s3;
        lds_barrier();
        if (half == 0) {
            const float rms = rsqrtf(((pg2[0] + pg2[1]) + (pg2[2] + pg2[3])) * (1.f / 128.f) + 1e-6f);
            const float zz = bf2f(p.z[(row0 + t) * 2048 + h * 128 + v]);
            p.gated[(row0 + t) * 2048 + h * 128 + v] = f2bf(o * rms * nw * silu(zz));
        }
    }
    {
        float* So = p.gs_sample + ((size_t)(b * 16 + h) * 128 + half * 64) * 128 + v;
#pragma unroll
        for (int k = 0; k < 64; ++k) So[(size_t)k * 128] = S[k];
    }
    lds_barrier();
}

#define MFMA32(a, b, c) __builtin_amdgcn_mfma_f32_32x32x16_bf16((a), (b), (c), 0, 0, 0)
constexpr int NCH = 65;
constexpr int NCU = BATCH * 16 * NCH;
__device__ __forceinline__ int crow(int reg, int hh) { return (reg & 3) + 8 * (reg >> 2) + 4 * hh; }
__device__ __forceinline__ bf16x8 pack_step(const f32x16& x, int s) {
    u32x4 q;
    q[0] = pk2(x[8 * s + 0], x[8 * s + 1]); q[1] = pk2(x[8 * s + 2], x[8 * s + 3]);
    q[2] = pk2(x[8 * s + 4], x[8 * s + 5]); q[3] = pk2(x[8 * s + 6], x[8 * s + 7]);
    return __builtin_bit_cast(bf16x8, q);
}
__device__ __forceinline__ bf16x8 frag_perm(const bf16_t* p0) {
    const uint2 lo = *(const uint2*)p0, hi = *(const uint2*)(p0 + 8);
    u32x4 q; q[0] = lo.x; q[1] = lo.y; q[2] = hi.x; q[3] = hi.y;
    return __builtin_bit_cast(bf16x8, q);
}

constexpr int SA_KB = 64 * 136 * 2, SA_VB = 2 * SA_KB, SA_AM = 3 * SA_KB, SA_SM = SA_AM + 64 * 68 * 4, SA_GROUP_BYTES = SA_SM + 5 * 64 * 4;
__device__ __forceinline__ void gdn_stageA(const Params& p, char* smem0, int bid, int nb) {
    {
        const int tid = tid_opaque();
        for (int idx = bid * NTHR + tid; idx < (BATCH + DB) * 3 * 4096; idx += nb * NTHR) {
            const int c = idx & 4095, r = (idx >> 12) % 3, b = idx / (3 * 4096);
            if (b < BATCH) p.gc_prompt[idx] = bf2f(p.mixed[((size_t)b * LP + (LP - 3) + r) * 4096 + c]);
            else { const int bs = b - BATCH; p.gc_sample[(size_t)(bs * 3 + r) * 4096 + c] = bf2f(p.mixed[((size_t)NPR + bs * 4 + 1 + r) * 4096 + c]); }
        }
    }
    for (int base = bid * 2; base < NCU; base += nb * 2) {
        const int tid = tid_opaque(), lane = tid & 63, grp = tid >> 8, wg = (tid >> 6) & 3, t2 = tid & 255;
        unsigned zofs = 0; asm volatile("" : "+v"(zofs));
        char* smem = smem0 + zofs + grp * SA_GROUP_BYTES;
        bf16_t* Qb = (bf16_t*)smem;
        bf16_t* Kb = (bf16_t*)(smem + SA_KB);
        bf16_t* Vb = (bf16_t*)(smem + SA_VB);
        float* Am = (float*)(smem + SA_AM);
        float* sbeta = (float*)(smem + SA_SM);
        float* sgc = sbeta + 64;
        float* segc = sgc + 64;
        float* sekd = segc + 64;
        float* srk = sekd + 64;
        const int u = base + grp;
        const int h = u & 15, n = (u >> 4) % NCH, b = u / (16 * NCH);
        const int kh = h >> 1;
        const size_t su = (size_t)((b * 16 + h) * NCH + n);
        const int t0 = n * 64;
        {
            const int cq = lane & 31, tsel = lane >> 5;
            const int tl0 = 16 * wg + 8 * tsel;
#pragma unroll
            for (int part = 0; part < 3; ++part) {
                const int chb = ((part == 0) ? (kh * 128) : (part == 1) ? (1024 + kh * 128) : (2048 + h * 128)) + cq * 4;
                f32x4 cw[4];
#pragma unroll
                for (int j = 0; j < 4; ++j) cw[j] = *(const f32x4*)(p.gdn_conv_w + j * 4096 + chb);
                uint2 xr[11];
#pragma unroll
                for (int i = 0; i < 11; ++i) {
                    const int t = t0 + tl0 - 3 + i;
                    if (t >= 0 && t < LP) xr[i] = *(const uint2*)(p.mixed + ((size_t)b * LP + t) * 4096 + chb);
                    else xr[i] = make_uint2(0u, 0u);
                }
                f32x4 yv[8];
                float ssv[8];
#pragma unroll
                for (int i = 0; i < 8; ++i) {
                    const f32x4 a = cvt_bf16x4(xr[i]) * cw[0] + cvt_bf16x4(xr[i + 1]) * cw[1] + cvt_bf16x4(xr[i + 2]) * cw[2] + cvt_bf16x4(xr[i + 3]) * cw[3];
                    const bool valid = (t0 + tl0 + i) < LP;
#pragma unroll
                    for (int e2 = 0; e2 < 4; ++e2) yv[i][e2] = valid ? silu(a[e2]) : 0.f;
                    ssv[i] = (yv[i][0] * yv[i][0] + yv[i][1] * yv[i][1]) + (yv[i][2] * yv[i][2] + yv[i][3] * yv[i][3]);
                }
                if (part < 2) {
#pragma unroll
                    for (int o = 1; o < 32; o <<= 1)
#pragma unroll
                        for (int i = 0; i < 8; ++i) ssv[i] += __shfl_xor(ssv[i], o);
                }
                bf16_t* dst = (part == 0) ? Qb : (part == 1) ? Kb : Vb;
#pragma unroll
                for (int i = 0; i < 8; ++i) {
                    f32x4 y = yv[i];
                    if (part < 2) y = y * (rsqrtf(ssv[i] + 1e-6f) * ((part == 0) ? 0.08838834764831845f : 1.f));
                    st_bf16x4(dst + (tl0 + i) * 136 + cq * 4, y);
                }
            }
        }
        if (wg == 0) {
            const int c = lane, t = t0 + c;
            float beta = 0.f, g = 0.f;
            if (t < LP) {
                const float* bap = p.ba + ((size_t)b * LP + t) * 32;
                beta = 1.f / (1.f + __expf(-bap[h]));
                const float aa = bap[16 + h] + p.gdn_dt_bias[h];
                const float sp = (aa > 20.f) ? aa : log1pf(__expf(aa));
                g = -__expf(p.gdn_a_log[h]) * sp;
            }
            float gc = g;
#pragma unroll
            for (int o = 1; o < 64; o <<= 1) { const float v = __shfl_up(gc, o); if (lane >= o) gc += v; }
            const float glast = __shfl(gc, 63);
            sbeta[c] = beta; sgc[c] = gc; segc[c] = __expf(gc); sekd[c] = __expf(glast - gc); srk[c] = beta * __expf(gc);
            if (lane == 0) p.g_dec[su] = __expf(glast);
        }
        lds_barrier();
        {
            const int ti = wg >> 1, tj = wg & 1;
            const int r = lane & 31, hh = lane >> 5;
            const int c = 32 * tj + r;
            const float gcc = sgc[c], bc = sbeta[c];
#pragma unroll
            for (int which = 0; which < 2; ++which) {
                f32x16 acc;
#pragma unroll
                for (int i = 0; i < 16; ++i) acc[i] = 0.f;
                const bf16_t* Ap = Kb + (32 * ti + r) * 136 + 8 * hh;
                const bf16_t* Bp = (which ? Qb : Kb) + (32 * tj + r) * 136 + 8 * hh;
#pragma unroll
                for (int ks = 0; ks < 8; ++ks) acc = MFMA32(*(const bf16x8*)(Ap + 16 * ks), *(const bf16x8*)(Bp + 16 * ks), acc);
                if (which == 0) {
#pragma unroll
                    for (int reg = 0; reg < 16; ++reg) {
                        const int cp = 32 * ti + crow(reg, hh);
                        const float dcy = __expf(fminf(gcc - sgc[cp], 0.f));
                        Am[c * 68 + cp] = (cp < c) ? (bc * acc[reg] * dcy) : 0.f;
                    }
                } else {
                    bf16_t* aq = p.g_aqk + su * 4096 + (size_t)c * 64;
#pragma unroll
                    for (int g4 = 0; g4 < 4; ++g4) {
                        const int cp0 = 32 * ti + 8 * g4 + 4 * hh;
                        f32x4 v;
#pragma unroll
                        for (int e2 = 0; e2 < 4; ++e2) {
                            const int cp = cp0 + e2;
                            const float dcy = __expf(fminf(gcc - sgc[cp], 0.f));
                            v[e2] = (cp <= c) ? (acc[4 * g4 + e2] * dcy) : 0.f;
                        }
                        st_bf16x4(aq + cp0, v);
                    }
                }
            }
        }
        {
#pragma unroll
            for (int it = 0; it < 4; ++it) {
                const int chk = t2 + 256 * it, c = chk >> 4, d0 = (chk & 15) * 8;
                const float ee = segc[c];
                const uint4 raw = *(const uint4*)(Qb + c * 136 + d0);
                uint4 o;
                o.x = pk2(__uint_as_float(raw.x << 16) * ee, __uint_as_float(raw.x & 0xffff0000u) * ee);
                o.y = pk2(__uint_as_float(raw.y << 16) * ee, __uint_as_float(raw.y & 0xffff0000u) * ee);
                o.z = pk2(__uint_as_float(raw.z << 16) * ee, __uint_as_float(raw.z & 0xffff0000u) * ee);
                o.w = pk2(__uint_as_float(raw.w << 16) * ee, __uint_as_float(raw.w & 0xffff0000u) * ee);
                *(uint4*)(p.g_qg + su * 8192 + c * 128 + d0) = o;
            }
#pragma unroll
            for (int it = 0; it < 4; ++it) {
                const int item = t2 + 256 * it, d = item & 127, c0 = (item >> 7) * 8;
                float v[8];
#pragma unroll
                for (int i = 0; i < 8; ++i) v[i] = bf2f(Kb[(c0 + i) * 136 + d]) * sekd[c0 + i];
                uint4 o; o.x = pk2(v[0], v[1]); o.y = pk2(v[2], v[3]); o.z = pk2(v[4], v[5]); o.w = pk2(v[6], v[7]);
                *(uint4*)(p.g_kdT + su * 8192 + d * 64 + c0) = o;
            }
        }
        lds_barrier();
        {
            const int col = 64 * wg + lane;
            const float* rs = sbeta + __builtin_amdgcn_readfirstlane((wg < 2) ? 0 : 256);
            const bf16_t* src = ((wg < 2) ? Vb : Kb) + (col & 127);
            float x[64];
#pragma unroll
            for (int i = 0; i < 64; ++i) x[i] = bf2f(src[i * 136]) * rs[i];
#pragma unroll
            for (int i0 = 0; i0 < 64; i0 += 4) {
                float a0 = x[i0], a1 = x[i0 + 1], a2 = x[i0 + 2], a3 = x[i0 + 3];
#pragma unroll
                for (int j4 = 0; j4 < i0; j4 += 4) {
                    const f32x4 r0 = *(const f32x4*)(Am + (i0) * 68 + j4), r1 = *(const f32x4*)(Am + (i0 + 1) * 68 + j4);
                    const f32x4 r2 = *(const f32x4*)(Am + (i0 + 2) * 68 + j4), r3 = *(const f32x4*)(Am + (i0 + 3) * 68 + j4);
                    a0 -= r0[0] * x[j4]; a1 -= r1[0] * x[j4]; a2 -= r2[0] * x[j4]; a3 -= r3[0] * x[j4];
                    a0 -= r0[1] * x[j4 + 1]; a1 -= r1[1] * x[j4 + 1]; a2 -= r2[1] * x[j4 + 1]; a3 -= r3[1] * x[j4 + 1];
                    a0 -= r0[2] * x[j4 + 2]; a1 -= r1[2] * x[j4 + 2]; a2 -= r2[2] * x[j4 + 2]; a3 -= r3[2] * x[j4 + 2];
                    a0 -= r0[3] * x[j4 + 3]; a1 -= r1[3] * x[j4 + 3]; a2 -= r2[3] * x[j4 + 3]; a3 -= r3[3] * x[j4 + 3];
                    if ((j4 & 12) == 12) asm volatile("" ::: "memory");
                }
                const f32x4 t1 = *(const f32x4*)(Am + (i0 + 1) * 68 + i0), t2v = *(const f32x4*)(Am + (i0 + 2) * 68 + i0), t3 = *(const f32x4*)(Am + (i0 + 3) * 68 + i0);
                a1 -= t1[0] * a0;
                a2 -= t2v[0] * a0; a2 -= t2v[1] * a1;
                a3 -= t3[0] * a0; a3 -= t3[1] * a1; a3 -= t3[2] * a2;
                x[i0] = a0; x[i0 + 1] = a1; x[i0 + 2] = a2; x[i0 + 3] = a3;
                asm volatile("" ::: "memory");
            }
            if (wg < 2) {
                float* up = p.g_u + su * 8192 + col;
#pragma unroll
                for (int i = 0; i < 64; ++i) up[i * 128] = x[i];
            } else {
                bf16_t* wp = p.g_negw + su * 8192 + (col - 128);
#pragma unroll
                for (int i = 0; i < 64; ++i) wp[i * 128] = f2bf(-x[i]);
            }
        }
        lds_barrier();
    }
}

constexpr int GB_NW = 0, GB_QG = 64 * 136, GB_KD = 2 * 64 * 136, GB_AQ = 2 * 64 * 136 + 128 * 72, GB_ELEMS = 2 * 64 * 136 + 128 * 72 + 64 * 72;
__device__ __forceinline__ void gdn_chain(const Params& p, char* smem, int b, int h) {
    bf16_t* lds = (bf16_t*)smem;
    const int tid = tid_opaque(), lane = tid & 63, wave = tid >> 6;
    const int r = lane & 31, hh = lane >> 5;
    const size_t su0 = (size_t)(b * 16 + h) * NCH;
    const bool loader = wave >= 4;
    const int t2 = tid - 256;
    uint4 sa0, sa1, sa2, sa3, sa4, sa5, sa6, sa7, sa8, sa9, sa10, sa11, sa12, sa13;
    uint4 sb0, sb1, sb2, sb3, sb4, sb5, sb6, sb7, sb8, sb9, sb10, sb11, sb12, sb13;
    f32x16 S[4], un0, un1;
#pragma unroll
    for (int i = 0; i < 4; ++i)
#pragma unroll
        for (int j = 0; j < 16; ++j) S[i][j] = 0.f;
    const int ch0 = t2, ch1 = t2 + 256, ch2 = t2 + 512, ch3 = t2 + 768;
#define GB_GLOAD(P, n_) do { const size_t su_ = su0 + (n_); \
        const bf16_t* a_ = p.g_negw + su_ * 8192; const bf16_t* b_ = p.g_qg + su_ * 8192; const bf16_t* c_ = p.g_kdT + su_ * 8192; const bf16_t* d_ = p.g_aqk + su_ * 4096; \
        P##0 = *(const uint4*)(a_ + (size_t)ch0 * 8); P##1 = *(const uint4*)(a_ + (size_t)ch1 * 8); P##2 = *(const uint4*)(a_ + (size_t)ch2 * 8); P##3 = *(const uint4*)(a_ + (size_t)ch3 * 8); \
        P##4 = *(const uint4*)(b_ + (size_t)ch0 * 8); P##5 = *(const uint4*)(b_ + (size_t)ch1 * 8); P##6 = *(const uint4*)(b_ + (size_t)ch2 * 8); P##7 = *(const uint4*)(b_ + (size_t)ch3 * 8); \
        P##8 = *(const uint4*)(c_ + (size_t)ch0 * 8); P##9 = *(const uint4*)(c_ + (size_t)ch1 * 8); P##10 = *(const uint4*)(c_ + (size_t)ch2 * 8); P##11 = *(const uint4*)(c_ + (size_t)ch3 * 8); \
        P##12 = *(const uint4*)(d_ + (size_t)ch0 * 8); P##13 = *(const uint4*)(d_ + (size_t)ch1 * 8); } while (0)
#define GB_SSTORE(P, buf_) do { bf16_t* q_ = (buf_); \
        *(uint4*)(q_ + GB_NW + (ch0 >> 4) * 136 + (ch0 & 15) * 8) = P##0; *(uint4*)(q_ + GB_NW + (ch1 >> 4) * 136 + (ch1 & 15) * 8) = P##1; \
        *(uint4*)(q_ + GB_NW + (ch2 >> 4) * 136 + (ch2 & 15) * 8) = P##2; *(uint4*)(q_ + GB_NW + (ch3 >> 4) * 136 + (ch3 & 15) * 8) = P##3; \
        *(uint4*)(q_ + GB_QG + (ch0 >> 4) * 136 + (ch0 & 15) * 8) = P##4; *(uint4*)(q_ + GB_QG + (ch1 >> 4) * 136 + (ch1 & 15) * 8) = P##5; \
        *(uint4*)(q_ + GB_QG + (ch2 >> 4) * 136 + (ch2 & 15) * 8) = P##6; *(uint4*)(q_ + GB_QG + (ch3 >> 4) * 136 + (ch3 & 15) * 8) = P##7; \
        *(uint4*)(q_ + GB_KD + (ch0 >> 3) * 72 + (ch0 & 7) * 8) = P##8; *(uint4*)(q_ + GB_KD + (ch1 >> 3) * 72 + (ch1 & 7) * 8) = P##9; \
        *(uint4*)(q_ + GB_KD + (ch2 >> 3) * 72 + (ch2 & 7) * 8) = P##10; *(uint4*)(q_ + GB_KD + (ch3 >> 3) * 72 + (ch3 & 7) * 8) = P##11; \
        *(uint4*)(q_ + GB_AQ + (ch0 >> 3) * 72 + (ch0 & 7) * 8) = P##12; *(uint4*)(q_ + GB_AQ + (ch1 >> 3) * 72 + (ch1 & 7) * 8) = P##13; } while (0)
#define GB_ULOAD(n_) do { const float* up_ = p.g_u + (su0 + (n_)) * 8192 + 32 * wave + r; \
        _Pragma("unroll") for (int reg_ = 0; reg_ < 16; ++reg_) { un0[reg_] = up_[(crow(reg_, hh)) * 128]; un1[reg_] = up_[(32 + crow(reg_, hh)) * 128]; } } while (0)
    if (loader) {
        bf16_t* buf0 = lds;
        bf16_t* buf1 = lds + GB_ELEMS;
        GB_GLOAD(sa, 0); GB_SSTORE(sa, buf0);
        GB_GLOAD(sa, 1);
        lds_barrier();
        for (int n = 0; n < NCH; n += 2) {
            if (n + 2 < NCH) { GB_GLOAD(sb, n + 2); }
            if (n + 1 < NCH) { GB_SSTORE(sa, buf1); }
            lds_barrier();
            if (n + 1 >= NCH) break;
            if (n + 3 < NCH) { GB_GLOAD(sa, n + 3); }
            if (n + 2 < NCH) { GB_SSTORE(sb, buf0); }
            lds_barrier();
        }
    } else {
        GB_ULOAD(0);
        float dec_next = p.g_dec[su0];
        lds_barrier();
        for (int n = 0; n < NCH; ++n) {
            unsigned zofs = 0; asm volatile("" : "+v"(zofs));
            bf16_t* cur = lds + (n & 1) * GB_ELEMS + zofs;
            const bool more = (n + 1 < NCH);
            const float dec = dec_next;
            if (more) dec_next = p.g_dec[su0 + n + 1];
            f32x16 vn[2], o[2];
            vn[0] = un0; vn[1] = un1;
#pragma unroll
            for (int j = 0; j < 16; ++j) { o[0][j] = 0.f; o[1][j] = 0.f; }
            if (more) { GB_ULOAD(n + 1); }
#pragma unroll
            for (int kt = 0; kt < 4; ++kt)
#pragma unroll
                for (int s = 0; s < 2; ++s) {
                    const bf16x8 sb = pack_step(S[kt], s);
                    const int k0 = 32 * kt + 16 * s + 4 * hh;
#pragma unroll
                    for (int ct = 0; ct < 2; ++ct) {
                        vn[ct] = MFMA32(frag_perm(cur + GB_NW + (32 * ct + r) * 136 + k0), sb, vn[ct]);
                        o[ct] = MFMA32(frag_perm(cur + GB_QG + (32 * ct + r) * 136 + k0), sb, o[ct]);
                    }
                }
            bf16x8 vb[2][2];
#pragma unroll
            for (int ct = 0; ct < 2; ++ct)
#pragma unroll
                for (int s = 0; s < 2; ++s) vb[ct][s] = pack_step(vn[ct], s);
#pragma unroll
            for (int s = 0; s < 2; ++s) {
                o[0] = MFMA32(frag_perm(cur + GB_AQ + (r) * 72 + 16 * s + 4 * hh), vb[0][s], o[0]);
                o[1] = MFMA32(frag_perm(cur + GB_AQ + (32 + r) * 72 + 16 * s + 4 * hh), vb[0][s], o[1]);
                o[1] = MFMA32(frag_perm(cur + GB_AQ + (32 + r) * 72 + 32 + 16 * s + 4 * hh), vb[1][s], o[1]);
            }
#pragma unroll
            for (int dt = 0; dt < 4; ++dt) {
                S[dt] = S[dt] * dec;
#pragma unroll
                for (int ckt = 0; ckt < 2; ++ckt)
#pragma unroll
                    for (int s = 0; s < 2; ++s)
                        S[dt] = MFMA32(frag_perm(cur + GB_KD + (32 * dt + r) * 72 + 32 * ckt + 16 * s + 4 * hh), vb[ckt][s], S[dt]);
            }
            asm volatile("" :: "v"(un0), "v"(un1), "v"(dec_next));
#pragma unroll
            for (int ct = 0; ct < 2; ++ct)
#pragma unroll
                for (int reg = 0; reg < 16; ++reg) {
                    const int t = 64 * n + 32 * ct + crow(reg, hh);
                    if (t < LP) p.g_o[(((size_t)b * LP + t) * 16 + h) * 128 + 32 * wave + r] = f2bf(o[ct][reg]);
                }
            lds_barrier();
        }
    }
    if (!loader) {
#pragma unroll
        for (int dt = 0; dt < 4; ++dt)
#pragma unroll
            for (int reg = 0; reg < 16; ++reg)
                p.gs_prompt[((size_t)(b * 16 + h) * 128 + 32 * dt + crow(reg, hh)) * 128 + 32 * wave + r] = S[dt][reg];
    }
    lds_barrier();
}

__device__ __forceinline__ void gdn_seq_phase(const Params& p, char* smem, int bid, int nb, int rep = 0) {
    if (bid < 64) gdn_chain(p, smem, bid >> 4, bid & 15);
    else {
        float* tile = (float*)smem;
        const int b2 = bid - 64, n2 = nb - 64;
        transpose_convert(p.gdn_w_out, 2048, D, D, p.wt_gout, tile, b2, n2);
        transpose_convert(p.mlp_w1, D, DFF, DFF, p.wt_w1, tile, b2, n2);
        transpose_convert(p.mlp_w1 + (size_t)D * DFF, D, DFF, DFF, p.wt_w1 + (size_t)D * DFF, tile, b2, n2);
        transpose_convert(p.mlp_w2, DFF, D, D, p.wt_w2, tile, b2, n2);
        transpose_convert(p.mlp_w2 + (size_t)D * DFF, DFF, D, D, p.wt_w2 + (size_t)D * DFF, tile, b2, n2);
        transpose_convert(p.dsa_w_in, D, DIN, DIN_PAD, p.wt_din, tile, b2, n2);
        transpose_convert(p.dsa_w_o, D, D, D, p.wt_do, tile, b2, n2);
    }
    int* slot = (int*)(smem + LDS_BYTES - 32);
    const int tid = tid_opaque();
    for (;;) {
        if (threadIdx.x == 0) *slot = (int)atomicAdd(p.bar + 3520 + 16 * rep, 1u);
        lds_barrier();
        const int u = *slot;
        lds_barrier();
        if (u >= DB * 16 / 2) break;
        gdn_sample_pass(p, smem, u, tid_opaque());
    }
}

__device__ __forceinline__ void gdn_gate_phase(const Params& p, int bid, int nb) {
    const int tid_ = tid_opaque(); const int lane = tid_ & 63, wave = tid_ >> 6;
    const int sub = lane >> 4, l16 = lane & 15;
    f32x4 nw0 = *(const f32x4*)(p.gdn_norm_w + l16 * 8), nw1 = *(const f32x4*)(p.gdn_norm_w + l16 * 8 + 4);
    for (int it4 = bid * 8 + wave; it4 < NPR * 4; it4 += nb * 8) {
        const size_t off = ((size_t)it4 * 4 + sub) * 128 + l16 * 8;
        const uint4 ov = *(const uint4*)(p.g_o + off);
        const uint4 zv = *(const uint4*)(p.z + off);
        const f32x4 o0 = cvt_bf16x4(make_uint2(ov.x, ov.y)), o1 = cvt_bf16x4(make_uint2(ov.z, ov.w));
        const f32x4 z0 = cvt_bf16x4(make_uint2(zv.x, zv.y)), z1 = cvt_bf16x4(make_uint2(zv.z, zv.w));
        float ss = ((o0[0] * o0[0] + o0[1] * o0[1]) + (o0[2] * o0[2] + o0[3] * o0[3])) + ((o1[0] * o1[0] + o1[1] * o1[1]) + (o1[2] * o1[2] + o1[3] * o1[3]));
#pragma unroll
        for (int x = 1; x < 16; x <<= 1) ss += __shfl_xor(ss, x);
        const float rms = rsqrtf(ss * (1.f / 128.f) + 1e-6f);
        uint4 g;
        g.x = pk2(o0[0] * rms * nw0[0] * silu(z0[0]), o0[1] * rms * nw0[1] * silu(z0[1]));
        g.y = pk2(o0[2] * rms * nw0[2] * silu(z0[2]), o0[3] * rms * nw0[3] * silu(z0[3]));
        g.z = pk2(o1[0] * rms * nw1[0] * silu(z1[0]), o1[1] * rms * nw1[1] * silu(z1[1]));
        g.w = pk2(o1[2] * rms * nw1[2] * silu(z1[2]), o1[3] * rms * nw1[3] * silu(z1[3]));
        *(uint4*)(p.gated + off) = g;
    }
}

__device__ __forceinline__ void rope4(const float* tab, int fi, f32x4 x, f32x4 partner, bool first, f32x4& o) {
    const f32x4 t0 = *(const f32x4*)(tab + fi * 2), t1 = *(const f32x4*)(tab + fi * 2 + 4);
    const float sg = first ? -1.f : 1.f;
    o[0] = x[0] * t0[0] + sg * partner[0] * t0[1];
    o[1] = x[1] * t0[2] + sg * partner[1] * t0[3];
    o[2] = x[2] * t1[0] + sg * partner[2] * t1[1];
    o[3] = x[3] * t1[2] + sg * partner[3] * t1[3];
}
__device__ __forceinline__ void dsa_post_phase(const Params& p, char* smem, int bid, int nb) {
    bf16_t* vt = (bf16_t*)smem;
    for (int u = bid; u < BATCH * 65 + 8; u += nb) {
        const int tid = tid_opaque(); const int lane = tid & 63, wave = tid >> 6;
        const bool prompt = u < BATCH * 65;
        const int b = prompt ? (u / 65) : 0, t0 = prompt ? (u % 65) * 64 : 0;
        for (int r8 = 0; r8 < 8; ++r8) {
            const int tl = wave * 8 + r8;
            const int t = t0 + tl;
            const bool rvalid = prompt ? (t < LP) : true;
            const int row = prompt ? (b * LP + t) : (NPR + (u - BATCH * 65) * 64 + tl);
            if (!rvalid) {
                for (int e = lane; e < 256; e += 64) vt[e * 72 + tl] = 0;
                continue;
            }
            const float* P = p.p1 + (size_t)row * DIN_PAD;
            const int pos = prompt ? t : (PAST + ((row - NPR) & 3));
            const float* tab = p.rope_tab + (size_t)pos * 48;
            float* kout = prompt ? (p.k_prompt + (size_t)row * 256) : (p.k_sample + (size_t)(row - NPR) * 256);
            float* vout = prompt ? (p.v_prompt + (size_t)row * 256) : (p.v_sample + (size_t)(row - NPR) * 256);
#pragma unroll
            for (int j = 0; j < 5; ++j) {
                const int e0 = (lane + 64 * j) * 4, d0 = e0 & 127;
                f32x4 x = *(const f32x4*)(P + e0);
                if (d0 < 32) {
                    const bool first = d0 < 16;
                    const f32x4 pr = *(const f32x4*)(P + (first ? e0 + 16 : e0 - 16));
                    rope4(tab, d0 & 15, x, pr, first, x);
                }
                if (j < 4) {
                    if (prompt) st_bf16x4(p.q_b + (size_t)row * 1024 + e0, x * 0.12751743f);
                    else *(f32x4*)(p.qr + (size_t)row * 1024 + e0) = x;
                } else {
                    const int ek = e0 - 1024;
                    *(f32x4*)(kout + ek) = x;
                    if (prompt) st_bf16x4(p.k_b + ((size_t)(b * 2 + (ek >> 7)) * LPAD + t) * 128 + d0, x);
                }
            }
            {
                const int e0 = lane * 4;
                const f32x4 x = *(const f32x4*)(P + 1280 + e0);
                *(f32x4*)(vout + e0) = x;
                if (prompt) {
#pragma unroll
                    for (int i = 0; i < 4; ++i) vt[(e0 + i) * 72 + tl] = f2bf(x[i]);
                }
            }
#pragma unroll
            for (int j = 0; j < 2; ++j) {
                const int e0 = (lane + 64 * j) * 4, d0 = e0 & 63;
                f32x4 x = *(const f32x4*)(P + 1536 + e0);
                if (d0 < 16) {
                    const bool first = d0 < 8;
                    const f32x4 pr = *(const f32x4*)(P + 1536 + (first ? e0 + 8 : e0 - 8));
                    rope4(tab, 16 + (d0 & 7), x, pr, first, x);
                }
                if (prompt) st_bf16x4(p.iq_b + (size_t)row * 512 + e0, x);
                else *(f32x4*)(p.iq + (size_t)row * 512 + e0) = x;
            }
            {
                const float x = P[2048 + lane];
                const float mu = wave_sum(x) * (1.f / 64.f);
                const float dv = x - mu;
                const float var = wave_sum(dv * dv) * (1.f / 64.f);
                const float xn = dv * rsqrtf(var + 1e-5f) * p.dsa_ik_g[lane] + p.dsa_ik_b[lane];
                const float other = __shfl_xor(xn, 8);
                float o = xn;
                if (lane < 16) {
                    const float c = tab[(16 + (lane & 7)) * 2], s = tab[(16 + (lane & 7)) * 2 + 1];
                    if (lane < 8) o = xn * c - other * s; else o = xn * c + other * s;
                }
                float* io = prompt ? (p.ik_prompt + (size_t)row * 64) : (p.ik_sample + (size_t)(row - NPR) * 64);
                io[lane] = o;
                if (prompt) p.ik_b[((size_t)b * LPAD + t) * 64 + lane] = f2bf(o);
            }
            if (lane < 8) p.iw[(size_t)row * 8 + lane] = P[2112 + lane] * 0.35355339059327373f;
        }
        lds_barrier();
        if (prompt) {
#pragma unroll
            for (int i = 0; i < 4; ++i) {
                const int ch = tid + 512 * i, rr = ch >> 3, c8 = (ch & 7) * 8;
                const uint4 v = *(const uint4*)(vt + rr * 72 + c8);
                *(uint4*)(p.vt_b + ((size_t)(b * 2 + (rr >> 7)) * 128 + (rr & 127)) * LPAD + t0 + c8) = v;
            }
        }
        lds_barrier();
    }
    for (int idx = bid * NTHR + tid_opaque(); idx < BATCH * (LPAD - LP) * 256; idx += nb * NTHR) {
        const int c = idx & 255, tp = (idx >> 8) % (LPAD - LP), bb = idx / ((LPAD - LP) * 256);
        const int t = LP + tp, kvh = c >> 7, d = c & 127;
        p.k_b[((size_t)(bb * 2 + kvh) * LPAD + t) * 128 + d] = 0;
        if (c < 64) p.ik_b[((size_t)bb * LPAD + t) * 64 + c] = 0;
        if (c < 65) p.maskT[((size_t)bb * 65 + c) * LPAD + t] = (c == 0) ? 1ull : 0ull;
    }
}

__device__ __forceinline__ const float* ik_row(const Params& p, bool prompt, int b, int s) {
    if (prompt) return p.ik_prompt + ((size_t)b * LP + s) * 64;
    if (s < PAST) { const int pg = p.page_table[b * 16 + (s >> 7)]; return p.cache_ik + ((size_t)pg * 128 + (s & 127)) * 64; }
    return p.ik_sample + ((size_t)b * DS + (s - PAST)) * 64;
}
__device__ __forceinline__ const float* kv_row(const float* own_p, const float* own_s, const float* cache, const int* page_table,
                                               bool prompt, int b, int s) {
    if (prompt) return own_p + ((size_t)b * LP + s) * 256;
    if (s < PAST) { const int pg = page_table[b * 16 + (s >> 7)]; return cache + ((size_t)pg * 128 + (s & 127)) * 256; }
    return own_s + ((size_t)b * DS + (s - PAST)) * 256;
}

template <bool PROMPT, int NREG>
__device__ __forceinline__ void select_emit(const float* sc, int qpos, int lane, unsigned long long* maskcol, int* selrow) {
    const unsigned long long ltmask = (1ull << lane) - 1ull;
    unsigned key[NREG];
    unsigned kmax = 0u, kmin = 0xffffffffu;
#pragma unroll
    for (int j = 0; j < NREG; ++j) {
        const int s = j * 64 + lane;
        const bool cand = (s >= 16 && s <= qpos);
        const float x = cand ? sc[s] : -INFINITY;
        const unsigned u = __float_as_uint(x);
        key[j] = (u & 0x80000000u) ? ~u : (u | 0x80000000u);
        kmax = max(kmax, key[j]);
        kmin = min(kmin, cand ? key[j] : 0xffffffffu);
    }
#pragma unroll
    for (int o = 1; o < 64; o <<= 1) { kmax = max(kmax, (unsigned)__shfl_xor((int)kmax, o)); kmin = min(kmin, (unsigned)__shfl_xor((int)kmin, o)); }
    unsigned lo = kmin, hi = kmax;
    bool exact = false;
    while (lo < hi) {
        const unsigned mid = lo + ((hi - lo) >> 1) + ((hi - lo) & 1u);
        int c = 0;
#pragma unroll
        for (int j = 0; j < NREG; ++j) c += __popcll(__ballot(key[j] >= mid));
        if (c >= 240) { lo = mid; if (c == 240) { exact = true; break; } } else hi = mid - 1u;
    }
    const unsigned T = lo;
    if (!PROMPT) { if (lane < 16) selrow[lane] = lane; }
    int base = 16;
    unsigned long long myword = 0ull, word64 = 0ull;
    if (exact) {
#pragma unroll
        for (int j = 0; j < NREG; ++j) {
            const bool take = key[j] >= T;
            unsigned long long m = __ballot(take);
            if (PROMPT) {
                if (j == 0) m |= 0xFFFFull;
                if (j < 64) { if (lane == j) myword = m; } else word64 = m;
            } else {
                if (take) selrow[base + __popcll(m & ltmask)] = j * 64 + lane;
                base += __popcll(m);
            }
        }
    } else {
        int cgt = 0;
#pragma unroll
        for (int j = 0; j < NREG; ++j) cgt += __popcll(__ballot(key[j] > T));
        const int need_eq = 240 - cgt;
        int erun = 0;
#pragma unroll
        for (int j = 0; j < NREG; ++j) {
            const bool gt = key[j] > T, eq = key[j] == T;
            const unsigned long long meq = __ballot(eq);
            const int rank = erun + __popcll(meq & ltmask);
            const bool take = gt || (eq && rank < need_eq);
            unsigned long long m = __ballot(take);
            if (PROMPT) {
                if (j == 0) m |= 0xFFFFull;
                if (j < 64) { if (lane == j) myword = m; } else word64 = m;
            } else {
                if (take) selrow[base + __popcll(m & ltmask)] = j * 64 + lane;
                base += __popcll(m);
            }
            erun += __popcll(meq);
        }
    }
    if (PROMPT) {
        if (NREG == 65) { maskcol[(size_t)lane * LPAD] = myword; if (lane == 0) maskcol[(size_t)64 * LPAD] = word64; }
        else { if (lane < NREG) maskcol[(size_t)lane * LPAD] = myword; else if (lane < 64) maskcol[(size_t)lane * LPAD] = 0ull; if (lane == 0) maskcol[(size_t)64 * LPAD] = 0ull; }
    }
}

__device__ __forceinline__ bf16x8 ld_f32x8_bf16(const float* p) {
    const f32x4 a = *(const f32x4*)p, b = *(const f32x4*)(p + 4);
    u32x4 q; q[0] = pk2(a[0], a[1]); q[1] = pk2(a[2], a[3]); q[2] = pk2(b[0], b[1]); q[3] = pk2(b[2], b[3]);
    return __builtin_bit_cast(bf16x8, q);
}
__device__ __forceinline__ void indexer_sample_unit(const Params& p, float* sc, int b, int tid) {
    const int lane = tid & 63, wave = tid >> 6;
    const int r = lane & 31, hh = lane >> 5;
    bf16x8 af[4];
    {
        const int e2 = r & 3, hb = (r >> 2) & 1, a = r >> 3;
        const int qi = 2 * hb + (a >> 1), head = 4 * (a & 1) + e2;
        const float* ap = p.iq + ((size_t)NPR + b * 4 + qi) * 512 + head * 64 + 8 * hh;
#pragma unroll
        for (int ks = 0; ks < 4; ++ks) af[ks] = ld_f32x8_bf16(ap + 16 * ks);
    }
    float wq[2][8];
#pragma unroll
    for (int ql = 0; ql < 2; ++ql) {
        const float* wp = p.iw + ((size_t)NPR + b * 4 + 2 * hh + ql) * 8;
        const f32x4 w0 = *(const f32x4*)wp, w1 = *(const f32x4*)(wp + 4);
#pragma unroll
        for (int e2 = 0; e2 < 4; ++e2) { wq[ql][e2] = w0[e2]; wq[ql][4 + e2] = w1[e2]; }
    }
    asm volatile("" :: "v"(af[0]), "v"(af[1]), "v"(af[2]), "v"(af[3]));
#pragma unroll
    for (int ql = 0; ql < 2; ++ql) asm volatile("" :: "v"(wq[ql][0]), "v"(wq[ql][1]), "v"(wq[ql][2]), "v"(wq[ql][3]), "v"(wq[ql][4]), "v"(wq[ql][5]), "v"(wq[ql][6]), "v"(wq[ql][7]));
    const float* kps[9];
#pragma unroll
    for (int i = 0; i < 9; ++i) {
        const int kt = wave + 8 * i;
        const int s = 32 * (kt < 65 ? kt : 64) + r;
        const float* kp;
        if (s < PAST) { const int pg = p.page_table[b * 16 + (s >> 7)]; kp = p.cache_ik + ((size_t)pg * 128 + (s & 127)) * 64; }
        else kp = p.ik_sample + ((size_t)b * DS + ((s - PAST) & 3)) * 64;
        kps[i] = kp + 8 * hh;
    }
    f32x4 nx[8];
#pragma unroll
    for (int ks = 0; ks < 4; ++ks) { nx[2 * ks] = *(const f32x4*)(kps[0] + 16 * ks); nx[2 * ks + 1] = *(const f32x4*)(kps[0] + 16 * ks + 4); }
#pragma unroll
    for (int i = 0; i < 9; ++i) {
        const int kt = wave + 8 * i;
        if (kt < 65) {
            const int s = 32 * kt + r;
            bf16x8 bq[4];
#pragma unroll
            for (int ks = 0; ks < 4; ++ks) {
                u32x4 q; q[0] = pk2(nx[2 * ks][0], nx[2 * ks][1]); q[1] = pk2(nx[2 * ks][2], nx[2 * ks][3]);
                q[2] = pk2(nx[2 * ks + 1][0], nx[2 * ks + 1][1]); q[3] = pk2(nx[2 * ks + 1][2], nx[2 * ks + 1][3]);
                bq[ks] = __builtin_bit_cast(bf16x8, q);
            }
            if (i + 1 < 9) {
#pragma unroll
                for (int ks = 0; ks < 4; ++ks) { nx[2 * ks] = *(const f32x4*)(kps[i + 1] + 16 * ks); nx[2 * ks + 1] = *(const f32x4*)(kps[i + 1] + 16 * ks + 4); }
            }
            f32x16 acc;
#pragma unroll
            for (int j = 0; j < 16; ++j) acc[j] = 0.f;
#pragma unroll
            for (int ks = 0; ks < 4; ++ks) acc = MFMA32(af[ks], bq[ks], acc);
#pragma unroll
            for (int ql = 0; ql < 2; ++ql) {
                float v = 0.f;
#pragma unroll
                for (int a2 = 0; a2 < 2; ++a2)
#pragma unroll
                    for (int e2 = 0; e2 < 4; ++e2) v += wq[ql][4 * a2 + e2] * fmaxf(acc[4 * (2 * ql + a2) + e2], 0.f);
                sc[(2 * hh + ql) * 2112 + s] = v;
            }
        }
    }
    lds_barrier();
    if (wave < 4) select_emit<false, 33>(sc + wave * 2112, PAST + wave, lane, nullptr, p.sel + ((size_t)NPR + b * 4 + wave) * 256);
    lds_barrier();
}

__device__ __forceinline__ void indexer_prompt_unit(const Params& p, float* sc, int b, int g8, int tid) {
    const int lane = tid & 63, wave = tid >> 6;
    const int r = lane & 31, hh = lane >> 5;
    const int t0 = g8 * 8;
    if (t0 < 256) {
        const int qpos = t0 + wave;
        unsigned long long* maskcol = p.maskT + (size_t)b * 65 * LPAD + qpos;
        for (int j = lane; j < 65; j += 64) {
            const int lo = j * 64;
            unsigned long long m = 0ull;
            if (qpos >= lo + 63) m = ~0ull; else if (qpos >= lo) m = (1ull << (qpos - lo + 1)) - 1ull;
            maskcol[(size_t)j * LPAD] = m;
        }
        return;
    }
    bf16x8 af[2][4];
    {
        const int e2 = r & 3, hb = (r >> 2) & 1, a = r >> 3;
        const int qi = 2 * hb + (a >> 1), head = 4 * (a & 1) + e2;
#pragma unroll
        for (int rt = 0; rt < 2; ++rt) {
            const bf16_t* ap = p.iq_b + ((size_t)b * LP + t0 + 4 * rt + qi) * 512 + head * 64 + 8 * hh;
#pragma unroll
            for (int ks = 0; ks < 4; ++ks) af[rt][ks] = *(const bf16x8*)(ap + 16 * ks);
        }
    }
    float wq[2][2][8];
#pragma unroll
    for (int rt = 0; rt < 2; ++rt)
#pragma unroll
        for (int ql = 0; ql < 2; ++ql) {
            const float* wp = p.iw + ((size_t)b * LP + t0 + 4 * rt + 2 * hh + ql) * 8;
            const f32x4 w0 = *(const f32x4*)wp, w1 = *(const f32x4*)(wp + 4);
#pragma unroll
            for (int e2 = 0; e2 < 4; ++e2) { wq[rt][ql][e2] = w0[e2]; wq[rt][ql][4 + e2] = w1[e2]; }
        }
    const int nkt = (t0 + 7) / 32 + 1;
    const bf16_t* kbase = p.ik_b + ((size_t)b * LPAD + r) * 64 + 8 * hh;
    bf16x8 bq[4], bn[4];
    {
        const int k1 = (wave + 8 < nkt) ? (wave + 8) : wave;
#pragma unroll
        for (int ks = 0; ks < 4; ++ks) { bq[ks] = *(const bf16x8*)(kbase + (size_t)wave * 32 * 64 + 16 * ks); bn[ks] = *(const bf16x8*)(kbase + (size_t)k1 * 32 * 64 + 16 * ks); }
    }
    asm volatile("" :: "v"(af[0][0]), "v"(af[0][1]), "v"(af[0][2]), "v"(af[0][3]), "v"(af[1][0]), "v"(af[1][1]), "v"(af[1][2]), "v"(af[1][3]));
#pragma unroll
    for (int rt = 0; rt < 2; ++rt)
#pragma unroll
        for (int ql = 0; ql < 2; ++ql) asm volatile("" :: "v"(wq[rt][ql][0]), "v"(wq[rt][ql][1]), "v"(wq[rt][ql][2]), "v"(wq[rt][ql][3]), "v"(wq[rt][ql][4]), "v"(wq[rt][ql][5]), "v"(wq[rt][ql][6]), "v"(wq[rt][ql][7]));
    for (int kt = wave; kt < nkt; kt += 8) {
        bf16x8 bn2[4];
        const int ktn = (kt + 16 < nkt) ? (kt + 16) : kt;
#pragma unroll
        for (int ks = 0; ks < 4; ++ks) bn2[ks] = *(const bf16x8*)(kbase + (size_t)ktn * 32 * 64 + 16 * ks);
#pragma unroll
        for (int rt = 0; rt < 2; ++rt) {
            f32x16 acc;
#pragma unroll
            for (int i = 0; i < 16; ++i) acc[i] = 0.f;
#pragma unroll
            for (int ks = 0; ks < 4; ++ks) acc = MFMA32(af[rt][ks], bq[ks], acc);
#pragma unroll
            for (int ql = 0; ql < 2; ++ql) {
                float s = 0.f;
#pragma unroll
                for (int a2 = 0; a2 < 2; ++a2)
#pragma unroll
                    for (int e2 = 0; e2 < 4; ++e2) s += wq[rt][ql][4 * a2 + e2] * fmaxf(acc[4 * (2 * ql + a2) + e2], 0.f);
                sc[(4 * rt + 2 * hh + ql) * 4160 + 32 * kt + r] = s;
            }
        }
#pragma unroll
        for (int ks = 0; ks < 4; ++ks) { bq[ks] = bn[ks]; bn[ks] = bn2[ks]; }
    }
    lds_barrier();
    {
        const int qpos = t0 + wave;
        if (t0 + 7 < 33 * 64) select_emit<true, 33>(sc + wave * 4160, qpos, lane, p.maskT + (size_t)b * 65 * LPAD + qpos, nullptr);
        else select_emit<true, 65>(sc + wave * 4160, qpos, lane, p.maskT + (size_t)b * 65 * LPAD + qpos, nullptr);
    }
    lds_barrier();
}

__device__ __forceinline__ void indexer_phase(const Params& p, char* smem, int bid, int nb, int rep = 0) {
    int* slot = (int*)(smem + LDS_BYTES - 32);
    for (;;) {
        const int tid = tid_opaque();
        unsigned zofs = 0; asm volatile("" : "+v"(zofs));
        float* sc = (float*)(smem + zofs);
        if (threadIdx.x == 0) *slot = (int)atomicAdd(p.bar + 3648 + 16 * rep, 1u);
        lds_barrier();
        const int u = *slot;
        lds_barrier();
        if (u >= DB + BATCH * 514) break;
        if (u < DB) {
            indexer_sample_unit(p, sc, u, tid);
        } else {
            const int v = u - DB;
            indexer_prompt_unit(p, sc, v & 3, 513 - (v >> 2), tid);
        }
    }
}

__device__ __forceinline__ void attn_sample_query(const Params& p, char* smem, int row) {
    float* qs = (float*)smem;
    float* ps = qs + 1024;
    const float** kptr = (const float**)(ps + 2048);
    const float** vptr = kptr + 256;
    float* red = (float*)(vptr + 256);
    const int tid = tid_opaque(), lane = tid & 63, wave = tid >> 6;
    const int b = (row - NPR) >> 2;
    qs[tid] = p.qr[(size_t)row * 1024 + tid];
    qs[tid + 512] = p.qr[(size_t)row * 1024 + 512 + tid];
    if (tid < 256) {
        const int s = p.sel[(size_t)row * 256 + tid];
        const float *kp, *vp;
        if (s < PAST) { const int pg = p.page_table[b * 16 + ((s < 0 ? 0 : s) >> 7)]; const size_t ro = ((size_t)pg * 128 + ((s < 0 ? 0 : s) & 127)) * 256; kp = p.cache_k + ro; vp = p.cache_v + ro; }
        else { const size_t ro = ((size_t)b * DS + (s - PAST)) * 256; kp = p.k_sample + ro; vp = p.v_sample + ro; }
        kptr[tid] = (s < 0) ? nullptr : kp;
        vptr[tid] = vp;
    }
    lds_barrier();
    {
        const int j = tid & 255, kvh = tid >> 8;
        const float* kp0 = kptr[j];
        const bool valid = kp0 != nullptr;
        const float* kp = (valid ? kp0 : vptr[j]) + kvh * 128;
        float d0 = 0.f, d1 = 0.f, d2 = 0.f, d3 = 0.f;
        const float* q0 = qs + (kvh * 4) * 128;
#pragma unroll 16
        for (int c = 0; c < 32; ++c) {
            const f32x4 kv = *(const f32x4*)(kp + c * 4);
            const f32x4 a0 = *(const f32x4*)(q0 + c * 4), a1 = *(const f32x4*)(q0 + 128 + c * 4), a2 = *(const f32x4*)(q0 + 256 + c * 4),
                        a3 = *(const f32x4*)(q0 + 384 + c * 4);
            d0 += kv[0] * a0[0] + kv[1] * a0[1] + kv[2] * a0[2] + kv[3] * a0[3];
            d1 += kv[0] * a1[0] + kv[1] * a1[1] + kv[2] * a1[2] + kv[3] * a1[3];
            d2 += kv[0] * a2[0] + kv[1] * a2[1] + kv[2] * a2[2] + kv[3] * a2[3];
            d3 += kv[0] * a3[0] + kv[1] * a3[1] + kv[2] * a3[2] + kv[3] * a3[3];
        }
        const float scl = 0.08838834764831845f;
        ps[(kvh * 4 + 0) * 256 + j] = valid ? d0 * scl : -INFINITY;
        ps[(kvh * 4 + 1) * 256 + j] = valid ? d1 * scl : -INFINITY;
        ps[(kvh * 4 + 2) * 256 + j] = valid ? d2 * scl : -INFINITY;
        ps[(kvh * 4 + 3) * 256 + j] = valid ? d3 * scl : -INFINITY;
    }
    lds_barrier();
    {
        float v[4]; float m = -INFINITY;
#pragma unroll
        for (int i = 0; i < 4; ++i) { v[i] = ps[wave * 256 + lane + 64 * i]; m = fmaxf(m, v[i]); }
        m = wave_max(m);
        float sum = 0.f;
#pragma unroll
        for (int i = 0; i < 4; ++i) { v[i] = __expf(v[i] - m); sum += v[i]; }
        sum = wave_sum(sum);
        const float inv = 1.f / sum;
#pragma unroll
        for (int i = 0; i < 4; ++i) ps[wave * 256 + lane + 64 * i] = v[i] * inv;
    }
    lds_barrier();
    {
        const int kvh = tid >> 8, kg = (tid >> 5) & 7, d4 = tid & 31;
        f32x4 acc[4];
#pragma unroll
        for (int g = 0; g < 4; ++g) acc[g] = (f32x4){0.f, 0.f, 0.f, 0.f};
#pragma unroll 16
        for (int i = 0; i < 32; ++i) {
            const int j = kg * 32 + i;
            const f32x4 vv = *(const f32x4*)(vptr[j] + kvh * 128 + d4 * 4);
#pragma unroll
            for (int g = 0; g < 4; ++g) acc[g] += vv * ps[(kvh * 4 + g) * 256 + j];
        }
#pragma unroll
        for (int g = 0; g < 4; ++g) *(f32x4*)(red + ((kg * 2 + kvh) * 4 + g) * 128 + d4 * 4) = acc[g];
    }
    lds_barrier();
    {
        const int h = wave, d = lane * 2;
        float o0 = 0.f, o1 = 0.f;
#pragma unroll
        for (int kg = 0; kg < 8; ++kg) { const f32x2 t = *(const f32x2*)(red + ((kg * 2 + (h >> 2)) * 4 + (h & 3)) * 128 + d); o0 += t[0]; o1 += t[1]; }
        *(unsigned*)(p.gated + (size_t)row * 1024 + h * 128 + d) = pk2(o0, o1);
    }
    lds_barrier();
}

constexpr int AT_K = 0, AT_V = 64 * 136, AT_ELEMS = 64 * 136 + 128 * 72;
__device__ __forceinline__ void attn_dense_unit(const Params& p, char* smem, int b, int kvh, int qb) {
    bf16_t* lds = (bf16_t*)smem;
    const int tid = tid_opaque(), lane = tid & 63, wave = tid >> 6;
    const int r = lane & 31, hh = lane >> 5;
    const int g = wave & 3, qs = wave >> 2;
    const int head = kvh * 4 + g;
    const int tq = 64 * qb + 32 * qs + r;
    const int tqc = (tq < LP) ? tq : (LP - 1);
    bf16x8 qf[8];
    {
        const bf16_t* qp = p.q_b + ((size_t)b * LP + tqc) * 1024 + head * 128 + 8 * hh;
#pragma unroll
        for (int ks = 0; ks < 8; ++ks) qf[ks] = *(const bf16x8*)(qp + 16 * ks);
    }
    f32x16 O[4];
#pragma unroll
    for (int i = 0; i < 4; ++i)
#pragma unroll
        for (int j = 0; j < 16; ++j) O[i][j] = 0.f;
    float mrun = -3.0e38f, lrun = 0.f;
    const bf16_t* Kg = p.k_b + ((size_t)(b * 2 + kvh) * LPAD) * 128;
    const bf16_t* Vg = p.vt_b + ((size_t)(b * 2 + kvh) * 128) * LPAD;
    const unsigned long long* mcol = p.maskT + (size_t)b * 65 * LPAD + tq;
    const int kc0 = tid, kc1 = tid + 512;
    uint4 sk0, sk1, sv0, sv1;
#define AT_GLOAD(kt_) do { const bf16_t* kg_ = Kg + (size_t)(kt_) * 64 * 128; const bf16_t* vg_ = Vg + (size_t)(kt_) * 64; \
        sk0 = *(const uint4*)(kg_ + (size_t)kc0 * 8); sk1 = *(const uint4*)(kg_ + (size_t)kc1 * 8); \
        sv0 = *(const uint4*)(vg_ + (size_t)(kc0 >> 3) * LPAD + (kc0 & 7) * 8); sv1 = *(const uint4*)(vg_ + (size_t)(kc1 >> 3) * LPAD + (kc1 & 7) * 8); } while (0)
#define AT_SSTORE(buf_) do { bf16_t* q_ = (buf_); \
        *(uint4*)(q_ + AT_K + (kc0 >> 4) * 136 + (kc0 & 15) * 8) = sk0; *(uint4*)(q_ + AT_K + (kc1 >> 4) * 136 + (kc1 & 15) * 8) = sk1; \
        *(uint4*)(q_ + AT_V + (kc0 >> 3) * 72 + (kc0 & 7) * 8) = sv0; *(uint4*)(q_ + AT_V + (kc1 >> 3) * 72 + (kc1 & 7) * 8) = sv1; } while (0)
    AT_GLOAD(0); AT_SSTORE(lds);
    unsigned long long mw_next = mcol[0];
    asm volatile("" :: "v"(qf[0]), "v"(qf[1]), "v"(qf[2]), "v"(qf[3]), "v"(qf[4]), "v"(qf[5]), "v"(qf[6]), "v"(qf[7]), "v"(mw_next));
    lds_barrier();
    for (int kt = 0; kt <= qb; ++kt) {
        unsigned zofs = 0; asm volatile("" : "+v"(zofs));
        bf16_t* cur = lds + (kt & 1) * AT_ELEMS + zofs;
        bf16_t* nxt = lds + ((kt + 1) & 1) * AT_ELEMS + zofs;
        const bool more = kt < qb;
        if (more) { AT_GLOAD(kt + 1); }
        const unsigned long long mw = mw_next;
        if (more) mw_next = mcol[(size_t)(kt + 1) * LPAD];
        f32x16 st[2];
#pragma unroll
        for (int j = 0; j < 16; ++j) { st[0][j] = 0.f; st[1][j] = 0.f; }
#pragma unroll
        for (int ks = 0; ks < 8; ++ks) {
            st[0] = MFMA32(*(const bf16x8*)(cur + AT_K + (r) * 136 + 16 * ks + 8 * hh), qf[ks], st[0]);
            st[1] = MFMA32(*(const bf16x8*)(cur + AT_K + (32 + r) * 136 + 16 * ks + 8 * hh), qf[ks], st[1]);
        }
        float mx = fmaxf(st[0][0], st[1][0]);
#pragma unroll
        for (int reg = 1; reg < 16; reg += 1) mx = fmaxf(mx, fmaxf(st[0][reg], st[1][reg]));
        mx = fmaxf(mx, __shfl_xor(mx, 32));
        const float mnew = (mx > mrun + 8.f) ? mx : mrun;
        if (__any(mnew != mrun)) {
            const float alpha = __builtin_amdgcn_exp2f(mrun - mnew);
            lrun *= alpha;
#pragma unroll
            for (int dt = 0; dt < 4; ++dt) O[dt] = O[dt] * alpha;
            mrun = mnew;
        }
        float psum = 0.f;
#pragma unroll
        for (int kk = 0; kk < 2; ++kk) {
            const int w = (int)((unsigned)(mw >> (32 * kk)) >> (4 * hh));
#pragma unroll
            for (int reg = 0; reg < 16; ++reg) {
                const int bit = (reg & 3) + 8 * (reg >> 2);
                const int keep = __builtin_amdgcn_sbfe(w, bit, 1);
                const float pv = __uint_as_float(__float_as_uint(__builtin_amdgcn_exp2f(st[kk][reg] - mrun)) & (unsigned)keep);
                st[kk][reg] = pv; psum += pv;
            }
        }
        lrun += psum;
        bf16x8 pb[2][2];
#pragma unroll
        for (int kk = 0; kk < 2; ++kk)
#pragma unroll
            for (int s = 0; s < 2; ++s) pb[kk][s] = pack_step(st[kk], s);
#pragma unroll
        for (int dt = 0; dt < 4; ++dt)
#pragma unroll
            for (int kk = 0; kk < 2; ++kk)
#pragma unroll
                for (int s = 0; s < 2; ++s)
                    O[dt] = MFMA32(frag_perm(cur + AT_V + (32 * dt + r) * 72 + 32 * kk + 16 * s + 4 * hh), pb[kk][s], O[dt]);
        if (more) { AT_SSTORE(nxt); }
        lds_barrier();
    }
    const float ltot = lrun + __shfl_xor(lrun, 32);
    const float inv = 1.f / ltot;
    if (tq < LP) {
        bf16_t* op = p.gated + ((size_t)b * LP + tq) * 1024 + head * 128;
#pragma unroll
        for (int dt = 0; dt < 4; ++dt)
#pragma unroll
            for (int g4 = 0; g4 < 4; ++g4) {
                f32x4 v;
#pragma unroll
                for (int e2 = 0; e2 < 4; ++e2) v[e2] = O[dt][4 * g4 + e2] * inv;
                st_bf16x4(op + 32 * dt + 8 * g4 + 4 * hh, v);
            }
    }
    lds_barrier();
}

__device__ __forceinline__ void attn_phase(const Params& p, char* smem, int bid, int nb, int rep = 0) {
    int* slot = (int*)(smem + LDS_BYTES - 32);
    for (;;) {
        if (threadIdx.x == 0) *slot = (int)atomicAdd(p.bar + 3584 + 16 * rep, 1u);
        lds_barrier();
        const int u = *slot;
        lds_barrier();
        if (u >= 520 + NSR) break;
        if (u < 520) attn_dense_unit(p, smem, (u & 7) >> 1, u & 1, 64 - (u >> 3));
        else attn_sample_query(p, smem, NPR + (u - 520));
    }
}

#define XB_TMO      128
#define XB_XCNT(j)  (256  + 64 * (j))
#define XB_XSUB(j)  (1280 + 64 * (j))
#define XB_XGEN(j)  (2304 + 64 * (j))
#define XB_TOP      3328
#define XB_TOPGEN   3392
#define XCD_BAR_WORDS 3456
#define XB_SPIN_CAP (1u << 18)
#define LAS __attribute__((address_space(3)))

__device__ __forceinline__ unsigned xb_ld(unsigned* p)              { return __hip_atomic_load(p, __ATOMIC_RELAXED, __HIP_MEMORY_SCOPE_AGENT); }
__device__ __forceinline__ unsigned xb_add(unsigned* p, unsigned v) { return __hip_atomic_fetch_add(p, v, __ATOMIC_RELAXED, __HIP_MEMORY_SCOPE_AGENT); }
__device__ __forceinline__ unsigned xb_xcc_id() { return (unsigned)__builtin_amdgcn_s_getreg((3 << 11) | 20) & 0xFu; }
#define XB_SPIN(cond, bar) do { unsigned _sp = 0; while (cond) { __builtin_amdgcn_s_sleep(1); \
    if ((++_sp & 255u) == 0u) { if (xb_ld(&(bar)[XB_TMO])) break; if (_sp > XB_SPIN_CAP) { atomicAdd(&(bar)[XB_TMO], 1u); break; } } } } while (0)

struct XcdBarrier {
    unsigned* bar; unsigned x;
    volatile LAS unsigned* st;
};

__device__ __forceinline__ XcdBarrier xcd_barrier_post(unsigned* bar, volatile LAS unsigned* st) {
    XcdBarrier b; b.bar = bar; b.x = xb_xcc_id(); b.st = st;
    if (threadIdx.x == 0) (void)xb_add(&bar[XB_XCNT(b.x)], 1u);
    return b;
}
__device__ __forceinline__ void xcd_barrier_complete(unsigned* bar, unsigned x, unsigned& nloc, unsigned& nx) {
    const unsigned G = gridDim.x * gridDim.y * gridDim.z;
    unsigned sum, cnt, mine, sp = 0u;
    for (;;) {
        sum = 0u; cnt = 0u; mine = 0u;
#pragma unroll
        for (unsigned j = 0; j < 16; ++j) { const unsigned c = xb_ld(&bar[XB_XCNT(j)]); sum += c; cnt += (c > 0u) ? 1u : 0u; mine = (j == x) ? c : mine; }
        if (sum == G) break;
        __builtin_amdgcn_s_sleep(1);
        if ((++sp & 255u) == 0u) { if (xb_ld(&bar[XB_TMO])) break; if (sp > XB_SPIN_CAP) { atomicAdd(&bar[XB_TMO], 1u); break; } }
    }
    nloc = mine > 0u ? mine : 1u; nx = cnt > 0u ? cnt : 1u;
}

__device__ __forceinline__ void xcd_barrier(const XcdBarrier& b) {
    asm volatile("s_waitcnt vmcnt(0)" ::: "memory");
    __syncthreads();
    if (threadIdx.x == 0) {
        unsigned* bar = b.bar;
        __builtin_amdgcn_s_waitcnt(0);
        unsigned nloc = b.st[0], nx = b.st[1];
        if (nloc == 0u) { xcd_barrier_complete(bar, b.x, nloc, nx); b.st[0] = nloc; b.st[1] = nx; }
        const unsigned old = xb_add(&bar[XB_XSUB(b.x)], 1u);
        const unsigned gen = old / nloc;
        if (old + 1u == (gen + 1u) * nloc) {
            __builtin_amdgcn_fence(__ATOMIC_RELEASE, "agent");
            asm volatile("s_waitcnt vmcnt(0)" ::: "memory");
            const unsigned og = xb_add(&bar[XB_TOP], 1u);
            const unsigned tg = og / nx;
            if (og + 1u == (tg + 1u) * nx) xb_add(&bar[XB_TOPGEN], 1u);
            else XB_SPIN(xb_ld(&bar[XB_TOPGEN]) == tg, bar);
            __builtin_amdgcn_fence(__ATOMIC_ACQUIRE, "agent");
            xb_add(&bar[XB_XGEN(b.x)], 1u);
            asm volatile("s_waitcnt vmcnt(0)" ::: "memory");
        } else {
            XB_SPIN(xb_ld(&bar[XB_XGEN(b.x)]) == gen, bar);
            __builtin_amdgcn_fence(__ATOMIC_ACQUIRE, "agent");
            asm volatile("s_waitcnt vmcnt(0)" ::: "memory");
        }
    }
    __syncthreads();
}


constexpr int NPHASE = 19;
template <int PH>
__device__ __forceinline__ void run_phase(const Params& p, char* smem, int bid, int nb, int rep = 0) {
    constexpr int MT = MPAD / 256;
    if constexpr (PH == 0) phase_prologue(p, smem, bid, nb);
    else if constexpr (PH == 1) gemm_big(p.hA, D, p.wt_gin, GIN_PAD, EpiGdnIn{p.mixed, p.z, p.ba}, smem, bid, nb);
    else if constexpr (PH == 2) gdn_stageA(p, smem, bid, nb);
    else if constexpr (PH == 3) gdn_seq_phase(p, smem, bid, nb, rep);
    else if constexpr (PH == 4) gdn_gate_phase(p, bid, nb);
    else if constexpr (PH == 5) gemm_n1024(p.gated, 2048, p.wt_gout, EpiResid{p.preln, p.hA}, EpiSlab{p.slab}, 8, smem, bid, nb);
    else if constexpr (PH == 6) ln_phase(p.preln, p.ln1_g, p.ln1_b, p.hB, nullptr, nullptr, p.slab, 8, p.hA, bid, nb);
    else if constexpr (PH == 7) gemm_big(p.hB, D, p.wt_w1, DFF, EpiRelu2{p.act}, smem, bid, nb);
    else if constexpr (PH == 8) gemm_n1024(p.act, DFF, p.wt_w2, EpiResid{p.preln, p.hB}, EpiSlab{p.slab}, 16, smem, bid, nb);
    else if constexpr (PH == 9) ln_phase(p.preln, p.ln2_g, p.ln2_b, p.hA, nullptr, nullptr, p.slab, 16, p.hB, bid, nb);
    else if constexpr (PH == 10) gemm_big(p.hA, D, p.wt_din, DIN_PAD, EpiF32{p.p1, DIN_PAD}, smem, bid, nb);
    else if constexpr (PH == 11) dsa_post_phase(p, smem, bid, nb);
    else if constexpr (PH == 12) indexer_phase(p, smem, bid, nb, rep);
    else if constexpr (PH == 13) attn_phase(p, smem, bid, nb, rep);
    else if constexpr (PH == 14) gemm_n1024(p.gated, D, p.wt_do, EpiResid{p.preln, p.hA}, EpiSlab{p.slab}, 4, smem, bid, nb);
    else if constexpr (PH == 15) ln_phase(p.preln, p.ln1_g + D, p.ln1_b + D, p.hB, nullptr, nullptr, p.slab, 4, p.hA, bid, nb);
    else if constexpr (PH == 16) gemm_big(p.hB, D, p.wt_w1 + (size_t)D * DFF, DFF, EpiRelu2{p.act}, smem, bid, nb);
    else if constexpr (PH == 17) gemm_n1024(p.act, DFF, p.wt_w2 + (size_t)D * DFF, EpiResid{p.preln, p.hB}, EpiSlab{p.slab}, 16, smem, bid, nb);
    else if constexpr (PH == 18) ln_phase(p.preln, p.ln2_g + D, p.ln2_b + D, nullptr, p.y_prompt, p.y_sample, p.slab, 16, p.hB, bid, nb);
}

template <int PH>
__global__ void __launch_bounds__(NTHR, 2) k_phase(Params p) {
    extern __shared__ __attribute__((aligned(16))) char smem[];
    run_phase<PH>(p, smem, blockIdx.x, gridDim.x);
}

template <int PH>
__device__ __forceinline__ void mega_run(const Params& p, char* smem, const XcdBarrier& bar) {
    run_phase<PH>(p, smem, blockIdx.x, gridDim.x);
#ifdef PROBE_MASK
    if constexpr ((PROBE_MASK >> PH) & 1) { xcd_barrier(bar); run_phase<PH>(p, smem, blockIdx.x, gridDim.x, 1); }
#endif
    if constexpr (PH + 1 < NPHASE) {
        xcd_barrier(bar);
        mega_run<PH + 1>(p, smem, bar);
    }
}
__global__ void __launch_bounds__(NTHR, 2) k_mega(Params p) {
    extern __shared__ __attribute__((aligned(16))) char smem[];
    volatile LAS unsigned* st = (volatile LAS unsigned*)(smem + LDS_BYTES - 16);
    if (threadIdx.x == 0) { st[0] = 0u; st[1] = 0u; st[2] = 0u; st[3] = 0u; }
    __syncthreads();
    XcdBarrier bar = xcd_barrier_post(p.bar, st);
    mega_run<0>(p, smem, bar);
}

template <int PH>
void launch_phase(const Params& p, hipStream_t stream) {
    static bool attr_done = false;
    if (!attr_done) {
        (void)hipFuncSetAttribute((const void*)k_phase<PH>, hipFuncAttributeMaxDynamicSharedMemorySize, LDS_BYTES);
        attr_done = true;
    }
    hipLaunchKernelGGL(k_phase<PH>, dim3(256), dim3(NTHR), LDS_BYTES, stream, p);
}
template <int PH>
void launch_all(const Params& p, hipStream_t stream) {
    launch_phase<PH>(p, stream);
    if constexpr (PH + 1 < NPHASE) launch_all<PH + 1>(p, stream);
}

}

extern "C" void kernel_launch(void* const* d_in, const int* in_sizes, int n_in, void* d_out, int out_size, void* d_ws, size_t ws_size,
                              hipStream_t stream) {
    Params p{};
    p.x_prompt = (const float*)d_in[0]; p.x_sample = (const float*)d_in[1]; p.state_gdn = (const float*)d_in[2];
    p.state_conv = (const float*)d_in[3]; p.cache_k = (const float*)d_in[4]; p.cache_v = (const float*)d_in[5];
    p.cache_ik = (const float*)d_in[6]; p.page_table = (const int*)d_in[7]; p.meta = (const float*)d_in[8];
    p.ln1_g = (const float*)d_in[9]; p.ln1_b = (const float*)d_in[10]; p.ln2_g = (const float*)d_in[11]; p.ln2_b = (const float*)d_in[12];
    p.mlp_w1 = (const float*)d_in[13]; p.mlp_w2 = (const float*)d_in[14]; p.gdn_w_in = (const float*)d_in[15];
    p.gdn_conv_w = (const float*)d_in[16]; p.gdn_a_log = (const float*)d_in[17]; p.gdn_dt_bias = (const float*)d_in[18];
    p.gdn_norm_w = (const float*)d_in[19]; p.gdn_w_out = (const float*)d_in[20]; p.dsa_w_in = (const float*)d_in[21];
    p.dsa_ik_g = (const float*)d_in[22]; p.dsa_ik_b = (const float*)d_in[23]; p.dsa_w_o = (const float*)d_in[24];
    float* o = (float*)d_out;
    p.y_prompt = o; o += (size_t)BATCH * SEQ * D;
    p.y_sample = o; o += (size_t)NSR * D;
    p.gs_prompt = o; o += (size_t)BATCH * 16 * 128 * 128;
    p.gc_prompt = o; o += (size_t)BATCH * 3 * 4096;
    p.gs_sample = o; o += (size_t)DB * 16 * 128 * 128;
    p.gc_sample = o; o += (size_t)DB * 3 * 4096;
    p.k_prompt = o; o += (size_t)NPR * 256;
    p.v_prompt = o; o += (size_t)NPR * 256;
    p.ik_prompt = o; o += (size_t)NPR * 64;
    p.k_sample = o; o += (size_t)NSR * 256;
    p.v_sample = o; o += (size_t)NSR * 256;
    p.ik_sample = o; o += (size_t)NSR * 64;
    char* w = (char*)d_ws;
    auto take = [&](size_t bytes) { char* r = w; w += (bytes + 255) & ~(size_t)255; return r; };
    p.bar = (unsigned*)take(16384);
    p.wt_gin = (bf16_t*)take((size_t)GIN_PAD * D * 2);
    p.wt_gout = (bf16_t*)take((size_t)D * 2048 * 2);
    p.wt_w1 = (bf16_t*)take((size_t)2 * D * DFF * 2);
    p.wt_w2 = (bf16_t*)take((size_t)2 * D * DFF * 2);
    p.wt_din = (bf16_t*)take((size_t)DIN_PAD * D * 2);
    p.wt_do = (bf16_t*)take((size_t)D * D * 2);
    p.hA = (bf16_t*)take((size_t)MPAD * D * 2);
    p.hB = (bf16_t*)take((size_t)MPAD * D * 2);
    p.preln = (float*)take((size_t)MPAD * D * 4);
    p.mixed = (bf16_t*)take((size_t)MPAD * 4096 * 2);
    p.z = (bf16_t*)take((size_t)MPAD * 2048 * 2);
    p.ba = (float*)take((size_t)MPAD * 32 * 4);
    p.gated = (bf16_t*)take((size_t)MPAD * 2048 * 2);
    p.act = (bf16_t*)take((size_t)MPAD * DFF * 2);
    p.p1 = (float*)take((size_t)MPAD * DIN_PAD * 4);
    p.qr = (float*)take((size_t)MPAD * 1024 * 4);
    p.iq = (float*)take((size_t)MPAD * 512 * 4);
    p.iw = (float*)take((size_t)MPAD * 8 * 4);
    p.sel = (int*)take((size_t)MPAD * 256 * 4);
    p.g_o = (bf16_t*)take((size_t)NPR * 2048 * 2);
    p.rope_tab = (float*)take((size_t)LP * 24 * 2 * 4);
    p.slab = (float*)take((size_t)16 * 768 * 1024 * 4);
    p.q_b = (bf16_t*)take((size_t)NPR * 1024 * 2);
    p.k_b = (bf16_t*)take((size_t)BATCH * 2 * LPAD * 128 * 2);
    p.vt_b = (bf16_t*)take((size_t)BATCH * 2 * 128 * LPAD * 2);
    p.iq_b = (bf16_t*)take((size_t)NPR * 512 * 2);
    p.ik_b = (bf16_t*)take((size_t)BATCH * LPAD * 64 * 2);
    p.maskT = (unsigned long long*)take((size_t)BATCH * 65 * LPAD * 8);
    p.g_dec = (float*)take((size_t)NCU * 4);
    p.g_u = (float*)p.act;
    p.g_negw = (bf16_t*)p.p1;
    p.g_qg = p.g_negw + (size_t)NCU * 8192;
    p.g_kdT = (bf16_t*)p.qr;
    p.g_aqk = (bf16_t*)p.iq;
    if ((size_t)(w - (char*)d_ws) > ws_size) { fprintf(stderr, "kernel_launch: workspace too small (%zu needed, %zu given)\n", (size_t)(w - (char*)d_ws), ws_size); return; }
#if MEGA
    static int grid = 0;
    if (grid == 0) {
        int dev = 0, cus = 0;
        if (hipGetDevice(&dev) != hipSuccess || hipDeviceGetAttribute(&cus, hipDeviceAttributeMultiprocessorCount, dev) != hipSuccess || cus <= 0) cus = 256;
        (void)hipFuncSetAttribute((const void*)k_mega, hipFuncAttributeMaxDynamicSharedMemorySize, LDS_BYTES);
        grid = cus;
    }
    (void)hipMemsetAsync(p.bar, 0, 16384, stream);
    hipLaunchKernelGGL(k_mega, dim3(grid), dim3(NTHR), LDS_BYTES, stream, p);
#else
    launch_all<0>(p, stream);
#endif
}
```

```cpp
#include <hip/hip_runtime.h>
#include <stdint.h>
#include <stdio.h>

#ifndef MEGA
#define MEGA 1
#endif

namespace {

typedef unsigned short bf16_t;
typedef short bf16x8 __attribute__((ext_vector_type(8)));
typedef float f32x4 __attribute__((ext_vector_type(4)));

constexpr int D = 1024, BATCH = 4, SEQ = 4096, NMETA = 16, LP = SEQ + NMETA;
constexpr int DB = 128, DS = 4, PAST = 2048;
constexpr int NPR = BATCH * LP;
constexpr int NSR = DB * DS;
constexpr int NT = NPR + NSR;
constexpr int MPAD = 17152;
constexpr int DFF = 4096;
constexpr int GIN = 6176, GIN_PAD = 6400;
constexpr int DIN = 2120, DIN_PAD = 2304;
constexpr int NTHR = 512;
constexpr int LPAD = 4160;
constexpr int LDS_BYTES = 150 * 1024;
constexpr float ALPHA = 1.4142135623730951f;

struct Params {
    const float *x_prompt, *x_sample, *state_gdn, *state_conv, *cache_k, *cache_v, *cache_ik;
    const int* page_table;
    const float *meta, *ln1_g, *ln1_b, *ln2_g, *ln2_b, *mlp_w1, *mlp_w2, *gdn_w_in, *gdn_conv_w, *gdn_a_log, *gdn_dt_bias,
        *gdn_norm_w, *gdn_w_out, *dsa_w_in, *dsa_ik_g, *dsa_ik_b, *dsa_w_o;
    float *y_prompt, *y_sample, *gs_prompt, *gc_prompt, *gs_sample, *gc_sample, *k_prompt, *v_prompt, *ik_prompt, *k_sample,
        *v_sample, *ik_sample;
    unsigned* bar;
    bf16_t *wt_gin, *wt_gout, *wt_w1, *wt_w2, *wt_din, *wt_do;
    bf16_t *hA, *hB;
    float* preln;
    bf16_t *mixed, *z;
    float* ba;
    bf16_t *gated, *act;
    float *p1, *qr, *iq, *iw;
    int* sel;
    bf16_t *g_negw, *g_qg, *g_kdT, *g_aqk;
    float *g_u, *g_dec;
    bf16_t* g_o;
    float* rope_tab;
    float* slab;
    bf16_t *q_b, *k_b, *vt_b, *iq_b, *ik_b;
    unsigned long long* maskT;
};

__device__ const double kInvFreq[16] = {1.0, 0.44036660267178046, 0.19392274474868576, 0.08539710028576561,
    0.03760603093086393, 0.016560440080994446, 0.007292664737217109, 0.003211445994752591, 0.001414213562373095,
    0.000622772421914596, 0.0002742481756762073, 0.00012076973741146504, 5.318295896944988e-05, 2.341999896140934e-05,
    1.031338537721246e-05, 4.5416704806078695e-06};

__device__ __forceinline__ float bf2f(bf16_t h) { return __uint_as_float(((unsigned)h) << 16); }
typedef __bf16 hwbf16x2 __attribute__((ext_vector_type(2)));
typedef float f32x2 __attribute__((ext_vector_type(2)));
typedef float f32x16 __attribute__((ext_vector_type(16)));
typedef unsigned u32x4 __attribute__((ext_vector_type(4)));
__device__ __forceinline__ unsigned pk2(float lo, float hi) {
    const f32x2 v = {lo, hi};
    return __builtin_bit_cast(unsigned, __builtin_convertvector(v, hwbf16x2));
}
__device__ __forceinline__ bf16_t f2bf(float f) { return (bf16_t)(pk2(f, 0.f) & 0xffffu); }
__device__ __forceinline__ void st_bf16x4(bf16_t* p, f32x4 v) {
    uint2 o; o.x = pk2(v[0], v[1]); o.y = pk2(v[2], v[3]);
    *(uint2*)p = o;
}
__device__ __forceinline__ f32x4 cvt_bf16x4(uint2 o) {
    f32x4 v; v[0] = __uint_as_float(o.x << 16); v[1] = __uint_as_float(o.x & 0xffff0000u);
    v[2] = __uint_as_float(o.y << 16); v[3] = __uint_as_float(o.y & 0xffff0000u);
    return v;
}
__device__ __forceinline__ f32x4 ld_bf16x4(const bf16_t* p) {
    uint2 o = *(const uint2*)p;
    f32x4 v; v[0] = __uint_as_float(o.x << 16); v[1] = __uint_as_float(o.x & 0xffff0000u);
    v[2] = __uint_as_float(o.y << 16); v[3] = __uint_as_float(o.y & 0xffff0000u);
    return v;
}
__device__ __forceinline__ float wave_sum(float v) {
#pragma unroll
    for (int o = 1; o < 64; o <<= 1) v += __shfl_xor(v, o);
    return v;
}
__device__ __forceinline__ float wave_max(float v) {
#pragma unroll
    for (int o = 1; o < 64; o <<= 1) v = fmaxf(v, __shfl_xor(v, o));
    return v;
}
__device__ __forceinline__ int wave_sum_i(int v) {
#pragma unroll
    for (int o = 1; o < 64; o <<= 1) v += __shfl_xor(v, o);
    return v;
}
__device__ __forceinline__ float silu(float x) { return x * __builtin_amdgcn_rcpf(1.f + __expf(-x)); }
__device__ __forceinline__ int tid_opaque() { int t = threadIdx.x; asm volatile("" : "+v"(t)); return t; }
__device__ __forceinline__ void lds_barrier() { asm volatile("s_waitcnt lgkmcnt(0)\n\ts_barrier" ::: "memory"); }
__device__ __forceinline__ void lds_fence() { asm volatile("s_waitcnt lgkmcnt(0)" ::: "memory"); }

__device__ __forceinline__ void transpose_convert(const float* __restrict__ W, int K, int N, int Npad, bf16_t* __restrict__ WT, float* tile,
                                  int bid, int nb) {
    const int tid = tid_opaque();
    const int tk = K / 64, tn = Npad / 64;
    for (int it = bid; it < tk * tn; it += nb) {
        const int kb = it / tn, nbk = it % tn, k0 = kb * 64, n0 = nbk * 64;
#pragma unroll
        for (int i = 0; i < 8; ++i) {
            const int r = (tid >> 6) + 8 * i, c = tid & 63, n = n0 + c;
            tile[r * 65 + c] = (n < N) ? W[(size_t)(k0 + r) * N + n] : 0.f;
        }
        __syncthreads();
        {
            const int rn = tid >> 3, c8 = (tid & 7) * 8;
            const float* tp = tile + c8 * 65 + rn;
            uint4 o;
            o.x = pk2(tp[0], tp[65]); o.y = pk2(tp[2 * 65], tp[3 * 65]); o.z = pk2(tp[4 * 65], tp[5 * 65]); o.w = pk2(tp[6 * 65], tp[7 * 65]);
            *(uint4*)(WT + (size_t)(n0 + rn) * K + k0 + c8) = o;
        }
        __syncthreads();
    }
}

__device__ __forceinline__ void phase_prologue(const Params& p, char* smem, int bid, int nb) {
    float* tile = (float*)smem;
    transpose_convert(p.gdn_w_in, D, GIN, GIN_PAD, p.wt_gin, tile, bid, nb);
    for (int idx = bid * NTHR + tid_opaque(); idx < LP * 24; idx += nb * NTHR) {
        const int pos = idx / 24, f = idx % 24;
        const int fi = (f < 16) ? f : (f - 16) * 2;
        const double rev = (double)pos * kInvFreq[fi] * 0.15915494309189535;
        const float r = (float)(rev - floor(rev));
        p.rope_tab[idx * 2] = __builtin_amdgcn_cosf(r);
        p.rope_tab[idx * 2 + 1] = __builtin_amdgcn_sinf(r);
    }
    for (int idx = bid * NTHR + tid_opaque(); idx < MPAD * 256; idx += nb * NTHR) {
        const int row = idx >> 8, c4 = (idx & 255) * 4;
        f32x4 v = {0.f, 0.f, 0.f, 0.f};
        if (row < NPR) {
            const int b = row / LP, t = row % LP;
            const float* src = (t < NMETA) ? (p.meta + (size_t)t * D) : (p.x_prompt + ((size_t)b * SEQ + (t - NMETA)) * D);
            v = *(const f32x4*)(src + c4);
        } else if (row < NT) {
            v = *(const f32x4*)(p.x_sample + (size_t)(row - NPR) * D + c4);
        }
        st_bf16x4(p.hA + (size_t)row * D + c4, v);
    }
}

template <class Epi>
__device__ __forceinline__ void gemm_phase(const bf16_t* __restrict__ A, int lda, const bf16_t* __restrict__ Bt, int K, int Mtiles, int Ntiles,
                           const Epi& epi, char* smem, int bid, int nb) {
    bf16_t* As = (bf16_t*)smem;
    bf16_t* Bs = As + 256 * 72;
    const int tid = tid_opaque(), lane = tid & 63, wave = tid >> 6;
    const int wm = wave >> 1, wn = wave & 1;
    const int fr = lane & 15, fq = lane >> 4;
    const int ntiles = Mtiles * Ntiles;
    const int nk = K / 64;
    for (int tile = bid; tile < ntiles; tile += nb) {
        const int tm = tile % Mtiles, tn = tile / Mtiles;
        const bf16_t* Ag = A + (size_t)tm * 256 * lda;
        const bf16_t* Bg = Bt + (size_t)tn * 128 * K;
        f32x4 acc[4][4];
#pragma unroll
        for (int i = 0; i < 4; ++i)
#pragma unroll
            for (int j = 0; j < 4; ++j) acc[i][j] = (f32x4){0.f, 0.f, 0.f, 0.f};
        const int c0 = tid, c1 = tid + 512, c2 = tid + 1024, c3 = tid + 1536;
        const bf16_t* ga0 = Ag + (size_t)(c0 >> 3) * lda + (c0 & 7) * 8;
        const bf16_t* ga1 = Ag + (size_t)(c1 >> 3) * lda + (c1 & 7) * 8;
        const bf16_t* ga2 = Ag + (size_t)(c2 >> 3) * lda + (c2 & 7) * 8;
        const bf16_t* ga3 = Ag + (size_t)(c3 >> 3) * lda + (c3 & 7) * 8;
        const bf16_t* gb0 = Bg + (size_t)(c0 >> 3) * K + (c0 & 7) * 8;
        const bf16_t* gb1 = Bg + (size_t)(c1 >> 3) * K + (c1 & 7) * 8;
        bf16_t* sa0 = As + (c0 >> 3) * 72 + (c0 & 7) * 8;
        bf16_t* sa1 = As + (c1 >> 3) * 72 + (c1 & 7) * 8;
        bf16_t* sa2 = As + (c2 >> 3) * 72 + (c2 & 7) * 8;
        bf16_t* sa3 = As + (c3 >> 3) * 72 + (c3 & 7) * 8;
        bf16_t* sb0 = Bs + (c0 >> 3) * 72 + (c0 & 7) * 8;
        bf16_t* sb1 = Bs + (c1 >> 3) * 72 + (c1 & 7) * 8;
        uint4 ra0 = *(const uint4*)ga0, ra1 = *(const uint4*)ga1, ra2 = *(const uint4*)ga2, ra3 = *(const uint4*)ga3;
        uint4 rb0 = *(const uint4*)gb0, rb1 = *(const uint4*)gb1;
        *(uint4*)sa0 = ra0; *(uint4*)sa1 = ra1; *(uint4*)sa2 = ra2; *(uint4*)sa3 = ra3; *(uint4*)sb0 = rb0; *(uint4*)sb1 = rb1;
        __syncthreads();
        for (int kt = 0; kt < nk; ++kt) {
            const bool more = (kt + 1 < nk);
            if (more) {
                const int k0 = (kt + 1) * 64;
                ra0 = *(const uint4*)(ga0 + k0); ra1 = *(const uint4*)(ga1 + k0); ra2 = *(const uint4*)(ga2 + k0); ra3 = *(const uint4*)(ga3 + k0);
                rb0 = *(const uint4*)(gb0 + k0); rb1 = *(const uint4*)(gb1 + k0);
            }
#pragma unroll
            for (int kk = 0; kk < 2; ++kk) {
                bf16x8 af[4], bfr[4];
#pragma unroll
                for (int i = 0; i < 4; ++i) af[i] = *(const bf16x8*)(As + (wm * 64 + i * 16 + fr) * 72 + kk * 32 + fq * 8);
#pragma unroll
                for (int j = 0; j < 4; ++j) bfr[j] = *(const bf16x8*)(Bs + (wn * 64 + j * 16 + fr) * 72 + kk * 32 + fq * 8);
#pragma unroll
                for (int i = 0; i < 4; ++i)
#pragma unroll
                    for (int j = 0; j < 4; ++j) acc[i][j] = __builtin_amdgcn_mfma_f32_16x16x32_bf16(bfr[j], af[i], acc[i][j], 0, 0, 0);
            }
            __syncthreads();
            if (more) {
                *(uint4*)sa0 = ra0; *(uint4*)sa1 = ra1; *(uint4*)sa2 = ra2; *(uint4*)sa3 = ra3; *(uint4*)sb0 = rb0; *(uint4*)sb1 = rb1;
                __syncthreads();
            }
        }
#pragma unroll
        for (int i = 0; i < 4; ++i)
#pragma unroll
            for (int j = 0; j < 4; ++j) {
                const int row = tm * 256 + wm * 64 + i * 16 + fr, col = tn * 128 + wn * 64 + j * 16 + fq * 4;
                epi(row, col, acc[i][j]);
            }
    }
}

namespace pg8 {
#define PG8_LAS __attribute__((address_space(3)))
constexpr int BM = 256, BK = 64, HALF = 128, HTB = HALF * BK * 2  , STAGE_BYTES = 8 * HTB, NXCD = 8, WGM = 16;
__device__ __forceinline__ int lds_byte(int r, int c) { const int st = (r >> 4) * 2 + (c >> 5), rr = r & 15, cc = c & 31, ob = rr * 64 + cc * 2; return st * 1024 + (ob ^ (((ob >> 9) & 1) << 5)); }
__device__ __forceinline__ void stage_rc(int b, int& R, int& C) { const int st = b / 1024, sb = b % 1024, swz = sb ^ (((sb >> 9) & 1) << 5); R = (st >> 1) * 16 + swz / 64; C = (st & 1) * 32 + (swz % 64) / 2; }
__device__ __forceinline__ int perm32(int rho) { const int n = rho >> 4, i = rho & 15; return 8 * (i >> 2) + 4 * n + (i & 3); }
struct Unit { int pm, pn, pk; };
struct Gemm { const bf16_t* A; const bf16_t* Bt; int K; int splits; };
struct StaticOrder {
    int nM, nN, nNr, pm0, nwg, G, c;
    __device__ void init(int nM_, int nNr_, int splits, int pm0_, int G_, int c_) { nM = nM_; nNr = nNr_; nN = nNr_ * splits; pm0 = pm0_; nwg = nM * nN; G = G_; c = c_; }
    __device__ bool next(int i, Unit& u) const {
        const long L = (long)i * G + c; if (L >= nwg) return false;
        int wgid = (int)L; { const int q = nwg / NXCD, r = nwg % NXCD, xcd = wgid % NXCD, off = wgid / NXCD; wgid = (xcd < r ? xcd * (q + 1) : r * (q + 1) + (xcd - r) * q) + off; }
        const int nig = WGM * nN, gid = wgid / nig, fm = gid * WGM, gsz = (nM - fm) < WGM ? (nM - fm) : WGM;
        const int pnv = (wgid % nig) / gsz;
        u.pm = pm0 + fm + ((wgid % nig) % gsz); u.pn = pnv % nNr; u.pk = pnv / nNr; return true;
    }
};
template <class Epi>
__device__ __forceinline__ void gemm_phase(PG8_LAS unsigned char* lds, const Gemm g, const StaticOrder& S, const Epi& E) {
    const int tid = tid_opaque(), wid = __builtin_amdgcn_readfirstlane(tid >> 6), lane = tid & 63, wr = wid >> 2, wc = wid & 3, fr = lane & 15, fq = lane >> 4;
    const int K = g.K, Kp = K / g.splits, nt = Kp / BK;
    unsigned voffA[2], voffB[2];
#pragma unroll
    for (int i = 0; i < 2; ++i) { int R, C; stage_rc(tid * 16 + i * 8192, R, C); const int Rb = (R & ~31) + perm32(R & 31);
        voffA[i] = (unsigned)(R * K + C) * 2u; voffB[i] = (unsigned)(Rb * K + C) * 2u; }
    const size_t kstep = (size_t)(BK * 2);
    const size_t hstep = (size_t)HALF * K * 2;
    const size_t tstep = 2 * hstep;
    const size_t pstep = (size_t)Kp * 2;
    const unsigned ldsw = (unsigned)wid * 1024u;
    const int aoff = lds_byte(wr * 64 + fr, fq * 8), boff = lds_byte(wc * 32 + fr, fq * 8);
#define PG8_SA(b, h) (((b) * 2 + (h)) * HTB)
#define PG8_SB(b, h) ((4 + (b) * 2 + (h)) * HTB)
#define PG8_STAGE(bufoff, gbase, voff) do { _Pragma("unroll") for (int _i = 0; _i < 2; ++_i) \
        __builtin_amdgcn_global_load_lds((const unsigned*)((const char*)(gbase) + (voff)[_i]), (PG8_LAS unsigned*)(lds + (bufoff) + ldsw + _i * 8192), 16, 0, 0); } while (0)
#define PG8_LDA(dst, b, h) do { _Pragma("unroll") for (int m = 0; m < 4; ++m) _Pragma("unroll") for (int k = 0; k < 2; ++k) dst[m][k] = *(const PG8_LAS bf16x8*)(lds + PG8_SA(b, h) + aoff + m * 2048 + k * 1024); } while (0)
#define PG8_LDB(dst, b, h) do { _Pragma("unroll") for (int n = 0; n < 2; ++n) _Pragma("unroll") for (int k = 0; k < 2; ++k) dst[n][k] = *(const PG8_LAS bf16x8*)(lds + PG8_SB(b, h) + boff + n * 2048 + k * 1024); } while (0)
#define PG8_MMA(ai, bj, At, Bt) do { __builtin_amdgcn_s_setprio(1); _Pragma("unroll") for (int m = 0; m < 4; ++m) _Pragma("unroll") for (int n = 0; n < 2; ++n) _Pragma("unroll") for (int k = 0; k < 2; ++k) \
        acc[ai][bj][m][n] = __builtin_amdgcn_mfma_f32_16x16x32_bf16(Bt[n][k], At[m][k], acc[ai][bj][m][n], 0, 0, 0); __builtin_amdgcn_s_setprio(0); } while (0)
#define PG8_WAIT_V(n) asm volatile("s_waitcnt vmcnt(" #n ")" ::: "memory")
#define PG8_WAIT_L(n) asm volatile("s_waitcnt lgkmcnt(" #n ")" ::: "memory")
#define PG8_BAR __builtin_amdgcn_s_barrier()
#define PG8_SCHED __builtin_amdgcn_sched_barrier(0)
    Unit cur, nxt; int ui = 0;
    if (!S.next(0, cur)) return;
    f32x4 acc[2][2][4][2];
#pragma unroll
    for (int a = 0; a < 2; ++a)
#pragma unroll
        for (int b = 0; b < 2; ++b)
#pragma unroll
            for (int m = 0; m < 4; ++m)
#pragma unroll
                for (int n = 0; n < 2; ++n) acc[a][b][m][n] = (f32x4){0.f, 0.f, 0.f, 0.f};
    bf16x8 At[4][2], B0[2][2], B1[2][2];
    const char* cA = (const char*)g.A + (size_t)cur.pm * tstep + (size_t)cur.pk * pstep; const char* cB = (const char*)g.Bt + (size_t)cur.pn * tstep + (size_t)cur.pk * pstep;
    PG8_STAGE(PG8_SB(0, 0), cB, voffB); PG8_STAGE(PG8_SA(0, 0), cA, voffA); PG8_STAGE(PG8_SB(0, 1), cB + hstep, voffB); PG8_STAGE(PG8_SA(0, 1), cA + hstep, voffA);
    if (wr == 1) PG8_BAR;
    PG8_WAIT_V(4); PG8_BAR;
    PG8_STAGE(PG8_SB(1, 0), cB + kstep, voffB); PG8_STAGE(PG8_SA(1, 0), cA + kstep, voffA); PG8_STAGE(PG8_SB(1, 1), cB + hstep + kstep, voffB);
    PG8_WAIT_V(6); PG8_BAR;
    for (;;) {
        const bool has_next = S.next(ui + 1, nxt);
        const char* nA = has_next ? (const char*)g.A + (size_t)nxt.pm * tstep + (size_t)nxt.pk * pstep : cA; const char* nB = has_next ? (const char*)g.Bt + (size_t)nxt.pn * tstep + (size_t)nxt.pk * pstep : cB;
        for (int t = 0; t < nt; t += 2) {
            const bool last = (t == nt - 2);
            const char* a1 = cA + (size_t)(t + 1) * kstep;
            const char* a2 = last ? nA : cA + (size_t)(t + 2) * kstep; const char* b2 = last ? nB : cB + (size_t)(t + 2) * kstep;
            const char* a3 = a2 + kstep; const char* b3 = b2 + kstep;
            PG8_LDB(B0, 0, 0); PG8_SCHED; PG8_LDA(At, 0, 0); PG8_STAGE(PG8_SA(1, 1), a1 + hstep, voffA);
            PG8_WAIT_L(8); PG8_BAR; PG8_WAIT_L(0); PG8_MMA(0, 0, At, B0); PG8_BAR; PG8_SCHED;
            PG8_LDB(B1, 0, 1); PG8_STAGE(PG8_SB(0, 0), b2, voffB);
            PG8_BAR; PG8_WAIT_L(0); PG8_MMA(0, 1, At, B1); PG8_BAR;
            PG8_LDA(At, 0, 1); PG8_STAGE(PG8_SA(0, 0), a2, voffA);
            PG8_BAR; PG8_WAIT_L(0); PG8_MMA(1, 0, At, B0); PG8_BAR; PG8_SCHED;
            PG8_STAGE(PG8_SB(0, 1), b2 + hstep, voffB);
            PG8_WAIT_V(6); PG8_BAR; PG8_MMA(1, 1, At, B1); PG8_BAR;
            PG8_LDB(B0, 1, 0); PG8_SCHED; PG8_LDA(At, 1, 0); PG8_STAGE(PG8_SA(0, 1), a2 + hstep, voffA);
            PG8_WAIT_L(8); PG8_BAR; PG8_WAIT_L(0); PG8_MMA(0, 0, At, B0); PG8_BAR; PG8_SCHED;
            PG8_LDB(B1, 1, 1); PG8_STAGE(PG8_SB(1, 0), b3, voffB);
            PG8_BAR; PG8_WAIT_L(0); PG8_MMA(0, 1, At, B1); PG8_BAR;
            PG8_LDA(At, 1, 1); PG8_STAGE(PG8_SA(1, 0), a3, voffA);
            PG8_BAR; PG8_WAIT_L(0); PG8_MMA(1, 0, At, B0); PG8_BAR; PG8_SCHED;
            PG8_STAGE(PG8_SB(1, 1), b3 + hstep, voffB);
            PG8_WAIT_V(6); PG8_BAR; PG8_MMA(1, 1, At, B1); PG8_BAR;
        }
#pragma unroll
        for (int ai = 0; ai < 2; ++ai)
#pragma unroll
            for (int m = 0; m < 4; ++m)
#pragma unroll
                for (int bj = 0; bj < 2; ++bj)
                    E(cur.pm * BM + ai * HALF + wr * 64 + m * 16 + fr, cur.pn * BM + bj * HALF + wc * 32 + 8 * fq, acc[ai][bj][m][0], acc[ai][bj][m][1], cur.pk);
        if (!has_next) break;
#pragma unroll
        for (int a = 0; a < 2; ++a)
#pragma unroll
            for (int b = 0; b < 2; ++b)
#pragma unroll
                for (int m = 0; m < 4; ++m)
#pragma unroll
                    for (int n = 0; n < 2; ++n) acc[a][b][m][n] = (f32x4){0.f, 0.f, 0.f, 0.f};
        cur = nxt; cA = nA; cB = nB; ++ui;
    }
    PG8_WAIT_V(0);
    if (wr == 0) PG8_BAR;
    PG8_BAR;
#undef PG8_SA
#undef PG8_SB
#undef PG8_STAGE
#undef PG8_LDA
#undef PG8_LDB
#undef PG8_MMA
#undef PG8_WAIT_V
#undef PG8_WAIT_L
#undef PG8_BAR
#undef PG8_SCHED
}
}

template <class Epi>
__device__ __forceinline__ void gemm_big(const bf16_t* A, int K, const bf16_t* Bt, int Npad, const Epi& e, char* smem, int bid, int nb) {
    pg8::StaticOrder S; S.init(MPAD / 256, Npad / 256, 1, 0, nb, bid);
    pg8::gemm_phase((PG8_LAS unsigned char*)smem, pg8::Gemm{A, Bt, K, 1}, S, e);
}
template <class Epi1, class Epi2>
__device__ __forceinline__ void gemm_n1024(const bf16_t* A, int K, const bf16_t* Bt, const Epi1& e1, const Epi2& e2, int splits, char* smem, int bid, int nb) {
    pg8::StaticOrder S; S.init(64, 4, 1, 0, nb, bid);
    pg8::gemm_phase((PG8_LAS unsigned char*)smem, pg8::Gemm{A, Bt, K, 1}, S, e1);
    pg8::StaticOrder S2; S2.init(3, 4, splits, 64, nb, bid);
    pg8::gemm_phase((PG8_LAS unsigned char*)smem, pg8::Gemm{A, Bt, K, splits}, S2, e2);
}

__device__ __forceinline__ void st_bf16x8(bf16_t* p, f32x4 a, f32x4 b) {
    u32x4 w; w[0] = pk2(a[0], a[1]); w[1] = pk2(a[2], a[3]); w[2] = pk2(b[0], b[1]); w[3] = pk2(b[2], b[3]);
    *(u32x4*)p = w;
}
struct EpiGdnIn {
    bf16_t *mixed, *z; float* ba;
    __device__ __forceinline__ void operator()(int row, int col, f32x4 v0, f32x4 v1, int = 0) const {
        if (col < 4096) st_bf16x8(mixed + (size_t)row * 4096 + col, v0, v1);
        else if (col < 6144) st_bf16x8(z + (size_t)row * 2048 + (col - 4096), v0, v1);
        else if (col < 6176) { *(f32x4*)(ba + (size_t)row * 32 + (col - 6144)) = v0; *(f32x4*)(ba + (size_t)row * 32 + (col - 6144) + 4) = v1; }
    }
};
struct EpiResid {
    float* out; const bf16_t* h;
    __device__ __forceinline__ void operator()(int row, int col, f32x4 v0, f32x4 v1, int = 0) const {
        const uint4 hr = *(const uint4*)(h + (size_t)row * D + col);
        const f32x4 r0 = cvt_bf16x4(make_uint2(hr.x, hr.y)), r1 = cvt_bf16x4(make_uint2(hr.z, hr.w));
        st_bf16x8((bf16_t*)out + (size_t)row * D + col, v0 + r0 * ALPHA, v1 + r1 * ALPHA);
    }
};
struct EpiSlab {
    float* slab;
    __device__ __forceinline__ void operator()(int row, int col, f32x4 v0, f32x4 v1, int pk) const {
        float* o = slab + ((size_t)pk * 768 + (row - 16384)) * D + col;
        *(f32x4*)o = v0; *(f32x4*)(o + 4) = v1;
    }
};
struct EpiRelu2 {
    bf16_t* act;
    __device__ __forceinline__ void operator()(int row, int col, f32x4 v0, f32x4 v1, int = 0) const {
#pragma unroll
        for (int e = 0; e < 4; ++e) { const float r = fmaxf(v0[e], 0.f); v0[e] = r * r; const float q = fmaxf(v1[e], 0.f); v1[e] = q * q; }
        st_bf16x8(act + (size_t)row * DFF + col, v0, v1);
    }
};
struct EpiBf16 {
    bf16_t* out; int ld;
    __device__ __forceinline__ void operator()(int row, int col, f32x4 v0, f32x4 v1, int = 0) const { st_bf16x8(out + (size_t)row * ld + col, v0, v1); }
};

__device__ __forceinline__ void ln_phase(const float* X, const float* __restrict__ g, const float* __restrict__ bta, bf16_t* Hout,
                         float* yp, float* ys, const float* slab, int splits, const bf16_t* hres, int bid, int nb) {
    const int tid_ = tid_opaque(); const int lane = tid_ & 63, wave = tid_ >> 6;
    f32x4 gv[4], bv[4];
#pragma unroll
    for (int j = 0; j < 4; ++j) { gv[j] = *(const f32x4*)(g + j * 256 + lane * 4); bv[j] = *(const f32x4*)(bta + j * 256 + lane * 4); }
    for (int row = bid * 8 + wave; row < NT; row += nb * 8) {
        f32x4 v[4]; float s = 0.f;
        if (row < 16384) {
#pragma unroll
            for (int j = 0; j < 4; ++j) v[j] = ld_bf16x4((const bf16_t*)X + (size_t)row * D + j * 256 + lane * 4);
        } else {
#pragma unroll
            for (int j = 0; j < 4; ++j) v[j] = ld_bf16x4(hres + (size_t)row * D + j * 256 + lane * 4) * ALPHA;
            for (int pk = 0; pk < splits; ++pk) {
                const float* sp = slab + ((size_t)pk * 768 + (row - 16384)) * D + lane * 4;
#pragma unroll
                for (int j = 0; j < 4; ++j) v[j] += *(const f32x4*)(sp + j * 256);
            }
        }
#pragma unroll
        for (int j = 0; j < 4; ++j) s += (v[j][0] + v[j][1]) + (v[j][2] + v[j][3]);
        const float mean = wave_sum(s) * (1.f / D);
        float s2 = 0.f;
#pragma unroll
        for (int j = 0; j < 4; ++j) { v[j] = v[j] - mean; s2 += (v[j][0] * v[j][0] + v[j][1] * v[j][1]) + (v[j][2] * v[j][2] + v[j][3] * v[j][3]); }
        const float rstd = rsqrtf(wave_sum(s2) * (1.f / D) + 1e-5f);
        float* yo = nullptr;
        if (yp) {
            if (row < NPR) { const int b = row / LP, t = row % LP; if (t >= NMETA) yo = yp + ((size_t)b * SEQ + (t - NMETA)) * D; }
            else yo = ys + (size_t)(row - NPR) * D;
        }
#pragma unroll
        for (int j = 0; j < 4; ++j) {
            const f32x4 o = v[j] * rstd * gv[j] + bv[j];
            if (Hout) st_bf16x4(Hout + (size_t)row * D + j * 256 + lane * 4, o);
            if (yo) *(f32x4*)(yo + j * 256 + lane * 4) = o;
        }
    }
}

__device__ __forceinline__ void gdn_sample_pass(const Params& p, char* smem, int pass, int tid) {
    float* sq = (float*)smem;
    float* sk = sq + 256;
    float* part = sk + 256;
    float* part2 = part + 16;
    const int lane = tid & 63, wave = tid >> 6, ug = wave >> 2, wq = wave & 3;
    const int half = lane >> 5, v = wq * 32 + (lane & 31);
    const int u = pass * 2 + ug, b = u >> 4, h = u & 15, kh = h >> 1;
    const size_t row0 = (size_t)NPR + (size_t)b * DS;
    float S[64];
    {
        const float* Sp = p.state_gdn + ((size_t)(b * 16 + h) * 128 + half * 64) * 128 + v;
#pragma unroll
        for (int k = 0; k < 64; ++k) S[k] = Sp[(size_t)k * 128];
    }
    const float Aexp = __expf(p.gdn_a_log[h]);
    const float dtb = p.gdn_dt_bias[h];
    const float nw = p.gdn_norm_w[v];
    const int chA = (half ? 1024 : 0) + kh * 128 + v, chv = 2048 + h * 128 + v;
    float cA[4], cv[4];
#pragma unroll
    for (int j = 0; j < 4; ++j) { cA[j] = p.gdn_conv_w[j * 4096 + chA]; cv[j] = p.gdn_conv_w[j * 4096 + chv]; }
    float xA[7], xv[7];
#pragma unroll
    for (int i = 0; i < 3; ++i) {
        const float* cs = p.state_conv + ((size_t)b * 3 + i) * 4096;
        xA[i] = cs[chA]; xv[i] = cs[chv];
    }
#pragma unroll
    for (int i = 0; i < 4; ++i) {
        const bf16_t* mr = p.mixed + (row0 + i) * 4096;
        xA[3 + i] = bf2f(mr[chA]); xv[3 + i] = bf2f(mr[chv]);
    }
    float* sqg = sq + ug * 128;
    float* skg = sk + ug * 128;
    float* pg = part + ug * 8;
    float* pg2 = part2 + ug * 4;
    const float* kmine = skg + half * 64;
    const float* qmine = sqg + half * 64;
#pragma unroll
    for (int t = 0; t < DS; ++t) {
        const float yA = silu(xA[t] * cA[0] + xA[t + 1] * cA[1] + xA[t + 2] * cA[2] + xA[t + 3] * cA[3]);
        const float yv = silu(xv[t] * cv[0] + xv[t + 1] * cv[1] + xv[t + 2] * cv[2] + xv[t + 3] * cv[3]);
        (half ? skg : sqg)[v] = yA;
        float ssA = yA * yA;
#pragma unroll
        for (int o = 1; o < 32; o <<= 1) ssA += __shfl_xor(ssA, o);
        if ((lane & 31) == 0) pg[wq * 2 + half] = ssA;
        lds_barrier();
        const float qn = rsqrtf((pg[0] + pg[2]) + (pg[4] + pg[6]) + 1e-6f) * 0.08838834764831845f;
        const float kn = rsqrtf((pg[1] + pg[3]) + (pg[5] + pg[7]) + 1e-6f);
        const float* bap = p.ba + (row0 + t) * 32;
        const float beta = 1.f / (1.f + __expf(-bap[h]));
        const float aa = bap[16 + h] + dtb;
        const float sp = (aa > 20.f) ? aa : log1pf(__expf(aa));
        const float dec = __expf(-Aexp * sp);
        float kS0 = 0.f, kS1 = 0.f;
#pragma unroll
        for (int k = 0; k < 64; k += 4) {
            const f32x4 kk = *(const f32x4*)(kmine + k);
            S[k] *= dec; S[k + 1] *= dec; S[k + 2] *= dec; S[k + 3] *= dec;
            kS0 += kk[0] * S[k]; kS1 += kk[1] * S[k + 1]; kS0 += kk[2] * S[k + 2]; kS1 += kk[3] * S[k + 3];
        }
        float kS = kS0 + kS1;
        kS += __shfl_xor(kS, 32);
        const float delta = (yv - kS * kn) * beta * kn;
        float o0 = 0.f, o1 = 0.f;
#pragma unroll
        for (int k = 0; k < 64; k += 4) {
            const f32x4 kk = *(const f32x4*)(kmine + k);
            const f32x4 qq = *(const f32x4*)(qmine + k);
            S[k] += kk[0] * delta; S[k + 1] += kk[1] * delta; S[k + 2] += kk[2] * delta; S[k + 3] += kk[3] * delta;
            o0 += qq[0] * S[k]; o1 += qq[1] * S[k + 1]; o0 += qq[2] * S[k + 2]; o1 += qq[3] * S[k + 3];
        }
        float o = o0 + o1;
        o = (o + __shfl_xor(o, 32)) * qn;
        float s3 = o * o;
#pragma unroll
        for (int x = 1; x < 32; x <<= 1) s3 += __shfl_xor(s3, x);
        if (lane == 0) pg2[wq] = s3;
        lds_barrier();
        if (half == 0) {
            const float rms = rsqrtf(((pg2[0] + pg2[1]) + (pg2[2] + pg2[3])) * (1.f / 128.f) + 1e-6f);
            const float zz = bf2f(p.z[(row0 + t) * 2048 + h * 128 + v]);
            p.gated[(row0 + t) * 2048 + h * 128 + v] = f2bf(o * rms * nw * silu(zz));
        }
    }
    {
        float* So = p.gs_sample + ((size_t)(b * 16 + h) * 128 + half * 64) * 128 + v;
#pragma unroll
        for (int k = 0; k < 64; ++k) So[(size_t)k * 128] = S[k];
    }
    lds_barrier();
}

#define MFMA32(a, b, c) __builtin_amdgcn_mfma_f32_32x32x16_bf16((a), (b), (c), 0, 0, 0)
constexpr int NCH = 65;
constexpr int NCU = BATCH * 16 * NCH;
__device__ __forceinline__ int crow(int reg, int hh) { return (reg & 3) + 8 * (reg >> 2) + 4 * hh; }
__device__ __forceinline__ bf16x8 pack_step(const f32x16& x, int s) {
    u32x4 q;
    q[0] = pk2(x[8 * s + 0], x[8 * s + 1]); q[1] = pk2(x[8 * s + 2], x[8 * s + 3]);
    q[2] = pk2(x[8 * s + 4], x[8 * s + 5]); q[3] = pk2(x[8 * s + 6], x[8 * s + 7]);
    return __builtin_bit_cast(bf16x8, q);
}
__device__ __forceinline__ bf16x8 frag_perm(const bf16_t* p0) {
    const uint2 lo = *(const uint2*)p0, hi = *(const uint2*)(p0 + 8);
    u32x4 q; q[0] = lo.x; q[1] = lo.y; q[2] = hi.x; q[3] = hi.y;
    return __builtin_bit_cast(bf16x8, q);
}

constexpr int SA_KB = 64 * 136 * 2, SA_VB = 2 * SA_KB, SA_AM = 3 * SA_KB, SA_SM = SA_AM + 64 * 68 * 4, SA_GROUP_BYTES = SA_SM + 5 * 64 * 4;
__device__ __forceinline__ void gdn_stageA(const Params& p, char* smem0, int bid, int nb) {
    {
        const int tid = tid_opaque();
        for (int idx = bid * NTHR + tid; idx < (BATCH + DB) * 3 * 4096; idx += nb * NTHR) {
            const int c = idx & 4095, r = (idx >> 12) % 3, b = idx / (3 * 4096);
            if (b < BATCH) p.gc_prompt[idx] = bf2f(p.mixed[((size_t)b * LP + (LP - 3) + r) * 4096 + c]);
            else { const int bs = b - BATCH; p.gc_sample[(size_t)(bs * 3 + r) * 4096 + c] = bf2f(p.mixed[((size_t)NPR + bs * 4 + 1 + r) * 4096 + c]); }
        }
    }
    for (int base = bid * 2; base < NCU; base += nb * 2) {
        const int tid = tid_opaque(), lane = tid & 63, grp = tid >> 8, wg = (tid >> 6) & 3, t2 = tid & 255;
        unsigned zofs = 0; asm volatile("" : "+v"(zofs));
        char* smem = smem0 + zofs + grp * SA_GROUP_BYTES;
        bf16_t* Qb = (bf16_t*)smem;
        bf16_t* Kb = (bf16_t*)(smem + SA_KB);
        bf16_t* Vb = (bf16_t*)(smem + SA_VB);
        float* Am = (float*)(smem + SA_AM);
        float* sbeta = (float*)(smem + SA_SM);
        float* sgc = sbeta + 64;
        float* segc = sgc + 64;
        float* sekd = segc + 64;
        float* srk = sekd + 64;
        const int u = base + grp;
        const bool tail = base >= 4096;
        const int h = u & 15, n = tail ? 64 : ((u >> 4) & 63), b = tail ? ((u - 4096) >> 4) : (u >> 10);
        const int kh = h >> 1;
        const size_t su = (size_t)((b * 16 + h) * NCH + n);
        const int t0 = n * 64;
        if (tail && wg > 0) {
            const int cq = lane & 31, tsel = lane >> 5;
            const int tl0 = 16 * wg + 8 * tsel;
#pragma unroll
            for (int i = 0; i < 8; ++i) {
                *(uint2*)(Qb + (tl0 + i) * 136 + cq * 4) = make_uint2(0u, 0u);
                *(uint2*)(Kb + (tl0 + i) * 136 + cq * 4) = make_uint2(0u, 0u);
                *(uint2*)(Vb + (tl0 + i) * 136 + cq * 4) = make_uint2(0u, 0u);
            }
        } else {
            const int cq = lane & 31, tsel = lane >> 5;
            const int tl0 = 16 * wg + 8 * tsel;
#pragma unroll
            for (int pp = 0; pp < 2; ++pp) {
                const int part = pp ? 2 : grp;
                const int chb = ((part == 0) ? (kh * 128) : (part == 1) ? (1024 + kh * 128) : (2048 + h * 128)) + cq * 4;
                f32x4 cw[4];
#pragma unroll
                for (int j = 0; j < 4; ++j) cw[j] = *(const f32x4*)(p.gdn_conv_w + j * 4096 + chb);
                uint2 xr[11];
#pragma unroll
                for (int i = 0; i < 11; ++i) {
                    const int t = t0 + tl0 - 3 + i;
                    if (t >= 0 && t < LP) xr[i] = *(const uint2*)(p.mixed + ((size_t)b * LP + t) * 4096 + chb);
                    else xr[i] = make_uint2(0u, 0u);
                }
                f32x4 yv[8];
                float ssv[8];
#pragma unroll
                for (int i = 0; i < 8; ++i) {
                    const f32x4 a = cvt_bf16x4(xr[i]) * cw[0] + cvt_bf16x4(xr[i + 1]) * cw[1] + cvt_bf16x4(xr[i + 2]) * cw[2] + cvt_bf16x4(xr[i + 3]) * cw[3];
                    const bool valid = (t0 + tl0 + i) < LP;
#pragma unroll
                    for (int e2 = 0; e2 < 4; ++e2) yv[i][e2] = valid ? silu(a[e2]) : 0.f;
                    ssv[i] = (yv[i][0] * yv[i][0] + yv[i][1] * yv[i][1]) + (yv[i][2] * yv[i][2] + yv[i][3] * yv[i][3]);
                }
                if (part < 2) {
#pragma unroll
                    for (int o = 1; o < 32; o <<= 1)
#pragma unroll
                        for (int i = 0; i < 8; ++i) ssv[i] += __shfl_xor(ssv[i], o);
                }
                bf16_t* dst = (part == 0) ? Qb : (part == 1) ? Kb : Vb;
                bf16_t* dst2 = (bf16_t*)((char*)dst + (grp ? -SA_GROUP_BYTES : SA_GROUP_BYTES));
#pragma unroll
                for (int i = 0; i < 8; ++i) {
                    f32x4 y = yv[i];
                    if (part < 2) y = y * (rsqrtf(ssv[i] + 1e-6f) * ((part == 0) ? 0.08838834764831845f : 1.f));
                    st_bf16x4(dst + (tl0 + i) * 136 + cq * 4, y);
                    if (part < 2) st_bf16x4(dst2 + (tl0 + i) * 136 + cq * 4, y);
                }
            }
        }
        if (wg == 0) {
            const int c = lane, t = t0 + c;
            float beta = 0.f, g = 0.f;
            if (t < LP) {
                const float* bap = p.ba + ((size_t)b * LP + t) * 32;
                beta = 1.f / (1.f + __expf(-bap[h]));
                const float aa = bap[16 + h] + p.gdn_dt_bias[h];
                const float sp = (aa > 20.f) ? aa : log1pf(__expf(aa));
                g = -__expf(p.gdn_a_log[h]) * sp;
            }
            float gc = g;
#pragma unroll
            for (int o = 1; o < 64; o <<= 1) { const float v = __shfl_up(gc, o); if (lane >= o) gc += v; }
            const float glast = __shfl(gc, 63);
            sbeta[c] = beta; sgc[c] = gc; segc[c] = __expf(gc); sekd[c] = __expf(glast - gc); srk[c] = beta * __expf(gc);
            if (lane == 0) p.g_dec[su] = __expf(glast);
        }
        lds_barrier();
        {
            const int ti = wg >> 1, tj = wg & 1;
            const int r = lane & 31, hh = lane >> 5;
            const int c = 32 * tj + r;
            const float gcc = sgc[c], bc = sbeta[c];
            f32x16 acck, accq;
#pragma unroll
            for (int i = 0; i < 16; ++i) { acck[i] = 0.f; accq[i] = 0.f; }
            {
                const bf16_t* Ap = Kb + (32 * ti + r) * 136 + 8 * hh;
                const bf16_t* Bk = Kb + (32 * tj + r) * 136 + 8 * hh;
                const bf16_t* Bq = Qb + (32 * tj + r) * 136 + 8 * hh;
#pragma unroll
                for (int ks = 0; ks < 8; ++ks) {
                    const bf16x8 a = *(const bf16x8*)(Ap + 16 * ks);
                    acck = MFMA32(a, *(const bf16x8*)(Bk + 16 * ks), acck);
                    accq = MFMA32(a, *(const bf16x8*)(Bq + 16 * ks), accq);
                }
            }
#pragma unroll
            for (int reg = 0; reg < 16; ++reg) {
                const int cp = 32 * ti + crow(reg, hh);
                const float dcy = __expf(fminf(gcc - sgc[cp], 0.f));
                Am[(c >> 1) * 136 + cp * 2 + (c & 1)] = (cp < c) ? (bc * acck[reg] * dcy) : 0.f;
            }
            {
                bf16_t* aq = p.g_aqk + su * 4096 + (size_t)(((ti * 2 + tj) * 4) * 2 * 32) * 4 + (size_t)(hh * 32 + r) * 4;
#pragma unroll
                for (int g4 = 0; g4 < 4; ++g4) {
                    const int cp0 = 32 * ti + 8 * g4 + 4 * hh;
                    f32x4 v;
#pragma unroll
                    for (int e2 = 0; e2 < 4; ++e2) {
                        const int cp = cp0 + e2;
                        const float dcy = __expf(fminf(gcc - sgc[cp], 0.f));
                        v[e2] = (cp <= c) ? (accq[4 * g4 + e2] * dcy) : 0.f;
                    }
                    st_bf16x4(aq + (size_t)g4 * (2 * 32 * 4), v);
                }
            }
        }
        {
#pragma unroll
            for (int it = 0; it < 4; ++it) {
                const int chk = t2 + 256 * it, c = chk >> 4, d0 = (chk & 15) * 8;
                const float ee = segc[c];
                const uint4 raw = *(const uint4*)(Qb + c * 136 + d0);
                uint4 o;
                o.x = pk2(__uint_as_float(raw.x << 16) * ee, __uint_as_float(raw.x & 0xffff0000u) * ee);
                o.y = pk2(__uint_as_float(raw.y << 16) * ee, __uint_as_float(raw.y & 0xffff0000u) * ee);
                o.z = pk2(__uint_as_float(raw.z << 16) * ee, __uint_as_float(raw.z & 0xffff0000u) * ee);
                o.w = pk2(__uint_as_float(raw.w << 16) * ee, __uint_as_float(raw.w & 0xffff0000u) * ee);
                *(uint4*)(p.g_qg + su * 8192 + c * 128 + d0) = o;
            }
#pragma unroll
            for (int it = 0; it < 4; ++it) {
                const int item = t2 + 256 * it, d = item & 127, c0 = (item >> 7) * 8;
                float v[8];
#pragma unroll
                for (int i = 0; i < 8; ++i) v[i] = bf2f(Kb[(c0 + i) * 136 + d]) * sekd[c0 + i];
                uint4 o; o.x = pk2(v[0], v[1]); o.y = pk2(v[2], v[3]); o.z = pk2(v[4], v[5]); o.w = pk2(v[6], v[7]);
                *(uint4*)(p.g_kdT + su * 8192 + (size_t)item * 8) = o;
            }
        }
        lds_barrier();
        {
            const int col = 64 * wg + lane;
            const float* rs = sbeta + __builtin_amdgcn_readfirstlane((wg < 2) ? 0 : 256);
            const bf16_t* src = ((wg < 2) ? Vb : Kb) + (col & 127);
            float x[64];
#pragma unroll
            for (int i = 0; i < 64; ++i) x[i] = bf2f(src[i * 136]) * rs[i];
#pragma unroll
            for (int i0 = 0; i0 < 64; i0 += 4) {
                if (tail && i0 >= 16) continue;
                f32x2 a01 = {x[i0], x[i0 + 1]}, a23 = {x[i0 + 2], x[i0 + 3]};
                const float* P0 = Am + (i0 >> 1) * 136;
                const float* P1 = P0 + 136;
#pragma unroll
                for (int j4 = 0; j4 < i0; j4 += 4) {
                    const f32x4 q0 = *(const f32x4*)(P0 + 2 * j4), q1 = *(const f32x4*)(P0 + 2 * j4 + 4);
                    const f32x4 q2 = *(const f32x4*)(P1 + 2 * j4), q3 = *(const f32x4*)(P1 + 2 * j4 + 4);
                    a01 -= (f32x2){q0[0], q0[1]} * x[j4]; a23 -= (f32x2){q2[0], q2[1]} * x[j4];
                    a01 -= (f32x2){q0[2], q0[3]} * x[j4 + 1]; a23 -= (f32x2){q2[2], q2[3]} * x[j4 + 1];
                    a01 -= (f32x2){q1[0], q1[1]} * x[j4 + 2]; a23 -= (f32x2){q3[0], q3[1]} * x[j4 + 2];
                    a01 -= (f32x2){q1[2], q1[3]} * x[j4 + 3]; a23 -= (f32x2){q3[2], q3[3]} * x[j4 + 3];
                    if ((j4 & 12) == 12) asm volatile("" ::: "memory");
                }
                const f32x4 l0 = *(const f32x4*)(P0 + 2 * i0), l1 = *(const f32x4*)(P1 + 2 * i0), l2 = *(const f32x4*)(P1 + 2 * i0 + 4);
                const float a0 = a01[0];
                const float a1 = a01[1] - l0[1] * a0;
                const float a2 = a23[0] - l1[0] * a0 - l1[2] * a1;
                const float a3 = a23[1] - l1[1] * a0 - l1[3] * a1 - l2[1] * a2;
                x[i0] = a0; x[i0 + 1] = a1; x[i0 + 2] = a2; x[i0 + 3] = a3;
                asm volatile("" ::: "memory");
            }
            if (wg < 2) {
                float* up = p.g_u + su * 8192 + col;
#pragma unroll
                for (int i = 0; i < 64; ++i) up[i * 128] = x[i];
            } else {
                bf16_t* wp = p.g_negw + su * 8192 + (col - 128);
#pragma unroll
                for (int i = 0; i < 64; ++i) wp[i * 128] = f2bf(-x[i]);
            }
        }
        lds_barrier();
    }
}

constexpr int GB_NW = 0, GB_QG = 64 * 136, GB_KD = 2 * 64 * 136, GB_AQ = 2 * 64 * 136 + 128 * 72, GB_ELEMS = 2 * 64 * 136 + 128 * 72 + 64 * 72;
__device__ __forceinline__ void gdn_chain(const Params& p, char* smem, int b, int h) {
    bf16_t* lds = (bf16_t*)smem;
    const int tid = tid_opaque(), lane = tid & 63, wave = tid >> 6;
    const int r = lane & 31, hh = lane >> 5;
    const size_t su0 = (size_t)(b * 16 + h) * NCH;
    const bool loader = wave >= 4;
    const int t2 = tid - 256;
    uint4 sa0, sa1, sa2, sa3, sa4, sa5, sa6, sa7, sa8, sa9, sa10, sa11, sa12, sa13;
    uint4 sb0, sb1, sb2, sb3, sb4, sb5, sb6, sb7, sb8, sb9, sb10, sb11, sb12, sb13;
    f32x16 S[4], un0, un1;
#pragma unroll
    for (int i = 0; i < 4; ++i)
#pragma unroll
        for (int j = 0; j < 16; ++j) S[i][j] = 0.f;
    const int ch0 = t2, ch1 = t2 + 256, ch2 = t2 + 512, ch3 = t2 + 768;
#define GB_GLOAD(P, n_) do { const size_t su_ = su0 + (n_); \
        const bf16_t* a_ = p.g_negw + su_ * 8192; const bf16_t* b_ = p.g_qg + su_ * 8192; const bf16_t* c_ = p.g_kdT + su_ * 8192; const bf16_t* d_ = p.g_aqk + su_ * 4096; \
        P##0 = *(const uint4*)(a_ + (size_t)ch0 * 8); P##1 = *(const uint4*)(a_ + (size_t)ch1 * 8); P##2 = *(const uint4*)(a_ + (size_t)ch2 * 8); P##3 = *(const uint4*)(a_ + (size_t)ch3 * 8); \
        P##4 = *(const uint4*)(b_ + (size_t)ch0 * 8); P##5 = *(const uint4*)(b_ + (size_t)ch1 * 8); P##6 = *(const uint4*)(b_ + (size_t)ch2 * 8); P##7 = *(const uint4*)(b_ + (size_t)ch3 * 8); \
        P##8 = *(const uint4*)(c_ + (size_t)ch0 * 8); P##9 = *(const uint4*)(c_ + (size_t)ch1 * 8); P##10 = *(const uint4*)(c_ + (size_t)ch2 * 8); P##11 = *(const uint4*)(c_ + (size_t)ch3 * 8); \
        P##12 = *(const uint4*)(d_ + (size_t)ch0 * 8); P##13 = *(const uint4*)(d_ + (size_t)ch1 * 8); } while (0)
#define GB_SSTORE(P, buf_) do { bf16_t* q_ = (buf_); \
        *(uint4*)(q_ + GB_NW + (ch0 >> 4) * 136 + (ch0 & 15) * 8) = P##0; *(uint4*)(q_ + GB_NW + (ch1 >> 4) * 136 + (ch1 & 15) * 8) = P##1; \
        *(uint4*)(q_ + GB_NW + (ch2 >> 4) * 136 + (ch2 & 15) * 8) = P##2; *(uint4*)(q_ + GB_NW + (ch3 >> 4) * 136 + (ch3 & 15) * 8) = P##3; \
        *(uint4*)(q_ + GB_QG + (ch0 >> 4) * 136 + (ch0 & 15) * 8) = P##4; *(uint4*)(q_ + GB_QG + (ch1 >> 4) * 136 + (ch1 & 15) * 8) = P##5; \
        *(uint4*)(q_ + GB_QG + (ch2 >> 4) * 136 + (ch2 & 15) * 8) = P##6; *(uint4*)(q_ + GB_QG + (ch3 >> 4) * 136 + (ch3 & 15) * 8) = P##7; \
        *(uint4*)(q_ + GB_KD + (ch0 & 127) * 72 + (ch0 >> 7) * 8) = P##8; *(uint4*)(q_ + GB_KD + (ch1 & 127) * 72 + (ch1 >> 7) * 8) = P##9; \
        *(uint4*)(q_ + GB_KD + (ch2 & 127) * 72 + (ch2 >> 7) * 8) = P##10; *(uint4*)(q_ + GB_KD + (ch3 & 127) * 72 + (ch3 >> 7) * 8) = P##11; \
        GB_AQ_ST(q_, ch0, P##12); GB_AQ_ST(q_, ch1, P##13); } while (0)
#define GB_AQ_ST(q_, ch_, v_) do { const int pq_ = 2 * (ch_), r_ = pq_ & 31, hh_ = (pq_ >> 5) & 1, g4_ = (pq_ >> 6) & 3, tl_ = pq_ >> 8; \
        bf16_t* d_ = (q_) + GB_AQ + (32 * (tl_ & 1) + r_) * 72 + 32 * (tl_ >> 1) + 8 * g4_ + 4 * hh_; \
        *(uint2*)d_ = make_uint2((v_).x, (v_).y); *(uint2*)(d_ + 72) = make_uint2((v_).z, (v_).w); } while (0)
#define GB_ULOAD(n_) do { const float* up_ = p.g_u + (su0 + (n_)) * 8192 + 32 * wave + r; \
        _Pragma("unroll") for (int reg_ = 0; reg_ < 16; ++reg_) { un0[reg_] = up_[(crow(reg_, hh)) * 128]; un1[reg_] = up_[(32 + crow(reg_, hh)) * 128]; } } while (0)
    if (loader) {
        bf16_t* buf0 = lds;
        bf16_t* buf1 = lds + GB_ELEMS;
        GB_GLOAD(sa, 0); GB_SSTORE(sa, buf0);
        GB_GLOAD(sa, 1);
        lds_barrier();
        for (int n = 0; n < NCH; n += 2) {
            if (n + 2 < NCH) { GB_GLOAD(sb, n + 2); }
            if (n + 1 < NCH) { GB_SSTORE(sa, buf1); }
            lds_barrier();
            if (n + 1 >= NCH) break;
            if (n + 3 < NCH) { GB_GLOAD(sa, n + 3); }
            if (n + 2 < NCH) { GB_SSTORE(sb, buf0); }
            lds_barrier();
        }
    } else {
        GB_ULOAD(0);
        float dec_next = p.g_dec[su0];
        lds_barrier();
        for (int n = 0; n < NCH; ++n) {
            unsigned zofs = 0; asm volatile("" : "+v"(zofs));
            bf16_t* cur = lds + (n & 1) * GB_ELEMS + zofs;
            const bool more = (n + 1 < NCH);
            const float dec = dec_next;
            if (more) dec_next = p.g_dec[su0 + n + 1];
            f32x16 vn[2], o[2];
            vn[0] = un0; vn[1] = un1;
#pragma unroll
            for (int j = 0; j < 16; ++j) { o[0][j] = 0.f; o[1][j] = 0.f; }
            if (more) { GB_ULOAD(n + 1); }
#pragma unroll
            for (int kt = 0; kt < 4; ++kt)
#pragma unroll
                for (int s = 0; s < 2; ++s) {
                    const bf16x8 sb = pack_step(S[kt], s);
                    const int k0 = 32 * kt + 16 * s + 4 * hh;
#pragma unroll
                    for (int ct = 0; ct < 2; ++ct) {
                        vn[ct] = MFMA32(frag_perm(cur + GB_NW + (32 * ct + r) * 136 + k0), sb, vn[ct]);
                        o[ct] = MFMA32(frag_perm(cur + GB_QG + (32 * ct + r) * 136 + k0), sb, o[ct]);
                    }
                }
            bf16x8 vb[2][2];
#pragma unroll
            for (int ct = 0; ct < 2; ++ct)
#pragma unroll
                for (int s = 0; s < 2; ++s) vb[ct][s] = pack_step(vn[ct], s);
            {
                o[1] = MFMA32(frag_perm(cur + GB_AQ + (32 + r) * 72 + 4 * hh), vb[0][0], o[1]);
                o[0] = MFMA32(frag_perm(cur + GB_AQ + (r) * 72 + 4 * hh), vb[0][0], o[0]);
                o[1] = MFMA32(frag_perm(cur + GB_AQ + (32 + r) * 72 + 16 + 4 * hh), vb[0][1], o[1]);
                o[0] = MFMA32(frag_perm(cur + GB_AQ + (r) * 72 + 16 + 4 * hh), vb[0][1], o[0]);
                o[1] = MFMA32(frag_perm(cur + GB_AQ + (32 + r) * 72 + 32 + 4 * hh), vb[1][0], o[1]);
                o[1] = MFMA32(frag_perm(cur + GB_AQ + (32 + r) * 72 + 32 + 16 + 4 * hh), vb[1][1], o[1]);
            }
#pragma unroll
            for (int dt = 0; dt < 4; ++dt) S[dt] = S[dt] * dec;
#pragma unroll
            for (int ckt = 0; ckt < 2; ++ckt)
#pragma unroll
                for (int s = 0; s < 2; ++s)
#pragma unroll
                    for (int dt = 0; dt < 4; ++dt)
                        S[dt] = MFMA32(frag_perm(cur + GB_KD + (32 * dt + r) * 72 + 32 * ckt + 16 * s + 4 * hh), vb[ckt][s], S[dt]);
            asm volatile("" :: "v"(un0), "v"(un1), "v"(dec_next));
#pragma unroll
            for (int ct = 0; ct < 2; ++ct)
#pragma unroll
                for (int reg = 0; reg < 16; ++reg) {
                    const int t = 64 * n + 32 * ct + crow(reg, hh);
                    if (t < LP) p.g_o[(((size_t)b * LP + t) * 16 + h) * 128 + 32 * wave + r] = f2bf(o[ct][reg]);
                }
            lds_barrier();
        }
    }
    if (!loader) {
#pragma unroll
        for (int dt = 0; dt < 4; ++dt)
#pragma unroll
            for (int reg = 0; reg < 16; ++reg)
                p.gs_prompt[((size_t)(b * 16 + h) * 128 + 32 * dt + crow(reg, hh)) * 128 + 32 * wave + r] = S[dt][reg];
    }
    lds_barrier();
}

__device__ __forceinline__ void gdn_seq_phase(const Params& p, char* smem, int bid, int nb, int rep = 0) {
    if (bid < 64) gdn_chain(p, smem, bid >> 4, bid & 15);
    else {
        float* tile = (float*)smem;
        const int b2 = bid - 64, n2 = nb - 64;
        transpose_convert(p.gdn_w_out, 2048, D, D, p.wt_gout, tile, b2, n2);
        transpose_convert(p.mlp_w1, D, DFF, DFF, p.wt_w1, tile, b2, n2);
        transpose_convert(p.mlp_w1 + (size_t)D * DFF, D, DFF, DFF, p.wt_w1 + (size_t)D * DFF, tile, b2, n2);
        transpose_convert(p.mlp_w2, DFF, D, D, p.wt_w2, tile, b2, n2);
        transpose_convert(p.mlp_w2 + (size_t)D * DFF, DFF, D, D, p.wt_w2 + (size_t)D * DFF, tile, b2, n2);
        transpose_convert(p.dsa_w_in, D, DIN, DIN_PAD, p.wt_din, tile, b2, n2);
        transpose_convert(p.dsa_w_o, D, D, D, p.wt_do, tile, b2, n2);
    }
    int* slot = (int*)(smem + LDS_BYTES - 32);
    const int tid = tid_opaque();
    for (;;) {
        if (threadIdx.x == 0) *slot = (int)atomicAdd(p.bar + 3520 + 16 * rep, 1u);
        lds_barrier();
        const int u = *slot;
        lds_barrier();
        if (u >= DB * 16 / 2) break;
        gdn_sample_pass(p, smem, u, tid_opaque());
    }
}

__device__ __forceinline__ void gdn_gate_phase(const Params& p, int bid, int nb) {
    const int tid_ = tid_opaque(); const int lane = tid_ & 63, wave = tid_ >> 6;
    const int sub = lane >> 4, l16 = lane & 15;
    f32x4 nw0 = *(const f32x4*)(p.gdn_norm_w + l16 * 8), nw1 = *(const f32x4*)(p.gdn_norm_w + l16 * 8 + 4);
    for (int it4 = bid * 8 + wave; it4 < NPR * 4; it4 += nb * 8) {
        const size_t off = ((size_t)it4 * 4 + sub) * 128 + l16 * 8;
        const uint4 ov = *(const uint4*)(p.g_o + off);
        const uint4 zv = *(const uint4*)(p.z + off);
        const f32x4 o0 = cvt_bf16x4(make_uint2(ov.x, ov.y)), o1 = cvt_bf16x4(make_uint2(ov.z, ov.w));
        const f32x4 z0 = cvt_bf16x4(make_uint2(zv.x, zv.y)), z1 = cvt_bf16x4(make_uint2(zv.z, zv.w));
        float ss = ((o0[0] * o0[0] + o0[1] * o0[1]) + (o0[2] * o0[2] + o0[3] * o0[3])) + ((o1[0] * o1[0] + o1[1] * o1[1]) + (o1[2] * o1[2] + o1[3] * o1[3]));
#pragma unroll
        for (int x = 1; x < 16; x <<= 1) ss += __shfl_xor(ss, x);
        const float rms = rsqrtf(ss * (1.f / 128.f) + 1e-6f);
        uint4 g;
        g.x = pk2(o0[0] * rms * nw0[0] * silu(z0[0]), o0[1] * rms * nw0[1] * silu(z0[1]));
        g.y = pk2(o0[2] * rms * nw0[2] * silu(z0[2]), o0[3] * rms * nw0[3] * silu(z0[3]));
        g.z = pk2(o1[0] * rms * nw1[0] * silu(z1[0]), o1[1] * rms * nw1[1] * silu(z1[1]));
        g.w = pk2(o1[2] * rms * nw1[2] * silu(z1[2]), o1[3] * rms * nw1[3] * silu(z1[3]));
        *(uint4*)(p.gated + off) = g;
    }
}

__device__ __forceinline__ void rope4(const float* tab, int fi, f32x4 x, f32x4 partner, bool first, f32x4& o) {
    const f32x4 t0 = *(const f32x4*)(tab + fi * 2), t1 = *(const f32x4*)(tab + fi * 2 + 4);
    const float sg = first ? -1.f : 1.f;
    o[0] = x[0] * t0[0] + sg * partner[0] * t0[1];
    o[1] = x[1] * t0[2] + sg * partner[1] * t0[3];
    o[2] = x[2] * t1[0] + sg * partner[2] * t1[1];
    o[3] = x[3] * t1[2] + sg * partner[3] * t1[3];
}
__device__ __forceinline__ void dsa_post_phase(const Params& p, char* smem, int bid, int nb) {
    bf16_t* vt = (bf16_t*)smem;
    for (int u = bid; u < 260 + NSR / 8; u += nb) {
        const int tid = tid_opaque(); const int lane = tid & 63, wave = tid >> 6;
        const bool prompt = u < 260;
        const int b = prompt ? ((u < 256) ? (u >> 6) : (u - 256)) : 0, t0 = prompt ? ((u < 256) ? (u & 63) * 64 : 4096) : 0;
        const int nr8 = prompt ? 8 : 1;
        for (int r8 = 0; r8 < nr8; ++r8) {
            const int tl = wave * 8 + r8;
            const int tlp = (tl & ~12) | ((tl & 4) << 1) | ((tl & 8) >> 1);
            const int t = t0 + tl;
            const bool rvalid = prompt ? (t < LP) : true;
            const int row = prompt ? (b * LP + t) : (NPR + (u - 260) * 8 + wave);
            if (!rvalid) {
                for (int e = lane; e < 256; e += 64) vt[e * 72 + tlp] = 0;
                continue;
            }
            const bf16_t* P = (const bf16_t*)p.p1 + (size_t)row * DIN_PAD;
            const int pos = prompt ? t : (PAST + ((row - NPR) & 3));
            const float* tab = p.rope_tab + (size_t)pos * 48;
            float* kout = prompt ? (p.k_prompt + (size_t)row * 256) : (p.k_sample + (size_t)(row - NPR) * 256);
            float* vout = prompt ? (p.v_prompt + (size_t)row * 256) : (p.v_sample + (size_t)(row - NPR) * 256);
#pragma unroll
            for (int j = 0; j < 5; ++j) {
                const int e0 = (lane + 64 * j) * 4, d0 = e0 & 127;
                f32x4 x = ld_bf16x4(P + e0);
                if (d0 < 32) {
                    const bool first = d0 < 16;
                    const f32x4 pr = ld_bf16x4(P + (first ? e0 + 16 : e0 - 16));
                    rope4(tab, d0 & 15, x, pr, first, x);
                }
                if (j < 4) {
                    if (prompt) st_bf16x4(p.q_b + (size_t)row * 1024 + e0, x * 0.12751743f);
                    else *(f32x4*)(p.qr + (size_t)row * 1024 + e0) = x;
                } else {
                    const int ek = e0 - 1024;
                    *(f32x4*)(kout + ek) = x;
                    if (prompt) st_bf16x4(p.k_b + ((size_t)(b * 2 + (ek >> 7)) * LPAD + t) * 128 + d0, x);
                }
            }
            {
                const int e0 = lane * 4;
                const f32x4 x = ld_bf16x4(P + 1280 + e0);
                *(f32x4*)(vout + e0) = x;
                if (prompt) {
#pragma unroll
                    for (int i = 0; i < 4; ++i) vt[(e0 + i) * 72 + tlp] = f2bf(x[i]);
                }
            }
#pragma unroll
            for (int j = 0; j < 2; ++j) {
                const int e0 = (lane + 64 * j) * 4, d0 = e0 & 63;
                f32x4 x = ld_bf16x4(P + 1536 + e0);
                if (d0 < 16) {
                    const bool first = d0 < 8;
                    const f32x4 pr = ld_bf16x4(P + 1536 + (first ? e0 + 8 : e0 - 8));
                    rope4(tab, 16 + (d0 & 7), x, pr, first, x);
                }
                if (prompt) st_bf16x4(p.iq_b + (size_t)row * 512 + e0, x);
                else *(f32x4*)(p.iq + (size_t)row * 512 + e0) = x;
            }
            {
                const float x = bf2f(P[2048 + lane]);
                const float mu = wave_sum(x) * (1.f / 64.f);
                const float dv = x - mu;
                const float var = wave_sum(dv * dv) * (1.f / 64.f);
                const float xn = dv * rsqrtf(var + 1e-5f) * p.dsa_ik_g[lane] + p.dsa_ik_b[lane];
                const float other = __shfl_xor(xn, 8);
                float o = xn;
                if (lane < 16) {
                    const float c = tab[(16 + (lane & 7)) * 2], s = tab[(16 + (lane & 7)) * 2 + 1];
                    if (lane < 8) o = xn * c - other * s; else o = xn * c + other * s;
                }
                float* io = prompt ? (p.ik_prompt + (size_t)row * 64) : (p.ik_sample + (size_t)(row - NPR) * 64);
                io[lane] = o;
                if (prompt) p.ik_b[((size_t)b * LPAD + t) * 64 + lane] = f2bf(o);
            }
            if (lane < 8) p.iw[(size_t)row * 8 + lane] = bf2f(P[2112 + lane]) * 0.35355339059327373f;
        }
        lds_barrier();
        if (prompt) {
#pragma unroll
            for (int i = 0; i < 4; ++i) {
                const int ch = tid + 512 * i, rr = ch >> 3, c8 = (ch & 7) * 8;
                const uint4 v = *(const uint4*)(vt + rr * 72 + c8);
                *(uint4*)(p.vt_b + ((size_t)(b * 2 + (rr >> 7)) * 128 + (rr & 127)) * LPAD + t0 + c8) = v;
            }
        }
        lds_barrier();
    }
    for (int idx = bid * NTHR + tid_opaque(); idx < BATCH * (LPAD - LP) * 256; idx += nb * NTHR) {
        const int c = idx & 255, tp = (idx >> 8) % (LPAD - LP), bb = idx / ((LPAD - LP) * 256);
        const int t = LP + tp, kvh = c >> 7, d = c & 127;
        p.k_b[((size_t)(bb * 2 + kvh) * LPAD + t) * 128 + d] = 0;
        if (c < 64) p.ik_b[((size_t)bb * LPAD + t) * 64 + c] = 0;
        if (c < 65) p.maskT[((size_t)bb * 65 + c) * LPAD + t] = (c == 0) ? 1ull : 0ull;
    }
}

__device__ __forceinline__ const float* ik_row(const Params& p, bool prompt, int b, int s) {
    if (prompt) return p.ik_prompt + ((size_t)b * LP + s) * 64;
    if (s < PAST) { const int pg = p.page_table[b * 16 + (s >> 7)]; return p.cache_ik + ((size_t)pg * 128 + (s & 127)) * 64; }
    return p.ik_sample + ((size_t)b * DS + (s - PAST)) * 64;
}
__device__ __forceinline__ const float* kv_row(const float* own_p, const float* own_s, const float* cache, const int* page_table,
                                               bool prompt, int b, int s) {
    if (prompt) return own_p + ((size_t)b * LP + s) * 256;
    if (s < PAST) { const int pg = page_table[b * 16 + (s >> 7)]; return cache + ((size_t)pg * 128 + (s & 127)) * 256; }
    return own_s + ((size_t)b * DS + (s - PAST)) * 256;
}

template <bool PROMPT, int NREG>
__device__ __forceinline__ void select_emit(const float* sc, int qpos, int lane, unsigned long long* maskcol, int* selrow) {
    const unsigned long long ltmask = (1ull << lane) - 1ull;
    unsigned key[NREG];
    unsigned kmax = 0u, kmin = 0xffffffffu;
#pragma unroll
    for (int j = 0; j < NREG; ++j) {
        const int s = j * 64 + lane;
        const bool cand = (s >= 16 && s <= qpos);
        const float x = cand ? sc[s] : -INFINITY;
        const unsigned u = __float_as_uint(x);
        key[j] = (u & 0x80000000u) ? ~u : (u | 0x80000000u);
        kmax = max(kmax, key[j]);
        kmin = min(kmin, cand ? key[j] : 0xffffffffu);
    }
#pragma unroll
    for (int o = 1; o < 64; o <<= 1) { kmax = max(kmax, (unsigned)__shfl_xor((int)kmax, o)); kmin = min(kmin, (unsigned)__shfl_xor((int)kmin, o)); }
    unsigned lo = kmin, hi = kmax;
    bool exact = false;
    while (lo < hi) {
        const unsigned mid = lo + ((hi - lo) >> 1) + ((hi - lo) & 1u);
        int c = 0;
#pragma unroll
        for (int j = 0; j < NREG; ++j) c += __popcll(__ballot(key[j] >= mid));
        if (c >= 240) { lo = mid; if (c == 240) { exact = true; break; } } else hi = mid - 1u;
    }
    const unsigned T = lo;
    if (!PROMPT) { if (lane < 16) selrow[lane] = lane; }
    int base = 16;
    unsigned long long myword = 0ull, word64 = 0ull;
    if (exact) {
#pragma unroll
        for (int j = 0; j < NREG; ++j) {
            const bool take = key[j] >= T;
            unsigned long long m = __ballot(take);
            if (PROMPT) {
                if (j == 0) m |= 0xFFFFull;
                if (j < 64) { if (lane == j) myword = m; } else word64 = m;
            } else {
                if (take) selrow[base + __popcll(m & ltmask)] = j * 64 + lane;
                base += __popcll(m);
            }
        }
    } else {
        int cgt = 0;
#pragma unroll
        for (int j = 0; j < NREG; ++j) cgt += __popcll(__ballot(key[j] > T));
        const int need_eq = 240 - cgt;
        int erun = 0;
#pragma unroll
        for (int j = 0; j < NREG; ++j) {
            const bool gt = key[j] > T, eq = key[j] == T;
            const unsigned long long meq = __ballot(eq);
            const int rank = erun + __popcll(meq & ltmask);
            const bool take = gt || (eq && rank < need_eq);
            unsigned long long m = __ballot(take);
            if (PROMPT) {
                if (j == 0) m |= 0xFFFFull;
                if (j < 64) { if (lane == j) myword = m; } else word64 = m;
            } else {
                if (take) selrow[base + __popcll(m & ltmask)] = j * 64 + lane;
                base += __popcll(m);
            }
            erun += __popcll(meq);
        }
    }
    if (PROMPT) {
        if (NREG == 65) { maskcol[(size_t)lane * LPAD] = myword; if (lane == 0) maskcol[(size_t)64 * LPAD] = word64; }
        else { if (lane < NREG) maskcol[(size_t)lane * LPAD] = myword; else if (lane < 64) maskcol[(size_t)lane * LPAD] = 0ull; if (lane == 0) maskcol[(size_t)64 * LPAD] = 0ull; }
    }
}

__device__ __forceinline__ bf16x8 ld_f32x8_bf16(const float* p) {
    const f32x4 a = *(const f32x4*)p, b = *(const f32x4*)(p + 4);
    u32x4 q; q[0] = pk2(a[0], a[1]); q[1] = pk2(a[2], a[3]); q[2] = pk2(b[0], b[1]); q[3] = pk2(b[2], b[3]);
    return __builtin_bit_cast(bf16x8, q);
}
__device__ __forceinline__ void indexer_sample_unit(const Params& p, float* sc, int b, int tid) {
    const int lane = tid & 63, wave = tid >> 6;
    const int r = lane & 31, hh = lane >> 5;
    bf16x8 af[4];
    {
        const int e2 = r & 3, hb = (r >> 2) & 1, a = r >> 3;
        const int qi = 2 * hb + (a >> 1), head = 4 * (a & 1) + e2;
        const float* ap = p.iq + ((size_t)NPR + b * 4 + qi) * 512 + head * 64 + 8 * hh;
#pragma unroll
        for (int ks = 0; ks < 4; ++ks) af[ks] = ld_f32x8_bf16(ap + 16 * ks);
    }
    float wq[2][8];
#pragma unroll
    for (int ql = 0; ql < 2; ++ql) {
        const float* wp = p.iw + ((size_t)NPR + b * 4 + 2 * hh + ql) * 8;
        const f32x4 w0 = *(const f32x4*)wp, w1 = *(const f32x4*)(wp + 4);
#pragma unroll
        for (int e2 = 0; e2 < 4; ++e2) { wq[ql][e2] = w0[e2]; wq[ql][4 + e2] = w1[e2]; }
    }
    asm volatile("" :: "v"(af[0]), "v"(af[1]), "v"(af[2]), "v"(af[3]));
#pragma unroll
    for (int ql = 0; ql < 2; ++ql) asm volatile("" :: "v"(wq[ql][0]), "v"(wq[ql][1]), "v"(wq[ql][2]), "v"(wq[ql][3]), "v"(wq[ql][4]), "v"(wq[ql][5]), "v"(wq[ql][6]), "v"(wq[ql][7]));
    const float* kps[9];
#pragma unroll
    for (int i = 0; i < 9; ++i) {
        const int kt = wave + 8 * i;
        const int s = 32 * (kt < 65 ? kt : 64) + r;
        const float* kp;
        if (s < PAST) { const int pg = p.page_table[b * 16 + (s >> 7)]; kp = p.cache_ik + ((size_t)pg * 128 + (s & 127)) * 64; }
        else kp = p.ik_sample + ((size_t)b * DS + ((s - PAST) & 3)) * 64;
        kps[i] = kp + 8 * hh;
    }
    f32x4 nx[8];
#pragma unroll
    for (int ks = 0; ks < 4; ++ks) { nx[2 * ks] = *(const f32x4*)(kps[0] + 16 * ks); nx[2 * ks + 1] = *(const f32x4*)(kps[0] + 16 * ks + 4); }
#pragma unroll
    for (int i = 0; i < 9; ++i) {
        const int kt = wave + 8 * i;
        if (kt < 65) {
            const int s = 32 * kt + r;
            bf16x8 bq[4];
#pragma unroll
            for (int ks = 0; ks < 4; ++ks) {
                u32x4 q; q[0] = pk2(nx[2 * ks][0], nx[2 * ks][1]); q[1] = pk2(nx[2 * ks][2], nx[2 * ks][3]);
                q[2] = pk2(nx[2 * ks + 1][0], nx[2 * ks + 1][1]); q[3] = pk2(nx[2 * ks + 1][2], nx[2 * ks + 1][3]);
                bq[ks] = __builtin_bit_cast(bf16x8, q);
            }
            if (i + 1 < 9) {
#pragma unroll
                for (int ks = 0; ks < 4; ++ks) { nx[2 * ks] = *(const f32x4*)(kps[i + 1] + 16 * ks); nx[2 * ks + 1] = *(const f32x4*)(kps[i + 1] + 16 * ks + 4); }
            }
            f32x16 acc;
#pragma unroll
            for (int j = 0; j < 16; ++j) acc[j] = 0.f;
#pragma unroll
            for (int ks = 0; ks < 4; ++ks) acc = MFMA32(af[ks], bq[ks], acc);
#pragma unroll
            for (int ql = 0; ql < 2; ++ql) {
                float v = 0.f;
#pragma unroll
                for (int a2 = 0; a2 < 2; ++a2)
#pragma unroll
                    for (int e2 = 0; e2 < 4; ++e2) v += wq[ql][4 * a2 + e2] * fmaxf(acc[4 * (2 * ql + a2) + e2], 0.f);
                sc[(2 * hh + ql) * 2112 + s] = v;
            }
        }
    }
    lds_barrier();
    if (wave < 4) select_emit<false, 33>(sc + wave * 2112, PAST + wave, lane, nullptr, p.sel + ((size_t)NPR + b * 4 + wave) * 256);
    lds_barrier();
}

__device__ __forceinline__ void indexer_prompt_unit(const Params& p, float* sc, int b, int g8, int tid) {
    const int lane = tid & 63, wave = tid >> 6;
    const int r = lane & 31, hh = lane >> 5;
    const int t0 = g8 * 8;
    if (t0 < 256) {
        const int qpos = t0 + wave;
        unsigned long long* maskcol = p.maskT + (size_t)b * 65 * LPAD + qpos;
        for (int j = lane; j < 65; j += 64) {
            const int lo = j * 64;
            unsigned long long m = 0ull;
            if (qpos >= lo + 63) m = ~0ull; else if (qpos >= lo) m = (1ull << (qpos - lo + 1)) - 1ull;
            maskcol[(size_t)j * LPAD] = m;
        }
        return;
    }
    bf16x8 af[2][4];
    {
        const int e2 = r & 3, hb = (r >> 2) & 1, a = r >> 3;
        const int qi = 2 * hb + (a >> 1), head = 4 * (a & 1) + e2;
#pragma unroll
        for (int rt = 0; rt < 2; ++rt) {
            const bf16_t* ap = p.iq_b + ((size_t)b * LP + t0 + 4 * rt + qi) * 512 + head * 64 + 8 * hh;
#pragma unroll
            for (int ks = 0; ks < 4; ++ks) af[rt][ks] = *(const bf16x8*)(ap + 16 * ks);
        }
    }
    float wq[2][2][8];
#pragma unroll
    for (int rt = 0; rt < 2; ++rt)
#pragma unroll
        for (int ql = 0; ql < 2; ++ql) {
            const float* wp = p.iw + ((size_t)b * LP + t0 + 4 * rt + 2 * hh + ql) * 8;
            const f32x4 w0 = *(const f32x4*)wp, w1 = *(const f32x4*)(wp + 4);
#pragma unroll
            for (int e2 = 0; e2 < 4; ++e2) { wq[rt][ql][e2] = w0[e2]; wq[rt][ql][4 + e2] = w1[e2]; }
        }
    const int nkt = (t0 + 7) / 32 + 1;
    const bf16_t* kbase = p.ik_b + ((size_t)b * LPAD + r) * 64 + 8 * hh;
    bf16x8 bq[2][4], bn[2][4];
#pragma unroll
    for (int j = 0; j < 2; ++j) {
        const int kt = wave + 8 * j, ktc = (kt < nkt) ? kt : (nkt - 1);
#pragma unroll
        for (int ks = 0; ks < 4; ++ks) bq[j][ks] = *(const bf16x8*)(kbase + (size_t)ktc * 32 * 64 + 16 * ks);
    }
    asm volatile("" :: "v"(af[0][0]), "v"(af[0][1]), "v"(af[0][2]), "v"(af[0][3]), "v"(af[1][0]), "v"(af[1][1]), "v"(af[1][2]), "v"(af[1][3]));
#pragma unroll
    for (int rt = 0; rt < 2; ++rt)
#pragma unroll
        for (int ql = 0; ql < 2; ++ql) asm volatile("" :: "v"(wq[rt][ql][0]), "v"(wq[rt][ql][1]), "v"(wq[rt][ql][2]), "v"(wq[rt][ql][3]), "v"(wq[rt][ql][4]), "v"(wq[rt][ql][5]), "v"(wq[rt][ql][6]), "v"(wq[rt][ql][7]));
    for (int kt0 = wave; kt0 < nkt; kt0 += 16) {
#pragma unroll
        for (int j = 0; j < 2; ++j) {
            const int kt = kt0 + 16 + 8 * j, ktc = (kt < nkt) ? kt : (nkt - 1);
#pragma unroll
            for (int ks = 0; ks < 4; ++ks) bn[j][ks] = *(const bf16x8*)(kbase + (size_t)ktc * 32 * 64 + 16 * ks);
        }
        f32x16 acc[2][2];
#pragma unroll
        for (int j = 0; j < 2; ++j)
#pragma unroll
            for (int rt = 0; rt < 2; ++rt)
#pragma unroll
                for (int i = 0; i < 16; ++i) acc[j][rt][i] = 0.f;
#pragma unroll
        for (int ks = 0; ks < 4; ++ks)
#pragma unroll
            for (int j = 0; j < 2; ++j)
#pragma unroll
                for (int rt = 0; rt < 2; ++rt) acc[j][rt] = MFMA32(af[rt][ks], bq[j][ks], acc[j][rt]);
#pragma unroll
        for (int j = 0; j < 2; ++j) {
            const int kt = kt0 + 8 * j;
            if (kt < nkt) {
#pragma unroll
                for (int rt = 0; rt < 2; ++rt)
#pragma unroll
                    for (int ql = 0; ql < 2; ++ql) {
                        float s = 0.f;
#pragma unroll
                        for (int a2 = 0; a2 < 2; ++a2)
#pragma unroll
                            for (int e2 = 0; e2 < 4; ++e2) s += wq[rt][ql][4 * a2 + e2] * fmaxf(acc[j][rt][4 * (2 * ql + a2) + e2], 0.f);
                        sc[(4 * rt + 2 * hh + ql) * 4160 + 32 * kt + r] = s;
                    }
            }
        }
#pragma unroll
        for (int j = 0; j < 2; ++j)
#pragma unroll
            for (int ks = 0; ks < 4; ++ks) bq[j][ks] = bn[j][ks];
    }
    lds_barrier();
    {
        const int qpos = t0 + wave;
        unsigned long long* mc = p.maskT + (size_t)b * 65 * LPAD + qpos;
        if (t0 + 7 < 17 * 64) select_emit<true, 17>(sc + wave * 4160, qpos, lane, mc, nullptr);
        else if (t0 + 7 < 33 * 64) select_emit<true, 33>(sc + wave * 4160, qpos, lane, mc, nullptr);
        else if (t0 + 7 < 49 * 64) select_emit<true, 49>(sc + wave * 4160, qpos, lane, mc, nullptr);
        else select_emit<true, 65>(sc + wave * 4160, qpos, lane, mc, nullptr);
    }
    lds_barrier();
}

__device__ __forceinline__ void indexer_phase(const Params& p, char* smem, int bid, int nb, int rep = 0) {
    int* slot = (int*)(smem + LDS_BYTES - 32);
    for (;;) {
        const int tid = tid_opaque();
        unsigned zofs = 0; asm volatile("" : "+v"(zofs));
        float* sc = (float*)(smem + zofs);
        if (threadIdx.x == 0) *slot = (int)atomicAdd(p.bar + 3648 + 16 * rep, 1u);
        lds_barrier();
        const int u = *slot;
        lds_barrier();
        if (u >= DB + BATCH * 514) break;
        if (u < DB) {
            indexer_sample_unit(p, sc, u, tid);
        } else {
            const int v = u - DB;
            indexer_prompt_unit(p, sc, v & 3, 513 - (v >> 2), tid);
        }
    }
}

__device__ __forceinline__ void attn_sample_query(const Params& p, char* smem, int row) {
    float* qs = (float*)smem;
    float* ps = qs + 1024;
    const float** kptr = (const float**)(ps + 2048);
    const float** vptr = kptr + 256;
    float* red = (float*)(vptr + 256);
    const int tid = tid_opaque(), lane = tid & 63, wave = tid >> 6;
    const int b = (row - NPR) >> 2;
    qs[tid] = p.qr[(size_t)row * 1024 + tid];
    qs[tid + 512] = p.qr[(size_t)row * 1024 + 512 + tid];
    if (tid < 256) {
        const int s = p.sel[(size_t)row * 256 + tid];
        const float *kp, *vp;
        if (s < PAST) { const int pg = p.page_table[b * 16 + ((s < 0 ? 0 : s) >> 7)]; const size_t ro = ((size_t)pg * 128 + ((s < 0 ? 0 : s) & 127)) * 256; kp = p.cache_k + ro; vp = p.cache_v + ro; }
        else { const size_t ro = ((size_t)b * DS + (s - PAST)) * 256; kp = p.k_sample + ro; vp = p.v_sample + ro; }
        kptr[tid] = (s < 0) ? nullptr : kp;
        vptr[tid] = vp;
    }
    lds_barrier();
    {
        const int j = tid & 255, kvh = tid >> 8;
        const float* kp0 = kptr[j];
        const bool valid = kp0 != nullptr;
        const float* kp = (valid ? kp0 : vptr[j]) + kvh * 128;
        float d0 = 0.f, d1 = 0.f, d2 = 0.f, d3 = 0.f;
        const float* q0 = qs + (kvh * 4) * 128;
#pragma unroll 16
        for (int c = 0; c < 32; ++c) {
            const f32x4 kv = *(const f32x4*)(kp + c * 4);
            const f32x4 a0 = *(const f32x4*)(q0 + c * 4), a1 = *(const f32x4*)(q0 + 128 + c * 4), a2 = *(const f32x4*)(q0 + 256 + c * 4),
                        a3 = *(const f32x4*)(q0 + 384 + c * 4);
            d0 += kv[0] * a0[0] + kv[1] * a0[1] + kv[2] * a0[2] + kv[3] * a0[3];
            d1 += kv[0] * a1[0] + kv[1] * a1[1] + kv[2] * a1[2] + kv[3] * a1[3];
            d2 += kv[0] * a2[0] + kv[1] * a2[1] + kv[2] * a2[2] + kv[3] * a2[3];
            d3 += kv[0] * a3[0] + kv[1] * a3[1] + kv[2] * a3[2] + kv[3] * a3[3];
        }
        const float scl = 0.08838834764831845f;
        ps[(kvh * 4 + 0) * 256 + j] = valid ? d0 * scl : -INFINITY;
        ps[(kvh * 4 + 1) * 256 + j] = valid ? d1 * scl : -INFINITY;
        ps[(kvh * 4 + 2) * 256 + j] = valid ? d2 * scl : -INFINITY;
        ps[(kvh * 4 + 3) * 256 + j] = valid ? d3 * scl : -INFINITY;
    }
    lds_barrier();
    {
        float v[4]; float m = -INFINITY;
#pragma unroll
        for (int i = 0; i < 4; ++i) { v[i] = ps[wave * 256 + lane + 64 * i]; m = fmaxf(m, v[i]); }
        m = wave_max(m);
        float sum = 0.f;
#pragma unroll
        for (int i = 0; i < 4; ++i) { v[i] = __expf(v[i] - m); sum += v[i]; }
        sum = wave_sum(sum);
        const float inv = 1.f / sum;
#pragma unroll
        for (int i = 0; i < 4; ++i) ps[wave * 256 + lane + 64 * i] = v[i] * inv;
    }
    lds_barrier();
    {
        const int kvh = tid >> 8, kg = (tid >> 5) & 7, d4 = tid & 31;
        f32x4 acc[4];
#pragma unroll
        for (int g = 0; g < 4; ++g) acc[g] = (f32x4){0.f, 0.f, 0.f, 0.f};
#pragma unroll 16
        for (int i = 0; i < 32; ++i) {
            const int j = kg * 32 + i;
            const f32x4 vv = *(const f32x4*)(vptr[j] + kvh * 128 + d4 * 4);
#pragma unroll
            for (int g = 0; g < 4; ++g) acc[g] += vv * ps[(kvh * 4 + g) * 256 + j];
        }
#pragma unroll
        for (int g = 0; g < 4; ++g) *(f32x4*)(red + ((kg * 2 + kvh) * 4 + g) * 128 + d4 * 4) = acc[g];
    }
    lds_barrier();
    {
        const int h = wave, d = lane * 2;
        float o0 = 0.f, o1 = 0.f;
#pragma unroll
        for (int kg = 0; kg < 8; ++kg) { const f32x2 t = *(const f32x2*)(red + ((kg * 2 + (h >> 2)) * 4 + (h & 3)) * 128 + d); o0 += t[0]; o1 += t[1]; }
        *(unsigned*)(p.gated + (size_t)row * 1024 + h * 128 + d) = pk2(o0, o1);
    }
    lds_barrier();
}

constexpr int AT_K = 0, AT_V = 64 * 136, AT_ELEMS = 64 * 136 + 128 * 72;
__device__ __forceinline__ void attn_dense_unit(const Params& p, char* smem, int b, int kvh, int qb) {
    bf16_t* lds = (bf16_t*)smem;
    const int tid = tid_opaque(), lane = tid & 63, wave = tid >> 6;
    const int r = lane & 31, hh = lane >> 5;
    const int g = wave & 3, qs = wave >> 2;
    const int head = kvh * 4 + g;
    const int tq = 64 * qb + 32 * qs + r;
    const int tqc = (tq < LP) ? tq : (LP - 1);
    bf16x8 qf[8];
    {
        const bf16_t* qp = p.q_b + ((size_t)b * LP + tqc) * 1024 + head * 128 + 8 * hh;
#pragma unroll
        for (int ks = 0; ks < 8; ++ks) qf[ks] = *(const bf16x8*)(qp + 16 * ks);
    }
    f32x16 O[4];
#pragma unroll
    for (int i = 0; i < 4; ++i)
#pragma unroll
        for (int j = 0; j < 16; ++j) O[i][j] = 0.f;
    float mrun = 0.f, lrun = 0.f;
    const bf16_t* Kg = p.k_b + ((size_t)(b * 2 + kvh) * LPAD) * 128;
    const bf16_t* Vg = p.vt_b + ((size_t)(b * 2 + kvh) * 128) * LPAD;
    const unsigned long long* mcol = p.maskT + (size_t)b * 65 * LPAD + tq;
    const int kc0 = tid, kc1 = tid + 512;
    uint4 sk0, sk1, sv0, sv1;
#define AT_GLOAD(kt_) do { const bf16_t* kg_ = Kg + (size_t)(kt_) * 64 * 128; const bf16_t* vg_ = Vg + (size_t)(kt_) * 64; \
        sk0 = *(const uint4*)(kg_ + (size_t)kc0 * 8); sk1 = *(const uint4*)(kg_ + (size_t)kc1 * 8); \
        sv0 = *(const uint4*)(vg_ + (size_t)(kc0 >> 3) * LPAD + (kc0 & 7) * 8); sv1 = *(const uint4*)(vg_ + (size_t)(kc1 >> 3) * LPAD + (kc1 & 7) * 8); } while (0)
#define AT_SSTORE(buf_) do { bf16_t* q_ = (buf_); \
        *(uint4*)(q_ + AT_K + (kc0 >> 4) * 136 + (kc0 & 15) * 8) = sk0; *(uint4*)(q_ + AT_K + (kc1 >> 4) * 136 + (kc1 & 15) * 8) = sk1; \
        *(uint4*)(q_ + AT_V + (kc0 >> 3) * 72 + (kc0 & 7) * 8) = sv0; *(uint4*)(q_ + AT_V + (kc1 >> 3) * 72 + (kc1 & 7) * 8) = sv1; } while (0)
    AT_GLOAD(0); AT_SSTORE(lds);
    unsigned long long mw_next = mcol[0];
    asm volatile("" :: "v"(qf[0]), "v"(qf[1]), "v"(qf[2]), "v"(qf[3]), "v"(qf[4]), "v"(qf[5]), "v"(qf[6]), "v"(qf[7]), "v"(mw_next));
    lds_barrier();
    for (int kt = 0; kt <= qb; ++kt) {
        unsigned zofs = 0; asm volatile("" : "+v"(zofs));
        bf16_t* cur = lds + (kt & 1) * AT_ELEMS + zofs;
        bf16_t* nxt = lds + ((kt + 1) & 1) * AT_ELEMS + zofs;
        const bool more = kt < qb;
        if (more) { AT_GLOAD(kt + 1); }
        const unsigned long long mw = mw_next;
        if (more) mw_next = mcol[(size_t)(kt + 1) * LPAD];
        f32x16 st[2];
        {
            const float ninit = -mrun;
#pragma unroll
            for (int j = 0; j < 16; ++j) { st[0][j] = ninit; st[1][j] = ninit; }
        }
#pragma unroll
        for (int ks = 0; ks < 8; ++ks) {
            st[0] = MFMA32(*(const bf16x8*)(cur + AT_K + (r) * 136 + 16 * ks + 8 * hh), qf[ks], st[0]);
            st[1] = MFMA32(*(const bf16x8*)(cur + AT_K + (32 + r) * 136 + 16 * ks + 8 * hh), qf[ks], st[1]);
        }
        float mx = fmaxf(st[0][0], st[1][0]);
#pragma unroll
        for (int reg = 1; reg < 16; reg += 1) mx = fmaxf(mx, fmaxf(st[0][reg], st[1][reg]));
        mx = fmaxf(mx, __shfl_xor(mx, 32));
        const bool move = (kt == 0) || (mx > 8.f);
        if (__any(move)) {
            const float delta = move ? mx : 0.f;
            if (kt > 0) {
                const float alpha = __builtin_amdgcn_exp2f(-delta);
                lrun *= alpha;
#pragma unroll
                for (int dt = 0; dt < 4; ++dt) O[dt] = O[dt] * alpha;
            }
            mrun += delta;
#pragma unroll
            for (int reg = 0; reg < 16; ++reg) { st[0][reg] -= delta; st[1][reg] -= delta; }
        }
        f32x2 psum2 = {0.f, 0.f};
#pragma unroll
        for (int kk = 0; kk < 2; ++kk) {
            const int w = (int)((unsigned)(mw >> (32 * kk)) >> (4 * hh));
#pragma unroll
            for (int reg = 0; reg < 16; reg += 2) {
                int keep0, keep1;
                asm("v_bfe_i32 %0, %1, %2, 1" : "=v"(keep0) : "v"(w), "n"((reg & 3) + 8 * (reg >> 2)));
                asm("v_bfe_i32 %0, %1, %2, 1" : "=v"(keep1) : "v"(w), "n"(((reg + 1) & 3) + 8 * ((reg + 1) >> 2)));
                f32x2 pv;
                pv[0] = __uint_as_float(__float_as_uint(__builtin_amdgcn_exp2f(st[kk][reg])) & (unsigned)keep0);
                pv[1] = __uint_as_float(__float_as_uint(__builtin_amdgcn_exp2f(st[kk][reg + 1])) & (unsigned)keep1);
                st[kk][reg] = pv[0]; st[kk][reg + 1] = pv[1];
                psum2 += pv;
            }
        }
        lrun += psum2[0] + psum2[1];
        bf16x8 pb[2][2];
#pragma unroll
        for (int kk = 0; kk < 2; ++kk)
#pragma unroll
            for (int s = 0; s < 2; ++s) pb[kk][s] = pack_step(st[kk], s);
#pragma unroll
        for (int kk = 0; kk < 2; ++kk)
#pragma unroll
            for (int s = 0; s < 2; ++s)
#pragma unroll
                for (int dt = 0; dt < 4; ++dt)
                    O[dt] = MFMA32(*(const bf16x8*)(cur + AT_V + (32 * dt + r) * 72 + 32 * kk + 16 * s + 8 * hh), pb[kk][s], O[dt]);
        if (more) { AT_SSTORE(nxt); }
        lds_barrier();
    }
    const float ltot = lrun + __shfl_xor(lrun, 32);
    const float inv = 1.f / ltot;
    if (tq < LP) {
        bf16_t* op = p.gated + ((size_t)b * LP + tq) * 1024 + head * 128;
#pragma unroll
        for (int dt = 0; dt < 4; ++dt)
#pragma unroll
            for (int g4 = 0; g4 < 4; ++g4) {
                f32x4 v;
#pragma unroll
                for (int e2 = 0; e2 < 4; ++e2) v[e2] = O[dt][4 * g4 + e2] * inv;
                st_bf16x4(op + 32 * dt + 8 * g4 + 4 * hh, v);
            }
    }
    lds_barrier();
}

__device__ __forceinline__ void attn_phase(const Params& p, char* smem, int bid, int nb, int rep = 0) {
    int* slot = (int*)(smem + LDS_BYTES - 32);
    for (;;) {
        if (threadIdx.x == 0) *slot = (int)atomicAdd(p.bar + 3584 + 16 * rep, 1u);
        lds_barrier();
        const int u = *slot;
        lds_barrier();
        if (u >= 520 + NSR) break;
        if (u < 520) attn_dense_unit(p, smem, (u & 7) >> 1, u & 1, 64 - (u >> 3));
        else attn_sample_query(p, smem, NPR + (u - 520));
    }
}

#define XB_TMO      128
#define XB_XCNT(j)  (256  + 64 * (j))
#define XB_XSUB(j)  (1280 + 64 * (j))
#define XB_XGEN(j)  (2304 + 64 * (j))
#define XB_TOP      3328
#define XB_TOPGEN   3392
#define XCD_BAR_WORDS 3456
#define XB_SPIN_CAP (1u << 18)
#define LAS __attribute__((address_space(3)))

__device__ __forceinline__ unsigned xb_ld(unsigned* p)              { return __hip_atomic_load(p, __ATOMIC_RELAXED, __HIP_MEMORY_SCOPE_AGENT); }
__device__ __forceinline__ unsigned xb_add(unsigned* p, unsigned v) { return __hip_atomic_fetch_add(p, v, __ATOMIC_RELAXED, __HIP_MEMORY_SCOPE_AGENT); }
__device__ __forceinline__ unsigned xb_xcc_id() { return (unsigned)__builtin_amdgcn_s_getreg((3 << 11) | 20) & 0xFu; }
#define XB_SPIN(cond, bar) do { unsigned _sp = 0; while (cond) { __builtin_amdgcn_s_sleep(1); \
    if ((++_sp & 255u) == 0u) { if (xb_ld(&(bar)[XB_TMO])) break; if (_sp > XB_SPIN_CAP) { atomicAdd(&(bar)[XB_TMO], 1u); break; } } } } while (0)

struct XcdBarrier {
    unsigned* bar; unsigned x;
    volatile LAS unsigned* st;
};

__device__ __forceinline__ XcdBarrier xcd_barrier_post(unsigned* bar, volatile LAS unsigned* st) {
    XcdBarrier b; b.bar = bar; b.x = xb_xcc_id(); b.st = st;
    if (threadIdx.x == 0) (void)xb_add(&bar[XB_XCNT(b.x)], 1u);
    return b;
}
__device__ __forceinline__ void xcd_barrier_complete(unsigned* bar, unsigned x, unsigned& nloc, unsigned& nx) {
    const unsigned G = gridDim.x * gridDim.y * gridDim.z;
    unsigned sum, cnt, mine, sp = 0u;
    for (;;) {
        sum = 0u; cnt = 0u; mine = 0u;
#pragma unroll
        for (unsigned j = 0; j < 16; ++j) { const unsigned c = xb_ld(&bar[XB_XCNT(j)]); sum += c; cnt += (c > 0u) ? 1u : 0u; mine = (j == x) ? c : mine; }
        if (sum == G) break;
        __builtin_amdgcn_s_sleep(1);
        if ((++sp & 255u) == 0u) { if (xb_ld(&bar[XB_TMO])) break; if (sp > XB_SPIN_CAP) { atomicAdd(&bar[XB_TMO], 1u); break; } }
    }
    nloc = mine > 0u ? mine : 1u; nx = cnt > 0u ? cnt : 1u;
}

__device__ __forceinline__ void xcd_barrier(const XcdBarrier& b) {
    asm volatile("s_waitcnt vmcnt(0)" ::: "memory");
    __syncthreads();
    if (threadIdx.x == 0) {
        unsigned* bar = b.bar;
        __builtin_amdgcn_s_waitcnt(0);
        unsigned nloc = b.st[0], nx = b.st[1];
        if (nloc == 0u) { xcd_barrier_complete(bar, b.x, nloc, nx); b.st[0] = nloc; b.st[1] = nx; }
        const unsigned old = xb_add(&bar[XB_XSUB(b.x)], 1u);
        const unsigned gen = old / nloc;
        if (old + 1u == (gen + 1u) * nloc) {
            __builtin_amdgcn_fence(__ATOMIC_RELEASE, "agent");
            asm volatile("s_waitcnt vmcnt(0)" ::: "memory");
            const unsigned og = xb_add(&bar[XB_TOP], 1u);
            const unsigned tg = og / nx;
            if (og + 1u == (tg + 1u) * nx) xb_add(&bar[XB_TOPGEN], 1u);
            else XB_SPIN(xb_ld(&bar[XB_TOPGEN]) == tg, bar);
            __builtin_amdgcn_fence(__ATOMIC_ACQUIRE, "agent");
            xb_add(&bar[XB_XGEN(b.x)], 1u);
            asm volatile("s_waitcnt vmcnt(0)" ::: "memory");
        } else {
            XB_SPIN(xb_ld(&bar[XB_XGEN(b.x)]) == gen, bar);
            __builtin_amdgcn_fence(__ATOMIC_ACQUIRE, "agent");
            asm volatile("s_waitcnt vmcnt(0)" ::: "memory");
        }
    }
    __syncthreads();
}


constexpr int NPHASE = 19;
template <int PH>
__device__ __forceinline__ void run_phase(const Params& p, char* smem, int bid, int nb, int rep = 0) {
    constexpr int MT = MPAD / 256;
    if constexpr (PH == 0) phase_prologue(p, smem, bid, nb);
    else if constexpr (PH == 1) gemm_big(p.hA, D, p.wt_gin, GIN_PAD, EpiGdnIn{p.mixed, p.z, p.ba}, smem, bid, nb);
    else if constexpr (PH == 2) gdn_stageA(p, smem, bid, nb);
    else if constexpr (PH == 3) gdn_seq_phase(p, smem, bid, nb, rep);
    else if constexpr (PH == 4) gdn_gate_phase(p, bid, nb);
    else if constexpr (PH == 5) gemm_n1024(p.gated, 2048, p.wt_gout, EpiResid{p.preln, p.hA}, EpiSlab{p.slab}, 8, smem, bid, nb);
    else if constexpr (PH == 6) ln_phase(p.preln, p.ln1_g, p.ln1_b, p.hB, nullptr, nullptr, p.slab, 8, p.hA, bid, nb);
    else if constexpr (PH == 7) gemm_big(p.hB, D, p.wt_w1, DFF, EpiRelu2{p.act}, smem, bid, nb);
    else if constexpr (PH == 8) gemm_n1024(p.act, DFF, p.wt_w2, EpiResid{p.preln, p.hB}, EpiSlab{p.slab}, 16, smem, bid, nb);
    else if constexpr (PH == 9) ln_phase(p.preln, p.ln2_g, p.ln2_b, p.hA, nullptr, nullptr, p.slab, 16, p.hB, bid, nb);
    else if constexpr (PH == 10) gemm_big(p.hA, D, p.wt_din, DIN_PAD, EpiBf16{(bf16_t*)p.p1, DIN_PAD}, smem, bid, nb);
    else if constexpr (PH == 11) dsa_post_phase(p, smem, bid, nb);
    else if constexpr (PH == 12) indexer_phase(p, smem, bid, nb, rep);
    else if constexpr (PH == 13) attn_phase(p, smem, bid, nb, rep);
    else if constexpr (PH == 14) gemm_n1024(p.gated, D, p.wt_do, EpiResid{p.preln, p.hA}, EpiSlab{p.slab}, 4, smem, bid, nb);
    else if constexpr (PH == 15) ln_phase(p.preln, p.ln1_g + D, p.ln1_b + D, p.hB, nullptr, nullptr, p.slab, 4, p.hA, bid, nb);
    else if constexpr (PH == 16) gemm_big(p.hB, D, p.wt_w1 + (size_t)D * DFF, DFF, EpiRelu2{p.act}, smem, bid, nb);
    else if constexpr (PH == 17) gemm_n1024(p.act, DFF, p.wt_w2 + (size_t)D * DFF, EpiResid{p.preln, p.hB}, EpiSlab{p.slab}, 16, smem, bid, nb);
    else if constexpr (PH == 18) ln_phase(p.preln, p.ln2_g + D, p.ln2_b + D, nullptr, p.y_prompt, p.y_sample, p.slab, 16, p.hB, bid, nb);
}

template <int PH>
__global__ void __launch_bounds__(NTHR, 2) k_phase(Params p) {
    extern __shared__ __attribute__((aligned(16))) char smem[];
    run_phase<PH>(p, smem, blockIdx.x, gridDim.x);
}

template <int PH>
__device__ __forceinline__ void mega_run(const Params& p, char* smem, const XcdBarrier& bar) {
    run_phase<PH>(p, smem, blockIdx.x, gridDim.x);
#ifdef PROBE_MASK
    if constexpr ((PROBE_MASK >> PH) & 1) { xcd_barrier(bar); run_phase<PH>(p, smem, blockIdx.x, gridDim.x, 1); }
#endif
    if constexpr (PH + 1 < NPHASE) {
        xcd_barrier(bar);
        mega_run<PH + 1>(p, smem, bar);
    }
}
__global__ void __launch_bounds__(NTHR, 2) k_mega(Params p) {
    extern __shared__ __attribute__((aligned(16))) char smem[];
    volatile LAS unsigned* st = (volatile LAS unsigned*)(smem + LDS_BYTES - 16);
    if (threadIdx.x == 0) { st[0] = 0u; st[1] = 0u; st[2] = 0u; st[3] = 0u; }
    __syncthreads();
    XcdBarrier bar = xcd_barrier_post(p.bar, st);
    mega_run<0>(p, smem, bar);
}

template <int PH>
void launch_phase(const Params& p, hipStream_t stream) {
    static bool attr_done = false;
    if (!attr_done) {
        (void)hipFuncSetAttribute((const void*)k_phase<PH>, hipFuncAttributeMaxDynamicSharedMemorySize, LDS_BYTES);
        attr_done = true;
    }
    hipLaunchKernelGGL(k_phase<PH>, dim3(256), dim3(NTHR), LDS_BYTES, stream, p);
}
template <int PH>
void launch_all(const Params& p, hipStream_t stream) {
    launch_phase<PH>(p, stream);
    if constexpr (PH + 1 < NPHASE) launch_all<PH + 1>(p, stream);
}

}

extern "C" void kernel_launch(void* const* d_in, const int* in_sizes, int n_in, void* d_out, int out_size, void* d_ws, size_t ws_size,
                              hipStream_t stream) {
    Params p{};
    p.x_prompt = (const float*)d_in[0]; p.x_sample = (const float*)d_in[1]; p.state_gdn = (const float*)d_in[2];
    p.state_conv = (const float*)d_in[3]; p.cache_k = (const float*)d_in[4]; p.cache_v = (const float*)d_in[5];
    p.cache_ik = (const float*)d_in[6]; p.page_table = (const int*)d_in[7]; p.meta = (const float*)d_in[8];
    p.ln1_g = (const float*)d_in[9]; p.ln1_b = (const float*)d_in[10]; p.ln2_g = (const float*)d_in[11]; p.ln2_b = (const float*)d_in[12];
    p.mlp_w1 = (const float*)d_in[13]; p.mlp_w2 = (const float*)d_in[14]; p.gdn_w_in = (const float*)d_in[15];
    p.gdn_conv_w = (const float*)d_in[16]; p.gdn_a_log = (const float*)d_in[17]; p.gdn_dt_bias = (const float*)d_in[18];
    p.gdn_norm_w = (const float*)d_in[19]; p.gdn_w_out = (const float*)d_in[20]; p.dsa_w_in = (const float*)d_in[21];
    p.dsa_ik_g = (const float*)d_in[22]; p.dsa_ik_b = (const float*)d_in[23]; p.dsa_w_o = (const float*)d_in[24];
    float* o = (float*)d_out;
    p.y_prompt = o; o += (size_t)BATCH * SEQ * D;
    p.y_sample = o; o += (size_t)NSR * D;
    p.gs_prompt = o; o += (size_t)BATCH * 16 * 128 * 128;
    p.gc_prompt = o; o += (size_t)BATCH * 3 * 4096;
    p.gs_sample = o; o += (size_t)DB * 16 * 128 * 128;
    p.gc_sample = o; o += (size_t)DB * 3 * 4096;
    p.k_prompt = o; o += (size_t)NPR * 256;
    p.v_prompt = o; o += (size_t)NPR * 256;
    p.ik_prompt = o; o += (size_t)NPR * 64;
    p.k_sample = o; o += (size_t)NSR * 256;
    p.v_sample = o; o += (size_t)NSR * 256;
    p.ik_sample = o; o += (size_t)NSR * 64;
    char* w = (char*)d_ws;
    auto take = [&](size_t bytes) { char* r = w; w += (bytes + 255) & ~(size_t)255; return r; };
    p.bar = (unsigned*)take(16384);
    p.wt_gin = (bf16_t*)take((size_t)GIN_PAD * D * 2);
    p.wt_gout = (bf16_t*)take((size_t)D * 2048 * 2);
    p.wt_w1 = (bf16_t*)take((size_t)2 * D * DFF * 2);
    p.wt_w2 = (bf16_t*)take((size_t)2 * D * DFF * 2);
    p.wt_din = (bf16_t*)take((size_t)DIN_PAD * D * 2);
    p.wt_do = (bf16_t*)take((size_t)D * D * 2);
    p.hA = (bf16_t*)take((size_t)MPAD * D * 2);
    p.hB = (bf16_t*)take((size_t)MPAD * D * 2);
    p.preln = (float*)take((size_t)MPAD * D * 4);
    p.mixed = (bf16_t*)take((size_t)MPAD * 4096 * 2);
    p.z = (bf16_t*)take((size_t)MPAD * 2048 * 2);
    p.ba = (float*)take((size_t)MPAD * 32 * 4);
    p.gated = (bf16_t*)take((size_t)MPAD * 2048 * 2);
    p.act = (bf16_t*)take((size_t)MPAD * DFF * 2);
    p.p1 = (float*)take((size_t)MPAD * DIN_PAD * 4);
    p.qr = (float*)take((size_t)MPAD * 1024 * 4);
    p.iq = (float*)take((size_t)MPAD * 512 * 4);
    p.iw = (float*)take((size_t)MPAD * 8 * 4);
    p.sel = (int*)take((size_t)MPAD * 256 * 4);
    p.g_o = (bf16_t*)take((size_t)NPR * 2048 * 2);
    p.rope_tab = (float*)take((size_t)LP * 24 * 2 * 4);
    p.slab = (float*)take((size_t)16 * 768 * 1024 * 4);
    p.q_b = (bf16_t*)take((size_t)NPR * 1024 * 2);
    p.k_b = (bf16_t*)take((size_t)BATCH * 2 * LPAD * 128 * 2);
    p.vt_b = (bf16_t*)take((size_t)BATCH * 2 * 128 * LPAD * 2);
    p.iq_b = (bf16_t*)take((size_t)NPR * 512 * 2);
    p.ik_b = (bf16_t*)take((size_t)BATCH * LPAD * 64 * 2);
    p.maskT = (unsigned long long*)take((size_t)BATCH * 65 * LPAD * 8);
    p.g_dec = (float*)take((size_t)NCU * 4);
    p.g_u = (float*)p.act;
    p.g_negw = (bf16_t*)p.p1;
    p.g_qg = p.g_negw + (size_t)NCU * 8192;
    p.g_kdT = (bf16_t*)p.qr;
    p.g_aqk = (bf16_t*)p.iq;
    if ((size_t)(w - (char*)d_ws) > ws_size) { fprintf(stderr, "kernel_launch: workspace too small (%zu needed, %zu given)\n", (size_t)(w - (char*)d_ws), ws_size); return; }
#if MEGA
    static int grid = 0;
    if (grid == 0) {
        int dev = 0, cus = 0;
        if (hipGetDevice(&dev) != hipSuccess || hipDeviceGetAttribute(&cus, hipDeviceAttributeMultiprocessorCount, dev) != hipSuccess || cus <= 0) cus = 256;
        (void)hipFuncSetAttribute((const void*)k_mega, hipFuncAttributeMaxDynamicSharedMemorySize, LDS_BYTES);
        grid = cus;
    }
    (void)hipMemsetAsync(p.bar, 0, 16384, stream);
    hipLaunchKernelGGL(k_mega, dim3(grid), dim3(NTHR), LDS_BYTES, stream, p);
#else
    launch_all<0>(p, stream);
#endif
}
```

```cpp
#include <hip/hip_runtime.h>
#include <stdint.h>
#include <stdio.h>

#ifndef MEGA
#define MEGA 1
#endif

namespace {

typedef unsigned short bf16_t;
typedef short bf16x8 __attribute__((ext_vector_type(8)));
typedef float f32x4 __attribute__((ext_vector_type(4)));

constexpr int D = 1024, BATCH = 4, SEQ = 4096, NMETA = 16, LP = SEQ + NMETA;
constexpr int DB = 128, DS = 4, PAST = 2048;
constexpr int NPR = BATCH * LP;
constexpr int NSR = DB * DS;
constexpr int NT = NPR + NSR;
constexpr int MPAD = 17152;
constexpr int DFF = 4096;
constexpr int GIN = 6176, GIN_PAD = 6400;
constexpr int DIN = 2120, DIN_PAD = 2304;
constexpr int NTHR = 512;
constexpr int LPAD = 4160;
constexpr int LDS_BYTES = 150 * 1024;
constexpr float ALPHA = 1.4142135623730951f;

struct Params {
    const float *x_prompt, *x_sample, *state_gdn, *state_conv, *cache_k, *cache_v, *cache_ik;
    const int* page_table;
    const float *meta, *ln1_g, *ln1_b, *ln2_g, *ln2_b, *mlp_w1, *mlp_w2, *gdn_w_in, *gdn_conv_w, *gdn_a_log, *gdn_dt_bias,
        *gdn_norm_w, *gdn_w_out, *dsa_w_in, *dsa_ik_g, *dsa_ik_b, *dsa_w_o;
    float *y_prompt, *y_sample, *gs_prompt, *gc_prompt, *gs_sample, *gc_sample, *k_prompt, *v_prompt, *ik_prompt, *k_sample,
        *v_sample, *ik_sample;
    unsigned* bar;
    bf16_t *wt_gin, *wt_gout, *wt_w1, *wt_w2, *wt_din, *wt_do;
    bf16_t *hA, *hB;
    float* preln;
    bf16_t *mixed, *z;
    float* ba;
    bf16_t *gated, *act;
    float *p1, *qr, *iq, *iw;
    int* sel;
    bf16_t *g_negw, *g_qg, *g_kdT, *g_aqk;
    float *g_u, *g_dec;
    bf16_t* g_o;
    float* rope_tab;
    float* slab;
    bf16_t *q_b, *k_b, *vt_b, *iq_b, *ik_b;
    unsigned long long* maskT;
};

__device__ const double kInvFreq[16] = {1.0, 0.44036660267178046, 0.19392274474868576, 0.08539710028576561,
    0.03760603093086393, 0.016560440080994446, 0.007292664737217109, 0.003211445994752591, 0.001414213562373095,
    0.000622772421914596, 0.0002742481756762073, 0.00012076973741146504, 5.318295896944988e-05, 2.341999896140934e-05,
    1.031338537721246e-05, 4.5416704806078695e-06};

__device__ __forceinline__ float bf2f(bf16_t h) { return __uint_as_float(((unsigned)h) << 16); }
typedef __bf16 hwbf16x2 __attribute__((ext_vector_type(2)));
typedef float f32x2 __attribute__((ext_vector_type(2)));
typedef float f32x16 __attribute__((ext_vector_type(16)));
typedef unsigned u32x4 __attribute__((ext_vector_type(4)));
__device__ __forceinline__ unsigned pk2(float lo, float hi) {
    const f32x2 v = {lo, hi};
    return __builtin_bit_cast(unsigned, __builtin_convertvector(v, hwbf16x2));
}
__device__ __forceinline__ bf16_t f2bf(float f) { return (bf16_t)(pk2(f, 0.f) & 0xffffu); }
__device__ __forceinline__ void st_bf16x4(bf16_t* p, f32x4 v) {
    uint2 o; o.x = pk2(v[0], v[1]); o.y = pk2(v[2], v[3]);
    *(uint2*)p = o;
}
__device__ __forceinline__ f32x4 cvt_bf16x4(uint2 o) {
    f32x4 v; v[0] = __uint_as_float(o.x << 16); v[1] = __uint_as_float(o.x & 0xffff0000u);
    v[2] = __uint_as_float(o.y << 16); v[3] = __uint_as_float(o.y & 0xffff0000u);
    return v;
}
__device__ __forceinline__ f32x4 ld_bf16x4(const bf16_t* p) {
    uint2 o = *(const uint2*)p;
    f32x4 v; v[0] = __uint_as_float(o.x << 16); v[1] = __uint_as_float(o.x & 0xffff0000u);
    v[2] = __uint_as_float(o.y << 16); v[3] = __uint_as_float(o.y & 0xffff0000u);
    return v;
}
__device__ __forceinline__ float wave_sum(float v) {
#pragma unroll
    for (int o = 1; o < 64; o <<= 1) v += __shfl_xor(v, o);
    return v;
}
__device__ __forceinline__ float wave_max(float v) {
#pragma unroll
    for (int o = 1; o < 64; o <<= 1) v = fmaxf(v, __shfl_xor(v, o));
    return v;
}
__device__ __forceinline__ int wave_sum_i(int v) {
#pragma unroll
    for (int o = 1; o < 64; o <<= 1) v += __shfl_xor(v, o);
    return v;
}
__device__ __forceinline__ float silu(float x) { return x * __builtin_amdgcn_rcpf(1.f + __expf(-x)); }
__device__ __forceinline__ int tid_opaque() { int t = threadIdx.x; asm volatile("" : "+v"(t)); return t; }
__device__ __forceinline__ void lds_barrier() { asm volatile("s_waitcnt lgkmcnt(0)\n\ts_barrier" ::: "memory"); }
__device__ __forceinline__ void lds_fence() { asm volatile("s_waitcnt lgkmcnt(0)" ::: "memory"); }

__device__ __forceinline__ void transpose_convert(const float* __restrict__ W, int K, int N, int Npad, bf16_t* __restrict__ WT, float* tile,
                                  int bid, int nb) {
    const int tid = tid_opaque();
    const int tk = K / 64, tn = Npad / 64;
    for (int it = bid; it < tk * tn; it += nb) {
        const int kb = it / tn, nbk = it % tn, k0 = kb * 64, n0 = nbk * 64;
#pragma unroll
        for (int i = 0; i < 8; ++i) {
            const int r = (tid >> 6) + 8 * i, c = tid & 63, n = n0 + c;
            tile[r * 65 + c] = (n < N) ? W[(size_t)(k0 + r) * N + n] : 0.f;
        }
        __syncthreads();
        {
            const int rn = tid >> 3, c8 = (tid & 7) * 8;
            const float* tp = tile + c8 * 65 + rn;
            uint4 o;
            o.x = pk2(tp[0], tp[65]); o.y = pk2(tp[2 * 65], tp[3 * 65]); o.z = pk2(tp[4 * 65], tp[5 * 65]); o.w = pk2(tp[6 * 65], tp[7 * 65]);
            *(uint4*)(WT + (size_t)(n0 + rn) * K + k0 + c8) = o;
        }
        __syncthreads();
    }
}

__device__ __forceinline__ void phase_prologue(const Params& p, char* smem, int bid, int nb) {
    float* tile = (float*)smem;
    transpose_convert(p.gdn_w_in, D, GIN, GIN_PAD, p.wt_gin, tile, bid, nb);
    for (int idx = bid * NTHR + tid_opaque(); idx < LP * 24; idx += nb * NTHR) {
        const int pos = idx / 24, f = idx % 24;
        const int fi = (f < 16) ? f : (f - 16) * 2;
        const double rev = (double)pos * kInvFreq[fi] * 0.15915494309189535;
        const float r = (float)(rev - floor(rev));
        p.rope_tab[idx * 2] = __builtin_amdgcn_cosf(r);
        p.rope_tab[idx * 2 + 1] = __builtin_amdgcn_sinf(r);
    }
    for (int idx = bid * NTHR + tid_opaque(); idx < MPAD * 256; idx += nb * NTHR) {
        const int row = idx >> 8, c4 = (idx & 255) * 4;
        f32x4 v = {0.f, 0.f, 0.f, 0.f};
        if (row < NPR) {
            const int b = row / LP, t = row % LP;
            const float* src = (t < NMETA) ? (p.meta + (size_t)t * D) : (p.x_prompt + ((size_t)b * SEQ + (t - NMETA)) * D);
            v = *(const f32x4*)(src + c4);
        } else if (row < NT) {
            v = *(const f32x4*)(p.x_sample + (size_t)(row - NPR) * D + c4);
        }
        st_bf16x4(p.hA + (size_t)row * D + c4, v);
    }
}

template <class Epi>
__device__ __forceinline__ void gemm_phase(const bf16_t* __restrict__ A, int lda, const bf16_t* __restrict__ Bt, int K, int Mtiles, int Ntiles,
                           const Epi& epi, char* smem, int bid, int nb) {
    bf16_t* As = (bf16_t*)smem;
    bf16_t* Bs = As + 256 * 72;
    const int tid = tid_opaque(), lane = tid & 63, wave = tid >> 6;
    const int wm = wave >> 1, wn = wave & 1;
    const int fr = lane & 15, fq = lane >> 4;
    const int ntiles = Mtiles * Ntiles;
    const int nk = K / 64;
    for (int tile = bid; tile < ntiles; tile += nb) {
        const int tm = tile % Mtiles, tn = tile / Mtiles;
        const bf16_t* Ag = A + (size_t)tm * 256 * lda;
        const bf16_t* Bg = Bt + (size_t)tn * 128 * K;
        f32x4 acc[4][4];
#pragma unroll
        for (int i = 0; i < 4; ++i)
#pragma unroll
            for (int j = 0; j < 4; ++j) acc[i][j] = (f32x4){0.f, 0.f, 0.f, 0.f};
        const int c0 = tid, c1 = tid + 512, c2 = tid + 1024, c3 = tid + 1536;
        const bf16_t* ga0 = Ag + (size_t)(c0 >> 3) * lda + (c0 & 7) * 8;
        const bf16_t* ga1 = Ag + (size_t)(c1 >> 3) * lda + (c1 & 7) * 8;
        const bf16_t* ga2 = Ag + (size_t)(c2 >> 3) * lda + (c2 & 7) * 8;
        const bf16_t* ga3 = Ag + (size_t)(c3 >> 3) * lda + (c3 & 7) * 8;
        const bf16_t* gb0 = Bg + (size_t)(c0 >> 3) * K + (c0 & 7) * 8;
        const bf16_t* gb1 = Bg + (size_t)(c1 >> 3) * K + (c1 & 7) * 8;
        bf16_t* sa0 = As + (c0 >> 3) * 72 + (c0 & 7) * 8;
        bf16_t* sa1 = As + (c1 >> 3) * 72 + (c1 & 7) * 8;
        bf16_t* sa2 = As + (c2 >> 3) * 72 + (c2 & 7) * 8;
        bf16_t* sa3 = As + (c3 >> 3) * 72 + (c3 & 7) * 8;
        bf16_t* sb0 = Bs + (c0 >> 3) * 72 + (c0 & 7) * 8;
        bf16_t* sb1 = Bs + (c1 >> 3) * 72 + (c1 & 7) * 8;
        uint4 ra0 = *(const uint4*)ga0, ra1 = *(const uint4*)ga1, ra2 = *(const uint4*)ga2, ra3 = *(const uint4*)ga3;
        uint4 rb0 = *(const uint4*)gb0, rb1 = *(const uint4*)gb1;
        *(uint4*)sa0 = ra0; *(uint4*)sa1 = ra1; *(uint4*)sa2 = ra2; *(uint4*)sa3 = ra3; *(uint4*)sb0 = rb0; *(uint4*)sb1 = rb1;
        __syncthreads();
        for (int kt = 0; kt < nk; ++kt) {
            const bool more = (kt + 1 < nk);
            if (more) {
                const int k0 = (kt + 1) * 64;
                ra0 = *(const uint4*)(ga0 + k0); ra1 = *(const uint4*)(ga1 + k0); ra2 = *(const uint4*)(ga2 + k0); ra3 = *(const uint4*)(ga3 + k0);
                rb0 = *(const uint4*)(gb0 + k0); rb1 = *(const uint4*)(gb1 + k0);
            }
#pragma unroll
            for (int kk = 0; kk < 2; ++kk) {
                bf16x8 af[4], bfr[4];
#pragma unroll
                for (int i = 0; i < 4; ++i) af[i] = *(const bf16x8*)(As + (wm * 64 + i * 16 + fr) * 72 + kk * 32 + fq * 8);
#pragma unroll
                for (int j = 0; j < 4; ++j) bfr[j] = *(const bf16x8*)(Bs + (wn * 64 + j * 16 + fr) * 72 + kk * 32 + fq * 8);
#pragma unroll
                for (int i = 0; i < 4; ++i)
#pragma unroll
                    for (int j = 0; j < 4; ++j) acc[i][j] = __builtin_amdgcn_mfma_f32_16x16x32_bf16(bfr[j], af[i], acc[i][j], 0, 0, 0);
            }
            __syncthreads();
            if (more) {
                *(uint4*)sa0 = ra0; *(uint4*)sa1 = ra1; *(uint4*)sa2 = ra2; *(uint4*)sa3 = ra3; *(uint4*)sb0 = rb0; *(uint4*)sb1 = rb1;
                __syncthreads();
            }
        }
#pragma unroll
        for (int i = 0; i < 4; ++i)
#pragma unroll
            for (int j = 0; j < 4; ++j) {
                const int row = tm * 256 + wm * 64 + i * 16 + fr, col = tn * 128 + wn * 64 + j * 16 + fq * 4;
                epi(row, col, acc[i][j]);
            }
    }
}

namespace pg8 {
#define PG8_LAS __attribute__((address_space(3)))
constexpr int BM = 256, BK = 64, HALF = 128, HTB = HALF * BK * 2  , STAGE_BYTES = 8 * HTB, NXCD = 8, WGM = 16;
__device__ __forceinline__ int lds_byte(int r, int c) { const int st = (r >> 4) * 2 + (c >> 5), rr = r & 15, cc = c & 31, ob = rr * 64 + cc * 2; return st * 1024 + (ob ^ (((ob >> 9) & 1) << 5)); }
__device__ __forceinline__ void stage_rc(int b, int& R, int& C) { const int st = b / 1024, sb = b % 1024, swz = sb ^ (((sb >> 9) & 1) << 5); R = (st >> 1) * 16 + swz / 64; C = (st & 1) * 32 + (swz % 64) / 2; }
__device__ __forceinline__ int perm32(int rho) { const int n = rho >> 4, i = rho & 15; return 8 * (i >> 2) + 4 * n + (i & 3); }
struct Unit { int pm, pn, pk; };
struct Gemm { const bf16_t* A; const bf16_t* Bt; int K; int splits; };
struct StaticOrder {
    int nM, nN, nNr, pm0, nwg, G, c;
    __device__ void init(int nM_, int nNr_, int splits, int pm0_, int G_, int c_) { nM = nM_; nNr = nNr_; nN = nNr_ * splits; pm0 = pm0_; nwg = nM * nN; G = G_; c = c_; }
    __device__ bool next(int i, Unit& u) const {
        const long L = (long)i * G + c; if (L >= nwg) return false;
        int wgid = (int)L; { const int q = nwg / NXCD, r = nwg % NXCD, xcd = wgid % NXCD, off = wgid / NXCD; wgid = (xcd < r ? xcd * (q + 1) : r * (q + 1) + (xcd - r) * q) + off; }
        const int nig = WGM * nN, gid = wgid / nig, fm = gid * WGM, gsz = (nM - fm) < WGM ? (nM - fm) : WGM;
        const int pnv = (wgid % nig) / gsz;
        u.pm = pm0 + fm + ((wgid % nig) % gsz); u.pn = pnv % nNr; u.pk = pnv / nNr; return true;
    }
};
template <class Epi>
__device__ __forceinline__ void gemm_phase(PG8_LAS unsigned char* lds, const Gemm g, const StaticOrder& S, const Epi& E) {
    const int tid = tid_opaque(), wid = __builtin_amdgcn_readfirstlane(tid >> 6), lane = tid & 63, wr = wid >> 2, wc = wid & 3, fr = lane & 15, fq = lane >> 4;
    const int K = g.K, Kp = K / g.splits, nt = Kp / BK;
    unsigned voffA[2], voffB[2];
#pragma unroll
    for (int i = 0; i < 2; ++i) { int R, C; stage_rc(tid * 16 + i * 8192, R, C); const int Rb = (R & ~31) + perm32(R & 31);
        voffA[i] = (unsigned)(R * K + C) * 2u; voffB[i] = (unsigned)(Rb * K + C) * 2u; }
    const size_t kstep = (size_t)(BK * 2);
    const size_t hstep = (size_t)HALF * K * 2;
    const size_t tstep = 2 * hstep;
    const size_t pstep = (size_t)Kp * 2;
    const unsigned ldsw = (unsigned)wid * 1024u;
    const int aoff = lds_byte(wr * 64 + fr, fq * 8), boff = lds_byte(wc * 32 + fr, fq * 8);
#define PG8_SA(b, h) (((b) * 2 + (h)) * HTB)
#define PG8_SB(b, h) ((4 + (b) * 2 + (h)) * HTB)
#define PG8_STAGE(bufoff, gbase, voff) do { _Pragma("unroll") for (int _i = 0; _i < 2; ++_i) \
        __builtin_amdgcn_global_load_lds((const unsigned*)((const char*)(gbase) + (voff)[_i]), (PG8_LAS unsigned*)(lds + (bufoff) + ldsw + _i * 8192), 16, 0, 0); } while (0)
#define PG8_LDA(dst, b, h) do { _Pragma("unroll") for (int m = 0; m < 4; ++m) _Pragma("unroll") for (int k = 0; k < 2; ++k) dst[m][k] = *(const PG8_LAS bf16x8*)(lds + PG8_SA(b, h) + aoff + m * 2048 + k * 1024); } while (0)
#define PG8_LDB(dst, b, h) do { _Pragma("unroll") for (int n = 0; n < 2; ++n) _Pragma("unroll") for (int k = 0; k < 2; ++k) dst[n][k] = *(const PG8_LAS bf16x8*)(lds + PG8_SB(b, h) + boff + n * 2048 + k * 1024); } while (0)
#define PG8_MMA(ai, bj, At, Bt) do { __builtin_amdgcn_s_setprio(1); _Pragma("unroll") for (int m = 0; m < 4; ++m) _Pragma("unroll") for (int n = 0; n < 2; ++n) _Pragma("unroll") for (int k = 0; k < 2; ++k) \
        acc[ai][bj][m][n] = __builtin_amdgcn_mfma_f32_16x16x32_bf16(Bt[n][k], At[m][k], acc[ai][bj][m][n], 0, 0, 0); __builtin_amdgcn_s_setprio(0); } while (0)
#define PG8_WAIT_V(n) asm volatile("s_waitcnt vmcnt(" #n ")" ::: "memory")
#define PG8_WAIT_L(n) asm volatile("s_waitcnt lgkmcnt(" #n ")" ::: "memory")
#define PG8_BAR __builtin_amdgcn_s_barrier()
#define PG8_SCHED __builtin_amdgcn_sched_barrier(0)
    Unit cur, nxt; int ui = 0;
    if (!S.next(0, cur)) return;
    f32x4 acc[2][2][4][2];
#pragma unroll
    for (int a = 0; a < 2; ++a)
#pragma unroll
        for (int b = 0; b < 2; ++b)
#pragma unroll
            for (int m = 0; m < 4; ++m)
#pragma unroll
                for (int n = 0; n < 2; ++n) acc[a][b][m][n] = (f32x4){0.f, 0.f, 0.f, 0.f};
    bf16x8 At[4][2], B0[2][2], B1[2][2];
    const char* cA = (const char*)g.A + (size_t)cur.pm * tstep + (size_t)cur.pk * pstep; const char* cB = (const char*)g.Bt + (size_t)cur.pn * tstep + (size_t)cur.pk * pstep;
    PG8_STAGE(PG8_SB(0, 0), cB, voffB); PG8_STAGE(PG8_SA(0, 0), cA, voffA); PG8_STAGE(PG8_SB(0, 1), cB + hstep, voffB); PG8_STAGE(PG8_SA(0, 1), cA + hstep, voffA);
    if (wr == 1) PG8_BAR;
    PG8_WAIT_V(4); PG8_BAR;
    PG8_STAGE(PG8_SB(1, 0), cB + kstep, voffB); PG8_STAGE(PG8_SA(1, 0), cA + kstep, voffA); PG8_STAGE(PG8_SB(1, 1), cB + hstep + kstep, voffB);
    PG8_WAIT_V(6); PG8_BAR;
    for (;;) {
        const bool has_next = S.next(ui + 1, nxt);
        const char* nA = has_next ? (const char*)g.A + (size_t)nxt.pm * tstep + (size_t)nxt.pk * pstep : cA; const char* nB = has_next ? (const char*)g.Bt + (size_t)nxt.pn * tstep + (size_t)nxt.pk * pstep : cB;
        for (int t = 0; t < nt; t += 2) {
            const bool last = (t == nt - 2);
            const char* a1 = cA + (size_t)(t + 1) * kstep;
            const char* a2 = last ? nA : cA + (size_t)(t + 2) * kstep; const char* b2 = last ? nB : cB + (size_t)(t + 2) * kstep;
            const char* a3 = a2 + kstep; const char* b3 = b2 + kstep;
            PG8_LDB(B0, 0, 0); PG8_SCHED; PG8_LDA(At, 0, 0); PG8_STAGE(PG8_SA(1, 1), a1 + hstep, voffA);
            PG8_WAIT_L(8); PG8_BAR; PG8_WAIT_L(0); PG8_MMA(0, 0, At, B0); PG8_BAR; PG8_SCHED;
            PG8_LDB(B1, 0, 1); PG8_STAGE(PG8_SB(0, 0), b2, voffB);
            PG8_BAR; PG8_WAIT_L(0); PG8_MMA(0, 1, At, B1); PG8_BAR;
            PG8_LDA(At, 0, 1); PG8_STAGE(PG8_SA(0, 0), a2, voffA);
            PG8_BAR; PG8_WAIT_L(0); PG8_MMA(1, 0, At, B0); PG8_BAR; PG8_SCHED;
            PG8_STAGE(PG8_SB(0, 1), b2 + hstep, voffB);
            PG8_WAIT_V(6); PG8_BAR; PG8_MMA(1, 1, At, B1); PG8_BAR;
            PG8_LDB(B0, 1, 0); PG8_SCHED; PG8_LDA(At, 1, 0); PG8_STAGE(PG8_SA(0, 1), a2 + hstep, voffA);
            PG8_WAIT_L(8); PG8_BAR; PG8_WAIT_L(0); PG8_MMA(0, 0, At, B0); PG8_BAR; PG8_SCHED;
            PG8_LDB(B1, 1, 1); PG8_STAGE(PG8_SB(1, 0), b3, voffB);
            PG8_BAR; PG8_WAIT_L(0); PG8_MMA(0, 1, At, B1); PG8_BAR;
            PG8_LDA(At, 1, 1); PG8_STAGE(PG8_SA(1, 0), a3, voffA);
            PG8_BAR; PG8_WAIT_L(0); PG8_MMA(1, 0, At, B0); PG8_BAR; PG8_SCHED;
            PG8_STAGE(PG8_SB(1, 1), b3 + hstep, voffB);
            PG8_WAIT_V(6); PG8_BAR; PG8_MMA(1, 1, At, B1); PG8_BAR;
        }
#pragma unroll
        for (int ai = 0; ai < 2; ++ai)
#pragma unroll
            for (int m = 0; m < 4; ++m)
#pragma unroll
                for (int bj = 0; bj < 2; ++bj)
                    E(cur.pm * BM + ai * HALF + wr * 64 + m * 16 + fr, cur.pn * BM + bj * HALF + wc * 32 + 8 * fq, acc[ai][bj][m][0], acc[ai][bj][m][1], cur.pk);
        if (!has_next) break;
#pragma unroll
        for (int a = 0; a < 2; ++a)
#pragma unroll
            for (int b = 0; b < 2; ++b)
#pragma unroll
                for (int m = 0; m < 4; ++m)
#pragma unroll
                    for (int n = 0; n < 2; ++n) acc[a][b][m][n] = (f32x4){0.f, 0.f, 0.f, 0.f};
        cur = nxt; cA = nA; cB = nB; ++ui;
    }
    PG8_WAIT_V(0);
    if (wr == 0) PG8_BAR;
    PG8_BAR;
#undef PG8_SA
#undef PG8_SB
#undef PG8_STAGE
#undef PG8_LDA
#undef PG8_LDB
#undef PG8_MMA
#undef PG8_WAIT_V
#undef PG8_WAIT_L
#undef PG8_BAR
#undef PG8_SCHED
}
}

template <class Epi>
__device__ __forceinline__ void gemm_big(const bf16_t* A, int K, const bf16_t* Bt, int Npad, const Epi& e, char* smem, int bid, int nb) {
    pg8::StaticOrder S; S.init(MPAD / 256, Npad / 256, 1, 0, nb, bid);
    pg8::gemm_phase((PG8_LAS unsigned char*)smem, pg8::Gemm{A, Bt, K, 1}, S, e);
}
template <class Epi1, class Epi2>
__device__ __forceinline__ void gemm_n1024(const bf16_t* A, int K, const bf16_t* Bt, const Epi1& e1, const Epi2& e2, int splits, char* smem, int bid, int nb) {
    pg8::StaticOrder S; S.init(64, 4, 1, 0, nb, bid);
    pg8::gemm_phase((PG8_LAS unsigned char*)smem, pg8::Gemm{A, Bt, K, 1}, S, e1);
    pg8::StaticOrder S2; S2.init(3, 4, splits, 64, nb, bid);
    pg8::gemm_phase((PG8_LAS unsigned char*)smem, pg8::Gemm{A, Bt, K, splits}, S2, e2);
}

__device__ __forceinline__ void st_bf16x8(bf16_t* p, f32x4 a, f32x4 b) {
    u32x4 w; w[0] = pk2(a[0], a[1]); w[1] = pk2(a[2], a[3]); w[2] = pk2(b[0], b[1]); w[3] = pk2(b[2], b[3]);
    *(u32x4*)p = w;
}
struct EpiGdnIn {
    bf16_t *mixed, *z; float* ba;
    __device__ __forceinline__ void operator()(int row, int col, f32x4 v0, f32x4 v1, int = 0) const {
        if (col < 4096) st_bf16x8(mixed + (size_t)row * 4096 + col, v0, v1);
        else if (col < 6144) st_bf16x8(z + (size_t)row * 2048 + (col - 4096), v0, v1);
        else if (col < 6176) { *(f32x4*)(ba + (size_t)row * 32 + (col - 6144)) = v0; *(f32x4*)(ba + (size_t)row * 32 + (col - 6144) + 4) = v1; }
    }
};
struct EpiResid {
    float* out; const bf16_t* h;
    __device__ __forceinline__ void operator()(int row, int col, f32x4 v0, f32x4 v1, int = 0) const {
        const uint4 hr = *(const uint4*)(h + (size_t)row * D + col);
        const f32x4 r0 = cvt_bf16x4(make_uint2(hr.x, hr.y)), r1 = cvt_bf16x4(make_uint2(hr.z, hr.w));
        st_bf16x8((bf16_t*)out + (size_t)row * D + col, v0 + r0 * ALPHA, v1 + r1 * ALPHA);
    }
};
struct EpiSlab {
    float* slab;
    __device__ __forceinline__ void operator()(int row, int col, f32x4 v0, f32x4 v1, int pk) const {
        st_bf16x8((bf16_t*)slab + ((size_t)pk * 768 + (row - 16384)) * D + col, v0, v1);
    }
};
struct EpiRelu2 {
    bf16_t* act;
    __device__ __forceinline__ void operator()(int row, int col, f32x4 v0, f32x4 v1, int = 0) const {
#pragma unroll
        for (int e = 0; e < 4; ++e) { const float r = fmaxf(v0[e], 0.f); v0[e] = r * r; const float q = fmaxf(v1[e], 0.f); v1[e] = q * q; }
        st_bf16x8(act + (size_t)row * DFF + col, v0, v1);
    }
};
struct EpiBf16 {
    bf16_t* out; int ld;
    __device__ __forceinline__ void operator()(int row, int col, f32x4 v0, f32x4 v1, int = 0) const { st_bf16x8(out + (size_t)row * ld + col, v0, v1); }
};

__device__ __forceinline__ void ln_phase(const float* X, const float* __restrict__ g, const float* __restrict__ bta, bf16_t* Hout,
                         float* yp, float* ys, const float* slab, int splits, const bf16_t* hres, int bid, int nb) {
    const int tid_ = tid_opaque(); const int lane = tid_ & 63, wave = tid_ >> 6;
    f32x4 gv[4], bv[4];
#pragma unroll
    for (int j = 0; j < 4; ++j) { gv[j] = *(const f32x4*)(g + j * 256 + lane * 4); bv[j] = *(const f32x4*)(bta + j * 256 + lane * 4); }
    for (int row = bid * 8 + wave; row < NT; row += nb * 8) {
        f32x4 v[4]; float s = 0.f;
        if (row < 16384) {
#pragma unroll
            for (int j = 0; j < 4; ++j) v[j] = ld_bf16x4((const bf16_t*)X + (size_t)row * D + j * 256 + lane * 4);
        } else {
#pragma unroll
            for (int j = 0; j < 4; ++j) v[j] = ld_bf16x4(hres + (size_t)row * D + j * 256 + lane * 4) * ALPHA;
            for (int pk = 0; pk < splits; ++pk) {
                const bf16_t* sp = (const bf16_t*)slab + ((size_t)pk * 768 + (row - 16384)) * D + lane * 4;
#pragma unroll
                for (int j = 0; j < 4; ++j) v[j] += ld_bf16x4(sp + j * 256);
            }
        }
#pragma unroll
        for (int j = 0; j < 4; ++j) s += (v[j][0] + v[j][1]) + (v[j][2] + v[j][3]);
        const float mean = wave_sum(s) * (1.f / D);
        float s2 = 0.f;
#pragma unroll
        for (int j = 0; j < 4; ++j) { v[j] = v[j] - mean; s2 += (v[j][0] * v[j][0] + v[j][1] * v[j][1]) + (v[j][2] * v[j][2] + v[j][3] * v[j][3]); }
        const float rstd = rsqrtf(wave_sum(s2) * (1.f / D) + 1e-5f);
        float* yo = nullptr;
        if (yp) {
            if (row < NPR) { const int b = row / LP, t = row % LP; if (t >= NMETA) yo = yp + ((size_t)b * SEQ + (t - NMETA)) * D; }
            else yo = ys + (size_t)(row - NPR) * D;
        }
#pragma unroll
        for (int j = 0; j < 4; ++j) {
            const f32x4 o = v[j] * rstd * gv[j] + bv[j];
            if (Hout) st_bf16x4(Hout + (size_t)row * D + j * 256 + lane * 4, o);
            if (yo) *(f32x4*)(yo + j * 256 + lane * 4) = o;
        }
    }
}

__device__ __forceinline__ void gdn_sample_pass(const Params& p, char* smem, int pass, int tid) {
    float* sq = (float*)smem;
    float* sk = sq + 256;
    float* part = sk + 256;
    float* part2 = part + 16;
    const int lane = tid & 63, wave = tid >> 6, ug = wave >> 2, wq = wave & 3;
    const int half = lane >> 5, v = wq * 32 + (lane & 31);
    const int u = pass * 2 + ug, b = u >> 4, h = u & 15, kh = h >> 1;
    const size_t row0 = (size_t)NPR + (size_t)b * DS;
    float S[64];
    {
        const float* Sp = p.state_gdn + ((size_t)(b * 16 + h) * 128 + half * 64) * 128 + v;
#pragma unroll
        for (int k = 0; k < 64; ++k) S[k] = Sp[(size_t)k * 128];
    }
    const float Aexp = __expf(p.gdn_a_log[h]);
    const float dtb = p.gdn_dt_bias[h];
    const float nw = p.gdn_norm_w[v];
    const int chA = (half ? 1024 : 0) + kh * 128 + v, chv = 2048 + h * 128 + v;
    float cA[4], cv[4];
#pragma unroll
    for (int j = 0; j < 4; ++j) { cA[j] = p.gdn_conv_w[j * 4096 + chA]; cv[j] = p.gdn_conv_w[j * 4096 + chv]; }
    float xA[7], xv[7];
#pragma unroll
    for (int i = 0; i < 3; ++i) {
        const float* cs = p.state_conv + ((size_t)b * 3 + i) * 4096;
        xA[i] = cs[chA]; xv[i] = cs[chv];
    }
#pragma unroll
    for (int i = 0; i < 4; ++i) {
        const bf16_t* mr = p.mixed + (row0 + i) * 4096;
        xA[3 + i] = bf2f(mr[chA]); xv[3 + i] = bf2f(mr[chv]);
    }
    float* sqg = sq + ug * 128;
    float* skg = sk + ug * 128;
    float* pg = part + ug * 8;
    float* pg2 = part2 + ug * 4;
    const float* kmine = skg + half * 64;
    const float* qmine = sqg + half * 64;
#pragma unroll
    for (int t = 0; t < DS; ++t) {
        const float yA = silu(xA[t] * cA[0] + xA[t + 1] * cA[1] + xA[t + 2] * cA[2] + xA[t + 3] * cA[3]);
        const float yv = silu(xv[t] * cv[0] + xv[t + 1] * cv[1] + xv[t + 2] * cv[2] + xv[t + 3] * cv[3]);
        (half ? skg : sqg)[v] = yA;
        float ssA = yA * yA;
#pragma unroll
        for (int o = 1; o < 32; o <<= 1) ssA += __shfl_xor(ssA, o);
        if ((lane & 31) == 0) pg[wq * 2 + half] = ssA;
        lds_barrier();
        const float qn = rsqrtf((pg[0] + pg[2]) + (pg[4] + pg[6]) + 1e-6f) * 0.08838834764831845f;
        const float kn = rsqrtf((pg[1] + pg[3]) + (pg[5] + pg[7]) + 1e-6f);
        const float* bap = p.ba + (row0 + t) * 32;
        const float beta = 1.f / (1.f + __expf(-bap[h]));
        const float aa = bap[16 + h] + dtb;
        const float sp = (aa > 20.f) ? aa : log1pf(__expf(aa));
        const float dec = __expf(-Aexp * sp);
        float kS0 = 0.f, kS1 = 0.f;
#pragma unroll
        for (int k = 0; k < 64; k += 4) {
            const f32x4 kk = *(const f32x4*)(kmine + k);
            S[k] *= dec; S[k + 1] *= dec; S[k + 2] *= dec; S[k + 3] *= dec;
            kS0 += kk[0] * S[k]; kS1 += kk[1] * S[k + 1]; kS0 += kk[2] * S[k + 2]; kS1 += kk[3] * S[k + 3];
        }
        float kS = kS0 + kS1;
        kS += __shfl_xor(kS, 32);
        const float delta = (yv - kS * kn) * beta * kn;
        float o0 = 0.f, o1 = 0.f;
#pragma unroll
        for (int k = 0; k < 64; k += 4) {
            const f32x4 kk = *(const f32x4*)(kmine + k);
            const f32x4 qq = *(const f32x4*)(qmine + k);
            S[k] += kk[0] * delta; S[k + 1] += kk[1] * delta; S[k + 2] += kk[2] * delta; S[k + 3] += kk[3] * delta;
            o0 += qq[0] * S[k]; o1 += qq[1] * S[k + 1]; o0 += qq[2] * S[k + 2]; o1 += qq[3] * S[k + 3];
        }
        float o = o0 + o1;
        o = (o + __shfl_xor(o, 32)) * qn;
        float s3 = o * o;
#pragma unroll
        for (int x = 1; x < 32; x <<= 1) s3 += __shfl_xor(s3, x);
        if (lane == 0) pg2[wq] = s3;
        lds_barrier();
        if (half == 0) {
            const float rms = rsqrtf(((pg2[0] + pg2[1]) + (pg2[2] + pg2[3])) * (1.f / 128.f) + 1e-6f);
            const float zz = bf2f(p.z[(row0 + t) * 2048 + h * 128 + v]);
            p.gated[(row0 + t) * 2048 + h * 128 + v] = f2bf(o * rms * nw * silu(zz));
        }
    }
    {
        float* So = p.gs_sample + ((size_t)(b * 16 + h) * 128 + half * 64) * 128 + v;
#pragma unroll
        for (int k = 0; k < 64; ++k) So[(size_t)k * 128] = S[k];
    }
    lds_barrier();
}

#define MFMA32(a, b, c) __builtin_amdgcn_mfma_f32_32x32x16_bf16((a), (b), (c), 0, 0, 0)
constexpr int NCH = 65;
constexpr int NCU = BATCH * 16 * NCH;
__device__ __forceinline__ int crow(int reg, int hh) { return (reg & 3) + 8 * (reg >> 2) + 4 * hh; }
__device__ __forceinline__ bf16x8 pack_step(const f32x16& x, int s) {
    u32x4 q;
    q[0] = pk2(x[8 * s + 0], x[8 * s + 1]); q[1] = pk2(x[8 * s + 2], x[8 * s + 3]);
    q[2] = pk2(x[8 * s + 4], x[8 * s + 5]); q[3] = pk2(x[8 * s + 6], x[8 * s + 7]);
    return __builtin_bit_cast(bf16x8, q);
}
__device__ __forceinline__ bf16x8 frag_perm(const bf16_t* p0) {
    const uint2 lo = *(const uint2*)p0, hi = *(const uint2*)(p0 + 8);
    u32x4 q; q[0] = lo.x; q[1] = lo.y; q[2] = hi.x; q[3] = hi.y;
    return __builtin_bit_cast(bf16x8, q);
}

constexpr int SA_KB = 64 * 136 * 2, SA_VB = 2 * SA_KB, SA_AM = 3 * SA_KB, SA_SM = SA_AM + 64 * 68 * 4, SA_GROUP_BYTES = SA_SM + 5 * 64 * 4;
__device__ __forceinline__ void gdn_stageA(const Params& p, char* smem0, int bid, int nb) {
    {
        const int tid = tid_opaque();
        for (int idx = bid * NTHR + tid; idx < (BATCH + DB) * 3 * 4096; idx += nb * NTHR) {
            const int c = idx & 4095, r = (idx >> 12) % 3, b = idx / (3 * 4096);
            if (b < BATCH) p.gc_prompt[idx] = bf2f(p.mixed[((size_t)b * LP + (LP - 3) + r) * 4096 + c]);
            else { const int bs = b - BATCH; p.gc_sample[(size_t)(bs * 3 + r) * 4096 + c] = bf2f(p.mixed[((size_t)NPR + bs * 4 + 1 + r) * 4096 + c]); }
        }
    }
    for (int base = bid * 2; base < NCU; base += nb * 2) {
        const int tid = tid_opaque(), lane = tid & 63, grp = tid >> 8, wg = (tid >> 6) & 3, t2 = tid & 255;
        unsigned zofs = 0; asm volatile("" : "+v"(zofs));
        char* smem = smem0 + zofs + grp * SA_GROUP_BYTES;
        bf16_t* Qb = (bf16_t*)smem;
        bf16_t* Kb = (bf16_t*)(smem + SA_KB);
        bf16_t* Vb = (bf16_t*)(smem + SA_VB);
        float* Am = (float*)(smem + SA_AM);
        float* sbeta = (float*)(smem + SA_SM);
        float* sgc = sbeta + 64;
        float* segc = sgc + 64;
        float* sekd = segc + 64;
        float* srk = sekd + 64;
        const int u = base + grp;
        const bool tail = base >= 4096;
        const int h = u & 15, n = tail ? 64 : ((u >> 4) & 63), b = tail ? ((u - 4096) >> 4) : (u >> 10);
        const int kh = h >> 1;
        const size_t su = (size_t)((b * 16 + h) * NCH + n);
        const int t0 = n * 64;
        if (tail && wg > 0) {
            const int cq = lane & 31, tsel = lane >> 5;
            const int tl0 = 16 * wg + 8 * tsel;
#pragma unroll
            for (int i = 0; i < 8; ++i) {
                *(uint2*)(Qb + (tl0 + i) * 136 + cq * 4) = make_uint2(0u, 0u);
                *(uint2*)(Kb + (tl0 + i) * 136 + cq * 4) = make_uint2(0u, 0u);
                *(uint2*)(Vb + (tl0 + i) * 136 + cq * 4) = make_uint2(0u, 0u);
            }
        } else {
            const int cq = lane & 31, tsel = lane >> 5;
            const int tl0 = 16 * wg + 8 * tsel;
#pragma unroll
            for (int pp = 0; pp < 2; ++pp) {
                const int part = pp ? 2 : grp;
                const int chb = ((part == 0) ? (kh * 128) : (part == 1) ? (1024 + kh * 128) : (2048 + h * 128)) + cq * 4;
                f32x4 cw[4];
#pragma unroll
                for (int j = 0; j < 4; ++j) cw[j] = *(const f32x4*)(p.gdn_conv_w + j * 4096 + chb);
                uint2 xr[11];
#pragma unroll
                for (int i = 0; i < 11; ++i) {
                    const int t = t0 + tl0 - 3 + i;
                    if (t >= 0 && t < LP) xr[i] = *(const uint2*)(p.mixed + ((size_t)b * LP + t) * 4096 + chb);
                    else xr[i] = make_uint2(0u, 0u);
                }
                f32x4 yv[8];
                float ssv[8];
#pragma unroll
                for (int i = 0; i < 8; ++i) {
                    const f32x4 a = cvt_bf16x4(xr[i]) * cw[0] + cvt_bf16x4(xr[i + 1]) * cw[1] + cvt_bf16x4(xr[i + 2]) * cw[2] + cvt_bf16x4(xr[i + 3]) * cw[3];
                    const bool valid = (t0 + tl0 + i) < LP;
#pragma unroll
                    for (int e2 = 0; e2 < 4; ++e2) yv[i][e2] = valid ? silu(a[e2]) : 0.f;
                    ssv[i] = (yv[i][0] * yv[i][0] + yv[i][1] * yv[i][1]) + (yv[i][2] * yv[i][2] + yv[i][3] * yv[i][3]);
                }
                if (part < 2) {
#pragma unroll
                    for (int o = 1; o < 32; o <<= 1)
#pragma unroll
                        for (int i = 0; i < 8; ++i) ssv[i] += __shfl_xor(ssv[i], o);
                }
                bf16_t* dst = (part == 0) ? Qb : (part == 1) ? Kb : Vb;
                bf16_t* dst2 = (bf16_t*)((char*)dst + (grp ? -SA_GROUP_BYTES : SA_GROUP_BYTES));
#pragma unroll
                for (int i = 0; i < 8; ++i) {
                    f32x4 y = yv[i];
                    if (part < 2) y = y * (rsqrtf(ssv[i] + 1e-6f) * ((part == 0) ? 0.08838834764831845f : 1.f));
                    st_bf16x4(dst + (tl0 + i) * 136 + cq * 4, y);
                    if (part < 2) st_bf16x4(dst2 + (tl0 + i) * 136 + cq * 4, y);
                }
            }
        }
        if (wg == 0) {
            const int c = lane, t = t0 + c;
            float beta = 0.f, g = 0.f;
            if (t < LP) {
                const float* bap = p.ba + ((size_t)b * LP + t) * 32;
                beta = 1.f / (1.f + __expf(-bap[h]));
                const float aa = bap[16 + h] + p.gdn_dt_bias[h];
                const float sp = (aa > 20.f) ? aa : log1pf(__expf(aa));
                g = -__expf(p.gdn_a_log[h]) * sp;
            }
            float gc = g;
#pragma unroll
            for (int o = 1; o < 64; o <<= 1) { const float v = __shfl_up(gc, o); if (lane >= o) gc += v; }
            const float glast = __shfl(gc, 63);
            sbeta[c] = beta; sgc[c] = gc; segc[c] = __expf(gc); sekd[c] = __expf(glast - gc); srk[c] = beta * __expf(gc);
            if (lane == 0) p.g_dec[su] = __expf(glast);
        }
        lds_barrier();
        {
            const int ti = wg >> 1, tj = wg & 1;
            const int r = lane & 31, hh = lane >> 5;
            const int c = 32 * tj + r;
            const float gcc = sgc[c], bc = sbeta[c];
            f32x16 acck, accq;
#pragma unroll
            for (int i = 0; i < 16; ++i) { acck[i] = 0.f; accq[i] = 0.f; }
            {
                const bf16_t* Ap = Kb + (32 * ti + r) * 136 + 8 * hh;
                const bf16_t* Bk = Kb + (32 * tj + r) * 136 + 8 * hh;
                const bf16_t* Bq = Qb + (32 * tj + r) * 136 + 8 * hh;
#pragma unroll
                for (int ks = 0; ks < 8; ++ks) {
                    const bf16x8 a = *(const bf16x8*)(Ap + 16 * ks);
                    acck = MFMA32(a, *(const bf16x8*)(Bk + 16 * ks), acck);
                    accq = MFMA32(a, *(const bf16x8*)(Bq + 16 * ks), accq);
                }
            }
#pragma unroll
            for (int reg = 0; reg < 16; ++reg) {
                const int cp = 32 * ti + crow(reg, hh);
                const float dcy = __expf(fminf(gcc - sgc[cp], 0.f));
                Am[(c >> 1) * 136 + cp * 2 + (c & 1)] = (cp < c) ? (bc * acck[reg] * dcy) : 0.f;
            }
            {
                bf16_t* aq = p.g_aqk + su * 4096 + (size_t)(((ti * 2 + tj) * 4) * 2 * 32) * 4 + (size_t)(hh * 32 + r) * 4;
#pragma unroll
                for (int g4 = 0; g4 < 4; ++g4) {
                    const int cp0 = 32 * ti + 8 * g4 + 4 * hh;
                    f32x4 v;
#pragma unroll
                    for (int e2 = 0; e2 < 4; ++e2) {
                        const int cp = cp0 + e2;
                        const float dcy = __expf(fminf(gcc - sgc[cp], 0.f));
                        v[e2] = (cp <= c) ? (accq[4 * g4 + e2] * dcy) : 0.f;
                    }
                    st_bf16x4(aq + (size_t)g4 * (2 * 32 * 4), v);
                }
            }
        }
        {
#pragma unroll
            for (int it = 0; it < 4; ++it) {
                const int chk = t2 + 256 * it, c = chk >> 4, d0 = (chk & 15) * 8;
                const float ee = segc[c];
                const uint4 raw = *(const uint4*)(Qb + c * 136 + d0);
                uint4 o;
                o.x = pk2(__uint_as_float(raw.x << 16) * ee, __uint_as_float(raw.x & 0xffff0000u) * ee);
                o.y = pk2(__uint_as_float(raw.y << 16) * ee, __uint_as_float(raw.y & 0xffff0000u) * ee);
                o.z = pk2(__uint_as_float(raw.z << 16) * ee, __uint_as_float(raw.z & 0xffff0000u) * ee);
                o.w = pk2(__uint_as_float(raw.w << 16) * ee, __uint_as_float(raw.w & 0xffff0000u) * ee);
                *(uint4*)(p.g_qg + su * 8192 + c * 128 + d0) = o;
            }
#pragma unroll
            for (int it = 0; it < 4; ++it) {
                const int item = t2 + 256 * it, d = item & 127, c0 = (item >> 7) * 8;
                float v[8];
#pragma unroll
                for (int i = 0; i < 8; ++i) v[i] = bf2f(Kb[(c0 + i) * 136 + d]) * sekd[c0 + i];
                uint4 o; o.x = pk2(v[0], v[1]); o.y = pk2(v[2], v[3]); o.z = pk2(v[4], v[5]); o.w = pk2(v[6], v[7]);
                *(uint4*)(p.g_kdT + su * 8192 + (size_t)item * 8) = o;
            }
        }
        lds_barrier();
        {
            const int col = 64 * wg + lane;
            const float* rs = sbeta + __builtin_amdgcn_readfirstlane((wg < 2) ? 0 : 256);
            const bf16_t* src = ((wg < 2) ? Vb : Kb) + (col & 127);
            float x[64];
#pragma unroll
            for (int i = 0; i < 64; ++i) x[i] = bf2f(src[i * 136]) * rs[i];
#pragma unroll
            for (int i0 = 0; i0 < 64; i0 += 4) {
                if (tail && i0 >= 16) continue;
                f32x2 a01 = {x[i0], x[i0 + 1]}, a23 = {x[i0 + 2], x[i0 + 3]};
                const float* P0 = Am + (i0 >> 1) * 136;
                const float* P1 = P0 + 136;
#pragma unroll
                for (int j4 = 0; j4 < i0; j4 += 4) {
                    const f32x4 q0 = *(const f32x4*)(P0 + 2 * j4), q1 = *(const f32x4*)(P0 + 2 * j4 + 4);
                    const f32x4 q2 = *(const f32x4*)(P1 + 2 * j4), q3 = *(const f32x4*)(P1 + 2 * j4 + 4);
                    a01 -= (f32x2){q0[0], q0[1]} * x[j4]; a23 -= (f32x2){q2[0], q2[1]} * x[j4];
                    a01 -= (f32x2){q0[2], q0[3]} * x[j4 + 1]; a23 -= (f32x2){q2[2], q2[3]} * x[j4 + 1];
                    a01 -= (f32x2){q1[0], q1[1]} * x[j4 + 2]; a23 -= (f32x2){q3[0], q3[1]} * x[j4 + 2];
                    a01 -= (f32x2){q1[2], q1[3]} * x[j4 + 3]; a23 -= (f32x2){q3[2], q3[3]} * x[j4 + 3];
                    if ((j4 & 12) == 12) asm volatile("" ::: "memory");
                }
                const f32x4 l0 = *(const f32x4*)(P0 + 2 * i0), l1 = *(const f32x4*)(P1 + 2 * i0), l2 = *(const f32x4*)(P1 + 2 * i0 + 4);
                const float a0 = a01[0];
                const float a1 = a01[1] - l0[1] * a0;
                const float a2 = a23[0] - l1[0] * a0 - l1[2] * a1;
                const float a3 = a23[1] - l1[1] * a0 - l1[3] * a1 - l2[1] * a2;
                x[i0] = a0; x[i0 + 1] = a1; x[i0 + 2] = a2; x[i0 + 3] = a3;
                asm volatile("" ::: "memory");
            }
            if (wg < 2) {
                float* up = p.g_u + su * 8192 + col;
#pragma unroll
                for (int i = 0; i < 64; ++i) up[i * 128] = x[i];
            } else {
                bf16_t* wp = p.g_negw + su * 8192 + (col - 128);
#pragma unroll
                for (int i = 0; i < 64; ++i) wp[i * 128] = f2bf(-x[i]);
            }
        }
        lds_barrier();
    }
}

constexpr int GB_NW = 0, GB_QG = 64 * 136, GB_KD = 2 * 64 * 136, GB_AQ = 2 * 64 * 136 + 128 * 72, GB_ELEMS = 2 * 64 * 136 + 128 * 72 + 64 * 72;
__device__ __forceinline__ void gdn_chain(const Params& p, char* smem, int b, int h) {
    bf16_t* lds = (bf16_t*)smem;
    const int tid = tid_opaque(), lane = tid & 63, wave = tid >> 6;
    const int r = lane & 31, hh = lane >> 5;
    const size_t su0 = (size_t)(b * 16 + h) * NCH;
    const bool loader = wave >= 4;
    const int t2 = tid - 256;
    uint4 sa0, sa1, sa2, sa3, sa4, sa5, sa6, sa7, sa8, sa9, sa10, sa11, sa12, sa13;
    uint4 sb0, sb1, sb2, sb3, sb4, sb5, sb6, sb7, sb8, sb9, sb10, sb11, sb12, sb13;
    f32x16 S[4], un0, un1;
#pragma unroll
    for (int i = 0; i < 4; ++i)
#pragma unroll
        for (int j = 0; j < 16; ++j) S[i][j] = 0.f;
    const int ch0 = t2, ch1 = t2 + 256, ch2 = t2 + 512, ch3 = t2 + 768;
#define GB_GLOAD(P, n_) do { const size_t su_ = su0 + (n_); \
        const bf16_t* a_ = p.g_negw + su_ * 8192; const bf16_t* b_ = p.g_qg + su_ * 8192; const bf16_t* c_ = p.g_kdT + su_ * 8192; const bf16_t* d_ = p.g_aqk + su_ * 4096; \
        P##0 = *(const uint4*)(a_ + (size_t)ch0 * 8); P##1 = *(const uint4*)(a_ + (size_t)ch1 * 8); P##2 = *(const uint4*)(a_ + (size_t)ch2 * 8); P##3 = *(const uint4*)(a_ + (size_t)ch3 * 8); \
        P##4 = *(const uint4*)(b_ + (size_t)ch0 * 8); P##5 = *(const uint4*)(b_ + (size_t)ch1 * 8); P##6 = *(const uint4*)(b_ + (size_t)ch2 * 8); P##7 = *(const uint4*)(b_ + (size_t)ch3 * 8); \
        P##8 = *(const uint4*)(c_ + (size_t)ch0 * 8); P##9 = *(const uint4*)(c_ + (size_t)ch1 * 8); P##10 = *(const uint4*)(c_ + (size_t)ch2 * 8); P##11 = *(const uint4*)(c_ + (size_t)ch3 * 8); \
        P##12 = *(const uint4*)(d_ + (size_t)ch0 * 8); P##13 = *(const uint4*)(d_ + (size_t)ch1 * 8); } while (0)
#define GB_SSTORE(P, buf_) do { bf16_t* q_ = (buf_); \
        *(uint4*)(q_ + GB_NW + (ch0 >> 4) * 136 + (ch0 & 15) * 8) = P##0; *(uint4*)(q_ + GB_NW + (ch1 >> 4) * 136 + (ch1 & 15) * 8) = P##1; \
        *(uint4*)(q_ + GB_NW + (ch2 >> 4) * 136 + (ch2 & 15) * 8) = P##2; *(uint4*)(q_ + GB_NW + (ch3 >> 4) * 136 + (ch3 & 15) * 8) = P##3; \
        *(uint4*)(q_ + GB_QG + (ch0 >> 4) * 136 + (ch0 & 15) * 8) = P##4; *(uint4*)(q_ + GB_QG + (ch1 >> 4) * 136 + (ch1 & 15) * 8) = P##5; \
        *(uint4*)(q_ + GB_QG + (ch2 >> 4) * 136 + (ch2 & 15) * 8) = P##6; *(uint4*)(q_ + GB_QG + (ch3 >> 4) * 136 + (ch3 & 15) * 8) = P##7; \
        *(uint4*)(q_ + GB_KD + (ch0 & 127) * 72 + (ch0 >> 7) * 8) = P##8; *(uint4*)(q_ + GB_KD + (ch1 & 127) * 72 + (ch1 >> 7) * 8) = P##9; \
        *(uint4*)(q_ + GB_KD + (ch2 & 127) * 72 + (ch2 >> 7) * 8) = P##10; *(uint4*)(q_ + GB_KD + (ch3 & 127) * 72 + (ch3 >> 7) * 8) = P##11; \
        GB_AQ_ST(q_, ch0, P##12); GB_AQ_ST(q_, ch1, P##13); } while (0)
#define GB_AQ_ST(q_, ch_, v_) do { const int pq_ = 2 * (ch_), r_ = pq_ & 31, hh_ = (pq_ >> 5) & 1, g4_ = (pq_ >> 6) & 3, tl_ = pq_ >> 8; \
        bf16_t* d_ = (q_) + GB_AQ + (32 * (tl_ & 1) + r_) * 72 + 32 * (tl_ >> 1) + 8 * g4_ + 4 * hh_; \
        *(uint2*)d_ = make_uint2((v_).x, (v_).y); *(uint2*)(d_ + 72) = make_uint2((v_).z, (v_).w); } while (0)
#define GB_ULOAD(n_) do { const float* up_ = p.g_u + (su0 + (n_)) * 8192 + 32 * wave + r; \
        _Pragma("unroll") for (int reg_ = 0; reg_ < 16; ++reg_) { un0[reg_] = up_[(crow(reg_, hh)) * 128]; un1[reg_] = up_[(32 + crow(reg_, hh)) * 128]; } } while (0)
    if (loader) {
        bf16_t* buf0 = lds;
        bf16_t* buf1 = lds + GB_ELEMS;
        GB_GLOAD(sa, 0); GB_SSTORE(sa, buf0);
        GB_GLOAD(sa, 1);
        lds_barrier();
        for (int n = 0; n < NCH; n += 2) {
            if (n + 2 < NCH) { GB_GLOAD(sb, n + 2); }
            if (n + 1 < NCH) { GB_SSTORE(sa, buf1); }
            lds_barrier();
            if (n + 1 >= NCH) break;
            if (n + 3 < NCH) { GB_GLOAD(sa, n + 3); }
            if (n + 2 < NCH) { GB_SSTORE(sb, buf0); }
            lds_barrier();
        }
    } else {
        GB_ULOAD(0);
        float dec_next = p.g_dec[su0];
        lds_barrier();
        for (int n = 0; n < NCH; ++n) {
            unsigned zofs = 0; asm volatile("" : "+v"(zofs));
            bf16_t* cur = lds + (n & 1) * GB_ELEMS + zofs;
            const bool more = (n + 1 < NCH);
            const float dec = dec_next;
            if (more) dec_next = p.g_dec[su0 + n + 1];
            f32x16 vn[2], o[2];
            vn[0] = un0; vn[1] = un1;
#pragma unroll
            for (int j = 0; j < 16; ++j) { o[0][j] = 0.f; o[1][j] = 0.f; }
            if (more) { GB_ULOAD(n + 1); }
#pragma unroll
            for (int kt = 0; kt < 4; ++kt)
#pragma unroll
                for (int s = 0; s < 2; ++s) {
                    const bf16x8 sb = pack_step(S[kt], s);
                    const int k0 = 32 * kt + 16 * s + 4 * hh;
#pragma unroll
                    for (int ct = 0; ct < 2; ++ct) {
                        vn[ct] = MFMA32(frag_perm(cur + GB_NW + (32 * ct + r) * 136 + k0), sb, vn[ct]);
                        o[ct] = MFMA32(frag_perm(cur + GB_QG + (32 * ct + r) * 136 + k0), sb, o[ct]);
                    }
                }
            bf16x8 vb[2][2];
#pragma unroll
            for (int ct = 0; ct < 2; ++ct)
#pragma unroll
                for (int s = 0; s < 2; ++s) vb[ct][s] = pack_step(vn[ct], s);
            {
                o[1] = MFMA32(frag_perm(cur + GB_AQ + (32 + r) * 72 + 4 * hh), vb[0][0], o[1]);
                o[0] = MFMA32(frag_perm(cur + GB_AQ + (r) * 72 + 4 * hh), vb[0][0], o[0]);
                o[1] = MFMA32(frag_perm(cur + GB_AQ + (32 + r) * 72 + 16 + 4 * hh), vb[0][1], o[1]);
                o[0] = MFMA32(frag_perm(cur + GB_AQ + (r) * 72 + 16 + 4 * hh), vb[0][1], o[0]);
                o[1] = MFMA32(frag_perm(cur + GB_AQ + (32 + r) * 72 + 32 + 4 * hh), vb[1][0], o[1]);
                o[1] = MFMA32(frag_perm(cur + GB_AQ + (32 + r) * 72 + 32 + 16 + 4 * hh), vb[1][1], o[1]);
            }
#pragma unroll
            for (int dt = 0; dt < 4; ++dt) S[dt] = S[dt] * dec;
#pragma unroll
            for (int ckt = 0; ckt < 2; ++ckt)
#pragma unroll
                for (int s = 0; s < 2; ++s)
#pragma unroll
                    for (int dt = 0; dt < 4; ++dt)
                        S[dt] = MFMA32(frag_perm(cur + GB_KD + (32 * dt + r) * 72 + 32 * ckt + 16 * s + 4 * hh), vb[ckt][s], S[dt]);
            asm volatile("" :: "v"(un0), "v"(un1), "v"(dec_next));
#pragma unroll
            for (int ct = 0; ct < 2; ++ct)
#pragma unroll
                for (int reg = 0; reg < 16; ++reg) {
                    const int t = 64 * n + 32 * ct + crow(reg, hh);
                    if (t < LP) p.g_o[(((size_t)b * LP + t) * 16 + h) * 128 + 32 * wave + r] = f2bf(o[ct][reg]);
                }
            lds_barrier();
        }
    }
    if (!loader) {
#pragma unroll
        for (int dt = 0; dt < 4; ++dt)
#pragma unroll
            for (int reg = 0; reg < 16; ++reg)
                p.gs_prompt[((size_t)(b * 16 + h) * 128 + 32 * dt + crow(reg, hh)) * 128 + 32 * wave + r] = S[dt][reg];
    }
    lds_barrier();
}

__device__ __forceinline__ void gdn_seq_phase(const Params& p, char* smem, int bid, int nb, int rep = 0) {
    if (bid < 64) gdn_chain(p, smem, bid >> 4, bid & 15);
    else {
        float* tile = (float*)smem;
        const int b2 = bid - 64, n2 = nb - 64;
        transpose_convert(p.gdn_w_out, 2048, D, D, p.wt_gout, tile, b2, n2);
        transpose_convert(p.mlp_w1, D, DFF, DFF, p.wt_w1, tile, b2, n2);
        transpose_convert(p.mlp_w1 + (size_t)D * DFF, D, DFF, DFF, p.wt_w1 + (size_t)D * DFF, tile, b2, n2);
        transpose_convert(p.mlp_w2, DFF, D, D, p.wt_w2, tile, b2, n2);
        transpose_convert(p.mlp_w2 + (size_t)D * DFF, DFF, D, D, p.wt_w2 + (size_t)D * DFF, tile, b2, n2);
        transpose_convert(p.dsa_w_in, D, DIN, DIN_PAD, p.wt_din, tile, b2, n2);
        transpose_convert(p.dsa_w_o, D, D, D, p.wt_do, tile, b2, n2);
    }
    int* slot = (int*)(smem + LDS_BYTES - 32);
    const int tid = tid_opaque();
    for (;;) {
        if (threadIdx.x == 0) *slot = (int)atomicAdd(p.bar + 3520 + 16 * rep, 1u);
        lds_barrier();
        const int u = *slot;
        lds_barrier();
        if (u >= DB * 16 / 2) break;
        gdn_sample_pass(p, smem, u, tid_opaque());
    }
}

__device__ __forceinline__ void gdn_gate_phase(const Params& p, int bid, int nb) {
    const int tid_ = tid_opaque(); const int lane = tid_ & 63, wave = tid_ >> 6;
    const int sub = lane >> 4, l16 = lane & 15;
    f32x4 nw0 = *(const f32x4*)(p.gdn_norm_w + l16 * 8), nw1 = *(const f32x4*)(p.gdn_norm_w + l16 * 8 + 4);
    for (int it4 = bid * 8 + wave; it4 < NPR * 4; it4 += nb * 8) {
        const size_t off = ((size_t)it4 * 4 + sub) * 128 + l16 * 8;
        const uint4 ov = *(const uint4*)(p.g_o + off);
        const uint4 zv = *(const uint4*)(p.z + off);
        const f32x4 o0 = cvt_bf16x4(make_uint2(ov.x, ov.y)), o1 = cvt_bf16x4(make_uint2(ov.z, ov.w));
        const f32x4 z0 = cvt_bf16x4(make_uint2(zv.x, zv.y)), z1 = cvt_bf16x4(make_uint2(zv.z, zv.w));
        float ss = ((o0[0] * o0[0] + o0[1] * o0[1]) + (o0[2] * o0[2] + o0[3] * o0[3])) + ((o1[0] * o1[0] + o1[1] * o1[1]) + (o1[2] * o1[2] + o1[3] * o1[3]));
#pragma unroll
        for (int x = 1; x < 16; x <<= 1) ss += __shfl_xor(ss, x);
        const float rms = rsqrtf(ss * (1.f / 128.f) + 1e-6f);
        uint4 g;
        g.x = pk2(o0[0] * rms * nw0[0] * silu(z0[0]), o0[1] * rms * nw0[1] * silu(z0[1]));
        g.y = pk2(o0[2] * rms * nw0[2] * silu(z0[2]), o0[3] * rms * nw0[3] * silu(z0[3]));
        g.z = pk2(o1[0] * rms * nw1[0] * silu(z1[0]), o1[1] * rms * nw1[1] * silu(z1[1]));
        g.w = pk2(o1[2] * rms * nw1[2] * silu(z1[2]), o1[3] * rms * nw1[3] * silu(z1[3]));
        *(uint4*)(p.gated + off) = g;
    }
}

__device__ __forceinline__ void rope4(const float* tab, int fi, f32x4 x, f32x4 partner, bool first, f32x4& o) {
    const f32x4 t0 = *(const f32x4*)(tab + fi * 2), t1 = *(const f32x4*)(tab + fi * 2 + 4);
    const float sg = first ? -1.f : 1.f;
    o[0] = x[0] * t0[0] + sg * partner[0] * t0[1];
    o[1] = x[1] * t0[2] + sg * partner[1] * t0[3];
    o[2] = x[2] * t1[0] + sg * partner[2] * t1[1];
    o[3] = x[3] * t1[2] + sg * partner[3] * t1[3];
}
__device__ __forceinline__ void dsa_post_phase(const Params& p, char* smem, int bid, int nb) {
    bf16_t* vt = (bf16_t*)smem;
    for (int u = bid; u < 260 + NSR / 8; u += nb) {
        const int tid = tid_opaque(); const int lane = tid & 63, wave = tid >> 6;
        const bool prompt = u < 260;
        const int b = prompt ? ((u < 256) ? (u >> 6) : (u - 256)) : 0, t0 = prompt ? ((u < 256) ? (u & 63) * 64 : 4096) : 0;
        const int nr8 = prompt ? 8 : 1;
        for (int r8 = 0; r8 < nr8; ++r8) {
            const int tl = wave * 8 + r8;
            const int tlp = (tl & ~12) | ((tl & 4) << 1) | ((tl & 8) >> 1);
            const int t = t0 + tl;
            const bool rvalid = prompt ? (t < LP) : true;
            const int row = prompt ? (b * LP + t) : (NPR + (u - 260) * 8 + wave);
            if (!rvalid) {
                for (int e = lane; e < 256; e += 64) vt[e * 72 + tlp] = 0;
                continue;
            }
            const bf16_t* P = (const bf16_t*)p.p1 + (size_t)row * DIN_PAD;
            const int pos = prompt ? t : (PAST + ((row - NPR) & 3));
            const float* tab = p.rope_tab + (size_t)pos * 48;
            float* kout = prompt ? (p.k_prompt + (size_t)row * 256) : (p.k_sample + (size_t)(row - NPR) * 256);
            float* vout = prompt ? (p.v_prompt + (size_t)row * 256) : (p.v_sample + (size_t)(row - NPR) * 256);
#pragma unroll
            for (int j = 0; j < 5; ++j) {
                const int e0 = (lane + 64 * j) * 4, d0 = e0 & 127;
                f32x4 x = ld_bf16x4(P + e0);
                if (d0 < 32) {
                    const bool first = d0 < 16;
                    const f32x4 pr = ld_bf16x4(P + (first ? e0 + 16 : e0 - 16));
                    rope4(tab, d0 & 15, x, pr, first, x);
                }
                if (j < 4) {
                    if (prompt) st_bf16x4(p.q_b + (size_t)row * 1024 + e0, x * 0.12751743f);
                    else *(f32x4*)(p.qr + (size_t)row * 1024 + e0) = x;
                } else {
                    const int ek = e0 - 1024;
                    *(f32x4*)(kout + ek) = x;
                    if (prompt) st_bf16x4(p.k_b + ((size_t)(b * 2 + (ek >> 7)) * LPAD + t) * 128 + d0, x);
                }
            }
            {
                const int e0 = lane * 4;
                const f32x4 x = ld_bf16x4(P + 1280 + e0);
                *(f32x4*)(vout + e0) = x;
                if (prompt) {
#pragma unroll
                    for (int i = 0; i < 4; ++i) vt[(e0 + i) * 72 + tlp] = f2bf(x[i]);
                }
            }
#pragma unroll
            for (int j = 0; j < 2; ++j) {
                const int e0 = (lane + 64 * j) * 4, d0 = e0 & 63;
                f32x4 x = ld_bf16x4(P + 1536 + e0);
                if (d0 < 16) {
                    const bool first = d0 < 8;
                    const f32x4 pr = ld_bf16x4(P + 1536 + (first ? e0 + 8 : e0 - 8));
                    rope4(tab, 16 + (d0 & 7), x, pr, first, x);
                }
                if (prompt) st_bf16x4(p.iq_b + (size_t)row * 512 + e0, x);
                else *(f32x4*)(p.iq + (size_t)row * 512 + e0) = x;
            }
            {
                const float x = bf2f(P[2048 + lane]);
                const float mu = wave_sum(x) * (1.f / 64.f);
                const float dv = x - mu;
                const float var = wave_sum(dv * dv) * (1.f / 64.f);
                const float xn = dv * rsqrtf(var + 1e-5f) * p.dsa_ik_g[lane] + p.dsa_ik_b[lane];
                const float other = __shfl_xor(xn, 8);
                float o = xn;
                if (lane < 16) {
                    const float c = tab[(16 + (lane & 7)) * 2], s = tab[(16 + (lane & 7)) * 2 + 1];
                    if (lane < 8) o = xn * c - other * s; else o = xn * c + other * s;
                }
                float* io = prompt ? (p.ik_prompt + (size_t)row * 64) : (p.ik_sample + (size_t)(row - NPR) * 64);
                io[lane] = o;
                if (prompt) p.ik_b[((size_t)b * LPAD + t) * 64 + lane] = f2bf(o);
            }
            if (lane < 8) p.iw[(size_t)row * 8 + lane] = bf2f(P[2112 + lane]) * 0.35355339059327373f;
        }
        lds_barrier();
        if (prompt) {
#pragma unroll
            for (int i = 0; i < 4; ++i) {
                const int ch = tid + 512 * i, rr = ch >> 3, c8 = (ch & 7) * 8;
                const uint4 v = *(const uint4*)(vt + rr * 72 + c8);
                *(uint4*)(p.vt_b + ((size_t)(b * 2 + (rr >> 7)) * 128 + (rr & 127)) * LPAD + t0 + c8) = v;
            }
        }
        lds_barrier();
    }
    for (int idx = bid * NTHR + tid_opaque(); idx < BATCH * (LPAD - LP) * 256; idx += nb * NTHR) {
        const int c = idx & 255, tp = (idx >> 8) % (LPAD - LP), bb = idx / ((LPAD - LP) * 256);
        const int t = LP + tp, kvh = c >> 7, d = c & 127;
        p.k_b[((size_t)(bb * 2 + kvh) * LPAD + t) * 128 + d] = 0;
        if (c < 64) p.ik_b[((size_t)bb * LPAD + t) * 64 + c] = 0;
        if (c < 65) p.maskT[((size_t)bb * 65 + c) * LPAD + t] = (c == 0) ? 1ull : 0ull;
    }
}

__device__ __forceinline__ const float* ik_row(const Params& p, bool prompt, int b, int s) {
    if (prompt) return p.ik_prompt + ((size_t)b * LP + s) * 64;
    if (s < PAST) { const int pg = p.page_table[b * 16 + (s >> 7)]; return p.cache_ik + ((size_t)pg * 128 + (s & 127)) * 64; }
    return p.ik_sample + ((size_t)b * DS + (s - PAST)) * 64;
}
__device__ __forceinline__ const float* kv_row(const float* own_p, const float* own_s, const float* cache, const int* page_table,
                                               bool prompt, int b, int s) {
    if (prompt) return own_p + ((size_t)b * LP + s) * 256;
    if (s < PAST) { const int pg = page_table[b * 16 + (s >> 7)]; return cache + ((size_t)pg * 128 + (s & 127)) * 256; }
    return own_s + ((size_t)b * DS + (s - PAST)) * 256;
}

template <bool PROMPT, int NREG>
__device__ __forceinline__ void select_emit(const float* sc, int qpos, int lane, unsigned long long* maskcol, int* selrow) {
    const unsigned long long ltmask = (1ull << lane) - 1ull;
    unsigned key[NREG];
    unsigned kmax = 0u, kmin = 0xffffffffu;
#pragma unroll
    for (int j = 0; j < NREG; ++j) {
        const int s = j * 64 + lane;
        const bool cand = (s >= 16 && s <= qpos);
        const float x = cand ? sc[s] : -INFINITY;
        const unsigned u = __float_as_uint(x);
        key[j] = (u & 0x80000000u) ? ~u : (u | 0x80000000u);
        kmax = max(kmax, key[j]);
        kmin = min(kmin, cand ? key[j] : 0xffffffffu);
    }
#pragma unroll
    for (int o = 1; o < 64; o <<= 1) { kmax = max(kmax, (unsigned)__shfl_xor((int)kmax, o)); kmin = min(kmin, (unsigned)__shfl_xor((int)kmin, o)); }
    unsigned lo = kmin, hi = kmax;
    bool exact = false;
    while (lo < hi) {
        const unsigned mid = lo + ((hi - lo) >> 1) + ((hi - lo) & 1u);
        int c = 0;
#pragma unroll
        for (int j = 0; j < NREG; ++j) c += __popcll(__ballot(key[j] >= mid));
        if (c >= 240) { lo = mid; if (c == 240) { exact = true; break; } } else hi = mid - 1u;
    }
    const unsigned T = lo;
    if (!PROMPT) { if (lane < 16) selrow[lane] = lane; }
    int base = 16;
    unsigned long long myword = 0ull, word64 = 0ull;
    if (exact) {
#pragma unroll
        for (int j = 0; j < NREG; ++j) {
            const bool take = key[j] >= T;
            unsigned long long m = __ballot(take);
            if (PROMPT) {
                if (j == 0) m |= 0xFFFFull;
                if (j < 64) { if (lane == j) myword = m; } else word64 = m;
            } else {
                if (take) selrow[base + __popcll(m & ltmask)] = j * 64 + lane;
                base += __popcll(m);
            }
        }
    } else {
        int cgt = 0;
#pragma unroll
        for (int j = 0; j < NREG; ++j) cgt += __popcll(__ballot(key[j] > T));
        const int need_eq = 240 - cgt;
        int erun = 0;
#pragma unroll
        for (int j = 0; j < NREG; ++j) {
            const bool gt = key[j] > T, eq = key[j] == T;
            const unsigned long long meq = __ballot(eq);
            const int rank = erun + __popcll(meq & ltmask);
            const bool take = gt || (eq && rank < need_eq);
            unsigned long long m = __ballot(take);
            if (PROMPT) {
                if (j == 0) m |= 0xFFFFull;
                if (j < 64) { if (lane == j) myword = m; } else word64 = m;
            } else {
                if (take) selrow[base + __popcll(m & ltmask)] = j * 64 + lane;
                base += __popcll(m);
            }
            erun += __popcll(meq);
        }
    }
    if (PROMPT) {
        if (NREG == 65) { maskcol[(size_t)lane * LPAD] = myword; if (lane == 0) maskcol[(size_t)64 * LPAD] = word64; }
        else { if (lane < NREG) maskcol[(size_t)lane * LPAD] = myword; else if (lane < 64) maskcol[(size_t)lane * LPAD] = 0ull; if (lane == 0) maskcol[(size_t)64 * LPAD] = 0ull; }
    }
}

__device__ __forceinline__ bf16x8 ld_f32x8_bf16(const float* p) {
    const f32x4 a = *(const f32x4*)p, b = *(const f32x4*)(p + 4);
    u32x4 q; q[0] = pk2(a[0], a[1]); q[1] = pk2(a[2], a[3]); q[2] = pk2(b[0], b[1]); q[3] = pk2(b[2], b[3]);
    return __builtin_bit_cast(bf16x8, q);
}
__device__ __forceinline__ void indexer_sample_unit(const Params& p, float* sc, int b, int tid) {
    const int lane = tid & 63, wave = tid >> 6;
    const int r = lane & 31, hh = lane >> 5;
    bf16x8 af[4];
    {
        const int e2 = r & 3, hb = (r >> 2) & 1, a = r >> 3;
        const int qi = 2 * hb + (a >> 1), head = 4 * (a & 1) + e2;
        const float* ap = p.iq + ((size_t)NPR + b * 4 + qi) * 512 + head * 64 + 8 * hh;
#pragma unroll
        for (int ks = 0; ks < 4; ++ks) af[ks] = ld_f32x8_bf16(ap + 16 * ks);
    }
    float wq[2][8];
#pragma unroll
    for (int ql = 0; ql < 2; ++ql) {
        const float* wp = p.iw + ((size_t)NPR + b * 4 + 2 * hh + ql) * 8;
        const f32x4 w0 = *(const f32x4*)wp, w1 = *(const f32x4*)(wp + 4);
#pragma unroll
        for (int e2 = 0; e2 < 4; ++e2) { wq[ql][e2] = w0[e2]; wq[ql][4 + e2] = w1[e2]; }
    }
    asm volatile("" :: "v"(af[0]), "v"(af[1]), "v"(af[2]), "v"(af[3]));
#pragma unroll
    for (int ql = 0; ql < 2; ++ql) asm volatile("" :: "v"(wq[ql][0]), "v"(wq[ql][1]), "v"(wq[ql][2]), "v"(wq[ql][3]), "v"(wq[ql][4]), "v"(wq[ql][5]), "v"(wq[ql][6]), "v"(wq[ql][7]));
    const float* kps[9];
#pragma unroll
    for (int i = 0; i < 9; ++i) {
        const int kt = wave + 8 * i;
        const int s = 32 * (kt < 65 ? kt : 64) + r;
        const float* kp;
        if (s < PAST) { const int pg = p.page_table[b * 16 + (s >> 7)]; kp = p.cache_ik + ((size_t)pg * 128 + (s & 127)) * 64; }
        else kp = p.ik_sample + ((size_t)b * DS + ((s - PAST) & 3)) * 64;
        kps[i] = kp + 8 * hh;
    }
    f32x4 nx[8];
#pragma unroll
    for (int ks = 0; ks < 4; ++ks) { nx[2 * ks] = *(const f32x4*)(kps[0] + 16 * ks); nx[2 * ks + 1] = *(const f32x4*)(kps[0] + 16 * ks + 4); }
#pragma unroll
    for (int i = 0; i < 9; ++i) {
        const int kt = wave + 8 * i;
        if (kt < 65) {
            const int s = 32 * kt + r;
            bf16x8 bq[4];
#pragma unroll
            for (int ks = 0; ks < 4; ++ks) {
                u32x4 q; q[0] = pk2(nx[2 * ks][0], nx[2 * ks][1]); q[1] = pk2(nx[2 * ks][2], nx[2 * ks][3]);
                q[2] = pk2(nx[2 * ks + 1][0], nx[2 * ks + 1][1]); q[3] = pk2(nx[2 * ks + 1][2], nx[2 * ks + 1][3]);
                bq[ks] = __builtin_bit_cast(bf16x8, q);
            }
            if (i + 1 < 9) {
#pragma unroll
                for (int ks = 0; ks < 4; ++ks) { nx[2 * ks] = *(const f32x4*)(kps[i + 1] + 16 * ks); nx[2 * ks + 1] = *(const f32x4*)(kps[i + 1] + 16 * ks + 4); }
            }
            f32x16 acc;
#pragma unroll
            for (int j = 0; j < 16; ++j) acc[j] = 0.f;
#pragma unroll
            for (int ks = 0; ks < 4; ++ks) acc = MFMA32(af[ks], bq[ks], acc);
#pragma unroll
            for (int ql = 0; ql < 2; ++ql) {
                float v = 0.f;
#pragma unroll
                for (int a2 = 0; a2 < 2; ++a2)
#pragma unroll
                    for (int e2 = 0; e2 < 4; ++e2) v += wq[ql][4 * a2 + e2] * fmaxf(acc[4 * (2 * ql + a2) + e2], 0.f);
                sc[(2 * hh + ql) * 2112 + s] = v;
            }
        }
    }
    lds_barrier();
    if (wave < 4) select_emit<false, 33>(sc + wave * 2112, PAST + wave, lane, nullptr, p.sel + ((size_t)NPR + b * 4 + wave) * 256);
    lds_barrier();
}

__device__ __forceinline__ void indexer_prompt_unit(const Params& p, float* sc, int b, int g8, int tid) {
    const int lane = tid & 63, wave = tid >> 6;
    const int r = lane & 31, hh = lane >> 5;
    const int t0 = g8 * 8;
    if (t0 < 256) {
        const int qpos = t0 + wave;
        unsigned long long* maskcol = p.maskT + (size_t)b * 65 * LPAD + qpos;
        for (int j = lane; j < 65; j += 64) {
            const int lo = j * 64;
            unsigned long long m = 0ull;
            if (qpos >= lo + 63) m = ~0ull; else if (qpos >= lo) m = (1ull << (qpos - lo + 1)) - 1ull;
            maskcol[(size_t)j * LPAD] = m;
        }
        return;
    }
    bf16x8 af[2][4];
    {
        const int e2 = r & 3, hb = (r >> 2) & 1, a = r >> 3;
        const int qi = 2 * hb + (a >> 1), head = 4 * (a & 1) + e2;
#pragma unroll
        for (int rt = 0; rt < 2; ++rt) {
            const bf16_t* ap = p.iq_b + ((size_t)b * LP + t0 + 4 * rt + qi) * 512 + head * 64 + 8 * hh;
#pragma unroll
            for (int ks = 0; ks < 4; ++ks) af[rt][ks] = *(const bf16x8*)(ap + 16 * ks);
        }
    }
    float wq[2][2][8];
#pragma unroll
    for (int rt = 0; rt < 2; ++rt)
#pragma unroll
        for (int ql = 0; ql < 2; ++ql) {
            const float* wp = p.iw + ((size_t)b * LP + t0 + 4 * rt + 2 * hh + ql) * 8;
            const f32x4 w0 = *(const f32x4*)wp, w1 = *(const f32x4*)(wp + 4);
#pragma unroll
            for (int e2 = 0; e2 < 4; ++e2) { wq[rt][ql][e2] = w0[e2]; wq[rt][ql][4 + e2] = w1[e2]; }
        }
    const int nkt = (t0 + 7) / 32 + 1;
    const bf16_t* kbase = p.ik_b + ((size_t)b * LPAD + r) * 64 + 8 * hh;
    bf16x8 bq[2][4], bn[2][4];
#pragma unroll
    for (int j = 0; j < 2; ++j) {
        const int kt = wave + 8 * j, ktc = (kt < nkt) ? kt : (nkt - 1);
#pragma unroll
        for (int ks = 0; ks < 4; ++ks) bq[j][ks] = *(const bf16x8*)(kbase + (size_t)ktc * 32 * 64 + 16 * ks);
    }
    asm volatile("" :: "v"(af[0][0]), "v"(af[0][1]), "v"(af[0][2]), "v"(af[0][3]), "v"(af[1][0]), "v"(af[1][1]), "v"(af[1][2]), "v"(af[1][3]));
#pragma unroll
    for (int rt = 0; rt < 2; ++rt)
#pragma unroll
        for (int ql = 0; ql < 2; ++ql) asm volatile("" :: "v"(wq[rt][ql][0]), "v"(wq[rt][ql][1]), "v"(wq[rt][ql][2]), "v"(wq[rt][ql][3]), "v"(wq[rt][ql][4]), "v"(wq[rt][ql][5]), "v"(wq[rt][ql][6]), "v"(wq[rt][ql][7]));
    for (int kt0 = wave; kt0 < nkt; kt0 += 16) {
#pragma unroll
        for (int j = 0; j < 2; ++j) {
            const int kt = kt0 + 16 + 8 * j, ktc = (kt < nkt) ? kt : (nkt - 1);
#pragma unroll
            for (int ks = 0; ks < 4; ++ks) bn[j][ks] = *(const bf16x8*)(kbase + (size_t)ktc * 32 * 64 + 16 * ks);
        }
        f32x16 acc[2][2];
#pragma unroll
        for (int j = 0; j < 2; ++j)
#pragma unroll
            for (int rt = 0; rt < 2; ++rt)
#pragma unroll
                for (int i = 0; i < 16; ++i) acc[j][rt][i] = 0.f;
#pragma unroll
        for (int ks = 0; ks < 4; ++ks)
#pragma unroll
            for (int j = 0; j < 2; ++j)
#pragma unroll
                for (int rt = 0; rt < 2; ++rt) acc[j][rt] = MFMA32(af[rt][ks], bq[j][ks], acc[j][rt]);
#pragma unroll
        for (int j = 0; j < 2; ++j) {
            const int kt = kt0 + 8 * j;
            if (kt < nkt) {
#pragma unroll
                for (int rt = 0; rt < 2; ++rt)
#pragma unroll
                    for (int ql = 0; ql < 2; ++ql) {
                        float s = 0.f;
#pragma unroll
                        for (int a2 = 0; a2 < 2; ++a2)
#pragma unroll
                            for (int e2 = 0; e2 < 4; ++e2) s += wq[rt][ql][4 * a2 + e2] * fmaxf(acc[j][rt][4 * (2 * ql + a2) + e2], 0.f);
                        sc[(4 * rt + 2 * hh + ql) * 4160 + 32 * kt + r] = s;
                    }
            }
        }
#pragma unroll
        for (int j = 0; j < 2; ++j)
#pragma unroll
            for (int ks = 0; ks < 4; ++ks) bq[j][ks] = bn[j][ks];
    }
    lds_barrier();
    {
        const int qpos = t0 + wave;
        unsigned long long* mc = p.maskT + (size_t)b * 65 * LPAD + qpos;
        if (t0 + 7 < 17 * 64) select_emit<true, 17>(sc + wave * 4160, qpos, lane, mc, nullptr);
        else if (t0 + 7 < 33 * 64) select_emit<true, 33>(sc + wave * 4160, qpos, lane, mc, nullptr);
        else if (t0 + 7 < 49 * 64) select_emit<true, 49>(sc + wave * 4160, qpos, lane, mc, nullptr);
        else select_emit<true, 65>(sc + wave * 4160, qpos, lane, mc, nullptr);
    }
    lds_barrier();
}

__device__ __forceinline__ void indexer_phase(const Params& p, char* smem, int bid, int nb, int rep = 0) {
    int* slot = (int*)(smem + LDS_BYTES - 32);
    for (;;) {
        const int tid = tid_opaque();
        unsigned zofs = 0; asm volatile("" : "+v"(zofs));
        float* sc = (float*)(smem + zofs);
        if (threadIdx.x == 0) *slot = (int)atomicAdd(p.bar + 3648 + 16 * rep, 1u);
        lds_barrier();
        const int u = *slot;
        lds_barrier();
        if (u >= DB + BATCH * 514) break;
        if (u < DB) {
            indexer_sample_unit(p, sc, u, tid);
        } else {
            const int v = u - DB;
            indexer_prompt_unit(p, sc, v & 3, 513 - (v >> 2), tid);
        }
    }
}

__device__ __forceinline__ void attn_sample_query(const Params& p, char* smem, int row) {
    float* qs = (float*)smem;
    float* ps = qs + 1024;
    const float** kptr = (const float**)(ps + 2048);
    const float** vptr = kptr + 256;
    float* red = (float*)(vptr + 256);
    const int tid = tid_opaque(), lane = tid & 63, wave = tid >> 6;
    const int b = (row - NPR) >> 2;
    qs[tid] = p.qr[(size_t)row * 1024 + tid];
    qs[tid + 512] = p.qr[(size_t)row * 1024 + 512 + tid];
    if (tid < 256) {
        const int s = p.sel[(size_t)row * 256 + tid];
        const float *kp, *vp;
        if (s < PAST) { const int pg = p.page_table[b * 16 + ((s < 0 ? 0 : s) >> 7)]; const size_t ro = ((size_t)pg * 128 + ((s < 0 ? 0 : s) & 127)) * 256; kp = p.cache_k + ro; vp = p.cache_v + ro; }
        else { const size_t ro = ((size_t)b * DS + (s - PAST)) * 256; kp = p.k_sample + ro; vp = p.v_sample + ro; }
        kptr[tid] = (s < 0) ? nullptr : kp;
        vptr[tid] = vp;
    }
    lds_barrier();
    {
        const int j = tid & 255, kvh = tid >> 8;
        const float* kp0 = kptr[j];
        const bool valid = kp0 != nullptr;
        const float* kp = (valid ? kp0 : vptr[j]) + kvh * 128;
        float d0 = 0.f, d1 = 0.f, d2 = 0.f, d3 = 0.f;
        const float* q0 = qs + (kvh * 4) * 128;
#pragma unroll 16
        for (int c = 0; c < 32; ++c) {
            const f32x4 kv = *(const f32x4*)(kp + c * 4);
            const f32x4 a0 = *(const f32x4*)(q0 + c * 4), a1 = *(const f32x4*)(q0 + 128 + c * 4), a2 = *(const f32x4*)(q0 + 256 + c * 4),
                        a3 = *(const f32x4*)(q0 + 384 + c * 4);
            d0 += kv[0] * a0[0] + kv[1] * a0[1] + kv[2] * a0[2] + kv[3] * a0[3];
            d1 += kv[0] * a1[0] + kv[1] * a1[1] + kv[2] * a1[2] + kv[3] * a1[3];
            d2 += kv[0] * a2[0] + kv[1] * a2[1] + kv[2] * a2[2] + kv[3] * a2[3];
            d3 += kv[0] * a3[0] + kv[1] * a3[1] + kv[2] * a3[2] + kv[3] * a3[3];
        }
        const float scl = 0.08838834764831845f;
        ps[(kvh * 4 + 0) * 256 + j] = valid ? d0 * scl : -INFINITY;
        ps[(kvh * 4 + 1) * 256 + j] = valid ? d1 * scl : -INFINITY;
        ps[(kvh * 4 + 2) * 256 + j] = valid ? d2 * scl : -INFINITY;
        ps[(kvh * 4 + 3) * 256 + j] = valid ? d3 * scl : -INFINITY;
    }
    lds_barrier();
    {
        float v[4]; float m = -INFINITY;
#pragma unroll
        for (int i = 0; i < 4; ++i) { v[i] = ps[wave * 256 + lane + 64 * i]; m = fmaxf(m, v[i]); }
        m = wave_max(m);
        float sum = 0.f;
#pragma unroll
        for (int i = 0; i < 4; ++i) { v[i] = __expf(v[i] - m); sum += v[i]; }
        sum = wave_sum(sum);
        const float inv = 1.f / sum;
#pragma unroll
        for (int i = 0; i < 4; ++i) ps[wave * 256 + lane + 64 * i] = v[i] * inv;
    }
    lds_barrier();
    {
        const int kvh = tid >> 8, kg = (tid >> 5) & 7, d4 = tid & 31;
        f32x4 acc[4];
#pragma unroll
        for (int g = 0; g < 4; ++g) acc[g] = (f32x4){0.f, 0.f, 0.f, 0.f};
#pragma unroll 16
        for (int i = 0; i < 32; ++i) {
            const int j = kg * 32 + i;
            const f32x4 vv = *(const f32x4*)(vptr[j] + kvh * 128 + d4 * 4);
#pragma unroll
            for (int g = 0; g < 4; ++g) acc[g] += vv * ps[(kvh * 4 + g) * 256 + j];
        }
#pragma unroll
        for (int g = 0; g < 4; ++g) *(f32x4*)(red + ((kg * 2 + kvh) * 4 + g) * 128 + d4 * 4) = acc[g];
    }
    lds_barrier();
    {
        const int h = wave, d = lane * 2;
        float o0 = 0.f, o1 = 0.f;
#pragma unroll
        for (int kg = 0; kg < 8; ++kg) { const f32x2 t = *(const f32x2*)(red + ((kg * 2 + (h >> 2)) * 4 + (h & 3)) * 128 + d); o0 += t[0]; o1 += t[1]; }
        *(unsigned*)(p.gated + (size_t)row * 1024 + h * 128 + d) = pk2(o0, o1);
    }
    lds_barrier();
}

constexpr int AT_K = 0, AT_V = 64 * 136, AT_ELEMS = 64 * 136 + 128 * 72;
__device__ __forceinline__ void attn_dense_unit(const Params& p, char* smem, int b, int kvh, int qb) {
    bf16_t* lds = (bf16_t*)smem;
    const int tid = tid_opaque(), lane = tid & 63, wave = tid >> 6;
    const int r = lane & 31, hh = lane >> 5;
    const int g = wave & 3, qs = wave >> 2;
    const int head = kvh * 4 + g;
    const int tq = 64 * qb + 32 * qs + r;
    const int tqc = (tq < LP) ? tq : (LP - 1);
    bf16x8 qf[8];
    {
        const bf16_t* qp = p.q_b + ((size_t)b * LP + tqc) * 1024 + head * 128 + 8 * hh;
#pragma unroll
        for (int ks = 0; ks < 8; ++ks) qf[ks] = *(const bf16x8*)(qp + 16 * ks);
    }
    f32x16 O[4];
#pragma unroll
    for (int i = 0; i < 4; ++i)
#pragma unroll
        for (int j = 0; j < 16; ++j) O[i][j] = 0.f;
    float mrun = -3.0e38f, lrun = 0.f;
    const bf16_t* Kg = p.k_b + ((size_t)(b * 2 + kvh) * LPAD) * 128;
    const bf16_t* Vg = p.vt_b + ((size_t)(b * 2 + kvh) * 128) * LPAD;
    const unsigned long long* mcol = p.maskT + (size_t)b * 65 * LPAD + tq;
    const int kc0 = tid, kc1 = tid + 512;
    uint4 sk0, sk1, sv0, sv1;
#define AT_GLOAD(kt_) do { const bf16_t* kg_ = Kg + (size_t)(kt_) * 64 * 128; const bf16_t* vg_ = Vg + (size_t)(kt_) * 64; \
        sk0 = *(const uint4*)(kg_ + (size_t)kc0 * 8); sk1 = *(const uint4*)(kg_ + (size_t)kc1 * 8); \
        sv0 = *(const uint4*)(vg_ + (size_t)(kc0 >> 3) * LPAD + (kc0 & 7) * 8); sv1 = *(const uint4*)(vg_ + (size_t)(kc1 >> 3) * LPAD + (kc1 & 7) * 8); } while (0)
#define AT_SSTORE(buf_) do { bf16_t* q_ = (buf_); \
        *(uint4*)(q_ + AT_K + (kc0 >> 4) * 136 + (kc0 & 15) * 8) = sk0; *(uint4*)(q_ + AT_K + (kc1 >> 4) * 136 + (kc1 & 15) * 8) = sk1; \
        *(uint4*)(q_ + AT_V + (kc0 >> 3) * 72 + (kc0 & 7) * 8) = sv0; *(uint4*)(q_ + AT_V + (kc1 >> 3) * 72 + (kc1 & 7) * 8) = sv1; } while (0)
    AT_GLOAD(0); AT_SSTORE(lds);
    unsigned long long mw_next = mcol[0];
    asm volatile("" :: "v"(qf[0]), "v"(qf[1]), "v"(qf[2]), "v"(qf[3]), "v"(qf[4]), "v"(qf[5]), "v"(qf[6]), "v"(qf[7]), "v"(mw_next));
    lds_barrier();
    for (int kt = 0; kt <= qb; ++kt) {
        unsigned zofs = 0; asm volatile("" : "+v"(zofs));
        bf16_t* cur = lds + (kt & 1) * AT_ELEMS + zofs;
        bf16_t* nxt = lds + ((kt + 1) & 1) * AT_ELEMS + zofs;
        const bool more = kt < qb;
        if (more) { AT_GLOAD(kt + 1); }
        const unsigned long long mw = mw_next;
        if (more) mw_next = mcol[(size_t)(kt + 1) * LPAD];
        f32x16 st[2];
#pragma unroll
        for (int j = 0; j < 16; ++j) { st[0][j] = 0.f; st[1][j] = 0.f; }
#pragma unroll
        for (int ks = 0; ks < 8; ++ks) {
            st[0] = MFMA32(*(const bf16x8*)(cur + AT_K + (r) * 136 + 16 * ks + 8 * hh), qf[ks], st[0]);
            st[1] = MFMA32(*(const bf16x8*)(cur + AT_K + (32 + r) * 136 + 16 * ks + 8 * hh), qf[ks], st[1]);
        }
        float mx = fmaxf(st[0][0], st[1][0]);
#pragma unroll
        for (int reg = 1; reg < 16; reg += 1) mx = fmaxf(mx, fmaxf(st[0][reg], st[1][reg]));
        mx = fmaxf(mx, __shfl_xor(mx, 32));
        const float mnew = (mx > mrun + 8.f) ? mx : mrun;
        if (__any(mnew != mrun)) {
            const float alpha = __builtin_amdgcn_exp2f(mrun - mnew);
            lrun *= alpha;
#pragma unroll
            for (int dt = 0; dt < 4; ++dt) O[dt] = O[dt] * alpha;
            mrun = mnew;
        }
        float psum = 0.f;
#pragma unroll
        for (int kk = 0; kk < 2; ++kk) {
            const int w = (int)((unsigned)(mw >> (32 * kk)) >> (4 * hh));
#pragma unroll
            for (int reg = 0; reg < 16; ++reg) {
                const int bit = (reg & 3) + 8 * (reg >> 2);
                const int keep = __builtin_amdgcn_sbfe(w, bit, 1);
                const float pv = __uint_as_float(__float_as_uint(__builtin_amdgcn_exp2f(st[kk][reg] - mrun)) & (unsigned)keep);
                st[kk][reg] = pv; psum += pv;
            }
        }
        lrun += psum;
        bf16x8 pb[2][2];
#pragma unroll
        for (int kk = 0; kk < 2; ++kk)
#pragma unroll
            for (int s = 0; s < 2; ++s) pb[kk][s] = pack_step(st[kk], s);
#pragma unroll
        for (int kk = 0; kk < 2; ++kk)
#pragma unroll
            for (int s = 0; s < 2; ++s)
#pragma unroll
                for (int dt = 0; dt < 4; ++dt)
                    O[dt] = MFMA32(*(const bf16x8*)(cur + AT_V + (32 * dt + r) * 72 + 32 * kk + 16 * s + 8 * hh), pb[kk][s], O[dt]);
        if (more) { AT_SSTORE(nxt); }
        lds_barrier();
    }
    const float ltot = lrun + __shfl_xor(lrun, 32);
    const float inv = 1.f / ltot;
    if (tq < LP) {
        bf16_t* op = p.gated + ((size_t)b * LP + tq) * 1024 + head * 128;
#pragma unroll
        for (int dt = 0; dt < 4; ++dt)
#pragma unroll
            for (int g4 = 0; g4 < 4; ++g4) {
                f32x4 v;
#pragma unroll
                for (int e2 = 0; e2 < 4; ++e2) v[e2] = O[dt][4 * g4 + e2] * inv;
                st_bf16x4(op + 32 * dt + 8 * g4 + 4 * hh, v);
            }
    }
    lds_barrier();
}

__device__ __forceinline__ void attn_phase(const Params& p, char* smem, int bid, int nb, int rep = 0) {
    int* slot = (int*)(smem + LDS_BYTES - 32);
    for (;;) {
        if (threadIdx.x == 0) *slot = (int)atomicAdd(p.bar + 3584 + 16 * rep, 1u);
        lds_barrier();
        const int u = *slot;
        lds_barrier();
        if (u >= 520 + NSR) break;
        if (u < 520) attn_dense_unit(p, smem, (u & 7) >> 1, u & 1, 64 - (u >> 3));
        else attn_sample_query(p, smem, NPR + (u - 520));
    }
}

#define XB_TMO      128
#define XB_XCNT(j)  (256  + 64 * (j))
#define XB_XSUB(j)  (1280 + 64 * (j))
#define XB_XGEN(j)  (2304 + 64 * (j))
#define XB_TOP      3328
#define XB_TOPGEN   3392
#define XCD_BAR_WORDS 3456
#define XB_SPIN_CAP (1u << 18)
#define LAS __attribute__((address_space(3)))

__device__ __forceinline__ unsigned xb_ld(unsigned* p)              { return __hip_atomic_load(p, __ATOMIC_RELAXED, __HIP_MEMORY_SCOPE_AGENT); }
__device__ __forceinline__ unsigned xb_add(unsigned* p, unsigned v) { return __hip_atomic_fetch_add(p, v, __ATOMIC_RELAXED, __HIP_MEMORY_SCOPE_AGENT); }
__device__ __forceinline__ unsigned xb_xcc_id() { return (unsigned)__builtin_amdgcn_s_getreg((3 << 11) | 20) & 0xFu; }
#define XB_SPIN(cond, bar) do { unsigned _sp = 0; while (cond) { __builtin_amdgcn_s_sleep(1); \
    if ((++_sp & 255u) == 0u) { if (xb_ld(&(bar)[XB_TMO])) break; if (_sp > XB_SPIN_CAP) { atomicAdd(&(bar)[XB_TMO], 1u); break; } } } } while (0)

struct XcdBarrier {
    unsigned* bar; unsigned x;
    volatile LAS unsigned* st;
};

__device__ __forceinline__ XcdBarrier xcd_barrier_post(unsigned* bar, volatile LAS unsigned* st) {
    XcdBarrier b; b.bar = bar; b.x = xb_xcc_id(); b.st = st;
    if (threadIdx.x == 0) (void)xb_add(&bar[XB_XCNT(b.x)], 1u);
    return b;
}
__device__ __forceinline__ void xcd_barrier_complete(unsigned* bar, unsigned x, unsigned& nloc, unsigned& nx) {
    const unsigned G = gridDim.x * gridDim.y * gridDim.z;
    unsigned sum, cnt, mine, sp = 0u;
    for (;;) {
        sum = 0u; cnt = 0u; mine = 0u;
#pragma unroll
        for (unsigned j = 0; j < 16; ++j) { const unsigned c = xb_ld(&bar[XB_XCNT(j)]); sum += c; cnt += (c > 0u) ? 1u : 0u; mine = (j == x) ? c : mine; }
        if (sum == G) break;
        __builtin_amdgcn_s_sleep(1);
        if ((++sp & 255u) == 0u) { if (xb_ld(&bar[XB_TMO])) break; if (sp > XB_SPIN_CAP) { atomicAdd(&bar[XB_TMO], 1u); break; } }
    }
    nloc = mine > 0u ? mine : 1u; nx = cnt > 0u ? cnt : 1u;
}

__device__ __forceinline__ void xcd_barrier(const XcdBarrier& b) {
    asm volatile("s_waitcnt vmcnt(0)" ::: "memory");
    __syncthreads();
    if (threadIdx.x == 0) {
        unsigned* bar = b.bar;
        __builtin_amdgcn_s_waitcnt(0);
        unsigned nloc = b.st[0], nx = b.st[1];
        if (nloc == 0u) { xcd_barrier_complete(bar, b.x, nloc, nx); b.st[0] = nloc; b.st[1] = nx; }
        const unsigned old = xb_add(&bar[XB_XSUB(b.x)], 1u);
        const unsigned gen = old / nloc;
        if (old + 1u == (gen + 1u) * nloc) {
            __builtin_amdgcn_fence(__ATOMIC_RELEASE, "agent");
            asm volatile("s_waitcnt vmcnt(0)" ::: "memory");
            const unsigned og = xb_add(&bar[XB_TOP], 1u);
            const unsigned tg = og / nx;
            if (og + 1u == (tg + 1u) * nx) xb_add(&bar[XB_TOPGEN], 1u);
            else XB_SPIN(xb_ld(&bar[XB_TOPGEN]) == tg, bar);
            __builtin_amdgcn_fence(__ATOMIC_ACQUIRE, "agent");
            xb_add(&bar[XB_XGEN(b.x)], 1u);
            asm volatile("s_waitcnt vmcnt(0)" ::: "memory");
        } else {
            XB_SPIN(xb_ld(&bar[XB_XGEN(b.x)]) == gen, bar);
            __builtin_amdgcn_fence(__ATOMIC_ACQUIRE, "agent");
            asm volatile("s_waitcnt vmcnt(0)" ::: "memory");
        }
    }
    __syncthreads();
}


constexpr int NPHASE = 19;
template <int PH>
__device__ __forceinline__ void run_phase(const Params& p, char* smem, int bid, int nb, int rep = 0) {
    constexpr int MT = MPAD / 256;
    if constexpr (PH == 0) phase_prologue(p, smem, bid, nb);
    else if constexpr (PH == 1) gemm_big(p.hA, D, p.wt_gin, GIN_PAD, EpiGdnIn{p.mixed, p.z, p.ba}, smem, bid, nb);
    else if constexpr (PH == 2) gdn_stageA(p, smem, bid, nb);
    else if constexpr (PH == 3) gdn_seq_phase(p, smem, bid, nb, rep);
    else if constexpr (PH == 4) gdn_gate_phase(p, bid, nb);
    else if constexpr (PH == 5) gemm_n1024(p.gated, 2048, p.wt_gout, EpiResid{p.preln, p.hA}, EpiSlab{p.slab}, 8, smem, bid, nb);
    else if constexpr (PH == 6) ln_phase(p.preln, p.ln1_g, p.ln1_b, p.hB, nullptr, nullptr, p.slab, 8, p.hA, bid, nb);
    else if constexpr (PH == 7) gemm_big(p.hB, D, p.wt_w1, DFF, EpiRelu2{p.act}, smem, bid, nb);
    else if constexpr (PH == 8) gemm_n1024(p.act, DFF, p.wt_w2, EpiResid{p.preln, p.hB}, EpiSlab{p.slab}, 16, smem, bid, nb);
    else if constexpr (PH == 9) ln_phase(p.preln, p.ln2_g, p.ln2_b, p.hA, nullptr, nullptr, p.slab, 16, p.hB, bid, nb);
    else if constexpr (PH == 10) gemm_big(p.hA, D, p.wt_din, DIN_PAD, EpiBf16{(bf16_t*)p.p1, DIN_PAD}, smem, bid, nb);
    else if constexpr (PH == 11) dsa_post_phase(p, smem, bid, nb);
    else if constexpr (PH == 12) indexer_phase(p, smem, bid, nb, rep);
    else if constexpr (PH == 13) attn_phase(p, smem, bid, nb, rep);
    else if constexpr (PH == 14) gemm_n1024(p.gated, D, p.wt_do, EpiResid{p.preln, p.hA}, EpiSlab{p.slab}, 4, smem, bid, nb);
    else if constexpr (PH == 15) ln_phase(p.preln, p.ln1_g + D, p.ln1_b + D, p.hB, nullptr, nullptr, p.slab, 4, p.hA, bid, nb);
    else if constexpr (PH == 16) gemm_big(p.hB, D, p.wt_w1 + (size_t)D * DFF, DFF, EpiRelu2{p.act}, smem, bid, nb);
    else if constexpr (PH == 17) gemm_n1024(p.act, DFF, p.wt_w2 + (size_t)D * DFF, EpiResid{p.preln, p.hB}, EpiSlab{p.slab}, 16, smem, bid, nb);
    else if constexpr (PH == 18) ln_phase(p.preln, p.ln2_g + D, p.ln2_b + D, nullptr, p.y_prompt, p.y_sample, p.slab, 16, p.hB, bid, nb);
}

template <int PH>
__global__ void __launch_bounds__(NTHR, 2) k_phase(Params p) {
    extern __shared__ __attribute__((aligned(16))) char smem[];
    run_phase<PH>(p, smem, blockIdx.x, gridDim.x);
}

template <int PH>
__device__ __forceinline__ void mega_run(const Params& p, char* smem, const XcdBarrier& bar) {
    run_phase<PH>(p, smem, blockIdx.x, gridDim.x);
#ifdef PROBE_MASK
    if constexpr ((PROBE_MASK >> PH) & 1) { xcd_barrier(bar); run_phase<PH>(p, smem, blockIdx.x, gridDim.x, 1); }
#endif
    if constexpr (PH + 1 < NPHASE) {
        xcd_barrier(bar);
        mega_run<PH + 1>(p, smem, bar);
    }
}
__global__ void __launch_bounds__(NTHR, 2) k_mega(Params p) {
    extern __shared__ __attribute__((aligned(16))) char smem[];
    volatile LAS unsigned* st = (volatile LAS unsigned*)(smem + LDS_BYTES - 16);
    if (threadIdx.x == 0) { st[0] = 0u; st[1] = 0u; st[2] = 0u; st[3] = 0u; }
    __syncthreads();
    XcdBarrier bar = xcd_barrier_post(p.bar, st);
    mega_run<0>(p, smem, bar);
}

template <int PH>
void launch_phase(const Params& p, hipStream_t stream) {
    static bool attr_done = false;
    if (!attr_done) {
        (void)hipFuncSetAttribute((const void*)k_phase<PH>, hipFuncAttributeMaxDynamicSharedMemorySize, LDS_BYTES);
        attr_done = true;
    }
    hipLaunchKernelGGL(k_phase<PH>, dim3(256), dim3(NTHR), LDS_BYTES, stream, p);
}
template <int PH>
void launch_all(const Params& p, hipStream_t stream) {
    launch_phase<PH>(p, stream);
    if constexpr (PH + 1 < NPHASE) launch_all<PH + 1>(p, stream);
}

}

extern "C" void kernel_launch(void* const* d_in, const int* in_sizes, int n_in, void* d_out, int out_size, void* d_ws, size_t ws_size,
                              hipStream_t stream) {
    Params p{};
    p.x_prompt = (const float*)d_in[0]; p.x_sample = (const float*)d_in[1]; p.state_gdn = (const float*)d_in[2];
    p.state_conv = (const float*)d_in[3]; p.cache_k = (const float*)d_in[4]; p.cache_v = (const float*)d_in[5];
    p.cache_ik = (const float*)d_in[6]; p.page_table = (const int*)d_in[7]; p.meta = (const float*)d_in[8];
    p.ln1_g = (const float*)d_in[9]; p.ln1_b = (const float*)d_in[10]; p.ln2_g = (const float*)d_in[11]; p.ln2_b = (const float*)d_in[12];
    p.mlp_w1 = (const float*)d_in[13]; p.mlp_w2 = (const float*)d_in[14]; p.gdn_w_in = (const float*)d_in[15];
    p.gdn_conv_w = (const float*)d_in[16]; p.gdn_a_log = (const float*)d_in[17]; p.gdn_dt_bias = (const float*)d_in[18];
    p.gdn_norm_w = (const float*)d_in[19]; p.gdn_w_out = (const float*)d_in[20]; p.dsa_w_in = (const float*)d_in[21];
    p.dsa_ik_g = (const float*)d_in[22]; p.dsa_ik_b = (const float*)d_in[23]; p.dsa_w_o = (const float*)d_in[24];
    float* o = (float*)d_out;
    p.y_prompt = o; o += (size_t)BATCH * SEQ * D;
    p.y_sample = o; o += (size_t)NSR * D;
    p.gs_prompt = o; o += (size_t)BATCH * 16 * 128 * 128;
    p.gc_prompt = o; o += (size_t)BATCH * 3 * 4096;
    p.gs_sample = o; o += (size_t)DB * 16 * 128 * 128;
    p.gc_sample = o; o += (size_t)DB * 3 * 4096;
    p.k_prompt = o; o += (size_t)NPR * 256;
    p.v_prompt = o; o += (size_t)NPR * 256;
    p.ik_prompt = o; o += (size_t)NPR * 64;
    p.k_sample = o; o += (size_t)NSR * 256;
    p.v_sample = o; o += (size_t)NSR * 256;
    p.ik_sample = o; o += (size_t)NSR * 64;
    char* w = (char*)d_ws;
    auto take = [&](size_t bytes) { char* r = w; w += (bytes + 255) & ~(size_t)255; return r; };
    p.bar = (unsigned*)take(16384);
    p.wt_gin = (bf16_t*)take((size_t)GIN_PAD * D * 2);
    p.wt_gout = (bf16_t*)take((size_t)D * 2048 * 2);
    p.wt_w1 = (bf16_t*)take((size_t)2 * D * DFF * 2);
    p.wt_w2 = (bf16_t*)take((size_t)2 * D * DFF * 2);
    p.wt_din = (bf16_t*)take((size_t)DIN_PAD * D * 2);
    p.wt_do = (bf16_t*)take((size_t)D * D * 2);
    p.hA = (bf16_t*)take((size_t)MPAD * D * 2);
    p.hB = (bf16_t*)take((size_t)MPAD * D * 2);
    p.preln = (float*)take((size_t)MPAD * D * 4);
    p.mixed = (bf16_t*)take((size_t)MPAD * 4096 * 2);
    p.z = (bf16_t*)take((size_t)MPAD * 2048 * 2);
    p.ba = (float*)take((size_t)MPAD * 32 * 4);
    p.gated = (bf16_t*)take((size_t)MPAD * 2048 * 2);
    p.act = (bf16_t*)take((size_t)MPAD * DFF * 2);
    p.p1 = (float*)take((size_t)MPAD * DIN_PAD * 4);
    p.qr = (float*)take((size_t)MPAD * 1024 * 4);
    p.iq = (float*)take((size_t)MPAD * 512 * 4);
    p.iw = (float*)take((size_t)MPAD * 8 * 4);
    p.sel = (int*)take((size_t)MPAD * 256 * 4);
    p.g_o = (bf16_t*)take((size_t)NPR * 2048 * 2);
    p.rope_tab = (float*)take((size_t)LP * 24 * 2 * 4);
    p.slab = (float*)take((size_t)16 * 768 * 1024 * 4);
    p.q_b = (bf16_t*)take((size_t)NPR * 1024 * 2);
    p.k_b = (bf16_t*)take((size_t)BATCH * 2 * LPAD * 128 * 2);
    p.vt_b = (bf16_t*)take((size_t)BATCH * 2 * 128 * LPAD * 2);
    p.iq_b = (bf16_t*)take((size_t)NPR * 512 * 2);
    p.ik_b = (bf16_t*)take((size_t)BATCH * LPAD * 64 * 2);
    p.maskT = (unsigned long long*)take((size_t)BATCH * 65 * LPAD * 8);
    p.g_dec = (float*)take((size_t)NCU * 4);
    p.g_u = (float*)p.act;
    p.g_negw = (bf16_t*)p.p1;
    p.g_qg = p.g_negw + (size_t)NCU * 8192;
    p.g_kdT = (bf16_t*)p.qr;
    p.g_aqk = (bf16_t*)p.iq;
    if ((size_t)(w - (char*)d_ws) > ws_size) { fprintf(stderr, "kernel_launch: workspace too small (%zu needed, %zu given)\n", (size_t)(w - (char*)d_ws), ws_size); return; }
#if MEGA
    static int grid = 0;
    if (grid == 0) {
        int dev = 0, cus = 0;
        if (hipGetDevice(&dev) != hipSuccess || hipDeviceGetAttribute(&cus, hipDeviceAttributeMultiprocessorCount, dev) != hipSuccess || cus <= 0) cus = 256;
        (void)hipFuncSetAttribute((const void*)k_mega, hipFuncAttributeMaxDynamicSharedMemorySize, LDS_BYTES);
        grid = cus;
    }
    (void)hipMemsetAsync(p.bar, 0, 16384, stream);
    hipLaunchKernelGGL(k_mega, dim3(grid), dim3(NTHR), LDS_BYTES, stream, p);
#else
    launch_all<0>(p, stream);
#endif
}
```

```cpp
#include <hip/hip_runtime.h>
#include <stdint.h>
#include <stdio.h>

#ifndef MEGA
#define MEGA 1
#endif

namespace {

typedef unsigned short bf16_t;
typedef short bf16x8 __attribute__((ext_vector_type(8)));
typedef float f32x4 __attribute__((ext_vector_type(4)));

constexpr int D = 1024, BATCH = 4, SEQ = 4096, NMETA = 16, LP = SEQ + NMETA;
constexpr int DB = 128, DS = 4, PAST = 2048;
constexpr int NPR = BATCH * LP;
constexpr int NSR = DB * DS;
constexpr int NT = NPR + NSR;
constexpr int MPAD = 17152;
constexpr int DFF = 4096;
constexpr int GIN = 6176, GIN_PAD = 6400;
constexpr int DIN = 2120, DIN_PAD = 2304;
constexpr int NTHR = 512;
constexpr int LPAD = 4160;
constexpr int LDS_BYTES = 150 * 1024;
constexpr float ALPHA = 1.4142135623730951f;

struct Params {
    const float *x_prompt, *x_sample, *state_gdn, *state_conv, *cache_k, *cache_v, *cache_ik;
    const int* page_table;
    const float *meta, *ln1_g, *ln1_b, *ln2_g, *ln2_b, *mlp_w1, *mlp_w2, *gdn_w_in, *gdn_conv_w, *gdn_a_log, *gdn_dt_bias,
        *gdn_norm_w, *gdn_w_out, *dsa_w_in, *dsa_ik_g, *dsa_ik_b, *dsa_w_o;
    float *y_prompt, *y_sample, *gs_prompt, *gc_prompt, *gs_sample, *gc_sample, *k_prompt, *v_prompt, *ik_prompt, *k_sample,
        *v_sample, *ik_sample;
    unsigned* bar;
    bf16_t *wt_gin, *wt_gout, *wt_w1, *wt_w2, *wt_din, *wt_do;
    bf16_t *hA, *hB;
    float* preln;
    bf16_t *mixed, *z;
    float* ba;
    bf16_t *gated, *act;
    float *p1, *qr, *iq, *iw;
    int* sel;
    bf16_t *g_negw, *g_qg, *g_kdT, *g_aqk;
    float *g_u, *g_dec;
    bf16_t* g_o;
    float* rope_tab;
    float* slab;
    bf16_t *q_b, *k_b, *vt_b, *iq_b, *ik_b;
    unsigned long long* maskT;
};

__device__ const double kInvFreq[16] = {1.0, 0.44036660267178046, 0.19392274474868576, 0.08539710028576561,
    0.03760603093086393, 0.016560440080994446, 0.007292664737217109, 0.003211445994752591, 0.001414213562373095,
    0.000622772421914596, 0.0002742481756762073, 0.00012076973741146504, 5.318295896944988e-05, 2.341999896140934e-05,
    1.031338537721246e-05, 4.5416704806078695e-06};

__device__ __forceinline__ float bf2f(bf16_t h) { return __uint_as_float(((unsigned)h) << 16); }
typedef __bf16 hwbf16x2 __attribute__((ext_vector_type(2)));
typedef float f32x2 __attribute__((ext_vector_type(2)));
typedef float f32x16 __attribute__((ext_vector_type(16)));
typedef unsigned u32x4 __attribute__((ext_vector_type(4)));
__device__ __forceinline__ unsigned pk2(float lo, float hi) {
    const f32x2 v = {lo, hi};
    return __builtin_bit_cast(unsigned, __builtin_convertvector(v, hwbf16x2));
}
__device__ __forceinline__ bf16_t f2bf(float f) { return (bf16_t)(pk2(f, 0.f) & 0xffffu); }
__device__ __forceinline__ void st_bf16x4(bf16_t* p, f32x4 v) {
    uint2 o; o.x = pk2(v[0], v[1]); o.y = pk2(v[2], v[3]);
    *(uint2*)p = o;
}
__device__ __forceinline__ f32x4 cvt_bf16x4(uint2 o) {
    f32x4 v; v[0] = __uint_as_float(o.x << 16); v[1] = __uint_as_float(o.x & 0xffff0000u);
    v[2] = __uint_as_float(o.y << 16); v[3] = __uint_as_float(o.y & 0xffff0000u);
    return v;
}
__device__ __forceinline__ f32x4 ld_bf16x4(const bf16_t* p) {
    uint2 o = *(const uint2*)p;
    f32x4 v; v[0] = __uint_as_float(o.x << 16); v[1] = __uint_as_float(o.x & 0xffff0000u);
    v[2] = __uint_as_float(o.y << 16); v[3] = __uint_as_float(o.y & 0xffff0000u);
    return v;
}
__device__ __forceinline__ float wave_sum(float v) {
#pragma unroll
    for (int o = 1; o < 64; o <<= 1) v += __shfl_xor(v, o);
    return v;
}
__device__ __forceinline__ float wave_max(float v) {
#pragma unroll
    for (int o = 1; o < 64; o <<= 1) v = fmaxf(v, __shfl_xor(v, o));
    return v;
}
__device__ __forceinline__ int wave_sum_i(int v) {
#pragma unroll
    for (int o = 1; o < 64; o <<= 1) v += __shfl_xor(v, o);
    return v;
}
__device__ __forceinline__ float silu(float x) { return x * __builtin_amdgcn_rcpf(1.f + __expf(-x)); }
__device__ __forceinline__ int tid_opaque() { int t = threadIdx.x; asm volatile("" : "+v"(t)); return t; }
__device__ __forceinline__ void lds_barrier() { asm volatile("s_waitcnt lgkmcnt(0)\n\ts_barrier" ::: "memory"); }
__device__ __forceinline__ void lds_fence() { asm volatile("s_waitcnt lgkmcnt(0)" ::: "memory"); }

__device__ __forceinline__ void transpose_convert(const float* __restrict__ W, int K, int N, int Npad, bf16_t* __restrict__ WT, float* tile,
                                  int bid, int nb) {
    const int tid = tid_opaque();
    const int tk = K / 64, tn = Npad / 64;
    for (int it = bid; it < tk * tn; it += nb) {
        const int kb = it / tn, nbk = it % tn, k0 = kb * 64, n0 = nbk * 64;
#pragma unroll
        for (int i = 0; i < 8; ++i) {
            const int r = (tid >> 6) + 8 * i, c = tid & 63, n = n0 + c;
            tile[r * 65 + c] = (n < N) ? W[(size_t)(k0 + r) * N + n] : 0.f;
        }
        __syncthreads();
        {
            const int rn = tid >> 3, c8 = (tid & 7) * 8;
            const float* tp = tile + c8 * 65 + rn;
            uint4 o;
            o.x = pk2(tp[0], tp[65]); o.y = pk2(tp[2 * 65], tp[3 * 65]); o.z = pk2(tp[4 * 65], tp[5 * 65]); o.w = pk2(tp[6 * 65], tp[7 * 65]);
            *(uint4*)(WT + (size_t)(n0 + rn) * K + k0 + c8) = o;
        }
        __syncthreads();
    }
}

__device__ __forceinline__ void phase_prologue(const Params& p, char* smem, int bid, int nb) {
    float* tile = (float*)smem;
    transpose_convert(p.gdn_w_in, D, GIN, GIN_PAD, p.wt_gin, tile, bid, nb);
    for (int idx = bid * NTHR + tid_opaque(); idx < LP * 24; idx += nb * NTHR) {
        const int pos = idx / 24, f = idx % 24;
        const int fi = (f < 16) ? f : (f - 16) * 2;
        const double rev = (double)pos * kInvFreq[fi] * 0.15915494309189535;
        const float r = (float)(rev - floor(rev));
        p.rope_tab[idx * 2] = __builtin_amdgcn_cosf(r);
        p.rope_tab[idx * 2 + 1] = __builtin_amdgcn_sinf(r);
    }
    for (int idx = bid * NTHR + tid_opaque(); idx < MPAD * 256; idx += nb * NTHR) {
        const int row = idx >> 8, c4 = (idx & 255) * 4;
        f32x4 v = {0.f, 0.f, 0.f, 0.f};
        if (row < NPR) {
            const int b = row / LP, t = row % LP;
            const float* src = (t < NMETA) ? (p.meta + (size_t)t * D) : (p.x_prompt + ((size_t)b * SEQ + (t - NMETA)) * D);
            v = *(const f32x4*)(src + c4);
        } else if (row < NT) {
            v = *(const f32x4*)(p.x_sample + (size_t)(row - NPR) * D + c4);
        }
        st_bf16x4(p.hA + (size_t)row * D + c4, v);
    }
}

template <class Epi>
__device__ __forceinline__ void gemm_phase(const bf16_t* __restrict__ A, int lda, const bf16_t* __restrict__ Bt, int K, int Mtiles, int Ntiles,
                           const Epi& epi, char* smem, int bid, int nb) {
    bf16_t* As = (bf16_t*)smem;
    bf16_t* Bs = As + 256 * 72;
    const int tid = tid_opaque(), lane = tid & 63, wave = tid >> 6;
    const int wm = wave >> 1, wn = wave & 1;
    const int fr = lane & 15, fq = lane >> 4;
    const int ntiles = Mtiles * Ntiles;
    const int nk = K / 64;
    for (int tile = bid; tile < ntiles; tile += nb) {
        const int tm = tile % Mtiles, tn = tile / Mtiles;
        const bf16_t* Ag = A + (size_t)tm * 256 * lda;
        const bf16_t* Bg = Bt + (size_t)tn * 128 * K;
        f32x4 acc[4][4];
#pragma unroll
        for (int i = 0; i < 4; ++i)
#pragma unroll
            for (int j = 0; j < 4; ++j) acc[i][j] = (f32x4){0.f, 0.f, 0.f, 0.f};
        const int c0 = tid, c1 = tid + 512, c2 = tid + 1024, c3 = tid + 1536;
        const bf16_t* ga0 = Ag + (size_t)(c0 >> 3) * lda + (c0 & 7) * 8;
        const bf16_t* ga1 = Ag + (size_t)(c1 >> 3) * lda + (c1 & 7) * 8;
        const bf16_t* ga2 = Ag + (size_t)(c2 >> 3) * lda + (c2 & 7) * 8;
        const bf16_t* ga3 = Ag + (size_t)(c3 >> 3) * lda + (c3 & 7) * 8;
        const bf16_t* gb0 = Bg + (size_t)(c0 >> 3) * K + (c0 & 7) * 8;
        const bf16_t* gb1 = Bg + (size_t)(c1 >> 3) * K + (c1 & 7) * 8;
        bf16_t* sa0 = As + (c0 >> 3) * 72 + (c0 & 7) * 8;
        bf16_t* sa1 = As + (c1 >> 3) * 72 + (c1 & 7) * 8;
        bf16_t* sa2 = As + (c2 >> 3) * 72 + (c2 & 7) * 8;
        bf16_t* sa3 = As + (c3 >> 3) * 72 + (c3 & 7) * 8;
        bf16_t* sb0 = Bs + (c0 >> 3) * 72 + (c0 & 7) * 8;
        bf16_t* sb1 = Bs + (c1 >> 3) * 72 + (c1 & 7) * 8;
        uint4 ra0 = *(const uint4*)ga0, ra1 = *(const uint4*)ga1, ra2 = *(const uint4*)ga2, ra3 = *(const uint4*)ga3;
        uint4 rb0 = *(const uint4*)gb0, rb1 = *(const uint4*)gb1;
        *(uint4*)sa0 = ra0; *(uint4*)sa1 = ra1; *(uint4*)sa2 = ra2; *(uint4*)sa3 = ra3; *(uint4*)sb0 = rb0; *(uint4*)sb1 = rb1;
        __syncthreads();
        for (int kt = 0; kt < nk; ++kt) {
            const bool more = (kt + 1 < nk);
            if (more) {
                const int k0 = (kt + 1) * 64;
                ra0 = *(const uint4*)(ga0 + k0); ra1 = *(const uint4*)(ga1 + k0); ra2 = *(const uint4*)(ga2 + k0); ra3 = *(const uint4*)(ga3 + k0);
                rb0 = *(const uint4*)(gb0 + k0); rb1 = *(const uint4*)(gb1 + k0);
            }
#pragma unroll
            for (int kk = 0; kk < 2; ++kk) {
                bf16x8 af[4], bfr[4];
#pragma unroll
                for (int i = 0; i < 4; ++i) af[i] = *(const bf16x8*)(As + (wm * 64 + i * 16 + fr) * 72 + kk * 32 + fq * 8);
#pragma unroll
                for (int j = 0; j < 4; ++j) bfr[j] = *(const bf16x8*)(Bs + (wn * 64 + j * 16 + fr) * 72 + kk * 32 + fq * 8);
#pragma unroll
                for (int i = 0; i < 4; ++i)
#pragma unroll
                    for (int j = 0; j < 4; ++j) acc[i][j] = __builtin_amdgcn_mfma_f32_16x16x32_bf16(bfr[j], af[i], acc[i][j], 0, 0, 0);
            }
            __syncthreads();
            if (more) {
                *(uint4*)sa0 = ra0; *(uint4*)sa1 = ra1; *(uint4*)sa2 = ra2; *(uint4*)sa3 = ra3; *(uint4*)sb0 = rb0; *(uint4*)sb1 = rb1;
                __syncthreads();
            }
        }
#pragma unroll
        for (int i = 0; i < 4; ++i)
#pragma unroll
            for (int j = 0; j < 4; ++j) {
                const int row = tm * 256 + wm * 64 + i * 16 + fr, col = tn * 128 + wn * 64 + j * 16 + fq * 4;
                epi(row, col, acc[i][j]);
            }
    }
}

namespace pg8 {
#define PG8_LAS __attribute__((address_space(3)))
constexpr int BM = 256, BK = 64, HALF = 128, HTB = HALF * BK * 2  , STAGE_BYTES = 8 * HTB, NXCD = 8, WGM = 16;
__device__ __forceinline__ int lds_byte(int r, int c) { const int st = (r >> 4) * 2 + (c >> 5), rr = r & 15, cc = c & 31, ob = rr * 64 + cc * 2; return st * 1024 + (ob ^ (((ob >> 9) & 1) << 5)); }
__device__ __forceinline__ void stage_rc(int b, int& R, int& C) { const int st = b / 1024, sb = b % 1024, swz = sb ^ (((sb >> 9) & 1) << 5); R = (st >> 1) * 16 + swz / 64; C = (st & 1) * 32 + (swz % 64) / 2; }
__device__ __forceinline__ int perm32(int rho) { const int n = rho >> 4, i = rho & 15; return 8 * (i >> 2) + 4 * n + (i & 3); }
struct Unit { int pm, pn, pk; };
struct Gemm { const bf16_t* A; const bf16_t* Bt; int K; int splits; };
struct StaticOrder {
    int nM, nN, nNr, pm0, nwg, G, c;
    __device__ void init(int nM_, int nNr_, int splits, int pm0_, int G_, int c_) { nM = nM_; nNr = nNr_; nN = nNr_ * splits; pm0 = pm0_; nwg = nM * nN; G = G_; c = c_; }
    __device__ bool next(int i, Unit& u) const {
        const long L = (long)i * G + c; if (L >= nwg) return false;
        int wgid = (int)L; { const int q = nwg / NXCD, r = nwg % NXCD, xcd = wgid % NXCD, off = wgid / NXCD; wgid = (xcd < r ? xcd * (q + 1) : r * (q + 1) + (xcd - r) * q) + off; }
        const int nig = WGM * nN, gid = wgid / nig, fm = gid * WGM, gsz = (nM - fm) < WGM ? (nM - fm) : WGM;
        const int pnv = (wgid % nig) / gsz;
        u.pm = pm0 + fm + ((wgid % nig) % gsz); u.pn = pnv % nNr; u.pk = pnv / nNr; return true;
    }
};
template <class Epi>
__device__ __forceinline__ void gemm_phase(PG8_LAS unsigned char* lds, const Gemm g, const StaticOrder& S, const Epi& E) {
    const int tid = tid_opaque(), wid = __builtin_amdgcn_readfirstlane(tid >> 6), lane = tid & 63, wr = wid >> 2, wc = wid & 3, fr = lane & 15, fq = lane >> 4;
    const int K = g.K, Kp = K / g.splits, nt = Kp / BK;
    unsigned voffA[2], voffB[2];
#pragma unroll
    for (int i = 0; i < 2; ++i) { int R, C; stage_rc(tid * 16 + i * 8192, R, C); const int Rb = (R & ~31) + perm32(R & 31);
        voffA[i] = (unsigned)(R * K + C) * 2u; voffB[i] = (unsigned)(Rb * K + C) * 2u; }
    const size_t kstep = (size_t)(BK * 2);
    const size_t hstep = (size_t)HALF * K * 2;
    const size_t tstep = 2 * hstep;
    const size_t pstep = (size_t)Kp * 2;
    const unsigned ldsw = (unsigned)wid * 1024u;
    const int aoff = lds_byte(wr * 64 + fr, fq * 8), boff = lds_byte(wc * 32 + fr, fq * 8);
#define PG8_SA(b, h) (((b) * 2 + (h)) * HTB)
#define PG8_SB(b, h) ((4 + (b) * 2 + (h)) * HTB)
#define PG8_STAGE(bufoff, gbase, voff) do { _Pragma("unroll") for (int _i = 0; _i < 2; ++_i) \
        __builtin_amdgcn_global_load_lds((const unsigned*)((const char*)(gbase) + (voff)[_i]), (PG8_LAS unsigned*)(lds + (bufoff) + ldsw + _i * 8192), 16, 0, 0); } while (0)
#define PG8_LDA(dst, b, h) do { _Pragma("unroll") for (int m = 0; m < 4; ++m) _Pragma("unroll") for (int k = 0; k < 2; ++k) dst[m][k] = *(const PG8_LAS bf16x8*)(lds + PG8_SA(b, h) + aoff + m * 2048 + k * 1024); } while (0)
#define PG8_LDB(dst, b, h) do { _Pragma("unroll") for (int n = 0; n < 2; ++n) _Pragma("unroll") for (int k = 0; k < 2; ++k) dst[n][k] = *(const PG8_LAS bf16x8*)(lds + PG8_SB(b, h) + boff + n * 2048 + k * 1024); } while (0)
#define PG8_MMA(ai, bj, At, Bt) do { __builtin_amdgcn_s_setprio(1); _Pragma("unroll") for (int m = 0; m < 4; ++m) _Pragma("unroll") for (int n = 0; n < 2; ++n) _Pragma("unroll") for (int k = 0; k < 2; ++k) \
        acc[ai][bj][m][n] = __builtin_amdgcn_mfma_f32_16x16x32_bf16(Bt[n][k], At[m][k], acc[ai][bj][m][n], 0, 0, 0); __builtin_amdgcn_s_setprio(0); } while (0)
#define PG8_WAIT_V(n) asm volatile("s_waitcnt vmcnt(" #n ")" ::: "memory")
#define PG8_WAIT_L(n) asm volatile("s_waitcnt lgkmcnt(" #n ")" ::: "memory")
#define PG8_BAR __builtin_amdgcn_s_barrier()
#define PG8_SCHED __builtin_amdgcn_sched_barrier(0)
    Unit cur, nxt; int ui = 0;
    if (!S.next(0, cur)) return;
    f32x4 acc[2][2][4][2];
#pragma unroll
    for (int a = 0; a < 2; ++a)
#pragma unroll
        for (int b = 0; b < 2; ++b)
#pragma unroll
            for (int m = 0; m < 4; ++m)
#pragma unroll
                for (int n = 0; n < 2; ++n) acc[a][b][m][n] = (f32x4){0.f, 0.f, 0.f, 0.f};
    bf16x8 At[4][2], B0[2][2], B1[2][2];
    const char* cA = (const char*)g.A + (size_t)cur.pm * tstep + (size_t)cur.pk * pstep; const char* cB = (const char*)g.Bt + (size_t)cur.pn * tstep + (size_t)cur.pk * pstep;
    PG8_STAGE(PG8_SB(0, 0), cB, voffB); PG8_STAGE(PG8_SA(0, 0), cA, voffA); PG8_STAGE(PG8_SB(0, 1), cB + hstep, voffB); PG8_STAGE(PG8_SA(0, 1), cA + hstep, voffA);
    if (wr == 1) PG8_BAR;
    PG8_WAIT_V(4); PG8_BAR;
    PG8_STAGE(PG8_SB(1, 0), cB + kstep, voffB); PG8_STAGE(PG8_SA(1, 0), cA + kstep, voffA); PG8_STAGE(PG8_SB(1, 1), cB + hstep + kstep, voffB);
    PG8_WAIT_V(6); PG8_BAR;
    for (;;) {
        const bool has_next = S.next(ui + 1, nxt);
        const char* nA = has_next ? (const char*)g.A + (size_t)nxt.pm * tstep + (size_t)nxt.pk * pstep : cA; const char* nB = has_next ? (const char*)g.Bt + (size_t)nxt.pn * tstep + (size_t)nxt.pk * pstep : cB;
        for (int t = 0; t < nt; t += 2) {
            const bool last = (t == nt - 2);
            const char* a1 = cA + (size_t)(t + 1) * kstep;
            const char* a2 = last ? nA : cA + (size_t)(t + 2) * kstep; const char* b2 = last ? nB : cB + (size_t)(t + 2) * kstep;
            const char* a3 = a2 + kstep; const char* b3 = b2 + kstep;
            PG8_LDB(B0, 0, 0); PG8_SCHED; PG8_LDA(At, 0, 0); PG8_STAGE(PG8_SA(1, 1), a1 + hstep, voffA);
            PG8_WAIT_L(8); PG8_BAR; PG8_WAIT_L(0); PG8_MMA(0, 0, At, B0); PG8_BAR; PG8_SCHED;
            PG8_LDB(B1, 0, 1); PG8_STAGE(PG8_SB(0, 0), b2, voffB);
            PG8_BAR; PG8_WAIT_L(0); PG8_MMA(0, 1, At, B1); PG8_BAR;
            PG8_LDA(At, 0, 1); PG8_STAGE(PG8_SA(0, 0), a2, voffA);
            PG8_BAR; PG8_WAIT_L(0); PG8_MMA(1, 0, At, B0); PG8_BAR; PG8_SCHED;
            PG8_STAGE(PG8_SB(0, 1), b2 + hstep, voffB);
            PG8_WAIT_V(6); PG8_BAR; PG8_MMA(1, 1, At, B1); PG8_BAR;
            PG8_LDB(B0, 1, 0); PG8_SCHED; PG8_LDA(At, 1, 0); PG8_STAGE(PG8_SA(0, 1), a2 + hstep, voffA);
            PG8_WAIT_L(8); PG8_BAR; PG8_WAIT_L(0); PG8_MMA(0, 0, At, B0); PG8_BAR; PG8_SCHED;
            PG8_LDB(B1, 1, 1); PG8_STAGE(PG8_SB(1, 0), b3, voffB);
            PG8_BAR; PG8_WAIT_L(0); PG8_MMA(0, 1, At, B1); PG8_BAR;
            PG8_LDA(At, 1, 1); PG8_STAGE(PG8_SA(1, 0), a3, voffA);
            PG8_BAR; PG8_WAIT_L(0); PG8_MMA(1, 0, At, B0); PG8_BAR; PG8_SCHED;
            PG8_STAGE(PG8_SB(1, 1), b3 + hstep, voffB);
            PG8_WAIT_V(6); PG8_BAR; PG8_MMA(1, 1, At, B1); PG8_BAR;
        }
#pragma unroll
        for (int ai = 0; ai < 2; ++ai)
#pragma unroll
            for (int m = 0; m < 4; ++m)
#pragma unroll
                for (int bj = 0; bj < 2; ++bj)
                    E(cur.pm * BM + ai * HALF + wr * 64 + m * 16 + fr, cur.pn * BM + bj * HALF + wc * 32 + 8 * fq, acc[ai][bj][m][0], acc[ai][bj][m][1], cur.pk);
        if (!has_next) break;
#pragma unroll
        for (int a = 0; a < 2; ++a)
#pragma unroll
            for (int b = 0; b < 2; ++b)
#pragma unroll
                for (int m = 0; m < 4; ++m)
#pragma unroll
                    for (int n = 0; n < 2; ++n) acc[a][b][m][n] = (f32x4){0.f, 0.f, 0.f, 0.f};
        cur = nxt; cA = nA; cB = nB; ++ui;
    }
    PG8_WAIT_V(0);
    if (wr == 0) PG8_BAR;
    PG8_BAR;
#undef PG8_SA
#undef PG8_SB
#undef PG8_STAGE
#undef PG8_LDA
#undef PG8_LDB
#undef PG8_MMA
#undef PG8_WAIT_V
#undef PG8_WAIT_L
#undef PG8_BAR
#undef PG8_SCHED
}
}

template <class Epi>
__device__ __forceinline__ void gemm_big(const bf16_t* A, int K, const bf16_t* Bt, int Npad, const Epi& e, char* smem, int bid, int nb) {
    pg8::StaticOrder S; S.init(MPAD / 256, Npad / 256, 1, 0, nb, bid);
    pg8::gemm_phase((PG8_LAS unsigned char*)smem, pg8::Gemm{A, Bt, K, 1}, S, e);
}
template <class Epi1, class Epi2>
__device__ __forceinline__ void gemm_n1024(const bf16_t* A, int K, const bf16_t* Bt, const Epi1& e1, const Epi2& e2, int splits, char* smem, int bid, int nb) {
    pg8::StaticOrder S; S.init(64, 4, 1, 0, nb, bid);
    pg8::gemm_phase((PG8_LAS unsigned char*)smem, pg8::Gemm{A, Bt, K, 1}, S, e1);
    pg8::StaticOrder S2; S2.init(3, 4, splits, 64, nb, bid);
    pg8::gemm_phase((PG8_LAS unsigned char*)smem, pg8::Gemm{A, Bt, K, splits}, S2, e2);
}

__device__ __forceinline__ void st_bf16x8(bf16_t* p, f32x4 a, f32x4 b) {
    u32x4 w; w[0] = pk2(a[0], a[1]); w[1] = pk2(a[2], a[3]); w[2] = pk2(b[0], b[1]); w[3] = pk2(b[2], b[3]);
    *(u32x4*)p = w;
}
struct EpiGdnIn {
    bf16_t *mixed, *z; float* ba;
    __device__ __forceinline__ void operator()(int row, int col, f32x4 v0, f32x4 v1, int = 0) const {
        if (col < 4096) st_bf16x8(mixed + (size_t)row * 4096 + col, v0, v1);
        else if (col < 6144) st_bf16x8(z + (size_t)row * 2048 + (col - 4096), v0, v1);
        else if (col < 6176) { *(f32x4*)(ba + (size_t)row * 32 + (col - 6144)) = v0; *(f32x4*)(ba + (size_t)row * 32 + (col - 6144) + 4) = v1; }
    }
};
struct EpiResid {
    float* out; const bf16_t* h;
    __device__ __forceinline__ void operator()(int row, int col, f32x4 v0, f32x4 v1, int = 0) const {
        const uint4 hr = *(const uint4*)(h + (size_t)row * D + col);
        const f32x4 r0 = cvt_bf16x4(make_uint2(hr.x, hr.y)), r1 = cvt_bf16x4(make_uint2(hr.z, hr.w));
        st_bf16x8((bf16_t*)out + (size_t)row * D + col, v0 + r0 * ALPHA, v1 + r1 * ALPHA);
    }
};
struct EpiSlab {
    float* slab;
    __device__ __forceinline__ void operator()(int row, int col, f32x4 v0, f32x4 v1, int pk) const {
        float* o = slab + ((size_t)pk * 768 + (row - 16384)) * D + col;
        *(f32x4*)o = v0; *(f32x4*)(o + 4) = v1;
    }
};
struct EpiRelu2 {
    bf16_t* act;
    __device__ __forceinline__ void operator()(int row, int col, f32x4 v0, f32x4 v1, int = 0) const {
#pragma unroll
        for (int e = 0; e < 4; ++e) { const float r = fmaxf(v0[e], 0.f); v0[e] = r * r; const float q = fmaxf(v1[e], 0.f); v1[e] = q * q; }
        st_bf16x8(act + (size_t)row * DFF + col, v0, v1);
    }
};
struct EpiBf16 {
    bf16_t* out; int ld;
    __device__ __forceinline__ void operator()(int row, int col, f32x4 v0, f32x4 v1, int = 0) const { st_bf16x8(out + (size_t)row * ld + col, v0, v1); }
};

__device__ __forceinline__ void ln_phase(const float* X, const float* __restrict__ g, const float* __restrict__ bta, bf16_t* Hout,
                         float* yp, float* ys, const float* slab, int splits, const bf16_t* hres, int bid, int nb) {
    const int tid_ = tid_opaque(); const int lane = tid_ & 63, wave = tid_ >> 6;
    f32x4 gv[4], bv[4];
#pragma unroll
    for (int j = 0; j < 4; ++j) { gv[j] = *(const f32x4*)(g + j * 256 + lane * 4); bv[j] = *(const f32x4*)(bta + j * 256 + lane * 4); }
    for (int row = bid * 8 + wave; row < NT; row += nb * 8) {
        f32x4 v[4]; float s = 0.f;
        if (row < 16384) {
#pragma unroll
            for (int j = 0; j < 4; ++j) v[j] = ld_bf16x4((const bf16_t*)X + (size_t)row * D + j * 256 + lane * 4);
        } else {
#pragma unroll
            for (int j = 0; j < 4; ++j) v[j] = ld_bf16x4(hres + (size_t)row * D + j * 256 + lane * 4) * ALPHA;
            for (int pk = 0; pk < splits; ++pk) {
                const float* sp = slab + ((size_t)pk * 768 + (row - 16384)) * D + lane * 4;
#pragma unroll
                for (int j = 0; j < 4; ++j) v[j] += *(const f32x4*)(sp + j * 256);
            }
        }
#pragma unroll
        for (int j = 0; j < 4; ++j) s += (v[j][0] + v[j][1]) + (v[j][2] + v[j][3]);
        const float mean = wave_sum(s) * (1.f / D);
        float s2 = 0.f;
#pragma unroll
        for (int j = 0; j < 4; ++j) { v[j] = v[j] - mean; s2 += (v[j][0] * v[j][0] + v[j][1] * v[j][1]) + (v[j][2] * v[j][2] + v[j][3] * v[j][3]); }
        const float rstd = rsqrtf(wave_sum(s2) * (1.f / D) + 1e-5f);
        float* yo = nullptr;
        if (yp) {
            if (row < NPR) { const int b = row / LP, t = row % LP; if (t >= NMETA) yo = yp + ((size_t)b * SEQ + (t - NMETA)) * D; }
            else yo = ys + (size_t)(row - NPR) * D;
        }
#pragma unroll
        for (int j = 0; j < 4; ++j) {
            const f32x4 o = v[j] * rstd * gv[j] + bv[j];
            if (Hout) st_bf16x4(Hout + (size_t)row * D + j * 256 + lane * 4, o);
            if (yo) *(f32x4*)(yo + j * 256 + lane * 4) = o;
        }
    }
}

__device__ __forceinline__ void gdn_sample_pass(const Params& p, char* smem, int pass, int tid) {
    float* sq = (float*)smem;
    float* sk = sq + 256;
    float* part = sk + 256;
    float* part2 = part + 16;
    const int lane = tid & 63, wave = tid >> 6, ug = wave >> 2, wq = wave & 3;
    const int half = lane >> 5, v = wq * 32 + (lane & 31);
    const int u = pass * 2 + ug, b = u >> 4, h = u & 15, kh = h >> 1;
    const size_t row0 = (size_t)NPR + (size_t)b * DS;
    float S[64];
    {
        const float* Sp = p.state_gdn + ((size_t)(b * 16 + h) * 128 + half * 64) * 128 + v;
#pragma unroll
        for (int k = 0; k < 64; ++k) S[k] = Sp[(size_t)k * 128];
    }
    const float Aexp = __expf(p.gdn_a_log[h]);
    const float dtb = p.gdn_dt_bias[h];
    const float nw = p.gdn_norm_w[v];
    const int chA = (half ? 1024 : 0) + kh * 128 + v, chv = 2048 + h * 128 + v;
    float cA[4], cv[4];
#pragma unroll
    for (int j = 0; j < 4; ++j) { cA[j] = p.gdn_conv_w[j * 4096 + chA]; cv[j] = p.gdn_conv_w[j * 4096 + chv]; }
    float xA[7], xv[7];
#pragma unroll
    for (int i = 0; i < 3; ++i) {
        const float* cs = p.state_conv + ((size_t)b * 3 + i) * 4096;
        xA[i] = cs[chA]; xv[i] = cs[chv];
    }
#pragma unroll
    for (int i = 0; i < 4; ++i) {
        const bf16_t* mr = p.mixed + (row0 + i) * 4096;
        xA[3 + i] = bf2f(mr[chA]); xv[3 + i] = bf2f(mr[chv]);
    }
    float* sqg = sq + ug * 128;
    float* skg = sk + ug * 128;
    float* pg = part + ug * 8;
    float* pg2 = part2 + ug * 4;
    const float* kmine = skg + half * 64;
    const float* qmine = sqg + half * 64;
#pragma unroll
    for (int t = 0; t < DS; ++t) {
        const float yA = silu(xA[t] * cA[0] + xA[t + 1] * cA[1] + xA[t + 2] * cA[2] + xA[t + 3] * cA[3]);
        const float yv = silu(xv[t] * cv[0] + xv[t + 1] * cv[1] + xv[t + 2] * cv[2] + xv[t + 3] * cv[3]);
        (half ? skg : sqg)[v] = yA;
        float ssA = yA * yA;
#pragma unroll
        for (int o = 1; o < 32; o <<= 1) ssA += __shfl_xor(ssA, o);
        if ((lane & 31) == 0) pg[wq * 2 + half] = ssA;
        lds_barrier();
        const float qn = rsqrtf((pg[0] + pg[2]) + (pg[4] + pg[6]) + 1e-6f) * 0.08838834764831845f;
        const float kn = rsqrtf((pg[1] + pg[3]) + (pg[5] + pg[7]) + 1e-6f);
        const float* bap = p.ba + (row0 + t) * 32;
        const float beta = 1.f / (1.f + __expf(-bap[h]));
        const float aa = bap[16 + h] + dtb;
        const float sp = (aa > 20.f) ? aa : log1pf(__expf(aa));
        const float dec = __expf(-Aexp * sp);
        float kS0 = 0.f, kS1 = 0.f;
#pragma unroll
        for (int k = 0; k < 64; k += 4) {
            const f32x4 kk = *(const f32x4*)(kmine + k);
            S[k] *= dec; S[k + 1] *= dec; S[k + 2] *= dec; S[k + 3] *= dec;
            kS0 += kk[0] * S[k]; kS1 += kk[1] * S[k + 1]; kS0 += kk[2] * S[k + 2]; kS1 += kk[3] * S[k + 3];
        }
        float kS = kS0 + kS1;
        kS += __shfl_xor(kS, 32);
        const float delta = (yv - kS * kn) * beta * kn;
        float o0 = 0.f, o1 = 0.f;
#pragma unroll
        for (int k = 0; k < 64; k += 4) {
            const f32x4 kk = *(const f32x4*)(kmine + k);
            const f32x4 qq = *(const f32x4*)(qmine + k);
            S[k] += kk[0] * delta; S[k + 1] += kk[1] * delta; S[k + 2] += kk[2] * delta; S[k + 3] += kk[3] * delta;
            o0 += qq[0] * S[k]; o1 += qq[1] * S[k + 1]; o0 += qq[2] * S[k + 2]; o1 += qq[3] * S[k + 3];
        }
        float o = o0 + o1;
        o = (o + __shfl_xor(o, 32)) * qn;
        float s3 = o * o;
#pragma unroll
        for (int x = 1; x < 32; x <<= 1) s3 += __shfl_xor(s3, x);
        if (lane == 0) pg2[wq] = s3;
        lds_barrier();
        if (half == 0) {
            const float rms = rsqrtf(((pg2[0] + pg2[1]) + (pg2[2] + pg2[3])) * (1.f / 128.f) + 1e-6f);
            const float zz = bf2f(p.z[(row0 + t) * 2048 + h * 128 + v]);
            p.gated[(row0 + t) * 2048 + h * 128 + v] = f2bf(o * rms * nw * silu(zz));
        }
    }
    {
        float* So = p.gs_sample + ((size_t)(b * 16 + h) * 128 + half * 64) * 128 + v;
#pragma unroll
        for (int k = 0; k < 64; ++k) So[(size_t)k * 128] = S[k];
    }
    lds_barrier();
}

#define MFMA32(a, b, c) __builtin_amdgcn_mfma_f32_32x32x16_bf16((a), (b), (c), 0, 0, 0)
constexpr int NCH = 65;
constexpr int NCU = BATCH * 16 * NCH;
__device__ __forceinline__ int crow(int reg, int hh) { return (reg & 3) + 8 * (reg >> 2) + 4 * hh; }
__device__ __forceinline__ bf16x8 pack_step(const f32x16& x, int s) {
    u32x4 q;
    q[0] = pk2(x[8 * s + 0], x[8 * s + 1]); q[1] = pk2(x[8 * s + 2], x[8 * s + 3]);
    q[2] = pk2(x[8 * s + 4], x[8 * s + 5]); q[3] = pk2(x[8 * s + 6], x[8 * s + 7]);
    return __builtin_bit_cast(bf16x8, q);
}
__device__ __forceinline__ bf16x8 frag_perm(const bf16_t* p0) {
    const uint2 lo = *(const uint2*)p0, hi = *(const uint2*)(p0 + 8);
    u32x4 q; q[0] = lo.x; q[1] = lo.y; q[2] = hi.x; q[3] = hi.y;
    return __builtin_bit_cast(bf16x8, q);
}

constexpr int SA_KB = 64 * 136 * 2, SA_VB = 2 * SA_KB, SA_AM = 3 * SA_KB, SA_SM = SA_AM + 64 * 68 * 4, SA_GROUP_BYTES = SA_SM + 5 * 64 * 4;
__device__ __forceinline__ void gdn_stageA(const Params& p, char* smem0, int bid, int nb) {
    {
        const int tid = tid_opaque();
        for (int idx = bid * NTHR + tid; idx < (BATCH + DB) * 3 * 4096; idx += nb * NTHR) {
            const int c = idx & 4095, r = (idx >> 12) % 3, b = idx / (3 * 4096);
            if (b < BATCH) p.gc_prompt[idx] = bf2f(p.mixed[((size_t)b * LP + (LP - 3) + r) * 4096 + c]);
            else { const int bs = b - BATCH; p.gc_sample[(size_t)(bs * 3 + r) * 4096 + c] = bf2f(p.mixed[((size_t)NPR + bs * 4 + 1 + r) * 4096 + c]); }
        }
    }
    for (int base = bid * 2; base < NCU; base += nb * 2) {
        const int tid = tid_opaque(), lane = tid & 63, grp = tid >> 8, wg = (tid >> 6) & 3, t2 = tid & 255;
        unsigned zofs = 0; asm volatile("" : "+v"(zofs));
        char* smem = smem0 + zofs + grp * SA_GROUP_BYTES;
        bf16_t* Qb = (bf16_t*)smem;
        bf16_t* Kb = (bf16_t*)(smem + SA_KB);
        bf16_t* Vb = (bf16_t*)(smem + SA_VB);
        float* Am = (float*)(smem + SA_AM);
        float* sbeta = (float*)(smem + SA_SM);
        float* sgc = sbeta + 64;
        float* segc = sgc + 64;
        float* sekd = segc + 64;
        float* srk = sekd + 64;
        const int u = base + grp;
        const bool tail = base >= 4096;
        const int h = u & 15, n = tail ? 64 : ((u >> 4) & 63), b = tail ? ((u - 4096) >> 4) : (u >> 10);
        const int kh = h >> 1;
        const size_t su = (size_t)((b * 16 + h) * NCH + n);
        const int t0 = n * 64;
        if (tail && wg > 0) {
            const int cq = lane & 31, tsel = lane >> 5;
            const int tl0 = 16 * wg + 8 * tsel;
#pragma unroll
            for (int i = 0; i < 8; ++i) {
                *(uint2*)(Qb + (tl0 + i) * 136 + cq * 4) = make_uint2(0u, 0u);
                *(uint2*)(Kb + (tl0 + i) * 136 + cq * 4) = make_uint2(0u, 0u);
                *(uint2*)(Vb + (tl0 + i) * 136 + cq * 4) = make_uint2(0u, 0u);
            }
        } else {
            const int cq = lane & 31, tsel = lane >> 5;
            const int tl0 = 16 * wg + 8 * tsel;
#pragma unroll
            for (int pp = 0; pp < 2; ++pp) {
                const int part = pp ? 2 : grp;
                const int chb = ((part == 0) ? (kh * 128) : (part == 1) ? (1024 + kh * 128) : (2048 + h * 128)) + cq * 4;
                f32x4 cw[4];
#pragma unroll
                for (int j = 0; j < 4; ++j) cw[j] = *(const f32x4*)(p.gdn_conv_w + j * 4096 + chb);
                uint2 xr[11];
#pragma unroll
                for (int i = 0; i < 11; ++i) {
                    const int t = t0 + tl0 - 3 + i;
                    if (t >= 0 && t < LP) xr[i] = *(const uint2*)(p.mixed + ((size_t)b * LP + t) * 4096 + chb);
                    else xr[i] = make_uint2(0u, 0u);
                }
                f32x4 yv[8];
                float ssv[8];
#pragma unroll
                for (int i = 0; i < 8; ++i) {
                    const f32x4 a = cvt_bf16x4(xr[i]) * cw[0] + cvt_bf16x4(xr[i + 1]) * cw[1] + cvt_bf16x4(xr[i + 2]) * cw[2] + cvt_bf16x4(xr[i + 3]) * cw[3];
                    const bool valid = (t0 + tl0 + i) < LP;
#pragma unroll
                    for (int e2 = 0; e2 < 4; ++e2) yv[i][e2] = valid ? silu(a[e2]) : 0.f;
                    ssv[i] = (yv[i][0] * yv[i][0] + yv[i][1] * yv[i][1]) + (yv[i][2] * yv[i][2] + yv[i][3] * yv[i][3]);
                }
                if (part < 2) {
#pragma unroll
                    for (int o = 1; o < 32; o <<= 1)
#pragma unroll
                        for (int i = 0; i < 8; ++i) ssv[i] += __shfl_xor(ssv[i], o);
                }
                bf16_t* dst = (part == 0) ? Qb : (part == 1) ? Kb : Vb;
                bf16_t* dst2 = (bf16_t*)((char*)dst + (grp ? -SA_GROUP_BYTES : SA_GROUP_BYTES));
#pragma unroll
                for (int i = 0; i < 8; ++i) {
                    f32x4 y = yv[i];
                    if (part < 2) y = y * (rsqrtf(ssv[i] + 1e-6f) * ((part == 0) ? 0.08838834764831845f : 1.f));
                    st_bf16x4(dst + (tl0 + i) * 136 + cq * 4, y);
                    if (part < 2) st_bf16x4(dst2 + (tl0 + i) * 136 + cq * 4, y);
                }
            }
        }
        if (wg == 0) {
            const int c = lane, t = t0 + c;
            float beta = 0.f, g = 0.f;
            if (t < LP) {
                const float* bap = p.ba + ((size_t)b * LP + t) * 32;
                beta = 1.f / (1.f + __expf(-bap[h]));
                const float aa = bap[16 + h] + p.gdn_dt_bias[h];
                const float sp = (aa > 20.f) ? aa : log1pf(__expf(aa));
                g = -__expf(p.gdn_a_log[h]) * sp;
            }
            float gc = g;
#pragma unroll
            for (int o = 1; o < 64; o <<= 1) { const float v = __shfl_up(gc, o); if (lane >= o) gc += v; }
            const float glast = __shfl(gc, 63);
            sbeta[c] = beta; sgc[c] = gc; segc[c] = __expf(gc); sekd[c] = __expf(glast - gc); srk[c] = beta * __expf(gc);
            if (lane == 0) p.g_dec[su] = __expf(glast);
        }
        lds_barrier();
        {
            const int ti = wg >> 1, tj = wg & 1;
            const int r = lane & 31, hh = lane >> 5;
            const int c = 32 * tj + r;
            const float gcc = sgc[c], bc = sbeta[c];
            f32x16 acck, accq;
#pragma unroll
            for (int i = 0; i < 16; ++i) { acck[i] = 0.f; accq[i] = 0.f; }
            {
                const bf16_t* Ap = Kb + (32 * ti + r) * 136 + 8 * hh;
                const bf16_t* Bk = Kb + (32 * tj + r) * 136 + 8 * hh;
                const bf16_t* Bq = Qb + (32 * tj + r) * 136 + 8 * hh;
#pragma unroll
                for (int ks = 0; ks < 8; ++ks) {
                    const bf16x8 a = *(const bf16x8*)(Ap + 16 * ks);
                    acck = MFMA32(a, *(const bf16x8*)(Bk + 16 * ks), acck);
                    accq = MFMA32(a, *(const bf16x8*)(Bq + 16 * ks), accq);
                }
            }
#pragma unroll
            for (int reg = 0; reg < 16; ++reg) {
                const int cp = 32 * ti + crow(reg, hh);
                const float dcy = __expf(fminf(gcc - sgc[cp], 0.f));
                Am[(c >> 1) * 136 + cp * 2 + (c & 1)] = (cp < c) ? (bc * acck[reg] * dcy) : 0.f;
            }
            {
                bf16_t* aq = p.g_aqk + su * 4096 + (size_t)(((ti * 2 + tj) * 4) * 2 * 32) * 4 + (size_t)(hh * 32 + r) * 4;
#pragma unroll
                for (int g4 = 0; g4 < 4; ++g4) {
                    const int cp0 = 32 * ti + 8 * g4 + 4 * hh;
                    f32x4 v;
#pragma unroll
                    for (int e2 = 0; e2 < 4; ++e2) {
                        const int cp = cp0 + e2;
                        const float dcy = __expf(fminf(gcc - sgc[cp], 0.f));
                        v[e2] = (cp <= c) ? (accq[4 * g4 + e2] * dcy) : 0.f;
                    }
                    st_bf16x4(aq + (size_t)g4 * (2 * 32 * 4), v);
                }
            }
        }
        {
#pragma unroll
            for (int it = 0; it < 4; ++it) {
                const int chk = t2 + 256 * it, c = chk >> 4, d0 = (chk & 15) * 8;
                const float ee = segc[c];
                const uint4 raw = *(const uint4*)(Qb + c * 136 + d0);
                uint4 o;
                o.x = pk2(__uint_as_float(raw.x << 16) * ee, __uint_as_float(raw.x & 0xffff0000u) * ee);
                o.y = pk2(__uint_as_float(raw.y << 16) * ee, __uint_as_float(raw.y & 0xffff0000u) * ee);
                o.z = pk2(__uint_as_float(raw.z << 16) * ee, __uint_as_float(raw.z & 0xffff0000u) * ee);
                o.w = pk2(__uint_as_float(raw.w << 16) * ee, __uint_as_float(raw.w & 0xffff0000u) * ee);
                *(uint4*)(p.g_qg + su * 8192 + c * 128 + d0) = o;
            }
#pragma unroll
            for (int it = 0; it < 4; ++it) {
                const int item = t2 + 256 * it, d = item & 127, c0 = (item >> 7) * 8;
                float v[8];
#pragma unroll
                for (int i = 0; i < 8; ++i) v[i] = bf2f(Kb[(c0 + i) * 136 + d]) * sekd[c0 + i];
                uint4 o; o.x = pk2(v[0], v[1]); o.y = pk2(v[2], v[3]); o.z = pk2(v[4], v[5]); o.w = pk2(v[6], v[7]);
                *(uint4*)(p.g_kdT + su * 8192 + (size_t)item * 8) = o;
            }
        }
        lds_barrier();
        {
            const int col = 64 * wg + lane;
            const float* rs = sbeta + __builtin_amdgcn_readfirstlane((wg < 2) ? 0 : 256);
            const bf16_t* src = ((wg < 2) ? Vb : Kb) + (col & 127);
            float x[64];
#pragma unroll
            for (int i = 0; i < 64; ++i) x[i] = bf2f(src[i * 136]) * rs[i];
#pragma unroll
            for (int i0 = 0; i0 < 64; i0 += 4) {
                if (tail && i0 >= 16) continue;
                f32x2 a01 = {x[i0], x[i0 + 1]}, a23 = {x[i0 + 2], x[i0 + 3]};
                const float* P0 = Am + (i0 >> 1) * 136;
                const float* P1 = P0 + 136;
#pragma unroll
                for (int j4 = 0; j4 < i0; j4 += 4) {
                    const f32x4 q0 = *(const f32x4*)(P0 + 2 * j4), q1 = *(const f32x4*)(P0 + 2 * j4 + 4);
                    const f32x4 q2 = *(const f32x4*)(P1 + 2 * j4), q3 = *(const f32x4*)(P1 + 2 * j4 + 4);
                    a01 -= (f32x2){q0[0], q0[1]} * x[j4]; a23 -= (f32x2){q2[0], q2[1]} * x[j4];
                    a01 -= (f32x2){q0[2], q0[3]} * x[j4 + 1]; a23 -= (f32x2){q2[2], q2[3]} * x[j4 + 1];
                    a01 -= (f32x2){q1[0], q1[1]} * x[j4 + 2]; a23 -= (f32x2){q3[0], q3[1]} * x[j4 + 2];
                    a01 -= (f32x2){q1[2], q1[3]} * x[j4 + 3]; a23 -= (f32x2){q3[2], q3[3]} * x[j4 + 3];
                    if ((j4 & 12) == 12) asm volatile("" ::: "memory");
                }
                const f32x4 l0 = *(const f32x4*)(P0 + 2 * i0), l1 = *(const f32x4*)(P1 + 2 * i0), l2 = *(const f32x4*)(P1 + 2 * i0 + 4);
                const float a0 = a01[0];
                const float a1 = a01[1] - l0[1] * a0;
                const float a2 = a23[0] - l1[0] * a0 - l1[2] * a1;
                const float a3 = a23[1] - l1[1] * a0 - l1[3] * a1 - l2[1] * a2;
                x[i0] = a0; x[i0 + 1] = a1; x[i0 + 2] = a2; x[i0 + 3] = a3;
                asm volatile("" ::: "memory");
            }
            if (wg < 2) {
                float* up = p.g_u + su * 8192 + col;
#pragma unroll
                for (int i = 0; i < 64; ++i) up[i * 128] = x[i];
            } else {
                bf16_t* wp = p.g_negw + su * 8192 + (col - 128);
#pragma unroll
                for (int i = 0; i < 64; ++i) wp[i * 128] = f2bf(-x[i]);
            }
        }
        lds_barrier();
    }
}

constexpr int GB_NW = 0, GB_QG = 64 * 136, GB_KD = 2 * 64 * 136, GB_AQ = 2 * 64 * 136 + 128 * 72, GB_ELEMS = 2 * 64 * 136 + 128 * 72 + 64 * 72;
__device__ __forceinline__ void gdn_chain(const Params& p, char* smem, int b, int h) {
    bf16_t* lds = (bf16_t*)smem;
    const int tid = tid_opaque(), lane = tid & 63, wave = tid >> 6;
    const int r = lane & 31, hh = lane >> 5;
    const size_t su0 = (size_t)(b * 16 + h) * NCH;
    const bool loader = wave >= 4;
    const int t2 = tid - 256;
    uint4 sa0, sa1, sa2, sa3, sa4, sa5, sa6, sa7, sa8, sa9, sa10, sa11, sa12, sa13;
    uint4 sb0, sb1, sb2, sb3, sb4, sb5, sb6, sb7, sb8, sb9, sb10, sb11, sb12, sb13;
    f32x16 S[4], un0, un1;
#pragma unroll
    for (int i = 0; i < 4; ++i)
#pragma unroll
        for (int j = 0; j < 16; ++j) S[i][j] = 0.f;
    const int ch0 = t2, ch1 = t2 + 256, ch2 = t2 + 512, ch3 = t2 + 768;
#define GB_GLOAD(P, n_) do { const size_t su_ = su0 + (n_); \
        const bf16_t* a_ = p.g_negw + su_ * 8192; const bf16_t* b_ = p.g_qg + su_ * 8192; const bf16_t* c_ = p.g_kdT + su_ * 8192; const bf16_t* d_ = p.g_aqk + su_ * 4096; \
        P##0 = *(const uint4*)(a_ + (size_t)ch0 * 8); P##1 = *(const uint4*)(a_ + (size_t)ch1 * 8); P##2 = *(const uint4*)(a_ + (size_t)ch2 * 8); P##3 = *(const uint4*)(a_ + (size_t)ch3 * 8); \
        P##4 = *(const uint4*)(b_ + (size_t)ch0 * 8); P##5 = *(const uint4*)(b_ + (size_t)ch1 * 8); P##6 = *(const uint4*)(b_ + (size_t)ch2 * 8); P##7 = *(const uint4*)(b_ + (size_t)ch3 * 8); \
        P##8 = *(const uint4*)(c_ + (size_t)ch0 * 8); P##9 = *(const uint4*)(c_ + (size_t)ch1 * 8); P##10 = *(const uint4*)(c_ + (size_t)ch2 * 8); P##11 = *(const uint4*)(c_ + (size_t)ch3 * 8); \
        P##12 = *(const uint4*)(d_ + (size_t)ch0 * 8); P##13 = *(const uint4*)(d_ + (size_t)ch1 * 8); } while (0)
#define GB_SSTORE(P, buf_) do { bf16_t* q_ = (buf_); \
        *(uint4*)(q_ + GB_NW + (ch0 >> 4) * 136 + (ch0 & 15) * 8) = P##0; *(uint4*)(q_ + GB_NW + (ch1 >> 4) * 136 + (ch1 & 15) * 8) = P##1; \
        *(uint4*)(q_ + GB_NW + (ch2 >> 4) * 136 + (ch2 & 15) * 8) = P##2; *(uint4*)(q_ + GB_NW + (ch3 >> 4) * 136 + (ch3 & 15) * 8) = P##3; \
        *(uint4*)(q_ + GB_QG + (ch0 >> 4) * 136 + (ch0 & 15) * 8) = P##4; *(uint4*)(q_ + GB_QG + (ch1 >> 4) * 136 + (ch1 & 15) * 8) = P##5; \
        *(uint4*)(q_ + GB_QG + (ch2 >> 4) * 136 + (ch2 & 15) * 8) = P##6; *(uint4*)(q_ + GB_QG + (ch3 >> 4) * 136 + (ch3 & 15) * 8) = P##7; \
        *(uint4*)(q_ + GB_KD + (ch0 & 127) * 72 + (ch0 >> 7) * 8) = P##8; *(uint4*)(q_ + GB_KD + (ch1 & 127) * 72 + (ch1 >> 7) * 8) = P##9; \
        *(uint4*)(q_ + GB_KD + (ch2 & 127) * 72 + (ch2 >> 7) * 8) = P##10; *(uint4*)(q_ + GB_KD + (ch3 & 127) * 72 + (ch3 >> 7) * 8) = P##11; \
        GB_AQ_ST(q_, ch0, P##12); GB_AQ_ST(q_, ch1, P##13); } while (0)
#define GB_AQ_ST(q_, ch_, v_) do { const int pq_ = 2 * (ch_), r_ = pq_ & 31, hh_ = (pq_ >> 5) & 1, g4_ = (pq_ >> 6) & 3, tl_ = pq_ >> 8; \
        bf16_t* d_ = (q_) + GB_AQ + (32 * (tl_ & 1) + r_) * 72 + 32 * (tl_ >> 1) + 8 * g4_ + 4 * hh_; \
        *(uint2*)d_ = make_uint2((v_).x, (v_).y); *(uint2*)(d_ + 72) = make_uint2((v_).z, (v_).w); } while (0)
#define GB_ULOAD(n_) do { const float* up_ = p.g_u + (su0 + (n_)) * 8192 + 32 * wave + r; \
        _Pragma("unroll") for (int reg_ = 0; reg_ < 16; ++reg_) { un0[reg_] = up_[(crow(reg_, hh)) * 128]; un1[reg_] = up_[(32 + crow(reg_, hh)) * 128]; } } while (0)
    if (loader) {
        bf16_t* buf0 = lds;
        bf16_t* buf1 = lds + GB_ELEMS;
        GB_GLOAD(sa, 0); GB_SSTORE(sa, buf0);
        GB_GLOAD(sa, 1);
        lds_barrier();
        for (int n = 0; n < NCH; n += 2) {
            if (n + 2 < NCH) { GB_GLOAD(sb, n + 2); }
            if (n + 1 < NCH) { GB_SSTORE(sa, buf1); }
            lds_barrier();
            if (n + 1 >= NCH) break;
            if (n + 3 < NCH) { GB_GLOAD(sa, n + 3); }
            if (n + 2 < NCH) { GB_SSTORE(sb, buf0); }
            lds_barrier();
        }
    } else {
        GB_ULOAD(0);
        float dec_next = p.g_dec[su0];
        lds_barrier();
        for (int n = 0; n < NCH; ++n) {
            unsigned zofs = 0; asm volatile("" : "+v"(zofs));
            bf16_t* cur = lds + (n & 1) * GB_ELEMS + zofs;
            const bool more = (n + 1 < NCH);
            const float dec = dec_next;
            if (more) dec_next = p.g_dec[su0 + n + 1];
            f32x16 vn[2], o[2];
            vn[0] = un0; vn[1] = un1;
#pragma unroll
            for (int j = 0; j < 16; ++j) { o[0][j] = 0.f; o[1][j] = 0.f; }
            if (more) { GB_ULOAD(n + 1); }
#pragma unroll
            for (int kt = 0; kt < 4; ++kt)
#pragma unroll
                for (int s = 0; s < 2; ++s) {
                    const bf16x8 sb = pack_step(S[kt], s);
                    const int k0 = 32 * kt + 16 * s + 4 * hh;
#pragma unroll
                    for (int ct = 0; ct < 2; ++ct) {
                        vn[ct] = MFMA32(frag_perm(cur + GB_NW + (32 * ct + r) * 136 + k0), sb, vn[ct]);
                        o[ct] = MFMA32(frag_perm(cur + GB_QG + (32 * ct + r) * 136 + k0), sb, o[ct]);
                    }
                }
            bf16x8 vb[2][2];
#pragma unroll
            for (int ct = 0; ct < 2; ++ct)
#pragma unroll
                for (int s = 0; s < 2; ++s) vb[ct][s] = pack_step(vn[ct], s);
            {
                o[1] = MFMA32(frag_perm(cur + GB_AQ + (32 + r) * 72 + 4 * hh), vb[0][0], o[1]);
                o[0] = MFMA32(frag_perm(cur + GB_AQ + (r) * 72 + 4 * hh), vb[0][0], o[0]);
                o[1] = MFMA32(frag_perm(cur + GB_AQ + (32 + r) * 72 + 16 + 4 * hh), vb[0][1], o[1]);
                o[0] = MFMA32(frag_perm(cur + GB_AQ + (r) * 72 + 16 + 4 * hh), vb[0][1], o[0]);
                o[1] = MFMA32(frag_perm(cur + GB_AQ + (32 + r) * 72 + 32 + 4 * hh), vb[1][0], o[1]);
                o[1] = MFMA32(frag_perm(cur + GB_AQ + (32 + r) * 72 + 32 + 16 + 4 * hh), vb[1][1], o[1]);
            }
#pragma unroll
            for (int dt = 0; dt < 4; ++dt) S[dt] = S[dt] * dec;
#pragma unroll
            for (int ckt = 0; ckt < 2; ++ckt)
#pragma unroll
                for (int s = 0; s < 2; ++s)
#pragma unroll
                    for (int dt = 0; dt < 4; ++dt)
                        S[dt] = MFMA32(frag_perm(cur + GB_KD + (32 * dt + r) * 72 + 32 * ckt + 16 * s + 4 * hh), vb[ckt][s], S[dt]);
            asm volatile("" :: "v"(un0), "v"(un1), "v"(dec_next));
#pragma unroll
            for (int ct = 0; ct < 2; ++ct)
#pragma unroll
                for (int reg = 0; reg < 16; ++reg) {
                    const int t = 64 * n + 32 * ct + crow(reg, hh);
                    if (t < LP) p.g_o[(((size_t)b * LP + t) * 16 + h) * 128 + 32 * wave + r] = f2bf(o[ct][reg]);
                }
            lds_barrier();
        }
    }
    if (!loader) {
#pragma unroll
        for (int dt = 0; dt < 4; ++dt)
#pragma unroll
            for (int reg = 0; reg < 16; ++reg)
                p.gs_prompt[((size_t)(b * 16 + h) * 128 + 32 * dt + crow(reg, hh)) * 128 + 32 * wave + r] = S[dt][reg];
    }
    lds_barrier();
}

__device__ __forceinline__ void gdn_seq_phase(const Params& p, char* smem, int bid, int nb, int rep = 0) {
    if (bid < 64) gdn_chain(p, smem, bid >> 4, bid & 15);
    else {
        float* tile = (float*)smem;
        const int b2 = bid - 64, n2 = nb - 64;
        transpose_convert(p.gdn_w_out, 2048, D, D, p.wt_gout, tile, b2, n2);
        transpose_convert(p.mlp_w1, D, DFF, DFF, p.wt_w1, tile, b2, n2);
        transpose_convert(p.mlp_w1 + (size_t)D * DFF, D, DFF, DFF, p.wt_w1 + (size_t)D * DFF, tile, b2, n2);
        transpose_convert(p.mlp_w2, DFF, D, D, p.wt_w2, tile, b2, n2);
        transpose_convert(p.mlp_w2 + (size_t)D * DFF, DFF, D, D, p.wt_w2 + (size_t)D * DFF, tile, b2, n2);
        transpose_convert(p.dsa_w_in, D, DIN, DIN_PAD, p.wt_din, tile, b2, n2);
        transpose_convert(p.dsa_w_o, D, D, D, p.wt_do, tile, b2, n2);
    }
    int* slot = (int*)(smem + LDS_BYTES - 32);
    const int tid = tid_opaque();
    for (;;) {
        if (threadIdx.x == 0) *slot = (int)atomicAdd(p.bar + 3520 + 16 * rep, 1u);
        lds_barrier();
        const int u = *slot;
        lds_barrier();
        if (u >= DB * 16 / 2) break;
        gdn_sample_pass(p, smem, u, tid_opaque());
    }
}

__device__ __forceinline__ void gdn_gate_phase(const Params& p, int bid, int nb) {
    const int tid_ = tid_opaque(); const int lane = tid_ & 63, wave = tid_ >> 6;
    const int sub = lane >> 4, l16 = lane & 15;
    f32x4 nw0 = *(const f32x4*)(p.gdn_norm_w + l16 * 8), nw1 = *(const f32x4*)(p.gdn_norm_w + l16 * 8 + 4);
    for (int it4 = bid * 8 + wave; it4 < NPR * 4; it4 += nb * 8) {
        const size_t off = ((size_t)it4 * 4 + sub) * 128 + l16 * 8;
        const uint4 ov = *(const uint4*)(p.g_o + off);
        const uint4 zv = *(const uint4*)(p.z + off);
        const f32x4 o0 = cvt_bf16x4(make_uint2(ov.x, ov.y)), o1 = cvt_bf16x4(make_uint2(ov.z, ov.w));
        const f32x4 z0 = cvt_bf16x4(make_uint2(zv.x, zv.y)), z1 = cvt_bf16x4(make_uint2(zv.z, zv.w));
        float ss = ((o0[0] * o0[0] + o0[1] * o0[1]) + (o0[2] * o0[2] + o0[3] * o0[3])) + ((o1[0] * o1[0] + o1[1] * o1[1]) + (o1[2] * o1[2] + o1[3] * o1[3]));
#pragma unroll
        for (int x = 1; x < 16; x <<= 1) ss += __shfl_xor(ss, x);
        const float rms = rsqrtf(ss * (1.f / 128.f) + 1e-6f);
        uint4 g;
        g.x = pk2(o0[0] * rms * nw0[0] * silu(z0[0]), o0[1] * rms * nw0[1] * silu(z0[1]));
        g.y = pk2(o0[2] * rms * nw0[2] * silu(z0[2]), o0[3] * rms * nw0[3] * silu(z0[3]));
        g.z = pk2(o1[0] * rms * nw1[0] * silu(z1[0]), o1[1] * rms * nw1[1] * silu(z1[1]));
        g.w = pk2(o1[2] * rms * nw1[2] * silu(z1[2]), o1[3] * rms * nw1[3] * silu(z1[3]));
        *(uint4*)(p.gated + off) = g;
    }
}

__device__ __forceinline__ size_t ikb_off(int b, int t, int d) {
    return (size_t)b * LPAD * 64 + (size_t)(t >> 5) * 2048 + (size_t)(d >> 4) * 512 + (size_t)((((d >> 3) & 1) * 32 + (t & 31)) * 8 + (d & 7));
}
__device__ __forceinline__ void rope4(const float* tab, int fi, f32x4 x, f32x4 partner, bool first, f32x4& o) {
    const f32x4 t0 = *(const f32x4*)(tab + fi * 2), t1 = *(const f32x4*)(tab + fi * 2 + 4);
    const float sg = first ? -1.f : 1.f;
    o[0] = x[0] * t0[0] + sg * partner[0] * t0[1];
    o[1] = x[1] * t0[2] + sg * partner[1] * t0[3];
    o[2] = x[2] * t1[0] + sg * partner[2] * t1[1];
    o[3] = x[3] * t1[2] + sg * partner[3] * t1[3];
}
__device__ __forceinline__ void dsa_post_phase(const Params& p, char* smem, int bid, int nb) {
    bf16_t* vt = (bf16_t*)smem;
    for (int u = bid; u < 260 + NSR / 8; u += nb) {
        const int tid = tid_opaque(); const int lane = tid & 63, wave = tid >> 6;
        const bool prompt = u < 260;
        const int b = prompt ? ((u < 256) ? (u >> 6) : (u - 256)) : 0, t0 = prompt ? ((u < 256) ? (u & 63) * 64 : 4096) : 0;
        const int nr8 = prompt ? 8 : 1;
        for (int r8 = 0; r8 < nr8; ++r8) {
            const int tl = wave * 8 + r8;
            const int tlp = (tl & ~12) | ((tl & 4) << 1) | ((tl & 8) >> 1);
            const int t = t0 + tl;
            const bool rvalid = prompt ? (t < LP) : true;
            const int row = prompt ? (b * LP + t) : (NPR + (u - 260) * 8 + wave);
            if (!rvalid) {
                for (int e = lane; e < 256; e += 64) vt[e * 72 + tlp] = 0;
                continue;
            }
            const bf16_t* P = (const bf16_t*)p.p1 + (size_t)row * DIN_PAD;
            const int pos = prompt ? t : (PAST + ((row - NPR) & 3));
            const float* tab = p.rope_tab + (size_t)pos * 48;
            float* kout = prompt ? (p.k_prompt + (size_t)row * 256) : (p.k_sample + (size_t)(row - NPR) * 256);
            float* vout = prompt ? (p.v_prompt + (size_t)row * 256) : (p.v_sample + (size_t)(row - NPR) * 256);
#pragma unroll
            for (int j = 0; j < 5; ++j) {
                const int e0 = (lane + 64 * j) * 4, d0 = e0 & 127;
                f32x4 x = ld_bf16x4(P + e0);
                if (d0 < 32) {
                    const bool first = d0 < 16;
                    const f32x4 pr = ld_bf16x4(P + (first ? e0 + 16 : e0 - 16));
                    rope4(tab, d0 & 15, x, pr, first, x);
                }
                if (j < 4) {
                    if (prompt) st_bf16x4(p.q_b + (size_t)row * 1024 + e0, x * 0.12751743f);
                    else *(f32x4*)(p.qr + (size_t)row * 1024 + e0) = x;
                } else {
                    const int ek = e0 - 1024;
                    *(f32x4*)(kout + ek) = x;
                    if (prompt) st_bf16x4(p.k_b + ((size_t)(b * 2 + (ek >> 7)) * LPAD + t) * 128 + d0, x);
                }
            }
            {
                const int e0 = lane * 4;
                const f32x4 x = ld_bf16x4(P + 1280 + e0);
                *(f32x4*)(vout + e0) = x;
                if (prompt) {
#pragma unroll
                    for (int i = 0; i < 4; ++i) vt[(e0 + i) * 72 + tlp] = f2bf(x[i]);
                }
            }
#pragma unroll
            for (int j = 0; j < 2; ++j) {
                const int e0 = (lane + 64 * j) * 4, d0 = e0 & 63;
                f32x4 x = ld_bf16x4(P + 1536 + e0);
                if (d0 < 16) {
                    const bool first = d0 < 8;
                    const f32x4 pr = ld_bf16x4(P + 1536 + (first ? e0 + 8 : e0 - 8));
                    rope4(tab, 16 + (d0 & 7), x, pr, first, x);
                }
                if (prompt) st_bf16x4(p.iq_b + (size_t)row * 512 + e0, x);
                else *(f32x4*)(p.iq + (size_t)row * 512 + e0) = x;
            }
            {
                const float x = bf2f(P[2048 + lane]);
                const float mu = wave_sum(x) * (1.f / 64.f);
                const float dv = x - mu;
                const float var = wave_sum(dv * dv) * (1.f / 64.f);
                const float xn = dv * rsqrtf(var + 1e-5f) * p.dsa_ik_g[lane] + p.dsa_ik_b[lane];
                const float other = __shfl_xor(xn, 8);
                float o = xn;
                if (lane < 16) {
                    const float c = tab[(16 + (lane & 7)) * 2], s = tab[(16 + (lane & 7)) * 2 + 1];
                    if (lane < 8) o = xn * c - other * s; else o = xn * c + other * s;
                }
                float* io = prompt ? (p.ik_prompt + (size_t)row * 64) : (p.ik_sample + (size_t)(row - NPR) * 64);
                io[lane] = o;
                if (prompt) p.ik_b[ikb_off(b, t, lane)] = f2bf(o);
            }
            if (lane < 8) p.iw[(size_t)row * 8 + lane] = bf2f(P[2112 + lane]) * 0.35355339059327373f;
        }
        lds_barrier();
        if (prompt) {
#pragma unroll
            for (int i = 0; i < 4; ++i) {
                const int ch = tid + 512 * i, rr = ch >> 3, c8 = (ch & 7) * 8;
                const uint4 v = *(const uint4*)(vt + rr * 72 + c8);
                *(uint4*)(p.vt_b + ((size_t)(b * 2 + (rr >> 7)) * 128 + (rr & 127)) * LPAD + t0 + c8) = v;
            }
        }
        lds_barrier();
    }
    for (int idx = bid * NTHR + tid_opaque(); idx < BATCH * (LPAD - LP) * 256; idx += nb * NTHR) {
        const int c = idx & 255, tp = (idx >> 8) % (LPAD - LP), bb = idx / ((LPAD - LP) * 256);
        const int t = LP + tp, kvh = c >> 7, d = c & 127;
        p.k_b[((size_t)(bb * 2 + kvh) * LPAD + t) * 128 + d] = 0;
        if (c < 64) p.ik_b[ikb_off(bb, t, c)] = 0;
        if (c < 65) p.maskT[((size_t)bb * 65 + c) * LPAD + t] = (c == 0) ? 1ull : 0ull;
    }
}

__device__ __forceinline__ const float* ik_row(const Params& p, bool prompt, int b, int s) {
    if (prompt) return p.ik_prompt + ((size_t)b * LP + s) * 64;
    if (s < PAST) { const int pg = p.page_table[b * 16 + (s >> 7)]; return p.cache_ik + ((size_t)pg * 128 + (s & 127)) * 64; }
    return p.ik_sample + ((size_t)b * DS + (s - PAST)) * 64;
}
__device__ __forceinline__ const float* kv_row(const float* own_p, const float* own_s, const float* cache, const int* page_table,
                                               bool prompt, int b, int s) {
    if (prompt) return own_p + ((size_t)b * LP + s) * 256;
    if (s < PAST) { const int pg = page_table[b * 16 + (s >> 7)]; return cache + ((size_t)pg * 128 + (s & 127)) * 256; }
    return own_s + ((size_t)b * DS + (s - PAST)) * 256;
}

template <bool PROMPT, int NREG>
__device__ __forceinline__ void select_emit(const float* sc, int qpos, int lane, unsigned long long* maskcol, int* selrow) {
    const unsigned long long ltmask = (1ull << lane) - 1ull;
    unsigned key[NREG];
    unsigned kmax = 0u, kmin = 0xffffffffu;
#pragma unroll
    for (int j = 0; j < NREG; ++j) {
        const int s = j * 64 + lane;
        const bool cand = (s >= 16 && s <= qpos);
        const float x = cand ? sc[s] : -INFINITY;
        const unsigned u = __float_as_uint(x);
        key[j] = (u & 0x80000000u) ? ~u : (u | 0x80000000u);
        kmax = max(kmax, key[j]);
        kmin = min(kmin, cand ? key[j] : 0xffffffffu);
    }
#pragma unroll
    for (int o = 1; o < 64; o <<= 1) { kmax = max(kmax, (unsigned)__shfl_xor((int)kmax, o)); kmin = min(kmin, (unsigned)__shfl_xor((int)kmin, o)); }
    unsigned lo = kmin, hi = kmax;
    bool exact = false;
    while (lo < hi) {
        const unsigned mid = lo + ((hi - lo) >> 1) + ((hi - lo) & 1u);
        int c = 0;
#pragma unroll
        for (int j = 0; j < NREG; ++j) c += __popcll(__ballot(key[j] >= mid));
        if (c >= 240) { lo = mid; if (c == 240) { exact = true; break; } } else hi = mid - 1u;
    }
    const unsigned T = lo;
    if (!PROMPT) { if (lane < 16) selrow[lane] = lane; }
    int base = 16;
    unsigned long long myword = 0ull, word64 = 0ull;
    if (exact) {
#pragma unroll
        for (int j = 0; j < NREG; ++j) {
            const bool take = key[j] >= T;
            unsigned long long m = __ballot(take);
            if (PROMPT) {
                if (j == 0) m |= 0xFFFFull;
                if (j < 64) { if (lane == j) myword = m; } else word64 = m;
            } else {
                if (take) selrow[base + __popcll(m & ltmask)] = j * 64 + lane;
                base += __popcll(m);
            }
        }
    } else {
        int cgt = 0;
#pragma unroll
        for (int j = 0; j < NREG; ++j) cgt += __popcll(__ballot(key[j] > T));
        const int need_eq = 240 - cgt;
        int erun = 0;
#pragma unroll
        for (int j = 0; j < NREG; ++j) {
            const bool gt = key[j] > T, eq = key[j] == T;
            const unsigned long long meq = __ballot(eq);
            const int rank = erun + __popcll(meq & ltmask);
            const bool take = gt || (eq && rank < need_eq);
            unsigned long long m = __ballot(take);
            if (PROMPT) {
                if (j == 0) m |= 0xFFFFull;
                if (j < 64) { if (lane == j) myword = m; } else word64 = m;
            } else {
                if (take) selrow[base + __popcll(m & ltmask)] = j * 64 + lane;
                base += __popcll(m);
            }
            erun += __popcll(meq);
        }
    }
    if (PROMPT) {
        if (NREG == 65) { maskcol[(size_t)lane * LPAD] = myword; if (lane == 0) maskcol[(size_t)64 * LPAD] = word64; }
        else { if (lane < NREG) maskcol[(size_t)lane * LPAD] = myword; else if (lane < 64) maskcol[(size_t)lane * LPAD] = 0ull; if (lane == 0) maskcol[(size_t)64 * LPAD] = 0ull; }
    }
}

__device__ __forceinline__ bf16x8 ld_f32x8_bf16(const float* p) {
    const f32x4 a = *(const f32x4*)p, b = *(const f32x4*)(p + 4);
    u32x4 q; q[0] = pk2(a[0], a[1]); q[1] = pk2(a[2], a[3]); q[2] = pk2(b[0], b[1]); q[3] = pk2(b[2], b[3]);
    return __builtin_bit_cast(bf16x8, q);
}
__device__ __forceinline__ void indexer_sample_unit(const Params& p, float* sc, int b, int tid) {
    const int lane = tid & 63, wave = tid >> 6;
    const int r = lane & 31, hh = lane >> 5;
    bf16x8 af[4];
    {
        const int e2 = r & 3, hb = (r >> 2) & 1, a = r >> 3;
        const int qi = 2 * hb + (a >> 1), head = 4 * (a & 1) + e2;
        const float* ap = p.iq + ((size_t)NPR + b * 4 + qi) * 512 + head * 64 + 8 * hh;
#pragma unroll
        for (int ks = 0; ks < 4; ++ks) af[ks] = ld_f32x8_bf16(ap + 16 * ks);
    }
    float wq[2][8];
#pragma unroll
    for (int ql = 0; ql < 2; ++ql) {
        const float* wp = p.iw + ((size_t)NPR + b * 4 + 2 * hh + ql) * 8;
        const f32x4 w0 = *(const f32x4*)wp, w1 = *(const f32x4*)(wp + 4);
#pragma unroll
        for (int e2 = 0; e2 < 4; ++e2) { wq[ql][e2] = w0[e2]; wq[ql][4 + e2] = w1[e2]; }
    }
    asm volatile("" :: "v"(af[0]), "v"(af[1]), "v"(af[2]), "v"(af[3]));
#pragma unroll
    for (int ql = 0; ql < 2; ++ql) asm volatile("" :: "v"(wq[ql][0]), "v"(wq[ql][1]), "v"(wq[ql][2]), "v"(wq[ql][3]), "v"(wq[ql][4]), "v"(wq[ql][5]), "v"(wq[ql][6]), "v"(wq[ql][7]));
    const float* kps[9];
#pragma unroll
    for (int i = 0; i < 9; ++i) {
        const int kt = wave + 8 * i;
        const int s = 32 * (kt < 65 ? kt : 64) + r;
        const float* kp;
        if (s < PAST) { const int pg = p.page_table[b * 16 + (s >> 7)]; kp = p.cache_ik + ((size_t)pg * 128 + (s & 127)) * 64; }
        else kp = p.ik_sample + ((size_t)b * DS + ((s - PAST) & 3)) * 64;
        kps[i] = kp + 8 * hh;
    }
    f32x4 nx[8];
#pragma unroll
    for (int ks = 0; ks < 4; ++ks) { nx[2 * ks] = *(const f32x4*)(kps[0] + 16 * ks); nx[2 * ks + 1] = *(const f32x4*)(kps[0] + 16 * ks + 4); }
#pragma unroll
    for (int i = 0; i < 9; ++i) {
        const int kt = wave + 8 * i;
        if (kt < 65) {
            const int s = 32 * kt + r;
            bf16x8 bq[4];
#pragma unroll
            for (int ks = 0; ks < 4; ++ks) {
                u32x4 q; q[0] = pk2(nx[2 * ks][0], nx[2 * ks][1]); q[1] = pk2(nx[2 * ks][2], nx[2 * ks][3]);
                q[2] = pk2(nx[2 * ks + 1][0], nx[2 * ks + 1][1]); q[3] = pk2(nx[2 * ks + 1][2], nx[2 * ks + 1][3]);
                bq[ks] = __builtin_bit_cast(bf16x8, q);
            }
            if (i + 1 < 9) {
#pragma unroll
                for (int ks = 0; ks < 4; ++ks) { nx[2 * ks] = *(const f32x4*)(kps[i + 1] + 16 * ks); nx[2 * ks + 1] = *(const f32x4*)(kps[i + 1] + 16 * ks + 4); }
            }
            f32x16 acc;
#pragma unroll
            for (int j = 0; j < 16; ++j) acc[j] = 0.f;
#pragma unroll
            for (int ks = 0; ks < 4; ++ks) acc = MFMA32(af[ks], bq[ks], acc);
#pragma unroll
            for (int ql = 0; ql < 2; ++ql) {
                float v = 0.f;
#pragma unroll
                for (int a2 = 0; a2 < 2; ++a2)
#pragma unroll
                    for (int e2 = 0; e2 < 4; ++e2) v += wq[ql][4 * a2 + e2] * fmaxf(acc[4 * (2 * ql + a2) + e2], 0.f);
                sc[(2 * hh + ql) * 2112 + s] = v;
            }
        }
    }
    lds_barrier();
    if (wave < 4) select_emit<false, 33>(sc + wave * 2112, PAST + wave, lane, nullptr, p.sel + ((size_t)NPR + b * 4 + wave) * 256);
    lds_barrier();
}

__device__ __forceinline__ void indexer_prompt_unit(const Params& p, float* sc, int b, int g8, int tid) {
    const int lane = tid & 63, wave = tid >> 6;
    const int r = lane & 31, hh = lane >> 5;
    const int t0 = g8 * 8;
    if (t0 < 256) {
        const int qpos = t0 + wave;
        unsigned long long* maskcol = p.maskT + (size_t)b * 65 * LPAD + qpos;
        for (int j = lane; j < 65; j += 64) {
            const int lo = j * 64;
            unsigned long long m = 0ull;
            if (qpos >= lo + 63) m = ~0ull; else if (qpos >= lo) m = (1ull << (qpos - lo + 1)) - 1ull;
            maskcol[(size_t)j * LPAD] = m;
        }
        return;
    }
    bf16x8 af[2][4];
    {
        const int e2 = r & 3, hb = (r >> 2) & 1, a = r >> 3;
        const int qi = 2 * hb + (a >> 1), head = 4 * (a & 1) + e2;
#pragma unroll
        for (int rt = 0; rt < 2; ++rt) {
            const bf16_t* ap = p.iq_b + ((size_t)b * LP + t0 + 4 * rt + qi) * 512 + head * 64 + 8 * hh;
#pragma unroll
            for (int ks = 0; ks < 4; ++ks) af[rt][ks] = *(const bf16x8*)(ap + 16 * ks);
        }
    }
    float wq[2][2][8];
#pragma unroll
    for (int rt = 0; rt < 2; ++rt)
#pragma unroll
        for (int ql = 0; ql < 2; ++ql) {
            const float* wp = p.iw + ((size_t)b * LP + t0 + 4 * rt + 2 * hh + ql) * 8;
            const f32x4 w0 = *(const f32x4*)wp, w1 = *(const f32x4*)(wp + 4);
#pragma unroll
            for (int e2 = 0; e2 < 4; ++e2) { wq[rt][ql][e2] = w0[e2]; wq[rt][ql][4 + e2] = w1[e2]; }
        }
    const int nkt = (t0 + 7) / 32 + 1;
    const bf16_t* kbase = p.ik_b + (size_t)b * LPAD * 64 + lane * 8;
    bf16x8 bq[2][4], bn[2][4];
#pragma unroll
    for (int j = 0; j < 2; ++j) {
        const int kt = wave + 8 * j, ktc = (kt < nkt) ? kt : (nkt - 1);
#pragma unroll
        for (int ks = 0; ks < 4; ++ks) bq[j][ks] = *(const bf16x8*)(kbase + (size_t)ktc * 2048 + 512 * ks);
    }
    asm volatile("" :: "v"(af[0][0]), "v"(af[0][1]), "v"(af[0][2]), "v"(af[0][3]), "v"(af[1][0]), "v"(af[1][1]), "v"(af[1][2]), "v"(af[1][3]));
#pragma unroll
    for (int rt = 0; rt < 2; ++rt)
#pragma unroll
        for (int ql = 0; ql < 2; ++ql) asm volatile("" :: "v"(wq[rt][ql][0]), "v"(wq[rt][ql][1]), "v"(wq[rt][ql][2]), "v"(wq[rt][ql][3]), "v"(wq[rt][ql][4]), "v"(wq[rt][ql][5]), "v"(wq[rt][ql][6]), "v"(wq[rt][ql][7]));
    for (int kt0 = wave; kt0 < nkt; kt0 += 16) {
#pragma unroll
        for (int j = 0; j < 2; ++j) {
            const int kt = kt0 + 16 + 8 * j, ktc = (kt < nkt) ? kt : (nkt - 1);
#pragma unroll
            for (int ks = 0; ks < 4; ++ks) bn[j][ks] = *(const bf16x8*)(kbase + (size_t)ktc * 2048 + 512 * ks);
        }
        f32x16 acc[2][2];
#pragma unroll
        for (int j = 0; j < 2; ++j)
#pragma unroll
            for (int rt = 0; rt < 2; ++rt)
#pragma unroll
                for (int i = 0; i < 16; ++i) acc[j][rt][i] = 0.f;
#pragma unroll
        for (int ks = 0; ks < 4; ++ks)
#pragma unroll
            for (int j = 0; j < 2; ++j)
#pragma unroll
                for (int rt = 0; rt < 2; ++rt) acc[j][rt] = MFMA32(af[rt][ks], bq[j][ks], acc[j][rt]);
#pragma unroll
        for (int j = 0; j < 2; ++j) {
            const int kt = kt0 + 8 * j;
            if (kt < nkt) {
#pragma unroll
                for (int rt = 0; rt < 2; ++rt)
#pragma unroll
                    for (int ql = 0; ql < 2; ++ql) {
                        float s = 0.f;
#pragma unroll
                        for (int a2 = 0; a2 < 2; ++a2)
#pragma unroll
                            for (int e2 = 0; e2 < 4; ++e2) s += wq[rt][ql][4 * a2 + e2] * fmaxf(acc[j][rt][4 * (2 * ql + a2) + e2], 0.f);
                        sc[(4 * rt + 2 * hh + ql) * 4160 + 32 * kt + r] = s;
                    }
            }
        }
#pragma unroll
        for (int j = 0; j < 2; ++j)
#pragma unroll
            for (int ks = 0; ks < 4; ++ks) bq[j][ks] = bn[j][ks];
    }
    lds_barrier();
    {
        const int qpos = t0 + wave;
        unsigned long long* mc = p.maskT + (size_t)b * 65 * LPAD + qpos;
        if (t0 + 7 < 17 * 64) select_emit<true, 17>(sc + wave * 4160, qpos, lane, mc, nullptr);
        else if (t0 + 7 < 33 * 64) select_emit<true, 33>(sc + wave * 4160, qpos, lane, mc, nullptr);
        else if (t0 + 7 < 49 * 64) select_emit<true, 49>(sc + wave * 4160, qpos, lane, mc, nullptr);
        else select_emit<true, 65>(sc + wave * 4160, qpos, lane, mc, nullptr);
    }
    lds_barrier();
}

__device__ __forceinline__ void indexer_phase(const Params& p, char* smem, int bid, int nb, int rep = 0) {
    int* slot = (int*)(smem + LDS_BYTES - 32);
    for (;;) {
        const int tid = tid_opaque();
        unsigned zofs = 0; asm volatile("" : "+v"(zofs));
        float* sc = (float*)(smem + zofs);
        if (threadIdx.x == 0) *slot = (int)atomicAdd(p.bar + 3648 + 16 * rep, 1u);
        lds_barrier();
        const int u = *slot;
        lds_barrier();
        if (u >= DB + BATCH * 514) break;
        if (u < DB) {
            indexer_sample_unit(p, sc, u, tid);
        } else {
            const int v = u - DB;
            indexer_prompt_unit(p, sc, v & 3, 513 - (v >> 2), tid);
        }
    }
}

__device__ __forceinline__ void attn_sample_query(const Params& p, char* smem, int row) {
    float* qs = (float*)smem;
    float* ps = qs + 1024;
    const float** kptr = (const float**)(ps + 2048);
    const float** vptr = kptr + 256;
    float* red = (float*)(vptr + 256);
    const int tid = tid_opaque(), lane = tid & 63, wave = tid >> 6;
    const int b = (row - NPR) >> 2;
    qs[tid] = p.qr[(size_t)row * 1024 + tid];
    qs[tid + 512] = p.qr[(size_t)row * 1024 + 512 + tid];
    if (tid < 256) {
        const int s = p.sel[(size_t)row * 256 + tid];
        const float *kp, *vp;
        if (s < PAST) { const int pg = p.page_table[b * 16 + ((s < 0 ? 0 : s) >> 7)]; const size_t ro = ((size_t)pg * 128 + ((s < 0 ? 0 : s) & 127)) * 256; kp = p.cache_k + ro; vp = p.cache_v + ro; }
        else { const size_t ro = ((size_t)b * DS + (s - PAST)) * 256; kp = p.k_sample + ro; vp = p.v_sample + ro; }
        kptr[tid] = (s < 0) ? nullptr : kp;
        vptr[tid] = vp;
    }
    lds_barrier();
    {
        const int j = tid & 255, kvh = tid >> 8;
        const float* kp0 = kptr[j];
        const bool valid = kp0 != nullptr;
        const float* kp = (valid ? kp0 : vptr[j]) + kvh * 128;
        float d0 = 0.f, d1 = 0.f, d2 = 0.f, d3 = 0.f;
        const float* q0 = qs + (kvh * 4) * 128;
#pragma unroll 16
        for (int c = 0; c < 32; ++c) {
            const f32x4 kv = *(const f32x4*)(kp + c * 4);
            const f32x4 a0 = *(const f32x4*)(q0 + c * 4), a1 = *(const f32x4*)(q0 + 128 + c * 4), a2 = *(const f32x4*)(q0 + 256 + c * 4),
                        a3 = *(const f32x4*)(q0 + 384 + c * 4);
            d0 += kv[0] * a0[0] + kv[1] * a0[1] + kv[2] * a0[2] + kv[3] * a0[3];
            d1 += kv[0] * a1[0] + kv[1] * a1[1] + kv[2] * a1[2] + kv[3] * a1[3];
            d2 += kv[0] * a2[0] + kv[1] * a2[1] + kv[2] * a2[2] + kv[3] * a2[3];
            d3 += kv[0] * a3[0] + kv[1] * a3[1] + kv[2] * a3[2] + kv[3] * a3[3];
        }
        const float scl = 0.08838834764831845f;
        ps[(kvh * 4 + 0) * 256 + j] = valid ? d0 * scl : -INFINITY;
        ps[(kvh * 4 + 1) * 256 + j] = valid ? d1 * scl : -INFINITY;
        ps[(kvh * 4 + 2) * 256 + j] = valid ? d2 * scl : -INFINITY;
        ps[(kvh * 4 + 3) * 256 + j] = valid ? d3 * scl : -INFINITY;
    }
    lds_barrier();
    {
        float v[4]; float m = -INFINITY;
#pragma unroll
        for (int i = 0; i < 4; ++i) { v[i] = ps[wave * 256 + lane + 64 * i]; m = fmaxf(m, v[i]); }
        m = wave_max(m);
        float sum = 0.f;
#pragma unroll
        for (int i = 0; i < 4; ++i) { v[i] = __expf(v[i] - m); sum += v[i]; }
        sum = wave_sum(sum);
        const float inv = 1.f / sum;
#pragma unroll
        for (int i = 0; i < 4; ++i) ps[wave * 256 + lane + 64 * i] = v[i] * inv;
    }
    lds_barrier();
    {
        const int kvh = tid >> 8, kg = (tid >> 5) & 7, d4 = tid & 31;
        f32x4 acc[4];
#pragma unroll
        for (int g = 0; g < 4; ++g) acc[g] = (f32x4){0.f, 0.f, 0.f, 0.f};
#pragma unroll 16
        for (int i = 0; i < 32; ++i) {
            const int j = kg * 32 + i;
            const f32x4 vv = *(const f32x4*)(vptr[j] + kvh * 128 + d4 * 4);
#pragma unroll
            for (int g = 0; g < 4; ++g) acc[g] += vv * ps[(kvh * 4 + g) * 256 + j];
        }
#pragma unroll
        for (int g = 0; g < 4; ++g) *(f32x4*)(red + ((kg * 2 + kvh) * 4 + g) * 128 + d4 * 4) = acc[g];
    }
    lds_barrier();
    {
        const int h = wave, d = lane * 2;
        float o0 = 0.f, o1 = 0.f;
#pragma unroll
        for (int kg = 0; kg < 8; ++kg) { const f32x2 t = *(const f32x2*)(red + ((kg * 2 + (h >> 2)) * 4 + (h & 3)) * 128 + d); o0 += t[0]; o1 += t[1]; }
        *(unsigned*)(p.gated + (size_t)row * 1024 + h * 128 + d) = pk2(o0, o1);
    }
    lds_barrier();
}

constexpr int AT_K = 0, AT_V = 64 * 136, AT_ELEMS = 64 * 136 + 128 * 72;
__device__ __forceinline__ void attn_dense_unit(const Params& p, char* smem, int b, int kvh, int qb) {
    bf16_t* lds = (bf16_t*)smem;
    const int tid = tid_opaque(), lane = tid & 63, wave = tid >> 6;
    const int r = lane & 31, hh = lane >> 5;
    const int g = wave & 3, qs = wave >> 2;
    const int head = kvh * 4 + g;
    const int tq = 64 * qb + 32 * qs + r;
    const int tqc = (tq < LP) ? tq : (LP - 1);
    bf16x8 qf[8];
    {
        const bf16_t* qp = p.q_b + ((size_t)b * LP + tqc) * 1024 + head * 128 + 8 * hh;
#pragma unroll
        for (int ks = 0; ks < 8; ++ks) qf[ks] = *(const bf16x8*)(qp + 16 * ks);
    }
    f32x16 O[4];
#pragma unroll
    for (int i = 0; i < 4; ++i)
#pragma unroll
        for (int j = 0; j < 16; ++j) O[i][j] = 0.f;
    float mrun = -3.0e38f, lrun = 0.f;
    const bf16_t* Kg = p.k_b + ((size_t)(b * 2 + kvh) * LPAD) * 128;
    const bf16_t* Vg = p.vt_b + ((size_t)(b * 2 + kvh) * 128) * LPAD;
    const unsigned long long* mcol = p.maskT + (size_t)b * 65 * LPAD + tq;
    const int kc0 = tid, kc1 = tid + 512;
    uint4 sk0, sk1, sv0, sv1;
#define AT_GLOAD(kt_) do { const bf16_t* kg_ = Kg + (size_t)(kt_) * 64 * 128; const bf16_t* vg_ = Vg + (size_t)(kt_) * 64; \
        sk0 = *(const uint4*)(kg_ + (size_t)kc0 * 8); sk1 = *(const uint4*)(kg_ + (size_t)kc1 * 8); \
        sv0 = *(const uint4*)(vg_ + (size_t)(kc0 >> 3) * LPAD + (kc0 & 7) * 8); sv1 = *(const uint4*)(vg_ + (size_t)(kc1 >> 3) * LPAD + (kc1 & 7) * 8); } while (0)
#define AT_SSTORE(buf_) do { bf16_t* q_ = (buf_); \
        *(uint4*)(q_ + AT_K + (kc0 >> 4) * 136 + (kc0 & 15) * 8) = sk0; *(uint4*)(q_ + AT_K + (kc1 >> 4) * 136 + (kc1 & 15) * 8) = sk1; \
        *(uint4*)(q_ + AT_V + (kc0 >> 3) * 72 + (kc0 & 7) * 8) = sv0; *(uint4*)(q_ + AT_V + (kc1 >> 3) * 72 + (kc1 & 7) * 8) = sv1; } while (0)
    AT_GLOAD(0); AT_SSTORE(lds);
    unsigned long long mw_next = mcol[0];
    asm volatile("" :: "v"(qf[0]), "v"(qf[1]), "v"(qf[2]), "v"(qf[3]), "v"(qf[4]), "v"(qf[5]), "v"(qf[6]), "v"(qf[7]), "v"(mw_next));
    lds_barrier();
    for (int kt = 0; kt <= qb; ++kt) {
        unsigned zofs = 0; asm volatile("" : "+v"(zofs));
        bf16_t* cur = lds + (kt & 1) * AT_ELEMS + zofs;
        bf16_t* nxt = lds + ((kt + 1) & 1) * AT_ELEMS + zofs;
        const bool more = kt < qb;
        if (more) { AT_GLOAD(kt + 1); }
        const unsigned long long mw = mw_next;
        if (more) mw_next = mcol[(size_t)(kt + 1) * LPAD];
        f32x16 st[2];
#pragma unroll
        for (int j = 0; j < 16; ++j) { st[0][j] = 0.f; st[1][j] = 0.f; }
#pragma unroll
        for (int ks = 0; ks < 8; ++ks) {
            st[0] = MFMA32(*(const bf16x8*)(cur + AT_K + (r) * 136 + 16 * ks + 8 * hh), qf[ks], st[0]);
            st[1] = MFMA32(*(const bf16x8*)(cur + AT_K + (32 + r) * 136 + 16 * ks + 8 * hh), qf[ks], st[1]);
        }
        float mx = fmaxf(st[0][0], st[1][0]);
#pragma unroll
        for (int reg = 1; reg < 16; reg += 1) mx = fmaxf(mx, fmaxf(st[0][reg], st[1][reg]));
        mx = fmaxf(mx, __shfl_xor(mx, 32));
        const float mnew = (mx > mrun + 8.f) ? mx : mrun;
        if (__any(mnew != mrun)) {
            const float alpha = __builtin_amdgcn_exp2f(mrun - mnew);
            lrun *= alpha;
#pragma unroll
            for (int dt = 0; dt < 4; ++dt) O[dt] = O[dt] * alpha;
            mrun = mnew;
        }
        float psum = 0.f;
#pragma unroll
        for (int kk = 0; kk < 2; ++kk) {
            const int w = (int)((unsigned)(mw >> (32 * kk)) >> (4 * hh));
#pragma unroll
            for (int reg = 0; reg < 16; ++reg) {
                const int bit = (reg & 3) + 8 * (reg >> 2);
                const int keep = __builtin_amdgcn_sbfe(w, bit, 1);
                const float pv = __uint_as_float(__float_as_uint(__builtin_amdgcn_exp2f(st[kk][reg] - mrun)) & (unsigned)keep);
                st[kk][reg] = pv; psum += pv;
            }
        }
        lrun += psum;
        bf16x8 pb[2][2];
#pragma unroll
        for (int kk = 0; kk < 2; ++kk)
#pragma unroll
            for (int s = 0; s < 2; ++s) pb[kk][s] = pack_step(st[kk], s);
#pragma unroll
        for (int kk = 0; kk < 2; ++kk)
#pragma unroll
            for (int s = 0; s < 2; ++s)
#pragma unroll
                for (int dt = 0; dt < 4; ++dt)
                    O[dt] = MFMA32(*(const bf16x8*)(cur + AT_V + (32 * dt + r) * 72 + 32 * kk + 16 * s + 8 * hh), pb[kk][s], O[dt]);
        if (more) { AT_SSTORE(nxt); }
        lds_barrier();
    }
    const float ltot = lrun + __shfl_xor(lrun, 32);
    const float inv = 1.f / ltot;
    if (tq < LP) {
        bf16_t* op = p.gated + ((size_t)b * LP + tq) * 1024 + head * 128;
#pragma unroll
        for (int dt = 0; dt < 4; ++dt)
#pragma unroll
            for (int g4 = 0; g4 < 4; ++g4) {
                f32x4 v;
#pragma unroll
                for (int e2 = 0; e2 < 4; ++e2) v[e2] = O[dt][4 * g4 + e2] * inv;
                st_bf16x4(op + 32 * dt + 8 * g4 + 4 * hh, v);
            }
    }
    lds_barrier();
}

__device__ __forceinline__ void attn_phase(const Params& p, char* smem, int bid, int nb, int rep = 0) {
    int* slot = (int*)(smem + LDS_BYTES - 32);
    for (;;) {
        if (threadIdx.x == 0) *slot = (int)atomicAdd(p.bar + 3584 + 16 * rep, 1u);
        lds_barrier();
        const int u = *slot;
        lds_barrier();
        if (u >= 520 + NSR) break;
        if (u < 520) attn_dense_unit(p, smem, (u & 7) >> 1, u & 1, 64 - (u >> 3));
        else attn_sample_query(p, smem, NPR + (u - 520));
    }
}

#define XB_TMO      128
#define XB_XCNT(j)  (256  + 64 * (j))
#define XB_XSUB(j)  (1280 + 64 * (j))
#define XB_XGEN(j)  (2304 + 64 * (j))
#define XB_TOP      3328
#define XB_TOPGEN   3392
#define XCD_BAR_WORDS 3456
#define XB_SPIN_CAP (1u << 18)
#define LAS __attribute__((address_space(3)))

__device__ __forceinline__ unsigned xb_ld(unsigned* p)              { return __hip_atomic_load(p, __ATOMIC_RELAXED, __HIP_MEMORY_SCOPE_AGENT); }
__device__ __forceinline__ unsigned xb_add(unsigned* p, unsigned v) { return __hip_atomic_fetch_add(p, v, __ATOMIC_RELAXED, __HIP_MEMORY_SCOPE_AGENT); }
__device__ __forceinline__ unsigned xb_xcc_id() { return (unsigned)__builtin_amdgcn_s_getreg((3 << 11) | 20) & 0xFu; }
#define XB_SPIN(cond, bar) do { unsigned _sp = 0; while (cond) { __builtin_amdgcn_s_sleep(1); \
    if ((++_sp & 255u) == 0u) { if (xb_ld(&(bar)[XB_TMO])) break; if (_sp > XB_SPIN_CAP) { atomicAdd(&(bar)[XB_TMO], 1u); break; } } } } while (0)

struct XcdBarrier {
    unsigned* bar; unsigned x;
    volatile LAS unsigned* st;
};

__device__ __forceinline__ XcdBarrier xcd_barrier_post(unsigned* bar, volatile LAS unsigned* st) {
    XcdBarrier b; b.bar = bar; b.x = xb_xcc_id(); b.st = st;
    if (threadIdx.x == 0) (void)xb_add(&bar[XB_XCNT(b.x)], 1u);
    return b;
}
__device__ __forceinline__ void xcd_barrier_complete(unsigned* bar, unsigned x, unsigned& nloc, unsigned& nx) {
    const unsigned G = gridDim.x * gridDim.y * gridDim.z;
    unsigned sum, cnt, mine, sp = 0u;
    for (;;) {
        sum = 0u; cnt = 0u; mine = 0u;
#pragma unroll
        for (unsigned j = 0; j < 16; ++j) { const unsigned c = xb_ld(&bar[XB_XCNT(j)]); sum += c; cnt += (c > 0u) ? 1u : 0u; mine = (j == x) ? c : mine; }
        if (sum == G) break;
        __builtin_amdgcn_s_sleep(1);
        if ((++sp & 255u) == 0u) { if (xb_ld(&bar[XB_TMO])) break; if (sp > XB_SPIN_CAP) { atomicAdd(&bar[XB_TMO], 1u); break; } }
    }
    nloc = mine > 0u ? mine : 1u; nx = cnt > 0u ? cnt : 1u;
}

__device__ __forceinline__ void xcd_barrier(const XcdBarrier& b) {
    asm volatile("s_waitcnt vmcnt(0)" ::: "memory");
    __syncthreads();
    if (threadIdx.x == 0) {
        unsigned* bar = b.bar;
        __builtin_amdgcn_s_waitcnt(0);
        unsigned nloc = b.st[0], nx = b.st[1];
        if (nloc == 0u) { xcd_barrier_complete(bar, b.x, nloc, nx); b.st[0] = nloc; b.st[1] = nx; }
        const unsigned old = xb_add(&bar[XB_XSUB(b.x)], 1u);
        const unsigned gen = old / nloc;
        if (old + 1u == (gen + 1u) * nloc) {
            __builtin_amdgcn_fence(__ATOMIC_RELEASE, "agent");
            asm volatile("s_waitcnt vmcnt(0)" ::: "memory");
            const unsigned og = xb_add(&bar[XB_TOP], 1u);
            const unsigned tg = og / nx;
            if (og + 1u == (tg + 1u) * nx) xb_add(&bar[XB_TOPGEN], 1u);
            else XB_SPIN(xb_ld(&bar[XB_TOPGEN]) == tg, bar);
            __builtin_amdgcn_fence(__ATOMIC_ACQUIRE, "agent");
            xb_add(&bar[XB_XGEN(b.x)], 1u);
            asm volatile("s_waitcnt vmcnt(0)" ::: "memory");
        } else {
            XB_SPIN(xb_ld(&bar[XB_XGEN(b.x)]) == gen, bar);
            __builtin_amdgcn_fence(__ATOMIC_ACQUIRE, "agent");
            asm volatile("s_waitcnt vmcnt(0)" ::: "memory");
        }
    }
    __syncthreads();
}


constexpr int NPHASE = 19;
template <int PH>
__device__ __forceinline__ void run_phase(const Params& p, char* smem, int bid, int nb, int rep = 0) {
    constexpr int MT = MPAD / 256;
    if constexpr (PH == 0) phase_prologue(p, smem, bid, nb);
    else if constexpr (PH == 1) gemm_big(p.hA, D, p.wt_gin, GIN_PAD, EpiGdnIn{p.mixed, p.z, p.ba}, smem, bid, nb);
    else if constexpr (PH == 2) gdn_stageA(p, smem, bid, nb);
    else if constexpr (PH == 3) gdn_seq_phase(p, smem, bid, nb, rep);
    else if constexpr (PH == 4) gdn_gate_phase(p, bid, nb);
    else if constexpr (PH == 5) gemm_n1024(p.gated, 2048, p.wt_gout, EpiResid{p.preln, p.hA}, EpiSlab{p.slab}, 8, smem, bid, nb);
    else if constexpr (PH == 6) ln_phase(p.preln, p.ln1_g, p.ln1_b, p.hB, nullptr, nullptr, p.slab, 8, p.hA, bid, nb);
    else if constexpr (PH == 7) gemm_big(p.hB, D, p.wt_w1, DFF, EpiRelu2{p.act}, smem, bid, nb);
    else if constexpr (PH == 8) gemm_n1024(p.act, DFF, p.wt_w2, EpiResid{p.preln, p.hB}, EpiSlab{p.slab}, 16, smem, bid, nb);
    else if constexpr (PH == 9) ln_phase(p.preln, p.ln2_g, p.ln2_b, p.hA, nullptr, nullptr, p.slab, 16, p.hB, bid, nb);
    else if constexpr (PH == 10) gemm_big(p.hA, D, p.wt_din, DIN_PAD, EpiBf16{(bf16_t*)p.p1, DIN_PAD}, smem, bid, nb);
    else if constexpr (PH == 11) dsa_post_phase(p, smem, bid, nb);
    else if constexpr (PH == 12) indexer_phase(p, smem, bid, nb, rep);
    else if constexpr (PH == 13) attn_phase(p, smem, bid, nb, rep);
    else if constexpr (PH == 14) gemm_n1024(p.gated, D, p.wt_do, EpiResid{p.preln, p.hA}, EpiSlab{p.slab}, 4, smem, bid, nb);
    else if constexpr (PH == 15) ln_phase(p.preln, p.ln1_g + D, p.ln1_b + D, p.hB, nullptr, nullptr, p.slab, 4, p.hA, bid, nb);
    else if constexpr (PH == 16) gemm_big(p.hB, D, p.wt_w1 + (size_t)D * DFF, DFF, EpiRelu2{p.act}, smem, bid, nb);
    else if constexpr (PH == 17) gemm_n1024(p.act, DFF, p.wt_w2 + (size_t)D * DFF, EpiResid{p.preln, p.hB}, EpiSlab{p.slab}, 16, smem, bid, nb);
    else if constexpr (PH == 18) ln_phase(p.preln, p.ln2_g + D, p.ln2_b + D, nullptr, p.y_prompt, p.y_sample, p.slab, 16, p.hB, bid, nb);
}

template <int PH>
__global__ void __launch_bounds__(NTHR, 2) k_phase(Params p) {
    extern __shared__ __attribute__((aligned(16))) char smem[];
    run_phase<PH>(p, smem, blockIdx.x, gridDim.x);
}

template <int PH>
__device__ __forceinline__ void mega_run(const Params& p, char* smem, const XcdBarrier& bar) {
    run_phase<PH>(p, smem, blockIdx.x, gridDim.x);
#ifdef PROBE_MASK
    if constexpr ((PROBE_MASK >> PH) & 1) { xcd_barrier(bar); run_phase<PH>(p, smem, blockIdx.x, gridDim.x, 1); }
#endif
    if constexpr (PH + 1 < NPHASE) {
        xcd_barrier(bar);
        mega_run<PH + 1>(p, smem, bar);
    }
}
__global__ void __launch_bounds__(NTHR, 2) k_mega(Params p) {
    extern __shared__ __attribute__((aligned(16))) char smem[];
    volatile LAS unsigned* st = (volatile LAS unsigned*)(smem + LDS_BYTES - 16);
    if (threadIdx.x == 0) { st[0] = 0u; st[1] = 0u; st[2] = 0u; st[3] = 0u; }
    __syncthreads();
    XcdBarrier bar = xcd_barrier_post(p.bar, st);
    mega_run<0>(p, smem, bar);
}

template <int PH>
void launch_phase(const Params& p, hipStream_t stream) {
    static bool attr_done = false;
    if (!attr_done) {
        (void)hipFuncSetAttribute((const void*)k_phase<PH>, hipFuncAttributeMaxDynamicSharedMemorySize, LDS_BYTES);
        attr_done = true;
    }
    hipLaunchKernelGGL(k_phase<PH>, dim3(256), dim3(NTHR), LDS_BYTES, stream, p);
}
template <int PH>
void launch_all(const Params& p, hipStream_t stream) {
    launch_phase<PH>(p, stream);
    if constexpr (PH + 1 < NPHASE) launch_all<PH + 1>(p, stream);
}

}

extern "C" void kernel_launch(void* const* d_in, const int* in_sizes, int n_in, void* d_out, int out_size, void* d_ws, size_t ws_size,
                              hipStream_t stream) {
    Params p{};
    p.x_prompt = (const float*)d_in[0]; p.x_sample = (const float*)d_in[1]; p.state_gdn = (const float*)d_in[2];
    p.state_conv = (const float*)d_in[3]; p.cache_k = (const float*)d_in[4]; p.cache_v = (const float*)d_in[5];
    p.cache_ik = (const float*)d_in[6]; p.page_table = (const int*)d_in[7]; p.meta = (const float*)d_in[8];
    p.ln1_g = (const float*)d_in[9]; p.ln1_b = (const float*)d_in[10]; p.ln2_g = (const float*)d_in[11]; p.ln2_b = (const float*)d_in[12];
    p.mlp_w1 = (const float*)d_in[13]; p.mlp_w2 = (const float*)d_in[14]; p.gdn_w_in = (const float*)d_in[15];
    p.gdn_conv_w = (const float*)d_in[16]; p.gdn_a_log = (const float*)d_in[17]; p.gdn_dt_bias = (const float*)d_in[18];
    p.gdn_norm_w = (const float*)d_in[19]; p.gdn_w_out = (const float*)d_in[20]; p.dsa_w_in = (const float*)d_in[21];
    p.dsa_ik_g = (const float*)d_in[22]; p.dsa_ik_b = (const float*)d_in[23]; p.dsa_w_o = (const float*)d_in[24];
    float* o = (float*)d_out;
    p.y_prompt = o; o += (size_t)BATCH * SEQ * D;
    p.y_sample = o; o += (size_t)NSR * D;
    p.gs_prompt = o; o += (size_t)BATCH * 16 * 128 * 128;
    p.gc_prompt = o; o += (size_t)BATCH * 3 * 4096;
    p.gs_sample = o; o += (size_t)DB * 16 * 128 * 128;
    p.gc_sample = o; o += (size_t)DB * 3 * 4096;
    p.k_prompt = o; o += (size_t)NPR * 256;
    p.v_prompt = o; o += (size_t)NPR * 256;
    p.ik_prompt = o; o += (size_t)NPR * 64;
    p.k_sample = o; o += (size_t)NSR * 256;
    p.v_sample = o; o += (size_t)NSR * 256;
    p.ik_sample = o; o += (size_t)NSR * 64;
    char* w = (char*)d_ws;
    auto take = [&](size_t bytes) { char* r = w; w += (bytes + 255) & ~(size_t)255; return r; };
    p.bar = (unsigned*)take(16384);
    p.wt_gin = (bf16_t*)take((size_t)GIN_PAD * D * 2);
    p.wt_gout = (bf16_t*)take((size_t)D * 2048 * 2);
    p.wt_w1 = (bf16_t*)take((size_t)2 * D * DFF * 2);
    p.wt_w2 = (bf16_t*)take((size_t)2 * D * DFF * 2);
    p.wt_din = (bf16_t*)take((size_t)DIN_PAD * D * 2);
    p.wt_do = (bf16_t*)take((size_t)D * D * 2);
    p.hA = (bf16_t*)take((size_t)MPAD * D * 2);
    p.hB = (bf16_t*)take((size_t)MPAD * D * 2);
    p.preln = (float*)take((size_t)MPAD * D * 4);
    p.mixed = (bf16_t*)take((size_t)MPAD * 4096 * 2);
    p.z = (bf16_t*)take((size_t)MPAD * 2048 * 2);
    p.ba = (float*)take((size_t)MPAD * 32 * 4);
    p.gated = (bf16_t*)take((size_t)MPAD * 2048 * 2);
    p.act = (bf16_t*)take((size_t)MPAD * DFF * 2);
    p.p1 = (float*)take((size_t)MPAD * DIN_PAD * 4);
    p.qr = (float*)take((size_t)MPAD * 1024 * 4);
    p.iq = (float*)take((size_t)MPAD * 512 * 4);
    p.iw = (float*)take((size_t)MPAD * 8 * 4);
    p.sel = (int*)take((size_t)MPAD * 256 * 4);
    p.g_o = (bf16_t*)take((size_t)NPR * 2048 * 2);
    p.rope_tab = (float*)take((size_t)LP * 24 * 2 * 4);
    p.slab = (float*)take((size_t)16 * 768 * 1024 * 4);
    p.q_b = (bf16_t*)take((size_t)NPR * 1024 * 2);
    p.k_b = (bf16_t*)take((size_t)BATCH * 2 * LPAD * 128 * 2);
    p.vt_b = (bf16_t*)take((size_t)BATCH * 2 * 128 * LPAD * 2);
    p.iq_b = (bf16_t*)take((size_t)NPR * 512 * 2);
    p.ik_b = (bf16_t*)take((size_t)BATCH * LPAD * 64 * 2);
    p.maskT = (unsigned long long*)take((size_t)BATCH * 65 * LPAD * 8);
    p.g_dec = (float*)take((size_t)NCU * 4);
    p.g_u = (float*)p.act;
    p.g_negw = (bf16_t*)p.p1;
    p.g_qg = p.g_negw + (size_t)NCU * 8192;
    p.g_kdT = (bf16_t*)p.qr;
    p.g_aqk = (bf16_t*)p.iq;
    if ((size_t)(w - (char*)d_ws) > ws_size) { fprintf(stderr, "kernel_launch: workspace too small (%zu needed, %zu given)\n", (size_t)(w - (char*)d_ws), ws_size); return; }
#if MEGA
    static int grid = 0;
    if (grid == 0) {
        int dev = 0, cus = 0;
        if (hipGetDevice(&dev) != hipSuccess || hipDeviceGetAttribute(&cus, hipDeviceAttributeMultiprocessorCount, dev) != hipSuccess || cus <= 0) cus = 256;
        (void)hipFuncSetAttribute((const void*)k_mega, hipFuncAttributeMaxDynamicSharedMemorySize, LDS_BYTES);
        grid = cus;
    }
    (void)hipMemsetAsync(p.bar, 0, 16384, stream);
    hipLaunchKernelGGL(k_mega, dim3(grid), dim3(NTHR), LDS_BYTES, stream, p);
#else
    launch_all<0>(p, stream);
#endif
}
```

```cpp
#include <hip/hip_runtime.h>
#include <stdint.h>
#include <stdio.h>

#ifndef MEGA
#define MEGA 1
#endif

namespace {

typedef unsigned short bf16_t;
typedef short bf16x8 __attribute__((ext_vector_type(8)));
typedef float f32x4 __attribute__((ext_vector_type(4)));

constexpr int D = 1024, BATCH = 4, SEQ = 4096, NMETA = 16, LP = SEQ + NMETA;
constexpr int DB = 128, DS = 4, PAST = 2048;
constexpr int NPR = BATCH * LP;
constexpr int NSR = DB * DS;
constexpr int NT = NPR + NSR;
constexpr int MPAD = 17152;
constexpr int DFF = 4096;
constexpr int GIN = 6176, GIN_PAD = 6400;
constexpr int DIN = 2120, DIN_PAD = 2304;
constexpr int NTHR = 512;
constexpr int LPAD = 4160;
constexpr int LDS_BYTES = 150 * 1024;
constexpr float ALPHA = 1.4142135623730951f;

struct Params {
    const float *x_prompt, *x_sample, *state_gdn, *state_conv, *cache_k, *cache_v, *cache_ik;
    const int* page_table;
    const float *meta, *ln1_g, *ln1_b, *ln2_g, *ln2_b, *mlp_w1, *mlp_w2, *gdn_w_in, *gdn_conv_w, *gdn_a_log, *gdn_dt_bias,
        *gdn_norm_w, *gdn_w_out, *dsa_w_in, *dsa_ik_g, *dsa_ik_b, *dsa_w_o;
    float *y_prompt, *y_sample, *gs_prompt, *gc_prompt, *gs_sample, *gc_sample, *k_prompt, *v_prompt, *ik_prompt, *k_sample,
        *v_sample, *ik_sample;
    unsigned* bar;
    bf16_t *wt_gin, *wt_gout, *wt_w1, *wt_w2, *wt_din, *wt_do;
    bf16_t *hA, *hB;
    float* preln;
    bf16_t *mixed, *z;
    float* ba;
    bf16_t *gated, *act;
    float *p1, *qr, *iq, *iw;
    int* sel;
    bf16_t *g_negw, *g_qg, *g_kdT, *g_aqk;
    float *g_u, *g_dec;
    bf16_t* g_o;
    float* rope_tab;
    float* slab;
    bf16_t *q_b, *k_b, *vt_b, *iq_b, *ik_b;
    unsigned long long* maskT;
};

__device__ const double kInvFreq[16] = {1.0, 0.44036660267178046, 0.19392274474868576, 0.08539710028576561,
    0.03760603093086393, 0.016560440080994446, 0.007292664737217109, 0.003211445994752591, 0.001414213562373095,
    0.000622772421914596, 0.0002742481756762073, 0.00012076973741146504, 5.318295896944988e-05, 2.341999896140934e-05,
    1.031338537721246e-05, 4.5416704806078695e-06};

__device__ __forceinline__ float bf2f(bf16_t h) { return __uint_as_float(((unsigned)h) << 16); }
typedef __bf16 hwbf16x2 __attribute__((ext_vector_type(2)));
typedef float f32x2 __attribute__((ext_vector_type(2)));
typedef float f32x16 __attribute__((ext_vector_type(16)));
typedef unsigned u32x4 __attribute__((ext_vector_type(4)));
__device__ __forceinline__ unsigned pk2(float lo, float hi) {
    const f32x2 v = {lo, hi};
    return __builtin_bit_cast(unsigned, __builtin_convertvector(v, hwbf16x2));
}
__device__ __forceinline__ bf16_t f2bf(float f) { return (bf16_t)(pk2(f, 0.f) & 0xffffu); }
__device__ __forceinline__ void st_bf16x4(bf16_t* p, f32x4 v) {
    uint2 o; o.x = pk2(v[0], v[1]); o.y = pk2(v[2], v[3]);
    *(uint2*)p = o;
}
__device__ __forceinline__ f32x4 cvt_bf16x4(uint2 o) {
    f32x4 v; v[0] = __uint_as_float(o.x << 16); v[1] = __uint_as_float(o.x & 0xffff0000u);
    v[2] = __uint_as_float(o.y << 16); v[3] = __uint_as_float(o.y & 0xffff0000u);
    return v;
}
__device__ __forceinline__ f32x4 ld_bf16x4(const bf16_t* p) {
    uint2 o = *(const uint2*)p;
    f32x4 v; v[0] = __uint_as_float(o.x << 16); v[1] = __uint_as_float(o.x & 0xffff0000u);
    v[2] = __uint_as_float(o.y << 16); v[3] = __uint_as_float(o.y & 0xffff0000u);
    return v;
}
__device__ __forceinline__ float wave_sum(float v) {
#pragma unroll
    for (int o = 1; o < 64; o <<= 1) v += __shfl_xor(v, o);
    return v;
}
__device__ __forceinline__ float wave_max(float v) {
#pragma unroll
    for (int o = 1; o < 64; o <<= 1) v = fmaxf(v, __shfl_xor(v, o));
    return v;
}
__device__ __forceinline__ int wave_sum_i(int v) {
#pragma unroll
    for (int o = 1; o < 64; o <<= 1) v += __shfl_xor(v, o);
    return v;
}
__device__ __forceinline__ float silu(float x) { return x * __builtin_amdgcn_rcpf(1.f + __expf(-x)); }
__device__ __forceinline__ int tid_opaque() { int t = threadIdx.x; asm volatile("" : "+v"(t)); return t; }
__device__ __forceinline__ void lds_barrier() { asm volatile("s_waitcnt lgkmcnt(0)\n\ts_barrier" ::: "memory"); }
__device__ __forceinline__ void lds_fence() { asm volatile("s_waitcnt lgkmcnt(0)" ::: "memory"); }

__device__ __forceinline__ void transpose_convert(const float* __restrict__ W, int K, int N, int Npad, bf16_t* __restrict__ WT, float* tile,
                                  int bid, int nb) {
    const int tid = tid_opaque();
    const int tk = K / 64, tn = Npad / 64;
    for (int it = bid; it < tk * tn; it += nb) {
        const int kb = it / tn, nbk = it % tn, k0 = kb * 64, n0 = nbk * 64;
#pragma unroll
        for (int i = 0; i < 8; ++i) {
            const int r = (tid >> 6) + 8 * i, c = tid & 63, n = n0 + c;
            tile[r * 65 + c] = (n < N) ? W[(size_t)(k0 + r) * N + n] : 0.f;
        }
        __syncthreads();
        {
            const int rn = tid >> 3, c8 = (tid & 7) * 8;
            const float* tp = tile + c8 * 65 + rn;
            uint4 o;
            o.x = pk2(tp[0], tp[65]); o.y = pk2(tp[2 * 65], tp[3 * 65]); o.z = pk2(tp[4 * 65], tp[5 * 65]); o.w = pk2(tp[6 * 65], tp[7 * 65]);
            *(uint4*)(WT + (size_t)(n0 + rn) * K + k0 + c8) = o;
        }
        __syncthreads();
    }
}

__device__ __forceinline__ void phase_prologue(const Params& p, char* smem, int bid, int nb) {
    float* tile = (float*)smem;
    transpose_convert(p.gdn_w_in, D, GIN, GIN_PAD, p.wt_gin, tile, bid, nb);
    for (int idx = bid * NTHR + tid_opaque(); idx < LP * 24; idx += nb * NTHR) {
        const int pos = idx / 24, f = idx % 24;
        const int fi = (f < 16) ? f : (f - 16) * 2;
        const double rev = (double)pos * kInvFreq[fi] * 0.15915494309189535;
        const float r = (float)(rev - floor(rev));
        p.rope_tab[idx * 2] = __builtin_amdgcn_cosf(r);
        p.rope_tab[idx * 2 + 1] = __builtin_amdgcn_sinf(r);
    }
    for (int idx = bid * NTHR + tid_opaque(); idx < MPAD * 256; idx += nb * NTHR) {
        const int row = idx >> 8, c4 = (idx & 255) * 4;
        f32x4 v = {0.f, 0.f, 0.f, 0.f};
        if (row < NPR) {
            const int b = row / LP, t = row % LP;
            const float* src = (t < NMETA) ? (p.meta + (size_t)t * D) : (p.x_prompt + ((size_t)b * SEQ + (t - NMETA)) * D);
            v = *(const f32x4*)(src + c4);
        } else if (row < NT) {
            v = *(const f32x4*)(p.x_sample + (size_t)(row - NPR) * D + c4);
        }
        st_bf16x4(p.hA + (size_t)row * D + c4, v);
    }
}

template <class Epi>
__device__ __forceinline__ void gemm_phase(const bf16_t* __restrict__ A, int lda, const bf16_t* __restrict__ Bt, int K, int Mtiles, int Ntiles,
                           const Epi& epi, char* smem, int bid, int nb) {
    bf16_t* As = (bf16_t*)smem;
    bf16_t* Bs = As + 256 * 72;
    const int tid = tid_opaque(), lane = tid & 63, wave = tid >> 6;
    const int wm = wave >> 1, wn = wave & 1;
    const int fr = lane & 15, fq = lane >> 4;
    const int ntiles = Mtiles * Ntiles;
    const int nk = K / 64;
    for (int tile = bid; tile < ntiles; tile += nb) {
        const int tm = tile % Mtiles, tn = tile / Mtiles;
        const bf16_t* Ag = A + (size_t)tm * 256 * lda;
        const bf16_t* Bg = Bt + (size_t)tn * 128 * K;
        f32x4 acc[4][4];
#pragma unroll
        for (int i = 0; i < 4; ++i)
#pragma unroll
            for (int j = 0; j < 4; ++j) acc[i][j] = (f32x4){0.f, 0.f, 0.f, 0.f};
        const int c0 = tid, c1 = tid + 512, c2 = tid + 1024, c3 = tid + 1536;
        const bf16_t* ga0 = Ag + (size_t)(c0 >> 3) * lda + (c0 & 7) * 8;
        const bf16_t* ga1 = Ag + (size_t)(c1 >> 3) * lda + (c1 & 7) * 8;
        const bf16_t* ga2 = Ag + (size_t)(c2 >> 3) * lda + (c2 & 7) * 8;
        const bf16_t* ga3 = Ag + (size_t)(c3 >> 3) * lda + (c3 & 7) * 8;
        const bf16_t* gb0 = Bg + (size_t)(c0 >> 3) * K + (c0 & 7) * 8;
        const bf16_t* gb1 = Bg + (size_t)(c1 >> 3) * K + (c1 & 7) * 8;
        bf16_t* sa0 = As + (c0 >> 3) * 72 + (c0 & 7) * 8;
        bf16_t* sa1 = As + (c1 >> 3) * 72 + (c1 & 7) * 8;
        bf16_t* sa2 = As + (c2 >> 3) * 72 + (c2 & 7) * 8;
        bf16_t* sa3 = As + (c3 >> 3) * 72 + (c3 & 7) * 8;
        bf16_t* sb0 = Bs + (c0 >> 3) * 72 + (c0 & 7) * 8;
        bf16_t* sb1 = Bs + (c1 >> 3) * 72 + (c1 & 7) * 8;
        uint4 ra0 = *(const uint4*)ga0, ra1 = *(const uint4*)ga1, ra2 = *(const uint4*)ga2, ra3 = *(const uint4*)ga3;
        uint4 rb0 = *(const uint4*)gb0, rb1 = *(const uint4*)gb1;
        *(uint4*)sa0 = ra0; *(uint4*)sa1 = ra1; *(uint4*)sa2 = ra2; *(uint4*)sa3 = ra3; *(uint4*)sb0 = rb0; *(uint4*)sb1 = rb1;
        __syncthreads();
        for (int kt = 0; kt < nk; ++kt) {
            const bool more = (kt + 1 < nk);
            if (more) {
                const int k0 = (kt + 1) * 64;
                ra0 = *(const uint4*)(ga0 + k0); ra1 = *(const uint4*)(ga1 + k0); ra2 = *(const uint4*)(ga2 + k0); ra3 = *(const uint4*)(ga3 + k0);
                rb0 = *(const uint4*)(gb0 + k0); rb1 = *(const uint4*)(gb1 + k0);
            }
#pragma unroll
            for (int kk = 0; kk < 2; ++kk) {
                bf16x8 af[4], bfr[4];
#pragma unroll
                for (int i = 0; i < 4; ++i) af[i] = *(const bf16x8*)(As + (wm * 64 + i * 16 + fr) * 72 + kk * 32 + fq * 8);
#pragma unroll
                for (int j = 0; j < 4; ++j) bfr[j] = *(const bf16x8*)(Bs + (wn * 64 + j * 16 + fr) * 72 + kk * 32 + fq * 8);
#pragma unroll
                for (int i = 0; i < 4; ++i)
#pragma unroll
                    for (int j = 0; j < 4; ++j) acc[i][j] = __builtin_amdgcn_mfma_f32_16x16x32_bf16(bfr[j], af[i], acc[i][j], 0, 0, 0);
            }
            __syncthreads();
            if (more) {
                *(uint4*)sa0 = ra0; *(uint4*)sa1 = ra1; *(uint4*)sa2 = ra2; *(uint4*)sa3 = ra3; *(uint4*)sb0 = rb0; *(uint4*)sb1 = rb1;
                __syncthreads();
            }
        }
#pragma unroll
        for (int i = 0; i < 4; ++i)
#pragma unroll
            for (int j = 0; j < 4; ++j) {
                const int row = tm * 256 + wm * 64 + i * 16 + fr, col = tn * 128 + wn * 64 + j * 16 + fq * 4;
                epi(row, col, acc[i][j]);
            }
    }
}

namespace pg8 {
#define PG8_LAS __attribute__((address_space(3)))
constexpr int BM = 256, BK = 64, HALF = 128, HTB = HALF * BK * 2  , STAGE_BYTES = 8 * HTB, NXCD = 8, WGM = 16;
__device__ __forceinline__ int lds_byte(int r, int c) { const int st = (r >> 4) * 2 + (c >> 5), rr = r & 15, cc = c & 31, ob = rr * 64 + cc * 2; return st * 1024 + (ob ^ (((ob >> 9) & 1) << 5)); }
__device__ __forceinline__ void stage_rc(int b, int& R, int& C) { const int st = b / 1024, sb = b % 1024, swz = sb ^ (((sb >> 9) & 1) << 5); R = (st >> 1) * 16 + swz / 64; C = (st & 1) * 32 + (swz % 64) / 2; }
__device__ __forceinline__ int perm32(int rho) { const int n = rho >> 4, i = rho & 15; return 8 * (i >> 2) + 4 * n + (i & 3); }
struct Unit { int pm, pn, pk; };
struct Gemm { const bf16_t* A; const bf16_t* Bt; int K; int splits; };
struct StaticOrder {
    int nM, nN, nNr, pm0, nwg, G, c;
    __device__ void init(int nM_, int nNr_, int splits, int pm0_, int G_, int c_) { nM = nM_; nNr = nNr_; nN = nNr_ * splits; pm0 = pm0_; nwg = nM * nN; G = G_; c = c_; }
    __device__ bool next(int i, Unit& u) const {
        const long L = (long)i * G + c; if (L >= nwg) return false;
        int wgid = (int)L; { const int q = nwg / NXCD, r = nwg % NXCD, xcd = wgid % NXCD, off = wgid / NXCD; wgid = (xcd < r ? xcd * (q + 1) : r * (q + 1) + (xcd - r) * q) + off; }
        const int nig = WGM * nN, gid = wgid / nig, fm = gid * WGM, gsz = (nM - fm) < WGM ? (nM - fm) : WGM;
        const int pnv = (wgid % nig) / gsz;
        u.pm = pm0 + fm + ((wgid % nig) % gsz); u.pn = pnv % nNr; u.pk = pnv / nNr; return true;
    }
};
template <class Epi>
__device__ __forceinline__ void gemm_phase(PG8_LAS unsigned char* lds, const Gemm g, const StaticOrder& S, const Epi& E) {
    const int tid = tid_opaque(), wid = __builtin_amdgcn_readfirstlane(tid >> 6), lane = tid & 63, wr = wid >> 2, wc = wid & 3, fr = lane & 15, fq = lane >> 4;
    const int K = g.K, Kp = K / g.splits, nt = Kp / BK;
    unsigned voffA[2], voffB[2];
#pragma unroll
    for (int i = 0; i < 2; ++i) { int R, C; stage_rc(tid * 16 + i * 8192, R, C); const int Rb = (R & ~31) + perm32(R & 31);
        voffA[i] = (unsigned)(R * K + C) * 2u; voffB[i] = (unsigned)(Rb * K + C) * 2u; }
    const size_t kstep = (size_t)(BK * 2);
    const size_t hstep = (size_t)HALF * K * 2;
    const size_t tstep = 2 * hstep;
    const size_t pstep = (size_t)Kp * 2;
    const unsigned ldsw = (unsigned)wid * 1024u;
    const int aoff = lds_byte(wr * 64 + fr, fq * 8), boff = lds_byte(wc * 32 + fr, fq * 8);
#define PG8_SA(b, h) (((b) * 2 + (h)) * HTB)
#define PG8_SB(b, h) ((4 + (b) * 2 + (h)) * HTB)
#define PG8_STAGE(bufoff, gbase, voff) do { _Pragma("unroll") for (int _i = 0; _i < 2; ++_i) \
        __builtin_amdgcn_global_load_lds((const unsigned*)((const char*)(gbase) + (voff)[_i]), (PG8_LAS unsigned*)(lds + (bufoff) + ldsw + _i * 8192), 16, 0, 0); } while (0)
#define PG8_LDA(dst, b, h) do { _Pragma("unroll") for (int m = 0; m < 4; ++m) _Pragma("unroll") for (int k = 0; k < 2; ++k) dst[m][k] = *(const PG8_LAS bf16x8*)(lds + PG8_SA(b, h) + aoff + m * 2048 + k * 1024); } while (0)
#define PG8_LDB(dst, b, h) do { _Pragma("unroll") for (int n = 0; n < 2; ++n) _Pragma("unroll") for (int k = 0; k < 2; ++k) dst[n][k] = *(const PG8_LAS bf16x8*)(lds + PG8_SB(b, h) + boff + n * 2048 + k * 1024); } while (0)
#define PG8_MMA(ai, bj, At, Bt) do { __builtin_amdgcn_s_setprio(1); _Pragma("unroll") for (int m = 0; m < 4; ++m) _Pragma("unroll") for (int n = 0; n < 2; ++n) _Pragma("unroll") for (int k = 0; k < 2; ++k) \
        acc[ai][bj][m][n] = __builtin_amdgcn_mfma_f32_16x16x32_bf16(Bt[n][k], At[m][k], acc[ai][bj][m][n], 0, 0, 0); __builtin_amdgcn_s_setprio(0); } while (0)
#define PG8_WAIT_V(n) asm volatile("s_waitcnt vmcnt(" #n ")" ::: "memory")
#define PG8_WAIT_L(n) asm volatile("s_waitcnt lgkmcnt(" #n ")" ::: "memory")
#define PG8_BAR __builtin_amdgcn_s_barrier()
#define PG8_SCHED __builtin_amdgcn_sched_barrier(0)
    Unit cur, nxt; int ui = 0;
    if (!S.next(0, cur)) return;
    f32x4 acc[2][2][4][2];
#pragma unroll
    for (int a = 0; a < 2; ++a)
#pragma unroll
        for (int b = 0; b < 2; ++b)
#pragma unroll
            for (int m = 0; m < 4; ++m)
#pragma unroll
                for (int n = 0; n < 2; ++n) acc[a][b][m][n] = (f32x4){0.f, 0.f, 0.f, 0.f};
    bf16x8 At[4][2], B0[2][2], B1[2][2];
    const char* cA = (const char*)g.A + (size_t)cur.pm * tstep + (size_t)cur.pk * pstep; const char* cB = (const char*)g.Bt + (size_t)cur.pn * tstep + (size_t)cur.pk * pstep;
    PG8_STAGE(PG8_SB(0, 0), cB, voffB); PG8_STAGE(PG8_SA(0, 0), cA, voffA); PG8_STAGE(PG8_SB(0, 1), cB + hstep, voffB); PG8_STAGE(PG8_SA(0, 1), cA + hstep, voffA);
    if (wr == 1) PG8_BAR;
    PG8_WAIT_V(4); PG8_BAR;
    PG8_STAGE(PG8_SB(1, 0), cB + kstep, voffB); PG8_STAGE(PG8_SA(1, 0), cA + kstep, voffA); PG8_STAGE(PG8_SB(1, 1), cB + hstep + kstep, voffB);
    PG8_WAIT_V(6); PG8_BAR;
    for (;;) {
        const bool has_next = S.next(ui + 1, nxt);
        const char* nA = has_next ? (const char*)g.A + (size_t)nxt.pm * tstep + (size_t)nxt.pk * pstep : cA; const char* nB = has_next ? (const char*)g.Bt + (size_t)nxt.pn * tstep + (size_t)nxt.pk * pstep : cB;
        for (int t = 0; t < nt; t += 2) {
            const bool last = (t == nt - 2);
            const char* a1 = cA + (size_t)(t + 1) * kstep;
            const char* a2 = last ? nA : cA + (size_t)(t + 2) * kstep; const char* b2 = last ? nB : cB + (size_t)(t + 2) * kstep;
            const char* a3 = a2 + kstep; const char* b3 = b2 + kstep;
            PG8_LDB(B0, 0, 0); PG8_SCHED; PG8_LDA(At, 0, 0); PG8_STAGE(PG8_SA(1, 1), a1 + hstep, voffA);
            PG8_WAIT_L(8); PG8_BAR; PG8_WAIT_L(0); PG8_MMA(0, 0, At, B0); PG8_BAR; PG8_SCHED;
            PG8_LDB(B1, 0, 1); PG8_STAGE(PG8_SB(0, 0), b2, voffB);
            PG8_BAR; PG8_WAIT_L(0); PG8_MMA(0, 1, At, B1); PG8_BAR;
            PG8_LDA(At, 0, 1); PG8_STAGE(PG8_SA(0, 0), a2, voffA);
            PG8_BAR; PG8_WAIT_L(0); PG8_MMA(1, 0, At, B0); PG8_BAR; PG8_SCHED;
            PG8_STAGE(PG8_SB(0, 1), b2 + hstep, voffB);
            PG8_WAIT_V(6); PG8_BAR; PG8_MMA(1, 1, At, B1); PG8_BAR;
            PG8_LDB(B0, 1, 0); PG8_SCHED; PG8_LDA(At, 1, 0); PG8_STAGE(PG8_SA(0, 1), a2 + hstep, voffA);
            PG8_WAIT_L(8); PG8_BAR; PG8_WAIT_L(0); PG8_MMA(0, 0, At, B0); PG8_BAR; PG8_SCHED;
            PG8_LDB(B1, 1, 1); PG8_STAGE(PG8_SB(1, 0), b3, voffB);
            PG8_BAR; PG8_WAIT_L(0); PG8_MMA(0, 1, At, B1); PG8_BAR;
            PG8_LDA(At, 1, 1); PG8_STAGE(PG8_SA(1, 0), a3, voffA);
            PG8_BAR; PG8_WAIT_L(0); PG8_MMA(1, 0, At, B0); PG8_BAR; PG8_SCHED;
            PG8_STAGE(PG8_SB(1, 1), b3 + hstep, voffB);
            PG8_WAIT_V(6); PG8_BAR; PG8_MMA(1, 1, At, B1); PG8_BAR;
        }
#pragma unroll
        for (int ai = 0; ai < 2; ++ai)
#pragma unroll
            for (int m = 0; m < 4; ++m)
#pragma unroll
                for (int bj = 0; bj < 2; ++bj)
                    E(cur.pm * BM + ai * HALF + wr * 64 + m * 16 + fr, cur.pn * BM + bj * HALF + wc * 32 + 8 * fq, acc[ai][bj][m][0], acc[ai][bj][m][1], cur.pk);
        if (!has_next) break;
#pragma unroll
        for (int a = 0; a < 2; ++a)
#pragma unroll
            for (int b = 0; b < 2; ++b)
#pragma unroll
                for (int m = 0; m < 4; ++m)
#pragma unroll
                    for (int n = 0; n < 2; ++n) acc[a][b][m][n] = (f32x4){0.f, 0.f, 0.f, 0.f};
        cur = nxt; cA = nA; cB = nB; ++ui;
    }
    PG8_WAIT_V(0);
    if (wr == 0) PG8_BAR;
    PG8_BAR;
#undef PG8_SA
#undef PG8_SB
#undef PG8_STAGE
#undef PG8_LDA
#undef PG8_LDB
#undef PG8_MMA
#undef PG8_WAIT_V
#undef PG8_WAIT_L
#undef PG8_BAR
#undef PG8_SCHED
}
}

template <class Epi>
__device__ __forceinline__ void gemm_big(const bf16_t* A, int K, const bf16_t* Bt, int Npad, const Epi& e, char* smem, int bid, int nb) {
    pg8::StaticOrder S; S.init(MPAD / 256, Npad / 256, 1, 0, nb, bid);
    pg8::gemm_phase((PG8_LAS unsigned char*)smem, pg8::Gemm{A, Bt, K, 1}, S, e);
}
template <class Epi1, class Epi2>
__device__ __forceinline__ void gemm_n1024(const bf16_t* A, int K, const bf16_t* Bt, const Epi1& e1, const Epi2& e2, int splits, char* smem, int bid, int nb) {
    pg8::StaticOrder S; S.init(64, 4, 1, 0, nb, bid);
    pg8::gemm_phase((PG8_LAS unsigned char*)smem, pg8::Gemm{A, Bt, K, 1}, S, e1);
    pg8::StaticOrder S2; S2.init(3, 4, splits, 64, nb, bid);
    pg8::gemm_phase((PG8_LAS unsigned char*)smem, pg8::Gemm{A, Bt, K, splits}, S2, e2);
}

__device__ __forceinline__ void st_bf16x8(bf16_t* p, f32x4 a, f32x4 b) {
    u32x4 w; w[0] = pk2(a[0], a[1]); w[1] = pk2(a[2], a[3]); w[2] = pk2(b[0], b[1]); w[3] = pk2(b[2], b[3]);
    *(u32x4*)p = w;
}
struct EpiGdnIn {
    bf16_t *mixed, *z; float* ba;
    __device__ __forceinline__ void operator()(int row, int col, f32x4 v0, f32x4 v1, int = 0) const {
        if (col < 4096) st_bf16x8(mixed + (size_t)row * 4096 + col, v0, v1);
        else if (col < 6144) st_bf16x8(z + (size_t)row * 2048 + (col - 4096), v0, v1);
        else if (col < 6176) { *(f32x4*)(ba + (size_t)row * 32 + (col - 6144)) = v0; *(f32x4*)(ba + (size_t)row * 32 + (col - 6144) + 4) = v1; }
    }
};
struct EpiResid {
    float* out; const bf16_t* h;
    __device__ __forceinline__ void operator()(int row, int col, f32x4 v0, f32x4 v1, int = 0) const {
        const uint4 hr = *(const uint4*)(h + (size_t)row * D + col);
        const f32x4 r0 = cvt_bf16x4(make_uint2(hr.x, hr.y)), r1 = cvt_bf16x4(make_uint2(hr.z, hr.w));
        st_bf16x8((bf16_t*)out + (size_t)row * D + col, v0 + r0 * ALPHA, v1 + r1 * ALPHA);
    }
};
struct EpiSlab {
    float* slab;
    __device__ __forceinline__ void operator()(int row, int col, f32x4 v0, f32x4 v1, int pk) const {
        float* o = slab + ((size_t)pk * 768 + (row - 16384)) * D + col;
        *(f32x4*)o = v0; *(f32x4*)(o + 4) = v1;
    }
};
struct EpiRelu2 {
    bf16_t* act;
    __device__ __forceinline__ void operator()(int row, int col, f32x4 v0, f32x4 v1, int = 0) const {
#pragma unroll
        for (int e = 0; e < 4; ++e) { const float r = fmaxf(v0[e], 0.f); v0[e] = r * r; const float q = fmaxf(v1[e], 0.f); v1[e] = q * q; }
        st_bf16x8(act + (size_t)row * DFF + col, v0, v1);
    }
};
struct EpiBf16 {
    bf16_t* out; int ld;
    __device__ __forceinline__ void operator()(int row, int col, f32x4 v0, f32x4 v1, int = 0) const { st_bf16x8(out + (size_t)row * ld + col, v0, v1); }
};

__device__ __forceinline__ void ln_phase(const float* X, const float* __restrict__ g, const float* __restrict__ bta, bf16_t* Hout,
                         float* yp, float* ys, const float* slab, int splits, const bf16_t* hres, int bid, int nb) {
    const int tid_ = tid_opaque(); const int lane = tid_ & 63, wave = tid_ >> 6;
    f32x4 gv[4], bv[4];
#pragma unroll
    for (int j = 0; j < 4; ++j) { gv[j] = *(const f32x4*)(g + j * 256 + lane * 4); bv[j] = *(const f32x4*)(bta + j * 256 + lane * 4); }
    for (int row = bid * 8 + wave; row < NT; row += nb * 8) {
        f32x4 v[4]; float s = 0.f;
        if (row < 16384) {
#pragma unroll
            for (int j = 0; j < 4; ++j) v[j] = ld_bf16x4((const bf16_t*)X + (size_t)row * D + j * 256 + lane * 4);
        } else {
#pragma unroll
            for (int j = 0; j < 4; ++j) v[j] = ld_bf16x4(hres + (size_t)row * D + j * 256 + lane * 4) * ALPHA;
            for (int pk = 0; pk < splits; ++pk) {
                const float* sp = slab + ((size_t)pk * 768 + (row - 16384)) * D + lane * 4;
#pragma unroll
                for (int j = 0; j < 4; ++j) v[j] += *(const f32x4*)(sp + j * 256);
            }
        }
#pragma unroll
        for (int j = 0; j < 4; ++j) s += (v[j][0] + v[j][1]) + (v[j][2] + v[j][3]);
        const float mean = wave_sum(s) * (1.f / D);
        float s2 = 0.f;
#pragma unroll
        for (int j = 0; j < 4; ++j) { v[j] = v[j] - mean; s2 += (v[j][0] * v[j][0] + v[j][1] * v[j][1]) + (v[j][2] * v[j][2] + v[j][3] * v[j][3]); }
        const float rstd = rsqrtf(wave_sum(s2) * (1.f / D) + 1e-5f);
        float* yo = nullptr;
        if (yp) {
            if (row < NPR) { const int b = row / LP, t = row % LP; if (t >= NMETA) yo = yp + ((size_t)b * SEQ + (t - NMETA)) * D; }
            else yo = ys + (size_t)(row - NPR) * D;
        }
#pragma unroll
        for (int j = 0; j < 4; ++j) {
            const f32x4 o = v[j] * rstd * gv[j] + bv[j];
            if (Hout) st_bf16x4(Hout + (size_t)row * D + j * 256 + lane * 4, o);
            if (yo) *(f32x4*)(yo + j * 256 + lane * 4) = o;
        }
    }
}

__device__ __forceinline__ void gdn_sample_pass(const Params& p, char* smem, int pass, int tid) {
    float* sq = (float*)smem;
    float* sk = sq + 256;
    float* part = sk + 256;
    float* part2 = part + 16;
    const int lane = tid & 63, wave = tid >> 6, ug = wave >> 2, wq = wave & 3;
    const int half = lane >> 5, v = wq * 32 + (lane & 31);
    const int u = pass * 2 + ug, b = u >> 4, h = u & 15, kh = h >> 1;
    const size_t row0 = (size_t)NPR + (size_t)b * DS;
    float S[64];
    {
        const float* Sp = p.state_gdn + ((size_t)(b * 16 + h) * 128 + half * 64) * 128 + v;
#pragma unroll
        for (int k = 0; k < 64; ++k) S[k] = Sp[(size_t)k * 128];
    }
    const float Aexp = __expf(p.gdn_a_log[h]);
    const float dtb = p.gdn_dt_bias[h];
    const float nw = p.gdn_norm_w[v];
    const int chA = (half ? 1024 : 0) + kh * 128 + v, chv = 2048 + h * 128 + v;
    float cA[4], cv[4];
#pragma unroll
    for (int j = 0; j < 4; ++j) { cA[j] = p.gdn_conv_w[j * 4096 + chA]; cv[j] = p.gdn_conv_w[j * 4096 + chv]; }
    float xA[7], xv[7];
#pragma unroll
    for (int i = 0; i < 3; ++i) {
        const float* cs = p.state_conv + ((size_t)b * 3 + i) * 4096;
        xA[i] = cs[chA]; xv[i] = cs[chv];
    }
#pragma unroll
    for (int i = 0; i < 4; ++i) {
        const bf16_t* mr = p.mixed + (row0 + i) * 4096;
        xA[3 + i] = bf2f(mr[chA]); xv[3 + i] = bf2f(mr[chv]);
    }
    float* sqg = sq + ug * 128;
    float* skg = sk + ug * 128;
    float* pg = part + ug * 8;
    float* pg2 = part2 + ug * 4;
    const float* kmine = skg + half * 64;
    const float* qmine = sqg + half * 64;
#pragma unroll
    for (int t = 0; t < DS; ++t) {
        const float yA = silu(xA[t] * cA[0] + xA[t + 1] * cA[1] + xA[t + 2] * cA[2] + xA[t + 3] * cA[3]);
        const float yv = silu(xv[t] * cv[0] + xv[t + 1] * cv[1] + xv[t + 2] * cv[2] + xv[t + 3] * cv[3]);
        (half ? skg : sqg)[v] = yA;
        float ssA = yA * yA;
#pragma unroll
        for (int o = 1; o < 32; o <<= 1) ssA += __shfl_xor(ssA, o);
        if ((lane & 31) == 0) pg[wq * 2 + half] = ssA;
        lds_barrier();
        const float qn = rsqrtf((pg[0] + pg[2]) + (pg[4] + pg[6]) + 1e-6f) * 0.08838834764831845f;
        const float kn = rsqrtf((pg[1] + pg[3]) + (pg[5] + pg[7]) + 1e-6f);
        const float* bap = p.ba + (row0 + t) * 32;
        const float beta = 1.f / (1.f + __expf(-bap[h]));
        const float aa = bap[16 + h] + dtb;
        const float sp = (aa > 20.f) ? aa : log1pf(__expf(aa));
        const float dec = __expf(-Aexp * sp);
        float kS0 = 0.f, kS1 = 0.f;
#pragma unroll
        for (int k = 0; k < 64; k += 4) {
            const f32x4 kk = *(const f32x4*)(kmine + k);
            S[k] *= dec; S[k + 1] *= dec; S[k + 2] *= dec; S[k + 3] *= dec;
            kS0 += kk[0] * S[k]; kS1 += kk[1] * S[k + 1]; kS0 += kk[2] * S[k + 2]; kS1 += kk[3] * S[k + 3];
        }
        float kS = kS0 + kS1;
        kS += __shfl_xor(kS, 32);
        const float delta = (yv - kS * kn) * beta * kn;
        float o0 = 0.f, o1 = 0.f;
#pragma unroll
        for (int k = 0; k < 64; k += 4) {
            const f32x4 kk = *(const f32x4*)(kmine + k);
            const f32x4 qq = *(const f32x4*)(qmine + k);
            S[k] += kk[0] * delta; S[k + 1] += kk[1] * delta; S[k + 2] += kk[2] * delta; S[k + 3] += kk[3] * delta;
            o0 += qq[0] * S[k]; o1 += qq[1] * S[k + 1]; o0 += qq[2] * S[k + 2]; o1 += qq[3] * S[k + 3];
        }
        float o = o0 + o1;
        o = (o + __shfl_xor(o, 32)) * qn;
        float s3 = o * o;
#pragma unroll
        for (int x = 1; x < 32; x <<= 1) s3 += __shfl_xor(s3, x);
        if (lane == 0) pg2[wq] = s3;
        lds_barrier();
        if (half == 0) {
            const float rms = rsqrtf(((pg2[0] + pg2[1]) + (pg2[2] + pg2[3])) * (1.f / 128.f) + 1e-6f);
            const float zz = bf2f(p.z[(row0 + t) * 2048 + h * 128 + v]);
            p.gated[(row0 + t) * 2048 + h * 128 + v] = f2bf(o * rms * nw * silu(zz));
        }
    }
    {
        float* So = p.gs_sample + ((size_t)(b * 16 + h) * 128 + half * 64) * 128 + v;
#pragma unroll
        for (int k = 0; k < 64; ++k) So[(size_t)k * 128] = S[k];
    }
    lds_barrier();
}

#define MFMA32(a, b, c) __builtin_amdgcn_mfma_f32_32x32x16_bf16((a), (b), (c), 0, 0, 0)
constexpr int NCH = 65;
constexpr int NCU = BATCH * 16 * NCH;
__device__ __forceinline__ int crow(int reg, int hh) { return (reg & 3) + 8 * (reg >> 2) + 4 * hh; }
__device__ __forceinline__ bf16x8 pack_step(const f32x16& x, int s) {
    u32x4 q;
    q[0] = pk2(x[8 * s + 0], x[8 * s + 1]); q[1] = pk2(x[8 * s + 2], x[8 * s + 3]);
    q[2] = pk2(x[8 * s + 4], x[8 * s + 5]); q[3] = pk2(x[8 * s + 6], x[8 * s + 7]);
    return __builtin_bit_cast(bf16x8, q);
}
__device__ __forceinline__ bf16x8 frag_perm(const bf16_t* p0) {
    const uint2 lo = *(const uint2*)p0, hi = *(const uint2*)(p0 + 8);
    u32x4 q; q[0] = lo.x; q[1] = lo.y; q[2] = hi.x; q[3] = hi.y;
    return __builtin_bit_cast(bf16x8, q);
}

constexpr int SA_KB = 64 * 136 * 2, SA_VB = 2 * SA_KB, SA_AM = 3 * SA_KB, SA_SM = SA_AM + 64 * 68 * 4, SA_GROUP_BYTES = SA_SM + 5 * 64 * 4;
__device__ __forceinline__ void gdn_stageA(const Params& p, char* smem0, int bid, int nb) {
    {
        const int tid = tid_opaque();
        for (int idx = bid * NTHR + tid; idx < (BATCH + DB) * 3 * 4096; idx += nb * NTHR) {
            const int c = idx & 4095, r = (idx >> 12) % 3, b = idx / (3 * 4096);
            if (b < BATCH) p.gc_prompt[idx] = bf2f(p.mixed[((size_t)b * LP + (LP - 3) + r) * 4096 + c]);
            else { const int bs = b - BATCH; p.gc_sample[(size_t)(bs * 3 + r) * 4096 + c] = bf2f(p.mixed[((size_t)NPR + bs * 4 + 1 + r) * 4096 + c]); }
        }
    }
    for (int base = bid * 2; base < NCU; base += nb * 2) {
        const int tid = tid_opaque(), lane = tid & 63, grp = tid >> 8, wg = (tid >> 6) & 3, t2 = tid & 255;
        unsigned zofs = 0; asm volatile("" : "+v"(zofs));
        char* smem = smem0 + zofs + grp * SA_GROUP_BYTES;
        bf16_t* Qb = (bf16_t*)smem;
        bf16_t* Kb = (bf16_t*)(smem + SA_KB);
        bf16_t* Vb = (bf16_t*)(smem + SA_VB);
        float* Am = (float*)(smem + SA_AM);
        float* sbeta = (float*)(smem + SA_SM);
        float* sgc = sbeta + 64;
        float* segc = sgc + 64;
        float* sekd = segc + 64;
        float* srk = sekd + 64;
        const int u = base + grp;
        const bool tail = base >= 4096;
        const int h = u & 15, n = tail ? 64 : ((u >> 4) & 63), b = tail ? ((u - 4096) >> 4) : (u >> 10);
        const int kh = h >> 1;
        const size_t su = (size_t)((b * 16 + h) * NCH + n);
        const int t0 = n * 64;
        if (tail && wg > 0) {
            const int cq = lane & 31, tsel = lane >> 5;
            const int tl0 = 16 * wg + 8 * tsel;
#pragma unroll
            for (int i = 0; i < 8; ++i) {
                *(uint2*)(Qb + (tl0 + i) * 136 + cq * 4) = make_uint2(0u, 0u);
                *(uint2*)(Kb + (tl0 + i) * 136 + cq * 4) = make_uint2(0u, 0u);
                *(uint2*)(Vb + (tl0 + i) * 136 + cq * 4) = make_uint2(0u, 0u);
            }
        } else {
            const int cq = lane & 31, tsel = lane >> 5;
            const int tl0 = 16 * wg + 8 * tsel;
#pragma unroll
            for (int pp = 0; pp < 2; ++pp) {
                const int part = pp ? 2 : grp;
                const int chb = ((part == 0) ? (kh * 128) : (part == 1) ? (1024 + kh * 128) : (2048 + h * 128)) + cq * 4;
                f32x4 cw[4];
#pragma unroll
                for (int j = 0; j < 4; ++j) cw[j] = *(const f32x4*)(p.gdn_conv_w + j * 4096 + chb);
                uint2 xr[11];
#pragma unroll
                for (int i = 0; i < 11; ++i) {
                    const int t = t0 + tl0 - 3 + i;
                    if (t >= 0 && t < LP) xr[i] = *(const uint2*)(p.mixed + ((size_t)b * LP + t) * 4096 + chb);
                    else xr[i] = make_uint2(0u, 0u);
                }
                f32x4 yv[8];
                float ssv[8];
#pragma unroll
                for (int i = 0; i < 8; ++i) {
                    const f32x4 a = cvt_bf16x4(xr[i]) * cw[0] + cvt_bf16x4(xr[i + 1]) * cw[1] + cvt_bf16x4(xr[i + 2]) * cw[2] + cvt_bf16x4(xr[i + 3]) * cw[3];
                    const bool valid = (t0 + tl0 + i) < LP;
#pragma unroll
                    for (int e2 = 0; e2 < 4; ++e2) yv[i][e2] = valid ? silu(a[e2]) : 0.f;
                    ssv[i] = (yv[i][0] * yv[i][0] + yv[i][1] * yv[i][1]) + (yv[i][2] * yv[i][2] + yv[i][3] * yv[i][3]);
                }
                if (part < 2) {
#pragma unroll
                    for (int o = 1; o < 32; o <<= 1)
#pragma unroll
                        for (int i = 0; i < 8; ++i) ssv[i] += __shfl_xor(ssv[i], o);
                }
                bf16_t* dst = (part == 0) ? Qb : (part == 1) ? Kb : Vb;
                bf16_t* dst2 = (bf16_t*)((char*)dst + (grp ? -SA_GROUP_BYTES : SA_GROUP_BYTES));
#pragma unroll
                for (int i = 0; i < 8; ++i) {
                    f32x4 y = yv[i];
                    if (part < 2) y = y * (rsqrtf(ssv[i] + 1e-6f) * ((part == 0) ? 0.08838834764831845f : 1.f));
                    st_bf16x4(dst + (tl0 + i) * 136 + cq * 4, y);
                    if (part < 2) st_bf16x4(dst2 + (tl0 + i) * 136 + cq * 4, y);
                }
            }
        }
        if (wg == 0) {
            const int c = lane, t = t0 + c;
            float beta = 0.f, g = 0.f;
            if (t < LP) {
                const float* bap = p.ba + ((size_t)b * LP + t) * 32;
                beta = 1.f / (1.f + __expf(-bap[h]));
                const float aa = bap[16 + h] + p.gdn_dt_bias[h];
                const float sp = (aa > 20.f) ? aa : log1pf(__expf(aa));
                g = -__expf(p.gdn_a_log[h]) * sp;
            }
            float gc = g;
#pragma unroll
            for (int o = 1; o < 64; o <<= 1) { const float v = __shfl_up(gc, o); if (lane >= o) gc += v; }
            const float glast = __shfl(gc, 63);
            sbeta[c] = beta; sgc[c] = gc; segc[c] = __expf(gc); sekd[c] = __expf(glast - gc); srk[c] = beta * __expf(gc);
            if (lane == 0) p.g_dec[su] = __expf(glast);
        }
        lds_barrier();
        {
            const int ti = wg >> 1, tj = wg & 1;
            const int r = lane & 31, hh = lane >> 5;
            const int c = 32 * tj + r;
            const float gcc = sgc[c], bc = sbeta[c];
            f32x16 acck, accq;
#pragma unroll
            for (int i = 0; i < 16; ++i) { acck[i] = 0.f; accq[i] = 0.f; }
            {
                const bf16_t* Ap = Kb + (32 * ti + r) * 136 + 8 * hh;
                const bf16_t* Bk = Kb + (32 * tj + r) * 136 + 8 * hh;
                const bf16_t* Bq = Qb + (32 * tj + r) * 136 + 8 * hh;
#pragma unroll
                for (int ks = 0; ks < 8; ++ks) {
                    const bf16x8 a = *(const bf16x8*)(Ap + 16 * ks);
                    acck = MFMA32(a, *(const bf16x8*)(Bk + 16 * ks), acck);
                    accq = MFMA32(a, *(const bf16x8*)(Bq + 16 * ks), accq);
                }
            }
#pragma unroll
            for (int reg = 0; reg < 16; ++reg) {
                const int cp = 32 * ti + crow(reg, hh);
                const float dcy = __expf(fminf(gcc - sgc[cp], 0.f));
                Am[(c >> 1) * 136 + cp * 2 + (c & 1)] = (cp < c) ? (bc * acck[reg] * dcy) : 0.f;
            }
            {
                bf16_t* aq = p.g_aqk + su * 4096 + (size_t)(((ti * 2 + tj) * 4) * 2 * 32) * 4 + (size_t)(hh * 32 + r) * 4;
#pragma unroll
                for (int g4 = 0; g4 < 4; ++g4) {
                    const int cp0 = 32 * ti + 8 * g4 + 4 * hh;
                    f32x4 v;
#pragma unroll
                    for (int e2 = 0; e2 < 4; ++e2) {
                        const int cp = cp0 + e2;
                        const float dcy = __expf(fminf(gcc - sgc[cp], 0.f));
                        v[e2] = (cp <= c) ? (accq[4 * g4 + e2] * dcy) : 0.f;
                    }
                    st_bf16x4(aq + (size_t)g4 * (2 * 32 * 4), v);
                }
            }
        }
        {
#pragma unroll
            for (int it = 0; it < 4; ++it) {
                const int chk = t2 + 256 * it, c = chk >> 4, d0 = (chk & 15) * 8;
                const float ee = segc[c];
                const uint4 raw = *(const uint4*)(Qb + c * 136 + d0);
                uint4 o;
                o.x = pk2(__uint_as_float(raw.x << 16) * ee, __uint_as_float(raw.x & 0xffff0000u) * ee);
                o.y = pk2(__uint_as_float(raw.y << 16) * ee, __uint_as_float(raw.y & 0xffff0000u) * ee);
                o.z = pk2(__uint_as_float(raw.z << 16) * ee, __uint_as_float(raw.z & 0xffff0000u) * ee);
                o.w = pk2(__uint_as_float(raw.w << 16) * ee, __uint_as_float(raw.w & 0xffff0000u) * ee);
                *(uint4*)(p.g_qg + su * 8192 + c * 128 + d0) = o;
            }
#pragma unroll
            for (int it = 0; it < 4; ++it) {
                const int item = t2 + 256 * it, d = item & 127, c0 = (item >> 7) * 8;
                float v[8];
#pragma unroll
                for (int i = 0; i < 8; ++i) v[i] = bf2f(Kb[(c0 + i) * 136 + d]) * sekd[c0 + i];
                uint4 o; o.x = pk2(v[0], v[1]); o.y = pk2(v[2], v[3]); o.z = pk2(v[4], v[5]); o.w = pk2(v[6], v[7]);
                *(uint4*)(p.g_kdT + su * 8192 + (size_t)item * 8) = o;
            }
        }
        lds_barrier();
        {
            const int col = 64 * wg + lane;
            const float* rs = sbeta + __builtin_amdgcn_readfirstlane((wg < 2) ? 0 : 256);
            const bf16_t* src = ((wg < 2) ? Vb : Kb) + (col & 127);
            float x[64];
#pragma unroll
            for (int i = 0; i < 64; ++i) x[i] = bf2f(src[i * 136]) * rs[i];
#pragma unroll
            for (int i0 = 0; i0 < 64; i0 += 4) {
                if (tail && i0 >= 16) continue;
                f32x2 a01 = {x[i0], x[i0 + 1]}, a23 = {x[i0 + 2], x[i0 + 3]};
                const float* P0 = Am + (i0 >> 1) * 136;
                const float* P1 = P0 + 136;
#pragma unroll
                for (int j4 = 0; j4 < i0; j4 += 4) {
                    const f32x4 q0 = *(const f32x4*)(P0 + 2 * j4), q1 = *(const f32x4*)(P0 + 2 * j4 + 4);
                    const f32x4 q2 = *(const f32x4*)(P1 + 2 * j4), q3 = *(const f32x4*)(P1 + 2 * j4 + 4);
                    a01 -= (f32x2){q0[0], q0[1]} * x[j4]; a23 -= (f32x2){q2[0], q2[1]} * x[j4];
                    a01 -= (f32x2){q0[2], q0[3]} * x[j4 + 1]; a23 -= (f32x2){q2[2], q2[3]} * x[j4 + 1];
                    a01 -= (f32x2){q1[0], q1[1]} * x[j4 + 2]; a23 -= (f32x2){q3[0], q3[1]} * x[j4 + 2];
                    a01 -= (f32x2){q1[2], q1[3]} * x[j4 + 3]; a23 -= (f32x2){q3[2], q3[3]} * x[j4 + 3];
                    if ((j4 & 12) == 12) asm volatile("" ::: "memory");
                }
                const f32x4 l0 = *(const f32x4*)(P0 + 2 * i0), l1 = *(const f32x4*)(P1 + 2 * i0), l2 = *(const f32x4*)(P1 + 2 * i0 + 4);
                const float a0 = a01[0];
                const float a1 = a01[1] - l0[1] * a0;
                const float a2 = a23[0] - l1[0] * a0 - l1[2] * a1;
                const float a3 = a23[1] - l1[1] * a0 - l1[3] * a1 - l2[1] * a2;
                x[i0] = a0; x[i0 + 1] = a1; x[i0 + 2] = a2; x[i0 + 3] = a3;
                asm volatile("" ::: "memory");
            }
            if (wg < 2) {
                float* up = p.g_u + su * 8192 + col;
#pragma unroll
                for (int i = 0; i < 64; ++i) up[i * 128] = x[i];
            } else {
                bf16_t* wp = p.g_negw + su * 8192 + (col - 128);
#pragma unroll
                for (int i = 0; i < 64; ++i) wp[i * 128] = f2bf(-x[i]);
            }
        }
        lds_barrier();
    }
}

constexpr int GB_NW = 0, GB_QG = 64 * 136, GB_KD = 2 * 64 * 136, GB_AQ = 2 * 64 * 136 + 128 * 72, GB_ELEMS = 2 * 64 * 136 + 128 * 72 + 64 * 72;
__device__ __forceinline__ void gdn_chain(const Params& p, char* smem, int b, int h) {
    bf16_t* lds = (bf16_t*)smem;
    const int tid = tid_opaque(), lane = tid & 63, wave = tid >> 6;
    const int r = lane & 31, hh = lane >> 5;
    const size_t su0 = (size_t)(b * 16 + h) * NCH;
    const bool loader = wave >= 4;
    const int t2 = tid - 256;
    uint4 sa0, sa1, sa2, sa3, sa4, sa5, sa6, sa7, sa8, sa9, sa10, sa11, sa12, sa13;
    uint4 sb0, sb1, sb2, sb3, sb4, sb5, sb6, sb7, sb8, sb9, sb10, sb11, sb12, sb13;
    f32x16 S[4], un0, un1;
#pragma unroll
    for (int i = 0; i < 4; ++i)
#pragma unroll
        for (int j = 0; j < 16; ++j) S[i][j] = 0.f;
    const int ch0 = t2, ch1 = t2 + 256, ch2 = t2 + 512, ch3 = t2 + 768;
#define GB_GLOAD(P, n_) do { const size_t su_ = su0 + (n_); \
        const bf16_t* a_ = p.g_negw + su_ * 8192; const bf16_t* b_ = p.g_qg + su_ * 8192; const bf16_t* c_ = p.g_kdT + su_ * 8192; const bf16_t* d_ = p.g_aqk + su_ * 4096; \
        P##0 = *(const uint4*)(a_ + (size_t)ch0 * 8); P##1 = *(const uint4*)(a_ + (size_t)ch1 * 8); P##2 = *(const uint4*)(a_ + (size_t)ch2 * 8); P##3 = *(const uint4*)(a_ + (size_t)ch3 * 8); \
        P##4 = *(const uint4*)(b_ + (size_t)ch0 * 8); P##5 = *(const uint4*)(b_ + (size_t)ch1 * 8); P##6 = *(const uint4*)(b_ + (size_t)ch2 * 8); P##7 = *(const uint4*)(b_ + (size_t)ch3 * 8); \
        P##8 = *(const uint4*)(c_ + (size_t)ch0 * 8); P##9 = *(const uint4*)(c_ + (size_t)ch1 * 8); P##10 = *(const uint4*)(c_ + (size_t)ch2 * 8); P##11 = *(const uint4*)(c_ + (size_t)ch3 * 8); \
        P##12 = *(const uint4*)(d_ + (size_t)ch0 * 8); P##13 = *(const uint4*)(d_ + (size_t)ch1 * 8); } while (0)
#define GB_SSTORE(P, buf_) do { bf16_t* q_ = (buf_); \
        *(uint4*)(q_ + GB_NW + (ch0 >> 4) * 136 + (ch0 & 15) * 8) = P##0; *(uint4*)(q_ + GB_NW + (ch1 >> 4) * 136 + (ch1 & 15) * 8) = P##1; \
        *(uint4*)(q_ + GB_NW + (ch2 >> 4) * 136 + (ch2 & 15) * 8) = P##2; *(uint4*)(q_ + GB_NW + (ch3 >> 4) * 136 + (ch3 & 15) * 8) = P##3; \
        *(uint4*)(q_ + GB_QG + (ch0 >> 4) * 136 + (ch0 & 15) * 8) = P##4; *(uint4*)(q_ + GB_QG + (ch1 >> 4) * 136 + (ch1 & 15) * 8) = P##5; \
        *(uint4*)(q_ + GB_QG + (ch2 >> 4) * 136 + (ch2 & 15) * 8) = P##6; *(uint4*)(q_ + GB_QG + (ch3 >> 4) * 136 + (ch3 & 15) * 8) = P##7; \
        *(uint4*)(q_ + GB_KD + (ch0 & 127) * 72 + (ch0 >> 7) * 8) = P##8; *(uint4*)(q_ + GB_KD + (ch1 & 127) * 72 + (ch1 >> 7) * 8) = P##9; \
        *(uint4*)(q_ + GB_KD + (ch2 & 127) * 72 + (ch2 >> 7) * 8) = P##10; *(uint4*)(q_ + GB_KD + (ch3 & 127) * 72 + (ch3 >> 7) * 8) = P##11; \
        GB_AQ_ST(q_, ch0, P##12); GB_AQ_ST(q_, ch1, P##13); } while (0)
#define GB_AQ_ST(q_, ch_, v_) do { const int pq_ = 2 * (ch_), r_ = pq_ & 31, hh_ = (pq_ >> 5) & 1, g4_ = (pq_ >> 6) & 3, tl_ = pq_ >> 8; \
        bf16_t* d_ = (q_) + GB_AQ + (32 * (tl_ & 1) + r_) * 72 + 32 * (tl_ >> 1) + 8 * g4_ + 4 * hh_; \
        *(uint2*)d_ = make_uint2((v_).x, (v_).y); *(uint2*)(d_ + 72) = make_uint2((v_).z, (v_).w); } while (0)
#define GB_ULOAD(n_) do { const float* up_ = p.g_u + (su0 + (n_)) * 8192 + 32 * wave + r; \
        _Pragma("unroll") for (int reg_ = 0; reg_ < 16; ++reg_) { un0[reg_] = up_[(crow(reg_, hh)) * 128]; un1[reg_] = up_[(32 + crow(reg_, hh)) * 128]; } } while (0)
    if (loader) {
        bf16_t* buf0 = lds;
        bf16_t* buf1 = lds + GB_ELEMS;
        GB_GLOAD(sa, 0); GB_SSTORE(sa, buf0);
        GB_GLOAD(sa, 1);
        lds_barrier();
        for (int n = 0; n < NCH; n += 2) {
            if (n + 2 < NCH) { GB_GLOAD(sb, n + 2); }
            if (n + 1 < NCH) { GB_SSTORE(sa, buf1); }
            lds_barrier();
            if (n + 1 >= NCH) break;
            if (n + 3 < NCH) { GB_GLOAD(sa, n + 3); }
            if (n + 2 < NCH) { GB_SSTORE(sb, buf0); }
            lds_barrier();
        }
    } else {
        GB_ULOAD(0);
        float dec_next = p.g_dec[su0];
        lds_barrier();
        for (int n = 0; n < NCH; ++n) {
            unsigned zofs = 0; asm volatile("" : "+v"(zofs));
            bf16_t* cur = lds + (n & 1) * GB_ELEMS + zofs;
            const bool more = (n + 1 < NCH);
            const float dec = dec_next;
            if (more) dec_next = p.g_dec[su0 + n + 1];
            f32x16 vn[2], o[2];
            vn[0] = un0; vn[1] = un1;
#pragma unroll
            for (int j = 0; j < 16; ++j) { o[0][j] = 0.f; o[1][j] = 0.f; }
            if (more) { GB_ULOAD(n + 1); }
#pragma unroll
            for (int kt = 0; kt < 4; ++kt)
#pragma unroll
                for (int s = 0; s < 2; ++s) {
                    const bf16x8 sb = pack_step(S[kt], s);
                    const int k0 = 32 * kt + 16 * s + 4 * hh;
#pragma unroll
                    for (int ct = 0; ct < 2; ++ct) {
                        vn[ct] = MFMA32(frag_perm(cur + GB_NW + (32 * ct + r) * 136 + k0), sb, vn[ct]);
                        o[ct] = MFMA32(frag_perm(cur + GB_QG + (32 * ct + r) * 136 + k0), sb, o[ct]);
                    }
                }
            bf16x8 vb[2][2];
#pragma unroll
            for (int ct = 0; ct < 2; ++ct)
#pragma unroll
                for (int s = 0; s < 2; ++s) vb[ct][s] = pack_step(vn[ct], s);
            {
                o[1] = MFMA32(frag_perm(cur + GB_AQ + (32 + r) * 72 + 4 * hh), vb[0][0], o[1]);
                o[0] = MFMA32(frag_perm(cur + GB_AQ + (r) * 72 + 4 * hh), vb[0][0], o[0]);
                o[1] = MFMA32(frag_perm(cur + GB_AQ + (32 + r) * 72 + 16 + 4 * hh), vb[0][1], o[1]);
                o[0] = MFMA32(frag_perm(cur + GB_AQ + (r) * 72 + 16 + 4 * hh), vb[0][1], o[0]);
                o[1] = MFMA32(frag_perm(cur + GB_AQ + (32 + r) * 72 + 32 + 4 * hh), vb[1][0], o[1]);
                o[1] = MFMA32(frag_perm(cur + GB_AQ + (32 + r) * 72 + 32 + 16 + 4 * hh), vb[1][1], o[1]);
            }
#pragma unroll
            for (int dt = 0; dt < 4; ++dt) S[dt] = S[dt] * dec;
#pragma unroll
            for (int ckt = 0; ckt < 2; ++ckt)
#pragma unroll
                for (int s = 0; s < 2; ++s)
#pragma unroll
                    for (int dt = 0; dt < 4; ++dt)
                        S[dt] = MFMA32(frag_perm(cur + GB_KD + (32 * dt + r) * 72 + 32 * ckt + 16 * s + 4 * hh), vb[ckt][s], S[dt]);
            asm volatile("" :: "v"(un0), "v"(un1), "v"(dec_next));
#pragma unroll
            for (int ct = 0; ct < 2; ++ct)
#pragma unroll
                for (int reg = 0; reg < 16; ++reg) {
                    const int t = 64 * n + 32 * ct + crow(reg, hh);
                    if (t < LP) p.g_o[(((size_t)b * LP + t) * 16 + h) * 128 + 32 * wave + r] = f2bf(o[ct][reg]);
                }
            lds_barrier();
        }
    }
    if (!loader) {
#pragma unroll
        for (int dt = 0; dt < 4; ++dt)
#pragma unroll
            for (int reg = 0; reg < 16; ++reg)
                p.gs_prompt[((size_t)(b * 16 + h) * 128 + 32 * dt + crow(reg, hh)) * 128 + 32 * wave + r] = S[dt][reg];
    }
    lds_barrier();
}

__device__ __forceinline__ void gdn_seq_phase(const Params& p, char* smem, int bid, int nb, int rep = 0) {
    if (bid < 64) gdn_chain(p, smem, bid >> 4, bid & 15);
    else {
        float* tile = (float*)smem;
        const int b2 = bid - 64, n2 = nb - 64;
        transpose_convert(p.gdn_w_out, 2048, D, D, p.wt_gout, tile, b2, n2);
        transpose_convert(p.mlp_w1, D, DFF, DFF, p.wt_w1, tile, b2, n2);
        transpose_convert(p.mlp_w1 + (size_t)D * DFF, D, DFF, DFF, p.wt_w1 + (size_t)D * DFF, tile, b2, n2);
        transpose_convert(p.mlp_w2, DFF, D, D, p.wt_w2, tile, b2, n2);
        transpose_convert(p.mlp_w2 + (size_t)D * DFF, DFF, D, D, p.wt_w2 + (size_t)D * DFF, tile, b2, n2);
        transpose_convert(p.dsa_w_in, D, DIN, DIN_PAD, p.wt_din, tile, b2, n2);
        transpose_convert(p.dsa_w_o, D, D, D, p.wt_do, tile, b2, n2);
    }
    int* slot = (int*)(smem + LDS_BYTES - 32);
    const int tid = tid_opaque();
    for (;;) {
        if (threadIdx.x == 0) *slot = (int)atomicAdd(p.bar + 3520 + 16 * rep, 1u);
        lds_barrier();
        const int u = *slot;
        lds_barrier();
        if (u >= DB * 16 / 2) break;
        gdn_sample_pass(p, smem, u, tid_opaque());
    }
}

__device__ __forceinline__ void gdn_gate_phase(const Params& p, int bid, int nb) {
    const int tid_ = tid_opaque(); const int lane = tid_ & 63, wave = tid_ >> 6;
    const int sub = lane >> 4, l16 = lane & 15;
    f32x4 nw0 = *(const f32x4*)(p.gdn_norm_w + l16 * 8), nw1 = *(const f32x4*)(p.gdn_norm_w + l16 * 8 + 4);
    for (int it4 = bid * 8 + wave; it4 < NPR * 4; it4 += nb * 8) {
        const size_t off = ((size_t)it4 * 4 + sub) * 128 + l16 * 8;
        const uint4 ov = *(const uint4*)(p.g_o + off);
        const uint4 zv = *(const uint4*)(p.z + off);
        const f32x4 o0 = cvt_bf16x4(make_uint2(ov.x, ov.y)), o1 = cvt_bf16x4(make_uint2(ov.z, ov.w));
        const f32x4 z0 = cvt_bf16x4(make_uint2(zv.x, zv.y)), z1 = cvt_bf16x4(make_uint2(zv.z, zv.w));
        float ss = ((o0[0] * o0[0] + o0[1] * o0[1]) + (o0[2] * o0[2] + o0[3] * o0[3])) + ((o1[0] * o1[0] + o1[1] * o1[1]) + (o1[2] * o1[2] + o1[3] * o1[3]));
#pragma unroll
        for (int x = 1; x < 16; x <<= 1) ss += __shfl_xor(ss, x);
        const float rms = rsqrtf(ss * (1.f / 128.f) + 1e-6f);
        uint4 g;
        g.x = pk2(o0[0] * rms * nw0[0] * silu(z0[0]), o0[1] * rms * nw0[1] * silu(z0[1]));
        g.y = pk2(o0[2] * rms * nw0[2] * silu(z0[2]), o0[3] * rms * nw0[3] * silu(z0[3]));
        g.z = pk2(o1[0] * rms * nw1[0] * silu(z1[0]), o1[1] * rms * nw1[1] * silu(z1[1]));
        g.w = pk2(o1[2] * rms * nw1[2] * silu(z1[2]), o1[3] * rms * nw1[3] * silu(z1[3]));
        *(uint4*)(p.gated + off) = g;
    }
}

__device__ __forceinline__ size_t ikb_off(int b, int t, int d) {
    return (size_t)b * LPAD * 64 + (size_t)(t >> 5) * 2048 + (size_t)(d >> 4) * 512 + (size_t)((((d >> 3) & 1) * 32 + (t & 31)) * 8 + (d & 7));
}
__device__ __forceinline__ size_t iqb_off(int b, int t, int head, int d) {
    const int g8 = t >> 3, rt = (t >> 2) & 1, qi = t & 3;
    const int rho = (head & 3) + 8 * (((qi & 1) << 1) | (head >> 2)) + 4 * (qi >> 1);
    return ((((size_t)b * 514 + g8) * 2 + rt) * 4 + (d >> 4)) * 512 + (size_t)((((d >> 3) & 1) * 32 + rho) * 8 + (d & 7));
}
__device__ __forceinline__ void rope4(const float* tab, int fi, f32x4 x, f32x4 partner, bool first, f32x4& o) {
    const f32x4 t0 = *(const f32x4*)(tab + fi * 2), t1 = *(const f32x4*)(tab + fi * 2 + 4);
    const float sg = first ? -1.f : 1.f;
    o[0] = x[0] * t0[0] + sg * partner[0] * t0[1];
    o[1] = x[1] * t0[2] + sg * partner[1] * t0[3];
    o[2] = x[2] * t1[0] + sg * partner[2] * t1[1];
    o[3] = x[3] * t1[2] + sg * partner[3] * t1[3];
}
__device__ __forceinline__ void dsa_post_phase(const Params& p, char* smem, int bid, int nb) {
    bf16_t* vt = (bf16_t*)smem;
    for (int u = bid; u < 260 + NSR / 8; u += nb) {
        const int tid = tid_opaque(); const int lane = tid & 63, wave = tid >> 6;
        const bool prompt = u < 260;
        const int b = prompt ? ((u < 256) ? (u >> 6) : (u - 256)) : 0, t0 = prompt ? ((u < 256) ? (u & 63) * 64 : 4096) : 0;
        const int nr8 = prompt ? 8 : 1;
        for (int r8 = 0; r8 < nr8; ++r8) {
            const int tl = wave * 8 + r8;
            const int tlp = (tl & ~12) | ((tl & 4) << 1) | ((tl & 8) >> 1);
            const int t = t0 + tl;
            const bool rvalid = prompt ? (t < LP) : true;
            const int row = prompt ? (b * LP + t) : (NPR + (u - 260) * 8 + wave);
            if (!rvalid) {
                for (int e = lane; e < 256; e += 64) vt[e * 72 + tlp] = 0;
                continue;
            }
            const bf16_t* P = (const bf16_t*)p.p1 + (size_t)row * DIN_PAD;
            const int pos = prompt ? t : (PAST + ((row - NPR) & 3));
            const float* tab = p.rope_tab + (size_t)pos * 48;
            float* kout = prompt ? (p.k_prompt + (size_t)row * 256) : (p.k_sample + (size_t)(row - NPR) * 256);
            float* vout = prompt ? (p.v_prompt + (size_t)row * 256) : (p.v_sample + (size_t)(row - NPR) * 256);
#pragma unroll
            for (int j = 0; j < 5; ++j) {
                const int e0 = (lane + 64 * j) * 4, d0 = e0 & 127;
                f32x4 x = ld_bf16x4(P + e0);
                if (d0 < 32) {
                    const bool first = d0 < 16;
                    const f32x4 pr = ld_bf16x4(P + (first ? e0 + 16 : e0 - 16));
                    rope4(tab, d0 & 15, x, pr, first, x);
                }
                if (j < 4) {
                    if (prompt) st_bf16x4(p.q_b + (size_t)row * 1024 + e0, x * 0.12751743f);
                    else *(f32x4*)(p.qr + (size_t)row * 1024 + e0) = x;
                } else {
                    const int ek = e0 - 1024;
                    *(f32x4*)(kout + ek) = x;
                    if (prompt) st_bf16x4(p.k_b + ((size_t)(b * 2 + (ek >> 7)) * LPAD + t) * 128 + d0, x);
                }
            }
            {
                const int e0 = lane * 4;
                const f32x4 x = ld_bf16x4(P + 1280 + e0);
                *(f32x4*)(vout + e0) = x;
                if (prompt) {
#pragma unroll
                    for (int i = 0; i < 4; ++i) vt[(e0 + i) * 72 + tlp] = f2bf(x[i]);
                }
            }
#pragma unroll
            for (int j = 0; j < 2; ++j) {
                const int e0 = (lane + 64 * j) * 4, d0 = e0 & 63;
                f32x4 x = ld_bf16x4(P + 1536 + e0);
                if (d0 < 16) {
                    const bool first = d0 < 8;
                    const f32x4 pr = ld_bf16x4(P + 1536 + (first ? e0 + 8 : e0 - 8));
                    rope4(tab, 16 + (d0 & 7), x, pr, first, x);
                }
                if (prompt) st_bf16x4(p.iq_b + iqb_off(b, t, e0 >> 6, d0), x);
                else *(f32x4*)(p.iq + (size_t)row * 512 + e0) = x;
            }
            {
                const float x = bf2f(P[2048 + lane]);
                const float mu = wave_sum(x) * (1.f / 64.f);
                const float dv = x - mu;
                const float var = wave_sum(dv * dv) * (1.f / 64.f);
                const float xn = dv * rsqrtf(var + 1e-5f) * p.dsa_ik_g[lane] + p.dsa_ik_b[lane];
                const float other = __shfl_xor(xn, 8);
                float o = xn;
                if (lane < 16) {
                    const float c = tab[(16 + (lane & 7)) * 2], s = tab[(16 + (lane & 7)) * 2 + 1];
                    if (lane < 8) o = xn * c - other * s; else o = xn * c + other * s;
                }
                float* io = prompt ? (p.ik_prompt + (size_t)row * 64) : (p.ik_sample + (size_t)(row - NPR) * 64);
                io[lane] = o;
                if (prompt) p.ik_b[ikb_off(b, t, lane)] = f2bf(o);
            }
            if (lane < 8) p.iw[(size_t)row * 8 + lane] = bf2f(P[2112 + lane]) * 0.35355339059327373f;
        }
        lds_barrier();
        if (prompt) {
#pragma unroll
            for (int i = 0; i < 4; ++i) {
                const int ch = tid + 512 * i, rr = ch >> 3, c8 = (ch & 7) * 8;
                const uint4 v = *(const uint4*)(vt + rr * 72 + c8);
                *(uint4*)(p.vt_b + ((size_t)(b * 2 + (rr >> 7)) * 128 + (rr & 127)) * LPAD + t0 + c8) = v;
            }
        }
        lds_barrier();
    }
    for (int idx = bid * NTHR + tid_opaque(); idx < BATCH * (LPAD - LP) * 256; idx += nb * NTHR) {
        const int c = idx & 255, tp = (idx >> 8) % (LPAD - LP), bb = idx / ((LPAD - LP) * 256);
        const int t = LP + tp, kvh = c >> 7, d = c & 127;
        p.k_b[((size_t)(bb * 2 + kvh) * LPAD + t) * 128 + d] = 0;
        if (c < 64) p.ik_b[ikb_off(bb, t, c)] = 0;
        if (c < 65) p.maskT[((size_t)bb * 65 + c) * LPAD + t] = (c == 0) ? 1ull : 0ull;
    }
}

__device__ __forceinline__ const float* ik_row(const Params& p, bool prompt, int b, int s) {
    if (prompt) return p.ik_prompt + ((size_t)b * LP + s) * 64;
    if (s < PAST) { const int pg = p.page_table[b * 16 + (s >> 7)]; return p.cache_ik + ((size_t)pg * 128 + (s & 127)) * 64; }
    return p.ik_sample + ((size_t)b * DS + (s - PAST)) * 64;
}
__device__ __forceinline__ const float* kv_row(const float* own_p, const float* own_s, const float* cache, const int* page_table,
                                               bool prompt, int b, int s) {
    if (prompt) return own_p + ((size_t)b * LP + s) * 256;
    if (s < PAST) { const int pg = page_table[b * 16 + (s >> 7)]; return cache + ((size_t)pg * 128 + (s & 127)) * 256; }
    return own_s + ((size_t)b * DS + (s - PAST)) * 256;
}

template <bool PROMPT, int NREG>
__device__ __forceinline__ void select_emit(const float* sc, int qpos, int lane, unsigned long long* maskcol, int* selrow) {
    const unsigned long long ltmask = (1ull << lane) - 1ull;
    unsigned key[NREG];
    unsigned kmax = 0u, kmin = 0xffffffffu;
#pragma unroll
    for (int j = 0; j < NREG; ++j) {
        const int s = j * 64 + lane;
        const bool cand = (s >= 16 && s <= qpos);
        const float x = cand ? sc[s] : -INFINITY;
        const unsigned u = __float_as_uint(x);
        key[j] = (u & 0x80000000u) ? ~u : (u | 0x80000000u);
        kmax = max(kmax, key[j]);
        kmin = min(kmin, cand ? key[j] : 0xffffffffu);
    }
#pragma unroll
    for (int o = 1; o < 64; o <<= 1) { kmax = max(kmax, (unsigned)__shfl_xor((int)kmax, o)); kmin = min(kmin, (unsigned)__shfl_xor((int)kmin, o)); }
    unsigned lo = kmin, hi = kmax;
    bool exact = false;
    while (lo < hi) {
        const unsigned mid = lo + ((hi - lo) >> 1) + ((hi - lo) & 1u);
        int c = 0;
#pragma unroll
        for (int j = 0; j < NREG; ++j) c += __popcll(__ballot(key[j] >= mid));
        if (c >= 240) { lo = mid; if (c == 240) { exact = true; break; } } else hi = mid - 1u;
    }
    const unsigned T = lo;
    if (!PROMPT) { if (lane < 16) selrow[lane] = lane; }
    int base = 16;
    unsigned long long myword = 0ull, word64 = 0ull;
    if (exact) {
#pragma unroll
        for (int j = 0; j < NREG; ++j) {
            const bool take = key[j] >= T;
            unsigned long long m = __ballot(take);
            if (PROMPT) {
                if (j == 0) m |= 0xFFFFull;
                if (j < 64) { if (lane == j) myword = m; } else word64 = m;
            } else {
                if (take) selrow[base + __popcll(m & ltmask)] = j * 64 + lane;
                base += __popcll(m);
            }
        }
    } else {
        int cgt = 0;
#pragma unroll
        for (int j = 0; j < NREG; ++j) cgt += __popcll(__ballot(key[j] > T));
        const int need_eq = 240 - cgt;
        int erun = 0;
#pragma unroll
        for (int j = 0; j < NREG; ++j) {
            const bool gt = key[j] > T, eq = key[j] == T;
            const unsigned long long meq = __ballot(eq);
            const int rank = erun + __popcll(meq & ltmask);
            const bool take = gt || (eq && rank < need_eq);
            unsigned long long m = __ballot(take);
            if (PROMPT) {
                if (j == 0) m |= 0xFFFFull;
                if (j < 64) { if (lane == j) myword = m; } else word64 = m;
            } else {
                if (take) selrow[base + __popcll(m & ltmask)] = j * 64 + lane;
                base += __popcll(m);
            }
            erun += __popcll(meq);
        }
    }
    if (PROMPT) {
        if (NREG == 65) { maskcol[(size_t)lane * LPAD] = myword; if (lane == 0) maskcol[(size_t)64 * LPAD] = word64; }
        else { if (lane < NREG) maskcol[(size_t)lane * LPAD] = myword; else if (lane < 64) maskcol[(size_t)lane * LPAD] = 0ull; if (lane == 0) maskcol[(size_t)64 * LPAD] = 0ull; }
    }
}

__device__ __forceinline__ bf16x8 ld_f32x8_bf16(const float* p) {
    const f32x4 a = *(const f32x4*)p, b = *(const f32x4*)(p + 4);
    u32x4 q; q[0] = pk2(a[0], a[1]); q[1] = pk2(a[2], a[3]); q[2] = pk2(b[0], b[1]); q[3] = pk2(b[2], b[3]);
    return __builtin_bit_cast(bf16x8, q);
}
__device__ __forceinline__ void indexer_sample_unit(const Params& p, float* sc, int b, int tid) {
    const int lane = tid & 63, wave = tid >> 6;
    const int r = lane & 31, hh = lane >> 5;
    bf16x8 af[4];
    {
        const int e2 = r & 3, hb = (r >> 2) & 1, a = r >> 3;
        const int qi = 2 * hb + (a >> 1), head = 4 * (a & 1) + e2;
        const float* ap = p.iq + ((size_t)NPR + b * 4 + qi) * 512 + head * 64 + 8 * hh;
#pragma unroll
        for (int ks = 0; ks < 4; ++ks) af[ks] = ld_f32x8_bf16(ap + 16 * ks);
    }
    float wq[2][8];
#pragma unroll
    for (int ql = 0; ql < 2; ++ql) {
        const float* wp = p.iw + ((size_t)NPR + b * 4 + 2 * hh + ql) * 8;
        const f32x4 w0 = *(const f32x4*)wp, w1 = *(const f32x4*)(wp + 4);
#pragma unroll
        for (int e2 = 0; e2 < 4; ++e2) { wq[ql][e2] = w0[e2]; wq[ql][4 + e2] = w1[e2]; }
    }
    asm volatile("" :: "v"(af[0]), "v"(af[1]), "v"(af[2]), "v"(af[3]));
#pragma unroll
    for (int ql = 0; ql < 2; ++ql) asm volatile("" :: "v"(wq[ql][0]), "v"(wq[ql][1]), "v"(wq[ql][2]), "v"(wq[ql][3]), "v"(wq[ql][4]), "v"(wq[ql][5]), "v"(wq[ql][6]), "v"(wq[ql][7]));
    const float* kps[9];
#pragma unroll
    for (int i = 0; i < 9; ++i) {
        const int kt = wave + 8 * i;
        const int s = 32 * (kt < 65 ? kt : 64) + r;
        const float* kp;
        if (s < PAST) { const int pg = p.page_table[b * 16 + (s >> 7)]; kp = p.cache_ik + ((size_t)pg * 128 + (s & 127)) * 64; }
        else kp = p.ik_sample + ((size_t)b * DS + ((s - PAST) & 3)) * 64;
        kps[i] = kp + 8 * hh;
    }
    f32x4 nx[8];
#pragma unroll
    for (int ks = 0; ks < 4; ++ks) { nx[2 * ks] = *(const f32x4*)(kps[0] + 16 * ks); nx[2 * ks + 1] = *(const f32x4*)(kps[0] + 16 * ks + 4); }
#pragma unroll
    for (int i = 0; i < 9; ++i) {
        const int kt = wave + 8 * i;
        if (kt < 65) {
            const int s = 32 * kt + r;
            bf16x8 bq[4];
#pragma unroll
            for (int ks = 0; ks < 4; ++ks) {
                u32x4 q; q[0] = pk2(nx[2 * ks][0], nx[2 * ks][1]); q[1] = pk2(nx[2 * ks][2], nx[2 * ks][3]);
                q[2] = pk2(nx[2 * ks + 1][0], nx[2 * ks + 1][1]); q[3] = pk2(nx[2 * ks + 1][2], nx[2 * ks + 1][3]);
                bq[ks] = __builtin_bit_cast(bf16x8, q);
            }
            if (i + 1 < 9) {
#pragma unroll
                for (int ks = 0; ks < 4; ++ks) { nx[2 * ks] = *(const f32x4*)(kps[i + 1] + 16 * ks); nx[2 * ks + 1] = *(const f32x4*)(kps[i + 1] + 16 * ks + 4); }
            }
            f32x16 acc;
#pragma unroll
            for (int j = 0; j < 16; ++j) acc[j] = 0.f;
#pragma unroll
            for (int ks = 0; ks < 4; ++ks) acc = MFMA32(af[ks], bq[ks], acc);
#pragma unroll
            for (int ql = 0; ql < 2; ++ql) {
                float v = 0.f;
#pragma unroll
                for (int a2 = 0; a2 < 2; ++a2)
#pragma unroll
                    for (int e2 = 0; e2 < 4; ++e2) v += wq[ql][4 * a2 + e2] * fmaxf(acc[4 * (2 * ql + a2) + e2], 0.f);
                sc[(2 * hh + ql) * 2112 + s] = v;
            }
        }
    }
    lds_barrier();
    if (wave < 4) select_emit<false, 33>(sc + wave * 2112, PAST + wave, lane, nullptr, p.sel + ((size_t)NPR + b * 4 + wave) * 256);
    lds_barrier();
}

__device__ __forceinline__ void indexer_prompt_unit(const Params& p, float* sc, int b, int g8, int tid) {
    const int lane = tid & 63, wave = tid >> 6;
    const int r = lane & 31, hh = lane >> 5;
    const int t0 = g8 * 8;
    if (t0 < 256) {
        const int qpos = t0 + wave;
        unsigned long long* maskcol = p.maskT + (size_t)b * 65 * LPAD + qpos;
        for (int j = lane; j < 65; j += 64) {
            const int lo = j * 64;
            unsigned long long m = 0ull;
            if (qpos >= lo + 63) m = ~0ull; else if (qpos >= lo) m = (1ull << (qpos - lo + 1)) - 1ull;
            maskcol[(size_t)j * LPAD] = m;
        }
        return;
    }
    bf16x8 af[2][4];
    {
        const int e2 = r & 3, hb = (r >> 2) & 1, a = r >> 3;
        const int qi = 2 * hb + (a >> 1), head = 4 * (a & 1) + e2;
        (void)qi; (void)head;
#pragma unroll
        for (int rt = 0; rt < 2; ++rt) {
            const bf16_t* ap = p.iq_b + ((((size_t)b * 514 + g8) * 2 + rt) * 4) * 512 + lane * 8;
#pragma unroll
            for (int ks = 0; ks < 4; ++ks) af[rt][ks] = *(const bf16x8*)(ap + 512 * ks);
        }
    }
    float wq[2][2][8];
#pragma unroll
    for (int rt = 0; rt < 2; ++rt)
#pragma unroll
        for (int ql = 0; ql < 2; ++ql) {
            const float* wp = p.iw + ((size_t)b * LP + t0 + 4 * rt + 2 * hh + ql) * 8;
            const f32x4 w0 = *(const f32x4*)wp, w1 = *(const f32x4*)(wp + 4);
#pragma unroll
            for (int e2 = 0; e2 < 4; ++e2) { wq[rt][ql][e2] = w0[e2]; wq[rt][ql][4 + e2] = w1[e2]; }
        }
    const int nkt = (t0 + 7) / 32 + 1;
    const bf16_t* kbase = p.ik_b + (size_t)b * LPAD * 64 + lane * 8;
    bf16x8 bq[2][4], bn[2][4];
#pragma unroll
    for (int j = 0; j < 2; ++j) {
        const int kt = wave + 8 * j, ktc = (kt < nkt) ? kt : (nkt - 1);
#pragma unroll
        for (int ks = 0; ks < 4; ++ks) bq[j][ks] = *(const bf16x8*)(kbase + (size_t)ktc * 2048 + 512 * ks);
    }
    asm volatile("" :: "v"(af[0][0]), "v"(af[0][1]), "v"(af[0][2]), "v"(af[0][3]), "v"(af[1][0]), "v"(af[1][1]), "v"(af[1][2]), "v"(af[1][3]));
#pragma unroll
    for (int rt = 0; rt < 2; ++rt)
#pragma unroll
        for (int ql = 0; ql < 2; ++ql) asm volatile("" :: "v"(wq[rt][ql][0]), "v"(wq[rt][ql][1]), "v"(wq[rt][ql][2]), "v"(wq[rt][ql][3]), "v"(wq[rt][ql][4]), "v"(wq[rt][ql][5]), "v"(wq[rt][ql][6]), "v"(wq[rt][ql][7]));
    for (int kt0 = wave; kt0 < nkt; kt0 += 16) {
#pragma unroll
        for (int j = 0; j < 2; ++j) {
            const int kt = kt0 + 16 + 8 * j, ktc = (kt < nkt) ? kt : (nkt - 1);
#pragma unroll
            for (int ks = 0; ks < 4; ++ks) bn[j][ks] = *(const bf16x8*)(kbase + (size_t)ktc * 2048 + 512 * ks);
        }
        f32x16 acc[2][2];
#pragma unroll
        for (int j = 0; j < 2; ++j)
#pragma unroll
            for (int rt = 0; rt < 2; ++rt)
#pragma unroll
                for (int i = 0; i < 16; ++i) acc[j][rt][i] = 0.f;
#pragma unroll
        for (int ks = 0; ks < 4; ++ks)
#pragma unroll
            for (int j = 0; j < 2; ++j)
#pragma unroll
                for (int rt = 0; rt < 2; ++rt) acc[j][rt] = MFMA32(af[rt][ks], bq[j][ks], acc[j][rt]);
#pragma unroll
        for (int j = 0; j < 2; ++j) {
            const int kt = kt0 + 8 * j;
            if (kt < nkt) {
#pragma unroll
                for (int rt = 0; rt < 2; ++rt)
#pragma unroll
                    for (int ql = 0; ql < 2; ++ql) {
                        float s = 0.f;
#pragma unroll
                        for (int a2 = 0; a2 < 2; ++a2)
#pragma unroll
                            for (int e2 = 0; e2 < 4; ++e2) s += wq[rt][ql][4 * a2 + e2] * fmaxf(acc[j][rt][4 * (2 * ql + a2) + e2], 0.f);
                        sc[(4 * rt + 2 * hh + ql) * 4160 + 32 * kt + r] = s;
                    }
            }
        }
#pragma unroll
        for (int j = 0; j < 2; ++j)
#pragma unroll
            for (int ks = 0; ks < 4; ++ks) bq[j][ks] = bn[j][ks];
    }
    lds_barrier();
    {
        const int qpos = t0 + wave;
        unsigned long long* mc = p.maskT + (size_t)b * 65 * LPAD + qpos;
        if (t0 + 7 < 17 * 64) select_emit<true, 17>(sc + wave * 4160, qpos, lane, mc, nullptr);
        else if (t0 + 7 < 33 * 64) select_emit<true, 33>(sc + wave * 4160, qpos, lane, mc, nullptr);
        else if (t0 + 7 < 49 * 64) select_emit<true, 49>(sc + wave * 4160, qpos, lane, mc, nullptr);
        else select_emit<true, 65>(sc + wave * 4160, qpos, lane, mc, nullptr);
    }
    lds_barrier();
}

__device__ __forceinline__ void indexer_phase(const Params& p, char* smem, int bid, int nb, int rep = 0) {
    int* slot = (int*)(smem + LDS_BYTES - 32);
    for (;;) {
        const int tid = tid_opaque();
        unsigned zofs = 0; asm volatile("" : "+v"(zofs));
        float* sc = (float*)(smem + zofs);
        if (threadIdx.x == 0) *slot = (int)atomicAdd(p.bar + 3648 + 16 * rep, 1u);
        lds_barrier();
        const int u = *slot;
        lds_barrier();
        if (u >= DB + BATCH * 514) break;
        if (u < DB) {
            indexer_sample_unit(p, sc, u, tid);
        } else {
            const int v = u - DB;
            indexer_prompt_unit(p, sc, v & 3, 513 - (v >> 2), tid);
        }
    }
}

__device__ __forceinline__ void attn_sample_query(const Params& p, char* smem, int row) {
    float* qs = (float*)smem;
    float* ps = qs + 1024;
    const float** kptr = (const float**)(ps + 2048);
    const float** vptr = kptr + 256;
    float* red = (float*)(vptr + 256);
    const int tid = tid_opaque(), lane = tid & 63, wave = tid >> 6;
    const int b = (row - NPR) >> 2;
    qs[tid] = p.qr[(size_t)row * 1024 + tid];
    qs[tid + 512] = p.qr[(size_t)row * 1024 + 512 + tid];
    if (tid < 256) {
        const int s = p.sel[(size_t)row * 256 + tid];
        const float *kp, *vp;
        if (s < PAST) { const int pg = p.page_table[b * 16 + ((s < 0 ? 0 : s) >> 7)]; const size_t ro = ((size_t)pg * 128 + ((s < 0 ? 0 : s) & 127)) * 256; kp = p.cache_k + ro; vp = p.cache_v + ro; }
        else { const size_t ro = ((size_t)b * DS + (s - PAST)) * 256; kp = p.k_sample + ro; vp = p.v_sample + ro; }
        kptr[tid] = (s < 0) ? nullptr : kp;
        vptr[tid] = vp;
    }
    lds_barrier();
    {
        const int j = tid & 255, kvh = tid >> 8;
        const float* kp0 = kptr[j];
        const bool valid = kp0 != nullptr;
        const float* kp = (valid ? kp0 : vptr[j]) + kvh * 128;
        float d0 = 0.f, d1 = 0.f, d2 = 0.f, d3 = 0.f;
        const float* q0 = qs + (kvh * 4) * 128;
#pragma unroll 16
        for (int c = 0; c < 32; ++c) {
            const f32x4 kv = *(const f32x4*)(kp + c * 4);
            const f32x4 a0 = *(const f32x4*)(q0 + c * 4), a1 = *(const f32x4*)(q0 + 128 + c * 4), a2 = *(const f32x4*)(q0 + 256 + c * 4),
                        a3 = *(const f32x4*)(q0 + 384 + c * 4);
            d0 += kv[0] * a0[0] + kv[1] * a0[1] + kv[2] * a0[2] + kv[3] * a0[3];
            d1 += kv[0] * a1[0] + kv[1] * a1[1] + kv[2] * a1[2] + kv[3] * a1[3];
            d2 += kv[0] * a2[0] + kv[1] * a2[1] + kv[2] * a2[2] + kv[3] * a2[3];
            d3 += kv[0] * a3[0] + kv[1] * a3[1] + kv[2] * a3[2] + kv[3] * a3[3];
        }
        const float scl = 0.08838834764831845f;
        ps[(kvh * 4 + 0) * 256 + j] = valid ? d0 * scl : -INFINITY;
        ps[(kvh * 4 + 1) * 256 + j] = valid ? d1 * scl : -INFINITY;
        ps[(kvh * 4 + 2) * 256 + j] = valid ? d2 * scl : -INFINITY;
        ps[(kvh * 4 + 3) * 256 + j] = valid ? d3 * scl : -INFINITY;
    }
    lds_barrier();
    {
        float v[4]; float m = -INFINITY;
#pragma unroll
        for (int i = 0; i < 4; ++i) { v[i] = ps[wave * 256 + lane + 64 * i]; m = fmaxf(m, v[i]); }
        m = wave_max(m);
        float sum = 0.f;
#pragma unroll
        for (int i = 0; i < 4; ++i) { v[i] = __expf(v[i] - m); sum += v[i]; }
        sum = wave_sum(sum);
        const float inv = 1.f / sum;
#pragma unroll
        for (int i = 0; i < 4; ++i) ps[wave * 256 + lane + 64 * i] = v[i] * inv;
    }
    lds_barrier();
    {
        const int kvh = tid >> 8, kg = (tid >> 5) & 7, d4 = tid & 31;
        f32x4 acc[4];
#pragma unroll
        for (int g = 0; g < 4; ++g) acc[g] = (f32x4){0.f, 0.f, 0.f, 0.f};
#pragma unroll 16
        for (int i = 0; i < 32; ++i) {
            const int j = kg * 32 + i;
            const f32x4 vv = *(const f32x4*)(vptr[j] + kvh * 128 + d4 * 4);
#pragma unroll
            for (int g = 0; g < 4; ++g) acc[g] += vv * ps[(kvh * 4 + g) * 256 + j];
        }
#pragma unroll
        for (int g = 0; g < 4; ++g) *(f32x4*)(red + ((kg * 2 + kvh) * 4 + g) * 128 + d4 * 4) = acc[g];
    }
    lds_barrier();
    {
        const int h = wave, d = lane * 2;
        float o0 = 0.f, o1 = 0.f;
#pragma unroll
        for (int kg = 0; kg < 8; ++kg) { const f32x2 t = *(const f32x2*)(red + ((kg * 2 + (h >> 2)) * 4 + (h & 3)) * 128 + d); o0 += t[0]; o1 += t[1]; }
        *(unsigned*)(p.gated + (size_t)row * 1024 + h * 128 + d) = pk2(o0, o1);
    }
    lds_barrier();
}

constexpr int AT_K = 0, AT_V = 64 * 136, AT_ELEMS = 64 * 136 + 128 * 72;
__device__ __forceinline__ void attn_dense_unit(const Params& p, char* smem, int b, int kvh, int qb) {
    bf16_t* lds = (bf16_t*)smem;
    const int tid = tid_opaque(), lane = tid & 63, wave = tid >> 6;
    const int r = lane & 31, hh = lane >> 5;
    const int g = wave & 3, qs = wave >> 2;
    const int head = kvh * 4 + g;
    const int tq = 64 * qb + 32 * qs + r;
    const int tqc = (tq < LP) ? tq : (LP - 1);
    bf16x8 qf[8];
    {
        const bf16_t* qp = p.q_b + ((size_t)b * LP + tqc) * 1024 + head * 128 + 8 * hh;
#pragma unroll
        for (int ks = 0; ks < 8; ++ks) qf[ks] = *(const bf16x8*)(qp + 16 * ks);
    }
    f32x16 O[4];
#pragma unroll
    for (int i = 0; i < 4; ++i)
#pragma unroll
        for (int j = 0; j < 16; ++j) O[i][j] = 0.f;
    float mrun = -3.0e38f, lrun = 0.f;
    const bf16_t* Kg = p.k_b + ((size_t)(b * 2 + kvh) * LPAD) * 128;
    const bf16_t* Vg = p.vt_b + ((size_t)(b * 2 + kvh) * 128) * LPAD;
    const unsigned long long* mcol = p.maskT + (size_t)b * 65 * LPAD + tq;
    const int kc0 = tid, kc1 = tid + 512;
    uint4 sk0, sk1, sv0, sv1;
#define AT_GLOAD(kt_) do { const bf16_t* kg_ = Kg + (size_t)(kt_) * 64 * 128; const bf16_t* vg_ = Vg + (size_t)(kt_) * 64; \
        sk0 = *(const uint4*)(kg_ + (size_t)kc0 * 8); sk1 = *(const uint4*)(kg_ + (size_t)kc1 * 8); \
        sv0 = *(const uint4*)(vg_ + (size_t)(kc0 >> 3) * LPAD + (kc0 & 7) * 8); sv1 = *(const uint4*)(vg_ + (size_t)(kc1 >> 3) * LPAD + (kc1 & 7) * 8); } while (0)
#define AT_SSTORE(buf_) do { bf16_t* q_ = (buf_); \
        *(uint4*)(q_ + AT_K + (kc0 >> 4) * 136 + (kc0 & 15) * 8) = sk0; *(uint4*)(q_ + AT_K + (kc1 >> 4) * 136 + (kc1 & 15) * 8) = sk1; \
        *(uint4*)(q_ + AT_V + (kc0 >> 3) * 72 + (kc0 & 7) * 8) = sv0; *(uint4*)(q_ + AT_V + (kc1 >> 3) * 72 + (kc1 & 7) * 8) = sv1; } while (0)
    AT_GLOAD(0); AT_SSTORE(lds);
    unsigned long long mw_next = mcol[0];
    asm volatile("" :: "v"(qf[0]), "v"(qf[1]), "v"(qf[2]), "v"(qf[3]), "v"(qf[4]), "v"(qf[5]), "v"(qf[6]), "v"(qf[7]), "v"(mw_next));
    lds_barrier();
    for (int kt = 0; kt <= qb; ++kt) {
        unsigned zofs = 0; asm volatile("" : "+v"(zofs));
        bf16_t* cur = lds + (kt & 1) * AT_ELEMS + zofs;
        bf16_t* nxt = lds + ((kt + 1) & 1) * AT_ELEMS + zofs;
        const bool more = kt < qb;
        if (more) { AT_GLOAD(kt + 1); }
        const unsigned long long mw = mw_next;
        if (more) mw_next = mcol[(size_t)(kt + 1) * LPAD];
        f32x16 st[2];
#pragma unroll
        for (int j = 0; j < 16; ++j) { st[0][j] = 0.f; st[1][j] = 0.f; }
#pragma unroll
        for (int ks = 0; ks < 8; ++ks) {
            st[0] = MFMA32(*(const bf16x8*)(cur + AT_K + (r) * 136 + 16 * ks + 8 * hh), qf[ks], st[0]);
            st[1] = MFMA32(*(const bf16x8*)(cur + AT_K + (32 + r) * 136 + 16 * ks + 8 * hh), qf[ks], st[1]);
        }
        float mx = fmaxf(st[0][0], st[1][0]);
#pragma unroll
        for (int reg = 1; reg < 16; reg += 1) mx = fmaxf(mx, fmaxf(st[0][reg], st[1][reg]));
        mx = fmaxf(mx, __shfl_xor(mx, 32));
        const float mnew = (mx > mrun + 8.f) ? mx : mrun;
        if (__any(mnew != mrun)) {
            const float alpha = __builtin_amdgcn_exp2f(mrun - mnew);
            lrun *= alpha;
#pragma unroll
            for (int dt = 0; dt < 4; ++dt) O[dt] = O[dt] * alpha;
            mrun = mnew;
        }
        float psum = 0.f;
#pragma unroll
        for (int kk = 0; kk < 2; ++kk) {
            const int w = (int)((unsigned)(mw >> (32 * kk)) >> (4 * hh));
#pragma unroll
            for (int reg = 0; reg < 16; ++reg) {
                const int bit = (reg & 3) + 8 * (reg >> 2);
                const int keep = __builtin_amdgcn_sbfe(w, bit, 1);
                const float pv = __uint_as_float(__float_as_uint(__builtin_amdgcn_exp2f(st[kk][reg] - mrun)) & (unsigned)keep);
                st[kk][reg] = pv; psum += pv;
            }
        }
        lrun += psum;
        bf16x8 pb[2][2];
#pragma unroll
        for (int kk = 0; kk < 2; ++kk)
#pragma unroll
            for (int s = 0; s < 2; ++s) pb[kk][s] = pack_step(st[kk], s);
#pragma unroll
        for (int kk = 0; kk < 2; ++kk)
#pragma unroll
            for (int s = 0; s < 2; ++s)
#pragma unroll
                for (int dt = 0; dt < 4; ++dt)
                    O[dt] = MFMA32(*(const bf16x8*)(cur + AT_V + (32 * dt + r) * 72 + 32 * kk + 16 * s + 8 * hh), pb[kk][s], O[dt]);
        if (more) { AT_SSTORE(nxt); }
        lds_barrier();
    }
    const float ltot = lrun + __shfl_xor(lrun, 32);
    const float inv = 1.f / ltot;
    if (tq < LP) {
        bf16_t* op = p.gated + ((size_t)b * LP + tq) * 1024 + head * 128;
#pragma unroll
        for (int dt = 0; dt < 4; ++dt)
#pragma unroll
            for (int g4 = 0; g4 < 4; ++g4) {
                f32x4 v;
#pragma unroll
                for (int e2 = 0; e2 < 4; ++e2) v[e2] = O[dt][4 * g4 + e2] * inv;
                st_bf16x4(op + 32 * dt + 8 * g4 + 4 * hh, v);
            }
    }
    lds_barrier();
}

__device__ __forceinline__ void attn_phase(const Params& p, char* smem, int bid, int nb, int rep = 0) {
    int* slot = (int*)(smem + LDS_BYTES - 32);
    for (;;) {
        if (threadIdx.x == 0) *slot = (int)atomicAdd(p.bar + 3584 + 16 * rep, 1u);
        lds_barrier();
        const int u = *slot;
        lds_barrier();
        if (u >= 520 + NSR) break;
        if (u < 520) attn_dense_unit(p, smem, (u & 7) >> 1, u & 1, 64 - (u >> 3));
        else attn_sample_query(p, smem, NPR + (u - 520));
    }
}

#define XB_TMO      128
#define XB_XCNT(j)  (256  + 64 * (j))
#define XB_XSUB(j)  (1280 + 64 * (j))
#define XB_XGEN(j)  (2304 + 64 * (j))
#define XB_TOP      3328
#define XB_TOPGEN   3392
#define XCD_BAR_WORDS 3456
#define XB_SPIN_CAP (1u << 18)
#define LAS __attribute__((address_space(3)))

__device__ __forceinline__ unsigned xb_ld(unsigned* p)              { return __hip_atomic_load(p, __ATOMIC_RELAXED, __HIP_MEMORY_SCOPE_AGENT); }
__device__ __forceinline__ unsigned xb_add(unsigned* p, unsigned v) { return __hip_atomic_fetch_add(p, v, __ATOMIC_RELAXED, __HIP_MEMORY_SCOPE_AGENT); }
__device__ __forceinline__ unsigned xb_xcc_id() { return (unsigned)__builtin_amdgcn_s_getreg((3 << 11) | 20) & 0xFu; }
#define XB_SPIN(cond, bar) do { unsigned _sp = 0; while (cond) { __builtin_amdgcn_s_sleep(1); \
    if ((++_sp & 255u) == 0u) { if (xb_ld(&(bar)[XB_TMO])) break; if (_sp > XB_SPIN_CAP) { atomicAdd(&(bar)[XB_TMO], 1u); break; } } } } while (0)

struct XcdBarrier {
    unsigned* bar; unsigned x;
    volatile LAS unsigned* st;
};

__device__ __forceinline__ XcdBarrier xcd_barrier_post(unsigned* bar, volatile LAS unsigned* st) {
    XcdBarrier b; b.bar = bar; b.x = xb_xcc_id(); b.st = st;
    if (threadIdx.x == 0) (void)xb_add(&bar[XB_XCNT(b.x)], 1u);
    return b;
}
__device__ __forceinline__ void xcd_barrier_complete(unsigned* bar, unsigned x, unsigned& nloc, unsigned& nx) {
    const unsigned G = gridDim.x * gridDim.y * gridDim.z;
    unsigned sum, cnt, mine, sp = 0u;
    for (;;) {
        sum = 0u; cnt = 0u; mine = 0u;
#pragma unroll
        for (unsigned j = 0; j < 16; ++j) { const unsigned c = xb_ld(&bar[XB_XCNT(j)]); sum += c; cnt += (c > 0u) ? 1u : 0u; mine = (j == x) ? c : mine; }
        if (sum == G) break;
        __builtin_amdgcn_s_sleep(1);
        if ((++sp & 255u) == 0u) { if (xb_ld(&bar[XB_TMO])) break; if (sp > XB_SPIN_CAP) { atomicAdd(&bar[XB_TMO], 1u); break; } }
    }
    nloc = mine > 0u ? mine : 1u; nx = cnt > 0u ? cnt : 1u;
}

__device__ __forceinline__ void xcd_barrier(const XcdBarrier& b) {
    asm volatile("s_waitcnt vmcnt(0)" ::: "memory");
    __syncthreads();
    if (threadIdx.x == 0) {
        unsigned* bar = b.bar;
        __builtin_amdgcn_s_waitcnt(0);
        unsigned nloc = b.st[0], nx = b.st[1];
        if (nloc == 0u) { xcd_barrier_complete(bar, b.x, nloc, nx); b.st[0] = nloc; b.st[1] = nx; }
        const unsigned old = xb_add(&bar[XB_XSUB(b.x)], 1u);
        const unsigned gen = old / nloc;
        if (old + 1u == (gen + 1u) * nloc) {
            __builtin_amdgcn_fence(__ATOMIC_RELEASE, "agent");
            asm volatile("s_waitcnt vmcnt(0)" ::: "memory");
            const unsigned og = xb_add(&bar[XB_TOP], 1u);
            const unsigned tg = og / nx;
            if (og + 1u == (tg + 1u) * nx) xb_add(&bar[XB_TOPGEN], 1u);
            else XB_SPIN(xb_ld(&bar[XB_TOPGEN]) == tg, bar);
            __builtin_amdgcn_fence(__ATOMIC_ACQUIRE, "agent");
            xb_add(&bar[XB_XGEN(b.x)], 1u);
            asm volatile("s_waitcnt vmcnt(0)" ::: "memory");
        } else {
            XB_SPIN(xb_ld(&bar[XB_XGEN(b.x)]) == gen, bar);
            __builtin_amdgcn_fence(__ATOMIC_ACQUIRE, "agent");
            asm volatile("s_waitcnt vmcnt(0)" ::: "memory");
        }
    }
    __syncthreads();
}


constexpr int NPHASE = 19;
template <int PH>
__device__ __forceinline__ void run_phase(const Params& p, char* smem, int bid, int nb, int rep = 0) {
    constexpr int MT = MPAD / 256;
    if constexpr (PH == 0) phase_prologue(p, smem, bid, nb);
    else if constexpr (PH == 1) gemm_big(p.hA, D, p.wt_gin, GIN_PAD, EpiGdnIn{p.mixed, p.z, p.ba}, smem, bid, nb);
    else if constexpr (PH == 2) gdn_stageA(p, smem, bid, nb);
    else if constexpr (PH == 3) gdn_seq_phase(p, smem, bid, nb, rep);
    else if constexpr (PH == 4) gdn_gate_phase(p, bid, nb);
    else if constexpr (PH == 5) gemm_n1024(p.gated, 2048, p.wt_gout, EpiResid{p.preln, p.hA}, EpiSlab{p.slab}, 8, smem, bid, nb);
    else if constexpr (PH == 6) ln_phase(p.preln, p.ln1_g, p.ln1_b, p.hB, nullptr, nullptr, p.slab, 8, p.hA, bid, nb);
    else if constexpr (PH == 7) gemm_big(p.hB, D, p.wt_w1, DFF, EpiRelu2{p.act}, smem, bid, nb);
    else if constexpr (PH == 8) gemm_n1024(p.act, DFF, p.wt_w2, EpiResid{p.preln, p.hB}, EpiSlab{p.slab}, 16, smem, bid, nb);
    else if constexpr (PH == 9) ln_phase(p.preln, p.ln2_g, p.ln2_b, p.hA, nullptr, nullptr, p.slab, 16, p.hB, bid, nb);
    else if constexpr (PH == 10) gemm_big(p.hA, D, p.wt_din, DIN_PAD, EpiBf16{(bf16_t*)p.p1, DIN_PAD}, smem, bid, nb);
    else if constexpr (PH == 11) dsa_post_phase(p, smem, bid, nb);
    else if constexpr (PH == 12) indexer_phase(p, smem, bid, nb, rep);
    else if constexpr (PH == 13) attn_phase(p, smem, bid, nb, rep);
    else if constexpr (PH == 14) gemm_n1024(p.gated, D, p.wt_do, EpiResid{p.preln, p.hA}, EpiSlab{p.slab}, 4, smem, bid, nb);
    else if constexpr (PH == 15) ln_phase(p.preln, p.ln1_g + D, p.ln1_b + D, p.hB, nullptr, nullptr, p.slab, 4, p.hA, bid, nb);
    else if constexpr (PH == 16) gemm_big(p.hB, D, p.wt_w1 + (size_t)D * DFF, DFF, EpiRelu2{p.act}, smem, bid, nb);
    else if constexpr (PH == 17) gemm_n1024(p.act, DFF, p.wt_w2 + (size_t)D * DFF, EpiResid{p.preln, p.hB}, EpiSlab{p.slab}, 16, smem, bid, nb);
    else if constexpr (PH == 18) ln_phase(p.preln, p.ln2_g + D, p.ln2_b + D, nullptr, p.y_prompt, p.y_sample, p.slab, 16, p.hB, bid, nb);
}

template <int PH>
__global__ void __launch_bounds__(NTHR, 2) k_phase(Params p) {
    extern __shared__ __attribute__((aligned(16))) char smem[];
    run_phase<PH>(p, smem, blockIdx.x, gridDim.x);
}

template <int PH>
__device__ __forceinline__ void mega_run(const Params& p, char* smem, const XcdBarrier& bar) {
    run_phase<PH>(p, smem, blockIdx.x, gridDim.x);
#ifdef PROBE_MASK
    if constexpr ((PROBE_MASK >> PH) & 1) { xcd_barrier(bar); run_phase<PH>(p, smem, blockIdx.x, gridDim.x, 1); }
#endif
    if constexpr (PH + 1 < NPHASE) {
        xcd_barrier(bar);
        mega_run<PH + 1>(p, smem, bar);
    }
}
__global__ void __launch_bounds__(NTHR, 2) k_mega(Params p) {
    extern __shared__ __attribute__((aligned(16))) char smem[];
    volatile LAS unsigned* st = (volatile LAS unsigned*)(smem + LDS_BYTES - 16);
    if (threadIdx.x == 0) { st[0] = 0u; st[1] = 0u; st[2] = 0u; st[3] = 0u; }
    __syncthreads();
    XcdBarrier bar = xcd_barrier_post(p.bar, st);
    mega_run<0>(p, smem, bar);
}

template <int PH>
void launch_phase(const Params& p, hipStream_t stream) {
    static bool attr_done = false;
    if (!attr_done) {
        (void)hipFuncSetAttribute((const void*)k_phase<PH>, hipFuncAttributeMaxDynamicSharedMemorySize, LDS_BYTES);
        attr_done = true;
    }
    hipLaunchKernelGGL(k_phase<PH>, dim3(256), dim3(NTHR), LDS_BYTES, stream, p);
}
template <int PH>
void launch_all(const Params& p, hipStream_t stream) {
    launch_phase<PH>(p, stream);
    if constexpr (PH + 1 < NPHASE) launch_all<PH + 1>(p, stream);
}

}

extern "C" void kernel_launch(void* const* d_in, const int* in_sizes, int n_in, void* d_out, int out_size, void* d_ws, size_t ws_size,
                              hipStream_t stream) {
    Params p{};
    p.x_prompt = (const float*)d_in[0]; p.x_sample = (const float*)d_in[1]; p.state_gdn = (const float*)d_in[2];
    p.state_conv = (const float*)d_in[3]; p.cache_k = (const float*)d_in[4]; p.cache_v = (const float*)d_in[5];
    p.cache_ik = (const float*)d_in[6]; p.page_table = (const int*)d_in[7]; p.meta = (const float*)d_in[8];
    p.ln1_g = (const float*)d_in[9]; p.ln1_b = (const float*)d_in[10]; p.ln2_g = (const float*)d_in[11]; p.ln2_b = (const float*)d_in[12];
    p.mlp_w1 = (const float*)d_in[13]; p.mlp_w2 = (const float*)d_in[14]; p.gdn_w_in = (const float*)d_in[15];
    p.gdn_conv_w = (const float*)d_in[16]; p.gdn_a_log = (const float*)d_in[17]; p.gdn_dt_bias = (const float*)d_in[18];
    p.gdn_norm_w = (const float*)d_in[19]; p.gdn_w_out = (const float*)d_in[20]; p.dsa_w_in = (const float*)d_in[21];
    p.dsa_ik_g = (const float*)d_in[22]; p.dsa_ik_b = (const float*)d_in[23]; p.dsa_w_o = (const float*)d_in[24];
    float* o = (float*)d_out;
    p.y_prompt = o; o += (size_t)BATCH * SEQ * D;
    p.y_sample = o; o += (size_t)NSR * D;
    p.gs_prompt = o; o += (size_t)BATCH * 16 * 128 * 128;
    p.gc_prompt = o; o += (size_t)BATCH * 3 * 4096;
    p.gs_sample = o; o += (size_t)DB * 16 * 128 * 128;
    p.gc_sample = o; o += (size_t)DB * 3 * 4096;
    p.k_prompt = o; o += (size_t)NPR * 256;
    p.v_prompt = o; o += (size_t)NPR * 256;
    p.ik_prompt = o; o += (size_t)NPR * 64;
    p.k_sample = o; o += (size_t)NSR * 256;
    p.v_sample = o; o += (size_t)NSR * 256;
    p.ik_sample = o; o += (size_t)NSR * 64;
    char* w = (char*)d_ws;
    auto take = [&](size_t bytes) { char* r = w; w += (bytes + 255) & ~(size_t)255; return r; };
    p.bar = (unsigned*)take(16384);
    p.wt_gin = (bf16_t*)take((size_t)GIN_PAD * D * 2);
    p.wt_gout = (bf16_t*)take((size_t)D * 2048 * 2);
    p.wt_w1 = (bf16_t*)take((size_t)2 * D * DFF * 2);
    p.wt_w2 = (bf16_t*)take((size_t)2 * D * DFF * 2);
    p.wt_din = (bf16_t*)take((size_t)DIN_PAD * D * 2);
    p.wt_do = (bf16_t*)take((size_t)D * D * 2);
    p.hA = (bf16_t*)take((size_t)MPAD * D * 2);
    p.hB = (bf16_t*)take((size_t)MPAD * D * 2);
    p.preln = (float*)take((size_t)MPAD * D * 4);
    p.mixed = (bf16_t*)take((size_t)MPAD * 4096 * 2);
    p.z = (bf16_t*)take((size_t)MPAD * 2048 * 2);
    p.ba = (float*)take((size_t)MPAD * 32 * 4);
    p.gated = (bf16_t*)take((size_t)MPAD * 2048 * 2);
    p.act = (bf16_t*)take((size_t)MPAD * DFF * 2);
    p.p1 = (float*)take((size_t)MPAD * DIN_PAD * 4);
    p.qr = (float*)take((size_t)MPAD * 1024 * 4);
    p.iq = (float*)take((size_t)MPAD * 512 * 4);
    p.iw = (float*)take((size_t)MPAD * 8 * 4);
    p.sel = (int*)take((size_t)MPAD * 256 * 4);
    p.g_o = (bf16_t*)take((size_t)NPR * 2048 * 2);
    p.rope_tab = (float*)take((size_t)LP * 24 * 2 * 4);
    p.slab = (float*)take((size_t)16 * 768 * 1024 * 4);
    p.q_b = (bf16_t*)take((size_t)NPR * 1024 * 2);
    p.k_b = (bf16_t*)take((size_t)BATCH * 2 * LPAD * 128 * 2);
    p.vt_b = (bf16_t*)take((size_t)BATCH * 2 * 128 * LPAD * 2);
    p.iq_b = (bf16_t*)take((size_t)NPR * 512 * 2);
    p.ik_b = (bf16_t*)take((size_t)BATCH * LPAD * 64 * 2);
    p.maskT = (unsigned long long*)take((size_t)BATCH * 65 * LPAD * 8);
    p.g_dec = (float*)take((size_t)NCU * 4);
    p.g_u = (float*)p.act;
    p.g_negw = (bf16_t*)p.p1;
    p.g_qg = p.g_negw + (size_t)NCU * 8192;
    p.g_kdT = (bf16_t*)p.qr;
    p.g_aqk = (bf16_t*)p.iq;
    if ((size_t)(w - (char*)d_ws) > ws_size) { fprintf(stderr, "kernel_launch: workspace too small (%zu needed, %zu given)\n", (size_t)(w - (char*)d_ws), ws_size); return; }
#if MEGA
    static int grid = 0;
    if (grid == 0) {
        int dev = 0, cus = 0;
        if (hipGetDevice(&dev) != hipSuccess || hipDeviceGetAttribute(&cus, hipDeviceAttributeMultiprocessorCount, dev) != hipSuccess || cus <= 0) cus = 256;
        (void)hipFuncSetAttribute((const void*)k_mega, hipFuncAttributeMaxDynamicSharedMemorySize, LDS_BYTES);
        grid = cus;
    }
    (void)hipMemsetAsync(p.bar, 0, 16384, stream);
    hipLaunchKernelGGL(k_mega, dim3(grid), dim3(NTHR), LDS_BYTES, stream, p);
#else
    launch_all<0>(p, stream);
#endif
}
```

```cpp
#include <hip/hip_runtime.h>
#include <stdint.h>
#include <stdio.h>

#ifndef MEGA
#define MEGA 1
#endif

namespace {

typedef unsigned short bf16_t;
typedef short bf16x8 __attribute__((ext_vector_type(8)));
typedef float f32x4 __attribute__((ext_vector_type(4)));

constexpr int D = 1024, BATCH = 4, SEQ = 4096, NMETA = 16, LP = SEQ + NMETA;
constexpr int DB = 128, DS = 4, PAST = 2048;
constexpr int NPR = BATCH * LP;
constexpr int NSR = DB * DS;
constexpr int NT = NPR + NSR;
constexpr int MPAD = 17152;
constexpr int DFF = 4096;
constexpr int GIN = 6176, GIN_PAD = 6400;
constexpr int DIN = 2120, DIN_PAD = 2304;
constexpr int NTHR = 512;
constexpr int LPAD = 4160;
constexpr int LDS_BYTES = 150 * 1024;
constexpr float ALPHA = 1.4142135623730951f;

struct Params {
    const float *x_prompt, *x_sample, *state_gdn, *state_conv, *cache_k, *cache_v, *cache_ik;
    const int* page_table;
    const float *meta, *ln1_g, *ln1_b, *ln2_g, *ln2_b, *mlp_w1, *mlp_w2, *gdn_w_in, *gdn_conv_w, *gdn_a_log, *gdn_dt_bias,
        *gdn_norm_w, *gdn_w_out, *dsa_w_in, *dsa_ik_g, *dsa_ik_b, *dsa_w_o;
    float *y_prompt, *y_sample, *gs_prompt, *gc_prompt, *gs_sample, *gc_sample, *k_prompt, *v_prompt, *ik_prompt, *k_sample,
        *v_sample, *ik_sample;
    unsigned* bar;
    bf16_t *wt_gin, *wt_gout, *wt_w1, *wt_w2, *wt_din, *wt_do;
    bf16_t *hA, *hB;
    float* preln;
    bf16_t *mixed, *z;
    float* ba;
    bf16_t *gated, *act;
    float *p1, *qr, *iq, *iw;
    int* sel;
    bf16_t *g_negw, *g_qg, *g_kdT, *g_aqk;
    float *g_u, *g_dec;
    bf16_t* g_o;
    float* rope_tab;
    float* slab;
    bf16_t *q_b, *k_b, *vt_b, *iq_b, *ik_b;
    unsigned long long* maskT;
};

__device__ const double kInvFreq[16] = {1.0, 0.44036660267178046, 0.19392274474868576, 0.08539710028576561,
    0.03760603093086393, 0.016560440080994446, 0.007292664737217109, 0.003211445994752591, 0.001414213562373095,
    0.000622772421914596, 0.0002742481756762073, 0.00012076973741146504, 5.318295896944988e-05, 2.341999896140934e-05,
    1.031338537721246e-05, 4.5416704806078695e-06};

__device__ __forceinline__ float bf2f(bf16_t h) { return __uint_as_float(((unsigned)h) << 16); }
typedef __bf16 hwbf16x2 __attribute__((ext_vector_type(2)));
typedef float f32x2 __attribute__((ext_vector_type(2)));
typedef float f32x16 __attribute__((ext_vector_type(16)));
typedef unsigned u32x4 __attribute__((ext_vector_type(4)));
__device__ __forceinline__ unsigned pk2(float lo, float hi) {
    const f32x2 v = {lo, hi};
    return __builtin_bit_cast(unsigned, __builtin_convertvector(v, hwbf16x2));
}
__device__ __forceinline__ bf16_t f2bf(float f) { return (bf16_t)(pk2(f, 0.f) & 0xffffu); }
__device__ __forceinline__ void st_bf16x4(bf16_t* p, f32x4 v) {
    uint2 o; o.x = pk2(v[0], v[1]); o.y = pk2(v[2], v[3]);
    *(uint2*)p = o;
}
__device__ __forceinline__ f32x4 cvt_bf16x4(uint2 o) {
    f32x4 v; v[0] = __uint_as_float(o.x << 16); v[1] = __uint_as_float(o.x & 0xffff0000u);
    v[2] = __uint_as_float(o.y << 16); v[3] = __uint_as_float(o.y & 0xffff0000u);
    return v;
}
__device__ __forceinline__ f32x4 ld_bf16x4(const bf16_t* p) {
    uint2 o = *(const uint2*)p;
    f32x4 v; v[0] = __uint_as_float(o.x << 16); v[1] = __uint_as_float(o.x & 0xffff0000u);
    v[2] = __uint_as_float(o.y << 16); v[3] = __uint_as_float(o.y & 0xffff0000u);
    return v;
}
__device__ __forceinline__ float wave_sum(float v) {
#pragma unroll
    for (int o = 1; o < 64; o <<= 1) v += __shfl_xor(v, o);
    return v;
}
__device__ __forceinline__ float wave_max(float v) {
#pragma unroll
    for (int o = 1; o < 64; o <<= 1) v = fmaxf(v, __shfl_xor(v, o));
    return v;
}
__device__ __forceinline__ int wave_sum_i(int v) {
#pragma unroll
    for (int o = 1; o < 64; o <<= 1) v += __shfl_xor(v, o);
    return v;
}
__device__ __forceinline__ float silu(float x) { return x * __builtin_amdgcn_rcpf(1.f + __expf(-x)); }
__device__ __forceinline__ int tid_opaque() { int t = threadIdx.x; asm volatile("" : "+v"(t)); return t; }
__device__ __forceinline__ void lds_barrier() { asm volatile("s_waitcnt lgkmcnt(0)\n\ts_barrier" ::: "memory"); }
__device__ __forceinline__ void lds_fence() { asm volatile("s_waitcnt lgkmcnt(0)" ::: "memory"); }

__device__ __forceinline__ void transpose_convert(const float* __restrict__ W, int K, int N, int Npad, bf16_t* __restrict__ WT, float* tile,
                                  int bid, int nb) {
    const int tid = tid_opaque();
    const int tk = K / 64, tn = Npad / 64;
    for (int it = bid; it < tk * tn; it += nb) {
        const int kb = it / tn, nbk = it % tn, k0 = kb * 64, n0 = nbk * 64;
#pragma unroll
        for (int i = 0; i < 8; ++i) {
            const int r = (tid >> 6) + 8 * i, c = tid & 63, n = n0 + c;
            tile[r * 65 + c] = (n < N) ? W[(size_t)(k0 + r) * N + n] : 0.f;
        }
        __syncthreads();
        {
            const int rn = tid >> 3, c8 = (tid & 7) * 8;
            const float* tp = tile + c8 * 65 + rn;
            uint4 o;
            o.x = pk2(tp[0], tp[65]); o.y = pk2(tp[2 * 65], tp[3 * 65]); o.z = pk2(tp[4 * 65], tp[5 * 65]); o.w = pk2(tp[6 * 65], tp[7 * 65]);
            *(uint4*)(WT + (size_t)(n0 + rn) * K + k0 + c8) = o;
        }
        __syncthreads();
    }
}

__device__ __forceinline__ void phase_prologue(const Params& p, char* smem, int bid, int nb) {
    float* tile = (float*)smem;
    transpose_convert(p.gdn_w_in, D, GIN, GIN_PAD, p.wt_gin, tile, bid, nb);
    for (int idx = bid * NTHR + tid_opaque(); idx < LP * 24; idx += nb * NTHR) {
        const int pos = idx / 24, f = idx % 24;
        const int fi = (f < 16) ? f : (f - 16) * 2;
        const double rev = (double)pos * kInvFreq[fi] * 0.15915494309189535;
        const float r = (float)(rev - floor(rev));
        p.rope_tab[idx * 2] = __builtin_amdgcn_cosf(r);
        p.rope_tab[idx * 2 + 1] = __builtin_amdgcn_sinf(r);
    }
    for (int idx = bid * NTHR + tid_opaque(); idx < MPAD * 256; idx += nb * NTHR) {
        const int row = idx >> 8, c4 = (idx & 255) * 4;
        f32x4 v = {0.f, 0.f, 0.f, 0.f};
        if (row < NPR) {
            const int b = row / LP, t = row % LP;
            const float* src = (t < NMETA) ? (p.meta + (size_t)t * D) : (p.x_prompt + ((size_t)b * SEQ + (t - NMETA)) * D);
            v = *(const f32x4*)(src + c4);
        } else if (row < NT) {
            v = *(const f32x4*)(p.x_sample + (size_t)(row - NPR) * D + c4);
        }
        st_bf16x4(p.hA + (size_t)row * D + c4, v);
    }
}

template <class Epi>
__device__ __forceinline__ void gemm_phase(const bf16_t* __restrict__ A, int lda, const bf16_t* __restrict__ Bt, int K, int Mtiles, int Ntiles,
                           const Epi& epi, char* smem, int bid, int nb) {
    bf16_t* As = (bf16_t*)smem;
    bf16_t* Bs = As + 256 * 72;
    const int tid = tid_opaque(), lane = tid & 63, wave = tid >> 6;
    const int wm = wave >> 1, wn = wave & 1;
    const int fr = lane & 15, fq = lane >> 4;
    const int ntiles = Mtiles * Ntiles;
    const int nk = K / 64;
    for (int tile = bid; tile < ntiles; tile += nb) {
        const int tm = tile % Mtiles, tn = tile / Mtiles;
        const bf16_t* Ag = A + (size_t)tm * 256 * lda;
        const bf16_t* Bg = Bt + (size_t)tn * 128 * K;
        f32x4 acc[4][4];
#pragma unroll
        for (int i = 0; i < 4; ++i)
#pragma unroll
            for (int j = 0; j < 4; ++j) acc[i][j] = (f32x4){0.f, 0.f, 0.f, 0.f};
        const int c0 = tid, c1 = tid + 512, c2 = tid + 1024, c3 = tid + 1536;
        const bf16_t* ga0 = Ag + (size_t)(c0 >> 3) * lda + (c0 & 7) * 8;
        const bf16_t* ga1 = Ag + (size_t)(c1 >> 3) * lda + (c1 & 7) * 8;
        const bf16_t* ga2 = Ag + (size_t)(c2 >> 3) * lda + (c2 & 7) * 8;
        const bf16_t* ga3 = Ag + (size_t)(c3 >> 3) * lda + (c3 & 7) * 8;
        const bf16_t* gb0 = Bg + (size_t)(c0 >> 3) * K + (c0 & 7) * 8;
        const bf16_t* gb1 = Bg + (size_t)(c1 >> 3) * K + (c1 & 7) * 8;
        bf16_t* sa0 = As + (c0 >> 3) * 72 + (c0 & 7) * 8;
        bf16_t* sa1 = As + (c1 >> 3) * 72 + (c1 & 7) * 8;
        bf16_t* sa2 = As + (c2 >> 3) * 72 + (c2 & 7) * 8;
        bf16_t* sa3 = As + (c3 >> 3) * 72 + (c3 & 7) * 8;
        bf16_t* sb0 = Bs + (c0 >> 3) * 72 + (c0 & 7) * 8;
        bf16_t* sb1 = Bs + (c1 >> 3) * 72 + (c1 & 7) * 8;
        uint4 ra0 = *(const uint4*)ga0, ra1 = *(const uint4*)ga1, ra2 = *(const uint4*)ga2, ra3 = *(const uint4*)ga3;
        uint4 rb0 = *(const uint4*)gb0, rb1 = *(const uint4*)gb1;
        *(uint4*)sa0 = ra0; *(uint4*)sa1 = ra1; *(uint4*)sa2 = ra2; *(uint4*)sa3 = ra3; *(uint4*)sb0 = rb0; *(uint4*)sb1 = rb1;
        __syncthreads();
        for (int kt = 0; kt < nk; ++kt) {
            const bool more = (kt + 1 < nk);
            if (more) {
                const int k0 = (kt + 1) * 64;
                ra0 = *(const uint4*)(ga0 + k0); ra1 = *(const uint4*)(ga1 + k0); ra2 = *(const uint4*)(ga2 + k0); ra3 = *(const uint4*)(ga3 + k0);
                rb0 = *(const uint4*)(gb0 + k0); rb1 = *(const uint4*)(gb1 + k0);
            }
#pragma unroll
            for (int kk = 0; kk < 2; ++kk) {
                bf16x8 af[4], bfr[4];
#pragma unroll
                for (int i = 0; i < 4; ++i) af[i] = *(const bf16x8*)(As + (wm * 64 + i * 16 + fr) * 72 + kk * 32 + fq * 8);
#pragma unroll
                for (int j = 0; j < 4; ++j) bfr[j] = *(const bf16x8*)(Bs + (wn * 64 + j * 16 + fr) * 72 + kk * 32 + fq * 8);
#pragma unroll
                for (int i = 0; i < 4; ++i)
#pragma unroll
                    for (int j = 0; j < 4; ++j) acc[i][j] = __builtin_amdgcn_mfma_f32_16x16x32_bf16(bfr[j], af[i], acc[i][j], 0, 0, 0);
            }
            __syncthreads();
            if (more) {
                *(uint4*)sa0 = ra0; *(uint4*)sa1 = ra1; *(uint4*)sa2 = ra2; *(uint4*)sa3 = ra3; *(uint4*)sb0 = rb0; *(uint4*)sb1 = rb1;
                __syncthreads();
            }
        }
#pragma unroll
        for (int i = 0; i < 4; ++i)
#pragma unroll
            for (int j = 0; j < 4; ++j) {
                const int row = tm * 256 + wm * 64 + i * 16 + fr, col = tn * 128 + wn * 64 + j * 16 + fq * 4;
                epi(row, col, acc[i][j]);
            }
    }
}

namespace pg8 {
#define PG8_LAS __attribute__((address_space(3)))
constexpr int BM = 256, BK = 64, HALF = 128, HTB = HALF * BK * 2  , STAGE_BYTES = 8 * HTB, NXCD = 8, WGM = 16;
__device__ __forceinline__ int lds_byte(int r, int c) { const int st = (r >> 4) * 2 + (c >> 5), rr = r & 15, cc = c & 31, ob = rr * 64 + cc * 2; return st * 1024 + (ob ^ (((ob >> 9) & 1) << 5)); }
__device__ __forceinline__ void stage_rc(int b, int& R, int& C) { const int st = b / 1024, sb = b % 1024, swz = sb ^ (((sb >> 9) & 1) << 5); R = (st >> 1) * 16 + swz / 64; C = (st & 1) * 32 + (swz % 64) / 2; }
__device__ __forceinline__ int perm32(int rho) { const int n = rho >> 4, i = rho & 15; return 8 * (i >> 2) + 4 * n + (i & 3); }
struct Unit { int pm, pn, pk; };
struct Gemm { const bf16_t* A; const bf16_t* Bt; int K; int splits; };
struct StaticOrder {
    int nM, nN, nNr, pm0, nwg, G, c;
    __device__ void init(int nM_, int nNr_, int splits, int pm0_, int G_, int c_) { nM = nM_; nNr = nNr_; nN = nNr_ * splits; pm0 = pm0_; nwg = nM * nN; G = G_; c = c_; }
    __device__ bool next(int i, Unit& u) const {
        const long L = (long)i * G + c; if (L >= nwg) return false;
        int wgid = (int)L; { const int q = nwg / NXCD, r = nwg % NXCD, xcd = wgid % NXCD, off = wgid / NXCD; wgid = (xcd < r ? xcd * (q + 1) : r * (q + 1) + (xcd - r) * q) + off; }
        const int nig = WGM * nN, gid = wgid / nig, fm = gid * WGM, gsz = (nM - fm) < WGM ? (nM - fm) : WGM;
        const int pnv = (wgid % nig) / gsz;
        u.pm = pm0 + fm + ((wgid % nig) % gsz); u.pn = pnv % nNr; u.pk = pnv / nNr; return true;
    }
};
template <class Epi>
__device__ __forceinline__ void gemm_phase(PG8_LAS unsigned char* lds, const Gemm g, const StaticOrder& S, const Epi& E) {
    const int tid = tid_opaque(), wid = __builtin_amdgcn_readfirstlane(tid >> 6), lane = tid & 63, wr = wid >> 2, wc = wid & 3, fr = lane & 15, fq = lane >> 4;
    const int K = g.K, Kp = K / g.splits, nt = Kp / BK;
    unsigned voffA[2], voffB[2];
#pragma unroll
    for (int i = 0; i < 2; ++i) { int R, C; stage_rc(tid * 16 + i * 8192, R, C); const int Rb = (R & ~31) + perm32(R & 31);
        voffA[i] = (unsigned)(R * K + C) * 2u; voffB[i] = (unsigned)(Rb * K + C) * 2u; }
    const size_t kstep = (size_t)(BK * 2);
    const size_t hstep = (size_t)HALF * K * 2;
    const size_t tstep = 2 * hstep;
    const size_t pstep = (size_t)Kp * 2;
    const unsigned ldsw = (unsigned)wid * 1024u;
    const int aoff = lds_byte(wr * 64 + fr, fq * 8), boff = lds_byte(wc * 32 + fr, fq * 8);
#define PG8_SA(b, h) (((b) * 2 + (h)) * HTB)
#define PG8_SB(b, h) ((4 + (b) * 2 + (h)) * HTB)
#define PG8_STAGE(bufoff, gbase, voff) do { _Pragma("unroll") for (int _i = 0; _i < 2; ++_i) \
        __builtin_amdgcn_global_load_lds((const unsigned*)((const char*)(gbase) + (voff)[_i]), (PG8_LAS unsigned*)(lds + (bufoff) + ldsw + _i * 8192), 16, 0, 0); } while (0)
#define PG8_LDA(dst, b, h) do { _Pragma("unroll") for (int m = 0; m < 4; ++m) _Pragma("unroll") for (int k = 0; k < 2; ++k) dst[m][k] = *(const PG8_LAS bf16x8*)(lds + PG8_SA(b, h) + aoff + m * 2048 + k * 1024); } while (0)
#define PG8_LDB(dst, b, h) do { _Pragma("unroll") for (int n = 0; n < 2; ++n) _Pragma("unroll") for (int k = 0; k < 2; ++k) dst[n][k] = *(const PG8_LAS bf16x8*)(lds + PG8_SB(b, h) + boff + n * 2048 + k * 1024); } while (0)
#define PG8_MMA(ai, bj, At, Bt) do { __builtin_amdgcn_s_setprio(1); _Pragma("unroll") for (int m = 0; m < 4; ++m) _Pragma("unroll") for (int n = 0; n < 2; ++n) _Pragma("unroll") for (int k = 0; k < 2; ++k) \
        acc[ai][bj][m][n] = __builtin_amdgcn_mfma_f32_16x16x32_bf16(Bt[n][k], At[m][k], acc[ai][bj][m][n], 0, 0, 0); __builtin_amdgcn_s_setprio(0); } while (0)
#define PG8_WAIT_V(n) asm volatile("s_waitcnt vmcnt(" #n ")" ::: "memory")
#define PG8_WAIT_L(n) asm volatile("s_waitcnt lgkmcnt(" #n ")" ::: "memory")
#define PG8_BAR __builtin_amdgcn_s_barrier()
#define PG8_SCHED __builtin_amdgcn_sched_barrier(0)
    Unit cur, nxt; int ui = 0;
    if (!S.next(0, cur)) return;
    f32x4 acc[2][2][4][2];
#pragma unroll
    for (int a = 0; a < 2; ++a)
#pragma unroll
        for (int b = 0; b < 2; ++b)
#pragma unroll
            for (int m = 0; m < 4; ++m)
#pragma unroll
                for (int n = 0; n < 2; ++n) acc[a][b][m][n] = (f32x4){0.f, 0.f, 0.f, 0.f};
    bf16x8 At[4][2], B0[2][2], B1[2][2];
    const char* cA = (const char*)g.A + (size_t)cur.pm * tstep + (size_t)cur.pk * pstep; const char* cB = (const char*)g.Bt + (size_t)cur.pn * tstep + (size_t)cur.pk * pstep;
    PG8_STAGE(PG8_SB(0, 0), cB, voffB); PG8_STAGE(PG8_SA(0, 0), cA, voffA); PG8_STAGE(PG8_SB(0, 1), cB + hstep, voffB); PG8_STAGE(PG8_SA(0, 1), cA + hstep, voffA);
    if (wr == 1) PG8_BAR;
    PG8_WAIT_V(4); PG8_BAR;
    PG8_STAGE(PG8_SB(1, 0), cB + kstep, voffB); PG8_STAGE(PG8_SA(1, 0), cA + kstep, voffA); PG8_STAGE(PG8_SB(1, 1), cB + hstep + kstep, voffB);
    PG8_WAIT_V(6); PG8_BAR;
    for (;;) {
        const bool has_next = S.next(ui + 1, nxt);
        const char* nA = has_next ? (const char*)g.A + (size_t)nxt.pm * tstep + (size_t)nxt.pk * pstep : cA; const char* nB = has_next ? (const char*)g.Bt + (size_t)nxt.pn * tstep + (size_t)nxt.pk * pstep : cB;
        for (int t = 0; t < nt; t += 2) {
            const bool last = (t == nt - 2);
            const char* a1 = cA + (size_t)(t + 1) * kstep;
            const char* a2 = last ? nA : cA + (size_t)(t + 2) * kstep; const char* b2 = last ? nB : cB + (size_t)(t + 2) * kstep;
            const char* a3 = a2 + kstep; const char* b3 = b2 + kstep;
            PG8_LDB(B0, 0, 0); PG8_SCHED; PG8_LDA(At, 0, 0); PG8_STAGE(PG8_SA(1, 1), a1 + hstep, voffA);
            PG8_WAIT_L(8); PG8_BAR; PG8_WAIT_L(0); PG8_MMA(0, 0, At, B0); PG8_BAR; PG8_SCHED;
            PG8_LDB(B1, 0, 1); PG8_STAGE(PG8_SB(0, 0), b2, voffB);
            PG8_BAR; PG8_WAIT_L(0); PG8_MMA(0, 1, At, B1); PG8_BAR;
            PG8_LDA(At, 0, 1); PG8_STAGE(PG8_SA(0, 0), a2, voffA);
            PG8_BAR; PG8_WAIT_L(0); PG8_MMA(1, 0, At, B0); PG8_BAR; PG8_SCHED;
            PG8_STAGE(PG8_SB(0, 1), b2 + hstep, voffB);
            PG8_WAIT_V(6); PG8_BAR; PG8_MMA(1, 1, At, B1); PG8_BAR;
            PG8_LDB(B0, 1, 0); PG8_SCHED; PG8_LDA(At, 1, 0); PG8_STAGE(PG8_SA(0, 1), a2 + hstep, voffA);
            PG8_WAIT_L(8); PG8_BAR; PG8_WAIT_L(0); PG8_MMA(0, 0, At, B0); PG8_BAR; PG8_SCHED;
            PG8_LDB(B1, 1, 1); PG8_STAGE(PG8_SB(1, 0), b3, voffB);
            PG8_BAR; PG8_WAIT_L(0); PG8_MMA(0, 1, At, B1); PG8_BAR;
            PG8_LDA(At, 1, 1); PG8_STAGE(PG8_SA(1, 0), a3, voffA);
            PG8_BAR; PG8_WAIT_L(0); PG8_MMA(1, 0, At, B0); PG8_BAR; PG8_SCHED;
            PG8_STAGE(PG8_SB(1, 1), b3 + hstep, voffB);
            PG8_WAIT_V(6); PG8_BAR; PG8_MMA(1, 1, At, B1); PG8_BAR;
        }
#pragma unroll
        for (int ai = 0; ai < 2; ++ai)
#pragma unroll
            for (int m = 0; m < 4; ++m)
#pragma unroll
                for (int bj = 0; bj < 2; ++bj)
                    E(cur.pm * BM + ai * HALF + wr * 64 + m * 16 + fr, cur.pn * BM + bj * HALF + wc * 32 + 8 * fq, acc[ai][bj][m][0], acc[ai][bj][m][1], cur.pk);
        if (!has_next) break;
#pragma unroll
        for (int a = 0; a < 2; ++a)
#pragma unroll
            for (int b = 0; b < 2; ++b)
#pragma unroll
                for (int m = 0; m < 4; ++m)
#pragma unroll
                    for (int n = 0; n < 2; ++n) acc[a][b][m][n] = (f32x4){0.f, 0.f, 0.f, 0.f};
        cur = nxt; cA = nA; cB = nB; ++ui;
    }
    PG8_WAIT_V(0);
    if (wr == 0) PG8_BAR;
    PG8_BAR;
#undef PG8_SA
#undef PG8_SB
#undef PG8_STAGE
#undef PG8_LDA
#undef PG8_LDB
#undef PG8_MMA
#undef PG8_WAIT_V
#undef PG8_WAIT_L
#undef PG8_BAR
#undef PG8_SCHED
}
}

template <class Epi>
__device__ __forceinline__ void gemm_big(const bf16_t* A, int K, const bf16_t* Bt, int Npad, const Epi& e, char* smem, int bid, int nb) {
    pg8::StaticOrder S; S.init(MPAD / 256, Npad / 256, 1, 0, nb, bid);
    pg8::gemm_phase((PG8_LAS unsigned char*)smem, pg8::Gemm{A, Bt, K, 1}, S, e);
}
template <class Epi1, class Epi2>
__device__ __forceinline__ void gemm_n1024(const bf16_t* A, int K, const bf16_t* Bt, const Epi1& e1, const Epi2& e2, int splits, char* smem, int bid, int nb) {
    pg8::StaticOrder S; S.init(64, 4, 1, 0, nb, bid);
    pg8::gemm_phase((PG8_LAS unsigned char*)smem, pg8::Gemm{A, Bt, K, 1}, S, e1);
    pg8::StaticOrder S2; S2.init(3, 4, splits, 64, nb, bid);
    pg8::gemm_phase((PG8_LAS unsigned char*)smem, pg8::Gemm{A, Bt, K, splits}, S2, e2);
}

__device__ __forceinline__ void st_bf16x8(bf16_t* p, f32x4 a, f32x4 b) {
    u32x4 w; w[0] = pk2(a[0], a[1]); w[1] = pk2(a[2], a[3]); w[2] = pk2(b[0], b[1]); w[3] = pk2(b[2], b[3]);
    *(u32x4*)p = w;
}
struct EpiGdnIn {
    bf16_t *mixed, *z; float* ba;
    __device__ __forceinline__ void operator()(int row, int col, f32x4 v0, f32x4 v1, int = 0) const {
        if (col < 4096) st_bf16x8(mixed + (size_t)row * 4096 + col, v0, v1);
        else if (col < 6144) st_bf16x8(z + (size_t)row * 2048 + (col - 4096), v0, v1);
        else if (col < 6176) { *(f32x4*)(ba + (size_t)row * 32 + (col - 6144)) = v0; *(f32x4*)(ba + (size_t)row * 32 + (col - 6144) + 4) = v1; }
    }
};
struct EpiResid {
    float* out; const bf16_t* h;
    __device__ __forceinline__ void operator()(int row, int col, f32x4 v0, f32x4 v1, int = 0) const {
        const uint4 hr = *(const uint4*)(h + (size_t)row * D + col);
        const f32x4 r0 = cvt_bf16x4(make_uint2(hr.x, hr.y)), r1 = cvt_bf16x4(make_uint2(hr.z, hr.w));
        st_bf16x8((bf16_t*)out + (size_t)row * D + col, v0 + r0 * ALPHA, v1 + r1 * ALPHA);
    }
};
struct EpiSlab {
    float* slab;
    __device__ __forceinline__ void operator()(int row, int col, f32x4 v0, f32x4 v1, int pk) const {
        float* o = slab + ((size_t)pk * 768 + (row - 16384)) * D + col;
        *(f32x4*)o = v0; *(f32x4*)(o + 4) = v1;
    }
};
struct EpiRelu2 {
    bf16_t* act;
    __device__ __forceinline__ void operator()(int row, int col, f32x4 v0, f32x4 v1, int = 0) const {
#pragma unroll
        for (int e = 0; e < 4; ++e) { const float r = fmaxf(v0[e], 0.f); v0[e] = r * r; const float q = fmaxf(v1[e], 0.f); v1[e] = q * q; }
        st_bf16x8(act + (size_t)row * DFF + col, v0, v1);
    }
};
struct EpiBf16 {
    bf16_t* out; int ld;
    __device__ __forceinline__ void operator()(int row, int col, f32x4 v0, f32x4 v1, int = 0) const { st_bf16x8(out + (size_t)row * ld + col, v0, v1); }
};

__device__ __forceinline__ void ln_phase(const float* X, const float* __restrict__ g, const float* __restrict__ bta, bf16_t* Hout,
                         float* yp, float* ys, const float* slab, int splits, const bf16_t* hres, int bid, int nb) {
    const int tid_ = tid_opaque(); const int lane = tid_ & 63, wave = tid_ >> 6;
    f32x4 gv[4], bv[4];
#pragma unroll
    for (int j = 0; j < 4; ++j) { gv[j] = *(const f32x4*)(g + j * 256 + lane * 4); bv[j] = *(const f32x4*)(bta + j * 256 + lane * 4); }
    for (int row = bid * 8 + wave; row < NT; row += nb * 8) {
        f32x4 v[4]; float s = 0.f;
        if (row < 16384) {
#pragma unroll
            for (int j = 0; j < 4; ++j) v[j] = ld_bf16x4((const bf16_t*)X + (size_t)row * D + j * 256 + lane * 4);
        } else {
#pragma unroll
            for (int j = 0; j < 4; ++j) v[j] = ld_bf16x4(hres + (size_t)row * D + j * 256 + lane * 4) * ALPHA;
            for (int pk = 0; pk < splits; ++pk) {
                const float* sp = slab + ((size_t)pk * 768 + (row - 16384)) * D + lane * 4;
#pragma unroll
                for (int j = 0; j < 4; ++j) v[j] += *(const f32x4*)(sp + j * 256);
            }
        }
#pragma unroll
        for (int j = 0; j < 4; ++j) s += (v[j][0] + v[j][1]) + (v[j][2] + v[j][3]);
        const float mean = wave_sum(s) * (1.f / D);
        float s2 = 0.f;
#pragma unroll
        for (int j = 0; j < 4; ++j) { v[j] = v[j] - mean; s2 += (v[j][0] * v[j][0] + v[j][1] * v[j][1]) + (v[j][2] * v[j][2] + v[j][3] * v[j][3]); }
        const float rstd = rsqrtf(wave_sum(s2) * (1.f / D) + 1e-5f);
        float* yo = nullptr;
        if (yp) {
            if (row < NPR) { const int b = row / LP, t = row % LP; if (t >= NMETA) yo = yp + ((size_t)b * SEQ + (t - NMETA)) * D; }
            else yo = ys + (size_t)(row - NPR) * D;
        }
#pragma unroll
        for (int j = 0; j < 4; ++j) {
            const f32x4 o = v[j] * rstd * gv[j] + bv[j];
            if (Hout) st_bf16x4(Hout + (size_t)row * D + j * 256 + lane * 4, o);
            if (yo) *(f32x4*)(yo + j * 256 + lane * 4) = o;
        }
    }
}

__device__ __forceinline__ void gdn_sample_pass(const Params& p, char* smem, int pass, int tid) {
    float* sq = (float*)smem;
    float* sk = sq + 256;
    float* part = sk + 256;
    float* part2 = part + 16;
    const int lane = tid & 63, wave = tid >> 6, ug = wave >> 2, wq = wave & 3;
    const int half = lane >> 5, v = wq * 32 + (lane & 31);
    const int u = pass * 2 + ug, b = u >> 4, h = u & 15, kh = h >> 1;
    const size_t row0 = (size_t)NPR + (size_t)b * DS;
    float S[64];
    {
        const float* Sp = p.state_gdn + ((size_t)(b * 16 + h) * 128 + half * 64) * 128 + v;
#pragma unroll
        for (int k = 0; k < 64; ++k) S[k] = Sp[(size_t)k * 128];
    }
    const float Aexp = __expf(p.gdn_a_log[h]);
    const float dtb = p.gdn_dt_bias[h];
    const float nw = p.gdn_norm_w[v];
    const int chA = (half ? 1024 : 0) + kh * 128 + v, chv = 2048 + h * 128 + v;
    float cA[4], cv[4];
#pragma unroll
    for (int j = 0; j < 4; ++j) { cA[j] = p.gdn_conv_w[j * 4096 + chA]; cv[j] = p.gdn_conv_w[j * 4096 + chv]; }
    float xA[7], xv[7];
#pragma unroll
    for (int i = 0; i < 3; ++i) {
        const float* cs = p.state_conv + ((size_t)b * 3 + i) * 4096;
        xA[i] = cs[chA]; xv[i] = cs[chv];
    }
#pragma unroll
    for (int i = 0; i < 4; ++i) {
        const bf16_t* mr = p.mixed + (row0 + i) * 4096;
        xA[3 + i] = bf2f(mr[chA]); xv[3 + i] = bf2f(mr[chv]);
    }
    float* sqg = sq + ug * 128;
    float* skg = sk + ug * 128;
    float* pg = part + ug * 8;
    float* pg2 = part2 + ug * 4;
    const float* kmine = skg + half * 64;
    const float* qmine = sqg + half * 64;
#pragma unroll
    for (int t = 0; t < DS; ++t) {
        const float yA = silu(xA[t] * cA[0] + xA[t + 1] * cA[1] + xA[t + 2] * cA[2] + xA[t + 3] * cA[3]);
        const float yv = silu(xv[t] * cv[0] + xv[t + 1] * cv[1] + xv[t + 2] * cv[2] + xv[t + 3] * cv[3]);
        (half ? skg : sqg)[v] = yA;
        float ssA = yA * yA;
#pragma unroll
        for (int o = 1; o < 32; o <<= 1) ssA += __shfl_xor(ssA, o);
        if ((lane & 31) == 0) pg[wq * 2 + half] = ssA;
        lds_barrier();
        const float qn = rsqrtf((pg[0] + pg[2]) + (pg[4] + pg[6]) + 1e-6f) * 0.08838834764831845f;
        const float kn = rsqrtf((pg[1] + pg[3]) + (pg[5] + pg[7]) + 1e-6f);
        const float* bap = p.ba + (row0 + t) * 32;
        const float beta = 1.f / (1.f + __expf(-bap[h]));
        const float aa = bap[16 + h] + dtb;
        const float sp = (aa > 20.f) ? aa : log1pf(__expf(aa));
        const float dec = __expf(-Aexp * sp);
        float kS0 = 0.f, kS1 = 0.f;
#pragma unroll
        for (int k = 0; k < 64; k += 4) {
            const f32x4 kk = *(const f32x4*)(kmine + k);
            S[k] *= dec; S[k + 1] *= dec; S[k + 2] *= dec; S[k + 3] *= dec;
            kS0 += kk[0] * S[k]; kS1 += kk[1] * S[k + 1]; kS0 += kk[2] * S[k + 2]; kS1 += kk[3] * S[k + 3];
        }
        float kS = kS0 + kS1;
        kS += __shfl_xor(kS, 32);
        const float delta = (yv - kS * kn) * beta * kn;
        float o0 = 0.f, o1 = 0.f;
#pragma unroll
        for (int k = 0; k < 64; k += 4) {
            const f32x4 kk = *(const f32x4*)(kmine + k);
            const f32x4 qq = *(const f32x4*)(qmine + k);
            S[k] += kk[0] * delta; S[k + 1] += kk[1] * delta; S[k + 2] += kk[2] * delta; S[k + 3] += kk[3] * delta;
            o0 += qq[0] * S[k]; o1 += qq[1] * S[k + 1]; o0 += qq[2] * S[k + 2]; o1 += qq[3] * S[k + 3];
        }
        float o = o0 + o1;
        o = (o + __shfl_xor(o, 32)) * qn;
        float s3 = o * o;
#pragma unroll
        for (int x = 1; x < 32; x <<= 1) s3 += __shfl_xor(s3, x);
        if (lane == 0) pg2[wq] = s3;
        lds_barrier();
        if (half == 0) {
            const float rms = rsqrtf(((pg2[0] + pg2[1]) + (pg2[2] + pg2[3])) * (1.f / 128.f) + 1e-6f);
            const float zz = bf2f(p.z[(row0 + t) * 2048 + h * 128 + v]);
            p.gated[(row0 + t) * 2048 + h * 128 + v] = f2bf(o * rms * nw * silu(zz));
        }
    }
    {
        float* So = p.gs_sample + ((size_t)(b * 16 + h) * 128 + half * 64) * 128 + v;
#pragma unroll
        for (int k = 0; k < 64; ++k) So[(size_t)k * 128] = S[k];
    }
    lds_barrier();
}

#define MFMA32(a, b, c) __builtin_amdgcn_mfma_f32_32x32x16_bf16((a), (b), (c), 0, 0, 0)
constexpr int NCH = 65;
constexpr int NCU = BATCH * 16 * NCH;
__device__ __forceinline__ int crow(int reg, int hh) { return (reg & 3) + 8 * (reg >> 2) + 4 * hh; }
__device__ __forceinline__ bf16x8 pack_step(const f32x16& x, int s) {
    u32x4 q;
    q[0] = pk2(x[8 * s + 0], x[8 * s + 1]); q[1] = pk2(x[8 * s + 2], x[8 * s + 3]);
    q[2] = pk2(x[8 * s + 4], x[8 * s + 5]); q[3] = pk2(x[8 * s + 6], x[8 * s + 7]);
    return __builtin_bit_cast(bf16x8, q);
}
__device__ __forceinline__ bf16x8 frag_perm(const bf16_t* p0) {
    const uint2 lo = *(const uint2*)p0, hi = *(const uint2*)(p0 + 8);
    u32x4 q; q[0] = lo.x; q[1] = lo.y; q[2] = hi.x; q[3] = hi.y;
    return __builtin_bit_cast(bf16x8, q);
}

constexpr int SA_KB = 64 * 136 * 2, SA_VB = 2 * SA_KB, SA_AM = 3 * SA_KB, SA_SM = SA_AM + 64 * 68 * 4, SA_GROUP_BYTES = SA_SM + 5 * 64 * 4;
__device__ __forceinline__ void gdn_stageA(const Params& p, char* smem0, int bid, int nb) {
    {
        const int tid = tid_opaque();
        for (int idx = bid * NTHR + tid; idx < (BATCH + DB) * 3 * 4096; idx += nb * NTHR) {
            const int c = idx & 4095, r = (idx >> 12) % 3, b = idx / (3 * 4096);
            if (b < BATCH) p.gc_prompt[idx] = bf2f(p.mixed[((size_t)b * LP + (LP - 3) + r) * 4096 + c]);
            else { const int bs = b - BATCH; p.gc_sample[(size_t)(bs * 3 + r) * 4096 + c] = bf2f(p.mixed[((size_t)NPR + bs * 4 + 1 + r) * 4096 + c]); }
        }
    }
    for (int base = bid * 2; base < NCU; base += nb * 2) {
        const int tid = tid_opaque(), lane = tid & 63, grp = tid >> 8, wg = (tid >> 6) & 3, t2 = tid & 255;
        unsigned zofs = 0; asm volatile("" : "+v"(zofs));
        char* smem = smem0 + zofs + grp * SA_GROUP_BYTES;
        bf16_t* Qb = (bf16_t*)smem;
        bf16_t* Kb = (bf16_t*)(smem + SA_KB);
        bf16_t* Vb = (bf16_t*)(smem + SA_VB);
        float* Am = (float*)(smem + SA_AM);
        float* sbeta = (float*)(smem + SA_SM);
        float* sgc = sbeta + 64;
        float* segc = sgc + 64;
        float* sekd = segc + 64;
        float* srk = sekd + 64;
        const int u = base + grp;
        const bool tail = base >= 4096;
        const int h = u & 15, n = tail ? 64 : ((u >> 4) & 63), b = tail ? ((u - 4096) >> 4) : (u >> 10);
        const int kh = h >> 1;
        const size_t su = (size_t)((b * 16 + h) * NCH + n);
        const int t0 = n * 64;
        if (tail && wg > 0) {
            const int cq = lane & 31, tsel = lane >> 5;
            const int tl0 = 16 * wg + 8 * tsel;
#pragma unroll
            for (int i = 0; i < 8; ++i) {
                *(uint2*)(Qb + (tl0 + i) * 136 + cq * 4) = make_uint2(0u, 0u);
                *(uint2*)(Kb + (tl0 + i) * 136 + cq * 4) = make_uint2(0u, 0u);
                *(uint2*)(Vb + (tl0 + i) * 136 + cq * 4) = make_uint2(0u, 0u);
            }
        } else {
            const int cq = lane & 31, tsel = lane >> 5;
            const int tl0 = 16 * wg + 8 * tsel;
#pragma unroll
            for (int pp = 0; pp < 2; ++pp) {
                const int part = pp ? 2 : grp;
                const int chb = ((part == 0) ? (kh * 128) : (part == 1) ? (1024 + kh * 128) : (2048 + h * 128)) + cq * 4;
                f32x4 cw[4];
#pragma unroll
                for (int j = 0; j < 4; ++j) cw[j] = *(const f32x4*)(p.gdn_conv_w + j * 4096 + chb);
                uint2 xr[11];
#pragma unroll
                for (int i = 0; i < 11; ++i) {
                    const int t = t0 + tl0 - 3 + i;
                    if (t >= 0 && t < LP) xr[i] = *(const uint2*)(p.mixed + ((size_t)b * LP + t) * 4096 + chb);
                    else xr[i] = make_uint2(0u, 0u);
                }
                f32x4 yv[8];
                float ssv[8];
#pragma unroll
                for (int i = 0; i < 8; ++i) {
                    const f32x4 a = cvt_bf16x4(xr[i]) * cw[0] + cvt_bf16x4(xr[i + 1]) * cw[1] + cvt_bf16x4(xr[i + 2]) * cw[2] + cvt_bf16x4(xr[i + 3]) * cw[3];
                    const bool valid = (t0 + tl0 + i) < LP;
#pragma unroll
                    for (int e2 = 0; e2 < 4; ++e2) yv[i][e2] = valid ? silu(a[e2]) : 0.f;
                    ssv[i] = (yv[i][0] * yv[i][0] + yv[i][1] * yv[i][1]) + (yv[i][2] * yv[i][2] + yv[i][3] * yv[i][3]);
                }
                if (part < 2) {
#pragma unroll
                    for (int o = 1; o < 32; o <<= 1)
#pragma unroll
                        for (int i = 0; i < 8; ++i) ssv[i] += __shfl_xor(ssv[i], o);
                }
                bf16_t* dst = (part == 0) ? Qb : (part == 1) ? Kb : Vb;
                bf16_t* dst2 = (bf16_t*)((char*)dst + (grp ? -SA_GROUP_BYTES : SA_GROUP_BYTES));
#pragma unroll
                for (int i = 0; i < 8; ++i) {
                    f32x4 y = yv[i];
                    if (part < 2) y = y * (rsqrtf(ssv[i] + 1e-6f) * ((part == 0) ? 0.08838834764831845f : 1.f));
                    st_bf16x4(dst + (tl0 + i) * 136 + cq * 4, y);
                    if (part < 2) st_bf16x4(dst2 + (tl0 + i) * 136 + cq * 4, y);
                }
            }
        }
        if (wg == 0) {
            const int c = lane, t = t0 + c;
            float beta = 0.f, g = 0.f;
            if (t < LP) {
                const float* bap = p.ba + ((size_t)b * LP + t) * 32;
                beta = 1.f / (1.f + __expf(-bap[h]));
                const float aa = bap[16 + h] + p.gdn_dt_bias[h];
                const float sp = (aa > 20.f) ? aa : log1pf(__expf(aa));
                g = -__expf(p.gdn_a_log[h]) * sp;
            }
            float gc = g;
#pragma unroll
            for (int o = 1; o < 64; o <<= 1) { const float v = __shfl_up(gc, o); if (lane >= o) gc += v; }
            const float glast = __shfl(gc, 63);
            sbeta[c] = beta; sgc[c] = gc; segc[c] = __expf(gc); sekd[c] = __expf(glast - gc); srk[c] = beta * __expf(gc);
            if (lane == 0) p.g_dec[su] = __expf(glast);
        }
        lds_barrier();
        {
            const int ti = wg >> 1, tj = wg & 1;
            const int r = lane & 31, hh = lane >> 5;
            const int c = 32 * tj + r;
            const float gcc = sgc[c], bc = sbeta[c];
            f32x16 acck, accq;
#pragma unroll
            for (int i = 0; i < 16; ++i) { acck[i] = 0.f; accq[i] = 0.f; }
            {
                const bf16_t* Ap = Kb + (32 * ti + r) * 136 + 8 * hh;
                const bf16_t* Bk = Kb + (32 * tj + r) * 136 + 8 * hh;
                const bf16_t* Bq = Qb + (32 * tj + r) * 136 + 8 * hh;
#pragma unroll
                for (int ks = 0; ks < 8; ++ks) {
                    const bf16x8 a = *(const bf16x8*)(Ap + 16 * ks);
                    acck = MFMA32(a, *(const bf16x8*)(Bk + 16 * ks), acck);
                    accq = MFMA32(a, *(const bf16x8*)(Bq + 16 * ks), accq);
                }
            }
#pragma unroll
            for (int reg = 0; reg < 16; ++reg) {
                const int cp = 32 * ti + crow(reg, hh);
                const float dcy = __expf(fminf(gcc - sgc[cp], 0.f));
                Am[(c >> 1) * 136 + cp * 2 + (c & 1)] = (cp < c) ? (bc * acck[reg] * dcy) : 0.f;
            }
            {
                bf16_t* aq = p.g_aqk + su * 4096 + (size_t)(((ti * 2 + tj) * 4) * 2 * 32) * 4 + (size_t)(hh * 32 + r) * 4;
#pragma unroll
                for (int g4 = 0; g4 < 4; ++g4) {
                    const int cp0 = 32 * ti + 8 * g4 + 4 * hh;
                    f32x4 v;
#pragma unroll
                    for (int e2 = 0; e2 < 4; ++e2) {
                        const int cp = cp0 + e2;
                        const float dcy = __expf(fminf(gcc - sgc[cp], 0.f));
                        v[e2] = (cp <= c) ? (accq[4 * g4 + e2] * dcy) : 0.f;
                    }
                    st_bf16x4(aq + (size_t)g4 * (2 * 32 * 4), v);
                }
            }
        }
        {
#pragma unroll
            for (int it = 0; it < 4; ++it) {
                const int chk = t2 + 256 * it, c = chk >> 4, d0 = (chk & 15) * 8;
                const float ee = segc[c];
                const uint4 raw = *(const uint4*)(Qb + c * 136 + d0);
                uint4 o;
                o.x = pk2(__uint_as_float(raw.x << 16) * ee, __uint_as_float(raw.x & 0xffff0000u) * ee);
                o.y = pk2(__uint_as_float(raw.y << 16) * ee, __uint_as_float(raw.y & 0xffff0000u) * ee);
                o.z = pk2(__uint_as_float(raw.z << 16) * ee, __uint_as_float(raw.z & 0xffff0000u) * ee);
                o.w = pk2(__uint_as_float(raw.w << 16) * ee, __uint_as_float(raw.w & 0xffff0000u) * ee);
                *(uint4*)(p.g_qg + su * 8192 + c * 128 + d0) = o;
            }
#pragma unroll
            for (int it = 0; it < 4; ++it) {
                const int item = t2 + 256 * it, d = item & 127, c0 = (item >> 7) * 8;
                float v[8];
#pragma unroll
                for (int i = 0; i < 8; ++i) v[i] = bf2f(Kb[(c0 + i) * 136 + d]) * sekd[c0 + i];
                uint4 o; o.x = pk2(v[0], v[1]); o.y = pk2(v[2], v[3]); o.z = pk2(v[4], v[5]); o.w = pk2(v[6], v[7]);
                *(uint4*)(p.g_kdT + su * 8192 + (size_t)item * 8) = o;
            }
        }
        lds_barrier();
        {
            const int col = 64 * wg + lane;
            const float* rs = sbeta + __builtin_amdgcn_readfirstlane((wg < 2) ? 0 : 256);
            const bf16_t* src = ((wg < 2) ? Vb : Kb) + (col & 127);
            float x[64];
#pragma unroll
            for (int i = 0; i < 64; ++i) x[i] = bf2f(src[i * 136]) * rs[i];
#pragma unroll
            for (int i0 = 0; i0 < 64; i0 += 4) {
                if (tail && i0 >= 16) continue;
                f32x2 a01 = {x[i0], x[i0 + 1]}, a23 = {x[i0 + 2], x[i0 + 3]};
                const float* P0 = Am + (i0 >> 1) * 136;
                const float* P1 = P0 + 136;
#pragma unroll
                for (int j4 = 0; j4 < i0; j4 += 4) {
                    const f32x4 q0 = *(const f32x4*)(P0 + 2 * j4), q1 = *(const f32x4*)(P0 + 2 * j4 + 4);
                    const f32x4 q2 = *(const f32x4*)(P1 + 2 * j4), q3 = *(const f32x4*)(P1 + 2 * j4 + 4);
                    a01 -= (f32x2){q0[0], q0[1]} * x[j4]; a23 -= (f32x2){q2[0], q2[1]} * x[j4];
                    a01 -= (f32x2){q0[2], q0[3]} * x[j4 + 1]; a23 -= (f32x2){q2[2], q2[3]} * x[j4 + 1];
                    a01 -= (f32x2){q1[0], q1[1]} * x[j4 + 2]; a23 -= (f32x2){q3[0], q3[1]} * x[j4 + 2];
                    a01 -= (f32x2){q1[2], q1[3]} * x[j4 + 3]; a23 -= (f32x2){q3[2], q3[3]} * x[j4 + 3];
                    if ((j4 & 12) == 12) asm volatile("" ::: "memory");
                }
                const f32x4 l0 = *(const f32x4*)(P0 + 2 * i0), l1 = *(const f32x4*)(P1 + 2 * i0), l2 = *(const f32x4*)(P1 + 2 * i0 + 4);
                const float a0 = a01[0];
                const float a1 = a01[1] - l0[1] * a0;
                const float a2 = a23[0] - l1[0] * a0 - l1[2] * a1;
                const float a3 = a23[1] - l1[1] * a0 - l1[3] * a1 - l2[1] * a2;
                x[i0] = a0; x[i0 + 1] = a1; x[i0 + 2] = a2; x[i0 + 3] = a3;
                asm volatile("" ::: "memory");
            }
            if (wg < 2) {
                float* up = p.g_u + su * 8192 + col;
#pragma unroll
                for (int i = 0; i < 64; ++i) up[i * 128] = x[i];
            } else {
                bf16_t* wp = p.g_negw + su * 8192 + (col - 128);
#pragma unroll
                for (int i = 0; i < 64; ++i) wp[i * 128] = f2bf(-x[i]);
            }
        }
        lds_barrier();
    }
}

constexpr int GB_P1 = 132, GB_P2 = 68;
constexpr int GB_NW = 0, GB_QG = 64 * GB_P1, GB_KD = 2 * 64 * GB_P1, GB_AQ = 2 * 64 * GB_P1 + 128 * GB_P2, GB_ELEMS = 2 * 64 * GB_P1 + 128 * GB_P2 + 64 * GB_P2;
__device__ __forceinline__ void gdn_chain(const Params& p, char* smem, int b, int h) {
    bf16_t* lds = (bf16_t*)smem;
    const int tid = tid_opaque(), lane = tid & 63, wave = tid >> 6;
    const int r = lane & 31, hh = lane >> 5;
    const size_t su0 = (size_t)(b * 16 + h) * NCH;
    const bool loader = wave >= 4;
    const int t2 = tid - 256;
    uint4 sa0, sa1, sa2, sa3, sa4, sa5, sa6, sa7, sa8, sa9, sa10, sa11, sa12, sa13;
    uint4 sb0, sb1, sb2, sb3, sb4, sb5, sb6, sb7, sb8, sb9, sb10, sb11, sb12, sb13;
    f32x16 S[4], un0, un1;
#pragma unroll
    for (int i = 0; i < 4; ++i)
#pragma unroll
        for (int j = 0; j < 16; ++j) S[i][j] = 0.f;
    const int ch0 = t2, ch1 = t2 + 256, ch2 = t2 + 512, ch3 = t2 + 768;
#define GB_GLOAD(P, n_) do { const size_t su_ = su0 + (n_); \
        const bf16_t* a_ = p.g_negw + su_ * 8192; const bf16_t* b_ = p.g_qg + su_ * 8192; const bf16_t* c_ = p.g_kdT + su_ * 8192; const bf16_t* d_ = p.g_aqk + su_ * 4096; \
        P##0 = *(const uint4*)(a_ + (size_t)ch0 * 8); P##1 = *(const uint4*)(a_ + (size_t)ch1 * 8); P##2 = *(const uint4*)(a_ + (size_t)ch2 * 8); P##3 = *(const uint4*)(a_ + (size_t)ch3 * 8); \
        P##4 = *(const uint4*)(b_ + (size_t)ch0 * 8); P##5 = *(const uint4*)(b_ + (size_t)ch1 * 8); P##6 = *(const uint4*)(b_ + (size_t)ch2 * 8); P##7 = *(const uint4*)(b_ + (size_t)ch3 * 8); \
        P##8 = *(const uint4*)(c_ + (size_t)ch0 * 8); P##9 = *(const uint4*)(c_ + (size_t)ch1 * 8); P##10 = *(const uint4*)(c_ + (size_t)ch2 * 8); P##11 = *(const uint4*)(c_ + (size_t)ch3 * 8); \
        P##12 = *(const uint4*)(d_ + (size_t)ch0 * 8); P##13 = *(const uint4*)(d_ + (size_t)ch1 * 8); } while (0)
#define GB_ST16(dst_, v_) do { bf16_t* d8_ = (dst_); *(uint2*)d8_ = make_uint2((v_).x, (v_).y); *(uint2*)(d8_ + 4) = make_uint2((v_).z, (v_).w); } while (0)
#define GB_SSTORE(P, buf_) do { bf16_t* q_ = (buf_); \
        GB_ST16(q_ + GB_NW + (ch0 >> 4) * GB_P1 + (ch0 & 15) * 8, P##0); GB_ST16(q_ + GB_NW + (ch1 >> 4) * GB_P1 + (ch1 & 15) * 8, P##1); \
        GB_ST16(q_ + GB_NW + (ch2 >> 4) * GB_P1 + (ch2 & 15) * 8, P##2); GB_ST16(q_ + GB_NW + (ch3 >> 4) * GB_P1 + (ch3 & 15) * 8, P##3); \
        GB_ST16(q_ + GB_QG + (ch0 >> 4) * GB_P1 + (ch0 & 15) * 8, P##4); GB_ST16(q_ + GB_QG + (ch1 >> 4) * GB_P1 + (ch1 & 15) * 8, P##5); \
        GB_ST16(q_ + GB_QG + (ch2 >> 4) * GB_P1 + (ch2 & 15) * 8, P##6); GB_ST16(q_ + GB_QG + (ch3 >> 4) * GB_P1 + (ch3 & 15) * 8, P##7); \
        GB_ST16(q_ + GB_KD + (ch0 & 127) * GB_P2 + (ch0 >> 7) * 8, P##8); GB_ST16(q_ + GB_KD + (ch1 & 127) * GB_P2 + (ch1 >> 7) * 8, P##9); \
        GB_ST16(q_ + GB_KD + (ch2 & 127) * GB_P2 + (ch2 >> 7) * 8, P##10); GB_ST16(q_ + GB_KD + (ch3 & 127) * GB_P2 + (ch3 >> 7) * 8, P##11); \
        GB_AQ_ST(q_, ch0, P##12); GB_AQ_ST(q_, ch1, P##13); } while (0)
#define GB_AQ_ST(q_, ch_, v_) do { const int pq_ = 2 * (ch_), r_ = pq_ & 31, hh_ = (pq_ >> 5) & 1, g4_ = (pq_ >> 6) & 3, tl_ = pq_ >> 8; \
        bf16_t* d_ = (q_) + GB_AQ + (32 * (tl_ & 1) + r_) * GB_P2 + 32 * (tl_ >> 1) + 8 * g4_ + 4 * hh_; \
        *(uint2*)d_ = make_uint2((v_).x, (v_).y); *(uint2*)(d_ + GB_P2) = make_uint2((v_).z, (v_).w); } while (0)
#define GB_ULOAD(n_) do { const float* up_ = p.g_u + (su0 + (n_)) * 8192 + 32 * wave + r; \
        _Pragma("unroll") for (int reg_ = 0; reg_ < 16; ++reg_) { un0[reg_] = up_[(crow(reg_, hh)) * 128]; un1[reg_] = up_[(32 + crow(reg_, hh)) * 128]; } } while (0)
    if (loader) {
        bf16_t* buf0 = lds;
        bf16_t* buf1 = lds + GB_ELEMS;
        GB_GLOAD(sa, 0); GB_SSTORE(sa, buf0);
        GB_GLOAD(sa, 1);
        lds_barrier();
        for (int n = 0; n < NCH; n += 2) {
            if (n + 2 < NCH) { GB_GLOAD(sb, n + 2); }
            if (n + 1 < NCH) { GB_SSTORE(sa, buf1); }
            lds_barrier();
            if (n + 1 >= NCH) break;
            if (n + 3 < NCH) { GB_GLOAD(sa, n + 3); }
            if (n + 2 < NCH) { GB_SSTORE(sb, buf0); }
            lds_barrier();
        }
    } else {
        GB_ULOAD(0);
        float dec_next = p.g_dec[su0];
        lds_barrier();
        for (int n = 0; n < NCH; ++n) {
            unsigned zofs = 0; asm volatile("" : "+v"(zofs));
            bf16_t* cur = lds + (n & 1) * GB_ELEMS + zofs;
            const bool more = (n + 1 < NCH);
            const float dec = dec_next;
            if (more) dec_next = p.g_dec[su0 + n + 1];
            f32x16 vn[2], o[2];
            vn[0] = un0; vn[1] = un1;
#pragma unroll
            for (int j = 0; j < 16; ++j) { o[0][j] = 0.f; o[1][j] = 0.f; }
            if (more) { GB_ULOAD(n + 1); }
#pragma unroll
            for (int kt = 0; kt < 4; ++kt)
#pragma unroll
                for (int s = 0; s < 2; ++s) {
                    const bf16x8 sb = pack_step(S[kt], s);
                    const int k0 = 32 * kt + 16 * s + 4 * hh;
#pragma unroll
                    for (int ct = 0; ct < 2; ++ct) {
                        vn[ct] = MFMA32(frag_perm(cur + GB_NW + (32 * ct + r) * GB_P1 + k0), sb, vn[ct]);
                        o[ct] = MFMA32(frag_perm(cur + GB_QG + (32 * ct + r) * GB_P1 + k0), sb, o[ct]);
                    }
                }
            bf16x8 vb[2][2];
#pragma unroll
            for (int ct = 0; ct < 2; ++ct)
#pragma unroll
                for (int s = 0; s < 2; ++s) vb[ct][s] = pack_step(vn[ct], s);
            {
                o[1] = MFMA32(frag_perm(cur + GB_AQ + (32 + r) * GB_P2 + 4 * hh), vb[0][0], o[1]);
                o[0] = MFMA32(frag_perm(cur + GB_AQ + (r) * GB_P2 + 4 * hh), vb[0][0], o[0]);
                o[1] = MFMA32(frag_perm(cur + GB_AQ + (32 + r) * GB_P2 + 16 + 4 * hh), vb[0][1], o[1]);
                o[0] = MFMA32(frag_perm(cur + GB_AQ + (r) * GB_P2 + 16 + 4 * hh), vb[0][1], o[0]);
                o[1] = MFMA32(frag_perm(cur + GB_AQ + (32 + r) * GB_P2 + 32 + 4 * hh), vb[1][0], o[1]);
                o[1] = MFMA32(frag_perm(cur + GB_AQ + (32 + r) * GB_P2 + 32 + 16 + 4 * hh), vb[1][1], o[1]);
            }
#pragma unroll
            for (int dt = 0; dt < 4; ++dt) S[dt] = S[dt] * dec;
#pragma unroll
            for (int ckt = 0; ckt < 2; ++ckt)
#pragma unroll
                for (int s = 0; s < 2; ++s)
#pragma unroll
                    for (int dt = 0; dt < 4; ++dt)
                        S[dt] = MFMA32(frag_perm(cur + GB_KD + (32 * dt + r) * GB_P2 + 32 * ckt + 16 * s + 4 * hh), vb[ckt][s], S[dt]);
            asm volatile("" :: "v"(un0), "v"(un1), "v"(dec_next));
#pragma unroll
            for (int ct = 0; ct < 2; ++ct)
#pragma unroll
                for (int reg = 0; reg < 16; ++reg) {
                    const int t = 64 * n + 32 * ct + crow(reg, hh);
                    if (t < LP) p.g_o[(((size_t)b * LP + t) * 16 + h) * 128 + 32 * wave + r] = f2bf(o[ct][reg]);
                }
            lds_barrier();
        }
    }
    if (!loader) {
#pragma unroll
        for (int dt = 0; dt < 4; ++dt)
#pragma unroll
            for (int reg = 0; reg < 16; ++reg)
                p.gs_prompt[((size_t)(b * 16 + h) * 128 + 32 * dt + crow(reg, hh)) * 128 + 32 * wave + r] = S[dt][reg];
    }
    lds_barrier();
}

__device__ __forceinline__ void gdn_seq_phase(const Params& p, char* smem, int bid, int nb, int rep = 0) {
    if (bid < 64) gdn_chain(p, smem, bid >> 4, bid & 15);
    else {
        float* tile = (float*)smem;
        const int b2 = bid - 64, n2 = nb - 64;
        transpose_convert(p.gdn_w_out, 2048, D, D, p.wt_gout, tile, b2, n2);
        transpose_convert(p.mlp_w1, D, DFF, DFF, p.wt_w1, tile, b2, n2);
        transpose_convert(p.mlp_w1 + (size_t)D * DFF, D, DFF, DFF, p.wt_w1 + (size_t)D * DFF, tile, b2, n2);
        transpose_convert(p.mlp_w2, DFF, D, D, p.wt_w2, tile, b2, n2);
        transpose_convert(p.mlp_w2 + (size_t)D * DFF, DFF, D, D, p.wt_w2 + (size_t)D * DFF, tile, b2, n2);
        transpose_convert(p.dsa_w_in, D, DIN, DIN_PAD, p.wt_din, tile, b2, n2);
        transpose_convert(p.dsa_w_o, D, D, D, p.wt_do, tile, b2, n2);
    }
    int* slot = (int*)(smem + LDS_BYTES - 32);
    const int tid = tid_opaque();
    for (;;) {
        if (threadIdx.x == 0) *slot = (int)atomicAdd(p.bar + 3520 + 16 * rep, 1u);
        lds_barrier();
        const int u = *slot;
        lds_barrier();
        if (u >= DB * 16 / 2) break;
        gdn_sample_pass(p, smem, u, tid_opaque());
    }
}

__device__ __forceinline__ void gdn_gate_phase(const Params& p, int bid, int nb) {
    const int tid_ = tid_opaque(); const int lane = tid_ & 63, wave = tid_ >> 6;
    const int sub = lane >> 4, l16 = lane & 15;
    f32x4 nw0 = *(const f32x4*)(p.gdn_norm_w + l16 * 8), nw1 = *(const f32x4*)(p.gdn_norm_w + l16 * 8 + 4);
    for (int it4 = bid * 8 + wave; it4 < NPR * 4; it4 += nb * 8) {
        const size_t off = ((size_t)it4 * 4 + sub) * 128 + l16 * 8;
        const uint4 ov = *(const uint4*)(p.g_o + off);
        const uint4 zv = *(const uint4*)(p.z + off);
        const f32x4 o0 = cvt_bf16x4(make_uint2(ov.x, ov.y)), o1 = cvt_bf16x4(make_uint2(ov.z, ov.w));
        const f32x4 z0 = cvt_bf16x4(make_uint2(zv.x, zv.y)), z1 = cvt_bf16x4(make_uint2(zv.z, zv.w));
        float ss = ((o0[0] * o0[0] + o0[1] * o0[1]) + (o0[2] * o0[2] + o0[3] * o0[3])) + ((o1[0] * o1[0] + o1[1] * o1[1]) + (o1[2] * o1[2] + o1[3] * o1[3]));
#pragma unroll
        for (int x = 1; x < 16; x <<= 1) ss += __shfl_xor(ss, x);
        const float rms = rsqrtf(ss * (1.f / 128.f) + 1e-6f);
        uint4 g;
        g.x = pk2(o0[0] * rms * nw0[0] * silu(z0[0]), o0[1] * rms * nw0[1] * silu(z0[1]));
        g.y = pk2(o0[2] * rms * nw0[2] * silu(z0[2]), o0[3] * rms * nw0[3] * silu(z0[3]));
        g.z = pk2(o1[0] * rms * nw1[0] * silu(z1[0]), o1[1] * rms * nw1[1] * silu(z1[1]));
        g.w = pk2(o1[2] * rms * nw1[2] * silu(z1[2]), o1[3] * rms * nw1[3] * silu(z1[3]));
        *(uint4*)(p.gated + off) = g;
    }
}

__device__ __forceinline__ size_t ikb_off(int b, int t, int d) {
    return (size_t)b * LPAD * 64 + (size_t)(t >> 5) * 2048 + (size_t)(d >> 4) * 512 + (size_t)((((d >> 3) & 1) * 32 + (t & 31)) * 8 + (d & 7));
}
__device__ __forceinline__ size_t iqb_off(int b, int t, int head, int d) {
    const int g8 = t >> 3, rt = (t >> 2) & 1, qi = t & 3;
    const int rho = (head & 3) + 8 * (((qi & 1) << 1) | (head >> 2)) + 4 * (qi >> 1);
    return ((((size_t)b * 514 + g8) * 2 + rt) * 4 + (d >> 4)) * 512 + (size_t)((((d >> 3) & 1) * 32 + rho) * 8 + (d & 7));
}
__device__ __forceinline__ void rope4(const float* tab, int fi, f32x4 x, f32x4 partner, bool first, f32x4& o) {
    const f32x4 t0 = *(const f32x4*)(tab + fi * 2), t1 = *(const f32x4*)(tab + fi * 2 + 4);
    const float sg = first ? -1.f : 1.f;
    o[0] = x[0] * t0[0] + sg * partner[0] * t0[1];
    o[1] = x[1] * t0[2] + sg * partner[1] * t0[3];
    o[2] = x[2] * t1[0] + sg * partner[2] * t1[1];
    o[3] = x[3] * t1[2] + sg * partner[3] * t1[3];
}
__device__ __forceinline__ void dsa_post_phase(const Params& p, char* smem, int bid, int nb) {
    bf16_t* vt = (bf16_t*)smem;
    for (int u = bid; u < 260 + NSR / 8; u += nb) {
        const int tid = tid_opaque(); const int lane = tid & 63, wave = tid >> 6;
        const bool prompt = u < 260;
        const int b = prompt ? ((u < 256) ? (u >> 6) : (u - 256)) : 0, t0 = prompt ? ((u < 256) ? (u & 63) * 64 : 4096) : 0;
        const int nr8 = prompt ? 8 : 1;
        for (int r8 = 0; r8 < nr8; ++r8) {
            const int tl = wave * 8 + r8;
            const int tlp = (tl & ~12) | ((tl & 4) << 1) | ((tl & 8) >> 1);
            const int t = t0 + tl;
            const bool rvalid = prompt ? (t < LP) : true;
            const int row = prompt ? (b * LP + t) : (NPR + (u - 260) * 8 + wave);
            if (!rvalid) {
                for (int e = lane; e < 256; e += 64) vt[e * 72 + tlp] = 0;
                continue;
            }
            const bf16_t* P = (const bf16_t*)p.p1 + (size_t)row * DIN_PAD;
            const int pos = prompt ? t : (PAST + ((row - NPR) & 3));
            const float* tab = p.rope_tab + (size_t)pos * 48;
            float* kout = prompt ? (p.k_prompt + (size_t)row * 256) : (p.k_sample + (size_t)(row - NPR) * 256);
            float* vout = prompt ? (p.v_prompt + (size_t)row * 256) : (p.v_sample + (size_t)(row - NPR) * 256);
#pragma unroll
            for (int j = 0; j < 5; ++j) {
                const int e0 = (lane + 64 * j) * 4, d0 = e0 & 127;
                f32x4 x = ld_bf16x4(P + e0);
                if (d0 < 32) {
                    const bool first = d0 < 16;
                    const f32x4 pr = ld_bf16x4(P + (first ? e0 + 16 : e0 - 16));
                    rope4(tab, d0 & 15, x, pr, first, x);
                }
                if (j < 4) {
                    if (prompt) st_bf16x4(p.q_b + (size_t)row * 1024 + e0, x * 0.12751743f);
                    else *(f32x4*)(p.qr + (size_t)row * 1024 + e0) = x;
                } else {
                    const int ek = e0 - 1024;
                    *(f32x4*)(kout + ek) = x;
                    if (prompt) st_bf16x4(p.k_b + ((size_t)(b * 2 + (ek >> 7)) * LPAD + t) * 128 + d0, x);
                }
            }
            {
                const int e0 = lane * 4;
                const f32x4 x = ld_bf16x4(P + 1280 + e0);
                *(f32x4*)(vout + e0) = x;
                if (prompt) {
#pragma unroll
                    for (int i = 0; i < 4; ++i) vt[(e0 + i) * 72 + tlp] = f2bf(x[i]);
                }
            }
#pragma unroll
            for (int j = 0; j < 2; ++j) {
                const int e0 = (lane + 64 * j) * 4, d0 = e0 & 63;
                f32x4 x = ld_bf16x4(P + 1536 + e0);
                if (d0 < 16) {
                    const bool first = d0 < 8;
                    const f32x4 pr = ld_bf16x4(P + 1536 + (first ? e0 + 8 : e0 - 8));
                    rope4(tab, 16 + (d0 & 7), x, pr, first, x);
                }
                if (prompt) st_bf16x4(p.iq_b + iqb_off(b, t, e0 >> 6, d0), x);
                else *(f32x4*)(p.iq + (size_t)row * 512 + e0) = x;
            }
            {
                const float x = bf2f(P[2048 + lane]);
                const float mu = wave_sum(x) * (1.f / 64.f);
                const float dv = x - mu;
                const float var = wave_sum(dv * dv) * (1.f / 64.f);
                const float xn = dv * rsqrtf(var + 1e-5f) * p.dsa_ik_g[lane] + p.dsa_ik_b[lane];
                const float other = __shfl_xor(xn, 8);
                float o = xn;
                if (lane < 16) {
                    const float c = tab[(16 + (lane & 7)) * 2], s = tab[(16 + (lane & 7)) * 2 + 1];
                    if (lane < 8) o = xn * c - other * s; else o = xn * c + other * s;
                }
                float* io = prompt ? (p.ik_prompt + (size_t)row * 64) : (p.ik_sample + (size_t)(row - NPR) * 64);
                io[lane] = o;
                if (prompt) p.ik_b[ikb_off(b, t, lane)] = f2bf(o);
            }
            if (lane < 8) p.iw[(size_t)row * 8 + lane] = bf2f(P[2112 + lane]) * 0.35355339059327373f;
        }
        lds_barrier();
        if (prompt) {
#pragma unroll
            for (int i = 0; i < 4; ++i) {
                const int ch = tid + 512 * i, rr = ch >> 3, c8 = (ch & 7) * 8;
                const uint4 v = *(const uint4*)(vt + rr * 72 + c8);
                *(uint4*)(p.vt_b + ((size_t)(b * 2 + (rr >> 7)) * 128 + (rr & 127)) * LPAD + t0 + c8) = v;
            }
        }
        lds_barrier();
    }
    for (int idx = bid * NTHR + tid_opaque(); idx < BATCH * (LPAD - LP) * 256; idx += nb * NTHR) {
        const int c = idx & 255, tp = (idx >> 8) % (LPAD - LP), bb = idx / ((LPAD - LP) * 256);
        const int t = LP + tp, kvh = c >> 7, d = c & 127;
        p.k_b[((size_t)(bb * 2 + kvh) * LPAD + t) * 128 + d] = 0;
        if (c < 64) p.ik_b[ikb_off(bb, t, c)] = 0;
        if (c < 65) p.maskT[((size_t)bb * 65 + c) * LPAD + t] = (c == 0) ? 1ull : 0ull;
    }
}

__device__ __forceinline__ const float* ik_row(const Params& p, bool prompt, int b, int s) {
    if (prompt) return p.ik_prompt + ((size_t)b * LP + s) * 64;
    if (s < PAST) { const int pg = p.page_table[b * 16 + (s >> 7)]; return p.cache_ik + ((size_t)pg * 128 + (s & 127)) * 64; }
    return p.ik_sample + ((size_t)b * DS + (s - PAST)) * 64;
}
__device__ __forceinline__ const float* kv_row(const float* own_p, const float* own_s, const float* cache, const int* page_table,
                                               bool prompt, int b, int s) {
    if (prompt) return own_p + ((size_t)b * LP + s) * 256;
    if (s < PAST) { const int pg = page_table[b * 16 + (s >> 7)]; return cache + ((size_t)pg * 128 + (s & 127)) * 256; }
    return own_s + ((size_t)b * DS + (s - PAST)) * 256;
}

template <bool PROMPT, int NREG>
__device__ __forceinline__ void select_emit(const float* sc, int qpos, int lane, unsigned long long* maskcol, int* selrow) {
    const unsigned long long ltmask = (1ull << lane) - 1ull;
    unsigned key[NREG];
    unsigned kmax = 0u, kmin = 0xffffffffu;
#pragma unroll
    for (int j = 0; j < NREG; ++j) {
        const int s = j * 64 + lane;
        const bool cand = (s >= 16 && s <= qpos);
        const float x = cand ? sc[s] : -INFINITY;
        const unsigned u = __float_as_uint(x);
        key[j] = (u & 0x80000000u) ? ~u : (u | 0x80000000u);
        kmax = max(kmax, key[j]);
        kmin = min(kmin, cand ? key[j] : 0xffffffffu);
    }
#pragma unroll
    for (int o = 1; o < 64; o <<= 1) { kmax = max(kmax, (unsigned)__shfl_xor((int)kmax, o)); kmin = min(kmin, (unsigned)__shfl_xor((int)kmin, o)); }
    unsigned lo = kmin, hi = kmax;
    bool exact = false;
    while (lo < hi) {
        const unsigned mid = lo + ((hi - lo) >> 1) + ((hi - lo) & 1u);
        int c = 0;
#pragma unroll
        for (int j = 0; j < NREG; ++j) c += __popcll(__ballot(key[j] >= mid));
        if (c >= 240) { lo = mid; if (c == 240) { exact = true; break; } } else hi = mid - 1u;
    }
    const unsigned T = lo;
    if (!PROMPT) { if (lane < 16) selrow[lane] = lane; }
    int base = 16;
    unsigned long long myword = 0ull, word64 = 0ull;
    if (exact) {
#pragma unroll
        for (int j = 0; j < NREG; ++j) {
            const bool take = key[j] >= T;
            unsigned long long m = __ballot(take);
            if (PROMPT) {
                if (j == 0) m |= 0xFFFFull;
                if (j < 64) { if (lane == j) myword = m; } else word64 = m;
            } else {
                if (take) selrow[base + __popcll(m & ltmask)] = j * 64 + lane;
                base += __popcll(m);
            }
        }
    } else {
        int cgt = 0;
#pragma unroll
        for (int j = 0; j < NREG; ++j) cgt += __popcll(__ballot(key[j] > T));
        const int need_eq = 240 - cgt;
        int erun = 0;
#pragma unroll
        for (int j = 0; j < NREG; ++j) {
            const bool gt = key[j] > T, eq = key[j] == T;
            const unsigned long long meq = __ballot(eq);
            const int rank = erun + __popcll(meq & ltmask);
            const bool take = gt || (eq && rank < need_eq);
            unsigned long long m = __ballot(take);
            if (PROMPT) {
                if (j == 0) m |= 0xFFFFull;
                if (j < 64) { if (lane == j) myword = m; } else word64 = m;
            } else {
                if (take) selrow[base + __popcll(m & ltmask)] = j * 64 + lane;
                base += __popcll(m);
            }
            erun += __popcll(meq);
        }
    }
    if (PROMPT) {
        if (NREG == 65) { maskcol[(size_t)lane * LPAD] = myword; if (lane == 0) maskcol[(size_t)64 * LPAD] = word64; }
        else { if (lane < NREG) maskcol[(size_t)lane * LPAD] = myword; else if (lane < 64) maskcol[(size_t)lane * LPAD] = 0ull; if (lane == 0) maskcol[(size_t)64 * LPAD] = 0ull; }
    }
}

__device__ __forceinline__ bf16x8 ld_f32x8_bf16(const float* p) {
    const f32x4 a = *(const f32x4*)p, b = *(const f32x4*)(p + 4);
    u32x4 q; q[0] = pk2(a[0], a[1]); q[1] = pk2(a[2], a[3]); q[2] = pk2(b[0], b[1]); q[3] = pk2(b[2], b[3]);
    return __builtin_bit_cast(bf16x8, q);
}
__device__ __forceinline__ void indexer_sample_unit(const Params& p, float* sc, int b, int tid) {
    const int lane = tid & 63, wave = tid >> 6;
    const int r = lane & 31, hh = lane >> 5;
    bf16x8 af[4];
    {
        const int e2 = r & 3, hb = (r >> 2) & 1, a = r >> 3;
        const int qi = 2 * hb + (a >> 1), head = 4 * (a & 1) + e2;
        const float* ap = p.iq + ((size_t)NPR + b * 4 + qi) * 512 + head * 64 + 8 * hh;
#pragma unroll
        for (int ks = 0; ks < 4; ++ks) af[ks] = ld_f32x8_bf16(ap + 16 * ks);
    }
    float wq[2][8];
#pragma unroll
    for (int ql = 0; ql < 2; ++ql) {
        const float* wp = p.iw + ((size_t)NPR + b * 4 + 2 * hh + ql) * 8;
        const f32x4 w0 = *(const f32x4*)wp, w1 = *(const f32x4*)(wp + 4);
#pragma unroll
        for (int e2 = 0; e2 < 4; ++e2) { wq[ql][e2] = w0[e2]; wq[ql][4 + e2] = w1[e2]; }
    }
    asm volatile("" :: "v"(af[0]), "v"(af[1]), "v"(af[2]), "v"(af[3]));
#pragma unroll
    for (int ql = 0; ql < 2; ++ql) asm volatile("" :: "v"(wq[ql][0]), "v"(wq[ql][1]), "v"(wq[ql][2]), "v"(wq[ql][3]), "v"(wq[ql][4]), "v"(wq[ql][5]), "v"(wq[ql][6]), "v"(wq[ql][7]));
    const float* kps[9];
#pragma unroll
    for (int i = 0; i < 9; ++i) {
        const int kt = wave + 8 * i;
        const int s = 32 * (kt < 65 ? kt : 64) + r;
        const float* kp;
        if (s < PAST) { const int pg = p.page_table[b * 16 + (s >> 7)]; kp = p.cache_ik + ((size_t)pg * 128 + (s & 127)) * 64; }
        else kp = p.ik_sample + ((size_t)b * DS + ((s - PAST) & 3)) * 64;
        kps[i] = kp + 8 * hh;
    }
    f32x4 nx[8];
#pragma unroll
    for (int ks = 0; ks < 4; ++ks) { nx[2 * ks] = *(const f32x4*)(kps[0] + 16 * ks); nx[2 * ks + 1] = *(const f32x4*)(kps[0] + 16 * ks + 4); }
#pragma unroll
    for (int i = 0; i < 9; ++i) {
        const int kt = wave + 8 * i;
        if (kt < 65) {
            const int s = 32 * kt + r;
            bf16x8 bq[4];
#pragma unroll
            for (int ks = 0; ks < 4; ++ks) {
                u32x4 q; q[0] = pk2(nx[2 * ks][0], nx[2 * ks][1]); q[1] = pk2(nx[2 * ks][2], nx[2 * ks][3]);
                q[2] = pk2(nx[2 * ks + 1][0], nx[2 * ks + 1][1]); q[3] = pk2(nx[2 * ks + 1][2], nx[2 * ks + 1][3]);
                bq[ks] = __builtin_bit_cast(bf16x8, q);
            }
            if (i + 1 < 9) {
#pragma unroll
                for (int ks = 0; ks < 4; ++ks) { nx[2 * ks] = *(const f32x4*)(kps[i + 1] + 16 * ks); nx[2 * ks + 1] = *(const f32x4*)(kps[i + 1] + 16 * ks + 4); }
            }
            f32x16 acc;
#pragma unroll
            for (int j = 0; j < 16; ++j) acc[j] = 0.f;
#pragma unroll
            for (int ks = 0; ks < 4; ++ks) acc = MFMA32(af[ks], bq[ks], acc);
#pragma unroll
            for (int ql = 0; ql < 2; ++ql) {
                float v = 0.f;
#pragma unroll
                for (int a2 = 0; a2 < 2; ++a2)
#pragma unroll
                    for (int e2 = 0; e2 < 4; ++e2) v += wq[ql][4 * a2 + e2] * fmaxf(acc[4 * (2 * ql + a2) + e2], 0.f);
                sc[(2 * hh + ql) * 2112 + s] = v;
            }
        }
    }
    lds_barrier();
    if (wave < 4) select_emit<false, 33>(sc + wave * 2112, PAST + wave, lane, nullptr, p.sel + ((size_t)NPR + b * 4 + wave) * 256);
    lds_barrier();
}

__device__ __forceinline__ void indexer_prompt_unit(const Params& p, float* sc, int b, int g8, int tid) {
    const int lane = tid & 63, wave = tid >> 6;
    const int r = lane & 31, hh = lane >> 5;
    const int t0 = g8 * 8;
    if (t0 < 256) {
        const int qpos = t0 + wave;
        unsigned long long* maskcol = p.maskT + (size_t)b * 65 * LPAD + qpos;
        for (int j = lane; j < 65; j += 64) {
            const int lo = j * 64;
            unsigned long long m = 0ull;
            if (qpos >= lo + 63) m = ~0ull; else if (qpos >= lo) m = (1ull << (qpos - lo + 1)) - 1ull;
            maskcol[(size_t)j * LPAD] = m;
        }
        return;
    }
    bf16x8 af[2][4];
    {
        const int e2 = r & 3, hb = (r >> 2) & 1, a = r >> 3;
        const int qi = 2 * hb + (a >> 1), head = 4 * (a & 1) + e2;
        (void)qi; (void)head;
#pragma unroll
        for (int rt = 0; rt < 2; ++rt) {
            const bf16_t* ap = p.iq_b + ((((size_t)b * 514 + g8) * 2 + rt) * 4) * 512 + lane * 8;
#pragma unroll
            for (int ks = 0; ks < 4; ++ks) af[rt][ks] = *(const bf16x8*)(ap + 512 * ks);
        }
    }
    float wq[2][2][8];
#pragma unroll
    for (int rt = 0; rt < 2; ++rt)
#pragma unroll
        for (int ql = 0; ql < 2; ++ql) {
            const float* wp = p.iw + ((size_t)b * LP + t0 + 4 * rt + 2 * hh + ql) * 8;
            const f32x4 w0 = *(const f32x4*)wp, w1 = *(const f32x4*)(wp + 4);
#pragma unroll
            for (int e2 = 0; e2 < 4; ++e2) { wq[rt][ql][e2] = w0[e2]; wq[rt][ql][4 + e2] = w1[e2]; }
        }
    const int nkt = (t0 + 7) / 32 + 1;
    const bf16_t* kbase = p.ik_b + (size_t)b * LPAD * 64 + lane * 8;
    bf16x8 bq[2][4], bn[2][4];
#pragma unroll
    for (int j = 0; j < 2; ++j) {
        const int kt = wave + 8 * j, ktc = (kt < nkt) ? kt : (nkt - 1);
#pragma unroll
        for (int ks = 0; ks < 4; ++ks) bq[j][ks] = *(const bf16x8*)(kbase + (size_t)ktc * 2048 + 512 * ks);
    }
    asm volatile("" :: "v"(af[0][0]), "v"(af[0][1]), "v"(af[0][2]), "v"(af[0][3]), "v"(af[1][0]), "v"(af[1][1]), "v"(af[1][2]), "v"(af[1][3]));
#pragma unroll
    for (int rt = 0; rt < 2; ++rt)
#pragma unroll
        for (int ql = 0; ql < 2; ++ql) asm volatile("" :: "v"(wq[rt][ql][0]), "v"(wq[rt][ql][1]), "v"(wq[rt][ql][2]), "v"(wq[rt][ql][3]), "v"(wq[rt][ql][4]), "v"(wq[rt][ql][5]), "v"(wq[rt][ql][6]), "v"(wq[rt][ql][7]));
    for (int kt0 = wave; kt0 < nkt; kt0 += 16) {
#pragma unroll
        for (int j = 0; j < 2; ++j) {
            const int kt = kt0 + 16 + 8 * j, ktc = (kt < nkt) ? kt : (nkt - 1);
#pragma unroll
            for (int ks = 0; ks < 4; ++ks) bn[j][ks] = *(const bf16x8*)(kbase + (size_t)ktc * 2048 + 512 * ks);
        }
        f32x16 acc[2][2];
#pragma unroll
        for (int j = 0; j < 2; ++j)
#pragma unroll
            for (int rt = 0; rt < 2; ++rt)
#pragma unroll
                for (int i = 0; i < 16; ++i) acc[j][rt][i] = 0.f;
#pragma unroll
        for (int ks = 0; ks < 4; ++ks)
#pragma unroll
            for (int j = 0; j < 2; ++j)
#pragma unroll
                for (int rt = 0; rt < 2; ++rt) acc[j][rt] = MFMA32(af[rt][ks], bq[j][ks], acc[j][rt]);
#pragma unroll
        for (int j = 0; j < 2; ++j) {
            const int kt = kt0 + 8 * j;
            if (kt < nkt) {
#pragma unroll
                for (int rt = 0; rt < 2; ++rt)
#pragma unroll
                    for (int ql = 0; ql < 2; ++ql) {
                        float s = 0.f;
#pragma unroll
                        for (int a2 = 0; a2 < 2; ++a2)
#pragma unroll
                            for (int e2 = 0; e2 < 4; ++e2) s += wq[rt][ql][4 * a2 + e2] * fmaxf(acc[j][rt][4 * (2 * ql + a2) + e2], 0.f);
                        sc[(4 * rt + 2 * hh + ql) * 4160 + 32 * kt + r] = s;
                    }
            }
        }
#pragma unroll
        for (int j = 0; j < 2; ++j)
#pragma unroll
            for (int ks = 0; ks < 4; ++ks) bq[j][ks] = bn[j][ks];
    }
    lds_barrier();
    {
        const int qpos = t0 + wave;
        unsigned long long* mc = p.maskT + (size_t)b * 65 * LPAD + qpos;
        if (t0 + 7 < 17 * 64) select_emit<true, 17>(sc + wave * 4160, qpos, lane, mc, nullptr);
        else if (t0 + 7 < 33 * 64) select_emit<true, 33>(sc + wave * 4160, qpos, lane, mc, nullptr);
        else if (t0 + 7 < 49 * 64) select_emit<true, 49>(sc + wave * 4160, qpos, lane, mc, nullptr);
        else select_emit<true, 65>(sc + wave * 4160, qpos, lane, mc, nullptr);
    }
    lds_barrier();
}

__device__ __forceinline__ void indexer_phase(const Params& p, char* smem, int bid, int nb, int rep = 0) {
    int* slot = (int*)(smem + LDS_BYTES - 32);
    for (;;) {
        const int tid = tid_opaque();
        unsigned zofs = 0; asm volatile("" : "+v"(zofs));
        float* sc = (float*)(smem + zofs);
        if (threadIdx.x == 0) *slot = (int)atomicAdd(p.bar + 3648 + 16 * rep, 1u);
        lds_barrier();
        const int u = *slot;
        lds_barrier();
        if (u >= DB + BATCH * 514) break;
        if (u < DB) {
            indexer_sample_unit(p, sc, u, tid);
        } else {
            const int v = u - DB;
            indexer_prompt_unit(p, sc, v & 3, 513 - (v >> 2), tid);
        }
    }
}

__device__ __forceinline__ void attn_sample_query(const Params& p, char* smem, int row) {
    float* qs = (float*)smem;
    float* ps = qs + 1024;
    const float** kptr = (const float**)(ps + 2048);
    const float** vptr = kptr + 256;
    float* red = (float*)(vptr + 256);
    const int tid = tid_opaque(), lane = tid & 63, wave = tid >> 6;
    const int b = (row - NPR) >> 2;
    qs[tid] = p.qr[(size_t)row * 1024 + tid];
    qs[tid + 512] = p.qr[(size_t)row * 1024 + 512 + tid];
    if (tid < 256) {
        const int s = p.sel[(size_t)row * 256 + tid];
        const float *kp, *vp;
        if (s < PAST) { const int pg = p.page_table[b * 16 + ((s < 0 ? 0 : s) >> 7)]; const size_t ro = ((size_t)pg * 128 + ((s < 0 ? 0 : s) & 127)) * 256; kp = p.cache_k + ro; vp = p.cache_v + ro; }
        else { const size_t ro = ((size_t)b * DS + (s - PAST)) * 256; kp = p.k_sample + ro; vp = p.v_sample + ro; }
        kptr[tid] = (s < 0) ? nullptr : kp;
        vptr[tid] = vp;
    }
    lds_barrier();
    {
        const int j = tid & 255, kvh = tid >> 8;
        const float* kp0 = kptr[j];
        const bool valid = kp0 != nullptr;
        const float* kp = (valid ? kp0 : vptr[j]) + kvh * 128;
        float d0 = 0.f, d1 = 0.f, d2 = 0.f, d3 = 0.f;
        const float* q0 = qs + (kvh * 4) * 128;
#pragma unroll 16
        for (int c = 0; c < 32; ++c) {
            const f32x4 kv = *(const f32x4*)(kp + c * 4);
            const f32x4 a0 = *(const f32x4*)(q0 + c * 4), a1 = *(const f32x4*)(q0 + 128 + c * 4), a2 = *(const f32x4*)(q0 + 256 + c * 4),
                        a3 = *(const f32x4*)(q0 + 384 + c * 4);
            d0 += kv[0] * a0[0] + kv[1] * a0[1] + kv[2] * a0[2] + kv[3] * a0[3];
            d1 += kv[0] * a1[0] + kv[1] * a1[1] + kv[2] * a1[2] + kv[3] * a1[3];
            d2 += kv[0] * a2[0] + kv[1] * a2[1] + kv[2] * a2[2] + kv[3] * a2[3];
            d3 += kv[0] * a3[0] + kv[1] * a3[1] + kv[2] * a3[2] + kv[3] * a3[3];
        }
        const float scl = 0.08838834764831845f;
        ps[(kvh * 4 + 0) * 256 + j] = valid ? d0 * scl : -INFINITY;
        ps[(kvh * 4 + 1) * 256 + j] = valid ? d1 * scl : -INFINITY;
        ps[(kvh * 4 + 2) * 256 + j] = valid ? d2 * scl : -INFINITY;
        ps[(kvh * 4 + 3) * 256 + j] = valid ? d3 * scl : -INFINITY;
    }
    lds_barrier();
    {
        float v[4]; float m = -INFINITY;
#pragma unroll
        for (int i = 0; i < 4; ++i) { v[i] = ps[wave * 256 + lane + 64 * i]; m = fmaxf(m, v[i]); }
        m = wave_max(m);
        float sum = 0.f;
#pragma unroll
        for (int i = 0; i < 4; ++i) { v[i] = __expf(v[i] - m); sum += v[i]; }
        sum = wave_sum(sum);
        const float inv = 1.f / sum;
#pragma unroll
        for (int i = 0; i < 4; ++i) ps[wave * 256 + lane + 64 * i] = v[i] * inv;
    }
    lds_barrier();
    {
        const int kvh = tid >> 8, kg = (tid >> 5) & 7, d4 = tid & 31;
        f32x4 acc[4];
#pragma unroll
        for (int g = 0; g < 4; ++g) acc[g] = (f32x4){0.f, 0.f, 0.f, 0.f};
#pragma unroll 16
        for (int i = 0; i < 32; ++i) {
            const int j = kg * 32 + i;
            const f32x4 vv = *(const f32x4*)(vptr[j] + kvh * 128 + d4 * 4);
#pragma unroll
            for (int g = 0; g < 4; ++g) acc[g] += vv * ps[(kvh * 4 + g) * 256 + j];
        }
#pragma unroll
        for (int g = 0; g < 4; ++g) *(f32x4*)(red + ((kg * 2 + kvh) * 4 + g) * 128 + d4 * 4) = acc[g];
    }
    lds_barrier();
    {
        const int h = wave, d = lane * 2;
        float o0 = 0.f, o1 = 0.f;
#pragma unroll
        for (int kg = 0; kg < 8; ++kg) { const f32x2 t = *(const f32x2*)(red + ((kg * 2 + (h >> 2)) * 4 + (h & 3)) * 128 + d); o0 += t[0]; o1 += t[1]; }
        *(unsigned*)(p.gated + (size_t)row * 1024 + h * 128 + d) = pk2(o0, o1);
    }
    lds_barrier();
}

constexpr int AT_K = 0, AT_V = 64 * 136, AT_ELEMS = 64 * 136 + 128 * 72;
__device__ __forceinline__ void attn_dense_unit(const Params& p, char* smem, int b, int kvh, int qb) {
    bf16_t* lds = (bf16_t*)smem;
    const int tid = tid_opaque(), lane = tid & 63, wave = tid >> 6;
    const int r = lane & 31, hh = lane >> 5;
    const int g = wave & 3, qs = wave >> 2;
    const int head = kvh * 4 + g;
    const int tq = 64 * qb + 32 * qs + r;
    const int tqc = (tq < LP) ? tq : (LP - 1);
    bf16x8 qf[8];
    {
        const bf16_t* qp = p.q_b + ((size_t)b * LP + tqc) * 1024 + head * 128 + 8 * hh;
#pragma unroll
        for (int ks = 0; ks < 8; ++ks) qf[ks] = *(const bf16x8*)(qp + 16 * ks);
    }
    f32x16 O[4];
#pragma unroll
    for (int i = 0; i < 4; ++i)
#pragma unroll
        for (int j = 0; j < 16; ++j) O[i][j] = 0.f;
    float mrun = -3.0e38f, lrun = 0.f;
    const bf16_t* Kg = p.k_b + ((size_t)(b * 2 + kvh) * LPAD) * 128;
    const bf16_t* Vg = p.vt_b + ((size_t)(b * 2 + kvh) * 128) * LPAD;
    const unsigned long long* mcol = p.maskT + (size_t)b * 65 * LPAD + tq;
    const int kc0 = tid, kc1 = tid + 512;
    uint4 sk0, sk1, sv0, sv1;
#define AT_GLOAD(kt_) do { const bf16_t* kg_ = Kg + (size_t)(kt_) * 64 * 128; const bf16_t* vg_ = Vg + (size_t)(kt_) * 64; \
        sk0 = *(const uint4*)(kg_ + (size_t)kc0 * 8); sk1 = *(const uint4*)(kg_ + (size_t)kc1 * 8); \
        sv0 = *(const uint4*)(vg_ + (size_t)(kc0 >> 3) * LPAD + (kc0 & 7) * 8); sv1 = *(const uint4*)(vg_ + (size_t)(kc1 >> 3) * LPAD + (kc1 & 7) * 8); } while (0)
#define AT_SSTORE(buf_) do { bf16_t* q_ = (buf_); \
        *(uint4*)(q_ + AT_K + (kc0 >> 4) * 136 + (kc0 & 15) * 8) = sk0; *(uint4*)(q_ + AT_K + (kc1 >> 4) * 136 + (kc1 & 15) * 8) = sk1; \
        *(uint4*)(q_ + AT_V + (kc0 >> 3) * 72 + (kc0 & 7) * 8) = sv0; *(uint4*)(q_ + AT_V + (kc1 >> 3) * 72 + (kc1 & 7) * 8) = sv1; } while (0)
    AT_GLOAD(0); AT_SSTORE(lds);
    unsigned long long mw_next = mcol[0];
    asm volatile("" :: "v"(qf[0]), "v"(qf[1]), "v"(qf[2]), "v"(qf[3]), "v"(qf[4]), "v"(qf[5]), "v"(qf[6]), "v"(qf[7]), "v"(mw_next));
    lds_barrier();
    for (int kt = 0; kt <= qb; ++kt) {
        unsigned zofs = 0; asm volatile("" : "+v"(zofs));
        bf16_t* cur = lds + (kt & 1) * AT_ELEMS + zofs;
        bf16_t* nxt = lds + ((kt + 1) & 1) * AT_ELEMS + zofs;
        const bool more = kt < qb;
        if (more) { AT_GLOAD(kt + 1); }
        const unsigned long long mw = mw_next;
        if (more) mw_next = mcol[(size_t)(kt + 1) * LPAD];
        f32x16 st[2];
#pragma unroll
        for (int j = 0; j < 16; ++j) { st[0][j] = 0.f; st[1][j] = 0.f; }
#pragma unroll
        for (int ks = 0; ks < 8; ++ks) {
            st[0] = MFMA32(*(const bf16x8*)(cur + AT_K + (r) * 136 + 16 * ks + 8 * hh), qf[ks], st[0]);
            st[1] = MFMA32(*(const bf16x8*)(cur + AT_K + (32 + r) * 136 + 16 * ks + 8 * hh), qf[ks], st[1]);
        }
        float mx = fmaxf(st[0][0], st[1][0]);
#pragma unroll
        for (int reg = 1; reg < 16; reg += 1) mx = fmaxf(mx, fmaxf(st[0][reg], st[1][reg]));
        mx = fmaxf(mx, __shfl_xor(mx, 32));
        const float mnew = (mx > mrun + 8.f) ? mx : mrun;
        if (__any(mnew != mrun)) {
            const float alpha = __builtin_amdgcn_exp2f(mrun - mnew);
            lrun *= alpha;
#pragma unroll
            for (int dt = 0; dt < 4; ++dt) O[dt] = O[dt] * alpha;
            mrun = mnew;
        }
        float psum = 0.f;
#pragma unroll
        for (int kk = 0; kk < 2; ++kk) {
            const int w = (int)((unsigned)(mw >> (32 * kk)) >> (4 * hh));
#pragma unroll
            for (int reg = 0; reg < 16; ++reg) {
                const int bit = (reg & 3) + 8 * (reg >> 2);
                const int keep = __builtin_amdgcn_sbfe(w, bit, 1);
                const float pv = __uint_as_float(__float_as_uint(__builtin_amdgcn_exp2f(st[kk][reg] - mrun)) & (unsigned)keep);
                st[kk][reg] = pv; psum += pv;
            }
        }
        lrun += psum;
        bf16x8 pb[2][2];
#pragma unroll
        for (int kk = 0; kk < 2; ++kk)
#pragma unroll
            for (int s = 0; s < 2; ++s) pb[kk][s] = pack_step(st[kk], s);
#pragma unroll
        for (int kk = 0; kk < 2; ++kk)
#pragma unroll
            for (int s = 0; s < 2; ++s)
#pragma unroll
                for (int dt = 0; dt < 4; ++dt)
                    O[dt] = MFMA32(*(const bf16x8*)(cur + AT_V + (32 * dt + r) * 72 + 32 * kk + 16 * s + 8 * hh), pb[kk][s], O[dt]);
        if (more) { AT_SSTORE(nxt); }
        lds_barrier();
    }
    const float ltot = lrun + __shfl_xor(lrun, 32);
    const float inv = 1.f / ltot;
    if (tq < LP) {
        bf16_t* op = p.gated + ((size_t)b * LP + tq) * 1024 + head * 128;
#pragma unroll
        for (int dt = 0; dt < 4; ++dt)
#pragma unroll
            for (int g4 = 0; g4 < 4; ++g4) {
                f32x4 v;
#pragma unroll
                for (int e2 = 0; e2 < 4; ++e2) v[e2] = O[dt][4 * g4 + e2] * inv;
                st_bf16x4(op + 32 * dt + 8 * g4 + 4 * hh, v);
            }
    }
    lds_barrier();
}

__device__ __forceinline__ void attn_phase(const Params& p, char* smem, int bid, int nb, int rep = 0) {
    int* slot = (int*)(smem + LDS_BYTES - 32);
    for (;;) {
        if (threadIdx.x == 0) *slot = (int)atomicAdd(p.bar + 3584 + 16 * rep, 1u);
        lds_barrier();
        const int u = *slot;
        lds_barrier();
        if (u >= 520 + NSR) break;
        if (u < 520) attn_dense_unit(p, smem, (u & 7) >> 1, u & 1, 64 - (u >> 3));
        else attn_sample_query(p, smem, NPR + (u - 520));
    }
}

#define XB_TMO      128
#define XB_XCNT(j)  (256  + 64 * (j))
#define XB_XSUB(j)  (1280 + 64 * (j))
#define XB_XGEN(j)  (2304 + 64 * (j))
#define XB_TOP      3328
#define XB_TOPGEN   3392
#define XCD_BAR_WORDS 3456
#define XB_SPIN_CAP (1u << 18)
#define LAS __attribute__((address_space(3)))

__device__ __forceinline__ unsigned xb_ld(unsigned* p)              { return __hip_atomic_load(p, __ATOMIC_RELAXED, __HIP_MEMORY_SCOPE_AGENT); }
__device__ __forceinline__ unsigned xb_add(unsigned* p, unsigned v) { return __hip_atomic_fetch_add(p, v, __ATOMIC_RELAXED, __HIP_MEMORY_SCOPE_AGENT); }
__device__ __forceinline__ unsigned xb_xcc_id() { return (unsigned)__builtin_amdgcn_s_getreg((3 << 11) | 20) & 0xFu; }
#define XB_SPIN(cond, bar) do { unsigned _sp = 0; while (cond) { __builtin_amdgcn_s_sleep(1); \
    if ((++_sp & 255u) == 0u) { if (xb_ld(&(bar)[XB_TMO])) break; if (_sp > XB_SPIN_CAP) { atomicAdd(&(bar)[XB_TMO], 1u); break; } } } } while (0)

struct XcdBarrier {
    unsigned* bar; unsigned x;
    volatile LAS unsigned* st;
};

__device__ __forceinline__ XcdBarrier xcd_barrier_post(unsigned* bar, volatile LAS unsigned* st) {
    XcdBarrier b; b.bar = bar; b.x = xb_xcc_id(); b.st = st;
    if (threadIdx.x == 0) (void)xb_add(&bar[XB_XCNT(b.x)], 1u);
    return b;
}
__device__ __forceinline__ void xcd_barrier_complete(unsigned* bar, unsigned x, unsigned& nloc, unsigned& nx) {
    const unsigned G = gridDim.x * gridDim.y * gridDim.z;
    unsigned sum, cnt, mine, sp = 0u;
    for (;;) {
        sum = 0u; cnt = 0u; mine = 0u;
#pragma unroll
        for (unsigned j = 0; j < 16; ++j) { const unsigned c = xb_ld(&bar[XB_XCNT(j)]); sum += c; cnt += (c > 0u) ? 1u : 0u; mine = (j == x) ? c : mine; }
        if (sum == G) break;
        __builtin_amdgcn_s_sleep(1);
        if ((++sp & 255u) == 0u) { if (xb_ld(&bar[XB_TMO])) break; if (sp > XB_SPIN_CAP) { atomicAdd(&bar[XB_TMO], 1u); break; } }
    }
    nloc = mine > 0u ? mine : 1u; nx = cnt > 0u ? cnt : 1u;
}

__device__ __forceinline__ void xcd_barrier(const XcdBarrier& b) {
    asm volatile("s_waitcnt vmcnt(0)" ::: "memory");
    __syncthreads();
    if (threadIdx.x == 0) {
        unsigned* bar = b.bar;
        __builtin_amdgcn_s_waitcnt(0);
        unsigned nloc = b.st[0], nx = b.st[1];
        if (nloc == 0u) { xcd_barrier_complete(bar, b.x, nloc, nx); b.st[0] = nloc; b.st[1] = nx; }
        const unsigned old = xb_add(&bar[XB_XSUB(b.x)], 1u);
        const unsigned gen = old / nloc;
        if (old + 1u == (gen + 1u) * nloc) {
            __builtin_amdgcn_fence(__ATOMIC_RELEASE, "agent");
            asm volatile("s_waitcnt vmcnt(0)" ::: "memory");
            const unsigned og = xb_add(&bar[XB_TOP], 1u);
            const unsigned tg = og / nx;
            if (og + 1u == (tg + 1u) * nx) xb_add(&bar[XB_TOPGEN], 1u);
            else XB_SPIN(xb_ld(&bar[XB_TOPGEN]) == tg, bar);
            __builtin_amdgcn_fence(__ATOMIC_ACQUIRE, "agent");
            xb_add(&bar[XB_XGEN(b.x)], 1u);
            asm volatile("s_waitcnt vmcnt(0)" ::: "memory");
        } else {
            XB_SPIN(xb_ld(&bar[XB_XGEN(b.x)]) == gen, bar);
            __builtin_amdgcn_fence(__ATOMIC_ACQUIRE, "agent");
            asm volatile("s_waitcnt vmcnt(0)" ::: "memory");
        }
    }
    __syncthreads();
}


constexpr int NPHASE = 19;
template <int PH>
__device__ __forceinline__ void run_phase(const Params& p, char* smem, int bid, int nb, int rep = 0) {
    constexpr int MT = MPAD / 256;
    if constexpr (PH == 0) phase_prologue(p, smem, bid, nb);
    else if constexpr (PH == 1) gemm_big(p.hA, D, p.wt_gin, GIN_PAD, EpiGdnIn{p.mixed, p.z, p.ba}, smem, bid, nb);
    else if constexpr (PH == 2) gdn_stageA(p, smem, bid, nb);
    else if constexpr (PH == 3) gdn_seq_phase(p, smem, bid, nb, rep);
    else if constexpr (PH == 4) gdn_gate_phase(p, bid, nb);
    else if constexpr (PH == 5) gemm_n1024(p.gated, 2048, p.wt_gout, EpiResid{p.preln, p.hA}, EpiSlab{p.slab}, 8, smem, bid, nb);
    else if constexpr (PH == 6) ln_phase(p.preln, p.ln1_g, p.ln1_b, p.hB, nullptr, nullptr, p.slab, 8, p.hA, bid, nb);
    else if constexpr (PH == 7) gemm_big(p.hB, D, p.wt_w1, DFF, EpiRelu2{p.act}, smem, bid, nb);
    else if constexpr (PH == 8) gemm_n1024(p.act, DFF, p.wt_w2, EpiResid{p.preln, p.hB}, EpiSlab{p.slab}, 16, smem, bid, nb);
    else if constexpr (PH == 9) ln_phase(p.preln, p.ln2_g, p.ln2_b, p.hA, nullptr, nullptr, p.slab, 16, p.hB, bid, nb);
    else if constexpr (PH == 10) gemm_big(p.hA, D, p.wt_din, DIN_PAD, EpiBf16{(bf16_t*)p.p1, DIN_PAD}, smem, bid, nb);
    else if constexpr (PH == 11) dsa_post_phase(p, smem, bid, nb);
    else if constexpr (PH == 12) indexer_phase(p, smem, bid, nb, rep);
    else if constexpr (PH == 13) attn_phase(p, smem, bid, nb, rep);
    else if constexpr (PH == 14) gemm_n1024(p.gated, D, p.wt_do, EpiResid{p.preln, p.hA}, EpiSlab{p.slab}, 4, smem, bid, nb);
    else if constexpr (PH == 15) ln_phase(p.preln, p.ln1_g + D, p.ln1_b + D, p.hB, nullptr, nullptr, p.slab, 4, p.hA, bid, nb);
    else if constexpr (PH == 16) gemm_big(p.hB, D, p.wt_w1 + (size_t)D * DFF, DFF, EpiRelu2{p.act}, smem, bid, nb);
    else if constexpr (PH == 17) gemm_n1024(p.act, DFF, p.wt_w2 + (size_t)D * DFF, EpiResid{p.preln, p.hB}, EpiSlab{p.slab}, 16, smem, bid, nb);
    else if constexpr (PH == 18) ln_phase(p.preln, p.ln2_g + D, p.ln2_b + D, nullptr, p.y_prompt, p.y_sample, p.slab, 16, p.hB, bid, nb);
}

template <int PH>
__global__ void __launch_bounds__(NTHR, 2) k_phase(Params p) {
    extern __shared__ __attribute__((aligned(16))) char smem[];
    run_phase<PH>(p, smem, blockIdx.x, gridDim.x);
}

template <int PH>
__device__ __forceinline__ void mega_run(const Params& p, char* smem, const XcdBarrier& bar) {
    run_phase<PH>(p, smem, blockIdx.x, gridDim.x);
#ifdef PROBE_MASK
    if constexpr ((PROBE_MASK >> PH) & 1) { xcd_barrier(bar); run_phase<PH>(p, smem, blockIdx.x, gridDim.x, 1); }
#endif
    if constexpr (PH + 1 < NPHASE) {
        xcd_barrier(bar);
        mega_run<PH + 1>(p, smem, bar);
    }
}
__global__ void __launch_bounds__(NTHR, 2) k_mega(Params p) {
    extern __shared__ __attribute__((aligned(16))) char smem[];
    volatile LAS unsigned* st = (volatile LAS unsigned*)(smem + LDS_BYTES - 16);
    if (threadIdx.x == 0) { st[0] = 0u; st[1] = 0u; st[2] = 0u; st[3] = 0u; }
    __syncthreads();
    XcdBarrier bar = xcd_barrier_post(p.bar, st);
    mega_run<0>(p, smem, bar);
}

template <int PH>
void launch_phase(const Params& p, hipStream_t stream) {
    static bool attr_done = false;
    if (!attr_done) {
        (void)hipFuncSetAttribute((const void*)k_phase<PH>, hipFuncAttributeMaxDynamicSharedMemorySize, LDS_BYTES);
        attr_done = true;
    }
    hipLaunchKernelGGL(k_phase<PH>, dim3(256), dim3(NTHR), LDS_BYTES, stream, p);
}
template <int PH>
void launch_all(const Params& p, hipStream_t stream) {
    launch_phase<PH>(p, stream);
    if constexpr (PH + 1 < NPHASE) launch_all<PH + 1>(p, stream);
}

}

extern "C" void kernel_launch(void* const* d_in, const int* in_sizes, int n_in, void* d_out, int out_size, void* d_ws, size_t ws_size,
                              hipStream_t stream) {
    Params p{};
    p.x_prompt = (const float*)d_in[0]; p.x_sample = (const float*)d_in[1]; p.state_gdn = (const float*)d_in[2];
    p.state_conv = (const float*)d_in[3]; p.cache_k = (const float*)d_in[4]; p.cache_v = (const float*)d_in[5];
    p.cache_ik = (const float*)d_in[6]; p.page_table = (const int*)d_in[7]; p.meta = (const float*)d_in[8];
    p.ln1_g = (const float*)d_in[9]; p.ln1_b = (const float*)d_in[10]; p.ln2_g = (const float*)d_in[11]; p.ln2_b = (const float*)d_in[12];
    p.mlp_w1 = (const float*)d_in[13]; p.mlp_w2 = (const float*)d_in[14]; p.gdn_w_in = (const float*)d_in[15];
    p.gdn_conv_w = (const float*)d_in[16]; p.gdn_a_log = (const float*)d_in[17]; p.gdn_dt_bias = (const float*)d_in[18];
    p.gdn_norm_w = (const float*)d_in[19]; p.gdn_w_out = (const float*)d_in[20]; p.dsa_w_in = (const float*)d_in[21];
    p.dsa_ik_g = (const float*)d_in[22]; p.dsa_ik_b = (const float*)d_in[23]; p.dsa_w_o = (const float*)d_in[24];
    float* o = (float*)d_out;
    p.y_prompt = o; o += (size_t)BATCH * SEQ * D;
    p.y_sample = o; o += (size_t)NSR * D;
    p.gs_prompt = o; o += (size_t)BATCH * 16 * 128 * 128;
    p.gc_prompt = o; o += (size_t)BATCH * 3 * 4096;
    p.gs_sample = o; o += (size_t)DB * 16 * 128 * 128;
    p.gc_sample = o; o += (size_t)DB * 3 * 4096;
    p.k_prompt = o; o += (size_t)NPR * 256;
    p.v_prompt = o; o += (size_t)NPR * 256;
    p.ik_prompt = o; o += (size_t)NPR * 64;
    p.k_sample = o; o += (size_t)NSR * 256;
    p.v_sample = o; o += (size_t)NSR * 256;
    p.ik_sample = o; o += (size_t)NSR * 64;
    char* w = (char*)d_ws;
    auto take = [&](size_t bytes) { char* r = w; w += (bytes + 255) & ~(size_t)255; return r; };
    p.bar = (unsigned*)take(16384);
    p.wt_gin = (bf16_t*)take((size_t)GIN_PAD * D * 2);
    p.wt_gout = (bf16_t*)take((size_t)D * 2048 * 2);
    p.wt_w1 = (bf16_t*)take((size_t)2 * D * DFF * 2);
    p.wt_w2 = (bf16_t*)take((size_t)2 * D * DFF * 2);
    p.wt_din = (bf16_t*)take((size_t)DIN_PAD * D * 2);
    p.wt_do = (bf16_t*)take((size_t)D * D * 2);
    p.hA = (bf16_t*)take((size_t)MPAD * D * 2);
    p.hB = (bf16_t*)take((size_t)MPAD * D * 2);
    p.preln = (float*)take((size_t)MPAD * D * 4);
    p.mixed = (bf16_t*)take((size_t)MPAD * 4096 * 2);
    p.z = (bf16_t*)take((size_t)MPAD * 2048 * 2);
    p.ba = (float*)take((size_t)MPAD * 32 * 4);
    p.gated = (bf16_t*)take((size_t)MPAD * 2048 * 2);
    p.act = (bf16_t*)take((size_t)MPAD * DFF * 2);
    p.p1 = (float*)take((size_t)MPAD * DIN_PAD * 4);
    p.qr = (float*)take((size_t)MPAD * 1024 * 4);
    p.iq = (float*)take((size_t)MPAD * 512 * 4);
    p.iw = (float*)take((size_t)MPAD * 8 * 4);
    p.sel = (int*)take((size_t)MPAD * 256 * 4);
    p.g_o = (bf16_t*)take((size_t)NPR * 2048 * 2);
    p.rope_tab = (float*)take((size_t)LP * 24 * 2 * 4);
    p.slab = (float*)take((size_t)16 * 768 * 1024 * 4);
    p.q_b = (bf16_t*)take((size_t)NPR * 1024 * 2);
    p.k_b = (bf16_t*)take((size_t)BATCH * 2 * LPAD * 128 * 2);
    p.vt_b = (bf16_t*)take((size_t)BATCH * 2 * 128 * LPAD * 2);
    p.iq_b = (bf16_t*)take((size_t)NPR * 512 * 2);
    p.ik_b = (bf16_t*)take((size_t)BATCH * LPAD * 64 * 2);
    p.maskT = (unsigned long long*)take((size_t)BATCH * 65 * LPAD * 8);
    p.g_dec = (float*)take((size_t)NCU * 4);
    p.g_u = (float*)p.act;
    p.g_negw = (bf16_t*)p.p1;
    p.g_qg = p.g_negw + (size_t)NCU * 8192;
    p.g_kdT = (bf16_t*)p.qr;
    p.g_aqk = (bf16_t*)p.iq;
    if ((size_t)(w - (char*)d_ws) > ws_size) { fprintf(stderr, "kernel_launch: workspace too small (%zu needed, %zu given)\n", (size_t)(w - (char*)d_ws), ws_size); return; }
#if MEGA
    static int grid = 0;
    if (grid == 0) {
        int dev = 0, cus = 0;
        if (hipGetDevice(&dev) != hipSuccess || hipDeviceGetAttribute(&cus, hipDeviceAttributeMultiprocessorCount, dev) != hipSuccess || cus <= 0) cus = 256;
        (void)hipFuncSetAttribute((const void*)k_mega, hipFuncAttributeMaxDynamicSharedMemorySize, LDS_BYTES);
        grid = cus;
    }
    (void)hipMemsetAsync(p.bar, 0, 16384, stream);
    hipLaunchKernelGGL(k_mega, dim3(grid), dim3(NTHR), LDS_BYTES, stream, p);
#else
    launch_all<0>(p, stream);
#endif
}
```

```cpp
#include <hip/hip_runtime.h>
#include <stdint.h>
#include <stdio.h>

#ifndef MEGA
#define MEGA 1
#endif

namespace {

typedef unsigned short bf16_t;
typedef short bf16x8 __attribute__((ext_vector_type(8)));
typedef float f32x4 __attribute__((ext_vector_type(4)));

constexpr int D = 1024, BATCH = 4, SEQ = 4096, NMETA = 16, LP = SEQ + NMETA;
constexpr int DB = 128, DS = 4, PAST = 2048;
constexpr int NPR = BATCH * LP;
constexpr int NSR = DB * DS;
constexpr int NT = NPR + NSR;
constexpr int MPAD = 17152;
constexpr int DFF = 4096;
constexpr int GIN = 6176, GIN_PAD = 6400;
constexpr int DIN = 2120, DIN_PAD = 2304;
constexpr int NTHR = 512;
constexpr int LPAD = 4160;
constexpr int LDS_BYTES = 150 * 1024;
constexpr float ALPHA = 1.4142135623730951f;

struct Params {
    const float *x_prompt, *x_sample, *state_gdn, *state_conv, *cache_k, *cache_v, *cache_ik;
    const int* page_table;
    const float *meta, *ln1_g, *ln1_b, *ln2_g, *ln2_b, *mlp_w1, *mlp_w2, *gdn_w_in, *gdn_conv_w, *gdn_a_log, *gdn_dt_bias,
        *gdn_norm_w, *gdn_w_out, *dsa_w_in, *dsa_ik_g, *dsa_ik_b, *dsa_w_o;
    float *y_prompt, *y_sample, *gs_prompt, *gc_prompt, *gs_sample, *gc_sample, *k_prompt, *v_prompt, *ik_prompt, *k_sample,
        *v_sample, *ik_sample;
    unsigned* bar;
    bf16_t *wt_gin, *wt_gout, *wt_w1, *wt_w2, *wt_din, *wt_do;
    bf16_t *hA, *hB;
    float* preln;
    bf16_t *mixed, *z;
    float* ba;
    bf16_t *gated, *act;
    float *p1, *qr, *iq, *iw;
    int* sel;
    bf16_t *g_negw, *g_qg, *g_kdT, *g_aqk;
    float *g_u, *g_dec;
    bf16_t* g_o;
    float* rope_tab;
    float* slab;
    bf16_t *q_b, *k_b, *vt_b, *iq_b, *ik_b;
    unsigned long long* maskT;
};

__device__ const double kInvFreq[16] = {1.0, 0.44036660267178046, 0.19392274474868576, 0.08539710028576561,
    0.03760603093086393, 0.016560440080994446, 0.007292664737217109, 0.003211445994752591, 0.001414213562373095,
    0.000622772421914596, 0.0002742481756762073, 0.00012076973741146504, 5.318295896944988e-05, 2.341999896140934e-05,
    1.031338537721246e-05, 4.5416704806078695e-06};

__device__ __forceinline__ float bf2f(bf16_t h) { return __uint_as_float(((unsigned)h) << 16); }
typedef __bf16 hwbf16x2 __attribute__((ext_vector_type(2)));
typedef float f32x2 __attribute__((ext_vector_type(2)));
typedef float f32x16 __attribute__((ext_vector_type(16)));
typedef unsigned u32x4 __attribute__((ext_vector_type(4)));
__device__ __forceinline__ unsigned pk2(float lo, float hi) {
    const f32x2 v = {lo, hi};
    return __builtin_bit_cast(unsigned, __builtin_convertvector(v, hwbf16x2));
}
__device__ __forceinline__ bf16_t f2bf(float f) { return (bf16_t)(pk2(f, 0.f) & 0xffffu); }
__device__ __forceinline__ void st_bf16x4(bf16_t* p, f32x4 v) {
    uint2 o; o.x = pk2(v[0], v[1]); o.y = pk2(v[2], v[3]);
    *(uint2*)p = o;
}
__device__ __forceinline__ f32x4 cvt_bf16x4(uint2 o) {
    f32x4 v; v[0] = __uint_as_float(o.x << 16); v[1] = __uint_as_float(o.x & 0xffff0000u);
    v[2] = __uint_as_float(o.y << 16); v[3] = __uint_as_float(o.y & 0xffff0000u);
    return v;
}
__device__ __forceinline__ f32x4 ld_bf16x4(const bf16_t* p) {
    uint2 o = *(const uint2*)p;
    f32x4 v; v[0] = __uint_as_float(o.x << 16); v[1] = __uint_as_float(o.x & 0xffff0000u);
    v[2] = __uint_as_float(o.y << 16); v[3] = __uint_as_float(o.y & 0xffff0000u);
    return v;
}
__device__ __forceinline__ float wave_sum(float v) {
#pragma unroll
    for (int o = 1; o < 64; o <<= 1) v += __shfl_xor(v, o);
    return v;
}
__device__ __forceinline__ float wave_max(float v) {
#pragma unroll
    for (int o = 1; o < 64; o <<= 1) v = fmaxf(v, __shfl_xor(v, o));
    return v;
}
__device__ __forceinline__ int wave_sum_i(int v) {
#pragma unroll
    for (int o = 1; o < 64; o <<= 1) v += __shfl_xor(v, o);
    return v;
}
__device__ __forceinline__ float silu(float x) { return x * __builtin_amdgcn_rcpf(1.f + __expf(-x)); }
__device__ __forceinline__ int tid_opaque() { int t = threadIdx.x; asm volatile("" : "+v"(t)); return t; }
__device__ __forceinline__ void lds_barrier() { asm volatile("s_waitcnt lgkmcnt(0)\n\ts_barrier" ::: "memory"); }
__device__ __forceinline__ void lds_fence() { asm volatile("s_waitcnt lgkmcnt(0)" ::: "memory"); }

__device__ __forceinline__ void transpose_convert(const float* __restrict__ W, int K, int N, int Npad, bf16_t* __restrict__ WT, float* tile,
                                  int bid, int nb) {
    const int tid = tid_opaque();
    const int tk = K / 64, tn = Npad / 64;
    for (int it = bid; it < tk * tn; it += nb) {
        const int kb = it / tn, nbk = it % tn, k0 = kb * 64, n0 = nbk * 64;
#pragma unroll
        for (int i = 0; i < 8; ++i) {
            const int r = (tid >> 6) + 8 * i, c = tid & 63, n = n0 + c;
            tile[r * 65 + c] = (n < N) ? W[(size_t)(k0 + r) * N + n] : 0.f;
        }
        __syncthreads();
        {
            const int rn = tid >> 3, c8 = (tid & 7) * 8;
            const float* tp = tile + c8 * 65 + rn;
            uint4 o;
            o.x = pk2(tp[0], tp[65]); o.y = pk2(tp[2 * 65], tp[3 * 65]); o.z = pk2(tp[4 * 65], tp[5 * 65]); o.w = pk2(tp[6 * 65], tp[7 * 65]);
            *(uint4*)(WT + (size_t)(n0 + rn) * K + k0 + c8) = o;
        }
        __syncthreads();
    }
}

__device__ __forceinline__ void phase_prologue(const Params& p, char* smem, int bid, int nb) {
    float* tile = (float*)smem;
    transpose_convert(p.gdn_w_in, D, GIN, GIN_PAD, p.wt_gin, tile, bid, nb);
    for (int idx = bid * NTHR + tid_opaque(); idx < LP * 24; idx += nb * NTHR) {
        const int pos = idx / 24, f = idx % 24;
        const int fi = (f < 16) ? f : (f - 16) * 2;
        const double rev = (double)pos * kInvFreq[fi] * 0.15915494309189535;
        const float r = (float)(rev - floor(rev));
        p.rope_tab[idx * 2] = __builtin_amdgcn_cosf(r);
        p.rope_tab[idx * 2 + 1] = __builtin_amdgcn_sinf(r);
    }
    for (int idx = bid * NTHR + tid_opaque(); idx < MPAD * 256; idx += nb * NTHR) {
        const int row = idx >> 8, c4 = (idx & 255) * 4;
        f32x4 v = {0.f, 0.f, 0.f, 0.f};
        if (row < NPR) {
            const int b = row / LP, t = row % LP;
            const float* src = (t < NMETA) ? (p.meta + (size_t)t * D) : (p.x_prompt + ((size_t)b * SEQ + (t - NMETA)) * D);
            v = *(const f32x4*)(src + c4);
        } else if (row < NT) {
            v = *(const f32x4*)(p.x_sample + (size_t)(row - NPR) * D + c4);
        }
        st_bf16x4(p.hA + (size_t)row * D + c4, v);
    }
}

template <class Epi>
__device__ __forceinline__ void gemm_phase(const bf16_t* __restrict__ A, int lda, const bf16_t* __restrict__ Bt, int K, int Mtiles, int Ntiles,
                           const Epi& epi, char* smem, int bid, int nb) {
    bf16_t* As = (bf16_t*)smem;
    bf16_t* Bs = As + 256 * 72;
    const int tid = tid_opaque(), lane = tid & 63, wave = tid >> 6;
    const int wm = wave >> 1, wn = wave & 1;
    const int fr = lane & 15, fq = lane >> 4;
    const int ntiles = Mtiles * Ntiles;
    const int nk = K / 64;
    for (int tile = bid; tile < ntiles; tile += nb) {
        const int tm = tile % Mtiles, tn = tile / Mtiles;
        const bf16_t* Ag = A + (size_t)tm * 256 * lda;
        const bf16_t* Bg = Bt + (size_t)tn * 128 * K;
        f32x4 acc[4][4];
#pragma unroll
        for (int i = 0; i < 4; ++i)
#pragma unroll
            for (int j = 0; j < 4; ++j) acc[i][j] = (f32x4){0.f, 0.f, 0.f, 0.f};
        const int c0 = tid, c1 = tid + 512, c2 = tid + 1024, c3 = tid + 1536;
        const bf16_t* ga0 = Ag + (size_t)(c0 >> 3) * lda + (c0 & 7) * 8;
        const bf16_t* ga1 = Ag + (size_t)(c1 >> 3) * lda + (c1 & 7) * 8;
        const bf16_t* ga2 = Ag + (size_t)(c2 >> 3) * lda + (c2 & 7) * 8;
        const bf16_t* ga3 = Ag + (size_t)(c3 >> 3) * lda + (c3 & 7) * 8;
        const bf16_t* gb0 = Bg + (size_t)(c0 >> 3) * K + (c0 & 7) * 8;
        const bf16_t* gb1 = Bg + (size_t)(c1 >> 3) * K + (c1 & 7) * 8;
        bf16_t* sa0 = As + (c0 >> 3) * 72 + (c0 & 7) * 8;
        bf16_t* sa1 = As + (c1 >> 3) * 72 + (c1 & 7) * 8;
        bf16_t* sa2 = As + (c2 >> 3) * 72 + (c2 & 7) * 8;
        bf16_t* sa3 = As + (c3 >> 3) * 72 + (c3 & 7) * 8;
        bf16_t* sb0 = Bs + (c0 >> 3) * 72 + (c0 & 7) * 8;
        bf16_t* sb1 = Bs + (c1 >> 3) * 72 + (c1 & 7) * 8;
        uint4 ra0 = *(const uint4*)ga0, ra1 = *(const uint4*)ga1, ra2 = *(const uint4*)ga2, ra3 = *(const uint4*)ga3;
        uint4 rb0 = *(const uint4*)gb0, rb1 = *(const uint4*)gb1;
        *(uint4*)sa0 = ra0; *(uint4*)sa1 = ra1; *(uint4*)sa2 = ra2; *(uint4*)sa3 = ra3; *(uint4*)sb0 = rb0; *(uint4*)sb1 = rb1;
        __syncthreads();
        for (int kt = 0; kt < nk; ++kt) {
            const bool more = (kt + 1 < nk);
            if (more) {
                const int k0 = (kt + 1) * 64;
                ra0 = *(const uint4*)(ga0 + k0); ra1 = *(const uint4*)(ga1 + k0); ra2 = *(const uint4*)(ga2 + k0); ra3 = *(const uint4*)(ga3 + k0);
                rb0 = *(const uint4*)(gb0 + k0); rb1 = *(const uint4*)(gb1 + k0);
            }
#pragma unroll
            for (int kk = 0; kk < 2; ++kk) {
                bf16x8 af[4], bfr[4];
#pragma unroll
                for (int i = 0; i < 4; ++i) af[i] = *(const bf16x8*)(As + (wm * 64 + i * 16 + fr) * 72 + kk * 32 + fq * 8);
#pragma unroll
                for (int j = 0; j < 4; ++j) bfr[j] = *(const bf16x8*)(Bs + (wn * 64 + j * 16 + fr) * 72 + kk * 32 + fq * 8);
#pragma unroll
                for (int i = 0; i < 4; ++i)
#pragma unroll
                    for (int j = 0; j < 4; ++j) acc[i][j] = __builtin_amdgcn_mfma_f32_16x16x32_bf16(bfr[j], af[i], acc[i][j], 0, 0, 0);
            }
            __syncthreads();
            if (more) {
                *(uint4*)sa0 = ra0; *(uint4*)sa1 = ra1; *(uint4*)sa2 = ra2; *(uint4*)sa3 = ra3; *(uint4*)sb0 = rb0; *(uint4*)sb1 = rb1;
                __syncthreads();
            }
        }
#pragma unroll
        for (int i = 0; i < 4; ++i)
#pragma unroll
            for (int j = 0; j < 4; ++j) {
                const int row = tm * 256 + wm * 64 + i * 16 + fr, col = tn * 128 + wn * 64 + j * 16 + fq * 4;
                epi(row, col, acc[i][j]);
            }
    }
}

namespace pg8 {
#define PG8_LAS __attribute__((address_space(3)))
constexpr int BM = 256, BK = 64, HALF = 128, HTB = HALF * BK * 2  , STAGE_BYTES = 8 * HTB, NXCD = 8, WGM = 16;
__device__ __forceinline__ int lds_byte(int r, int c) { const int st = (r >> 4) * 2 + (c >> 5), rr = r & 15, cc = c & 31, ob = rr * 64 + cc * 2; return st * 1024 + (ob ^ (((ob >> 9) & 1) << 5)); }
__device__ __forceinline__ void stage_rc(int b, int& R, int& C) { const int st = b / 1024, sb = b % 1024, swz = sb ^ (((sb >> 9) & 1) << 5); R = (st >> 1) * 16 + swz / 64; C = (st & 1) * 32 + (swz % 64) / 2; }
__device__ __forceinline__ int perm32(int rho) { const int n = rho >> 4, i = rho & 15; return 8 * (i >> 2) + 4 * n + (i & 3); }
struct Unit { int pm, pn, pk; };
struct Gemm { const bf16_t* A; const bf16_t* Bt; int K; int splits; };
struct StaticOrder {
    int nM, nN, nNr, pm0, nwg, G, c;
    __device__ void init(int nM_, int nNr_, int splits, int pm0_, int G_, int c_) { nM = nM_; nNr = nNr_; nN = nNr_ * splits; pm0 = pm0_; nwg = nM * nN; G = G_; c = c_; }
    __device__ bool next(int i, Unit& u) const {
        const long L = (long)i * G + c; if (L >= nwg) return false;
        int wgid = (int)L; { const int q = nwg / NXCD, r = nwg % NXCD, xcd = wgid % NXCD, off = wgid / NXCD; wgid = (xcd < r ? xcd * (q + 1) : r * (q + 1) + (xcd - r) * q) + off; }
        const int nig = WGM * nN, gid = wgid / nig, fm = gid * WGM, gsz = (nM - fm) < WGM ? (nM - fm) : WGM;
        const int pnv = (wgid % nig) / gsz;
        u.pm = pm0 + fm + ((wgid % nig) % gsz); u.pn = pnv % nNr; u.pk = pnv / nNr; return true;
    }
};
template <class Epi>
__device__ __forceinline__ void gemm_phase(PG8_LAS unsigned char* lds, const Gemm g, const StaticOrder& S, const Epi& E) {
    const int tid = tid_opaque(), wid = __builtin_amdgcn_readfirstlane(tid >> 6), lane = tid & 63, wr = wid >> 2, wc = wid & 3, fr = lane & 15, fq = lane >> 4;
    const int K = g.K, Kp = K / g.splits, nt = Kp / BK;
    unsigned voffA[2], voffB[2];
#pragma unroll
    for (int i = 0; i < 2; ++i) { int R, C; stage_rc(tid * 16 + i * 8192, R, C); const int Rb = (R & ~31) + perm32(R & 31);
        voffA[i] = (unsigned)(R * K + C) * 2u; voffB[i] = (unsigned)(Rb * K + C) * 2u; }
    const size_t kstep = (size_t)(BK * 2);
    const size_t hstep = (size_t)HALF * K * 2;
    const size_t tstep = 2 * hstep;
    const size_t pstep = (size_t)Kp * 2;
    const unsigned ldsw = (unsigned)wid * 1024u;
    const int aoff = lds_byte(wr * 64 + fr, fq * 8), boff = lds_byte(wc * 32 + fr, fq * 8);
#define PG8_SA(b, h) (((b) * 2 + (h)) * HTB)
#define PG8_SB(b, h) ((4 + (b) * 2 + (h)) * HTB)
#define PG8_STAGE(bufoff, gbase, voff) do { _Pragma("unroll") for (int _i = 0; _i < 2; ++_i) \
        __builtin_amdgcn_global_load_lds((const unsigned*)((const char*)(gbase) + (voff)[_i]), (PG8_LAS unsigned*)(lds + (bufoff) + ldsw + _i * 8192), 16, 0, 0); } while (0)
#define PG8_LDA(dst, b, h) do { _Pragma("unroll") for (int m = 0; m < 4; ++m) _Pragma("unroll") for (int k = 0; k < 2; ++k) dst[m][k] = *(const PG8_LAS bf16x8*)(lds + PG8_SA(b, h) + aoff + m * 2048 + k * 1024); } while (0)
#define PG8_LDB(dst, b, h) do { _Pragma("unroll") for (int n = 0; n < 2; ++n) _Pragma("unroll") for (int k = 0; k < 2; ++k) dst[n][k] = *(const PG8_LAS bf16x8*)(lds + PG8_SB(b, h) + boff + n * 2048 + k * 1024); } while (0)
#define PG8_MMA(ai, bj, At, Bt) do { __builtin_amdgcn_s_setprio(1); _Pragma("unroll") for (int m = 0; m < 4; ++m) _Pragma("unroll") for (int n = 0; n < 2; ++n) _Pragma("unroll") for (int k = 0; k < 2; ++k) \
        acc[ai][bj][m][n] = __builtin_amdgcn_mfma_f32_16x16x32_bf16(Bt[n][k], At[m][k], acc[ai][bj][m][n], 0, 0, 0); __builtin_amdgcn_s_setprio(0); } while (0)
#define PG8_WAIT_V(n) asm volatile("s_waitcnt vmcnt(" #n ")" ::: "memory")
#define PG8_WAIT_L(n) asm volatile("s_waitcnt lgkmcnt(" #n ")" ::: "memory")
#define PG8_BAR __builtin_amdgcn_s_barrier()
#define PG8_SCHED __builtin_amdgcn_sched_barrier(0)
    Unit cur, nxt; int ui = 0;
    if (!S.next(0, cur)) return;
    f32x4 acc[2][2][4][2];
#pragma unroll
    for (int a = 0; a < 2; ++a)
#pragma unroll
        for (int b = 0; b < 2; ++b)
#pragma unroll
            for (int m = 0; m < 4; ++m)
#pragma unroll
                for (int n = 0; n < 2; ++n) acc[a][b][m][n] = (f32x4){0.f, 0.f, 0.f, 0.f};
    bf16x8 At[4][2], B0[2][2], B1[2][2];
    const char* cA = (const char*)g.A + (size_t)cur.pm * tstep + (size_t)cur.pk * pstep; const char* cB = (const char*)g.Bt + (size_t)cur.pn * tstep + (size_t)cur.pk * pstep;
    PG8_STAGE(PG8_SB(0, 0), cB, voffB); PG8_STAGE(PG8_SA(0, 0), cA, voffA); PG8_STAGE(PG8_SB(0, 1), cB + hstep, voffB); PG8_STAGE(PG8_SA(0, 1), cA + hstep, voffA);
    if (wr == 1) PG8_BAR;
    PG8_WAIT_V(4); PG8_BAR;
    PG8_STAGE(PG8_SB(1, 0), cB + kstep, voffB); PG8_STAGE(PG8_SA(1, 0), cA + kstep, voffA); PG8_STAGE(PG8_SB(1, 1), cB + hstep + kstep, voffB);
    PG8_WAIT_V(6); PG8_BAR;
    for (;;) {
        const bool has_next = S.next(ui + 1, nxt);
        const char* nA = has_next ? (const char*)g.A + (size_t)nxt.pm * tstep + (size_t)nxt.pk * pstep : cA; const char* nB = has_next ? (const char*)g.Bt + (size_t)nxt.pn * tstep + (size_t)nxt.pk * pstep : cB;
        for (int t = 0; t < nt; t += 2) {
            const bool last = (t == nt - 2);
            const char* a1 = cA + (size_t)(t + 1) * kstep;
            const char* a2 = last ? nA : cA + (size_t)(t + 2) * kstep; const char* b2 = last ? nB : cB + (size_t)(t + 2) * kstep;
            const char* a3 = a2 + kstep; const char* b3 = b2 + kstep;
            PG8_LDB(B0, 0, 0); PG8_SCHED; PG8_LDA(At, 0, 0); PG8_STAGE(PG8_SA(1, 1), a1 + hstep, voffA);
            PG8_WAIT_L(8); PG8_BAR; PG8_WAIT_L(0); PG8_MMA(0, 0, At, B0); PG8_BAR; PG8_SCHED;
            PG8_LDB(B1, 0, 1); PG8_STAGE(PG8_SB(0, 0), b2, voffB);
            PG8_BAR; PG8_WAIT_L(0); PG8_MMA(0, 1, At, B1); PG8_BAR;
            PG8_LDA(At, 0, 1); PG8_STAGE(PG8_SA(0, 0), a2, voffA);
            PG8_BAR; PG8_WAIT_L(0); PG8_MMA(1, 0, At, B0); PG8_BAR; PG8_SCHED;
            PG8_STAGE(PG8_SB(0, 1), b2 + hstep, voffB);
            PG8_WAIT_V(6); PG8_BAR; PG8_MMA(1, 1, At, B1); PG8_BAR;
            PG8_LDB(B0, 1, 0); PG8_SCHED; PG8_LDA(At, 1, 0); PG8_STAGE(PG8_SA(0, 1), a2 + hstep, voffA);
            PG8_WAIT_L(8); PG8_BAR; PG8_WAIT_L(0); PG8_MMA(0, 0, At, B0); PG8_BAR; PG8_SCHED;
            PG8_LDB(B1, 1, 1); PG8_STAGE(PG8_SB(1, 0), b3, voffB);
            PG8_BAR; PG8_WAIT_L(0); PG8_MMA(0, 1, At, B1); PG8_BAR;
            PG8_LDA(At, 1, 1); PG8_STAGE(PG8_SA(1, 0), a3, voffA);
            PG8_BAR; PG8_WAIT_L(0); PG8_MMA(1, 0, At, B0); PG8_BAR; PG8_SCHED;
            PG8_STAGE(PG8_SB(1, 1), b3 + hstep, voffB);
            PG8_WAIT_V(6); PG8_BAR; PG8_MMA(1, 1, At, B1); PG8_BAR;
        }
#pragma unroll
        for (int ai = 0; ai < 2; ++ai)
#pragma unroll
            for (int m = 0; m < 4; ++m)
#pragma unroll
                for (int bj = 0; bj < 2; ++bj)
                    E(cur.pm * BM + ai * HALF + wr * 64 + m * 16 + fr, cur.pn * BM + bj * HALF + wc * 32 + 8 * fq, acc[ai][bj][m][0], acc[ai][bj][m][1], cur.pk);
        if (!has_next) break;
#pragma unroll
        for (int a = 0; a < 2; ++a)
#pragma unroll
            for (int b = 0; b < 2; ++b)
#pragma unroll
                for (int m = 0; m < 4; ++m)
#pragma unroll
                    for (int n = 0; n < 2; ++n) acc[a][b][m][n] = (f32x4){0.f, 0.f, 0.f, 0.f};
        cur = nxt; cA = nA; cB = nB; ++ui;
    }
    PG8_WAIT_V(0);
    if (wr == 0) PG8_BAR;
    PG8_BAR;
#undef PG8_SA
#undef PG8_SB
#undef PG8_STAGE
#undef PG8_LDA
#undef PG8_LDB
#undef PG8_MMA
#undef PG8_WAIT_V
#undef PG8_WAIT_L
#undef PG8_BAR
#undef PG8_SCHED
}
}

template <class Epi>
__device__ __forceinline__ void gemm_big(const bf16_t* A, int K, const bf16_t* Bt, int Npad, const Epi& e, char* smem, int bid, int nb) {
    pg8::StaticOrder S; S.init(MPAD / 256, Npad / 256, 1, 0, nb, bid);
    pg8::gemm_phase((PG8_LAS unsigned char*)smem, pg8::Gemm{A, Bt, K, 1}, S, e);
}
template <class Epi1, class Epi2>
__device__ __forceinline__ void gemm_n1024(const bf16_t* A, int K, const bf16_t* Bt, const Epi1& e1, const Epi2& e2, int splits, char* smem, int bid, int nb) {
    pg8::StaticOrder S; S.init(64, 4, 1, 0, nb, bid);
    pg8::gemm_phase((PG8_LAS unsigned char*)smem, pg8::Gemm{A, Bt, K, 1}, S, e1);
    pg8::StaticOrder S2; S2.init(3, 4, splits, 64, nb, bid);
    pg8::gemm_phase((PG8_LAS unsigned char*)smem, pg8::Gemm{A, Bt, K, splits}, S2, e2);
}

__device__ __forceinline__ void st_bf16x8(bf16_t* p, f32x4 a, f32x4 b) {
    u32x4 w; w[0] = pk2(a[0], a[1]); w[1] = pk2(a[2], a[3]); w[2] = pk2(b[0], b[1]); w[3] = pk2(b[2], b[3]);
    *(u32x4*)p = w;
}
struct EpiGdnIn {
    bf16_t *mixed, *z; float* ba;
    __device__ __forceinline__ void operator()(int row, int col, f32x4 v0, f32x4 v1, int = 0) const {
        if (col < 4096) st_bf16x8(mixed + (size_t)row * 4096 + col, v0, v1);
        else if (col < 6144) st_bf16x8(z + (size_t)row * 2048 + (col - 4096), v0, v1);
        else if (col < 6176) { *(f32x4*)(ba + (size_t)row * 32 + (col - 6144)) = v0; *(f32x4*)(ba + (size_t)row * 32 + (col - 6144) + 4) = v1; }
    }
};
struct EpiResid {
    float* out; const bf16_t* h;
    __device__ __forceinline__ void operator()(int row, int col, f32x4 v0, f32x4 v1, int = 0) const {
        const uint4 hr = *(const uint4*)(h + (size_t)row * D + col);
        const f32x4 r0 = cvt_bf16x4(make_uint2(hr.x, hr.y)), r1 = cvt_bf16x4(make_uint2(hr.z, hr.w));
        st_bf16x8((bf16_t*)out + (size_t)row * D + col, v0 + r0 * ALPHA, v1 + r1 * ALPHA);
    }
};
struct EpiSlab {
    float* slab;
    __device__ __forceinline__ void operator()(int row, int col, f32x4 v0, f32x4 v1, int pk) const {
        float* o = slab + ((size_t)pk * 768 + (row - 16384)) * D + col;
        *(f32x4*)o = v0; *(f32x4*)(o + 4) = v1;
    }
};
struct EpiRelu2 {
    bf16_t* act;
    __device__ __forceinline__ void operator()(int row, int col, f32x4 v0, f32x4 v1, int = 0) const {
#pragma unroll
        for (int e = 0; e < 4; ++e) { const float r = fmaxf(v0[e], 0.f); v0[e] = r * r; const float q = fmaxf(v1[e], 0.f); v1[e] = q * q; }
        st_bf16x8(act + (size_t)row * DFF + col, v0, v1);
    }
};
struct EpiBf16 {
    bf16_t* out; int ld;
    __device__ __forceinline__ void operator()(int row, int col, f32x4 v0, f32x4 v1, int = 0) const { st_bf16x8(out + (size_t)row * ld + col, v0, v1); }
};

__device__ __forceinline__ void ln_phase(const float* X, const float* __restrict__ g, const float* __restrict__ bta, bf16_t* Hout,
                         float* yp, float* ys, const float* slab, int splits, const bf16_t* hres, int bid, int nb) {
    const int tid_ = tid_opaque(); const int lane = tid_ & 63, wave = tid_ >> 6;
    f32x4 gv[4], bv[4];
#pragma unroll
    for (int j = 0; j < 4; ++j) { gv[j] = *(const f32x4*)(g + j * 256 + lane * 4); bv[j] = *(const f32x4*)(bta + j * 256 + lane * 4); }
    for (int row = bid * 8 + wave; row < NT; row += nb * 8) {
        f32x4 v[4]; float s = 0.f;
        if (row < 16384) {
#pragma unroll
            for (int j = 0; j < 4; ++j) v[j] = ld_bf16x4((const bf16_t*)X + (size_t)row * D + j * 256 + lane * 4);
        } else {
#pragma unroll
            for (int j = 0; j < 4; ++j) v[j] = ld_bf16x4(hres + (size_t)row * D + j * 256 + lane * 4) * ALPHA;
            for (int pk = 0; pk < splits; ++pk) {
                const float* sp = slab + ((size_t)pk * 768 + (row - 16384)) * D + lane * 4;
#pragma unroll
                for (int j = 0; j < 4; ++j) v[j] += *(const f32x4*)(sp + j * 256);
            }
        }
#pragma unroll
        for (int j = 0; j < 4; ++j) s += (v[j][0] + v[j][1]) + (v[j][2] + v[j][3]);
        const float mean = wave_sum(s) * (1.f / D);
        float s2 = 0.f;
#pragma unroll
        for (int j = 0; j < 4; ++j) { v[j] = v[j] - mean; s2 += (v[j][0] * v[j][0] + v[j][1] * v[j][1]) + (v[j][2] * v[j][2] + v[j][3] * v[j][3]); }
        const float rstd = rsqrtf(wave_sum(s2) * (1.f / D) + 1e-5f);
        float* yo = nullptr;
        if (yp) {
            if (row < NPR) { const int b = row / LP, t = row % LP; if (t >= NMETA) yo = yp + ((size_t)b * SEQ + (t - NMETA)) * D; }
            else yo = ys + (size_t)(row - NPR) * D;
        }
#pragma unroll
        for (int j = 0; j < 4; ++j) {
            const f32x4 o = v[j] * rstd * gv[j] + bv[j];
            if (Hout) st_bf16x4(Hout + (size_t)row * D + j * 256 + lane * 4, o);
            if (yo) *(f32x4*)(yo + j * 256 + lane * 4) = o;
        }
    }
}

__device__ __forceinline__ void gdn_sample_pass(const Params& p, char* smem, int pass, int tid) {
    float* sq = (float*)smem;
    float* sk = sq + 256;
    float* part = sk + 256;
    float* part2 = part + 16;
    const int lane = tid & 63, wave = tid >> 6, ug = wave >> 2, wq = wave & 3;
    const int half = lane >> 5, v = wq * 32 + (lane & 31);
    const int u = pass * 2 + ug, b = u >> 4, h = u & 15, kh = h >> 1;
    const size_t row0 = (size_t)NPR + (size_t)b * DS;
    float S[64];
    {
        const float* Sp = p.state_gdn + ((size_t)(b * 16 + h) * 128 + half * 64) * 128 + v;
#pragma unroll
        for (int k = 0; k < 64; ++k) S[k] = Sp[(size_t)k * 128];
    }
    const float Aexp = __expf(p.gdn_a_log[h]);
    const float dtb = p.gdn_dt_bias[h];
    const float nw = p.gdn_norm_w[v];
    const int chA = (half ? 1024 : 0) + kh * 128 + v, chv = 2048 + h * 128 + v;
    float cA[4], cv[4];
#pragma unroll
    for (int j = 0; j < 4; ++j) { cA[j] = p.gdn_conv_w[j * 4096 + chA]; cv[j] = p.gdn_conv_w[j * 4096 + chv]; }
    float xA[7], xv[7];
#pragma unroll
    for (int i = 0; i < 3; ++i) {
        const float* cs = p.state_conv + ((size_t)b * 3 + i) * 4096;
        xA[i] = cs[chA]; xv[i] = cs[chv];
    }
#pragma unroll
    for (int i = 0; i < 4; ++i) {
        const bf16_t* mr = p.mixed + (row0 + i) * 4096;
        xA[3 + i] = bf2f(mr[chA]); xv[3 + i] = bf2f(mr[chv]);
    }
    float* sqg = sq + ug * 128;
    float* skg = sk + ug * 128;
    float* pg = part + ug * 8;
    float* pg2 = part2 + ug * 4;
    const float* kmine = skg + half * 64;
    const float* qmine = sqg + half * 64;
#pragma unroll
    for (int t = 0; t < DS; ++t) {
        const float yA = silu(xA[t] * cA[0] + xA[t + 1] * cA[1] + xA[t + 2] * cA[2] + xA[t + 3] * cA[3]);
        const float yv = silu(xv[t] * cv[0] + xv[t + 1] * cv[1] + xv[t + 2] * cv[2] + xv[t + 3] * cv[3]);
        (half ? skg : sqg)[v] = yA;
        float ssA = yA * yA;
#pragma unroll
        for (int o = 1; o < 32; o <<= 1) ssA += __shfl_xor(ssA, o);
        if ((lane & 31) == 0) pg[wq * 2 + half] = ssA;
        lds_barrier();
        const float qn = rsqrtf((pg[0] + pg[2]) + (pg[4] + pg[6]) + 1e-6f) * 0.08838834764831845f;
        const float kn = rsqrtf((pg[1] + pg[3]) + (pg[5] + pg[7]) + 1e-6f);
        const float* bap = p.ba + (row0 + t) * 32;
        const float beta = 1.f / (1.f + __expf(-bap[h]));
        const float aa = bap[16 + h] + dtb;
        const float sp = (aa > 20.f) ? aa : log1pf(__expf(aa));
        const float dec = __expf(-Aexp * sp);
        float kS0 = 0.f, kS1 = 0.f;
#pragma unroll
        for (int k = 0; k < 64; k += 4) {
            const f32x4 kk = *(const f32x4*)(kmine + k);
            S[k] *= dec; S[k + 1] *= dec; S[k + 2] *= dec; S[k + 3] *= dec;
            kS0 += kk[0] * S[k]; kS1 += kk[1] * S[k + 1]; kS0 += kk[2] * S[k + 2]; kS1 += kk[3] * S[k + 3];
        }
        float kS = kS0 + kS1;
        kS += __shfl_xor(kS, 32);
        const float delta = (yv - kS * kn) * beta * kn;
        float o0 = 0.f, o1 = 0.f;
#pragma unroll
        for (int k = 0; k < 64; k += 4) {
            const f32x4 kk = *(const f32x4*)(kmine + k);
            const f32x4 qq = *(const f32x4*)(qmine + k);
            S[k] += kk[0] * delta; S[k + 1] += kk[1] * delta; S[k + 2] += kk[2] * delta; S[k + 3] += kk[3] * delta;
            o0 += qq[0] * S[k]; o1 += qq[1] * S[k + 1]; o0 += qq[2] * S[k + 2]; o1 += qq[3] * S[k + 3];
        }
        float o = o0 + o1;
        o = (o + __shfl_xor(o, 32)) * qn;
        float s3 = o * o;
#pragma unroll
        for (int x = 1; x < 32; x <<= 1) s3 += __shfl_xor(s3, x);
        if (lane == 0) pg2[wq] = s3;
        lds_barrier();
        if (half == 0) {
            const float rms = rsqrtf(((pg2[0] + pg2[1]) + (pg2[2] + pg2[3])) * (1.f / 128.f) + 1e-6f);
            const float zz = bf2f(p.z[(row0 + t) * 2048 + h * 128 + v]);
            p.gated[(row0 + t) * 2048 + h * 128 + v] = f2bf(o * rms * nw * silu(zz));
        }
    }
    {
        float* So = p.gs_sample + ((size_t)(b * 16 + h) * 128 + half * 64) * 128 + v;
#pragma unroll
        for (int k = 0; k < 64; ++k) So[(size_t)k * 128] = S[k];
    }
    lds_barrier();
}

#define MFMA32(a, b, c) __builtin_amdgcn_mfma_f32_32x32x16_bf16((a), (b), (c), 0, 0, 0)
constexpr int NCH = 65;
constexpr int NCU = BATCH * 16 * NCH;
__device__ __forceinline__ int crow(int reg, int hh) { return (reg & 3) + 8 * (reg >> 2) + 4 * hh; }
__device__ __forceinline__ bf16x8 pack_step(const f32x16& x, int s) {
    u32x4 q;
    q[0] = pk2(x[8 * s + 0], x[8 * s + 1]); q[1] = pk2(x[8 * s + 2], x[8 * s + 3]);
    q[2] = pk2(x[8 * s + 4], x[8 * s + 5]); q[3] = pk2(x[8 * s + 6], x[8 * s + 7]);
    return __builtin_bit_cast(bf16x8, q);
}
__device__ __forceinline__ bf16x8 frag_perm(const bf16_t* p0) {
    const uint2 lo = *(const uint2*)p0, hi = *(const uint2*)(p0 + 8);
    u32x4 q; q[0] = lo.x; q[1] = lo.y; q[2] = hi.x; q[3] = hi.y;
    return __builtin_bit_cast(bf16x8, q);
}

constexpr int SA_KB = 64 * 136 * 2, SA_VB = 2 * SA_KB, SA_AM = 3 * SA_KB, SA_SM = SA_AM + 64 * 68 * 4, SA_GROUP_BYTES = SA_SM + 5 * 64 * 4;
__device__ __forceinline__ void gdn_stageA(const Params& p, char* smem0, int bid, int nb) {
    {
        const int tid = tid_opaque();
        for (int idx = bid * NTHR + tid; idx < (BATCH + DB) * 3 * 4096; idx += nb * NTHR) {
            const int c = idx & 4095, r = (idx >> 12) % 3, b = idx / (3 * 4096);
            if (b < BATCH) p.gc_prompt[idx] = bf2f(p.mixed[((size_t)b * LP + (LP - 3) + r) * 4096 + c]);
            else { const int bs = b - BATCH; p.gc_sample[(size_t)(bs * 3 + r) * 4096 + c] = bf2f(p.mixed[((size_t)NPR + bs * 4 + 1 + r) * 4096 + c]); }
        }
    }
    for (int base = bid * 2; base < NCU; base += nb * 2) {
        const int tid = tid_opaque(), lane = tid & 63, grp = tid >> 8, wg = (tid >> 6) & 3, t2 = tid & 255;
        unsigned zofs = 0; asm volatile("" : "+v"(zofs));
        char* smem = smem0 + zofs + grp * SA_GROUP_BYTES;
        bf16_t* Qb = (bf16_t*)smem;
        bf16_t* Kb = (bf16_t*)(smem + SA_KB);
        bf16_t* Vb = (bf16_t*)(smem + SA_VB);
        float* Am = (float*)(smem + SA_AM);
        float* sbeta = (float*)(smem + SA_SM);
        float* sgc = sbeta + 64;
        float* segc = sgc + 64;
        float* sekd = segc + 64;
        float* srk = sekd + 64;
        const int u = base + grp;
        const bool tail = base >= 4096;
        const int h = u & 15, n = tail ? 64 : ((u >> 4) & 63), b = tail ? ((u - 4096) >> 4) : (u >> 10);
        const int kh = h >> 1;
        const size_t su = (size_t)((b * 16 + h) * NCH + n);
        const int t0 = n * 64;
        if (tail && wg > 0) {
            const int cq = lane & 31, tsel = lane >> 5;
            const int tl0 = 16 * wg + 8 * tsel;
#pragma unroll
            for (int i = 0; i < 8; ++i) {
                *(uint2*)(Qb + (tl0 + i) * 136 + cq * 4) = make_uint2(0u, 0u);
                *(uint2*)(Kb + (tl0 + i) * 136 + cq * 4) = make_uint2(0u, 0u);
                *(uint2*)(Vb + (tl0 + i) * 136 + cq * 4) = make_uint2(0u, 0u);
            }
        } else {
            const int cq = lane & 31, tsel = lane >> 5;
            const int tl0 = 16 * wg + 8 * tsel;
#pragma unroll
            for (int pp = 0; pp < 2; ++pp) {
                const int part = pp ? 2 : grp;
                const int chb = ((part == 0) ? (kh * 128) : (part == 1) ? (1024 + kh * 128) : (2048 + h * 128)) + cq * 4;
                f32x4 cw[4];
#pragma unroll
                for (int j = 0; j < 4; ++j) cw[j] = *(const f32x4*)(p.gdn_conv_w + j * 4096 + chb);
                uint2 xr[11];
#pragma unroll
                for (int i = 0; i < 11; ++i) {
                    const int t = t0 + tl0 - 3 + i;
                    if (t >= 0 && t < LP) xr[i] = *(const uint2*)(p.mixed + ((size_t)b * LP + t) * 4096 + chb);
                    else xr[i] = make_uint2(0u, 0u);
                }
                f32x4 yv[8];
                float ssv[8];
#pragma unroll
                for (int i = 0; i < 8; ++i) {
                    const f32x4 a = cvt_bf16x4(xr[i]) * cw[0] + cvt_bf16x4(xr[i + 1]) * cw[1] + cvt_bf16x4(xr[i + 2]) * cw[2] + cvt_bf16x4(xr[i + 3]) * cw[3];
                    const bool valid = (t0 + tl0 + i) < LP;
#pragma unroll
                    for (int e2 = 0; e2 < 4; ++e2) yv[i][e2] = valid ? silu(a[e2]) : 0.f;
                    ssv[i] = (yv[i][0] * yv[i][0] + yv[i][1] * yv[i][1]) + (yv[i][2] * yv[i][2] + yv[i][3] * yv[i][3]);
                }
                if (part < 2) {
#pragma unroll
                    for (int o = 1; o < 32; o <<= 1)
#pragma unroll
                        for (int i = 0; i < 8; ++i) ssv[i] += __shfl_xor(ssv[i], o);
                }
                bf16_t* dst = (part == 0) ? Qb : (part == 1) ? Kb : Vb;
                bf16_t* dst2 = (bf16_t*)((char*)dst + (grp ? -SA_GROUP_BYTES : SA_GROUP_BYTES));
#pragma unroll
                for (int i = 0; i < 8; ++i) {
                    f32x4 y = yv[i];
                    if (part < 2) y = y * (rsqrtf(ssv[i] + 1e-6f) * ((part == 0) ? 0.08838834764831845f : 1.f));
                    st_bf16x4(dst + (tl0 + i) * 136 + cq * 4, y);
                    if (part < 2) st_bf16x4(dst2 + (tl0 + i) * 136 + cq * 4, y);
                }
            }
        }
        if (wg == 0) {
            const int c = lane, t = t0 + c;
            float beta = 0.f, g = 0.f;
            if (t < LP) {
                const float* bap = p.ba + ((size_t)b * LP + t) * 32;
                beta = 1.f / (1.f + __expf(-bap[h]));
                const float aa = bap[16 + h] + p.gdn_dt_bias[h];
                const float sp = (aa > 20.f) ? aa : log1pf(__expf(aa));
                g = -__expf(p.gdn_a_log[h]) * sp;
            }
            float gc = g;
#pragma unroll
            for (int o = 1; o < 64; o <<= 1) { const float v = __shfl_up(gc, o); if (lane >= o) gc += v; }
            const float glast = __shfl(gc, 63);
            sbeta[c] = beta; sgc[c] = gc; segc[c] = __expf(gc); sekd[c] = __expf(glast - gc); srk[c] = beta * __expf(gc);
            if (lane == 0) p.g_dec[su] = __expf(glast);
        }
        lds_barrier();
        {
            const int ti = wg >> 1, tj = wg & 1;
            const int r = lane & 31, hh = lane >> 5;
            const int c = 32 * tj + r;
            const float gcc = sgc[c], bc = sbeta[c];
            f32x16 acck, accq;
#pragma unroll
            for (int i = 0; i < 16; ++i) { acck[i] = 0.f; accq[i] = 0.f; }
            {
                const bf16_t* Ap = Kb + (32 * ti + r) * 136 + 8 * hh;
                const bf16_t* Bk = Kb + (32 * tj + r) * 136 + 8 * hh;
                const bf16_t* Bq = Qb + (32 * tj + r) * 136 + 8 * hh;
#pragma unroll
                for (int ks = 0; ks < 8; ++ks) {
                    const bf16x8 a = *(const bf16x8*)(Ap + 16 * ks);
                    acck = MFMA32(a, *(const bf16x8*)(Bk + 16 * ks), acck);
                    accq = MFMA32(a, *(const bf16x8*)(Bq + 16 * ks), accq);
                }
            }
#pragma unroll
            for (int reg = 0; reg < 16; ++reg) {
                const int cp = 32 * ti + crow(reg, hh);
                const float dcy = __expf(fminf(gcc - sgc[cp], 0.f));
                Am[(c >> 1) * 136 + cp * 2 + (c & 1)] = (cp < c) ? (bc * acck[reg] * dcy) : 0.f;
            }
            {
                bf16_t* aq = p.g_aqk + su * 4096 + (size_t)(((ti * 2 + tj) * 4) * 2 * 32) * 4 + (size_t)(hh * 32 + r) * 4;
#pragma unroll
                for (int g4 = 0; g4 < 4; ++g4) {
                    const int cp0 = 32 * ti + 8 * g4 + 4 * hh;
                    f32x4 v;
#pragma unroll
                    for (int e2 = 0; e2 < 4; ++e2) {
                        const int cp = cp0 + e2;
                        const float dcy = __expf(fminf(gcc - sgc[cp], 0.f));
                        v[e2] = (cp <= c) ? (accq[4 * g4 + e2] * dcy) : 0.f;
                    }
                    st_bf16x4(aq + (size_t)g4 * (2 * 32 * 4), v);
                }
            }
        }
        {
#pragma unroll
            for (int it = 0; it < 4; ++it) {
                const int chk = t2 + 256 * it, c = chk >> 4, d0 = (chk & 15) * 8;
                const float ee = segc[c];
                const uint4 raw = *(const uint4*)(Qb + c * 136 + d0);
                uint4 o;
                o.x = pk2(__uint_as_float(raw.x << 16) * ee, __uint_as_float(raw.x & 0xffff0000u) * ee);
                o.y = pk2(__uint_as_float(raw.y << 16) * ee, __uint_as_float(raw.y & 0xffff0000u) * ee);
                o.z = pk2(__uint_as_float(raw.z << 16) * ee, __uint_as_float(raw.z & 0xffff0000u) * ee);
                o.w = pk2(__uint_as_float(raw.w << 16) * ee, __uint_as_float(raw.w & 0xffff0000u) * ee);
                *(uint4*)(p.g_qg + su * 8192 + c * 128 + d0) = o;
            }
#pragma unroll
            for (int it = 0; it < 4; ++it) {
                const int item = t2 + 256 * it, d = item & 127, c0 = (item >> 7) * 8;
                float v[8];
#pragma unroll
                for (int i = 0; i < 8; ++i) v[i] = bf2f(Kb[(c0 + i) * 136 + d]) * sekd[c0 + i];
                uint4 o; o.x = pk2(v[0], v[1]); o.y = pk2(v[2], v[3]); o.z = pk2(v[4], v[5]); o.w = pk2(v[6], v[7]);
                *(uint4*)(p.g_kdT + su * 8192 + (size_t)item * 8) = o;
            }
        }
        lds_barrier();
        {
            const int col = 64 * wg + lane;
            const float* rs = sbeta + __builtin_amdgcn_readfirstlane((wg < 2) ? 0 : 256);
            const bf16_t* src = ((wg < 2) ? Vb : Kb) + (col & 127);
            float x[64];
#pragma unroll
            for (int i = 0; i < 64; ++i) x[i] = bf2f(src[i * 136]) * rs[i];
#pragma unroll
            for (int i0 = 0; i0 < 64; i0 += 4) {
                if (tail && i0 >= 16) continue;
                f32x2 a01 = {x[i0], x[i0 + 1]}, a23 = {x[i0 + 2], x[i0 + 3]};
                const float* P0 = Am + (i0 >> 1) * 136;
                const float* P1 = P0 + 136;
#pragma unroll
                for (int j4 = 0; j4 < i0; j4 += 4) {
                    const f32x4 q0 = *(const f32x4*)(P0 + 2 * j4), q1 = *(const f32x4*)(P0 + 2 * j4 + 4);
                    const f32x4 q2 = *(const f32x4*)(P1 + 2 * j4), q3 = *(const f32x4*)(P1 + 2 * j4 + 4);
                    a01 -= (f32x2){q0[0], q0[1]} * x[j4]; a23 -= (f32x2){q2[0], q2[1]} * x[j4];
                    a01 -= (f32x2){q0[2], q0[3]} * x[j4 + 1]; a23 -= (f32x2){q2[2], q2[3]} * x[j4 + 1];
                    a01 -= (f32x2){q1[0], q1[1]} * x[j4 + 2]; a23 -= (f32x2){q3[0], q3[1]} * x[j4 + 2];
                    a01 -= (f32x2){q1[2], q1[3]} * x[j4 + 3]; a23 -= (f32x2){q3[2], q3[3]} * x[j4 + 3];
                    if ((j4 & 12) == 12) asm volatile("" ::: "memory");
                }
                const f32x4 l0 = *(const f32x4*)(P0 + 2 * i0), l1 = *(const f32x4*)(P1 + 2 * i0), l2 = *(const f32x4*)(P1 + 2 * i0 + 4);
                const float a0 = a01[0];
                const float a1 = a01[1] - l0[1] * a0;
                const float a2 = a23[0] - l1[0] * a0 - l1[2] * a1;
                const float a3 = a23[1] - l1[1] * a0 - l1[3] * a1 - l2[1] * a2;
                x[i0] = a0; x[i0 + 1] = a1; x[i0 + 2] = a2; x[i0 + 3] = a3;
                asm volatile("" ::: "memory");
            }
            if (wg < 2) {
                float* up = p.g_u + su * 8192 + col;
#pragma unroll
                for (int i = 0; i < 64; ++i) up[i * 128] = x[i];
            } else {
                bf16_t* wp = p.g_negw + su * 8192 + (col - 128);
#pragma unroll
                for (int i = 0; i < 64; ++i) wp[i * 128] = f2bf(-x[i]);
            }
        }
        lds_barrier();
    }
}

constexpr int GB_P1 = 136, GB_P2 = 72;
constexpr int GB_NW = 0, GB_QG = 64 * GB_P1, GB_KD = 2 * 64 * GB_P1, GB_AQ = 2 * 64 * GB_P1 + 128 * GB_P2, GB_ELEMS = 2 * 64 * GB_P1 + 128 * GB_P2 + 64 * GB_P2;
__device__ __forceinline__ void gdn_chain(const Params& p, char* smem, int b, int h) {
    bf16_t* lds = (bf16_t*)smem;
    const int tid = tid_opaque(), lane = tid & 63, wave = tid >> 6;
    const int r = lane & 31, hh = lane >> 5;
    const size_t su0 = (size_t)(b * 16 + h) * NCH;
    const bool loader = wave >= 4;
    const int t2 = tid - 256;
    uint4 sa0, sa1, sa2, sa3, sa4, sa5, sa6, sa7, sa8, sa9, sa10, sa11, sa12, sa13;
    uint4 sb0, sb1, sb2, sb3, sb4, sb5, sb6, sb7, sb8, sb9, sb10, sb11, sb12, sb13;
    f32x16 S[4], un0, un1;
#pragma unroll
    for (int i = 0; i < 4; ++i)
#pragma unroll
        for (int j = 0; j < 16; ++j) S[i][j] = 0.f;
    const int ch0 = t2, ch1 = t2 + 256, ch2 = t2 + 512, ch3 = t2 + 768;
#define GB_GLOAD(P, n_) do { const size_t su_ = su0 + (n_); \
        const bf16_t* a_ = p.g_negw + su_ * 8192; const bf16_t* b_ = p.g_qg + su_ * 8192; const bf16_t* c_ = p.g_kdT + su_ * 8192; const bf16_t* d_ = p.g_aqk + su_ * 4096; \
        P##0 = *(const uint4*)(a_ + (size_t)ch0 * 8); P##1 = *(const uint4*)(a_ + (size_t)ch1 * 8); P##2 = *(const uint4*)(a_ + (size_t)ch2 * 8); P##3 = *(const uint4*)(a_ + (size_t)ch3 * 8); \
        P##4 = *(const uint4*)(b_ + (size_t)ch0 * 8); P##5 = *(const uint4*)(b_ + (size_t)ch1 * 8); P##6 = *(const uint4*)(b_ + (size_t)ch2 * 8); P##7 = *(const uint4*)(b_ + (size_t)ch3 * 8); \
        P##8 = *(const uint4*)(c_ + (size_t)ch0 * 8); P##9 = *(const uint4*)(c_ + (size_t)ch1 * 8); P##10 = *(const uint4*)(c_ + (size_t)ch2 * 8); P##11 = *(const uint4*)(c_ + (size_t)ch3 * 8); \
        P##12 = *(const uint4*)(d_ + (size_t)ch0 * 8); P##13 = *(const uint4*)(d_ + (size_t)ch1 * 8); } while (0)
#define kperm16(k_) ((((k_)) & ~15) + 4 * ((((((k_)) >> 2) & 1) << 1) | ((((k_)) >> 3) & 1)) + (((k_)) & 3))
#define GB_ST16(row_, e8_, v_) do { bf16_t* d8_ = (row_) + ((e8_) & ~15) + (((e8_) >> 3) & 1) * 4; *(uint2*)d8_ = make_uint2((v_).x, (v_).y); *(uint2*)(d8_ + 8) = make_uint2((v_).z, (v_).w); } while (0)
#define GB_SSTORE(P, buf_) do { bf16_t* q_ = (buf_); \
        GB_ST16(q_ + GB_NW + (ch0 >> 4) * GB_P1, (ch0 & 15) * 8, P##0); GB_ST16(q_ + GB_NW + (ch1 >> 4) * GB_P1, (ch1 & 15) * 8, P##1); \
        GB_ST16(q_ + GB_NW + (ch2 >> 4) * GB_P1, (ch2 & 15) * 8, P##2); GB_ST16(q_ + GB_NW + (ch3 >> 4) * GB_P1, (ch3 & 15) * 8, P##3); \
        GB_ST16(q_ + GB_QG + (ch0 >> 4) * GB_P1, (ch0 & 15) * 8, P##4); GB_ST16(q_ + GB_QG + (ch1 >> 4) * GB_P1, (ch1 & 15) * 8, P##5); \
        GB_ST16(q_ + GB_QG + (ch2 >> 4) * GB_P1, (ch2 & 15) * 8, P##6); GB_ST16(q_ + GB_QG + (ch3 >> 4) * GB_P1, (ch3 & 15) * 8, P##7); \
        GB_ST16(q_ + GB_KD + (ch0 & 127) * GB_P2, (ch0 >> 7) * 8, P##8); GB_ST16(q_ + GB_KD + (ch1 & 127) * GB_P2, (ch1 >> 7) * 8, P##9); \
        GB_ST16(q_ + GB_KD + (ch2 & 127) * GB_P2, (ch2 >> 7) * 8, P##10); GB_ST16(q_ + GB_KD + (ch3 & 127) * GB_P2, (ch3 >> 7) * 8, P##11); \
        GB_AQ_ST(q_, ch0, P##12); GB_AQ_ST(q_, ch1, P##13); } while (0)
#define GB_AQ_ST(q_, ch_, v_) do { const int pq_ = 2 * (ch_), r_ = pq_ & 31, hh_ = (pq_ >> 5) & 1, g4_ = (pq_ >> 6) & 3, tl_ = pq_ >> 8; \
        bf16_t* d_ = (q_) + GB_AQ + (32 * (tl_ & 1) + r_) * GB_P2 + kperm16(32 * (tl_ >> 1) + 8 * g4_ + 4 * hh_); \
        *(uint2*)d_ = make_uint2((v_).x, (v_).y); *(uint2*)(d_ + GB_P2) = make_uint2((v_).z, (v_).w); } while (0)
#define GB_ULOAD(n_) do { const float* up_ = p.g_u + (su0 + (n_)) * 8192 + 32 * wave + r; \
        _Pragma("unroll") for (int reg_ = 0; reg_ < 16; ++reg_) { un0[reg_] = up_[(crow(reg_, hh)) * 128]; un1[reg_] = up_[(32 + crow(reg_, hh)) * 128]; } } while (0)
    if (loader) {
        bf16_t* buf0 = lds;
        bf16_t* buf1 = lds + GB_ELEMS;
        GB_GLOAD(sa, 0); GB_SSTORE(sa, buf0);
        GB_GLOAD(sa, 1);
        lds_barrier();
        for (int n = 0; n < NCH; n += 2) {
            if (n + 2 < NCH) { GB_GLOAD(sb, n + 2); }
            if (n + 1 < NCH) { GB_SSTORE(sa, buf1); }
            lds_barrier();
            if (n + 1 >= NCH) break;
            if (n + 3 < NCH) { GB_GLOAD(sa, n + 3); }
            if (n + 2 < NCH) { GB_SSTORE(sb, buf0); }
            lds_barrier();
        }
    } else {
        GB_ULOAD(0);
        float dec_next = p.g_dec[su0];
        lds_barrier();
        for (int n = 0; n < NCH; ++n) {
            unsigned zofs = 0; asm volatile("" : "+v"(zofs));
            bf16_t* cur = lds + (n & 1) * GB_ELEMS + zofs;
            const bool more = (n + 1 < NCH);
            const float dec = dec_next;
            if (more) dec_next = p.g_dec[su0 + n + 1];
            f32x16 vn[2], o[2];
            vn[0] = un0; vn[1] = un1;
#pragma unroll
            for (int j = 0; j < 16; ++j) { o[0][j] = 0.f; o[1][j] = 0.f; }
            if (more) { GB_ULOAD(n + 1); }
#pragma unroll
            for (int kt = 0; kt < 4; ++kt)
#pragma unroll
                for (int s = 0; s < 2; ++s) {
                    const bf16x8 sb = pack_step(S[kt], s);
                    const int k0 = 32 * kt + 16 * s + 8 * hh;
#pragma unroll
                    for (int ct = 0; ct < 2; ++ct) {
                        vn[ct] = MFMA32(*(const bf16x8*)(cur + GB_NW + (32 * ct + r) * GB_P1 + k0), sb, vn[ct]);
                        o[ct] = MFMA32(*(const bf16x8*)(cur + GB_QG + (32 * ct + r) * GB_P1 + k0), sb, o[ct]);
                    }
                }
            bf16x8 vb[2][2];
#pragma unroll
            for (int ct = 0; ct < 2; ++ct)
#pragma unroll
                for (int s = 0; s < 2; ++s) vb[ct][s] = pack_step(vn[ct], s);
            {
                o[1] = MFMA32(*(const bf16x8*)(cur + GB_AQ + (32 + r) * GB_P2 + 8 * hh), vb[0][0], o[1]);
                o[0] = MFMA32(*(const bf16x8*)(cur + GB_AQ + (r) * GB_P2 + 8 * hh), vb[0][0], o[0]);
                o[1] = MFMA32(*(const bf16x8*)(cur + GB_AQ + (32 + r) * GB_P2 + 16 + 8 * hh), vb[0][1], o[1]);
                o[0] = MFMA32(*(const bf16x8*)(cur + GB_AQ + (r) * GB_P2 + 16 + 8 * hh), vb[0][1], o[0]);
                o[1] = MFMA32(*(const bf16x8*)(cur + GB_AQ + (32 + r) * GB_P2 + 32 + 8 * hh), vb[1][0], o[1]);
                o[1] = MFMA32(*(const bf16x8*)(cur + GB_AQ + (32 + r) * GB_P2 + 32 + 16 + 8 * hh), vb[1][1], o[1]);
            }
#pragma unroll
            for (int dt = 0; dt < 4; ++dt) S[dt] = S[dt] * dec;
#pragma unroll
            for (int ckt = 0; ckt < 2; ++ckt)
#pragma unroll
                for (int s = 0; s < 2; ++s)
#pragma unroll
                    for (int dt = 0; dt < 4; ++dt)
                        S[dt] = MFMA32(*(const bf16x8*)(cur + GB_KD + (32 * dt + r) * GB_P2 + 32 * ckt + 16 * s + 8 * hh), vb[ckt][s], S[dt]);
            asm volatile("" :: "v"(un0), "v"(un1), "v"(dec_next));
#pragma unroll
            for (int ct = 0; ct < 2; ++ct)
#pragma unroll
                for (int reg = 0; reg < 16; ++reg) {
                    const int t = 64 * n + 32 * ct + crow(reg, hh);
                    if (t < LP) p.g_o[(((size_t)b * LP + t) * 16 + h) * 128 + 32 * wave + r] = f2bf(o[ct][reg]);
                }
            lds_barrier();
        }
    }
    if (!loader) {
#pragma unroll
        for (int dt = 0; dt < 4; ++dt)
#pragma unroll
            for (int reg = 0; reg < 16; ++reg)
                p.gs_prompt[((size_t)(b * 16 + h) * 128 + 32 * dt + crow(reg, hh)) * 128 + 32 * wave + r] = S[dt][reg];
    }
    lds_barrier();
}

__device__ __forceinline__ void gdn_seq_phase(const Params& p, char* smem, int bid, int nb, int rep = 0) {
    if (bid < 64) gdn_chain(p, smem, bid >> 4, bid & 15);
    else {
        float* tile = (float*)smem;
        const int b2 = bid - 64, n2 = nb - 64;
        transpose_convert(p.gdn_w_out, 2048, D, D, p.wt_gout, tile, b2, n2);
        transpose_convert(p.mlp_w1, D, DFF, DFF, p.wt_w1, tile, b2, n2);
        transpose_convert(p.mlp_w1 + (size_t)D * DFF, D, DFF, DFF, p.wt_w1 + (size_t)D * DFF, tile, b2, n2);
        transpose_convert(p.mlp_w2, DFF, D, D, p.wt_w2, tile, b2, n2);
        transpose_convert(p.mlp_w2 + (size_t)D * DFF, DFF, D, D, p.wt_w2 + (size_t)D * DFF, tile, b2, n2);
        transpose_convert(p.dsa_w_in, D, DIN, DIN_PAD, p.wt_din, tile, b2, n2);
        transpose_convert(p.dsa_w_o, D, D, D, p.wt_do, tile, b2, n2);
    }
    int* slot = (int*)(smem + LDS_BYTES - 32);
    const int tid = tid_opaque();
    for (;;) {
        if (threadIdx.x == 0) *slot = (int)atomicAdd(p.bar + 3520 + 16 * rep, 1u);
        lds_barrier();
        const int u = *slot;
        lds_barrier();
        if (u >= DB * 16 / 2) break;
        gdn_sample_pass(p, smem, u, tid_opaque());
    }
}

__device__ __forceinline__ void gdn_gate_phase(const Params& p, int bid, int nb) {
    const int tid_ = tid_opaque(); const int lane = tid_ & 63, wave = tid_ >> 6;
    const int sub = lane >> 4, l16 = lane & 15;
    f32x4 nw0 = *(const f32x4*)(p.gdn_norm_w + l16 * 8), nw1 = *(const f32x4*)(p.gdn_norm_w + l16 * 8 + 4);
    for (int it4 = bid * 8 + wave; it4 < NPR * 4; it4 += nb * 8) {
        const size_t off = ((size_t)it4 * 4 + sub) * 128 + l16 * 8;
        const uint4 ov = *(const uint4*)(p.g_o + off);
        const uint4 zv = *(const uint4*)(p.z + off);
        const f32x4 o0 = cvt_bf16x4(make_uint2(ov.x, ov.y)), o1 = cvt_bf16x4(make_uint2(ov.z, ov.w));
        const f32x4 z0 = cvt_bf16x4(make_uint2(zv.x, zv.y)), z1 = cvt_bf16x4(make_uint2(zv.z, zv.w));
        float ss = ((o0[0] * o0[0] + o0[1] * o0[1]) + (o0[2] * o0[2] + o0[3] * o0[3])) + ((o1[0] * o1[0] + o1[1] * o1[1]) + (o1[2] * o1[2] + o1[3] * o1[3]));
#pragma unroll
        for (int x = 1; x < 16; x <<= 1) ss += __shfl_xor(ss, x);
        const float rms = rsqrtf(ss * (1.f / 128.f) + 1e-6f);
        uint4 g;
        g.x = pk2(o0[0] * rms * nw0[0] * silu(z0[0]), o0[1] * rms * nw0[1] * silu(z0[1]));
        g.y = pk2(o0[2] * rms * nw0[2] * silu(z0[2]), o0[3] * rms * nw0[3] * silu(z0[3]));
        g.z = pk2(o1[0] * rms * nw1[0] * silu(z1[0]), o1[1] * rms * nw1[1] * silu(z1[1]));
        g.w = pk2(o1[2] * rms * nw1[2] * silu(z1[2]), o1[3] * rms * nw1[3] * silu(z1[3]));
        *(uint4*)(p.gated + off) = g;
    }
}

__device__ __forceinline__ size_t ikb_off(int b, int t, int d) {
    return (size_t)b * LPAD * 64 + (size_t)(t >> 5) * 2048 + (size_t)(d >> 4) * 512 + (size_t)((((d >> 3) & 1) * 32 + (t & 31)) * 8 + (d & 7));
}
__device__ __forceinline__ size_t iqb_off(int b, int t, int head, int d) {
    const int g8 = t >> 3, rt = (t >> 2) & 1, qi = t & 3;
    const int rho = (head & 3) + 8 * (((qi & 1) << 1) | (head >> 2)) + 4 * (qi >> 1);
    return ((((size_t)b * 514 + g8) * 2 + rt) * 4 + (d >> 4)) * 512 + (size_t)((((d >> 3) & 1) * 32 + rho) * 8 + (d & 7));
}
__device__ __forceinline__ void rope4(const float* tab, int fi, f32x4 x, f32x4 partner, bool first, f32x4& o) {
    const f32x4 t0 = *(const f32x4*)(tab + fi * 2), t1 = *(const f32x4*)(tab + fi * 2 + 4);
    const float sg = first ? -1.f : 1.f;
    o[0] = x[0] * t0[0] + sg * partner[0] * t0[1];
    o[1] = x[1] * t0[2] + sg * partner[1] * t0[3];
    o[2] = x[2] * t1[0] + sg * partner[2] * t1[1];
    o[3] = x[3] * t1[2] + sg * partner[3] * t1[3];
}
__device__ __forceinline__ void dsa_post_phase(const Params& p, char* smem, int bid, int nb) {
    bf16_t* vt = (bf16_t*)smem;
    for (int u = bid; u < 260 + NSR / 8; u += nb) {
        const int tid = tid_opaque(); const int lane = tid & 63, wave = tid >> 6;
        const bool prompt = u < 260;
        const int b = prompt ? ((u < 256) ? (u >> 6) : (u - 256)) : 0, t0 = prompt ? ((u < 256) ? (u & 63) * 64 : 4096) : 0;
        const int nr8 = prompt ? 8 : 1;
        for (int r8 = 0; r8 < nr8; ++r8) {
            const int tl = wave * 8 + r8;
            const int tlp = (tl & ~12) | ((tl & 4) << 1) | ((tl & 8) >> 1);
            const int t = t0 + tl;
            const bool rvalid = prompt ? (t < LP) : true;
            const int row = prompt ? (b * LP + t) : (NPR + (u - 260) * 8 + wave);
            if (!rvalid) {
                for (int e = lane; e < 256; e += 64) vt[e * 72 + tlp] = 0;
                continue;
            }
            const bf16_t* P = (const bf16_t*)p.p1 + (size_t)row * DIN_PAD;
            const int pos = prompt ? t : (PAST + ((row - NPR) & 3));
            const float* tab = p.rope_tab + (size_t)pos * 48;
            float* kout = prompt ? (p.k_prompt + (size_t)row * 256) : (p.k_sample + (size_t)(row - NPR) * 256);
            float* vout = prompt ? (p.v_prompt + (size_t)row * 256) : (p.v_sample + (size_t)(row - NPR) * 256);
#pragma unroll
            for (int j = 0; j < 5; ++j) {
                const int e0 = (lane + 64 * j) * 4, d0 = e0 & 127;
                f32x4 x = ld_bf16x4(P + e0);
                if (d0 < 32) {
                    const bool first = d0 < 16;
                    const f32x4 pr = ld_bf16x4(P + (first ? e0 + 16 : e0 - 16));
                    rope4(tab, d0 & 15, x, pr, first, x);
                }
                if (j < 4) {
                    if (prompt) st_bf16x4(p.q_b + (size_t)row * 1024 + e0, x * 0.12751743f);
                    else *(f32x4*)(p.qr + (size_t)row * 1024 + e0) = x;
                } else {
                    const int ek = e0 - 1024;
                    *(f32x4*)(kout + ek) = x;
                    if (prompt) st_bf16x4(p.k_b + ((size_t)(b * 2 + (ek >> 7)) * LPAD + t) * 128 + d0, x);
                }
            }
            {
                const int e0 = lane * 4;
                const f32x4 x = ld_bf16x4(P + 1280 + e0);
                *(f32x4*)(vout + e0) = x;
                if (prompt) {
#pragma unroll
                    for (int i = 0; i < 4; ++i) vt[(e0 + i) * 72 + tlp] = f2bf(x[i]);
                }
            }
#pragma unroll
            for (int j = 0; j < 2; ++j) {
                const int e0 = (lane + 64 * j) * 4, d0 = e0 & 63;
                f32x4 x = ld_bf16x4(P + 1536 + e0);
                if (d0 < 16) {
                    const bool first = d0 < 8;
                    const f32x4 pr = ld_bf16x4(P + 1536 + (first ? e0 + 8 : e0 - 8));
                    rope4(tab, 16 + (d0 & 7), x, pr, first, x);
                }
                if (prompt) st_bf16x4(p.iq_b + iqb_off(b, t, e0 >> 6, d0), x);
                else *(f32x4*)(p.iq + (size_t)row * 512 + e0) = x;
            }
            {
                const float x = bf2f(P[2048 + lane]);
                const float mu = wave_sum(x) * (1.f / 64.f);
                const float dv = x - mu;
                const float var = wave_sum(dv * dv) * (1.f / 64.f);
                const float xn = dv * rsqrtf(var + 1e-5f) * p.dsa_ik_g[lane] + p.dsa_ik_b[lane];
                const float other = __shfl_xor(xn, 8);
                float o = xn;
                if (lane < 16) {
                    const float c = tab[(16 + (lane & 7)) * 2], s = tab[(16 + (lane & 7)) * 2 + 1];
                    if (lane < 8) o = xn * c - other * s; else o = xn * c + other * s;
                }
                float* io = prompt ? (p.ik_prompt + (size_t)row * 64) : (p.ik_sample + (size_t)(row - NPR) * 64);
                io[lane] = o;
                if (prompt) p.ik_b[ikb_off(b, t, lane)] = f2bf(o);
            }
            if (lane < 8) p.iw[(size_t)row * 8 + lane] = bf2f(P[2112 + lane]) * 0.35355339059327373f;
        }
        lds_barrier();
        if (prompt) {
#pragma unroll
            for (int i = 0; i < 4; ++i) {
                const int ch = tid + 512 * i, rr = ch >> 3, c8 = (ch & 7) * 8;
                const uint4 v = *(const uint4*)(vt + rr * 72 + c8);
                *(uint4*)(p.vt_b + ((size_t)(b * 2 + (rr >> 7)) * 128 + (rr & 127)) * LPAD + t0 + c8) = v;
            }
        }
        lds_barrier();
    }
    for (int idx = bid * NTHR + tid_opaque(); idx < BATCH * (LPAD - LP) * 256; idx += nb * NTHR) {
        const int c = idx & 255, tp = (idx >> 8) % (LPAD - LP), bb = idx / ((LPAD - LP) * 256);
        const int t = LP + tp, kvh = c >> 7, d = c & 127;
        p.k_b[((size_t)(bb * 2 + kvh) * LPAD + t) * 128 + d] = 0;
        if (c < 64) p.ik_b[ikb_off(bb, t, c)] = 0;
        if (c < 65) p.maskT[((size_t)bb * 65 + c) * LPAD + t] = (c == 0) ? 1ull : 0ull;
    }
}

__device__ __forceinline__ const float* ik_row(const Params& p, bool prompt, int b, int s) {
    if (prompt) return p.ik_prompt + ((size_t)b * LP + s) * 64;
    if (s < PAST) { const int pg = p.page_table[b * 16 + (s >> 7)]; return p.cache_ik + ((size_t)pg * 128 + (s & 127)) * 64; }
    return p.ik_sample + ((size_t)b * DS + (s - PAST)) * 64;
}
__device__ __forceinline__ const float* kv_row(const float* own_p, const float* own_s, const float* cache, const int* page_table,
                                               bool prompt, int b, int s) {
    if (prompt) return own_p + ((size_t)b * LP + s) * 256;
    if (s < PAST) { const int pg = page_table[b * 16 + (s >> 7)]; return cache + ((size_t)pg * 128 + (s & 127)) * 256; }
    return own_s + ((size_t)b * DS + (s - PAST)) * 256;
}

template <bool PROMPT, int NREG>
__device__ __forceinline__ void select_emit(const float* sc, int qpos, int lane, unsigned long long* maskcol, int* selrow) {
    const unsigned long long ltmask = (1ull << lane) - 1ull;
    unsigned key[NREG];
    unsigned kmax = 0u, kmin = 0xffffffffu;
#pragma unroll
    for (int j = 0; j < NREG; ++j) {
        const int s = j * 64 + lane;
        const bool cand = (s >= 16 && s <= qpos);
        const float x = cand ? sc[s] : -INFINITY;
        const unsigned u = __float_as_uint(x);
        key[j] = (u & 0x80000000u) ? ~u : (u | 0x80000000u);
        kmax = max(kmax, key[j]);
        kmin = min(kmin, cand ? key[j] : 0xffffffffu);
    }
#pragma unroll
    for (int o = 1; o < 64; o <<= 1) { kmax = max(kmax, (unsigned)__shfl_xor((int)kmax, o)); kmin = min(kmin, (unsigned)__shfl_xor((int)kmin, o)); }
    unsigned lo = kmin, hi = kmax;
    bool exact = false;
    while (lo < hi) {
        const unsigned mid = lo + ((hi - lo) >> 1) + ((hi - lo) & 1u);
        int c = 0;
#pragma unroll
        for (int j = 0; j < NREG; ++j) c += __popcll(__ballot(key[j] >= mid));
        if (c >= 240) { lo = mid; if (c == 240) { exact = true; break; } } else hi = mid - 1u;
    }
    const unsigned T = lo;
    if (!PROMPT) { if (lane < 16) selrow[lane] = lane; }
    int base = 16;
    unsigned long long myword = 0ull, word64 = 0ull;
    if (exact) {
#pragma unroll
        for (int j = 0; j < NREG; ++j) {
            const bool take = key[j] >= T;
            unsigned long long m = __ballot(take);
            if (PROMPT) {
                if (j == 0) m |= 0xFFFFull;
                if (j < 64) { if (lane == j) myword = m; } else word64 = m;
            } else {
                if (take) selrow[base + __popcll(m & ltmask)] = j * 64 + lane;
                base += __popcll(m);
            }
        }
    } else {
        int cgt = 0;
#pragma unroll
        for (int j = 0; j < NREG; ++j) cgt += __popcll(__ballot(key[j] > T));
        const int need_eq = 240 - cgt;
        int erun = 0;
#pragma unroll
        for (int j = 0; j < NREG; ++j) {
            const bool gt = key[j] > T, eq = key[j] == T;
            const unsigned long long meq = __ballot(eq);
            const int rank = erun + __popcll(meq & ltmask);
            const bool take = gt || (eq && rank < need_eq);
            unsigned long long m = __ballot(take);
            if (PROMPT) {
                if (j == 0) m |= 0xFFFFull;
                if (j < 64) { if (lane == j) myword = m; } else word64 = m;
            } else {
                if (take) selrow[base + __popcll(m & ltmask)] = j * 64 + lane;
                base += __popcll(m);
            }
            erun += __popcll(meq);
        }
    }
    if (PROMPT) {
        if (NREG == 65) { maskcol[(size_t)lane * LPAD] = myword; if (lane == 0) maskcol[(size_t)64 * LPAD] = word64; }
        else { if (lane < NREG) maskcol[(size_t)lane * LPAD] = myword; else if (lane < 64) maskcol[(size_t)lane * LPAD] = 0ull; if (lane == 0) maskcol[(size_t)64 * LPAD] = 0ull; }
    }
}

__device__ __forceinline__ bf16x8 ld_f32x8_bf16(const float* p) {
    const f32x4 a = *(const f32x4*)p, b = *(const f32x4*)(p + 4);
    u32x4 q; q[0] = pk2(a[0], a[1]); q[1] = pk2(a[2], a[3]); q[2] = pk2(b[0], b[1]); q[3] = pk2(b[2], b[3]);
    return __builtin_bit_cast(bf16x8, q);
}
__device__ __forceinline__ void indexer_sample_unit(const Params& p, float* sc, int b, int tid) {
    const int lane = tid & 63, wave = tid >> 6;
    const int r = lane & 31, hh = lane >> 5;
    bf16x8 af[4];
    {
        const int e2 = r & 3, hb = (r >> 2) & 1, a = r >> 3;
        const int qi = 2 * hb + (a >> 1), head = 4 * (a & 1) + e2;
        const float* ap = p.iq + ((size_t)NPR + b * 4 + qi) * 512 + head * 64 + 8 * hh;
#pragma unroll
        for (int ks = 0; ks < 4; ++ks) af[ks] = ld_f32x8_bf16(ap + 16 * ks);
    }
    float wq[2][8];
#pragma unroll
    for (int ql = 0; ql < 2; ++ql) {
        const float* wp = p.iw + ((size_t)NPR + b * 4 + 2 * hh + ql) * 8;
        const f32x4 w0 = *(const f32x4*)wp, w1 = *(const f32x4*)(wp + 4);
#pragma unroll
        for (int e2 = 0; e2 < 4; ++e2) { wq[ql][e2] = w0[e2]; wq[ql][4 + e2] = w1[e2]; }
    }
    asm volatile("" :: "v"(af[0]), "v"(af[1]), "v"(af[2]), "v"(af[3]));
#pragma unroll
    for (int ql = 0; ql < 2; ++ql) asm volatile("" :: "v"(wq[ql][0]), "v"(wq[ql][1]), "v"(wq[ql][2]), "v"(wq[ql][3]), "v"(wq[ql][4]), "v"(wq[ql][5]), "v"(wq[ql][6]), "v"(wq[ql][7]));
    const float* kps[9];
#pragma unroll
    for (int i = 0; i < 9; ++i) {
        const int kt = wave + 8 * i;
        const int s = 32 * (kt < 65 ? kt : 64) + r;
        const float* kp;
        if (s < PAST) { const int pg = p.page_table[b * 16 + (s >> 7)]; kp = p.cache_ik + ((size_t)pg * 128 + (s & 127)) * 64; }
        else kp = p.ik_sample + ((size_t)b * DS + ((s - PAST) & 3)) * 64;
        kps[i] = kp + 8 * hh;
    }
    f32x4 nx[8];
#pragma unroll
    for (int ks = 0; ks < 4; ++ks) { nx[2 * ks] = *(const f32x4*)(kps[0] + 16 * ks); nx[2 * ks + 1] = *(const f32x4*)(kps[0] + 16 * ks + 4); }
#pragma unroll
    for (int i = 0; i < 9; ++i) {
        const int kt = wave + 8 * i;
        if (kt < 65) {
            const int s = 32 * kt + r;
            bf16x8 bq[4];
#pragma unroll
            for (int ks = 0; ks < 4; ++ks) {
                u32x4 q; q[0] = pk2(nx[2 * ks][0], nx[2 * ks][1]); q[1] = pk2(nx[2 * ks][2], nx[2 * ks][3]);
                q[2] = pk2(nx[2 * ks + 1][0], nx[2 * ks + 1][1]); q[3] = pk2(nx[2 * ks + 1][2], nx[2 * ks + 1][3]);
                bq[ks] = __builtin_bit_cast(bf16x8, q);
            }
            if (i + 1 < 9) {
#pragma unroll
                for (int ks = 0; ks < 4; ++ks) { nx[2 * ks] = *(const f32x4*)(kps[i + 1] + 16 * ks); nx[2 * ks + 1] = *(const f32x4*)(kps[i + 1] + 16 * ks + 4); }
            }
            f32x16 acc;
#pragma unroll
            for (int j = 0; j < 16; ++j) acc[j] = 0.f;
#pragma unroll
            for (int ks = 0; ks < 4; ++ks) acc = MFMA32(af[ks], bq[ks], acc);
#pragma unroll
            for (int ql = 0; ql < 2; ++ql) {
                float v = 0.f;
#pragma unroll
                for (int a2 = 0; a2 < 2; ++a2)
#pragma unroll
                    for (int e2 = 0; e2 < 4; ++e2) v += wq[ql][4 * a2 + e2] * fmaxf(acc[4 * (2 * ql + a2) + e2], 0.f);
                sc[(2 * hh + ql) * 2112 + s] = v;
            }
        }
    }
    lds_barrier();
    if (wave < 4) select_emit<false, 33>(sc + wave * 2112, PAST + wave, lane, nullptr, p.sel + ((size_t)NPR + b * 4 + wave) * 256);
    lds_barrier();
}

__device__ __forceinline__ void indexer_prompt_unit(const Params& p, float* sc, int b, int g8, int tid) {
    const int lane = tid & 63, wave = tid >> 6;
    const int r = lane & 31, hh = lane >> 5;
    const int t0 = g8 * 8;
    if (t0 < 256) {
        const int qpos = t0 + wave;
        unsigned long long* maskcol = p.maskT + (size_t)b * 65 * LPAD + qpos;
        for (int j = lane; j < 65; j += 64) {
            const int lo = j * 64;
            unsigned long long m = 0ull;
            if (qpos >= lo + 63) m = ~0ull; else if (qpos >= lo) m = (1ull << (qpos - lo + 1)) - 1ull;
            maskcol[(size_t)j * LPAD] = m;
        }
        return;
    }
    bf16x8 af[2][4];
    {
        const int e2 = r & 3, hb = (r >> 2) & 1, a = r >> 3;
        const int qi = 2 * hb + (a >> 1), head = 4 * (a & 1) + e2;
        (void)qi; (void)head;
#pragma unroll
        for (int rt = 0; rt < 2; ++rt) {
            const bf16_t* ap = p.iq_b + ((((size_t)b * 514 + g8) * 2 + rt) * 4) * 512 + lane * 8;
#pragma unroll
            for (int ks = 0; ks < 4; ++ks) af[rt][ks] = *(const bf16x8*)(ap + 512 * ks);
        }
    }
    float wq[2][2][8];
#pragma unroll
    for (int rt = 0; rt < 2; ++rt)
#pragma unroll
        for (int ql = 0; ql < 2; ++ql) {
            const float* wp = p.iw + ((size_t)b * LP + t0 + 4 * rt + 2 * hh + ql) * 8;
            const f32x4 w0 = *(const f32x4*)wp, w1 = *(const f32x4*)(wp + 4);
#pragma unroll
            for (int e2 = 0; e2 < 4; ++e2) { wq[rt][ql][e2] = w0[e2]; wq[rt][ql][4 + e2] = w1[e2]; }
        }
    const int nkt = (t0 + 7) / 32 + 1;
    const bf16_t* kbase = p.ik_b + (size_t)b * LPAD * 64 + lane * 8;
    bf16x8 bq[2][4], bn[2][4];
#pragma unroll
    for (int j = 0; j < 2; ++j) {
        const int kt = wave + 8 * j, ktc = (kt < nkt) ? kt : (nkt - 1);
#pragma unroll
        for (int ks = 0; ks < 4; ++ks) bq[j][ks] = *(const bf16x8*)(kbase + (size_t)ktc * 2048 + 512 * ks);
    }
    asm volatile("" :: "v"(af[0][0]), "v"(af[0][1]), "v"(af[0][2]), "v"(af[0][3]), "v"(af[1][0]), "v"(af[1][1]), "v"(af[1][2]), "v"(af[1][3]));
#pragma unroll
    for (int rt = 0; rt < 2; ++rt)
#pragma unroll
        for (int ql = 0; ql < 2; ++ql) asm volatile("" :: "v"(wq[rt][ql][0]), "v"(wq[rt][ql][1]), "v"(wq[rt][ql][2]), "v"(wq[rt][ql][3]), "v"(wq[rt][ql][4]), "v"(wq[rt][ql][5]), "v"(wq[rt][ql][6]), "v"(wq[rt][ql][7]));
    for (int kt0 = wave; kt0 < nkt; kt0 += 16) {
#pragma unroll
        for (int j = 0; j < 2; ++j) {
            const int kt = kt0 + 16 + 8 * j, ktc = (kt < nkt) ? kt : (nkt - 1);
#pragma unroll
            for (int ks = 0; ks < 4; ++ks) bn[j][ks] = *(const bf16x8*)(kbase + (size_t)ktc * 2048 + 512 * ks);
        }
        f32x16 acc[2][2];
#pragma unroll
        for (int j = 0; j < 2; ++j)
#pragma unroll
            for (int rt = 0; rt < 2; ++rt)
#pragma unroll
                for (int i = 0; i < 16; ++i) acc[j][rt][i] = 0.f;
#pragma unroll
        for (int ks = 0; ks < 4; ++ks)
#pragma unroll
            for (int j = 0; j < 2; ++j)
#pragma unroll
                for (int rt = 0; rt < 2; ++rt) acc[j][rt] = MFMA32(af[rt][ks], bq[j][ks], acc[j][rt]);
#pragma unroll
        for (int j = 0; j < 2; ++j) {
            const int kt = kt0 + 8 * j;
            if (kt < nkt) {
#pragma unroll
                for (int rt = 0; rt < 2; ++rt)
#pragma unroll
                    for (int ql = 0; ql < 2; ++ql) {
                        float s = 0.f;
#pragma unroll
                        for (int a2 = 0; a2 < 2; ++a2)
#pragma unroll
                            for (int e2 = 0; e2 < 4; ++e2) s += wq[rt][ql][4 * a2 + e2] * fmaxf(acc[j][rt][4 * (2 * ql + a2) + e2], 0.f);
                        sc[(4 * rt + 2 * hh + ql) * 4160 + 32 * kt + r] = s;
                    }
            }
        }
#pragma unroll
        for (int j = 0; j < 2; ++j)
#pragma unroll
            for (int ks = 0; ks < 4; ++ks) bq[j][ks] = bn[j][ks];
    }
    lds_barrier();
    {
        const int qpos = t0 + wave;
        unsigned long long* mc = p.maskT + (size_t)b * 65 * LPAD + qpos;
        if (t0 + 7 < 17 * 64) select_emit<true, 17>(sc + wave * 4160, qpos, lane, mc, nullptr);
        else if (t0 + 7 < 33 * 64) select_emit<true, 33>(sc + wave * 4160, qpos, lane, mc, nullptr);
        else if (t0 + 7 < 49 * 64) select_emit<true, 49>(sc + wave * 4160, qpos, lane, mc, nullptr);
        else select_emit<true, 65>(sc + wave * 4160, qpos, lane, mc, nullptr);
    }
    lds_barrier();
}

__device__ __forceinline__ void indexer_phase(const Params& p, char* smem, int bid, int nb, int rep = 0) {
    int* slot = (int*)(smem + LDS_BYTES - 32);
    for (;;) {
        const int tid = tid_opaque();
        unsigned zofs = 0; asm volatile("" : "+v"(zofs));
        float* sc = (float*)(smem + zofs);
        if (threadIdx.x == 0) *slot = (int)atomicAdd(p.bar + 3648 + 16 * rep, 1u);
        lds_barrier();
        const int u = *slot;
        lds_barrier();
        if (u >= DB + BATCH * 514) break;
        if (u < DB) {
            indexer_sample_unit(p, sc, u, tid);
        } else {
            const int v = u - DB;
            indexer_prompt_unit(p, sc, v & 3, 513 - (v >> 2), tid);
        }
    }
}

__device__ __forceinline__ void attn_sample_query(const Params& p, char* smem, int row) {
    float* qs = (float*)smem;
    float* ps = qs + 1024;
    const float** kptr = (const float**)(ps + 2048);
    const float** vptr = kptr + 256;
    float* red = (float*)(vptr + 256);
    const int tid = tid_opaque(), lane = tid & 63, wave = tid >> 6;
    const int b = (row - NPR) >> 2;
    qs[tid] = p.qr[(size_t)row * 1024 + tid];
    qs[tid + 512] = p.qr[(size_t)row * 1024 + 512 + tid];
    if (tid < 256) {
        const int s = p.sel[(size_t)row * 256 + tid];
        const float *kp, *vp;
        if (s < PAST) { const int pg = p.page_table[b * 16 + ((s < 0 ? 0 : s) >> 7)]; const size_t ro = ((size_t)pg * 128 + ((s < 0 ? 0 : s) & 127)) * 256; kp = p.cache_k + ro; vp = p.cache_v + ro; }
        else { const size_t ro = ((size_t)b * DS + (s - PAST)) * 256; kp = p.k_sample + ro; vp = p.v_sample + ro; }
        kptr[tid] = (s < 0) ? nullptr : kp;
        vptr[tid] = vp;
    }
    lds_barrier();
    {
        const int j = tid & 255, kvh = tid >> 8;
        const float* kp0 = kptr[j];
        const bool valid = kp0 != nullptr;
        const float* kp = (valid ? kp0 : vptr[j]) + kvh * 128;
        float d0 = 0.f, d1 = 0.f, d2 = 0.f, d3 = 0.f;
        const float* q0 = qs + (kvh * 4) * 128;
#pragma unroll 16
        for (int c = 0; c < 32; ++c) {
            const f32x4 kv = *(const f32x4*)(kp + c * 4);
            const f32x4 a0 = *(const f32x4*)(q0 + c * 4), a1 = *(const f32x4*)(q0 + 128 + c * 4), a2 = *(const f32x4*)(q0 + 256 + c * 4),
                        a3 = *(const f32x4*)(q0 + 384 + c * 4);
            d0 += kv[0] * a0[0] + kv[1] * a0[1] + kv[2] * a0[2] + kv[3] * a0[3];
            d1 += kv[0] * a1[0] + kv[1] * a1[1] + kv[2] * a1[2] + kv[3] * a1[3];
            d2 += kv[0] * a2[0] + kv[1] * a2[1] + kv[2] * a2[2] + kv[3] * a2[3];
            d3 += kv[0] * a3[0] + kv[1] * a3[1] + kv[2] * a3[2] + kv[3] * a3[3];
        }
        const float scl = 0.08838834764831845f;
        ps[(kvh * 4 + 0) * 256 + j] = valid ? d0 * scl : -INFINITY;
        ps[(kvh * 4 + 1) * 256 + j] = valid ? d1 * scl : -INFINITY;
        ps[(kvh * 4 + 2) * 256 + j] = valid ? d2 * scl : -INFINITY;
        ps[(kvh * 4 + 3) * 256 + j] = valid ? d3 * scl : -INFINITY;
    }
    lds_barrier();
    {
        float v[4]; float m = -INFINITY;
#pragma unroll
        for (int i = 0; i < 4; ++i) { v[i] = ps[wave * 256 + lane + 64 * i]; m = fmaxf(m, v[i]); }
        m = wave_max(m);
        float sum = 0.f;
#pragma unroll
        for (int i = 0; i < 4; ++i) { v[i] = __expf(v[i] - m); sum += v[i]; }
        sum = wave_sum(sum);
        const float inv = 1.f / sum;
#pragma unroll
        for (int i = 0; i < 4; ++i) ps[wave * 256 + lane + 64 * i] = v[i] * inv;
    }
    lds_barrier();
    {
        const int kvh = tid >> 8, kg = (tid >> 5) & 7, d4 = tid & 31;
        f32x4 acc[4];
#pragma unroll
        for (int g = 0; g < 4; ++g) acc[g] = (f32x4){0.f, 0.f, 0.f, 0.f};
#pragma unroll 16
        for (int i = 0; i < 32; ++i) {
            const int j = kg * 32 + i;
            const f32x4 vv = *(const f32x4*)(vptr[j] + kvh * 128 + d4 * 4);
#pragma unroll
            for (int g = 0; g < 4; ++g) acc[g] += vv * ps[(kvh * 4 + g) * 256 + j];
        }
#pragma unroll
        for (int g = 0; g < 4; ++g) *(f32x4*)(red + ((kg * 2 + kvh) * 4 + g) * 128 + d4 * 4) = acc[g];
    }
    lds_barrier();
    {
        const int h = wave, d = lane * 2;
        float o0 = 0.f, o1 = 0.f;
#pragma unroll
        for (int kg = 0; kg < 8; ++kg) { const f32x2 t = *(const f32x2*)(red + ((kg * 2 + (h >> 2)) * 4 + (h & 3)) * 128 + d); o0 += t[0]; o1 += t[1]; }
        *(unsigned*)(p.gated + (size_t)row * 1024 + h * 128 + d) = pk2(o0, o1);
    }
    lds_barrier();
}

constexpr int AT_K = 0, AT_V = 64 * 136, AT_ELEMS = 64 * 136 + 128 * 72;
__device__ __forceinline__ void attn_dense_unit(const Params& p, char* smem, int b, int kvh, int qb) {
    bf16_t* lds = (bf16_t*)smem;
    const int tid = tid_opaque(), lane = tid & 63, wave = tid >> 6;
    const int r = lane & 31, hh = lane >> 5;
    const int g = wave & 3, qs = wave >> 2;
    const int head = kvh * 4 + g;
    const int tq = 64 * qb + 32 * qs + r;
    const int tqc = (tq < LP) ? tq : (LP - 1);
    bf16x8 qf[8];
    {
        const bf16_t* qp = p.q_b + ((size_t)b * LP + tqc) * 1024 + head * 128 + 8 * hh;
#pragma unroll
        for (int ks = 0; ks < 8; ++ks) qf[ks] = *(const bf16x8*)(qp + 16 * ks);
    }
    f32x16 O[4];
#pragma unroll
    for (int i = 0; i < 4; ++i)
#pragma unroll
        for (int j = 0; j < 16; ++j) O[i][j] = 0.f;
    float mrun = -3.0e38f, lrun = 0.f;
    const bf16_t* Kg = p.k_b + ((size_t)(b * 2 + kvh) * LPAD) * 128;
    const bf16_t* Vg = p.vt_b + ((size_t)(b * 2 + kvh) * 128) * LPAD;
    const unsigned long long* mcol = p.maskT + (size_t)b * 65 * LPAD + tq;
    const int kc0 = tid, kc1 = tid + 512;
    uint4 sk0, sk1, sv0, sv1;
#define AT_GLOAD(kt_) do { const bf16_t* kg_ = Kg + (size_t)(kt_) * 64 * 128; const bf16_t* vg_ = Vg + (size_t)(kt_) * 64; \
        sk0 = *(const uint4*)(kg_ + (size_t)kc0 * 8); sk1 = *(const uint4*)(kg_ + (size_t)kc1 * 8); \
        sv0 = *(const uint4*)(vg_ + (size_t)(kc0 >> 3) * LPAD + (kc0 & 7) * 8); sv1 = *(const uint4*)(vg_ + (size_t)(kc1 >> 3) * LPAD + (kc1 & 7) * 8); } while (0)
#define AT_SSTORE(buf_) do { bf16_t* q_ = (buf_); \
        *(uint4*)(q_ + AT_K + (kc0 >> 4) * 136 + (kc0 & 15) * 8) = sk0; *(uint4*)(q_ + AT_K + (kc1 >> 4) * 136 + (kc1 & 15) * 8) = sk1; \
        *(uint4*)(q_ + AT_V + (kc0 >> 3) * 72 + (kc0 & 7) * 8) = sv0; *(uint4*)(q_ + AT_V + (kc1 >> 3) * 72 + (kc1 & 7) * 8) = sv1; } while (0)
    AT_GLOAD(0); AT_SSTORE(lds);
    unsigned long long mw_next = mcol[0];
    asm volatile("" :: "v"(qf[0]), "v"(qf[1]), "v"(qf[2]), "v"(qf[3]), "v"(qf[4]), "v"(qf[5]), "v"(qf[6]), "v"(qf[7]), "v"(mw_next));
    lds_barrier();
    for (int kt = 0; kt <= qb; ++kt) {
        unsigned zofs = 0; asm volatile("" : "+v"(zofs));
        bf16_t* cur = lds + (kt & 1) * AT_ELEMS + zofs;
        bf16_t* nxt = lds + ((kt + 1) & 1) * AT_ELEMS + zofs;
        const bool more = kt < qb;
        if (more) { AT_GLOAD(kt + 1); }
        const unsigned long long mw = mw_next;
        if (more) mw_next = mcol[(size_t)(kt + 1) * LPAD];
        f32x16 st[2];
#pragma unroll
        for (int j = 0; j < 16; ++j) { st[0][j] = 0.f; st[1][j] = 0.f; }
#pragma unroll
        for (int ks = 0; ks < 8; ++ks) {
            st[0] = MFMA32(*(const bf16x8*)(cur + AT_K + (r) * 136 + 16 * ks + 8 * hh), qf[ks], st[0]);
            st[1] = MFMA32(*(const bf16x8*)(cur + AT_K + (32 + r) * 136 + 16 * ks + 8 * hh), qf[ks], st[1]);
        }
        float mx = fmaxf(st[0][0], st[1][0]);
#pragma unroll
        for (int reg = 1; reg < 16; reg += 1) mx = fmaxf(mx, fmaxf(st[0][reg], st[1][reg]));
        mx = fmaxf(mx, __shfl_xor(mx, 32));
        const float mnew = (mx > mrun + 8.f) ? mx : mrun;
        if (__any(mnew != mrun)) {
            const float alpha = __builtin_amdgcn_exp2f(mrun - mnew);
            lrun *= alpha;
#pragma unroll
            for (int dt = 0; dt < 4; ++dt) O[dt] = O[dt] * alpha;
            mrun = mnew;
        }
        float psum = 0.f;
#pragma unroll
        for (int kk = 0; kk < 2; ++kk) {
            const int w = (int)((unsigned)(mw >> (32 * kk)) >> (4 * hh));
#pragma unroll
            for (int reg = 0; reg < 16; ++reg) {
                const int bit = (reg & 3) + 8 * (reg >> 2);
                const int keep = __builtin_amdgcn_sbfe(w, bit, 1);
                const float pv = __uint_as_float(__float_as_uint(__builtin_amdgcn_exp2f(st[kk][reg] - mrun)) & (unsigned)keep);
                st[kk][reg] = pv; psum += pv;
            }
        }
        lrun += psum;
        bf16x8 pb[2][2];
#pragma unroll
        for (int kk = 0; kk < 2; ++kk)
#pragma unroll
            for (int s = 0; s < 2; ++s) pb[kk][s] = pack_step(st[kk], s);
#pragma unroll
        for (int kk = 0; kk < 2; ++kk)
#pragma unroll
            for (int s = 0; s < 2; ++s)
#pragma unroll
                for (int dt = 0; dt < 4; ++dt)
                    O[dt] = MFMA32(*(const bf16x8*)(cur + AT_V + (32 * dt + r) * 72 + 32 * kk + 16 * s + 8 * hh), pb[kk][s], O[dt]);
        if (more) { AT_SSTORE(nxt); }
        lds_barrier();
    }
    const float ltot = lrun + __shfl_xor(lrun, 32);
    const float inv = 1.f / ltot;
    if (tq < LP) {
        bf16_t* op = p.gated + ((size_t)b * LP + tq) * 1024 + head * 128;
#pragma unroll
        for (int dt = 0; dt < 4; ++dt)
#pragma unroll
            for (int g4 = 0; g4 < 4; ++g4) {
                f32x4 v;
#pragma unroll
                for (int e2 = 0; e2 < 4; ++e2) v[e2] = O[dt][4 * g4 + e2] * inv;
                st_bf16x4(op + 32 * dt + 8 * g4 + 4 * hh, v);
            }
    }
    lds_barrier();
}

__device__ __forceinline__ void attn_phase(const Params& p, char* smem, int bid, int nb, int rep = 0) {
    int* slot = (int*)(smem + LDS_BYTES - 32);
    for (;;) {
        if (threadIdx.x == 0) *slot = (int)atomicAdd(p.bar + 3584 + 16 * rep, 1u);
        lds_barrier();
        const int u = *slot;
        lds_barrier();
        if (u >= 520 + NSR) break;
        if (u < 520) attn_dense_unit(p, smem, (u & 7) >> 1, u & 1, 64 - (u >> 3));
        else attn_sample_query(p, smem, NPR + (u - 520));
    }
}

#define XB_TMO      128
#define XB_XCNT(j)  (256  + 64 * (j))
#define XB_XSUB(j)  (1280 + 64 * (j))
#define XB_XGEN(j)  (2304 + 64 * (j))
#define XB_TOP      3328
#define XB_TOPGEN   3392
#define XCD_BAR_WORDS 3456
#define XB_SPIN_CAP (1u << 18)
#define LAS __attribute__((address_space(3)))

__device__ __forceinline__ unsigned xb_ld(unsigned* p)              { return __hip_atomic_load(p, __ATOMIC_RELAXED, __HIP_MEMORY_SCOPE_AGENT); }
__device__ __forceinline__ unsigned xb_add(unsigned* p, unsigned v) { return __hip_atomic_fetch_add(p, v, __ATOMIC_RELAXED, __HIP_MEMORY_SCOPE_AGENT); }
__device__ __forceinline__ unsigned xb_xcc_id() { return (unsigned)__builtin_amdgcn_s_getreg((3 << 11) | 20) & 0xFu; }
#define XB_SPIN(cond, bar) do { unsigned _sp = 0; while (cond) { __builtin_amdgcn_s_sleep(1); \
    if ((++_sp & 255u) == 0u) { if (xb_ld(&(bar)[XB_TMO])) break; if (_sp > XB_SPIN_CAP) { atomicAdd(&(bar)[XB_TMO], 1u); break; } } } } while (0)

struct XcdBarrier {
    unsigned* bar; unsigned x;
    volatile LAS unsigned* st;
};

__device__ __forceinline__ XcdBarrier xcd_barrier_post(unsigned* bar, volatile LAS unsigned* st) {
    XcdBarrier b; b.bar = bar; b.x = xb_xcc_id(); b.st = st;
    if (threadIdx.x == 0) (void)xb_add(&bar[XB_XCNT(b.x)], 1u);
    return b;
}
__device__ __forceinline__ void xcd_barrier_complete(unsigned* bar, unsigned x, unsigned& nloc, unsigned& nx) {
    const unsigned G = gridDim.x * gridDim.y * gridDim.z;
    unsigned sum, cnt, mine, sp = 0u;
    for (;;) {
        sum = 0u; cnt = 0u; mine = 0u;
#pragma unroll
        for (unsigned j = 0; j < 16; ++j) { const unsigned c = xb_ld(&bar[XB_XCNT(j)]); sum += c; cnt += (c > 0u) ? 1u : 0u; mine = (j == x) ? c : mine; }
        if (sum == G) break;
        __builtin_amdgcn_s_sleep(1);
        if ((++sp & 255u) == 0u) { if (xb_ld(&bar[XB_TMO])) break; if (sp > XB_SPIN_CAP) { atomicAdd(&bar[XB_TMO], 1u); break; } }
    }
    nloc = mine > 0u ? mine : 1u; nx = cnt > 0u ? cnt : 1u;
}

__device__ __forceinline__ void xcd_barrier(const XcdBarrier& b) {
    asm volatile("s_waitcnt vmcnt(0)" ::: "memory");
    __syncthreads();
    if (threadIdx.x == 0) {
        unsigned* bar = b.bar;
        __builtin_amdgcn_s_waitcnt(0);
        unsigned nloc = b.st[0], nx = b.st[1];
        if (nloc == 0u) { xcd_barrier_complete(bar, b.x, nloc, nx); b.st[0] = nloc; b.st[1] = nx; }
        const unsigned old = xb_add(&bar[XB_XSUB(b.x)], 1u);
        const unsigned gen = old / nloc;
        if (old + 1u == (gen + 1u) * nloc) {
            __builtin_amdgcn_fence(__ATOMIC_RELEASE, "agent");
            asm volatile("s_waitcnt vmcnt(0)" ::: "memory");
            const unsigned og = xb_add(&bar[XB_TOP], 1u);
            const unsigned tg = og / nx;
            if (og + 1u == (tg + 1u) * nx) xb_add(&bar[XB_TOPGEN], 1u);
            else XB_SPIN(xb_ld(&bar[XB_TOPGEN]) == tg, bar);
            __builtin_amdgcn_fence(__ATOMIC_ACQUIRE, "agent");
            xb_add(&bar[XB_XGEN(b.x)], 1u);
            asm volatile("s_waitcnt vmcnt(0)" ::: "memory");
        } else {
            XB_SPIN(xb_ld(&bar[XB_XGEN(b.x)]) == gen, bar);
            __builtin_amdgcn_fence(__ATOMIC_ACQUIRE, "agent");
            asm volatile("s_waitcnt vmcnt(0)" ::: "memory");
        }
    }
    __syncthreads();
}


constexpr int NPHASE = 19;
template <int PH>
__device__ __forceinline__ void run_phase(const Params& p, char* smem, int bid, int nb, int rep = 0) {
    constexpr int MT = MPAD / 256;
    if constexpr (PH == 0) phase_prologue(p, smem, bid, nb);
    else if constexpr (PH == 1) gemm_big(p.hA, D, p.wt_gin, GIN_PAD, EpiGdnIn{p.mixed, p.z, p.ba}, smem, bid, nb);
    else if constexpr (PH == 2) gdn_stageA(p, smem, bid, nb);
    else if constexpr (PH == 3) gdn_seq_phase(p, smem, bid, nb, rep);
    else if constexpr (PH == 4) gdn_gate_phase(p, bid, nb);
    else if constexpr (PH == 5) gemm_n1024(p.gated, 2048, p.wt_gout, EpiResid{p.preln, p.hA}, EpiSlab{p.slab}, 8, smem, bid, nb);
    else if constexpr (PH == 6) ln_phase(p.preln, p.ln1_g, p.ln1_b, p.hB, nullptr, nullptr, p.slab, 8, p.hA, bid, nb);
    else if constexpr (PH == 7) gemm_big(p.hB, D, p.wt_w1, DFF, EpiRelu2{p.act}, smem, bid, nb);
    else if constexpr (PH == 8) gemm_n1024(p.act, DFF, p.wt_w2, EpiResid{p.preln, p.hB}, EpiSlab{p.slab}, 16, smem, bid, nb);
    else if constexpr (PH == 9) ln_phase(p.preln, p.ln2_g, p.ln2_b, p.hA, nullptr, nullptr, p.slab, 16, p.hB, bid, nb);
    else if constexpr (PH == 10) gemm_big(p.hA, D, p.wt_din, DIN_PAD, EpiBf16{(bf16_t*)p.p1, DIN_PAD}, smem, bid, nb);
    else if constexpr (PH == 11) dsa_post_phase(p, smem, bid, nb);
    else if constexpr (PH == 12) indexer_phase(p, smem, bid, nb, rep);
    else if constexpr (PH == 13) attn_phase(p, smem, bid, nb, rep);
    else if constexpr (PH == 14) gemm_n1024(p.gated, D, p.wt_do, EpiResid{p.preln, p.hA}, EpiSlab{p.slab}, 4, smem, bid, nb);
    else if constexpr (PH == 15) ln_phase(p.preln, p.ln1_g + D, p.ln1_b + D, p.hB, nullptr, nullptr, p.slab, 4, p.hA, bid, nb);
    else if constexpr (PH == 16) gemm_big(p.hB, D, p.wt_w1 + (size_t)D * DFF, DFF, EpiRelu2{p.act}, smem, bid, nb);
    else if constexpr (PH == 17) gemm_n1024(p.act, DFF, p.wt_w2 + (size_t)D * DFF, EpiResid{p.preln, p.hB}, EpiSlab{p.slab}, 16, smem, bid, nb);
    else if constexpr (PH == 18) ln_phase(p.preln, p.ln2_g + D, p.ln2_b + D, nullptr, p.y_prompt, p.y_sample, p.slab, 16, p.hB, bid, nb);
}

template <int PH>
__global__ void __launch_bounds__(NTHR, 2) k_phase(Params p) {
    extern __shared__ __attribute__((aligned(16))) char smem[];
    run_phase<PH>(p, smem, blockIdx.x, gridDim.x);
}

template <int PH>
__device__ __forceinline__ void mega_run(const Params& p, char* smem, const XcdBarrier& bar) {
    run_phase<PH>(p, smem, blockIdx.x, gridDim.x);
#ifdef PROBE_MASK
    if constexpr ((PROBE_MASK >> PH) & 1) { xcd_barrier(bar); run_phase<PH>(p, smem, blockIdx.x, gridDim.x, 1); }
#endif
    if constexpr (PH + 1 < NPHASE) {
        xcd_barrier(bar);
        mega_run<PH + 1>(p, smem, bar);
    }
}
__global__ void __launch_bounds__(NTHR, 2) k_mega(Params p) {
    extern __shared__ __attribute__((aligned(16))) char smem[];
    volatile LAS unsigned* st = (volatile LAS unsigned*)(smem + LDS_BYTES - 16);
    if (threadIdx.x == 0) { st[0] = 0u; st[1] = 0u; st[2] = 0u; st[3] = 0u; }
    __syncthreads();
    XcdBarrier bar = xcd_barrier_post(p.bar, st);
    mega_run<0>(p, smem, bar);
}

template <int PH>
void launch_phase(const Params& p, hipStream_t stream) {
    static bool attr_done = false;
    if (!attr_done) {
        (void)hipFuncSetAttribute((const void*)k_phase<PH>, hipFuncAttributeMaxDynamicSharedMemorySize, LDS_BYTES);
        attr_done = true;
    }
    hipLaunchKernelGGL(k_phase<PH>, dim3(256), dim3(NTHR), LDS_BYTES, stream, p);
}
template <int PH>
void launch_all(const Params& p, hipStream_t stream) {
    launch_phase<PH>(p, stream);
    if constexpr (PH + 1 < NPHASE) launch_all<PH + 1>(p, stream);
}

}

extern "C" void kernel_launch(void* const* d_in, const int* in_sizes, int n_in, void* d_out, int out_size, void* d_ws, size_t ws_size,
                              hipStream_t stream) {
    Params p{};
    p.x_prompt = (const float*)d_in[0]; p.x_sample = (const float*)d_in[1]; p.state_gdn = (const float*)d_in[2];
    p.state_conv = (const float*)d_in[3]; p.cache_k = (const float*)d_in[4]; p.cache_v = (const float*)d_in[5];
    p.cache_ik = (const float*)d_in[6]; p.page_table = (const int*)d_in[7]; p.meta = (const float*)d_in[8];
    p.ln1_g = (const float*)d_in[9]; p.ln1_b = (const float*)d_in[10]; p.ln2_g = (const float*)d_in[11]; p.ln2_b = (const float*)d_in[12];
    p.mlp_w1 = (const float*)d_in[13]; p.mlp_w2 = (const float*)d_in[14]; p.gdn_w_in = (const float*)d_in[15];
    p.gdn_conv_w = (const float*)d_in[16]; p.gdn_a_log = (const float*)d_in[17]; p.gdn_dt_bias = (const float*)d_in[18];
    p.gdn_norm_w = (const float*)d_in[19]; p.gdn_w_out = (const float*)d_in[20]; p.dsa_w_in = (const float*)d_in[21];
    p.dsa_ik_g = (const float*)d_in[22]; p.dsa_ik_b = (const float*)d_in[23]; p.dsa_w_o = (const float*)d_in[24];
    float* o = (float*)d_out;
    p.y_prompt = o; o += (size_t)BATCH * SEQ * D;
    p.y_sample = o; o += (size_t)NSR * D;
    p.gs_prompt = o; o += (size_t)BATCH * 16 * 128 * 128;
    p.gc_prompt = o; o += (size_t)BATCH * 3 * 4096;
    p.gs_sample = o; o += (size_t)DB * 16 * 128 * 128;
    p.gc_sample = o; o += (size_t)DB * 3 * 4096;
    p.k_prompt = o; o += (size_t)NPR * 256;
    p.v_prompt = o; o += (size_t)NPR * 256;
    p.ik_prompt = o; o += (size_t)NPR * 64;
    p.k_sample = o; o += (size_t)NSR * 256;
    p.v_sample = o; o += (size_t)NSR * 256;
    p.ik_sample = o; o += (size_t)NSR * 64;
    char* w = (char*)d_ws;
    auto take = [&](size_t bytes) { char* r = w; w += (bytes + 255) & ~(size_t)255; return r; };
    p.bar = (unsigned*)take(16384);
    p.wt_gin = (bf16_t*)take((size_t)GIN_PAD * D * 2);
    p.wt_gout = (bf16_t*)take((size_t)D * 2048 * 2);
    p.wt_w1 = (bf16_t*)take((size_t)2 * D * DFF * 2);
    p.wt_w2 = (bf16_t*)take((size_t)2 * D * DFF * 2);
    p.wt_din = (bf16_t*)take((size_t)DIN_PAD * D * 2);
    p.wt_do = (bf16_t*)take((size_t)D * D * 2);
    p.hA = (bf16_t*)take((size_t)MPAD * D * 2);
    p.hB = (bf16_t*)take((size_t)MPAD * D * 2);
    p.preln = (float*)take((size_t)MPAD * D * 4);
    p.mixed = (bf16_t*)take((size_t)MPAD * 4096 * 2);
    p.z = (bf16_t*)take((size_t)MPAD * 2048 * 2);
    p.ba = (float*)take((size_t)MPAD * 32 * 4);
    p.gated = (bf16_t*)take((size_t)MPAD * 2048 * 2);
    p.act = (bf16_t*)take((size_t)MPAD * DFF * 2);
    p.p1 = (float*)take((size_t)MPAD * DIN_PAD * 4);
    p.qr = (float*)take((size_t)MPAD * 1024 * 4);
    p.iq = (float*)take((size_t)MPAD * 512 * 4);
    p.iw = (float*)take((size_t)MPAD * 8 * 4);
    p.sel = (int*)take((size_t)MPAD * 256 * 4);
    p.g_o = (bf16_t*)take((size_t)NPR * 2048 * 2);
    p.rope_tab = (float*)take((size_t)LP * 24 * 2 * 4);
    p.slab = (float*)take((size_t)16 * 768 * 1024 * 4);
    p.q_b = (bf16_t*)take((size_t)NPR * 1024 * 2);
    p.k_b = (bf16_t*)take((size_t)BATCH * 2 * LPAD * 128 * 2);
    p.vt_b = (bf16_t*)take((size_t)BATCH * 2 * 128 * LPAD * 2);
    p.iq_b = (bf16_t*)take((size_t)NPR * 512 * 2);
    p.ik_b = (bf16_t*)take((size_t)BATCH * LPAD * 64 * 2);
    p.maskT = (unsigned long long*)take((size_t)BATCH * 65 * LPAD * 8);
    p.g_dec = (float*)take((size_t)NCU * 4);
    p.g_u = (float*)p.act;
    p.g_negw = (bf16_t*)p.p1;
    p.g_qg = p.g_negw + (size_t)NCU * 8192;
    p.g_kdT = (bf16_t*)p.qr;
    p.g_aqk = (bf16_t*)p.iq;
    if ((size_t)(w - (char*)d_ws) > ws_size) { fprintf(stderr, "kernel_launch: workspace too small (%zu needed, %zu given)\n", (size_t)(w - (char*)d_ws), ws_size); return; }
#if MEGA
    static int grid = 0;
    if (grid == 0) {
        int dev = 0, cus = 0;
        if (hipGetDevice(&dev) != hipSuccess || hipDeviceGetAttribute(&cus, hipDeviceAttributeMultiprocessorCount, dev) != hipSuccess || cus <= 0) cus = 256;
        (void)hipFuncSetAttribute((const void*)k_mega, hipFuncAttributeMaxDynamicSharedMemorySize, LDS_BYTES);
        grid = cus;
    }
    (void)hipMemsetAsync(p.bar, 0, 16384, stream);
    hipLaunchKernelGGL(k_mega, dim3(grid), dim3(NTHR), LDS_BYTES, stream, p);
#else
    launch_all<0>(p, stream);
#endif
}
```
